# Optimizing an MI355X kernel written in HIP

```python
import math
import jax, jax.numpy as jnp
from jax import lax
import numpy as np

D_MODEL = 1024
BATCH = 8
SEQ = 4096
DEPTH = 1
DEC_BATCH = 128
DEC_SEQ = 4
PAST_LEN = 16384
PAGE_SIZE = 128

N_META = 16
EPS = 1e-6
HEAD_DIM = 64
N_HEADS_A = D_MODEL // 2 // HEAD_DIM
N_KV_HEADS = N_HEADS_A // 4
GROUP = N_HEADS_A // N_KV_HEADS
WINDOW = 128
BLOCK = 128
ROPE_THETA = 10000.0
SWA_CACHE = min(WINDOW, PAST_LEN)
DK = 128
DV = 128
N_HEADS_B = D_MODEL // 2 // DV
CONV_W = 4
CHUNK = 64
D_FF = -(-8 * D_MODEL // (3 * 256)) * 256

Q_A = N_HEADS_A * HEAD_DIM
KV_A = N_KV_HEADS * HEAD_DIM
QK_B = N_HEADS_B * DK
V_B = N_HEADS_B * DV
CONV_DIM = 2 * QK_B + V_B
IN_SIZES = (Q_A, KV_A, KV_A, CONV_DIM, V_B, N_HEADS_B, N_HEADS_B, 2 * D_MODEL)
IN_DIM = sum(IN_SIZES)

kernel_name = 'hybrid_swa_sink_gated_deltanet_step'


def _rms_norm(x, w):
    xf = x.astype(jnp.float32)
    y = xf * lax.rsqrt(jnp.mean(xf * xf, axis=-1, keepdims=True) + EPS)
    return (y * w.astype(jnp.float32)).astype(x.dtype)


def _gated_rms_norm(o, z, w):
    of = o.astype(jnp.float32)
    y = of * lax.rsqrt(jnp.mean(of * of, axis=-1, keepdims=True) + EPS) * w.astype(jnp.float32)
    return (y * jax.nn.silu(z.astype(jnp.float32))).astype(z.dtype)


def _l2norm(x):
    return x * lax.rsqrt(jnp.sum(x * x, axis=-1, keepdims=True) + EPS)


def _rope(x, pos):
    half = HEAD_DIM // 2
    inv = ROPE_THETA ** (-jnp.arange(half, dtype=jnp.float32) / half)
    ang = pos.astype(jnp.float32)[:, None] * inv[None, :]
    cos = jnp.cos(ang)[None, :, None, :]
    sin = jnp.sin(ang)[None, :, None, :]
    xf = x.astype(jnp.float32)
    x1, x2 = xf[..., :half], xf[..., half:]
    return jnp.concatenate([x1 * cos - x2 * sin, x2 * cos + x1 * sin], axis=-1).astype(x.dtype)


def _sink_softmax(s, sinks, mask):
    sk = sinks.astype(jnp.float32).reshape(N_KV_HEADS, GROUP, 1, 1)
    s = jnp.where(mask, s, -jnp.inf)
    m = jnp.maximum(jnp.max(s, axis=-1, keepdims=True), sk)
    p = jnp.exp(s - m)
    return p / (jnp.sum(p, axis=-1, keepdims=True) + jnp.exp(sk - m))


def _swa_prompt(q, k, v, sinks):
    B, T = q.shape[:2]
    nb = -(-T // BLOCK)
    pad = ((0, 0), (0, nb * BLOCK - T), (0, 0), (0, 0))
    qb = jnp.pad(q, pad).reshape(B, nb, BLOCK, N_KV_HEADS, GROUP, HEAD_DIM)
    kb = jnp.pad(k, pad).reshape(B, nb, BLOCK, N_KV_HEADS, HEAD_DIM)
    vb = jnp.pad(v, pad).reshape(B, nb, BLOCK, N_KV_HEADS, HEAD_DIM)

    def band(x):
        prev = jnp.concatenate([jnp.zeros_like(x[:, :1]), x[:, :-1]], axis=1)
        return jnp.concatenate([prev, x], axis=2)

    kband, vband = band(kb), band(vb)
    qi = jnp.arange(BLOCK)[:, None]
    kj = jnp.arange(2 * BLOCK)[None, :]
    rel = qi + BLOCK - kj
    in_win = (rel >= 0) & (rel <= WINDOW)
    first = jnp.arange(nb)[:, None, None] == 0
    mask = in_win[None] & ~(first & (kj < BLOCK)[None])
    s = jnp.einsum('bnqkgd,bnskd->bnkgqs', qb, kband, preferred_element_type=jnp.float32) * (HEAD_DIM ** -0.5)
    p = _sink_softmax(s, sinks, mask[None, :, None, None])
    o = jnp.einsum('bnkgqs,bnskd->bnqkgd', p.astype(v.dtype), vband)
    return o.reshape(B, nb * BLOCK, Q_A)[:, :T]


def _swa_sample(q, k, v, k_past, v_past, sinks):
    B, L = q.shape[:2]
    kc = jnp.concatenate([k_past.astype(k.dtype), k], axis=1)
    vc = jnp.concatenate([v_past.astype(v.dtype), v], axis=1)
    qg = q.reshape(B, L, N_KV_HEADS, GROUP, HEAD_DIM)
    qi = jnp.arange(L)[:, None]
    kj = jnp.arange(SWA_CACHE + L)[None, :]
    rel = qi + SWA_CACHE - kj
    mask = (rel >= 0) & (rel <= WINDOW)
    s = jnp.einsum('bqkgd,bskd->bkgqs', qg, kc, preferred_element_type=jnp.float32) * (HEAD_DIM ** -0.5)
    p = _sink_softmax(s, sinks, mask)
    o = jnp.einsum('bkgqs,bskd->bqkgd', p.astype(v.dtype), vc).reshape(B, L, Q_A)
    return o, kc[:, -SWA_CACHE:], vc[:, -SWA_CACHE:]


def _short_conv(u, past, w):
    T = u.shape[1]
    up = jnp.concatenate([past.astype(u.dtype), u], axis=1)
    y = up[:, 0:T] * w[0]
    for i in range(1, CONV_W):
        y = y + up[:, i:i + T] * w[i]
    return jax.nn.silu(y), up[:, T:]


def _gated_delta_chunk(S, q, k, v, g, beta):
    L = q.shape[2]
    gc = jnp.cumsum(g, axis=-1)
    incl = jnp.tril(jnp.ones((L, L), dtype=bool))
    strict = jnp.tril(jnp.ones((L, L), dtype=bool), -1)
    diff = gc[..., :, None] - gc[..., None, :]
    decay = jnp.where(incl, jnp.exp(jnp.where(incl, diff, 0.0)), 0.0)
    kk = jnp.einsum('bhid,bhjd->bhij', k, k)
    a_mat = jnp.where(strict, beta[..., :, None] * decay * kk, 0.0) + jnp.eye(L, dtype=jnp.float32)
    eg = jnp.exp(gc)
    rhs = beta[..., None] * (v - eg[..., None] * jnp.einsum('bhid,bhde->bhie', k, S))
    u = lax.linalg.triangular_solve(a_mat, rhs, left_side=True, lower=True, unit_diagonal=True)
    qk = jnp.einsum('bhid,bhjd->bhij', q, k) * decay
    o = eg[..., None] * jnp.einsum('bhid,bhde->bhie', q, S) + jnp.einsum('bhij,bhje->bhie', qk, u)
    w_last = jnp.exp(gc[..., -1:] - gc)
    S_new = jnp.exp(gc[..., -1])[..., None, None] * S + jnp.einsum('bhjd,bhj,bhje->bhde', k, w_last, u)
    return S_new, o


def _delta_prompt(S0, q, k, v, g, beta):
    m = N_META
    S, o_meta = _gated_delta_chunk(S0, q[:, :, :m], k[:, :, :m], v[:, :, :m], g[:, :, :m], beta[:, :, :m])

    def to_chunks(x):
        x = x[:, :, m:]
        B, H, T = x.shape[:3]
        x = x.reshape((B, H, T // CHUNK, CHUNK) + x.shape[3:])
        return jnp.moveaxis(x, 2, 0)

    xs = (to_chunks(q), to_chunks(k), to_chunks(v), to_chunks(g), to_chunks(beta))
    S, o = lax.scan(lambda c, t: _gated_delta_chunk(c, *t), S, xs)
    o = jnp.moveaxis(o, 0, 2)
    o = o.reshape(o.shape[0], o.shape[1], -1, DV)
    return S, jnp.concatenate([o_meta, o], axis=2)


def _layer(h, pos, k_past, v_past, s0, conv_past, w, prompt):
    (norm_mix, w_in, conv_w, a_log, dt_bias, sinks, gdn_norm,
     w_oa, w_ob, w_out, norm_ffn, w_gate, w_up, w_down) = w
    B, T, _ = h.shape
    xn = _rms_norm(h, norm_mix)
    split_idx = np.cumsum(IN_SIZES)[:-1].tolist()
    qa, ka, va, qkv_b, z, a, b, gate_logits = jnp.split(xn @ w_in, split_idx, axis=-1)

    qa = _rope(qa.reshape(B, T, N_HEADS_A, HEAD_DIM), pos)
    ka = _rope(ka.reshape(B, T, N_KV_HEADS, HEAD_DIM), pos)
    va = va.reshape(B, T, N_KV_HEADS, HEAD_DIM)
    if prompt:
        oa = _swa_prompt(qa, ka, va, sinks)
        k_state, v_state = ka[:, -SWA_CACHE:], va[:, -SWA_CACHE:]
    else:
        oa, k_state, v_state = _swa_sample(qa, ka, va, k_past, v_past, sinks)

    cb, conv_state = _short_conv(qkv_b, conv_past, conv_w)
    qb, kb, vb = jnp.split(cb, [QK_B, 2 * QK_B], axis=-1)

    def heads(x, d):
        return jnp.swapaxes(x.reshape(B, T, N_HEADS_B, d), 1, 2).astype(jnp.float32)

    qb = _l2norm(heads(qb, DK)) * (DK ** -0.5)
    kb = _l2norm(heads(kb, DK))
    vb = heads(vb, DV)
    beta = jnp.swapaxes(jax.nn.sigmoid(b.astype(jnp.float32)), 1, 2)
    g = jnp.swapaxes(-jnp.exp(a_log.astype(jnp.float32))
                     * jax.nn.softplus(a.astype(jnp.float32) + dt_bias.astype(jnp.float32)), 1, 2)
    if prompt:
        s_new, ob = _delta_prompt(s0.astype(jnp.float32), qb, kb, vb, g, beta)
    else:
        s_new, ob = _gated_delta_chunk(s0.astype(jnp.float32), qb, kb, vb, g, beta)
    ob = jnp.swapaxes(ob, 1, 2).astype(h.dtype)
    ob = _gated_rms_norm(ob, z.reshape(B, T, N_HEADS_B, DV), gdn_norm).reshape(B, T, V_B)

    ga, gb = jnp.split(jax.nn.sigmoid(gate_logits), 2, axis=-1)
    h = h + (ga * (oa @ w_oa) + gb * (ob @ w_ob)) @ w_out

    hn = _rms_norm(h, norm_ffn)
    h = h + (jax.nn.silu(hn @ w_gate) * (hn @ w_up)) @ w_down
    return h, k_state, v_state, s_new.astype(h.dtype), conv_state


def setup_inputs(seed: int = 0) -> dict:
    key = jax.random.key(seed)
    ks = jax.random.split(key, 24)
    f32 = jnp.float32

    def nrm(k, shape, scale):
        return jax.random.normal(k, shape, f32) * scale

    dt = jnp.exp(jax.random.uniform(ks[11], (DEPTH, N_HEADS_B), f32, math.log(1e-3), math.log(1e-1)))
    return {
        'x_prompt': nrm(ks[0], (BATCH, SEQ, D_MODEL), 1.0),
        'x_sample': nrm(ks[1], (DEC_BATCH, DEC_SEQ, D_MODEL), 1.0),
        'cache_swa_k': nrm(ks[2], (DEPTH, DEC_BATCH, SWA_CACHE, N_KV_HEADS, HEAD_DIM), 1.0),
        'cache_swa_v': nrm(ks[3], (DEPTH, DEC_BATCH, SWA_CACHE, N_KV_HEADS, HEAD_DIM), 1.0),
        'state_delta': nrm(ks[4], (DEPTH, DEC_BATCH, N_HEADS_B, DK, DV), 0.1),
        'state_conv': nrm(ks[5], (DEPTH, DEC_BATCH, CONV_W - 1, CONV_DIM), 1.0),
        'meta_tokens': nrm(ks[6], (N_META, D_MODEL), 1.0),
        'norm_mix': 1.0 + nrm(ks[7], (DEPTH, D_MODEL), 0.02),
        'w_in': nrm(ks[8], (DEPTH, D_MODEL, IN_DIM), D_MODEL ** -0.5),
        'conv_w': nrm(ks[9], (DEPTH, CONV_W, CONV_DIM), CONV_W ** -0.5),
        'a_log': jnp.log(jax.random.uniform(ks[10], (DEPTH, N_HEADS_B), f32, 1.0, 16.0)),
        'dt_bias': dt + jnp.log(-jnp.expm1(-dt)),
        'sinks': nrm(ks[12], (DEPTH, N_HEADS_A), 0.5),
        'gdn_norm': 1.0 + nrm(ks[13], (DEPTH, DV), 0.02),
        'w_oa': nrm(ks[14], (DEPTH, Q_A, D_MODEL), Q_A ** -0.5),
        'w_ob': nrm(ks[15], (DEPTH, V_B, D_MODEL), V_B ** -0.5),
        'w_out': nrm(ks[16], (DEPTH, D_MODEL, D_MODEL), D_MODEL ** -0.5),
        'norm_ffn': 1.0 + nrm(ks[17], (DEPTH, D_MODEL), 0.02),
        'w_gate': nrm(ks[18], (DEPTH, D_MODEL, D_FF), D_MODEL ** -0.5),
        'w_up': nrm(ks[19], (DEPTH, D_MODEL, D_FF), D_MODEL ** -0.5),
        'w_down': nrm(ks[20], (DEPTH, D_FF, D_MODEL), D_FF ** -0.5),
        'norm_final': 1.0 + nrm(ks[21], (D_MODEL,), 0.02),
    }


def reference(x_prompt, x_sample, cache_swa_k, cache_swa_v, state_delta, state_conv,
              meta_tokens, norm_mix, w_in, conv_w, a_log, dt_bias, sinks, gdn_norm,
              w_oa, w_ob, w_out, norm_ffn, w_gate, w_up, w_down, norm_final):
    B = x_prompt.shape[0]
    meta = jnp.broadcast_to(meta_tokens.astype(x_prompt.dtype)[None], (B, N_META, D_MODEL))
    hp = jnp.concatenate([meta, x_prompt], axis=1)
    hs = x_sample
    pos_p = jnp.arange(hp.shape[1], dtype=jnp.int32)
    pos_s = PAST_LEN + jnp.arange(hs.shape[1], dtype=jnp.int32)
    kp_l, vp_l, sp_l, cp_l = [], [], [], []
    ks_l, vs_l, ss_l, cs_l = [], [], [], []
    for l in range(DEPTH):
        w = (norm_mix[l], w_in[l], conv_w[l], a_log[l], dt_bias[l], sinks[l], gdn_norm[l],
             w_oa[l], w_ob[l], w_out[l], norm_ffn[l], w_gate[l], w_up[l], w_down[l])
        s0_p = jnp.zeros((B, N_HEADS_B, DK, DV), jnp.float32)
        c0_p = jnp.zeros((B, CONV_W - 1, CONV_DIM), hp.dtype)
        hp, kp, vp, sp, cp = _layer(hp, pos_p, None, None, s0_p, c0_p, w, True)
        hs, kn, vn, sn, cn = _layer(hs, pos_s, cache_swa_k[l], cache_swa_v[l], state_delta[l], state_conv[l], w, False)
        kp_l.append(kp); vp_l.append(vp); sp_l.append(sp); cp_l.append(cp)
        ks_l.append(kn); vs_l.append(vn); ss_l.append(sn); cs_l.append(cn)
    y_prompt = _rms_norm(hp, norm_final)[:, N_META:]
    y_sample = _rms_norm(hs, norm_final)
    return (y_prompt, y_sample,
            jnp.stack(kp_l), jnp.stack(vp_l), jnp.stack(sp_l), jnp.stack(cp_l),
            jnp.stack(ks_l), jnp.stack(vs_l), jnp.stack(ss_l), jnp.stack(cs_l))
```

```cpp
#include <hip/hip_runtime.h>
#include <hip/hip_cooperative_groups.h>
#include <cstdio>
#include <cstdint>
namespace cg = cooperative_groups;

#ifndef MK_N_LAUNCHES
#define MK_N_LAUNCHES 1
#endif
#ifndef MK_BARRIER
#define MK_BARRIER 1
#endif

constexpr int D = 1024, NBATCH = 8, SEQ = 4096, NMETA = 16, TP = SEQ + NMETA, MP = NBATCH * TP;
constexpr int SBATCH = 128, TS = 4, MS = SBATCH * TS, MU = MP + MS, MUP = 33536, MC = NBATCH * SEQ + MS;
constexpr int PAST = 16384;
constexpr int HD = 64, NHA = 8, NKV = 2;
constexpr int NHB = 4, CONVD = 1536;
constexpr int DFF = 2816, NIN_SRC = 4872, NIN = 4864;
constexpr float EPS = 1e-6f;
constexpr float QSCALE = 0.125f * 1.4426950408889634f;

constexpr size_t MiB = 1u << 20, KiB = 1024;
constexpr size_t WS_CTL = 0, CTL_BYTES = 1 * MiB;
constexpr size_t WS_WIN = 1 * MiB;
constexpr size_t WS_WOA = 11 * MiB, WS_WOB = 12 * MiB;
constexpr size_t WS_WOUT = 13 * MiB;
constexpr size_t WS_WGU = 15 * MiB;
constexpr size_t WS_WD = 26 * MiB;
constexpr size_t WS_ROPE = 32 * MiB;
constexpr size_t WS_GB = 34 * MiB;
constexpr size_t WS_SC = 36 * MiB;
constexpr size_t WS_SS1 = 37 * MiB, WS_SS2 = 37 * MiB + 512 * KiB;
constexpr size_t WS_QA = 41 * MiB;
constexpr size_t WS_KV = WS_QA + (size_t)MUP * 512 * 2;
constexpr size_t WS_QKVB = WS_KV + (size_t)MUP * 256 * 2;
constexpr size_t WS_Z = WS_QKVB + (size_t)MUP * 1536 * 2;
constexpr size_t WS_G = WS_Z + (size_t)MUP * 512 * 2;
constexpr size_t WS_GEND = WS_G + (size_t)MUP * 2048 * 2;
constexpr size_t WS_B = 353 * MiB, WS_END = 512 * MiB;
static_assert(WS_GEND <= WS_B, "ws map");
constexpr size_t WS_XN = WS_B;
constexpr size_t PREP_SLOT = 96 * KiB;
constexpr int PREP_N1 = (int)((WS_END - WS_B) / PREP_SLOT);
constexpr size_t WS_OA = WS_QKVB;
constexpr size_t WS_OBRAW = WS_QKVB + 33 * MiB;
static_assert(WS_OBRAW + (size_t)MC * 512 * 4 <= WS_Z, "ws map");
constexpr size_t WS_OB = WS_QA;
constexpr size_t WS_MB = WS_B;
constexpr size_t WS_HB1 = WS_B + 66 * MiB;
static_assert(WS_HB1 + (size_t)MC * 1024 * 2 <= WS_END, "ws map");
constexpr size_t WS_ACT = WS_QA;
static_assert(WS_ACT + (size_t)MC * DFF * 2 <= WS_G, "ws map");
constexpr int SL_BEK = 0, SL_BV = 16 * 1024, SL_T = 32 * 1024, SL_QKD = 40 * 1024, SL_QE = 48 * 1024, SL_KWT = 64 * 1024, SL_A = 80 * 1024;
constexpr int N_PROMPT_SEQ = NBATCH * NHB, CHUNKS_P = 65, N_ITEMS_P = N_PROMPT_SEQ * CHUNKS_P, N_ITEMS = N_ITEMS_P + SBATCH * NHB;
static_assert(N_ITEMS <= PREP_N1 + (int)(((size_t)MC * 1024 * 4) / PREP_SLOT), "prep slots");

constexpr size_t O_YP = 0, O_YS = (size_t)NBATCH * SEQ * D, O_KP = O_YS + (size_t)MS * D, O_VP = O_KP + 8 * 128 * 2 * 64, O_DP = O_VP + 8 * 128 * 2 * 64,
                 O_CP = O_DP + 8 * 4 * 128 * 128, O_KS = O_CP + 8 * 3 * 1536, O_VS = O_KS + (size_t)128 * 128 * 2 * 64, O_DS = O_VS + (size_t)128 * 128 * 2 * 64,
                 O_CS = O_DS + (size_t)128 * 4 * 128 * 128, O_END = O_CS + (size_t)128 * 3 * 1536;
static_assert(O_END == 48074752, "d_out size");

#define DI __device__ __forceinline__
#define GAS __attribute__((address_space(1)))
#define LAS __attribute__((address_space(3)))
typedef unsigned short bf16;
typedef short bf16x8 __attribute__((ext_vector_type(8)));
typedef float f32x4 __attribute__((ext_vector_type(4)));
typedef float f32x2 __attribute__((ext_vector_type(2)));
typedef float f32x16 __attribute__((ext_vector_type(16)));
typedef unsigned u32x4 __attribute__((ext_vector_type(4)));
typedef unsigned u32x2 __attribute__((ext_vector_type(2)));
typedef __bf16 bf16x2_t __attribute__((ext_vector_type(2)));

DI unsigned cvtpk(float lo, float hi) { f32x2 v = {lo, hi}; bf16x2_t b = __builtin_convertvector(v, bf16x2_t); return __builtin_bit_cast(unsigned, b); }
DI bf16 f2bf(float f) { return (bf16)(cvtpk(f, 0.f) & 0xffffu); }
DI float bf2f(unsigned short h) { return __uint_as_float((unsigned)h << 16); }
DI float bflo(unsigned w) { return __uint_as_float(w << 16); }
DI float bfhi(unsigned w) { return __uint_as_float(w & 0xffff0000u); }
DI u32x4 pack8f(f32x4 a, f32x4 b) { u32x4 w; w.x = cvtpk(a[0], a[1]); w.y = cvtpk(a[2], a[3]); w.z = cvtpk(b[0], b[1]); w.w = cvtpk(b[2], b[3]); return w; }
DI float sigmoidf_(float x) { return 1.0f / (1.0f + __expf(-x)); }
DI float siluf_(float x) { return x / (1.0f + __expf(-x)); }
DI int pos_of_d(int d) { const int dd = d & 31; return 8 * (dd >> 2) + (dd & 3) + ((d >> 5) << 2); }
DI int d_of_pos(int p) { const int j = p & 7; return 4 * (p >> 3) + (j & 3) + ((j >> 2) << 5); }
namespace pg8 {
#define PG8_LAS __attribute__((address_space(3)))
typedef unsigned short bf16_t;
typedef short bf16x8 __attribute__((ext_vector_type(8)));
typedef float f32x4 __attribute__((ext_vector_type(4)));
typedef unsigned u32x4 __attribute__((ext_vector_type(4)));
constexpr int BM = 256, BK = 64, HALF = 128, HTB = HALF * BK * 2  , STAGE_BYTES = 8 * HTB, NXCD = 8, WGM = 8;

__host__ __device__ __forceinline__ int lds_byte(int r, int c) { const int st = (r >> 4) * 2 + (c >> 5), rr = r & 15, cc = c & 31, ob = rr * 64 + cc * 2; return st * 1024 + (ob ^ (((ob >> 9) & 1) << 5)); }
__host__ __device__ __forceinline__ void stage_rc(int b, int& R, int& C) { const int st = b / 1024, sb = b % 1024, swz = sb ^ (((sb >> 9) & 1) << 5); R = (st >> 1) * 16 + swz / 64; C = (st & 1) * 32 + (swz % 64) / 2; }
__host__ __device__ __forceinline__ int perm32(int rho) { const int n = rho >> 4, i = rho & 15; return 8 * (i >> 2) + 4 * n + (i & 3); }

struct Unit { int pm, pn; };
struct Gemm { const bf16_t* A; const bf16_t* Bt; int M, N, K; };

struct StaticOrder {
    int nM, nN, nwg, G, c;
    __host__ __device__ void init(int M, int N, int G_, int c_) { nM = M / BM; nN = N / BM; nwg = nM * nN; G = G_; c = c_; }
    __host__ __device__ bool next(int i, Unit& u) const {
        const long L = (long)i * G + c; if (L >= nwg) return false;
        int wgid = (int)L; { const int q = nwg / NXCD, r = nwg % NXCD, xcd = wgid % NXCD, off = wgid / NXCD; wgid = (xcd < r ? xcd * (q + 1) : r * (q + 1) + (xcd - r) * q) + off; }
        const int nig = WGM * nN, gid = wgid / nig, fm = gid * WGM, gsz = (nM - fm) < WGM ? (nM - fm) : WGM;
        u.pm = fm + ((wgid % nig) % gsz); u.pn = (wgid % nig) / gsz; return true;
    }
    __device__ __forceinline__ void a_ready(const Unit&) const {}
    __device__ __forceinline__ void done(const Unit&) const {}
};

__device__ __forceinline__ void urow_info(int urow, int& kind, int& b, int& t, int& ridx) {
    if (urow < MP) { b = urow / TP; t = urow - b * TP; kind = 0; ridx = t; }
    else if (urow < MU) { const int s = urow - MP; b = s >> 2; t = s & 3; kind = 1; ridx = TP + t; }
    else { kind = 2; b = 0; t = 0; ridx = 0; }
}
__device__ __forceinline__ int crow_to_urow(int crow) { return crow < NBATCH * SEQ ? crow + NMETA * ((crow >> 12) + 1) : MP + (crow - NBATCH * SEQ); }

struct EpiInProj {
    static constexpr bool PERM = true, AFTER_DRAIN = false;
    bf16_t *QA, *KV, *QKVB, *Z, *G; const float *COS, *SIN; float* out;
    __device__ __forceinline__ void operator()(const f32x4 (&acc)[2][2][4][2], const Unit& u, int wr, int wc, int fr, int fq) const {
        const int pn = u.pn;
#pragma unroll
        for (int ai = 0; ai < 2; ++ai)
#pragma unroll
            for (int m = 0; m < 4; ++m) {
                const int row = u.pm * BM + ai * HALF + wr * 64 + m * 16 + fr;
                int kind, b, t, ridx; urow_info(row, kind, b, t, ridx);
#pragma unroll
                for (int bj = 0; bj < 2; ++bj) {
                    const int cl = bj * HALF + wc * 32 + 8 * fq;
                    const f32x4 v0 = acc[ai][bj][m][0], v1 = acc[ai][bj][m][1];
                    if (pn < 2) {
                        const int c = pn * 256 + cl, d0 = ((c & 63) >> 3) * 4;
                        const f32x4 cs = *(const f32x4*)(COS + ridx * 32 + d0), sn = *(const f32x4*)(SIN + ridx * 32 + d0);
                        const f32x4 o1 = (v0 * cs - v1 * sn) * QSCALE, o2 = (v1 * cs + v0 * sn) * QSCALE;
                        *(u32x4*)(QA + (size_t)row * 512 + c) = pack8f(o1, o2);
                    } else if (pn == 2) {
                        if (bj == 0) {
                            const int kh = cl >> 6, d0 = ((cl & 63) >> 3) * 4;
                            const f32x4 cs = *(const f32x4*)(COS + ridx * 32 + d0), sn = *(const f32x4*)(SIN + ridx * 32 + d0);
                            const f32x4 o1 = v0 * cs - v1 * sn, o2 = v1 * cs + v0 * sn;
                            *(u32x4*)(KV + (size_t)row * 256 + cl) = pack8f(o1, o2);
                            float* dst = nullptr;
                            if (kind == 0 && t >= TP - 128) dst = out + O_KP + ((size_t)(b * 128 + (t - (TP - 128))) * 2 + kh) * 64;
                            else if (kind == 1) dst = out + O_KS + ((size_t)(b * 128 + 124 + t) * 2 + kh) * 64;
                            if (dst) { *(f32x4*)(dst + d0) = o1; *(f32x4*)(dst + 32 + d0) = o2; }
                        } else {
                            const int cv = cl - 128, kh = cv >> 6, dd = cv & 63;
                            *(u32x4*)(KV + (size_t)row * 256 + cl) = pack8f(v0, v1);
                            float* dst = nullptr;
                            if (kind == 0 && t >= TP - 128) dst = out + O_VP + ((size_t)(b * 128 + (t - (TP - 128))) * 2 + kh) * 64;
                            else if (kind == 1) dst = out + O_VS + ((size_t)(b * 128 + 124 + t) * 2 + kh) * 64;
                            if (dst) { *(f32x4*)(dst + dd) = v0; *(f32x4*)(dst + dd + 4) = v1; }
                        }
                    } else if (pn < 9) {
                        const int c = (pn - 3) * 256 + cl;
                        *(u32x4*)(QKVB + (size_t)row * 1536 + c) = pack8f(v0, v1);
                        float* dst = nullptr;
                        if (kind == 0 && t >= TP - 3) dst = out + O_CP + ((size_t)b * 3 + (t - (TP - 3))) * 1536;
                        else if (kind == 1 && t >= 1) dst = out + O_CS + ((size_t)b * 3 + (t - 1)) * 1536;
                        if (dst) { *(f32x4*)(dst + c) = v0; *(f32x4*)(dst + c + 4) = v1; }
                    } else if (pn < 11) {
                        const int c = (pn - 9) * 256 + cl;
                        *(u32x4*)(Z + (size_t)row * 512 + c) = pack8f(v0, v1);
                    } else {
                        const int c = (pn - 11) * 256 + cl;
                        f32x4 g0, g1;
#pragma unroll
                        for (int e = 0; e < 4; ++e) { g0[e] = sigmoidf_(v0[e]); g1[e] = sigmoidf_(v1[e]); }
                        *(u32x4*)(G + (size_t)row * 2048 + c) = pack8f(g0, g1);
                    }
                }
            }
    }
};

template <bool ACCUM> struct EpiMerge {
    static constexpr bool PERM = true, AFTER_DRAIN = false;
    bf16_t* MBp; const bf16_t* G; int gate_off;
    __device__ __forceinline__ void operator()(const f32x4 (&acc)[2][2][4][2], const Unit& u, int wr, int wc, int fr, int fq) const {
#pragma unroll
        for (int ai = 0; ai < 2; ++ai)
#pragma unroll
            for (int m = 0; m < 4; ++m) {
                const int crow = u.pm * BM + ai * HALF + wr * 64 + m * 16 + fr, urow = crow_to_urow(crow);
#pragma unroll
                for (int bj = 0; bj < 2; ++bj) {
                    const int c = u.pn * BM + bj * HALF + wc * 32 + 8 * fq;
                    const u32x4 gw = *(const u32x4*)(G + (size_t)urow * 2048 + gate_off + c);
                    f32x4 v0 = acc[ai][bj][m][0], v1 = acc[ai][bj][m][1];
                    v0[0] *= bflo(gw.x); v0[1] *= bfhi(gw.x); v0[2] *= bflo(gw.y); v0[3] *= bfhi(gw.y);
                    v1[0] *= bflo(gw.z); v1[1] *= bfhi(gw.z); v1[2] *= bflo(gw.w); v1[3] *= bfhi(gw.w);
                    bf16_t* p = MBp + (size_t)crow * 1024 + c;
                    if (ACCUM) { const u32x4 pw = *(const u32x4*)p;
                        v0[0] += bflo(pw.x); v0[1] += bfhi(pw.x); v0[2] += bflo(pw.y); v0[3] += bfhi(pw.y);
                        v1[0] += bflo(pw.z); v1[1] += bfhi(pw.z); v1[2] += bflo(pw.w); v1[3] += bfhi(pw.w); }
                    *(u32x4*)p = pack8f(v0, v1);
                }
            }
    }
};

struct EpiWout {
    static constexpr bool PERM = true, AFTER_DRAIN = false;
    const float* xp; const float* xs; float* H; bf16_t* HB; float* SS;
    __device__ __forceinline__ void operator()(const f32x4 (&acc)[2][2][4][2], const Unit& u, int wr, int wc, int fr, int fq) const {
#pragma unroll
        for (int ai = 0; ai < 2; ++ai)
#pragma unroll
            for (int m = 0; m < 4; ++m) {
                const int crow = u.pm * BM + ai * HALF + wr * 64 + m * 16 + fr;
                const float* hs = crow < NBATCH * SEQ ? xp + (size_t)crow * D : xs + (size_t)(crow - NBATCH * SEQ) * D;
                float ss = 0.f;
#pragma unroll
                for (int bj = 0; bj < 2; ++bj) {
                    const int c = u.pn * BM + bj * HALF + wc * 32 + 8 * fq;
                    const f32x4 r0 = *(const f32x4*)(hs + c) + acc[ai][bj][m][0], r1 = *(const f32x4*)(hs + c + 4) + acc[ai][bj][m][1];
                    *(f32x4*)(H + (size_t)crow * D + c) = r0; *(f32x4*)(H + (size_t)crow * D + c + 4) = r1;
                    *(u32x4*)(HB + (size_t)crow * D + c) = pack8f(r0, r1);
                    ss += (r0[0] * r0[0] + r0[1] * r0[1]) + (r0[2] * r0[2] + r0[3] * r0[3]) + (r1[0] * r1[0] + r1[1] * r1[1]) + (r1[2] * r1[2] + r1[3] * r1[3]);
                }
                ss += __shfl_xor(ss, 16); ss += __shfl_xor(ss, 32);
                if (fq == 0) atomicAdd(SS + crow, ss);
            }
    }
};

struct EpiGateUp {
    static constexpr bool PERM = true, AFTER_DRAIN = false;
    bf16_t* ACT; const float* SS;
    __device__ __forceinline__ void operator()(const f32x4 (&acc)[2][2][4][2], const Unit& u, int wr, int wc, int fr, int fq) const {
#pragma unroll
        for (int ai = 0; ai < 2; ++ai)
#pragma unroll
            for (int m = 0; m < 4; ++m) {
                const int crow = u.pm * BM + ai * HALF + wr * 64 + m * 16 + fr;
                const float rstd = rsqrtf(SS[crow] * (1.0f / D) + EPS);
                f32x4 a[2];
#pragma unroll
                for (int n = 0; n < 2; ++n)
#pragma unroll
                    for (int e = 0; e < 4; ++e) { const float g = acc[ai][0][m][n][e] * rstd, up = acc[ai][1][m][n][e] * rstd; a[n][e] = siluf_(g) * up; }
                *(u32x4*)(ACT + (size_t)crow * DFF + u.pn * HALF + wc * 32 + 8 * fq) = pack8f(a[0], a[1]);
            }
    }
};

struct EpiDown {
    static constexpr bool PERM = true, AFTER_DRAIN = false;
    float* H; float* SS;
    __device__ __forceinline__ void operator()(const f32x4 (&acc)[2][2][4][2], const Unit& u, int wr, int wc, int fr, int fq) const {
#pragma unroll
        for (int ai = 0; ai < 2; ++ai)
#pragma unroll
            for (int m = 0; m < 4; ++m) {
                const int crow = u.pm * BM + ai * HALF + wr * 64 + m * 16 + fr;
                float ss = 0.f;
#pragma unroll
                for (int bj = 0; bj < 2; ++bj) {
                    float* p = H + (size_t)crow * D + u.pn * BM + bj * HALF + wc * 32 + 8 * fq;
                    const f32x4 r0 = *(const f32x4*)p + acc[ai][bj][m][0], r1 = *(const f32x4*)(p + 4) + acc[ai][bj][m][1];
                    *(f32x4*)p = r0; *(f32x4*)(p + 4) = r1;
                    ss += (r0[0] * r0[0] + r0[1] * r0[1]) + (r0[2] * r0[2] + r0[3] * r0[3]) + (r1[0] * r1[0] + r1[1] * r1[1]) + (r1[2] * r1[2] + r1[3] * r1[3]);
                }
                ss += __shfl_xor(ss, 16); ss += __shfl_xor(ss, 32);
                if (fq == 0) atomicAdd(SS + crow, ss);
            }
    }
};
template <class Epi, class Sched, bool ALIGN_EPI = false, bool SP2 = false>
__device__ __forceinline__ void gemm_phase(PG8_LAS unsigned char* lds, const Gemm g, const Sched& S, const Epi& E) {
    const int tid = threadIdx.x, wid = __builtin_amdgcn_readfirstlane(tid >> 6), lane = tid & 63, wr = wid >> 2, wc = wid & 3, fr = lane & 15, fq = lane >> 4;
    const int K = g.K, nt = K / BK;
    unsigned voffA[2], voffB[2];
#pragma unroll
    for (int i = 0; i < 2; ++i) { int R, C; stage_rc(tid * 16 + i * 8192, R, C); const int Rb = Epi::PERM ? ((R & ~31) + perm32(R & 31)) : R;
        voffA[i] = (unsigned)(R * K + C) * 2u; voffB[i] = (unsigned)(Rb * K + C) * 2u; }
    const size_t kstep = (size_t)(BK * 2);
    const size_t hstep = (size_t)HALF * K * 2;
    const size_t tstep = 2 * hstep;
    const unsigned ldsw = (unsigned)wid * 1024u;
    const int aoff = lds_byte(wr * 64 + fr, fq * 8), boff = lds_byte(wc * 32 + fr, fq * 8);
#define PG8_SA(b, h) (((b) * 2 + (h)) * HTB)
#define PG8_SB(b, h) ((4 + (b) * 2 + (h)) * HTB)
#define PG8_STAGE(bufoff, gbase, voff) do { _Pragma("unroll") for (int _i = 0; _i < 2; ++_i) \
        __builtin_amdgcn_global_load_lds((const unsigned*)((const char*)(gbase) + (voff)[_i]), (PG8_LAS unsigned*)(lds + (bufoff) + ldsw + _i * 8192), 16, 0, 0); } while (0)
#define PG8_LDA(dst, b, h) do { _Pragma("unroll") for (int m = 0; m < 4; ++m) _Pragma("unroll") for (int k = 0; k < 2; ++k) dst[m][k] = *(const PG8_LAS bf16x8*)(lds + PG8_SA(b, h) + aoff + m * 2048 + k * 1024); } while (0)
#define PG8_LDB(dst, b, h) do { _Pragma("unroll") for (int n = 0; n < 2; ++n) _Pragma("unroll") for (int k = 0; k < 2; ++k) dst[n][k] = *(const PG8_LAS bf16x8*)(lds + PG8_SB(b, h) + boff + n * 2048 + k * 1024); } while (0)
#define PG8_MMA(ai, bj, At, Bt) do { __builtin_amdgcn_s_setprio(1); _Pragma("unroll") for (int m = 0; m < 4; ++m) _Pragma("unroll") for (int n = 0; n < 2; ++n) _Pragma("unroll") for (int k = 0; k < 2; ++k) \
        acc[ai][bj][m][n] = __builtin_amdgcn_mfma_f32_16x16x32_bf16(Bt[n][k], At[m][k], acc[ai][bj][m][n], 0, 0, 0); __builtin_amdgcn_s_setprio(0); } while (0)
#define PG8_WAIT_V(n) asm volatile("s_waitcnt vmcnt(" #n ")" ::: "memory")
#define PG8_WAIT_L(n) asm volatile("s_waitcnt lgkmcnt(" #n ")" ::: "memory")
#define PG8_BAR __builtin_amdgcn_s_barrier()
#define PG8_SCHED __builtin_amdgcn_sched_barrier(0)
    Unit cur, nxt; int ui = 0;
    if (!S.next(0, cur)) return;
    f32x4 acc[2][2][4][2];
#pragma unroll
    for (int a = 0; a < 2; ++a)
#pragma unroll
        for (int b = 0; b < 2; ++b)
#pragma unroll
            for (int m = 0; m < 4; ++m)
#pragma unroll
                for (int n = 0; n < 2; ++n) acc[a][b][m][n] = (f32x4){0.f, 0.f, 0.f, 0.f};
    bf16x8 At[4][2], B0[2][2], B1[2][2];
    const char* cA = (const char*)g.A + (size_t)cur.pm * tstep; const char* cB = (const char*)g.Bt + (size_t)cur.pn * tstep;
    S.a_ready(cur);
    if constexpr (SP2) {
        PG8_STAGE(PG8_SB(0, 0), cB, voffB); PG8_STAGE(PG8_SB(0, 1), cB + hstep, voffB); PG8_STAGE(PG8_SA(0, 0), cA, voffA); PG8_STAGE(PG8_SA(0, 1), cA + hstep, voffA);
        if (wr == 1) PG8_BAR;
        PG8_WAIT_V(2); PG8_BAR;
        PG8_STAGE(PG8_SB(1, 0), cB + kstep, voffB); PG8_STAGE(PG8_SA(1, 0), cA + kstep, voffA); PG8_STAGE(PG8_SB(1, 1), cB + hstep + kstep, voffB);
        PG8_WAIT_V(6); PG8_BAR;
    } else {
        PG8_STAGE(PG8_SB(0, 0), cB, voffB); PG8_STAGE(PG8_SA(0, 0), cA, voffA); PG8_STAGE(PG8_SB(0, 1), cB + hstep, voffB); PG8_STAGE(PG8_SA(0, 1), cA + hstep, voffA);
        if (wr == 1) PG8_BAR;
        PG8_WAIT_V(4); PG8_BAR;
        PG8_STAGE(PG8_SB(1, 0), cB + kstep, voffB); PG8_STAGE(PG8_SA(1, 0), cA + kstep, voffA); PG8_STAGE(PG8_SB(1, 1), cB + hstep + kstep, voffB);
        PG8_WAIT_V(6); PG8_BAR;
    }
    for (;;) {
        const bool has_next = S.next(ui + 1, nxt);
        const char* nA = has_next ? (const char*)g.A + (size_t)nxt.pm * tstep : cA; const char* nB = has_next ? (const char*)g.Bt + (size_t)nxt.pn * tstep : cB;
        for (int t = 0; t < nt; t += 2) {
            const bool last = (t == nt - 2);
            const char* a1 = cA + (size_t)(t + 1) * kstep;
            const char* a2 = last ? nA : cA + (size_t)(t + 2) * kstep; const char* b2 = last ? nB : cB + (size_t)(t + 2) * kstep;
            const char* a3 = a2 + kstep; const char* b3 = b2 + kstep;
            if (last && has_next) S.a_ready(nxt);
            if constexpr (SP2) {
            PG8_LDB(B0, 0, 0); PG8_LDB(B1, 0, 1); PG8_SCHED; PG8_LDA(At, 0, 0); PG8_STAGE(PG8_SA(1, 1), a1 + hstep, voffA);
            PG8_WAIT_V(8); PG8_WAIT_L(0); PG8_BAR; PG8_MMA(0, 0, At, B0); PG8_MMA(0, 1, At, B1); PG8_BAR; PG8_SCHED;
            PG8_LDA(At, 0, 1); PG8_STAGE(PG8_SB(0, 0), b2, voffB); PG8_STAGE(PG8_SB(0, 1), b2 + hstep, voffB); PG8_STAGE(PG8_SA(0, 0), a2, voffA);
            PG8_WAIT_V(8); PG8_WAIT_L(0); PG8_BAR; PG8_MMA(1, 0, At, B0); PG8_MMA(1, 1, At, B1); PG8_BAR; PG8_SCHED;
            PG8_LDB(B0, 1, 0); PG8_LDB(B1, 1, 1); PG8_SCHED; PG8_LDA(At, 1, 0); PG8_STAGE(PG8_SA(0, 1), a2 + hstep, voffA);
            PG8_WAIT_V(8); PG8_WAIT_L(0); PG8_BAR; PG8_MMA(0, 0, At, B0); PG8_MMA(0, 1, At, B1); PG8_BAR; PG8_SCHED;
            PG8_LDA(At, 1, 1); PG8_STAGE(PG8_SB(1, 0), b3, voffB); PG8_STAGE(PG8_SB(1, 1), b3 + hstep, voffB); PG8_STAGE(PG8_SA(1, 0), a3, voffA);
            PG8_WAIT_V(8); PG8_WAIT_L(0); PG8_BAR; PG8_MMA(1, 0, At, B0); PG8_MMA(1, 1, At, B1); PG8_BAR; PG8_SCHED;
            } else {
            PG8_LDB(B0, 0, 0); PG8_SCHED; PG8_LDA(At, 0, 0); PG8_STAGE(PG8_SA(1, 1), a1 + hstep, voffA);
            PG8_WAIT_L(8); PG8_BAR; PG8_WAIT_L(0); PG8_MMA(0, 0, At, B0); PG8_BAR; PG8_SCHED;
            PG8_LDB(B1, 0, 1); PG8_STAGE(PG8_SB(0, 0), b2, voffB);
            PG8_BAR; PG8_WAIT_L(0); PG8_MMA(0, 1, At, B1); PG8_BAR;
            PG8_LDA(At, 0, 1); PG8_STAGE(PG8_SA(0, 0), a2, voffA);
            PG8_BAR; PG8_WAIT_L(0); PG8_MMA(1, 0, At, B0); PG8_BAR; PG8_SCHED;
            PG8_STAGE(PG8_SB(0, 1), b2 + hstep, voffB);
            PG8_WAIT_V(6); PG8_BAR; PG8_MMA(1, 1, At, B1); PG8_BAR;
            PG8_LDB(B0, 1, 0); PG8_SCHED; PG8_LDA(At, 1, 0); PG8_STAGE(PG8_SA(0, 1), a2 + hstep, voffA);
            PG8_WAIT_L(8); PG8_BAR; PG8_WAIT_L(0); PG8_MMA(0, 0, At, B0); PG8_BAR; PG8_SCHED;
            PG8_LDB(B1, 1, 1); PG8_STAGE(PG8_SB(1, 0), b3, voffB);
            PG8_BAR; PG8_WAIT_L(0); PG8_MMA(0, 1, At, B1); PG8_BAR;
            PG8_LDA(At, 1, 1); PG8_STAGE(PG8_SA(1, 0), a3, voffA);
            PG8_BAR; PG8_WAIT_L(0); PG8_MMA(1, 0, At, B0); PG8_BAR; PG8_SCHED;
            PG8_STAGE(PG8_SB(1, 1), b3 + hstep, voffB);
            PG8_WAIT_V(6); PG8_BAR; PG8_MMA(1, 1, At, B1); PG8_BAR;
            }
        }
        if constexpr (ALIGN_EPI) { if (wr == 0) PG8_BAR; }
        if constexpr (!Epi::AFTER_DRAIN) { E(acc, cur, wr, wc, fr, fq); S.done(cur); }
        if (!has_next) break;
#pragma unroll
        for (int a = 0; a < 2; ++a)
#pragma unroll
            for (int b = 0; b < 2; ++b)
#pragma unroll
                for (int m = 0; m < 4; ++m)
#pragma unroll
                    for (int n = 0; n < 2; ++n) acc[a][b][m][n] = (f32x4){0.f, 0.f, 0.f, 0.f};
        cur = nxt; cA = nA; cB = nB; ++ui;
        if constexpr (ALIGN_EPI) { if (wr == 1) PG8_BAR; }
    }
    PG8_WAIT_V(0);
    if constexpr (!ALIGN_EPI) { if (wr == 0) PG8_BAR; }
    PG8_BAR;
    if constexpr (Epi::AFTER_DRAIN) { E.fused(acc, cur, wr, wc, fr, fq, lds, wid, lane); S.done(cur); }
#undef PG8_SA
#undef PG8_SB
#undef PG8_STAGE
#undef PG8_LDA
#undef PG8_LDB
#undef PG8_MMA
#undef PG8_WAIT_V
#undef PG8_WAIT_L
#undef PG8_BAR
#undef PG8_SCHED
}
}
constexpr int NWAVES = 8, NTHREADS = NWAVES * 64;
constexpr int LDS_BYTES = 147456;
constexpr int LDS_MISC = 131072;
constexpr int N_PHASES = 10;

struct Args {
    const float *x_prompt, *x_sample, *cache_k, *cache_v, *state_delta, *state_conv, *meta, *norm_mix, *w_in, *conv_w, *a_log, *dt_bias, *sinks, *gdn_norm,
                *w_oa, *w_ob, *w_out, *norm_ffn, *w_gate, *w_up, *w_down, *norm_final;
    float* out; unsigned char* ws; int ph_lo, ph_hi;
};

typedef const __attribute__((address_space(4))) Args* KA;
DI KA kargs() { KA p = (KA)__builtin_amdgcn_kernarg_segment_ptr(); asm volatile("" : "+s"(p)); return p; }
#define RLX_AGENT __ATOMIC_RELAXED, __HIP_MEMORY_SCOPE_AGENT
#define LDS_WAIT() asm volatile("s_waitcnt lgkmcnt(0)" ::: "memory")
#define MFMA32(a, b, c) __builtin_amdgcn_mfma_f32_32x32x16_bf16((a), (b), (c), 0, 0, 0)
DI int crow16(int reg, int h) { return (reg & 3) + 8 * (reg >> 2) + 4 * h; }
DI float wave_sum(float v) {
#pragma unroll
    for (int o = 1; o < 64; o <<= 1) v += __shfl_xor(v, o);
    return v;
}
DI float wave_max(float v) {
#pragma unroll
    for (int o = 1; o < 64; o <<= 1) v = fmaxf(v, __shfl_xor(v, o));
    return v;
}
template <int S> DI bf16x8 pack_step(const f32x16& x) {
    u32x4 p; p.x = cvtpk(x[8 * S], x[8 * S + 1]); p.y = cvtpk(x[8 * S + 2], x[8 * S + 3]); p.z = cvtpk(x[8 * S + 4], x[8 * S + 5]); p.w = cvtpk(x[8 * S + 6], x[8 * S + 7]);
    return __builtin_bit_cast(bf16x8, p);
}
DI int frag_idx(int row, int k, int NKS) { const int kkk = k & 15; return (((row >> 5) * NKS + (k >> 4)) * 64 + (row & 31) + 32 * ((kkk >> 2) & 1)) * 8 + (((kkk >> 3) << 2) | (kkk & 3)); }
DI unsigned char* slot_ptr(KA A, int item) { return item < PREP_N1 ? A->ws + WS_B + (size_t)item * PREP_SLOT : (unsigned char*)A->out + (size_t)(item - PREP_N1) * PREP_SLOT; }

#define XB_TMO      128
#define XB_XCNT(j)  (256  + 64 * (j))
#define XB_XSUB(j)  (1280 + 64 * (j))
#define XB_XGEN(j)  (2304 + 64 * (j))
#define XB_TOP      3328
#define XB_TOPGEN   3392
#define XCD_BAR_WORDS 3456
#define XB_SPIN_CAP (1u << 20)
DI unsigned xb_ld(unsigned* p)              { return __hip_atomic_load(p, __ATOMIC_RELAXED, __HIP_MEMORY_SCOPE_AGENT); }
DI unsigned xb_add(unsigned* p, unsigned v) { return __hip_atomic_fetch_add(p, v, __ATOMIC_RELAXED, __HIP_MEMORY_SCOPE_AGENT); }
DI unsigned xb_xcc_id() { return (unsigned)__builtin_amdgcn_s_getreg((3 << 11) | 20) & 0xFu; }
#define XB_SPIN(cond, bar) do { unsigned _sp = 0; while (cond) { __builtin_amdgcn_s_sleep(1); \
    if ((++_sp & 255u) == 0u) { if (xb_ld(&(bar)[XB_TMO])) break; if (_sp > XB_SPIN_CAP) { atomicAdd(&(bar)[XB_TMO], 1u); break; } } } } while (0)
struct XcdBarrier { unsigned* bar; unsigned x; volatile LAS unsigned* st; };
DI XcdBarrier xcd_barrier_post(unsigned* bar, volatile LAS unsigned* st) {
    XcdBarrier b; b.bar = bar; b.x = xb_xcc_id(); b.st = st;
    if (threadIdx.x == 0) (void)xb_add(&bar[XB_XCNT(b.x)], 1u);
    return b;
}
DI void xcd_barrier_complete(unsigned* bar, unsigned x, unsigned& nloc, unsigned& nx) {
    const unsigned G = gridDim.x * gridDim.y * gridDim.z;
    unsigned sum, cnt, mine, sp = 0u;
    for (;;) {
        sum = 0u; cnt = 0u; mine = 0u;
#pragma unroll
        for (unsigned j = 0; j < 16; ++j) { const unsigned c = xb_ld(&bar[XB_XCNT(j)]); sum += c; cnt += (c > 0u) ? 1u : 0u; mine = (j == x) ? c : mine; }
        if (sum == G) break;
        __builtin_amdgcn_s_sleep(1);
        if ((++sp & 255u) == 0u) { if (xb_ld(&bar[XB_TMO])) break; if (sp > XB_SPIN_CAP) { atomicAdd(&bar[XB_TMO], 1u); break; } }
    }
    nloc = mine > 0u ? mine : 1u; nx = cnt > 0u ? cnt : 1u;
}
DI void xcd_barrier(const XcdBarrier& b) {
    asm volatile("s_waitcnt vmcnt(0)" ::: "memory");
    __syncthreads();
    if (threadIdx.x == 0) {
        unsigned* bar = b.bar;
        __builtin_amdgcn_s_waitcnt(0);
        unsigned nloc = b.st[0], nx = b.st[1];
        if (nloc == 0u) { xcd_barrier_complete(bar, b.x, nloc, nx); b.st[0] = nloc; b.st[1] = nx; }
        const unsigned old = xb_add(&bar[XB_XSUB(b.x)], 1u);
        const unsigned gen = old / nloc;
        if (old + 1u == (gen + 1u) * nloc) {
            __builtin_amdgcn_fence(__ATOMIC_RELEASE, "agent");
            asm volatile("s_waitcnt vmcnt(0)" ::: "memory");
            const unsigned og = xb_add(&bar[XB_TOP], 1u);
            const unsigned tg = og / nx;
            if (og + 1u == (tg + 1u) * nx) xb_add(&bar[XB_TOPGEN], 1u);
            else XB_SPIN(xb_ld(&bar[XB_TOPGEN]) == tg, bar);
            __builtin_amdgcn_fence(__ATOMIC_ACQUIRE, "agent");
            xb_add(&bar[XB_XGEN(b.x)], 1u);
            asm volatile("s_waitcnt vmcnt(0)" ::: "memory");
        } else {
            XB_SPIN(xb_ld(&bar[XB_XGEN(b.x)]) == gen, bar);
            __builtin_amdgcn_fence(__ATOMIC_ACQUIRE, "agent");
            asm volatile("s_waitcnt vmcnt(0)" ::: "memory");
        }
    }
    __syncthreads();
}

template <class RowMap> DI void transpose_item(const float* W, int K, int N, bf16* WT, RowMap rm, const float* kscale, LAS float* scr, int item, int lane) {
    const int nblk = (N + 31) / 32, kb = item / nblk, nb = item - kb * nblk, k0 = 64 * kb, n0 = 32 * nb;
    const int ncol = n0 + (lane & 31);
#pragma unroll 8
    for (int i = 0; i < 32; ++i) { const int kk = 2 * i + (lane >> 5);
        float v = ncol < N ? W[(size_t)(k0 + kk) * N + ncol] : 0.f;
        if (kscale) v *= kscale[k0 + kk];
        scr[kk * 33 + (lane & 31)] = v; }
    LDS_WAIT(); asm volatile("" ::: "memory");
    const int c = lane & 7;
#pragma unroll
    for (int j = 0; j < 4; ++j) { const int n = (lane >> 3) + 8 * j; const LAS float* s = scr + (8 * c) * 33 + n;
        const int nsrc = n0 + n; const int drow = nsrc < N ? rm(nsrc) : -1;
        u32x4 o; o.x = cvtpk(s[0 * 33], s[1 * 33]); o.y = cvtpk(s[2 * 33], s[3 * 33]); o.z = cvtpk(s[4 * 33], s[5 * 33]); o.w = cvtpk(s[6 * 33], s[7 * 33]);
        if (drow >= 0) *(u32x4*)(WT + (size_t)drow * K + k0 + 8 * c) = o; }
    LDS_WAIT(); asm volatile("" ::: "memory");
}
DI float softplusf_(float x) { return x > 20.f ? x : log1pf(__expf(x)); }

DI void p0_prologue(KA A, LAS unsigned char* lds) {
    const int tid = threadIdx.x, lane = tid & 63, wave = __builtin_amdgcn_readfirstlane(tid >> 6);
    const int G = gridDim.x, gw = blockIdx.x * NWAVES + wave, NGW = G * NWAVES;
    const int gt = blockIdx.x * NTHREADS + tid, NGT = G * NTHREADS;
    unsigned char* ws = A->ws;
    {
        LAS float* scr = (LAS float*)(lds + wave * 16384);
        constexpr int I_IN = 16 * 153, I_OA = 8 * 32, I_OUT = 16 * 32, I_G = 16 * 88, I_D = 44 * 32;
        constexpr int NIT = I_IN + 2 * I_OA + I_OUT + 2 * I_G + I_D;
        for (int it = gw; it < NIT; it += NGW) {
            int r = it;
            if (r < I_IN) { transpose_item(A->w_in, 1024, NIN_SRC, (bf16*)(ws + WS_WIN), [](int c) -> int {
                    if (c < 640) return (c & ~63) + pos_of_d(c & 63);
                    if (c < 2816) return c;
                    if (c < 2824) return -1;
                    return c - 8; }, nullptr, scr, r, lane); continue; } r -= I_IN;
            if (r < I_OA) { transpose_item(A->w_oa, 512, 1024, (bf16*)(ws + WS_WOA), [](int c) -> int { return c; }, nullptr, scr, r, lane); continue; } r -= I_OA;
            if (r < I_OA) { transpose_item(A->w_ob, 512, 1024, (bf16*)(ws + WS_WOB), [](int c) -> int { return c; }, nullptr, scr, r, lane); continue; } r -= I_OA;
            if (r < I_OUT) { transpose_item(A->w_out, 1024, 1024, (bf16*)(ws + WS_WOUT), [](int c) -> int { return c; }, nullptr, scr, r, lane); continue; } r -= I_OUT;
            if (r < I_G) { transpose_item(A->w_gate, 1024, DFF, (bf16*)(ws + WS_WGU), [](int c) -> int { return 256 * (c >> 7) + (c & 127); }, A->norm_ffn, scr, r, lane); continue; } r -= I_G;
            if (r < I_G) { transpose_item(A->w_up, 1024, DFF, (bf16*)(ws + WS_WGU), [](int c) -> int { return 256 * (c >> 7) + 128 + (c & 127); }, A->norm_ffn, scr, r, lane); continue; } r -= I_G;
            transpose_item(A->w_down, DFF, 1024, (bf16*)(ws + WS_WD), [](int c) -> int { return c; }, nullptr, scr, r, lane);
        }
    }
    {
        float* COS = (float*)(ws + WS_ROPE); float* SIN = COS + (TP + TS) * 32;
        for (int i = gt; i < (TP + TS) * 32; i += NGT) { const int ri = i >> 5, f = i & 31; const double pos = ri < TP ? (double)ri : (double)(PAST + ri - TP);
            const double inv = exp2(-(double)f * (13.287712379549449 / 32.0)), ang = pos * inv; COS[i] = (float)cos(ang); SIN[i] = (float)sin(ang); }
        float* SS1 = (float*)(ws + WS_SS1); float* SS2 = (float*)(ws + WS_SS2);
        for (int i = gt; i < MC; i += NGT) { SS1[i] = 0.f; SS2[i] = 0.f; }
        constexpr int PERB = 124 * 128 / 4;
        for (int i = gt; i < SBATCH * PERB; i += NGT) { const int b = i / PERB, o = i - b * PERB;
            ((f32x4*)(A->out + O_KS))[(size_t)b * 4096 + o] = ((const f32x4*)A->cache_k)[(size_t)b * 4096 + 128 + o];
            ((f32x4*)(A->out + O_VS))[(size_t)b * 4096 + o] = ((const f32x4*)A->cache_v)[(size_t)b * 4096 + 128 + o]; }
    }
    {
        unsigned wab[16][4];
        f32x4 nm[4];
#pragma unroll
        for (int j = 0; j < 4; ++j) {
            nm[j] = ((const f32x4*)A->norm_mix)[lane + 64 * j];
#pragma unroll
            for (int e = 0; e < 4; ++e) { const float* p = A->w_in + (size_t)(4 * (lane + 64 * j) + e) * NIN_SRC + 2816;
                const f32x4 a = *(const f32x4*)p, b = *(const f32x4*)(p + 4);
                wab[j * 4 + e][0] = cvtpk(a[0], a[1]); wab[j * 4 + e][1] = cvtpk(a[2], a[3]); wab[j * 4 + e][2] = cvtpk(b[0], b[1]); wab[j * 4 + e][3] = cvtpk(b[2], b[3]); }
        }
        bf16* XN = (bf16*)(ws + WS_XN); f32x2* GB = (f32x2*)(ws + WS_GB);
        for (int urow = gw; urow < MUP; urow += NGW) {
            const float* src = nullptr;
            if (urow < MP) { const int b = urow / TP, t = urow - b * TP; src = t < NMETA ? A->meta + (size_t)t * D : A->x_prompt + ((size_t)b * SEQ + (t - NMETA)) * D; }
            else if (urow < MU) src = A->x_sample + (size_t)(urow - MP) * D;
            u32x2* o8 = (u32x2*)(XN + (size_t)urow * D) + lane;
            if (!src) {
#pragma unroll
                for (int j = 0; j < 4; ++j) o8[64 * j] = (u32x2){0u, 0u};
                if (lane < 4) GB[(size_t)urow * 4 + lane] = (f32x2){0.f, 0.f};
                continue; }
            f32x4 v[4]; float ss = 0.f;
#pragma unroll
            for (int j = 0; j < 4; ++j) { v[j] = ((const f32x4*)src)[lane + 64 * j]; ss += (v[j][0] * v[j][0] + v[j][1] * v[j][1]) + (v[j][2] * v[j][2] + v[j][3] * v[j][3]); }
            const float rstd = rsqrtf(wave_sum(ss) * (1.0f / D) + EPS);
            float dot[8];
#pragma unroll
            for (int c = 0; c < 8; ++c) dot[c] = 0.f;
#pragma unroll
            for (int j = 0; j < 4; ++j) { v[j] = v[j] * rstd * nm[j];
                o8[64 * j] = (u32x2){cvtpk(v[j][0], v[j][1]), cvtpk(v[j][2], v[j][3])};
#pragma unroll
                for (int e = 0; e < 4; ++e)
#pragma unroll
                    for (int c = 0; c < 4; ++c) { dot[2 * c] += v[j][e] * bflo(wab[j * 4 + e][c]); dot[2 * c + 1] += v[j][e] * bfhi(wab[j * 4 + e][c]); } }
#pragma unroll
            for (int c = 0; c < 8; ++c) dot[c] = wave_sum(dot[c]);
            if (lane < 4) {
                const float a = lane == 0 ? dot[0] : lane == 1 ? dot[1] : lane == 2 ? dot[2] : dot[3];
                const float bb = lane == 0 ? dot[4] : lane == 1 ? dot[5] : lane == 2 ? dot[6] : dot[7];
                const float g = -__expf(A->a_log[lane]) * softplusf_(a + A->dt_bias[lane]);
                GB[(size_t)urow * 4 + lane] = (f32x2){g, sigmoidf_(bb)};
            }
        }
    }
}
DI void item_decode(int item, int& b, int& h, bool& sample, int& t0, int& L) {
    if (item < N_ITEMS_P) { const int s = item / CHUNKS_P, c = item - s * CHUNKS_P; b = s >> 2; h = s & 3; sample = false; if (c == 0) { t0 = 0; L = NMETA; } else { t0 = NMETA + 64 * (c - 1); L = 64; } }
    else { const int s = item - N_ITEMS_P; b = s >> 2; h = s & 3; sample = true; t0 = 0; L = TS; }
}
constexpr int PITCH = 132;
DI bf16x8 frag_nat(const LAS float* src, int row, int k0) {
    const f32x4 lo = *(const LAS f32x4*)(src + row * PITCH + k0), hi = *(const LAS f32x4*)(src + row * PITCH + k0 + 4);
    return __builtin_bit_cast(bf16x8, pack8f(lo, hi));
}
DI void prep_stage1(KA A, int item, LAS unsigned char* ldsb) {
    const int tid = threadIdx.x, lane = tid & 63, wave = __builtin_amdgcn_readfirstlane(tid >> 6), r = lane & 31, hh = lane >> 5;
    int b, h, t0, L; bool sample; item_decode(item, b, h, sample, t0, L);
    LAS float* Qs = (LAS float*)ldsb; LAS float* Ks = Qs + 64 * PITCH; LAS float* Vs = Ks + 64 * PITCH; LAS float* gcs = Vs + 64 * PITCH; LAS float* betas = gcs + 64;
    const bf16* QKVB = (const bf16*)(A->ws + WS_QKVB);
    unsigned char* slot = slot_ptr(A, item);
    {
        const int col = tid & 127, r0 = (tid >> 7) * 16;
#pragma unroll 1
        for (int grp = 0; grp < 3; ++grp) {
            const int cidx = grp * 512 + h * 128 + col;
            const float w0 = A->conv_w[cidx], w1 = A->conv_w[CONVD + cidx], w2 = A->conv_w[2 * CONVD + cidx], w3 = A->conv_w[3 * CONVD + cidx];
            auto getx = [&](int i) -> float {
                if (!sample) { const int t = t0 + i; return t < 0 ? 0.f : bf2f(QKVB[(size_t)(b * TP + t) * CONVD + cidx]); }
                if (i < 0) return A->state_conv[((size_t)b * 3 + (3 + i)) * CONVD + cidx];
                return bf2f(QKVB[(size_t)(MP + b * TS + i) * CONVD + cidx]);
            };
            float xm3 = getx(r0 - 3), xm2 = getx(r0 - 2), xm1 = getx(r0 - 1);
            LAS float* dst = Qs + grp * 64 * PITCH;
#pragma unroll 4
            for (int rr = r0; rr < r0 + 16; ++rr) { const float x = getx(rr); const float y = w0 * xm3 + w1 * xm2 + w2 * xm1 + w3 * x;
                dst[rr * PITCH + col] = rr < L ? siluf_(y) : 0.f; xm3 = xm2; xm2 = xm1; xm1 = x; }
        }
    }
    __syncthreads();
    {
        const int i = tid >> 3, sub = tid & 7; float sq = 0.f, sk = 0.f;
#pragma unroll
        for (int e = 0; e < 16; ++e) { const float a = Qs[i * PITCH + sub * 16 + e], c = Ks[i * PITCH + sub * 16 + e]; sq += a * a; sk += c * c; }
        sq += __shfl_xor(sq, 1); sq += __shfl_xor(sq, 2); sq += __shfl_xor(sq, 4);
        sk += __shfl_xor(sk, 1); sk += __shfl_xor(sk, 2); sk += __shfl_xor(sk, 4);
        const float rq = rsqrtf(sq + EPS) * 0.08838834764831845f, rk = rsqrtf(sk + EPS);
#pragma unroll
        for (int e = 0; e < 16; ++e) { Qs[i * PITCH + sub * 16 + e] *= rq; Ks[i * PITCH + sub * 16 + e] *= rk; }
    }
    if (wave == 0) {
        float g = 0.f, be = 0.f;
        if (lane < L) { const int urow = sample ? MP + b * TS + lane : b * TP + t0 + lane; const f32x2 gb = ((const f32x2*)(A->ws + WS_GB))[(size_t)urow * 4 + h]; g = gb[0]; be = gb[1]; }
        float gc = g;
#pragma unroll
        for (int o = 1; o < 64; o <<= 1) { const float t = __shfl_up(gc, o); if (lane >= o) gc += t; }
        gcs[lane] = gc; betas[lane] = be;
        if (lane == 63) ((float*)(A->ws + WS_SC))[item] = __expf(gc);
    }
    __syncthreads();
    if (wave < 6) {
        const bool isqk = wave >= 3; const int tsel = isqk ? wave - 3 : wave, ib = tsel == 0 ? 0 : 1, jb = tsel == 2 ? 1 : 0;
        const LAS float* Asrc = isqk ? Qs : Ks;
        f32x16 acc;
#pragma unroll
        for (int e = 0; e < 16; ++e) acc[e] = 0.f;
#pragma unroll
        for (int s = 0; s < 8; ++s) acc = MFMA32(frag_nat(Asrc, 32 * ib + r, 16 * s + 8 * hh), frag_nat(Ks, 32 * jb + r, 16 * s + 8 * hh), acc);
        const int j = 32 * jb + r; const float gcj = gcs[j];
        float* Aout = (float*)(slot + SL_A); bf16* QKD = (bf16*)(slot + SL_QKD);
#pragma unroll
        for (int reg = 0; reg < 16; ++reg) { const int i = 32 * ib + crow16(reg, hh); const float dec = __expf(fminf(gcs[i] - gcj, 0.f));
            if (!isqk) Aout[j * 64 + i] = i > j ? betas[i] * dec * acc[reg] : 0.f;
            else QKD[frag_idx(i, j, 4)] = f2bf(i >= j ? dec * acc[reg] : 0.f); }
    }
    const float gcl = gcs[63];
#pragma unroll 1
    for (int job = wave; job < 56; job += 8) {
        if (job < 32) {
            const bool isq = job >= 16; const int jj = job & 15, rb = jj >> 3, ks = jj & 7, row = 32 * rb + r, k0 = 16 * ks + 4 * hh;
            const LAS float* src = isq ? Qs : Ks; const float sc = isq ? __expf(gcs[row]) : betas[row] * __expf(gcs[row]);
            const f32x4 lo = *(const LAS f32x4*)(src + row * PITCH + k0) * sc, hi = *(const LAS f32x4*)(src + row * PITCH + k0 + 8) * sc;
            *(u32x4*)(slot + (isq ? SL_QE : SL_BEK) + ((rb * 8 + ks) * 64 + lane) * 16) = pack8f(lo, hi);
        } else if (job < 48) {
            const int jj = job - 32, rb = jj >> 2, ks = jj & 3, dk = 32 * rb + r;
            f32x4 lo, hi;
#pragma unroll
            for (int e = 0; e < 4; ++e) { const int j0 = 16 * ks + 4 * hh + e, j1 = j0 + 8;
                lo[e] = Ks[j0 * PITCH + dk] * __expf(gcl - gcs[j0]); hi[e] = Ks[j1 * PITCH + dk] * __expf(gcl - gcs[j1]); }
            *(u32x4*)(slot + SL_KWT + ((rb * 4 + ks) * 64 + lane) * 16) = pack8f(lo, hi);
        } else {
            const int q = job - 48, w = q >> 1, ib = q & 1, dv = 32 * w + r;
            float v[16];
#pragma unroll
            for (int reg = 0; reg < 16; ++reg) { const int i = 32 * ib + crow16(reg, hh); v[reg] = betas[i] * Vs[i * PITCH + dv]; }
            u32x4* dst = (u32x4*)(slot + SL_BV + ((w * 2 + ib) * 64 + lane) * 32);
            dst[0] = (u32x4){cvtpk(v[0], v[1]), cvtpk(v[2], v[3]), cvtpk(v[4], v[5]), cvtpk(v[6], v[7])};
            dst[1] = (u32x4){cvtpk(v[8], v[9]), cvtpk(v[10], v[11]), cvtpk(v[12], v[13]), cvtpk(v[14], v[15])};
        }
    }
    __syncthreads();
}
DI void prep_stage2(KA A, int item, LAS float* M) {
    int lane = threadIdx.x & 63; asm volatile("" : "+v"(lane));
    const int r = lane & 31, hh = lane >> 5;
    unsigned char* slot = slot_ptr(A, item);
    const f32x4* Ain = (const f32x4*)(slot + SL_A);
#pragma unroll
    for (int q = 0; q < 16; ++q) *(LAS f32x4*)(M + (q * 64 + lane) * 4) = Ain[q * 64 + lane];
    LDS_WAIT(); asm volatile("" ::: "memory");
#pragma unroll 1
    for (int rb = 0; rb < 4; ++rb) {
        float acc[16];
#pragma unroll
        for (int i = 0; i < 16; ++i) acc[i] = lane == 16 * rb + i ? 1.f : 0.f;
#pragma unroll 2
        for (int j = 0; j < 16 * rb; ++j) {
            float tj = M[j * 64 + lane]; tj = lane <= j ? tj : 0.f;
            const LAS f32x4* ar = (const LAS f32x4*)(M + j * 64 + 16 * rb);
            const f32x4 a0 = ar[0], a1 = ar[1], a2 = ar[2], a3 = ar[3];
#pragma unroll
            for (int e = 0; e < 4; ++e) { acc[e] -= a0[e] * tj; acc[4 + e] -= a1[e] * tj; acc[8 + e] -= a2[e] * tj; acc[12 + e] -= a3[e] * tj; }
        }
#pragma unroll
        for (int j = 0; j < 16; ++j) {
            const float tj = acc[j]; const int row = 16 * rb + j;
            const LAS f32x4* ar = (const LAS f32x4*)(M + row * 64 + 16 * rb);
            float a[16];
#pragma unroll
            for (int q = j >> 2; q < 4; ++q) { const f32x4 v = ar[q]; a[4 * q] = v[0]; a[4 * q + 1] = v[1]; a[4 * q + 2] = v[2]; a[4 * q + 3] = v[3]; }
            if (lane <= row) M[row * 64 + lane] = tj;
#pragma unroll
            for (int i = j + 1; i < 16; ++i) acc[i] -= a[i] * tj;
        }
        asm volatile("" ::: "memory");
    }
    LDS_WAIT(); asm volatile("" ::: "memory");
#pragma unroll
    for (int f = 0; f < 8; ++f) { const int rb = f >> 2, ks = f & 3, row = 32 * rb + r, k0 = 16 * ks + 4 * hh;
        f32x4 lo = *(const LAS f32x4*)(M + row * 64 + k0), hi = *(const LAS f32x4*)(M + row * 64 + k0 + 8);
#pragma unroll
        for (int e = 0; e < 4; ++e) { lo[e] = k0 + e <= row ? lo[e] : 0.f; hi[e] = k0 + 8 + e <= row ? hi[e] : 0.f; }
        *(u32x4*)(slot + SL_T + ((rb * 4 + ks) * 64 + lane) * 16) = pack8f(lo, hi); }
    LDS_WAIT(); asm volatile("" ::: "memory");
}
DI void p2_prep(KA A, LAS unsigned char* lds) {
    const int wave = __builtin_amdgcn_readfirstlane(threadIdx.x >> 6), G = gridDim.x;
    for (int item = blockIdx.x; item < N_ITEMS; item += G) prep_stage1(A, item, lds);
    asm volatile("s_waitcnt vmcnt(0)" ::: "memory"); __syncthreads();
    int n = 0;
    for (int item = blockIdx.x; item < N_ITEMS; item += G, ++n) if ((n & 7) == wave) prep_stage2(A, item, (LAS float*)(lds + wave * 16384));
}

DI void scan_seq(KA A, int seq, int w, int lane) {
    const int r = lane & 31, hh = lane >> 5, dv = 32 * w + r;
    const bool sample = seq >= N_PROMPT_SEQ; const int sidx = sample ? seq - N_PROMPT_SEQ : seq, b = sidx >> 2, h = sidx & 3, nch = sample ? 1 : CHUNKS_P;
    f32x16 S[4];
    if (sample) {
        const float* S0 = A->state_delta + ((size_t)(b * 4 + h) * 128) * 128 + dv;
#pragma unroll
        for (int kb = 0; kb < 4; ++kb)
#pragma unroll
            for (int reg = 0; reg < 16; ++reg) S[kb][reg] = S0[(size_t)(32 * kb + crow16(reg, hh)) * 128];
    } else {
#pragma unroll
        for (int kb = 0; kb < 4; ++kb)
#pragma unroll
            for (int reg = 0; reg < 16; ++reg) S[kb][reg] = 0.f;
    }
    float* OBR = (float*)(A->ws + WS_OBRAW);
#pragma unroll 1
    for (int c = 0; c < nch; ++c) {
        const int item = sample ? N_ITEMS_P + sidx : seq * CHUNKS_P + c;
        const unsigned char* slot = slot_ptr(A, item);
        const float gcl = ((const float*)(A->ws + WS_SC))[item];
        const bf16x8* bek = (const bf16x8*)(slot + SL_BEK) + lane; const bf16x8* tp = (const bf16x8*)(slot + SL_T) + lane;
        const bf16x8* qe = (const bf16x8*)(slot + SL_QE) + lane; const bf16x8* qkd = (const bf16x8*)(slot + SL_QKD) + lane; const bf16x8* kwt = (const bf16x8*)(slot + SL_KWT) + lane;
        bf16x8 sf[8];
#pragma unroll
        for (int kb = 0; kb < 4; ++kb) { sf[2 * kb] = pack_step<0>(S[kb]); sf[2 * kb + 1] = pack_step<1>(S[kb]); }
        f32x16 x0, x1;
#pragma unroll
        for (int e = 0; e < 16; ++e) { x0[e] = 0.f; x1[e] = 0.f; }
#pragma unroll
        for (int ks = 0; ks < 8; ++ks) { x0 = MFMA32(bek[ks * 64], sf[ks], x0); x1 = MFMA32(bek[(8 + ks) * 64], sf[ks], x1); }
        {
            const u32x4* bv = (const u32x4*)(slot + SL_BV) + ((w * 2) * 64 + lane) * 2;
            const u32x4 a0 = bv[0], a1 = bv[1], c0 = bv[128], c1 = bv[129];
            x0[0] = bflo(a0.x) - x0[0]; x0[1] = bfhi(a0.x) - x0[1]; x0[2] = bflo(a0.y) - x0[2]; x0[3] = bfhi(a0.y) - x0[3];
            x0[4] = bflo(a0.z) - x0[4]; x0[5] = bfhi(a0.z) - x0[5]; x0[6] = bflo(a0.w) - x0[6]; x0[7] = bfhi(a0.w) - x0[7];
            x0[8] = bflo(a1.x) - x0[8]; x0[9] = bfhi(a1.x) - x0[9]; x0[10] = bflo(a1.y) - x0[10]; x0[11] = bfhi(a1.y) - x0[11];
            x0[12] = bflo(a1.z) - x0[12]; x0[13] = bfhi(a1.z) - x0[13]; x0[14] = bflo(a1.w) - x0[14]; x0[15] = bfhi(a1.w) - x0[15];
            x1[0] = bflo(c0.x) - x1[0]; x1[1] = bfhi(c0.x) - x1[1]; x1[2] = bflo(c0.y) - x1[2]; x1[3] = bfhi(c0.y) - x1[3];
            x1[4] = bflo(c0.z) - x1[4]; x1[5] = bfhi(c0.z) - x1[5]; x1[6] = bflo(c0.w) - x1[6]; x1[7] = bfhi(c0.w) - x1[7];
            x1[8] = bflo(c1.x) - x1[8]; x1[9] = bfhi(c1.x) - x1[9]; x1[10] = bflo(c1.y) - x1[10]; x1[11] = bfhi(c1.y) - x1[11];
            x1[12] = bflo(c1.z) - x1[12]; x1[13] = bfhi(c1.z) - x1[13]; x1[14] = bflo(c1.w) - x1[14]; x1[15] = bfhi(c1.w) - x1[15];
        }
        bf16x8 rf[4] = {pack_step<0>(x0), pack_step<1>(x0), pack_step<0>(x1), pack_step<1>(x1)};
        f32x16 u0, u1;
#pragma unroll
        for (int e = 0; e < 16; ++e) { u0[e] = 0.f; u1[e] = 0.f; }
        u0 = MFMA32(tp[0 * 64], rf[0], u0); u0 = MFMA32(tp[1 * 64], rf[1], u0);
#pragma unroll
        for (int ks = 0; ks < 4; ++ks) u1 = MFMA32(tp[(4 + ks) * 64], rf[ks], u1);
        bf16x8 uf[4] = {pack_step<0>(u0), pack_step<1>(u0), pack_step<0>(u1), pack_step<1>(u1)};
        if (sample || c > 0) {
#pragma unroll
            for (int e = 0; e < 16; ++e) { x0[e] = 0.f; x1[e] = 0.f; }
#pragma unroll
            for (int ks = 0; ks < 8; ++ks) { x0 = MFMA32(qe[ks * 64], sf[ks], x0); x1 = MFMA32(qe[(8 + ks) * 64], sf[ks], x1); }
            x0 = MFMA32(qkd[0 * 64], uf[0], x0); x0 = MFMA32(qkd[1 * 64], uf[1], x0);
#pragma unroll
            for (int ks = 0; ks < 4; ++ks) x1 = MFMA32(qkd[(4 + ks) * 64], uf[ks], x1);
            const int crow0 = sample ? NBATCH * SEQ + b * TS : b * SEQ + 64 * (c - 1), L = sample ? TS : 64;
#pragma unroll
            for (int reg = 0; reg < 16; ++reg) { const int i0 = crow16(reg, hh), i1 = 32 + i0;
                if (i0 < L) OBR[(size_t)(crow0 + i0) * 512 + h * 128 + dv] = x0[reg];
                if (i1 < L) OBR[(size_t)(crow0 + i1) * 512 + h * 128 + dv] = x1[reg]; }
        }
#pragma unroll
        for (int kb = 0; kb < 4; ++kb) {
            S[kb] = S[kb] * gcl;
#pragma unroll
            for (int ks = 0; ks < 4; ++ks) S[kb] = MFMA32(kwt[(kb * 4 + ks) * 64], uf[ks], S[kb]);
        }
    }
    float* So = A->out + (sample ? O_DS : O_DP) + ((size_t)(b * 4 + h) * 128) * 128 + dv;
#pragma unroll
    for (int kb = 0; kb < 4; ++kb)
#pragma unroll
        for (int reg = 0; reg < 16; ++reg) So[(size_t)(32 * kb + crow16(reg, hh)) * 128] = S[kb][reg];
}

constexpr int KPITCH = 72, VPITCH = 264;
DI void attn_unit(KA A, int unit, LAS unsigned char* ldsb) {
    const int tid = threadIdx.x, lane = tid & 63, wave = __builtin_amdgcn_readfirstlane(tid >> 6), r = lane & 31, hh = lane >> 5;
    const int b = unit >> 6, kh = (unit >> 5) & 1, jb = unit & 31, T0 = NMETA + 128 * jb;
    LAS bf16* Ksm = (LAS bf16*)ldsb; LAS bf16* VTs = Ksm + 256 * KPITCH;
    const bf16* KVg = (const bf16*)(A->ws + WS_KV); const bf16* QAg = (const bf16*)(A->ws + WS_QA);
#pragma unroll
    for (int e4 = 0; e4 < 4; ++e4) {
        const int id = tid + 512 * e4, key = id >> 3, cch = id & 7, tk = T0 - 128 + key;
        u32x4 kq = (u32x4){0u, 0u, 0u, 0u}, vq = kq;
        if (tk >= 0) { const bf16* src = KVg + (size_t)(b * TP + tk) * 256 + kh * 64 + 8 * cch; kq = *(const u32x4*)src; vq = *(const u32x4*)(src + 128); }
        *(LAS u32x4*)(Ksm + key * KPITCH + 8 * cch) = kq;
        const int kkk = key & 15, pos = (key & ~15) + 8 * ((kkk >> 2) & 1) + (((kkk >> 3) << 2) | (kkk & 3));
        LAS bf16* vd = VTs + (8 * cch) * VPITCH + pos;
        vd[0 * VPITCH] = (bf16)(vq.x & 0xffffu); vd[1 * VPITCH] = (bf16)(vq.x >> 16); vd[2 * VPITCH] = (bf16)(vq.y & 0xffffu); vd[3 * VPITCH] = (bf16)(vq.y >> 16);
        vd[4 * VPITCH] = (bf16)(vq.z & 0xffffu); vd[5 * VPITCH] = (bf16)(vq.z >> 16); vd[6 * VPITCH] = (bf16)(vq.w & 0xffffu); vd[7 * VPITCH] = (bf16)(vq.w >> 16);
    }
    __syncthreads();
    const int g = wave >> 1, qh = wave & 1, head = 4 * kh + g;
    const float sink2 = A->sinks[head] * 1.4426950408889634f;
    const int kmin = jb == 0 ? 128 - NMETA : 0;
#pragma unroll 1
    for (int q2 = 0; q2 < 2; ++q2) {
        const int qb = 2 * qh + q2, iq = 32 * qb + r;
        const bf16* qrow = QAg + (size_t)(b * TP + T0 + iq) * 512 + head * 64 + 8 * hh;
        bf16x8 qf[4];
#pragma unroll
        for (int s = 0; s < 4; ++s) qf[s] = *(const bf16x8*)(qrow + 16 * s);
        f32x16 st[5];
        float m = sink2;
#pragma unroll
        for (int kt5 = 0; kt5 < 5; ++kt5) {
            const int kt = qb + kt5;
            f32x16 acc;
#pragma unroll
            for (int e = 0; e < 16; ++e) acc[e] = 0.f;
#pragma unroll
            for (int s = 0; s < 4; ++s) acc = MFMA32(*(const LAS bf16x8*)(Ksm + (32 * kt + r) * KPITCH + 16 * s + 8 * hh), qf[s], acc);
#pragma unroll
            for (int reg = 0; reg < 16; ++reg) { const int kk = 32 * kt + crow16(reg, hh); const bool ok = kk >= iq && kk <= iq + 128 && kk >= kmin;
                acc[reg] = ok ? acc[reg] : -INFINITY; m = fmaxf(m, acc[reg]); }
            st[kt5] = acc;
        }
        m = fmaxf(m, __shfl_xor(m, 32));
        float l = 0.f;
#pragma unroll
        for (int kt5 = 0; kt5 < 5; ++kt5)
#pragma unroll
            for (int reg = 0; reg < 16; ++reg) { const float p = exp2f(st[kt5][reg] - m); st[kt5][reg] = p; l += p; }
        l += __shfl_xor(l, 32); l += exp2f(sink2 - m);
        f32x16 o0, o1;
#pragma unroll
        for (int e = 0; e < 16; ++e) { o0[e] = 0.f; o1[e] = 0.f; }
#pragma unroll
        for (int kt5 = 0; kt5 < 5; ++kt5) {
            const int kt = qb + kt5;
            const bf16x8 p0 = pack_step<0>(st[kt5]), p1 = pack_step<1>(st[kt5]);
            const LAS bf16* vb = VTs + r * VPITCH + 32 * kt + 8 * hh;
            o0 = MFMA32(*(const LAS bf16x8*)(vb), p0, o0); o0 = MFMA32(*(const LAS bf16x8*)(vb + 16), p1, o0);
            o1 = MFMA32(*(const LAS bf16x8*)(vb + 32 * VPITCH), p0, o1); o1 = MFMA32(*(const LAS bf16x8*)(vb + 32 * VPITCH + 16), p1, o1);
        }
        const float rl = 1.0f / l;
        bf16* orow = (bf16*)(A->ws + WS_OA) + (size_t)(b * SEQ + 128 * jb + iq) * 512 + head * 64 + 4 * hh;
#pragma unroll
        for (int g4 = 0; g4 < 4; ++g4) {
            *(u32x2*)(orow + 8 * g4) = (u32x2){cvtpk(o0[4 * g4] * rl, o0[4 * g4 + 1] * rl), cvtpk(o0[4 * g4 + 2] * rl, o0[4 * g4 + 3] * rl)};
            *(u32x2*)(orow + 32 + 8 * g4) = (u32x2){cvtpk(o1[4 * g4] * rl, o1[4 * g4 + 1] * rl), cvtpk(o1[4 * g4 + 2] * rl, o1[4 * g4 + 3] * rl)};
        }
    }
    __syncthreads();
}
DI void sample_attn(KA A, int b, int head, LAS float* wl, int lane) {
    const int kh = head >> 2;
    LAS float* qn = wl; LAS float* ps = wl + 256;
    const bf16* QAg = (const bf16*)(A->ws + WS_QA); const bf16* KVg = (const bf16*)(A->ws + WS_KV);
#pragma unroll
    for (int i = 0; i < 4; ++i) qn[i * 64 + lane] = bf2f(QAg[(size_t)(MP + b * TS + i) * 512 + head * 64 + pos_of_d(lane)]);
    LDS_WAIT(); asm volatile("" ::: "memory");
    const float sink2 = A->sinks[head] * 1.4426950408889634f;
#pragma unroll 1
    for (int kq = 0; kq < 3; ++kq) {
        const int kj = lane + 64 * kq;
        float sc0 = 0.f, sc1 = 0.f, sc2 = 0.f, sc3 = 0.f;
        if (kj < 128) {
            const f32x4* kr = (const f32x4*)(A->cache_k + ((size_t)(b * 128 + kj) * 2 + kh) * 64);
#pragma unroll 4
            for (int d4 = 0; d4 < 16; ++d4) { const f32x4 kv = kr[d4];
                const f32x4 q0 = *(const LAS f32x4*)(qn + 4 * d4), q1 = *(const LAS f32x4*)(qn + 64 + 4 * d4), q2 = *(const LAS f32x4*)(qn + 128 + 4 * d4), q3 = *(const LAS f32x4*)(qn + 192 + 4 * d4);
                sc0 += (kv[0] * q0[0] + kv[1] * q0[1]) + (kv[2] * q0[2] + kv[3] * q0[3]); sc1 += (kv[0] * q1[0] + kv[1] * q1[1]) + (kv[2] * q1[2] + kv[3] * q1[3]);
                sc2 += (kv[0] * q2[0] + kv[1] * q2[1]) + (kv[2] * q2[2] + kv[3] * q2[3]); sc3 += (kv[0] * q3[0] + kv[1] * q3[1]) + (kv[2] * q3[2] + kv[3] * q3[3]); }
        } else if (kj < 132) {
            const bf16* kr = KVg + (size_t)(MP + b * TS + (kj - 128)) * 256 + kh * 64;
#pragma unroll 4
            for (int p = 0; p < 64; ++p) { const float kv = bf2f(kr[p]); const int d = d_of_pos(p);
                sc0 += kv * qn[d]; sc1 += kv * qn[64 + d]; sc2 += kv * qn[128 + d]; sc3 += kv * qn[192 + d]; }
        }
        if (kj < 132) {
            ps[0 * 132 + kj] = (kj >= 0 && kj <= 128) ? sc0 : -INFINITY; ps[1 * 132 + kj] = (kj >= 1 && kj <= 129) ? sc1 : -INFINITY;
            ps[2 * 132 + kj] = (kj >= 2 && kj <= 130) ? sc2 : -INFINITY; ps[3 * 132 + kj] = (kj >= 3 && kj <= 131) ? sc3 : -INFINITY; }
    }
    LDS_WAIT(); asm volatile("" ::: "memory");
    float linv[4];
#pragma unroll
    for (int i = 0; i < 4; ++i) {
        const float s0 = ps[i * 132 + lane], s1 = ps[i * 132 + 64 + lane], s2 = lane < 4 ? ps[i * 132 + 128 + lane] : -INFINITY;
        const float m = wave_max(fmaxf(fmaxf(s0, s1), fmaxf(s2, sink2)));
        const float p0 = exp2f(s0 - m), p1 = exp2f(s1 - m), p2 = exp2f(s2 - m);
        ps[i * 132 + lane] = p0; ps[i * 132 + 64 + lane] = p1; if (lane < 4) ps[i * 132 + 128 + lane] = p2;
        linv[i] = 1.0f / (wave_sum(p0 + p1 + p2) + exp2f(sink2 - m));
    }
    LDS_WAIT(); asm volatile("" ::: "memory");
    float o[4] = {0.f, 0.f, 0.f, 0.f};
#pragma unroll 4
    for (int kj = 0; kj < 128; ++kj) { const float v = A->cache_v[((size_t)(b * 128 + kj) * 2 + kh) * 64 + lane];
#pragma unroll
        for (int i = 0; i < 4; ++i) o[i] += ps[i * 132 + kj] * v; }
#pragma unroll
    for (int kj = 128; kj < 132; ++kj) { const float v = bf2f(KVg[(size_t)(MP + b * TS + (kj - 128)) * 256 + 128 + kh * 64 + lane]);
#pragma unroll
        for (int i = 0; i < 4; ++i) o[i] += ps[i * 132 + kj] * v; }
    bf16* OAg = (bf16*)(A->ws + WS_OA);
#pragma unroll
    for (int i = 0; i < 4; ++i) OAg[(size_t)(NBATCH * SEQ + b * TS + i) * 512 + head * 64 + lane] = f2bf(o[i] * linv[i]);
    LDS_WAIT(); asm volatile("" ::: "memory");
}
DI void p3_mixers(KA A, LAS unsigned char* lds) {
    const int tid = threadIdx.x, lane = tid & 63, wave = __builtin_amdgcn_readfirstlane(tid >> 6), G = gridDim.x, wg = blockIdx.x;
    const int NSCAN = N_PROMPT_SEQ;
    int worker = -1; const int NW = (G - NSCAN) * NWAVES + NSCAN * 4;
#ifndef T_NOSCAN1
    if (wg < NSCAN) { if (wave < 4) scan_seq(A, wg, wave, lane); else
#else
    if (wg < NSCAN) { if (wave < 4) {} else
#endif
 worker = (G - NSCAN) * NWAVES + wg * 4 + (wave - 4); }
    else {
#ifndef T_NOATTN
        for (int u = wg - NSCAN; u < NBATCH * NKV * 32; u += G - NSCAN) attn_unit(A, u, lds);
#endif
        worker = (wg - NSCAN) * NWAVES + wave;
    }
    if (worker >= 0) {
        LAS float* wl = (LAS float*)(lds + 98304 + wave * 4096);
        for (int it = worker; it < SBATCH * NHB * 4 + SBATCH * NHA; it += NW) {
#ifndef T_NOSCAN2
            if (it < SBATCH * NHB * 4) scan_seq(A, N_PROMPT_SEQ + (it >> 2), it & 3, lane);
#else
            if (it < SBATCH * NHB * 4) {}
#endif
#ifndef T_NOSATTN
            else { const int q = it - SBATCH * NHB * 4; sample_attn(A, q >> 3, q & 7, wl, lane); }
#endif
        }
    }
}

DI void p3b_gated_norm(KA A) {
    const int tid = threadIdx.x, lane = tid & 63, wave = tid >> 6, gw = blockIdx.x * NWAVES + wave, NGW = gridDim.x * NWAVES;
    const int head = lane >> 4, dv0 = 8 * (lane & 15);
    const f32x4 w0 = *(const f32x4*)(A->gdn_norm + dv0), w1 = *(const f32x4*)(A->gdn_norm + dv0 + 4);
    const float* OBR = (const float*)(A->ws + WS_OBRAW); const bf16* Zg = (const bf16*)(A->ws + WS_Z); bf16* OBg = (bf16*)(A->ws + WS_OB);
    for (int crow = gw; crow < MC; crow += NGW) {
        const float* op = OBR + (size_t)crow * 512 + head * 128 + dv0;
        const f32x4 a = *(const f32x4*)op, c = *(const f32x4*)(op + 4);
        float ss = (a[0] * a[0] + a[1] * a[1]) + (a[2] * a[2] + a[3] * a[3]) + (c[0] * c[0] + c[1] * c[1]) + (c[2] * c[2] + c[3] * c[3]);
        ss += __shfl_xor(ss, 1); ss += __shfl_xor(ss, 2); ss += __shfl_xor(ss, 4); ss += __shfl_xor(ss, 8);
        const float rstd = rsqrtf(ss * (1.0f / 128.0f) + EPS);
        const u32x4 zw = *(const u32x4*)(Zg + (size_t)pg8::crow_to_urow(crow) * 512 + head * 128 + dv0);
        f32x4 y0, y1;
        y0[0] = a[0] * rstd * w0[0] * siluf_(bflo(zw.x)); y0[1] = a[1] * rstd * w0[1] * siluf_(bfhi(zw.x)); y0[2] = a[2] * rstd * w0[2] * siluf_(bflo(zw.y)); y0[3] = a[3] * rstd * w0[3] * siluf_(bfhi(zw.y));
        y1[0] = c[0] * rstd * w1[0] * siluf_(bflo(zw.z)); y1[1] = c[1] * rstd * w1[1] * siluf_(bfhi(zw.z)); y1[2] = c[2] * rstd * w1[2] * siluf_(bflo(zw.w)); y1[3] = c[3] * rstd * w1[3] * siluf_(bfhi(zw.w));
        *(u32x4*)(OBg + (size_t)crow * 512 + head * 128 + dv0) = pack8f(y0, y1);
    }
}
DI void p8_final_norm(KA A) {
    const int tid = threadIdx.x, lane = tid & 63, wave = tid >> 6, gw = blockIdx.x * NWAVES + wave, NGW = gridDim.x * NWAVES;
    f32x4 nf[4];
#pragma unroll
    for (int j = 0; j < 4; ++j) nf[j] = ((const f32x4*)A->norm_final)[lane + 64 * j];
    const float* SS2 = (const float*)(A->ws + WS_SS2);
    for (int crow = gw; crow < MC; crow += NGW) {
        f32x4* row = (f32x4*)(A->out + (size_t)crow * D);
        const float rstd = rsqrtf(SS2[crow] * (1.0f / D) + EPS);
#pragma unroll
        for (int j = 0; j < 4; ++j) row[lane + 64 * j] = row[lane + 64 * j] * rstd * nf[j];
    }
}
__global__ void __launch_bounds__(NTHREADS, 2) hybrid_fwd(Args Aval) {
    extern __shared__ __attribute__((aligned(16))) unsigned char lds_raw[];
    LAS unsigned char* lds = (LAS unsigned char*)lds_raw;
    const int tid = threadIdx.x;
    int lo, hi; { KA A0 = kargs(); lo = A0->ph_lo; hi = A0->ph_hi; }
#if MK_N_LAUNCHES == 1
#if MK_BARRIER == 1
    volatile LAS unsigned* MISC = (volatile LAS unsigned*)(lds + LDS_MISC);
    if (tid < 64) MISC[tid] = 0u;
    __syncthreads();
    XcdBarrier bar; { KA A0 = kargs(); bar = xcd_barrier_post((unsigned*)(A0->ws + WS_CTL) + 4096, MISC + 8); }
#define GRID_BAR() xcd_barrier(bar)
#else
    cg::grid_group grid = cg::this_grid();
#define GRID_BAR() grid.sync()
#endif
#else
#define GRID_BAR() do {} while (0)
#endif
#ifndef PH_MASK
#define PH_MASK 0x3ff
#endif
#define IN(k) (((PH_MASK >> (k)) & 1) && lo <= (k) && (k) < hi)
#define SEAM(k) do { if (IN(k) && IN((k) + 1)) GRID_BAR(); } while (0)
    const int G = gridDim.x, wgid = blockIdx.x;
    if (IN(0)) { KA A = kargs(); p0_prologue(A, lds); } SEAM(0);
    if (IN(1)) { KA A = kargs(); unsigned char* ws = A->ws;
        pg8::Gemm g{(const bf16*)(ws + WS_XN), (const bf16*)(ws + WS_WIN), MUP, NIN, D}; pg8::StaticOrder S; S.init(MUP, NIN, G, wgid);
        pg8::EpiInProj E{(bf16*)(ws + WS_QA), (bf16*)(ws + WS_KV), (bf16*)(ws + WS_QKVB), (bf16*)(ws + WS_Z), (bf16*)(ws + WS_G),
                         (const float*)(ws + WS_ROPE), (const float*)(ws + WS_ROPE) + (TP + TS) * 32, A->out};
        pg8::gemm_phase<pg8::EpiInProj, pg8::StaticOrder, true, true>(lds, g, S, E);
    } SEAM(1);
    if (IN(2)) { KA A = kargs(); p2_prep(A, lds); } SEAM(2);
    if (IN(3)) { KA A = kargs(); p3_mixers(A, lds); } SEAM(3);
    if (IN(4)) { KA A = kargs(); p3b_gated_norm(A); } SEAM(4);
    if (IN(5)) { KA A = kargs(); unsigned char* ws = A->ws;
        { pg8::Gemm g{(const bf16*)(ws + WS_OA), (const bf16*)(ws + WS_WOA), MC, D, 512}; pg8::StaticOrder S; S.init(MC, D, G, wgid);
          pg8::EpiMerge<false> E{(bf16*)(ws + WS_MB), (const bf16*)(ws + WS_G), 0};
          pg8::gemm_phase<pg8::EpiMerge<false>, pg8::StaticOrder, true, true>(lds, g, S, E); }
        asm volatile("s_waitcnt vmcnt(0)" ::: "memory"); __syncthreads();
        { pg8::Gemm g{(const bf16*)(ws + WS_OB), (const bf16*)(ws + WS_WOB), MC, D, 512}; pg8::StaticOrder S; S.init(MC, D, G, wgid);
          pg8::EpiMerge<true> E{(bf16*)(ws + WS_MB), (const bf16*)(ws + WS_G), 1024};
          pg8::gemm_phase<pg8::EpiMerge<true>, pg8::StaticOrder, true, true>(lds, g, S, E); }
    } SEAM(5);
    if (IN(6)) { KA A = kargs(); unsigned char* ws = A->ws;
        pg8::Gemm g{(const bf16*)(ws + WS_MB), (const bf16*)(ws + WS_WOUT), MC, D, D}; pg8::StaticOrder S; S.init(MC, D, G, wgid);
        pg8::EpiWout E{A->x_prompt, A->x_sample, A->out, (bf16*)(ws + WS_HB1), (float*)(ws + WS_SS1)};
        pg8::gemm_phase<pg8::EpiWout, pg8::StaticOrder, true, true>(lds, g, S, E);
    } SEAM(6);
    if (IN(7)) { KA A = kargs(); unsigned char* ws = A->ws;
        pg8::Gemm g{(const bf16*)(ws + WS_HB1), (const bf16*)(ws + WS_WGU), MC, 2 * DFF, D}; pg8::StaticOrder S; S.init(MC, 2 * DFF, G, wgid);
        pg8::EpiGateUp E{(bf16*)(ws + WS_ACT), (const float*)(ws + WS_SS1)};
        pg8::gemm_phase<pg8::EpiGateUp, pg8::StaticOrder, true, true>(lds, g, S, E);
    } SEAM(7);
    if (IN(8)) { KA A = kargs(); unsigned char* ws = A->ws;
        pg8::Gemm g{(const bf16*)(ws + WS_ACT), (const bf16*)(ws + WS_WD), MC, D, DFF}; pg8::StaticOrder S; S.init(MC, D, G, wgid);
        pg8::EpiDown E{A->out, (float*)(ws + WS_SS2)};
        pg8::gemm_phase<pg8::EpiDown, pg8::StaticOrder, true, true>(lds, g, S, E);
    } SEAM(8);
    if (IN(9)) { KA A = kargs(); p8_final_norm(A); }
#undef IN
#undef SEAM
}

extern "C" void kernel_launch(void* const* d_in, const int* in_sizes, int n_in, void* d_out, int out_size, void* d_ws, size_t ws_size, hipStream_t stream) {
    static int grid = 0;
    if (grid == 0) {
        if (n_in != 22 || out_size != (int)O_END || ws_size < WS_END) { fprintf(stderr, "kernel_launch: unexpected problem (n_in %d, out %d, ws %zu)\n", n_in, out_size, ws_size); grid = -1; return; }
        int dev = 0, cus = 0, per_cu = 0;
        if (hipGetDevice(&dev) != hipSuccess || hipDeviceGetAttribute(&cus, hipDeviceAttributeMultiprocessorCount, dev) != hipSuccess) { grid = -1; return; }
        if (hipFuncSetAttribute((const void*)hybrid_fwd, hipFuncAttributeMaxDynamicSharedMemorySize, LDS_BYTES) != hipSuccess) { fprintf(stderr, "kernel_launch: hipFuncSetAttribute failed\n"); grid = -1; return; }
        if (hipOccupancyMaxActiveBlocksPerMultiprocessor(&per_cu, (const void*)hybrid_fwd, NTHREADS, LDS_BYTES) != hipSuccess || per_cu < 1) { fprintf(stderr, "kernel_launch: occupancy query says %d\n", per_cu); per_cu = 1; }
        (void)hipGetLastError();
        grid = cus;
        if (grid > 256) grid = 256;
    }
    if (grid < 0) return;
    (void)hipMemsetAsync((char*)d_ws + WS_CTL, 0, CTL_BYTES, stream);
    Args a{};
    const float** ap = (const float**)&a;
    for (int i = 0; i < 22; ++i) ap[i] = (const float*)d_in[i];
    a.out = (float*)d_out; a.ws = (unsigned char*)d_ws;
#if MK_N_LAUNCHES == 1
    a.ph_lo = 0; a.ph_hi = N_PHASES;
#if MK_BARRIER == 1
    hipLaunchKernelGGL(hybrid_fwd, dim3(grid), dim3(NTHREADS), LDS_BYTES, stream, a);
#else
    void* args[] = {&a};
    hipError_t e = hipLaunchCooperativeKernel((const void*)hybrid_fwd, dim3(grid), dim3(NTHREADS), args, LDS_BYTES, stream);
    if (e != hipSuccess) fprintf(stderr, "cooperative launch failed: %s (grid %d)\n", hipGetErrorString(e), grid);
#endif
#else
    for (int p = 0; p < N_PHASES; ++p) { a.ph_lo = p; a.ph_hi = p + 1; hipLaunchKernelGGL(hybrid_fwd, dim3(grid), dim3(NTHREADS), LDS_BYTES, stream, a); }
#endif
}
```

```cpp
#include <hip/hip_runtime.h>
#include <hip/hip_cooperative_groups.h>
#include <cstdio>
#include <cstdint>
namespace cg = cooperative_groups;

#ifndef MK_N_LAUNCHES
#define MK_N_LAUNCHES 1
#endif
#ifndef MK_BARRIER
#define MK_BARRIER 1
#endif

constexpr int D = 1024, NBATCH = 8, SEQ = 4096, NMETA = 16, TP = SEQ + NMETA, MP = NBATCH * TP;
constexpr int SBATCH = 128, TS = 4, MS = SBATCH * TS, MU = MP + MS, MUP = 33536, MC = NBATCH * SEQ + MS;
constexpr int PAST = 16384;
constexpr int HD = 64, NHA = 8, NKV = 2;
constexpr int NHB = 4, CONVD = 1536;
constexpr int DFF = 2816, NIN_SRC = 4872, NIN = 4864;
constexpr float EPS = 1e-6f;
constexpr float QSCALE = 0.125f * 1.4426950408889634f;

constexpr size_t MiB = 1u << 20, KiB = 1024;
constexpr size_t WS_CTL = 0, CTL_BYTES = 1 * MiB;
constexpr size_t WS_WIN = 1 * MiB;
constexpr size_t WS_WOA = 11 * MiB, WS_WOB = 12 * MiB;
constexpr size_t WS_WOUT = 13 * MiB;
constexpr size_t WS_WGU = 15 * MiB;
constexpr size_t WS_WD = 26 * MiB;
constexpr size_t WS_ROPE = 32 * MiB;
constexpr size_t WS_GB = 34 * MiB;
constexpr size_t WS_SC = 36 * MiB;
constexpr size_t WS_SS1 = 37 * MiB, WS_SS2 = 37 * MiB + 512 * KiB;
constexpr size_t WS_QA = 41 * MiB;
constexpr size_t WS_KV = WS_QA + (size_t)MUP * 512 * 2;
constexpr size_t WS_QKVB = WS_KV + (size_t)MUP * 256 * 2;
constexpr size_t WS_Z = WS_QKVB + (size_t)MUP * 1536 * 2;
constexpr size_t WS_G = WS_Z + (size_t)MUP * 512 * 2;
constexpr size_t WS_GEND = WS_G + (size_t)MUP * 2048 * 2;
constexpr size_t WS_B = 353 * MiB, WS_END = 512 * MiB;
static_assert(WS_GEND <= WS_B, "ws map");
constexpr size_t WS_XN = WS_B;
constexpr size_t PREP_SLOT = 96 * KiB;
constexpr int PREP_N1 = (int)((WS_END - WS_B) / PREP_SLOT);
constexpr size_t WS_OA = WS_QKVB;
constexpr size_t WS_OBRAW = WS_QKVB + 33 * MiB;
static_assert(WS_OBRAW + (size_t)MC * 512 * 4 <= WS_Z, "ws map");
constexpr size_t WS_OB = WS_QA;
constexpr size_t WS_MB = WS_B;
constexpr size_t WS_HB1 = WS_B + 66 * MiB;
static_assert(WS_HB1 + (size_t)MC * 1024 * 2 <= WS_END, "ws map");
constexpr size_t WS_ACT = WS_QA;
static_assert(WS_ACT + (size_t)MC * DFF * 2 <= WS_G, "ws map");
constexpr int SL_BEK = 0, SL_BV = 16 * 1024, SL_T = 32 * 1024, SL_QKD = 40 * 1024, SL_QE = 48 * 1024, SL_KWT = 64 * 1024, SL_A = 80 * 1024;
constexpr int N_PROMPT_SEQ = NBATCH * NHB, CHUNKS_P = 65, N_ITEMS_P = N_PROMPT_SEQ * CHUNKS_P, N_ITEMS = N_ITEMS_P + SBATCH * NHB;
static_assert(N_ITEMS <= PREP_N1 + (int)(((size_t)MC * 1024 * 4) / PREP_SLOT), "prep slots");

constexpr size_t O_YP = 0, O_YS = (size_t)NBATCH * SEQ * D, O_KP = O_YS + (size_t)MS * D, O_VP = O_KP + 8 * 128 * 2 * 64, O_DP = O_VP + 8 * 128 * 2 * 64,
                 O_CP = O_DP + 8 * 4 * 128 * 128, O_KS = O_CP + 8 * 3 * 1536, O_VS = O_KS + (size_t)128 * 128 * 2 * 64, O_DS = O_VS + (size_t)128 * 128 * 2 * 64,
                 O_CS = O_DS + (size_t)128 * 4 * 128 * 128, O_END = O_CS + (size_t)128 * 3 * 1536;
static_assert(O_END == 48074752, "d_out size");

#define DI __device__ __forceinline__
#define GAS __attribute__((address_space(1)))
#define LAS __attribute__((address_space(3)))
typedef unsigned short bf16;
typedef short bf16x8 __attribute__((ext_vector_type(8)));
typedef float f32x4 __attribute__((ext_vector_type(4)));
typedef float f32x2 __attribute__((ext_vector_type(2)));
typedef float f32x16 __attribute__((ext_vector_type(16)));
typedef unsigned u32x4 __attribute__((ext_vector_type(4)));
typedef unsigned u32x2 __attribute__((ext_vector_type(2)));
typedef __bf16 bf16x2_t __attribute__((ext_vector_type(2)));

DI unsigned cvtpk(float lo, float hi) { f32x2 v = {lo, hi}; bf16x2_t b = __builtin_convertvector(v, bf16x2_t); return __builtin_bit_cast(unsigned, b); }
DI bf16 f2bf(float f) { return (bf16)(cvtpk(f, 0.f) & 0xffffu); }
DI float bf2f(unsigned short h) { return __uint_as_float((unsigned)h << 16); }
DI float bflo(unsigned w) { return __uint_as_float(w << 16); }
DI float bfhi(unsigned w) { return __uint_as_float(w & 0xffff0000u); }
DI u32x4 pack8f(f32x4 a, f32x4 b) { u32x4 w; w.x = cvtpk(a[0], a[1]); w.y = cvtpk(a[2], a[3]); w.z = cvtpk(b[0], b[1]); w.w = cvtpk(b[2], b[3]); return w; }
DI float sigmoidf_(float x) { return 1.0f / (1.0f + __expf(-x)); }
DI float siluf_(float x) { return x / (1.0f + __expf(-x)); }
DI int pos_of_d(int d) { const int dd = d & 31; return 8 * (dd >> 2) + (dd & 3) + ((d >> 5) << 2); }
DI int d_of_pos(int p) { const int j = p & 7; return 4 * (p >> 3) + (j & 3) + ((j >> 2) << 5); }
namespace pg8 {
#define PG8_LAS __attribute__((address_space(3)))
typedef unsigned short bf16_t;
typedef short bf16x8 __attribute__((ext_vector_type(8)));
typedef float f32x4 __attribute__((ext_vector_type(4)));
typedef unsigned u32x4 __attribute__((ext_vector_type(4)));
constexpr int BM = 256, BK = 64, HALF = 128, HTB = HALF * BK * 2  , STAGE_BYTES = 8 * HTB, NXCD = 8, WGM = 8;

__host__ __device__ __forceinline__ int lds_byte(int r, int c) { const int st = (r >> 4) * 2 + (c >> 5), rr = r & 15, cc = c & 31, ob = rr * 64 + cc * 2; return st * 1024 + (ob ^ (((ob >> 9) & 1) << 5)); }
__host__ __device__ __forceinline__ void stage_rc(int b, int& R, int& C) { const int st = b / 1024, sb = b % 1024, swz = sb ^ (((sb >> 9) & 1) << 5); R = (st >> 1) * 16 + swz / 64; C = (st & 1) * 32 + (swz % 64) / 2; }
__host__ __device__ __forceinline__ int perm32(int rho) { const int n = rho >> 4, i = rho & 15; return 8 * (i >> 2) + 4 * n + (i & 3); }

struct Unit { int pm, pn; };
struct Gemm { const bf16_t* A; const bf16_t* Bt; int M, N, K; };

struct StaticOrder {
    int nM, nN, nwg, G, c;
    __host__ __device__ void init(int M, int N, int G_, int c_) { nM = M / BM; nN = N / BM; nwg = nM * nN; G = G_; c = c_; }
    __host__ __device__ bool next(int i, Unit& u) const {
        const long L = (long)i * G + c; if (L >= nwg) return false;
        int wgid = (int)L; { const int q = nwg / NXCD, r = nwg % NXCD, xcd = wgid % NXCD, off = wgid / NXCD; wgid = (xcd < r ? xcd * (q + 1) : r * (q + 1) + (xcd - r) * q) + off; }
        const int nig = WGM * nN, gid = wgid / nig, fm = gid * WGM, gsz = (nM - fm) < WGM ? (nM - fm) : WGM;
        u.pm = fm + ((wgid % nig) % gsz); u.pn = (wgid % nig) / gsz; return true;
    }
    __device__ __forceinline__ void a_ready(const Unit&) const {}
    __device__ __forceinline__ void done(const Unit&) const {}
};

__device__ __forceinline__ void urow_info(int urow, int& kind, int& b, int& t, int& ridx) {
    if (urow < MP) { b = urow / TP; t = urow - b * TP; kind = 0; ridx = t; }
    else if (urow < MU) { const int s = urow - MP; b = s >> 2; t = s & 3; kind = 1; ridx = TP + t; }
    else { kind = 2; b = 0; t = 0; ridx = 0; }
}
__device__ __forceinline__ int crow_to_urow(int crow) { return crow < NBATCH * SEQ ? crow + NMETA * ((crow >> 12) + 1) : MP + (crow - NBATCH * SEQ); }

struct EpiInProj {
    static constexpr bool PERM = true, AFTER_DRAIN = false;
    bf16_t *QA, *KV, *QKVB, *Z, *G; const float *COS, *SIN; float* out;
    __device__ __forceinline__ void operator()(const f32x4 (&acc)[2][2][4][2], const Unit& u, int wr, int wc, int fr, int fq) const {
        const int pn = u.pn;
#pragma unroll
        for (int ai = 0; ai < 2; ++ai)
#pragma unroll
            for (int m = 0; m < 4; ++m) {
                const int row = u.pm * BM + ai * HALF + wr * 64 + m * 16 + fr;
                int kind, b, t, ridx; urow_info(row, kind, b, t, ridx);
#pragma unroll
                for (int bj = 0; bj < 2; ++bj) {
                    const int cl = bj * HALF + wc * 32 + 8 * fq;
                    const f32x4 v0 = acc[ai][bj][m][0], v1 = acc[ai][bj][m][1];
                    if (pn < 2) {
                        const int c = pn * 256 + cl, d0 = ((c & 63) >> 3) * 4;
                        const f32x4 cs = *(const f32x4*)(COS + ridx * 32 + d0), sn = *(const f32x4*)(SIN + ridx * 32 + d0);
                        const f32x4 o1 = (v0 * cs - v1 * sn) * QSCALE, o2 = (v1 * cs + v0 * sn) * QSCALE;
                        *(u32x4*)(QA + (size_t)row * 512 + c) = pack8f(o1, o2);
                    } else if (pn == 2) {
                        if (bj == 0) {
                            const int kh = cl >> 6, d0 = ((cl & 63) >> 3) * 4;
                            const f32x4 cs = *(const f32x4*)(COS + ridx * 32 + d0), sn = *(const f32x4*)(SIN + ridx * 32 + d0);
                            const f32x4 o1 = v0 * cs - v1 * sn, o2 = v1 * cs + v0 * sn;
                            *(u32x4*)(KV + (size_t)row * 256 + cl) = pack8f(o1, o2);
                            float* dst = nullptr;
                            if (kind == 0 && t >= TP - 128) dst = out + O_KP + ((size_t)(b * 128 + (t - (TP - 128))) * 2 + kh) * 64;
                            else if (kind == 1) dst = out + O_KS + ((size_t)(b * 128 + 124 + t) * 2 + kh) * 64;
                            if (dst) { *(f32x4*)(dst + d0) = o1; *(f32x4*)(dst + 32 + d0) = o2; }
                        } else {
                            const int cv = cl - 128, kh = cv >> 6, dd = cv & 63;
                            *(u32x4*)(KV + (size_t)row * 256 + cl) = pack8f(v0, v1);
                            float* dst = nullptr;
                            if (kind == 0 && t >= TP - 128) dst = out + O_VP + ((size_t)(b * 128 + (t - (TP - 128))) * 2 + kh) * 64;
                            else if (kind == 1) dst = out + O_VS + ((size_t)(b * 128 + 124 + t) * 2 + kh) * 64;
                            if (dst) { *(f32x4*)(dst + dd) = v0; *(f32x4*)(dst + dd + 4) = v1; }
                        }
                    } else if (pn < 9) {
                        const int c = (pn - 3) * 256 + cl;
                        *(u32x4*)(QKVB + (size_t)row * 1536 + c) = pack8f(v0, v1);
                        float* dst = nullptr;
                        if (kind == 0 && t >= TP - 3) dst = out + O_CP + ((size_t)b * 3 + (t - (TP - 3))) * 1536;
                        else if (kind == 1 && t >= 1) dst = out + O_CS + ((size_t)b * 3 + (t - 1)) * 1536;
                        if (dst) { *(f32x4*)(dst + c) = v0; *(f32x4*)(dst + c + 4) = v1; }
                    } else if (pn < 11) {
                        const int c = (pn - 9) * 256 + cl;
                        *(u32x4*)(Z + (size_t)row * 512 + c) = pack8f(v0, v1);
                    } else {
                        const int c = (pn - 11) * 256 + cl;
                        f32x4 g0, g1;
#pragma unroll
                        for (int e = 0; e < 4; ++e) { g0[e] = sigmoidf_(v0[e]); g1[e] = sigmoidf_(v1[e]); }
                        *(u32x4*)(G + (size_t)row * 2048 + c) = pack8f(g0, g1);
                    }
                }
            }
    }
};

template <bool ACCUM> struct EpiMerge {
    static constexpr bool PERM = true, AFTER_DRAIN = false;
    bf16_t* MBp; const bf16_t* G; int gate_off;
    __device__ __forceinline__ void operator()(const f32x4 (&acc)[2][2][4][2], const Unit& u, int wr, int wc, int fr, int fq) const {
#pragma unroll
        for (int ai = 0; ai < 2; ++ai)
#pragma unroll
            for (int m = 0; m < 4; ++m) {
                const int crow = u.pm * BM + ai * HALF + wr * 64 + m * 16 + fr, urow = crow_to_urow(crow);
#pragma unroll
                for (int bj = 0; bj < 2; ++bj) {
                    const int c = u.pn * BM + bj * HALF + wc * 32 + 8 * fq;
                    const u32x4 gw = *(const u32x4*)(G + (size_t)urow * 2048 + gate_off + c);
                    f32x4 v0 = acc[ai][bj][m][0], v1 = acc[ai][bj][m][1];
                    v0[0] *= bflo(gw.x); v0[1] *= bfhi(gw.x); v0[2] *= bflo(gw.y); v0[3] *= bfhi(gw.y);
                    v1[0] *= bflo(gw.z); v1[1] *= bfhi(gw.z); v1[2] *= bflo(gw.w); v1[3] *= bfhi(gw.w);
                    bf16_t* p = MBp + (size_t)crow * 1024 + c;
                    if (ACCUM) { const u32x4 pw = *(const u32x4*)p;
                        v0[0] += bflo(pw.x); v0[1] += bfhi(pw.x); v0[2] += bflo(pw.y); v0[3] += bfhi(pw.y);
                        v1[0] += bflo(pw.z); v1[1] += bfhi(pw.z); v1[2] += bflo(pw.w); v1[3] += bfhi(pw.w); }
                    *(u32x4*)p = pack8f(v0, v1);
                }
            }
    }
};

template <bool ATOM = true> struct EpiWout {
    static constexpr bool PERM = true, AFTER_DRAIN = false;
    const float* xp; const float* xs; float* H; bf16_t* HB; float* SS;
    __device__ __forceinline__ void operator()(const f32x4 (&acc)[2][2][4][2], const Unit& u, int wr, int wc, int fr, int fq) const {
#pragma unroll
        for (int ai = 0; ai < 2; ++ai)
#pragma unroll
            for (int m = 0; m < 4; ++m) {
                const int crow = u.pm * BM + ai * HALF + wr * 64 + m * 16 + fr;
                const float* hs = crow < NBATCH * SEQ ? xp + (size_t)crow * D : xs + (size_t)(crow - NBATCH * SEQ) * D;
                float ss = 0.f;
#pragma unroll
                for (int bj = 0; bj < 2; ++bj) {
                    const int c = u.pn * BM + bj * HALF + wc * 32 + 8 * fq;
                    const f32x4 r0 = *(const f32x4*)(hs + c) + acc[ai][bj][m][0], r1 = *(const f32x4*)(hs + c + 4) + acc[ai][bj][m][1];
                    *(f32x4*)(H + (size_t)crow * D + c) = r0; *(f32x4*)(H + (size_t)crow * D + c + 4) = r1;
                    *(u32x4*)(HB + (size_t)crow * D + c) = pack8f(r0, r1);
                    ss += (r0[0] * r0[0] + r0[1] * r0[1]) + (r0[2] * r0[2] + r0[3] * r0[3]) + (r1[0] * r1[0] + r1[1] * r1[1]) + (r1[2] * r1[2] + r1[3] * r1[3]);
                }
                ss += __shfl_xor(ss, 16); ss += __shfl_xor(ss, 32);
                if (ATOM && fq == 0) atomicAdd(SS + crow, ss);
            }
    }
};

struct EpiGateUp {
    static constexpr bool PERM = true, AFTER_DRAIN = false;
    bf16_t* ACT; const float* SS;
    __device__ __forceinline__ void operator()(const f32x4 (&acc)[2][2][4][2], const Unit& u, int wr, int wc, int fr, int fq) const {
#pragma unroll
        for (int ai = 0; ai < 2; ++ai)
#pragma unroll
            for (int m = 0; m < 4; ++m) {
                const int crow = u.pm * BM + ai * HALF + wr * 64 + m * 16 + fr;
                const float rstd = rsqrtf(SS[crow] * (1.0f / D) + EPS);
                f32x4 a[2];
#pragma unroll
                for (int n = 0; n < 2; ++n)
#pragma unroll
                    for (int e = 0; e < 4; ++e) { const float g = acc[ai][0][m][n][e] * rstd, up = acc[ai][1][m][n][e] * rstd; a[n][e] = siluf_(g) * up; }
                *(u32x4*)(ACT + (size_t)crow * DFF + u.pn * HALF + wc * 32 + 8 * fq) = pack8f(a[0], a[1]);
            }
    }
};

template <bool DRY = false> struct EpiDown {
    static constexpr bool PERM = true, AFTER_DRAIN = false;
    float* H; float* SS;
    __device__ __forceinline__ void operator()(const f32x4 (&acc)[2][2][4][2], const Unit& u, int wr, int wc, int fr, int fq) const {
#pragma unroll
        for (int ai = 0; ai < 2; ++ai)
#pragma unroll
            for (int m = 0; m < 4; ++m) {
                const int crow = u.pm * BM + ai * HALF + wr * 64 + m * 16 + fr;
                float ss = 0.f;
#pragma unroll
                for (int bj = 0; bj < 2; ++bj) {
                    float* p = H + (size_t)crow * D + u.pn * BM + bj * HALF + wc * 32 + 8 * fq;
                    const f32x4 r0 = *(const f32x4*)p + acc[ai][bj][m][0] * (DRY ? 0.f : 1.f), r1 = *(const f32x4*)(p + 4) + acc[ai][bj][m][1] * (DRY ? 0.f : 1.f);
                    *(f32x4*)p = r0; *(f32x4*)(p + 4) = r1;
                    ss += (r0[0] * r0[0] + r0[1] * r0[1]) + (r0[2] * r0[2] + r0[3] * r0[3]) + (r1[0] * r1[0] + r1[1] * r1[1]) + (r1[2] * r1[2] + r1[3] * r1[3]);
                }
                ss += __shfl_xor(ss, 16); ss += __shfl_xor(ss, 32);
                if (!DRY && fq == 0) atomicAdd(SS + crow, ss);
            }
    }
};
template <class Epi, class Sched, bool ALIGN_EPI = false, bool SP2 = false>
__device__ __forceinline__ void gemm_phase(PG8_LAS unsigned char* lds, const Gemm g, const Sched& S, const Epi& E) {
    const int tid = threadIdx.x, wid = __builtin_amdgcn_readfirstlane(tid >> 6), lane = tid & 63, wr = wid >> 2, wc = wid & 3, fr = lane & 15, fq = lane >> 4;
    const int K = g.K, nt = K / BK;
    unsigned voffA[2], voffB[2];
#pragma unroll
    for (int i = 0; i < 2; ++i) { int R, C; stage_rc(tid * 16 + i * 8192, R, C); const int Rb = Epi::PERM ? ((R & ~31) + perm32(R & 31)) : R;
        voffA[i] = (unsigned)(R * K + C) * 2u; voffB[i] = (unsigned)(Rb * K + C) * 2u; }
    const size_t kstep = (size_t)(BK * 2);
    const size_t hstep = (size_t)HALF * K * 2;
    const size_t tstep = 2 * hstep;
    const unsigned ldsw = (unsigned)wid * 1024u;
    const int aoff = lds_byte(wr * 64 + fr, fq * 8), boff = lds_byte(wc * 32 + fr, fq * 8);
#define PG8_SA(b, h) (((b) * 2 + (h)) * HTB)
#define PG8_SB(b, h) ((4 + (b) * 2 + (h)) * HTB)
#define PG8_STAGE(bufoff, gbase, voff) do { _Pragma("unroll") for (int _i = 0; _i < 2; ++_i) \
        __builtin_amdgcn_global_load_lds((const unsigned*)((const char*)(gbase) + (voff)[_i]), (PG8_LAS unsigned*)(lds + (bufoff) + ldsw + _i * 8192), 16, 0, 0); } while (0)
#define PG8_LDA(dst, b, h) do { _Pragma("unroll") for (int m = 0; m < 4; ++m) _Pragma("unroll") for (int k = 0; k < 2; ++k) dst[m][k] = *(const PG8_LAS bf16x8*)(lds + PG8_SA(b, h) + aoff + m * 2048 + k * 1024); } while (0)
#define PG8_LDB(dst, b, h) do { _Pragma("unroll") for (int n = 0; n < 2; ++n) _Pragma("unroll") for (int k = 0; k < 2; ++k) dst[n][k] = *(const PG8_LAS bf16x8*)(lds + PG8_SB(b, h) + boff + n * 2048 + k * 1024); } while (0)
#define PG8_MMA(ai, bj, At, Bt) do { __builtin_amdgcn_s_setprio(1); _Pragma("unroll") for (int m = 0; m < 4; ++m) _Pragma("unroll") for (int n = 0; n < 2; ++n) _Pragma("unroll") for (int k = 0; k < 2; ++k) \
        acc[ai][bj][m][n] = __builtin_amdgcn_mfma_f32_16x16x32_bf16(Bt[n][k], At[m][k], acc[ai][bj][m][n], 0, 0, 0); __builtin_amdgcn_s_setprio(0); } while (0)
#define PG8_WAIT_V(n) asm volatile("s_waitcnt vmcnt(" #n ")" ::: "memory")
#define PG8_WAIT_L(n) asm volatile("s_waitcnt lgkmcnt(" #n ")" ::: "memory")
#define PG8_BAR __builtin_amdgcn_s_barrier()
#define PG8_SCHED __builtin_amdgcn_sched_barrier(0)
    Unit cur, nxt; int ui = 0;
    if (!S.next(0, cur)) return;
    f32x4 acc[2][2][4][2];
#pragma unroll
    for (int a = 0; a < 2; ++a)
#pragma unroll
        for (int b = 0; b < 2; ++b)
#pragma unroll
            for (int m = 0; m < 4; ++m)
#pragma unroll
                for (int n = 0; n < 2; ++n) acc[a][b][m][n] = (f32x4){0.f, 0.f, 0.f, 0.f};
    bf16x8 At[4][2], B0[2][2], B1[2][2];
    const char* cA = (const char*)g.A + (size_t)cur.pm * tstep; const char* cB = (const char*)g.Bt + (size_t)cur.pn * tstep;
    S.a_ready(cur);
    if constexpr (SP2) {
        PG8_STAGE(PG8_SB(0, 0), cB, voffB); PG8_STAGE(PG8_SB(0, 1), cB + hstep, voffB); PG8_STAGE(PG8_SA(0, 0), cA, voffA); PG8_STAGE(PG8_SA(0, 1), cA + hstep, voffA);
        if (wr == 1) PG8_BAR;
        PG8_WAIT_V(2); PG8_BAR;
        PG8_STAGE(PG8_SB(1, 0), cB + kstep, voffB); PG8_STAGE(PG8_SA(1, 0), cA + kstep, voffA); PG8_STAGE(PG8_SB(1, 1), cB + hstep + kstep, voffB);
        PG8_WAIT_V(6); PG8_BAR;
    } else {
        PG8_STAGE(PG8_SB(0, 0), cB, voffB); PG8_STAGE(PG8_SA(0, 0), cA, voffA); PG8_STAGE(PG8_SB(0, 1), cB + hstep, voffB); PG8_STAGE(PG8_SA(0, 1), cA + hstep, voffA);
        if (wr == 1) PG8_BAR;
        PG8_WAIT_V(4); PG8_BAR;
        PG8_STAGE(PG8_SB(1, 0), cB + kstep, voffB); PG8_STAGE(PG8_SA(1, 0), cA + kstep, voffA); PG8_STAGE(PG8_SB(1, 1), cB + hstep + kstep, voffB);
        PG8_WAIT_V(6); PG8_BAR;
    }
    for (;;) {
        const bool has_next = S.next(ui + 1, nxt);
        const char* nA = has_next ? (const char*)g.A + (size_t)nxt.pm * tstep : cA; const char* nB = has_next ? (const char*)g.Bt + (size_t)nxt.pn * tstep : cB;
        for (int t = 0; t < nt; t += 2) {
            const bool last = (t == nt - 2);
            const char* a1 = cA + (size_t)(t + 1) * kstep;
            const char* a2 = last ? nA : cA + (size_t)(t + 2) * kstep; const char* b2 = last ? nB : cB + (size_t)(t + 2) * kstep;
            const char* a3 = a2 + kstep; const char* b3 = b2 + kstep;
            if (last && has_next) S.a_ready(nxt);
            if constexpr (SP2) {
            PG8_LDB(B0, 0, 0); PG8_LDB(B1, 0, 1); PG8_SCHED; PG8_LDA(At, 0, 0); PG8_STAGE(PG8_SA(1, 1), a1 + hstep, voffA);
            PG8_WAIT_V(8); PG8_WAIT_L(0); PG8_BAR; PG8_MMA(0, 0, At, B0); PG8_MMA(0, 1, At, B1); PG8_BAR; PG8_SCHED;
            PG8_LDA(At, 0, 1); PG8_STAGE(PG8_SB(0, 0), b2, voffB); PG8_STAGE(PG8_SB(0, 1), b2 + hstep, voffB); PG8_STAGE(PG8_SA(0, 0), a2, voffA);
            PG8_WAIT_V(8); PG8_WAIT_L(0); PG8_BAR; PG8_MMA(1, 0, At, B0); PG8_MMA(1, 1, At, B1); PG8_BAR; PG8_SCHED;
            PG8_LDB(B0, 1, 0); PG8_LDB(B1, 1, 1); PG8_SCHED; PG8_LDA(At, 1, 0); PG8_STAGE(PG8_SA(0, 1), a2 + hstep, voffA);
            PG8_WAIT_V(8); PG8_WAIT_L(0); PG8_BAR; PG8_MMA(0, 0, At, B0); PG8_MMA(0, 1, At, B1); PG8_BAR; PG8_SCHED;
            PG8_LDA(At, 1, 1); PG8_STAGE(PG8_SB(1, 0), b3, voffB); PG8_STAGE(PG8_SB(1, 1), b3 + hstep, voffB); PG8_STAGE(PG8_SA(1, 0), a3, voffA);
            PG8_WAIT_V(8); PG8_WAIT_L(0); PG8_BAR; PG8_MMA(1, 0, At, B0); PG8_MMA(1, 1, At, B1); PG8_BAR; PG8_SCHED;
            } else {
            PG8_LDB(B0, 0, 0); PG8_SCHED; PG8_LDA(At, 0, 0); PG8_STAGE(PG8_SA(1, 1), a1 + hstep, voffA);
            PG8_WAIT_L(8); PG8_BAR; PG8_WAIT_L(0); PG8_MMA(0, 0, At, B0); PG8_BAR; PG8_SCHED;
            PG8_LDB(B1, 0, 1); PG8_STAGE(PG8_SB(0, 0), b2, voffB);
            PG8_BAR; PG8_WAIT_L(0); PG8_MMA(0, 1, At, B1); PG8_BAR;
            PG8_LDA(At, 0, 1); PG8_STAGE(PG8_SA(0, 0), a2, voffA);
            PG8_BAR; PG8_WAIT_L(0); PG8_MMA(1, 0, At, B0); PG8_BAR; PG8_SCHED;
            PG8_STAGE(PG8_SB(0, 1), b2 + hstep, voffB);
            PG8_WAIT_V(6); PG8_BAR; PG8_MMA(1, 1, At, B1); PG8_BAR;
            PG8_LDB(B0, 1, 0); PG8_SCHED; PG8_LDA(At, 1, 0); PG8_STAGE(PG8_SA(0, 1), a2 + hstep, voffA);
            PG8_WAIT_L(8); PG8_BAR; PG8_WAIT_L(0); PG8_MMA(0, 0, At, B0); PG8_BAR; PG8_SCHED;
            PG8_LDB(B1, 1, 1); PG8_STAGE(PG8_SB(1, 0), b3, voffB);
            PG8_BAR; PG8_WAIT_L(0); PG8_MMA(0, 1, At, B1); PG8_BAR;
            PG8_LDA(At, 1, 1); PG8_STAGE(PG8_SA(1, 0), a3, voffA);
            PG8_BAR; PG8_WAIT_L(0); PG8_MMA(1, 0, At, B0); PG8_BAR; PG8_SCHED;
            PG8_STAGE(PG8_SB(1, 1), b3 + hstep, voffB);
            PG8_WAIT_V(6); PG8_BAR; PG8_MMA(1, 1, At, B1); PG8_BAR;
            }
        }
        if constexpr (ALIGN_EPI) { if (wr == 0) PG8_BAR; }
        if constexpr (!Epi::AFTER_DRAIN) { E(acc, cur, wr, wc, fr, fq); S.done(cur); }
        if (!has_next) break;
#pragma unroll
        for (int a = 0; a < 2; ++a)
#pragma unroll
            for (int b = 0; b < 2; ++b)
#pragma unroll
                for (int m = 0; m < 4; ++m)
#pragma unroll
                    for (int n = 0; n < 2; ++n) acc[a][b][m][n] = (f32x4){0.f, 0.f, 0.f, 0.f};
        cur = nxt; cA = nA; cB = nB; ++ui;
        if constexpr (ALIGN_EPI) { if (wr == 1) PG8_BAR; }
    }
    PG8_WAIT_V(0);
    if constexpr (!ALIGN_EPI) { if (wr == 0) PG8_BAR; }
    PG8_BAR;
    if constexpr (Epi::AFTER_DRAIN) { E.fused(acc, cur, wr, wc, fr, fq, lds, wid, lane); S.done(cur); }
#undef PG8_SA
#undef PG8_SB
#undef PG8_STAGE
#undef PG8_LDA
#undef PG8_LDB
#undef PG8_MMA
#undef PG8_WAIT_V
#undef PG8_WAIT_L
#undef PG8_BAR
#undef PG8_SCHED
}
}
constexpr int NWAVES = 8, NTHREADS = NWAVES * 64;
constexpr int LDS_BYTES = 147456;
constexpr int LDS_MISC = 131072;
constexpr int N_PHASES = 10;

struct Args {
    const float *x_prompt, *x_sample, *cache_k, *cache_v, *state_delta, *state_conv, *meta, *norm_mix, *w_in, *conv_w, *a_log, *dt_bias, *sinks, *gdn_norm,
                *w_oa, *w_ob, *w_out, *norm_ffn, *w_gate, *w_up, *w_down, *norm_final;
    float* out; unsigned char* ws; int ph_lo, ph_hi;
};

typedef const __attribute__((address_space(4))) Args* KA;
DI KA kargs() { KA p = (KA)__builtin_amdgcn_kernarg_segment_ptr(); asm volatile("" : "+s"(p)); return p; }
#define RLX_AGENT __ATOMIC_RELAXED, __HIP_MEMORY_SCOPE_AGENT
#define LDS_WAIT() asm volatile("s_waitcnt lgkmcnt(0)" ::: "memory")
#define MFMA32(a, b, c) __builtin_amdgcn_mfma_f32_32x32x16_bf16((a), (b), (c), 0, 0, 0)
DI int crow16(int reg, int h) { return (reg & 3) + 8 * (reg >> 2) + 4 * h; }
DI float wave_sum(float v) {
#pragma unroll
    for (int o = 1; o < 64; o <<= 1) v += __shfl_xor(v, o);
    return v;
}
DI float wave_max(float v) {
#pragma unroll
    for (int o = 1; o < 64; o <<= 1) v = fmaxf(v, __shfl_xor(v, o));
    return v;
}
template <int S> DI bf16x8 pack_step(const f32x16& x) {
    u32x4 p; p.x = cvtpk(x[8 * S], x[8 * S + 1]); p.y = cvtpk(x[8 * S + 2], x[8 * S + 3]); p.z = cvtpk(x[8 * S + 4], x[8 * S + 5]); p.w = cvtpk(x[8 * S + 6], x[8 * S + 7]);
    return __builtin_bit_cast(bf16x8, p);
}
DI int frag_idx(int row, int k, int NKS) { const int kkk = k & 15; return (((row >> 5) * NKS + (k >> 4)) * 64 + (row & 31) + 32 * ((kkk >> 2) & 1)) * 8 + (((kkk >> 3) << 2) | (kkk & 3)); }
DI unsigned char* slot_ptr(KA A, int item) { return item < PREP_N1 ? A->ws + WS_B + (size_t)item * PREP_SLOT : (unsigned char*)A->out + (size_t)(item - PREP_N1) * PREP_SLOT; }

#define XB_TMO      128
#define XB_XCNT(j)  (256  + 64 * (j))
#define XB_XSUB(j)  (1280 + 64 * (j))
#define XB_XGEN(j)  (2304 + 64 * (j))
#define XB_TOP      3328
#define XB_TOPGEN   3392
#define XCD_BAR_WORDS 3456
#define XB_SPIN_CAP (1u << 20)
DI unsigned xb_ld(unsigned* p)              { return __hip_atomic_load(p, __ATOMIC_RELAXED, __HIP_MEMORY_SCOPE_AGENT); }
DI unsigned xb_add(unsigned* p, unsigned v) { return __hip_atomic_fetch_add(p, v, __ATOMIC_RELAXED, __HIP_MEMORY_SCOPE_AGENT); }
DI unsigned xb_xcc_id() { return (unsigned)__builtin_amdgcn_s_getreg((3 << 11) | 20) & 0xFu; }
#define XB_SPIN(cond, bar) do { unsigned _sp = 0; while (cond) { __builtin_amdgcn_s_sleep(1); \
    if ((++_sp & 255u) == 0u) { if (xb_ld(&(bar)[XB_TMO])) break; if (_sp > XB_SPIN_CAP) { atomicAdd(&(bar)[XB_TMO], 1u); break; } } } } while (0)
struct XcdBarrier { unsigned* bar; unsigned x; volatile LAS unsigned* st; };
DI XcdBarrier xcd_barrier_post(unsigned* bar, volatile LAS unsigned* st) {
    XcdBarrier b; b.bar = bar; b.x = xb_xcc_id(); b.st = st;
    if (threadIdx.x == 0) (void)xb_add(&bar[XB_XCNT(b.x)], 1u);
    return b;
}
DI void xcd_barrier_complete(unsigned* bar, unsigned x, unsigned& nloc, unsigned& nx) {
    const unsigned G = gridDim.x * gridDim.y * gridDim.z;
    unsigned sum, cnt, mine, sp = 0u;
    for (;;) {
        sum = 0u; cnt = 0u; mine = 0u;
#pragma unroll
        for (unsigned j = 0; j < 16; ++j) { const unsigned c = xb_ld(&bar[XB_XCNT(j)]); sum += c; cnt += (c > 0u) ? 1u : 0u; mine = (j == x) ? c : mine; }
        if (sum == G) break;
        __builtin_amdgcn_s_sleep(1);
        if ((++sp & 255u) == 0u) { if (xb_ld(&bar[XB_TMO])) break; if (sp > XB_SPIN_CAP) { atomicAdd(&bar[XB_TMO], 1u); break; } }
    }
    nloc = mine > 0u ? mine : 1u; nx = cnt > 0u ? cnt : 1u;
}
DI void xcd_barrier(const XcdBarrier& b) {
    asm volatile("s_waitcnt vmcnt(0)" ::: "memory");
    __syncthreads();
    if (threadIdx.x == 0) {
        unsigned* bar = b.bar;
        __builtin_amdgcn_s_waitcnt(0);
        unsigned nloc = b.st[0], nx = b.st[1];
        if (nloc == 0u) { xcd_barrier_complete(bar, b.x, nloc, nx); b.st[0] = nloc; b.st[1] = nx; }
        const unsigned old = xb_add(&bar[XB_XSUB(b.x)], 1u);
        const unsigned gen = old / nloc;
        if (old + 1u == (gen + 1u) * nloc) {
            __builtin_amdgcn_fence(__ATOMIC_RELEASE, "agent");
            asm volatile("s_waitcnt vmcnt(0)" ::: "memory");
            const unsigned og = xb_add(&bar[XB_TOP], 1u);
            const unsigned tg = og / nx;
            if (og + 1u == (tg + 1u) * nx) xb_add(&bar[XB_TOPGEN], 1u);
            else XB_SPIN(xb_ld(&bar[XB_TOPGEN]) == tg, bar);
            __builtin_amdgcn_fence(__ATOMIC_ACQUIRE, "agent");
            xb_add(&bar[XB_XGEN(b.x)], 1u);
            asm volatile("s_waitcnt vmcnt(0)" ::: "memory");
        } else {
            XB_SPIN(xb_ld(&bar[XB_XGEN(b.x)]) == gen, bar);
            __builtin_amdgcn_fence(__ATOMIC_ACQUIRE, "agent");
            asm volatile("s_waitcnt vmcnt(0)" ::: "memory");
        }
    }
    __syncthreads();
}

template <class RowMap> DI void transpose_item(const float* W, int K, int N, bf16* WT, RowMap rm, const float* kscale, LAS float* scr, int item, int lane) {
    const int nblk = (N + 31) / 32, kb = item / nblk, nb = item - kb * nblk, k0 = 64 * kb, n0 = 32 * nb;
    const int ncol = n0 + (lane & 31);
#pragma unroll 8
    for (int i = 0; i < 32; ++i) { const int kk = 2 * i + (lane >> 5);
        float v = ncol < N ? W[(size_t)(k0 + kk) * N + ncol] : 0.f;
        if (kscale) v *= kscale[k0 + kk];
        scr[kk * 33 + (lane & 31)] = v; }
    LDS_WAIT(); asm volatile("" ::: "memory");
    const int c = lane & 7;
#pragma unroll
    for (int j = 0; j < 4; ++j) { const int n = (lane >> 3) + 8 * j; const LAS float* s = scr + (8 * c) * 33 + n;
        const int nsrc = n0 + n; const int drow = nsrc < N ? rm(nsrc) : -1;
        u32x4 o; o.x = cvtpk(s[0 * 33], s[1 * 33]); o.y = cvtpk(s[2 * 33], s[3 * 33]); o.z = cvtpk(s[4 * 33], s[5 * 33]); o.w = cvtpk(s[6 * 33], s[7 * 33]);
        if (drow >= 0) *(u32x4*)(WT + (size_t)drow * K + k0 + 8 * c) = o; }
    LDS_WAIT(); asm volatile("" ::: "memory");
}
DI float softplusf_(float x) { return x > 20.f ? x : log1pf(__expf(x)); }

DI void p0_prologue(KA A, LAS unsigned char* lds) {
    const int tid = threadIdx.x, lane = tid & 63, wave = __builtin_amdgcn_readfirstlane(tid >> 6);
    const int G = gridDim.x, gw = blockIdx.x * NWAVES + wave, NGW = G * NWAVES;
    const int gt = blockIdx.x * NTHREADS + tid, NGT = G * NTHREADS;
    unsigned char* ws = A->ws;
    {
        LAS float* scr = (LAS float*)(lds + wave * 16384);
        constexpr int I_IN = 16 * 153, I_OA = 8 * 32, I_OUT = 16 * 32, I_G = 16 * 88, I_D = 44 * 32;
        constexpr int NIT = I_IN + 2 * I_OA + I_OUT + 2 * I_G + I_D;
        for (int it = gw; it < NIT; it += NGW) {
            int r = it;
            if (r < I_IN) { transpose_item(A->w_in, 1024, NIN_SRC, (bf16*)(ws + WS_WIN), [](int c) -> int {
                    if (c < 640) return (c & ~63) + pos_of_d(c & 63);
                    if (c < 2816) return c;
                    if (c < 2824) return -1;
                    return c - 8; }, nullptr, scr, r, lane); continue; } r -= I_IN;
            if (r < I_OA) { transpose_item(A->w_oa, 512, 1024, (bf16*)(ws + WS_WOA), [](int c) -> int { return c; }, nullptr, scr, r, lane); continue; } r -= I_OA;
            if (r < I_OA) { transpose_item(A->w_ob, 512, 1024, (bf16*)(ws + WS_WOB), [](int c) -> int { return c; }, nullptr, scr, r, lane); continue; } r -= I_OA;
            if (r < I_OUT) { transpose_item(A->w_out, 1024, 1024, (bf16*)(ws + WS_WOUT), [](int c) -> int { return c; }, nullptr, scr, r, lane); continue; } r -= I_OUT;
            if (r < I_G) { transpose_item(A->w_gate, 1024, DFF, (bf16*)(ws + WS_WGU), [](int c) -> int { return 256 * (c >> 7) + (c & 127); }, A->norm_ffn, scr, r, lane); continue; } r -= I_G;
            if (r < I_G) { transpose_item(A->w_up, 1024, DFF, (bf16*)(ws + WS_WGU), [](int c) -> int { return 256 * (c >> 7) + 128 + (c & 127); }, A->norm_ffn, scr, r, lane); continue; } r -= I_G;
            transpose_item(A->w_down, DFF, 1024, (bf16*)(ws + WS_WD), [](int c) -> int { return c; }, nullptr, scr, r, lane);
        }
    }
    {
        float* COS = (float*)(ws + WS_ROPE); float* SIN = COS + (TP + TS) * 32;
        for (int i = gt; i < (TP + TS) * 32; i += NGT) { const int ri = i >> 5, f = i & 31; const double pos = ri < TP ? (double)ri : (double)(PAST + ri - TP);
            const double inv = exp2(-(double)f * (13.287712379549449 / 32.0)), ang = pos * inv; COS[i] = (float)cos(ang); SIN[i] = (float)sin(ang); }
        float* SS1 = (float*)(ws + WS_SS1); float* SS2 = (float*)(ws + WS_SS2);
        for (int i = gt; i < MC; i += NGT) { SS1[i] = 0.f; SS2[i] = 0.f; }
        constexpr int PERB = 124 * 128 / 4;
        for (int i = gt; i < SBATCH * PERB; i += NGT) { const int b = i / PERB, o = i - b * PERB;
            ((f32x4*)(A->out + O_KS))[(size_t)b * 4096 + o] = ((const f32x4*)A->cache_k)[(size_t)b * 4096 + 128 + o];
            ((f32x4*)(A->out + O_VS))[(size_t)b * 4096 + o] = ((const f32x4*)A->cache_v)[(size_t)b * 4096 + 128 + o]; }
    }
    {
        unsigned wab[16][4];
        f32x4 nm[4];
#pragma unroll
        for (int j = 0; j < 4; ++j) {
            nm[j] = ((const f32x4*)A->norm_mix)[lane + 64 * j];
#pragma unroll
            for (int e = 0; e < 4; ++e) { const float* p = A->w_in + (size_t)(4 * (lane + 64 * j) + e) * NIN_SRC + 2816;
                const f32x4 a = *(const f32x4*)p, b = *(const f32x4*)(p + 4);
                wab[j * 4 + e][0] = cvtpk(a[0], a[1]); wab[j * 4 + e][1] = cvtpk(a[2], a[3]); wab[j * 4 + e][2] = cvtpk(b[0], b[1]); wab[j * 4 + e][3] = cvtpk(b[2], b[3]); }
        }
        bf16* XN = (bf16*)(ws + WS_XN); f32x2* GB = (f32x2*)(ws + WS_GB);
        for (int urow = gw; urow < MUP; urow += NGW) {
            const float* src = nullptr;
            if (urow < MP) { const int b = urow / TP, t = urow - b * TP; src = t < NMETA ? A->meta + (size_t)t * D : A->x_prompt + ((size_t)b * SEQ + (t - NMETA)) * D; }
            else if (urow < MU) src = A->x_sample + (size_t)(urow - MP) * D;
            u32x2* o8 = (u32x2*)(XN + (size_t)urow * D) + lane;
            if (!src) {
#pragma unroll
                for (int j = 0; j < 4; ++j) o8[64 * j] = (u32x2){0u, 0u};
                if (lane < 4) GB[(size_t)urow * 4 + lane] = (f32x2){0.f, 0.f};
                continue; }
            f32x4 v[4]; float ss = 0.f;
#pragma unroll
            for (int j = 0; j < 4; ++j) { v[j] = ((const f32x4*)src)[lane + 64 * j]; ss += (v[j][0] * v[j][0] + v[j][1] * v[j][1]) + (v[j][2] * v[j][2] + v[j][3] * v[j][3]); }
            const float rstd = rsqrtf(wave_sum(ss) * (1.0f / D) + EPS);
            float dot[8];
#pragma unroll
            for (int c = 0; c < 8; ++c) dot[c] = 0.f;
#pragma unroll
            for (int j = 0; j < 4; ++j) { v[j] = v[j] * rstd * nm[j];
                o8[64 * j] = (u32x2){cvtpk(v[j][0], v[j][1]), cvtpk(v[j][2], v[j][3])};
#pragma unroll
                for (int e = 0; e < 4; ++e)
#pragma unroll
                    for (int c = 0; c < 4; ++c) { dot[2 * c] += v[j][e] * bflo(wab[j * 4 + e][c]); dot[2 * c + 1] += v[j][e] * bfhi(wab[j * 4 + e][c]); } }
#pragma unroll
            for (int c = 0; c < 8; ++c) dot[c] = wave_sum(dot[c]);
            if (lane < 4) {
                const float a = lane == 0 ? dot[0] : lane == 1 ? dot[1] : lane == 2 ? dot[2] : dot[3];
                const float bb = lane == 0 ? dot[4] : lane == 1 ? dot[5] : lane == 2 ? dot[6] : dot[7];
                const float g = -__expf(A->a_log[lane]) * softplusf_(a + A->dt_bias[lane]);
                GB[(size_t)urow * 4 + lane] = (f32x2){g, sigmoidf_(bb)};
            }
        }
    }
}
DI void item_decode(int item, int& b, int& h, bool& sample, int& t0, int& L) {
    if (item < N_ITEMS_P) { const int s = item / CHUNKS_P, c = item - s * CHUNKS_P; b = s >> 2; h = s & 3; sample = false; if (c == 0) { t0 = 0; L = NMETA; } else { t0 = NMETA + 64 * (c - 1); L = 64; } }
    else { const int s = item - N_ITEMS_P; b = s >> 2; h = s & 3; sample = true; t0 = 0; L = TS; }
}
constexpr int PITCH = 132;
DI bf16x8 frag_nat(const LAS float* src, int row, int k0) {
    const f32x4 lo = *(const LAS f32x4*)(src + row * PITCH + k0), hi = *(const LAS f32x4*)(src + row * PITCH + k0 + 4);
    return __builtin_bit_cast(bf16x8, pack8f(lo, hi));
}
DI void prep_stage1(KA A, int item, LAS unsigned char* ldsb) {
    const int tid = threadIdx.x, lane = tid & 63, wave = __builtin_amdgcn_readfirstlane(tid >> 6), r = lane & 31, hh = lane >> 5;
    int b, h, t0, L; bool sample; item_decode(item, b, h, sample, t0, L);
    LAS float* Qs = (LAS float*)ldsb; LAS float* Ks = Qs + 64 * PITCH; LAS float* Vs = Ks + 64 * PITCH; LAS float* gcs = Vs + 64 * PITCH; LAS float* betas = gcs + 64;
    const bf16* QKVB = (const bf16*)(A->ws + WS_QKVB);
    unsigned char* slot = slot_ptr(A, item);
    if (tid < 384) {
        const int cv = tid % 48, rg = tid / 48, grp = cv >> 4, col0 = (cv & 15) * 8, r0 = rg * 8, cidx = grp * 512 + h * 128 + col0;
        u32x4 xr[11];
#pragma unroll
        for (int q = 0; q < 11; ++q) {
            const int i = r0 - 3 + q;
            long urow = sample ? (long)MP + b * TS + i : (long)b * TP + t0 + i;
            const bool ok = sample ? i >= 0 : t0 + i >= 0;
            if (!ok) urow = 0;
            xr[q] = *(const u32x4*)(QKVB + (size_t)urow * CONVD + cidx);
            if (!ok) xr[q] = (u32x4){0u, 0u, 0u, 0u};
        }
        float xf[3][8];
#pragma unroll
        for (int q = 0; q < 3; ++q) { xf[q][0] = bflo(xr[q].x); xf[q][1] = bfhi(xr[q].x); xf[q][2] = bflo(xr[q].y); xf[q][3] = bfhi(xr[q].y);
                                      xf[q][4] = bflo(xr[q].z); xf[q][5] = bfhi(xr[q].z); xf[q][6] = bflo(xr[q].w); xf[q][7] = bfhi(xr[q].w); }
        if (sample && rg == 0) {
#pragma unroll
            for (int q = 0; q < 3; ++q) { const float* sp = A->state_conv + ((size_t)b * 3 + q) * CONVD + cidx; const f32x4 s0 = *(const f32x4*)sp, s1 = *(const f32x4*)(sp + 4);
                xf[q][0] = s0[0]; xf[q][1] = s0[1]; xf[q][2] = s0[2]; xf[q][3] = s0[3]; xf[q][4] = s1[0]; xf[q][5] = s1[1]; xf[q][6] = s1[2]; xf[q][7] = s1[3]; }
        }
        float w[4][8];
#pragma unroll
        for (int i = 0; i < 4; ++i) { const f32x4 a0 = *(const f32x4*)(A->conv_w + i * CONVD + cidx), a1 = *(const f32x4*)(A->conv_w + i * CONVD + cidx + 4);
            w[i][0] = a0[0]; w[i][1] = a0[1]; w[i][2] = a0[2]; w[i][3] = a0[3]; w[i][4] = a1[0]; w[i][5] = a1[1]; w[i][6] = a1[2]; w[i][7] = a1[3]; }
        LAS float* dst = Qs + grp * 64 * PITCH + col0;
#pragma unroll
        for (int q = 3; q < 11; ++q) {
            const int rr = r0 + q - 3;
            float x[8] = {bflo(xr[q].x), bfhi(xr[q].x), bflo(xr[q].y), bfhi(xr[q].y), bflo(xr[q].z), bfhi(xr[q].z), bflo(xr[q].w), bfhi(xr[q].w)};
            f32x4 o0, o1;
#pragma unroll
            for (int e = 0; e < 8; ++e) { const float y = w[0][e] * xf[0][e] + w[1][e] * xf[1][e] + w[2][e] * xf[2][e] + w[3][e] * x[e];
                const float v = rr < L ? siluf_(y) : 0.f; if (e < 4) o0[e] = v; else o1[e - 4] = v;
                xf[0][e] = xf[1][e]; xf[1][e] = xf[2][e]; xf[2][e] = x[e]; }
            *(LAS f32x4*)(dst + rr * PITCH) = o0; *(LAS f32x4*)(dst + rr * PITCH + 4) = o1;
        }
    }
    __syncthreads();
    {
        const int i = tid >> 3, sub = tid & 7; float sq = 0.f, sk = 0.f;
#pragma unroll
        for (int e = 0; e < 16; ++e) { const float a = Qs[i * PITCH + sub * 16 + e], c = Ks[i * PITCH + sub * 16 + e]; sq += a * a; sk += c * c; }
        sq += __shfl_xor(sq, 1); sq += __shfl_xor(sq, 2); sq += __shfl_xor(sq, 4);
        sk += __shfl_xor(sk, 1); sk += __shfl_xor(sk, 2); sk += __shfl_xor(sk, 4);
        const float rq = rsqrtf(sq + EPS) * 0.08838834764831845f, rk = rsqrtf(sk + EPS);
#pragma unroll
        for (int e = 0; e < 16; ++e) { Qs[i * PITCH + sub * 16 + e] *= rq; Ks[i * PITCH + sub * 16 + e] *= rk; }
    }
    if (wave == 0) {
        float g = 0.f, be = 0.f;
        if (lane < L) { const int urow = sample ? MP + b * TS + lane : b * TP + t0 + lane; const f32x2 gb = ((const f32x2*)(A->ws + WS_GB))[(size_t)urow * 4 + h]; g = gb[0]; be = gb[1]; }
        float gc = g;
#pragma unroll
        for (int o = 1; o < 64; o <<= 1) { const float t = __shfl_up(gc, o); if (lane >= o) gc += t; }
        gcs[lane] = gc; betas[lane] = be;
        if (lane == 63) ((float*)(A->ws + WS_SC))[item] = __expf(gc);
    }
    __syncthreads();
    if (wave < 6) {
        const bool isqk = wave >= 3; const int tsel = isqk ? wave - 3 : wave, ib = tsel == 0 ? 0 : 1, jb = tsel == 2 ? 1 : 0;
        const LAS float* Asrc = isqk ? Qs : Ks;
        f32x16 acc;
#pragma unroll
        for (int e = 0; e < 16; ++e) acc[e] = 0.f;
#pragma unroll
        for (int s = 0; s < 8; ++s) acc = MFMA32(frag_nat(Asrc, 32 * ib + r, 16 * s + 8 * hh), frag_nat(Ks, 32 * jb + r, 16 * s + 8 * hh), acc);
        const int j = 32 * jb + r; const float gcj = gcs[j];
        float* Aout = (float*)(slot + SL_A); bf16* QKD = (bf16*)(slot + SL_QKD);
#pragma unroll
        for (int reg = 0; reg < 16; ++reg) { const int i = 32 * ib + crow16(reg, hh); const float dec = __expf(fminf(gcs[i] - gcj, 0.f));
            if (!isqk) Aout[j * 64 + i] = i > j ? betas[i] * dec * acc[reg] : 0.f;
            else QKD[frag_idx(i, j, 4)] = f2bf(i >= j ? dec * acc[reg] : 0.f); }
    }
    const float gcl = gcs[63];
#pragma unroll 1
    for (int job = wave; job < 56; job += 8) {
        if (job < 32) {
            const bool isq = job >= 16; const int jj = job & 15, rb = jj >> 3, ks = jj & 7, row = 32 * rb + r, k0 = 16 * ks + 4 * hh;
            const LAS float* src = isq ? Qs : Ks; const float sc = isq ? __expf(gcs[row]) : betas[row] * __expf(gcs[row]);
            const f32x4 lo = *(const LAS f32x4*)(src + row * PITCH + k0) * sc, hi = *(const LAS f32x4*)(src + row * PITCH + k0 + 8) * sc;
            *(u32x4*)(slot + (isq ? SL_QE : SL_BEK) + ((rb * 8 + ks) * 64 + lane) * 16) = pack8f(lo, hi);
        } else if (job < 48) {
            const int jj = job - 32, rb = jj >> 2, ks = jj & 3, dk = 32 * rb + r;
            f32x4 lo, hi;
#pragma unroll
            for (int e = 0; e < 4; ++e) { const int j0 = 16 * ks + 4 * hh + e, j1 = j0 + 8;
                lo[e] = Ks[j0 * PITCH + dk] * __expf(gcl - gcs[j0]); hi[e] = Ks[j1 * PITCH + dk] * __expf(gcl - gcs[j1]); }
            *(u32x4*)(slot + SL_KWT + ((rb * 4 + ks) * 64 + lane) * 16) = pack8f(lo, hi);
        } else {
            const int q = job - 48, w = q >> 1, ib = q & 1, dv = 32 * w + r;
            float v[16];
#pragma unroll
            for (int reg = 0; reg < 16; ++reg) { const int i = 32 * ib + crow16(reg, hh); v[reg] = betas[i] * Vs[i * PITCH + dv]; }
            u32x4* dst = (u32x4*)(slot + SL_BV + ((w * 2 + ib) * 64 + lane) * 32);
            dst[0] = (u32x4){cvtpk(v[0], v[1]), cvtpk(v[2], v[3]), cvtpk(v[4], v[5]), cvtpk(v[6], v[7])};
            dst[1] = (u32x4){cvtpk(v[8], v[9]), cvtpk(v[10], v[11]), cvtpk(v[12], v[13]), cvtpk(v[14], v[15])};
        }
    }
    __syncthreads();
}
DI void prep_stage2(KA A, int item, LAS float* M) {
    int lane = threadIdx.x & 63; asm volatile("" : "+v"(lane));
    const int r = lane & 31, hh = lane >> 5;
    unsigned char* slot = slot_ptr(A, item);
    const f32x4* Ain = (const f32x4*)(slot + SL_A);
#pragma unroll
    for (int q = 0; q < 16; ++q) *(LAS f32x4*)(M + (q * 64 + lane) * 4) = Ain[q * 64 + lane];
    LDS_WAIT(); asm volatile("" ::: "memory");
#pragma unroll 1
    for (int rb = 0; rb < 4; ++rb) {
        float acc[16];
#pragma unroll
        for (int i = 0; i < 16; ++i) acc[i] = lane == 16 * rb + i ? 1.f : 0.f;
#pragma unroll 2
        for (int j = 0; j < 16 * rb; ++j) {
            float tj = M[j * 64 + lane]; tj = lane <= j ? tj : 0.f;
            const LAS f32x4* ar = (const LAS f32x4*)(M + j * 64 + 16 * rb);
            const f32x4 a0 = ar[0], a1 = ar[1], a2 = ar[2], a3 = ar[3];
#pragma unroll
            for (int e = 0; e < 4; ++e) { acc[e] -= a0[e] * tj; acc[4 + e] -= a1[e] * tj; acc[8 + e] -= a2[e] * tj; acc[12 + e] -= a3[e] * tj; }
        }
#pragma unroll
        for (int j = 0; j < 16; ++j) {
            const float tj = acc[j]; const int row = 16 * rb + j;
            const LAS f32x4* ar = (const LAS f32x4*)(M + row * 64 + 16 * rb);
            float a[16];
#pragma unroll
            for (int q = j >> 2; q < 4; ++q) { const f32x4 v = ar[q]; a[4 * q] = v[0]; a[4 * q + 1] = v[1]; a[4 * q + 2] = v[2]; a[4 * q + 3] = v[3]; }
            if (lane <= row) M[row * 64 + lane] = tj;
#pragma unroll
            for (int i = j + 1; i < 16; ++i) acc[i] -= a[i] * tj;
        }
        asm volatile("" ::: "memory");
    }
    LDS_WAIT(); asm volatile("" ::: "memory");
#pragma unroll
    for (int f = 0; f < 8; ++f) { const int rb = f >> 2, ks = f & 3, row = 32 * rb + r, k0 = 16 * ks + 4 * hh;
        f32x4 lo = *(const LAS f32x4*)(M + row * 64 + k0), hi = *(const LAS f32x4*)(M + row * 64 + k0 + 8);
#pragma unroll
        for (int e = 0; e < 4; ++e) { lo[e] = k0 + e <= row ? lo[e] : 0.f; hi[e] = k0 + 8 + e <= row ? hi[e] : 0.f; }
        *(u32x4*)(slot + SL_T + ((rb * 4 + ks) * 64 + lane) * 16) = pack8f(lo, hi); }
    LDS_WAIT(); asm volatile("" ::: "memory");
}
DI void p2_prep(KA A, LAS unsigned char* lds) {
    const int wave = __builtin_amdgcn_readfirstlane(threadIdx.x >> 6), G = gridDim.x;
    for (int item = blockIdx.x; item < N_ITEMS; item += G) prep_stage1(A, item, lds);
    asm volatile("s_waitcnt vmcnt(0)" ::: "memory"); __syncthreads();
    int n = 0;
    for (int item = blockIdx.x; item < N_ITEMS; item += G, ++n) if ((n & 7) == wave) prep_stage2(A, item, (LAS float*)(lds + wave * 16384));
}

DI void scan_seq(KA A, int seq, int w, int lane) {
    const int r = lane & 31, hh = lane >> 5, dv = 32 * w + r;
    const bool sample = seq >= N_PROMPT_SEQ; const int sidx = sample ? seq - N_PROMPT_SEQ : seq, b = sidx >> 2, h = sidx & 3, nch = sample ? 1 : CHUNKS_P;
    f32x16 S[4];
    if (sample) {
        const float* S0 = A->state_delta + ((size_t)(b * 4 + h) * 128) * 128 + dv;
#pragma unroll
        for (int kb = 0; kb < 4; ++kb)
#pragma unroll
            for (int reg = 0; reg < 16; ++reg) S[kb][reg] = S0[(size_t)(32 * kb + crow16(reg, hh)) * 128];
    } else {
#pragma unroll
        for (int kb = 0; kb < 4; ++kb)
#pragma unroll
            for (int reg = 0; reg < 16; ++reg) S[kb][reg] = 0.f;
    }
    float* OBR = (float*)(A->ws + WS_OBRAW);
#pragma unroll 1
    for (int c = 0; c < nch; ++c) {
        const int item = sample ? N_ITEMS_P + sidx : seq * CHUNKS_P + c;
        const unsigned char* slot = slot_ptr(A, item);
        const float gcl = ((const float*)(A->ws + WS_SC))[item];
        const bf16x8* bek = (const bf16x8*)(slot + SL_BEK) + lane; const bf16x8* tp = (const bf16x8*)(slot + SL_T) + lane;
        const bf16x8* qe = (const bf16x8*)(slot + SL_QE) + lane; const bf16x8* qkd = (const bf16x8*)(slot + SL_QKD) + lane; const bf16x8* kwt = (const bf16x8*)(slot + SL_KWT) + lane;
        bf16x8 sf[8];
#pragma unroll
        for (int kb = 0; kb < 4; ++kb) { sf[2 * kb] = pack_step<0>(S[kb]); sf[2 * kb + 1] = pack_step<1>(S[kb]); }
        f32x16 x0, x1;
#pragma unroll
        for (int e = 0; e < 16; ++e) { x0[e] = 0.f; x1[e] = 0.f; }
#pragma unroll
        for (int ks = 0; ks < 8; ++ks) { x0 = MFMA32(bek[ks * 64], sf[ks], x0); x1 = MFMA32(bek[(8 + ks) * 64], sf[ks], x1); }
        {
            const u32x4* bv = (const u32x4*)(slot + SL_BV) + ((w * 2) * 64 + lane) * 2;
            const u32x4 a0 = bv[0], a1 = bv[1], c0 = bv[128], c1 = bv[129];
            x0[0] = bflo(a0.x) - x0[0]; x0[1] = bfhi(a0.x) - x0[1]; x0[2] = bflo(a0.y) - x0[2]; x0[3] = bfhi(a0.y) - x0[3];
            x0[4] = bflo(a0.z) - x0[4]; x0[5] = bfhi(a0.z) - x0[5]; x0[6] = bflo(a0.w) - x0[6]; x0[7] = bfhi(a0.w) - x0[7];
            x0[8] = bflo(a1.x) - x0[8]; x0[9] = bfhi(a1.x) - x0[9]; x0[10] = bflo(a1.y) - x0[10]; x0[11] = bfhi(a1.y) - x0[11];
            x0[12] = bflo(a1.z) - x0[12]; x0[13] = bfhi(a1.z) - x0[13]; x0[14] = bflo(a1.w) - x0[14]; x0[15] = bfhi(a1.w) - x0[15];
            x1[0] = bflo(c0.x) - x1[0]; x1[1] = bfhi(c0.x) - x1[1]; x1[2] = bflo(c0.y) - x1[2]; x1[3] = bfhi(c0.y) - x1[3];
            x1[4] = bflo(c0.z) - x1[4]; x1[5] = bfhi(c0.z) - x1[5]; x1[6] = bflo(c0.w) - x1[6]; x1[7] = bfhi(c0.w) - x1[7];
            x1[8] = bflo(c1.x) - x1[8]; x1[9] = bfhi(c1.x) - x1[9]; x1[10] = bflo(c1.y) - x1[10]; x1[11] = bfhi(c1.y) - x1[11];
            x1[12] = bflo(c1.z) - x1[12]; x1[13] = bfhi(c1.z) - x1[13]; x1[14] = bflo(c1.w) - x1[14]; x1[15] = bfhi(c1.w) - x1[15];
        }
        bf16x8 rf[4] = {pack_step<0>(x0), pack_step<1>(x0), pack_step<0>(x1), pack_step<1>(x1)};
        f32x16 u0, u1;
#pragma unroll
        for (int e = 0; e < 16; ++e) { u0[e] = 0.f; u1[e] = 0.f; }
        u0 = MFMA32(tp[0 * 64], rf[0], u0); u0 = MFMA32(tp[1 * 64], rf[1], u0);
#pragma unroll
        for (int ks = 0; ks < 4; ++ks) u1 = MFMA32(tp[(4 + ks) * 64], rf[ks], u1);
        bf16x8 uf[4] = {pack_step<0>(u0), pack_step<1>(u0), pack_step<0>(u1), pack_step<1>(u1)};
        if (sample || c > 0) {
#pragma unroll
            for (int e = 0; e < 16; ++e) { x0[e] = 0.f; x1[e] = 0.f; }
#pragma unroll
            for (int ks = 0; ks < 8; ++ks) { x0 = MFMA32(qe[ks * 64], sf[ks], x0); x1 = MFMA32(qe[(8 + ks) * 64], sf[ks], x1); }
            x0 = MFMA32(qkd[0 * 64], uf[0], x0); x0 = MFMA32(qkd[1 * 64], uf[1], x0);
#pragma unroll
            for (int ks = 0; ks < 4; ++ks) x1 = MFMA32(qkd[(4 + ks) * 64], uf[ks], x1);
            const int crow0 = sample ? NBATCH * SEQ + b * TS : b * SEQ + 64 * (c - 1), L = sample ? TS : 64;
#pragma unroll
            for (int reg = 0; reg < 16; ++reg) { const int i0 = crow16(reg, hh), i1 = 32 + i0;
                if (i0 < L) OBR[(size_t)(crow0 + i0) * 512 + h * 128 + dv] = x0[reg];
                if (i1 < L) OBR[(size_t)(crow0 + i1) * 512 + h * 128 + dv] = x1[reg]; }
        }
#pragma unroll
        for (int kb = 0; kb < 4; ++kb) {
            S[kb] = S[kb] * gcl;
#pragma unroll
            for (int ks = 0; ks < 4; ++ks) S[kb] = MFMA32(kwt[(kb * 4 + ks) * 64], uf[ks], S[kb]);
        }
    }
    float* So = A->out + (sample ? O_DS : O_DP) + ((size_t)(b * 4 + h) * 128) * 128 + dv;
#pragma unroll
    for (int kb = 0; kb < 4; ++kb)
#pragma unroll
        for (int reg = 0; reg < 16; ++reg) So[(size_t)(32 * kb + crow16(reg, hh)) * 128] = S[kb][reg];
}

constexpr int HALF_BYTES = 40960;
DI void scan_prompt_wg(KA A, int seq, LAS unsigned char* lds) {
    const int tid = threadIdx.x, lane = tid & 63, wave = __builtin_amdgcn_readfirstlane(tid >> 6);
    const int b = seq >> 2, h = seq & 3;
    constexpr int N = 2 * CHUNKS_P;
    if (wave >= 4) {
        const int loff = (wave - 4) * 10240 + lane * 16;
        u32x4 r0[10], r1[10];
        LAS u32x4* d0 = (LAS u32x4*)(lds + loff); LAS u32x4* d1 = (LAS u32x4*)(lds + HALF_BYTES + loff);
#define SCAN_SRC(n) ((const u32x4*)(slot_ptr(A, seq * CHUNKS_P + ((n) >> 1)) + ((n) & 1) * HALF_BYTES + loff))
        { const u32x4* s = SCAN_SRC(0);
#pragma unroll
            for (int q = 0; q < 10; ++q) r0[q] = s[q * 64]; }
#pragma unroll
        for (int q = 0; q < 10; ++q) d0[q * 64] = r0[q];
        { const u32x4* s = SCAN_SRC(1);
#pragma unroll
            for (int q = 0; q < 10; ++q) r1[q] = s[q * 64]; }
        __syncthreads();
#pragma unroll 1
        for (int n = 0; n < N; n += 2) {
            if (n + 2 < N) { const u32x4* s = SCAN_SRC(n + 2);
#pragma unroll
                for (int q = 0; q < 10; ++q) r0[q] = s[q * 64]; }
#pragma unroll
            for (int q = 0; q < 10; ++q) d1[q * 64] = r1[q];
            __syncthreads();
            if (n + 3 < N) { const u32x4* s = SCAN_SRC(n + 3);
#pragma unroll
                for (int q = 0; q < 10; ++q) r1[q] = s[q * 64]; }
            if (n + 2 < N) {
#pragma unroll
                for (int q = 0; q < 10; ++q) d0[q * 64] = r0[q]; }
            __syncthreads();
        }
#undef SCAN_SRC
    } else {
        const int w = wave, r = lane & 31, hh = lane >> 5, dv = 32 * w + r;
        f32x16 S[4];
#pragma unroll
        for (int kb = 0; kb < 4; ++kb)
#pragma unroll
            for (int reg = 0; reg < 16; ++reg) S[kb][reg] = 0.f;
        float* OBR = (float*)(A->ws + WS_OBRAW);
        const float* SCp = (const float*)(A->ws + WS_SC) + seq * CHUNKS_P;
        const LAS bf16x8* bek = (const LAS bf16x8*)(lds + SL_BEK) + lane; const LAS bf16x8* tp = (const LAS bf16x8*)(lds + SL_T) + lane;
        const LAS u32x4* bv = (const LAS u32x4*)(lds + SL_BV) + ((w * 2) * 64 + lane) * 2;
        const LAS bf16x8* qkd = (const LAS bf16x8*)(lds + HALF_BYTES + (SL_QKD - HALF_BYTES)) + lane; const LAS bf16x8* qe = (const LAS bf16x8*)(lds + HALF_BYTES + (SL_QE - HALF_BYTES)) + lane;
        const LAS bf16x8* kwt = (const LAS bf16x8*)(lds + HALF_BYTES + (SL_KWT - HALF_BYTES)) + lane;
        __syncthreads();
#pragma unroll 1
        for (int c = 0; c < CHUNKS_P; ++c) {
            const float gcl = SCp[c];
            bf16x8 sf[8];
#pragma unroll
            for (int kb = 0; kb < 4; ++kb) { sf[2 * kb] = pack_step<0>(S[kb]); sf[2 * kb + 1] = pack_step<1>(S[kb]); }
            f32x16 x0, x1;
#pragma unroll
            for (int e = 0; e < 16; ++e) { x0[e] = 0.f; x1[e] = 0.f; }
#pragma unroll
            for (int ks = 0; ks < 8; ++ks) { x0 = MFMA32(bek[ks * 64], sf[ks], x0); x1 = MFMA32(bek[(8 + ks) * 64], sf[ks], x1); }
            {
                const u32x4 a0 = bv[0], a1 = bv[1], c0 = bv[128], c1 = bv[129];
                x0[0] = bflo(a0.x) - x0[0]; x0[1] = bfhi(a0.x) - x0[1]; x0[2] = bflo(a0.y) - x0[2]; x0[3] = bfhi(a0.y) - x0[3];
                x0[4] = bflo(a0.z) - x0[4]; x0[5] = bfhi(a0.z) - x0[5]; x0[6] = bflo(a0.w) - x0[6]; x0[7] = bfhi(a0.w) - x0[7];
                x0[8] = bflo(a1.x) - x0[8]; x0[9] = bfhi(a1.x) - x0[9]; x0[10] = bflo(a1.y) - x0[10]; x0[11] = bfhi(a1.y) - x0[11];
                x0[12] = bflo(a1.z) - x0[12]; x0[13] = bfhi(a1.z) - x0[13]; x0[14] = bflo(a1.w) - x0[14]; x0[15] = bfhi(a1.w) - x0[15];
                x1[0] = bflo(c0.x) - x1[0]; x1[1] = bfhi(c0.x) - x1[1]; x1[2] = bflo(c0.y) - x1[2]; x1[3] = bfhi(c0.y) - x1[3];
                x1[4] = bflo(c0.z) - x1[4]; x1[5] = bfhi(c0.z) - x1[5]; x1[6] = bflo(c0.w) - x1[6]; x1[7] = bfhi(c0.w) - x1[7];
                x1[8] = bflo(c1.x) - x1[8]; x1[9] = bfhi(c1.x) - x1[9]; x1[10] = bflo(c1.y) - x1[10]; x1[11] = bfhi(c1.y) - x1[11];
                x1[12] = bflo(c1.z) - x1[12]; x1[13] = bfhi(c1.z) - x1[13]; x1[14] = bflo(c1.w) - x1[14]; x1[15] = bfhi(c1.w) - x1[15];
            }
            bf16x8 rf[4] = {pack_step<0>(x0), pack_step<1>(x0), pack_step<0>(x1), pack_step<1>(x1)};
            f32x16 u0, u1;
#pragma unroll
            for (int e = 0; e < 16; ++e) { u0[e] = 0.f; u1[e] = 0.f; }
            u0 = MFMA32(tp[0 * 64], rf[0], u0); u0 = MFMA32(tp[1 * 64], rf[1], u0);
#pragma unroll
            for (int ks = 0; ks < 4; ++ks) u1 = MFMA32(tp[(4 + ks) * 64], rf[ks], u1);
            bf16x8 uf[4] = {pack_step<0>(u0), pack_step<1>(u0), pack_step<0>(u1), pack_step<1>(u1)};
            __syncthreads();
            if (c > 0) {
#pragma unroll
                for (int e = 0; e < 16; ++e) { x0[e] = 0.f; x1[e] = 0.f; }
#pragma unroll
                for (int ks = 0; ks < 8; ++ks) { x0 = MFMA32(qe[ks * 64], sf[ks], x0); x1 = MFMA32(qe[(8 + ks) * 64], sf[ks], x1); }
                x0 = MFMA32(qkd[0 * 64], uf[0], x0); x0 = MFMA32(qkd[1 * 64], uf[1], x0);
#pragma unroll
                for (int ks = 0; ks < 4; ++ks) x1 = MFMA32(qkd[(4 + ks) * 64], uf[ks], x1);
                float* orow = OBR + (size_t)(b * SEQ + 64 * (c - 1)) * 512 + h * 128 + dv;
#pragma unroll
                for (int reg = 0; reg < 16; ++reg) { const int i0 = crow16(reg, hh); orow[(size_t)i0 * 512] = x0[reg]; orow[(size_t)(32 + i0) * 512] = x1[reg]; }
            }
#pragma unroll
            for (int kb = 0; kb < 4; ++kb) {
                S[kb] = S[kb] * gcl;
#pragma unroll
                for (int ks = 0; ks < 4; ++ks) S[kb] = MFMA32(kwt[(kb * 4 + ks) * 64], uf[ks], S[kb]);
            }
            __syncthreads();
        }
        float* So = A->out + O_DP + ((size_t)(b * 4 + h) * 128) * 128 + dv;
#pragma unroll
        for (int kb = 0; kb < 4; ++kb)
#pragma unroll
            for (int reg = 0; reg < 16; ++reg) So[(size_t)(32 * kb + crow16(reg, hh)) * 128] = S[kb][reg];
    }
}

constexpr int KPITCH = 72, VPITCH = 264;
DI void attn_unit(KA A, int unit, LAS unsigned char* ldsb) {
    const int tid = threadIdx.x, lane = tid & 63, wave = __builtin_amdgcn_readfirstlane(tid >> 6), r = lane & 31, hh = lane >> 5;
    const int b = unit >> 6, kh = (unit >> 5) & 1, jb = unit & 31, T0 = NMETA + 128 * jb;
    LAS bf16* Ksm = (LAS bf16*)ldsb; LAS bf16* VTs = Ksm + 256 * KPITCH;
    const bf16* KVg = (const bf16*)(A->ws + WS_KV); const bf16* QAg = (const bf16*)(A->ws + WS_QA);
#pragma unroll
    for (int e4 = 0; e4 < 4; ++e4) {
        const int id = tid + 512 * e4, key = id >> 3, cch = id & 7, tk = T0 - 128 + key;
        u32x4 kq = (u32x4){0u, 0u, 0u, 0u}, vq = kq;
        if (tk >= 0) { const bf16* src = KVg + (size_t)(b * TP + tk) * 256 + kh * 64 + 8 * cch; kq = *(const u32x4*)src; vq = *(const u32x4*)(src + 128); }
        *(LAS u32x4*)(Ksm + key * KPITCH + 8 * cch) = kq;
        const int kkk = key & 15, pos = (key & ~15) + 8 * ((kkk >> 2) & 1) + (((kkk >> 3) << 2) | (kkk & 3));
        LAS bf16* vd = VTs + (8 * cch) * VPITCH + pos;
        vd[0 * VPITCH] = (bf16)(vq.x & 0xffffu); vd[1 * VPITCH] = (bf16)(vq.x >> 16); vd[2 * VPITCH] = (bf16)(vq.y & 0xffffu); vd[3 * VPITCH] = (bf16)(vq.y >> 16);
        vd[4 * VPITCH] = (bf16)(vq.z & 0xffffu); vd[5 * VPITCH] = (bf16)(vq.z >> 16); vd[6 * VPITCH] = (bf16)(vq.w & 0xffffu); vd[7 * VPITCH] = (bf16)(vq.w >> 16);
    }
    __syncthreads();
    const int g = wave >> 1, qh = wave & 1, head = 4 * kh + g;
    const float sink2 = A->sinks[head] * 1.4426950408889634f;
    const int kmin = jb == 0 ? 128 - NMETA : 0;
#pragma unroll 1
    for (int q2 = 0; q2 < 2; ++q2) {
        const int qb = 2 * qh + q2, iq = 32 * qb + r;
        const bf16* qrow = QAg + (size_t)(b * TP + T0 + iq) * 512 + head * 64 + 8 * hh;
        bf16x8 qf[4];
#pragma unroll
        for (int s = 0; s < 4; ++s) qf[s] = *(const bf16x8*)(qrow + 16 * s);
        f32x16 st[5];
        float m = sink2;
#pragma unroll
        for (int kt5 = 0; kt5 < 5; ++kt5) {
            const int kt = qb + kt5;
            f32x16 acc;
#pragma unroll
            for (int e = 0; e < 16; ++e) acc[e] = 0.f;
#pragma unroll
            for (int s = 0; s < 4; ++s) acc = MFMA32(*(const LAS bf16x8*)(Ksm + (32 * kt + r) * KPITCH + 16 * s + 8 * hh), qf[s], acc);
#pragma unroll
            for (int reg = 0; reg < 16; ++reg) { const int kk = 32 * kt + crow16(reg, hh); const bool ok = kk >= iq && kk <= iq + 128 && kk >= kmin;
                acc[reg] = ok ? acc[reg] : -INFINITY; m = fmaxf(m, acc[reg]); }
            st[kt5] = acc;
        }
        m = fmaxf(m, __shfl_xor(m, 32));
        float l = 0.f;
#pragma unroll
        for (int kt5 = 0; kt5 < 5; ++kt5)
#pragma unroll
            for (int reg = 0; reg < 16; ++reg) { const float p = exp2f(st[kt5][reg] - m); st[kt5][reg] = p; l += p; }
        l += __shfl_xor(l, 32); l += exp2f(sink2 - m);
        f32x16 o0, o1;
#pragma unroll
        for (int e = 0; e < 16; ++e) { o0[e] = 0.f; o1[e] = 0.f; }
#pragma unroll
        for (int kt5 = 0; kt5 < 5; ++kt5) {
            const int kt = qb + kt5;
            const bf16x8 p0 = pack_step<0>(st[kt5]), p1 = pack_step<1>(st[kt5]);
            const LAS bf16* vb = VTs + r * VPITCH + 32 * kt + 8 * hh;
            o0 = MFMA32(*(const LAS bf16x8*)(vb), p0, o0); o0 = MFMA32(*(const LAS bf16x8*)(vb + 16), p1, o0);
            o1 = MFMA32(*(const LAS bf16x8*)(vb + 32 * VPITCH), p0, o1); o1 = MFMA32(*(const LAS bf16x8*)(vb + 32 * VPITCH + 16), p1, o1);
        }
        const float rl = 1.0f / l;
        bf16* orow = (bf16*)(A->ws + WS_OA) + (size_t)(b * SEQ + 128 * jb + iq) * 512 + head * 64 + 4 * hh;
#pragma unroll
        for (int g4 = 0; g4 < 4; ++g4) {
            *(u32x2*)(orow + 8 * g4) = (u32x2){cvtpk(o0[4 * g4] * rl, o0[4 * g4 + 1] * rl), cvtpk(o0[4 * g4 + 2] * rl, o0[4 * g4 + 3] * rl)};
            *(u32x2*)(orow + 32 + 8 * g4) = (u32x2){cvtpk(o1[4 * g4] * rl, o1[4 * g4 + 1] * rl), cvtpk(o1[4 * g4 + 2] * rl, o1[4 * g4 + 3] * rl)};
        }
    }
    __syncthreads();
}
DI void sample_attn(KA A, int b, int head, LAS float* wl, int lane) {
    const int kh = head >> 2;
    LAS float* qn = wl; LAS float* ps = wl + 256;
    const bf16* QAg = (const bf16*)(A->ws + WS_QA); const bf16* KVg = (const bf16*)(A->ws + WS_KV);
#pragma unroll
    for (int i = 0; i < 4; ++i) qn[i * 64 + lane] = bf2f(QAg[(size_t)(MP + b * TS + i) * 512 + head * 64 + pos_of_d(lane)]);
    LDS_WAIT(); asm volatile("" ::: "memory");
    const float sink2 = A->sinks[head] * 1.4426950408889634f;
#pragma unroll 1
    for (int kq = 0; kq < 3; ++kq) {
        const int kj = lane + 64 * kq;
        float sc0 = 0.f, sc1 = 0.f, sc2 = 0.f, sc3 = 0.f;
        if (kj < 128) {
            const f32x4* kr = (const f32x4*)(A->cache_k + ((size_t)(b * 128 + kj) * 2 + kh) * 64);
#pragma unroll 4
            for (int d4 = 0; d4 < 16; ++d4) { const f32x4 kv = kr[d4];
                const f32x4 q0 = *(const LAS f32x4*)(qn + 4 * d4), q1 = *(const LAS f32x4*)(qn + 64 + 4 * d4), q2 = *(const LAS f32x4*)(qn + 128 + 4 * d4), q3 = *(const LAS f32x4*)(qn + 192 + 4 * d4);
                sc0 += (kv[0] * q0[0] + kv[1] * q0[1]) + (kv[2] * q0[2] + kv[3] * q0[3]); sc1 += (kv[0] * q1[0] + kv[1] * q1[1]) + (kv[2] * q1[2] + kv[3] * q1[3]);
                sc2 += (kv[0] * q2[0] + kv[1] * q2[1]) + (kv[2] * q2[2] + kv[3] * q2[3]); sc3 += (kv[0] * q3[0] + kv[1] * q3[1]) + (kv[2] * q3[2] + kv[3] * q3[3]); }
        } else if (kj < 132) {
            const bf16* kr = KVg + (size_t)(MP + b * TS + (kj - 128)) * 256 + kh * 64;
#pragma unroll 4
            for (int p = 0; p < 64; ++p) { const float kv = bf2f(kr[p]); const int d = d_of_pos(p);
                sc0 += kv * qn[d]; sc1 += kv * qn[64 + d]; sc2 += kv * qn[128 + d]; sc3 += kv * qn[192 + d]; }
        }
        if (kj < 132) {
            ps[0 * 132 + kj] = (kj >= 0 && kj <= 128) ? sc0 : -INFINITY; ps[1 * 132 + kj] = (kj >= 1 && kj <= 129) ? sc1 : -INFINITY;
            ps[2 * 132 + kj] = (kj >= 2 && kj <= 130) ? sc2 : -INFINITY; ps[3 * 132 + kj] = (kj >= 3 && kj <= 131) ? sc3 : -INFINITY; }
    }
    LDS_WAIT(); asm volatile("" ::: "memory");
    float linv[4];
#pragma unroll
    for (int i = 0; i < 4; ++i) {
        const float s0 = ps[i * 132 + lane], s1 = ps[i * 132 + 64 + lane], s2 = lane < 4 ? ps[i * 132 + 128 + lane] : -INFINITY;
        const float m = wave_max(fmaxf(fmaxf(s0, s1), fmaxf(s2, sink2)));
        const float p0 = exp2f(s0 - m), p1 = exp2f(s1 - m), p2 = exp2f(s2 - m);
        ps[i * 132 + lane] = p0; ps[i * 132 + 64 + lane] = p1; if (lane < 4) ps[i * 132 + 128 + lane] = p2;
        linv[i] = 1.0f / (wave_sum(p0 + p1 + p2) + exp2f(sink2 - m));
    }
    LDS_WAIT(); asm volatile("" ::: "memory");
    float o[4] = {0.f, 0.f, 0.f, 0.f};
#pragma unroll 4
    for (int kj = 0; kj < 128; ++kj) { const float v = A->cache_v[((size_t)(b * 128 + kj) * 2 + kh) * 64 + lane];
#pragma unroll
        for (int i = 0; i < 4; ++i) o[i] += ps[i * 132 + kj] * v; }
#pragma unroll
    for (int kj = 128; kj < 132; ++kj) { const float v = bf2f(KVg[(size_t)(MP + b * TS + (kj - 128)) * 256 + 128 + kh * 64 + lane]);
#pragma unroll
        for (int i = 0; i < 4; ++i) o[i] += ps[i * 132 + kj] * v; }
    bf16* OAg = (bf16*)(A->ws + WS_OA);
#pragma unroll
    for (int i = 0; i < 4; ++i) OAg[(size_t)(NBATCH * SEQ + b * TS + i) * 512 + head * 64 + lane] = f2bf(o[i] * linv[i]);
    LDS_WAIT(); asm volatile("" ::: "memory");
}
DI void p3_mixers(KA A, LAS unsigned char* lds) {
    const int tid = threadIdx.x, lane = tid & 63, wave = __builtin_amdgcn_readfirstlane(tid >> 6), G = gridDim.x, wg = blockIdx.x;
    const int NSCAN = N_PROMPT_SEQ;
    if (wg < NSCAN) { scan_prompt_wg(A, wg, lds); return; }
    for (int u = wg - NSCAN; u < NBATCH * NKV * 32; u += G - NSCAN) attn_unit(A, u, lds);
    const int worker = (wg - NSCAN) * NWAVES + wave, NW = (G - NSCAN) * NWAVES;
    LAS float* wl = (LAS float*)(lds + 98304 + wave * 4096);
    for (int it = worker; it < SBATCH * NHB * 4 + SBATCH * NHA; it += NW) {
        if (it < SBATCH * NHB * 4) scan_seq(A, N_PROMPT_SEQ + (it >> 2), it & 3, lane);
        else { const int q = it - SBATCH * NHB * 4; sample_attn(A, q >> 3, q & 7, wl, lane); }
    }
}

DI void p3b_gated_norm(KA A) {
    const int tid = threadIdx.x, lane = tid & 63, wave = tid >> 6, gw = blockIdx.x * NWAVES + wave, NGW = gridDim.x * NWAVES;
    const int head = lane >> 4, dv0 = 8 * (lane & 15);
    const f32x4 w0 = *(const f32x4*)(A->gdn_norm + dv0), w1 = *(const f32x4*)(A->gdn_norm + dv0 + 4);
    const float* OBR = (const float*)(A->ws + WS_OBRAW); const bf16* Zg = (const bf16*)(A->ws + WS_Z); bf16* OBg = (bf16*)(A->ws + WS_OB);
    for (int crow = gw; crow < MC; crow += NGW) {
        const float* op = OBR + (size_t)crow * 512 + head * 128 + dv0;
        const f32x4 a = *(const f32x4*)op, c = *(const f32x4*)(op + 4);
        float ss = (a[0] * a[0] + a[1] * a[1]) + (a[2] * a[2] + a[3] * a[3]) + (c[0] * c[0] + c[1] * c[1]) + (c[2] * c[2] + c[3] * c[3]);
        ss += __shfl_xor(ss, 1); ss += __shfl_xor(ss, 2); ss += __shfl_xor(ss, 4); ss += __shfl_xor(ss, 8);
        const float rstd = rsqrtf(ss * (1.0f / 128.0f) + EPS);
        const u32x4 zw = *(const u32x4*)(Zg + (size_t)pg8::crow_to_urow(crow) * 512 + head * 128 + dv0);
        f32x4 y0, y1;
        y0[0] = a[0] * rstd * w0[0] * siluf_(bflo(zw.x)); y0[1] = a[1] * rstd * w0[1] * siluf_(bfhi(zw.x)); y0[2] = a[2] * rstd * w0[2] * siluf_(bflo(zw.y)); y0[3] = a[3] * rstd * w0[3] * siluf_(bfhi(zw.y));
        y1[0] = c[0] * rstd * w1[0] * siluf_(bflo(zw.z)); y1[1] = c[1] * rstd * w1[1] * siluf_(bfhi(zw.z)); y1[2] = c[2] * rstd * w1[2] * siluf_(bflo(zw.w)); y1[3] = c[3] * rstd * w1[3] * siluf_(bfhi(zw.w));
        *(u32x4*)(OBg + (size_t)crow * 512 + head * 128 + dv0) = pack8f(y0, y1);
    }
}
DI void p8_final_norm(KA A) {
    const int tid = threadIdx.x, lane = tid & 63, wave = tid >> 6, gw = blockIdx.x * NWAVES + wave, NGW = gridDim.x * NWAVES;
    f32x4 nf[4];
#pragma unroll
    for (int j = 0; j < 4; ++j) nf[j] = ((const f32x4*)A->norm_final)[lane + 64 * j];
    const float* SS2 = (const float*)(A->ws + WS_SS2);
    for (int crow = gw; crow < MC; crow += NGW) {
        f32x4* row = (f32x4*)(A->out + (size_t)crow * D);
        const float rstd = rsqrtf(SS2[crow] * (1.0f / D) + EPS);
#pragma unroll
        for (int j = 0; j < 4; ++j) row[lane + 64 * j] = row[lane + 64 * j] * rstd * nf[j];
    }
}
__global__ void __launch_bounds__(NTHREADS, 2) hybrid_fwd(Args Aval) {
    extern __shared__ __attribute__((aligned(16))) unsigned char lds_raw[];
    LAS unsigned char* lds = (LAS unsigned char*)lds_raw;
    const int tid = threadIdx.x;
    int lo, hi; { KA A0 = kargs(); lo = A0->ph_lo; hi = A0->ph_hi; }
#if MK_N_LAUNCHES == 1
#if MK_BARRIER == 1
    volatile LAS unsigned* MISC = (volatile LAS unsigned*)(lds + LDS_MISC);
    if (tid < 64) MISC[tid] = 0u;
    __syncthreads();
    XcdBarrier bar; { KA A0 = kargs(); bar = xcd_barrier_post((unsigned*)(A0->ws + WS_CTL) + 4096, MISC + 8); }
#define GRID_BAR() xcd_barrier(bar)
#else
    cg::grid_group grid = cg::this_grid();
#define GRID_BAR() grid.sync()
#endif
#else
#define GRID_BAR() do {} while (0)
#endif
#ifndef PH_MASK
#define PH_MASK 0x3ff
#endif
#define IN(k) (((PH_MASK >> (k)) & 1) && lo <= (k) && (k) < hi)
#ifndef PROBE_REP
#define PROBE_REP -1
#endif
#define NREP(k) (PROBE_REP == (k) ? 2 : 1)
#define SEAM(k) do { if (IN(k) && IN((k) + 1)) GRID_BAR(); } while (0)
    const int G = gridDim.x, wgid = blockIdx.x;
#if PROBE_REP == 0
    if (IN(0)) { KA A = kargs(); p0_prologue(A, lds); __syncthreads(); }
#endif
    if (IN(0)) { KA A = kargs(); p0_prologue(A, lds); } SEAM(0);
    if (IN(1)) for (int rep = 0; rep < NREP(1); ++rep) { KA A = kargs(); unsigned char* ws = A->ws;
        pg8::Gemm g{(const bf16*)(ws + WS_XN), (const bf16*)(ws + WS_WIN), MUP, NIN, D}; pg8::StaticOrder S; S.init(MUP, NIN, G, wgid);
        pg8::EpiInProj E{(bf16*)(ws + WS_QA), (bf16*)(ws + WS_KV), (bf16*)(ws + WS_QKVB), (bf16*)(ws + WS_Z), (bf16*)(ws + WS_G),
                         (const float*)(ws + WS_ROPE), (const float*)(ws + WS_ROPE) + (TP + TS) * 32, A->out};
        pg8::gemm_phase<pg8::EpiInProj, pg8::StaticOrder, true, true>(lds, g, S, E);
    } SEAM(1);
    if (IN(2)) for (int rep = 0; rep < NREP(2); ++rep) { KA A = kargs(); p2_prep(A, lds); __syncthreads(); } SEAM(2);
#if PROBE_REP == 3
    if (IN(3)) { KA A = kargs(); p3_mixers(A, lds); __syncthreads(); }
#endif
    if (IN(3)) { KA A = kargs(); p3_mixers(A, lds); } SEAM(3);
    if (IN(4)) for (int rep = 0; rep < NREP(4); ++rep) { KA A = kargs(); p3b_gated_norm(A); } SEAM(4);
    if (IN(5)) for (int rep = 0; rep < NREP(5); ++rep) { KA A = kargs(); unsigned char* ws = A->ws;
        { pg8::Gemm g{(const bf16*)(ws + WS_OA), (const bf16*)(ws + WS_WOA), MC, D, 512}; pg8::StaticOrder S; S.init(MC, D, G, wgid);
          pg8::EpiMerge<false> E{(bf16*)(ws + WS_MB), (const bf16*)(ws + WS_G), 0};
          pg8::gemm_phase<pg8::EpiMerge<false>, pg8::StaticOrder, true, true>(lds, g, S, E); }
        asm volatile("s_waitcnt vmcnt(0)" ::: "memory"); __syncthreads();
        { pg8::Gemm g{(const bf16*)(ws + WS_OB), (const bf16*)(ws + WS_WOB), MC, D, 512}; pg8::StaticOrder S; S.init(MC, D, G, wgid);
          pg8::EpiMerge<true> E{(bf16*)(ws + WS_MB), (const bf16*)(ws + WS_G), 1024};
          pg8::gemm_phase<pg8::EpiMerge<true>, pg8::StaticOrder, true, true>(lds, g, S, E); }
    } SEAM(5);
    if (IN(6)) { KA A = kargs(); unsigned char* ws = A->ws;
        pg8::Gemm g{(const bf16*)(ws + WS_MB), (const bf16*)(ws + WS_WOUT), MC, D, D}; pg8::StaticOrder S; S.init(MC, D, G, wgid);
        pg8::EpiWout<true> E{A->x_prompt, A->x_sample, A->out, (bf16*)(ws + WS_HB1), (float*)(ws + WS_SS1)};
        pg8::gemm_phase<pg8::EpiWout<true>, pg8::StaticOrder, true, true>(lds, g, S, E);
#if PROBE_REP == 6
        { pg8::EpiWout<false> E2{A->x_prompt, A->x_sample, A->out, (bf16*)(ws + WS_HB1), (float*)(ws + WS_SS1)}; pg8::gemm_phase<pg8::EpiWout<false>, pg8::StaticOrder, true, true>(lds, g, S, E2); }
#endif
    } SEAM(6);
    if (IN(7)) for (int rep = 0; rep < NREP(7); ++rep) { KA A = kargs(); unsigned char* ws = A->ws;
        pg8::Gemm g{(const bf16*)(ws + WS_HB1), (const bf16*)(ws + WS_WGU), MC, 2 * DFF, D}; pg8::StaticOrder S; S.init(MC, 2 * DFF, G, wgid);
        pg8::EpiGateUp E{(bf16*)(ws + WS_ACT), (const float*)(ws + WS_SS1)};
        pg8::gemm_phase<pg8::EpiGateUp, pg8::StaticOrder, true, true>(lds, g, S, E);
    } SEAM(7);
    if (IN(8)) { KA A = kargs(); unsigned char* ws = A->ws;
        pg8::Gemm g{(const bf16*)(ws + WS_ACT), (const bf16*)(ws + WS_WD), MC, D, DFF}; pg8::StaticOrder S; S.init(MC, D, G, wgid);
        pg8::EpiDown<false> E{A->out, (float*)(ws + WS_SS2)};
        pg8::gemm_phase<pg8::EpiDown<false>, pg8::StaticOrder, true, true>(lds, g, S, E);
#if PROBE_REP == 8
        { pg8::EpiDown<true> E2{A->out, (float*)(ws + WS_SS2)}; pg8::gemm_phase<pg8::EpiDown<true>, pg8::StaticOrder, true, true>(lds, g, S, E2); }
#endif
    } SEAM(8);
    if (IN(9)) { KA A = kargs(); p8_final_norm(A); }
#undef IN
#undef SEAM
}

extern "C" void kernel_launch(void* const* d_in, const int* in_sizes, int n_in, void* d_out, int out_size, void* d_ws, size_t ws_size, hipStream_t stream) {
    static int grid = 0;
    if (grid == 0) {
        if (n_in != 22 || out_size != (int)O_END || ws_size < WS_END) { fprintf(stderr, "kernel_launch: unexpected problem (n_in %d, out %d, ws %zu)\n", n_in, out_size, ws_size); grid = -1; return; }
        int dev = 0, cus = 0, per_cu = 0;
        if (hipGetDevice(&dev) != hipSuccess || hipDeviceGetAttribute(&cus, hipDeviceAttributeMultiprocessorCount, dev) != hipSuccess) { grid = -1; return; }
        if (hipFuncSetAttribute((const void*)hybrid_fwd, hipFuncAttributeMaxDynamicSharedMemorySize, LDS_BYTES) != hipSuccess) { fprintf(stderr, "kernel_launch: hipFuncSetAttribute failed\n"); grid = -1; return; }
        if (hipOccupancyMaxActiveBlocksPerMultiprocessor(&per_cu, (const void*)hybrid_fwd, NTHREADS, LDS_BYTES) != hipSuccess || per_cu < 1) { fprintf(stderr, "kernel_launch: occupancy query says %d\n", per_cu); per_cu = 1; }
        (void)hipGetLastError();
        grid = cus;
        if (grid > 256) grid = 256;
    }
    if (grid < 0) return;
    (void)hipMemsetAsync((char*)d_ws + WS_CTL, 0, CTL_BYTES, stream);
    Args a{};
    const float** ap = (const float**)&a;
    for (int i = 0; i < 22; ++i) ap[i] = (const float*)d_in[i];
    a.out = (float*)d_out; a.ws = (unsigned char*)d_ws;
#if MK_N_LAUNCHES == 1
    a.ph_lo = 0; a.ph_hi = N_PHASES;
#if MK_BARRIER == 1
    hipLaunchKernelGGL(hybrid_fwd, dim3(grid), dim3(NTHREADS), LDS_BYTES, stream, a);
#else
    void* args[] = {&a};
    hipError_t e = hipLaunchCooperativeKernel((const void*)hybrid_fwd, dim3(grid), dim3(NTHREADS), args, LDS_BYTES, stream);
    if (e != hipSuccess) fprintf(stderr, "cooperative launch failed: %s (grid %d)\n", hipGetErrorString(e), grid);
#endif
#else
    for (int p = 0; p < N_PHASES; ++p) { a.ph_lo = p; a.ph_hi = p + 1; hipLaunchKernelGGL(hybrid_fwd, dim3(grid), dim3(NTHREADS), LDS_BYTES, stream, a); }
#endif
}
```

```cpp
#include <hip/hip_runtime.h>
#include <hip/hip_cooperative_groups.h>
#include <cstdio>
#include <cstdint>
namespace cg = cooperative_groups;

#ifndef MK_N_LAUNCHES
#define MK_N_LAUNCHES 1
#endif
#ifndef MK_BARRIER
#define MK_BARRIER 1
#endif

constexpr int D = 1024, NBATCH = 8, SEQ = 4096, NMETA = 16, TP = SEQ + NMETA, MP = NBATCH * TP;
constexpr int SBATCH = 128, TS = 4, MS = SBATCH * TS, MU = MP + MS, MUP = 33536, MC = NBATCH * SEQ + MS;
constexpr int PAST = 16384;
constexpr int HD = 64, NHA = 8, NKV = 2;
constexpr int NHB = 4, CONVD = 1536;
constexpr int DFF = 2816, NIN_SRC = 4872, NIN = 4864;
constexpr float EPS = 1e-6f;
constexpr float QSCALE = 0.125f * 1.4426950408889634f;

constexpr size_t MiB = 1u << 20, KiB = 1024;
constexpr size_t WS_CTL = 0, CTL_BYTES = 1 * MiB;
constexpr size_t WS_WIN = 1 * MiB;
constexpr size_t WS_WOA = 11 * MiB, WS_WOB = 12 * MiB;
constexpr size_t WS_WOUT = 13 * MiB;
constexpr size_t WS_WGU = 15 * MiB;
constexpr size_t WS_WD = 26 * MiB;
constexpr size_t WS_ROPE = 32 * MiB;
constexpr size_t WS_GB = 34 * MiB;
constexpr size_t WS_SC = 36 * MiB;
constexpr size_t WS_SS1 = 37 * MiB, WS_SS2 = 37 * MiB + 512 * KiB;
constexpr size_t WS_QA = 41 * MiB;
constexpr size_t WS_KV = WS_QA + (size_t)MUP * 512 * 2;
constexpr size_t WS_QKVB = WS_KV + (size_t)MUP * 256 * 2;
constexpr size_t WS_Z = WS_QKVB + (size_t)MUP * 1536 * 2;
constexpr size_t WS_G = WS_Z + (size_t)MUP * 512 * 2;
constexpr size_t WS_GEND = WS_G + (size_t)MUP * 2048 * 2;
constexpr size_t WS_B = 353 * MiB, WS_END = 512 * MiB;
static_assert(WS_GEND <= WS_B, "ws map");
constexpr size_t WS_XN = WS_B;
constexpr size_t PREP_SLOT = 96 * KiB;
constexpr int PREP_N1 = (int)((WS_END - WS_B) / PREP_SLOT);
constexpr size_t WS_OA = WS_QKVB;
constexpr size_t WS_OBRAW = WS_QKVB + 33 * MiB;
static_assert(WS_OBRAW + (size_t)MC * 512 * 4 <= WS_Z, "ws map");
constexpr size_t WS_OB = WS_QA;
constexpr size_t WS_MB = WS_B;
constexpr size_t WS_HB1 = WS_B + 66 * MiB;
static_assert(WS_HB1 + (size_t)MC * 1024 * 2 <= WS_END, "ws map");
constexpr size_t WS_ACT = WS_QA;
static_assert(WS_ACT + (size_t)MC * DFF * 2 <= WS_G, "ws map");
constexpr int SL_BEK = 0, SL_BV = 16 * 1024, SL_T = 32 * 1024, SL_QKD = 40 * 1024, SL_QE = 48 * 1024, SL_KWT = 64 * 1024, SL_A = 80 * 1024;
constexpr int N_PROMPT_SEQ = NBATCH * NHB, CHUNKS_P = 65, N_ITEMS_P = N_PROMPT_SEQ * CHUNKS_P, N_ITEMS = N_ITEMS_P + SBATCH * NHB;
static_assert(N_ITEMS <= PREP_N1 + (int)(((size_t)MC * 1024 * 4) / PREP_SLOT), "prep slots");

constexpr size_t O_YP = 0, O_YS = (size_t)NBATCH * SEQ * D, O_KP = O_YS + (size_t)MS * D, O_VP = O_KP + 8 * 128 * 2 * 64, O_DP = O_VP + 8 * 128 * 2 * 64,
                 O_CP = O_DP + 8 * 4 * 128 * 128, O_KS = O_CP + 8 * 3 * 1536, O_VS = O_KS + (size_t)128 * 128 * 2 * 64, O_DS = O_VS + (size_t)128 * 128 * 2 * 64,
                 O_CS = O_DS + (size_t)128 * 4 * 128 * 128, O_END = O_CS + (size_t)128 * 3 * 1536;
static_assert(O_END == 48074752, "d_out size");

#define DI __device__ __forceinline__
#define GAS __attribute__((address_space(1)))
#define LAS __attribute__((address_space(3)))
typedef unsigned short bf16;
typedef short bf16x8 __attribute__((ext_vector_type(8)));
typedef float f32x4 __attribute__((ext_vector_type(4)));
typedef float f32x2 __attribute__((ext_vector_type(2)));
typedef float f32x16 __attribute__((ext_vector_type(16)));
typedef unsigned u32x4 __attribute__((ext_vector_type(4)));
typedef unsigned u32x2 __attribute__((ext_vector_type(2)));
typedef __bf16 bf16x2_t __attribute__((ext_vector_type(2)));

DI unsigned cvtpk(float lo, float hi) { f32x2 v = {lo, hi}; bf16x2_t b = __builtin_convertvector(v, bf16x2_t); return __builtin_bit_cast(unsigned, b); }
DI bf16 f2bf(float f) { return (bf16)(cvtpk(f, 0.f) & 0xffffu); }
DI float bf2f(unsigned short h) { return __uint_as_float((unsigned)h << 16); }
DI float bflo(unsigned w) { return __uint_as_float(w << 16); }
DI float bfhi(unsigned w) { return __uint_as_float(w & 0xffff0000u); }
DI u32x4 pack8f(f32x4 a, f32x4 b) { u32x4 w; w.x = cvtpk(a[0], a[1]); w.y = cvtpk(a[2], a[3]); w.z = cvtpk(b[0], b[1]); w.w = cvtpk(b[2], b[3]); return w; }
DI float frcp_(float x) { return __builtin_amdgcn_rcpf(x); }
DI float sigmoidf_(float x) { return frcp_(1.0f + __builtin_amdgcn_exp2f(x * -1.4426950408889634f)); }
DI float siluf_(float x) { return x * sigmoidf_(x); }
DI int pos_of_d(int d) { const int dd = d & 31; return 8 * (dd >> 2) + (dd & 3) + ((d >> 5) << 2); }
DI int d_of_pos(int p) { const int j = p & 7; return 4 * (p >> 3) + (j & 3) + ((j >> 2) << 5); }
namespace pg8 {
#define PG8_LAS __attribute__((address_space(3)))
typedef unsigned short bf16_t;
typedef short bf16x8 __attribute__((ext_vector_type(8)));
typedef float f32x4 __attribute__((ext_vector_type(4)));
typedef unsigned u32x4 __attribute__((ext_vector_type(4)));
constexpr int BM = 256, BK = 64, HALF = 128, HTB = HALF * BK * 2  , STAGE_BYTES = 8 * HTB, NXCD = 8, WGM = 8;

__host__ __device__ __forceinline__ int lds_byte(int r, int c) { const int st = (r >> 4) * 2 + (c >> 5), rr = r & 15, cc = c & 31, ob = rr * 64 + cc * 2; return st * 1024 + (ob ^ (((ob >> 9) & 1) << 5)); }
__host__ __device__ __forceinline__ void stage_rc(int b, int& R, int& C) { const int st = b / 1024, sb = b % 1024, swz = sb ^ (((sb >> 9) & 1) << 5); R = (st >> 1) * 16 + swz / 64; C = (st & 1) * 32 + (swz % 64) / 2; }
__host__ __device__ __forceinline__ int perm32(int rho) { const int n = rho >> 4, i = rho & 15; return 8 * (i >> 2) + 4 * n + (i & 3); }

struct Unit { int pm, pn; };
struct Gemm { const bf16_t* A; const bf16_t* Bt; int M, N, K; };

struct StaticOrder {
    int nM, nN, nwg, G, c;
    __host__ __device__ void init(int M, int N, int G_, int c_) { nM = M / BM; nN = N / BM; nwg = nM * nN; G = G_; c = c_; }
    __host__ __device__ bool next(int i, Unit& u) const {
        const long L = (long)i * G + c; if (L >= nwg) return false;
        int wgid = (int)L; { const int q = nwg / NXCD, r = nwg % NXCD, xcd = wgid % NXCD, off = wgid / NXCD; wgid = (xcd < r ? xcd * (q + 1) : r * (q + 1) + (xcd - r) * q) + off; }
        const int nig = WGM * nN, gid = wgid / nig, fm = gid * WGM, gsz = (nM - fm) < WGM ? (nM - fm) : WGM;
        u.pm = fm + ((wgid % nig) % gsz); u.pn = (wgid % nig) / gsz; return true;
    }
    __device__ __forceinline__ void a_ready(const Unit&) const {}
    __device__ __forceinline__ void done(const Unit&) const {}
};

__device__ __forceinline__ void urow_info(int urow, int& kind, int& b, int& t, int& ridx) {
    if (urow < MP) { b = urow / TP; t = urow - b * TP; kind = 0; ridx = t; }
    else if (urow < MU) { const int s = urow - MP; b = s >> 2; t = s & 3; kind = 1; ridx = TP + t; }
    else { kind = 2; b = 0; t = 0; ridx = 0; }
}
__device__ __forceinline__ int crow_to_urow(int crow) { return crow < NBATCH * SEQ ? crow + NMETA * ((crow >> 12) + 1) : MP + (crow - NBATCH * SEQ); }

struct EpiInProj {
    static constexpr bool PERM = true, AFTER_DRAIN = false;
    bf16_t *QA, *KV, *QKVB, *Z, *G; const float *COS, *SIN; float* out;
    __device__ __forceinline__ void operator()(const f32x4 (&acc)[2][2][4][2], const Unit& u, int wr, int wc, int fr, int fq) const {
        const int pn = u.pn;
#pragma unroll
        for (int ai = 0; ai < 2; ++ai)
#pragma unroll
            for (int m = 0; m < 4; ++m) {
                const int row = u.pm * BM + ai * HALF + wr * 64 + m * 16 + fr;
                int kind, b, t, ridx; urow_info(row, kind, b, t, ridx);
#pragma unroll
                for (int bj = 0; bj < 2; ++bj) {
                    const int cl = bj * HALF + wc * 32 + 8 * fq;
                    const f32x4 v0 = acc[ai][bj][m][0], v1 = acc[ai][bj][m][1];
                    if (pn < 2) {
                        const int c = pn * 256 + cl, d0 = ((c & 63) >> 3) * 4;
                        const f32x4 cs = *(const f32x4*)(COS + ridx * 32 + d0), sn = *(const f32x4*)(SIN + ridx * 32 + d0);
                        const f32x4 o1 = (v0 * cs - v1 * sn) * QSCALE, o2 = (v1 * cs + v0 * sn) * QSCALE;
                        *(u32x4*)(QA + (size_t)row * 512 + c) = pack8f(o1, o2);
                    } else if (pn == 2) {
                        if (bj == 0) {
                            const int kh = cl >> 6, d0 = ((cl & 63) >> 3) * 4;
                            const f32x4 cs = *(const f32x4*)(COS + ridx * 32 + d0), sn = *(const f32x4*)(SIN + ridx * 32 + d0);
                            const f32x4 o1 = v0 * cs - v1 * sn, o2 = v1 * cs + v0 * sn;
                            *(u32x4*)(KV + (size_t)row * 256 + cl) = pack8f(o1, o2);
                            float* dst = nullptr;
                            if (kind == 0 && t >= TP - 128) dst = out + O_KP + ((size_t)(b * 128 + (t - (TP - 128))) * 2 + kh) * 64;
                            else if (kind == 1) dst = out + O_KS + ((size_t)(b * 128 + 124 + t) * 2 + kh) * 64;
                            if (dst) { *(f32x4*)(dst + d0) = o1; *(f32x4*)(dst + 32 + d0) = o2; }
                        } else {
                            const int cv = cl - 128, kh = cv >> 6, dd = cv & 63;
                            *(u32x4*)(KV + (size_t)row * 256 + cl) = pack8f(v0, v1);
                            float* dst = nullptr;
                            if (kind == 0 && t >= TP - 128) dst = out + O_VP + ((size_t)(b * 128 + (t - (TP - 128))) * 2 + kh) * 64;
                            else if (kind == 1) dst = out + O_VS + ((size_t)(b * 128 + 124 + t) * 2 + kh) * 64;
                            if (dst) { *(f32x4*)(dst + dd) = v0; *(f32x4*)(dst + dd + 4) = v1; }
                        }
                    } else if (pn < 9) {
                        const int c = (pn - 3) * 256 + cl;
                        *(u32x4*)(QKVB + (size_t)row * 1536 + c) = pack8f(v0, v1);
                        float* dst = nullptr;
                        if (kind == 0 && t >= TP - 3) dst = out + O_CP + ((size_t)b * 3 + (t - (TP - 3))) * 1536;
                        else if (kind == 1 && t >= 1) dst = out + O_CS + ((size_t)b * 3 + (t - 1)) * 1536;
                        if (dst) { *(f32x4*)(dst + c) = v0; *(f32x4*)(dst + c + 4) = v1; }
                    } else if (pn < 11) {
                        const int c = (pn - 9) * 256 + cl;
                        *(u32x4*)(Z + (size_t)row * 512 + c) = pack8f(v0, v1);
                    } else {
                        const int c = (pn - 11) * 256 + cl;
                        f32x4 g0, g1;
#pragma unroll
                        for (int e = 0; e < 4; ++e) { g0[e] = sigmoidf_(v0[e]); g1[e] = sigmoidf_(v1[e]); }
                        *(u32x4*)(G + (size_t)row * 2048 + c) = pack8f(g0, g1);
                    }
                }
            }
    }
};

template <bool ACCUM> struct EpiMerge {
    static constexpr bool PERM = true, AFTER_DRAIN = false;
    bf16_t* MBp; const bf16_t* G; int gate_off;
    __device__ __forceinline__ void operator()(const f32x4 (&acc)[2][2][4][2], const Unit& u, int wr, int wc, int fr, int fq) const {
#pragma unroll
        for (int ai = 0; ai < 2; ++ai)
#pragma unroll
            for (int m = 0; m < 4; ++m) {
                const int crow = u.pm * BM + ai * HALF + wr * 64 + m * 16 + fr, urow = crow_to_urow(crow);
#pragma unroll
                for (int bj = 0; bj < 2; ++bj) {
                    const int c = u.pn * BM + bj * HALF + wc * 32 + 8 * fq;
                    const u32x4 gw = *(const u32x4*)(G + (size_t)urow * 2048 + gate_off + c);
                    f32x4 v0 = acc[ai][bj][m][0], v1 = acc[ai][bj][m][1];
                    v0[0] *= bflo(gw.x); v0[1] *= bfhi(gw.x); v0[2] *= bflo(gw.y); v0[3] *= bfhi(gw.y);
                    v1[0] *= bflo(gw.z); v1[1] *= bfhi(gw.z); v1[2] *= bflo(gw.w); v1[3] *= bfhi(gw.w);
                    bf16_t* p = MBp + (size_t)crow * 1024 + c;
                    if (ACCUM) { const u32x4 pw = *(const u32x4*)p;
                        v0[0] += bflo(pw.x); v0[1] += bfhi(pw.x); v0[2] += bflo(pw.y); v0[3] += bfhi(pw.y);
                        v1[0] += bflo(pw.z); v1[1] += bfhi(pw.z); v1[2] += bflo(pw.w); v1[3] += bfhi(pw.w); }
                    *(u32x4*)p = pack8f(v0, v1);
                }
            }
    }
};

template <bool ATOM = true> struct EpiWout {
    static constexpr bool PERM = true, AFTER_DRAIN = false;
    const float* xp; const float* xs; float* H; bf16_t* HB; float* SS;
    __device__ __forceinline__ void operator()(const f32x4 (&acc)[2][2][4][2], const Unit& u, int wr, int wc, int fr, int fq) const {
#pragma unroll
        for (int ai = 0; ai < 2; ++ai)
#pragma unroll
            for (int m = 0; m < 4; ++m) {
                const int crow = u.pm * BM + ai * HALF + wr * 64 + m * 16 + fr;
                const float* hs = crow < NBATCH * SEQ ? xp + (size_t)crow * D : xs + (size_t)(crow - NBATCH * SEQ) * D;
                float ss = 0.f;
#pragma unroll
                for (int bj = 0; bj < 2; ++bj) {
                    const int c = u.pn * BM + bj * HALF + wc * 32 + 8 * fq;
                    const f32x4 r0 = *(const f32x4*)(hs + c) + acc[ai][bj][m][0], r1 = *(const f32x4*)(hs + c + 4) + acc[ai][bj][m][1];
                    *(f32x4*)(H + (size_t)crow * D + c) = r0; *(f32x4*)(H + (size_t)crow * D + c + 4) = r1;
                    *(u32x4*)(HB + (size_t)crow * D + c) = pack8f(r0, r1);
                    ss += (r0[0] * r0[0] + r0[1] * r0[1]) + (r0[2] * r0[2] + r0[3] * r0[3]) + (r1[0] * r1[0] + r1[1] * r1[1]) + (r1[2] * r1[2] + r1[3] * r1[3]);
                }
                ss += __shfl_xor(ss, 16); ss += __shfl_xor(ss, 32);
                if (ATOM && fq == 0) atomicAdd(SS + crow, ss);
            }
    }
};

struct EpiGateUp {
    static constexpr bool PERM = true, AFTER_DRAIN = false;
    bf16_t* ACT; const float* SS;
    __device__ __forceinline__ void operator()(const f32x4 (&acc)[2][2][4][2], const Unit& u, int wr, int wc, int fr, int fq) const {
#pragma unroll
        for (int ai = 0; ai < 2; ++ai)
#pragma unroll
            for (int m = 0; m < 4; ++m) {
                const int crow = u.pm * BM + ai * HALF + wr * 64 + m * 16 + fr;
                const float rstd = rsqrtf(SS[crow] * (1.0f / D) + EPS);
                f32x4 a[2];
#pragma unroll
                for (int n = 0; n < 2; ++n)
#pragma unroll
                    for (int e = 0; e < 4; ++e) { const float g = acc[ai][0][m][n][e] * rstd, up = acc[ai][1][m][n][e] * rstd; a[n][e] = siluf_(g) * up; }
                *(u32x4*)(ACT + (size_t)crow * DFF + u.pn * HALF + wc * 32 + 8 * fq) = pack8f(a[0], a[1]);
            }
    }
};

template <bool DRY = false> struct EpiDown {
    static constexpr bool PERM = true, AFTER_DRAIN = false;
    float* H;
    __device__ __forceinline__ void operator()(const f32x4 (&acc)[2][2][4][2], const Unit& u, int wr, int wc, int fr, int fq) const {
#pragma unroll
        for (int ai = 0; ai < 2; ++ai)
#pragma unroll
            for (int m = 0; m < 4; ++m) {
                const int crow = u.pm * BM + ai * HALF + wr * 64 + m * 16 + fr;
#pragma unroll
                for (int bj = 0; bj < 2; ++bj) {
                    float* p = H + (size_t)crow * D + u.pn * BM + bj * HALF + wc * 32 + 8 * fq;
                    const f32x4 r0 = *(const f32x4*)p + acc[ai][bj][m][0] * (DRY ? 0.f : 1.f), r1 = *(const f32x4*)(p + 4) + acc[ai][bj][m][1] * (DRY ? 0.f : 1.f);
                    *(f32x4*)p = r0; *(f32x4*)(p + 4) = r1;
                }
            }
    }
};
template <class Epi, class Sched, bool ALIGN_EPI = false, bool SP2 = false>
__device__ __forceinline__ void gemm_phase(PG8_LAS unsigned char* lds, const Gemm g, const Sched& S, const Epi& E) {
    const int tid = threadIdx.x, wid = __builtin_amdgcn_readfirstlane(tid >> 6), lane = tid & 63, wr = wid >> 2, wc = wid & 3, fr = lane & 15, fq = lane >> 4;
    const int K = g.K, nt = K / BK;
    unsigned voffA[2], voffB[2];
#pragma unroll
    for (int i = 0; i < 2; ++i) { int R, C; stage_rc(tid * 16 + i * 8192, R, C); const int Rb = Epi::PERM ? ((R & ~31) + perm32(R & 31)) : R;
        voffA[i] = (unsigned)(R * K + C) * 2u; voffB[i] = (unsigned)(Rb * K + C) * 2u; }
    const size_t kstep = (size_t)(BK * 2);
    const size_t hstep = (size_t)HALF * K * 2;
    const size_t tstep = 2 * hstep;
    const unsigned ldsw = (unsigned)wid * 1024u;
    const int aoff = lds_byte(wr * 64 + fr, fq * 8), boff = lds_byte(wc * 32 + fr, fq * 8);
#define PG8_SA(b, h) (((b) * 2 + (h)) * HTB)
#define PG8_SB(b, h) ((4 + (b) * 2 + (h)) * HTB)
#define PG8_STAGE(bufoff, gbase, voff) do { _Pragma("unroll") for (int _i = 0; _i < 2; ++_i) \
        __builtin_amdgcn_global_load_lds((const unsigned*)((const char*)(gbase) + (voff)[_i]), (PG8_LAS unsigned*)(lds + (bufoff) + ldsw + _i * 8192), 16, 0, 0); } while (0)
#define PG8_LDA(dst, b, h) do { _Pragma("unroll") for (int m = 0; m < 4; ++m) _Pragma("unroll") for (int k = 0; k < 2; ++k) dst[m][k] = *(const PG8_LAS bf16x8*)(lds + PG8_SA(b, h) + aoff + m * 2048 + k * 1024); } while (0)
#define PG8_LDB(dst, b, h) do { _Pragma("unroll") for (int n = 0; n < 2; ++n) _Pragma("unroll") for (int k = 0; k < 2; ++k) dst[n][k] = *(const PG8_LAS bf16x8*)(lds + PG8_SB(b, h) + boff + n * 2048 + k * 1024); } while (0)
#define PG8_MMA(ai, bj, At, Bt) do { __builtin_amdgcn_s_setprio(1); _Pragma("unroll") for (int m = 0; m < 4; ++m) _Pragma("unroll") for (int n = 0; n < 2; ++n) _Pragma("unroll") for (int k = 0; k < 2; ++k) \
        acc[ai][bj][m][n] = __builtin_amdgcn_mfma_f32_16x16x32_bf16(Bt[n][k], At[m][k], acc[ai][bj][m][n], 0, 0, 0); __builtin_amdgcn_s_setprio(0); } while (0)
#define PG8_WAIT_V(n) asm volatile("s_waitcnt vmcnt(" #n ")" ::: "memory")
#define PG8_WAIT_L(n) asm volatile("s_waitcnt lgkmcnt(" #n ")" ::: "memory")
#define PG8_BAR __builtin_amdgcn_s_barrier()
#define PG8_SCHED __builtin_amdgcn_sched_barrier(0)
    Unit cur, nxt; int ui = 0;
    if (!S.next(0, cur)) return;
    f32x4 acc[2][2][4][2];
#pragma unroll
    for (int a = 0; a < 2; ++a)
#pragma unroll
        for (int b = 0; b < 2; ++b)
#pragma unroll
            for (int m = 0; m < 4; ++m)
#pragma unroll
                for (int n = 0; n < 2; ++n) acc[a][b][m][n] = (f32x4){0.f, 0.f, 0.f, 0.f};
    bf16x8 At[4][2], B0[2][2], B1[2][2];
    const char* cA = (const char*)g.A + (size_t)cur.pm * tstep; const char* cB = (const char*)g.Bt + (size_t)cur.pn * tstep;
    S.a_ready(cur);
    if constexpr (SP2) {
        PG8_STAGE(PG8_SB(0, 0), cB, voffB); PG8_STAGE(PG8_SB(0, 1), cB + hstep, voffB); PG8_STAGE(PG8_SA(0, 0), cA, voffA); PG8_STAGE(PG8_SA(0, 1), cA + hstep, voffA);
        if (wr == 1) PG8_BAR;
        PG8_WAIT_V(2); PG8_BAR;
        PG8_STAGE(PG8_SB(1, 0), cB + kstep, voffB); PG8_STAGE(PG8_SA(1, 0), cA + kstep, voffA); PG8_STAGE(PG8_SB(1, 1), cB + hstep + kstep, voffB);
        PG8_WAIT_V(6); PG8_BAR;
    } else {
        PG8_STAGE(PG8_SB(0, 0), cB, voffB); PG8_STAGE(PG8_SA(0, 0), cA, voffA); PG8_STAGE(PG8_SB(0, 1), cB + hstep, voffB); PG8_STAGE(PG8_SA(0, 1), cA + hstep, voffA);
        if (wr == 1) PG8_BAR;
        PG8_WAIT_V(4); PG8_BAR;
        PG8_STAGE(PG8_SB(1, 0), cB + kstep, voffB); PG8_STAGE(PG8_SA(1, 0), cA + kstep, voffA); PG8_STAGE(PG8_SB(1, 1), cB + hstep + kstep, voffB);
        PG8_WAIT_V(6); PG8_BAR;
    }
    for (;;) {
        const bool has_next = S.next(ui + 1, nxt);
        const char* nA = has_next ? (const char*)g.A + (size_t)nxt.pm * tstep : cA; const char* nB = has_next ? (const char*)g.Bt + (size_t)nxt.pn * tstep : cB;
        for (int t = 0; t < nt; t += 2) {
            const bool last = (t == nt - 2);
            const char* a1 = cA + (size_t)(t + 1) * kstep;
            const char* a2 = last ? nA : cA + (size_t)(t + 2) * kstep; const char* b2 = last ? nB : cB + (size_t)(t + 2) * kstep;
            const char* a3 = a2 + kstep; const char* b3 = b2 + kstep;
            if (last && has_next) S.a_ready(nxt);
            if constexpr (SP2) {
            PG8_LDB(B0, 0, 0); PG8_LDB(B1, 0, 1); PG8_SCHED; PG8_LDA(At, 0, 0); PG8_STAGE(PG8_SA(1, 1), a1 + hstep, voffA);
            PG8_WAIT_V(8); PG8_WAIT_L(0); PG8_BAR; PG8_MMA(0, 0, At, B0); PG8_MMA(0, 1, At, B1); PG8_BAR; PG8_SCHED;
            PG8_LDA(At, 0, 1); PG8_STAGE(PG8_SB(0, 0), b2, voffB); PG8_STAGE(PG8_SB(0, 1), b2 + hstep, voffB); PG8_STAGE(PG8_SA(0, 0), a2, voffA);
            PG8_WAIT_V(8); PG8_WAIT_L(0); PG8_BAR; PG8_MMA(1, 0, At, B0); PG8_MMA(1, 1, At, B1); PG8_BAR; PG8_SCHED;
            PG8_LDB(B0, 1, 0); PG8_LDB(B1, 1, 1); PG8_SCHED; PG8_LDA(At, 1, 0); PG8_STAGE(PG8_SA(0, 1), a2 + hstep, voffA);
            PG8_WAIT_V(8); PG8_WAIT_L(0); PG8_BAR; PG8_MMA(0, 0, At, B0); PG8_MMA(0, 1, At, B1); PG8_BAR; PG8_SCHED;
            PG8_LDA(At, 1, 1); PG8_STAGE(PG8_SB(1, 0), b3, voffB); PG8_STAGE(PG8_SB(1, 1), b3 + hstep, voffB); PG8_STAGE(PG8_SA(1, 0), a3, voffA);
            PG8_WAIT_V(8); PG8_WAIT_L(0); PG8_BAR; PG8_MMA(1, 0, At, B0); PG8_MMA(1, 1, At, B1); PG8_BAR; PG8_SCHED;
            } else {
            PG8_LDB(B0, 0, 0); PG8_SCHED; PG8_LDA(At, 0, 0); PG8_STAGE(PG8_SA(1, 1), a1 + hstep, voffA);
            PG8_WAIT_L(8); PG8_BAR; PG8_WAIT_L(0); PG8_MMA(0, 0, At, B0); PG8_BAR; PG8_SCHED;
            PG8_LDB(B1, 0, 1); PG8_STAGE(PG8_SB(0, 0), b2, voffB);
            PG8_BAR; PG8_WAIT_L(0); PG8_MMA(0, 1, At, B1); PG8_BAR;
            PG8_LDA(At, 0, 1); PG8_STAGE(PG8_SA(0, 0), a2, voffA);
            PG8_BAR; PG8_WAIT_L(0); PG8_MMA(1, 0, At, B0); PG8_BAR; PG8_SCHED;
            PG8_STAGE(PG8_SB(0, 1), b2 + hstep, voffB);
            PG8_WAIT_V(6); PG8_BAR; PG8_MMA(1, 1, At, B1); PG8_BAR;
            PG8_LDB(B0, 1, 0); PG8_SCHED; PG8_LDA(At, 1, 0); PG8_STAGE(PG8_SA(0, 1), a2 + hstep, voffA);
            PG8_WAIT_L(8); PG8_BAR; PG8_WAIT_L(0); PG8_MMA(0, 0, At, B0); PG8_BAR; PG8_SCHED;
            PG8_LDB(B1, 1, 1); PG8_STAGE(PG8_SB(1, 0), b3, voffB);
            PG8_BAR; PG8_WAIT_L(0); PG8_MMA(0, 1, At, B1); PG8_BAR;
            PG8_LDA(At, 1, 1); PG8_STAGE(PG8_SA(1, 0), a3, voffA);
            PG8_BAR; PG8_WAIT_L(0); PG8_MMA(1, 0, At, B0); PG8_BAR; PG8_SCHED;
            PG8_STAGE(PG8_SB(1, 1), b3 + hstep, voffB);
            PG8_WAIT_V(6); PG8_BAR; PG8_MMA(1, 1, At, B1); PG8_BAR;
            }
        }
        if constexpr (ALIGN_EPI) { if (wr == 0) PG8_BAR; }
        if constexpr (!Epi::AFTER_DRAIN) { E(acc, cur, wr, wc, fr, fq); S.done(cur); }
        if (!has_next) break;
#pragma unroll
        for (int a = 0; a < 2; ++a)
#pragma unroll
            for (int b = 0; b < 2; ++b)
#pragma unroll
                for (int m = 0; m < 4; ++m)
#pragma unroll
                    for (int n = 0; n < 2; ++n) acc[a][b][m][n] = (f32x4){0.f, 0.f, 0.f, 0.f};
        cur = nxt; cA = nA; cB = nB; ++ui;
        if constexpr (ALIGN_EPI) { if (wr == 1) PG8_BAR; }
    }
    PG8_WAIT_V(0);
    if constexpr (!ALIGN_EPI) { if (wr == 0) PG8_BAR; }
    PG8_BAR;
    if constexpr (Epi::AFTER_DRAIN) { E.fused(acc, cur, wr, wc, fr, fq, lds, wid, lane); S.done(cur); }
#undef PG8_SA
#undef PG8_SB
#undef PG8_STAGE
#undef PG8_LDA
#undef PG8_LDB
#undef PG8_MMA
#undef PG8_WAIT_V
#undef PG8_WAIT_L
#undef PG8_BAR
#undef PG8_SCHED
}
}
constexpr int NWAVES = 8, NTHREADS = NWAVES * 64;
constexpr int LDS_BYTES = 147456;
constexpr int LDS_MISC = 131072;
constexpr int N_PHASES = 10;

struct Args {
    const float *x_prompt, *x_sample, *cache_k, *cache_v, *state_delta, *state_conv, *meta, *norm_mix, *w_in, *conv_w, *a_log, *dt_bias, *sinks, *gdn_norm,
                *w_oa, *w_ob, *w_out, *norm_ffn, *w_gate, *w_up, *w_down, *norm_final;
    float* out; unsigned char* ws; int ph_lo, ph_hi;
};

typedef const __attribute__((address_space(4))) Args* KA;
DI KA kargs() { KA p = (KA)__builtin_amdgcn_kernarg_segment_ptr(); asm volatile("" : "+s"(p)); return p; }
#define RLX_AGENT __ATOMIC_RELAXED, __HIP_MEMORY_SCOPE_AGENT
#define LDS_WAIT() asm volatile("s_waitcnt lgkmcnt(0)" ::: "memory")
#define MFMA32(a, b, c) __builtin_amdgcn_mfma_f32_32x32x16_bf16((a), (b), (c), 0, 0, 0)
DI int crow16(int reg, int h) { return (reg & 3) + 8 * (reg >> 2) + 4 * h; }
DI float wave_sum(float v) {
#pragma unroll
    for (int o = 1; o < 64; o <<= 1) v += __shfl_xor(v, o);
    return v;
}
DI float wave_max(float v) {
#pragma unroll
    for (int o = 1; o < 64; o <<= 1) v = fmaxf(v, __shfl_xor(v, o));
    return v;
}
template <int S> DI bf16x8 pack_step(const f32x16& x) {
    u32x4 p; p.x = cvtpk(x[8 * S], x[8 * S + 1]); p.y = cvtpk(x[8 * S + 2], x[8 * S + 3]); p.z = cvtpk(x[8 * S + 4], x[8 * S + 5]); p.w = cvtpk(x[8 * S + 6], x[8 * S + 7]);
    return __builtin_bit_cast(bf16x8, p);
}
DI int frag_idx(int row, int k, int NKS) { const int kkk = k & 15; return (((row >> 5) * NKS + (k >> 4)) * 64 + (row & 31) + 32 * ((kkk >> 2) & 1)) * 8 + (((kkk >> 3) << 2) | (kkk & 3)); }
DI unsigned char* slot_ptr(KA A, int item) { return item < PREP_N1 ? A->ws + WS_B + (size_t)item * PREP_SLOT : (unsigned char*)A->out + (size_t)(item - PREP_N1) * PREP_SLOT; }

#define XB_TMO      128
#define XB_XCNT(j)  (256  + 64 * (j))
#define XB_XSUB(j)  (1280 + 64 * (j))
#define XB_XGEN(j)  (2304 + 64 * (j))
#define XB_TOP      3328
#define XB_TOPGEN   3392
#define XCD_BAR_WORDS 3456
#define XB_SPIN_CAP (1u << 20)
DI unsigned xb_ld(unsigned* p)              { return __hip_atomic_load(p, __ATOMIC_RELAXED, __HIP_MEMORY_SCOPE_AGENT); }
DI unsigned xb_add(unsigned* p, unsigned v) { return __hip_atomic_fetch_add(p, v, __ATOMIC_RELAXED, __HIP_MEMORY_SCOPE_AGENT); }
DI unsigned xb_xcc_id() { return (unsigned)__builtin_amdgcn_s_getreg((3 << 11) | 20) & 0xFu; }
#define XB_SPIN(cond, bar) do { unsigned _sp = 0; while (cond) { __builtin_amdgcn_s_sleep(1); \
    if ((++_sp & 255u) == 0u) { if (xb_ld(&(bar)[XB_TMO])) break; if (_sp > XB_SPIN_CAP) { atomicAdd(&(bar)[XB_TMO], 1u); break; } } } } while (0)
struct XcdBarrier { unsigned* bar; unsigned x; volatile LAS unsigned* st; };
DI XcdBarrier xcd_barrier_post(unsigned* bar, volatile LAS unsigned* st) {
    XcdBarrier b; b.bar = bar; b.x = xb_xcc_id(); b.st = st;
    if (threadIdx.x == 0) (void)xb_add(&bar[XB_XCNT(b.x)], 1u);
    return b;
}
DI void xcd_barrier_complete(unsigned* bar, unsigned x, unsigned& nloc, unsigned& nx) {
    const unsigned G = gridDim.x * gridDim.y * gridDim.z;
    unsigned sum, cnt, mine, sp = 0u;
    for (;;) {
        sum = 0u; cnt = 0u; mine = 0u;
#pragma unroll
        for (unsigned j = 0; j < 16; ++j) { const unsigned c = xb_ld(&bar[XB_XCNT(j)]); sum += c; cnt += (c > 0u) ? 1u : 0u; mine = (j == x) ? c : mine; }
        if (sum == G) break;
        __builtin_amdgcn_s_sleep(1);
        if ((++sp & 255u) == 0u) { if (xb_ld(&bar[XB_TMO])) break; if (sp > XB_SPIN_CAP) { atomicAdd(&bar[XB_TMO], 1u); break; } }
    }
    nloc = mine > 0u ? mine : 1u; nx = cnt > 0u ? cnt : 1u;
}
DI void xcd_barrier(const XcdBarrier& b) {
    asm volatile("s_waitcnt vmcnt(0)" ::: "memory");
    __syncthreads();
    if (threadIdx.x == 0) {
        unsigned* bar = b.bar;
        __builtin_amdgcn_s_waitcnt(0);
        unsigned nloc = b.st[0], nx = b.st[1];
        if (nloc == 0u) { xcd_barrier_complete(bar, b.x, nloc, nx); b.st[0] = nloc; b.st[1] = nx; }
        const unsigned old = xb_add(&bar[XB_XSUB(b.x)], 1u);
        const unsigned gen = old / nloc;
        if (old + 1u == (gen + 1u) * nloc) {
            __builtin_amdgcn_fence(__ATOMIC_RELEASE, "agent");
            asm volatile("s_waitcnt vmcnt(0)" ::: "memory");
            const unsigned og = xb_add(&bar[XB_TOP], 1u);
            const unsigned tg = og / nx;
            if (og + 1u == (tg + 1u) * nx) xb_add(&bar[XB_TOPGEN], 1u);
            else XB_SPIN(xb_ld(&bar[XB_TOPGEN]) == tg, bar);
            __builtin_amdgcn_fence(__ATOMIC_ACQUIRE, "agent");
            xb_add(&bar[XB_XGEN(b.x)], 1u);
            asm volatile("s_waitcnt vmcnt(0)" ::: "memory");
        } else {
            XB_SPIN(xb_ld(&bar[XB_XGEN(b.x)]) == gen, bar);
            __builtin_amdgcn_fence(__ATOMIC_ACQUIRE, "agent");
            asm volatile("s_waitcnt vmcnt(0)" ::: "memory");
        }
    }
    __syncthreads();
}

template <class RowMap> DI void transpose_item(const float* W, int K, int N, bf16* WT, RowMap rm, const float* kscale, LAS float* scr, int item, int lane) {
    const int nblk = (N + 31) / 32, kb = item / nblk, nb = item - kb * nblk, k0 = 64 * kb, n0 = 32 * nb;
    const int ncol = n0 + (lane & 31);
#pragma unroll 8
    for (int i = 0; i < 32; ++i) { const int kk = 2 * i + (lane >> 5);
        float v = ncol < N ? W[(size_t)(k0 + kk) * N + ncol] : 0.f;
        if (kscale) v *= kscale[k0 + kk];
        scr[kk * 33 + (lane & 31)] = v; }
    LDS_WAIT(); asm volatile("" ::: "memory");
    const int c = lane & 7;
#pragma unroll
    for (int j = 0; j < 4; ++j) { const int n = (lane >> 3) + 8 * j; const LAS float* s = scr + (8 * c) * 33 + n;
        const int nsrc = n0 + n; const int drow = nsrc < N ? rm(nsrc) : -1;
        u32x4 o; o.x = cvtpk(s[0 * 33], s[1 * 33]); o.y = cvtpk(s[2 * 33], s[3 * 33]); o.z = cvtpk(s[4 * 33], s[5 * 33]); o.w = cvtpk(s[6 * 33], s[7 * 33]);
        if (drow >= 0) *(u32x4*)(WT + (size_t)drow * K + k0 + 8 * c) = o; }
    LDS_WAIT(); asm volatile("" ::: "memory");
}
DI float softplusf_(float x) { return x > 20.f ? x : log1pf(__expf(x)); }

#ifndef PROBE_REP
#define PROBE_REP -1
#endif
DI void p0_prologue(KA A, LAS unsigned char* lds) {
    const int tid = threadIdx.x, lane = tid & 63, wave = __builtin_amdgcn_readfirstlane(tid >> 6);
    const int G = gridDim.x, gw = blockIdx.x * NWAVES + wave, NGW = G * NWAVES;
    const int gt = blockIdx.x * NTHREADS + tid, NGT = G * NTHREADS;
    unsigned char* ws = A->ws;
    for (int rep = 0; rep < (PROBE_REP == 1001 ? 2 : 1); ++rep) {
        LAS float* scr = (LAS float*)(lds + wave * 16384);
        constexpr int I_IN = 16 * 153, I_OA = 8 * 32, I_OUT = 16 * 32, I_G = 16 * 88, I_D = 44 * 32;
        constexpr int NIT = I_IN + 2 * I_OA + I_OUT + 2 * I_G + I_D;
        for (int it = gw; it < NIT; it += NGW) {
            int r = it;
            if (r < I_IN) { transpose_item(A->w_in, 1024, NIN_SRC, (bf16*)(ws + WS_WIN), [](int c) -> int {
                    if (c < 640) return (c & ~63) + pos_of_d(c & 63);
                    if (c < 2816) return c;
                    if (c < 2824) return -1;
                    return c - 8; }, nullptr, scr, r, lane); continue; } r -= I_IN;
            if (r < I_OA) { transpose_item(A->w_oa, 512, 1024, (bf16*)(ws + WS_WOA), [](int c) -> int { return c; }, nullptr, scr, r, lane); continue; } r -= I_OA;
            if (r < I_OA) { transpose_item(A->w_ob, 512, 1024, (bf16*)(ws + WS_WOB), [](int c) -> int { return c; }, nullptr, scr, r, lane); continue; } r -= I_OA;
            if (r < I_OUT) { transpose_item(A->w_out, 1024, 1024, (bf16*)(ws + WS_WOUT), [](int c) -> int { return c; }, nullptr, scr, r, lane); continue; } r -= I_OUT;
            if (r < I_G) { transpose_item(A->w_gate, 1024, DFF, (bf16*)(ws + WS_WGU), [](int c) -> int { return 256 * (c >> 7) + (c & 127); }, A->norm_ffn, scr, r, lane); continue; } r -= I_G;
            if (r < I_G) { transpose_item(A->w_up, 1024, DFF, (bf16*)(ws + WS_WGU), [](int c) -> int { return 256 * (c >> 7) + 128 + (c & 127); }, A->norm_ffn, scr, r, lane); continue; } r -= I_G;
            transpose_item(A->w_down, DFF, 1024, (bf16*)(ws + WS_WD), [](int c) -> int { return c; }, nullptr, scr, r, lane);
        }
    }
    for (int rep = 0; rep < (PROBE_REP == 1002 ? 2 : 1); ++rep) {
        float* COS = (float*)(ws + WS_ROPE); float* SIN = COS + (TP + TS) * 32;
        for (int i = gt; i < (TP + TS) * 32; i += NGT) { const int ri = i >> 5, f = i & 31; const double pos = ri < TP ? (double)ri : (double)(PAST + ri - TP);
            const double inv = exp2(-(double)f * (13.287712379549449 / 32.0)), ang = pos * inv; COS[i] = (float)cos(ang); SIN[i] = (float)sin(ang); }
        float* SS1 = (float*)(ws + WS_SS1);
        for (int i = gt; i < MC; i += NGT) SS1[i] = 0.f;
        constexpr int PERB = 124 * 128 / 4;
        for (int i = gt; i < SBATCH * PERB; i += NGT) { const int b = i / PERB, o = i - b * PERB;
            ((f32x4*)(A->out + O_KS))[(size_t)b * 4096 + o] = ((const f32x4*)A->cache_k)[(size_t)b * 4096 + 128 + o];
            ((f32x4*)(A->out + O_VS))[(size_t)b * 4096 + o] = ((const f32x4*)A->cache_v)[(size_t)b * 4096 + 128 + o]; }
    }
    for (int rep = 0; rep < (PROBE_REP == 1003 ? 2 : 1); ++rep) {
        unsigned wab[16][4];
        f32x4 nm[4];
#pragma unroll
        for (int j = 0; j < 4; ++j) {
            nm[j] = ((const f32x4*)A->norm_mix)[lane + 64 * j];
#pragma unroll
            for (int e = 0; e < 4; ++e) { const float* p = A->w_in + (size_t)(4 * (lane + 64 * j) + e) * NIN_SRC + 2816;
                const f32x4 a = *(const f32x4*)p, b = *(const f32x4*)(p + 4);
                wab[j * 4 + e][0] = cvtpk(a[0], a[1]); wab[j * 4 + e][1] = cvtpk(a[2], a[3]); wab[j * 4 + e][2] = cvtpk(b[0], b[1]); wab[j * 4 + e][3] = cvtpk(b[2], b[3]); }
        }
        bf16* XN = (bf16*)(ws + WS_XN); f32x2* GB = (f32x2*)(ws + WS_GB);
        for (int urow = gw; urow < MUP; urow += NGW) {
            const float* src = nullptr;
            if (urow < MP) { const int b = urow / TP, t = urow - b * TP; src = t < NMETA ? A->meta + (size_t)t * D : A->x_prompt + ((size_t)b * SEQ + (t - NMETA)) * D; }
            else if (urow < MU) src = A->x_sample + (size_t)(urow - MP) * D;
            u32x2* o8 = (u32x2*)(XN + (size_t)urow * D) + lane;
            if (!src) {
#pragma unroll
                for (int j = 0; j < 4; ++j) o8[64 * j] = (u32x2){0u, 0u};
                if (lane < 4) GB[(size_t)urow * 4 + lane] = (f32x2){0.f, 0.f};
                continue; }
            f32x4 v[4]; float ss = 0.f;
#pragma unroll
            for (int j = 0; j < 4; ++j) { v[j] = ((const f32x4*)src)[lane + 64 * j]; ss += (v[j][0] * v[j][0] + v[j][1] * v[j][1]) + (v[j][2] * v[j][2] + v[j][3] * v[j][3]); }
            const float rstd = rsqrtf(wave_sum(ss) * (1.0f / D) + EPS);
            float dot[8];
#pragma unroll
            for (int c = 0; c < 8; ++c) dot[c] = 0.f;
#pragma unroll
            for (int j = 0; j < 4; ++j) { v[j] = v[j] * rstd * nm[j];
                o8[64 * j] = (u32x2){cvtpk(v[j][0], v[j][1]), cvtpk(v[j][2], v[j][3])};
#pragma unroll
                for (int e = 0; e < 4; ++e)
#pragma unroll
                    for (int c = 0; c < 4; ++c) { dot[2 * c] += v[j][e] * bflo(wab[j * 4 + e][c]); dot[2 * c + 1] += v[j][e] * bfhi(wab[j * 4 + e][c]); } }
#pragma unroll
            for (int c = 0; c < 8; ++c) dot[c] = wave_sum(dot[c]);
            if (lane < 4) {
                const float a = lane == 0 ? dot[0] : lane == 1 ? dot[1] : lane == 2 ? dot[2] : dot[3];
                const float bb = lane == 0 ? dot[4] : lane == 1 ? dot[5] : lane == 2 ? dot[6] : dot[7];
                const float g = -__expf(A->a_log[lane]) * softplusf_(a + A->dt_bias[lane]);
                GB[(size_t)urow * 4 + lane] = (f32x2){g, sigmoidf_(bb)};
            }
        }
    }
}
DI void item_decode(int item, int& b, int& h, bool& sample, int& t0, int& L) {
    if (item < N_ITEMS_P) { const int s = item / CHUNKS_P, c = item - s * CHUNKS_P; b = s >> 2; h = s & 3; sample = false; if (c == 0) { t0 = 0; L = NMETA; } else { t0 = NMETA + 64 * (c - 1); L = 64; } }
    else { const int s = item - N_ITEMS_P; b = s >> 2; h = s & 3; sample = true; t0 = 0; L = TS; }
}
#define LDS_BARRIER() do { asm volatile("s_waitcnt lgkmcnt(0)" ::: "memory"); __builtin_amdgcn_s_barrier(); asm volatile("" ::: "memory"); } while (0)
constexpr int PITCH = 132;
DI bf16x8 frag_nat(const LAS float* src, int row, int k0) {
    const f32x4 lo = *(const LAS f32x4*)(src + row * PITCH + k0), hi = *(const LAS f32x4*)(src + row * PITCH + k0 + 4);
    return __builtin_bit_cast(bf16x8, pack8f(lo, hi));
}
struct S1Pre { u32x4 xr[11]; f32x4 w[4][2]; f32x2 gb; };
DI void stage1_issue(KA A, int item, S1Pre& P) {
    const int tid = threadIdx.x, lane = tid & 63, wave = __builtin_amdgcn_readfirstlane(tid >> 6);
    int b, h, t0, L; bool sample; item_decode(item, b, h, sample, t0, L);
    const bf16* QKVB = (const bf16*)(A->ws + WS_QKVB);
    const int cv = lane < 48 ? lane : 47, grp = cv >> 4, col0 = (cv & 15) * 8, r0 = wave * 8, cidx = grp * 512 + h * 128 + col0;
#pragma unroll
    for (int q = 0; q < 11; ++q) {
        const int i = r0 - 3 + q;
        long urow = sample ? (long)MP + b * TS + i : (long)b * TP + t0 + i;
        const bool ok = sample ? i >= 0 : t0 + i >= 0;
        if (!ok) urow = 0;
        P.xr[q] = *(const u32x4*)(QKVB + (size_t)urow * CONVD + cidx);
        if (!ok) P.xr[q] = (u32x4){0u, 0u, 0u, 0u};
    }
#pragma unroll
    for (int i = 0; i < 4; ++i) { P.w[i][0] = *(const f32x4*)(A->conv_w + i * CONVD + cidx); P.w[i][1] = *(const f32x4*)(A->conv_w + i * CONVD + cidx + 4); }
    P.gb = (f32x2){0.f, 0.f};
    if (wave == 7 && lane < L) { const int urow = sample ? MP + b * TS + lane : b * TP + t0 + lane; P.gb = ((const f32x2*)(A->ws + WS_GB))[(size_t)urow * 4 + h]; }
}
DI void prep_stage1(KA A, int item, int next_item, S1Pre& P, LAS unsigned char* ldsb) {
    const int tid = threadIdx.x, lane = tid & 63, wave = __builtin_amdgcn_readfirstlane(tid >> 6), r = lane & 31, hh = lane >> 5;
    int b, h, t0, L; bool sample; item_decode(item, b, h, sample, t0, L);
    LAS float* Qs = (LAS float*)ldsb; LAS float* Ks = Qs + 64 * PITCH; LAS float* Vs = Ks + 64 * PITCH; LAS float* gcs = Vs + 64 * PITCH; LAS float* betas = gcs + 64;
    unsigned char* slot = slot_ptr(A, item);
    {
        const int cv = lane < 48 ? lane : 47, grp = cv >> 4, col0 = (cv & 15) * 8, r0 = wave * 8, cidx = grp * 512 + h * 128 + col0;
        float xf[3][8];
#pragma unroll
        for (int q = 0; q < 3; ++q) { xf[q][0] = bflo(P.xr[q].x); xf[q][1] = bfhi(P.xr[q].x); xf[q][2] = bflo(P.xr[q].y); xf[q][3] = bfhi(P.xr[q].y);
                                      xf[q][4] = bflo(P.xr[q].z); xf[q][5] = bfhi(P.xr[q].z); xf[q][6] = bflo(P.xr[q].w); xf[q][7] = bfhi(P.xr[q].w); }
        if (sample && wave == 0) {
#pragma unroll
            for (int q = 0; q < 3; ++q) { const float* sp = A->state_conv + ((size_t)b * 3 + q) * CONVD + cidx; const f32x4 s0 = *(const f32x4*)sp, s1 = *(const f32x4*)(sp + 4);
                xf[q][0] = s0[0]; xf[q][1] = s0[1]; xf[q][2] = s0[2]; xf[q][3] = s0[3]; xf[q][4] = s1[0]; xf[q][5] = s1[1]; xf[q][6] = s1[2]; xf[q][7] = s1[3]; }
        }
        float w[4][8];
#pragma unroll
        for (int i = 0; i < 4; ++i) { w[i][0] = P.w[i][0][0]; w[i][1] = P.w[i][0][1]; w[i][2] = P.w[i][0][2]; w[i][3] = P.w[i][0][3]; w[i][4] = P.w[i][1][0]; w[i][5] = P.w[i][1][1]; w[i][6] = P.w[i][1][2]; w[i][7] = P.w[i][1][3]; }
        LAS float* dst = Qs + grp * 64 * PITCH + col0;
        const float nsc = grp == 0 ? 0.08838834764831845f : 1.0f;
#pragma unroll
        for (int q = 3; q < 11; ++q) {
            const int rr = r0 + q - 3;
            float x[8] = {bflo(P.xr[q].x), bfhi(P.xr[q].x), bflo(P.xr[q].y), bfhi(P.xr[q].y), bflo(P.xr[q].z), bfhi(P.xr[q].z), bflo(P.xr[q].w), bfhi(P.xr[q].w)};
            float v[8]; float ss = 0.f;
#pragma unroll
            for (int e = 0; e < 8; ++e) { const float y = w[0][e] * xf[0][e] + w[1][e] * xf[1][e] + w[2][e] * xf[2][e] + w[3][e] * x[e];
                v[e] = rr < L ? siluf_(y) : 0.f; ss += v[e] * v[e];
                xf[0][e] = xf[1][e]; xf[1][e] = xf[2][e]; xf[2][e] = x[e]; }
            ss += __shfl_xor(ss, 1); ss += __shfl_xor(ss, 2); ss += __shfl_xor(ss, 4); ss += __shfl_xor(ss, 8);
            const float sc = grp == 2 ? 1.0f : rsqrtf(ss + EPS) * nsc;
            if (lane < 48) { *(LAS f32x4*)(dst + rr * PITCH) = (f32x4){v[0] * sc, v[1] * sc, v[2] * sc, v[3] * sc}; *(LAS f32x4*)(dst + rr * PITCH + 4) = (f32x4){v[4] * sc, v[5] * sc, v[6] * sc, v[7] * sc}; }
        }
    }
    if (wave == 7) {
        float gc = P.gb[0];
#pragma unroll
        for (int o = 1; o < 64; o <<= 1) { const float t = __shfl_up(gc, o); if (lane >= o) gc += t; }
        gcs[lane] = gc; betas[lane] = P.gb[1];
        if (lane == 63) ((float*)(A->ws + WS_SC))[item] = __expf(gc);
    }
    if (next_item < N_ITEMS) stage1_issue(A, next_item, P);
    LDS_BARRIER();
    if (wave < 6) {
        const bool isqk = wave >= 3; const int tsel = isqk ? wave - 3 : wave, ib = tsel == 0 ? 0 : 1, jb = tsel == 2 ? 1 : 0;
        const LAS float* Asrc = isqk ? Qs : Ks;
        f32x16 acc;
#pragma unroll
        for (int e = 0; e < 16; ++e) acc[e] = 0.f;
#pragma unroll
        for (int s = 0; s < 8; ++s) acc = MFMA32(frag_nat(Asrc, 32 * ib + r, 16 * s + 8 * hh), frag_nat(Ks, 32 * jb + r, 16 * s + 8 * hh), acc);
        const int j = 32 * jb + r; const float gcj = gcs[j];
        float* Aout = (float*)(slot + SL_A); bf16* QKD = (bf16*)(slot + SL_QKD);
        if (!isqk) {
#pragma unroll
            for (int g4 = 0; g4 < 4; ++g4) { f32x4 v;
#pragma unroll
                for (int e = 0; e < 4; ++e) { const int i = 32 * ib + 8 * g4 + 4 * hh + e; v[e] = i > j ? betas[i] * __expf(fminf(gcs[i] - gcj, 0.f)) * acc[4 * g4 + e] : 0.f; }
                *(f32x4*)(Aout + j * 64 + 32 * ib + 8 * g4 + 4 * hh) = v; }
        } else {
#pragma unroll
            for (int reg = 0; reg < 16; ++reg) { const int i = 32 * ib + crow16(reg, hh); const float dec = __expf(fminf(gcs[i] - gcj, 0.f));
                QKD[frag_idx(i, j, 4)] = f2bf(i >= j ? dec * acc[reg] : 0.f); }
        }
    }
    const float gcl = gcs[63];
#pragma unroll 1
    for (int job = wave; job < 56; job += 8) {
        if (job < 32) {
            const bool isq = job >= 16; const int jj = job & 15, rb = jj >> 3, ks = jj & 7, row = 32 * rb + r, k0 = 16 * ks + 4 * hh;
            const LAS float* src = isq ? Qs : Ks; const float sc = isq ? __expf(gcs[row]) : betas[row] * __expf(gcs[row]);
            const f32x4 lo = *(const LAS f32x4*)(src + row * PITCH + k0) * sc, hi = *(const LAS f32x4*)(src + row * PITCH + k0 + 8) * sc;
            *(u32x4*)(slot + (isq ? SL_QE : SL_BEK) + ((rb * 8 + ks) * 64 + lane) * 16) = pack8f(lo, hi);
        } else if (job < 48) {
            const int jj = job - 32, rb = jj >> 2, ks = jj & 3, dk = 32 * rb + r;
            f32x4 lo, hi;
#pragma unroll
            for (int e = 0; e < 4; ++e) { const int j0 = 16 * ks + 4 * hh + e, j1 = j0 + 8;
                lo[e] = Ks[j0 * PITCH + dk] * __expf(gcl - gcs[j0]); hi[e] = Ks[j1 * PITCH + dk] * __expf(gcl - gcs[j1]); }
            *(u32x4*)(slot + SL_KWT + ((rb * 4 + ks) * 64 + lane) * 16) = pack8f(lo, hi);
        } else {
            const int q = job - 48, w = q >> 1, ib = q & 1, dv = 32 * w + r;
            float v[16];
#pragma unroll
            for (int reg = 0; reg < 16; ++reg) { const int i = 32 * ib + crow16(reg, hh); v[reg] = betas[i] * Vs[i * PITCH + dv]; }
            u32x4* dst = (u32x4*)(slot + SL_BV + ((w * 2 + ib) * 64 + lane) * 32);
            dst[0] = (u32x4){cvtpk(v[0], v[1]), cvtpk(v[2], v[3]), cvtpk(v[4], v[5]), cvtpk(v[6], v[7])};
            dst[1] = (u32x4){cvtpk(v[8], v[9]), cvtpk(v[10], v[11]), cvtpk(v[12], v[13]), cvtpk(v[14], v[15])};
        }
    }
    LDS_BARRIER();
}
DI void prep_stage2(KA A, int item, LAS float* M) {
    int lane = threadIdx.x & 63; asm volatile("" : "+v"(lane));
    const int r = lane & 31, hh = lane >> 5;
    unsigned char* slot = slot_ptr(A, item);
    const f32x4* Ain = (const f32x4*)(slot + SL_A);
#pragma unroll
    for (int q = 0; q < 16; ++q) *(LAS f32x4*)(M + (q * 64 + lane) * 4) = Ain[q * 64 + lane];
    LDS_WAIT(); asm volatile("" ::: "memory");
#pragma unroll 1
    for (int rb = 0; rb < 4; ++rb) {
        float acc[16];
#pragma unroll
        for (int i = 0; i < 16; ++i) acc[i] = lane == 16 * rb + i ? 1.f : 0.f;
#pragma unroll 2
        for (int j = 0; j < 16 * rb; ++j) {
            float tj = M[j * 64 + lane]; tj = lane <= j ? tj : 0.f;
            const LAS f32x4* ar = (const LAS f32x4*)(M + j * 64 + 16 * rb);
            const f32x4 a0 = ar[0], a1 = ar[1], a2 = ar[2], a3 = ar[3];
#pragma unroll
            for (int e = 0; e < 4; ++e) { acc[e] -= a0[e] * tj; acc[4 + e] -= a1[e] * tj; acc[8 + e] -= a2[e] * tj; acc[12 + e] -= a3[e] * tj; }
        }
#pragma unroll
        for (int j = 0; j < 16; ++j) {
            const float tj = acc[j]; const int row = 16 * rb + j;
            const LAS f32x4* ar = (const LAS f32x4*)(M + row * 64 + 16 * rb);
            float a[16];
#pragma unroll
            for (int q = j >> 2; q < 4; ++q) { const f32x4 v = ar[q]; a[4 * q] = v[0]; a[4 * q + 1] = v[1]; a[4 * q + 2] = v[2]; a[4 * q + 3] = v[3]; }
            if (lane <= row) M[row * 64 + lane] = tj;
#pragma unroll
            for (int i = j + 1; i < 16; ++i) acc[i] -= a[i] * tj;
        }
        asm volatile("" ::: "memory");
    }
    LDS_WAIT(); asm volatile("" ::: "memory");
#pragma unroll
    for (int f = 0; f < 8; ++f) { const int rb = f >> 2, ks = f & 3, row = 32 * rb + r, k0 = 16 * ks + 4 * hh;
        f32x4 lo = *(const LAS f32x4*)(M + row * 64 + k0), hi = *(const LAS f32x4*)(M + row * 64 + k0 + 8);
#pragma unroll
        for (int e = 0; e < 4; ++e) { lo[e] = k0 + e <= row ? lo[e] : 0.f; hi[e] = k0 + 8 + e <= row ? hi[e] : 0.f; }
        *(u32x4*)(slot + SL_T + ((rb * 4 + ks) * 64 + lane) * 16) = pack8f(lo, hi); }
    LDS_WAIT(); asm volatile("" ::: "memory");
}
DI void p2_prep(KA A, LAS unsigned char* lds) {
    const int wave = __builtin_amdgcn_readfirstlane(threadIdx.x >> 6), G = gridDim.x;
    for (int rep = 0; rep < (PROBE_REP == 21 ? 2 : 1); ++rep)
    { S1Pre P;
      if ((int)blockIdx.x < N_ITEMS) stage1_issue(A, blockIdx.x, P);
      for (int item = blockIdx.x; item < N_ITEMS; item += G) prep_stage1(A, item, item + G, P, lds); }
    asm volatile("s_waitcnt vmcnt(0)" ::: "memory"); __syncthreads();
    for (int rep = 0; rep < (PROBE_REP == 22 ? 2 : 1); ++rep) {
    int n = 0;
    for (int item = blockIdx.x; item < N_ITEMS; item += G, ++n) if ((n & 7) == wave) prep_stage2(A, item, (LAS float*)(lds + wave * 16384));
    }
}

DI void scan_seq(KA A, int seq, int w, int lane) {
    const int r = lane & 31, hh = lane >> 5, dv = 32 * w + r;
    const bool sample = seq >= N_PROMPT_SEQ; const int sidx = sample ? seq - N_PROMPT_SEQ : seq, b = sidx >> 2, h = sidx & 3, nch = sample ? 1 : CHUNKS_P;
    f32x16 S[4];
    if (sample) {
        const float* S0 = A->state_delta + ((size_t)(b * 4 + h) * 128) * 128 + dv;
#pragma unroll
        for (int kb = 0; kb < 4; ++kb)
#pragma unroll
            for (int reg = 0; reg < 16; ++reg) S[kb][reg] = S0[(size_t)(32 * kb + crow16(reg, hh)) * 128];
    } else {
#pragma unroll
        for (int kb = 0; kb < 4; ++kb)
#pragma unroll
            for (int reg = 0; reg < 16; ++reg) S[kb][reg] = 0.f;
    }
    float* OBR = (float*)(A->ws + WS_OBRAW);
#pragma unroll 1
    for (int c = 0; c < nch; ++c) {
        const int item = sample ? N_ITEMS_P + sidx : seq * CHUNKS_P + c;
        const unsigned char* slot = slot_ptr(A, item);
        const float gcl = ((const float*)(A->ws + WS_SC))[item];
        const bf16x8* bek = (const bf16x8*)(slot + SL_BEK) + lane; const bf16x8* tp = (const bf16x8*)(slot + SL_T) + lane;
        const bf16x8* qe = (const bf16x8*)(slot + SL_QE) + lane; const bf16x8* qkd = (const bf16x8*)(slot + SL_QKD) + lane; const bf16x8* kwt = (const bf16x8*)(slot + SL_KWT) + lane;
        bf16x8 sf[8];
#pragma unroll
        for (int kb = 0; kb < 4; ++kb) { sf[2 * kb] = pack_step<0>(S[kb]); sf[2 * kb + 1] = pack_step<1>(S[kb]); }
        f32x16 x0, x1;
#pragma unroll
        for (int e = 0; e < 16; ++e) { x0[e] = 0.f; x1[e] = 0.f; }
#pragma unroll
        for (int ks = 0; ks < 8; ++ks) { x0 = MFMA32(bek[ks * 64], sf[ks], x0); x1 = MFMA32(bek[(8 + ks) * 64], sf[ks], x1); }
        {
            const u32x4* bv = (const u32x4*)(slot + SL_BV) + ((w * 2) * 64 + lane) * 2;
            const u32x4 a0 = bv[0], a1 = bv[1], c0 = bv[128], c1 = bv[129];
            x0[0] = bflo(a0.x) - x0[0]; x0[1] = bfhi(a0.x) - x0[1]; x0[2] = bflo(a0.y) - x0[2]; x0[3] = bfhi(a0.y) - x0[3];
            x0[4] = bflo(a0.z) - x0[4]; x0[5] = bfhi(a0.z) - x0[5]; x0[6] = bflo(a0.w) - x0[6]; x0[7] = bfhi(a0.w) - x0[7];
            x0[8] = bflo(a1.x) - x0[8]; x0[9] = bfhi(a1.x) - x0[9]; x0[10] = bflo(a1.y) - x0[10]; x0[11] = bfhi(a1.y) - x0[11];
            x0[12] = bflo(a1.z) - x0[12]; x0[13] = bfhi(a1.z) - x0[13]; x0[14] = bflo(a1.w) - x0[14]; x0[15] = bfhi(a1.w) - x0[15];
            x1[0] = bflo(c0.x) - x1[0]; x1[1] = bfhi(c0.x) - x1[1]; x1[2] = bflo(c0.y) - x1[2]; x1[3] = bfhi(c0.y) - x1[3];
            x1[4] = bflo(c0.z) - x1[4]; x1[5] = bfhi(c0.z) - x1[5]; x1[6] = bflo(c0.w) - x1[6]; x1[7] = bfhi(c0.w) - x1[7];
            x1[8] = bflo(c1.x) - x1[8]; x1[9] = bfhi(c1.x) - x1[9]; x1[10] = bflo(c1.y) - x1[10]; x1[11] = bfhi(c1.y) - x1[11];
            x1[12] = bflo(c1.z) - x1[12]; x1[13] = bfhi(c1.z) - x1[13]; x1[14] = bflo(c1.w) - x1[14]; x1[15] = bfhi(c1.w) - x1[15];
        }
        bf16x8 rf[4] = {pack_step<0>(x0), pack_step<1>(x0), pack_step<0>(x1), pack_step<1>(x1)};
        f32x16 u0, u1;
#pragma unroll
        for (int e = 0; e < 16; ++e) { u0[e] = 0.f; u1[e] = 0.f; }
        u0 = MFMA32(tp[0 * 64], rf[0], u0); u0 = MFMA32(tp[1 * 64], rf[1], u0);
#pragma unroll
        for (int ks = 0; ks < 4; ++ks) u1 = MFMA32(tp[(4 + ks) * 64], rf[ks], u1);
        bf16x8 uf[4] = {pack_step<0>(u0), pack_step<1>(u0), pack_step<0>(u1), pack_step<1>(u1)};
        if (sample || c > 0) {
#pragma unroll
            for (int e = 0; e < 16; ++e) { x0[e] = 0.f; x1[e] = 0.f; }
#pragma unroll
            for (int ks = 0; ks < 8; ++ks) { x0 = MFMA32(qe[ks * 64], sf[ks], x0); x1 = MFMA32(qe[(8 + ks) * 64], sf[ks], x1); }
            x0 = MFMA32(qkd[0 * 64], uf[0], x0); x0 = MFMA32(qkd[1 * 64], uf[1], x0);
#pragma unroll
            for (int ks = 0; ks < 4; ++ks) x1 = MFMA32(qkd[(4 + ks) * 64], uf[ks], x1);
            const int crow0 = sample ? NBATCH * SEQ + b * TS : b * SEQ + 64 * (c - 1), L = sample ? TS : 64;
#pragma unroll
            for (int reg = 0; reg < 16; ++reg) { const int i0 = crow16(reg, hh), i1 = 32 + i0;
                if (i0 < L) OBR[(size_t)(crow0 + i0) * 512 + h * 128 + dv] = x0[reg];
                if (i1 < L) OBR[(size_t)(crow0 + i1) * 512 + h * 128 + dv] = x1[reg]; }
        }
#pragma unroll
        for (int kb = 0; kb < 4; ++kb) {
            S[kb] = S[kb] * gcl;
#pragma unroll
            for (int ks = 0; ks < 4; ++ks) S[kb] = MFMA32(kwt[(kb * 4 + ks) * 64], uf[ks], S[kb]);
        }
    }
    float* So = A->out + (sample ? O_DS : O_DP) + ((size_t)(b * 4 + h) * 128) * 128 + dv;
#pragma unroll
    for (int kb = 0; kb < 4; ++kb)
#pragma unroll
        for (int reg = 0; reg < 16; ++reg) So[(size_t)(32 * kb + crow16(reg, hh)) * 128] = S[kb][reg];
}

constexpr int HALF_BYTES = 40960;
DI void scan_prompt_wg(KA A, int seq, LAS unsigned char* lds) {
    const int tid = threadIdx.x, lane = tid & 63, wave = __builtin_amdgcn_readfirstlane(tid >> 6);
    const int b = seq >> 2, h = seq & 3;
    constexpr int N = 2 * CHUNKS_P;
    if (wave >= 4) {
        const int loff = (wave - 4) * 10240 + lane * 16;
        u32x4 r0[10], r1[10];
        LAS u32x4* d0 = (LAS u32x4*)(lds + loff); LAS u32x4* d1 = (LAS u32x4*)(lds + HALF_BYTES + loff);
#define SCAN_SRC(n) ((const u32x4*)(slot_ptr(A, seq * CHUNKS_P + ((n) >> 1)) + ((n) & 1) * HALF_BYTES + loff))
        { const u32x4* s = SCAN_SRC(0);
#pragma unroll
            for (int q = 0; q < 10; ++q) r0[q] = s[q * 64]; }
#pragma unroll
        for (int q = 0; q < 10; ++q) d0[q * 64] = r0[q];
        { const u32x4* s = SCAN_SRC(1);
#pragma unroll
            for (int q = 0; q < 10; ++q) r1[q] = s[q * 64]; }
        LDS_BARRIER();
#pragma unroll 1
        for (int n = 0; n < N; n += 2) {
            if (n + 2 < N) { const u32x4* s = SCAN_SRC(n + 2);
#pragma unroll
                for (int q = 0; q < 10; ++q) r0[q] = s[q * 64]; }
#pragma unroll
            for (int q = 0; q < 10; ++q) d1[q * 64] = r1[q];
            LDS_BARRIER();
            if (n + 3 < N) { const u32x4* s = SCAN_SRC(n + 3);
#pragma unroll
                for (int q = 0; q < 10; ++q) r1[q] = s[q * 64]; }
            if (n + 2 < N) {
#pragma unroll
                for (int q = 0; q < 10; ++q) d0[q * 64] = r0[q]; }
            LDS_BARRIER();
        }
#undef SCAN_SRC
    } else {
        const int w = wave, r = lane & 31, hh = lane >> 5, dv = 32 * w + r;
        f32x16 S[4];
#pragma unroll
        for (int kb = 0; kb < 4; ++kb)
#pragma unroll
            for (int reg = 0; reg < 16; ++reg) S[kb][reg] = 0.f;
        float* OBR = (float*)(A->ws + WS_OBRAW);
        const float* SCp = (const float*)(A->ws + WS_SC) + seq * CHUNKS_P;
        const LAS bf16x8* bek = (const LAS bf16x8*)(lds + SL_BEK) + lane; const LAS bf16x8* tp = (const LAS bf16x8*)(lds + SL_T) + lane;
        const LAS u32x4* bv = (const LAS u32x4*)(lds + SL_BV) + ((w * 2) * 64 + lane) * 2;
        const LAS bf16x8* qkd = (const LAS bf16x8*)(lds + HALF_BYTES + (SL_QKD - HALF_BYTES)) + lane; const LAS bf16x8* qe = (const LAS bf16x8*)(lds + HALF_BYTES + (SL_QE - HALF_BYTES)) + lane;
        const LAS bf16x8* kwt = (const LAS bf16x8*)(lds + HALF_BYTES + (SL_KWT - HALF_BYTES)) + lane;
        LDS_BARRIER();
#pragma unroll 1
        for (int c = 0; c < CHUNKS_P; ++c) {
            const float gcl = SCp[c];
            bf16x8 sf[8];
#pragma unroll
            for (int kb = 0; kb < 4; ++kb) { sf[2 * kb] = pack_step<0>(S[kb]); sf[2 * kb + 1] = pack_step<1>(S[kb]); }
            f32x16 x0, x1;
#pragma unroll
            for (int e = 0; e < 16; ++e) { x0[e] = 0.f; x1[e] = 0.f; }
#pragma unroll
            for (int ks = 0; ks < 8; ++ks) { x0 = MFMA32(bek[ks * 64], sf[ks], x0); x1 = MFMA32(bek[(8 + ks) * 64], sf[ks], x1); }
            {
                const u32x4 a0 = bv[0], a1 = bv[1], c0 = bv[128], c1 = bv[129];
                x0[0] = bflo(a0.x) - x0[0]; x0[1] = bfhi(a0.x) - x0[1]; x0[2] = bflo(a0.y) - x0[2]; x0[3] = bfhi(a0.y) - x0[3];
                x0[4] = bflo(a0.z) - x0[4]; x0[5] = bfhi(a0.z) - x0[5]; x0[6] = bflo(a0.w) - x0[6]; x0[7] = bfhi(a0.w) - x0[7];
                x0[8] = bflo(a1.x) - x0[8]; x0[9] = bfhi(a1.x) - x0[9]; x0[10] = bflo(a1.y) - x0[10]; x0[11] = bfhi(a1.y) - x0[11];
                x0[12] = bflo(a1.z) - x0[12]; x0[13] = bfhi(a1.z) - x0[13]; x0[14] = bflo(a1.w) - x0[14]; x0[15] = bfhi(a1.w) - x0[15];
                x1[0] = bflo(c0.x) - x1[0]; x1[1] = bfhi(c0.x) - x1[1]; x1[2] = bflo(c0.y) - x1[2]; x1[3] = bfhi(c0.y) - x1[3];
                x1[4] = bflo(c0.z) - x1[4]; x1[5] = bfhi(c0.z) - x1[5]; x1[6] = bflo(c0.w) - x1[6]; x1[7] = bfhi(c0.w) - x1[7];
                x1[8] = bflo(c1.x) - x1[8]; x1[9] = bfhi(c1.x) - x1[9]; x1[10] = bflo(c1.y) - x1[10]; x1[11] = bfhi(c1.y) - x1[11];
                x1[12] = bflo(c1.z) - x1[12]; x1[13] = bfhi(c1.z) - x1[13]; x1[14] = bflo(c1.w) - x1[14]; x1[15] = bfhi(c1.w) - x1[15];
            }
            bf16x8 rf[4] = {pack_step<0>(x0), pack_step<1>(x0), pack_step<0>(x1), pack_step<1>(x1)};
            f32x16 u0, u1;
#pragma unroll
            for (int e = 0; e < 16; ++e) { u0[e] = 0.f; u1[e] = 0.f; }
            u0 = MFMA32(tp[0 * 64], rf[0], u0); u0 = MFMA32(tp[1 * 64], rf[1], u0);
#pragma unroll
            for (int ks = 0; ks < 4; ++ks) u1 = MFMA32(tp[(4 + ks) * 64], rf[ks], u1);
            bf16x8 uf[4] = {pack_step<0>(u0), pack_step<1>(u0), pack_step<0>(u1), pack_step<1>(u1)};
            LDS_BARRIER();
            if (c > 0) {
#pragma unroll
                for (int e = 0; e < 16; ++e) { x0[e] = 0.f; x1[e] = 0.f; }
#pragma unroll
                for (int ks = 0; ks < 8; ++ks) { x0 = MFMA32(qe[ks * 64], sf[ks], x0); x1 = MFMA32(qe[(8 + ks) * 64], sf[ks], x1); }
                x0 = MFMA32(qkd[0 * 64], uf[0], x0); x0 = MFMA32(qkd[1 * 64], uf[1], x0);
#pragma unroll
                for (int ks = 0; ks < 4; ++ks) x1 = MFMA32(qkd[(4 + ks) * 64], uf[ks], x1);
                float* orow = OBR + (size_t)(b * SEQ + 64 * (c - 1)) * 512 + h * 128 + dv;
#pragma unroll
                for (int reg = 0; reg < 16; ++reg) { const int i0 = crow16(reg, hh); orow[(size_t)i0 * 512] = x0[reg]; orow[(size_t)(32 + i0) * 512] = x1[reg]; }
            }
#pragma unroll
            for (int kb = 0; kb < 4; ++kb) {
                S[kb] = S[kb] * gcl;
#pragma unroll
                for (int ks = 0; ks < 4; ++ks) S[kb] = MFMA32(kwt[(kb * 4 + ks) * 64], uf[ks], S[kb]);
            }
            LDS_BARRIER();
        }
        float* So = A->out + O_DP + ((size_t)(b * 4 + h) * 128) * 128 + dv;
#pragma unroll
        for (int kb = 0; kb < 4; ++kb)
#pragma unroll
            for (int reg = 0; reg < 16; ++reg) So[(size_t)(32 * kb + crow16(reg, hh)) * 128] = S[kb][reg];
    }
}

constexpr int KPITCH = 72, VPITCH = 264;
DI void attn_unit(KA A, int unit, LAS unsigned char* ldsb) {
    const int tid = threadIdx.x, lane = tid & 63, wave = __builtin_amdgcn_readfirstlane(tid >> 6), r = lane & 31, hh = lane >> 5;
    const int b = unit >> 6, kh = (unit >> 5) & 1, jb = unit & 31, T0 = NMETA + 128 * jb;
    LAS bf16* Ksm = (LAS bf16*)ldsb; LAS bf16* VTs = Ksm + 256 * KPITCH;
    const bf16* KVg = (const bf16*)(A->ws + WS_KV); const bf16* QAg = (const bf16*)(A->ws + WS_QA);
#pragma unroll
    for (int e4 = 0; e4 < 4; ++e4) {
        const int id = tid + 512 * e4, key = id >> 3, cch = id & 7, tk = T0 - 128 + key;
        u32x4 kq = (u32x4){0u, 0u, 0u, 0u}, vq = kq;
        if (tk >= 0) { const bf16* src = KVg + (size_t)(b * TP + tk) * 256 + kh * 64 + 8 * cch; kq = *(const u32x4*)src; vq = *(const u32x4*)(src + 128); }
        *(LAS u32x4*)(Ksm + key * KPITCH + 8 * cch) = kq;
        const int kkk = key & 15, pos = (key & ~15) + 8 * ((kkk >> 2) & 1) + (((kkk >> 3) << 2) | (kkk & 3));
        LAS bf16* vd = VTs + (8 * cch) * VPITCH + pos;
        vd[0 * VPITCH] = (bf16)(vq.x & 0xffffu); vd[1 * VPITCH] = (bf16)(vq.x >> 16); vd[2 * VPITCH] = (bf16)(vq.y & 0xffffu); vd[3 * VPITCH] = (bf16)(vq.y >> 16);
        vd[4 * VPITCH] = (bf16)(vq.z & 0xffffu); vd[5 * VPITCH] = (bf16)(vq.z >> 16); vd[6 * VPITCH] = (bf16)(vq.w & 0xffffu); vd[7 * VPITCH] = (bf16)(vq.w >> 16);
    }
    LDS_BARRIER();
    const int g = wave >> 1, qh = wave & 1, head = 4 * kh + g;
    const float sink2 = A->sinks[head] * 1.4426950408889634f;
    const int kmin = jb == 0 ? 128 - NMETA : 0;
#pragma unroll 1
    for (int q2 = 0; q2 < 2; ++q2) {
        const int qb = 2 * qh + q2, iq = 32 * qb + r;
        const bf16* qrow = QAg + (size_t)(b * TP + T0 + iq) * 512 + head * 64 + 8 * hh;
        bf16x8 qf[4];
#pragma unroll
        for (int s = 0; s < 4; ++s) qf[s] = *(const bf16x8*)(qrow + 16 * s);
        f32x16 st[5];
        float m = sink2;
#pragma unroll
        for (int kt5 = 0; kt5 < 5; ++kt5) {
            const int kt = qb + kt5;
            f32x16 acc;
#pragma unroll
            for (int e = 0; e < 16; ++e) acc[e] = 0.f;
#pragma unroll
            for (int s = 0; s < 4; ++s) acc = MFMA32(*(const LAS bf16x8*)(Ksm + (32 * kt + r) * KPITCH + 16 * s + 8 * hh), qf[s], acc);
#pragma unroll
            for (int reg = 0; reg < 16; ++reg) { const int kk = 32 * kt + crow16(reg, hh); const bool ok = kk >= iq && kk <= iq + 128 && kk >= kmin;
                acc[reg] = ok ? acc[reg] : -INFINITY; m = fmaxf(m, acc[reg]); }
            st[kt5] = acc;
        }
        m = fmaxf(m, __shfl_xor(m, 32));
        float l = 0.f;
#pragma unroll
        for (int kt5 = 0; kt5 < 5; ++kt5)
#pragma unroll
            for (int reg = 0; reg < 16; ++reg) { const float p = exp2f(st[kt5][reg] - m); st[kt5][reg] = p; l += p; }
        l += __shfl_xor(l, 32); l += exp2f(sink2 - m);
        f32x16 o0, o1;
#pragma unroll
        for (int e = 0; e < 16; ++e) { o0[e] = 0.f; o1[e] = 0.f; }
#pragma unroll
        for (int kt5 = 0; kt5 < 5; ++kt5) {
            const int kt = qb + kt5;
            const bf16x8 p0 = pack_step<0>(st[kt5]), p1 = pack_step<1>(st[kt5]);
            const LAS bf16* vb = VTs + r * VPITCH + 32 * kt + 8 * hh;
            o0 = MFMA32(*(const LAS bf16x8*)(vb), p0, o0); o0 = MFMA32(*(const LAS bf16x8*)(vb + 16), p1, o0);
            o1 = MFMA32(*(const LAS bf16x8*)(vb + 32 * VPITCH), p0, o1); o1 = MFMA32(*(const LAS bf16x8*)(vb + 32 * VPITCH + 16), p1, o1);
        }
        const float rl = 1.0f / l;
        bf16* orow = (bf16*)(A->ws + WS_OA) + (size_t)(b * SEQ + 128 * jb + iq) * 512 + head * 64 + 4 * hh;
#pragma unroll
        for (int g4 = 0; g4 < 4; ++g4) {
            *(u32x2*)(orow + 8 * g4) = (u32x2){cvtpk(o0[4 * g4] * rl, o0[4 * g4 + 1] * rl), cvtpk(o0[4 * g4 + 2] * rl, o0[4 * g4 + 3] * rl)};
            *(u32x2*)(orow + 32 + 8 * g4) = (u32x2){cvtpk(o1[4 * g4] * rl, o1[4 * g4 + 1] * rl), cvtpk(o1[4 * g4 + 2] * rl, o1[4 * g4 + 3] * rl)};
        }
    }
    LDS_BARRIER();
}
DI void sample_attn(KA A, int b, int head, LAS float* wl, int lane) {
    const int kh = head >> 2;
    LAS float* qn = wl; LAS float* ps = wl + 256;
    const bf16* QAg = (const bf16*)(A->ws + WS_QA); const bf16* KVg = (const bf16*)(A->ws + WS_KV);
#pragma unroll
    for (int i = 0; i < 4; ++i) qn[i * 64 + lane] = bf2f(QAg[(size_t)(MP + b * TS + i) * 512 + head * 64 + pos_of_d(lane)]);
    LDS_WAIT(); asm volatile("" ::: "memory");
    const float sink2 = A->sinks[head] * 1.4426950408889634f;
#pragma unroll 1
    for (int kq = 0; kq < 3; ++kq) {
        const int kj = lane + 64 * kq;
        float sc0 = 0.f, sc1 = 0.f, sc2 = 0.f, sc3 = 0.f;
        if (kj < 128) {
            const f32x4* kr = (const f32x4*)(A->cache_k + ((size_t)(b * 128 + kj) * 2 + kh) * 64);
#pragma unroll 4
            for (int d4 = 0; d4 < 16; ++d4) { const f32x4 kv = kr[d4];
                const f32x4 q0 = *(const LAS f32x4*)(qn + 4 * d4), q1 = *(const LAS f32x4*)(qn + 64 + 4 * d4), q2 = *(const LAS f32x4*)(qn + 128 + 4 * d4), q3 = *(const LAS f32x4*)(qn + 192 + 4 * d4);
                sc0 += (kv[0] * q0[0] + kv[1] * q0[1]) + (kv[2] * q0[2] + kv[3] * q0[3]); sc1 += (kv[0] * q1[0] + kv[1] * q1[1]) + (kv[2] * q1[2] + kv[3] * q1[3]);
                sc2 += (kv[0] * q2[0] + kv[1] * q2[1]) + (kv[2] * q2[2] + kv[3] * q2[3]); sc3 += (kv[0] * q3[0] + kv[1] * q3[1]) + (kv[2] * q3[2] + kv[3] * q3[3]); }
        } else if (kj < 132) {
            const bf16* kr = KVg + (size_t)(MP + b * TS + (kj - 128)) * 256 + kh * 64;
#pragma unroll 4
            for (int p = 0; p < 64; ++p) { const float kv = bf2f(kr[p]); const int d = d_of_pos(p);
                sc0 += kv * qn[d]; sc1 += kv * qn[64 + d]; sc2 += kv * qn[128 + d]; sc3 += kv * qn[192 + d]; }
        }
        if (kj < 132) {
            ps[0 * 132 + kj] = (kj >= 0 && kj <= 128) ? sc0 : -INFINITY; ps[1 * 132 + kj] = (kj >= 1 && kj <= 129) ? sc1 : -INFINITY;
            ps[2 * 132 + kj] = (kj >= 2 && kj <= 130) ? sc2 : -INFINITY; ps[3 * 132 + kj] = (kj >= 3 && kj <= 131) ? sc3 : -INFINITY; }
    }
    LDS_WAIT(); asm volatile("" ::: "memory");
    float linv[4];
#pragma unroll
    for (int i = 0; i < 4; ++i) {
        const float s0 = ps[i * 132 + lane], s1 = ps[i * 132 + 64 + lane], s2 = lane < 4 ? ps[i * 132 + 128 + lane] : -INFINITY;
        const float m = wave_max(fmaxf(fmaxf(s0, s1), fmaxf(s2, sink2)));
        const float p0 = exp2f(s0 - m), p1 = exp2f(s1 - m), p2 = exp2f(s2 - m);
        ps[i * 132 + lane] = p0; ps[i * 132 + 64 + lane] = p1; if (lane < 4) ps[i * 132 + 128 + lane] = p2;
        linv[i] = 1.0f / (wave_sum(p0 + p1 + p2) + exp2f(sink2 - m));
    }
    LDS_WAIT(); asm volatile("" ::: "memory");
    float o[4] = {0.f, 0.f, 0.f, 0.f};
#pragma unroll 4
    for (int kj = 0; kj < 128; ++kj) { const float v = A->cache_v[((size_t)(b * 128 + kj) * 2 + kh) * 64 + lane];
#pragma unroll
        for (int i = 0; i < 4; ++i) o[i] += ps[i * 132 + kj] * v; }
#pragma unroll
    for (int kj = 128; kj < 132; ++kj) { const float v = bf2f(KVg[(size_t)(MP + b * TS + (kj - 128)) * 256 + 128 + kh * 64 + lane]);
#pragma unroll
        for (int i = 0; i < 4; ++i) o[i] += ps[i * 132 + kj] * v; }
    bf16* OAg = (bf16*)(A->ws + WS_OA);
#pragma unroll
    for (int i = 0; i < 4; ++i) OAg[(size_t)(NBATCH * SEQ + b * TS + i) * 512 + head * 64 + lane] = f2bf(o[i] * linv[i]);
    LDS_WAIT(); asm volatile("" ::: "memory");
}
DI void p3_mixers(KA A, LAS unsigned char* lds) {
    const int tid = threadIdx.x, lane = tid & 63, wave = __builtin_amdgcn_readfirstlane(tid >> 6), G = gridDim.x, wg = blockIdx.x;
    const int NSCAN = N_PROMPT_SEQ;
    if (wg < NSCAN) { for (int rep = 0; rep < (PROBE_REP == 31 ? 2 : 1); ++rep) scan_prompt_wg(A, wg, lds); return; }
    for (int rep = 0; rep < (PROBE_REP == 32 ? 2 : 1); ++rep)
    for (int u = wg - NSCAN; u < NBATCH * NKV * 32; u += G - NSCAN) attn_unit(A, u, lds);
    const int worker = (wg - NSCAN) * NWAVES + wave, NW = (G - NSCAN) * NWAVES;
    LAS float* wl = (LAS float*)(lds + 98304 + wave * 4096);
    for (int rep = 0; rep < (PROBE_REP == 33 ? 2 : 1); ++rep)
    for (int it = worker; it < SBATCH * NHB * 4 + SBATCH * NHA; it += NW) {
        if (it < SBATCH * NHB * 4) scan_seq(A, N_PROMPT_SEQ + (it >> 2), it & 3, lane);
        else { const int q = it - SBATCH * NHB * 4; sample_attn(A, q >> 3, q & 7, wl, lane); }
    }
}

DI void p3b_gated_norm(KA A) {
    const int tid = threadIdx.x, lane = tid & 63, wave = tid >> 6, gw = blockIdx.x * NWAVES + wave, NGW = gridDim.x * NWAVES;
    const int head = lane >> 4, dv0 = 8 * (lane & 15);
    const f32x4 w0 = *(const f32x4*)(A->gdn_norm + dv0), w1 = *(const f32x4*)(A->gdn_norm + dv0 + 4);
    const float* OBR = (const float*)(A->ws + WS_OBRAW); const bf16* Zg = (const bf16*)(A->ws + WS_Z); bf16* OBg = (bf16*)(A->ws + WS_OB);
    for (int crow = gw; crow < MC; crow += NGW) {
        const float* op = OBR + (size_t)crow * 512 + head * 128 + dv0;
        const f32x4 a = *(const f32x4*)op, c = *(const f32x4*)(op + 4);
        float ss = (a[0] * a[0] + a[1] * a[1]) + (a[2] * a[2] + a[3] * a[3]) + (c[0] * c[0] + c[1] * c[1]) + (c[2] * c[2] + c[3] * c[3]);
        ss += __shfl_xor(ss, 1); ss += __shfl_xor(ss, 2); ss += __shfl_xor(ss, 4); ss += __shfl_xor(ss, 8);
        const float rstd = rsqrtf(ss * (1.0f / 128.0f) + EPS);
        const u32x4 zw = *(const u32x4*)(Zg + (size_t)pg8::crow_to_urow(crow) * 512 + head * 128 + dv0);
        f32x4 y0, y1;
        y0[0] = a[0] * rstd * w0[0] * siluf_(bflo(zw.x)); y0[1] = a[1] * rstd * w0[1] * siluf_(bfhi(zw.x)); y0[2] = a[2] * rstd * w0[2] * siluf_(bflo(zw.y)); y0[3] = a[3] * rstd * w0[3] * siluf_(bfhi(zw.y));
        y1[0] = c[0] * rstd * w1[0] * siluf_(bflo(zw.z)); y1[1] = c[1] * rstd * w1[1] * siluf_(bfhi(zw.z)); y1[2] = c[2] * rstd * w1[2] * siluf_(bflo(zw.w)); y1[3] = c[3] * rstd * w1[3] * siluf_(bfhi(zw.w));
        *(u32x4*)(OBg + (size_t)crow * 512 + head * 128 + dv0) = pack8f(y0, y1);
    }
}
DI void p8_final_norm(KA A) {
    const int tid = threadIdx.x, lane = tid & 63, wave = tid >> 6, gw = blockIdx.x * NWAVES + wave, NGW = gridDim.x * NWAVES;
    f32x4 nf[4];
#pragma unroll
    for (int j = 0; j < 4; ++j) nf[j] = ((const f32x4*)A->norm_final)[lane + 64 * j];
    for (int crow = gw; crow < MC; crow += NGW) {
        f32x4* row = (f32x4*)(A->out + (size_t)crow * D);
        f32x4 v[4]; float ss = 0.f;
#pragma unroll
        for (int j = 0; j < 4; ++j) { v[j] = row[lane + 64 * j]; ss += (v[j][0] * v[j][0] + v[j][1] * v[j][1]) + (v[j][2] * v[j][2] + v[j][3] * v[j][3]); }
        const float rstd = rsqrtf(wave_sum(ss) * (1.0f / D) + EPS);
#pragma unroll
        for (int j = 0; j < 4; ++j) row[lane + 64 * j] = v[j] * rstd * nf[j];
    }
}
__global__ void __launch_bounds__(NTHREADS, 2) hybrid_fwd(Args Aval) {
    extern __shared__ __attribute__((aligned(16))) unsigned char lds_raw[];
    LAS unsigned char* lds = (LAS unsigned char*)lds_raw;
    const int tid = threadIdx.x;
    int lo, hi; { KA A0 = kargs(); lo = A0->ph_lo; hi = A0->ph_hi; }
#if MK_N_LAUNCHES == 1
#if MK_BARRIER == 1
    volatile LAS unsigned* MISC = (volatile LAS unsigned*)(lds + LDS_MISC);
    if (tid < 64) MISC[tid] = 0u;
    __syncthreads();
    XcdBarrier bar; { KA A0 = kargs(); bar = xcd_barrier_post((unsigned*)(A0->ws + WS_CTL) + 4096, MISC + 8); }
#define GRID_BAR() xcd_barrier(bar)
#else
    cg::grid_group grid = cg::this_grid();
#define GRID_BAR() grid.sync()
#endif
#else
#define GRID_BAR() do {} while (0)
#endif
#ifndef PH_MASK
#define PH_MASK 0x3ff
#endif
#define IN(k) (((PH_MASK >> (k)) & 1) && lo <= (k) && (k) < hi)
#ifndef PROBE_REP
#define PROBE_REP -1
#endif
#define NREP(k) (PROBE_REP == (k) ? 2 : 1)
#define SEAM(k) do { if (IN(k) && IN((k) + 1)) GRID_BAR(); } while (0)
    const int G = gridDim.x, wgid = blockIdx.x;
#if PROBE_REP == 0
    if (IN(0)) { KA A = kargs(); p0_prologue(A, lds); __syncthreads(); }
#endif
    if (IN(0)) { KA A = kargs(); p0_prologue(A, lds); } SEAM(0);
    if (IN(1)) for (int rep = 0; rep < NREP(1); ++rep) { KA A = kargs(); unsigned char* ws = A->ws;
        pg8::Gemm g{(const bf16*)(ws + WS_XN), (const bf16*)(ws + WS_WIN), MUP, NIN, D}; pg8::StaticOrder S; S.init(MUP, NIN, G, wgid);
        pg8::EpiInProj E{(bf16*)(ws + WS_QA), (bf16*)(ws + WS_KV), (bf16*)(ws + WS_QKVB), (bf16*)(ws + WS_Z), (bf16*)(ws + WS_G),
                         (const float*)(ws + WS_ROPE), (const float*)(ws + WS_ROPE) + (TP + TS) * 32, A->out};
        pg8::gemm_phase<pg8::EpiInProj, pg8::StaticOrder, true, true>(lds, g, S, E);
    } SEAM(1);
    if (IN(2)) for (int rep = 0; rep < NREP(2); ++rep) { KA A = kargs(); p2_prep(A, lds); __syncthreads(); } SEAM(2);
#if PROBE_REP == 3
    if (IN(3)) { KA A = kargs(); p3_mixers(A, lds); __syncthreads(); }
#endif
    if (IN(3)) { KA A = kargs(); p3_mixers(A, lds); } SEAM(3);
    if (IN(4)) for (int rep = 0; rep < NREP(4); ++rep) { KA A = kargs(); p3b_gated_norm(A); } SEAM(4);
    if (IN(5)) for (int rep = 0; rep < NREP(5); ++rep) { KA A = kargs(); unsigned char* ws = A->ws;
        { pg8::Gemm g{(const bf16*)(ws + WS_OA), (const bf16*)(ws + WS_WOA), MC, D, 512}; pg8::StaticOrder S; S.init(MC, D, G, wgid);
          pg8::EpiMerge<false> E{(bf16*)(ws + WS_MB), (const bf16*)(ws + WS_G), 0};
          pg8::gemm_phase<pg8::EpiMerge<false>, pg8::StaticOrder, true, true>(lds, g, S, E); }
        asm volatile("s_waitcnt vmcnt(0)" ::: "memory"); __syncthreads();
        { pg8::Gemm g{(const bf16*)(ws + WS_OB), (const bf16*)(ws + WS_WOB), MC, D, 512}; pg8::StaticOrder S; S.init(MC, D, G, wgid);
          pg8::EpiMerge<true> E{(bf16*)(ws + WS_MB), (const bf16*)(ws + WS_G), 1024};
          pg8::gemm_phase<pg8::EpiMerge<true>, pg8::StaticOrder, true, true>(lds, g, S, E); }
    } SEAM(5);
    if (IN(6)) { KA A = kargs(); unsigned char* ws = A->ws;
        pg8::Gemm g{(const bf16*)(ws + WS_MB), (const bf16*)(ws + WS_WOUT), MC, D, D}; pg8::StaticOrder S; S.init(MC, D, G, wgid);
        pg8::EpiWout<true> E{A->x_prompt, A->x_sample, A->out, (bf16*)(ws + WS_HB1), (float*)(ws + WS_SS1)};
        pg8::gemm_phase<pg8::EpiWout<true>, pg8::StaticOrder, true, true>(lds, g, S, E);
#if PROBE_REP == 6
        { pg8::EpiWout<false> E2{A->x_prompt, A->x_sample, A->out, (bf16*)(ws + WS_HB1), (float*)(ws + WS_SS1)}; pg8::gemm_phase<pg8::EpiWout<false>, pg8::StaticOrder, true, true>(lds, g, S, E2); }
#endif
    } SEAM(6);
    if (IN(7)) for (int rep = 0; rep < NREP(7); ++rep) { KA A = kargs(); unsigned char* ws = A->ws;
        pg8::Gemm g{(const bf16*)(ws + WS_HB1), (const bf16*)(ws + WS_WGU), MC, 2 * DFF, D}; pg8::StaticOrder S; S.init(MC, 2 * DFF, G, wgid);
        pg8::EpiGateUp E{(bf16*)(ws + WS_ACT), (const float*)(ws + WS_SS1)};
        pg8::gemm_phase<pg8::EpiGateUp, pg8::StaticOrder, true, true>(lds, g, S, E);
    } SEAM(7);
    if (IN(8)) { KA A = kargs(); unsigned char* ws = A->ws;
        pg8::Gemm g{(const bf16*)(ws + WS_ACT), (const bf16*)(ws + WS_WD), MC, D, DFF}; pg8::StaticOrder S; S.init(MC, D, G, wgid);
        pg8::EpiDown<false> E{A->out};
        pg8::gemm_phase<pg8::EpiDown<false>, pg8::StaticOrder, true, true>(lds, g, S, E);
#if PROBE_REP == 8
        { pg8::EpiDown<true> E2{A->out}; pg8::gemm_phase<pg8::EpiDown<true>, pg8::StaticOrder, true, true>(lds, g, S, E2); }
#endif
    } SEAM(8);
    if (IN(9)) { KA A = kargs(); p8_final_norm(A); }
#undef IN
#undef SEAM
}

extern "C" void kernel_launch(void* const* d_in, const int* in_sizes, int n_in, void* d_out, int out_size, void* d_ws, size_t ws_size, hipStream_t stream) {
    static int grid = 0;
    if (grid == 0) {
        if (n_in != 22 || out_size != (int)O_END || ws_size < WS_END) { fprintf(stderr, "kernel_launch: unexpected problem (n_in %d, out %d, ws %zu)\n", n_in, out_size, ws_size); grid = -1; return; }
        int dev = 0, cus = 0, per_cu = 0;
        if (hipGetDevice(&dev) != hipSuccess || hipDeviceGetAttribute(&cus, hipDeviceAttributeMultiprocessorCount, dev) != hipSuccess) { grid = -1; return; }
        if (hipFuncSetAttribute((const void*)hybrid_fwd, hipFuncAttributeMaxDynamicSharedMemorySize, LDS_BYTES) != hipSuccess) { fprintf(stderr, "kernel_launch: hipFuncSetAttribute failed\n"); grid = -1; return; }
        if (hipOccupancyMaxActiveBlocksPerMultiprocessor(&per_cu, (const void*)hybrid_fwd, NTHREADS, LDS_BYTES) != hipSuccess || per_cu < 1) { fprintf(stderr, "kernel_launch: occupancy query says %d\n", per_cu); per_cu = 1; }
        (void)hipGetLastError();
        grid = cus;
        if (grid > 256) grid = 256;
    }
    if (grid < 0) return;
    (void)hipMemsetAsync((char*)d_ws + WS_CTL, 0, CTL_BYTES, stream);
    Args a{};
    const float** ap = (const float**)&a;
    for (int i = 0; i < 22; ++i) ap[i] = (const float*)d_in[i];
    a.out = (float*)d_out; a.ws = (unsigned char*)d_ws;
#if MK_N_LAUNCHES == 1
    a.ph_lo = 0; a.ph_hi = N_PHASES;
#if MK_BARRIER == 1
    hipLaunchKernelGGL(hybrid_fwd, dim3(grid), dim3(NTHREADS), LDS_BYTES, stream, a);
#else
    void* args[] = {&a};
    hipError_t e = hipLaunchCooperativeKernel((const void*)hybrid_fwd, dim3(grid), dim3(NTHREADS), args, LDS_BYTES, stream);
    if (e != hipSuccess) fprintf(stderr, "cooperative launch failed: %s (grid %d)\n", hipGetErrorString(e), grid);
#endif
#else
    for (int p = 0; p < N_PHASES; ++p) { a.ph_lo = p; a.ph_hi = p + 1; hipLaunchKernelGGL(hybrid_fwd, dim3(grid), dim3(NTHREADS), LDS_BYTES, stream, a); }
#endif
}
```

```cpp
#include <hip/hip_runtime.h>
#include <hip/hip_cooperative_groups.h>
#include <cstdio>
#include <cstdint>
namespace cg = cooperative_groups;

#ifndef MK_N_LAUNCHES
#define MK_N_LAUNCHES 1
#endif
#ifndef MK_BARRIER
#define MK_BARRIER 1
#endif

constexpr int D = 1024, NBATCH = 8, SEQ = 4096, NMETA = 16, TP = SEQ + NMETA, MP = NBATCH * TP;
constexpr int SBATCH = 128, TS = 4, MS = SBATCH * TS, MU = MP + MS, MUP = 33536, MC = NBATCH * SEQ + MS;
constexpr int PAST = 16384;
constexpr int HD = 64, NHA = 8, NKV = 2;
constexpr int NHB = 4, CONVD = 1536;
constexpr int DFF = 2816, NIN_SRC = 4872, NIN = 4864;
constexpr float EPS = 1e-6f;
constexpr float QSCALE = 0.125f * 1.4426950408889634f;

constexpr size_t MiB = 1u << 20, KiB = 1024;
constexpr size_t WS_CTL = 0, CTL_BYTES = 1 * MiB;
constexpr size_t WS_WIN = 1 * MiB;
constexpr size_t WS_WOA = 11 * MiB, WS_WOB = 12 * MiB;
constexpr size_t WS_WOUT = 13 * MiB;
constexpr size_t WS_WGU = 15 * MiB;
constexpr size_t WS_WD = 26 * MiB;
constexpr size_t WS_ROPE = 32 * MiB;
constexpr size_t WS_GB = 34 * MiB;
constexpr size_t WS_SC = 36 * MiB;
constexpr size_t WS_SS1 = 37 * MiB, WS_SS2 = 37 * MiB + 512 * KiB;
constexpr size_t WS_QA = 41 * MiB;
constexpr size_t WS_KV = WS_QA + (size_t)MUP * 512 * 2;
constexpr size_t WS_QKVB = WS_KV + (size_t)MUP * 256 * 2;
constexpr size_t WS_Z = WS_QKVB + (size_t)MUP * 1536 * 2;
constexpr size_t WS_G = WS_Z + (size_t)MUP * 512 * 2;
constexpr size_t WS_GEND = WS_G + (size_t)MUP * 2048 * 2;
constexpr size_t WS_B = 353 * MiB, WS_END = 512 * MiB;
static_assert(WS_GEND <= WS_B, "ws map");
constexpr size_t WS_XN = WS_B;
constexpr size_t PREP_SLOT = 80 * KiB;
constexpr int PREP_N1 = (int)((WS_END - WS_B) / PREP_SLOT);
constexpr size_t DO_OA = 44 * MiB;
constexpr size_t DO_OB = DO_OA + (size_t)MC * 512 * 2;
constexpr size_t DO_ATS = DO_OB + (size_t)MC * 512 * 2;
constexpr size_t ATS_ITEM = 3 * 32 * 32 * 4;
static_assert(DO_ATS + 224 * 8 * ATS_ITEM <= (size_t)MC * 1024 * 4, "d_out scratch map");
constexpr size_t WS_MB = WS_B;
constexpr size_t WS_HB1 = WS_B + 66 * MiB;
static_assert(WS_HB1 + (size_t)MC * 1024 * 2 <= WS_END, "ws map");
constexpr size_t WS_ACT = WS_QA;
static_assert(WS_ACT + (size_t)MC * DFF * 2 <= WS_G, "ws map");
constexpr int SL_BEK = 0, SL_BV = 16 * 1024, SL_T = 32 * 1024, SL_QKD = 40 * 1024, SL_QE = 48 * 1024, SL_KWT = 64 * 1024;
constexpr int N_PROMPT_SEQ = NBATCH * NHB, CHUNKS_P = 65, N_ITEMS_P = N_PROMPT_SEQ * CHUNKS_P, N_ITEMS = N_ITEMS_P + SBATCH * NHB;
static_assert((size_t)(N_ITEMS - PREP_N1) * PREP_SLOT <= DO_OA, "prep slots");

constexpr size_t O_YP = 0, O_YS = (size_t)NBATCH * SEQ * D, O_KP = O_YS + (size_t)MS * D, O_VP = O_KP + 8 * 128 * 2 * 64, O_DP = O_VP + 8 * 128 * 2 * 64,
                 O_CP = O_DP + 8 * 4 * 128 * 128, O_KS = O_CP + 8 * 3 * 1536, O_VS = O_KS + (size_t)128 * 128 * 2 * 64, O_DS = O_VS + (size_t)128 * 128 * 2 * 64,
                 O_CS = O_DS + (size_t)128 * 4 * 128 * 128, O_END = O_CS + (size_t)128 * 3 * 1536;
static_assert(O_END == 48074752, "d_out size");

#define DI __device__ __forceinline__
#define GAS __attribute__((address_space(1)))
#define LAS __attribute__((address_space(3)))
typedef unsigned short bf16;
typedef short bf16x8 __attribute__((ext_vector_type(8)));
typedef float f32x4 __attribute__((ext_vector_type(4)));
typedef float f32x2 __attribute__((ext_vector_type(2)));
typedef float f32x16 __attribute__((ext_vector_type(16)));
typedef unsigned u32x4 __attribute__((ext_vector_type(4)));
typedef unsigned u32x2 __attribute__((ext_vector_type(2)));
typedef __bf16 bf16x2_t __attribute__((ext_vector_type(2)));

DI unsigned cvtpk(float lo, float hi) { f32x2 v = {lo, hi}; bf16x2_t b = __builtin_convertvector(v, bf16x2_t); return __builtin_bit_cast(unsigned, b); }
DI bf16 f2bf(float f) { return (bf16)(cvtpk(f, 0.f) & 0xffffu); }
DI float bf2f(unsigned short h) { return __uint_as_float((unsigned)h << 16); }
DI float bflo(unsigned w) { return __uint_as_float(w << 16); }
DI float bfhi(unsigned w) { return __uint_as_float(w & 0xffff0000u); }
DI u32x4 pack8f(f32x4 a, f32x4 b) { u32x4 w; w.x = cvtpk(a[0], a[1]); w.y = cvtpk(a[2], a[3]); w.z = cvtpk(b[0], b[1]); w.w = cvtpk(b[2], b[3]); return w; }
DI float frcp_(float x) { return __builtin_amdgcn_rcpf(x); }
DI float sigmoidf_(float x) { return frcp_(1.0f + __builtin_amdgcn_exp2f(x * -1.4426950408889634f)); }
DI float siluf_(float x) { return x * sigmoidf_(x); }
DI int pos_of_d(int d) { const int dd = d & 31; return 8 * (dd >> 2) + (dd & 3) + ((d >> 5) << 2); }
DI int d_of_pos(int p) { const int j = p & 7; return 4 * (p >> 3) + (j & 3) + ((j >> 2) << 5); }
namespace pg8 {
#define PG8_LAS __attribute__((address_space(3)))
typedef unsigned short bf16_t;
typedef short bf16x8 __attribute__((ext_vector_type(8)));
typedef float f32x4 __attribute__((ext_vector_type(4)));
typedef unsigned u32x4 __attribute__((ext_vector_type(4)));
constexpr int BM = 256, BK = 64, HALF = 128, HTB = HALF * BK * 2  , STAGE_BYTES = 8 * HTB, NXCD = 8, WGM = 8;

__host__ __device__ __forceinline__ int lds_byte(int r, int c) { const int st = (r >> 4) * 2 + (c >> 5), rr = r & 15, cc = c & 31, ob = rr * 64 + cc * 2; return st * 1024 + (ob ^ (((ob >> 9) & 1) << 5)); }
__host__ __device__ __forceinline__ void stage_rc(int b, int& R, int& C) { const int st = b / 1024, sb = b % 1024, swz = sb ^ (((sb >> 9) & 1) << 5); R = (st >> 1) * 16 + swz / 64; C = (st & 1) * 32 + (swz % 64) / 2; }
__host__ __device__ __forceinline__ int perm32(int rho) { const int n = rho >> 4, i = rho & 15; return 8 * (i >> 2) + 4 * n + (i & 3); }

struct Unit { int pm, pn; };
struct Gemm { const bf16_t* A; const bf16_t* Bt; int M, N, K; };

struct StaticOrder {
    int nM, nN, nwg, G, c;
    __host__ __device__ void init(int M, int N, int G_, int c_) { nM = M / BM; nN = N / BM; nwg = nM * nN; G = G_; c = c_; }
    __host__ __device__ bool next(int i, Unit& u) const {
        const long L = (long)i * G + c; if (L >= nwg) return false;
        int wgid = (int)L; { const int q = nwg / NXCD, r = nwg % NXCD, xcd = wgid % NXCD, off = wgid / NXCD; wgid = (xcd < r ? xcd * (q + 1) : r * (q + 1) + (xcd - r) * q) + off; }
        const int nig = WGM * nN, gid = wgid / nig, fm = gid * WGM, gsz = (nM - fm) < WGM ? (nM - fm) : WGM;
        u.pm = fm + ((wgid % nig) % gsz); u.pn = (wgid % nig) / gsz; return true;
    }
    __device__ __forceinline__ void a_ready(const Unit&) const {}
    __device__ __forceinline__ void done(const Unit&) const {}
};

__device__ __forceinline__ void urow_info(int urow, int& kind, int& b, int& t, int& ridx) {
    if (urow < MP) { b = urow / TP; t = urow - b * TP; kind = 0; ridx = t; }
    else if (urow < MU) { const int s = urow - MP; b = s >> 2; t = s & 3; kind = 1; ridx = TP + t; }
    else { kind = 2; b = 0; t = 0; ridx = 0; }
}
__device__ __forceinline__ int crow_to_urow(int crow) { return crow < NBATCH * SEQ ? crow + NMETA * ((crow >> 12) + 1) : MP + (crow - NBATCH * SEQ); }

struct EpiInProj {
    static constexpr bool PERM = true, AFTER_DRAIN = false;
    bf16_t *QA, *KV, *QKVB, *Z, *G; const float *COS, *SIN; float* out;
    __device__ __forceinline__ void operator()(const f32x4 (&acc)[2][2][4][2], const Unit& u, int wr, int wc, int fr, int fq) const {
        const int pn = u.pn;
#pragma unroll
        for (int ai = 0; ai < 2; ++ai)
#pragma unroll
            for (int m = 0; m < 4; ++m) {
                const int row = u.pm * BM + ai * HALF + wr * 64 + m * 16 + fr;
                int kind, b, t, ridx; urow_info(row, kind, b, t, ridx);
#pragma unroll
                for (int bj = 0; bj < 2; ++bj) {
                    const int cl = bj * HALF + wc * 32 + 8 * fq;
                    const f32x4 v0 = acc[ai][bj][m][0], v1 = acc[ai][bj][m][1];
                    if (pn < 2) {
                        const int c = pn * 256 + cl, d0 = ((c & 63) >> 3) * 4;
                        const f32x4 cs = *(const f32x4*)(COS + ridx * 32 + d0), sn = *(const f32x4*)(SIN + ridx * 32 + d0);
                        const f32x4 o1 = (v0 * cs - v1 * sn) * QSCALE, o2 = (v1 * cs + v0 * sn) * QSCALE;
                        *(u32x4*)(QA + (size_t)row * 512 + c) = pack8f(o1, o2);
                    } else if (pn == 2) {
                        if (bj == 0) {
                            const int kh = cl >> 6, d0 = ((cl & 63) >> 3) * 4;
                            const f32x4 cs = *(const f32x4*)(COS + ridx * 32 + d0), sn = *(const f32x4*)(SIN + ridx * 32 + d0);
                            const f32x4 o1 = v0 * cs - v1 * sn, o2 = v1 * cs + v0 * sn;
                            *(u32x4*)(KV + (size_t)row * 256 + cl) = pack8f(o1, o2);
                            float* dst = nullptr;
                            if (kind == 0 && t >= TP - 128) dst = out + O_KP + ((size_t)(b * 128 + (t - (TP - 128))) * 2 + kh) * 64;
                            else if (kind == 1) dst = out + O_KS + ((size_t)(b * 128 + 124 + t) * 2 + kh) * 64;
                            if (dst) { *(f32x4*)(dst + d0) = o1; *(f32x4*)(dst + 32 + d0) = o2; }
                        } else {
                            const int cv = cl - 128, kh = cv >> 6, dd = cv & 63;
                            *(u32x4*)(KV + (size_t)row * 256 + cl) = pack8f(v0, v1);
                            float* dst = nullptr;
                            if (kind == 0 && t >= TP - 128) dst = out + O_VP + ((size_t)(b * 128 + (t - (TP - 128))) * 2 + kh) * 64;
                            else if (kind == 1) dst = out + O_VS + ((size_t)(b * 128 + 124 + t) * 2 + kh) * 64;
                            if (dst) { *(f32x4*)(dst + dd) = v0; *(f32x4*)(dst + dd + 4) = v1; }
                        }
                    } else if (pn < 9) {
                        const int c = (pn - 3) * 256 + cl;
                        *(u32x4*)(QKVB + (size_t)row * 1536 + c) = pack8f(v0, v1);
                        float* dst = nullptr;
                        if (kind == 0 && t >= TP - 3) dst = out + O_CP + ((size_t)b * 3 + (t - (TP - 3))) * 1536;
                        else if (kind == 1 && t >= 1) dst = out + O_CS + ((size_t)b * 3 + (t - 1)) * 1536;
                        if (dst) { *(f32x4*)(dst + c) = v0; *(f32x4*)(dst + c + 4) = v1; }
                    } else if (pn < 11) {
                        const int c = (pn - 9) * 256 + cl;
                        *(u32x4*)(Z + (size_t)row * 512 + c) = pack8f(v0, v1);
                    } else {
                        const int c = (pn - 11) * 256 + cl;
                        f32x4 g0, g1;
#pragma unroll
                        for (int e = 0; e < 4; ++e) { g0[e] = sigmoidf_(v0[e]); g1[e] = sigmoidf_(v1[e]); }
                        *(u32x4*)(G + (size_t)row * 2048 + c) = pack8f(g0, g1);
                    }
                }
            }
    }
};

template <bool ACCUM> struct EpiMerge {
    static constexpr bool PERM = true, AFTER_DRAIN = false;
    bf16_t* MBp; const bf16_t* G; int gate_off;
    __device__ __forceinline__ void operator()(const f32x4 (&acc)[2][2][4][2], const Unit& u, int wr, int wc, int fr, int fq) const {
#pragma unroll
        for (int ai = 0; ai < 2; ++ai)
#pragma unroll
            for (int m = 0; m < 4; ++m) {
                const int crow = u.pm * BM + ai * HALF + wr * 64 + m * 16 + fr, urow = crow_to_urow(crow);
#pragma unroll
                for (int bj = 0; bj < 2; ++bj) {
                    const int c = u.pn * BM + bj * HALF + wc * 32 + 8 * fq;
                    const u32x4 gw = *(const u32x4*)(G + (size_t)urow * 2048 + gate_off + c);
                    f32x4 v0 = acc[ai][bj][m][0], v1 = acc[ai][bj][m][1];
                    v0[0] *= bflo(gw.x); v0[1] *= bfhi(gw.x); v0[2] *= bflo(gw.y); v0[3] *= bfhi(gw.y);
                    v1[0] *= bflo(gw.z); v1[1] *= bfhi(gw.z); v1[2] *= bflo(gw.w); v1[3] *= bfhi(gw.w);
                    bf16_t* p = MBp + (size_t)crow * 1024 + c;
                    if (ACCUM) { const u32x4 pw = *(const u32x4*)p;
                        v0[0] += bflo(pw.x); v0[1] += bfhi(pw.x); v0[2] += bflo(pw.y); v0[3] += bfhi(pw.y);
                        v1[0] += bflo(pw.z); v1[1] += bfhi(pw.z); v1[2] += bflo(pw.w); v1[3] += bfhi(pw.w); }
                    *(u32x4*)p = pack8f(v0, v1);
                }
            }
    }
};

template <bool ATOM = true> struct EpiWout {
    static constexpr bool PERM = true, AFTER_DRAIN = false;
    const float* xp; const float* xs; float* H; bf16_t* HB; float* SS;
    __device__ __forceinline__ void operator()(const f32x4 (&acc)[2][2][4][2], const Unit& u, int wr, int wc, int fr, int fq) const {
#pragma unroll
        for (int ai = 0; ai < 2; ++ai)
#pragma unroll
            for (int m = 0; m < 4; ++m) {
                const int crow = u.pm * BM + ai * HALF + wr * 64 + m * 16 + fr;
                const float* hs = crow < NBATCH * SEQ ? xp + (size_t)crow * D : xs + (size_t)(crow - NBATCH * SEQ) * D;
                float ss = 0.f;
#pragma unroll
                for (int bj = 0; bj < 2; ++bj) {
                    const int c = u.pn * BM + bj * HALF + wc * 32 + 8 * fq;
                    const f32x4 r0 = *(const f32x4*)(hs + c) + acc[ai][bj][m][0], r1 = *(const f32x4*)(hs + c + 4) + acc[ai][bj][m][1];
                    *(f32x4*)(H + (size_t)crow * D + c) = r0; *(f32x4*)(H + (size_t)crow * D + c + 4) = r1;
                    *(u32x4*)(HB + (size_t)crow * D + c) = pack8f(r0, r1);
                    ss += (r0[0] * r0[0] + r0[1] * r0[1]) + (r0[2] * r0[2] + r0[3] * r0[3]) + (r1[0] * r1[0] + r1[1] * r1[1]) + (r1[2] * r1[2] + r1[3] * r1[3]);
                }
                ss += __shfl_xor(ss, 16); ss += __shfl_xor(ss, 32);
                if (ATOM && fq == 0) atomicAdd(SS + crow, ss);
            }
    }
};

struct EpiGateUp {
    static constexpr bool PERM = true, AFTER_DRAIN = false;
    bf16_t* ACT; const float* SS;
    __device__ __forceinline__ void operator()(const f32x4 (&acc)[2][2][4][2], const Unit& u, int wr, int wc, int fr, int fq) const {
#pragma unroll
        for (int ai = 0; ai < 2; ++ai)
#pragma unroll
            for (int m = 0; m < 4; ++m) {
                const int crow = u.pm * BM + ai * HALF + wr * 64 + m * 16 + fr;
                const float rstd = rsqrtf(SS[crow] * (1.0f / D) + EPS);
                f32x4 a[2];
#pragma unroll
                for (int n = 0; n < 2; ++n)
#pragma unroll
                    for (int e = 0; e < 4; ++e) { const float g = acc[ai][0][m][n][e] * rstd, up = acc[ai][1][m][n][e] * rstd; a[n][e] = siluf_(g) * up; }
                *(u32x4*)(ACT + (size_t)crow * DFF + u.pn * HALF + wc * 32 + 8 * fq) = pack8f(a[0], a[1]);
            }
    }
};

template <bool DRY = false> struct EpiDown {
    static constexpr bool PERM = true, AFTER_DRAIN = false;
    float* H;
    __device__ __forceinline__ void operator()(const f32x4 (&acc)[2][2][4][2], const Unit& u, int wr, int wc, int fr, int fq) const {
#pragma unroll
        for (int ai = 0; ai < 2; ++ai)
#pragma unroll
            for (int m = 0; m < 4; ++m) {
                const int crow = u.pm * BM + ai * HALF + wr * 64 + m * 16 + fr;
#pragma unroll
                for (int bj = 0; bj < 2; ++bj) {
                    float* p = H + (size_t)crow * D + u.pn * BM + bj * HALF + wc * 32 + 8 * fq;
                    const f32x4 r0 = *(const f32x4*)p + acc[ai][bj][m][0] * (DRY ? 0.f : 1.f), r1 = *(const f32x4*)(p + 4) + acc[ai][bj][m][1] * (DRY ? 0.f : 1.f);
                    *(f32x4*)p = r0; *(f32x4*)(p + 4) = r1;
                }
            }
    }
};
template <class Epi, class Sched, bool ALIGN_EPI = false, bool SP2 = false>
__device__ __forceinline__ void gemm_phase(PG8_LAS unsigned char* lds, const Gemm g, const Sched& S, const Epi& E) {
    const int tid = threadIdx.x, wid = __builtin_amdgcn_readfirstlane(tid >> 6), lane = tid & 63, wr = wid >> 2, wc = wid & 3, fr = lane & 15, fq = lane >> 4;
    const int K = g.K, nt = K / BK;
    unsigned voffA[2], voffB[2];
#pragma unroll
    for (int i = 0; i < 2; ++i) { int R, C; stage_rc(tid * 16 + i * 8192, R, C); const int Rb = Epi::PERM ? ((R & ~31) + perm32(R & 31)) : R;
        voffA[i] = (unsigned)(R * K + C) * 2u; voffB[i] = (unsigned)(Rb * K + C) * 2u; }
    const size_t kstep = (size_t)(BK * 2);
    const size_t hstep = (size_t)HALF * K * 2;
    const size_t tstep = 2 * hstep;
    const unsigned ldsw = (unsigned)wid * 1024u;
    const int aoff = lds_byte(wr * 64 + fr, fq * 8), boff = lds_byte(wc * 32 + fr, fq * 8);
#define PG8_SA(b, h) (((b) * 2 + (h)) * HTB)
#define PG8_SB(b, h) ((4 + (b) * 2 + (h)) * HTB)
#define PG8_STAGE(bufoff, gbase, voff) do { _Pragma("unroll") for (int _i = 0; _i < 2; ++_i) \
        __builtin_amdgcn_global_load_lds((const unsigned*)((const char*)(gbase) + (voff)[_i]), (PG8_LAS unsigned*)(lds + (bufoff) + ldsw + _i * 8192), 16, 0, 0); } while (0)
#define PG8_LDA(dst, b, h) do { _Pragma("unroll") for (int m = 0; m < 4; ++m) _Pragma("unroll") for (int k = 0; k < 2; ++k) dst[m][k] = *(const PG8_LAS bf16x8*)(lds + PG8_SA(b, h) + aoff + m * 2048 + k * 1024); } while (0)
#define PG8_LDB(dst, b, h) do { _Pragma("unroll") for (int n = 0; n < 2; ++n) _Pragma("unroll") for (int k = 0; k < 2; ++k) dst[n][k] = *(const PG8_LAS bf16x8*)(lds + PG8_SB(b, h) + boff + n * 2048 + k * 1024); } while (0)
#define PG8_MMA(ai, bj, At, Bt) do { __builtin_amdgcn_s_setprio(1); _Pragma("unroll") for (int m = 0; m < 4; ++m) _Pragma("unroll") for (int n = 0; n < 2; ++n) _Pragma("unroll") for (int k = 0; k < 2; ++k) \
        acc[ai][bj][m][n] = __builtin_amdgcn_mfma_f32_16x16x32_bf16(Bt[n][k], At[m][k], acc[ai][bj][m][n], 0, 0, 0); __builtin_amdgcn_s_setprio(0); } while (0)
#define PG8_WAIT_V(n) asm volatile("s_waitcnt vmcnt(" #n ")" ::: "memory")
#define PG8_WAIT_L(n) asm volatile("s_waitcnt lgkmcnt(" #n ")" ::: "memory")
#define PG8_BAR __builtin_amdgcn_s_barrier()
#define PG8_SCHED __builtin_amdgcn_sched_barrier(0)
    Unit cur, nxt; int ui = 0;
    if (!S.next(0, cur)) return;
    f32x4 acc[2][2][4][2];
#pragma unroll
    for (int a = 0; a < 2; ++a)
#pragma unroll
        for (int b = 0; b < 2; ++b)
#pragma unroll
            for (int m = 0; m < 4; ++m)
#pragma unroll
                for (int n = 0; n < 2; ++n) acc[a][b][m][n] = (f32x4){0.f, 0.f, 0.f, 0.f};
    bf16x8 At[4][2], B0[2][2], B1[2][2];
    const char* cA = (const char*)g.A + (size_t)cur.pm * tstep; const char* cB = (const char*)g.Bt + (size_t)cur.pn * tstep;
    S.a_ready(cur);
    if constexpr (SP2) {
        PG8_STAGE(PG8_SB(0, 0), cB, voffB); PG8_STAGE(PG8_SB(0, 1), cB + hstep, voffB); PG8_STAGE(PG8_SA(0, 0), cA, voffA); PG8_STAGE(PG8_SA(0, 1), cA + hstep, voffA);
        if (wr == 1) PG8_BAR;
        PG8_WAIT_V(2); PG8_BAR;
        PG8_STAGE(PG8_SB(1, 0), cB + kstep, voffB); PG8_STAGE(PG8_SA(1, 0), cA + kstep, voffA); PG8_STAGE(PG8_SB(1, 1), cB + hstep + kstep, voffB);
        PG8_WAIT_V(6); PG8_BAR;
    } else {
        PG8_STAGE(PG8_SB(0, 0), cB, voffB); PG8_STAGE(PG8_SA(0, 0), cA, voffA); PG8_STAGE(PG8_SB(0, 1), cB + hstep, voffB); PG8_STAGE(PG8_SA(0, 1), cA + hstep, voffA);
        if (wr == 1) PG8_BAR;
        PG8_WAIT_V(4); PG8_BAR;
        PG8_STAGE(PG8_SB(1, 0), cB + kstep, voffB); PG8_STAGE(PG8_SA(1, 0), cA + kstep, voffA); PG8_STAGE(PG8_SB(1, 1), cB + hstep + kstep, voffB);
        PG8_WAIT_V(6); PG8_BAR;
    }
    for (;;) {
        const bool has_next = S.next(ui + 1, nxt);
        const char* nA = has_next ? (const char*)g.A + (size_t)nxt.pm * tstep : cA; const char* nB = has_next ? (const char*)g.Bt + (size_t)nxt.pn * tstep : cB;
        for (int t = 0; t < nt; t += 2) {
            const bool last = (t == nt - 2);
            const char* a1 = cA + (size_t)(t + 1) * kstep;
            const char* a2 = last ? nA : cA + (size_t)(t + 2) * kstep; const char* b2 = last ? nB : cB + (size_t)(t + 2) * kstep;
            const char* a3 = a2 + kstep; const char* b3 = b2 + kstep;
            if (last && has_next) S.a_ready(nxt);
            if constexpr (SP2) {
            PG8_LDB(B0, 0, 0); PG8_LDB(B1, 0, 1); PG8_SCHED; PG8_LDA(At, 0, 0); PG8_STAGE(PG8_SA(1, 1), a1 + hstep, voffA);
            PG8_WAIT_V(8); PG8_WAIT_L(0); PG8_BAR; PG8_MMA(0, 0, At, B0); PG8_MMA(0, 1, At, B1); PG8_BAR; PG8_SCHED;
            PG8_LDA(At, 0, 1); PG8_STAGE(PG8_SB(0, 0), b2, voffB); PG8_STAGE(PG8_SB(0, 1), b2 + hstep, voffB); PG8_STAGE(PG8_SA(0, 0), a2, voffA);
            PG8_WAIT_V(8); PG8_WAIT_L(0); PG8_BAR; PG8_MMA(1, 0, At, B0); PG8_MMA(1, 1, At, B1); PG8_BAR; PG8_SCHED;
            PG8_LDB(B0, 1, 0); PG8_LDB(B1, 1, 1); PG8_SCHED; PG8_LDA(At, 1, 0); PG8_STAGE(PG8_SA(0, 1), a2 + hstep, voffA);
            PG8_WAIT_V(8); PG8_WAIT_L(0); PG8_BAR; PG8_MMA(0, 0, At, B0); PG8_MMA(0, 1, At, B1); PG8_BAR; PG8_SCHED;
            PG8_LDA(At, 1, 1); PG8_STAGE(PG8_SB(1, 0), b3, voffB); PG8_STAGE(PG8_SB(1, 1), b3 + hstep, voffB); PG8_STAGE(PG8_SA(1, 0), a3, voffA);
            PG8_WAIT_V(8); PG8_WAIT_L(0); PG8_BAR; PG8_MMA(1, 0, At, B0); PG8_MMA(1, 1, At, B1); PG8_BAR; PG8_SCHED;
            } else {
            PG8_LDB(B0, 0, 0); PG8_SCHED; PG8_LDA(At, 0, 0); PG8_STAGE(PG8_SA(1, 1), a1 + hstep, voffA);
            PG8_WAIT_L(8); PG8_BAR; PG8_WAIT_L(0); PG8_MMA(0, 0, At, B0); PG8_BAR; PG8_SCHED;
            PG8_LDB(B1, 0, 1); PG8_STAGE(PG8_SB(0, 0), b2, voffB);
            PG8_BAR; PG8_WAIT_L(0); PG8_MMA(0, 1, At, B1); PG8_BAR;
            PG8_LDA(At, 0, 1); PG8_STAGE(PG8_SA(0, 0), a2, voffA);
            PG8_BAR; PG8_WAIT_L(0); PG8_MMA(1, 0, At, B0); PG8_BAR; PG8_SCHED;
            PG8_STAGE(PG8_SB(0, 1), b2 + hstep, voffB);
            PG8_WAIT_V(6); PG8_BAR; PG8_MMA(1, 1, At, B1); PG8_BAR;
            PG8_LDB(B0, 1, 0); PG8_SCHED; PG8_LDA(At, 1, 0); PG8_STAGE(PG8_SA(0, 1), a2 + hstep, voffA);
            PG8_WAIT_L(8); PG8_BAR; PG8_WAIT_L(0); PG8_MMA(0, 0, At, B0); PG8_BAR; PG8_SCHED;
            PG8_LDB(B1, 1, 1); PG8_STAGE(PG8_SB(1, 0), b3, voffB);
            PG8_BAR; PG8_WAIT_L(0); PG8_MMA(0, 1, At, B1); PG8_BAR;
            PG8_LDA(At, 1, 1); PG8_STAGE(PG8_SA(1, 0), a3, voffA);
            PG8_BAR; PG8_WAIT_L(0); PG8_MMA(1, 0, At, B0); PG8_BAR; PG8_SCHED;
            PG8_STAGE(PG8_SB(1, 1), b3 + hstep, voffB);
            PG8_WAIT_V(6); PG8_BAR; PG8_MMA(1, 1, At, B1); PG8_BAR;
            }
        }
        if constexpr (ALIGN_EPI) { if (wr == 0) PG8_BAR; }
        if constexpr (!Epi::AFTER_DRAIN) { E(acc, cur, wr, wc, fr, fq); S.done(cur); }
        if (!has_next) break;
#pragma unroll
        for (int a = 0; a < 2; ++a)
#pragma unroll
            for (int b = 0; b < 2; ++b)
#pragma unroll
                for (int m = 0; m < 4; ++m)
#pragma unroll
                    for (int n = 0; n < 2; ++n) acc[a][b][m][n] = (f32x4){0.f, 0.f, 0.f, 0.f};
        cur = nxt; cA = nA; cB = nB; ++ui;
        if constexpr (ALIGN_EPI) { if (wr == 1) PG8_BAR; }
    }
    PG8_WAIT_V(0);
    if constexpr (!ALIGN_EPI) { if (wr == 0) PG8_BAR; }
    PG8_BAR;
    if constexpr (Epi::AFTER_DRAIN) { E.fused(acc, cur, wr, wc, fr, fq, lds, wid, lane); S.done(cur); }
#undef PG8_SA
#undef PG8_SB
#undef PG8_STAGE
#undef PG8_LDA
#undef PG8_LDB
#undef PG8_MMA
#undef PG8_WAIT_V
#undef PG8_WAIT_L
#undef PG8_BAR
#undef PG8_SCHED
}
}
constexpr int NWAVES = 8, NTHREADS = NWAVES * 64;
constexpr int LDS_BYTES = 147456;
constexpr int LDS_MISC = 131072;
constexpr int N_PHASES = 9;

struct Args {
    const float *x_prompt, *x_sample, *cache_k, *cache_v, *state_delta, *state_conv, *meta, *norm_mix, *w_in, *conv_w, *a_log, *dt_bias, *sinks, *gdn_norm,
                *w_oa, *w_ob, *w_out, *norm_ffn, *w_gate, *w_up, *w_down, *norm_final;
    float* out; unsigned char* ws; int ph_lo, ph_hi;
};

typedef const __attribute__((address_space(4))) Args* KA;
DI KA kargs() { KA p = (KA)__builtin_amdgcn_kernarg_segment_ptr(); asm volatile("" : "+s"(p)); return p; }
#define RLX_AGENT __ATOMIC_RELAXED, __HIP_MEMORY_SCOPE_AGENT
#define LDS_WAIT() asm volatile("s_waitcnt lgkmcnt(0)" ::: "memory")
#define MFMA32(a, b, c) __builtin_amdgcn_mfma_f32_32x32x16_bf16((a), (b), (c), 0, 0, 0)
DI int crow16(int reg, int h) { return (reg & 3) + 8 * (reg >> 2) + 4 * h; }
DI float wave_sum(float v) {
#pragma unroll
    for (int o = 1; o < 64; o <<= 1) v += __shfl_xor(v, o);
    return v;
}
DI float wave_max(float v) {
#pragma unroll
    for (int o = 1; o < 64; o <<= 1) v = fmaxf(v, __shfl_xor(v, o));
    return v;
}
template <int S> DI bf16x8 pack_step(const f32x16& x) {
    u32x4 p; p.x = cvtpk(x[8 * S], x[8 * S + 1]); p.y = cvtpk(x[8 * S + 2], x[8 * S + 3]); p.z = cvtpk(x[8 * S + 4], x[8 * S + 5]); p.w = cvtpk(x[8 * S + 6], x[8 * S + 7]);
    return __builtin_bit_cast(bf16x8, p);
}
DI int frag_idx(int row, int k, int NKS) { const int kkk = k & 15; return (((row >> 5) * NKS + (k >> 4)) * 64 + (row & 31) + 32 * ((kkk >> 2) & 1)) * 8 + (((kkk >> 3) << 2) | (kkk & 3)); }
DI unsigned char* slot_ptr(KA A, int item) { return item < PREP_N1 ? A->ws + WS_B + (size_t)item * PREP_SLOT : (unsigned char*)A->out + (size_t)(item - PREP_N1) * PREP_SLOT; }

#define XB_TMO      128
#define XB_XCNT(j)  (256  + 64 * (j))
#define XB_XSUB(j)  (1280 + 64 * (j))
#define XB_XGEN(j)  (2304 + 64 * (j))
#define XB_TOP      3328
#define XB_TOPGEN   3392
#define XCD_BAR_WORDS 3456
#define XB_SPIN_CAP (1u << 20)
DI unsigned xb_ld(unsigned* p)              { return __hip_atomic_load(p, __ATOMIC_RELAXED, __HIP_MEMORY_SCOPE_AGENT); }
DI unsigned xb_add(unsigned* p, unsigned v) { return __hip_atomic_fetch_add(p, v, __ATOMIC_RELAXED, __HIP_MEMORY_SCOPE_AGENT); }
DI unsigned xb_xcc_id() { return (unsigned)__builtin_amdgcn_s_getreg((3 << 11) | 20) & 0xFu; }
#define XB_SPIN(cond, bar) do { unsigned _sp = 0; while (cond) { __builtin_amdgcn_s_sleep(1); \
    if ((++_sp & 255u) == 0u) { if (xb_ld(&(bar)[XB_TMO])) break; if (_sp > XB_SPIN_CAP) { atomicAdd(&(bar)[XB_TMO], 1u); break; } } } } while (0)
struct XcdBarrier { unsigned* bar; unsigned x; volatile LAS unsigned* st; };
DI XcdBarrier xcd_barrier_post(unsigned* bar, volatile LAS unsigned* st) {
    XcdBarrier b; b.bar = bar; b.x = xb_xcc_id(); b.st = st;
    if (threadIdx.x == 0) (void)xb_add(&bar[XB_XCNT(b.x)], 1u);
    return b;
}
DI void xcd_barrier_complete(unsigned* bar, unsigned x, unsigned& nloc, unsigned& nx) {
    const unsigned G = gridDim.x * gridDim.y * gridDim.z;
    unsigned sum, cnt, mine, sp = 0u;
    for (;;) {
        sum = 0u; cnt = 0u; mine = 0u;
#pragma unroll
        for (unsigned j = 0; j < 16; ++j) { const unsigned c = xb_ld(&bar[XB_XCNT(j)]); sum += c; cnt += (c > 0u) ? 1u : 0u; mine = (j == x) ? c : mine; }
        if (sum == G) break;
        __builtin_amdgcn_s_sleep(1);
        if ((++sp & 255u) == 0u) { if (xb_ld(&bar[XB_TMO])) break; if (sp > XB_SPIN_CAP) { atomicAdd(&bar[XB_TMO], 1u); break; } }
    }
    nloc = mine > 0u ? mine : 1u; nx = cnt > 0u ? cnt : 1u;
}
DI void xcd_barrier(const XcdBarrier& b) {
    asm volatile("s_waitcnt vmcnt(0)" ::: "memory");
    __syncthreads();
    if (threadIdx.x == 0) {
        unsigned* bar = b.bar;
        __builtin_amdgcn_s_waitcnt(0);
        unsigned nloc = b.st[0], nx = b.st[1];
        if (nloc == 0u) { xcd_barrier_complete(bar, b.x, nloc, nx); b.st[0] = nloc; b.st[1] = nx; }
        const unsigned old = xb_add(&bar[XB_XSUB(b.x)], 1u);
        const unsigned gen = old / nloc;
        if (old + 1u == (gen + 1u) * nloc) {
            __builtin_amdgcn_fence(__ATOMIC_RELEASE, "agent");
            asm volatile("s_waitcnt vmcnt(0)" ::: "memory");
            const unsigned og = xb_add(&bar[XB_TOP], 1u);
            const unsigned tg = og / nx;
            if (og + 1u == (tg + 1u) * nx) xb_add(&bar[XB_TOPGEN], 1u);
            else XB_SPIN(xb_ld(&bar[XB_TOPGEN]) == tg, bar);
            __builtin_amdgcn_fence(__ATOMIC_ACQUIRE, "agent");
            xb_add(&bar[XB_XGEN(b.x)], 1u);
            asm volatile("s_waitcnt vmcnt(0)" ::: "memory");
        } else {
            XB_SPIN(xb_ld(&bar[XB_XGEN(b.x)]) == gen, bar);
            __builtin_amdgcn_fence(__ATOMIC_ACQUIRE, "agent");
            asm volatile("s_waitcnt vmcnt(0)" ::: "memory");
        }
    }
    __syncthreads();
}

template <class RowMap> DI void transpose_item(const float* W, int K, int N, bf16* WT, RowMap rm, const float* kscale, LAS float* scr, int item, int lane) {
    const int nblk = (N + 31) / 32, kb = item / nblk, nb = item - kb * nblk, k0 = 64 * kb, n0 = 32 * nb;
    const int ncol = n0 + (lane & 31);
#pragma unroll 8
    for (int i = 0; i < 32; ++i) { const int kk = 2 * i + (lane >> 5);
        float v = ncol < N ? W[(size_t)(k0 + kk) * N + ncol] : 0.f;
        if (kscale) v *= kscale[k0 + kk];
        scr[kk * 33 + (lane & 31)] = v; }
    LDS_WAIT(); asm volatile("" ::: "memory");
    const int c = lane & 7;
#pragma unroll
    for (int j = 0; j < 4; ++j) { const int n = (lane >> 3) + 8 * j; const LAS float* s = scr + (8 * c) * 33 + n;
        const int nsrc = n0 + n; const int drow = nsrc < N ? rm(nsrc) : -1;
        u32x4 o; o.x = cvtpk(s[0 * 33], s[1 * 33]); o.y = cvtpk(s[2 * 33], s[3 * 33]); o.z = cvtpk(s[4 * 33], s[5 * 33]); o.w = cvtpk(s[6 * 33], s[7 * 33]);
        if (drow >= 0) *(u32x4*)(WT + (size_t)drow * K + k0 + 8 * c) = o; }
    LDS_WAIT(); asm volatile("" ::: "memory");
}
DI float softplusf_(float x) { return x > 20.f ? x : log1pf(__expf(x)); }

#ifndef PROBE_REP
#define PROBE_REP -1
#endif
DI void p0_prologue(KA A, LAS unsigned char* lds) {
    const int tid = threadIdx.x, lane = tid & 63, wave = __builtin_amdgcn_readfirstlane(tid >> 6);
    const int G = gridDim.x, gw = blockIdx.x * NWAVES + wave, NGW = G * NWAVES;
    const int gt = blockIdx.x * NTHREADS + tid, NGT = G * NTHREADS;
    unsigned char* ws = A->ws;
    for (int rep = 0; rep < (PROBE_REP == 1001 ? 2 : 1); ++rep) {
        LAS float* scr = (LAS float*)(lds + wave * 16384);
        constexpr int I_IN = 16 * 153, I_OA = 8 * 32, I_OUT = 16 * 32, I_G = 16 * 88, I_D = 44 * 32;
        constexpr int NIT = I_IN + 2 * I_OA + I_OUT + 2 * I_G + I_D;
        for (int it = gw; it < NIT; it += NGW) {
            int r = it;
            if (r < I_IN) { transpose_item(A->w_in, 1024, NIN_SRC, (bf16*)(ws + WS_WIN), [](int c) -> int {
                    if (c < 640) return (c & ~63) + pos_of_d(c & 63);
                    if (c < 2816) return c;
                    if (c < 2824) return -1;
                    return c - 8; }, nullptr, scr, r, lane); continue; } r -= I_IN;
            if (r < I_OA) { transpose_item(A->w_oa, 512, 1024, (bf16*)(ws + WS_WOA), [](int c) -> int { return c; }, nullptr, scr, r, lane); continue; } r -= I_OA;
            if (r < I_OA) { transpose_item(A->w_ob, 512, 1024, (bf16*)(ws + WS_WOB), [](int c) -> int { return c; }, nullptr, scr, r, lane); continue; } r -= I_OA;
            if (r < I_OUT) { transpose_item(A->w_out, 1024, 1024, (bf16*)(ws + WS_WOUT), [](int c) -> int { return c; }, nullptr, scr, r, lane); continue; } r -= I_OUT;
            if (r < I_G) { transpose_item(A->w_gate, 1024, DFF, (bf16*)(ws + WS_WGU), [](int c) -> int { return 256 * (c >> 7) + (c & 127); }, A->norm_ffn, scr, r, lane); continue; } r -= I_G;
            if (r < I_G) { transpose_item(A->w_up, 1024, DFF, (bf16*)(ws + WS_WGU), [](int c) -> int { return 256 * (c >> 7) + 128 + (c & 127); }, A->norm_ffn, scr, r, lane); continue; } r -= I_G;
            transpose_item(A->w_down, DFF, 1024, (bf16*)(ws + WS_WD), [](int c) -> int { return c; }, nullptr, scr, r, lane);
        }
    }
    for (int rep = 0; rep < (PROBE_REP == 1002 ? 2 : 1); ++rep) {
        float* COS = (float*)(ws + WS_ROPE); float* SIN = COS + (TP + TS) * 32;
        for (int i = gt; i < (TP + TS) * 32; i += NGT) { const int ri = i >> 5, f = i & 31; const double pos = ri < TP ? (double)ri : (double)(PAST + ri - TP);
            const double inv = exp2(-(double)f * (13.287712379549449 / 32.0)), ang = pos * inv; COS[i] = (float)cos(ang); SIN[i] = (float)sin(ang); }
        float* SS1 = (float*)(ws + WS_SS1);
        for (int i = gt; i < MC; i += NGT) SS1[i] = 0.f;
        constexpr int PERB = 124 * 128 / 4;
        for (int i = gt; i < SBATCH * PERB; i += NGT) { const int b = i / PERB, o = i - b * PERB;
            ((f32x4*)(A->out + O_KS))[(size_t)b * 4096 + o] = ((const f32x4*)A->cache_k)[(size_t)b * 4096 + 128 + o];
            ((f32x4*)(A->out + O_VS))[(size_t)b * 4096 + o] = ((const f32x4*)A->cache_v)[(size_t)b * 4096 + 128 + o]; }
    }
    for (int rep = 0; rep < (PROBE_REP == 1003 ? 2 : 1); ++rep) {
        unsigned wab[16][4];
        f32x4 nm[4];
#pragma unroll
        for (int j = 0; j < 4; ++j) {
            nm[j] = ((const f32x4*)A->norm_mix)[lane + 64 * j];
#pragma unroll
            for (int e = 0; e < 4; ++e) { const float* p = A->w_in + (size_t)(4 * (lane + 64 * j) + e) * NIN_SRC + 2816;
                const f32x4 a = *(const f32x4*)p, b = *(const f32x4*)(p + 4);
                wab[j * 4 + e][0] = cvtpk(a[0], a[1]); wab[j * 4 + e][1] = cvtpk(a[2], a[3]); wab[j * 4 + e][2] = cvtpk(b[0], b[1]); wab[j * 4 + e][3] = cvtpk(b[2], b[3]); }
        }
        bf16* XN = (bf16*)(ws + WS_XN); f32x2* GB = (f32x2*)(ws + WS_GB);
        for (int urow = gw; urow < MUP; urow += NGW) {
            const float* src = nullptr;
            if (urow < MP) { const int b = urow / TP, t = urow - b * TP; src = t < NMETA ? A->meta + (size_t)t * D : A->x_prompt + ((size_t)b * SEQ + (t - NMETA)) * D; }
            else if (urow < MU) src = A->x_sample + (size_t)(urow - MP) * D;
            u32x2* o8 = (u32x2*)(XN + (size_t)urow * D) + lane;
            if (!src) {
#pragma unroll
                for (int j = 0; j < 4; ++j) o8[64 * j] = (u32x2){0u, 0u};
                if (lane < 4) GB[(size_t)urow * 4 + lane] = (f32x2){0.f, 0.f};
                continue; }
            f32x4 v[4]; float ss = 0.f;
#pragma unroll
            for (int j = 0; j < 4; ++j) { v[j] = ((const f32x4*)src)[lane + 64 * j]; ss += (v[j][0] * v[j][0] + v[j][1] * v[j][1]) + (v[j][2] * v[j][2] + v[j][3] * v[j][3]); }
            const float rstd = rsqrtf(wave_sum(ss) * (1.0f / D) + EPS);
            float dot[8];
#pragma unroll
            for (int c = 0; c < 8; ++c) dot[c] = 0.f;
#pragma unroll
            for (int j = 0; j < 4; ++j) { v[j] = v[j] * rstd * nm[j];
                o8[64 * j] = (u32x2){cvtpk(v[j][0], v[j][1]), cvtpk(v[j][2], v[j][3])};
#pragma unroll
                for (int e = 0; e < 4; ++e)
#pragma unroll
                    for (int c = 0; c < 4; ++c) { dot[2 * c] += v[j][e] * bflo(wab[j * 4 + e][c]); dot[2 * c + 1] += v[j][e] * bfhi(wab[j * 4 + e][c]); } }
#pragma unroll
            for (int c = 0; c < 8; ++c) dot[c] = wave_sum(dot[c]);
            if (lane < 4) {
                const float a = lane == 0 ? dot[0] : lane == 1 ? dot[1] : lane == 2 ? dot[2] : dot[3];
                const float bb = lane == 0 ? dot[4] : lane == 1 ? dot[5] : lane == 2 ? dot[6] : dot[7];
                const float g = -__expf(A->a_log[lane]) * softplusf_(a + A->dt_bias[lane]);
                GB[(size_t)urow * 4 + lane] = (f32x2){g, sigmoidf_(bb)};
            }
        }
    }
}
DI void item_decode(int item, int& b, int& h, bool& sample, int& t0, int& L) {
    if (item < N_ITEMS_P) { const int s = item / CHUNKS_P, c = item - s * CHUNKS_P; b = s >> 2; h = s & 3; sample = false; if (c == 0) { t0 = 0; L = NMETA; } else { t0 = NMETA + 64 * (c - 1); L = 64; } }
    else { const int s = item - N_ITEMS_P; b = s >> 2; h = s & 3; sample = true; t0 = 0; L = TS; }
}
#define LDS_BARRIER() do { asm volatile("s_waitcnt lgkmcnt(0)" ::: "memory"); __builtin_amdgcn_s_barrier(); asm volatile("" ::: "memory"); } while (0)
DI void st16_sc1(void* p, u32x4 v) { asm volatile("global_store_dwordx4 %0, %1, off sc1\n\ts_nop 1" :: "v"(p), "v"(v) : "memory"); }
DI void st2_sc1(void* p, unsigned v) { asm volatile("global_store_short %0, %1, off sc1\n\ts_nop 1" :: "v"(p), "v"(v) : "memory"); }
typedef GAS unsigned long long gu64;
constexpr size_t CTL_GRAN = 65536;
DI gu64* item_granule(KA A, int item) { return (gu64*)(A->ws + WS_CTL + CTL_GRAN + (size_t)item * 64); }
DI float wait_item(gu64* g) {
    unsigned long long x; unsigned spins = 0;
    for (;;) { x = __hip_atomic_load(g, __ATOMIC_RELAXED, __HIP_MEMORY_SCOPE_AGENT); if ((x >> 32) != 0ull) break; __builtin_amdgcn_s_sleep(4); if (++spins > (1u << 20)) break; }
    asm volatile("" ::: "memory");
    return __uint_as_float((unsigned)__builtin_amdgcn_readfirstlane((int)(unsigned)x));
}
constexpr int LDS_GCL = 139264;
constexpr int PITCH = 132;
DI bf16x8 frag_nat(const LAS float* src, int row, int k0) {
    const f32x4 lo = *(const LAS f32x4*)(src + row * PITCH + k0), hi = *(const LAS f32x4*)(src + row * PITCH + k0 + 4);
    return __builtin_bit_cast(bf16x8, pack8f(lo, hi));
}
struct S1Pre { u32x4 xr[11]; f32x4 w[4][2]; f32x2 gb; };
DI void stage1_issue(KA A, int item, S1Pre& P) {
    const int tid = threadIdx.x, lane = tid & 63, wave = __builtin_amdgcn_readfirstlane(tid >> 6);
    int b, h, t0, L; bool sample; item_decode(item, b, h, sample, t0, L);
    const bf16* QKVB = (const bf16*)(A->ws + WS_QKVB);
    const int cv = lane < 48 ? lane : 47, grp = cv >> 4, col0 = (cv & 15) * 8, r0 = wave * 8, cidx = grp * 512 + h * 128 + col0;
#pragma unroll
    for (int q = 0; q < 11; ++q) {
        const int i = r0 - 3 + q;
        long urow = sample ? (long)MP + b * TS + i : (long)b * TP + t0 + i;
        const bool ok = sample ? i >= 0 : t0 + i >= 0;
        if (!ok) urow = 0;
        P.xr[q] = *(const u32x4*)(QKVB + (size_t)urow * CONVD + cidx);
        if (!ok) P.xr[q] = (u32x4){0u, 0u, 0u, 0u};
    }
#pragma unroll
    for (int i = 0; i < 4; ++i) { P.w[i][0] = *(const f32x4*)(A->conv_w + i * CONVD + cidx); P.w[i][1] = *(const f32x4*)(A->conv_w + i * CONVD + cidx + 4); }
    P.gb = (f32x2){0.f, 0.f};
    if (wave == 7 && lane < L) { const int urow = sample ? MP + b * TS + lane : b * TP + t0 + lane; P.gb = ((const f32x2*)(A->ws + WS_GB))[(size_t)urow * 4 + h]; }
}
DI void prep_stage1(KA A, int item, int next_item, int bslot, float* ats, S1Pre& P, LAS unsigned char* ldsb) {
    const int tid = threadIdx.x, lane = tid & 63, wave = __builtin_amdgcn_readfirstlane(tid >> 6), r = lane & 31, hh = lane >> 5;
    int b, h, t0, L; bool sample; item_decode(item, b, h, sample, t0, L);
    LAS float* Qs = (LAS float*)ldsb; LAS float* Ks = Qs + 64 * PITCH; LAS float* Vs = Ks + 64 * PITCH; LAS float* gcs = Vs + 64 * PITCH; LAS float* betas = gcs + 64;
    unsigned char* slot = slot_ptr(A, item);
    {
        const int cv = lane < 48 ? lane : 47, grp = cv >> 4, col0 = (cv & 15) * 8, r0 = wave * 8, cidx = grp * 512 + h * 128 + col0;
        float xf[3][8];
#pragma unroll
        for (int q = 0; q < 3; ++q) { xf[q][0] = bflo(P.xr[q].x); xf[q][1] = bfhi(P.xr[q].x); xf[q][2] = bflo(P.xr[q].y); xf[q][3] = bfhi(P.xr[q].y);
                                      xf[q][4] = bflo(P.xr[q].z); xf[q][5] = bfhi(P.xr[q].z); xf[q][6] = bflo(P.xr[q].w); xf[q][7] = bfhi(P.xr[q].w); }
        if (sample && wave == 0) {
#pragma unroll
            for (int q = 0; q < 3; ++q) { const float* sp = A->state_conv + ((size_t)b * 3 + q) * CONVD + cidx; const f32x4 s0 = *(const f32x4*)sp, s1 = *(const f32x4*)(sp + 4);
                xf[q][0] = s0[0]; xf[q][1] = s0[1]; xf[q][2] = s0[2]; xf[q][3] = s0[3]; xf[q][4] = s1[0]; xf[q][5] = s1[1]; xf[q][6] = s1[2]; xf[q][7] = s1[3]; }
        }
        float w[4][8];
#pragma unroll
        for (int i = 0; i < 4; ++i) { w[i][0] = P.w[i][0][0]; w[i][1] = P.w[i][0][1]; w[i][2] = P.w[i][0][2]; w[i][3] = P.w[i][0][3]; w[i][4] = P.w[i][1][0]; w[i][5] = P.w[i][1][1]; w[i][6] = P.w[i][1][2]; w[i][7] = P.w[i][1][3]; }
        LAS float* dst = Qs + grp * 64 * PITCH + col0;
        const float nsc = grp == 0 ? 0.08838834764831845f : 1.0f;
#pragma unroll
        for (int q = 3; q < 11; ++q) {
            const int rr = r0 + q - 3;
            float x[8] = {bflo(P.xr[q].x), bfhi(P.xr[q].x), bflo(P.xr[q].y), bfhi(P.xr[q].y), bflo(P.xr[q].z), bfhi(P.xr[q].z), bflo(P.xr[q].w), bfhi(P.xr[q].w)};
            float v[8]; float ss = 0.f;
#pragma unroll
            for (int e = 0; e < 8; ++e) { const float y = w[0][e] * xf[0][e] + w[1][e] * xf[1][e] + w[2][e] * xf[2][e] + w[3][e] * x[e];
                v[e] = rr < L ? siluf_(y) : 0.f; ss += v[e] * v[e];
                xf[0][e] = xf[1][e]; xf[1][e] = xf[2][e]; xf[2][e] = x[e]; }
            ss += __shfl_xor(ss, 1); ss += __shfl_xor(ss, 2); ss += __shfl_xor(ss, 4); ss += __shfl_xor(ss, 8);
            const float sc = grp == 2 ? 1.0f : rsqrtf(ss + EPS) * nsc;
            if (lane < 48) { *(LAS f32x4*)(dst + rr * PITCH) = (f32x4){v[0] * sc, v[1] * sc, v[2] * sc, v[3] * sc}; *(LAS f32x4*)(dst + rr * PITCH + 4) = (f32x4){v[4] * sc, v[5] * sc, v[6] * sc, v[7] * sc}; }
        }
    }
    if (wave == 7) {
        float gc = P.gb[0];
#pragma unroll
        for (int o = 1; o < 64; o <<= 1) { const float t = __shfl_up(gc, o); if (lane >= o) gc += t; }
        gcs[lane] = gc; betas[lane] = P.gb[1];
        if (lane == 63) ((LAS float*)(ldsb + LDS_GCL))[bslot] = __expf(gc);
    }
    if (next_item < N_ITEMS) stage1_issue(A, next_item, P);
    LDS_BARRIER();
    if (wave < 6) {
        const bool isqk = wave >= 3; const int tsel = isqk ? wave - 3 : wave, ib = tsel == 0 ? 0 : 1, jb = tsel == 2 ? 1 : 0;
        const LAS float* Asrc = isqk ? Qs : Ks;
        f32x16 acc;
#pragma unroll
        for (int e = 0; e < 16; ++e) acc[e] = 0.f;
#pragma unroll
        for (int s = 0; s < 8; ++s) acc = MFMA32(frag_nat(Asrc, 32 * ib + r, 16 * s + 8 * hh), frag_nat(Ks, 32 * jb + r, 16 * s + 8 * hh), acc);
        const int j = 32 * jb + r; const float gcj = gcs[j];
        float* Aout = ats + (ib + jb) * 1024; bf16* QKD = (bf16*)(slot + SL_QKD);
        if (!isqk) {
#pragma unroll
            for (int g4 = 0; g4 < 4; ++g4) { f32x4 v;
#pragma unroll
                for (int e = 0; e < 4; ++e) { const int i = 32 * ib + 8 * g4 + 4 * hh + e; v[e] = i > j ? betas[i] * __expf(fminf(gcs[i] - gcj, 0.f)) * acc[4 * g4 + e] : 0.f; }
                *(f32x4*)(Aout + r * 32 + 8 * g4 + 4 * hh) = v; }
        } else {
#pragma unroll
            for (int reg = 0; reg < 16; ++reg) { const int i = 32 * ib + crow16(reg, hh); const float dec = __expf(fminf(gcs[i] - gcj, 0.f));
                st2_sc1(QKD + frag_idx(i, j, 4), (unsigned)f2bf(i >= j ? dec * acc[reg] : 0.f)); }
        }
    }
    const float gcl = gcs[63];
#pragma unroll 1
    for (int job = wave; job < 56; job += 8) {
        if (job < 32) {
            const bool isq = job >= 16; const int jj = job & 15, rb = jj >> 3, ks = jj & 7, row = 32 * rb + r, k0 = 16 * ks + 4 * hh;
            const LAS float* src = isq ? Qs : Ks; const float sc = isq ? __expf(gcs[row]) : betas[row] * __expf(gcs[row]);
            const f32x4 lo = *(const LAS f32x4*)(src + row * PITCH + k0) * sc, hi = *(const LAS f32x4*)(src + row * PITCH + k0 + 8) * sc;
            st16_sc1(slot + (isq ? SL_QE : SL_BEK) + ((rb * 8 + ks) * 64 + lane) * 16, pack8f(lo, hi));
        } else if (job < 48) {
            const int jj = job - 32, rb = jj >> 2, ks = jj & 3, dk = 32 * rb + r;
            f32x4 lo, hi;
#pragma unroll
            for (int e = 0; e < 4; ++e) { const int j0 = 16 * ks + 4 * hh + e, j1 = j0 + 8;
                lo[e] = Ks[j0 * PITCH + dk] * __expf(gcl - gcs[j0]); hi[e] = Ks[j1 * PITCH + dk] * __expf(gcl - gcs[j1]); }
            st16_sc1(slot + SL_KWT + ((rb * 4 + ks) * 64 + lane) * 16, pack8f(lo, hi));
        } else {
            const int q = job - 48, w = q >> 1, ib = q & 1, dv = 32 * w + r;
            float v[16];
#pragma unroll
            for (int reg = 0; reg < 16; ++reg) { const int i = 32 * ib + crow16(reg, hh); v[reg] = betas[i] * Vs[i * PITCH + dv]; }
            u32x4* dst = (u32x4*)(slot + SL_BV + ((w * 2 + ib) * 64 + lane) * 32);
            st16_sc1(dst, (u32x4){cvtpk(v[0], v[1]), cvtpk(v[2], v[3]), cvtpk(v[4], v[5]), cvtpk(v[6], v[7])});
            st16_sc1(dst + 1, (u32x4){cvtpk(v[8], v[9]), cvtpk(v[10], v[11]), cvtpk(v[12], v[13]), cvtpk(v[14], v[15])});
        }
    }
    LDS_BARRIER();
}
DI void prep_stage2(KA A, int item, float gcl, const float* ats, LAS float* M) {
    int lane = threadIdx.x & 63; asm volatile("" : "+v"(lane));
    const int r = lane & 31, hh = lane >> 5;
    unsigned char* slot = slot_ptr(A, item);
    const f32x4* Ain = (const f32x4*)ats;
#pragma unroll
    for (int tt = 0; tt < 3; ++tt) { const int jb = tt >> 1, ib = (tt + 1) >> 1;
#pragma unroll
        for (int q = 0; q < 4; ++q) { const int idx = q * 64 + lane, jj = idx >> 3, i4 = idx & 7;
            *(LAS f32x4*)(M + (32 * jb + jj) * 64 + 32 * ib + 4 * i4) = Ain[tt * 256 + idx]; } }
    LDS_WAIT(); asm volatile("" ::: "memory");
#pragma unroll 1
    for (int rb = 0; rb < 4; ++rb) {
        float acc[16];
#pragma unroll
        for (int i = 0; i < 16; ++i) acc[i] = lane == 16 * rb + i ? 1.f : 0.f;
#pragma unroll 2
        for (int j = 0; j < 16 * rb; ++j) {
            float tj = M[j * 64 + lane]; tj = lane <= j ? tj : 0.f;
            const LAS f32x4* ar = (const LAS f32x4*)(M + j * 64 + 16 * rb);
            const f32x4 a0 = ar[0], a1 = ar[1], a2 = ar[2], a3 = ar[3];
#pragma unroll
            for (int e = 0; e < 4; ++e) { acc[e] -= a0[e] * tj; acc[4 + e] -= a1[e] * tj; acc[8 + e] -= a2[e] * tj; acc[12 + e] -= a3[e] * tj; }
        }
#pragma unroll
        for (int j = 0; j < 16; ++j) {
            const float tj = acc[j]; const int row = 16 * rb + j;
            const LAS f32x4* ar = (const LAS f32x4*)(M + row * 64 + 16 * rb);
            float a[16];
#pragma unroll
            for (int q = j >> 2; q < 4; ++q) { const f32x4 v = ar[q]; a[4 * q] = v[0]; a[4 * q + 1] = v[1]; a[4 * q + 2] = v[2]; a[4 * q + 3] = v[3]; }
            if (lane <= row) M[row * 64 + lane] = tj;
#pragma unroll
            for (int i = j + 1; i < 16; ++i) acc[i] -= a[i] * tj;
        }
        asm volatile("" ::: "memory");
    }
    LDS_WAIT(); asm volatile("" ::: "memory");
#pragma unroll
    for (int f = 0; f < 8; ++f) { const int rb = f >> 2, ks = f & 3, row = 32 * rb + r, k0 = 16 * ks + 4 * hh;
        f32x4 lo = *(const LAS f32x4*)(M + row * 64 + k0), hi = *(const LAS f32x4*)(M + row * 64 + k0 + 8);
#pragma unroll
        for (int e = 0; e < 4; ++e) { lo[e] = k0 + e <= row ? lo[e] : 0.f; hi[e] = k0 + 8 + e <= row ? hi[e] : 0.f; }
        st16_sc1(slot + SL_T + ((rb * 4 + ks) * 64 + lane) * 16, pack8f(lo, hi)); }
    LDS_WAIT();
    asm volatile("s_waitcnt vmcnt(0)" ::: "memory");
    if (lane == 0) __hip_atomic_store(item_granule(A, item), (1ull << 32) | (unsigned long long)__float_as_uint(gcl), __ATOMIC_RELAXED, __HIP_MEMORY_SCOPE_AGENT);
}
DI void scan_seq(KA A, int seq, int w, int lane) {
    const int r = lane & 31, hh = lane >> 5, dv = 32 * w + r;
    const bool sample = seq >= N_PROMPT_SEQ; const int sidx = sample ? seq - N_PROMPT_SEQ : seq, b = sidx >> 2, h = sidx & 3, nch = sample ? 1 : CHUNKS_P;
    f32x16 S[4];
    if (sample) {
        const float* S0 = A->state_delta + ((size_t)(b * 4 + h) * 128) * 128 + dv;
#pragma unroll
        for (int kb = 0; kb < 4; ++kb)
#pragma unroll
            for (int reg = 0; reg < 16; ++reg) S[kb][reg] = S0[(size_t)(32 * kb + crow16(reg, hh)) * 128];
    } else {
#pragma unroll
        for (int kb = 0; kb < 4; ++kb)
#pragma unroll
            for (int reg = 0; reg < 16; ++reg) S[kb][reg] = 0.f;
    }
    bf16* OBR = (bf16*)((unsigned char*)A->out + DO_OB);
#pragma unroll 1
    for (int c = 0; c < nch; ++c) {
        const int item = sample ? N_ITEMS_P + sidx : seq * CHUNKS_P + c;
        const unsigned char* slot = slot_ptr(A, item);
        const float gcl = wait_item(item_granule(A, item));
        __builtin_amdgcn_fence(__ATOMIC_ACQUIRE, "agent");
        const bf16x8* bek = (const bf16x8*)(slot + SL_BEK) + lane; const bf16x8* tp = (const bf16x8*)(slot + SL_T) + lane;
        const bf16x8* qe = (const bf16x8*)(slot + SL_QE) + lane; const bf16x8* qkd = (const bf16x8*)(slot + SL_QKD) + lane; const bf16x8* kwt = (const bf16x8*)(slot + SL_KWT) + lane;
        bf16x8 sf[8];
#pragma unroll
        for (int kb = 0; kb < 4; ++kb) { sf[2 * kb] = pack_step<0>(S[kb]); sf[2 * kb + 1] = pack_step<1>(S[kb]); }
        f32x16 x0, x1;
#pragma unroll
        for (int e = 0; e < 16; ++e) { x0[e] = 0.f; x1[e] = 0.f; }
#pragma unroll
        for (int ks = 0; ks < 8; ++ks) { x0 = MFMA32(bek[ks * 64], sf[ks], x0); x1 = MFMA32(bek[(8 + ks) * 64], sf[ks], x1); }
        {
            const u32x4* bv = (const u32x4*)(slot + SL_BV) + ((w * 2) * 64 + lane) * 2;
            const u32x4 a0 = bv[0], a1 = bv[1], c0 = bv[128], c1 = bv[129];
            x0[0] = bflo(a0.x) - x0[0]; x0[1] = bfhi(a0.x) - x0[1]; x0[2] = bflo(a0.y) - x0[2]; x0[3] = bfhi(a0.y) - x0[3];
            x0[4] = bflo(a0.z) - x0[4]; x0[5] = bfhi(a0.z) - x0[5]; x0[6] = bflo(a0.w) - x0[6]; x0[7] = bfhi(a0.w) - x0[7];
            x0[8] = bflo(a1.x) - x0[8]; x0[9] = bfhi(a1.x) - x0[9]; x0[10] = bflo(a1.y) - x0[10]; x0[11] = bfhi(a1.y) - x0[11];
            x0[12] = bflo(a1.z) - x0[12]; x0[13] = bfhi(a1.z) - x0[13]; x0[14] = bflo(a1.w) - x0[14]; x0[15] = bfhi(a1.w) - x0[15];
            x1[0] = bflo(c0.x) - x1[0]; x1[1] = bfhi(c0.x) - x1[1]; x1[2] = bflo(c0.y) - x1[2]; x1[3] = bfhi(c0.y) - x1[3];
            x1[4] = bflo(c0.z) - x1[4]; x1[5] = bfhi(c0.z) - x1[5]; x1[6] = bflo(c0.w) - x1[6]; x1[7] = bfhi(c0.w) - x1[7];
            x1[8] = bflo(c1.x) - x1[8]; x1[9] = bfhi(c1.x) - x1[9]; x1[10] = bflo(c1.y) - x1[10]; x1[11] = bfhi(c1.y) - x1[11];
            x1[12] = bflo(c1.z) - x1[12]; x1[13] = bfhi(c1.z) - x1[13]; x1[14] = bflo(c1.w) - x1[14]; x1[15] = bfhi(c1.w) - x1[15];
        }
        bf16x8 rf[4] = {pack_step<0>(x0), pack_step<1>(x0), pack_step<0>(x1), pack_step<1>(x1)};
        f32x16 u0, u1;
#pragma unroll
        for (int e = 0; e < 16; ++e) { u0[e] = 0.f; u1[e] = 0.f; }
        u0 = MFMA32(tp[0 * 64], rf[0], u0); u0 = MFMA32(tp[1 * 64], rf[1], u0);
#pragma unroll
        for (int ks = 0; ks < 4; ++ks) u1 = MFMA32(tp[(4 + ks) * 64], rf[ks], u1);
        bf16x8 uf[4] = {pack_step<0>(u0), pack_step<1>(u0), pack_step<0>(u1), pack_step<1>(u1)};
        if (sample || c > 0) {
#pragma unroll
            for (int e = 0; e < 16; ++e) { x0[e] = 0.f; x1[e] = 0.f; }
#pragma unroll
            for (int ks = 0; ks < 8; ++ks) { x0 = MFMA32(qe[ks * 64], sf[ks], x0); x1 = MFMA32(qe[(8 + ks) * 64], sf[ks], x1); }
            x0 = MFMA32(qkd[0 * 64], uf[0], x0); x0 = MFMA32(qkd[1 * 64], uf[1], x0);
#pragma unroll
            for (int ks = 0; ks < 4; ++ks) x1 = MFMA32(qkd[(4 + ks) * 64], uf[ks], x1);
            const int crow0 = sample ? NBATCH * SEQ + b * TS : b * SEQ + 64 * (c - 1), L = sample ? TS : 64;
#pragma unroll
            for (int reg = 0; reg < 16; ++reg) { const int i0 = crow16(reg, hh), i1 = 32 + i0;
                if (i0 < L) OBR[(size_t)(crow0 + i0) * 512 + h * 128 + dv] = f2bf(x0[reg]);
                if (i1 < L) OBR[(size_t)(crow0 + i1) * 512 + h * 128 + dv] = f2bf(x1[reg]); }
        }
#pragma unroll
        for (int kb = 0; kb < 4; ++kb) {
            S[kb] = S[kb] * gcl;
#pragma unroll
            for (int ks = 0; ks < 4; ++ks) S[kb] = MFMA32(kwt[(kb * 4 + ks) * 64], uf[ks], S[kb]);
        }
    }
    float* So = A->out + (sample ? O_DS : O_DP) + ((size_t)(b * 4 + h) * 128) * 128 + dv;
#pragma unroll
    for (int kb = 0; kb < 4; ++kb)
#pragma unroll
        for (int reg = 0; reg < 16; ++reg) So[(size_t)(32 * kb + crow16(reg, hh)) * 128] = S[kb][reg];
}

constexpr int HALF_BYTES = 40960;
DI void scan_prompt_wg(KA A, int seq, LAS unsigned char* lds) {
    const int tid = threadIdx.x, lane = tid & 63, wave = __builtin_amdgcn_readfirstlane(tid >> 6);
    const int b = seq >> 2, h = seq & 3;
    constexpr int N = 2 * CHUNKS_P;
    if (wave >= 4) {
        const int loff = (wave - 4) * 10240 + lane * 16;
        u32x4 r0[10], r1[10];
        LAS u32x4* d0 = (LAS u32x4*)(lds + loff); LAS u32x4* d1 = (LAS u32x4*)(lds + HALF_BYTES + loff);
        LAS float* gclw = (LAS float*)(lds + 2 * HALF_BYTES);
#define SCAN_LOAD(n, R) do { const int item_ = seq * CHUNKS_P + ((n) >> 1); \
            if (((n) & 1) == 0) { const float g_ = wait_item(item_granule(A, item_)); __builtin_amdgcn_fence(__ATOMIC_ACQUIRE, "agent"); if (wave == 4 && lane == 0) gclw[((n) >> 1) & 3] = g_; } \
            const __amdgpu_buffer_rsrc_t rs_ = __builtin_amdgcn_make_buffer_rsrc((void*)slot_ptr(A, item_), 0, (int)PREP_SLOT, 0x00020000); \
            _Pragma("unroll") for (int q = 0; q < 10; ++q) R[q] = __builtin_bit_cast(u32x4, __builtin_amdgcn_raw_buffer_load_b128(rs_, ((n) & 1) * HALF_BYTES + loff + q * 1024, 0, 17)); } while (0)
        SCAN_LOAD(0, r0);
#pragma unroll
        for (int q = 0; q < 10; ++q) d0[q * 64] = r0[q];
        SCAN_LOAD(1, r1);
        LDS_BARRIER();
#pragma unroll 1
        for (int n = 0; n < N; n += 2) {
            if (n + 2 < N) SCAN_LOAD(n + 2, r0);
#pragma unroll
            for (int q = 0; q < 10; ++q) d1[q * 64] = r1[q];
            LDS_BARRIER();
            if (n + 3 < N) SCAN_LOAD(n + 3, r1);
            if (n + 2 < N) {
#pragma unroll
                for (int q = 0; q < 10; ++q) d0[q * 64] = r0[q]; }
            LDS_BARRIER();
        }
#undef SCAN_LOAD
    } else {
        const int w = wave, r = lane & 31, hh = lane >> 5, dv = 32 * w + r;
        f32x16 S[4];
#pragma unroll
        for (int kb = 0; kb < 4; ++kb)
#pragma unroll
            for (int reg = 0; reg < 16; ++reg) S[kb][reg] = 0.f;
        bf16* OBR = (bf16*)((unsigned char*)A->out + DO_OB);
        const LAS float* gclw = (const LAS float*)(lds + 2 * HALF_BYTES);
        const LAS bf16x8* bek = (const LAS bf16x8*)(lds + SL_BEK) + lane; const LAS bf16x8* tp = (const LAS bf16x8*)(lds + SL_T) + lane;
        const LAS u32x4* bv = (const LAS u32x4*)(lds + SL_BV) + ((w * 2) * 64 + lane) * 2;
        const LAS bf16x8* qkd = (const LAS bf16x8*)(lds + HALF_BYTES + (SL_QKD - HALF_BYTES)) + lane; const LAS bf16x8* qe = (const LAS bf16x8*)(lds + HALF_BYTES + (SL_QE - HALF_BYTES)) + lane;
        const LAS bf16x8* kwt = (const LAS bf16x8*)(lds + HALF_BYTES + (SL_KWT - HALF_BYTES)) + lane;
        LDS_BARRIER();
#pragma unroll 1
        for (int c = 0; c < CHUNKS_P; ++c) {
            bf16x8 sf[8];
#pragma unroll
            for (int kb = 0; kb < 4; ++kb) { sf[2 * kb] = pack_step<0>(S[kb]); sf[2 * kb + 1] = pack_step<1>(S[kb]); }
            f32x16 x0, x1;
#pragma unroll
            for (int e = 0; e < 16; ++e) { x0[e] = 0.f; x1[e] = 0.f; }
#pragma unroll
            for (int ks = 0; ks < 8; ++ks) { x0 = MFMA32(bek[ks * 64], sf[ks], x0); x1 = MFMA32(bek[(8 + ks) * 64], sf[ks], x1); }
            {
                const u32x4 a0 = bv[0], a1 = bv[1], c0 = bv[128], c1 = bv[129];
                x0[0] = bflo(a0.x) - x0[0]; x0[1] = bfhi(a0.x) - x0[1]; x0[2] = bflo(a0.y) - x0[2]; x0[3] = bfhi(a0.y) - x0[3];
                x0[4] = bflo(a0.z) - x0[4]; x0[5] = bfhi(a0.z) - x0[5]; x0[6] = bflo(a0.w) - x0[6]; x0[7] = bfhi(a0.w) - x0[7];
                x0[8] = bflo(a1.x) - x0[8]; x0[9] = bfhi(a1.x) - x0[9]; x0[10] = bflo(a1.y) - x0[10]; x0[11] = bfhi(a1.y) - x0[11];
                x0[12] = bflo(a1.z) - x0[12]; x0[13] = bfhi(a1.z) - x0[13]; x0[14] = bflo(a1.w) - x0[14]; x0[15] = bfhi(a1.w) - x0[15];
                x1[0] = bflo(c0.x) - x1[0]; x1[1] = bfhi(c0.x) - x1[1]; x1[2] = bflo(c0.y) - x1[2]; x1[3] = bfhi(c0.y) - x1[3];
                x1[4] = bflo(c0.z) - x1[4]; x1[5] = bfhi(c0.z) - x1[5]; x1[6] = bflo(c0.w) - x1[6]; x1[7] = bfhi(c0.w) - x1[7];
                x1[8] = bflo(c1.x) - x1[8]; x1[9] = bfhi(c1.x) - x1[9]; x1[10] = bflo(c1.y) - x1[10]; x1[11] = bfhi(c1.y) - x1[11];
                x1[12] = bflo(c1.z) - x1[12]; x1[13] = bfhi(c1.z) - x1[13]; x1[14] = bflo(c1.w) - x1[14]; x1[15] = bfhi(c1.w) - x1[15];
            }
            bf16x8 rf[4] = {pack_step<0>(x0), pack_step<1>(x0), pack_step<0>(x1), pack_step<1>(x1)};
            f32x16 u0, u1;
#pragma unroll
            for (int e = 0; e < 16; ++e) { u0[e] = 0.f; u1[e] = 0.f; }
            u0 = MFMA32(tp[0 * 64], rf[0], u0); u0 = MFMA32(tp[1 * 64], rf[1], u0);
#pragma unroll
            for (int ks = 0; ks < 4; ++ks) u1 = MFMA32(tp[(4 + ks) * 64], rf[ks], u1);
            bf16x8 uf[4] = {pack_step<0>(u0), pack_step<1>(u0), pack_step<0>(u1), pack_step<1>(u1)};
            LDS_BARRIER();
            if (c > 0) {
#pragma unroll
                for (int e = 0; e < 16; ++e) { x0[e] = 0.f; x1[e] = 0.f; }
#pragma unroll
                for (int ks = 0; ks < 8; ++ks) { x0 = MFMA32(qe[ks * 64], sf[ks], x0); x1 = MFMA32(qe[(8 + ks) * 64], sf[ks], x1); }
                x0 = MFMA32(qkd[0 * 64], uf[0], x0); x0 = MFMA32(qkd[1 * 64], uf[1], x0);
#pragma unroll
                for (int ks = 0; ks < 4; ++ks) x1 = MFMA32(qkd[(4 + ks) * 64], uf[ks], x1);
                bf16* orow = OBR + (size_t)(b * SEQ + 64 * (c - 1)) * 512 + h * 128 + dv;
#pragma unroll
                for (int reg = 0; reg < 16; ++reg) { const int i0 = crow16(reg, hh); orow[(size_t)i0 * 512] = f2bf(x0[reg]); orow[(size_t)(32 + i0) * 512] = f2bf(x1[reg]); }
            }
            const float gcl = gclw[c & 3];
#pragma unroll
            for (int kb = 0; kb < 4; ++kb) {
                S[kb] = S[kb] * gcl;
#pragma unroll
                for (int ks = 0; ks < 4; ++ks) S[kb] = MFMA32(kwt[(kb * 4 + ks) * 64], uf[ks], S[kb]);
            }
            LDS_BARRIER();
        }
        float* So = A->out + O_DP + ((size_t)(b * 4 + h) * 128) * 128 + dv;
#pragma unroll
        for (int kb = 0; kb < 4; ++kb)
#pragma unroll
            for (int reg = 0; reg < 16; ++reg) So[(size_t)(32 * kb + crow16(reg, hh)) * 128] = S[kb][reg];
    }
}

constexpr int KPITCH = 72, VPITCH = 264;
DI void attn_unit(KA A, int unit, LAS unsigned char* ldsb) {
    const int tid = threadIdx.x, lane = tid & 63, wave = __builtin_amdgcn_readfirstlane(tid >> 6), r = lane & 31, hh = lane >> 5;
    const int b = unit >> 6, kh = (unit >> 5) & 1, jb = unit & 31, T0 = NMETA + 128 * jb;
    LAS bf16* Ksm = (LAS bf16*)ldsb; LAS bf16* VTs = Ksm + 256 * KPITCH;
    const bf16* KVg = (const bf16*)(A->ws + WS_KV); const bf16* QAg = (const bf16*)(A->ws + WS_QA);
#pragma unroll
    for (int e4 = 0; e4 < 4; ++e4) {
        const int id = tid + 512 * e4, key = id >> 3, cch = id & 7, tk = T0 - 128 + key;
        u32x4 kq = (u32x4){0u, 0u, 0u, 0u}, vq = kq;
        if (tk >= 0) { const bf16* src = KVg + (size_t)(b * TP + tk) * 256 + kh * 64 + 8 * cch; kq = *(const u32x4*)src; vq = *(const u32x4*)(src + 128); }
        *(LAS u32x4*)(Ksm + key * KPITCH + 8 * cch) = kq;
        const int kkk = key & 15, pos = (key & ~15) + 8 * ((kkk >> 2) & 1) + (((kkk >> 3) << 2) | (kkk & 3));
        LAS bf16* vd = VTs + (8 * cch) * VPITCH + pos;
        vd[0 * VPITCH] = (bf16)(vq.x & 0xffffu); vd[1 * VPITCH] = (bf16)(vq.x >> 16); vd[2 * VPITCH] = (bf16)(vq.y & 0xffffu); vd[3 * VPITCH] = (bf16)(vq.y >> 16);
        vd[4 * VPITCH] = (bf16)(vq.z & 0xffffu); vd[5 * VPITCH] = (bf16)(vq.z >> 16); vd[6 * VPITCH] = (bf16)(vq.w & 0xffffu); vd[7 * VPITCH] = (bf16)(vq.w >> 16);
    }
    LDS_BARRIER();
    const int g = wave >> 1, qh = wave & 1, head = 4 * kh + g;
    const float sink2 = A->sinks[head] * 1.4426950408889634f;
    const int kmin = jb == 0 ? 128 - NMETA : 0;
#pragma unroll 1
    for (int q2 = 0; q2 < 2; ++q2) {
        const int qb = 2 * qh + q2, iq = 32 * qb + r;
        const bf16* qrow = QAg + (size_t)(b * TP + T0 + iq) * 512 + head * 64 + 8 * hh;
        bf16x8 qf[4];
#pragma unroll
        for (int s = 0; s < 4; ++s) qf[s] = *(const bf16x8*)(qrow + 16 * s);
        f32x16 st[5];
        float m = sink2;
#pragma unroll
        for (int kt5 = 0; kt5 < 5; ++kt5) {
            const int kt = qb + kt5;
            f32x16 acc;
#pragma unroll
            for (int e = 0; e < 16; ++e) acc[e] = 0.f;
#pragma unroll
            for (int s = 0; s < 4; ++s) acc = MFMA32(*(const LAS bf16x8*)(Ksm + (32 * kt + r) * KPITCH + 16 * s + 8 * hh), qf[s], acc);
#pragma unroll
            for (int reg = 0; reg < 16; ++reg) { const int kk = 32 * kt + crow16(reg, hh); const bool ok = kk >= iq && kk <= iq + 128 && kk >= kmin;
                acc[reg] = ok ? acc[reg] : -INFINITY; m = fmaxf(m, acc[reg]); }
            st[kt5] = acc;
        }
        m = fmaxf(m, __shfl_xor(m, 32));
        float l = 0.f;
#pragma unroll
        for (int kt5 = 0; kt5 < 5; ++kt5)
#pragma unroll
            for (int reg = 0; reg < 16; ++reg) { const float p = exp2f(st[kt5][reg] - m); st[kt5][reg] = p; l += p; }
        l += __shfl_xor(l, 32); l += exp2f(sink2 - m);
        f32x16 o0, o1;
#pragma unroll
        for (int e = 0; e < 16; ++e) { o0[e] = 0.f; o1[e] = 0.f; }
#pragma unroll
        for (int kt5 = 0; kt5 < 5; ++kt5) {
            const int kt = qb + kt5;
            const bf16x8 p0 = pack_step<0>(st[kt5]), p1 = pack_step<1>(st[kt5]);
            const LAS bf16* vb = VTs + r * VPITCH + 32 * kt + 8 * hh;
            o0 = MFMA32(*(const LAS bf16x8*)(vb), p0, o0); o0 = MFMA32(*(const LAS bf16x8*)(vb + 16), p1, o0);
            o1 = MFMA32(*(const LAS bf16x8*)(vb + 32 * VPITCH), p0, o1); o1 = MFMA32(*(const LAS bf16x8*)(vb + 32 * VPITCH + 16), p1, o1);
        }
        const float rl = 1.0f / l;
        bf16* orow = (bf16*)((unsigned char*)A->out + DO_OA) + (size_t)(b * SEQ + 128 * jb + iq) * 512 + head * 64 + 4 * hh;
#pragma unroll
        for (int g4 = 0; g4 < 4; ++g4) {
            *(u32x2*)(orow + 8 * g4) = (u32x2){cvtpk(o0[4 * g4] * rl, o0[4 * g4 + 1] * rl), cvtpk(o0[4 * g4 + 2] * rl, o0[4 * g4 + 3] * rl)};
            *(u32x2*)(orow + 32 + 8 * g4) = (u32x2){cvtpk(o1[4 * g4] * rl, o1[4 * g4 + 1] * rl), cvtpk(o1[4 * g4 + 2] * rl, o1[4 * g4 + 3] * rl)};
        }
    }
    LDS_BARRIER();
}
DI void sample_attn(KA A, int b, int head, LAS float* wl, int lane) {
    const int kh = head >> 2;
    LAS float* qn = wl; LAS float* ps = wl + 256;
    const bf16* QAg = (const bf16*)(A->ws + WS_QA); const bf16* KVg = (const bf16*)(A->ws + WS_KV);
#pragma unroll
    for (int i = 0; i < 4; ++i) qn[i * 64 + lane] = bf2f(QAg[(size_t)(MP + b * TS + i) * 512 + head * 64 + pos_of_d(lane)]);
    LDS_WAIT(); asm volatile("" ::: "memory");
    const float sink2 = A->sinks[head] * 1.4426950408889634f;
#pragma unroll 1
    for (int kq = 0; kq < 3; ++kq) {
        const int kj = lane + 64 * kq;
        float sc0 = 0.f, sc1 = 0.f, sc2 = 0.f, sc3 = 0.f;
        if (kj < 128) {
            const f32x4* kr = (const f32x4*)(A->cache_k + ((size_t)(b * 128 + kj) * 2 + kh) * 64);
#pragma unroll 4
            for (int d4 = 0; d4 < 16; ++d4) { const f32x4 kv = kr[d4];
                const f32x4 q0 = *(const LAS f32x4*)(qn + 4 * d4), q1 = *(const LAS f32x4*)(qn + 64 + 4 * d4), q2 = *(const LAS f32x4*)(qn + 128 + 4 * d4), q3 = *(const LAS f32x4*)(qn + 192 + 4 * d4);
                sc0 += (kv[0] * q0[0] + kv[1] * q0[1]) + (kv[2] * q0[2] + kv[3] * q0[3]); sc1 += (kv[0] * q1[0] + kv[1] * q1[1]) + (kv[2] * q1[2] + kv[3] * q1[3]);
                sc2 += (kv[0] * q2[0] + kv[1] * q2[1]) + (kv[2] * q2[2] + kv[3] * q2[3]); sc3 += (kv[0] * q3[0] + kv[1] * q3[1]) + (kv[2] * q3[2] + kv[3] * q3[3]); }
        } else if (kj < 132) {
            const bf16* kr = KVg + (size_t)(MP + b * TS + (kj - 128)) * 256 + kh * 64;
#pragma unroll 4
            for (int p = 0; p < 64; ++p) { const float kv = bf2f(kr[p]); const int d = d_of_pos(p);
                sc0 += kv * qn[d]; sc1 += kv * qn[64 + d]; sc2 += kv * qn[128 + d]; sc3 += kv * qn[192 + d]; }
        }
        if (kj < 132) {
            ps[0 * 132 + kj] = (kj >= 0 && kj <= 128) ? sc0 : -INFINITY; ps[1 * 132 + kj] = (kj >= 1 && kj <= 129) ? sc1 : -INFINITY;
            ps[2 * 132 + kj] = (kj >= 2 && kj <= 130) ? sc2 : -INFINITY; ps[3 * 132 + kj] = (kj >= 3 && kj <= 131) ? sc3 : -INFINITY; }
    }
    LDS_WAIT(); asm volatile("" ::: "memory");
    float linv[4];
#pragma unroll
    for (int i = 0; i < 4; ++i) {
        const float s0 = ps[i * 132 + lane], s1 = ps[i * 132 + 64 + lane], s2 = lane < 4 ? ps[i * 132 + 128 + lane] : -INFINITY;
        const float m = wave_max(fmaxf(fmaxf(s0, s1), fmaxf(s2, sink2)));
        const float p0 = exp2f(s0 - m), p1 = exp2f(s1 - m), p2 = exp2f(s2 - m);
        ps[i * 132 + lane] = p0; ps[i * 132 + 64 + lane] = p1; if (lane < 4) ps[i * 132 + 128 + lane] = p2;
        linv[i] = 1.0f / (wave_sum(p0 + p1 + p2) + exp2f(sink2 - m));
    }
    LDS_WAIT(); asm volatile("" ::: "memory");
    float o[4] = {0.f, 0.f, 0.f, 0.f};
#pragma unroll 4
    for (int kj = 0; kj < 128; ++kj) { const float v = A->cache_v[((size_t)(b * 128 + kj) * 2 + kh) * 64 + lane];
#pragma unroll
        for (int i = 0; i < 4; ++i) o[i] += ps[i * 132 + kj] * v; }
#pragma unroll
    for (int kj = 128; kj < 132; ++kj) { const float v = bf2f(KVg[(size_t)(MP + b * TS + (kj - 128)) * 256 + 128 + kh * 64 + lane]);
#pragma unroll
        for (int i = 0; i < 4; ++i) o[i] += ps[i * 132 + kj] * v; }
    bf16* OAg = (bf16*)((unsigned char*)A->out + DO_OA);
#pragma unroll
    for (int i = 0; i < 4; ++i) OAg[(size_t)(NBATCH * SEQ + b * TS + i) * 512 + head * 64 + lane] = f2bf(o[i] * linv[i]);
    LDS_WAIT(); asm volatile("" ::: "memory");
}
DI void p23_mixers(KA A, LAS unsigned char* lds, const XcdBarrier& dbg_bar) {
    const int tid = threadIdx.x, lane = tid & 63, wave = __builtin_amdgcn_readfirstlane(tid >> 6), G = gridDim.x, wg = blockIdx.x;
    const int NSCAN = N_PROMPT_SEQ;
#ifdef P23_DEBUG_BARRIER
    if (wg < NSCAN) xcd_barrier(dbg_bar);
#endif
#ifdef P23_FLUSH_EXPERIMENT
    if (wg < NSCAN) {
        const u32x4* src = (const u32x4*)(A->ws + WS_G) + (size_t)wg * 131072 + tid; unsigned accx = 0u;
        for (int i = 0; i < 256; ++i) { const u32x4 v = src[(size_t)i * 512]; accx += v.x ^ v.y ^ v.z ^ v.w; }
        if (accx == 0x12345679u) ((unsigned*)(A->ws + WS_SC))[tid] = accx;
    }
#endif
    if (wg < NSCAN) { scan_prompt_wg(A, wg, lds); return; }
    const int p = wg - NSCAN, NP = G - NSCAN;
    const int nprompt = p < N_ITEMS_P ? (N_ITEMS_P - 1 - p) / NP + 1 : 0;
    const int nsample = p < SBATCH * NHB ? (SBATCH * NHB - 1 - p) / NP + 1 : 0;
    const int ntot = nprompt + nsample;
#define PROD_ITEM(k) ((k) < nprompt ? (((p + NP * (k)) & 31) * CHUNKS_P + ((p + NP * (k)) >> 5)) : ((k) < ntot ? N_ITEMS_P + p + NP * ((k) - nprompt) : N_ITEMS))
    {
        S1Pre P;
        float* ats0 = (float*)((unsigned char*)A->out + DO_ATS + (size_t)p * 8 * ATS_ITEM);
        if (ntot > 0) stage1_issue(A, PROD_ITEM(0), P);
        int k = 0, bs = 1;
        int nb = 0;
#pragma unroll 1
        while (k < ntot) {
            const int cnt = ntot - k < bs ? ntot - k : bs;
#pragma unroll 1
            for (int i = 0; i < cnt; ++i) prep_stage1(A, PROD_ITEM(k + i), PROD_ITEM(k + i + 1), i, ats0 + i * (ATS_ITEM / 4), P, lds);
            asm volatile("s_waitcnt vmcnt(0)" ::: "memory"); __syncthreads();
            if (wave < cnt) prep_stage2(A, PROD_ITEM(k + wave), ((const LAS float*)(lds + LDS_GCL))[wave], ats0 + wave * (ATS_ITEM / 4), (LAS float*)(lds + wave * 16384));
            __syncthreads();
            k += cnt; ++nb; bs = nb == 1 ? 1 : (nb == 2 ? 2 : (nb == 3 ? 4 : 8));
        }
    }
#undef PROD_ITEM
#ifdef P23_DEBUG_BARRIER
    xcd_barrier(dbg_bar);
#endif
    for (int u = p; u < NBATCH * NKV * 32; u += NP) attn_unit(A, u, lds);
    const int worker = p * NWAVES + wave, NW = NP * NWAVES;
    LAS float* wl = (LAS float*)(lds + 98304 + wave * 4096);
    for (int it = worker; it < SBATCH * NHB * 4 + SBATCH * NHA; it += NW) {
        if (it < SBATCH * NHB * 4) scan_seq(A, N_PROMPT_SEQ + (it >> 2), it & 3, lane);
        else { const int q = it - SBATCH * NHB * 4; sample_attn(A, q >> 3, q & 7, wl, lane); }
    }
}

DI void p3b_gated_norm(KA A) {
    const int tid = threadIdx.x, lane = tid & 63, wave = tid >> 6, gw = blockIdx.x * NWAVES + wave, NGW = gridDim.x * NWAVES;
    const int head = lane >> 4, dv0 = 8 * (lane & 15);
    const f32x4 w0 = *(const f32x4*)(A->gdn_norm + dv0), w1 = *(const f32x4*)(A->gdn_norm + dv0 + 4);
    bf16* OBg = (bf16*)((unsigned char*)A->out + DO_OB); const bf16* Zg = (const bf16*)(A->ws + WS_Z);
    for (int crow = gw; crow < MC; crow += NGW) {
        const u32x4 ow = *(const u32x4*)(OBg + (size_t)crow * 512 + head * 128 + dv0);
        const f32x4 a = {bflo(ow.x), bfhi(ow.x), bflo(ow.y), bfhi(ow.y)}, c = {bflo(ow.z), bfhi(ow.z), bflo(ow.w), bfhi(ow.w)};
        float ss = (a[0] * a[0] + a[1] * a[1]) + (a[2] * a[2] + a[3] * a[3]) + (c[0] * c[0] + c[1] * c[1]) + (c[2] * c[2] + c[3] * c[3]);
        ss += __shfl_xor(ss, 1); ss += __shfl_xor(ss, 2); ss += __shfl_xor(ss, 4); ss += __shfl_xor(ss, 8);
        const float rstd = rsqrtf(ss * (1.0f / 128.0f) + EPS);
        const u32x4 zw = *(const u32x4*)(Zg + (size_t)pg8::crow_to_urow(crow) * 512 + head * 128 + dv0);
        f32x4 y0, y1;
        y0[0] = a[0] * rstd * w0[0] * siluf_(bflo(zw.x)); y0[1] = a[1] * rstd * w0[1] * siluf_(bfhi(zw.x)); y0[2] = a[2] * rstd * w0[2] * siluf_(bflo(zw.y)); y0[3] = a[3] * rstd * w0[3] * siluf_(bfhi(zw.y));
        y1[0] = c[0] * rstd * w1[0] * siluf_(bflo(zw.z)); y1[1] = c[1] * rstd * w1[1] * siluf_(bfhi(zw.z)); y1[2] = c[2] * rstd * w1[2] * siluf_(bflo(zw.w)); y1[3] = c[3] * rstd * w1[3] * siluf_(bfhi(zw.w));
        *(u32x4*)(OBg + (size_t)crow * 512 + head * 128 + dv0) = pack8f(y0, y1);
    }
}
DI void p8_final_norm(KA A) {
    const int tid = threadIdx.x, lane = tid & 63, wave = tid >> 6, gw = blockIdx.x * NWAVES + wave, NGW = gridDim.x * NWAVES;
    f32x4 nf[4];
#pragma unroll
    for (int j = 0; j < 4; ++j) nf[j] = ((const f32x4*)A->norm_final)[lane + 64 * j];
    for (int crow = gw; crow < MC; crow += NGW) {
        f32x4* row = (f32x4*)(A->out + (size_t)crow * D);
        f32x4 v[4]; float ss = 0.f;
#pragma unroll
        for (int j = 0; j < 4; ++j) { v[j] = row[lane + 64 * j]; ss += (v[j][0] * v[j][0] + v[j][1] * v[j][1]) + (v[j][2] * v[j][2] + v[j][3] * v[j][3]); }
        const float rstd = rsqrtf(wave_sum(ss) * (1.0f / D) + EPS);
#pragma unroll
        for (int j = 0; j < 4; ++j) row[lane + 64 * j] = v[j] * rstd * nf[j];
    }
}
__global__ void __launch_bounds__(NTHREADS, 2) hybrid_fwd(Args Aval) {
    extern __shared__ __attribute__((aligned(16))) unsigned char lds_raw[];
    LAS unsigned char* lds = (LAS unsigned char*)lds_raw;
    const int tid = threadIdx.x;
    int lo, hi; { KA A0 = kargs(); lo = A0->ph_lo; hi = A0->ph_hi; }
#if MK_N_LAUNCHES == 1
#if MK_BARRIER == 1
    volatile LAS unsigned* MISC = (volatile LAS unsigned*)(lds + LDS_MISC);
    if (tid < 64) MISC[tid] = 0u;
    __syncthreads();
    XcdBarrier bar; { KA A0 = kargs(); bar = xcd_barrier_post((unsigned*)(A0->ws + WS_CTL) + 4096, MISC + 8); }
#define GRID_BAR() xcd_barrier(bar)
#else
    cg::grid_group grid = cg::this_grid();
#define GRID_BAR() grid.sync()
#endif
#else
#define GRID_BAR() do {} while (0)
#endif
#ifndef PH_MASK
#define PH_MASK 0x1ff
#endif
#define IN(k) (((PH_MASK >> (k)) & 1) && lo <= (k) && (k) < hi)
#ifndef PROBE_REP
#define PROBE_REP -1
#endif
#define NREP(k) (PROBE_REP == (k) ? 2 : 1)
#define SEAM(k) do { if (IN(k) && IN((k) + 1)) GRID_BAR(); } while (0)
    const int G = gridDim.x, wgid = blockIdx.x;
#if PROBE_REP == 0
    if (IN(0)) { KA A = kargs(); p0_prologue(A, lds); __syncthreads(); }
#endif
    if (IN(0)) { KA A = kargs(); p0_prologue(A, lds); } SEAM(0);
    if (IN(1)) for (int rep = 0; rep < NREP(1); ++rep) { KA A = kargs(); unsigned char* ws = A->ws;
        pg8::Gemm g{(const bf16*)(ws + WS_XN), (const bf16*)(ws + WS_WIN), MUP, NIN, D}; pg8::StaticOrder S; S.init(MUP, NIN, G, wgid);
        pg8::EpiInProj E{(bf16*)(ws + WS_QA), (bf16*)(ws + WS_KV), (bf16*)(ws + WS_QKVB), (bf16*)(ws + WS_Z), (bf16*)(ws + WS_G),
                         (const float*)(ws + WS_ROPE), (const float*)(ws + WS_ROPE) + (TP + TS) * 32, A->out};
        pg8::gemm_phase<pg8::EpiInProj, pg8::StaticOrder, true, true>(lds, g, S, E);
    } SEAM(1);
    if (IN(2)) { KA A = kargs(); p23_mixers(A, lds, bar); } SEAM(2);
    if (IN(3)) for (int rep = 0; rep < NREP(3); ++rep) { KA A = kargs(); p3b_gated_norm(A); } SEAM(3);
    if (IN(4)) for (int rep = 0; rep < NREP(4); ++rep) { KA A = kargs(); unsigned char* ws = A->ws;
        { pg8::Gemm g{(const bf16*)((unsigned char*)A->out + DO_OA), (const bf16*)(ws + WS_WOA), MC, D, 512}; pg8::StaticOrder S; S.init(MC, D, G, wgid);
          pg8::EpiMerge<false> E{(bf16*)(ws + WS_MB), (const bf16*)(ws + WS_G), 0};
          pg8::gemm_phase<pg8::EpiMerge<false>, pg8::StaticOrder, true, true>(lds, g, S, E); }
        asm volatile("s_waitcnt vmcnt(0)" ::: "memory"); __syncthreads();
        { pg8::Gemm g{(const bf16*)((unsigned char*)A->out + DO_OB), (const bf16*)(ws + WS_WOB), MC, D, 512}; pg8::StaticOrder S; S.init(MC, D, G, wgid);
          pg8::EpiMerge<true> E{(bf16*)(ws + WS_MB), (const bf16*)(ws + WS_G), 1024};
          pg8::gemm_phase<pg8::EpiMerge<true>, pg8::StaticOrder, true, true>(lds, g, S, E); }
    } SEAM(4);
    if (IN(5)) { KA A = kargs(); unsigned char* ws = A->ws;
        pg8::Gemm g{(const bf16*)(ws + WS_MB), (const bf16*)(ws + WS_WOUT), MC, D, D}; pg8::StaticOrder S; S.init(MC, D, G, wgid);
        pg8::EpiWout<true> E{A->x_prompt, A->x_sample, A->out, (bf16*)(ws + WS_HB1), (float*)(ws + WS_SS1)};
        pg8::gemm_phase<pg8::EpiWout<true>, pg8::StaticOrder, true, true>(lds, g, S, E);
#if PROBE_REP == 5
        { pg8::EpiWout<false> E2{A->x_prompt, A->x_sample, A->out, (bf16*)(ws + WS_HB1), (float*)(ws + WS_SS1)}; pg8::gemm_phase<pg8::EpiWout<false>, pg8::StaticOrder, true, true>(lds, g, S, E2); }
#endif
    } SEAM(5);
    if (IN(6)) for (int rep = 0; rep < NREP(6); ++rep) { KA A = kargs(); unsigned char* ws = A->ws;
        pg8::Gemm g{(const bf16*)(ws + WS_HB1), (const bf16*)(ws + WS_WGU), MC, 2 * DFF, D}; pg8::StaticOrder S; S.init(MC, 2 * DFF, G, wgid);
        pg8::EpiGateUp E{(bf16*)(ws + WS_ACT), (const float*)(ws + WS_SS1)};
        pg8::gemm_phase<pg8::EpiGateUp, pg8::StaticOrder, true, true>(lds, g, S, E);
    } SEAM(6);
    if (IN(7)) { KA A = kargs(); unsigned char* ws = A->ws;
        pg8::Gemm g{(const bf16*)(ws + WS_ACT), (const bf16*)(ws + WS_WD), MC, D, DFF}; pg8::StaticOrder S; S.init(MC, D, G, wgid);
        pg8::EpiDown<false> E{A->out};
        pg8::gemm_phase<pg8::EpiDown<false>, pg8::StaticOrder, true, true>(lds, g, S, E);
#if PROBE_REP == 7
        { pg8::EpiDown<true> E2{A->out}; pg8::gemm_phase<pg8::EpiDown<true>, pg8::StaticOrder, true, true>(lds, g, S, E2); }
#endif
    } SEAM(7);
    if (IN(8)) { KA A = kargs(); p8_final_norm(A); }
#undef IN
#undef SEAM
}

extern "C" void kernel_launch(void* const* d_in, const int* in_sizes, int n_in, void* d_out, int out_size, void* d_ws, size_t ws_size, hipStream_t stream) {
    static int grid = 0;
    if (grid == 0) {
        if (n_in != 22 || out_size != (int)O_END || ws_size < WS_END) { fprintf(stderr, "kernel_launch: unexpected problem (n_in %d, out %d, ws %zu)\n", n_in, out_size, ws_size); grid = -1; return; }
        int dev = 0, cus = 0, per_cu = 0;
        if (hipGetDevice(&dev) != hipSuccess || hipDeviceGetAttribute(&cus, hipDeviceAttributeMultiprocessorCount, dev) != hipSuccess) { grid = -1; return; }
        if (hipFuncSetAttribute((const void*)hybrid_fwd, hipFuncAttributeMaxDynamicSharedMemorySize, LDS_BYTES) != hipSuccess) { fprintf(stderr, "kernel_launch: hipFuncSetAttribute failed\n"); grid = -1; return; }
        if (hipOccupancyMaxActiveBlocksPerMultiprocessor(&per_cu, (const void*)hybrid_fwd, NTHREADS, LDS_BYTES) != hipSuccess || per_cu < 1) { fprintf(stderr, "kernel_launch: occupancy query says %d\n", per_cu); per_cu = 1; }
        (void)hipGetLastError();
        grid = cus;
        if (grid > 256) grid = 256;
    }
    if (grid < 0) return;
    (void)hipMemsetAsync((char*)d_ws + WS_CTL, 0, CTL_BYTES, stream);
    Args a{};
    const float** ap = (const float**)&a;
    for (int i = 0; i < 22; ++i) ap[i] = (const float*)d_in[i];
    a.out = (float*)d_out; a.ws = (unsigned char*)d_ws;
#if MK_N_LAUNCHES == 1
    a.ph_lo = 0; a.ph_hi = N_PHASES;
#if MK_BARRIER == 1
    hipLaunchKernelGGL(hybrid_fwd, dim3(grid), dim3(NTHREADS), LDS_BYTES, stream, a);
#else
    void* args[] = {&a};
    hipError_t e = hipLaunchCooperativeKernel((const void*)hybrid_fwd, dim3(grid), dim3(NTHREADS), args, LDS_BYTES, stream);
    if (e != hipSuccess) fprintf(stderr, "cooperative launch failed: %s (grid %d)\n", hipGetErrorString(e), grid);
#endif
#else
    for (int p = 0; p < N_PHASES; ++p) { a.ph_lo = p; a.ph_hi = p + 1; hipLaunchKernelGGL(hybrid_fwd, dim3(grid), dim3(NTHREADS), LDS_BYTES, stream, a); }
#endif
}
```

```cpp
#include <hip/hip_runtime.h>
#include <hip/hip_cooperative_groups.h>
#include <cstdio>
#include <cstdint>
namespace cg = cooperative_groups;

#ifndef MK_N_LAUNCHES
#define MK_N_LAUNCHES 1
#endif
#ifndef MK_BARRIER
#define MK_BARRIER 1
#endif

constexpr int D = 1024, NBATCH = 8, SEQ = 4096, NMETA = 16, TP = SEQ + NMETA, MP = NBATCH * TP;
constexpr int SBATCH = 128, TS = 4, MS = SBATCH * TS, MU = MP + MS, MUP = 33536, MC = NBATCH * SEQ + MS;
constexpr int PAST = 16384;
constexpr int HD = 64, NHA = 8, NKV = 2;
constexpr int NHB = 4, CONVD = 1536;
constexpr int DFF = 2816, NIN_SRC = 4872, NIN = 4864;
constexpr float EPS = 1e-6f;
constexpr float QSCALE = 0.125f * 1.4426950408889634f;

constexpr size_t MiB = 1u << 20, KiB = 1024;
constexpr size_t WS_CTL = 0, CTL_BYTES = 1 * MiB;
constexpr size_t WS_WIN = 1 * MiB;
constexpr size_t WS_WOA = 11 * MiB, WS_WOB = 12 * MiB;
constexpr size_t WS_WOUT = 13 * MiB;
constexpr size_t WS_WGU = 15 * MiB;
constexpr size_t WS_WD = 26 * MiB;
constexpr size_t WS_ROPE = 32 * MiB;
constexpr size_t WS_GB = 34 * MiB;
constexpr size_t WS_SC = 36 * MiB;
constexpr size_t WS_SS1 = 37 * MiB, WS_SS2 = 37 * MiB + 512 * KiB;
constexpr size_t WS_QA = 41 * MiB;
constexpr size_t WS_KV = WS_QA + (size_t)MUP * 512 * 2;
constexpr size_t WS_QKVB = WS_KV + (size_t)MUP * 256 * 2;
constexpr size_t WS_Z = WS_QKVB + (size_t)MUP * 1536 * 2;
constexpr size_t WS_G = WS_Z + (size_t)MUP * 512 * 2;
constexpr size_t WS_GEND = WS_G + (size_t)MUP * 2048 * 2;
constexpr size_t WS_B = 353 * MiB, WS_END = 512 * MiB;
static_assert(WS_GEND <= WS_B, "ws map");
constexpr size_t WS_XN = WS_B;
constexpr size_t PREP_SLOT = 80 * KiB;
constexpr int PREP_N1 = (int)((WS_END - WS_B) / PREP_SLOT);
constexpr size_t DO_OA = 44 * MiB;
constexpr size_t DO_OB = DO_OA + (size_t)MC * 512 * 2;
constexpr size_t DO_ATS = DO_OB + (size_t)MC * 512 * 2;
constexpr size_t ATS_ITEM = 3 * 32 * 32 * 4;
static_assert(DO_ATS + 224 * 8 * ATS_ITEM <= (size_t)MC * 1024 * 4, "d_out scratch map");
constexpr size_t WS_MB = WS_B;
constexpr size_t WS_HB1 = WS_B + 66 * MiB;
static_assert(WS_HB1 + (size_t)MC * 1024 * 2 <= WS_END, "ws map");
constexpr size_t WS_ACT = WS_QA;
static_assert(WS_ACT + (size_t)MC * DFF * 2 <= WS_G, "ws map");
constexpr int SL_BEK = 0, SL_BV = 16 * 1024, SL_T = 32 * 1024, SL_QKD = 40 * 1024, SL_QE = 48 * 1024, SL_KWT = 64 * 1024;
constexpr int N_PROMPT_SEQ = NBATCH * NHB, CHUNKS_P = 65, N_ITEMS_P = N_PROMPT_SEQ * CHUNKS_P, N_ITEMS = N_ITEMS_P + SBATCH * NHB;
static_assert((size_t)(N_ITEMS - PREP_N1) * PREP_SLOT <= DO_OA, "prep slots");

constexpr size_t O_YP = 0, O_YS = (size_t)NBATCH * SEQ * D, O_KP = O_YS + (size_t)MS * D, O_VP = O_KP + 8 * 128 * 2 * 64, O_DP = O_VP + 8 * 128 * 2 * 64,
                 O_CP = O_DP + 8 * 4 * 128 * 128, O_KS = O_CP + 8 * 3 * 1536, O_VS = O_KS + (size_t)128 * 128 * 2 * 64, O_DS = O_VS + (size_t)128 * 128 * 2 * 64,
                 O_CS = O_DS + (size_t)128 * 4 * 128 * 128, O_END = O_CS + (size_t)128 * 3 * 1536;
static_assert(O_END == 48074752, "d_out size");

#define DI __device__ __forceinline__
#define GAS __attribute__((address_space(1)))
#define LAS __attribute__((address_space(3)))
typedef unsigned short bf16;
typedef short bf16x8 __attribute__((ext_vector_type(8)));
typedef float f32x4 __attribute__((ext_vector_type(4)));
typedef float f32x2 __attribute__((ext_vector_type(2)));
typedef float f32x16 __attribute__((ext_vector_type(16)));
typedef unsigned u32x4 __attribute__((ext_vector_type(4)));
typedef unsigned u32x2 __attribute__((ext_vector_type(2)));
typedef __bf16 bf16x2_t __attribute__((ext_vector_type(2)));

DI unsigned cvtpk(float lo, float hi) { f32x2 v = {lo, hi}; bf16x2_t b = __builtin_convertvector(v, bf16x2_t); return __builtin_bit_cast(unsigned, b); }
DI bf16 f2bf(float f) { return (bf16)(cvtpk(f, 0.f) & 0xffffu); }
DI float bf2f(unsigned short h) { return __uint_as_float((unsigned)h << 16); }
DI float bflo(unsigned w) { return __uint_as_float(w << 16); }
DI float bfhi(unsigned w) { return __uint_as_float(w & 0xffff0000u); }
DI u32x4 pack8f(f32x4 a, f32x4 b) { u32x4 w; w.x = cvtpk(a[0], a[1]); w.y = cvtpk(a[2], a[3]); w.z = cvtpk(b[0], b[1]); w.w = cvtpk(b[2], b[3]); return w; }
DI float frcp_(float x) { return __builtin_amdgcn_rcpf(x); }
DI float sigmoidf_(float x) { return frcp_(1.0f + __builtin_amdgcn_exp2f(x * -1.4426950408889634f)); }
DI float siluf_(float x) { return x * sigmoidf_(x); }
DI void st16_sc1(void* p, u32x4 v) { asm volatile("global_store_dwordx4 %0, %1, off sc1\n\ts_nop 1" :: "v"(p), "v"(v) : "memory"); }
DI void st16_sc1f(void* p, f32x4 v) { asm volatile("global_store_dwordx4 %0, %1, off sc1\n\ts_nop 1" :: "v"(p), "v"(v) : "memory"); }
DI void st2_sc1(void* p, unsigned v) { asm volatile("global_store_short %0, %1, off sc1\n\ts_nop 1" :: "v"(p), "v"(v) : "memory"); }
constexpr size_t CTL_GRAN = 65536, CTL_CNT = 245760, CTL_SS1 = 458752;
static_assert(CTL_CNT + 5 * 130 * 256 <= CTL_SS1 && CTL_SS1 + 33280 * 4 <= 1048576 && CTL_GRAN + 2592 * 64 <= CTL_CNT, "control region map");
constexpr int CNT_STRIDE = 130 * 64;
DI int pos_of_d(int d) { const int dd = d & 31; return 8 * (dd >> 2) + (dd & 3) + ((d >> 5) << 2); }
DI int d_of_pos(int p) { const int j = p & 7; return 4 * (p >> 3) + (j & 3) + ((j >> 2) << 5); }
namespace pg8 {
#define PG8_LAS __attribute__((address_space(3)))
typedef unsigned short bf16_t;
typedef short bf16x8 __attribute__((ext_vector_type(8)));
typedef float f32x4 __attribute__((ext_vector_type(4)));
typedef unsigned u32x4 __attribute__((ext_vector_type(4)));
constexpr int BM = 256, BK = 64, HALF = 128, HTB = HALF * BK * 2  , STAGE_BYTES = 8 * HTB, NXCD = 8, WGM = 8;

__host__ __device__ __forceinline__ int lds_byte(int r, int c) { const int st = (r >> 4) * 2 + (c >> 5), rr = r & 15, cc = c & 31, ob = rr * 64 + cc * 2; return st * 1024 + (ob ^ (((ob >> 9) & 1) << 5)); }
__host__ __device__ __forceinline__ void stage_rc(int b, int& R, int& C) { const int st = b / 1024, sb = b % 1024, swz = sb ^ (((sb >> 9) & 1) << 5); R = (st >> 1) * 16 + swz / 64; C = (st & 1) * 32 + (swz % 64) / 2; }
__host__ __device__ __forceinline__ int perm32(int rho) { const int n = rho >> 4, i = rho & 15; return 8 * (i >> 2) + 4 * n + (i & 3); }

struct Unit { int pm, pn; };
struct Gemm { const bf16_t* A; const bf16_t* Bt; int M, N, K; };

struct StaticOrder {
    static constexpr bool A_SC1 = false;
    int nM, nN, nwg, G, c;
    __host__ __device__ void init(int M, int N, int G_, int c_) { nM = M / BM; nN = N / BM; nwg = nM * nN; G = G_; c = c_; }
    __host__ __device__ bool next(int i, Unit& u) const {
        const long L = (long)i * G + c; if (L >= nwg) return false;
        int wgid = (int)L; { const int q = nwg / NXCD, r = nwg % NXCD, xcd = wgid % NXCD, off = wgid / NXCD; wgid = (xcd < r ? xcd * (q + 1) : r * (q + 1) + (xcd - r) * q) + off; }
        const int nig = WGM * nN, gid = wgid / nig, fm = gid * WGM, gsz = (nM - fm) < WGM ? (nM - fm) : WGM;
        u.pm = fm + ((wgid % nig) % gsz); u.pn = (wgid % nig) / gsz; return true;
    }
    __device__ __forceinline__ void a_ready(const Unit&) const {}
    __device__ __forceinline__ void done(const Unit&) const {}
};
struct FlagOrder : StaticOrder {
    static constexpr bool A_SC1 = true;
    const unsigned* ready; unsigned need; unsigned* pub; unsigned* gpub;
    __device__ __forceinline__ void a_ready(const Unit& u) const {
        if (ready) {
            if (threadIdx.x < 64) { unsigned spins = 0;
                while ((unsigned)__builtin_amdgcn_readfirstlane(__hip_atomic_load(ready + 64 * u.pm, __ATOMIC_RELAXED, __HIP_MEMORY_SCOPE_AGENT)) < need) { __builtin_amdgcn_s_sleep(2); if (++spins > (1u << 22)) break; } }
            asm volatile("" ::: "memory"); __builtin_amdgcn_s_barrier(); asm volatile("" ::: "memory");
        }
    }
    __device__ __forceinline__ void done(const Unit& u) const {
        if (pub) { asm volatile("s_waitcnt vmcnt(0)" ::: "memory");
            if ((threadIdx.x & 63) == 0) { __hip_atomic_fetch_add(pub + 64 * u.pm, 1u, __ATOMIC_RELAXED, __HIP_MEMORY_SCOPE_AGENT); if (gpub) __hip_atomic_fetch_add(gpub, 1u, __ATOMIC_RELAXED, __HIP_MEMORY_SCOPE_AGENT); } }
    }
};

__device__ __forceinline__ void urow_info(int urow, int& kind, int& b, int& t, int& ridx) {
    if (urow < MP) { b = urow / TP; t = urow - b * TP; kind = 0; ridx = t; }
    else if (urow < MU) { const int s = urow - MP; b = s >> 2; t = s & 3; kind = 1; ridx = TP + t; }
    else { kind = 2; b = 0; t = 0; ridx = 0; }
}
__device__ __forceinline__ int crow_to_urow(int crow) { return crow < NBATCH * SEQ ? crow + NMETA * ((crow >> 12) + 1) : MP + (crow - NBATCH * SEQ); }

struct EpiInProj {
    static constexpr bool PERM = true, AFTER_DRAIN = false;
    bf16_t *QA, *KV, *QKVB, *Z, *G; const float *COS, *SIN; float* out;
    __device__ __forceinline__ void operator()(const f32x4 (&acc)[2][2][4][2], const Unit& u, int wr, int wc, int fr, int fq) const {
        const int pn = u.pn;
#pragma unroll
        for (int ai = 0; ai < 2; ++ai)
#pragma unroll
            for (int m = 0; m < 4; ++m) {
                const int row = u.pm * BM + ai * HALF + wr * 64 + m * 16 + fr;
                int kind, b, t, ridx; urow_info(row, kind, b, t, ridx);
#pragma unroll
                for (int bj = 0; bj < 2; ++bj) {
                    const int cl = bj * HALF + wc * 32 + 8 * fq;
                    const f32x4 v0 = acc[ai][bj][m][0], v1 = acc[ai][bj][m][1];
                    if (pn < 2) {
                        const int c = pn * 256 + cl, d0 = ((c & 63) >> 3) * 4;
                        const f32x4 cs = *(const f32x4*)(COS + ridx * 32 + d0), sn = *(const f32x4*)(SIN + ridx * 32 + d0);
                        const f32x4 o1 = (v0 * cs - v1 * sn) * QSCALE, o2 = (v1 * cs + v0 * sn) * QSCALE;
                        *(u32x4*)(QA + (size_t)row * 512 + c) = pack8f(o1, o2);
                    } else if (pn == 2) {
                        if (bj == 0) {
                            const int kh = cl >> 6, d0 = ((cl & 63) >> 3) * 4;
                            const f32x4 cs = *(const f32x4*)(COS + ridx * 32 + d0), sn = *(const f32x4*)(SIN + ridx * 32 + d0);
                            const f32x4 o1 = v0 * cs - v1 * sn, o2 = v1 * cs + v0 * sn;
                            *(u32x4*)(KV + (size_t)row * 256 + cl) = pack8f(o1, o2);
                            float* dst = nullptr;
                            if (kind == 0 && t >= TP - 128) dst = out + O_KP + ((size_t)(b * 128 + (t - (TP - 128))) * 2 + kh) * 64;
                            else if (kind == 1) dst = out + O_KS + ((size_t)(b * 128 + 124 + t) * 2 + kh) * 64;
                            if (dst) { *(f32x4*)(dst + d0) = o1; *(f32x4*)(dst + 32 + d0) = o2; }
                        } else {
                            const int cv = cl - 128, kh = cv >> 6, dd = cv & 63;
                            *(u32x4*)(KV + (size_t)row * 256 + cl) = pack8f(v0, v1);
                            float* dst = nullptr;
                            if (kind == 0 && t >= TP - 128) dst = out + O_VP + ((size_t)(b * 128 + (t - (TP - 128))) * 2 + kh) * 64;
                            else if (kind == 1) dst = out + O_VS + ((size_t)(b * 128 + 124 + t) * 2 + kh) * 64;
                            if (dst) { *(f32x4*)(dst + dd) = v0; *(f32x4*)(dst + dd + 4) = v1; }
                        }
                    } else if (pn < 9) {
                        const int c = (pn - 3) * 256 + cl;
                        *(u32x4*)(QKVB + (size_t)row * 1536 + c) = pack8f(v0, v1);
                        float* dst = nullptr;
                        if (kind == 0 && t >= TP - 3) dst = out + O_CP + ((size_t)b * 3 + (t - (TP - 3))) * 1536;
                        else if (kind == 1 && t >= 1) dst = out + O_CS + ((size_t)b * 3 + (t - 1)) * 1536;
                        if (dst) { *(f32x4*)(dst + c) = v0; *(f32x4*)(dst + c + 4) = v1; }
                    } else if (pn < 11) {
                        const int c = (pn - 9) * 256 + cl;
                        *(u32x4*)(Z + (size_t)row * 512 + c) = pack8f(v0, v1);
                    } else {
                        const int c = (pn - 11) * 256 + cl;
                        f32x4 g0, g1;
#pragma unroll
                        for (int e = 0; e < 4; ++e) { g0[e] = sigmoidf_(v0[e]); g1[e] = sigmoidf_(v1[e]); }
                        *(u32x4*)(G + (size_t)row * 2048 + c) = pack8f(g0, g1);
                    }
                }
            }
    }
};

template <bool ACCUM> struct EpiMerge {
    static constexpr bool PERM = true, AFTER_DRAIN = false;
    bf16_t* MBp; const bf16_t* G; int gate_off;
    __device__ __forceinline__ void operator()(const f32x4 (&acc)[2][2][4][2], const Unit& u, int wr, int wc, int fr, int fq) const {
#pragma unroll
        for (int ai = 0; ai < 2; ++ai)
#pragma unroll
            for (int m = 0; m < 4; ++m) {
                const int crow = u.pm * BM + ai * HALF + wr * 64 + m * 16 + fr, urow = crow_to_urow(crow);
#pragma unroll
                for (int bj = 0; bj < 2; ++bj) {
                    const int c = u.pn * BM + bj * HALF + wc * 32 + 8 * fq;
                    const u32x4 gw = *(const u32x4*)(G + (size_t)urow * 2048 + gate_off + c);
                    f32x4 v0 = acc[ai][bj][m][0], v1 = acc[ai][bj][m][1];
                    v0[0] *= bflo(gw.x); v0[1] *= bfhi(gw.x); v0[2] *= bflo(gw.y); v0[3] *= bfhi(gw.y);
                    v1[0] *= bflo(gw.z); v1[1] *= bfhi(gw.z); v1[2] *= bflo(gw.w); v1[3] *= bfhi(gw.w);
                    bf16_t* p = MBp + (size_t)crow * 1024 + c;
                    if (ACCUM) { const u32x4 pw = *(const u32x4*)p;
                        v0[0] += bflo(pw.x); v0[1] += bfhi(pw.x); v0[2] += bflo(pw.y); v0[3] += bfhi(pw.y);
                        v1[0] += bflo(pw.z); v1[1] += bfhi(pw.z); v1[2] += bflo(pw.w); v1[3] += bfhi(pw.w); }
                    *(u32x4*)p = pack8f(v0, v1);
                }
            }
    }
};

template <bool ATOM = true> struct EpiWout {
    static constexpr bool PERM = true, AFTER_DRAIN = false;
    const float* xp; const float* xs; bf16_t* HB; float* SS;
    __device__ __forceinline__ void operator()(const f32x4 (&acc)[2][2][4][2], const Unit& u, int wr, int wc, int fr, int fq) const {
#pragma unroll
        for (int ai = 0; ai < 2; ++ai)
#pragma unroll
            for (int m = 0; m < 4; ++m) {
                const int crow = u.pm * BM + ai * HALF + wr * 64 + m * 16 + fr;
                const float* hs = crow < NBATCH * SEQ ? xp + (size_t)crow * D : xs + (size_t)(crow - NBATCH * SEQ) * D;
                float ss = 0.f;
#pragma unroll
                for (int bj = 0; bj < 2; ++bj) {
                    const int c = u.pn * BM + bj * HALF + wc * 32 + 8 * fq;
                    const f32x4 r0 = *(const f32x4*)(hs + c) + acc[ai][bj][m][0], r1 = *(const f32x4*)(hs + c + 4) + acc[ai][bj][m][1];
                    *(u32x4*)(HB + (size_t)crow * D + c) = pack8f(r0, r1);
                    ss += (r0[0] * r0[0] + r0[1] * r0[1]) + (r0[2] * r0[2] + r0[3] * r0[3]) + (r1[0] * r1[0] + r1[1] * r1[1]) + (r1[2] * r1[2] + r1[3] * r1[3]);
                }
                ss += __shfl_xor(ss, 16); ss += __shfl_xor(ss, 32);
                if (ATOM && fq == 0) atomicAdd(SS + crow, ss);
            }
    }
};

struct EpiGateUp {
    static constexpr bool PERM = true, AFTER_DRAIN = false;
    bf16_t* ACT; const float* SS;
    __device__ __forceinline__ void operator()(const f32x4 (&acc)[2][2][4][2], const Unit& u, int wr, int wc, int fr, int fq) const {
#pragma unroll
        for (int ai = 0; ai < 2; ++ai)
#pragma unroll
            for (int m = 0; m < 4; ++m) {
                const int crow = u.pm * BM + ai * HALF + wr * 64 + m * 16 + fr;
                const float rstd = rsqrtf(SS[crow] * (1.0f / D) + EPS);
                f32x4 a[2];
#pragma unroll
                for (int n = 0; n < 2; ++n)
#pragma unroll
                    for (int e = 0; e < 4; ++e) { const float g = acc[ai][0][m][n][e] * rstd, up = acc[ai][1][m][n][e] * rstd; a[n][e] = siluf_(g) * up; }
                *(u32x4*)(ACT + (size_t)crow * DFF + u.pn * HALF + wc * 32 + 8 * fq) = pack8f(a[0], a[1]);
            }
    }
};

template <bool DRY = false> struct EpiDown {
    static constexpr bool PERM = true, AFTER_DRAIN = false;
    const bf16_t* HB; float* H;
    __device__ __forceinline__ void operator()(const f32x4 (&acc)[2][2][4][2], const Unit& u, int wr, int wc, int fr, int fq) const {
#pragma unroll
        for (int ai = 0; ai < 2; ++ai)
#pragma unroll
            for (int m = 0; m < 4; ++m) {
                const int crow = u.pm * BM + ai * HALF + wr * 64 + m * 16 + fr;
#pragma unroll
                for (int bj = 0; bj < 2; ++bj) {
                    const size_t off = (size_t)crow * D + u.pn * BM + bj * HALF + wc * 32 + 8 * fq;
                    const u32x4 hw = *(const u32x4*)(HB + off);
                    f32x4 r0 = acc[ai][bj][m][0], r1 = acc[ai][bj][m][1];
                    r0[0] += bflo(hw.x); r0[1] += bfhi(hw.x); r0[2] += bflo(hw.y); r0[3] += bfhi(hw.y);
                    r1[0] += bflo(hw.z); r1[1] += bfhi(hw.z); r1[2] += bflo(hw.w); r1[3] += bfhi(hw.w);
                    *(f32x4*)(H + off) = r0; *(f32x4*)(H + off + 4) = r1;
                }
            }
    }
};
template <class Epi, class Sched, bool ALIGN_EPI = false, bool SP2 = false>
__device__ __forceinline__ void gemm_phase(PG8_LAS unsigned char* lds, const Gemm g, const Sched& S, const Epi& E) {
    const int tid = threadIdx.x, wid = __builtin_amdgcn_readfirstlane(tid >> 6), lane = tid & 63, wr = wid >> 2, wc = wid & 3, fr = lane & 15, fq = lane >> 4;
    const int K = g.K, nt = K / BK;
    unsigned voffA[2], voffB[2];
#pragma unroll
    for (int i = 0; i < 2; ++i) { int R, C; stage_rc(tid * 16 + i * 8192, R, C); const int Rb = Epi::PERM ? ((R & ~31) + perm32(R & 31)) : R;
        voffA[i] = (unsigned)(R * K + C) * 2u; voffB[i] = (unsigned)(Rb * K + C) * 2u; }
    const size_t kstep = (size_t)(BK * 2);
    const size_t hstep = (size_t)HALF * K * 2;
    const size_t tstep = 2 * hstep;
    const unsigned ldsw = (unsigned)wid * 1024u;
    const int aoff = lds_byte(wr * 64 + fr, fq * 8), boff = lds_byte(wc * 32 + fr, fq * 8);
#define PG8_SA(b, h) (((b) * 2 + (h)) * HTB)
#define PG8_SB(b, h) ((4 + (b) * 2 + (h)) * HTB)
#define PG8_STAGE(bufoff, gbase, voff) do { _Pragma("unroll") for (int _i = 0; _i < 2; ++_i) \
        __builtin_amdgcn_global_load_lds((const unsigned*)((const char*)(gbase) + (voff)[_i]), (PG8_LAS unsigned*)(lds + (bufoff) + ldsw + _i * 8192), 16, 0, 0); } while (0)
#define PG8_STAGE_A(bufoff, gbase, voff) do { _Pragma("unroll") for (int _i = 0; _i < 2; ++_i) { \
        if constexpr (Sched::A_SC1) __builtin_amdgcn_global_load_lds((const unsigned*)((const char*)(gbase) + (voff)[_i]), (PG8_LAS unsigned*)(lds + (bufoff) + ldsw + _i * 8192), 16, 0, 16); \
        else __builtin_amdgcn_global_load_lds((const unsigned*)((const char*)(gbase) + (voff)[_i]), (PG8_LAS unsigned*)(lds + (bufoff) + ldsw + _i * 8192), 16, 0, 0); } } while (0)
#define PG8_LDA(dst, b, h) do { _Pragma("unroll") for (int m = 0; m < 4; ++m) _Pragma("unroll") for (int k = 0; k < 2; ++k) dst[m][k] = *(const PG8_LAS bf16x8*)(lds + PG8_SA(b, h) + aoff + m * 2048 + k * 1024); } while (0)
#define PG8_LDB(dst, b, h) do { _Pragma("unroll") for (int n = 0; n < 2; ++n) _Pragma("unroll") for (int k = 0; k < 2; ++k) dst[n][k] = *(const PG8_LAS bf16x8*)(lds + PG8_SB(b, h) + boff + n * 2048 + k * 1024); } while (0)
#define PG8_MMA(ai, bj, At, Bt) do { __builtin_amdgcn_s_setprio(1); _Pragma("unroll") for (int m = 0; m < 4; ++m) _Pragma("unroll") for (int n = 0; n < 2; ++n) _Pragma("unroll") for (int k = 0; k < 2; ++k) \
        acc[ai][bj][m][n] = __builtin_amdgcn_mfma_f32_16x16x32_bf16(Bt[n][k], At[m][k], acc[ai][bj][m][n], 0, 0, 0); __builtin_amdgcn_s_setprio(0); } while (0)
#define PG8_WAIT_V(n) asm volatile("s_waitcnt vmcnt(" #n ")" ::: "memory")
#define PG8_WAIT_L(n) asm volatile("s_waitcnt lgkmcnt(" #n ")" ::: "memory")
#define PG8_BAR __builtin_amdgcn_s_barrier()
#define PG8_SCHED __builtin_amdgcn_sched_barrier(0)
    Unit cur, nxt; int ui = 0;
    if (!S.next(0, cur)) return;
    f32x4 acc[2][2][4][2];
#pragma unroll
    for (int a = 0; a < 2; ++a)
#pragma unroll
        for (int b = 0; b < 2; ++b)
#pragma unroll
            for (int m = 0; m < 4; ++m)
#pragma unroll
                for (int n = 0; n < 2; ++n) acc[a][b][m][n] = (f32x4){0.f, 0.f, 0.f, 0.f};
    bf16x8 At[4][2], B0[2][2], B1[2][2];
    const char* cA = (const char*)g.A + (size_t)cur.pm * tstep; const char* cB = (const char*)g.Bt + (size_t)cur.pn * tstep;
    S.a_ready(cur);
    if constexpr (SP2) {
        PG8_STAGE(PG8_SB(0, 0), cB, voffB); PG8_STAGE(PG8_SB(0, 1), cB + hstep, voffB); PG8_STAGE_A(PG8_SA(0, 0), cA, voffA); PG8_STAGE_A(PG8_SA(0, 1), cA + hstep, voffA);
        if (wr == 1) PG8_BAR;
        PG8_WAIT_V(2); PG8_BAR;
        PG8_STAGE(PG8_SB(1, 0), cB + kstep, voffB); PG8_STAGE_A(PG8_SA(1, 0), cA + kstep, voffA); PG8_STAGE(PG8_SB(1, 1), cB + hstep + kstep, voffB);
        PG8_WAIT_V(6); PG8_BAR;
    } else {
        PG8_STAGE(PG8_SB(0, 0), cB, voffB); PG8_STAGE_A(PG8_SA(0, 0), cA, voffA); PG8_STAGE(PG8_SB(0, 1), cB + hstep, voffB); PG8_STAGE_A(PG8_SA(0, 1), cA + hstep, voffA);
        if (wr == 1) PG8_BAR;
        PG8_WAIT_V(4); PG8_BAR;
        PG8_STAGE(PG8_SB(1, 0), cB + kstep, voffB); PG8_STAGE_A(PG8_SA(1, 0), cA + kstep, voffA); PG8_STAGE(PG8_SB(1, 1), cB + hstep + kstep, voffB);
        PG8_WAIT_V(6); PG8_BAR;
    }
    for (;;) {
        const bool has_next = S.next(ui + 1, nxt);
        const char* nA = has_next ? (const char*)g.A + (size_t)nxt.pm * tstep : cA; const char* nB = has_next ? (const char*)g.Bt + (size_t)nxt.pn * tstep : cB;
        for (int t = 0; t < nt; t += 2) {
            const bool last = (t == nt - 2);
            const char* a1 = cA + (size_t)(t + 1) * kstep;
            const char* a2 = last ? nA : cA + (size_t)(t + 2) * kstep; const char* b2 = last ? nB : cB + (size_t)(t + 2) * kstep;
            const char* a3 = a2 + kstep; const char* b3 = b2 + kstep;
            if (last && has_next) S.a_ready(nxt);
            if constexpr (SP2) {
            PG8_LDB(B0, 0, 0); PG8_LDB(B1, 0, 1); PG8_SCHED; PG8_LDA(At, 0, 0); PG8_STAGE_A(PG8_SA(1, 1), a1 + hstep, voffA);
            PG8_WAIT_V(8); PG8_WAIT_L(0); PG8_BAR; PG8_MMA(0, 0, At, B0); PG8_MMA(0, 1, At, B1); PG8_BAR; PG8_SCHED;
            PG8_LDA(At, 0, 1); PG8_STAGE(PG8_SB(0, 0), b2, voffB); PG8_STAGE(PG8_SB(0, 1), b2 + hstep, voffB); PG8_STAGE_A(PG8_SA(0, 0), a2, voffA);
            PG8_WAIT_V(8); PG8_WAIT_L(0); PG8_BAR; PG8_MMA(1, 0, At, B0); PG8_MMA(1, 1, At, B1); PG8_BAR; PG8_SCHED;
            PG8_LDB(B0, 1, 0); PG8_LDB(B1, 1, 1); PG8_SCHED; PG8_LDA(At, 1, 0); PG8_STAGE_A(PG8_SA(0, 1), a2 + hstep, voffA);
            PG8_WAIT_V(8); PG8_WAIT_L(0); PG8_BAR; PG8_MMA(0, 0, At, B0); PG8_MMA(0, 1, At, B1); PG8_BAR; PG8_SCHED;
            PG8_LDA(At, 1, 1); PG8_STAGE(PG8_SB(1, 0), b3, voffB); PG8_STAGE(PG8_SB(1, 1), b3 + hstep, voffB); PG8_STAGE_A(PG8_SA(1, 0), a3, voffA);
            PG8_WAIT_V(8); PG8_WAIT_L(0); PG8_BAR; PG8_MMA(1, 0, At, B0); PG8_MMA(1, 1, At, B1); PG8_BAR; PG8_SCHED;
            } else {
            PG8_LDB(B0, 0, 0); PG8_SCHED; PG8_LDA(At, 0, 0); PG8_STAGE_A(PG8_SA(1, 1), a1 + hstep, voffA);
            PG8_WAIT_L(8); PG8_BAR; PG8_WAIT_L(0); PG8_MMA(0, 0, At, B0); PG8_BAR; PG8_SCHED;
            PG8_LDB(B1, 0, 1); PG8_STAGE(PG8_SB(0, 0), b2, voffB);
            PG8_BAR; PG8_WAIT_L(0); PG8_MMA(0, 1, At, B1); PG8_BAR;
            PG8_LDA(At, 0, 1); PG8_STAGE_A(PG8_SA(0, 0), a2, voffA);
            PG8_BAR; PG8_WAIT_L(0); PG8_MMA(1, 0, At, B0); PG8_BAR; PG8_SCHED;
            PG8_STAGE(PG8_SB(0, 1), b2 + hstep, voffB);
            PG8_WAIT_V(6); PG8_BAR; PG8_MMA(1, 1, At, B1); PG8_BAR;
            PG8_LDB(B0, 1, 0); PG8_SCHED; PG8_LDA(At, 1, 0); PG8_STAGE_A(PG8_SA(0, 1), a2 + hstep, voffA);
            PG8_WAIT_L(8); PG8_BAR; PG8_WAIT_L(0); PG8_MMA(0, 0, At, B0); PG8_BAR; PG8_SCHED;
            PG8_LDB(B1, 1, 1); PG8_STAGE(PG8_SB(1, 0), b3, voffB);
            PG8_BAR; PG8_WAIT_L(0); PG8_MMA(0, 1, At, B1); PG8_BAR;
            PG8_LDA(At, 1, 1); PG8_STAGE_A(PG8_SA(1, 0), a3, voffA);
            PG8_BAR; PG8_WAIT_L(0); PG8_MMA(1, 0, At, B0); PG8_BAR; PG8_SCHED;
            PG8_STAGE(PG8_SB(1, 1), b3 + hstep, voffB);
            PG8_WAIT_V(6); PG8_BAR; PG8_MMA(1, 1, At, B1); PG8_BAR;
            }
        }
        if constexpr (ALIGN_EPI) { if (wr == 0) PG8_BAR; }
        if constexpr (!Epi::AFTER_DRAIN) { E(acc, cur, wr, wc, fr, fq); S.done(cur); }
        if (!has_next) break;
#pragma unroll
        for (int a = 0; a < 2; ++a)
#pragma unroll
            for (int b = 0; b < 2; ++b)
#pragma unroll
                for (int m = 0; m < 4; ++m)
#pragma unroll
                    for (int n = 0; n < 2; ++n) acc[a][b][m][n] = (f32x4){0.f, 0.f, 0.f, 0.f};
        cur = nxt; cA = nA; cB = nB; ++ui;
        if constexpr (ALIGN_EPI) { if (wr == 1) PG8_BAR; }
    }
    PG8_WAIT_V(0);
    if constexpr (!ALIGN_EPI) { if (wr == 0) PG8_BAR; }
    PG8_BAR;
    if constexpr (Epi::AFTER_DRAIN) { E.fused(acc, cur, wr, wc, fr, fq, lds, wid, lane); S.done(cur); }
#undef PG8_SA
#undef PG8_SB
#undef PG8_STAGE
#undef PG8_STAGE_A
#undef PG8_LDA
#undef PG8_LDB
#undef PG8_MMA
#undef PG8_WAIT_V
#undef PG8_WAIT_L
#undef PG8_BAR
#undef PG8_SCHED
}
}
constexpr int NWAVES = 8, NTHREADS = NWAVES * 64;
constexpr int LDS_BYTES = 147456;
constexpr int LDS_MISC = 131072;
constexpr int N_PHASES = 9;

struct Args {
    const float *x_prompt, *x_sample, *cache_k, *cache_v, *state_delta, *state_conv, *meta, *norm_mix, *w_in, *conv_w, *a_log, *dt_bias, *sinks, *gdn_norm,
                *w_oa, *w_ob, *w_out, *norm_ffn, *w_gate, *w_up, *w_down, *norm_final;
    float* out; unsigned char* ws; int ph_lo, ph_hi;
};

typedef const __attribute__((address_space(4))) Args* KA;
DI KA kargs() { KA p = (KA)__builtin_amdgcn_kernarg_segment_ptr(); asm volatile("" : "+s"(p)); return p; }
#define RLX_AGENT __ATOMIC_RELAXED, __HIP_MEMORY_SCOPE_AGENT
#define LDS_WAIT() asm volatile("s_waitcnt lgkmcnt(0)" ::: "memory")
#define MFMA32(a, b, c) __builtin_amdgcn_mfma_f32_32x32x16_bf16((a), (b), (c), 0, 0, 0)
DI int crow16(int reg, int h) { return (reg & 3) + 8 * (reg >> 2) + 4 * h; }
DI float wave_sum(float v) {
#pragma unroll
    for (int o = 1; o < 64; o <<= 1) v += __shfl_xor(v, o);
    return v;
}
DI float wave_max(float v) {
#pragma unroll
    for (int o = 1; o < 64; o <<= 1) v = fmaxf(v, __shfl_xor(v, o));
    return v;
}
template <int S> DI bf16x8 pack_step(const f32x16& x) {
    u32x4 p; p.x = cvtpk(x[8 * S], x[8 * S + 1]); p.y = cvtpk(x[8 * S + 2], x[8 * S + 3]); p.z = cvtpk(x[8 * S + 4], x[8 * S + 5]); p.w = cvtpk(x[8 * S + 6], x[8 * S + 7]);
    return __builtin_bit_cast(bf16x8, p);
}
DI int frag_idx(int row, int k, int NKS) { const int kkk = k & 15; return (((row >> 5) * NKS + (k >> 4)) * 64 + (row & 31) + 32 * ((kkk >> 2) & 1)) * 8 + (((kkk >> 3) << 2) | (kkk & 3)); }
DI unsigned char* slot_ptr(KA A, int item) { return item < PREP_N1 ? A->ws + WS_B + (size_t)item * PREP_SLOT : (unsigned char*)A->out + (size_t)(item - PREP_N1) * PREP_SLOT; }

#define XB_TMO      128
#define XB_XCNT(j)  (256  + 64 * (j))
#define XB_XSUB(j)  (1280 + 64 * (j))
#define XB_XGEN(j)  (2304 + 64 * (j))
#define XB_TOP      3328
#define XB_TOPGEN   3392
#define XCD_BAR_WORDS 3456
#define XB_SPIN_CAP (1u << 20)
DI unsigned xb_ld(unsigned* p)              { return __hip_atomic_load(p, __ATOMIC_RELAXED, __HIP_MEMORY_SCOPE_AGENT); }
DI unsigned xb_add(unsigned* p, unsigned v) { return __hip_atomic_fetch_add(p, v, __ATOMIC_RELAXED, __HIP_MEMORY_SCOPE_AGENT); }
DI unsigned xb_xcc_id() { return (unsigned)__builtin_amdgcn_s_getreg((3 << 11) | 20) & 0xFu; }
#define XB_SPIN(cond, bar) do { unsigned _sp = 0; while (cond) { __builtin_amdgcn_s_sleep(1); \
    if ((++_sp & 255u) == 0u) { if (xb_ld(&(bar)[XB_TMO])) break; if (_sp > XB_SPIN_CAP) { atomicAdd(&(bar)[XB_TMO], 1u); break; } } } } while (0)
struct XcdBarrier { unsigned* bar; unsigned x; volatile LAS unsigned* st; };
DI XcdBarrier xcd_barrier_post(unsigned* bar, volatile LAS unsigned* st) {
    XcdBarrier b; b.bar = bar; b.x = xb_xcc_id(); b.st = st;
    if (threadIdx.x == 0) (void)xb_add(&bar[XB_XCNT(b.x)], 1u);
    return b;
}
DI void xcd_barrier_complete(unsigned* bar, unsigned x, unsigned& nloc, unsigned& nx) {
    const unsigned G = gridDim.x * gridDim.y * gridDim.z;
    unsigned sum, cnt, mine, sp = 0u;
    for (;;) {
        sum = 0u; cnt = 0u; mine = 0u;
#pragma unroll
        for (unsigned j = 0; j < 16; ++j) { const unsigned c = xb_ld(&bar[XB_XCNT(j)]); sum += c; cnt += (c > 0u) ? 1u : 0u; mine = (j == x) ? c : mine; }
        if (sum == G) break;
        __builtin_amdgcn_s_sleep(1);
        if ((++sp & 255u) == 0u) { if (xb_ld(&bar[XB_TMO])) break; if (sp > XB_SPIN_CAP) { atomicAdd(&bar[XB_TMO], 1u); break; } }
    }
    nloc = mine > 0u ? mine : 1u; nx = cnt > 0u ? cnt : 1u;
}
DI void xcd_barrier(const XcdBarrier& b) {
    asm volatile("s_waitcnt vmcnt(0)" ::: "memory");
    __syncthreads();
    if (threadIdx.x == 0) {
        unsigned* bar = b.bar;
        __builtin_amdgcn_s_waitcnt(0);
        unsigned nloc = b.st[0], nx = b.st[1];
        if (nloc == 0u) { xcd_barrier_complete(bar, b.x, nloc, nx); b.st[0] = nloc; b.st[1] = nx; }
        const unsigned old = xb_add(&bar[XB_XSUB(b.x)], 1u);
        const unsigned gen = old / nloc;
        if (old + 1u == (gen + 1u) * nloc) {
            __builtin_amdgcn_fence(__ATOMIC_RELEASE, "agent");
            asm volatile("s_waitcnt vmcnt(0)" ::: "memory");
            const unsigned og = xb_add(&bar[XB_TOP], 1u);
            const unsigned tg = og / nx;
            if (og + 1u == (tg + 1u) * nx) xb_add(&bar[XB_TOPGEN], 1u);
            else XB_SPIN(xb_ld(&bar[XB_TOPGEN]) == tg, bar);
            __builtin_amdgcn_fence(__ATOMIC_ACQUIRE, "agent");
            xb_add(&bar[XB_XGEN(b.x)], 1u);
            asm volatile("s_waitcnt vmcnt(0)" ::: "memory");
        } else {
            XB_SPIN(xb_ld(&bar[XB_XGEN(b.x)]) == gen, bar);
            __builtin_amdgcn_fence(__ATOMIC_ACQUIRE, "agent");
            asm volatile("s_waitcnt vmcnt(0)" ::: "memory");
        }
    }
    __syncthreads();
}

template <class RowMap> DI void transpose_item(const float* W, int K, int N, bf16* WT, RowMap rm, const float* kscale, LAS float* scr, int item, int lane) {
    const int nblk = (N + 31) / 32, kb = item / nblk, nb = item - kb * nblk, k0 = 64 * kb, n0 = 32 * nb;
    const int ncol = n0 + (lane & 31);
#pragma unroll 8
    for (int i = 0; i < 32; ++i) { const int kk = 2 * i + (lane >> 5);
        float v = ncol < N ? W[(size_t)(k0 + kk) * N + ncol] : 0.f;
        if (kscale) v *= kscale[k0 + kk];
        scr[kk * 33 + (lane & 31)] = v; }
    LDS_WAIT(); asm volatile("" ::: "memory");
    const int c = lane & 7;
#pragma unroll
    for (int j = 0; j < 4; ++j) { const int n = (lane >> 3) + 8 * j; const LAS float* s = scr + (8 * c) * 33 + n;
        const int nsrc = n0 + n; const int drow = nsrc < N ? rm(nsrc) : -1;
        u32x4 o; o.x = cvtpk(s[0 * 33], s[1 * 33]); o.y = cvtpk(s[2 * 33], s[3 * 33]); o.z = cvtpk(s[4 * 33], s[5 * 33]); o.w = cvtpk(s[6 * 33], s[7 * 33]);
        if (drow >= 0) *(u32x4*)(WT + (size_t)drow * K + k0 + 8 * c) = o; }
    LDS_WAIT(); asm volatile("" ::: "memory");
}
DI float softplusf_(float x) { return x > 20.f ? x : log1pf(__expf(x)); }

#ifndef PROBE_REP
#define PROBE_REP -1
#endif
DI void p0_prologue(KA A, LAS unsigned char* lds) {
    const int tid = threadIdx.x, lane = tid & 63, wave = __builtin_amdgcn_readfirstlane(tid >> 6);
    const int G = gridDim.x, gw = blockIdx.x * NWAVES + wave, NGW = G * NWAVES;
    const int gt = blockIdx.x * NTHREADS + tid, NGT = G * NTHREADS;
    unsigned char* ws = A->ws;
    for (int rep = 0; rep < (PROBE_REP == 1001 ? 2 : 1); ++rep) {
        LAS float* scr = (LAS float*)(lds + wave * 16384);
        constexpr int I_IN = 16 * 153, I_OA = 8 * 32, I_OUT = 16 * 32, I_G = 16 * 88, I_D = 44 * 32;
        constexpr int NIT = I_IN + 2 * I_OA + I_OUT + 2 * I_G + I_D;
        for (int it = gw; it < NIT; it += NGW) {
            int r = it;
            if (r < I_IN) { transpose_item(A->w_in, 1024, NIN_SRC, (bf16*)(ws + WS_WIN), [](int c) -> int {
                    if (c < 640) return (c & ~63) + pos_of_d(c & 63);
                    if (c < 2816) return c;
                    if (c < 2824) return -1;
                    return c - 8; }, nullptr, scr, r, lane); continue; } r -= I_IN;
            if (r < I_OA) { transpose_item(A->w_oa, 512, 1024, (bf16*)(ws + WS_WOA), [](int c) -> int { return c; }, nullptr, scr, r, lane); continue; } r -= I_OA;
            if (r < I_OA) { transpose_item(A->w_ob, 512, 1024, (bf16*)(ws + WS_WOB), [](int c) -> int { return c; }, nullptr, scr, r, lane); continue; } r -= I_OA;
            if (r < I_OUT) { transpose_item(A->w_out, 1024, 1024, (bf16*)(ws + WS_WOUT), [](int c) -> int { return c; }, nullptr, scr, r, lane); continue; } r -= I_OUT;
            if (r < I_G) { transpose_item(A->w_gate, 1024, DFF, (bf16*)(ws + WS_WGU), [](int c) -> int { return 256 * (c >> 7) + (c & 127); }, A->norm_ffn, scr, r, lane); continue; } r -= I_G;
            if (r < I_G) { transpose_item(A->w_up, 1024, DFF, (bf16*)(ws + WS_WGU), [](int c) -> int { return 256 * (c >> 7) + 128 + (c & 127); }, A->norm_ffn, scr, r, lane); continue; } r -= I_G;
            transpose_item(A->w_down, DFF, 1024, (bf16*)(ws + WS_WD), [](int c) -> int { return c; }, nullptr, scr, r, lane);
        }
    }
    for (int rep = 0; rep < (PROBE_REP == 1002 ? 2 : 1); ++rep) {
        float* COS = (float*)(ws + WS_ROPE); float* SIN = COS + (TP + TS) * 32;
        for (int i = gt; i < (TP + TS) * 32; i += NGT) { const int ri = i >> 5, f = i & 31; const double pos = ri < TP ? (double)ri : (double)(PAST + ri - TP);
            const double inv = exp2(-(double)f * (13.287712379549449 / 32.0)), ang = pos * inv; COS[i] = (float)cos(ang); SIN[i] = (float)sin(ang); }
        constexpr int PERB = 124 * 128 / 4;
        for (int i = gt; i < SBATCH * PERB; i += NGT) { const int b = i / PERB, o = i - b * PERB;
            ((f32x4*)(A->out + O_KS))[(size_t)b * 4096 + o] = ((const f32x4*)A->cache_k)[(size_t)b * 4096 + 128 + o];
            ((f32x4*)(A->out + O_VS))[(size_t)b * 4096 + o] = ((const f32x4*)A->cache_v)[(size_t)b * 4096 + 128 + o]; }
    }
    for (int rep = 0; rep < (PROBE_REP == 1003 ? 2 : 1); ++rep) {
        unsigned wab[16][4];
        f32x4 nm[4];
#pragma unroll
        for (int j = 0; j < 4; ++j) {
            nm[j] = ((const f32x4*)A->norm_mix)[lane + 64 * j];
#pragma unroll
            for (int e = 0; e < 4; ++e) { const float* p = A->w_in + (size_t)(4 * (lane + 64 * j) + e) * NIN_SRC + 2816;
                const f32x4 a = *(const f32x4*)p, b = *(const f32x4*)(p + 4);
                wab[j * 4 + e][0] = cvtpk(a[0], a[1]); wab[j * 4 + e][1] = cvtpk(a[2], a[3]); wab[j * 4 + e][2] = cvtpk(b[0], b[1]); wab[j * 4 + e][3] = cvtpk(b[2], b[3]); }
        }
        bf16* XN = (bf16*)(ws + WS_XN); f32x2* GB = (f32x2*)(ws + WS_GB);
        for (int urow = gw; urow < MUP; urow += NGW) {
            const float* src = nullptr;
            if (urow < MP) { const int b = urow / TP, t = urow - b * TP; src = t < NMETA ? A->meta + (size_t)t * D : A->x_prompt + ((size_t)b * SEQ + (t - NMETA)) * D; }
            else if (urow < MU) src = A->x_sample + (size_t)(urow - MP) * D;
            u32x2* o8 = (u32x2*)(XN + (size_t)urow * D) + lane;
            if (!src) {
#pragma unroll
                for (int j = 0; j < 4; ++j) o8[64 * j] = (u32x2){0u, 0u};
                if (lane < 4) GB[(size_t)urow * 4 + lane] = (f32x2){0.f, 0.f};
                continue; }
            f32x4 v[4]; float ss = 0.f;
#pragma unroll
            for (int j = 0; j < 4; ++j) { v[j] = ((const f32x4*)src)[lane + 64 * j]; ss += (v[j][0] * v[j][0] + v[j][1] * v[j][1]) + (v[j][2] * v[j][2] + v[j][3] * v[j][3]); }
            const float rstd = rsqrtf(wave_sum(ss) * (1.0f / D) + EPS);
            float dot[8];
#pragma unroll
            for (int c = 0; c < 8; ++c) dot[c] = 0.f;
#pragma unroll
            for (int j = 0; j < 4; ++j) { v[j] = v[j] * rstd * nm[j];
                o8[64 * j] = (u32x2){cvtpk(v[j][0], v[j][1]), cvtpk(v[j][2], v[j][3])};
#pragma unroll
                for (int e = 0; e < 4; ++e)
#pragma unroll
                    for (int c = 0; c < 4; ++c) { dot[2 * c] += v[j][e] * bflo(wab[j * 4 + e][c]); dot[2 * c + 1] += v[j][e] * bfhi(wab[j * 4 + e][c]); } }
#pragma unroll
            for (int c = 0; c < 8; ++c) dot[c] = wave_sum(dot[c]);
            if (lane < 4) {
                const float a = lane == 0 ? dot[0] : lane == 1 ? dot[1] : lane == 2 ? dot[2] : dot[3];
                const float bb = lane == 0 ? dot[4] : lane == 1 ? dot[5] : lane == 2 ? dot[6] : dot[7];
                const float g = -__expf(A->a_log[lane]) * softplusf_(a + A->dt_bias[lane]);
                GB[(size_t)urow * 4 + lane] = (f32x2){g, sigmoidf_(bb)};
            }
        }
    }
}
DI void item_decode(int item, int& b, int& h, bool& sample, int& t0, int& L) {
    if (item < N_ITEMS_P) { const int s = item / CHUNKS_P, c = item - s * CHUNKS_P; b = s >> 2; h = s & 3; sample = false; if (c == 0) { t0 = 0; L = NMETA; } else { t0 = NMETA + 64 * (c - 1); L = 64; } }
    else { const int s = item - N_ITEMS_P; b = s >> 2; h = s & 3; sample = true; t0 = 0; L = TS; }
}
#define LDS_BARRIER() do { asm volatile("s_waitcnt lgkmcnt(0)" ::: "memory"); __builtin_amdgcn_s_barrier(); asm volatile("" ::: "memory"); } while (0)
typedef GAS unsigned long long gu64;
DI gu64* item_granule(KA A, int item) { return (gu64*)(A->ws + WS_CTL + CTL_GRAN + (size_t)item * 64); }
DI float wait_item(gu64* g) {
    unsigned long long x; unsigned spins = 0;
    for (;;) { x = __hip_atomic_load(g, __ATOMIC_RELAXED, __HIP_MEMORY_SCOPE_AGENT); if ((x >> 32) != 0ull) break; __builtin_amdgcn_s_sleep(4); if (++spins > (1u << 20)) break; }
    asm volatile("" ::: "memory");
    return __uint_as_float((unsigned)__builtin_amdgcn_readfirstlane((int)(unsigned)x));
}
constexpr int LDS_GCL = 139264;
constexpr int PITCH = 132;
DI bf16x8 frag_nat(const LAS float* src, int row, int k0) {
    const f32x4 lo = *(const LAS f32x4*)(src + row * PITCH + k0), hi = *(const LAS f32x4*)(src + row * PITCH + k0 + 4);
    return __builtin_bit_cast(bf16x8, pack8f(lo, hi));
}
struct S1Pre { u32x4 xr[11]; f32x4 w[4][2]; f32x2 gb; };
DI void stage1_issue(KA A, int item, S1Pre& P) {
    const int tid = threadIdx.x, lane = tid & 63, wave = __builtin_amdgcn_readfirstlane(tid >> 6);
    int b, h, t0, L; bool sample; item_decode(item, b, h, sample, t0, L);
    const bf16* QKVB = (const bf16*)(A->ws + WS_QKVB);
    const int cv = lane < 48 ? lane : 47, grp = cv >> 4, col0 = (cv & 15) * 8, r0 = wave * 8, cidx = grp * 512 + h * 128 + col0;
#pragma unroll
    for (int q = 0; q < 11; ++q) {
        const int i = r0 - 3 + q;
        long urow = sample ? (long)MP + b * TS + i : (long)b * TP + t0 + i;
        const bool ok = sample ? i >= 0 : t0 + i >= 0;
        if (!ok) urow = 0;
        P.xr[q] = *(const u32x4*)(QKVB + (size_t)urow * CONVD + cidx);
        if (!ok) P.xr[q] = (u32x4){0u, 0u, 0u, 0u};
    }
#pragma unroll
    for (int i = 0; i < 4; ++i) { P.w[i][0] = *(const f32x4*)(A->conv_w + i * CONVD + cidx); P.w[i][1] = *(const f32x4*)(A->conv_w + i * CONVD + cidx + 4); }
    P.gb = (f32x2){0.f, 0.f};
    if (wave == 7 && lane < L) { const int urow = sample ? MP + b * TS + lane : b * TP + t0 + lane; P.gb = ((const f32x2*)(A->ws + WS_GB))[(size_t)urow * 4 + h]; }
}
DI void prep_stage1(KA A, int item, int next_item, int bslot, float* ats, S1Pre& P, LAS unsigned char* ldsb) {
    const int tid = threadIdx.x, lane = tid & 63, wave = __builtin_amdgcn_readfirstlane(tid >> 6), r = lane & 31, hh = lane >> 5;
    int b, h, t0, L; bool sample; item_decode(item, b, h, sample, t0, L);
    LAS float* Qs = (LAS float*)ldsb; LAS float* Ks = Qs + 64 * PITCH; LAS float* Vs = Ks + 64 * PITCH; LAS float* gcs = Vs + 64 * PITCH; LAS float* betas = gcs + 64;
    unsigned char* slot = slot_ptr(A, item);
    {
        const int cv = lane < 48 ? lane : 47, grp = cv >> 4, col0 = (cv & 15) * 8, r0 = wave * 8, cidx = grp * 512 + h * 128 + col0;
        float xf[3][8];
#pragma unroll
        for (int q = 0; q < 3; ++q) { xf[q][0] = bflo(P.xr[q].x); xf[q][1] = bfhi(P.xr[q].x); xf[q][2] = bflo(P.xr[q].y); xf[q][3] = bfhi(P.xr[q].y);
                                      xf[q][4] = bflo(P.xr[q].z); xf[q][5] = bfhi(P.xr[q].z); xf[q][6] = bflo(P.xr[q].w); xf[q][7] = bfhi(P.xr[q].w); }
        if (sample && wave == 0) {
#pragma unroll
            for (int q = 0; q < 3; ++q) { const float* sp = A->state_conv + ((size_t)b * 3 + q) * CONVD + cidx; const f32x4 s0 = *(const f32x4*)sp, s1 = *(const f32x4*)(sp + 4);
                xf[q][0] = s0[0]; xf[q][1] = s0[1]; xf[q][2] = s0[2]; xf[q][3] = s0[3]; xf[q][4] = s1[0]; xf[q][5] = s1[1]; xf[q][6] = s1[2]; xf[q][7] = s1[3]; }
        }
        float w[4][8];
#pragma unroll
        for (int i = 0; i < 4; ++i) { w[i][0] = P.w[i][0][0]; w[i][1] = P.w[i][0][1]; w[i][2] = P.w[i][0][2]; w[i][3] = P.w[i][0][3]; w[i][4] = P.w[i][1][0]; w[i][5] = P.w[i][1][1]; w[i][6] = P.w[i][1][2]; w[i][7] = P.w[i][1][3]; }
        LAS float* dst = Qs + grp * 64 * PITCH + col0;
        const float nsc = grp == 0 ? 0.08838834764831845f : 1.0f;
#pragma unroll
        for (int q = 3; q < 11; ++q) {
            const int rr = r0 + q - 3;
            float x[8] = {bflo(P.xr[q].x), bfhi(P.xr[q].x), bflo(P.xr[q].y), bfhi(P.xr[q].y), bflo(P.xr[q].z), bfhi(P.xr[q].z), bflo(P.xr[q].w), bfhi(P.xr[q].w)};
            float v[8]; float ss = 0.f;
#pragma unroll
            for (int e = 0; e < 8; ++e) { const float y = w[0][e] * xf[0][e] + w[1][e] * xf[1][e] + w[2][e] * xf[2][e] + w[3][e] * x[e];
                v[e] = rr < L ? siluf_(y) : 0.f; ss += v[e] * v[e];
                xf[0][e] = xf[1][e]; xf[1][e] = xf[2][e]; xf[2][e] = x[e]; }
            ss += __shfl_xor(ss, 1); ss += __shfl_xor(ss, 2); ss += __shfl_xor(ss, 4); ss += __shfl_xor(ss, 8);
            const float sc = grp == 2 ? 1.0f : rsqrtf(ss + EPS) * nsc;
            if (lane < 48) { *(LAS f32x4*)(dst + rr * PITCH) = (f32x4){v[0] * sc, v[1] * sc, v[2] * sc, v[3] * sc}; *(LAS f32x4*)(dst + rr * PITCH + 4) = (f32x4){v[4] * sc, v[5] * sc, v[6] * sc, v[7] * sc}; }
        }
    }
    if (wave == 7) {
        float gc = P.gb[0];
#pragma unroll
        for (int o = 1; o < 64; o <<= 1) { const float t = __shfl_up(gc, o); if (lane >= o) gc += t; }
        gcs[lane] = gc; betas[lane] = P.gb[1];
        if (lane == 63) ((LAS float*)(ldsb + LDS_GCL))[bslot] = __expf(gc);
    }
    if (next_item < N_ITEMS) stage1_issue(A, next_item, P);
    LDS_BARRIER();
    if (wave < 6) {
        const bool isqk = wave >= 3; const int tsel = isqk ? wave - 3 : wave, ib = tsel == 0 ? 0 : 1, jb = tsel == 2 ? 1 : 0;
        const LAS float* Asrc = isqk ? Qs : Ks;
        f32x16 acc;
#pragma unroll
        for (int e = 0; e < 16; ++e) acc[e] = 0.f;
#pragma unroll
        for (int s = 0; s < 8; ++s) acc = MFMA32(frag_nat(Asrc, 32 * ib + r, 16 * s + 8 * hh), frag_nat(Ks, 32 * jb + r, 16 * s + 8 * hh), acc);
        const int j = 32 * jb + r; const float gcj = gcs[j];
        float* Aout = ats + (ib + jb) * 1024; bf16* QKD = (bf16*)(slot + SL_QKD);
        if (!isqk) {
#pragma unroll
            for (int g4 = 0; g4 < 4; ++g4) { f32x4 v;
#pragma unroll
                for (int e = 0; e < 4; ++e) { const int i = 32 * ib + 8 * g4 + 4 * hh + e; v[e] = i > j ? betas[i] * __expf(fminf(gcs[i] - gcj, 0.f)) * acc[4 * g4 + e] : 0.f; }
                *(f32x4*)(Aout + r * 32 + 8 * g4 + 4 * hh) = v; }
        } else {
#pragma unroll
            for (int reg = 0; reg < 16; ++reg) { const int i = 32 * ib + crow16(reg, hh); const float dec = __expf(fminf(gcs[i] - gcj, 0.f));
                st2_sc1(QKD + frag_idx(i, j, 4), (unsigned)f2bf(i >= j ? dec * acc[reg] : 0.f)); }
        }
    }
    const float gcl = gcs[63];
#pragma unroll 1
    for (int job = wave; job < 56; job += 8) {
        if (job < 32) {
            const bool isq = job >= 16; const int jj = job & 15, rb = jj >> 3, ks = jj & 7, row = 32 * rb + r, k0 = 16 * ks + 4 * hh;
            const LAS float* src = isq ? Qs : Ks; const float sc = isq ? __expf(gcs[row]) : betas[row] * __expf(gcs[row]);
            const f32x4 lo = *(const LAS f32x4*)(src + row * PITCH + k0) * sc, hi = *(const LAS f32x4*)(src + row * PITCH + k0 + 8) * sc;
            st16_sc1(slot + (isq ? SL_QE : SL_BEK) + ((rb * 8 + ks) * 64 + lane) * 16, pack8f(lo, hi));
        } else if (job < 48) {
            const int jj = job - 32, rb = jj >> 2, ks = jj & 3, dk = 32 * rb + r;
            f32x4 lo, hi;
#pragma unroll
            for (int e = 0; e < 4; ++e) { const int j0 = 16 * ks + 4 * hh + e, j1 = j0 + 8;
                lo[e] = Ks[j0 * PITCH + dk] * __expf(gcl - gcs[j0]); hi[e] = Ks[j1 * PITCH + dk] * __expf(gcl - gcs[j1]); }
            st16_sc1(slot + SL_KWT + ((rb * 4 + ks) * 64 + lane) * 16, pack8f(lo, hi));
        } else {
            const int q = job - 48, w = q >> 1, ib = q & 1, dv = 32 * w + r;
            float v[16];
#pragma unroll
            for (int reg = 0; reg < 16; ++reg) { const int i = 32 * ib + crow16(reg, hh); v[reg] = betas[i] * Vs[i * PITCH + dv]; }
            u32x4* dst = (u32x4*)(slot + SL_BV + ((w * 2 + ib) * 64 + lane) * 32);
            st16_sc1(dst, (u32x4){cvtpk(v[0], v[1]), cvtpk(v[2], v[3]), cvtpk(v[4], v[5]), cvtpk(v[6], v[7])});
            st16_sc1(dst + 1, (u32x4){cvtpk(v[8], v[9]), cvtpk(v[10], v[11]), cvtpk(v[12], v[13]), cvtpk(v[14], v[15])});
        }
    }
    LDS_BARRIER();
}
DI void prep_stage2(KA A, int item, float gcl, const float* ats, LAS float* M) {
    int lane = threadIdx.x & 63; asm volatile("" : "+v"(lane));
    const int r = lane & 31, hh = lane >> 5;
    unsigned char* slot = slot_ptr(A, item);
    const f32x4* Ain = (const f32x4*)ats;
#pragma unroll
    for (int tt = 0; tt < 3; ++tt) { const int jb = tt >> 1, ib = (tt + 1) >> 1;
#pragma unroll
        for (int q = 0; q < 4; ++q) { const int idx = q * 64 + lane, jj = idx >> 3, i4 = idx & 7;
            *(LAS f32x4*)(M + (32 * jb + jj) * 64 + 32 * ib + 4 * i4) = Ain[tt * 256 + idx]; } }
    LDS_WAIT(); asm volatile("" ::: "memory");
#pragma unroll 1
    for (int rb = 0; rb < 4; ++rb) {
        float acc[16];
#pragma unroll
        for (int i = 0; i < 16; ++i) acc[i] = lane == 16 * rb + i ? 1.f : 0.f;
#pragma unroll 2
        for (int j = 0; j < 16 * rb; ++j) {
            float tj = M[j * 64 + lane]; tj = lane <= j ? tj : 0.f;
            const LAS f32x4* ar = (const LAS f32x4*)(M + j * 64 + 16 * rb);
            const f32x4 a0 = ar[0], a1 = ar[1], a2 = ar[2], a3 = ar[3];
#pragma unroll
            for (int e = 0; e < 4; ++e) { acc[e] -= a0[e] * tj; acc[4 + e] -= a1[e] * tj; acc[8 + e] -= a2[e] * tj; acc[12 + e] -= a3[e] * tj; }
        }
#pragma unroll
        for (int j = 0; j < 16; ++j) {
            const float tj = acc[j]; const int row = 16 * rb + j;
            const LAS f32x4* ar = (const LAS f32x4*)(M + row * 64 + 16 * rb);
            float a[16];
#pragma unroll
            for (int q = j >> 2; q < 4; ++q) { const f32x4 v = ar[q]; a[4 * q] = v[0]; a[4 * q + 1] = v[1]; a[4 * q + 2] = v[2]; a[4 * q + 3] = v[3]; }
            if (lane <= row) M[row * 64 + lane] = tj;
#pragma unroll
            for (int i = j + 1; i < 16; ++i) acc[i] -= a[i] * tj;
        }
        asm volatile("" ::: "memory");
    }
    LDS_WAIT(); asm volatile("" ::: "memory");
#pragma unroll
    for (int f = 0; f < 8; ++f) { const int rb = f >> 2, ks = f & 3, row = 32 * rb + r, k0 = 16 * ks + 4 * hh;
        f32x4 lo = *(const LAS f32x4*)(M + row * 64 + k0), hi = *(const LAS f32x4*)(M + row * 64 + k0 + 8);
#pragma unroll
        for (int e = 0; e < 4; ++e) { lo[e] = k0 + e <= row ? lo[e] : 0.f; hi[e] = k0 + 8 + e <= row ? hi[e] : 0.f; }
        st16_sc1(slot + SL_T + ((rb * 4 + ks) * 64 + lane) * 16, pack8f(lo, hi)); }
    LDS_WAIT();
    asm volatile("s_waitcnt vmcnt(0)" ::: "memory");
    if (lane == 0) __hip_atomic_store(item_granule(A, item), (1ull << 32) | (unsigned long long)__float_as_uint(gcl), __ATOMIC_RELAXED, __HIP_MEMORY_SCOPE_AGENT);
}
DI void scan_seq(KA A, int seq, int w, int lane) {
    const int r = lane & 31, hh = lane >> 5, dv = 32 * w + r;
    const bool sample = seq >= N_PROMPT_SEQ; const int sidx = sample ? seq - N_PROMPT_SEQ : seq, b = sidx >> 2, h = sidx & 3, nch = sample ? 1 : CHUNKS_P;
    f32x16 S[4];
    if (sample) {
        const float* S0 = A->state_delta + ((size_t)(b * 4 + h) * 128) * 128 + dv;
#pragma unroll
        for (int kb = 0; kb < 4; ++kb)
#pragma unroll
            for (int reg = 0; reg < 16; ++reg) S[kb][reg] = S0[(size_t)(32 * kb + crow16(reg, hh)) * 128];
    } else {
#pragma unroll
        for (int kb = 0; kb < 4; ++kb)
#pragma unroll
            for (int reg = 0; reg < 16; ++reg) S[kb][reg] = 0.f;
    }
    bf16* OBR = (bf16*)((unsigned char*)A->out + DO_OB);
#pragma unroll 1
    for (int c = 0; c < nch; ++c) {
        const int item = sample ? N_ITEMS_P + sidx : seq * CHUNKS_P + c;
        const unsigned char* slot = slot_ptr(A, item);
        const float gcl = wait_item(item_granule(A, item));
        __builtin_amdgcn_fence(__ATOMIC_ACQUIRE, "agent");
        const bf16x8* bek = (const bf16x8*)(slot + SL_BEK) + lane; const bf16x8* tp = (const bf16x8*)(slot + SL_T) + lane;
        const bf16x8* qe = (const bf16x8*)(slot + SL_QE) + lane; const bf16x8* qkd = (const bf16x8*)(slot + SL_QKD) + lane; const bf16x8* kwt = (const bf16x8*)(slot + SL_KWT) + lane;
        bf16x8 sf[8];
#pragma unroll
        for (int kb = 0; kb < 4; ++kb) { sf[2 * kb] = pack_step<0>(S[kb]); sf[2 * kb + 1] = pack_step<1>(S[kb]); }
        f32x16 x0, x1;
#pragma unroll
        for (int e = 0; e < 16; ++e) { x0[e] = 0.f; x1[e] = 0.f; }
#pragma unroll
        for (int ks = 0; ks < 8; ++ks) { x0 = MFMA32(bek[ks * 64], sf[ks], x0); x1 = MFMA32(bek[(8 + ks) * 64], sf[ks], x1); }
        {
            const u32x4* bv = (const u32x4*)(slot + SL_BV) + ((w * 2) * 64 + lane) * 2;
            const u32x4 a0 = bv[0], a1 = bv[1], c0 = bv[128], c1 = bv[129];
            x0[0] = bflo(a0.x) - x0[0]; x0[1] = bfhi(a0.x) - x0[1]; x0[2] = bflo(a0.y) - x0[2]; x0[3] = bfhi(a0.y) - x0[3];
            x0[4] = bflo(a0.z) - x0[4]; x0[5] = bfhi(a0.z) - x0[5]; x0[6] = bflo(a0.w) - x0[6]; x0[7] = bfhi(a0.w) - x0[7];
            x0[8] = bflo(a1.x) - x0[8]; x0[9] = bfhi(a1.x) - x0[9]; x0[10] = bflo(a1.y) - x0[10]; x0[11] = bfhi(a1.y) - x0[11];
            x0[12] = bflo(a1.z) - x0[12]; x0[13] = bfhi(a1.z) - x0[13]; x0[14] = bflo(a1.w) - x0[14]; x0[15] = bfhi(a1.w) - x0[15];
            x1[0] = bflo(c0.x) - x1[0]; x1[1] = bfhi(c0.x) - x1[1]; x1[2] = bflo(c0.y) - x1[2]; x1[3] = bfhi(c0.y) - x1[3];
            x1[4] = bflo(c0.z) - x1[4]; x1[5] = bfhi(c0.z) - x1[5]; x1[6] = bflo(c0.w) - x1[6]; x1[7] = bfhi(c0.w) - x1[7];
            x1[8] = bflo(c1.x) - x1[8]; x1[9] = bfhi(c1.x) - x1[9]; x1[10] = bflo(c1.y) - x1[10]; x1[11] = bfhi(c1.y) - x1[11];
            x1[12] = bflo(c1.z) - x1[12]; x1[13] = bfhi(c1.z) - x1[13]; x1[14] = bflo(c1.w) - x1[14]; x1[15] = bfhi(c1.w) - x1[15];
        }
        bf16x8 rf[4] = {pack_step<0>(x0), pack_step<1>(x0), pack_step<0>(x1), pack_step<1>(x1)};
        f32x16 u0, u1;
#pragma unroll
        for (int e = 0; e < 16; ++e) { u0[e] = 0.f; u1[e] = 0.f; }
        u0 = MFMA32(tp[0 * 64], rf[0], u0); u0 = MFMA32(tp[1 * 64], rf[1], u0);
#pragma unroll
        for (int ks = 0; ks < 4; ++ks) u1 = MFMA32(tp[(4 + ks) * 64], rf[ks], u1);
        bf16x8 uf[4] = {pack_step<0>(u0), pack_step<1>(u0), pack_step<0>(u1), pack_step<1>(u1)};
        if (sample || c > 0) {
#pragma unroll
            for (int e = 0; e < 16; ++e) { x0[e] = 0.f; x1[e] = 0.f; }
#pragma unroll
            for (int ks = 0; ks < 8; ++ks) { x0 = MFMA32(qe[ks * 64], sf[ks], x0); x1 = MFMA32(qe[(8 + ks) * 64], sf[ks], x1); }
            x0 = MFMA32(qkd[0 * 64], uf[0], x0); x0 = MFMA32(qkd[1 * 64], uf[1], x0);
#pragma unroll
            for (int ks = 0; ks < 4; ++ks) x1 = MFMA32(qkd[(4 + ks) * 64], uf[ks], x1);
            const int crow0 = sample ? NBATCH * SEQ + b * TS : b * SEQ + 64 * (c - 1), L = sample ? TS : 64;
#pragma unroll
            for (int reg = 0; reg < 16; ++reg) { const int i0 = crow16(reg, hh), i1 = 32 + i0;
                if (i0 < L) OBR[(size_t)(crow0 + i0) * 512 + h * 128 + dv] = f2bf(x0[reg]);
                if (i1 < L) OBR[(size_t)(crow0 + i1) * 512 + h * 128 + dv] = f2bf(x1[reg]); }
        }
#pragma unroll
        for (int kb = 0; kb < 4; ++kb) {
            S[kb] = S[kb] * gcl;
#pragma unroll
            for (int ks = 0; ks < 4; ++ks) S[kb] = MFMA32(kwt[(kb * 4 + ks) * 64], uf[ks], S[kb]);
        }
    }
    float* So = A->out + (sample ? O_DS : O_DP) + ((size_t)(b * 4 + h) * 128) * 128 + dv;
#pragma unroll
    for (int kb = 0; kb < 4; ++kb)
#pragma unroll
        for (int reg = 0; reg < 16; ++reg) So[(size_t)(32 * kb + crow16(reg, hh)) * 128] = S[kb][reg];
}

constexpr int HALF_BYTES = 40960;
DI void scan_prompt_wg(KA A, int seq, LAS unsigned char* lds) {
    const int tid = threadIdx.x, lane = tid & 63, wave = __builtin_amdgcn_readfirstlane(tid >> 6);
    const int b = seq >> 2, h = seq & 3;
    constexpr int N = 2 * CHUNKS_P;
    if (wave >= 4) {
        const int loff = (wave - 4) * 10240 + lane * 16;
        u32x4 r0[10], r1[10];
        LAS u32x4* d0 = (LAS u32x4*)(lds + loff); LAS u32x4* d1 = (LAS u32x4*)(lds + HALF_BYTES + loff);
        LAS float* gclw = (LAS float*)(lds + 2 * HALF_BYTES);
#define SCAN_LOAD(n, R) do { const int item_ = seq * CHUNKS_P + ((n) >> 1); \
            if (((n) & 1) == 0) { const float g_ = wait_item(item_granule(A, item_)); __builtin_amdgcn_fence(__ATOMIC_ACQUIRE, "agent"); if (wave == 4 && lane == 0) gclw[((n) >> 1) & 3] = g_; } \
            const __amdgpu_buffer_rsrc_t rs_ = __builtin_amdgcn_make_buffer_rsrc((void*)slot_ptr(A, item_), 0, (int)PREP_SLOT, 0x00020000); \
            _Pragma("unroll") for (int q = 0; q < 10; ++q) R[q] = __builtin_bit_cast(u32x4, __builtin_amdgcn_raw_buffer_load_b128(rs_, ((n) & 1) * HALF_BYTES + loff + q * 1024, 0, 17)); } while (0)
        SCAN_LOAD(0, r0);
#pragma unroll
        for (int q = 0; q < 10; ++q) d0[q * 64] = r0[q];
        SCAN_LOAD(1, r1);
        LDS_BARRIER();
#pragma unroll 1
        for (int n = 0; n < N; n += 2) {
            if (n + 2 < N) SCAN_LOAD(n + 2, r0);
#pragma unroll
            for (int q = 0; q < 10; ++q) d1[q * 64] = r1[q];
            LDS_BARRIER();
            if (n + 3 < N) SCAN_LOAD(n + 3, r1);
            if (n + 2 < N) {
#pragma unroll
                for (int q = 0; q < 10; ++q) d0[q * 64] = r0[q]; }
            LDS_BARRIER();
        }
#undef SCAN_LOAD
    } else {
        const int w = wave, r = lane & 31, hh = lane >> 5, dv = 32 * w + r;
        f32x16 S[4];
#pragma unroll
        for (int kb = 0; kb < 4; ++kb)
#pragma unroll
            for (int reg = 0; reg < 16; ++reg) S[kb][reg] = 0.f;
        bf16* OBR = (bf16*)((unsigned char*)A->out + DO_OB);
        const LAS float* gclw = (const LAS float*)(lds + 2 * HALF_BYTES);
        const LAS bf16x8* bek = (const LAS bf16x8*)(lds + SL_BEK) + lane; const LAS bf16x8* tp = (const LAS bf16x8*)(lds + SL_T) + lane;
        const LAS u32x4* bv = (const LAS u32x4*)(lds + SL_BV) + ((w * 2) * 64 + lane) * 2;
        const LAS bf16x8* qkd = (const LAS bf16x8*)(lds + HALF_BYTES + (SL_QKD - HALF_BYTES)) + lane; const LAS bf16x8* qe = (const LAS bf16x8*)(lds + HALF_BYTES + (SL_QE - HALF_BYTES)) + lane;
        const LAS bf16x8* kwt = (const LAS bf16x8*)(lds + HALF_BYTES + (SL_KWT - HALF_BYTES)) + lane;
        LDS_BARRIER();
#pragma unroll 1
        for (int c = 0; c < CHUNKS_P; ++c) {
            bf16x8 sf[8];
#pragma unroll
            for (int kb = 0; kb < 4; ++kb) { sf[2 * kb] = pack_step<0>(S[kb]); sf[2 * kb + 1] = pack_step<1>(S[kb]); }
            f32x16 x0, x1;
#pragma unroll
            for (int e = 0; e < 16; ++e) { x0[e] = 0.f; x1[e] = 0.f; }
#pragma unroll
            for (int ks = 0; ks < 8; ++ks) { x0 = MFMA32(bek[ks * 64], sf[ks], x0); x1 = MFMA32(bek[(8 + ks) * 64], sf[ks], x1); }
            {
                const u32x4 a0 = bv[0], a1 = bv[1], c0 = bv[128], c1 = bv[129];
                x0[0] = bflo(a0.x) - x0[0]; x0[1] = bfhi(a0.x) - x0[1]; x0[2] = bflo(a0.y) - x0[2]; x0[3] = bfhi(a0.y) - x0[3];
                x0[4] = bflo(a0.z) - x0[4]; x0[5] = bfhi(a0.z) - x0[5]; x0[6] = bflo(a0.w) - x0[6]; x0[7] = bfhi(a0.w) - x0[7];
                x0[8] = bflo(a1.x) - x0[8]; x0[9] = bfhi(a1.x) - x0[9]; x0[10] = bflo(a1.y) - x0[10]; x0[11] = bfhi(a1.y) - x0[11];
                x0[12] = bflo(a1.z) - x0[12]; x0[13] = bfhi(a1.z) - x0[13]; x0[14] = bflo(a1.w) - x0[14]; x0[15] = bfhi(a1.w) - x0[15];
                x1[0] = bflo(c0.x) - x1[0]; x1[1] = bfhi(c0.x) - x1[1]; x1[2] = bflo(c0.y) - x1[2]; x1[3] = bfhi(c0.y) - x1[3];
                x1[4] = bflo(c0.z) - x1[4]; x1[5] = bfhi(c0.z) - x1[5]; x1[6] = bflo(c0.w) - x1[6]; x1[7] = bfhi(c0.w) - x1[7];
                x1[8] = bflo(c1.x) - x1[8]; x1[9] = bfhi(c1.x) - x1[9]; x1[10] = bflo(c1.y) - x1[10]; x1[11] = bfhi(c1.y) - x1[11];
                x1[12] = bflo(c1.z) - x1[12]; x1[13] = bfhi(c1.z) - x1[13]; x1[14] = bflo(c1.w) - x1[14]; x1[15] = bfhi(c1.w) - x1[15];
            }
            bf16x8 rf[4] = {pack_step<0>(x0), pack_step<1>(x0), pack_step<0>(x1), pack_step<1>(x1)};
            f32x16 u0, u1;
#pragma unroll
            for (int e = 0; e < 16; ++e) { u0[e] = 0.f; u1[e] = 0.f; }
            u0 = MFMA32(tp[0 * 64], rf[0], u0); u0 = MFMA32(tp[1 * 64], rf[1], u0);
#pragma unroll
            for (int ks = 0; ks < 4; ++ks) u1 = MFMA32(tp[(4 + ks) * 64], rf[ks], u1);
            bf16x8 uf[4] = {pack_step<0>(u0), pack_step<1>(u0), pack_step<0>(u1), pack_step<1>(u1)};
            LDS_BARRIER();
            if (c > 0) {
#pragma unroll
                for (int e = 0; e < 16; ++e) { x0[e] = 0.f; x1[e] = 0.f; }
#pragma unroll
                for (int ks = 0; ks < 8; ++ks) { x0 = MFMA32(qe[ks * 64], sf[ks], x0); x1 = MFMA32(qe[(8 + ks) * 64], sf[ks], x1); }
                x0 = MFMA32(qkd[0 * 64], uf[0], x0); x0 = MFMA32(qkd[1 * 64], uf[1], x0);
#pragma unroll
                for (int ks = 0; ks < 4; ++ks) x1 = MFMA32(qkd[(4 + ks) * 64], uf[ks], x1);
                bf16* orow = OBR + (size_t)(b * SEQ + 64 * (c - 1)) * 512 + h * 128 + dv;
#pragma unroll
                for (int reg = 0; reg < 16; ++reg) { const int i0 = crow16(reg, hh); orow[(size_t)i0 * 512] = f2bf(x0[reg]); orow[(size_t)(32 + i0) * 512] = f2bf(x1[reg]); }
            }
            const float gcl = gclw[c & 3];
#pragma unroll
            for (int kb = 0; kb < 4; ++kb) {
                S[kb] = S[kb] * gcl;
#pragma unroll
                for (int ks = 0; ks < 4; ++ks) S[kb] = MFMA32(kwt[(kb * 4 + ks) * 64], uf[ks], S[kb]);
            }
            LDS_BARRIER();
        }
        float* So = A->out + O_DP + ((size_t)(b * 4 + h) * 128) * 128 + dv;
#pragma unroll
        for (int kb = 0; kb < 4; ++kb)
#pragma unroll
            for (int reg = 0; reg < 16; ++reg) So[(size_t)(32 * kb + crow16(reg, hh)) * 128] = S[kb][reg];
    }
}

constexpr int KPITCH = 72, VPITCH = 264;
DI void attn_unit(KA A, int unit, LAS unsigned char* ldsb) {
    const int tid = threadIdx.x, lane = tid & 63, wave = __builtin_amdgcn_readfirstlane(tid >> 6), r = lane & 31, hh = lane >> 5;
    const int b = unit >> 6, kh = (unit >> 5) & 1, jb = unit & 31, T0 = NMETA + 128 * jb;
    LAS bf16* Ksm = (LAS bf16*)ldsb; LAS bf16* VTs = Ksm + 256 * KPITCH;
    const bf16* KVg = (const bf16*)(A->ws + WS_KV); const bf16* QAg = (const bf16*)(A->ws + WS_QA);
#pragma unroll
    for (int e4 = 0; e4 < 4; ++e4) {
        const int id = tid + 512 * e4, key = id >> 3, cch = id & 7, tk = T0 - 128 + key;
        u32x4 kq = (u32x4){0u, 0u, 0u, 0u}, vq = kq;
        if (tk >= 0) { const bf16* src = KVg + (size_t)(b * TP + tk) * 256 + kh * 64 + 8 * cch; kq = *(const u32x4*)src; vq = *(const u32x4*)(src + 128); }
        *(LAS u32x4*)(Ksm + key * KPITCH + 8 * cch) = kq;
        const int kkk = key & 15, pos = (key & ~15) + 8 * ((kkk >> 2) & 1) + (((kkk >> 3) << 2) | (kkk & 3));
        LAS bf16* vd = VTs + (8 * cch) * VPITCH + pos;
        vd[0 * VPITCH] = (bf16)(vq.x & 0xffffu); vd[1 * VPITCH] = (bf16)(vq.x >> 16); vd[2 * VPITCH] = (bf16)(vq.y & 0xffffu); vd[3 * VPITCH] = (bf16)(vq.y >> 16);
        vd[4 * VPITCH] = (bf16)(vq.z & 0xffffu); vd[5 * VPITCH] = (bf16)(vq.z >> 16); vd[6 * VPITCH] = (bf16)(vq.w & 0xffffu); vd[7 * VPITCH] = (bf16)(vq.w >> 16);
    }
    LDS_BARRIER();
    const int g = wave >> 1, qh = wave & 1, head = 4 * kh + g;
    const float sink2 = A->sinks[head] * 1.4426950408889634f;
    const int kmin = jb == 0 ? 128 - NMETA : 0;
#pragma unroll 1
    for (int q2 = 0; q2 < 2; ++q2) {
        const int qb = 2 * qh + q2, iq = 32 * qb + r;
        const bf16* qrow = QAg + (size_t)(b * TP + T0 + iq) * 512 + head * 64 + 8 * hh;
        bf16x8 qf[4];
#pragma unroll
        for (int s = 0; s < 4; ++s) qf[s] = *(const bf16x8*)(qrow + 16 * s);
        f32x16 st[5];
        float m = sink2;
#pragma unroll
        for (int kt5 = 0; kt5 < 5; ++kt5) {
            const int kt = qb + kt5;
            f32x16 acc;
#pragma unroll
            for (int e = 0; e < 16; ++e) acc[e] = 0.f;
#pragma unroll
            for (int s = 0; s < 4; ++s) acc = MFMA32(*(const LAS bf16x8*)(Ksm + (32 * kt + r) * KPITCH + 16 * s + 8 * hh), qf[s], acc);
#pragma unroll
            for (int reg = 0; reg < 16; ++reg) { const int kk = 32 * kt + crow16(reg, hh); const bool ok = kk >= iq && kk <= iq + 128 && kk >= kmin;
                acc[reg] = ok ? acc[reg] : -INFINITY; m = fmaxf(m, acc[reg]); }
            st[kt5] = acc;
        }
        m = fmaxf(m, __shfl_xor(m, 32));
        float l = 0.f;
#pragma unroll
        for (int kt5 = 0; kt5 < 5; ++kt5)
#pragma unroll
            for (int reg = 0; reg < 16; ++reg) { const float p = exp2f(st[kt5][reg] - m); st[kt5][reg] = p; l += p; }
        l += __shfl_xor(l, 32); l += exp2f(sink2 - m);
        f32x16 o0, o1;
#pragma unroll
        for (int e = 0; e < 16; ++e) { o0[e] = 0.f; o1[e] = 0.f; }
#pragma unroll
        for (int kt5 = 0; kt5 < 5; ++kt5) {
            const int kt = qb + kt5;
            const bf16x8 p0 = pack_step<0>(st[kt5]), p1 = pack_step<1>(st[kt5]);
            const LAS bf16* vb = VTs + r * VPITCH + 32 * kt + 8 * hh;
            o0 = MFMA32(*(const LAS bf16x8*)(vb), p0, o0); o0 = MFMA32(*(const LAS bf16x8*)(vb + 16), p1, o0);
            o1 = MFMA32(*(const LAS bf16x8*)(vb + 32 * VPITCH), p0, o1); o1 = MFMA32(*(const LAS bf16x8*)(vb + 32 * VPITCH + 16), p1, o1);
        }
        const float rl = 1.0f / l;
        bf16* orow = (bf16*)((unsigned char*)A->out + DO_OA) + (size_t)(b * SEQ + 128 * jb + iq) * 512 + head * 64 + 4 * hh;
#pragma unroll
        for (int g4 = 0; g4 < 4; ++g4) {
            *(u32x2*)(orow + 8 * g4) = (u32x2){cvtpk(o0[4 * g4] * rl, o0[4 * g4 + 1] * rl), cvtpk(o0[4 * g4 + 2] * rl, o0[4 * g4 + 3] * rl)};
            *(u32x2*)(orow + 32 + 8 * g4) = (u32x2){cvtpk(o1[4 * g4] * rl, o1[4 * g4 + 1] * rl), cvtpk(o1[4 * g4 + 2] * rl, o1[4 * g4 + 3] * rl)};
        }
    }
    LDS_BARRIER();
}
DI void sample_attn(KA A, int b, int head, LAS float* wl, int lane) {
    const int kh = head >> 2;
    LAS float* qn = wl; LAS float* ps = wl + 256;
    const bf16* QAg = (const bf16*)(A->ws + WS_QA); const bf16* KVg = (const bf16*)(A->ws + WS_KV);
#pragma unroll
    for (int i = 0; i < 4; ++i) qn[i * 64 + lane] = bf2f(QAg[(size_t)(MP + b * TS + i) * 512 + head * 64 + pos_of_d(lane)]);
    LDS_WAIT(); asm volatile("" ::: "memory");
    const float sink2 = A->sinks[head] * 1.4426950408889634f;
#pragma unroll 1
    for (int kq = 0; kq < 3; ++kq) {
        const int kj = lane + 64 * kq;
        float sc0 = 0.f, sc1 = 0.f, sc2 = 0.f, sc3 = 0.f;
        if (kj < 128) {
            const f32x4* kr = (const f32x4*)(A->cache_k + ((size_t)(b * 128 + kj) * 2 + kh) * 64);
#pragma unroll 4
            for (int d4 = 0; d4 < 16; ++d4) { const f32x4 kv = kr[d4];
                const f32x4 q0 = *(const LAS f32x4*)(qn + 4 * d4), q1 = *(const LAS f32x4*)(qn + 64 + 4 * d4), q2 = *(const LAS f32x4*)(qn + 128 + 4 * d4), q3 = *(const LAS f32x4*)(qn + 192 + 4 * d4);
                sc0 += (kv[0] * q0[0] + kv[1] * q0[1]) + (kv[2] * q0[2] + kv[3] * q0[3]); sc1 += (kv[0] * q1[0] + kv[1] * q1[1]) + (kv[2] * q1[2] + kv[3] * q1[3]);
                sc2 += (kv[0] * q2[0] + kv[1] * q2[1]) + (kv[2] * q2[2] + kv[3] * q2[3]); sc3 += (kv[0] * q3[0] + kv[1] * q3[1]) + (kv[2] * q3[2] + kv[3] * q3[3]); }
        } else if (kj < 132) {
            const bf16* kr = KVg + (size_t)(MP + b * TS + (kj - 128)) * 256 + kh * 64;
#pragma unroll 4
            for (int p = 0; p < 64; ++p) { const float kv = bf2f(kr[p]); const int d = d_of_pos(p);
                sc0 += kv * qn[d]; sc1 += kv * qn[64 + d]; sc2 += kv * qn[128 + d]; sc3 += kv * qn[192 + d]; }
        }
        if (kj < 132) {
            ps[0 * 132 + kj] = (kj >= 0 && kj <= 128) ? sc0 : -INFINITY; ps[1 * 132 + kj] = (kj >= 1 && kj <= 129) ? sc1 : -INFINITY;
            ps[2 * 132 + kj] = (kj >= 2 && kj <= 130) ? sc2 : -INFINITY; ps[3 * 132 + kj] = (kj >= 3 && kj <= 131) ? sc3 : -INFINITY; }
    }
    LDS_WAIT(); asm volatile("" ::: "memory");
    float linv[4];
#pragma unroll
    for (int i = 0; i < 4; ++i) {
        const float s0 = ps[i * 132 + lane], s1 = ps[i * 132 + 64 + lane], s2 = lane < 4 ? ps[i * 132 + 128 + lane] : -INFINITY;
        const float m = wave_max(fmaxf(fmaxf(s0, s1), fmaxf(s2, sink2)));
        const float p0 = exp2f(s0 - m), p1 = exp2f(s1 - m), p2 = exp2f(s2 - m);
        ps[i * 132 + lane] = p0; ps[i * 132 + 64 + lane] = p1; if (lane < 4) ps[i * 132 + 128 + lane] = p2;
        linv[i] = 1.0f / (wave_sum(p0 + p1 + p2) + exp2f(sink2 - m));
    }
    LDS_WAIT(); asm volatile("" ::: "memory");
    float o[4] = {0.f, 0.f, 0.f, 0.f};
#pragma unroll 4
    for (int kj = 0; kj < 128; ++kj) { const float v = A->cache_v[((size_t)(b * 128 + kj) * 2 + kh) * 64 + lane];
#pragma unroll
        for (int i = 0; i < 4; ++i) o[i] += ps[i * 132 + kj] * v; }
#pragma unroll
    for (int kj = 128; kj < 132; ++kj) { const float v = bf2f(KVg[(size_t)(MP + b * TS + (kj - 128)) * 256 + 128 + kh * 64 + lane]);
#pragma unroll
        for (int i = 0; i < 4; ++i) o[i] += ps[i * 132 + kj] * v; }
    bf16* OAg = (bf16*)((unsigned char*)A->out + DO_OA);
#pragma unroll
    for (int i = 0; i < 4; ++i) OAg[(size_t)(NBATCH * SEQ + b * TS + i) * 512 + head * 64 + lane] = f2bf(o[i] * linv[i]);
    LDS_WAIT(); asm volatile("" ::: "memory");
}
DI void p23_mixers(KA A, LAS unsigned char* lds, const XcdBarrier& dbg_bar) {
    const int tid = threadIdx.x, lane = tid & 63, wave = __builtin_amdgcn_readfirstlane(tid >> 6), G = gridDim.x, wg = blockIdx.x;
    const int NSCAN = N_PROMPT_SEQ;
#ifdef P23_DEBUG_BARRIER
    if (wg < NSCAN) xcd_barrier(dbg_bar);
#endif
#ifdef P23_FLUSH_EXPERIMENT
    if (wg < NSCAN) {
        const u32x4* src = (const u32x4*)(A->ws + WS_G) + (size_t)wg * 131072 + tid; unsigned accx = 0u;
        for (int i = 0; i < 256; ++i) { const u32x4 v = src[(size_t)i * 512]; accx += v.x ^ v.y ^ v.z ^ v.w; }
        if (accx == 0x12345679u) ((unsigned*)(A->ws + WS_SC))[tid] = accx;
    }
#endif
    if (wg < NSCAN) { scan_prompt_wg(A, wg, lds); return; }
    const int p = wg - NSCAN, NP = G - NSCAN;
    const int nprompt = p < N_ITEMS_P ? (N_ITEMS_P - 1 - p) / NP + 1 : 0;
    const int nsample = p < SBATCH * NHB ? (SBATCH * NHB - 1 - p) / NP + 1 : 0;
    const int ntot = nprompt + nsample;
#define PROD_ITEM(k) ((k) < nprompt ? (((p + NP * (k)) & 31) * CHUNKS_P + ((p + NP * (k)) >> 5)) : ((k) < ntot ? N_ITEMS_P + p + NP * ((k) - nprompt) : N_ITEMS))
    {
        S1Pre P;
        float* ats0 = (float*)((unsigned char*)A->out + DO_ATS + (size_t)p * 8 * ATS_ITEM);
        if (ntot > 0) stage1_issue(A, PROD_ITEM(0), P);
        int k = 0, bs = 1;
        int nb = 0;
#pragma unroll 1
        while (k < ntot) {
            const int cnt = ntot - k < bs ? ntot - k : bs;
#pragma unroll 1
            for (int i = 0; i < cnt; ++i) prep_stage1(A, PROD_ITEM(k + i), PROD_ITEM(k + i + 1), i, ats0 + i * (ATS_ITEM / 4), P, lds);
            asm volatile("s_waitcnt vmcnt(0)" ::: "memory"); __syncthreads();
            if (wave < cnt) prep_stage2(A, PROD_ITEM(k + wave), ((const LAS float*)(lds + LDS_GCL))[wave], ats0 + wave * (ATS_ITEM / 4), (LAS float*)(lds + wave * 16384));
            __syncthreads();
            k += cnt; ++nb; bs = nb == 1 ? 1 : (nb == 2 ? 2 : (nb == 3 ? 4 : 8));
        }
    }
#undef PROD_ITEM
#ifdef P23_DEBUG_BARRIER
    xcd_barrier(dbg_bar);
#endif
    for (int u = p; u < NBATCH * NKV * 32; u += NP) attn_unit(A, u, lds);
    const int worker = p * NWAVES + wave, NW = NP * NWAVES;
    LAS float* wl = (LAS float*)(lds + 98304 + wave * 4096);
    for (int it = worker; it < SBATCH * NHB * 4 + SBATCH * NHA; it += NW) {
        if (it < SBATCH * NHB * 4) scan_seq(A, N_PROMPT_SEQ + (it >> 2), it & 3, lane);
        else { const int q = it - SBATCH * NHB * 4; sample_attn(A, q >> 3, q & 7, wl, lane); }
    }
}

DI void p3b_gated_norm(KA A) {
    const int tid = threadIdx.x, lane = tid & 63, wave = tid >> 6, gw = blockIdx.x * NWAVES + wave, NGW = gridDim.x * NWAVES;
    const int head = lane >> 4, dv0 = 8 * (lane & 15);
    const f32x4 w0 = *(const f32x4*)(A->gdn_norm + dv0), w1 = *(const f32x4*)(A->gdn_norm + dv0 + 4);
    bf16* OBg = (bf16*)((unsigned char*)A->out + DO_OB); const bf16* Zg = (const bf16*)(A->ws + WS_Z);
    for (int crow = gw; crow < MC; crow += NGW) {
        const u32x4 ow = *(const u32x4*)(OBg + (size_t)crow * 512 + head * 128 + dv0);
        const f32x4 a = {bflo(ow.x), bfhi(ow.x), bflo(ow.y), bfhi(ow.y)}, c = {bflo(ow.z), bfhi(ow.z), bflo(ow.w), bfhi(ow.w)};
        float ss = (a[0] * a[0] + a[1] * a[1]) + (a[2] * a[2] + a[3] * a[3]) + (c[0] * c[0] + c[1] * c[1]) + (c[2] * c[2] + c[3] * c[3]);
        ss += __shfl_xor(ss, 1); ss += __shfl_xor(ss, 2); ss += __shfl_xor(ss, 4); ss += __shfl_xor(ss, 8);
        const float rstd = rsqrtf(ss * (1.0f / 128.0f) + EPS);
        const u32x4 zw = *(const u32x4*)(Zg + (size_t)pg8::crow_to_urow(crow) * 512 + head * 128 + dv0);
        f32x4 y0, y1;
        y0[0] = a[0] * rstd * w0[0] * siluf_(bflo(zw.x)); y0[1] = a[1] * rstd * w0[1] * siluf_(bfhi(zw.x)); y0[2] = a[2] * rstd * w0[2] * siluf_(bflo(zw.y)); y0[3] = a[3] * rstd * w0[3] * siluf_(bfhi(zw.y));
        y1[0] = c[0] * rstd * w1[0] * siluf_(bflo(zw.z)); y1[1] = c[1] * rstd * w1[1] * siluf_(bfhi(zw.z)); y1[2] = c[2] * rstd * w1[2] * siluf_(bflo(zw.w)); y1[3] = c[3] * rstd * w1[3] * siluf_(bfhi(zw.w));
        *(u32x4*)(OBg + (size_t)crow * 512 + head * 128 + dv0) = pack8f(y0, y1);
    }
}
DI void p8_final_norm(KA A) {
    const int tid = threadIdx.x, lane = tid & 63, wave = tid >> 6, gw = blockIdx.x * NWAVES + wave, NGW = gridDim.x * NWAVES;
    f32x4 nf[4];
#pragma unroll
    for (int j = 0; j < 4; ++j) nf[j] = ((const f32x4*)A->norm_final)[lane + 64 * j];
    for (int crow = gw; crow < MC; crow += NGW) {
        f32x4* row = (f32x4*)(A->out + (size_t)crow * D);
        f32x4 v[4]; float ss = 0.f;
#pragma unroll
        for (int j = 0; j < 4; ++j) { v[j] = row[lane + 64 * j]; ss += (v[j][0] * v[j][0] + v[j][1] * v[j][1]) + (v[j][2] * v[j][2] + v[j][3] * v[j][3]); }
        const float rstd = rsqrtf(wave_sum(ss) * (1.0f / D) + EPS);
#pragma unroll
        for (int j = 0; j < 4; ++j) row[lane + 64 * j] = v[j] * rstd * nf[j];
    }
}
__global__ void __launch_bounds__(NTHREADS, 2) hybrid_fwd(Args Aval) {
    extern __shared__ __attribute__((aligned(16))) unsigned char lds_raw[];
    LAS unsigned char* lds = (LAS unsigned char*)lds_raw;
    const int tid = threadIdx.x;
    int lo, hi; { KA A0 = kargs(); lo = A0->ph_lo; hi = A0->ph_hi; }
#if MK_N_LAUNCHES == 1
#if MK_BARRIER == 1
    volatile LAS unsigned* MISC = (volatile LAS unsigned*)(lds + LDS_MISC);
    if (tid < 64) MISC[tid] = 0u;
    __syncthreads();
    XcdBarrier bar; { KA A0 = kargs(); bar = xcd_barrier_post((unsigned*)(A0->ws + WS_CTL) + 4096, MISC + 8); }
#define GRID_BAR() xcd_barrier(bar)
#else
    cg::grid_group grid = cg::this_grid();
#define GRID_BAR() grid.sync()
#endif
#else
#define GRID_BAR() do {} while (0)
#endif
#ifndef PH_MASK
#define PH_MASK 0x1ff
#endif
#define IN(k) (((PH_MASK >> (k)) & 1) && lo <= (k) && (k) < hi)
#ifndef PROBE_REP
#define PROBE_REP -1
#endif
#define NREP(k) (PROBE_REP == (k) ? 2 : 1)
#define SEAM(k) do { if (IN(k) && IN((k) + 1)) GRID_BAR(); } while (0)
    const int G = gridDim.x, wgid = blockIdx.x;
#if PROBE_REP == 0
    if (IN(0)) { KA A = kargs(); p0_prologue(A, lds); __syncthreads(); }
#endif
    if (IN(0)) { KA A = kargs(); p0_prologue(A, lds); } SEAM(0);
    if (IN(1)) for (int rep = 0; rep < NREP(1); ++rep) { KA A = kargs(); unsigned char* ws = A->ws;
        pg8::Gemm g{(const bf16*)(ws + WS_XN), (const bf16*)(ws + WS_WIN), MUP, NIN, D}; pg8::StaticOrder S; S.init(MUP, NIN, G, wgid);
        pg8::EpiInProj E{(bf16*)(ws + WS_QA), (bf16*)(ws + WS_KV), (bf16*)(ws + WS_QKVB), (bf16*)(ws + WS_Z), (bf16*)(ws + WS_G),
                         (const float*)(ws + WS_ROPE), (const float*)(ws + WS_ROPE) + (TP + TS) * 32, A->out};
        pg8::gemm_phase<pg8::EpiInProj, pg8::StaticOrder, true, true>(lds, g, S, E);
    } SEAM(1);
    if (IN(2)) { KA A = kargs(); p23_mixers(A, lds, bar); } SEAM(2);
    if (IN(3)) for (int rep = 0; rep < NREP(3); ++rep) { KA A = kargs(); p3b_gated_norm(A); } SEAM(3);
    if (IN(4)) { KA A = kargs(); unsigned char* ws = A->ws;
        { pg8::Gemm g{(const bf16*)((unsigned char*)A->out + DO_OA), (const bf16*)(ws + WS_WOA), MC, D, 512}; pg8::StaticOrder S; S.init(MC, D, G, wgid);
          pg8::EpiMerge<false> E{(bf16*)(ws + WS_MB), (const bf16*)(ws + WS_G), 0};
          pg8::gemm_phase<pg8::EpiMerge<false>, pg8::StaticOrder, true, true>(lds, g, S, E); }
        asm volatile("s_waitcnt vmcnt(0)" ::: "memory"); __syncthreads();
        { pg8::Gemm g{(const bf16*)((unsigned char*)A->out + DO_OB), (const bf16*)(ws + WS_WOB), MC, D, 512}; pg8::StaticOrder S; S.init(MC, D, G, wgid);
          pg8::EpiMerge<true> E{(bf16*)(ws + WS_MB), (const bf16*)(ws + WS_G), 1024};
          pg8::gemm_phase<pg8::EpiMerge<true>, pg8::StaticOrder, true, true>(lds, g, S, E); }
    } SEAM(4);
    if (IN(5)) { KA A = kargs(); unsigned char* ws = A->ws;
        pg8::Gemm g{(const bf16*)(ws + WS_MB), (const bf16*)(ws + WS_WOUT), MC, D, D}; pg8::StaticOrder S; S.init(MC, D, G, wgid);
        pg8::EpiWout<true> E{A->x_prompt, A->x_sample, (bf16*)(ws + WS_HB1), (float*)(ws + WS_CTL + CTL_SS1)};
        pg8::gemm_phase<pg8::EpiWout<true>, pg8::StaticOrder, true, true>(lds, g, S, E);
    } SEAM(5);
    if (IN(6)) { KA A = kargs(); unsigned char* ws = A->ws;
        pg8::Gemm g{(const bf16*)(ws + WS_HB1), (const bf16*)(ws + WS_WGU), MC, 2 * DFF, D}; pg8::StaticOrder S; S.init(MC, 2 * DFF, G, wgid);
        pg8::EpiGateUp E{(bf16*)(ws + WS_ACT), (const float*)(ws + WS_CTL + CTL_SS1)};
        pg8::gemm_phase<pg8::EpiGateUp, pg8::StaticOrder, true, true>(lds, g, S, E);
    } SEAM(6);
    if (IN(7)) { KA A = kargs(); unsigned char* ws = A->ws;
        pg8::Gemm g{(const bf16*)(ws + WS_ACT), (const bf16*)(ws + WS_WD), MC, D, DFF}; pg8::StaticOrder S; S.init(MC, D, G, wgid);
        pg8::EpiDown<false> E{(const bf16*)(ws + WS_HB1), A->out};
        pg8::gemm_phase<pg8::EpiDown<false>, pg8::StaticOrder, true, true>(lds, g, S, E);
    } SEAM(7);
    if (IN(8)) { KA A = kargs(); p8_final_norm(A); }
#undef IN
#undef SEAM
}

extern "C" void kernel_launch(void* const* d_in, const int* in_sizes, int n_in, void* d_out, int out_size, void* d_ws, size_t ws_size, hipStream_t stream) {
    static int grid = 0;
    if (grid == 0) {
        if (n_in != 22 || out_size != (int)O_END || ws_size < WS_END) { fprintf(stderr, "kernel_launch: unexpected problem (n_in %d, out %d, ws %zu)\n", n_in, out_size, ws_size); grid = -1; return; }
        int dev = 0, cus = 0, per_cu = 0;
        if (hipGetDevice(&dev) != hipSuccess || hipDeviceGetAttribute(&cus, hipDeviceAttributeMultiprocessorCount, dev) != hipSuccess) { grid = -1; return; }
        if (hipFuncSetAttribute((const void*)hybrid_fwd, hipFuncAttributeMaxDynamicSharedMemorySize, LDS_BYTES) != hipSuccess) { fprintf(stderr, "kernel_launch: hipFuncSetAttribute failed\n"); grid = -1; return; }
        if (hipOccupancyMaxActiveBlocksPerMultiprocessor(&per_cu, (const void*)hybrid_fwd, NTHREADS, LDS_BYTES) != hipSuccess || per_cu < 1) { fprintf(stderr, "kernel_launch: occupancy query says %d\n", per_cu); per_cu = 1; }
        (void)hipGetLastError();
        grid = cus;
        if (grid > 256) grid = 256;
    }
    if (grid < 0) return;
    (void)hipMemsetAsync((char*)d_ws + WS_CTL, 0, CTL_BYTES, stream);
    Args a{};
    const float** ap = (const float**)&a;
    for (int i = 0; i < 22; ++i) ap[i] = (const float*)d_in[i];
    a.out = (float*)d_out; a.ws = (unsigned char*)d_ws;
#if MK_N_LAUNCHES == 1
    a.ph_lo = 0; a.ph_hi = N_PHASES;
#if MK_BARRIER == 1
    hipLaunchKernelGGL(hybrid_fwd, dim3(grid), dim3(NTHREADS), LDS_BYTES, stream, a);
#else
    void* args[] = {&a};
    hipError_t e = hipLaunchCooperativeKernel((const void*)hybrid_fwd, dim3(grid), dim3(NTHREADS), args, LDS_BYTES, stream);
    if (e != hipSuccess) fprintf(stderr, "cooperative launch failed: %s (grid %d)\n", hipGetErrorString(e), grid);
#endif
#else
    for (int p = 0; p < N_PHASES; ++p) { a.ph_lo = p; a.ph_hi = p + 1; hipLaunchKernelGGL(hybrid_fwd, dim3(grid), dim3(NTHREADS), LDS_BYTES, stream, a); }
#endif
}
```

```cpp
#include <hip/hip_runtime.h>
#include <hip/hip_cooperative_groups.h>
#include <cstdio>
#include <cstdint>
namespace cg = cooperative_groups;

#ifndef MK_N_LAUNCHES
#define MK_N_LAUNCHES 1
#endif
#ifndef MK_BARRIER
#define MK_BARRIER 1
#endif

constexpr int D = 1024, NBATCH = 8, SEQ = 4096, NMETA = 16, TP = SEQ + NMETA, MP = NBATCH * TP;
constexpr int SBATCH = 128, TS = 4, MS = SBATCH * TS, MU = MP + MS, MUP = 33536, MC = NBATCH * SEQ + MS;
constexpr int PAST = 16384;
constexpr int HD = 64, NHA = 8, NKV = 2;
constexpr int NHB = 4, CONVD = 1536;
constexpr int DFF = 2816, NIN_SRC = 4872, NIN = 4864;
constexpr float EPS = 1e-6f;
constexpr float QSCALE = 0.125f * 1.4426950408889634f;

constexpr size_t MiB = 1u << 20, KiB = 1024;
constexpr size_t WS_CTL = 0, CTL_BYTES = 1 * MiB;
constexpr size_t WS_WIN = 1 * MiB;
constexpr size_t WS_WOA = 11 * MiB, WS_WOB = 12 * MiB;
constexpr size_t WS_WOUT = 13 * MiB;
constexpr size_t WS_WGU = 15 * MiB;
constexpr size_t WS_WD = 26 * MiB;
constexpr size_t WS_ROPE = 32 * MiB;
constexpr size_t WS_GB = 34 * MiB;
constexpr size_t WS_SC = 36 * MiB;
constexpr size_t WS_SS1 = 37 * MiB, WS_SS2 = 37 * MiB + 512 * KiB;
constexpr size_t WS_QA = 41 * MiB;
constexpr size_t WS_KV = WS_QA + (size_t)MUP * 512 * 2;
constexpr size_t WS_QKVB = WS_KV + (size_t)MUP * 256 * 2;
constexpr size_t WS_Z = WS_QKVB + (size_t)MUP * 1536 * 2;
constexpr size_t WS_G = WS_Z + (size_t)MUP * 512 * 2;
constexpr size_t WS_GEND = WS_G + (size_t)MUP * 2048 * 2;
constexpr size_t WS_B = 353 * MiB, WS_END = 512 * MiB;
static_assert(WS_GEND <= WS_B, "ws map");
constexpr size_t WS_XN = WS_B;
constexpr size_t PREP_SLOT = 80 * KiB;
constexpr int PREP_N1 = (int)((WS_END - WS_B) / PREP_SLOT);
constexpr size_t DO_OA = 44 * MiB;
constexpr size_t DO_OB = DO_OA + (size_t)MC * 512 * 2;
constexpr size_t DO_ATS = DO_OB + (size_t)MC * 512 * 2;
constexpr size_t ATS_ITEM = 3 * 32 * 32 * 4;
static_assert(DO_ATS + 212 * 8 * ATS_ITEM <= (size_t)MC * 1024 * 4, "d_out scratch map");
constexpr size_t WS_MB = WS_B;
constexpr size_t WS_HB1 = WS_B + 66 * MiB;
static_assert(WS_HB1 + (size_t)MC * 1024 * 2 <= WS_END, "ws map");
constexpr size_t WS_ACT = WS_QA;
static_assert(WS_ACT + (size_t)MC * DFF * 2 <= WS_G, "ws map");
constexpr int SL_BEK = 0, SL_BV = 16 * 1024, SL_T = 32 * 1024, SL_QKD = 40 * 1024, SL_QE = 48 * 1024, SL_KWT = 64 * 1024;
constexpr int N_PROMPT_SEQ = NBATCH * NHB, CHUNKS_P = 65, N_ITEMS_P = N_PROMPT_SEQ * CHUNKS_P, N_ITEMS = N_ITEMS_P + SBATCH * NHB;
static_assert((size_t)(N_ITEMS - PREP_N1) * PREP_SLOT <= DO_OA, "prep slots");

constexpr size_t O_YP = 0, O_YS = (size_t)NBATCH * SEQ * D, O_KP = O_YS + (size_t)MS * D, O_VP = O_KP + 8 * 128 * 2 * 64, O_DP = O_VP + 8 * 128 * 2 * 64,
                 O_CP = O_DP + 8 * 4 * 128 * 128, O_KS = O_CP + 8 * 3 * 1536, O_VS = O_KS + (size_t)128 * 128 * 2 * 64, O_DS = O_VS + (size_t)128 * 128 * 2 * 64,
                 O_CS = O_DS + (size_t)128 * 4 * 128 * 128, O_END = O_CS + (size_t)128 * 3 * 1536;
static_assert(O_END == 48074752, "d_out size");

#define DI __device__ __forceinline__
#define GAS __attribute__((address_space(1)))
#define LAS __attribute__((address_space(3)))
typedef unsigned short bf16;
typedef short bf16x8 __attribute__((ext_vector_type(8)));
typedef float f32x4 __attribute__((ext_vector_type(4)));
typedef float f32x2 __attribute__((ext_vector_type(2)));
typedef float f32x16 __attribute__((ext_vector_type(16)));
typedef unsigned u32x4 __attribute__((ext_vector_type(4)));
typedef unsigned u32x2 __attribute__((ext_vector_type(2)));
typedef __bf16 bf16x2_t __attribute__((ext_vector_type(2)));

DI unsigned cvtpk(float lo, float hi) { f32x2 v = {lo, hi}; bf16x2_t b = __builtin_convertvector(v, bf16x2_t); return __builtin_bit_cast(unsigned, b); }
DI bf16 f2bf(float f) { return (bf16)(cvtpk(f, 0.f) & 0xffffu); }
DI float bf2f(unsigned short h) { return __uint_as_float((unsigned)h << 16); }
DI float bflo(unsigned w) { return __uint_as_float(w << 16); }
DI float bfhi(unsigned w) { return __uint_as_float(w & 0xffff0000u); }
DI u32x4 pack8f(f32x4 a, f32x4 b) { u32x4 w; w.x = cvtpk(a[0], a[1]); w.y = cvtpk(a[2], a[3]); w.z = cvtpk(b[0], b[1]); w.w = cvtpk(b[2], b[3]); return w; }
DI float frcp_(float x) { return __builtin_amdgcn_rcpf(x); }
DI float sigmoidf_(float x) { return frcp_(1.0f + __builtin_amdgcn_exp2f(x * -1.4426950408889634f)); }
DI float siluf_(float x) { return x * sigmoidf_(x); }
DI void st16_sc1(void* p, u32x4 v) { asm volatile("global_store_dwordx4 %0, %1, off sc1\n\ts_nop 1" :: "v"(p), "v"(v) : "memory"); }
DI void st16_sc1f(void* p, f32x4 v) { asm volatile("global_store_dwordx4 %0, %1, off sc1\n\ts_nop 1" :: "v"(p), "v"(v) : "memory"); }
DI void st2_sc1(void* p, unsigned v) { asm volatile("global_store_short %0, %1, off sc1\n\ts_nop 1" :: "v"(p), "v"(v) : "memory"); }
constexpr size_t CTL_GRAN = 65536, CTL_CNT = 245760, CTL_SS1 = 458752;
static_assert(CTL_CNT + 5 * 130 * 256 <= CTL_SS1 && CTL_SS1 + 33280 * 4 <= 1048576 && CTL_GRAN + 2592 * 64 <= CTL_CNT, "control region map");
constexpr int CNT_STRIDE = 130 * 64;
DI int pos_of_d(int d) { const int dd = d & 31; return 8 * (dd >> 2) + (dd & 3) + ((d >> 5) << 2); }
DI int d_of_pos(int p) { const int j = p & 7; return 4 * (p >> 3) + (j & 3) + ((j >> 2) << 5); }
namespace pg8 {
#define PG8_LAS __attribute__((address_space(3)))
typedef unsigned short bf16_t;
typedef short bf16x8 __attribute__((ext_vector_type(8)));
typedef float f32x4 __attribute__((ext_vector_type(4)));
typedef unsigned u32x4 __attribute__((ext_vector_type(4)));
constexpr int BM = 256, BK = 64, HALF = 128, HTB = HALF * BK * 2  , STAGE_BYTES = 8 * HTB, NXCD = 8, WGM = 8;

__host__ __device__ __forceinline__ int lds_byte(int r, int c) { const int st = (r >> 4) * 2 + (c >> 5), rr = r & 15, cc = c & 31, ob = rr * 64 + cc * 2; return st * 1024 + (ob ^ (((ob >> 9) & 1) << 5)); }
__host__ __device__ __forceinline__ void stage_rc(int b, int& R, int& C) { const int st = b / 1024, sb = b % 1024, swz = sb ^ (((sb >> 9) & 1) << 5); R = (st >> 1) * 16 + swz / 64; C = (st & 1) * 32 + (swz % 64) / 2; }
__host__ __device__ __forceinline__ int perm32(int rho) { const int n = rho >> 4, i = rho & 15; return 8 * (i >> 2) + 4 * n + (i & 3); }

struct Unit { int pm, pn; };
struct Gemm { const bf16_t* A; const bf16_t* Bt; int M, N, K; };

struct StaticOrder {
    static constexpr bool A_SC1 = false;
    int nM, nN, nwg, G, c;
    __host__ __device__ void init(int M, int N, int G_, int c_) { nM = M / BM; nN = N / BM; nwg = nM * nN; G = G_; c = c_; }
    __host__ __device__ bool next(int i, Unit& u) const {
        const long L = (long)i * G + c; if (L >= nwg) return false;
        int wgid = (int)L; { const int q = nwg / NXCD, r = nwg % NXCD, xcd = wgid % NXCD, off = wgid / NXCD; wgid = (xcd < r ? xcd * (q + 1) : r * (q + 1) + (xcd - r) * q) + off; }
        const int nig = WGM * nN, gid = wgid / nig, fm = gid * WGM, gsz = (nM - fm) < WGM ? (nM - fm) : WGM;
        u.pm = fm + ((wgid % nig) % gsz); u.pn = (wgid % nig) / gsz; return true;
    }
    __device__ __forceinline__ void a_ready(const Unit&) const {}
    __device__ __forceinline__ void done(const Unit&) const {}
};
struct FlagOrder : StaticOrder {
    static constexpr bool A_SC1 = true;
    const unsigned* ready; unsigned need; unsigned* pub; unsigned* gpub;
    __device__ __forceinline__ void a_ready(const Unit& u) const {
        if (ready) {
            if (threadIdx.x < 64) { unsigned spins = 0;
                while ((unsigned)__builtin_amdgcn_readfirstlane(__hip_atomic_load(ready + 64 * u.pm, __ATOMIC_RELAXED, __HIP_MEMORY_SCOPE_AGENT)) < need) { __builtin_amdgcn_s_sleep(2); if (++spins > (1u << 22)) break; } }
            asm volatile("" ::: "memory"); __builtin_amdgcn_s_barrier(); asm volatile("" ::: "memory");
        }
    }
    __device__ __forceinline__ void done(const Unit& u) const {
        if (pub) { asm volatile("s_waitcnt vmcnt(0)" ::: "memory");
            if ((threadIdx.x & 63) == 0) { __hip_atomic_fetch_add(pub + 64 * u.pm, 1u, __ATOMIC_RELAXED, __HIP_MEMORY_SCOPE_AGENT); if (gpub) __hip_atomic_fetch_add(gpub, 1u, __ATOMIC_RELAXED, __HIP_MEMORY_SCOPE_AGENT); } }
    }
};

__device__ __forceinline__ void urow_info(int urow, int& kind, int& b, int& t, int& ridx) {
    if (urow < MP) { b = urow / TP; t = urow - b * TP; kind = 0; ridx = t; }
    else if (urow < MU) { const int s = urow - MP; b = s >> 2; t = s & 3; kind = 1; ridx = TP + t; }
    else { kind = 2; b = 0; t = 0; ridx = 0; }
}
__device__ __forceinline__ int crow_to_urow(int crow) { return crow < NBATCH * SEQ ? crow + NMETA * ((crow >> 12) + 1) : MP + (crow - NBATCH * SEQ); }

struct EpiInProj {
    static constexpr bool PERM = true, AFTER_DRAIN = false;
    bf16_t *QA, *KV, *QKVB, *Z, *G; const float *COS, *SIN; float* out;
    __device__ __forceinline__ void operator()(const f32x4 (&acc)[2][2][4][2], const Unit& u, int wr, int wc, int fr, int fq) const {
        const int pn = u.pn;
#pragma unroll
        for (int ai = 0; ai < 2; ++ai)
#pragma unroll
            for (int m = 0; m < 4; ++m) {
                const int row = u.pm * BM + ai * HALF + wr * 64 + m * 16 + fr;
                int kind, b, t, ridx; urow_info(row, kind, b, t, ridx);
#pragma unroll
                for (int bj = 0; bj < 2; ++bj) {
                    const int cl = bj * HALF + wc * 32 + 8 * fq;
                    const f32x4 v0 = acc[ai][bj][m][0], v1 = acc[ai][bj][m][1];
                    if (pn < 2) {
                        const int c = pn * 256 + cl, d0 = ((c & 63) >> 3) * 4;
                        const f32x4 cs = *(const f32x4*)(COS + ridx * 32 + d0), sn = *(const f32x4*)(SIN + ridx * 32 + d0);
                        const f32x4 o1 = (v0 * cs - v1 * sn) * QSCALE, o2 = (v1 * cs + v0 * sn) * QSCALE;
                        *(u32x4*)(QA + (size_t)row * 512 + c) = pack8f(o1, o2);
                    } else if (pn == 2) {
                        if (bj == 0) {
                            const int kh = cl >> 6, d0 = ((cl & 63) >> 3) * 4;
                            const f32x4 cs = *(const f32x4*)(COS + ridx * 32 + d0), sn = *(const f32x4*)(SIN + ridx * 32 + d0);
                            const f32x4 o1 = v0 * cs - v1 * sn, o2 = v1 * cs + v0 * sn;
                            *(u32x4*)(KV + (size_t)row * 256 + cl) = pack8f(o1, o2);
                            float* dst = nullptr;
                            if (kind == 0 && t >= TP - 128) dst = out + O_KP + ((size_t)(b * 128 + (t - (TP - 128))) * 2 + kh) * 64;
                            else if (kind == 1) dst = out + O_KS + ((size_t)(b * 128 + 124 + t) * 2 + kh) * 64;
                            if (dst) { *(f32x4*)(dst + d0) = o1; *(f32x4*)(dst + 32 + d0) = o2; }
                        } else {
                            const int cv = cl - 128, kh = cv >> 6, dd = cv & 63;
                            *(u32x4*)(KV + (size_t)row * 256 + cl) = pack8f(v0, v1);
                            float* dst = nullptr;
                            if (kind == 0 && t >= TP - 128) dst = out + O_VP + ((size_t)(b * 128 + (t - (TP - 128))) * 2 + kh) * 64;
                            else if (kind == 1) dst = out + O_VS + ((size_t)(b * 128 + 124 + t) * 2 + kh) * 64;
                            if (dst) { *(f32x4*)(dst + dd) = v0; *(f32x4*)(dst + dd + 4) = v1; }
                        }
                    } else if (pn < 9) {
                        const int c = (pn - 3) * 256 + cl;
                        *(u32x4*)(QKVB + (size_t)row * 1536 + c) = pack8f(v0, v1);
                        float* dst = nullptr;
                        if (kind == 0 && t >= TP - 3) dst = out + O_CP + ((size_t)b * 3 + (t - (TP - 3))) * 1536;
                        else if (kind == 1 && t >= 1) dst = out + O_CS + ((size_t)b * 3 + (t - 1)) * 1536;
                        if (dst) { *(f32x4*)(dst + c) = v0; *(f32x4*)(dst + c + 4) = v1; }
                    } else if (pn < 11) {
                        const int c = (pn - 9) * 256 + cl;
                        *(u32x4*)(Z + (size_t)row * 512 + c) = pack8f(v0, v1);
                    } else {
                        const int c = (pn - 11) * 256 + cl;
                        f32x4 g0, g1;
#pragma unroll
                        for (int e = 0; e < 4; ++e) { g0[e] = sigmoidf_(v0[e]); g1[e] = sigmoidf_(v1[e]); }
                        *(u32x4*)(G + (size_t)row * 2048 + c) = pack8f(g0, g1);
                    }
                }
            }
    }
};

template <bool ACCUM> struct EpiMerge {
    static constexpr bool PERM = true, AFTER_DRAIN = false;
    bf16_t* MBp; const bf16_t* G; int gate_off;
    __device__ __forceinline__ void operator()(const f32x4 (&acc)[2][2][4][2], const Unit& u, int wr, int wc, int fr, int fq) const {
#pragma unroll
        for (int ai = 0; ai < 2; ++ai)
#pragma unroll
            for (int m = 0; m < 4; ++m) {
                const int crow = u.pm * BM + ai * HALF + wr * 64 + m * 16 + fr, urow = crow_to_urow(crow);
#pragma unroll
                for (int bj = 0; bj < 2; ++bj) {
                    const int c = u.pn * BM + bj * HALF + wc * 32 + 8 * fq;
                    const u32x4 gw = *(const u32x4*)(G + (size_t)urow * 2048 + gate_off + c);
                    f32x4 v0 = acc[ai][bj][m][0], v1 = acc[ai][bj][m][1];
                    v0[0] *= bflo(gw.x); v0[1] *= bfhi(gw.x); v0[2] *= bflo(gw.y); v0[3] *= bfhi(gw.y);
                    v1[0] *= bflo(gw.z); v1[1] *= bfhi(gw.z); v1[2] *= bflo(gw.w); v1[3] *= bfhi(gw.w);
                    bf16_t* p = MBp + (size_t)crow * 1024 + c;
                    if (ACCUM) { const u32x4 pw = *(const u32x4*)p;
                        v0[0] += bflo(pw.x); v0[1] += bfhi(pw.x); v0[2] += bflo(pw.y); v0[3] += bfhi(pw.y);
                        v1[0] += bflo(pw.z); v1[1] += bfhi(pw.z); v1[2] += bflo(pw.w); v1[3] += bfhi(pw.w); }
                    *(u32x4*)p = pack8f(v0, v1);
                }
            }
    }
};

template <bool ATOM = true> struct EpiWout {
    static constexpr bool PERM = true, AFTER_DRAIN = false;
    const float* xp; const float* xs; bf16_t* HB; float* SS;
    __device__ __forceinline__ void operator()(const f32x4 (&acc)[2][2][4][2], const Unit& u, int wr, int wc, int fr, int fq) const {
#pragma unroll
        for (int ai = 0; ai < 2; ++ai)
#pragma unroll
            for (int m = 0; m < 4; ++m) {
                const int crow = u.pm * BM + ai * HALF + wr * 64 + m * 16 + fr;
                const float* hs = crow < NBATCH * SEQ ? xp + (size_t)crow * D : xs + (size_t)(crow - NBATCH * SEQ) * D;
                float ss = 0.f;
#pragma unroll
                for (int bj = 0; bj < 2; ++bj) {
                    const int c = u.pn * BM + bj * HALF + wc * 32 + 8 * fq;
                    const f32x4 r0 = *(const f32x4*)(hs + c) + acc[ai][bj][m][0], r1 = *(const f32x4*)(hs + c + 4) + acc[ai][bj][m][1];
                    *(u32x4*)(HB + (size_t)crow * D + c) = pack8f(r0, r1);
                    ss += (r0[0] * r0[0] + r0[1] * r0[1]) + (r0[2] * r0[2] + r0[3] * r0[3]) + (r1[0] * r1[0] + r1[1] * r1[1]) + (r1[2] * r1[2] + r1[3] * r1[3]);
                }
                ss += __shfl_xor(ss, 16); ss += __shfl_xor(ss, 32);
                if (ATOM && fq == 0) atomicAdd(SS + crow, ss);
            }
    }
};

struct EpiGateUp {
    static constexpr bool PERM = true, AFTER_DRAIN = false;
    bf16_t* ACT; const float* SS;
    __device__ __forceinline__ void operator()(const f32x4 (&acc)[2][2][4][2], const Unit& u, int wr, int wc, int fr, int fq) const {
#pragma unroll
        for (int ai = 0; ai < 2; ++ai)
#pragma unroll
            for (int m = 0; m < 4; ++m) {
                const int crow = u.pm * BM + ai * HALF + wr * 64 + m * 16 + fr;
                const float rstd = rsqrtf(SS[crow] * (1.0f / D) + EPS);
                f32x4 a[2];
#pragma unroll
                for (int n = 0; n < 2; ++n)
#pragma unroll
                    for (int e = 0; e < 4; ++e) { const float g = acc[ai][0][m][n][e] * rstd, up = acc[ai][1][m][n][e] * rstd; a[n][e] = siluf_(g) * up; }
                *(u32x4*)(ACT + (size_t)crow * DFF + u.pn * HALF + wc * 32 + 8 * fq) = pack8f(a[0], a[1]);
            }
    }
};

template <bool DRY = false> struct EpiDown {
    static constexpr bool PERM = true, AFTER_DRAIN = false;
    const bf16_t* HB; float* H;
    __device__ __forceinline__ void operator()(const f32x4 (&acc)[2][2][4][2], const Unit& u, int wr, int wc, int fr, int fq) const {
#pragma unroll
        for (int ai = 0; ai < 2; ++ai)
#pragma unroll
            for (int m = 0; m < 4; ++m) {
                const int crow = u.pm * BM + ai * HALF + wr * 64 + m * 16 + fr;
#pragma unroll
                for (int bj = 0; bj < 2; ++bj) {
                    const size_t off = (size_t)crow * D + u.pn * BM + bj * HALF + wc * 32 + 8 * fq;
                    const u32x4 hw = *(const u32x4*)(HB + off);
                    f32x4 r0 = acc[ai][bj][m][0], r1 = acc[ai][bj][m][1];
                    r0[0] += bflo(hw.x); r0[1] += bfhi(hw.x); r0[2] += bflo(hw.y); r0[3] += bfhi(hw.y);
                    r1[0] += bflo(hw.z); r1[1] += bfhi(hw.z); r1[2] += bflo(hw.w); r1[3] += bfhi(hw.w);
                    *(f32x4*)(H + off) = r0; *(f32x4*)(H + off + 4) = r1;
                }
            }
    }
};
template <class Epi, class Sched, bool ALIGN_EPI = false, bool SP2 = false>
__device__ __forceinline__ void gemm_phase(PG8_LAS unsigned char* lds, const Gemm g, const Sched& S, const Epi& E) {
    const int tid = threadIdx.x, wid = __builtin_amdgcn_readfirstlane(tid >> 6), lane = tid & 63, wr = wid >> 2, wc = wid & 3, fr = lane & 15, fq = lane >> 4;
    const int K = g.K, nt = K / BK;
    unsigned voffA[2], voffB[2];
#pragma unroll
    for (int i = 0; i < 2; ++i) { int R, C; stage_rc(tid * 16 + i * 8192, R, C); const int Rb = Epi::PERM ? ((R & ~31) + perm32(R & 31)) : R;
        voffA[i] = (unsigned)(R * K + C) * 2u; voffB[i] = (unsigned)(Rb * K + C) * 2u; }
    const size_t kstep = (size_t)(BK * 2);
    const size_t hstep = (size_t)HALF * K * 2;
    const size_t tstep = 2 * hstep;
    const unsigned ldsw = (unsigned)wid * 1024u;
    const int aoff = lds_byte(wr * 64 + fr, fq * 8), boff = lds_byte(wc * 32 + fr, fq * 8);
#define PG8_SA(b, h) (((b) * 2 + (h)) * HTB)
#define PG8_SB(b, h) ((4 + (b) * 2 + (h)) * HTB)
#define PG8_STAGE(bufoff, gbase, voff) do { _Pragma("unroll") for (int _i = 0; _i < 2; ++_i) \
        __builtin_amdgcn_global_load_lds((const unsigned*)((const char*)(gbase) + (voff)[_i]), (PG8_LAS unsigned*)(lds + (bufoff) + ldsw + _i * 8192), 16, 0, 0); } while (0)
#define PG8_STAGE_A(bufoff, gbase, voff) do { _Pragma("unroll") for (int _i = 0; _i < 2; ++_i) { \
        if constexpr (Sched::A_SC1) __builtin_amdgcn_global_load_lds((const unsigned*)((const char*)(gbase) + (voff)[_i]), (PG8_LAS unsigned*)(lds + (bufoff) + ldsw + _i * 8192), 16, 0, 16); \
        else __builtin_amdgcn_global_load_lds((const unsigned*)((const char*)(gbase) + (voff)[_i]), (PG8_LAS unsigned*)(lds + (bufoff) + ldsw + _i * 8192), 16, 0, 0); } } while (0)
#define PG8_LDA(dst, b, h) do { _Pragma("unroll") for (int m = 0; m < 4; ++m) _Pragma("unroll") for (int k = 0; k < 2; ++k) dst[m][k] = *(const PG8_LAS bf16x8*)(lds + PG8_SA(b, h) + aoff + m * 2048 + k * 1024); } while (0)
#define PG8_LDB(dst, b, h) do { _Pragma("unroll") for (int n = 0; n < 2; ++n) _Pragma("unroll") for (int k = 0; k < 2; ++k) dst[n][k] = *(const PG8_LAS bf16x8*)(lds + PG8_SB(b, h) + boff + n * 2048 + k * 1024); } while (0)
#define PG8_MMA(ai, bj, At, Bt) do { __builtin_amdgcn_s_setprio(1); _Pragma("unroll") for (int m = 0; m < 4; ++m) _Pragma("unroll") for (int n = 0; n < 2; ++n) _Pragma("unroll") for (int k = 0; k < 2; ++k) \
        acc[ai][bj][m][n] = __builtin_amdgcn_mfma_f32_16x16x32_bf16(Bt[n][k], At[m][k], acc[ai][bj][m][n], 0, 0, 0); __builtin_amdgcn_s_setprio(0); } while (0)
#define PG8_WAIT_V(n) asm volatile("s_waitcnt vmcnt(" #n ")" ::: "memory")
#define PG8_WAIT_L(n) asm volatile("s_waitcnt lgkmcnt(" #n ")" ::: "memory")
#define PG8_BAR __builtin_amdgcn_s_barrier()
#define PG8_SCHED __builtin_amdgcn_sched_barrier(0)
    Unit cur, nxt; int ui = 0;
    if (!S.next(0, cur)) return;
    f32x4 acc[2][2][4][2];
#pragma unroll
    for (int a = 0; a < 2; ++a)
#pragma unroll
        for (int b = 0; b < 2; ++b)
#pragma unroll
            for (int m = 0; m < 4; ++m)
#pragma unroll
                for (int n = 0; n < 2; ++n) acc[a][b][m][n] = (f32x4){0.f, 0.f, 0.f, 0.f};
    bf16x8 At[4][2], B0[2][2], B1[2][2];
    const char* cA = (const char*)g.A + (size_t)cur.pm * tstep; const char* cB = (const char*)g.Bt + (size_t)cur.pn * tstep;
    S.a_ready(cur);
    if constexpr (SP2) {
        PG8_STAGE(PG8_SB(0, 0), cB, voffB); PG8_STAGE(PG8_SB(0, 1), cB + hstep, voffB); PG8_STAGE_A(PG8_SA(0, 0), cA, voffA); PG8_STAGE_A(PG8_SA(0, 1), cA + hstep, voffA);
        if (wr == 1) PG8_BAR;
        PG8_WAIT_V(2); PG8_BAR;
        PG8_STAGE(PG8_SB(1, 0), cB + kstep, voffB); PG8_STAGE_A(PG8_SA(1, 0), cA + kstep, voffA); PG8_STAGE(PG8_SB(1, 1), cB + hstep + kstep, voffB);
        PG8_WAIT_V(6); PG8_BAR;
    } else {
        PG8_STAGE(PG8_SB(0, 0), cB, voffB); PG8_STAGE_A(PG8_SA(0, 0), cA, voffA); PG8_STAGE(PG8_SB(0, 1), cB + hstep, voffB); PG8_STAGE_A(PG8_SA(0, 1), cA + hstep, voffA);
        if (wr == 1) PG8_BAR;
        PG8_WAIT_V(4); PG8_BAR;
        PG8_STAGE(PG8_SB(1, 0), cB + kstep, voffB); PG8_STAGE_A(PG8_SA(1, 0), cA + kstep, voffA); PG8_STAGE(PG8_SB(1, 1), cB + hstep + kstep, voffB);
        PG8_WAIT_V(6); PG8_BAR;
    }
    for (;;) {
        const bool has_next = S.next(ui + 1, nxt);
        const char* nA = has_next ? (const char*)g.A + (size_t)nxt.pm * tstep : cA; const char* nB = has_next ? (const char*)g.Bt + (size_t)nxt.pn * tstep : cB;
        for (int t = 0; t < nt; t += 2) {
            const bool last = (t == nt - 2);
            const char* a1 = cA + (size_t)(t + 1) * kstep;
            const char* a2 = last ? nA : cA + (size_t)(t + 2) * kstep; const char* b2 = last ? nB : cB + (size_t)(t + 2) * kstep;
            const char* a3 = a2 + kstep; const char* b3 = b2 + kstep;
            if (last && has_next) S.a_ready(nxt);
            if constexpr (SP2) {
            PG8_LDB(B0, 0, 0); PG8_LDB(B1, 0, 1); PG8_SCHED; PG8_LDA(At, 0, 0); PG8_STAGE_A(PG8_SA(1, 1), a1 + hstep, voffA);
            PG8_WAIT_V(8); PG8_WAIT_L(0); PG8_BAR; PG8_MMA(0, 0, At, B0); PG8_MMA(0, 1, At, B1); PG8_BAR; PG8_SCHED;
            PG8_LDA(At, 0, 1); PG8_STAGE(PG8_SB(0, 0), b2, voffB); PG8_STAGE(PG8_SB(0, 1), b2 + hstep, voffB); PG8_STAGE_A(PG8_SA(0, 0), a2, voffA);
            PG8_WAIT_V(8); PG8_WAIT_L(0); PG8_BAR; PG8_MMA(1, 0, At, B0); PG8_MMA(1, 1, At, B1); PG8_BAR; PG8_SCHED;
            PG8_LDB(B0, 1, 0); PG8_LDB(B1, 1, 1); PG8_SCHED; PG8_LDA(At, 1, 0); PG8_STAGE_A(PG8_SA(0, 1), a2 + hstep, voffA);
            PG8_WAIT_V(8); PG8_WAIT_L(0); PG8_BAR; PG8_MMA(0, 0, At, B0); PG8_MMA(0, 1, At, B1); PG8_BAR; PG8_SCHED;
            PG8_LDA(At, 1, 1); PG8_STAGE(PG8_SB(1, 0), b3, voffB); PG8_STAGE(PG8_SB(1, 1), b3 + hstep, voffB); PG8_STAGE_A(PG8_SA(1, 0), a3, voffA);
            PG8_WAIT_V(8); PG8_WAIT_L(0); PG8_BAR; PG8_MMA(1, 0, At, B0); PG8_MMA(1, 1, At, B1); PG8_BAR; PG8_SCHED;
            } else {
            PG8_LDB(B0, 0, 0); PG8_SCHED; PG8_LDA(At, 0, 0); PG8_STAGE_A(PG8_SA(1, 1), a1 + hstep, voffA);
            PG8_WAIT_L(8); PG8_BAR; PG8_WAIT_L(0); PG8_MMA(0, 0, At, B0); PG8_BAR; PG8_SCHED;
            PG8_LDB(B1, 0, 1); PG8_STAGE(PG8_SB(0, 0), b2, voffB);
            PG8_BAR; PG8_WAIT_L(0); PG8_MMA(0, 1, At, B1); PG8_BAR;
            PG8_LDA(At, 0, 1); PG8_STAGE_A(PG8_SA(0, 0), a2, voffA);
            PG8_BAR; PG8_WAIT_L(0); PG8_MMA(1, 0, At, B0); PG8_BAR; PG8_SCHED;
            PG8_STAGE(PG8_SB(0, 1), b2 + hstep, voffB);
            PG8_WAIT_V(6); PG8_BAR; PG8_MMA(1, 1, At, B1); PG8_BAR;
            PG8_LDB(B0, 1, 0); PG8_SCHED; PG8_LDA(At, 1, 0); PG8_STAGE_A(PG8_SA(0, 1), a2 + hstep, voffA);
            PG8_WAIT_L(8); PG8_BAR; PG8_WAIT_L(0); PG8_MMA(0, 0, At, B0); PG8_BAR; PG8_SCHED;
            PG8_LDB(B1, 1, 1); PG8_STAGE(PG8_SB(1, 0), b3, voffB);
            PG8_BAR; PG8_WAIT_L(0); PG8_MMA(0, 1, At, B1); PG8_BAR;
            PG8_LDA(At, 1, 1); PG8_STAGE_A(PG8_SA(1, 0), a3, voffA);
            PG8_BAR; PG8_WAIT_L(0); PG8_MMA(1, 0, At, B0); PG8_BAR; PG8_SCHED;
            PG8_STAGE(PG8_SB(1, 1), b3 + hstep, voffB);
            PG8_WAIT_V(6); PG8_BAR; PG8_MMA(1, 1, At, B1); PG8_BAR;
            }
        }
        if constexpr (ALIGN_EPI) { if (wr == 0) PG8_BAR; }
        if constexpr (!Epi::AFTER_DRAIN) { E(acc, cur, wr, wc, fr, fq); S.done(cur); }
        if (!has_next) break;
#pragma unroll
        for (int a = 0; a < 2; ++a)
#pragma unroll
            for (int b = 0; b < 2; ++b)
#pragma unroll
                for (int m = 0; m < 4; ++m)
#pragma unroll
                    for (int n = 0; n < 2; ++n) acc[a][b][m][n] = (f32x4){0.f, 0.f, 0.f, 0.f};
        cur = nxt; cA = nA; cB = nB; ++ui;
        if constexpr (ALIGN_EPI) { if (wr == 1) PG8_BAR; }
    }
    PG8_WAIT_V(0);
    if constexpr (!ALIGN_EPI) { if (wr == 0) PG8_BAR; }
    PG8_BAR;
    if constexpr (Epi::AFTER_DRAIN) { E.fused(acc, cur, wr, wc, fr, fq, lds, wid, lane); S.done(cur); }
#undef PG8_SA
#undef PG8_SB
#undef PG8_STAGE
#undef PG8_STAGE_A
#undef PG8_LDA
#undef PG8_LDB
#undef PG8_MMA
#undef PG8_WAIT_V
#undef PG8_WAIT_L
#undef PG8_BAR
#undef PG8_SCHED
}
}
constexpr int NWAVES = 8, NTHREADS = NWAVES * 64;
constexpr int LDS_BYTES = 147456;
constexpr int LDS_MISC = 131072;
constexpr int N_PHASES = 9;

struct Args {
    const float *x_prompt, *x_sample, *cache_k, *cache_v, *state_delta, *state_conv, *meta, *norm_mix, *w_in, *conv_w, *a_log, *dt_bias, *sinks, *gdn_norm,
                *w_oa, *w_ob, *w_out, *norm_ffn, *w_gate, *w_up, *w_down, *norm_final;
    float* out; unsigned char* ws; int ph_lo, ph_hi;
};

typedef const __attribute__((address_space(4))) Args* KA;
DI KA kargs() { KA p = (KA)__builtin_amdgcn_kernarg_segment_ptr(); asm volatile("" : "+s"(p)); return p; }
#define RLX_AGENT __ATOMIC_RELAXED, __HIP_MEMORY_SCOPE_AGENT
#define LDS_WAIT() asm volatile("s_waitcnt lgkmcnt(0)" ::: "memory")
#define MFMA32(a, b, c) __builtin_amdgcn_mfma_f32_32x32x16_bf16((a), (b), (c), 0, 0, 0)
DI int crow16(int reg, int h) { return (reg & 3) + 8 * (reg >> 2) + 4 * h; }
DI float wave_sum(float v) {
#pragma unroll
    for (int o = 1; o < 64; o <<= 1) v += __shfl_xor(v, o);
    return v;
}
DI float wave_max(float v) {
#pragma unroll
    for (int o = 1; o < 64; o <<= 1) v = fmaxf(v, __shfl_xor(v, o));
    return v;
}
template <int S> DI bf16x8 pack_step(const f32x16& x) {
    u32x4 p; p.x = cvtpk(x[8 * S], x[8 * S + 1]); p.y = cvtpk(x[8 * S + 2], x[8 * S + 3]); p.z = cvtpk(x[8 * S + 4], x[8 * S + 5]); p.w = cvtpk(x[8 * S + 6], x[8 * S + 7]);
    return __builtin_bit_cast(bf16x8, p);
}
DI int frag_idx(int row, int k, int NKS) { const int kkk = k & 15; return (((row >> 5) * NKS + (k >> 4)) * 64 + (row & 31) + 32 * ((kkk >> 2) & 1)) * 8 + (((kkk >> 3) << 2) | (kkk & 3)); }
DI unsigned char* slot_ptr(KA A, int item) { return item < PREP_N1 ? A->ws + WS_B + (size_t)item * PREP_SLOT : (unsigned char*)A->out + (size_t)(item - PREP_N1) * PREP_SLOT; }

#define XB_TMO      128
#define XB_XCNT(j)  (256  + 64 * (j))
#define XB_XSUB(j)  (1280 + 64 * (j))
#define XB_XGEN(j)  (2304 + 64 * (j))
#define XB_TOP      3328
#define XB_TOPGEN   3392
#define XCD_BAR_WORDS 3456
#define XB_SPIN_CAP (1u << 20)
DI unsigned xb_ld(unsigned* p)              { return __hip_atomic_load(p, __ATOMIC_RELAXED, __HIP_MEMORY_SCOPE_AGENT); }
DI unsigned xb_add(unsigned* p, unsigned v) { return __hip_atomic_fetch_add(p, v, __ATOMIC_RELAXED, __HIP_MEMORY_SCOPE_AGENT); }
DI unsigned xb_xcc_id() { return (unsigned)__builtin_amdgcn_s_getreg((3 << 11) | 20) & 0xFu; }
#define XB_SPIN(cond, bar) do { unsigned _sp = 0; while (cond) { __builtin_amdgcn_s_sleep(1); \
    if ((++_sp & 255u) == 0u) { if (xb_ld(&(bar)[XB_TMO])) break; if (_sp > XB_SPIN_CAP) { atomicAdd(&(bar)[XB_TMO], 1u); break; } } } } while (0)
struct XcdBarrier { unsigned* bar; unsigned x; volatile LAS unsigned* st; };
DI XcdBarrier xcd_barrier_post(unsigned* bar, volatile LAS unsigned* st) {
    XcdBarrier b; b.bar = bar; b.x = xb_xcc_id(); b.st = st;
    if (threadIdx.x == 0) (void)xb_add(&bar[XB_XCNT(b.x)], 1u);
    return b;
}
DI void xcd_barrier_complete(unsigned* bar, unsigned x, unsigned& nloc, unsigned& nx) {
    const unsigned G = gridDim.x * gridDim.y * gridDim.z;
    unsigned sum, cnt, mine, sp = 0u;
    for (;;) {
        sum = 0u; cnt = 0u; mine = 0u;
#pragma unroll
        for (unsigned j = 0; j < 16; ++j) { const unsigned c = xb_ld(&bar[XB_XCNT(j)]); sum += c; cnt += (c > 0u) ? 1u : 0u; mine = (j == x) ? c : mine; }
        if (sum == G) break;
        __builtin_amdgcn_s_sleep(1);
        if ((++sp & 255u) == 0u) { if (xb_ld(&bar[XB_TMO])) break; if (sp > XB_SPIN_CAP) { atomicAdd(&bar[XB_TMO], 1u); break; } }
    }
    nloc = mine > 0u ? mine : 1u; nx = cnt > 0u ? cnt : 1u;
}
DI void xcd_barrier(const XcdBarrier& b) {
    asm volatile("s_waitcnt vmcnt(0)" ::: "memory");
    __syncthreads();
    if (threadIdx.x == 0) {
        unsigned* bar = b.bar;
        __builtin_amdgcn_s_waitcnt(0);
        unsigned nloc = b.st[0], nx = b.st[1];
        if (nloc == 0u) { xcd_barrier_complete(bar, b.x, nloc, nx); b.st[0] = nloc; b.st[1] = nx; }
        const unsigned old = xb_add(&bar[XB_XSUB(b.x)], 1u);
        const unsigned gen = old / nloc;
        if (old + 1u == (gen + 1u) * nloc) {
            __builtin_amdgcn_fence(__ATOMIC_RELEASE, "agent");
            asm volatile("s_waitcnt vmcnt(0)" ::: "memory");
            const unsigned og = xb_add(&bar[XB_TOP], 1u);
            const unsigned tg = og / nx;
            if (og + 1u == (tg + 1u) * nx) xb_add(&bar[XB_TOPGEN], 1u);
            else XB_SPIN(xb_ld(&bar[XB_TOPGEN]) == tg, bar);
            __builtin_amdgcn_fence(__ATOMIC_ACQUIRE, "agent");
            xb_add(&bar[XB_XGEN(b.x)], 1u);
            asm volatile("s_waitcnt vmcnt(0)" ::: "memory");
        } else {
            XB_SPIN(xb_ld(&bar[XB_XGEN(b.x)]) == gen, bar);
            __builtin_amdgcn_fence(__ATOMIC_ACQUIRE, "agent");
            asm volatile("s_waitcnt vmcnt(0)" ::: "memory");
        }
    }
    __syncthreads();
}

template <class RowMap> DI void transpose_item(const float* W, int K, int N, bf16* WT, RowMap rm, const float* kscale, LAS float* scr, int item, int lane) {
    const int nblk = (N + 31) / 32, kb = item / nblk, nb = item - kb * nblk, k0 = 64 * kb, n0 = 32 * nb;
    const int ncol = n0 + (lane & 31);
#pragma unroll 8
    for (int i = 0; i < 32; ++i) { const int kk = 2 * i + (lane >> 5);
        float v = ncol < N ? W[(size_t)(k0 + kk) * N + ncol] : 0.f;
        if (kscale) v *= kscale[k0 + kk];
        scr[kk * 33 + (lane & 31)] = v; }
    LDS_WAIT(); asm volatile("" ::: "memory");
    const int c = lane & 7;
#pragma unroll
    for (int j = 0; j < 4; ++j) { const int n = (lane >> 3) + 8 * j; const LAS float* s = scr + (8 * c) * 33 + n;
        const int nsrc = n0 + n; const int drow = nsrc < N ? rm(nsrc) : -1;
        u32x4 o; o.x = cvtpk(s[0 * 33], s[1 * 33]); o.y = cvtpk(s[2 * 33], s[3 * 33]); o.z = cvtpk(s[4 * 33], s[5 * 33]); o.w = cvtpk(s[6 * 33], s[7 * 33]);
        if (drow >= 0) *(u32x4*)(WT + (size_t)drow * K + k0 + 8 * c) = o; }
    LDS_WAIT(); asm volatile("" ::: "memory");
}
DI float softplusf_(float x) { return x > 20.f ? x : log1pf(__expf(x)); }

#ifndef PROBE_REP
#define PROBE_REP -1
#endif
DI void p0_prologue(KA A, LAS unsigned char* lds) {
    const int tid = threadIdx.x, lane = tid & 63, wave = __builtin_amdgcn_readfirstlane(tid >> 6);
    const int G = gridDim.x, gw = blockIdx.x * NWAVES + wave, NGW = G * NWAVES;
    const int gt = blockIdx.x * NTHREADS + tid, NGT = G * NTHREADS;
    unsigned char* ws = A->ws;
    for (int rep = 0; rep < (PROBE_REP == 1001 ? 2 : 1); ++rep) {
        LAS float* scr = (LAS float*)(lds + wave * 16384);
        constexpr int I_IN = 16 * 153, I_OA = 8 * 32, I_OUT = 16 * 32, I_G = 16 * 88, I_D = 44 * 32;
        constexpr int NIT = I_IN + 2 * I_OA + I_OUT + 2 * I_G + I_D;
        for (int it = gw; it < NIT; it += NGW) {
            int r = it;
            if (r < I_IN) { transpose_item(A->w_in, 1024, NIN_SRC, (bf16*)(ws + WS_WIN), [](int c) -> int {
                    if (c < 640) return (c & ~63) + pos_of_d(c & 63);
                    if (c < 2816) return c;
                    if (c < 2824) return -1;
                    return c - 8; }, nullptr, scr, r, lane); continue; } r -= I_IN;
            if (r < I_OA) { transpose_item(A->w_oa, 512, 1024, (bf16*)(ws + WS_WOA), [](int c) -> int { return c; }, nullptr, scr, r, lane); continue; } r -= I_OA;
            if (r < I_OA) { transpose_item(A->w_ob, 512, 1024, (bf16*)(ws + WS_WOB), [](int c) -> int { return c; }, nullptr, scr, r, lane); continue; } r -= I_OA;
            if (r < I_OUT) { transpose_item(A->w_out, 1024, 1024, (bf16*)(ws + WS_WOUT), [](int c) -> int { return c; }, nullptr, scr, r, lane); continue; } r -= I_OUT;
            if (r < I_G) { transpose_item(A->w_gate, 1024, DFF, (bf16*)(ws + WS_WGU), [](int c) -> int { return 256 * (c >> 7) + (c & 127); }, A->norm_ffn, scr, r, lane); continue; } r -= I_G;
            if (r < I_G) { transpose_item(A->w_up, 1024, DFF, (bf16*)(ws + WS_WGU), [](int c) -> int { return 256 * (c >> 7) + 128 + (c & 127); }, A->norm_ffn, scr, r, lane); continue; } r -= I_G;
            transpose_item(A->w_down, DFF, 1024, (bf16*)(ws + WS_WD), [](int c) -> int { return c; }, nullptr, scr, r, lane);
        }
    }
    for (int rep = 0; rep < (PROBE_REP == 1002 ? 2 : 1); ++rep) {
        float* COS = (float*)(ws + WS_ROPE); float* SIN = COS + (TP + TS) * 32;
        for (int i = gt; i < (TP + TS) * 32; i += NGT) { const int ri = i >> 5, f = i & 31; const double pos = ri < TP ? (double)ri : (double)(PAST + ri - TP);
            const double inv = exp2(-(double)f * (13.287712379549449 / 32.0)), ang = pos * inv; COS[i] = (float)cos(ang); SIN[i] = (float)sin(ang); }
        constexpr int PERB = 124 * 128 / 4;
        for (int i = gt; i < SBATCH * PERB; i += NGT) { const int b = i / PERB, o = i - b * PERB;
            ((f32x4*)(A->out + O_KS))[(size_t)b * 4096 + o] = ((const f32x4*)A->cache_k)[(size_t)b * 4096 + 128 + o];
            ((f32x4*)(A->out + O_VS))[(size_t)b * 4096 + o] = ((const f32x4*)A->cache_v)[(size_t)b * 4096 + 128 + o]; }
    }
    for (int rep = 0; rep < (PROBE_REP == 1003 ? 2 : 1); ++rep) {
        unsigned wab[16][4];
        f32x4 nm[4];
#pragma unroll
        for (int j = 0; j < 4; ++j) {
            nm[j] = ((const f32x4*)A->norm_mix)[lane + 64 * j];
#pragma unroll
            for (int e = 0; e < 4; ++e) { const float* p = A->w_in + (size_t)(4 * (lane + 64 * j) + e) * NIN_SRC + 2816;
                const f32x4 a = *(const f32x4*)p, b = *(const f32x4*)(p + 4);
                wab[j * 4 + e][0] = cvtpk(a[0], a[1]); wab[j * 4 + e][1] = cvtpk(a[2], a[3]); wab[j * 4 + e][2] = cvtpk(b[0], b[1]); wab[j * 4 + e][3] = cvtpk(b[2], b[3]); }
        }
        bf16* XN = (bf16*)(ws + WS_XN); f32x2* GB = (f32x2*)(ws + WS_GB);
        for (int urow = gw; urow < MUP; urow += NGW) {
            const float* src = nullptr;
            if (urow < MP) { const int b = urow / TP, t = urow - b * TP; src = t < NMETA ? A->meta + (size_t)t * D : A->x_prompt + ((size_t)b * SEQ + (t - NMETA)) * D; }
            else if (urow < MU) src = A->x_sample + (size_t)(urow - MP) * D;
            u32x2* o8 = (u32x2*)(XN + (size_t)urow * D) + lane;
            if (!src) {
#pragma unroll
                for (int j = 0; j < 4; ++j) o8[64 * j] = (u32x2){0u, 0u};
                if (lane < 4) GB[(size_t)urow * 4 + lane] = (f32x2){0.f, 0.f};
                continue; }
            f32x4 v[4]; float ss = 0.f;
#pragma unroll
            for (int j = 0; j < 4; ++j) { v[j] = ((const f32x4*)src)[lane + 64 * j]; ss += (v[j][0] * v[j][0] + v[j][1] * v[j][1]) + (v[j][2] * v[j][2] + v[j][3] * v[j][3]); }
            const float rstd = rsqrtf(wave_sum(ss) * (1.0f / D) + EPS);
            float dot[8];
#pragma unroll
            for (int c = 0; c < 8; ++c) dot[c] = 0.f;
#pragma unroll
            for (int j = 0; j < 4; ++j) { v[j] = v[j] * rstd * nm[j];
                o8[64 * j] = (u32x2){cvtpk(v[j][0], v[j][1]), cvtpk(v[j][2], v[j][3])};
#pragma unroll
                for (int e = 0; e < 4; ++e)
#pragma unroll
                    for (int c = 0; c < 4; ++c) { dot[2 * c] += v[j][e] * bflo(wab[j * 4 + e][c]); dot[2 * c + 1] += v[j][e] * bfhi(wab[j * 4 + e][c]); } }
#pragma unroll
            for (int c = 0; c < 8; ++c) dot[c] = wave_sum(dot[c]);
            if (lane < 4) {
                const float a = lane == 0 ? dot[0] : lane == 1 ? dot[1] : lane == 2 ? dot[2] : dot[3];
                const float bb = lane == 0 ? dot[4] : lane == 1 ? dot[5] : lane == 2 ? dot[6] : dot[7];
                const float g = -__expf(A->a_log[lane]) * softplusf_(a + A->dt_bias[lane]);
                GB[(size_t)urow * 4 + lane] = (f32x2){g, sigmoidf_(bb)};
            }
        }
    }
}
DI void item_decode(int item, int& b, int& h, bool& sample, int& t0, int& L) {
    if (item < N_ITEMS_P) { const int s = item / CHUNKS_P, c = item - s * CHUNKS_P; b = s >> 2; h = s & 3; sample = false; if (c == 0) { t0 = 0; L = NMETA; } else { t0 = NMETA + 64 * (c - 1); L = 64; } }
    else { const int s = item - N_ITEMS_P; b = s >> 2; h = s & 3; sample = true; t0 = 0; L = TS; }
}
#define LDS_BARRIER() do { asm volatile("s_waitcnt lgkmcnt(0)" ::: "memory"); __builtin_amdgcn_s_barrier(); asm volatile("" ::: "memory"); } while (0)
typedef GAS unsigned long long gu64;
constexpr size_t CTL_F1 = 655360;
static_assert(CTL_F1 + 2592 * 64 <= 1048576, "control region map");
DI gu64* item_flag1(KA A, int item) { return (gu64*)(A->ws + WS_CTL + CTL_F1 + (size_t)item * 64); }
DI int order_item(int m) { return m < N_ITEMS_P ? (m & 31) * CHUNKS_P + (m >> 5) : m; }
DI gu64* item_granule(KA A, int item) { return (gu64*)(A->ws + WS_CTL + CTL_GRAN + (size_t)item * 64); }
DI float wait_item(gu64* g, unsigned ep = 1u) {
    unsigned long long x; unsigned spins = 0;
    for (;;) { x = __hip_atomic_load(g, __ATOMIC_RELAXED, __HIP_MEMORY_SCOPE_AGENT); if ((unsigned)(x >> 32) >= ep) break; __builtin_amdgcn_s_sleep(8); if (++spins > (1u << 20)) break; }
    asm volatile("" ::: "memory");
    return __uint_as_float((unsigned)__builtin_amdgcn_readfirstlane((int)(unsigned)x));
}
constexpr int LDS_GCL = 139264;
constexpr int PITCH = 132;
DI bf16x8 frag_nat(const LAS float* src, int row, int k0) {
    const f32x4 lo = *(const LAS f32x4*)(src + row * PITCH + k0), hi = *(const LAS f32x4*)(src + row * PITCH + k0 + 4);
    return __builtin_bit_cast(bf16x8, pack8f(lo, hi));
}
struct S1Pre { u32x4 xr[11]; f32x4 w[4][2]; f32x2 gb; };
DI void stage1_issue(KA A, int item, S1Pre& P) {
    const int tid = threadIdx.x, lane = tid & 63, wave = __builtin_amdgcn_readfirstlane(tid >> 6);
    int b, h, t0, L; bool sample; item_decode(item, b, h, sample, t0, L);
    const bf16* QKVB = (const bf16*)(A->ws + WS_QKVB);
    const int cv = lane < 48 ? lane : 47, grp = cv >> 4, col0 = (cv & 15) * 8, r0 = wave * 8, cidx = grp * 512 + h * 128 + col0;
#pragma unroll
    for (int q = 0; q < 11; ++q) {
        const int i = r0 - 3 + q;
        long urow = sample ? (long)MP + b * TS + i : (long)b * TP + t0 + i;
        const bool ok = sample ? i >= 0 : t0 + i >= 0;
        if (!ok) urow = 0;
        P.xr[q] = *(const u32x4*)(QKVB + (size_t)urow * CONVD + cidx);
        if (!ok) P.xr[q] = (u32x4){0u, 0u, 0u, 0u};
    }
#pragma unroll
    for (int i = 0; i < 4; ++i) { P.w[i][0] = *(const f32x4*)(A->conv_w + i * CONVD + cidx); P.w[i][1] = *(const f32x4*)(A->conv_w + i * CONVD + cidx + 4); }
    P.gb = (f32x2){0.f, 0.f};
    if (wave == 7 && lane < L) { const int urow = sample ? MP + b * TS + lane : b * TP + t0 + lane; P.gb = ((const f32x2*)(A->ws + WS_GB))[(size_t)urow * 4 + h]; }
}
DI void prep_stage1(KA A, int item, int next_item, int prev_item, int wait_item_idx, int bslot, float* ats, S1Pre& P, LAS unsigned char* ldsb, unsigned ep, int pmode = 0) {
    const int tid = threadIdx.x, lane = tid & 63, wave = __builtin_amdgcn_readfirstlane(tid >> 6), r = lane & 31, hh = lane >> 5;
#ifdef PROBE_PLAIN
    const bool plain_ = ep == 2u;
#define ST16(p, ...) do { if (plain_) *(u32x4*)(p) = (__VA_ARGS__); else st16_sc1((p), (__VA_ARGS__)); } while (0)
#define ST16F(p, ...) do { if (plain_) *(f32x4*)(p) = (__VA_ARGS__); else st16_sc1f((p), (__VA_ARGS__)); } while (0)
#else
#define ST16(p, ...) st16_sc1((p), (__VA_ARGS__))
#define ST16F(p, ...) st16_sc1f((p), (__VA_ARGS__))
#endif
    int b, h, t0, L; bool sample; item_decode(item, b, h, sample, t0, L);
    LAS float* Qs = (LAS float*)ldsb; LAS float* Ks = Qs + 64 * PITCH; LAS float* Vs = Ks + 64 * PITCH; LAS float* gcs = Vs + 64 * PITCH; LAS float* betas = gcs + 64;
    unsigned char* slot = slot_ptr(A, item);
    if (!(pmode & 8)) {
        const int cv = lane < 48 ? lane : 47, grp = cv >> 4, col0 = (cv & 15) * 8, r0 = wave * 8, cidx = grp * 512 + h * 128 + col0;
        float x[11][8];
#pragma unroll
        for (int q = 0; q < 11; ++q) { x[q][0] = bflo(P.xr[q].x); x[q][1] = bfhi(P.xr[q].x); x[q][2] = bflo(P.xr[q].y); x[q][3] = bfhi(P.xr[q].y);
                                       x[q][4] = bflo(P.xr[q].z); x[q][5] = bfhi(P.xr[q].z); x[q][6] = bflo(P.xr[q].w); x[q][7] = bfhi(P.xr[q].w); }
        if (sample && wave == 0) {
#pragma unroll
            for (int q = 0; q < 3; ++q) { const float* sp = A->state_conv + ((size_t)b * 3 + q) * CONVD + cidx; const f32x4 s0 = *(const f32x4*)sp, s1 = *(const f32x4*)(sp + 4);
                x[q][0] = s0[0]; x[q][1] = s0[1]; x[q][2] = s0[2]; x[q][3] = s0[3]; x[q][4] = s1[0]; x[q][5] = s1[1]; x[q][6] = s1[2]; x[q][7] = s1[3]; }
        }
        float w[4][8];
#pragma unroll
        for (int i = 0; i < 4; ++i) { w[i][0] = P.w[i][0][0]; w[i][1] = P.w[i][0][1]; w[i][2] = P.w[i][0][2]; w[i][3] = P.w[i][0][3]; w[i][4] = P.w[i][1][0]; w[i][5] = P.w[i][1][1]; w[i][6] = P.w[i][1][2]; w[i][7] = P.w[i][1][3]; }
        LAS float* dst = Qs + grp * 64 * PITCH + col0;
        const float nsc = grp == 0 ? 0.08838834764831845f : 1.0f;
#pragma unroll
        for (int q = 3; q < 11; ++q) {
            const int rr = r0 + q - 3;
            float v[8]; float ss = 0.f;
#pragma unroll
            for (int e = 0; e < 8; ++e) {
                const float y = __builtin_fmaf(w[3][e], x[q][e], __builtin_fmaf(w[2][e], x[q - 1][e], __builtin_fmaf(w[1][e], x[q - 2][e], w[0][e] * x[q - 3][e])));
                const float sv = siluf_(y); v[e] = sv; ss = __builtin_fmaf(sv, sv, ss); }
            ss += __builtin_bit_cast(float, __builtin_amdgcn_update_dpp(0, __builtin_bit_cast(int, ss), 0xB1, 0xF, 0xF, true));
            ss += __builtin_bit_cast(float, __builtin_amdgcn_update_dpp(0, __builtin_bit_cast(int, ss), 0x4E, 0xF, 0xF, true));
            ss += __builtin_bit_cast(float, __builtin_amdgcn_update_dpp(0, __builtin_bit_cast(int, ss), 0x141, 0xF, 0xF, true));
            ss += __builtin_bit_cast(float, __builtin_amdgcn_update_dpp(0, __builtin_bit_cast(int, ss), 0x140, 0xF, 0xF, true));
            float sc = grp == 2 ? 1.0f : rsqrtf(ss + EPS) * nsc;
            sc = rr < L ? sc : 0.f;
            if (lane < 48) { *(LAS f32x4*)(dst + rr * PITCH) = (f32x4){v[0] * sc, v[1] * sc, v[2] * sc, v[3] * sc}; *(LAS f32x4*)(dst + rr * PITCH + 4) = (f32x4){v[4] * sc, v[5] * sc, v[6] * sc, v[7] * sc}; }
        }
    }
    if (wave == 7) {
        float gc = P.gb[0];
#pragma unroll
        for (int o = 1; o < 64; o <<= 1) { const float t = __shfl_up(gc, o); if (lane >= o) gc += t; }
        gcs[lane] = gc; betas[lane] = P.gb[1];
        if (lane == 63) ((LAS float*)(ldsb + LDS_GCL))[bslot] = __expf(gc);
    }
    asm volatile("s_waitcnt vmcnt(0)" ::: "memory");
    if (next_item < N_ITEMS) stage1_issue(A, next_item, P);
    if (wait_item_idx >= 0 && wave == 0) (void)wait_item(item_granule(A, wait_item_idx), ep);
    LDS_BARRIER();
    if (prev_item >= 0 && tid == 0) __hip_atomic_store(item_flag1(A, prev_item), ((unsigned long long)ep << 32) | (unsigned long long)__float_as_uint(((const LAS float*)(ldsb + LDS_GCL))[bslot ^ 1]), __ATOMIC_RELAXED, __HIP_MEMORY_SCOPE_AGENT);
    if (wave < 6 && !(pmode & 4)) {
        const bool isqk = wave >= 3; const int tsel = isqk ? wave - 3 : wave, ib = tsel == 0 ? 0 : 1, jb = tsel == 2 ? 1 : 0;
        const LAS float* Asrc = isqk ? Qs : Ks;
        f32x16 acc;
#pragma unroll
        for (int e = 0; e < 16; ++e) acc[e] = 0.f;
#pragma unroll
        for (int s = 0; s < 8; ++s) acc = MFMA32(frag_nat(Asrc, 32 * ib + r, 16 * s + 8 * hh), frag_nat(Ks, 32 * jb + r, 16 * s + 8 * hh), acc);
        const int j = 32 * jb + r; const float gcj = gcs[j];
        float* Aout = ats + (ib + jb) * 1024; bf16* QKD = (bf16*)(slot + SL_QKD);
        if (!isqk) {
#pragma unroll
            for (int g4 = 0; g4 < 4; ++g4) { f32x4 v;
#pragma unroll
                for (int e = 0; e < 4; ++e) { const int i = 32 * ib + 8 * g4 + 4 * hh + e; v[e] = i > j ? betas[i] * __expf(fminf(gcs[i] - gcj, 0.f)) * acc[4 * g4 + e] : 0.f; }
                ST16F(Aout + r * 32 + 8 * g4 + 4 * hh, v); }
        } else {
            LAS float* patch = (LAS float*)(ldsb + 106496) + (wave - 3) * (32 * 36);
#pragma unroll
            for (int reg = 0; reg < 16; ++reg) { const int il = crow16(reg, hh), i = 32 * ib + il; const float dec = __expf(fminf(gcs[i] - gcj, 0.f));
                patch[il * 36 + r] = i >= j ? dec * acc[reg] : 0.f; }
            LDS_WAIT(); asm volatile("" ::: "memory");
#pragma unroll
            for (int ks2 = 0; ks2 < 2; ++ks2) { const int k0 = 16 * ks2 + 4 * hh;
                const f32x4 lo = *(const LAS f32x4*)(patch + r * 36 + k0), hi = *(const LAS f32x4*)(patch + r * 36 + k0 + 8);
                ST16((unsigned char*)QKD + ((ib * 4 + 2 * jb + ks2) * 64 + lane) * 16, pack8f(lo, hi)); }
        }
    }
    const float gcl = gcs[63];
#pragma unroll 1
    for (int job = (pmode & 4) ? 56 : wave; job < 56; job += 8) {
        if (job < 32) {
            const bool isq = job >= 16; const int jj = job & 15, rb = jj >> 3, ks = jj & 7, row = 32 * rb + r, k0 = 16 * ks + 4 * hh;
            const LAS float* src = isq ? Qs : Ks; const float sc = isq ? __expf(gcs[row]) : betas[row] * __expf(gcs[row]);
            const f32x4 lo = *(const LAS f32x4*)(src + row * PITCH + k0) * sc, hi = *(const LAS f32x4*)(src + row * PITCH + k0 + 8) * sc;
            ST16(slot + (isq ? SL_QE : SL_BEK) + ((rb * 8 + ks) * 64 + lane) * 16, pack8f(lo, hi));
        } else if (job < 48) {
            const int jj = job - 32, rb = jj >> 2, ks = jj & 3, dk = 32 * rb + r;
            f32x4 lo, hi;
#pragma unroll
            for (int e = 0; e < 4; ++e) { const int j0 = 16 * ks + 4 * hh + e, j1 = j0 + 8;
                lo[e] = Ks[j0 * PITCH + dk] * __expf(gcl - gcs[j0]); hi[e] = Ks[j1 * PITCH + dk] * __expf(gcl - gcs[j1]); }
            ST16(slot + SL_KWT + ((rb * 4 + ks) * 64 + lane) * 16, pack8f(lo, hi));
        } else {
            const int q = job - 48, w = q >> 1, ib = q & 1, dv = 32 * w + r;
            float v[16];
#pragma unroll
            for (int reg = 0; reg < 16; ++reg) { const int i = 32 * ib + crow16(reg, hh); v[reg] = betas[i] * Vs[i * PITCH + dv]; }
            u32x4* dst = (u32x4*)(slot + SL_BV + ((w * 2 + ib) * 64 + lane) * 32);
            ST16(dst, (u32x4){cvtpk(v[0], v[1]), cvtpk(v[2], v[3]), cvtpk(v[4], v[5]), cvtpk(v[6], v[7])});
            ST16(dst + 1, (u32x4){cvtpk(v[8], v[9]), cvtpk(v[10], v[11]), cvtpk(v[12], v[13]), cvtpk(v[14], v[15])});
        }
    }
    LDS_BARRIER();
}
DI void prep_stage2(KA A, int item, float gcl, const float* ats, LAS float* M, unsigned ep) {
    int lane = threadIdx.x & 63; asm volatile("" : "+v"(lane));
    const int r = lane & 31, hh = lane >> 5, base = 32 * hh;
    unsigned char* slot = slot_ptr(A, item);
    const f32x4* Ain = (const f32x4*)ats;
#pragma unroll
    for (int tt = 0; tt < 3; ++tt) { const int jb = tt >> 1, ib = (tt + 1) >> 1;
#pragma unroll
        for (int q = 0; q < 4; ++q) { const int idx = q * 64 + lane, jj = idx >> 3, i4 = idx & 7;
            *(LAS f32x4*)(M + (32 * jb + jj) * 64 + 32 * ib + 4 * i4) = Ain[tt * 256 + idx]; } }
    LDS_WAIT(); asm volatile("" ::: "memory");
#pragma unroll 1
    for (int rb = 0; rb < 2; ++rb) {
        float acc[16];
#pragma unroll
        for (int i = 0; i < 16; ++i) acc[i] = r == 16 * rb + i ? 1.f : 0.f;
        if (rb == 1) {
#pragma unroll 4
            for (int j = 0; j < 16; ++j) {
                float tj = M[(base + j) * 64 + base + r]; tj = r <= j ? tj : 0.f;
                const LAS f32x4* ar = (const LAS f32x4*)(M + (base + j) * 64 + base + 16);
                const f32x4 a0 = ar[0], a1 = ar[1], a2 = ar[2], a3 = ar[3];
#pragma unroll
                for (int e = 0; e < 4; ++e) { acc[e] -= a0[e] * tj; acc[4 + e] -= a1[e] * tj; acc[8 + e] -= a2[e] * tj; acc[12 + e] -= a3[e] * tj; }
            }
        }
#pragma unroll
        for (int j = 0; j < 16; ++j) {
            const float tj = acc[j]; const int row = base + 16 * rb + j;
            const LAS f32x4* ar = (const LAS f32x4*)(M + row * 64 + base + 16 * rb);
            float a[16];
#pragma unroll
            for (int q = j >> 2; q < 4; ++q) { const f32x4 v = ar[q]; a[4 * q] = v[0]; a[4 * q + 1] = v[1]; a[4 * q + 2] = v[2]; a[4 * q + 3] = v[3]; }
            if (r <= 16 * rb + j) M[row * 64 + base + r] = tj;
#pragma unroll
            for (int i = j + 1; i < 16; ++i) acc[i] -= a[i] * tj;
        }
        asm volatile("" ::: "memory");
    }
    LDS_WAIT(); asm volatile("" ::: "memory");
    f32x16 X;
#pragma unroll
    for (int e = 0; e < 16; ++e) X[e] = 0.f;
#pragma unroll
    for (int s2 = 0; s2 < 16; ++s2) { const int k = 2 * s2 + hh; const float a = M[k * 64 + 32 + r]; float bb = M[k * 64 + r]; bb = r <= k ? bb : 0.f;
        X = __builtin_amdgcn_mfma_f32_32x32x2f32(a, bb, X, 0, 0, 0); }
#pragma unroll
    for (int reg = 0; reg < 16; ++reg) M[crow16(reg, hh) * 64 + 32 + r] = X[reg];
    LDS_WAIT(); asm volatile("" ::: "memory");
    f32x16 Y;
#pragma unroll
    for (int e = 0; e < 16; ++e) Y[e] = 0.f;
#pragma unroll
    for (int s2 = 0; s2 < 16; ++s2) { const int k = 2 * s2 + hh; float a = M[(32 + r) * 64 + 32 + k]; a = k <= r ? a : 0.f; const float bb = M[k * 64 + 32 + r];
        Y = __builtin_amdgcn_mfma_f32_32x32x2f32(a, bb, Y, 0, 0, 0); }
#pragma unroll
    for (int reg = 0; reg < 16; ++reg) M[(32 + crow16(reg, hh)) * 64 + r] = -Y[reg];
    LDS_WAIT(); asm volatile("" ::: "memory");
#pragma unroll
    for (int f = 0; f < 8; ++f) { const int rb = f >> 2, ks = f & 3, row = 32 * rb + r, k0 = 16 * ks + 4 * hh;
        f32x4 lo = *(const LAS f32x4*)(M + row * 64 + k0), hi = *(const LAS f32x4*)(M + row * 64 + k0 + 8);
#pragma unroll
        for (int e = 0; e < 4; ++e) { lo[e] = k0 + e <= row ? lo[e] : 0.f; hi[e] = k0 + 8 + e <= row ? hi[e] : 0.f; }
        st16_sc1(slot + SL_T + ((rb * 4 + ks) * 64 + lane) * 16, pack8f(lo, hi)); }
    LDS_WAIT();
    asm volatile("s_waitcnt vmcnt(0)" ::: "memory");
    if (lane == 0) __hip_atomic_store(item_granule(A, item), ((unsigned long long)ep << 32) | (unsigned long long)__float_as_uint(gcl), __ATOMIC_RELAXED, __HIP_MEMORY_SCOPE_AGENT);
}
DI void scan_seq(KA A, int seq, int w, int lane, unsigned ep) {
    const int r = lane & 31, hh = lane >> 5, dv = 32 * w + r;
    const bool sample = seq >= N_PROMPT_SEQ; const int sidx = sample ? seq - N_PROMPT_SEQ : seq, b = sidx >> 2, h = sidx & 3, nch = sample ? 1 : CHUNKS_P;
    f32x16 S[4];
    if (sample) {
        const float* S0 = A->state_delta + ((size_t)(b * 4 + h) * 128) * 128 + dv;
#pragma unroll
        for (int kb = 0; kb < 4; ++kb)
#pragma unroll
            for (int reg = 0; reg < 16; ++reg) S[kb][reg] = S0[(size_t)(32 * kb + crow16(reg, hh)) * 128];
    } else {
#pragma unroll
        for (int kb = 0; kb < 4; ++kb)
#pragma unroll
            for (int reg = 0; reg < 16; ++reg) S[kb][reg] = 0.f;
    }
    bf16* OBR = (bf16*)((unsigned char*)A->out + DO_OB);
#pragma unroll 1
    for (int c = 0; c < nch; ++c) {
        const int item = sample ? N_ITEMS_P + sidx : seq * CHUNKS_P + c;
        const unsigned char* slot = slot_ptr(A, item);
        const float gcl = wait_item(item_granule(A, item), ep);
        __builtin_amdgcn_fence(__ATOMIC_ACQUIRE, "agent");
        const bf16x8* bek = (const bf16x8*)(slot + SL_BEK) + lane; const bf16x8* tp = (const bf16x8*)(slot + SL_T) + lane;
        const bf16x8* qe = (const bf16x8*)(slot + SL_QE) + lane; const bf16x8* qkd = (const bf16x8*)(slot + SL_QKD) + lane; const bf16x8* kwt = (const bf16x8*)(slot + SL_KWT) + lane;
        bf16x8 sf[8];
#pragma unroll
        for (int kb = 0; kb < 4; ++kb) { sf[2 * kb] = pack_step<0>(S[kb]); sf[2 * kb + 1] = pack_step<1>(S[kb]); }
        f32x16 x0, x1;
#pragma unroll
        for (int e = 0; e < 16; ++e) { x0[e] = 0.f; x1[e] = 0.f; }
#pragma unroll
        for (int ks = 0; ks < 8; ++ks) { x0 = MFMA32(bek[ks * 64], sf[ks], x0); x1 = MFMA32(bek[(8 + ks) * 64], sf[ks], x1); }
        {
            const u32x4* bv = (const u32x4*)(slot + SL_BV) + ((w * 2) * 64 + lane) * 2;
            const u32x4 a0 = bv[0], a1 = bv[1], c0 = bv[128], c1 = bv[129];
            x0[0] = bflo(a0.x) - x0[0]; x0[1] = bfhi(a0.x) - x0[1]; x0[2] = bflo(a0.y) - x0[2]; x0[3] = bfhi(a0.y) - x0[3];
            x0[4] = bflo(a0.z) - x0[4]; x0[5] = bfhi(a0.z) - x0[5]; x0[6] = bflo(a0.w) - x0[6]; x0[7] = bfhi(a0.w) - x0[7];
            x0[8] = bflo(a1.x) - x0[8]; x0[9] = bfhi(a1.x) - x0[9]; x0[10] = bflo(a1.y) - x0[10]; x0[11] = bfhi(a1.y) - x0[11];
            x0[12] = bflo(a1.z) - x0[12]; x0[13] = bfhi(a1.z) - x0[13]; x0[14] = bflo(a1.w) - x0[14]; x0[15] = bfhi(a1.w) - x0[15];
            x1[0] = bflo(c0.x) - x1[0]; x1[1] = bfhi(c0.x) - x1[1]; x1[2] = bflo(c0.y) - x1[2]; x1[3] = bfhi(c0.y) - x1[3];
            x1[4] = bflo(c0.z) - x1[4]; x1[5] = bfhi(c0.z) - x1[5]; x1[6] = bflo(c0.w) - x1[6]; x1[7] = bfhi(c0.w) - x1[7];
            x1[8] = bflo(c1.x) - x1[8]; x1[9] = bfhi(c1.x) - x1[9]; x1[10] = bflo(c1.y) - x1[10]; x1[11] = bfhi(c1.y) - x1[11];
            x1[12] = bflo(c1.z) - x1[12]; x1[13] = bfhi(c1.z) - x1[13]; x1[14] = bflo(c1.w) - x1[14]; x1[15] = bfhi(c1.w) - x1[15];
        }
        bf16x8 rf[4] = {pack_step<0>(x0), pack_step<1>(x0), pack_step<0>(x1), pack_step<1>(x1)};
        f32x16 u0, u1;
#pragma unroll
        for (int e = 0; e < 16; ++e) { u0[e] = 0.f; u1[e] = 0.f; }
        u0 = MFMA32(tp[0 * 64], rf[0], u0); u0 = MFMA32(tp[1 * 64], rf[1], u0);
#pragma unroll
        for (int ks = 0; ks < 4; ++ks) u1 = MFMA32(tp[(4 + ks) * 64], rf[ks], u1);
        bf16x8 uf[4] = {pack_step<0>(u0), pack_step<1>(u0), pack_step<0>(u1), pack_step<1>(u1)};
        if (sample || c > 0) {
#pragma unroll
            for (int e = 0; e < 16; ++e) { x0[e] = 0.f; x1[e] = 0.f; }
#pragma unroll
            for (int ks = 0; ks < 8; ++ks) { x0 = MFMA32(qe[ks * 64], sf[ks], x0); x1 = MFMA32(qe[(8 + ks) * 64], sf[ks], x1); }
            x0 = MFMA32(qkd[0 * 64], uf[0], x0); x0 = MFMA32(qkd[1 * 64], uf[1], x0);
#pragma unroll
            for (int ks = 0; ks < 4; ++ks) x1 = MFMA32(qkd[(4 + ks) * 64], uf[ks], x1);
            const int crow0 = sample ? NBATCH * SEQ + b * TS : b * SEQ + 64 * (c - 1), L = sample ? TS : 64;
#pragma unroll
            for (int reg = 0; reg < 16; ++reg) { const int i0 = crow16(reg, hh), i1 = 32 + i0;
                if (i0 < L) OBR[(size_t)(crow0 + i0) * 512 + h * 128 + dv] = f2bf(x0[reg]);
                if (i1 < L) OBR[(size_t)(crow0 + i1) * 512 + h * 128 + dv] = f2bf(x1[reg]); }
        }
#pragma unroll
        for (int kb = 0; kb < 4; ++kb) {
            S[kb] = S[kb] * gcl;
#pragma unroll
            for (int ks = 0; ks < 4; ++ks) S[kb] = MFMA32(kwt[(kb * 4 + ks) * 64], uf[ks], S[kb]);
        }
    }
    float* So = A->out + (sample ? O_DS : O_DP) + ((size_t)(b * 4 + h) * 128) * 128 + dv;
#pragma unroll
    for (int kb = 0; kb < 4; ++kb)
#pragma unroll
        for (int reg = 0; reg < 16; ++reg) So[(size_t)(32 * kb + crow16(reg, hh)) * 128] = S[kb][reg];
}

constexpr int HALF_BYTES = 40960;
DI void scan_prompt_wg(KA A, int seq, LAS unsigned char* lds, unsigned ep) {
    const int tid = threadIdx.x, lane = tid & 63, wave = __builtin_amdgcn_readfirstlane(tid >> 6);
    const int b = seq >> 2, h = seq & 3;
    constexpr int N = 2 * CHUNKS_P;
    if (wave >= 4) {
        const int loff = (wave - 4) * 10240 + lane * 16;
        u32x4 r0[10], r1[10];
        LAS u32x4* d0 = (LAS u32x4*)(lds + loff); LAS u32x4* d1 = (LAS u32x4*)(lds + HALF_BYTES + loff);
        LAS float* gclw = (LAS float*)(lds + 2 * HALF_BYTES);
#define SCAN_LOAD(n, R) do { const int item_ = seq * CHUNKS_P + ((n) >> 1); \
            if (((n) & 1) == 0) { const float g_ = wait_item(item_granule(A, item_), ep); if (wave == 4 && lane == 0) gclw[((n) >> 1) & 3] = g_; } \
            const __amdgpu_buffer_rsrc_t rs_ = __builtin_amdgcn_make_buffer_rsrc((void*)slot_ptr(A, item_), 0, (int)PREP_SLOT, 0x00020000); \
            _Pragma("unroll") for (int q = 0; q < 10; ++q) R[q] = __builtin_bit_cast(u32x4, __builtin_amdgcn_raw_buffer_load_b128(rs_, ((n) & 1) * HALF_BYTES + loff + q * 1024, 0, 16)); } while (0)
        SCAN_LOAD(0, r0);
#pragma unroll
        for (int q = 0; q < 10; ++q) d0[q * 64] = r0[q];
        SCAN_LOAD(1, r1);
        LDS_BARRIER();
#pragma unroll 1
        for (int n = 0; n < N; n += 2) {
            if (n + 2 < N) SCAN_LOAD(n + 2, r0);
#pragma unroll
            for (int q = 0; q < 10; ++q) d1[q * 64] = r1[q];
            LDS_BARRIER();
            if (n + 3 < N) SCAN_LOAD(n + 3, r1);
            if (n + 2 < N) {
#pragma unroll
                for (int q = 0; q < 10; ++q) d0[q * 64] = r0[q]; }
            LDS_BARRIER();
        }
#undef SCAN_LOAD
    } else {
        const int w = wave, r = lane & 31, hh = lane >> 5, dv = 32 * w + r;
        f32x16 S[4];
#pragma unroll
        for (int kb = 0; kb < 4; ++kb)
#pragma unroll
            for (int reg = 0; reg < 16; ++reg) S[kb][reg] = 0.f;
        bf16* OBR = (bf16*)((unsigned char*)A->out + DO_OB);
        const LAS float* gclw = (const LAS float*)(lds + 2 * HALF_BYTES);
        const LAS bf16x8* bek = (const LAS bf16x8*)(lds + SL_BEK) + lane; const LAS bf16x8* tp = (const LAS bf16x8*)(lds + SL_T) + lane;
        const LAS u32x4* bv = (const LAS u32x4*)(lds + SL_BV) + ((w * 2) * 64 + lane) * 2;
        const LAS bf16x8* qkd = (const LAS bf16x8*)(lds + HALF_BYTES + (SL_QKD - HALF_BYTES)) + lane; const LAS bf16x8* qe = (const LAS bf16x8*)(lds + HALF_BYTES + (SL_QE - HALF_BYTES)) + lane;
        const LAS bf16x8* kwt = (const LAS bf16x8*)(lds + HALF_BYTES + (SL_KWT - HALF_BYTES)) + lane;
        LDS_BARRIER();
#pragma unroll 1
        for (int c = 0; c < CHUNKS_P; ++c) {
            bf16x8 sf[8];
#pragma unroll
            for (int kb = 0; kb < 4; ++kb) { sf[2 * kb] = pack_step<0>(S[kb]); sf[2 * kb + 1] = pack_step<1>(S[kb]); }
            f32x16 x0, x1;
#pragma unroll
            for (int e = 0; e < 16; ++e) { x0[e] = 0.f; x1[e] = 0.f; }
#pragma unroll
            for (int ks = 0; ks < 8; ++ks) { x0 = MFMA32(bek[ks * 64], sf[ks], x0); x1 = MFMA32(bek[(8 + ks) * 64], sf[ks], x1); }
            {
                const u32x4 a0 = bv[0], a1 = bv[1], c0 = bv[128], c1 = bv[129];
                x0[0] = bflo(a0.x) - x0[0]; x0[1] = bfhi(a0.x) - x0[1]; x0[2] = bflo(a0.y) - x0[2]; x0[3] = bfhi(a0.y) - x0[3];
                x0[4] = bflo(a0.z) - x0[4]; x0[5] = bfhi(a0.z) - x0[5]; x0[6] = bflo(a0.w) - x0[6]; x0[7] = bfhi(a0.w) - x0[7];
                x0[8] = bflo(a1.x) - x0[8]; x0[9] = bfhi(a1.x) - x0[9]; x0[10] = bflo(a1.y) - x0[10]; x0[11] = bfhi(a1.y) - x0[11];
                x0[12] = bflo(a1.z) - x0[12]; x0[13] = bfhi(a1.z) - x0[13]; x0[14] = bflo(a1.w) - x0[14]; x0[15] = bfhi(a1.w) - x0[15];
                x1[0] = bflo(c0.x) - x1[0]; x1[1] = bfhi(c0.x) - x1[1]; x1[2] = bflo(c0.y) - x1[2]; x1[3] = bfhi(c0.y) - x1[3];
                x1[4] = bflo(c0.z) - x1[4]; x1[5] = bfhi(c0.z) - x1[5]; x1[6] = bflo(c0.w) - x1[6]; x1[7] = bfhi(c0.w) - x1[7];
                x1[8] = bflo(c1.x) - x1[8]; x1[9] = bfhi(c1.x) - x1[9]; x1[10] = bflo(c1.y) - x1[10]; x1[11] = bfhi(c1.y) - x1[11];
                x1[12] = bflo(c1.z) - x1[12]; x1[13] = bfhi(c1.z) - x1[13]; x1[14] = bflo(c1.w) - x1[14]; x1[15] = bfhi(c1.w) - x1[15];
            }
            bf16x8 rf[4] = {pack_step<0>(x0), pack_step<1>(x0), pack_step<0>(x1), pack_step<1>(x1)};
            f32x16 u0, u1;
#pragma unroll
            for (int e = 0; e < 16; ++e) { u0[e] = 0.f; u1[e] = 0.f; }
            u0 = MFMA32(tp[0 * 64], rf[0], u0); u0 = MFMA32(tp[1 * 64], rf[1], u0);
#pragma unroll
            for (int ks = 0; ks < 4; ++ks) u1 = MFMA32(tp[(4 + ks) * 64], rf[ks], u1);
            bf16x8 uf[4] = {pack_step<0>(u0), pack_step<1>(u0), pack_step<0>(u1), pack_step<1>(u1)};
            LDS_BARRIER();
            if (c > 0) {
#pragma unroll
                for (int e = 0; e < 16; ++e) { x0[e] = 0.f; x1[e] = 0.f; }
#pragma unroll
                for (int ks = 0; ks < 8; ++ks) { x0 = MFMA32(qe[ks * 64], sf[ks], x0); x1 = MFMA32(qe[(8 + ks) * 64], sf[ks], x1); }
                x0 = MFMA32(qkd[0 * 64], uf[0], x0); x0 = MFMA32(qkd[1 * 64], uf[1], x0);
#pragma unroll
                for (int ks = 0; ks < 4; ++ks) x1 = MFMA32(qkd[(4 + ks) * 64], uf[ks], x1);
                bf16* orow = OBR + (size_t)(b * SEQ + 64 * (c - 1)) * 512 + h * 128 + dv;
#pragma unroll
                for (int reg = 0; reg < 16; ++reg) { const int i0 = crow16(reg, hh); orow[(size_t)i0 * 512] = f2bf(x0[reg]); orow[(size_t)(32 + i0) * 512] = f2bf(x1[reg]); }
            }
            const float gcl = gclw[c & 3];
#pragma unroll
            for (int kb = 0; kb < 4; ++kb) {
                S[kb] = S[kb] * gcl;
#pragma unroll
                for (int ks = 0; ks < 4; ++ks) S[kb] = MFMA32(kwt[(kb * 4 + ks) * 64], uf[ks], S[kb]);
            }
            LDS_BARRIER();
        }
        float* So = A->out + O_DP + ((size_t)(b * 4 + h) * 128) * 128 + dv;
#pragma unroll
        for (int kb = 0; kb < 4; ++kb)
#pragma unroll
            for (int reg = 0; reg < 16; ++reg) So[(size_t)(32 * kb + crow16(reg, hh)) * 128] = S[kb][reg];
    }
}

constexpr int KPITCH = 72, VPITCH = 264;
DI void attn_unit(KA A, int unit, LAS unsigned char* ldsb) {
    const int tid = threadIdx.x, lane = tid & 63, wave = __builtin_amdgcn_readfirstlane(tid >> 6), r = lane & 31, hh = lane >> 5;
    const int b = unit >> 6, kh = (unit >> 5) & 1, jb = unit & 31, T0 = NMETA + 128 * jb;
    LAS bf16* Ksm = (LAS bf16*)ldsb; LAS bf16* VTs = Ksm + 256 * KPITCH;
    const bf16* KVg = (const bf16*)(A->ws + WS_KV); const bf16* QAg = (const bf16*)(A->ws + WS_QA);
#pragma unroll
    for (int e4 = 0; e4 < 4; ++e4) {
        const int id = tid + 512 * e4, key = id >> 3, cch = id & 7, tk = T0 - 128 + key;
        u32x4 kq = (u32x4){0u, 0u, 0u, 0u}, vq = kq;
        if (tk >= 0) { const bf16* src = KVg + (size_t)(b * TP + tk) * 256 + kh * 64 + 8 * cch; kq = *(const u32x4*)src; vq = *(const u32x4*)(src + 128); }
        *(LAS u32x4*)(Ksm + key * KPITCH + 8 * cch) = kq;
        const int kkk = key & 15, pos = (key & ~15) + 8 * ((kkk >> 2) & 1) + (((kkk >> 3) << 2) | (kkk & 3));
        LAS bf16* vd = VTs + (8 * cch) * VPITCH + pos;
        vd[0 * VPITCH] = (bf16)(vq.x & 0xffffu); vd[1 * VPITCH] = (bf16)(vq.x >> 16); vd[2 * VPITCH] = (bf16)(vq.y & 0xffffu); vd[3 * VPITCH] = (bf16)(vq.y >> 16);
        vd[4 * VPITCH] = (bf16)(vq.z & 0xffffu); vd[5 * VPITCH] = (bf16)(vq.z >> 16); vd[6 * VPITCH] = (bf16)(vq.w & 0xffffu); vd[7 * VPITCH] = (bf16)(vq.w >> 16);
    }
    LDS_BARRIER();
    const int g = wave >> 1, qh = wave & 1, head = 4 * kh + g;
    const float sink2 = A->sinks[head] * 1.4426950408889634f;
    const int kmin = jb == 0 ? 128 - NMETA : 0;
#pragma unroll 1
    for (int q2 = 0; q2 < 2; ++q2) {
        const int qb = 2 * qh + q2, iq = 32 * qb + r;
        const bf16* qrow = QAg + (size_t)(b * TP + T0 + iq) * 512 + head * 64 + 8 * hh;
        bf16x8 qf[4];
#pragma unroll
        for (int s = 0; s < 4; ++s) qf[s] = *(const bf16x8*)(qrow + 16 * s);
        f32x16 st[5];
        float m = sink2;
#pragma unroll
        for (int kt5 = 0; kt5 < 5; ++kt5) {
            const int kt = qb + kt5;
            f32x16 acc;
#pragma unroll
            for (int e = 0; e < 16; ++e) acc[e] = 0.f;
#pragma unroll
            for (int s = 0; s < 4; ++s) acc = MFMA32(*(const LAS bf16x8*)(Ksm + (32 * kt + r) * KPITCH + 16 * s + 8 * hh), qf[s], acc);
#pragma unroll
            for (int reg = 0; reg < 16; ++reg) { const int kk = 32 * kt + crow16(reg, hh); const bool ok = kk >= iq && kk <= iq + 128 && kk >= kmin;
                acc[reg] = ok ? acc[reg] : -INFINITY; m = fmaxf(m, acc[reg]); }
            st[kt5] = acc;
        }
        m = fmaxf(m, __shfl_xor(m, 32));
        float l = 0.f;
#pragma unroll
        for (int kt5 = 0; kt5 < 5; ++kt5)
#pragma unroll
            for (int reg = 0; reg < 16; ++reg) { const float p = exp2f(st[kt5][reg] - m); st[kt5][reg] = p; l += p; }
        l += __shfl_xor(l, 32); l += exp2f(sink2 - m);
        f32x16 o0, o1;
#pragma unroll
        for (int e = 0; e < 16; ++e) { o0[e] = 0.f; o1[e] = 0.f; }
#pragma unroll
        for (int kt5 = 0; kt5 < 5; ++kt5) {
            const int kt = qb + kt5;
            const bf16x8 p0 = pack_step<0>(st[kt5]), p1 = pack_step<1>(st[kt5]);
            const LAS bf16* vb = VTs + r * VPITCH + 32 * kt + 8 * hh;
            o0 = MFMA32(*(const LAS bf16x8*)(vb), p0, o0); o0 = MFMA32(*(const LAS bf16x8*)(vb + 16), p1, o0);
            o1 = MFMA32(*(const LAS bf16x8*)(vb + 32 * VPITCH), p0, o1); o1 = MFMA32(*(const LAS bf16x8*)(vb + 32 * VPITCH + 16), p1, o1);
        }
        const float rl = 1.0f / l;
        bf16* orow = (bf16*)((unsigned char*)A->out + DO_OA) + (size_t)(b * SEQ + 128 * jb + iq) * 512 + head * 64 + 4 * hh;
#pragma unroll
        for (int g4 = 0; g4 < 4; ++g4) {
            *(u32x2*)(orow + 8 * g4) = (u32x2){cvtpk(o0[4 * g4] * rl, o0[4 * g4 + 1] * rl), cvtpk(o0[4 * g4 + 2] * rl, o0[4 * g4 + 3] * rl)};
            *(u32x2*)(orow + 32 + 8 * g4) = (u32x2){cvtpk(o1[4 * g4] * rl, o1[4 * g4 + 1] * rl), cvtpk(o1[4 * g4 + 2] * rl, o1[4 * g4 + 3] * rl)};
        }
    }
    LDS_BARRIER();
}
DI void sample_attn(KA A, int b, int head, LAS float* wl, int lane) {
    const int kh = head >> 2;
    LAS float* qn = wl; LAS float* ps = wl + 256;
    const bf16* QAg = (const bf16*)(A->ws + WS_QA); const bf16* KVg = (const bf16*)(A->ws + WS_KV);
#pragma unroll
    for (int i = 0; i < 4; ++i) qn[i * 64 + lane] = bf2f(QAg[(size_t)(MP + b * TS + i) * 512 + head * 64 + pos_of_d(lane)]);
    LDS_WAIT(); asm volatile("" ::: "memory");
    const float sink2 = A->sinks[head] * 1.4426950408889634f;
#pragma unroll 1
    for (int kq = 0; kq < 3; ++kq) {
        const int kj = lane + 64 * kq;
        float sc0 = 0.f, sc1 = 0.f, sc2 = 0.f, sc3 = 0.f;
        if (kj < 128) {
            const f32x4* kr = (const f32x4*)(A->cache_k + ((size_t)(b * 128 + kj) * 2 + kh) * 64);
#pragma unroll 4
            for (int d4 = 0; d4 < 16; ++d4) { const f32x4 kv = kr[d4];
                const f32x4 q0 = *(const LAS f32x4*)(qn + 4 * d4), q1 = *(const LAS f32x4*)(qn + 64 + 4 * d4), q2 = *(const LAS f32x4*)(qn + 128 + 4 * d4), q3 = *(const LAS f32x4*)(qn + 192 + 4 * d4);
                sc0 += (kv[0] * q0[0] + kv[1] * q0[1]) + (kv[2] * q0[2] + kv[3] * q0[3]); sc1 += (kv[0] * q1[0] + kv[1] * q1[1]) + (kv[2] * q1[2] + kv[3] * q1[3]);
                sc2 += (kv[0] * q2[0] + kv[1] * q2[1]) + (kv[2] * q2[2] + kv[3] * q2[3]); sc3 += (kv[0] * q3[0] + kv[1] * q3[1]) + (kv[2] * q3[2] + kv[3] * q3[3]); }
        } else if (kj < 132) {
            const bf16* kr = KVg + (size_t)(MP + b * TS + (kj - 128)) * 256 + kh * 64;
#pragma unroll 4
            for (int p = 0; p < 64; ++p) { const float kv = bf2f(kr[p]); const int d = d_of_pos(p);
                sc0 += kv * qn[d]; sc1 += kv * qn[64 + d]; sc2 += kv * qn[128 + d]; sc3 += kv * qn[192 + d]; }
        }
        if (kj < 132) {
            ps[0 * 132 + kj] = (kj >= 0 && kj <= 128) ? sc0 : -INFINITY; ps[1 * 132 + kj] = (kj >= 1 && kj <= 129) ? sc1 : -INFINITY;
            ps[2 * 132 + kj] = (kj >= 2 && kj <= 130) ? sc2 : -INFINITY; ps[3 * 132 + kj] = (kj >= 3 && kj <= 131) ? sc3 : -INFINITY; }
    }
    LDS_WAIT(); asm volatile("" ::: "memory");
    float linv[4];
#pragma unroll
    for (int i = 0; i < 4; ++i) {
        const float s0 = ps[i * 132 + lane], s1 = ps[i * 132 + 64 + lane], s2 = lane < 4 ? ps[i * 132 + 128 + lane] : -INFINITY;
        const float m = wave_max(fmaxf(fmaxf(s0, s1), fmaxf(s2, sink2)));
        const float p0 = exp2f(s0 - m), p1 = exp2f(s1 - m), p2 = exp2f(s2 - m);
        ps[i * 132 + lane] = p0; ps[i * 132 + 64 + lane] = p1; if (lane < 4) ps[i * 132 + 128 + lane] = p2;
        linv[i] = 1.0f / (wave_sum(p0 + p1 + p2) + exp2f(sink2 - m));
    }
    LDS_WAIT(); asm volatile("" ::: "memory");
    float o[4] = {0.f, 0.f, 0.f, 0.f};
#pragma unroll 4
    for (int kj = 0; kj < 128; ++kj) { const float v = A->cache_v[((size_t)(b * 128 + kj) * 2 + kh) * 64 + lane];
#pragma unroll
        for (int i = 0; i < 4; ++i) o[i] += ps[i * 132 + kj] * v; }
#pragma unroll
    for (int kj = 128; kj < 132; ++kj) { const float v = bf2f(KVg[(size_t)(MP + b * TS + (kj - 128)) * 256 + 128 + kh * 64 + lane]);
#pragma unroll
        for (int i = 0; i < 4; ++i) o[i] += ps[i * 132 + kj] * v; }
    bf16* OAg = (bf16*)((unsigned char*)A->out + DO_OA);
#pragma unroll
    for (int i = 0; i < 4; ++i) OAg[(size_t)(NBATCH * SEQ + b * TS + i) * 512 + head * 64 + lane] = f2bf(o[i] * linv[i]);
    LDS_WAIT(); asm volatile("" ::: "memory");
}
constexpr int NINV_WG = 24;
DI void p23_mixers(KA A, LAS unsigned char* lds, const XcdBarrier& dbg_bar, unsigned ep, int pmode = 0) {
    const int tid = threadIdx.x, lane = tid & 63, wave = __builtin_amdgcn_readfirstlane(tid >> 6), G = gridDim.x, wg = blockIdx.x;
    const int NSCAN = N_PROMPT_SEQ, NP = G - NSCAN - NINV_WG;
    if (wg < NSCAN) { if (!(pmode & 2)) scan_prompt_wg(A, wg, lds, ep); return; }
    if (wg < NSCAN + NINV_WG) {
        const int wv = (wg - NSCAN) * NWAVES + wave, NWV = NINV_WG * NWAVES;
#pragma unroll 1
        for (int m = wv; m < N_ITEMS; m += NWV) {
            const int item = order_item(m), p = m % NP, k = m / NP;
            const float gcl = wait_item(item_flag1(A, item), ep);
            __builtin_amdgcn_fence(__ATOMIC_ACQUIRE, "agent");
            const float* ats = (const float*)((const unsigned char*)A->out + DO_ATS + ((size_t)p * 8 + (k & 7)) * ATS_ITEM);
            if (pmode & 16) { if (lane == 0) __hip_atomic_store(item_granule(A, item), ((unsigned long long)ep << 32), __ATOMIC_RELAXED, __HIP_MEMORY_SCOPE_AGENT); }
            else prep_stage2(A, item, gcl, ats, (LAS float*)(lds + wave * 16384), ep);
        }
        return;
    }
    const int p = wg - NSCAN - NINV_WG;
    {
        const int ntot = p < N_ITEMS ? (N_ITEMS - 1 - p) / NP + 1 : 0;
        S1Pre P;
        if (ntot > 0) stage1_issue(A, order_item(p), P);
        int prev = -1;
#pragma unroll 1
        for (int k = 0; k < ntot; ++k) {
            const int m = p + NP * k, item = order_item(m), nxt = k + 1 < ntot ? order_item(m + NP) : N_ITEMS;
            float* ats = (float*)((unsigned char*)A->out + DO_ATS + ((size_t)p * 8 + (k & 7)) * ATS_ITEM);
            prep_stage1(A, item, nxt, prev, k >= 8 ? order_item(m - 8 * NP) : -1, k & 1, ats, P, lds, ep, pmode);
            prev = item;
        }
        asm volatile("s_waitcnt vmcnt(0)" ::: "memory"); __syncthreads();
        if (prev >= 0 && tid == 0) __hip_atomic_store(item_flag1(A, prev), ((unsigned long long)ep << 32) | (unsigned long long)__float_as_uint(((const LAS float*)(lds + LDS_GCL))[(ntot - 1) & 1]), __ATOMIC_RELAXED, __HIP_MEMORY_SCOPE_AGENT);
    }
    if (pmode & 1) return;
    for (int u = p; u < NBATCH * NKV * 32; u += NP) attn_unit(A, u, lds);
    const int worker = p * NWAVES + wave, NW = NP * NWAVES;
    LAS float* wl = (LAS float*)(lds + 98304 + wave * 4096);
    for (int it = worker; it < SBATCH * NHB * 4 + SBATCH * NHA; it += NW) {
        if (it < SBATCH * NHB * 4) scan_seq(A, N_PROMPT_SEQ + (it >> 2), it & 3, lane, ep);
        else { const int q = it - SBATCH * NHB * 4; sample_attn(A, q >> 3, q & 7, wl, lane); }
    }
}

DI void p3b_gated_norm(KA A) {
    const int tid = threadIdx.x, lane = tid & 63, wave = tid >> 6, gw = blockIdx.x * NWAVES + wave, NGW = gridDim.x * NWAVES;
    const int head = lane >> 4, dv0 = 8 * (lane & 15);
    const f32x4 w0 = *(const f32x4*)(A->gdn_norm + dv0), w1 = *(const f32x4*)(A->gdn_norm + dv0 + 4);
    bf16* OBg = (bf16*)((unsigned char*)A->out + DO_OB); const bf16* Zg = (const bf16*)(A->ws + WS_Z);
    for (int crow = gw; crow < MC; crow += NGW) {
        const u32x4 ow = *(const u32x4*)(OBg + (size_t)crow * 512 + head * 128 + dv0);
        const f32x4 a = {bflo(ow.x), bfhi(ow.x), bflo(ow.y), bfhi(ow.y)}, c = {bflo(ow.z), bfhi(ow.z), bflo(ow.w), bfhi(ow.w)};
        float ss = (a[0] * a[0] + a[1] * a[1]) + (a[2] * a[2] + a[3] * a[3]) + (c[0] * c[0] + c[1] * c[1]) + (c[2] * c[2] + c[3] * c[3]);
        ss += __shfl_xor(ss, 1); ss += __shfl_xor(ss, 2); ss += __shfl_xor(ss, 4); ss += __shfl_xor(ss, 8);
        const float rstd = rsqrtf(ss * (1.0f / 128.0f) + EPS);
        const u32x4 zw = *(const u32x4*)(Zg + (size_t)pg8::crow_to_urow(crow) * 512 + head * 128 + dv0);
        f32x4 y0, y1;
        y0[0] = a[0] * rstd * w0[0] * siluf_(bflo(zw.x)); y0[1] = a[1] * rstd * w0[1] * siluf_(bfhi(zw.x)); y0[2] = a[2] * rstd * w0[2] * siluf_(bflo(zw.y)); y0[3] = a[3] * rstd * w0[3] * siluf_(bfhi(zw.y));
        y1[0] = c[0] * rstd * w1[0] * siluf_(bflo(zw.z)); y1[1] = c[1] * rstd * w1[1] * siluf_(bfhi(zw.z)); y1[2] = c[2] * rstd * w1[2] * siluf_(bflo(zw.w)); y1[3] = c[3] * rstd * w1[3] * siluf_(bfhi(zw.w));
        *(u32x4*)(OBg + (size_t)crow * 512 + head * 128 + dv0) = pack8f(y0, y1);
    }
}
DI void p8_final_norm(KA A) {
    const int tid = threadIdx.x, lane = tid & 63, wave = tid >> 6, gw = blockIdx.x * NWAVES + wave, NGW = gridDim.x * NWAVES;
    f32x4 nf[4];
#pragma unroll
    for (int j = 0; j < 4; ++j) nf[j] = ((const f32x4*)A->norm_final)[lane + 64 * j];
    for (int crow = gw; crow < MC; crow += NGW) {
        f32x4* row = (f32x4*)(A->out + (size_t)crow * D);
        f32x4 v[4]; float ss = 0.f;
#pragma unroll
        for (int j = 0; j < 4; ++j) { v[j] = row[lane + 64 * j]; ss += (v[j][0] * v[j][0] + v[j][1] * v[j][1]) + (v[j][2] * v[j][2] + v[j][3] * v[j][3]); }
        const float rstd = rsqrtf(wave_sum(ss) * (1.0f / D) + EPS);
#pragma unroll
        for (int j = 0; j < 4; ++j) row[lane + 64 * j] = v[j] * rstd * nf[j];
    }
}
__global__ void __launch_bounds__(NTHREADS, 2) hybrid_fwd(Args Aval) {
    extern __shared__ __attribute__((aligned(16))) unsigned char lds_raw[];
    LAS unsigned char* lds = (LAS unsigned char*)lds_raw;
    const int tid = threadIdx.x;
    int lo, hi; { KA A0 = kargs(); lo = A0->ph_lo; hi = A0->ph_hi; }
#if MK_N_LAUNCHES == 1
#if MK_BARRIER == 1
    volatile LAS unsigned* MISC = (volatile LAS unsigned*)(lds + LDS_MISC);
    if (tid < 64) MISC[tid] = 0u;
    __syncthreads();
    XcdBarrier bar; { KA A0 = kargs(); bar = xcd_barrier_post((unsigned*)(A0->ws + WS_CTL) + 4096, MISC + 8); }
#define GRID_BAR() xcd_barrier(bar)
#else
    cg::grid_group grid = cg::this_grid();
#define GRID_BAR() grid.sync()
#endif
#else
#define GRID_BAR() do {} while (0)
#endif
#ifndef PH_MASK
#define PH_MASK 0x1ff
#endif
#define IN(k) (((PH_MASK >> (k)) & 1) && lo <= (k) && (k) < hi)
#ifndef PROBE_REP
#define PROBE_REP -1
#endif
#define NREP(k) (PROBE_REP == (k) ? 2 : 1)
#define SEAM(k) do { if (IN(k) && IN((k) + 1)) GRID_BAR(); } while (0)
    const int G = gridDim.x, wgid = blockIdx.x;
#if PROBE_REP == 0
    if (IN(0)) { KA A = kargs(); p0_prologue(A, lds); __syncthreads(); }
#endif
    if (IN(0)) { KA A = kargs(); p0_prologue(A, lds); } SEAM(0);
    if (IN(1)) for (int rep = 0; rep < NREP(1); ++rep) { KA A = kargs(); unsigned char* ws = A->ws;
        pg8::Gemm g{(const bf16*)(ws + WS_XN), (const bf16*)(ws + WS_WIN), MUP, NIN, D}; pg8::StaticOrder S; S.init(MUP, NIN, G, wgid);
        pg8::EpiInProj E{(bf16*)(ws + WS_QA), (bf16*)(ws + WS_KV), (bf16*)(ws + WS_QKVB), (bf16*)(ws + WS_Z), (bf16*)(ws + WS_G),
                         (const float*)(ws + WS_ROPE), (const float*)(ws + WS_ROPE) + (TP + TS) * 32, A->out};
        pg8::gemm_phase<pg8::EpiInProj, pg8::StaticOrder, true, true>(lds, g, S, E);
    } SEAM(1);
#ifndef PROBE_MODE
#define PROBE_MODE 0
#endif
#if PROBE_REP == 2
    if (IN(2)) { KA A = kargs(); p23_mixers(A, lds, bar, 1u); GRID_BAR(); }
    if (IN(2)) { KA A = kargs(); p23_mixers(A, lds, bar, 2u, PROBE_MODE); } SEAM(2);
#else
    if (IN(2)) { KA A = kargs(); p23_mixers(A, lds, bar, 1u); } SEAM(2);
#endif
    if (IN(3)) for (int rep = 0; rep < NREP(3); ++rep) { KA A = kargs(); p3b_gated_norm(A); } SEAM(3);
    if (IN(4)) for (int rep = 0; rep < NREP(4); ++rep) { KA A = kargs(); unsigned char* ws = A->ws;
        { pg8::Gemm g{(const bf16*)((unsigned char*)A->out + DO_OA), (const bf16*)(ws + WS_WOA), MC, D, 512}; pg8::StaticOrder S; S.init(MC, D, G, wgid);
          pg8::EpiMerge<false> E{(bf16*)(ws + WS_MB), (const bf16*)(ws + WS_G), 0};
          pg8::gemm_phase<pg8::EpiMerge<false>, pg8::StaticOrder, true, true>(lds, g, S, E); }
        asm volatile("s_waitcnt vmcnt(0)" ::: "memory"); __syncthreads();
        { pg8::Gemm g{(const bf16*)((unsigned char*)A->out + DO_OB), (const bf16*)(ws + WS_WOB), MC, D, 512}; pg8::StaticOrder S; S.init(MC, D, G, wgid);
          pg8::EpiMerge<true> E{(bf16*)(ws + WS_MB), (const bf16*)(ws + WS_G), 1024};
          pg8::gemm_phase<pg8::EpiMerge<true>, pg8::StaticOrder, true, true>(lds, g, S, E); }
    } SEAM(4);
    if (IN(5)) { KA A = kargs(); unsigned char* ws = A->ws;
        pg8::Gemm g{(const bf16*)(ws + WS_MB), (const bf16*)(ws + WS_WOUT), MC, D, D}; pg8::StaticOrder S; S.init(MC, D, G, wgid);
        pg8::EpiWout<true> E{A->x_prompt, A->x_sample, (bf16*)(ws + WS_HB1), (float*)(ws + WS_CTL + CTL_SS1)};
        pg8::gemm_phase<pg8::EpiWout<true>, pg8::StaticOrder, true, true>(lds, g, S, E);
    } SEAM(5);
    if (IN(6)) for (int rep = 0; rep < NREP(6); ++rep) { KA A = kargs(); unsigned char* ws = A->ws;
        pg8::Gemm g{(const bf16*)(ws + WS_HB1), (const bf16*)(ws + WS_WGU), MC, 2 * DFF, D}; pg8::StaticOrder S; S.init(MC, 2 * DFF, G, wgid);
        pg8::EpiGateUp E{(bf16*)(ws + WS_ACT), (const float*)(ws + WS_CTL + CTL_SS1)};
        pg8::gemm_phase<pg8::EpiGateUp, pg8::StaticOrder, true, true>(lds, g, S, E);
    } SEAM(6);
    if (IN(7)) for (int rep = 0; rep < NREP(7); ++rep) { KA A = kargs(); unsigned char* ws = A->ws;
        pg8::Gemm g{(const bf16*)(ws + WS_ACT), (const bf16*)(ws + WS_WD), MC, D, DFF}; pg8::StaticOrder S; S.init(MC, D, G, wgid);
        pg8::EpiDown<false> E{(const bf16*)(ws + WS_HB1), A->out};
        pg8::gemm_phase<pg8::EpiDown<false>, pg8::StaticOrder, true, true>(lds, g, S, E);
    } SEAM(7);
    if (IN(8)) { KA A = kargs(); p8_final_norm(A); }
#undef IN
#undef SEAM
}

extern "C" void kernel_launch(void* const* d_in, const int* in_sizes, int n_in, void* d_out, int out_size, void* d_ws, size_t ws_size, hipStream_t stream) {
    static int grid = 0;
    if (grid == 0) {
        if (n_in != 22 || out_size != (int)O_END || ws_size < WS_END) { fprintf(stderr, "kernel_launch: unexpected problem (n_in %d, out %d, ws %zu)\n", n_in, out_size, ws_size); grid = -1; return; }
        int dev = 0, cus = 0, per_cu = 0;
        if (hipGetDevice(&dev) != hipSuccess || hipDeviceGetAttribute(&cus, hipDeviceAttributeMultiprocessorCount, dev) != hipSuccess) { grid = -1; return; }
        if (hipFuncSetAttribute((const void*)hybrid_fwd, hipFuncAttributeMaxDynamicSharedMemorySize, LDS_BYTES) != hipSuccess) { fprintf(stderr, "kernel_launch: hipFuncSetAttribute failed\n"); grid = -1; return; }
        if (hipOccupancyMaxActiveBlocksPerMultiprocessor(&per_cu, (const void*)hybrid_fwd, NTHREADS, LDS_BYTES) != hipSuccess || per_cu < 1) { fprintf(stderr, "kernel_launch: occupancy query says %d\n", per_cu); per_cu = 1; }
        (void)hipGetLastError();
        grid = cus;
        if (grid > 256) grid = 256;
    }
    if (grid < 0) return;
    (void)hipMemsetAsync((char*)d_ws + WS_CTL, 0, CTL_BYTES, stream);
    Args a{};
    const float** ap = (const float**)&a;
    for (int i = 0; i < 22; ++i) ap[i] = (const float*)d_in[i];
    a.out = (float*)d_out; a.ws = (unsigned char*)d_ws;
#if MK_N_LAUNCHES == 1
    a.ph_lo = 0; a.ph_hi = N_PHASES;
#if MK_BARRIER == 1
    hipLaunchKernelGGL(hybrid_fwd, dim3(grid), dim3(NTHREADS), LDS_BYTES, stream, a);
#else
    void* args[] = {&a};
    hipError_t e = hipLaunchCooperativeKernel((const void*)hybrid_fwd, dim3(grid), dim3(NTHREADS), args, LDS_BYTES, stream);
    if (e != hipSuccess) fprintf(stderr, "cooperative launch failed: %s (grid %d)\n", hipGetErrorString(e), grid);
#endif
#else
    for (int p = 0; p < N_PHASES; ++p) { a.ph_lo = p; a.ph_hi = p + 1; hipLaunchKernelGGL(hybrid_fwd, dim3(grid), dim3(NTHREADS), LDS_BYTES, stream, a); }
#endif
}
```

```cpp
#include <hip/hip_runtime.h>
#include <hip/hip_cooperative_groups.h>
#include <cstdio>
#include <cstdint>
namespace cg = cooperative_groups;

#ifndef MK_N_LAUNCHES
#define MK_N_LAUNCHES 1
#endif
#ifndef MK_BARRIER
#define MK_BARRIER 1
#endif

constexpr int D = 1024, NBATCH = 8, SEQ = 4096, NMETA = 16, TP = SEQ + NMETA, MP = NBATCH * TP;
constexpr int SBATCH = 128, TS = 4, MS = SBATCH * TS, MU = MP + MS, MUP = 33536, MC = NBATCH * SEQ + MS;
constexpr int PAST = 16384;
constexpr int HD = 64, NHA = 8, NKV = 2;
constexpr int NHB = 4, CONVD = 1536;
constexpr int DFF = 2816, NIN_SRC = 4872, NIN = 4864;
constexpr float EPS = 1e-6f;
constexpr float QSCALE = 0.125f * 1.4426950408889634f;

constexpr size_t MiB = 1u << 20, KiB = 1024;
constexpr size_t WS_CTL = 0, CTL_BYTES = 1 * MiB;
constexpr size_t WS_WIN = 1 * MiB;
constexpr size_t WS_WOA = 11 * MiB, WS_WOB = 12 * MiB;
constexpr size_t WS_WOUT = 13 * MiB;
constexpr size_t WS_WGU = 15 * MiB;
constexpr size_t WS_WD = 26 * MiB;
constexpr size_t WS_ROPE = 32 * MiB;
constexpr size_t WS_GB = 34 * MiB;
constexpr size_t WS_SC = 36 * MiB;
constexpr size_t WS_SS1 = 37 * MiB, WS_SS2 = 37 * MiB + 512 * KiB;
constexpr size_t WS_SCR = 38 * MiB, SCR_BYTES = 2 * MiB;
constexpr size_t CTL_SPL = 49152;
constexpr size_t WS_QA = 41 * MiB;
constexpr size_t WS_KV = WS_QA + (size_t)MUP * 512 * 2;
constexpr size_t WS_QKVB = WS_KV + (size_t)MUP * 256 * 2;
constexpr size_t WS_Z = WS_QKVB + (size_t)MUP * 1536 * 2;
constexpr size_t WS_G = WS_Z + (size_t)MUP * 512 * 2;
constexpr size_t WS_GEND = WS_G + (size_t)MUP * 2048 * 2;
constexpr size_t WS_B = 353 * MiB, WS_END = 512 * MiB;
static_assert(WS_GEND <= WS_B, "ws map");
constexpr size_t WS_XN = WS_B;
constexpr size_t PREP_SLOT = 80 * KiB;
constexpr int PREP_N1 = (int)((WS_END - WS_B) / PREP_SLOT);
constexpr size_t DO_OA = 44 * MiB;
constexpr size_t DO_OB = DO_OA + (size_t)MC * 512 * 2;
constexpr size_t DO_ATS = DO_OB + (size_t)MC * 512 * 2;
constexpr size_t ATS_ITEM = 3 * 32 * 32 * 4;
static_assert(DO_ATS + 212 * 8 * ATS_ITEM <= (size_t)MC * 1024 * 4, "d_out scratch map");
constexpr size_t WS_MB = WS_B;
constexpr size_t WS_HB1 = WS_B + 66 * MiB;
static_assert(WS_HB1 + (size_t)MC * 1024 * 2 <= WS_END, "ws map");
constexpr size_t WS_ACT = WS_QA;
static_assert(WS_ACT + (size_t)MC * DFF * 2 <= WS_G, "ws map");
constexpr int SL_BEK = 0, SL_BV = 16 * 1024, SL_T = 32 * 1024, SL_QKD = 40 * 1024, SL_QE = 48 * 1024, SL_KWT = 64 * 1024;
constexpr int N_PROMPT_SEQ = NBATCH * NHB, CHUNKS_P = 65, N_ITEMS_P = N_PROMPT_SEQ * CHUNKS_P, N_ITEMS = N_ITEMS_P + SBATCH * NHB;
static_assert((size_t)(N_ITEMS - PREP_N1) * PREP_SLOT <= DO_OA, "prep slots");

constexpr size_t O_YP = 0, O_YS = (size_t)NBATCH * SEQ * D, O_KP = O_YS + (size_t)MS * D, O_VP = O_KP + 8 * 128 * 2 * 64, O_DP = O_VP + 8 * 128 * 2 * 64,
                 O_CP = O_DP + 8 * 4 * 128 * 128, O_KS = O_CP + 8 * 3 * 1536, O_VS = O_KS + (size_t)128 * 128 * 2 * 64, O_DS = O_VS + (size_t)128 * 128 * 2 * 64,
                 O_CS = O_DS + (size_t)128 * 4 * 128 * 128, O_END = O_CS + (size_t)128 * 3 * 1536;
static_assert(O_END == 48074752, "d_out size");

#define DI __device__ __forceinline__
#define GAS __attribute__((address_space(1)))
#define LAS __attribute__((address_space(3)))
typedef unsigned short bf16;
typedef short bf16x8 __attribute__((ext_vector_type(8)));
typedef float f32x4 __attribute__((ext_vector_type(4)));
typedef float f32x2 __attribute__((ext_vector_type(2)));
typedef float f32x16 __attribute__((ext_vector_type(16)));
typedef unsigned u32x4 __attribute__((ext_vector_type(4)));
typedef unsigned u32x2 __attribute__((ext_vector_type(2)));
typedef __bf16 bf16x2_t __attribute__((ext_vector_type(2)));

DI unsigned cvtpk(float lo, float hi) { f32x2 v = {lo, hi}; bf16x2_t b = __builtin_convertvector(v, bf16x2_t); return __builtin_bit_cast(unsigned, b); }
DI bf16 f2bf(float f) { return (bf16)(cvtpk(f, 0.f) & 0xffffu); }
DI float bf2f(unsigned short h) { return __uint_as_float((unsigned)h << 16); }
DI float bflo(unsigned w) { return __uint_as_float(w << 16); }
DI float bfhi(unsigned w) { return __uint_as_float(w & 0xffff0000u); }
DI u32x4 pack8f(f32x4 a, f32x4 b) { u32x4 w; w.x = cvtpk(a[0], a[1]); w.y = cvtpk(a[2], a[3]); w.z = cvtpk(b[0], b[1]); w.w = cvtpk(b[2], b[3]); return w; }
DI float frcp_(float x) { return __builtin_amdgcn_rcpf(x); }
DI float sigmoidf_(float x) { return frcp_(1.0f + __builtin_amdgcn_exp2f(x * -1.4426950408889634f)); }
DI float siluf_(float x) { return x * sigmoidf_(x); }
DI void st16_sc1(void* p, u32x4 v) { asm volatile("global_store_dwordx4 %0, %1, off sc1\n\ts_nop 1" :: "v"(p), "v"(v) : "memory"); }
DI void st16_sc1f(void* p, f32x4 v) { asm volatile("global_store_dwordx4 %0, %1, off sc1\n\ts_nop 1" :: "v"(p), "v"(v) : "memory"); }
DI void st2_sc1(void* p, unsigned v) { asm volatile("global_store_short %0, %1, off sc1\n\ts_nop 1" :: "v"(p), "v"(v) : "memory"); }
constexpr size_t CTL_GRAN = 65536, CTL_CNT = 245760, CTL_SS1 = 458752;
static_assert(CTL_CNT + 5 * 130 * 256 <= CTL_SS1 && CTL_SS1 + 33280 * 4 <= 1048576 && CTL_GRAN + 2592 * 64 <= CTL_CNT, "control region map");
constexpr int CNT_STRIDE = 130 * 64;
DI int pos_of_d(int d) { const int dd = d & 31; return 8 * (dd >> 2) + (dd & 3) + ((d >> 5) << 2); }
DI int d_of_pos(int p) { const int j = p & 7; return 4 * (p >> 3) + (j & 3) + ((j >> 2) << 5); }
namespace pg8 {
#define PG8_LAS __attribute__((address_space(3)))
typedef unsigned short bf16_t;
typedef short bf16x8 __attribute__((ext_vector_type(8)));
typedef float f32x4 __attribute__((ext_vector_type(4)));
typedef unsigned u32x4 __attribute__((ext_vector_type(4)));
constexpr int BM = 256, BK = 64, HALF = 128, HTB = HALF * BK * 2  , STAGE_BYTES = 8 * HTB, NXCD = 8, WGM = 8;

__host__ __device__ __forceinline__ int lds_byte(int r, int c) { const int st = (r >> 4) * 2 + (c >> 5), rr = r & 15, cc = c & 31, ob = rr * 64 + cc * 2; return st * 1024 + (ob ^ (((ob >> 9) & 1) << 5)); }
__host__ __device__ __forceinline__ void stage_rc(int b, int& R, int& C) { const int st = b / 1024, sb = b % 1024, swz = sb ^ (((sb >> 9) & 1) << 5); R = (st >> 1) * 16 + swz / 64; C = (st & 1) * 32 + (swz % 64) / 2; }
__host__ __device__ __forceinline__ int perm32(int rho) { const int n = rho >> 4, i = rho & 15; return 8 * (i >> 2) + 4 * n + (i & 3); }

struct Unit { int pm, pn; };
struct Gemm { const bf16_t* A; const bf16_t* Bt; int M, N, K; int ldk; };

struct StaticOrder {
    static constexpr bool A_SC1 = false;
    int nM, nN, nwg, G, c, lim;
    __host__ __device__ void init(int M, int N, int G_, int c_) { nM = M / BM; nN = N / BM; nwg = nM * nN; G = G_; c = c_; lim = nwg; }
    __host__ __device__ bool next(int i, Unit& u) const {
        const long L = (long)i * G + c; if (L >= lim) return false;
        int wgid = (int)L; { const int q = nwg / NXCD, r = nwg % NXCD, xcd = wgid % NXCD, off = wgid / NXCD; wgid = (xcd < r ? xcd * (q + 1) : r * (q + 1) + (xcd - r) * q) + off; }
        const int nig = WGM * nN, gid = wgid / nig, fm = gid * WGM, gsz = (nM - fm) < WGM ? (nM - fm) : WGM;
        u.pm = fm + ((wgid % nig) % gsz); u.pn = (wgid % nig) / gsz; return true;
    }
    __device__ __forceinline__ void a_ready(const Unit&) const {}
    __device__ __forceinline__ void done(const Unit&) const {}
};
struct FlagOrder : StaticOrder {
    static constexpr bool A_SC1 = true;
    const unsigned* ready; unsigned need; unsigned* pub; unsigned* gpub;
    __device__ __forceinline__ void a_ready(const Unit& u) const {
        if (ready) {
            if (threadIdx.x < 64) { unsigned spins = 0;
                while ((unsigned)__builtin_amdgcn_readfirstlane(__hip_atomic_load(ready + 64 * u.pm, __ATOMIC_RELAXED, __HIP_MEMORY_SCOPE_AGENT)) < need) { __builtin_amdgcn_s_sleep(2); if (++spins > (1u << 22)) break; } }
            asm volatile("" ::: "memory"); __builtin_amdgcn_s_barrier(); asm volatile("" ::: "memory");
        }
    }
    __device__ __forceinline__ void done(const Unit& u) const {
        if (pub) { asm volatile("s_waitcnt vmcnt(0)" ::: "memory");
            if ((threadIdx.x & 63) == 0) { __hip_atomic_fetch_add(pub + 64 * u.pm, 1u, __ATOMIC_RELAXED, __HIP_MEMORY_SCOPE_AGENT); if (gpub) __hip_atomic_fetch_add(gpub, 1u, __ATOMIC_RELAXED, __HIP_MEMORY_SCOPE_AGENT); } }
    }
};
struct SliceOrder : StaticOrder {
    int t;
    __host__ __device__ void init_slice(int M, int N, int G_, int first, int t_) { init(M, N, G_, 0); t = t_; c = first + t_; G = 0; }
    __host__ __device__ bool next(int i, Unit& u) const { return i == 0 ? StaticOrder::next(0, u) : false; }
};

__device__ __forceinline__ void urow_info(int urow, int& kind, int& b, int& t, int& ridx) {
    if (urow < MP) { b = urow / TP; t = urow - b * TP; kind = 0; ridx = t; }
    else if (urow < MU) { const int s = urow - MP; b = s >> 2; t = s & 3; kind = 1; ridx = TP + t; }
    else { kind = 2; b = 0; t = 0; ridx = 0; }
}
__device__ __forceinline__ int crow_to_urow(int crow) { return crow < NBATCH * SEQ ? crow + NMETA * ((crow >> 12) + 1) : MP + (crow - NBATCH * SEQ); }

struct EpiInProj {
    static constexpr bool PERM = true, AFTER_DRAIN = false;
    bf16_t *QA, *KV, *QKVB, *Z, *G; const float *COS, *SIN; float* out;
    __device__ __forceinline__ void operator()(const f32x4 (&acc)[2][2][4][2], const Unit& u, int wr, int wc, int fr, int fq) const {
        const int pn = u.pn;
#pragma unroll
        for (int ai = 0; ai < 2; ++ai)
#pragma unroll
            for (int m = 0; m < 4; ++m) {
                const int row = u.pm * BM + ai * HALF + wr * 64 + m * 16 + fr;
                int kind, b, t, ridx; urow_info(row, kind, b, t, ridx);
#pragma unroll
                for (int bj = 0; bj < 2; ++bj) {
                    const int cl = bj * HALF + wc * 32 + 8 * fq;
                    const f32x4 v0 = acc[ai][bj][m][0], v1 = acc[ai][bj][m][1];
                    if (pn < 2) {
                        const int c = pn * 256 + cl, d0 = ((c & 63) >> 3) * 4;
                        const f32x4 cs = *(const f32x4*)(COS + ridx * 32 + d0), sn = *(const f32x4*)(SIN + ridx * 32 + d0);
                        const f32x4 o1 = (v0 * cs - v1 * sn) * QSCALE, o2 = (v1 * cs + v0 * sn) * QSCALE;
                        *(u32x4*)(QA + (size_t)row * 512 + c) = pack8f(o1, o2);
                    } else if (pn == 2) {
                        if (bj == 0) {
                            const int kh = cl >> 6, d0 = ((cl & 63) >> 3) * 4;
                            const f32x4 cs = *(const f32x4*)(COS + ridx * 32 + d0), sn = *(const f32x4*)(SIN + ridx * 32 + d0);
                            const f32x4 o1 = v0 * cs - v1 * sn, o2 = v1 * cs + v0 * sn;
                            *(u32x4*)(KV + (size_t)row * 256 + cl) = pack8f(o1, o2);
                            float* dst = nullptr;
                            if (kind == 0 && t >= TP - 128) dst = out + O_KP + ((size_t)(b * 128 + (t - (TP - 128))) * 2 + kh) * 64;
                            else if (kind == 1) dst = out + O_KS + ((size_t)(b * 128 + 124 + t) * 2 + kh) * 64;
                            if (dst) { *(f32x4*)(dst + d0) = o1; *(f32x4*)(dst + 32 + d0) = o2; }
                        } else {
                            const int cv = cl - 128, kh = cv >> 6, dd = cv & 63;
                            *(u32x4*)(KV + (size_t)row * 256 + cl) = pack8f(v0, v1);
                            float* dst = nullptr;
                            if (kind == 0 && t >= TP - 128) dst = out + O_VP + ((size_t)(b * 128 + (t - (TP - 128))) * 2 + kh) * 64;
                            else if (kind == 1) dst = out + O_VS + ((size_t)(b * 128 + 124 + t) * 2 + kh) * 64;
                            if (dst) { *(f32x4*)(dst + dd) = v0; *(f32x4*)(dst + dd + 4) = v1; }
                        }
                    } else if (pn < 9) {
                        const int c = (pn - 3) * 256 + cl;
                        *(u32x4*)(QKVB + (size_t)row * 1536 + c) = pack8f(v0, v1);
                        float* dst = nullptr;
                        if (kind == 0 && t >= TP - 3) dst = out + O_CP + ((size_t)b * 3 + (t - (TP - 3))) * 1536;
                        else if (kind == 1 && t >= 1) dst = out + O_CS + ((size_t)b * 3 + (t - 1)) * 1536;
                        if (dst) { *(f32x4*)(dst + c) = v0; *(f32x4*)(dst + c + 4) = v1; }
                    } else if (pn < 11) {
                        const int c = (pn - 9) * 256 + cl;
                        *(u32x4*)(Z + (size_t)row * 512 + c) = pack8f(v0, v1);
                    } else {
                        const int c = (pn - 11) * 256 + cl;
                        f32x4 g0, g1;
#pragma unroll
                        for (int e = 0; e < 4; ++e) { g0[e] = sigmoidf_(v0[e]); g1[e] = sigmoidf_(v1[e]); }
                        *(u32x4*)(G + (size_t)row * 2048 + c) = pack8f(g0, g1);
                    }
                }
            }
    }
};

template <bool ACCUM> struct EpiMerge {
    static constexpr bool PERM = true, AFTER_DRAIN = false;
    bf16_t* MBp; const bf16_t* G; int gate_off;
    __device__ __forceinline__ void operator()(const f32x4 (&acc)[2][2][4][2], const Unit& u, int wr, int wc, int fr, int fq) const {
#pragma unroll
        for (int ai = 0; ai < 2; ++ai)
#pragma unroll
            for (int m = 0; m < 4; ++m) {
                const int crow = u.pm * BM + ai * HALF + wr * 64 + m * 16 + fr, urow = crow_to_urow(crow);
#pragma unroll
                for (int bj = 0; bj < 2; ++bj) {
                    const int c = u.pn * BM + bj * HALF + wc * 32 + 8 * fq;
                    const u32x4 gw = *(const u32x4*)(G + (size_t)urow * 2048 + gate_off + c);
                    f32x4 v0 = acc[ai][bj][m][0], v1 = acc[ai][bj][m][1];
                    v0[0] *= bflo(gw.x); v0[1] *= bfhi(gw.x); v0[2] *= bflo(gw.y); v0[3] *= bfhi(gw.y);
                    v1[0] *= bflo(gw.z); v1[1] *= bfhi(gw.z); v1[2] *= bflo(gw.w); v1[3] *= bfhi(gw.w);
                    bf16_t* p = MBp + (size_t)crow * 1024 + c;
                    if (ACCUM) { const u32x4 pw = *(const u32x4*)p;
                        v0[0] += bflo(pw.x); v0[1] += bfhi(pw.x); v0[2] += bflo(pw.y); v0[3] += bfhi(pw.y);
                        v1[0] += bflo(pw.z); v1[1] += bfhi(pw.z); v1[2] += bflo(pw.w); v1[3] += bfhi(pw.w); }
                    *(u32x4*)p = pack8f(v0, v1);
                }
            }
    }
};

template <bool ATOM = true> struct EpiWout {
    static constexpr bool PERM = true, AFTER_DRAIN = false;
    const float* xp; const float* xs; bf16_t* HB; float* SS;
    __device__ __forceinline__ void operator()(const f32x4 (&acc)[2][2][4][2], const Unit& u, int wr, int wc, int fr, int fq) const {
#pragma unroll
        for (int ai = 0; ai < 2; ++ai)
#pragma unroll
            for (int m = 0; m < 4; ++m) {
                const int crow = u.pm * BM + ai * HALF + wr * 64 + m * 16 + fr;
                const float* hs = crow < NBATCH * SEQ ? xp + (size_t)crow * D : xs + (size_t)(crow - NBATCH * SEQ) * D;
                float ss = 0.f;
#pragma unroll
                for (int bj = 0; bj < 2; ++bj) {
                    const int c = u.pn * BM + bj * HALF + wc * 32 + 8 * fq;
                    const f32x4 r0 = *(const f32x4*)(hs + c) + acc[ai][bj][m][0], r1 = *(const f32x4*)(hs + c + 4) + acc[ai][bj][m][1];
                    *(u32x4*)(HB + (size_t)crow * D + c) = pack8f(r0, r1);
                    ss += (r0[0] * r0[0] + r0[1] * r0[1]) + (r0[2] * r0[2] + r0[3] * r0[3]) + (r1[0] * r1[0] + r1[1] * r1[1]) + (r1[2] * r1[2] + r1[3] * r1[3]);
                }
                ss += __shfl_xor(ss, 16); ss += __shfl_xor(ss, 32);
                if (ATOM && fq == 0) atomicAdd(SS + crow, ss);
            }
    }
};

struct EpiGateUp {
    static constexpr bool PERM = true, AFTER_DRAIN = false;
    bf16_t* ACT; const float* SS;
    __device__ __forceinline__ void operator()(const f32x4 (&acc)[2][2][4][2], const Unit& u, int wr, int wc, int fr, int fq) const {
#pragma unroll
        for (int ai = 0; ai < 2; ++ai)
#pragma unroll
            for (int m = 0; m < 4; ++m) {
                const int crow = u.pm * BM + ai * HALF + wr * 64 + m * 16 + fr;
                const float rstd = rsqrtf(SS[crow] * (1.0f / D) + EPS);
                f32x4 a[2];
#pragma unroll
                for (int n = 0; n < 2; ++n)
#pragma unroll
                    for (int e = 0; e < 4; ++e) { const float g = acc[ai][0][m][n][e] * rstd, up = acc[ai][1][m][n][e] * rstd; a[n][e] = siluf_(g) * up; }
                *(u32x4*)(ACT + (size_t)crow * DFF + u.pn * HALF + wc * 32 + 8 * fq) = pack8f(a[0], a[1]);
            }
    }
};

template <bool DRY = false> struct EpiDown {
    static constexpr bool PERM = true, AFTER_DRAIN = false;
    const bf16_t* HB; float* H;
    __device__ __forceinline__ void operator()(const f32x4 (&acc)[2][2][4][2], const Unit& u, int wr, int wc, int fr, int fq) const {
#pragma unroll
        for (int ai = 0; ai < 2; ++ai)
#pragma unroll
            for (int m = 0; m < 4; ++m) {
                const int crow = u.pm * BM + ai * HALF + wr * 64 + m * 16 + fr;
#pragma unroll
                for (int bj = 0; bj < 2; ++bj) {
                    const size_t off = (size_t)crow * D + u.pn * BM + bj * HALF + wc * 32 + 8 * fq;
                    const u32x4 hw = *(const u32x4*)(HB + off);
                    f32x4 r0 = acc[ai][bj][m][0], r1 = acc[ai][bj][m][1];
                    r0[0] += bflo(hw.x); r0[1] += bfhi(hw.x); r0[2] += bflo(hw.y); r0[3] += bfhi(hw.y);
                    r1[0] += bflo(hw.z); r1[1] += bfhi(hw.z); r1[2] += bflo(hw.w); r1[3] += bfhi(hw.w);
                    *(f32x4*)(H + off) = r0; *(f32x4*)(H + off + 4) = r1;
                }
            }
    }
};

template <class Inner, bool GATED = false> struct EpiSplit {
    static constexpr bool PERM = Inner::PERM, AFTER_DRAIN = false;
    Inner inner; float* scr; unsigned* cnt; unsigned S; const bf16_t* G; int gate_off;
    __device__ __forceinline__ void operator()(const f32x4 (&acc_)[2][2][4][2], const Unit& u, int wr, int wc, int fr, int fq) const {
        f32x4 (&acc)[2][2][4][2] = const_cast<f32x4 (&)[2][2][4][2]>(acc_);
        const int lane = fr + 16 * fq, wave = wr * 4 + wc;
        float* p = scr + (size_t)wave * 8192 + lane;
#pragma unroll
        for (int ai = 0; ai < 2; ++ai)
#pragma unroll
            for (int m = 0; m < 4; ++m) {
                int urow = 0;
                if (GATED) urow = crow_to_urow(u.pm * BM + ai * HALF + wr * 64 + m * 16 + fr);
#pragma unroll
                for (int bj = 0; bj < 2; ++bj) {
                    f32x4 v0 = acc[ai][bj][m][0], v1 = acc[ai][bj][m][1];
                    if (GATED) { const u32x4 gw = *(const u32x4*)(G + (size_t)urow * 2048 + gate_off + u.pn * BM + bj * HALF + wc * 32 + 8 * fq);
                        v0[0] *= bflo(gw.x); v0[1] *= bfhi(gw.x); v0[2] *= bflo(gw.y); v0[3] *= bfhi(gw.y); v1[0] *= bflo(gw.z); v1[1] *= bfhi(gw.z); v1[2] *= bflo(gw.w); v1[3] *= bfhi(gw.w); }
                    float* q = p + (((ai * 2 + bj) * 4 + m) * 8) * 64;
                    asm volatile("" : "+v"(q));
#pragma unroll
                    for (int x = 0; x < 4; ++x) { unsafeAtomicAdd(q + x * 64, v0[x]); unsafeAtomicAdd(q + (4 + x) * 64, v1[x]); }
                }
            }
        asm volatile("s_waitcnt vmcnt(0)" ::: "memory");
        unsigned old = 0u;
        if (lane == 0) old = __hip_atomic_fetch_add(cnt + wave, 1u, __ATOMIC_RELAXED, __HIP_MEMORY_SCOPE_AGENT);
        old = (unsigned)__builtin_amdgcn_readfirstlane((int)old);
        if (old == S - 1u) {
#pragma unroll
            for (int ai = 0; ai < 2; ++ai)
#pragma unroll
                for (int bj = 0; bj < 2; ++bj)
#pragma unroll
                    for (int m = 0; m < 4; ++m) {
                        float* q = p + (((ai * 2 + bj) * 4 + m) * 8) * 64;
                        asm volatile("" : "+v"(q));
#pragma unroll
                        for (int n = 0; n < 2; ++n)
#pragma unroll
                            for (int x = 0; x < 4; ++x) acc[ai][bj][m][n][x] = __hip_atomic_exchange(q + (n * 4 + x) * 64, 0.0f, __ATOMIC_RELAXED, __HIP_MEMORY_SCOPE_AGENT);
                    }
            if (lane == 0) __hip_atomic_store(cnt + wave, 0u, __ATOMIC_RELAXED, __HIP_MEMORY_SCOPE_AGENT);
            inner(acc, u, wr, wc, fr, fq);
        }
    }
};
struct EpiStoreMB {
    static constexpr bool PERM = true, AFTER_DRAIN = false;
    bf16_t* MBp;
    __device__ __forceinline__ void operator()(const f32x4 (&acc)[2][2][4][2], const Unit& u, int wr, int wc, int fr, int fq) const {
#pragma unroll
        for (int ai = 0; ai < 2; ++ai)
#pragma unroll
            for (int m = 0; m < 4; ++m) {
                const int crow = u.pm * BM + ai * HALF + wr * 64 + m * 16 + fr;
#pragma unroll
                for (int bj = 0; bj < 2; ++bj) *(u32x4*)(MBp + (size_t)crow * 1024 + u.pn * BM + bj * HALF + wc * 32 + 8 * fq) = pack8f(acc[ai][bj][m][0], acc[ai][bj][m][1]);
            }
    }
};

template <class Epi, class Sched, bool ALIGN_EPI = false, bool SP2 = false>
__device__ __forceinline__ void gemm_phase(PG8_LAS unsigned char* lds, const Gemm g, const Sched& S, const Epi& E) {
    const int tid = threadIdx.x, wid = __builtin_amdgcn_readfirstlane(tid >> 6), lane = tid & 63, wr = wid >> 2, wc = wid & 3, fr = lane & 15, fq = lane >> 4;
    const int K = g.ldk ? g.ldk : g.K, nt = g.K / BK;
    unsigned voffA[2], voffB[2];
#pragma unroll
    for (int i = 0; i < 2; ++i) { int R, C; stage_rc(tid * 16 + i * 8192, R, C); const int Rb = Epi::PERM ? ((R & ~31) + perm32(R & 31)) : R;
        voffA[i] = (unsigned)(R * K + C) * 2u; voffB[i] = (unsigned)(Rb * K + C) * 2u; }
    const size_t kstep = (size_t)(BK * 2);
    const size_t hstep = (size_t)HALF * K * 2;
    const size_t tstep = 2 * hstep;
    const unsigned ldsw = (unsigned)wid * 1024u;
    const int aoff = lds_byte(wr * 64 + fr, fq * 8), boff = lds_byte(wc * 32 + fr, fq * 8);
#define PG8_SA(b, h) (((b) * 2 + (h)) * HTB)
#define PG8_SB(b, h) ((4 + (b) * 2 + (h)) * HTB)
#define PG8_STAGE(bufoff, gbase, voff) do { _Pragma("unroll") for (int _i = 0; _i < 2; ++_i) \
        __builtin_amdgcn_global_load_lds((const unsigned*)((const char*)(gbase) + (voff)[_i]), (PG8_LAS unsigned*)(lds + (bufoff) + ldsw + _i * 8192), 16, 0, 0); } while (0)
#define PG8_STAGE_A(bufoff, gbase, voff) do { _Pragma("unroll") for (int _i = 0; _i < 2; ++_i) { \
        if constexpr (Sched::A_SC1) __builtin_amdgcn_global_load_lds((const unsigned*)((const char*)(gbase) + (voff)[_i]), (PG8_LAS unsigned*)(lds + (bufoff) + ldsw + _i * 8192), 16, 0, 16); \
        else __builtin_amdgcn_global_load_lds((const unsigned*)((const char*)(gbase) + (voff)[_i]), (PG8_LAS unsigned*)(lds + (bufoff) + ldsw + _i * 8192), 16, 0, 0); } } while (0)
#define PG8_LDA(dst, b, h) do { _Pragma("unroll") for (int m = 0; m < 4; ++m) _Pragma("unroll") for (int k = 0; k < 2; ++k) dst[m][k] = *(const PG8_LAS bf16x8*)(lds + PG8_SA(b, h) + aoff + m * 2048 + k * 1024); } while (0)
#define PG8_LDB(dst, b, h) do { _Pragma("unroll") for (int n = 0; n < 2; ++n) _Pragma("unroll") for (int k = 0; k < 2; ++k) dst[n][k] = *(const PG8_LAS bf16x8*)(lds + PG8_SB(b, h) + boff + n * 2048 + k * 1024); } while (0)
#define PG8_MMA(ai, bj, At, Bt) do { __builtin_amdgcn_s_setprio(1); _Pragma("unroll") for (int m = 0; m < 4; ++m) _Pragma("unroll") for (int n = 0; n < 2; ++n) _Pragma("unroll") for (int k = 0; k < 2; ++k) \
        acc[ai][bj][m][n] = __builtin_amdgcn_mfma_f32_16x16x32_bf16(Bt[n][k], At[m][k], acc[ai][bj][m][n], 0, 0, 0); __builtin_amdgcn_s_setprio(0); } while (0)
#define PG8_WAIT_V(n) asm volatile("s_waitcnt vmcnt(" #n ")" ::: "memory")
#define PG8_WAIT_L(n) asm volatile("s_waitcnt lgkmcnt(" #n ")" ::: "memory")
#define PG8_BAR __builtin_amdgcn_s_barrier()
#define PG8_SCHED __builtin_amdgcn_sched_barrier(0)
    Unit cur, nxt; int ui = 0;
    if (!S.next(0, cur)) return;
    f32x4 acc[2][2][4][2];
#pragma unroll
    for (int a = 0; a < 2; ++a)
#pragma unroll
        for (int b = 0; b < 2; ++b)
#pragma unroll
            for (int m = 0; m < 4; ++m)
#pragma unroll
                for (int n = 0; n < 2; ++n) acc[a][b][m][n] = (f32x4){0.f, 0.f, 0.f, 0.f};
    bf16x8 At[4][2], B0[2][2], B1[2][2];
    const char* cA = (const char*)g.A + (size_t)cur.pm * tstep; const char* cB = (const char*)g.Bt + (size_t)cur.pn * tstep;
    S.a_ready(cur);
    if constexpr (SP2) {
        PG8_STAGE(PG8_SB(0, 0), cB, voffB); PG8_STAGE(PG8_SB(0, 1), cB + hstep, voffB); PG8_STAGE_A(PG8_SA(0, 0), cA, voffA); PG8_STAGE_A(PG8_SA(0, 1), cA + hstep, voffA);
        if (wr == 1) PG8_BAR;
        PG8_WAIT_V(2); PG8_BAR;
        PG8_STAGE(PG8_SB(1, 0), cB + kstep, voffB); PG8_STAGE_A(PG8_SA(1, 0), cA + kstep, voffA); PG8_STAGE(PG8_SB(1, 1), cB + hstep + kstep, voffB);
        PG8_WAIT_V(6); PG8_BAR;
    } else {
        PG8_STAGE(PG8_SB(0, 0), cB, voffB); PG8_STAGE_A(PG8_SA(0, 0), cA, voffA); PG8_STAGE(PG8_SB(0, 1), cB + hstep, voffB); PG8_STAGE_A(PG8_SA(0, 1), cA + hstep, voffA);
        if (wr == 1) PG8_BAR;
        PG8_WAIT_V(4); PG8_BAR;
        PG8_STAGE(PG8_SB(1, 0), cB + kstep, voffB); PG8_STAGE_A(PG8_SA(1, 0), cA + kstep, voffA); PG8_STAGE(PG8_SB(1, 1), cB + hstep + kstep, voffB);
        PG8_WAIT_V(6); PG8_BAR;
    }
    for (;;) {
        const bool has_next = S.next(ui + 1, nxt);
        const char* nA = has_next ? (const char*)g.A + (size_t)nxt.pm * tstep : cA; const char* nB = has_next ? (const char*)g.Bt + (size_t)nxt.pn * tstep : cB;
        for (int t = 0; t < nt; t += 2) {
            const bool last = (t == nt - 2);
            const char* a1 = cA + (size_t)(t + 1) * kstep;
            const char* a2 = last ? nA : cA + (size_t)(t + 2) * kstep; const char* b2 = last ? nB : cB + (size_t)(t + 2) * kstep;
            const char* a3 = a2 + kstep; const char* b3 = b2 + kstep;
            if (last && has_next) S.a_ready(nxt);
            if constexpr (SP2) {
            PG8_LDB(B0, 0, 0); PG8_LDB(B1, 0, 1); PG8_SCHED; PG8_LDA(At, 0, 0); PG8_STAGE_A(PG8_SA(1, 1), a1 + hstep, voffA);
            PG8_WAIT_V(8); PG8_WAIT_L(0); PG8_BAR; PG8_MMA(0, 0, At, B0); PG8_MMA(0, 1, At, B1); PG8_BAR; PG8_SCHED;
            PG8_LDA(At, 0, 1); PG8_STAGE(PG8_SB(0, 0), b2, voffB); PG8_STAGE(PG8_SB(0, 1), b2 + hstep, voffB); PG8_STAGE_A(PG8_SA(0, 0), a2, voffA);
            PG8_WAIT_V(8); PG8_WAIT_L(0); PG8_BAR; PG8_MMA(1, 0, At, B0); PG8_MMA(1, 1, At, B1); PG8_BAR; PG8_SCHED;
            PG8_LDB(B0, 1, 0); PG8_LDB(B1, 1, 1); PG8_SCHED; PG8_LDA(At, 1, 0); PG8_STAGE_A(PG8_SA(0, 1), a2 + hstep, voffA);
            PG8_WAIT_V(8); PG8_WAIT_L(0); PG8_BAR; PG8_MMA(0, 0, At, B0); PG8_MMA(0, 1, At, B1); PG8_BAR; PG8_SCHED;
            PG8_LDA(At, 1, 1); PG8_STAGE(PG8_SB(1, 0), b3, voffB); PG8_STAGE(PG8_SB(1, 1), b3 + hstep, voffB); PG8_STAGE_A(PG8_SA(1, 0), a3, voffA);
            PG8_WAIT_V(8); PG8_WAIT_L(0); PG8_BAR; PG8_MMA(1, 0, At, B0); PG8_MMA(1, 1, At, B1); PG8_BAR; PG8_SCHED;
            } else {
            PG8_LDB(B0, 0, 0); PG8_SCHED; PG8_LDA(At, 0, 0); PG8_STAGE_A(PG8_SA(1, 1), a1 + hstep, voffA);
            PG8_WAIT_L(8); PG8_BAR; PG8_WAIT_L(0); PG8_MMA(0, 0, At, B0); PG8_BAR; PG8_SCHED;
            PG8_LDB(B1, 0, 1); PG8_STAGE(PG8_SB(0, 0), b2, voffB);
            PG8_BAR; PG8_WAIT_L(0); PG8_MMA(0, 1, At, B1); PG8_BAR;
            PG8_LDA(At, 0, 1); PG8_STAGE_A(PG8_SA(0, 0), a2, voffA);
            PG8_BAR; PG8_WAIT_L(0); PG8_MMA(1, 0, At, B0); PG8_BAR; PG8_SCHED;
            PG8_STAGE(PG8_SB(0, 1), b2 + hstep, voffB);
            PG8_WAIT_V(6); PG8_BAR; PG8_MMA(1, 1, At, B1); PG8_BAR;
            PG8_LDB(B0, 1, 0); PG8_SCHED; PG8_LDA(At, 1, 0); PG8_STAGE_A(PG8_SA(0, 1), a2 + hstep, voffA);
            PG8_WAIT_L(8); PG8_BAR; PG8_WAIT_L(0); PG8_MMA(0, 0, At, B0); PG8_BAR; PG8_SCHED;
            PG8_LDB(B1, 1, 1); PG8_STAGE(PG8_SB(1, 0), b3, voffB);
            PG8_BAR; PG8_WAIT_L(0); PG8_MMA(0, 1, At, B1); PG8_BAR;
            PG8_LDA(At, 1, 1); PG8_STAGE_A(PG8_SA(1, 0), a3, voffA);
            PG8_BAR; PG8_WAIT_L(0); PG8_MMA(1, 0, At, B0); PG8_BAR; PG8_SCHED;
            PG8_STAGE(PG8_SB(1, 1), b3 + hstep, voffB);
            PG8_WAIT_V(6); PG8_BAR; PG8_MMA(1, 1, At, B1); PG8_BAR;
            }
        }
        if constexpr (ALIGN_EPI) { if (wr == 0) PG8_BAR; }
        if constexpr (!Epi::AFTER_DRAIN) { E(acc, cur, wr, wc, fr, fq); S.done(cur); }
        if (!has_next) break;
#pragma unroll
        for (int a = 0; a < 2; ++a)
#pragma unroll
            for (int b = 0; b < 2; ++b)
#pragma unroll
                for (int m = 0; m < 4; ++m)
#pragma unroll
                    for (int n = 0; n < 2; ++n) acc[a][b][m][n] = (f32x4){0.f, 0.f, 0.f, 0.f};
        cur = nxt; cA = nA; cB = nB; ++ui;
        if constexpr (ALIGN_EPI) { if (wr == 1) PG8_BAR; }
    }
    PG8_WAIT_V(0);
    if constexpr (!ALIGN_EPI) { if (wr == 0) PG8_BAR; }
    PG8_BAR;
    if constexpr (Epi::AFTER_DRAIN) { E.fused(acc, cur, wr, wc, fr, fq, lds, wid, lane); S.done(cur); }
#undef PG8_SA
#undef PG8_SB
#undef PG8_STAGE
#undef PG8_STAGE_A
#undef PG8_LDA
#undef PG8_LDB
#undef PG8_MMA
#undef PG8_WAIT_V
#undef PG8_WAIT_L
#undef PG8_BAR
#undef PG8_SCHED
}
}
constexpr int NWAVES = 8, NTHREADS = NWAVES * 64;
constexpr int LDS_BYTES = 147456;
constexpr int LDS_MISC = 131072;
constexpr int N_PHASES = 9;

struct Args {
    const float *x_prompt, *x_sample, *cache_k, *cache_v, *state_delta, *state_conv, *meta, *norm_mix, *w_in, *conv_w, *a_log, *dt_bias, *sinks, *gdn_norm,
                *w_oa, *w_ob, *w_out, *norm_ffn, *w_gate, *w_up, *w_down, *norm_final;
    float* out; unsigned char* ws; int ph_lo, ph_hi;
};

typedef const __attribute__((address_space(4))) Args* KA;
DI KA kargs() { KA p = (KA)__builtin_amdgcn_kernarg_segment_ptr(); asm volatile("" : "+s"(p)); return p; }
#define RLX_AGENT __ATOMIC_RELAXED, __HIP_MEMORY_SCOPE_AGENT
#define LDS_WAIT() asm volatile("s_waitcnt lgkmcnt(0)" ::: "memory")
#define MFMA32(a, b, c) __builtin_amdgcn_mfma_f32_32x32x16_bf16((a), (b), (c), 0, 0, 0)
DI int crow16(int reg, int h) { return (reg & 3) + 8 * (reg >> 2) + 4 * h; }
DI float wave_sum(float v) {
#pragma unroll
    for (int o = 1; o < 64; o <<= 1) v += __shfl_xor(v, o);
    return v;
}
DI float wave_max(float v) {
#pragma unroll
    for (int o = 1; o < 64; o <<= 1) v = fmaxf(v, __shfl_xor(v, o));
    return v;
}
template <int S> DI bf16x8 pack_step(const f32x16& x) {
    u32x4 p; p.x = cvtpk(x[8 * S], x[8 * S + 1]); p.y = cvtpk(x[8 * S + 2], x[8 * S + 3]); p.z = cvtpk(x[8 * S + 4], x[8 * S + 5]); p.w = cvtpk(x[8 * S + 6], x[8 * S + 7]);
    return __builtin_bit_cast(bf16x8, p);
}
DI int frag_idx(int row, int k, int NKS) { const int kkk = k & 15; return (((row >> 5) * NKS + (k >> 4)) * 64 + (row & 31) + 32 * ((kkk >> 2) & 1)) * 8 + (((kkk >> 3) << 2) | (kkk & 3)); }
DI unsigned char* slot_ptr(KA A, int item) { return item < PREP_N1 ? A->ws + WS_B + (size_t)item * PREP_SLOT : (unsigned char*)A->out + (size_t)(item - PREP_N1) * PREP_SLOT; }

#define XB_TMO      128
#define XB_XCNT(j)  (256  + 64 * (j))
#define XB_XSUB(j)  (1280 + 64 * (j))
#define XB_XGEN(j)  (2304 + 64 * (j))
#define XB_TOP      3328
#define XB_TOPGEN   3392
#define XCD_BAR_WORDS 3456
#define XB_SPIN_CAP (1u << 20)
DI unsigned xb_ld(unsigned* p)              { return __hip_atomic_load(p, __ATOMIC_RELAXED, __HIP_MEMORY_SCOPE_AGENT); }
DI unsigned xb_add(unsigned* p, unsigned v) { return __hip_atomic_fetch_add(p, v, __ATOMIC_RELAXED, __HIP_MEMORY_SCOPE_AGENT); }
DI unsigned xb_xcc_id() { return (unsigned)__builtin_amdgcn_s_getreg((3 << 11) | 20) & 0xFu; }
#define XB_SPIN(cond, bar) do { unsigned _sp = 0; while (cond) { __builtin_amdgcn_s_sleep(1); \
    if ((++_sp & 255u) == 0u) { if (xb_ld(&(bar)[XB_TMO])) break; if (_sp > XB_SPIN_CAP) { atomicAdd(&(bar)[XB_TMO], 1u); break; } } } } while (0)
struct XcdBarrier { unsigned* bar; unsigned x; volatile LAS unsigned* st; };
DI XcdBarrier xcd_barrier_post(unsigned* bar, volatile LAS unsigned* st) {
    XcdBarrier b; b.bar = bar; b.x = xb_xcc_id(); b.st = st;
    if (threadIdx.x == 0) (void)xb_add(&bar[XB_XCNT(b.x)], 1u);
    return b;
}
DI void xcd_barrier_complete(unsigned* bar, unsigned x, unsigned& nloc, unsigned& nx) {
    const unsigned G = gridDim.x * gridDim.y * gridDim.z;
    unsigned sum, cnt, mine, sp = 0u;
    for (;;) {
        sum = 0u; cnt = 0u; mine = 0u;
#pragma unroll
        for (unsigned j = 0; j < 16; ++j) { const unsigned c = xb_ld(&bar[XB_XCNT(j)]); sum += c; cnt += (c > 0u) ? 1u : 0u; mine = (j == x) ? c : mine; }
        if (sum == G) break;
        __builtin_amdgcn_s_sleep(1);
        if ((++sp & 255u) == 0u) { if (xb_ld(&bar[XB_TMO])) break; if (sp > XB_SPIN_CAP) { atomicAdd(&bar[XB_TMO], 1u); break; } }
    }
    nloc = mine > 0u ? mine : 1u; nx = cnt > 0u ? cnt : 1u;
}
DI void xcd_barrier(const XcdBarrier& b) {
    asm volatile("s_waitcnt vmcnt(0)" ::: "memory");
    __syncthreads();
    if (threadIdx.x == 0) {
        unsigned* bar = b.bar;
        __builtin_amdgcn_s_waitcnt(0);
        unsigned nloc = b.st[0], nx = b.st[1];
        if (nloc == 0u) { xcd_barrier_complete(bar, b.x, nloc, nx); b.st[0] = nloc; b.st[1] = nx; }
        const unsigned old = xb_add(&bar[XB_XSUB(b.x)], 1u);
        const unsigned gen = old / nloc;
        if (old + 1u == (gen + 1u) * nloc) {
            __builtin_amdgcn_fence(__ATOMIC_RELEASE, "agent");
            asm volatile("s_waitcnt vmcnt(0)" ::: "memory");
            const unsigned og = xb_add(&bar[XB_TOP], 1u);
            const unsigned tg = og / nx;
            if (og + 1u == (tg + 1u) * nx) xb_add(&bar[XB_TOPGEN], 1u);
            else XB_SPIN(xb_ld(&bar[XB_TOPGEN]) == tg, bar);
            __builtin_amdgcn_fence(__ATOMIC_ACQUIRE, "agent");
            xb_add(&bar[XB_XGEN(b.x)], 1u);
            asm volatile("s_waitcnt vmcnt(0)" ::: "memory");
        } else {
            XB_SPIN(xb_ld(&bar[XB_XGEN(b.x)]) == gen, bar);
            __builtin_amdgcn_fence(__ATOMIC_ACQUIRE, "agent");
            asm volatile("s_waitcnt vmcnt(0)" ::: "memory");
        }
    }
    __syncthreads();
}

template <class RowMap> DI void transpose_item(const float* W, int K, int N, bf16* WT, RowMap rm, const float* kscale, LAS float* scr, int item, int lane) {
    const int nblk = (N + 31) / 32, kb = item / nblk, nb = item - kb * nblk, k0 = 64 * kb, n0 = 32 * nb;
    const int ncol = n0 + (lane & 31);
#pragma unroll 8
    for (int i = 0; i < 32; ++i) { const int kk = 2 * i + (lane >> 5);
        float v = ncol < N ? W[(size_t)(k0 + kk) * N + ncol] : 0.f;
        if (kscale) v *= kscale[k0 + kk];
        scr[kk * 33 + (lane & 31)] = v; }
    LDS_WAIT(); asm volatile("" ::: "memory");
    const int c = lane & 7;
#pragma unroll
    for (int j = 0; j < 4; ++j) { const int n = (lane >> 3) + 8 * j; const LAS float* s = scr + (8 * c) * 33 + n;
        const int nsrc = n0 + n; const int drow = nsrc < N ? rm(nsrc) : -1;
        u32x4 o; o.x = cvtpk(s[0 * 33], s[1 * 33]); o.y = cvtpk(s[2 * 33], s[3 * 33]); o.z = cvtpk(s[4 * 33], s[5 * 33]); o.w = cvtpk(s[6 * 33], s[7 * 33]);
        if (drow >= 0) *(u32x4*)(WT + (size_t)drow * K + k0 + 8 * c) = o; }
    LDS_WAIT(); asm volatile("" ::: "memory");
}
DI float softplusf_(float x) { return x > 20.f ? x : log1pf(__expf(x)); }

#ifndef PROBE_REP
#define PROBE_REP -1
#endif
DI void p0_prologue(KA A, LAS unsigned char* lds) {
    const int tid = threadIdx.x, lane = tid & 63, wave = __builtin_amdgcn_readfirstlane(tid >> 6);
    const int G = gridDim.x, gw = blockIdx.x * NWAVES + wave, NGW = G * NWAVES;
    const int gt = blockIdx.x * NTHREADS + tid, NGT = G * NTHREADS;
    unsigned char* ws = A->ws;
    for (int rep = 0; rep < (PROBE_REP == 1001 ? 2 : 1); ++rep) {
        LAS float* scr = (LAS float*)(lds + wave * 16384);
        constexpr int I_IN = 16 * 153, I_OA = 8 * 32, I_OUT = 16 * 32, I_G = 16 * 88, I_D = 44 * 32;
        constexpr int NIT = I_IN + 2 * I_OA + I_OUT + 2 * I_G + I_D;
        for (int it = gw; it < NIT; it += NGW) {
            int r = it;
            if (r < I_IN) { transpose_item(A->w_in, 1024, NIN_SRC, (bf16*)(ws + WS_WIN), [](int c) -> int {
                    if (c < 640) return (c & ~63) + pos_of_d(c & 63);
                    if (c < 2816) return c;
                    if (c < 2824) return -1;
                    return c - 8; }, nullptr, scr, r, lane); continue; } r -= I_IN;
            if (r < I_OA) { transpose_item(A->w_oa, 512, 1024, (bf16*)(ws + WS_WOA), [](int c) -> int { return c; }, nullptr, scr, r, lane); continue; } r -= I_OA;
            if (r < I_OA) { transpose_item(A->w_ob, 512, 1024, (bf16*)(ws + WS_WOB), [](int c) -> int { return c; }, nullptr, scr, r, lane); continue; } r -= I_OA;
            if (r < I_OUT) { transpose_item(A->w_out, 1024, 1024, (bf16*)(ws + WS_WOUT), [](int c) -> int { return c; }, nullptr, scr, r, lane); continue; } r -= I_OUT;
            if (r < I_G) { transpose_item(A->w_gate, 1024, DFF, (bf16*)(ws + WS_WGU), [](int c) -> int { return 256 * (c >> 7) + (c & 127); }, A->norm_ffn, scr, r, lane); continue; } r -= I_G;
            if (r < I_G) { transpose_item(A->w_up, 1024, DFF, (bf16*)(ws + WS_WGU), [](int c) -> int { return 256 * (c >> 7) + 128 + (c & 127); }, A->norm_ffn, scr, r, lane); continue; } r -= I_G;
            transpose_item(A->w_down, DFF, 1024, (bf16*)(ws + WS_WD), [](int c) -> int { return c; }, nullptr, scr, r, lane);
        }
    }
    for (int rep = 0; rep < (PROBE_REP == 1002 ? 2 : 1); ++rep) {
        float* COS = (float*)(ws + WS_ROPE); float* SIN = COS + (TP + TS) * 32;
        for (int i = gt; i < (TP + TS) * 32; i += NGT) { const int ri = i >> 5, f = i & 31; const double pos = ri < TP ? (double)ri : (double)(PAST + ri - TP);
            const double inv = exp2(-(double)f * (13.287712379549449 / 32.0)), ang = pos * inv; COS[i] = (float)cos(ang); SIN[i] = (float)sin(ang); }
        constexpr int PERB = 124 * 128 / 4;
        for (int i = gt; i < SBATCH * PERB; i += NGT) { const int b = i / PERB, o = i - b * PERB;
            ((f32x4*)(A->out + O_KS))[(size_t)b * 4096 + o] = ((const f32x4*)A->cache_k)[(size_t)b * 4096 + 128 + o];
            ((f32x4*)(A->out + O_VS))[(size_t)b * 4096 + o] = ((const f32x4*)A->cache_v)[(size_t)b * 4096 + 128 + o]; }
    }
    for (int rep = 0; rep < (PROBE_REP == 1003 ? 2 : 1); ++rep) {
        unsigned wab[16][4];
        f32x4 nm[4];
#pragma unroll
        for (int j = 0; j < 4; ++j) {
            nm[j] = ((const f32x4*)A->norm_mix)[lane + 64 * j];
#pragma unroll
            for (int e = 0; e < 4; ++e) { const float* p = A->w_in + (size_t)(4 * (lane + 64 * j) + e) * NIN_SRC + 2816;
                const f32x4 a = *(const f32x4*)p, b = *(const f32x4*)(p + 4);
                wab[j * 4 + e][0] = cvtpk(a[0], a[1]); wab[j * 4 + e][1] = cvtpk(a[2], a[3]); wab[j * 4 + e][2] = cvtpk(b[0], b[1]); wab[j * 4 + e][3] = cvtpk(b[2], b[3]); }
        }
        bf16* XN = (bf16*)(ws + WS_XN); f32x2* GB = (f32x2*)(ws + WS_GB);
        for (int urow = gw; urow < MUP; urow += NGW) {
            const float* src = nullptr;
            if (urow < MP) { const int b = urow / TP, t = urow - b * TP; src = t < NMETA ? A->meta + (size_t)t * D : A->x_prompt + ((size_t)b * SEQ + (t - NMETA)) * D; }
            else if (urow < MU) src = A->x_sample + (size_t)(urow - MP) * D;
            u32x2* o8 = (u32x2*)(XN + (size_t)urow * D) + lane;
            if (!src) {
#pragma unroll
                for (int j = 0; j < 4; ++j) o8[64 * j] = (u32x2){0u, 0u};
                if (lane < 4) GB[(size_t)urow * 4 + lane] = (f32x2){0.f, 0.f};
                continue; }
            f32x4 v[4]; float ss = 0.f;
#pragma unroll
            for (int j = 0; j < 4; ++j) { v[j] = ((const f32x4*)src)[lane + 64 * j]; ss += (v[j][0] * v[j][0] + v[j][1] * v[j][1]) + (v[j][2] * v[j][2] + v[j][3] * v[j][3]); }
            const float rstd = rsqrtf(wave_sum(ss) * (1.0f / D) + EPS);
            float dot[8];
#pragma unroll
            for (int c = 0; c < 8; ++c) dot[c] = 0.f;
#pragma unroll
            for (int j = 0; j < 4; ++j) { v[j] = v[j] * rstd * nm[j];
                o8[64 * j] = (u32x2){cvtpk(v[j][0], v[j][1]), cvtpk(v[j][2], v[j][3])};
#pragma unroll
                for (int e = 0; e < 4; ++e)
#pragma unroll
                    for (int c = 0; c < 4; ++c) { dot[2 * c] += v[j][e] * bflo(wab[j * 4 + e][c]); dot[2 * c + 1] += v[j][e] * bfhi(wab[j * 4 + e][c]); } }
#pragma unroll
            for (int c = 0; c < 8; ++c) dot[c] = wave_sum(dot[c]);
            if (lane < 4) {
                const float a = lane == 0 ? dot[0] : lane == 1 ? dot[1] : lane == 2 ? dot[2] : dot[3];
                const float bb = lane == 0 ? dot[4] : lane == 1 ? dot[5] : lane == 2 ? dot[6] : dot[7];
                const float g = -__expf(A->a_log[lane]) * softplusf_(a + A->dt_bias[lane]);
                GB[(size_t)urow * 4 + lane] = (f32x2){g, sigmoidf_(bb)};
            }
        }
    }
}
DI void item_decode(int item, int& b, int& h, bool& sample, int& t0, int& L) {
    if (item < N_ITEMS_P) { const int s = item / CHUNKS_P, c = item - s * CHUNKS_P; b = s >> 2; h = s & 3; sample = false; if (c == 0) { t0 = 0; L = NMETA; } else { t0 = NMETA + 64 * (c - 1); L = 64; } }
    else { const int s = item - N_ITEMS_P; b = s >> 2; h = s & 3; sample = true; t0 = 0; L = TS; }
}
#define LDS_BARRIER() do { asm volatile("s_waitcnt lgkmcnt(0)" ::: "memory"); __builtin_amdgcn_s_barrier(); asm volatile("" ::: "memory"); } while (0)
typedef GAS unsigned long long gu64;
constexpr size_t CTL_F1 = 655360;
static_assert(CTL_F1 + 2592 * 64 <= 1048576, "control region map");
DI gu64* item_flag1(KA A, int item) { return (gu64*)(A->ws + WS_CTL + CTL_F1 + (size_t)item * 64); }
DI int order_item(int m) { return m < N_ITEMS_P ? (m & 31) * CHUNKS_P + (m >> 5) : m; }
DI gu64* item_granule(KA A, int item) { return (gu64*)(A->ws + WS_CTL + CTL_GRAN + (size_t)item * 64); }
DI float wait_item(gu64* g, unsigned ep = 1u) {
    unsigned long long x; unsigned spins = 0;
    for (;;) { x = __hip_atomic_load(g, __ATOMIC_RELAXED, __HIP_MEMORY_SCOPE_AGENT); if ((unsigned)(x >> 32) >= ep) break; __builtin_amdgcn_s_sleep(8); if (++spins > (1u << 20)) break; }
    asm volatile("" ::: "memory");
    return __uint_as_float((unsigned)__builtin_amdgcn_readfirstlane((int)(unsigned)x));
}
constexpr int LDS_GCL = 139264;
constexpr int PITCH = 132;
DI bf16x8 frag_nat(const LAS float* src, int row, int k0) {
    const f32x4 lo = *(const LAS f32x4*)(src + row * PITCH + k0), hi = *(const LAS f32x4*)(src + row * PITCH + k0 + 4);
    return __builtin_bit_cast(bf16x8, pack8f(lo, hi));
}
struct S1Pre { u32x4 xr[11]; f32x4 w[4][2]; f32x2 gb; };
DI void stage1_issue(KA A, int item, S1Pre& P) {
    const int tid = threadIdx.x, lane = tid & 63, wave = __builtin_amdgcn_readfirstlane(tid >> 6);
    int b, h, t0, L; bool sample; item_decode(item, b, h, sample, t0, L);
    const bf16* QKVB = (const bf16*)(A->ws + WS_QKVB);
    const int cv = lane < 48 ? lane : 47, grp = cv >> 4, col0 = (cv & 15) * 8, r0 = wave * 8, cidx = grp * 512 + h * 128 + col0;
#pragma unroll
    for (int q = 0; q < 11; ++q) {
        const int i = r0 - 3 + q;
        long urow = sample ? (long)MP + b * TS + i : (long)b * TP + t0 + i;
        const bool ok = sample ? i >= 0 : t0 + i >= 0;
        if (!ok) urow = 0;
        P.xr[q] = *(const u32x4*)(QKVB + (size_t)urow * CONVD + cidx);
        if (!ok) P.xr[q] = (u32x4){0u, 0u, 0u, 0u};
    }
#pragma unroll
    for (int i = 0; i < 4; ++i) { P.w[i][0] = *(const f32x4*)(A->conv_w + i * CONVD + cidx); P.w[i][1] = *(const f32x4*)(A->conv_w + i * CONVD + cidx + 4); }
    P.gb = (f32x2){0.f, 0.f};
    if (wave == 7 && lane < L) { const int urow = sample ? MP + b * TS + lane : b * TP + t0 + lane; P.gb = ((const f32x2*)(A->ws + WS_GB))[(size_t)urow * 4 + h]; }
}
DI void prep_stage1(KA A, int item, int next_item, int prev_item, int wait_item_idx, int bslot, float* ats, S1Pre& P, LAS unsigned char* ldsb, unsigned ep, int pmode = 0) {
    const int tid = threadIdx.x, lane = tid & 63, wave = __builtin_amdgcn_readfirstlane(tid >> 6), r = lane & 31, hh = lane >> 5;
#ifdef PROBE_PLAIN
    const bool plain_ = ep == 2u;
#define ST16(p, ...) do { if (plain_) *(u32x4*)(p) = (__VA_ARGS__); else st16_sc1((p), (__VA_ARGS__)); } while (0)
#define ST16F(p, ...) do { if (plain_) *(f32x4*)(p) = (__VA_ARGS__); else st16_sc1f((p), (__VA_ARGS__)); } while (0)
#else
#define ST16(p, ...) st16_sc1((p), (__VA_ARGS__))
#define ST16F(p, ...) st16_sc1f((p), (__VA_ARGS__))
#endif
    int b, h, t0, L; bool sample; item_decode(item, b, h, sample, t0, L);
    LAS float* Qs = (LAS float*)ldsb; LAS float* Ks = Qs + 64 * PITCH; LAS float* Vs = Ks + 64 * PITCH; LAS float* gcs = Vs + 64 * PITCH; LAS float* betas = gcs + 64;
    unsigned char* slot = slot_ptr(A, item);
    if (!(pmode & 8)) {
        const int cv = lane < 48 ? lane : 47, grp = cv >> 4, col0 = (cv & 15) * 8, r0 = wave * 8, cidx = grp * 512 + h * 128 + col0;
        float x[11][8];
#pragma unroll
        for (int q = 0; q < 11; ++q) { x[q][0] = bflo(P.xr[q].x); x[q][1] = bfhi(P.xr[q].x); x[q][2] = bflo(P.xr[q].y); x[q][3] = bfhi(P.xr[q].y);
                                       x[q][4] = bflo(P.xr[q].z); x[q][5] = bfhi(P.xr[q].z); x[q][6] = bflo(P.xr[q].w); x[q][7] = bfhi(P.xr[q].w); }
        if (sample && wave == 0) {
#pragma unroll
            for (int q = 0; q < 3; ++q) { const float* sp = A->state_conv + ((size_t)b * 3 + q) * CONVD + cidx; const f32x4 s0 = *(const f32x4*)sp, s1 = *(const f32x4*)(sp + 4);
                x[q][0] = s0[0]; x[q][1] = s0[1]; x[q][2] = s0[2]; x[q][3] = s0[3]; x[q][4] = s1[0]; x[q][5] = s1[1]; x[q][6] = s1[2]; x[q][7] = s1[3]; }
        }
        float w[4][8];
#pragma unroll
        for (int i = 0; i < 4; ++i) { w[i][0] = P.w[i][0][0]; w[i][1] = P.w[i][0][1]; w[i][2] = P.w[i][0][2]; w[i][3] = P.w[i][0][3]; w[i][4] = P.w[i][1][0]; w[i][5] = P.w[i][1][1]; w[i][6] = P.w[i][1][2]; w[i][7] = P.w[i][1][3]; }
        LAS float* dst = Qs + grp * 64 * PITCH + col0;
        const float nsc = grp == 0 ? 0.08838834764831845f : 1.0f;
#pragma unroll
        for (int q = 3; q < 11; ++q) {
            const int rr = r0 + q - 3;
            float v[8]; float ss = 0.f;
#pragma unroll
            for (int e = 0; e < 8; ++e) {
                const float y = __builtin_fmaf(w[3][e], x[q][e], __builtin_fmaf(w[2][e], x[q - 1][e], __builtin_fmaf(w[1][e], x[q - 2][e], w[0][e] * x[q - 3][e])));
                const float sv = siluf_(y); v[e] = sv; ss = __builtin_fmaf(sv, sv, ss); }
            ss += __builtin_bit_cast(float, __builtin_amdgcn_update_dpp(0, __builtin_bit_cast(int, ss), 0xB1, 0xF, 0xF, true));
            ss += __builtin_bit_cast(float, __builtin_amdgcn_update_dpp(0, __builtin_bit_cast(int, ss), 0x4E, 0xF, 0xF, true));
            ss += __builtin_bit_cast(float, __builtin_amdgcn_update_dpp(0, __builtin_bit_cast(int, ss), 0x141, 0xF, 0xF, true));
            ss += __builtin_bit_cast(float, __builtin_amdgcn_update_dpp(0, __builtin_bit_cast(int, ss), 0x140, 0xF, 0xF, true));
            float sc = grp == 2 ? 1.0f : rsqrtf(ss + EPS) * nsc;
            sc = rr < L ? sc : 0.f;
            if (lane < 48) { *(LAS f32x4*)(dst + rr * PITCH) = (f32x4){v[0] * sc, v[1] * sc, v[2] * sc, v[3] * sc}; *(LAS f32x4*)(dst + rr * PITCH + 4) = (f32x4){v[4] * sc, v[5] * sc, v[6] * sc, v[7] * sc}; }
        }
    }
    if (wave == 7) {
        float gc = P.gb[0];
#pragma unroll
        for (int o = 1; o < 64; o <<= 1) { const float t = __shfl_up(gc, o); if (lane >= o) gc += t; }
        gcs[lane] = gc; betas[lane] = P.gb[1];
        if (lane == 63) ((LAS float*)(ldsb + LDS_GCL))[bslot] = __expf(gc);
    }
    asm volatile("s_waitcnt vmcnt(0)" ::: "memory");
    if (next_item < N_ITEMS) stage1_issue(A, next_item, P);
    if (wait_item_idx >= 0 && wave == 0) (void)wait_item(item_granule(A, wait_item_idx), ep);
    LDS_BARRIER();
    if (prev_item >= 0 && tid == 0) __hip_atomic_store(item_flag1(A, prev_item), ((unsigned long long)ep << 32) | (unsigned long long)__float_as_uint(((const LAS float*)(ldsb + LDS_GCL))[bslot ^ 1]), __ATOMIC_RELAXED, __HIP_MEMORY_SCOPE_AGENT);
    if (wave < 6 && !(pmode & 4)) {
        const bool isqk = wave >= 3; const int tsel = isqk ? wave - 3 : wave, ib = tsel == 0 ? 0 : 1, jb = tsel == 2 ? 1 : 0;
        const LAS float* Asrc = isqk ? Qs : Ks;
        f32x16 acc;
#pragma unroll
        for (int e = 0; e < 16; ++e) acc[e] = 0.f;
#pragma unroll
        for (int s = 0; s < 8; ++s) acc = MFMA32(frag_nat(Asrc, 32 * ib + r, 16 * s + 8 * hh), frag_nat(Ks, 32 * jb + r, 16 * s + 8 * hh), acc);
        const int j = 32 * jb + r; const float gcj = gcs[j];
        float* Aout = ats + (ib + jb) * 1024; bf16* QKD = (bf16*)(slot + SL_QKD);
        if (!isqk) {
#pragma unroll
            for (int g4 = 0; g4 < 4; ++g4) { f32x4 v;
#pragma unroll
                for (int e = 0; e < 4; ++e) { const int i = 32 * ib + 8 * g4 + 4 * hh + e; v[e] = i > j ? betas[i] * __expf(fminf(gcs[i] - gcj, 0.f)) * acc[4 * g4 + e] : 0.f; }
                ST16F(Aout + r * 32 + 8 * g4 + 4 * hh, v); }
        } else {
            LAS float* patch = (LAS float*)(ldsb + 106496) + (wave - 3) * (32 * 36);
#pragma unroll
            for (int reg = 0; reg < 16; ++reg) { const int il = crow16(reg, hh), i = 32 * ib + il; const float dec = __expf(fminf(gcs[i] - gcj, 0.f));
                patch[il * 36 + r] = i >= j ? dec * acc[reg] : 0.f; }
            LDS_WAIT(); asm volatile("" ::: "memory");
#pragma unroll
            for (int ks2 = 0; ks2 < 2; ++ks2) { const int k0 = 16 * ks2 + 4 * hh;
                const f32x4 lo = *(const LAS f32x4*)(patch + r * 36 + k0), hi = *(const LAS f32x4*)(patch + r * 36 + k0 + 8);
                ST16((unsigned char*)QKD + ((ib * 4 + 2 * jb + ks2) * 64 + lane) * 16, pack8f(lo, hi)); }
        }
    }
    const float gcl = gcs[63];
#pragma unroll 1
    for (int job = (pmode & 4) ? 56 : wave; job < 56; job += 8) {
        if (job < 32) {
            const bool isq = job >= 16; const int jj = job & 15, rb = jj >> 3, ks = jj & 7, row = 32 * rb + r, k0 = 16 * ks + 4 * hh;
            const LAS float* src = isq ? Qs : Ks; const float sc = isq ? __expf(gcs[row]) : betas[row] * __expf(gcs[row]);
            const f32x4 lo = *(const LAS f32x4*)(src + row * PITCH + k0) * sc, hi = *(const LAS f32x4*)(src + row * PITCH + k0 + 8) * sc;
            ST16(slot + (isq ? SL_QE : SL_BEK) + ((rb * 8 + ks) * 64 + lane) * 16, pack8f(lo, hi));
        } else if (job < 48) {
            const int jj = job - 32, rb = jj >> 2, ks = jj & 3, dk = 32 * rb + r;
            f32x4 lo, hi;
#pragma unroll
            for (int e = 0; e < 4; ++e) { const int j0 = 16 * ks + 4 * hh + e, j1 = j0 + 8;
                lo[e] = Ks[j0 * PITCH + dk] * __expf(gcl - gcs[j0]); hi[e] = Ks[j1 * PITCH + dk] * __expf(gcl - gcs[j1]); }
            ST16(slot + SL_KWT + ((rb * 4 + ks) * 64 + lane) * 16, pack8f(lo, hi));
        } else {
            const int q = job - 48, w = q >> 1, ib = q & 1, dv = 32 * w + r;
            float v[16];
#pragma unroll
            for (int reg = 0; reg < 16; ++reg) { const int i = 32 * ib + crow16(reg, hh); v[reg] = betas[i] * Vs[i * PITCH + dv]; }
            u32x4* dst = (u32x4*)(slot + SL_BV + ((w * 2 + ib) * 64 + lane) * 32);
            ST16(dst, (u32x4){cvtpk(v[0], v[1]), cvtpk(v[2], v[3]), cvtpk(v[4], v[5]), cvtpk(v[6], v[7])});
            ST16(dst + 1, (u32x4){cvtpk(v[8], v[9]), cvtpk(v[10], v[11]), cvtpk(v[12], v[13]), cvtpk(v[14], v[15])});
        }
    }
    LDS_BARRIER();
}
DI void prep_stage2(KA A, int item, float gcl, const float* ats, LAS float* M, unsigned ep) {
    int lane = threadIdx.x & 63; asm volatile("" : "+v"(lane));
    const int r = lane & 31, hh = lane >> 5, base = 32 * hh;
    unsigned char* slot = slot_ptr(A, item);
    const f32x4* Ain = (const f32x4*)ats;
#pragma unroll
    for (int tt = 0; tt < 3; ++tt) { const int jb = tt >> 1, ib = (tt + 1) >> 1;
#pragma unroll
        for (int q = 0; q < 4; ++q) { const int idx = q * 64 + lane, jj = idx >> 3, i4 = idx & 7;
            *(LAS f32x4*)(M + (32 * jb + jj) * 64 + 32 * ib + 4 * i4) = Ain[tt * 256 + idx]; } }
    LDS_WAIT(); asm volatile("" ::: "memory");
#pragma unroll 1
    for (int rb = 0; rb < 2; ++rb) {
        float acc[16];
#pragma unroll
        for (int i = 0; i < 16; ++i) acc[i] = r == 16 * rb + i ? 1.f : 0.f;
        if (rb == 1) {
#pragma unroll 4
            for (int j = 0; j < 16; ++j) {
                float tj = M[(base + j) * 64 + base + r]; tj = r <= j ? tj : 0.f;
                const LAS f32x4* ar = (const LAS f32x4*)(M + (base + j) * 64 + base + 16);
                const f32x4 a0 = ar[0], a1 = ar[1], a2 = ar[2], a3 = ar[3];
#pragma unroll
                for (int e = 0; e < 4; ++e) { acc[e] -= a0[e] * tj; acc[4 + e] -= a1[e] * tj; acc[8 + e] -= a2[e] * tj; acc[12 + e] -= a3[e] * tj; }
            }
        }
#pragma unroll
        for (int j = 0; j < 16; ++j) {
            const float tj = acc[j]; const int row = base + 16 * rb + j;
            const LAS f32x4* ar = (const LAS f32x4*)(M + row * 64 + base + 16 * rb);
            float a[16];
#pragma unroll
            for (int q = j >> 2; q < 4; ++q) { const f32x4 v = ar[q]; a[4 * q] = v[0]; a[4 * q + 1] = v[1]; a[4 * q + 2] = v[2]; a[4 * q + 3] = v[3]; }
            if (r <= 16 * rb + j) M[row * 64 + base + r] = tj;
#pragma unroll
            for (int i = j + 1; i < 16; ++i) acc[i] -= a[i] * tj;
        }
        asm volatile("" ::: "memory");
    }
    LDS_WAIT(); asm volatile("" ::: "memory");
    f32x16 X;
#pragma unroll
    for (int e = 0; e < 16; ++e) X[e] = 0.f;
#pragma unroll
    for (int s2 = 0; s2 < 16; ++s2) { const int k = 2 * s2 + hh; const float a = M[k * 64 + 32 + r]; float bb = M[k * 64 + r]; bb = r <= k ? bb : 0.f;
        X = __builtin_amdgcn_mfma_f32_32x32x2f32(a, bb, X, 0, 0, 0); }
#pragma unroll
    for (int reg = 0; reg < 16; ++reg) M[crow16(reg, hh) * 64 + 32 + r] = X[reg];
    LDS_WAIT(); asm volatile("" ::: "memory");
    f32x16 Y;
#pragma unroll
    for (int e = 0; e < 16; ++e) Y[e] = 0.f;
#pragma unroll
    for (int s2 = 0; s2 < 16; ++s2) { const int k = 2 * s2 + hh; float a = M[(32 + r) * 64 + 32 + k]; a = k <= r ? a : 0.f; const float bb = M[k * 64 + 32 + r];
        Y = __builtin_amdgcn_mfma_f32_32x32x2f32(a, bb, Y, 0, 0, 0); }
#pragma unroll
    for (int reg = 0; reg < 16; ++reg) M[(32 + crow16(reg, hh)) * 64 + r] = -Y[reg];
    LDS_WAIT(); asm volatile("" ::: "memory");
#pragma unroll
    for (int f = 0; f < 8; ++f) { const int rb = f >> 2, ks = f & 3, row = 32 * rb + r, k0 = 16 * ks + 4 * hh;
        f32x4 lo = *(const LAS f32x4*)(M + row * 64 + k0), hi = *(const LAS f32x4*)(M + row * 64 + k0 + 8);
#pragma unroll
        for (int e = 0; e < 4; ++e) { lo[e] = k0 + e <= row ? lo[e] : 0.f; hi[e] = k0 + 8 + e <= row ? hi[e] : 0.f; }
        st16_sc1(slot + SL_T + ((rb * 4 + ks) * 64 + lane) * 16, pack8f(lo, hi)); }
    LDS_WAIT();
    asm volatile("s_waitcnt vmcnt(0)" ::: "memory");
    if (lane == 0) __hip_atomic_store(item_granule(A, item), ((unsigned long long)ep << 32) | (unsigned long long)__float_as_uint(gcl), __ATOMIC_RELAXED, __HIP_MEMORY_SCOPE_AGENT);
}
DI void scan_seq(KA A, int seq, int w, int lane, unsigned ep) {
    const int r = lane & 31, hh = lane >> 5, dv = 32 * w + r;
    const bool sample = seq >= N_PROMPT_SEQ; const int sidx = sample ? seq - N_PROMPT_SEQ : seq, b = sidx >> 2, h = sidx & 3, nch = sample ? 1 : CHUNKS_P;
    f32x16 S[4];
    if (sample) {
        const float* S0 = A->state_delta + ((size_t)(b * 4 + h) * 128) * 128 + dv;
#pragma unroll
        for (int kb = 0; kb < 4; ++kb)
#pragma unroll
            for (int reg = 0; reg < 16; ++reg) S[kb][reg] = S0[(size_t)(32 * kb + crow16(reg, hh)) * 128];
    } else {
#pragma unroll
        for (int kb = 0; kb < 4; ++kb)
#pragma unroll
            for (int reg = 0; reg < 16; ++reg) S[kb][reg] = 0.f;
    }
    bf16* OBR = (bf16*)((unsigned char*)A->out + DO_OB);
#pragma unroll 1
    for (int c = 0; c < nch; ++c) {
        const int item = sample ? N_ITEMS_P + sidx : seq * CHUNKS_P + c;
        const unsigned char* slot = slot_ptr(A, item);
        const float gcl = wait_item(item_granule(A, item), ep);
        __builtin_amdgcn_fence(__ATOMIC_ACQUIRE, "agent");
        const bf16x8* bek = (const bf16x8*)(slot + SL_BEK) + lane; const bf16x8* tp = (const bf16x8*)(slot + SL_T) + lane;
        const bf16x8* qe = (const bf16x8*)(slot + SL_QE) + lane; const bf16x8* qkd = (const bf16x8*)(slot + SL_QKD) + lane; const bf16x8* kwt = (const bf16x8*)(slot + SL_KWT) + lane;
        bf16x8 sf[8];
#pragma unroll
        for (int kb = 0; kb < 4; ++kb) { sf[2 * kb] = pack_step<0>(S[kb]); sf[2 * kb + 1] = pack_step<1>(S[kb]); }
        f32x16 x0, x1;
#pragma unroll
        for (int e = 0; e < 16; ++e) { x0[e] = 0.f; x1[e] = 0.f; }
#pragma unroll
        for (int ks = 0; ks < 8; ++ks) { x0 = MFMA32(bek[ks * 64], sf[ks], x0); x1 = MFMA32(bek[(8 + ks) * 64], sf[ks], x1); }
        {
            const u32x4* bv = (const u32x4*)(slot + SL_BV) + ((w * 2) * 64 + lane) * 2;
            const u32x4 a0 = bv[0], a1 = bv[1], c0 = bv[128], c1 = bv[129];
            x0[0] = bflo(a0.x) - x0[0]; x0[1] = bfhi(a0.x) - x0[1]; x0[2] = bflo(a0.y) - x0[2]; x0[3] = bfhi(a0.y) - x0[3];
            x0[4] = bflo(a0.z) - x0[4]; x0[5] = bfhi(a0.z) - x0[5]; x0[6] = bflo(a0.w) - x0[6]; x0[7] = bfhi(a0.w) - x0[7];
            x0[8] = bflo(a1.x) - x0[8]; x0[9] = bfhi(a1.x) - x0[9]; x0[10] = bflo(a1.y) - x0[10]; x0[11] = bfhi(a1.y) - x0[11];
            x0[12] = bflo(a1.z) - x0[12]; x0[13] = bfhi(a1.z) - x0[13]; x0[14] = bflo(a1.w) - x0[14]; x0[15] = bfhi(a1.w) - x0[15];
            x1[0] = bflo(c0.x) - x1[0]; x1[1] = bfhi(c0.x) - x1[1]; x1[2] = bflo(c0.y) - x1[2]; x1[3] = bfhi(c0.y) - x1[3];
            x1[4] = bflo(c0.z) - x1[4]; x1[5] = bfhi(c0.z) - x1[5]; x1[6] = bflo(c0.w) - x1[6]; x1[7] = bfhi(c0.w) - x1[7];
            x1[8] = bflo(c1.x) - x1[8]; x1[9] = bfhi(c1.x) - x1[9]; x1[10] = bflo(c1.y) - x1[10]; x1[11] = bfhi(c1.y) - x1[11];
            x1[12] = bflo(c1.z) - x1[12]; x1[13] = bfhi(c1.z) - x1[13]; x1[14] = bflo(c1.w) - x1[14]; x1[15] = bfhi(c1.w) - x1[15];
        }
        bf16x8 rf[4] = {pack_step<0>(x0), pack_step<1>(x0), pack_step<0>(x1), pack_step<1>(x1)};
        f32x16 u0, u1;
#pragma unroll
        for (int e = 0; e < 16; ++e) { u0[e] = 0.f; u1[e] = 0.f; }
        u0 = MFMA32(tp[0 * 64], rf[0], u0); u0 = MFMA32(tp[1 * 64], rf[1], u0);
#pragma unroll
        for (int ks = 0; ks < 4; ++ks) u1 = MFMA32(tp[(4 + ks) * 64], rf[ks], u1);
        bf16x8 uf[4] = {pack_step<0>(u0), pack_step<1>(u0), pack_step<0>(u1), pack_step<1>(u1)};
        if (sample || c > 0) {
#pragma unroll
            for (int e = 0; e < 16; ++e) { x0[e] = 0.f; x1[e] = 0.f; }
#pragma unroll
            for (int ks = 0; ks < 8; ++ks) { x0 = MFMA32(qe[ks * 64], sf[ks], x0); x1 = MFMA32(qe[(8 + ks) * 64], sf[ks], x1); }
            x0 = MFMA32(qkd[0 * 64], uf[0], x0); x0 = MFMA32(qkd[1 * 64], uf[1], x0);
#pragma unroll
            for (int ks = 0; ks < 4; ++ks) x1 = MFMA32(qkd[(4 + ks) * 64], uf[ks], x1);
            const int crow0 = sample ? NBATCH * SEQ + b * TS : b * SEQ + 64 * (c - 1), L = sample ? TS : 64;
#pragma unroll
            for (int reg = 0; reg < 16; ++reg) { const int i0 = crow16(reg, hh), i1 = 32 + i0;
                if (i0 < L) OBR[(size_t)(crow0 + i0) * 512 + h * 128 + dv] = f2bf(x0[reg]);
                if (i1 < L) OBR[(size_t)(crow0 + i1) * 512 + h * 128 + dv] = f2bf(x1[reg]); }
        }
#pragma unroll
        for (int kb = 0; kb < 4; ++kb) {
            S[kb] = S[kb] * gcl;
#pragma unroll
            for (int ks = 0; ks < 4; ++ks) S[kb] = MFMA32(kwt[(kb * 4 + ks) * 64], uf[ks], S[kb]);
        }
    }
    float* So = A->out + (sample ? O_DS : O_DP) + ((size_t)(b * 4 + h) * 128) * 128 + dv;
#pragma unroll
    for (int kb = 0; kb < 4; ++kb)
#pragma unroll
        for (int reg = 0; reg < 16; ++reg) So[(size_t)(32 * kb + crow16(reg, hh)) * 128] = S[kb][reg];
}

constexpr int HALF_BYTES = 40960;
DI void scan_prompt_wg(KA A, int seq, LAS unsigned char* lds, unsigned ep) {
    const int tid = threadIdx.x, lane = tid & 63, wave = __builtin_amdgcn_readfirstlane(tid >> 6);
    const int b = seq >> 2, h = seq & 3;
    constexpr int N = 2 * CHUNKS_P;
    if (wave >= 4) {
        const int loff = (wave - 4) * 10240 + lane * 16;
        u32x4 r0[10], r1[10];
        LAS u32x4* d0 = (LAS u32x4*)(lds + loff); LAS u32x4* d1 = (LAS u32x4*)(lds + HALF_BYTES + loff);
        LAS float* gclw = (LAS float*)(lds + 2 * HALF_BYTES);
#define SCAN_LOAD(n, R) do { const int item_ = seq * CHUNKS_P + ((n) >> 1); \
            if (((n) & 1) == 0) { const float g_ = wait_item(item_granule(A, item_), ep); if (wave == 4 && lane == 0) gclw[((n) >> 1) & 3] = g_; } \
            const __amdgpu_buffer_rsrc_t rs_ = __builtin_amdgcn_make_buffer_rsrc((void*)slot_ptr(A, item_), 0, (int)PREP_SLOT, 0x00020000); \
            _Pragma("unroll") for (int q = 0; q < 10; ++q) R[q] = __builtin_bit_cast(u32x4, __builtin_amdgcn_raw_buffer_load_b128(rs_, ((n) & 1) * HALF_BYTES + loff + q * 1024, 0, 16)); } while (0)
        SCAN_LOAD(0, r0);
#pragma unroll
        for (int q = 0; q < 10; ++q) d0[q * 64] = r0[q];
        SCAN_LOAD(1, r1);
        LDS_BARRIER();
#pragma unroll 1
        for (int n = 0; n < N; n += 2) {
            if (n + 2 < N) SCAN_LOAD(n + 2, r0);
#pragma unroll
            for (int q = 0; q < 10; ++q) d1[q * 64] = r1[q];
            LDS_BARRIER();
            if (n + 3 < N) SCAN_LOAD(n + 3, r1);
            if (n + 2 < N) {
#pragma unroll
                for (int q = 0; q < 10; ++q) d0[q * 64] = r0[q]; }
            LDS_BARRIER();
        }
#undef SCAN_LOAD
    } else {
        const int w = wave, r = lane & 31, hh = lane >> 5, dv = 32 * w + r;
        f32x16 S[4];
#pragma unroll
        for (int kb = 0; kb < 4; ++kb)
#pragma unroll
            for (int reg = 0; reg < 16; ++reg) S[kb][reg] = 0.f;
        bf16* OBR = (bf16*)((unsigned char*)A->out + DO_OB);
        const LAS float* gclw = (const LAS float*)(lds + 2 * HALF_BYTES);
        const LAS bf16x8* bek = (const LAS bf16x8*)(lds + SL_BEK) + lane; const LAS bf16x8* tp = (const LAS bf16x8*)(lds + SL_T) + lane;
        const LAS u32x4* bv = (const LAS u32x4*)(lds + SL_BV) + ((w * 2) * 64 + lane) * 2;
        const LAS bf16x8* qkd = (const LAS bf16x8*)(lds + HALF_BYTES + (SL_QKD - HALF_BYTES)) + lane; const LAS bf16x8* qe = (const LAS bf16x8*)(lds + HALF_BYTES + (SL_QE - HALF_BYTES)) + lane;
        const LAS bf16x8* kwt = (const LAS bf16x8*)(lds + HALF_BYTES + (SL_KWT - HALF_BYTES)) + lane;
        LDS_BARRIER();
#pragma unroll 1
        for (int c = 0; c < CHUNKS_P; ++c) {
            bf16x8 sf[8];
#pragma unroll
            for (int kb = 0; kb < 4; ++kb) { sf[2 * kb] = pack_step<0>(S[kb]); sf[2 * kb + 1] = pack_step<1>(S[kb]); }
            f32x16 x0, x1;
#pragma unroll
            for (int e = 0; e < 16; ++e) { x0[e] = 0.f; x1[e] = 0.f; }
#pragma unroll
            for (int ks = 0; ks < 8; ++ks) { x0 = MFMA32(bek[ks * 64], sf[ks], x0); x1 = MFMA32(bek[(8 + ks) * 64], sf[ks], x1); }
            {
                const u32x4 a0 = bv[0], a1 = bv[1], c0 = bv[128], c1 = bv[129];
                x0[0] = bflo(a0.x) - x0[0]; x0[1] = bfhi(a0.x) - x0[1]; x0[2] = bflo(a0.y) - x0[2]; x0[3] = bfhi(a0.y) - x0[3];
                x0[4] = bflo(a0.z) - x0[4]; x0[5] = bfhi(a0.z) - x0[5]; x0[6] = bflo(a0.w) - x0[6]; x0[7] = bfhi(a0.w) - x0[7];
                x0[8] = bflo(a1.x) - x0[8]; x0[9] = bfhi(a1.x) - x0[9]; x0[10] = bflo(a1.y) - x0[10]; x0[11] = bfhi(a1.y) - x0[11];
                x0[12] = bflo(a1.z) - x0[12]; x0[13] = bfhi(a1.z) - x0[13]; x0[14] = bflo(a1.w) - x0[14]; x0[15] = bfhi(a1.w) - x0[15];
                x1[0] = bflo(c0.x) - x1[0]; x1[1] = bfhi(c0.x) - x1[1]; x1[2] = bflo(c0.y) - x1[2]; x1[3] = bfhi(c0.y) - x1[3];
                x1[4] = bflo(c0.z) - x1[4]; x1[5] = bfhi(c0.z) - x1[5]; x1[6] = bflo(c0.w) - x1[6]; x1[7] = bfhi(c0.w) - x1[7];
                x1[8] = bflo(c1.x) - x1[8]; x1[9] = bfhi(c1.x) - x1[9]; x1[10] = bflo(c1.y) - x1[10]; x1[11] = bfhi(c1.y) - x1[11];
                x1[12] = bflo(c1.z) - x1[12]; x1[13] = bfhi(c1.z) - x1[13]; x1[14] = bflo(c1.w) - x1[14]; x1[15] = bfhi(c1.w) - x1[15];
            }
            bf16x8 rf[4] = {pack_step<0>(x0), pack_step<1>(x0), pack_step<0>(x1), pack_step<1>(x1)};
            f32x16 u0, u1;
#pragma unroll
            for (int e = 0; e < 16; ++e) { u0[e] = 0.f; u1[e] = 0.f; }
            u0 = MFMA32(tp[0 * 64], rf[0], u0); u0 = MFMA32(tp[1 * 64], rf[1], u0);
#pragma unroll
            for (int ks = 0; ks < 4; ++ks) u1 = MFMA32(tp[(4 + ks) * 64], rf[ks], u1);
            bf16x8 uf[4] = {pack_step<0>(u0), pack_step<1>(u0), pack_step<0>(u1), pack_step<1>(u1)};
            LDS_BARRIER();
            if (c > 0) {
#pragma unroll
                for (int e = 0; e < 16; ++e) { x0[e] = 0.f; x1[e] = 0.f; }
#pragma unroll
                for (int ks = 0; ks < 8; ++ks) { x0 = MFMA32(qe[ks * 64], sf[ks], x0); x1 = MFMA32(qe[(8 + ks) * 64], sf[ks], x1); }
                x0 = MFMA32(qkd[0 * 64], uf[0], x0); x0 = MFMA32(qkd[1 * 64], uf[1], x0);
#pragma unroll
                for (int ks = 0; ks < 4; ++ks) x1 = MFMA32(qkd[(4 + ks) * 64], uf[ks], x1);
                bf16* orow = OBR + (size_t)(b * SEQ + 64 * (c - 1)) * 512 + h * 128 + dv;
#pragma unroll
                for (int reg = 0; reg < 16; ++reg) { const int i0 = crow16(reg, hh); orow[(size_t)i0 * 512] = f2bf(x0[reg]); orow[(size_t)(32 + i0) * 512] = f2bf(x1[reg]); }
            }
            const float gcl = gclw[c & 3];
#pragma unroll
            for (int kb = 0; kb < 4; ++kb) {
                S[kb] = S[kb] * gcl;
#pragma unroll
                for (int ks = 0; ks < 4; ++ks) S[kb] = MFMA32(kwt[(kb * 4 + ks) * 64], uf[ks], S[kb]);
            }
            LDS_BARRIER();
        }
        float* So = A->out + O_DP + ((size_t)(b * 4 + h) * 128) * 128 + dv;
#pragma unroll
        for (int kb = 0; kb < 4; ++kb)
#pragma unroll
            for (int reg = 0; reg < 16; ++reg) So[(size_t)(32 * kb + crow16(reg, hh)) * 128] = S[kb][reg];
    }
}

constexpr int KPITCH = 72, VPITCH = 264;
DI void attn_unit(KA A, int unit, LAS unsigned char* ldsb) {
    const int tid = threadIdx.x, lane = tid & 63, wave = __builtin_amdgcn_readfirstlane(tid >> 6), r = lane & 31, hh = lane >> 5;
    const int b = unit >> 6, kh = (unit >> 5) & 1, jb = unit & 31, T0 = NMETA + 128 * jb;
    LAS bf16* Ksm = (LAS bf16*)ldsb; LAS bf16* VTs = Ksm + 256 * KPITCH;
    const bf16* KVg = (const bf16*)(A->ws + WS_KV); const bf16* QAg = (const bf16*)(A->ws + WS_QA);
#pragma unroll
    for (int e4 = 0; e4 < 4; ++e4) {
        const int id = tid + 512 * e4, key = id >> 3, cch = id & 7, tk = T0 - 128 + key;
        u32x4 kq = (u32x4){0u, 0u, 0u, 0u}, vq = kq;
        if (tk >= 0) { const bf16* src = KVg + (size_t)(b * TP + tk) * 256 + kh * 64 + 8 * cch; kq = *(const u32x4*)src; vq = *(const u32x4*)(src + 128); }
        *(LAS u32x4*)(Ksm + key * KPITCH + 8 * cch) = kq;
        const int kkk = key & 15, pos = (key & ~15) + 8 * ((kkk >> 2) & 1) + (((kkk >> 3) << 2) | (kkk & 3));
        LAS bf16* vd = VTs + (8 * cch) * VPITCH + pos;
        vd[0 * VPITCH] = (bf16)(vq.x & 0xffffu); vd[1 * VPITCH] = (bf16)(vq.x >> 16); vd[2 * VPITCH] = (bf16)(vq.y & 0xffffu); vd[3 * VPITCH] = (bf16)(vq.y >> 16);
        vd[4 * VPITCH] = (bf16)(vq.z & 0xffffu); vd[5 * VPITCH] = (bf16)(vq.z >> 16); vd[6 * VPITCH] = (bf16)(vq.w & 0xffffu); vd[7 * VPITCH] = (bf16)(vq.w >> 16);
    }
    LDS_BARRIER();
    const int g = wave >> 1, qh = wave & 1, head = 4 * kh + g;
    const float sink2 = A->sinks[head] * 1.4426950408889634f;
    const int kmin = jb == 0 ? 128 - NMETA : 0;
#pragma unroll 1
    for (int q2 = 0; q2 < 2; ++q2) {
        const int qb = 2 * qh + q2, iq = 32 * qb + r;
        const bf16* qrow = QAg + (size_t)(b * TP + T0 + iq) * 512 + head * 64 + 8 * hh;
        bf16x8 qf[4];
#pragma unroll
        for (int s = 0; s < 4; ++s) qf[s] = *(const bf16x8*)(qrow + 16 * s);
        f32x16 st[5];
        float m = sink2;
#pragma unroll
        for (int kt5 = 0; kt5 < 5; ++kt5) {
            const int kt = qb + kt5;
            f32x16 acc;
#pragma unroll
            for (int e = 0; e < 16; ++e) acc[e] = 0.f;
#pragma unroll
            for (int s = 0; s < 4; ++s) acc = MFMA32(*(const LAS bf16x8*)(Ksm + (32 * kt + r) * KPITCH + 16 * s + 8 * hh), qf[s], acc);
#pragma unroll
            for (int reg = 0; reg < 16; ++reg) { const int kk = 32 * kt + crow16(reg, hh); const bool ok = kk >= iq && kk <= iq + 128 && kk >= kmin;
                acc[reg] = ok ? acc[reg] : -INFINITY; m = fmaxf(m, acc[reg]); }
            st[kt5] = acc;
        }
        m = fmaxf(m, __shfl_xor(m, 32));
        float l = 0.f;
#pragma unroll
        for (int kt5 = 0; kt5 < 5; ++kt5)
#pragma unroll
            for (int reg = 0; reg < 16; ++reg) { const float p = exp2f(st[kt5][reg] - m); st[kt5][reg] = p; l += p; }
        l += __shfl_xor(l, 32); l += exp2f(sink2 - m);
        f32x16 o0, o1;
#pragma unroll
        for (int e = 0; e < 16; ++e) { o0[e] = 0.f; o1[e] = 0.f; }
#pragma unroll
        for (int kt5 = 0; kt5 < 5; ++kt5) {
            const int kt = qb + kt5;
            const bf16x8 p0 = pack_step<0>(st[kt5]), p1 = pack_step<1>(st[kt5]);
            const LAS bf16* vb = VTs + r * VPITCH + 32 * kt + 8 * hh;
            o0 = MFMA32(*(const LAS bf16x8*)(vb), p0, o0); o0 = MFMA32(*(const LAS bf16x8*)(vb + 16), p1, o0);
            o1 = MFMA32(*(const LAS bf16x8*)(vb + 32 * VPITCH), p0, o1); o1 = MFMA32(*(const LAS bf16x8*)(vb + 32 * VPITCH + 16), p1, o1);
        }
        const float rl = 1.0f / l;
        bf16* orow = (bf16*)((unsigned char*)A->out + DO_OA) + (size_t)(b * SEQ + 128 * jb + iq) * 512 + head * 64 + 4 * hh;
#pragma unroll
        for (int g4 = 0; g4 < 4; ++g4) {
            *(u32x2*)(orow + 8 * g4) = (u32x2){cvtpk(o0[4 * g4] * rl, o0[4 * g4 + 1] * rl), cvtpk(o0[4 * g4 + 2] * rl, o0[4 * g4 + 3] * rl)};
            *(u32x2*)(orow + 32 + 8 * g4) = (u32x2){cvtpk(o1[4 * g4] * rl, o1[4 * g4 + 1] * rl), cvtpk(o1[4 * g4 + 2] * rl, o1[4 * g4 + 3] * rl)};
        }
    }
    LDS_BARRIER();
}
DI void sample_attn(KA A, int b, int head, LAS float* wl, int lane) {
    const int kh = head >> 2;
    LAS float* qn = wl; LAS float* ps = wl + 256;
    const bf16* QAg = (const bf16*)(A->ws + WS_QA); const bf16* KVg = (const bf16*)(A->ws + WS_KV);
#pragma unroll
    for (int i = 0; i < 4; ++i) qn[i * 64 + lane] = bf2f(QAg[(size_t)(MP + b * TS + i) * 512 + head * 64 + pos_of_d(lane)]);
    LDS_WAIT(); asm volatile("" ::: "memory");
    const float sink2 = A->sinks[head] * 1.4426950408889634f;
#pragma unroll 1
    for (int kq = 0; kq < 3; ++kq) {
        const int kj = lane + 64 * kq;
        float sc0 = 0.f, sc1 = 0.f, sc2 = 0.f, sc3 = 0.f;
        if (kj < 128) {
            const f32x4* kr = (const f32x4*)(A->cache_k + ((size_t)(b * 128 + kj) * 2 + kh) * 64);
#pragma unroll 4
            for (int d4 = 0; d4 < 16; ++d4) { const f32x4 kv = kr[d4];
                const f32x4 q0 = *(const LAS f32x4*)(qn + 4 * d4), q1 = *(const LAS f32x4*)(qn + 64 + 4 * d4), q2 = *(const LAS f32x4*)(qn + 128 + 4 * d4), q3 = *(const LAS f32x4*)(qn + 192 + 4 * d4);
                sc0 += (kv[0] * q0[0] + kv[1] * q0[1]) + (kv[2] * q0[2] + kv[3] * q0[3]); sc1 += (kv[0] * q1[0] + kv[1] * q1[1]) + (kv[2] * q1[2] + kv[3] * q1[3]);
                sc2 += (kv[0] * q2[0] + kv[1] * q2[1]) + (kv[2] * q2[2] + kv[3] * q2[3]); sc3 += (kv[0] * q3[0] + kv[1] * q3[1]) + (kv[2] * q3[2] + kv[3] * q3[3]); }
        } else if (kj < 132) {
            const bf16* kr = KVg + (size_t)(MP + b * TS + (kj - 128)) * 256 + kh * 64;
#pragma unroll 4
            for (int p = 0; p < 64; ++p) { const float kv = bf2f(kr[p]); const int d = d_of_pos(p);
                sc0 += kv * qn[d]; sc1 += kv * qn[64 + d]; sc2 += kv * qn[128 + d]; sc3 += kv * qn[192 + d]; }
        }
        if (kj < 132) {
            ps[0 * 132 + kj] = (kj >= 0 && kj <= 128) ? sc0 : -INFINITY; ps[1 * 132 + kj] = (kj >= 1 && kj <= 129) ? sc1 : -INFINITY;
            ps[2 * 132 + kj] = (kj >= 2 && kj <= 130) ? sc2 : -INFINITY; ps[3 * 132 + kj] = (kj >= 3 && kj <= 131) ? sc3 : -INFINITY; }
    }
    LDS_WAIT(); asm volatile("" ::: "memory");
    float linv[4];
#pragma unroll
    for (int i = 0; i < 4; ++i) {
        const float s0 = ps[i * 132 + lane], s1 = ps[i * 132 + 64 + lane], s2 = lane < 4 ? ps[i * 132 + 128 + lane] : -INFINITY;
        const float m = wave_max(fmaxf(fmaxf(s0, s1), fmaxf(s2, sink2)));
        const float p0 = exp2f(s0 - m), p1 = exp2f(s1 - m), p2 = exp2f(s2 - m);
        ps[i * 132 + lane] = p0; ps[i * 132 + 64 + lane] = p1; if (lane < 4) ps[i * 132 + 128 + lane] = p2;
        linv[i] = 1.0f / (wave_sum(p0 + p1 + p2) + exp2f(sink2 - m));
    }
    LDS_WAIT(); asm volatile("" ::: "memory");
    float o[4] = {0.f, 0.f, 0.f, 0.f};
#pragma unroll 4
    for (int kj = 0; kj < 128; ++kj) { const float v = A->cache_v[((size_t)(b * 128 + kj) * 2 + kh) * 64 + lane];
#pragma unroll
        for (int i = 0; i < 4; ++i) o[i] += ps[i * 132 + kj] * v; }
#pragma unroll
    for (int kj = 128; kj < 132; ++kj) { const float v = bf2f(KVg[(size_t)(MP + b * TS + (kj - 128)) * 256 + 128 + kh * 64 + lane]);
#pragma unroll
        for (int i = 0; i < 4; ++i) o[i] += ps[i * 132 + kj] * v; }
    bf16* OAg = (bf16*)((unsigned char*)A->out + DO_OA);
#pragma unroll
    for (int i = 0; i < 4; ++i) OAg[(size_t)(NBATCH * SEQ + b * TS + i) * 512 + head * 64 + lane] = f2bf(o[i] * linv[i]);
    LDS_WAIT(); asm volatile("" ::: "memory");
}
constexpr int NINV_WG = 24;
DI void p23_mixers(KA A, LAS unsigned char* lds, const XcdBarrier& dbg_bar, unsigned ep, int pmode = 0) {
    const int tid = threadIdx.x, lane = tid & 63, wave = __builtin_amdgcn_readfirstlane(tid >> 6), G = gridDim.x, wg = blockIdx.x;
    const int NSCAN = N_PROMPT_SEQ, NP = G - NSCAN - NINV_WG;
    if (wg < NSCAN) { if (!(pmode & 2)) scan_prompt_wg(A, wg, lds, ep); return; }
    if (wg < NSCAN + NINV_WG) {
        const int wv = (wg - NSCAN) * NWAVES + wave, NWV = NINV_WG * NWAVES;
#pragma unroll 1
        for (int m = wv; m < N_ITEMS; m += NWV) {
            const int item = order_item(m), p = m % NP, k = m / NP;
            const float gcl = wait_item(item_flag1(A, item), ep);
            __builtin_amdgcn_fence(__ATOMIC_ACQUIRE, "agent");
            const float* ats = (const float*)((const unsigned char*)A->out + DO_ATS + ((size_t)p * 8 + (k & 7)) * ATS_ITEM);
            if (pmode & 16) { if (lane == 0) __hip_atomic_store(item_granule(A, item), ((unsigned long long)ep << 32), __ATOMIC_RELAXED, __HIP_MEMORY_SCOPE_AGENT); }
            else prep_stage2(A, item, gcl, ats, (LAS float*)(lds + wave * 16384), ep);
        }
        return;
    }
    const int p = wg - NSCAN - NINV_WG;
    {
        const int ntot = p < N_ITEMS ? (N_ITEMS - 1 - p) / NP + 1 : 0;
        S1Pre P;
        if (ntot > 0) stage1_issue(A, order_item(p), P);
        int prev = -1;
#pragma unroll 1
        for (int k = 0; k < ntot; ++k) {
            const int m = p + NP * k, item = order_item(m), nxt = k + 1 < ntot ? order_item(m + NP) : N_ITEMS;
            float* ats = (float*)((unsigned char*)A->out + DO_ATS + ((size_t)p * 8 + (k & 7)) * ATS_ITEM);
            prep_stage1(A, item, nxt, prev, k >= 8 ? order_item(m - 8 * NP) : -1, k & 1, ats, P, lds, ep, pmode);
            prev = item;
        }
        asm volatile("s_waitcnt vmcnt(0)" ::: "memory"); __syncthreads();
        if (prev >= 0 && tid == 0) __hip_atomic_store(item_flag1(A, prev), ((unsigned long long)ep << 32) | (unsigned long long)__float_as_uint(((const LAS float*)(lds + LDS_GCL))[(ntot - 1) & 1]), __ATOMIC_RELAXED, __HIP_MEMORY_SCOPE_AGENT);
    }
    if (pmode & 1) return;
    for (int u = p; u < NBATCH * NKV * 32; u += NP) attn_unit(A, u, lds);
    const int worker = p * NWAVES + wave, NW = NP * NWAVES;
    LAS float* wl = (LAS float*)(lds + 98304 + wave * 4096);
    for (int it = worker; it < SBATCH * NHB * 4 + SBATCH * NHA; it += NW) {
        if (it < SBATCH * NHB * 4) scan_seq(A, N_PROMPT_SEQ + (it >> 2), it & 3, lane, ep);
        else { const int q = it - SBATCH * NHB * 4; sample_attn(A, q >> 3, q & 7, wl, lane); }
    }
}

DI void p3b_gated_norm(KA A) {
    const int tid = threadIdx.x, lane = tid & 63, wave = tid >> 6, gw = blockIdx.x * NWAVES + wave, NGW = gridDim.x * NWAVES;
    const int head = lane >> 4, dv0 = 8 * (lane & 15);
    const f32x4 w0 = *(const f32x4*)(A->gdn_norm + dv0), w1 = *(const f32x4*)(A->gdn_norm + dv0 + 4);
    bf16* OBg = (bf16*)((unsigned char*)A->out + DO_OB); const bf16* Zg = (const bf16*)(A->ws + WS_Z);
    for (int crow = gw; crow < MC; crow += NGW) {
        const u32x4 ow = *(const u32x4*)(OBg + (size_t)crow * 512 + head * 128 + dv0);
        const f32x4 a = {bflo(ow.x), bfhi(ow.x), bflo(ow.y), bfhi(ow.y)}, c = {bflo(ow.z), bfhi(ow.z), bflo(ow.w), bfhi(ow.w)};
        float ss = (a[0] * a[0] + a[1] * a[1]) + (a[2] * a[2] + a[3] * a[3]) + (c[0] * c[0] + c[1] * c[1]) + (c[2] * c[2] + c[3] * c[3]);
        ss += __shfl_xor(ss, 1); ss += __shfl_xor(ss, 2); ss += __shfl_xor(ss, 4); ss += __shfl_xor(ss, 8);
        const float rstd = rsqrtf(ss * (1.0f / 128.0f) + EPS);
        const u32x4 zw = *(const u32x4*)(Zg + (size_t)pg8::crow_to_urow(crow) * 512 + head * 128 + dv0);
        f32x4 y0, y1;
        y0[0] = a[0] * rstd * w0[0] * siluf_(bflo(zw.x)); y0[1] = a[1] * rstd * w0[1] * siluf_(bfhi(zw.x)); y0[2] = a[2] * rstd * w0[2] * siluf_(bflo(zw.y)); y0[3] = a[3] * rstd * w0[3] * siluf_(bfhi(zw.y));
        y1[0] = c[0] * rstd * w1[0] * siluf_(bflo(zw.z)); y1[1] = c[1] * rstd * w1[1] * siluf_(bfhi(zw.z)); y1[2] = c[2] * rstd * w1[2] * siluf_(bflo(zw.w)); y1[3] = c[3] * rstd * w1[3] * siluf_(bfhi(zw.w));
        *(u32x4*)(OBg + (size_t)crow * 512 + head * 128 + dv0) = pack8f(y0, y1);
    }
}
DI void p8_final_norm(KA A) {
    const int tid = threadIdx.x, lane = tid & 63, wave = tid >> 6, gw = blockIdx.x * NWAVES + wave, NGW = gridDim.x * NWAVES;
    f32x4 nf[4];
#pragma unroll
    for (int j = 0; j < 4; ++j) nf[j] = ((const f32x4*)A->norm_final)[lane + 64 * j];
    for (int crow = gw; crow < MC; crow += NGW) {
        f32x4* row = (f32x4*)(A->out + (size_t)crow * D);
        f32x4 v[4]; float ss = 0.f;
#pragma unroll
        for (int j = 0; j < 4; ++j) { v[j] = row[lane + 64 * j]; ss += (v[j][0] * v[j][0] + v[j][1] * v[j][1]) + (v[j][2] * v[j][2] + v[j][3] * v[j][3]); }
        const float rstd = rsqrtf(wave_sum(ss) * (1.0f / D) + EPS);
#pragma unroll
        for (int j = 0; j < 4; ++j) row[lane + 64 * j] = v[j] * rstd * nf[j];
    }
}
__global__ void __launch_bounds__(NTHREADS, 2) hybrid_fwd(Args Aval) {
    extern __shared__ __attribute__((aligned(16))) unsigned char lds_raw[];
    LAS unsigned char* lds = (LAS unsigned char*)lds_raw;
    const int tid = threadIdx.x;
    int lo, hi; { KA A0 = kargs(); lo = A0->ph_lo; hi = A0->ph_hi; }
#if MK_N_LAUNCHES == 1
#if MK_BARRIER == 1
    volatile LAS unsigned* MISC = (volatile LAS unsigned*)(lds + LDS_MISC);
    if (tid < 64) MISC[tid] = 0u;
    __syncthreads();
    XcdBarrier bar; { KA A0 = kargs(); bar = xcd_barrier_post((unsigned*)(A0->ws + WS_CTL) + 4096, MISC + 8); }
#define GRID_BAR() xcd_barrier(bar)
#else
    cg::grid_group grid = cg::this_grid();
#define GRID_BAR() grid.sync()
#endif
#else
#define GRID_BAR() do {} while (0)
#endif
#ifndef PH_MASK
#define PH_MASK 0x1ff
#endif
#define IN(k) (((PH_MASK >> (k)) & 1) && lo <= (k) && (k) < hi)
#ifndef PROBE_REP
#define PROBE_REP -1
#endif
#define NREP(k) (PROBE_REP == (k) ? 2 : 1)
#define SEAM(k) do { if (IN(k) && IN((k) + 1)) GRID_BAR(); } while (0)
    const int G = gridDim.x, wgid = blockIdx.x;
#if PROBE_REP == 0
    if (IN(0)) { KA A = kargs(); p0_prologue(A, lds); __syncthreads(); }
#endif
    if (IN(0)) { KA A = kargs(); p0_prologue(A, lds); } SEAM(0);
    if (IN(1)) for (int rep = 0; rep < NREP(1); ++rep) { KA A = kargs(); unsigned char* ws = A->ws;
        pg8::Gemm g{(const bf16*)(ws + WS_XN), (const bf16*)(ws + WS_WIN), MUP, NIN, D}; pg8::StaticOrder S; S.init(MUP, NIN, G, wgid);
        pg8::EpiInProj E{(bf16*)(ws + WS_QA), (bf16*)(ws + WS_KV), (bf16*)(ws + WS_QKVB), (bf16*)(ws + WS_Z), (bf16*)(ws + WS_G),
                         (const float*)(ws + WS_ROPE), (const float*)(ws + WS_ROPE) + (TP + TS) * 32, A->out};
        pg8::gemm_phase<pg8::EpiInProj, pg8::StaticOrder, true, true>(lds, g, S, E);
    } SEAM(1);
#ifndef PROBE_MODE
#define PROBE_MODE 0
#endif
#if PROBE_REP == 2
    if (IN(2)) { KA A = kargs(); p23_mixers(A, lds, bar, 1u); GRID_BAR(); }
    if (IN(2)) { KA A = kargs(); p23_mixers(A, lds, bar, 2u, PROBE_MODE); } SEAM(2);
#else
    if (IN(2)) { KA A = kargs(); p23_mixers(A, lds, bar, 1u); } SEAM(2);
#endif
    if (IN(3)) for (int rep = 0; rep < NREP(3); ++rep) { KA A = kargs(); p3b_gated_norm(A); } SEAM(3);
    if (IN(4)) for (int rep = 0; rep < NREP(4); ++rep) { KA A = kargs(); unsigned char* ws = A->ws;
        const bf16* OAp = (const bf16*)((unsigned char*)A->out + DO_OA); const bf16* OBp = (const bf16*)((unsigned char*)A->out + DO_OB);
        { pg8::Gemm g{OAp, (const bf16*)(ws + WS_WOA), MC, D, 512}; pg8::StaticOrder S; S.init(MC, D, G, wgid); S.lim = (S.nwg / G) * G;
          pg8::EpiMerge<false> E{(bf16*)(ws + WS_MB), (const bf16*)(ws + WS_G), 0};
          pg8::gemm_phase<pg8::EpiMerge<false>, pg8::StaticOrder, true, true>(lds, g, S, E); }
        asm volatile("s_waitcnt vmcnt(0)" ::: "memory"); __syncthreads();
        { pg8::Gemm g{OBp, (const bf16*)(ws + WS_WOB), MC, D, 512}; pg8::StaticOrder S; S.init(MC, D, G, wgid); S.lim = (S.nwg / G) * G;
          pg8::EpiMerge<true> E{(bf16*)(ws + WS_MB), (const bf16*)(ws + WS_G), 1024};
          pg8::gemm_phase<pg8::EpiMerge<true>, pg8::StaticOrder, true, true>(lds, g, S, E); }
        { const int nstr = (MC / 256) * 4 - ((MC / 256) * 4 / G) * G;
          if (wgid < nstr * 4) { const int t = wgid >> 2, sl = wgid & 3, isb = sl >> 1, koff = (sl & 1) * 256;
            pg8::Gemm g{(isb ? OBp : OAp) + koff, (const bf16*)(ws + (isb ? WS_WOB : WS_WOA)) + koff, MC, D, 256, 512};
            pg8::SliceOrder S; S.init_slice(MC, D, G, ((MC / 256) * 4 / G) * G, t);
            pg8::EpiSplit<pg8::EpiStoreMB, true> E{pg8::EpiStoreMB{(bf16*)(ws + WS_MB)}, (float*)(ws + WS_SCR) + (size_t)t * 65536, (unsigned*)(ws + WS_CTL + CTL_SPL) + t * 8, 4u, (const bf16*)(ws + WS_G), isb ? 1024 : 0};
            pg8::gemm_phase<pg8::EpiSplit<pg8::EpiStoreMB, true>, pg8::SliceOrder, true, true>(lds, g, S, E); } }
    } SEAM(4);
    if (IN(5)) { KA A = kargs(); unsigned char* ws = A->ws;
        { pg8::Gemm g{(const bf16*)(ws + WS_MB), (const bf16*)(ws + WS_WOUT), MC, D, D}; pg8::StaticOrder S; S.init(MC, D, G, wgid); S.lim = (S.nwg / G) * G;
          pg8::EpiWout<true> E{A->x_prompt, A->x_sample, (bf16*)(ws + WS_HB1), (float*)(ws + WS_CTL + CTL_SS1)};
          pg8::gemm_phase<pg8::EpiWout<true>, pg8::StaticOrder, true, true>(lds, g, S, E); }
        { const int nstr = (MC / 256) * 4 - ((MC / 256) * 4 / G) * G;
          if (wgid < nstr * 4) { const int t = wgid >> 2, koff = (wgid & 3) * 256;
            pg8::Gemm g{(const bf16*)(ws + WS_MB) + koff, (const bf16*)(ws + WS_WOUT) + koff, MC, D, 256, D};
            pg8::SliceOrder S; S.init_slice(MC, D, G, ((MC / 256) * 4 / G) * G, t);
            pg8::EpiSplit<pg8::EpiWout<true>, false> E{pg8::EpiWout<true>{A->x_prompt, A->x_sample, (bf16*)(ws + WS_HB1), (float*)(ws + WS_CTL + CTL_SS1)}, (float*)(ws + WS_SCR) + (size_t)t * 65536, (unsigned*)(ws + WS_CTL + CTL_SPL) + t * 8, 4u, nullptr, 0};
            pg8::gemm_phase<pg8::EpiSplit<pg8::EpiWout<true>, false>, pg8::SliceOrder, true, true>(lds, g, S, E); } }
    } SEAM(5);
    if (IN(6)) for (int rep = 0; rep < NREP(6); ++rep) { KA A = kargs(); unsigned char* ws = A->ws;
        pg8::Gemm g{(const bf16*)(ws + WS_HB1), (const bf16*)(ws + WS_WGU), MC, 2 * DFF, D}; pg8::StaticOrder S; S.init(MC, 2 * DFF, G, wgid);
        pg8::EpiGateUp E{(bf16*)(ws + WS_ACT), (const float*)(ws + WS_CTL + CTL_SS1)};
        pg8::gemm_phase<pg8::EpiGateUp, pg8::StaticOrder, true, true>(lds, g, S, E);
    } SEAM(6);
    if (IN(7)) for (int rep = 0; rep < NREP(7); ++rep) { KA A = kargs(); unsigned char* ws = A->ws;
        { pg8::Gemm g{(const bf16*)(ws + WS_ACT), (const bf16*)(ws + WS_WD), MC, D, DFF}; pg8::StaticOrder S; S.init(MC, D, G, wgid); S.lim = (S.nwg / G) * G;
          pg8::EpiDown<false> E{(const bf16*)(ws + WS_HB1), A->out};
          pg8::gemm_phase<pg8::EpiDown<false>, pg8::StaticOrder, true, true>(lds, g, S, E); }
        { const int nstr = (MC / 256) * 4 - ((MC / 256) * 4 / G) * G;
          if (wgid < nstr * 11) { const int t = wgid / 11, koff = (wgid % 11) * 256;
            pg8::Gemm g{(const bf16*)(ws + WS_ACT) + koff, (const bf16*)(ws + WS_WD) + koff, MC, D, 256, DFF};
            pg8::SliceOrder S; S.init_slice(MC, D, G, ((MC / 256) * 4 / G) * G, t);
            pg8::EpiSplit<pg8::EpiDown<false>, false> E{pg8::EpiDown<false>{(const bf16*)(ws + WS_HB1), A->out}, (float*)(ws + WS_SCR) + (size_t)t * 65536, (unsigned*)(ws + WS_CTL + CTL_SPL) + t * 8, 11u, nullptr, 0};
            pg8::gemm_phase<pg8::EpiSplit<pg8::EpiDown<false>, false>, pg8::SliceOrder, true, true>(lds, g, S, E); } }
    } SEAM(7);
    if (IN(8)) { KA A = kargs(); p8_final_norm(A); }
#undef IN
#undef SEAM
}

extern "C" void kernel_launch(void* const* d_in, const int* in_sizes, int n_in, void* d_out, int out_size, void* d_ws, size_t ws_size, hipStream_t stream) {
    static int grid = 0;
    if (grid == 0) {
        if (n_in != 22 || out_size != (int)O_END || ws_size < WS_END) { fprintf(stderr, "kernel_launch: unexpected problem (n_in %d, out %d, ws %zu)\n", n_in, out_size, ws_size); grid = -1; return; }
        int dev = 0, cus = 0, per_cu = 0;
        if (hipGetDevice(&dev) != hipSuccess || hipDeviceGetAttribute(&cus, hipDeviceAttributeMultiprocessorCount, dev) != hipSuccess) { grid = -1; return; }
        if (hipFuncSetAttribute((const void*)hybrid_fwd, hipFuncAttributeMaxDynamicSharedMemorySize, LDS_BYTES) != hipSuccess) { fprintf(stderr, "kernel_launch: hipFuncSetAttribute failed\n"); grid = -1; return; }
        if (hipOccupancyMaxActiveBlocksPerMultiprocessor(&per_cu, (const void*)hybrid_fwd, NTHREADS, LDS_BYTES) != hipSuccess || per_cu < 1) { fprintf(stderr, "kernel_launch: occupancy query says %d\n", per_cu); per_cu = 1; }
        (void)hipGetLastError();
        grid = cus;
        if (grid > 256) grid = 256;
    }
    if (grid < 0) return;
    (void)hipMemsetAsync((char*)d_ws + WS_CTL, 0, CTL_BYTES, stream);
    (void)hipMemsetAsync((char*)d_ws + WS_SCR, 0, SCR_BYTES, stream);
    Args a{};
    const float** ap = (const float**)&a;
    for (int i = 0; i < 22; ++i) ap[i] = (const float*)d_in[i];
    a.out = (float*)d_out; a.ws = (unsigned char*)d_ws;
#if MK_N_LAUNCHES == 1
    a.ph_lo = 0; a.ph_hi = N_PHASES;
#if MK_BARRIER == 1
    hipLaunchKernelGGL(hybrid_fwd, dim3(grid), dim3(NTHREADS), LDS_BYTES, stream, a);
#else
    void* args[] = {&a};
    hipError_t e = hipLaunchCooperativeKernel((const void*)hybrid_fwd, dim3(grid), dim3(NTHREADS), args, LDS_BYTES, stream);
    if (e != hipSuccess) fprintf(stderr, "cooperative launch failed: %s (grid %d)\n", hipGetErrorString(e), grid);
#endif
#else
    for (int p = 0; p < N_PHASES; ++p) { a.ph_lo = p; a.ph_hi = p + 1; hipLaunchKernelGGL(hybrid_fwd, dim3(grid), dim3(NTHREADS), LDS_BYTES, stream, a); }
#endif
}
```

```cpp
#include <hip/hip_runtime.h>
#include <hip/hip_cooperative_groups.h>
#include <cstdio>
#include <cstdint>
namespace cg = cooperative_groups;

#ifndef MK_N_LAUNCHES
#define MK_N_LAUNCHES 1
#endif
#ifndef MK_BARRIER
#define MK_BARRIER 1
#endif

constexpr int D = 1024, NBATCH = 8, SEQ = 4096, NMETA = 16, TP = SEQ + NMETA, MP = NBATCH * TP;
constexpr int SBATCH = 128, TS = 4, MS = SBATCH * TS, MU = MP + MS, MUP = 33536, MC = NBATCH * SEQ + MS;
constexpr int PAST = 16384;
constexpr int HD = 64, NHA = 8, NKV = 2;
constexpr int NHB = 4, CONVD = 1536;
constexpr int DFF = 2816, NIN_SRC = 4872, NIN = 4864;
constexpr float EPS = 1e-6f;
constexpr float QSCALE = 0.125f * 1.4426950408889634f;

constexpr size_t MiB = 1u << 20, KiB = 1024;
constexpr size_t WS_CTL = 0, CTL_BYTES = 1 * MiB;
constexpr size_t WS_WIN = 1 * MiB;
constexpr size_t WS_WOA = 11 * MiB, WS_WOB = 12 * MiB;
constexpr size_t WS_WOUT = 13 * MiB;
constexpr size_t WS_WGU = 15 * MiB;
constexpr size_t WS_WD = 26 * MiB;
constexpr size_t WS_ROPE = 32 * MiB;
constexpr size_t WS_GB = 34 * MiB;
constexpr size_t WS_SC = 36 * MiB;
constexpr size_t WS_SS1 = 37 * MiB, WS_SS2 = 37 * MiB + 512 * KiB;
constexpr size_t WS_SCR = 38 * MiB, SCR_BYTES = 2 * MiB;
constexpr size_t CTL_SPL = 49152;
constexpr size_t WS_QA = 41 * MiB;
constexpr size_t WS_KV = WS_QA + (size_t)MUP * 512 * 2;
constexpr size_t WS_QKVB = WS_KV + (size_t)MUP * 256 * 2;
constexpr size_t WS_Z = WS_QKVB + (size_t)MUP * 1536 * 2;
constexpr size_t WS_G = WS_Z + (size_t)MUP * 512 * 2;
constexpr size_t WS_GEND = WS_G + (size_t)MUP * 2048 * 2;
constexpr size_t WS_B = 353 * MiB, WS_END = 512 * MiB;
static_assert(WS_GEND <= WS_B, "ws map");
constexpr size_t WS_XN = WS_B;
constexpr size_t PREP_SLOT = 80 * KiB;
constexpr int PREP_N1 = (int)((WS_END - WS_B) / PREP_SLOT);
constexpr size_t DO_OA = 44 * MiB;
constexpr size_t DO_OB = DO_OA + (size_t)MC * 512 * 2;
constexpr size_t DO_ATS = DO_OB + (size_t)MC * 512 * 2;
constexpr size_t ATS_ITEM = 3 * 32 * 32 * 4;
static_assert(DO_ATS + 212 * 8 * ATS_ITEM <= (size_t)MC * 1024 * 4, "d_out scratch map");
constexpr size_t WS_MB = WS_B;
constexpr size_t WS_HB1 = WS_B + 66 * MiB;
static_assert(WS_HB1 + (size_t)MC * 1024 * 2 <= WS_END, "ws map");
constexpr size_t WS_ACT = WS_QA;
static_assert(WS_ACT + (size_t)MC * DFF * 2 <= WS_G, "ws map");
constexpr int SL_BEK = 0, SL_BV = 16 * 1024, SL_T = 32 * 1024, SL_QKD = 40 * 1024, SL_QE = 48 * 1024, SL_KWT = 64 * 1024;
constexpr int N_PROMPT_SEQ = NBATCH * NHB, CHUNKS_P = 65, N_ITEMS_P = N_PROMPT_SEQ * CHUNKS_P, N_ITEMS = N_ITEMS_P + SBATCH * NHB;
static_assert((size_t)(N_ITEMS - PREP_N1) * PREP_SLOT <= DO_OA, "prep slots");

constexpr size_t O_YP = 0, O_YS = (size_t)NBATCH * SEQ * D, O_KP = O_YS + (size_t)MS * D, O_VP = O_KP + 8 * 128 * 2 * 64, O_DP = O_VP + 8 * 128 * 2 * 64,
                 O_CP = O_DP + 8 * 4 * 128 * 128, O_KS = O_CP + 8 * 3 * 1536, O_VS = O_KS + (size_t)128 * 128 * 2 * 64, O_DS = O_VS + (size_t)128 * 128 * 2 * 64,
                 O_CS = O_DS + (size_t)128 * 4 * 128 * 128, O_END = O_CS + (size_t)128 * 3 * 1536;
static_assert(O_END == 48074752, "d_out size");

#define DI __device__ __forceinline__
#define GAS __attribute__((address_space(1)))
#define LAS __attribute__((address_space(3)))
typedef unsigned short bf16;
typedef short bf16x8 __attribute__((ext_vector_type(8)));
typedef float f32x4 __attribute__((ext_vector_type(4)));
typedef float f32x2 __attribute__((ext_vector_type(2)));
typedef float f32x16 __attribute__((ext_vector_type(16)));
typedef unsigned u32x4 __attribute__((ext_vector_type(4)));
typedef unsigned u32x2 __attribute__((ext_vector_type(2)));
typedef __bf16 bf16x2_t __attribute__((ext_vector_type(2)));

DI unsigned cvtpk(float lo, float hi) { f32x2 v = {lo, hi}; bf16x2_t b = __builtin_convertvector(v, bf16x2_t); return __builtin_bit_cast(unsigned, b); }
DI bf16 f2bf(float f) { return (bf16)(cvtpk(f, 0.f) & 0xffffu); }
DI float bf2f(unsigned short h) { return __uint_as_float((unsigned)h << 16); }
DI float bflo(unsigned w) { return __uint_as_float(w << 16); }
DI float bfhi(unsigned w) { return __uint_as_float(w & 0xffff0000u); }
DI u32x4 pack8f(f32x4 a, f32x4 b) { u32x4 w; w.x = cvtpk(a[0], a[1]); w.y = cvtpk(a[2], a[3]); w.z = cvtpk(b[0], b[1]); w.w = cvtpk(b[2], b[3]); return w; }
DI float frcp_(float x) { return __builtin_amdgcn_rcpf(x); }
DI float sigmoidf_(float x) { return frcp_(1.0f + __builtin_amdgcn_exp2f(x * -1.4426950408889634f)); }
DI float siluf_(float x) { return x * sigmoidf_(x); }
DI void st16_sc1(void* p, u32x4 v) { asm volatile("global_store_dwordx4 %0, %1, off sc1\n\ts_nop 1" :: "v"(p), "v"(v) : "memory"); }
DI void st16_sc1f(void* p, f32x4 v) { asm volatile("global_store_dwordx4 %0, %1, off sc1\n\ts_nop 1" :: "v"(p), "v"(v) : "memory"); }
DI void st2_sc1(void* p, unsigned v) { asm volatile("global_store_short %0, %1, off sc1\n\ts_nop 1" :: "v"(p), "v"(v) : "memory"); }
constexpr size_t CTL_GRAN = 65536, CTL_CNT = 245760, CTL_SS1 = 458752;
static_assert(CTL_CNT + 5 * 130 * 256 <= CTL_SS1 && CTL_SS1 + 33280 * 4 <= 1048576 && CTL_GRAN + 2592 * 64 <= CTL_CNT, "control region map");
constexpr int CNT_STRIDE = 130 * 64;
DI int pos_of_d(int d) { const int dd = d & 31; return 8 * (dd >> 2) + (dd & 3) + ((d >> 5) << 2); }
DI int d_of_pos(int p) { const int j = p & 7; return 4 * (p >> 3) + (j & 3) + ((j >> 2) << 5); }
namespace pg8 {
#define PG8_LAS __attribute__((address_space(3)))
typedef unsigned short bf16_t;
typedef short bf16x8 __attribute__((ext_vector_type(8)));
typedef float f32x4 __attribute__((ext_vector_type(4)));
typedef unsigned u32x4 __attribute__((ext_vector_type(4)));
constexpr int BM = 256, BK = 64, HALF = 128, HTB = HALF * BK * 2  , STAGE_BYTES = 8 * HTB, NXCD = 8, WGM = 8;

__host__ __device__ __forceinline__ int lds_byte(int r, int c) { const int st = (r >> 4) * 2 + (c >> 5), rr = r & 15, cc = c & 31, ob = rr * 64 + cc * 2; return st * 1024 + (ob ^ (((ob >> 9) & 1) << 5)); }
__host__ __device__ __forceinline__ void stage_rc(int b, int& R, int& C) { const int st = b / 1024, sb = b % 1024, swz = sb ^ (((sb >> 9) & 1) << 5); R = (st >> 1) * 16 + swz / 64; C = (st & 1) * 32 + (swz % 64) / 2; }
__host__ __device__ __forceinline__ int perm32(int rho) { const int n = rho >> 4, i = rho & 15; return 8 * (i >> 2) + 4 * n + (i & 3); }

struct Unit { int pm, pn; };
struct Gemm { const bf16_t* A; const bf16_t* Bt; int M, N, K; int ldk; };

struct StaticOrder {
    static constexpr bool A_SC1 = false;
    int nM, nN, nwg, G, c, lim;
    __host__ __device__ void init(int M, int N, int G_, int c_) { nM = M / BM; nN = N / BM; nwg = nM * nN; G = G_; c = c_; lim = nwg; }
    __host__ __device__ bool next(int i, Unit& u) const {
        const long L = (long)i * G + c; if (L >= lim) return false;
        int wgid = (int)L; { const int q = nwg / NXCD, r = nwg % NXCD, xcd = wgid % NXCD, off = wgid / NXCD; wgid = (xcd < r ? xcd * (q + 1) : r * (q + 1) + (xcd - r) * q) + off; }
        const int nig = WGM * nN, gid = wgid / nig, fm = gid * WGM, gsz = (nM - fm) < WGM ? (nM - fm) : WGM;
        u.pm = fm + ((wgid % nig) % gsz); u.pn = (wgid % nig) / gsz; return true;
    }
    __device__ __forceinline__ void a_ready(const Unit&) const {}
    __device__ __forceinline__ void done(const Unit&) const {}
};
struct FlagOrder : StaticOrder {
    static constexpr bool A_SC1 = true;
    const unsigned* ready; unsigned need; unsigned* pub; unsigned* gpub;
    __device__ __forceinline__ void a_ready(const Unit& u) const {
        if (ready) {
            if (threadIdx.x < 64) { unsigned spins = 0;
                while ((unsigned)__builtin_amdgcn_readfirstlane(__hip_atomic_load(ready + 64 * u.pm, __ATOMIC_RELAXED, __HIP_MEMORY_SCOPE_AGENT)) < need) { __builtin_amdgcn_s_sleep(2); if (++spins > (1u << 22)) break; } }
            asm volatile("" ::: "memory"); __builtin_amdgcn_s_barrier(); asm volatile("" ::: "memory");
        }
    }
    __device__ __forceinline__ void done(const Unit& u) const {
        if (pub) { asm volatile("s_waitcnt vmcnt(0)" ::: "memory");
            if ((threadIdx.x & 63) == 0) { __hip_atomic_fetch_add(pub + 64 * u.pm, 1u, __ATOMIC_RELAXED, __HIP_MEMORY_SCOPE_AGENT); if (gpub) __hip_atomic_fetch_add(gpub, 1u, __ATOMIC_RELAXED, __HIP_MEMORY_SCOPE_AGENT); } }
    }
};
struct SliceOrder : StaticOrder {
    int t;
    __host__ __device__ void init_slice(int M, int N, int G_, int first, int t_) { init(M, N, G_, 0); t = t_; c = first + t_; G = 0; }
    __host__ __device__ bool next(int i, Unit& u) const { return i == 0 ? StaticOrder::next(0, u) : false; }
};

__device__ __forceinline__ void urow_info(int urow, int& kind, int& b, int& t, int& ridx) {
    if (urow < MP) { b = urow / TP; t = urow - b * TP; kind = 0; ridx = t; }
    else if (urow < MU) { const int s = urow - MP; b = s >> 2; t = s & 3; kind = 1; ridx = TP + t; }
    else { kind = 2; b = 0; t = 0; ridx = 0; }
}
__device__ __forceinline__ int crow_to_urow(int crow) { return crow < NBATCH * SEQ ? crow + NMETA * ((crow >> 12) + 1) : MP + (crow - NBATCH * SEQ); }

struct EpiInProj {
    static constexpr bool PERM = true, AFTER_DRAIN = false;
    bf16_t *QA, *KV, *QKVB, *Z, *G; const float *COS, *SIN; float* out;
    __device__ __forceinline__ void operator()(const f32x4 (&acc)[2][2][4][2], const Unit& u, int wr, int wc, int fr, int fq) const {
        const int pn = u.pn;
#pragma unroll
        for (int ai = 0; ai < 2; ++ai)
#pragma unroll
            for (int m = 0; m < 4; ++m) {
                const int row = u.pm * BM + ai * HALF + wr * 64 + m * 16 + fr;
                int kind, b, t, ridx; urow_info(row, kind, b, t, ridx);
#pragma unroll
                for (int bj = 0; bj < 2; ++bj) {
                    const int cl = bj * HALF + wc * 32 + 8 * fq;
                    const f32x4 v0 = acc[ai][bj][m][0], v1 = acc[ai][bj][m][1];
                    if (pn < 2) {
                        const int c = pn * 256 + cl, d0 = ((c & 63) >> 3) * 4;
                        const f32x4 cs = *(const f32x4*)(COS + ridx * 32 + d0), sn = *(const f32x4*)(SIN + ridx * 32 + d0);
                        const f32x4 o1 = (v0 * cs - v1 * sn) * QSCALE, o2 = (v1 * cs + v0 * sn) * QSCALE;
                        *(u32x4*)(QA + (size_t)row * 512 + c) = pack8f(o1, o2);
                    } else if (pn == 2) {
                        if (bj == 0) {
                            const int kh = cl >> 6, d0 = ((cl & 63) >> 3) * 4;
                            const f32x4 cs = *(const f32x4*)(COS + ridx * 32 + d0), sn = *(const f32x4*)(SIN + ridx * 32 + d0);
                            const f32x4 o1 = v0 * cs - v1 * sn, o2 = v1 * cs + v0 * sn;
                            *(u32x4*)(KV + (size_t)row * 256 + cl) = pack8f(o1, o2);
                            float* dst = nullptr;
                            if (kind == 0 && t >= TP - 128) dst = out + O_KP + ((size_t)(b * 128 + (t - (TP - 128))) * 2 + kh) * 64;
                            else if (kind == 1) dst = out + O_KS + ((size_t)(b * 128 + 124 + t) * 2 + kh) * 64;
                            if (dst) { *(f32x4*)(dst + d0) = o1; *(f32x4*)(dst + 32 + d0) = o2; }
                        } else {
                            const int cv = cl - 128, kh = cv >> 6, dd = cv & 63;
                            *(u32x4*)(KV + (size_t)row * 256 + cl) = pack8f(v0, v1);
                            float* dst = nullptr;
                            if (kind == 0 && t >= TP - 128) dst = out + O_VP + ((size_t)(b * 128 + (t - (TP - 128))) * 2 + kh) * 64;
                            else if (kind == 1) dst = out + O_VS + ((size_t)(b * 128 + 124 + t) * 2 + kh) * 64;
                            if (dst) { *(f32x4*)(dst + dd) = v0; *(f32x4*)(dst + dd + 4) = v1; }
                        }
                    } else if (pn < 9) {
                        const int c = (pn - 3) * 256 + cl;
                        *(u32x4*)(QKVB + (size_t)row * 1536 + c) = pack8f(v0, v1);
                        float* dst = nullptr;
                        if (kind == 0 && t >= TP - 3) dst = out + O_CP + ((size_t)b * 3 + (t - (TP - 3))) * 1536;
                        else if (kind == 1 && t >= 1) dst = out + O_CS + ((size_t)b * 3 + (t - 1)) * 1536;
                        if (dst) { *(f32x4*)(dst + c) = v0; *(f32x4*)(dst + c + 4) = v1; }
                    } else if (pn < 11) {
                        const int c = (pn - 9) * 256 + cl;
                        *(u32x4*)(Z + (size_t)row * 512 + c) = pack8f(v0, v1);
                    } else {
                        const int c = (pn - 11) * 256 + cl;
                        f32x4 g0, g1;
#pragma unroll
                        for (int e = 0; e < 4; ++e) { g0[e] = sigmoidf_(v0[e]); g1[e] = sigmoidf_(v1[e]); }
                        *(u32x4*)(G + (size_t)row * 2048 + c) = pack8f(g0, g1);
                    }
                }
            }
    }
};

template <bool ACCUM> struct EpiMerge {
    static constexpr bool PERM = true, AFTER_DRAIN = false;
    bf16_t* MBp; const bf16_t* G; int gate_off;
    __device__ __forceinline__ void operator()(const f32x4 (&acc)[2][2][4][2], const Unit& u, int wr, int wc, int fr, int fq) const {
#pragma unroll
        for (int ai = 0; ai < 2; ++ai)
#pragma unroll
            for (int m = 0; m < 4; ++m) {
                const int crow = u.pm * BM + ai * HALF + wr * 64 + m * 16 + fr, urow = crow_to_urow(crow);
#pragma unroll
                for (int bj = 0; bj < 2; ++bj) {
                    const int c = u.pn * BM + bj * HALF + wc * 32 + 8 * fq;
                    const u32x4 gw = *(const u32x4*)(G + (size_t)urow * 2048 + gate_off + c);
                    f32x4 v0 = acc[ai][bj][m][0], v1 = acc[ai][bj][m][1];
                    v0[0] *= bflo(gw.x); v0[1] *= bfhi(gw.x); v0[2] *= bflo(gw.y); v0[3] *= bfhi(gw.y);
                    v1[0] *= bflo(gw.z); v1[1] *= bfhi(gw.z); v1[2] *= bflo(gw.w); v1[3] *= bfhi(gw.w);
                    bf16_t* p = MBp + (size_t)crow * 1024 + c;
                    if (ACCUM) { const u32x4 pw = *(const u32x4*)p;
                        v0[0] += bflo(pw.x); v0[1] += bfhi(pw.x); v0[2] += bflo(pw.y); v0[3] += bfhi(pw.y);
                        v1[0] += bflo(pw.z); v1[1] += bfhi(pw.z); v1[2] += bflo(pw.w); v1[3] += bfhi(pw.w); }
                    *(u32x4*)p = pack8f(v0, v1);
                }
            }
    }
};

template <bool ATOM = true> struct EpiWout {
    static constexpr bool PERM = true, AFTER_DRAIN = false;
    const float* xp; const float* xs; bf16_t* HB; float* SS;
    __device__ __forceinline__ void operator()(const f32x4 (&acc)[2][2][4][2], const Unit& u, int wr, int wc, int fr, int fq) const {
#pragma unroll
        for (int ai = 0; ai < 2; ++ai)
#pragma unroll
            for (int m = 0; m < 4; ++m) {
                const int crow = u.pm * BM + ai * HALF + wr * 64 + m * 16 + fr;
                const float* hs = crow < NBATCH * SEQ ? xp + (size_t)crow * D : xs + (size_t)(crow - NBATCH * SEQ) * D;
                float ss = 0.f;
#pragma unroll
                for (int bj = 0; bj < 2; ++bj) {
                    const int c = u.pn * BM + bj * HALF + wc * 32 + 8 * fq;
                    const f32x4 r0 = *(const f32x4*)(hs + c) + acc[ai][bj][m][0], r1 = *(const f32x4*)(hs + c + 4) + acc[ai][bj][m][1];
                    *(u32x4*)(HB + (size_t)crow * D + c) = pack8f(r0, r1);
                    ss += (r0[0] * r0[0] + r0[1] * r0[1]) + (r0[2] * r0[2] + r0[3] * r0[3]) + (r1[0] * r1[0] + r1[1] * r1[1]) + (r1[2] * r1[2] + r1[3] * r1[3]);
                }
                ss += __shfl_xor(ss, 16); ss += __shfl_xor(ss, 32);
                if (ATOM && fq == 0) atomicAdd(SS + crow, ss);
            }
    }
};

struct EpiGateUp {
    static constexpr bool PERM = true, AFTER_DRAIN = false;
    bf16_t* ACT; const float* SS;
    __device__ __forceinline__ void operator()(const f32x4 (&acc)[2][2][4][2], const Unit& u, int wr, int wc, int fr, int fq) const {
#pragma unroll
        for (int ai = 0; ai < 2; ++ai)
#pragma unroll
            for (int m = 0; m < 4; ++m) {
                const int crow = u.pm * BM + ai * HALF + wr * 64 + m * 16 + fr;
                const float rstd = rsqrtf(SS[crow] * (1.0f / D) + EPS);
                f32x4 a[2];
#pragma unroll
                for (int n = 0; n < 2; ++n)
#pragma unroll
                    for (int e = 0; e < 4; ++e) { const float g = acc[ai][0][m][n][e] * rstd, up = acc[ai][1][m][n][e] * rstd; a[n][e] = siluf_(g) * up; }
                *(u32x4*)(ACT + (size_t)crow * DFF + u.pn * HALF + wc * 32 + 8 * fq) = pack8f(a[0], a[1]);
            }
    }
};

template <bool DRY = false> struct EpiDown {
    static constexpr bool PERM = true, AFTER_DRAIN = false;
    const bf16_t* HB; float* H;
    __device__ __forceinline__ void operator()(const f32x4 (&acc)[2][2][4][2], const Unit& u, int wr, int wc, int fr, int fq) const {
#pragma unroll
        for (int ai = 0; ai < 2; ++ai)
#pragma unroll
            for (int m = 0; m < 4; ++m) {
                const int crow = u.pm * BM + ai * HALF + wr * 64 + m * 16 + fr;
#pragma unroll
                for (int bj = 0; bj < 2; ++bj) {
                    const size_t off = (size_t)crow * D + u.pn * BM + bj * HALF + wc * 32 + 8 * fq;
                    const u32x4 hw = *(const u32x4*)(HB + off);
                    f32x4 r0 = acc[ai][bj][m][0], r1 = acc[ai][bj][m][1];
                    r0[0] += bflo(hw.x); r0[1] += bfhi(hw.x); r0[2] += bflo(hw.y); r0[3] += bfhi(hw.y);
                    r1[0] += bflo(hw.z); r1[1] += bfhi(hw.z); r1[2] += bflo(hw.w); r1[3] += bfhi(hw.w);
                    *(f32x4*)(H + off) = r0; *(f32x4*)(H + off + 4) = r1;
                }
            }
    }
};

template <class Inner, bool GATED = false> struct EpiSplit {
    static constexpr bool PERM = Inner::PERM, AFTER_DRAIN = false;
    Inner inner; float* scr; unsigned* cnt; unsigned S; const bf16_t* G; int gate_off;
    __device__ __forceinline__ void operator()(const f32x4 (&acc_)[2][2][4][2], const Unit& u, int wr, int wc, int fr, int fq) const {
        f32x4 (&acc)[2][2][4][2] = const_cast<f32x4 (&)[2][2][4][2]>(acc_);
        const int lane = fr + 16 * fq, wave = wr * 4 + wc;
        float* p = scr + (size_t)wave * 8192 + lane;
#pragma unroll
        for (int ai = 0; ai < 2; ++ai)
#pragma unroll
            for (int m = 0; m < 4; ++m) {
                int urow = 0;
                if (GATED) urow = crow_to_urow(u.pm * BM + ai * HALF + wr * 64 + m * 16 + fr);
#pragma unroll
                for (int bj = 0; bj < 2; ++bj) {
                    f32x4 v0 = acc[ai][bj][m][0], v1 = acc[ai][bj][m][1];
                    if (GATED) { const u32x4 gw = *(const u32x4*)(G + (size_t)urow * 2048 + gate_off + u.pn * BM + bj * HALF + wc * 32 + 8 * fq);
                        v0[0] *= bflo(gw.x); v0[1] *= bfhi(gw.x); v0[2] *= bflo(gw.y); v0[3] *= bfhi(gw.y); v1[0] *= bflo(gw.z); v1[1] *= bfhi(gw.z); v1[2] *= bflo(gw.w); v1[3] *= bfhi(gw.w); }
                    float* q = p + (((ai * 2 + bj) * 4 + m) * 8) * 64;
                    asm volatile("" : "+v"(q));
#pragma unroll
                    for (int x = 0; x < 4; ++x) { unsafeAtomicAdd(q + x * 64, v0[x]); unsafeAtomicAdd(q + (4 + x) * 64, v1[x]); }
                }
            }
        asm volatile("s_waitcnt vmcnt(0)" ::: "memory");
        unsigned old = 0u;
        if (lane == 0) old = __hip_atomic_fetch_add(cnt + wave, 1u, __ATOMIC_RELAXED, __HIP_MEMORY_SCOPE_AGENT);
        old = (unsigned)__builtin_amdgcn_readfirstlane((int)old);
        if (old == S - 1u) {
#pragma unroll
            for (int ai = 0; ai < 2; ++ai)
#pragma unroll
                for (int bj = 0; bj < 2; ++bj)
#pragma unroll
                    for (int m = 0; m < 4; ++m) {
                        float* q = p + (((ai * 2 + bj) * 4 + m) * 8) * 64;
                        asm volatile("" : "+v"(q));
#pragma unroll
                        for (int n = 0; n < 2; ++n)
#pragma unroll
                            for (int x = 0; x < 4; ++x) acc[ai][bj][m][n][x] = __hip_atomic_exchange(q + (n * 4 + x) * 64, 0.0f, __ATOMIC_RELAXED, __HIP_MEMORY_SCOPE_AGENT);
                    }
            if (lane == 0) __hip_atomic_store(cnt + wave, 0u, __ATOMIC_RELAXED, __HIP_MEMORY_SCOPE_AGENT);
            inner(acc, u, wr, wc, fr, fq);
        }
    }
};
struct EpiStoreMB {
    static constexpr bool PERM = true, AFTER_DRAIN = false;
    bf16_t* MBp;
    __device__ __forceinline__ void operator()(const f32x4 (&acc)[2][2][4][2], const Unit& u, int wr, int wc, int fr, int fq) const {
#pragma unroll
        for (int ai = 0; ai < 2; ++ai)
#pragma unroll
            for (int m = 0; m < 4; ++m) {
                const int crow = u.pm * BM + ai * HALF + wr * 64 + m * 16 + fr;
#pragma unroll
                for (int bj = 0; bj < 2; ++bj) *(u32x4*)(MBp + (size_t)crow * 1024 + u.pn * BM + bj * HALF + wc * 32 + 8 * fq) = pack8f(acc[ai][bj][m][0], acc[ai][bj][m][1]);
            }
    }
};

template <class Epi, class Sched, bool ALIGN_EPI = false, bool SP2 = false>
__device__ __forceinline__ void gemm_phase(PG8_LAS unsigned char* lds, const Gemm g, const Sched& S, const Epi& E) {
    const int tid = threadIdx.x, wid = __builtin_amdgcn_readfirstlane(tid >> 6), lane = tid & 63, wr = wid >> 2, wc = wid & 3, fr = lane & 15, fq = lane >> 4;
    const int K = g.ldk ? g.ldk : g.K, nt = g.K / BK;
    unsigned voffA[2], voffB[2];
#pragma unroll
    for (int i = 0; i < 2; ++i) { int R, C; stage_rc(tid * 16 + i * 8192, R, C); const int Rb = Epi::PERM ? ((R & ~31) + perm32(R & 31)) : R;
        voffA[i] = (unsigned)(R * K + C) * 2u; voffB[i] = (unsigned)(Rb * K + C) * 2u; }
    const size_t kstep = (size_t)(BK * 2);
    const size_t hstep = (size_t)HALF * K * 2;
    const size_t tstep = 2 * hstep;
    const unsigned ldsw = (unsigned)wid * 1024u;
    const int aoff = lds_byte(wr * 64 + fr, fq * 8), boff = lds_byte(wc * 32 + fr, fq * 8);
#define PG8_SA(b, h) (((b) * 2 + (h)) * HTB)
#define PG8_SB(b, h) ((4 + (b) * 2 + (h)) * HTB)
#define PG8_STAGE(bufoff, gbase, voff) do { _Pragma("unroll") for (int _i = 0; _i < 2; ++_i) \
        __builtin_amdgcn_global_load_lds((const unsigned*)((const char*)(gbase) + (voff)[_i]), (PG8_LAS unsigned*)(lds + (bufoff) + ldsw + _i * 8192), 16, 0, 0); } while (0)
#define PG8_STAGE_A(bufoff, gbase, voff) do { _Pragma("unroll") for (int _i = 0; _i < 2; ++_i) { \
        if constexpr (Sched::A_SC1) __builtin_amdgcn_global_load_lds((const unsigned*)((const char*)(gbase) + (voff)[_i]), (PG8_LAS unsigned*)(lds + (bufoff) + ldsw + _i * 8192), 16, 0, 16); \
        else __builtin_amdgcn_global_load_lds((const unsigned*)((const char*)(gbase) + (voff)[_i]), (PG8_LAS unsigned*)(lds + (bufoff) + ldsw + _i * 8192), 16, 0, 0); } } while (0)
#define PG8_LDA(dst, b, h) do { _Pragma("unroll") for (int m = 0; m < 4; ++m) _Pragma("unroll") for (int k = 0; k < 2; ++k) dst[m][k] = *(const PG8_LAS bf16x8*)(lds + PG8_SA(b, h) + aoff + m * 2048 + k * 1024); } while (0)
#define PG8_LDB(dst, b, h) do { _Pragma("unroll") for (int n = 0; n < 2; ++n) _Pragma("unroll") for (int k = 0; k < 2; ++k) dst[n][k] = *(const PG8_LAS bf16x8*)(lds + PG8_SB(b, h) + boff + n * 2048 + k * 1024); } while (0)
#define PG8_MMA(ai, bj, At, Bt) do { __builtin_amdgcn_s_setprio(1); _Pragma("unroll") for (int m = 0; m < 4; ++m) _Pragma("unroll") for (int n = 0; n < 2; ++n) _Pragma("unroll") for (int k = 0; k < 2; ++k) \
        acc[ai][bj][m][n] = __builtin_amdgcn_mfma_f32_16x16x32_bf16(Bt[n][k], At[m][k], acc[ai][bj][m][n], 0, 0, 0); __builtin_amdgcn_s_setprio(0); } while (0)
#define PG8_WAIT_V(n) asm volatile("s_waitcnt vmcnt(" #n ")" ::: "memory")
#define PG8_WAIT_L(n) asm volatile("s_waitcnt lgkmcnt(" #n ")" ::: "memory")
#define PG8_BAR __builtin_amdgcn_s_barrier()
#define PG8_SCHED __builtin_amdgcn_sched_barrier(0)
    Unit cur, nxt; int ui = 0;
    if (!S.next(0, cur)) return;
    f32x4 acc[2][2][4][2];
#pragma unroll
    for (int a = 0; a < 2; ++a)
#pragma unroll
        for (int b = 0; b < 2; ++b)
#pragma unroll
            for (int m = 0; m < 4; ++m)
#pragma unroll
                for (int n = 0; n < 2; ++n) acc[a][b][m][n] = (f32x4){0.f, 0.f, 0.f, 0.f};
    bf16x8 At[4][2], B0[2][2], B1[2][2];
    const char* cA = (const char*)g.A + (size_t)cur.pm * tstep; const char* cB = (const char*)g.Bt + (size_t)cur.pn * tstep;
    S.a_ready(cur);
    if constexpr (SP2) {
        PG8_STAGE(PG8_SB(0, 0), cB, voffB); PG8_STAGE(PG8_SB(0, 1), cB + hstep, voffB); PG8_STAGE_A(PG8_SA(0, 0), cA, voffA); PG8_STAGE_A(PG8_SA(0, 1), cA + hstep, voffA);
        if (wr == 1) PG8_BAR;
        PG8_WAIT_V(2); PG8_BAR;
        PG8_STAGE(PG8_SB(1, 0), cB + kstep, voffB); PG8_STAGE_A(PG8_SA(1, 0), cA + kstep, voffA); PG8_STAGE(PG8_SB(1, 1), cB + hstep + kstep, voffB);
        PG8_WAIT_V(6); PG8_BAR;
    } else {
        PG8_STAGE(PG8_SB(0, 0), cB, voffB); PG8_STAGE_A(PG8_SA(0, 0), cA, voffA); PG8_STAGE(PG8_SB(0, 1), cB + hstep, voffB); PG8_STAGE_A(PG8_SA(0, 1), cA + hstep, voffA);
        if (wr == 1) PG8_BAR;
        PG8_WAIT_V(4); PG8_BAR;
        PG8_STAGE(PG8_SB(1, 0), cB + kstep, voffB); PG8_STAGE_A(PG8_SA(1, 0), cA + kstep, voffA); PG8_STAGE(PG8_SB(1, 1), cB + hstep + kstep, voffB);
        PG8_WAIT_V(6); PG8_BAR;
    }
    for (;;) {
        const bool has_next = S.next(ui + 1, nxt);
        const char* nA = has_next ? (const char*)g.A + (size_t)nxt.pm * tstep : cA; const char* nB = has_next ? (const char*)g.Bt + (size_t)nxt.pn * tstep : cB;
        for (int t = 0; t < nt; t += 2) {
            const bool last = (t == nt - 2);
            const char* a1 = cA + (size_t)(t + 1) * kstep;
            const char* a2 = last ? nA : cA + (size_t)(t + 2) * kstep; const char* b2 = last ? nB : cB + (size_t)(t + 2) * kstep;
            const char* a3 = a2 + kstep; const char* b3 = b2 + kstep;
            if (last && has_next) S.a_ready(nxt);
            if constexpr (SP2) {
            PG8_LDB(B0, 0, 0); PG8_LDB(B1, 0, 1); PG8_SCHED; PG8_LDA(At, 0, 0); PG8_STAGE_A(PG8_SA(1, 1), a1 + hstep, voffA);
            PG8_WAIT_V(8); PG8_WAIT_L(0); PG8_BAR; PG8_MMA(0, 0, At, B0); PG8_MMA(0, 1, At, B1); PG8_BAR; PG8_SCHED;
            PG8_LDA(At, 0, 1); PG8_STAGE(PG8_SB(0, 0), b2, voffB); PG8_STAGE(PG8_SB(0, 1), b2 + hstep, voffB); PG8_STAGE_A(PG8_SA(0, 0), a2, voffA);
            PG8_WAIT_V(8); PG8_WAIT_L(0); PG8_BAR; PG8_MMA(1, 0, At, B0); PG8_MMA(1, 1, At, B1); PG8_BAR; PG8_SCHED;
            PG8_LDB(B0, 1, 0); PG8_LDB(B1, 1, 1); PG8_SCHED; PG8_LDA(At, 1, 0); PG8_STAGE_A(PG8_SA(0, 1), a2 + hstep, voffA);
            PG8_WAIT_V(8); PG8_WAIT_L(0); PG8_BAR; PG8_MMA(0, 0, At, B0); PG8_MMA(0, 1, At, B1); PG8_BAR; PG8_SCHED;
            PG8_LDA(At, 1, 1); PG8_STAGE(PG8_SB(1, 0), b3, voffB); PG8_STAGE(PG8_SB(1, 1), b3 + hstep, voffB); PG8_STAGE_A(PG8_SA(1, 0), a3, voffA);
            PG8_WAIT_V(8); PG8_WAIT_L(0); PG8_BAR; PG8_MMA(1, 0, At, B0); PG8_MMA(1, 1, At, B1); PG8_BAR; PG8_SCHED;
            } else {
            PG8_LDB(B0, 0, 0); PG8_SCHED; PG8_LDA(At, 0, 0); PG8_STAGE_A(PG8_SA(1, 1), a1 + hstep, voffA);
            PG8_WAIT_L(8); PG8_BAR; PG8_WAIT_L(0); PG8_MMA(0, 0, At, B0); PG8_BAR; PG8_SCHED;
            PG8_LDB(B1, 0, 1); PG8_STAGE(PG8_SB(0, 0), b2, voffB);
            PG8_BAR; PG8_WAIT_L(0); PG8_MMA(0, 1, At, B1); PG8_BAR;
            PG8_LDA(At, 0, 1); PG8_STAGE_A(PG8_SA(0, 0), a2, voffA);
            PG8_BAR; PG8_WAIT_L(0); PG8_MMA(1, 0, At, B0); PG8_BAR; PG8_SCHED;
            PG8_STAGE(PG8_SB(0, 1), b2 + hstep, voffB);
            PG8_WAIT_V(6); PG8_BAR; PG8_MMA(1, 1, At, B1); PG8_BAR;
            PG8_LDB(B0, 1, 0); PG8_SCHED; PG8_LDA(At, 1, 0); PG8_STAGE_A(PG8_SA(0, 1), a2 + hstep, voffA);
            PG8_WAIT_L(8); PG8_BAR; PG8_WAIT_L(0); PG8_MMA(0, 0, At, B0); PG8_BAR; PG8_SCHED;
            PG8_LDB(B1, 1, 1); PG8_STAGE(PG8_SB(1, 0), b3, voffB);
            PG8_BAR; PG8_WAIT_L(0); PG8_MMA(0, 1, At, B1); PG8_BAR;
            PG8_LDA(At, 1, 1); PG8_STAGE_A(PG8_SA(1, 0), a3, voffA);
            PG8_BAR; PG8_WAIT_L(0); PG8_MMA(1, 0, At, B0); PG8_BAR; PG8_SCHED;
            PG8_STAGE(PG8_SB(1, 1), b3 + hstep, voffB);
            PG8_WAIT_V(6); PG8_BAR; PG8_MMA(1, 1, At, B1); PG8_BAR;
            }
        }
        if constexpr (ALIGN_EPI) { if (wr == 0) PG8_BAR; }
        if constexpr (!Epi::AFTER_DRAIN) { E(acc, cur, wr, wc, fr, fq); S.done(cur); }
        if (!has_next) break;
#pragma unroll
        for (int a = 0; a < 2; ++a)
#pragma unroll
            for (int b = 0; b < 2; ++b)
#pragma unroll
                for (int m = 0; m < 4; ++m)
#pragma unroll
                    for (int n = 0; n < 2; ++n) acc[a][b][m][n] = (f32x4){0.f, 0.f, 0.f, 0.f};
        cur = nxt; cA = nA; cB = nB; ++ui;
        if constexpr (ALIGN_EPI) { if (wr == 1) PG8_BAR; }
    }
    PG8_WAIT_V(0);
    if constexpr (!ALIGN_EPI) { if (wr == 0) PG8_BAR; }
    PG8_BAR;
    if constexpr (Epi::AFTER_DRAIN) { E.fused(acc, cur, wr, wc, fr, fq, lds, wid, lane); S.done(cur); }
#undef PG8_SA
#undef PG8_SB
#undef PG8_STAGE
#undef PG8_STAGE_A
#undef PG8_LDA
#undef PG8_LDB
#undef PG8_MMA
#undef PG8_WAIT_V
#undef PG8_WAIT_L
#undef PG8_BAR
#undef PG8_SCHED
}
}
constexpr int NWAVES = 8, NTHREADS = NWAVES * 64;
constexpr int LDS_BYTES = 147456;
constexpr int LDS_MISC = 131072;
constexpr int N_PHASES = 9;

struct Args {
    const float *x_prompt, *x_sample, *cache_k, *cache_v, *state_delta, *state_conv, *meta, *norm_mix, *w_in, *conv_w, *a_log, *dt_bias, *sinks, *gdn_norm,
                *w_oa, *w_ob, *w_out, *norm_ffn, *w_gate, *w_up, *w_down, *norm_final;
    float* out; unsigned char* ws; int ph_lo, ph_hi;
};

typedef const __attribute__((address_space(4))) Args* KA;
DI KA kargs() { KA p = (KA)__builtin_amdgcn_kernarg_segment_ptr(); asm volatile("" : "+s"(p)); return p; }
#define RLX_AGENT __ATOMIC_RELAXED, __HIP_MEMORY_SCOPE_AGENT
#define LDS_WAIT() asm volatile("s_waitcnt lgkmcnt(0)" ::: "memory")
#define MFMA32(a, b, c) __builtin_amdgcn_mfma_f32_32x32x16_bf16((a), (b), (c), 0, 0, 0)
DI int crow16(int reg, int h) { return (reg & 3) + 8 * (reg >> 2) + 4 * h; }
DI float wave_sum(float v) {
#pragma unroll
    for (int o = 1; o < 64; o <<= 1) v += __shfl_xor(v, o);
    return v;
}
DI float wave_max(float v) {
#pragma unroll
    for (int o = 1; o < 64; o <<= 1) v = fmaxf(v, __shfl_xor(v, o));
    return v;
}
template <int S> DI bf16x8 pack_step(const f32x16& x) {
    u32x4 p; p.x = cvtpk(x[8 * S], x[8 * S + 1]); p.y = cvtpk(x[8 * S + 2], x[8 * S + 3]); p.z = cvtpk(x[8 * S + 4], x[8 * S + 5]); p.w = cvtpk(x[8 * S + 6], x[8 * S + 7]);
    return __builtin_bit_cast(bf16x8, p);
}
DI int frag_idx(int row, int k, int NKS) { const int kkk = k & 15; return (((row >> 5) * NKS + (k >> 4)) * 64 + (row & 31) + 32 * ((kkk >> 2) & 1)) * 8 + (((kkk >> 3) << 2) | (kkk & 3)); }
DI unsigned char* slot_ptr(KA A, int item) { return item < PREP_N1 ? A->ws + WS_B + (size_t)item * PREP_SLOT : (unsigned char*)A->out + (size_t)(item - PREP_N1) * PREP_SLOT; }

#define XB_TMO      128
#define XB_XCNT(j)  (256  + 64 * (j))
#define XB_XSUB(j)  (1280 + 64 * (j))
#define XB_XGEN(j)  (2304 + 64 * (j))
#define XB_TOP      3328
#define XB_TOPGEN   3392
#define XCD_BAR_WORDS 3456
#define XB_SPIN_CAP (1u << 20)
DI unsigned xb_ld(unsigned* p)              { return __hip_atomic_load(p, __ATOMIC_RELAXED, __HIP_MEMORY_SCOPE_AGENT); }
DI unsigned xb_add(unsigned* p, unsigned v) { return __hip_atomic_fetch_add(p, v, __ATOMIC_RELAXED, __HIP_MEMORY_SCOPE_AGENT); }
DI unsigned xb_xcc_id() { return (unsigned)__builtin_amdgcn_s_getreg((3 << 11) | 20) & 0xFu; }
#define XB_SPIN(cond, bar) do { unsigned _sp = 0; while (cond) { __builtin_amdgcn_s_sleep(1); \
    if ((++_sp & 255u) == 0u) { if (xb_ld(&(bar)[XB_TMO])) break; if (_sp > XB_SPIN_CAP) { atomicAdd(&(bar)[XB_TMO], 1u); break; } } } } while (0)
struct XcdBarrier { unsigned* bar; unsigned x; volatile LAS unsigned* st; };
DI XcdBarrier xcd_barrier_post(unsigned* bar, volatile LAS unsigned* st) {
    XcdBarrier b; b.bar = bar; b.x = xb_xcc_id(); b.st = st;
    if (threadIdx.x == 0) (void)xb_add(&bar[XB_XCNT(b.x)], 1u);
    return b;
}
DI void xcd_barrier_complete(unsigned* bar, unsigned x, unsigned& nloc, unsigned& nx) {
    const unsigned G = gridDim.x * gridDim.y * gridDim.z;
    unsigned sum, cnt, mine, sp = 0u;
    for (;;) {
        sum = 0u; cnt = 0u; mine = 0u;
#pragma unroll
        for (unsigned j = 0; j < 16; ++j) { const unsigned c = xb_ld(&bar[XB_XCNT(j)]); sum += c; cnt += (c > 0u) ? 1u : 0u; mine = (j == x) ? c : mine; }
        if (sum == G) break;
        __builtin_amdgcn_s_sleep(1);
        if ((++sp & 255u) == 0u) { if (xb_ld(&bar[XB_TMO])) break; if (sp > XB_SPIN_CAP) { atomicAdd(&bar[XB_TMO], 1u); break; } }
    }
    nloc = mine > 0u ? mine : 1u; nx = cnt > 0u ? cnt : 1u;
}
DI void xcd_barrier(const XcdBarrier& b) {
    asm volatile("s_waitcnt vmcnt(0)" ::: "memory");
    __syncthreads();
    if (threadIdx.x == 0) {
        unsigned* bar = b.bar;
        __builtin_amdgcn_s_waitcnt(0);
        unsigned nloc = b.st[0], nx = b.st[1];
        if (nloc == 0u) { xcd_barrier_complete(bar, b.x, nloc, nx); b.st[0] = nloc; b.st[1] = nx; }
        const unsigned old = xb_add(&bar[XB_XSUB(b.x)], 1u);
        const unsigned gen = old / nloc;
        if (old + 1u == (gen + 1u) * nloc) {
            __builtin_amdgcn_fence(__ATOMIC_RELEASE, "agent");
            asm volatile("s_waitcnt vmcnt(0)" ::: "memory");
            const unsigned og = xb_add(&bar[XB_TOP], 1u);
            const unsigned tg = og / nx;
            if (og + 1u == (tg + 1u) * nx) xb_add(&bar[XB_TOPGEN], 1u);
            else XB_SPIN(xb_ld(&bar[XB_TOPGEN]) == tg, bar);
            __builtin_amdgcn_fence(__ATOMIC_ACQUIRE, "agent");
            xb_add(&bar[XB_XGEN(b.x)], 1u);
            asm volatile("s_waitcnt vmcnt(0)" ::: "memory");
        } else {
            XB_SPIN(xb_ld(&bar[XB_XGEN(b.x)]) == gen, bar);
            __builtin_amdgcn_fence(__ATOMIC_ACQUIRE, "agent");
            asm volatile("s_waitcnt vmcnt(0)" ::: "memory");
        }
    }
    __syncthreads();
}

template <class RowMap> DI void transpose_item(const float* W, int K, int N, bf16* WT, RowMap rm, const float* kscale, LAS float* scr, int item, int lane) {
    const int nblk = (N + 31) / 32, kb = item / nblk, nb = item - kb * nblk, k0 = 64 * kb, n0 = 32 * nb;
    const int n4 = n0 + (lane & 7) * 4;
    f32x4 v[8];
#pragma unroll
    for (int i = 0; i < 8; ++i) { const int kk = 8 * i + (lane >> 3);
        v[i] = n4 < N ? *(const f32x4*)(W + (size_t)(k0 + kk) * N + n4) : (f32x4){0.f, 0.f, 0.f, 0.f}; }
#pragma unroll
    for (int i = 0; i < 8; ++i) { const int kk = 8 * i + (lane >> 3);
        if (kscale) v[i] = v[i] * kscale[k0 + kk];
        LAS float* d = scr + kk * 33 + (lane & 7) * 4; d[0] = v[i][0]; d[1] = v[i][1]; d[2] = v[i][2]; d[3] = v[i][3]; }
    LDS_WAIT(); asm volatile("" ::: "memory");
    const int c = lane & 7;
#pragma unroll
    for (int j = 0; j < 4; ++j) { const int n = (lane >> 3) + 8 * j; const LAS float* s = scr + (8 * c) * 33 + n;
        const int nsrc = n0 + n; const int drow = nsrc < N ? rm(nsrc) : -1;
        u32x4 o; o.x = cvtpk(s[0 * 33], s[1 * 33]); o.y = cvtpk(s[2 * 33], s[3 * 33]); o.z = cvtpk(s[4 * 33], s[5 * 33]); o.w = cvtpk(s[6 * 33], s[7 * 33]);
        if (drow >= 0) *(u32x4*)(WT + (size_t)drow * K + k0 + 8 * c) = o; }
    LDS_WAIT(); asm volatile("" ::: "memory");
}
DI float softplusf_(float x) { return x > 20.f ? x : log1pf(__expf(x)); }

#ifndef PROBE_REP
#define PROBE_REP -1
#endif
DI void p0_prologue(KA A, LAS unsigned char* lds) {
    const int tid = threadIdx.x, lane = tid & 63, wave = __builtin_amdgcn_readfirstlane(tid >> 6);
    const int G = gridDim.x, gw = blockIdx.x * NWAVES + wave, NGW = G * NWAVES;
    const int gt = blockIdx.x * NTHREADS + tid, NGT = G * NTHREADS;
    unsigned char* ws = A->ws;
    for (int rep = 0; rep < (PROBE_REP == 1001 ? 2 : 1); ++rep) {
        LAS float* scr = (LAS float*)(lds + wave * 16384);
        constexpr int I_IN = 16 * 153, I_OA = 8 * 32, I_OUT = 16 * 32, I_G = 16 * 88, I_D = 44 * 32;
        constexpr int NIT = I_IN + 2 * I_OA + I_OUT + 2 * I_G + I_D;
        for (int it = gw; it < NIT; it += NGW) {
            int r = it;
            if (r < I_IN) { transpose_item(A->w_in, 1024, NIN_SRC, (bf16*)(ws + WS_WIN), [](int c) -> int {
                    if (c < 640) return (c & ~63) + pos_of_d(c & 63);
                    if (c < 2816) return c;
                    if (c < 2824) return -1;
                    return c - 8; }, nullptr, scr, r, lane); continue; } r -= I_IN;
            if (r < I_OA) { transpose_item(A->w_oa, 512, 1024, (bf16*)(ws + WS_WOA), [](int c) -> int { return c; }, nullptr, scr, r, lane); continue; } r -= I_OA;
            if (r < I_OA) { transpose_item(A->w_ob, 512, 1024, (bf16*)(ws + WS_WOB), [](int c) -> int { return c; }, nullptr, scr, r, lane); continue; } r -= I_OA;
            if (r < I_OUT) { transpose_item(A->w_out, 1024, 1024, (bf16*)(ws + WS_WOUT), [](int c) -> int { return c; }, nullptr, scr, r, lane); continue; } r -= I_OUT;
            if (r < I_G) { transpose_item(A->w_gate, 1024, DFF, (bf16*)(ws + WS_WGU), [](int c) -> int { return 256 * (c >> 7) + (c & 127); }, A->norm_ffn, scr, r, lane); continue; } r -= I_G;
            if (r < I_G) { transpose_item(A->w_up, 1024, DFF, (bf16*)(ws + WS_WGU), [](int c) -> int { return 256 * (c >> 7) + 128 + (c & 127); }, A->norm_ffn, scr, r, lane); continue; } r -= I_G;
            transpose_item(A->w_down, DFF, 1024, (bf16*)(ws + WS_WD), [](int c) -> int { return c; }, nullptr, scr, r, lane);
        }
    }
    for (int rep = 0; rep < (PROBE_REP == 1002 ? 2 : 1); ++rep) {
        float* COS = (float*)(ws + WS_ROPE); float* SIN = COS + (TP + TS) * 32;
        for (int i = gt; i < (TP + TS) * 32; i += NGT) { const int ri = i >> 5, f = i & 31; const double pos = ri < TP ? (double)ri : (double)(PAST + ri - TP);
            const double inv = exp2(-(double)f * (13.287712379549449 / 32.0)), ang = pos * inv; COS[i] = (float)cos(ang); SIN[i] = (float)sin(ang); }
        constexpr int PERB = 124 * 128 / 4;
        for (int i = gt; i < SBATCH * PERB; i += NGT) { const int b = i / PERB, o = i - b * PERB;
            ((f32x4*)(A->out + O_KS))[(size_t)b * 4096 + o] = ((const f32x4*)A->cache_k)[(size_t)b * 4096 + 128 + o];
            ((f32x4*)(A->out + O_VS))[(size_t)b * 4096 + o] = ((const f32x4*)A->cache_v)[(size_t)b * 4096 + 128 + o]; }
    }
    for (int rep = 0; rep < (PROBE_REP == 1003 ? 2 : 1); ++rep) {
        unsigned wab[16][4];
        f32x4 nm[4];
#pragma unroll
        for (int j = 0; j < 4; ++j) {
            nm[j] = ((const f32x4*)A->norm_mix)[lane + 64 * j];
#pragma unroll
            for (int e = 0; e < 4; ++e) { const float* p = A->w_in + (size_t)(4 * (lane + 64 * j) + e) * NIN_SRC + 2816;
                const f32x4 a = *(const f32x4*)p, b = *(const f32x4*)(p + 4);
                wab[j * 4 + e][0] = cvtpk(a[0], a[1]); wab[j * 4 + e][1] = cvtpk(a[2], a[3]); wab[j * 4 + e][2] = cvtpk(b[0], b[1]); wab[j * 4 + e][3] = cvtpk(b[2], b[3]); }
        }
        bf16* XN = (bf16*)(ws + WS_XN); f32x2* GB = (f32x2*)(ws + WS_GB);
        auto row_src = [&](int urow) -> const float* {
            if (urow < MP) { const int b = urow / TP, t = urow - b * TP; return t < NMETA ? A->meta + (size_t)t * D : A->x_prompt + ((size_t)b * SEQ + (t - NMETA)) * D; }
            if (urow < MU) return A->x_sample + (size_t)(urow - MP) * D;
            return nullptr; };
        f32x4 nx[4];
        { const float* s0 = gw < MUP ? row_src(gw) : nullptr;
#pragma unroll
          for (int j = 0; j < 4; ++j) nx[j] = s0 ? ((const f32x4*)s0)[lane + 64 * j] : (f32x4){0.f, 0.f, 0.f, 0.f}; }
#pragma unroll 1
        for (int urow = gw; urow < MUP; urow += NGW) {
            f32x4 v[4];
#pragma unroll
            for (int j = 0; j < 4; ++j) v[j] = nx[j];
            { const int un = urow + NGW; const float* s1 = un < MUP ? row_src(un) : nullptr;
#pragma unroll
              for (int j = 0; j < 4; ++j) nx[j] = s1 ? ((const f32x4*)s1)[lane + 64 * j] : (f32x4){0.f, 0.f, 0.f, 0.f}; }
            u32x2* o8 = (u32x2*)(XN + (size_t)urow * D) + lane;
            float ss = 0.f;
#pragma unroll
            for (int j = 0; j < 4; ++j) ss += (v[j][0] * v[j][0] + v[j][1] * v[j][1]) + (v[j][2] * v[j][2] + v[j][3] * v[j][3]);
            const float rstd = urow < MU ? rsqrtf(wave_sum(ss) * (1.0f / D) + EPS) : 0.f;
            float dot[8];
#pragma unroll
            for (int c = 0; c < 8; ++c) dot[c] = 0.f;
#pragma unroll
            for (int j = 0; j < 4; ++j) { v[j] = v[j] * rstd * nm[j];
                o8[64 * j] = (u32x2){cvtpk(v[j][0], v[j][1]), cvtpk(v[j][2], v[j][3])};
#pragma unroll
                for (int e = 0; e < 4; ++e)
#pragma unroll
                    for (int c = 0; c < 4; ++c) { dot[2 * c] += v[j][e] * bflo(wab[j * 4 + e][c]); dot[2 * c + 1] += v[j][e] * bfhi(wab[j * 4 + e][c]); } }
            float d4[4], d2[2], d1;
#pragma unroll
            for (int c = 0; c < 4; ++c) { const float keep = (lane & 32) ? dot[4 + c] : dot[c], send = (lane & 32) ? dot[c] : dot[4 + c]; d4[c] = keep + __shfl_xor(send, 32); }
#pragma unroll
            for (int c = 0; c < 2; ++c) { const float keep = (lane & 16) ? d4[2 + c] : d4[c], send = (lane & 16) ? d4[c] : d4[2 + c]; d2[c] = keep + __shfl_xor(send, 16); }
            { const float keep = (lane & 8) ? d2[1] : d2[0], send = (lane & 8) ? d2[0] : d2[1]; d1 = keep + __shfl_xor(send, 8); }
            d1 += __shfl_xor(d1, 4); d1 += __shfl_xor(d1, 2); d1 += __shfl_xor(d1, 1);
            const float a_ = __shfl(d1, ((lane & 2) ? 16 : 0) + ((lane & 1) ? 8 : 0));
            const float b_ = __shfl(d1, 32 + ((lane & 2) ? 16 : 0) + ((lane & 1) ? 8 : 0));
            if (lane < 4) {
                const float g = -__expf(A->a_log[lane]) * softplusf_(a_ + A->dt_bias[lane]);
                GB[(size_t)urow * 4 + lane] = urow < MU ? (f32x2){g, sigmoidf_(b_)} : (f32x2){0.f, 0.f};
            }
        }
    }
}
DI void item_decode(int item, int& b, int& h, bool& sample, int& t0, int& L) {
    if (item < N_ITEMS_P) { const int s = item / CHUNKS_P, c = item - s * CHUNKS_P; b = s >> 2; h = s & 3; sample = false; if (c == 0) { t0 = 0; L = NMETA; } else { t0 = NMETA + 64 * (c - 1); L = 64; } }
    else { const int s = item - N_ITEMS_P; b = s >> 2; h = s & 3; sample = true; t0 = 0; L = TS; }
}
#define LDS_BARRIER() do { asm volatile("s_waitcnt lgkmcnt(0)" ::: "memory"); __builtin_amdgcn_s_barrier(); asm volatile("" ::: "memory"); } while (0)
typedef GAS unsigned long long gu64;
constexpr size_t CTL_F1 = 655360;
static_assert(CTL_F1 + 2592 * 64 <= 1048576, "control region map");
DI gu64* item_flag1(KA A, int item) { return (gu64*)(A->ws + WS_CTL + CTL_F1 + (size_t)item * 64); }
DI int order_item(int m) { return m < N_ITEMS_P ? (m & 31) * CHUNKS_P + (m >> 5) : m; }
DI gu64* item_granule(KA A, int item) { return (gu64*)(A->ws + WS_CTL + CTL_GRAN + (size_t)item * 64); }
DI float wait_item(gu64* g, unsigned ep = 1u) {
    unsigned long long x; unsigned spins = 0;
    for (;;) { x = __hip_atomic_load(g, __ATOMIC_RELAXED, __HIP_MEMORY_SCOPE_AGENT); if ((unsigned)(x >> 32) >= ep) break; __builtin_amdgcn_s_sleep(8); if (++spins > (1u << 20)) break; }
    asm volatile("" ::: "memory");
    return __uint_as_float((unsigned)__builtin_amdgcn_readfirstlane((int)(unsigned)x));
}
constexpr int LDS_GCL = 139264;
constexpr int PITCH = 132;
DI bf16x8 frag_nat(const LAS float* src, int row, int k0) {
    const f32x4 lo = *(const LAS f32x4*)(src + row * PITCH + k0), hi = *(const LAS f32x4*)(src + row * PITCH + k0 + 4);
    return __builtin_bit_cast(bf16x8, pack8f(lo, hi));
}
struct S1Pre { u32x4 xr[11]; f32x4 w[4][2]; f32x2 gb; };
DI void stage1_issue(KA A, int item, S1Pre& P) {
    const int tid = threadIdx.x, lane = tid & 63, wave = __builtin_amdgcn_readfirstlane(tid >> 6);
    int b, h, t0, L; bool sample; item_decode(item, b, h, sample, t0, L);
    const bf16* QKVB = (const bf16*)(A->ws + WS_QKVB);
    const int cv = lane < 48 ? lane : 47, grp = cv >> 4, col0 = (cv & 15) * 8, r0 = wave * 8, cidx = grp * 512 + h * 128 + col0;
#pragma unroll
    for (int q = 0; q < 11; ++q) {
        const int i = r0 - 3 + q;
        long urow = sample ? (long)MP + b * TS + i : (long)b * TP + t0 + i;
        const bool ok = sample ? i >= 0 : t0 + i >= 0;
        if (!ok) urow = 0;
        P.xr[q] = *(const u32x4*)(QKVB + (size_t)urow * CONVD + cidx);
        if (!ok) P.xr[q] = (u32x4){0u, 0u, 0u, 0u};
    }
#pragma unroll
    for (int i = 0; i < 4; ++i) { P.w[i][0] = *(const f32x4*)(A->conv_w + i * CONVD + cidx); P.w[i][1] = *(const f32x4*)(A->conv_w + i * CONVD + cidx + 4); }
    P.gb = (f32x2){0.f, 0.f};
    if (wave == 7 && lane < L) { const int urow = sample ? MP + b * TS + lane : b * TP + t0 + lane; P.gb = ((const f32x2*)(A->ws + WS_GB))[(size_t)urow * 4 + h]; }
}
DI void prep_stage1(KA A, int item, int next_item, int prev_item, int wait_item_idx, int bslot, float* ats, S1Pre& P, LAS unsigned char* ldsb, unsigned ep, int pmode = 0) {
    const int tid = threadIdx.x, lane = tid & 63, wave = __builtin_amdgcn_readfirstlane(tid >> 6), r = lane & 31, hh = lane >> 5;
#ifdef PROBE_PLAIN
    const bool plain_ = ep == 2u;
#define ST16(p, ...) do { if (plain_) *(u32x4*)(p) = (__VA_ARGS__); else st16_sc1((p), (__VA_ARGS__)); } while (0)
#define ST16F(p, ...) do { if (plain_) *(f32x4*)(p) = (__VA_ARGS__); else st16_sc1f((p), (__VA_ARGS__)); } while (0)
#else
#define ST16(p, ...) st16_sc1((p), (__VA_ARGS__))
#define ST16F(p, ...) st16_sc1f((p), (__VA_ARGS__))
#endif
    int b, h, t0, L; bool sample; item_decode(item, b, h, sample, t0, L);
    LAS float* Qs = (LAS float*)ldsb; LAS float* Ks = Qs + 64 * PITCH; LAS float* Vs = Ks + 64 * PITCH; LAS float* gcs = Vs + 64 * PITCH; LAS float* betas = gcs + 64;
    unsigned char* slot = slot_ptr(A, item);
    if (!(pmode & 8)) {
        const int cv = lane < 48 ? lane : 47, grp = cv >> 4, col0 = (cv & 15) * 8, r0 = wave * 8, cidx = grp * 512 + h * 128 + col0;
        float x[11][8];
#pragma unroll
        for (int q = 0; q < 11; ++q) { x[q][0] = bflo(P.xr[q].x); x[q][1] = bfhi(P.xr[q].x); x[q][2] = bflo(P.xr[q].y); x[q][3] = bfhi(P.xr[q].y);
                                       x[q][4] = bflo(P.xr[q].z); x[q][5] = bfhi(P.xr[q].z); x[q][6] = bflo(P.xr[q].w); x[q][7] = bfhi(P.xr[q].w); }
        if (sample && wave == 0) {
#pragma unroll
            for (int q = 0; q < 3; ++q) { const float* sp = A->state_conv + ((size_t)b * 3 + q) * CONVD + cidx; const f32x4 s0 = *(const f32x4*)sp, s1 = *(const f32x4*)(sp + 4);
                x[q][0] = s0[0]; x[q][1] = s0[1]; x[q][2] = s0[2]; x[q][3] = s0[3]; x[q][4] = s1[0]; x[q][5] = s1[1]; x[q][6] = s1[2]; x[q][7] = s1[3]; }
        }
        float w[4][8];
#pragma unroll
        for (int i = 0; i < 4; ++i) { w[i][0] = P.w[i][0][0]; w[i][1] = P.w[i][0][1]; w[i][2] = P.w[i][0][2]; w[i][3] = P.w[i][0][3]; w[i][4] = P.w[i][1][0]; w[i][5] = P.w[i][1][1]; w[i][6] = P.w[i][1][2]; w[i][7] = P.w[i][1][3]; }
        LAS float* dst = Qs + grp * 64 * PITCH + col0;
        const float nsc = grp == 0 ? 0.08838834764831845f : 1.0f;
#pragma unroll
        for (int q = 3; q < 11; ++q) {
            const int rr = r0 + q - 3;
            float v[8]; float ss = 0.f;
#pragma unroll
            for (int e = 0; e < 8; ++e) {
                const float y = __builtin_fmaf(w[3][e], x[q][e], __builtin_fmaf(w[2][e], x[q - 1][e], __builtin_fmaf(w[1][e], x[q - 2][e], w[0][e] * x[q - 3][e])));
                const float sv = siluf_(y); v[e] = sv; ss = __builtin_fmaf(sv, sv, ss); }
            ss += __builtin_bit_cast(float, __builtin_amdgcn_update_dpp(0, __builtin_bit_cast(int, ss), 0xB1, 0xF, 0xF, true));
            ss += __builtin_bit_cast(float, __builtin_amdgcn_update_dpp(0, __builtin_bit_cast(int, ss), 0x4E, 0xF, 0xF, true));
            ss += __builtin_bit_cast(float, __builtin_amdgcn_update_dpp(0, __builtin_bit_cast(int, ss), 0x141, 0xF, 0xF, true));
            ss += __builtin_bit_cast(float, __builtin_amdgcn_update_dpp(0, __builtin_bit_cast(int, ss), 0x140, 0xF, 0xF, true));
            float sc = grp == 2 ? 1.0f : rsqrtf(ss + EPS) * nsc;
            sc = rr < L ? sc : 0.f;
            if (lane < 48) { *(LAS f32x4*)(dst + rr * PITCH) = (f32x4){v[0] * sc, v[1] * sc, v[2] * sc, v[3] * sc}; *(LAS f32x4*)(dst + rr * PITCH + 4) = (f32x4){v[4] * sc, v[5] * sc, v[6] * sc, v[7] * sc}; }
        }
    }
    if (wave == 7) {
        float gc = P.gb[0];
#pragma unroll
        for (int o = 1; o < 64; o <<= 1) { const float t = __shfl_up(gc, o); if (lane >= o) gc += t; }
        gcs[lane] = gc; betas[lane] = P.gb[1];
        if (lane == 63) ((LAS float*)(ldsb + LDS_GCL))[bslot] = __expf(gc);
    }
    asm volatile("s_waitcnt vmcnt(0)" ::: "memory");
    if (next_item < N_ITEMS) stage1_issue(A, next_item, P);
    if (wait_item_idx >= 0 && wave == 0) (void)wait_item(item_granule(A, wait_item_idx), ep);
    LDS_BARRIER();
    if (prev_item >= 0 && tid == 0) __hip_atomic_store(item_flag1(A, prev_item), ((unsigned long long)ep << 32) | (unsigned long long)__float_as_uint(((const LAS float*)(ldsb + LDS_GCL))[bslot ^ 1]), __ATOMIC_RELAXED, __HIP_MEMORY_SCOPE_AGENT);
    if (wave < 6 && !(pmode & 4)) {
        const bool isqk = wave >= 3; const int tsel = isqk ? wave - 3 : wave, ib = tsel == 0 ? 0 : 1, jb = tsel == 2 ? 1 : 0;
        const LAS float* Asrc = isqk ? Qs : Ks;
        f32x16 acc;
#pragma unroll
        for (int e = 0; e < 16; ++e) acc[e] = 0.f;
#pragma unroll
        for (int s = 0; s < 8; ++s) acc = MFMA32(frag_nat(Asrc, 32 * ib + r, 16 * s + 8 * hh), frag_nat(Ks, 32 * jb + r, 16 * s + 8 * hh), acc);
        const int j = 32 * jb + r; const float gcj = gcs[j];
        float* Aout = ats + (ib + jb) * 1024; bf16* QKD = (bf16*)(slot + SL_QKD);
        if (!isqk) {
#pragma unroll
            for (int g4 = 0; g4 < 4; ++g4) { f32x4 v;
#pragma unroll
                for (int e = 0; e < 4; ++e) { const int i = 32 * ib + 8 * g4 + 4 * hh + e; v[e] = i > j ? betas[i] * __expf(fminf(gcs[i] - gcj, 0.f)) * acc[4 * g4 + e] : 0.f; }
                ST16F(Aout + r * 32 + 8 * g4 + 4 * hh, v); }
        } else {
            LAS float* patch = (LAS float*)(ldsb + 106496) + (wave - 3) * (32 * 36);
#pragma unroll
            for (int reg = 0; reg < 16; ++reg) { const int il = crow16(reg, hh), i = 32 * ib + il; const float dec = __expf(fminf(gcs[i] - gcj, 0.f));
                patch[il * 36 + r] = i >= j ? dec * acc[reg] : 0.f; }
            LDS_WAIT(); asm volatile("" ::: "memory");
#pragma unroll
            for (int ks2 = 0; ks2 < 2; ++ks2) { const int k0 = 16 * ks2 + 4 * hh;
                const f32x4 lo = *(const LAS f32x4*)(patch + r * 36 + k0), hi = *(const LAS f32x4*)(patch + r * 36 + k0 + 8);
                ST16((unsigned char*)QKD + ((ib * 4 + 2 * jb + ks2) * 64 + lane) * 16, pack8f(lo, hi)); }
        }
    }
    const float gcl = gcs[63];
#pragma unroll 1
    for (int job = (pmode & 4) ? 56 : wave; job < 56; job += 8) {
        if (job < 32) {
            const bool isq = job >= 16; const int jj = job & 15, rb = jj >> 3, ks = jj & 7, row = 32 * rb + r, k0 = 16 * ks + 4 * hh;
            const LAS float* src = isq ? Qs : Ks; const float sc = isq ? __expf(gcs[row]) : betas[row] * __expf(gcs[row]);
            const f32x4 lo = *(const LAS f32x4*)(src + row * PITCH + k0) * sc, hi = *(const LAS f32x4*)(src + row * PITCH + k0 + 8) * sc;
            ST16(slot + (isq ? SL_QE : SL_BEK) + ((rb * 8 + ks) * 64 + lane) * 16, pack8f(lo, hi));
        } else if (job < 48) {
            const int jj = job - 32, rb = jj >> 2, ks = jj & 3, dk = 32 * rb + r;
            f32x4 lo, hi;
#pragma unroll
            for (int e = 0; e < 4; ++e) { const int j0 = 16 * ks + 4 * hh + e, j1 = j0 + 8;
                lo[e] = Ks[j0 * PITCH + dk] * __expf(gcl - gcs[j0]); hi[e] = Ks[j1 * PITCH + dk] * __expf(gcl - gcs[j1]); }
            ST16(slot + SL_KWT + ((rb * 4 + ks) * 64 + lane) * 16, pack8f(lo, hi));
        } else {
            const int q = job - 48, w = q >> 1, ib = q & 1, dv = 32 * w + r;
            float v[16];
#pragma unroll
            for (int reg = 0; reg < 16; ++reg) { const int i = 32 * ib + crow16(reg, hh); v[reg] = betas[i] * Vs[i * PITCH + dv]; }
            u32x4* dst = (u32x4*)(slot + SL_BV + ((w * 2 + ib) * 64 + lane) * 32);
            ST16(dst, (u32x4){cvtpk(v[0], v[1]), cvtpk(v[2], v[3]), cvtpk(v[4], v[5]), cvtpk(v[6], v[7])});
            ST16(dst + 1, (u32x4){cvtpk(v[8], v[9]), cvtpk(v[10], v[11]), cvtpk(v[12], v[13]), cvtpk(v[14], v[15])});
        }
    }
    LDS_BARRIER();
}
DI void prep_stage2(KA A, int item, float gcl, const float* ats, LAS float* M, unsigned ep) {
    int lane = threadIdx.x & 63; asm volatile("" : "+v"(lane));
    const int r = lane & 31, hh = lane >> 5, base = 32 * hh;
    unsigned char* slot = slot_ptr(A, item);
    const f32x4* Ain = (const f32x4*)ats;
#pragma unroll
    for (int tt = 0; tt < 3; ++tt) { const int jb = tt >> 1, ib = (tt + 1) >> 1;
#pragma unroll
        for (int q = 0; q < 4; ++q) { const int idx = q * 64 + lane, jj = idx >> 3, i4 = idx & 7;
            *(LAS f32x4*)(M + (32 * jb + jj) * 64 + 32 * ib + 4 * i4) = Ain[tt * 256 + idx]; } }
    LDS_WAIT(); asm volatile("" ::: "memory");
#pragma unroll 1
    for (int rb = 0; rb < 2; ++rb) {
        float acc[16];
#pragma unroll
        for (int i = 0; i < 16; ++i) acc[i] = r == 16 * rb + i ? 1.f : 0.f;
        if (rb == 1) {
#pragma unroll 4
            for (int j = 0; j < 16; ++j) {
                float tj = M[(base + j) * 64 + base + r]; tj = r <= j ? tj : 0.f;
                const LAS f32x4* ar = (const LAS f32x4*)(M + (base + j) * 64 + base + 16);
                const f32x4 a0 = ar[0], a1 = ar[1], a2 = ar[2], a3 = ar[3];
#pragma unroll
                for (int e = 0; e < 4; ++e) { acc[e] -= a0[e] * tj; acc[4 + e] -= a1[e] * tj; acc[8 + e] -= a2[e] * tj; acc[12 + e] -= a3[e] * tj; }
            }
        }
#pragma unroll
        for (int j = 0; j < 16; ++j) {
            const float tj = acc[j]; const int row = base + 16 * rb + j;
            const LAS f32x4* ar = (const LAS f32x4*)(M + row * 64 + base + 16 * rb);
            float a[16];
#pragma unroll
            for (int q = j >> 2; q < 4; ++q) { const f32x4 v = ar[q]; a[4 * q] = v[0]; a[4 * q + 1] = v[1]; a[4 * q + 2] = v[2]; a[4 * q + 3] = v[3]; }
            if (r <= 16 * rb + j) M[row * 64 + base + r] = tj;
#pragma unroll
            for (int i = j + 1; i < 16; ++i) acc[i] -= a[i] * tj;
        }
        asm volatile("" ::: "memory");
    }
    LDS_WAIT(); asm volatile("" ::: "memory");
    f32x16 X;
#pragma unroll
    for (int e = 0; e < 16; ++e) X[e] = 0.f;
#pragma unroll
    for (int s2 = 0; s2 < 16; ++s2) { const int k = 2 * s2 + hh; const float a = M[k * 64 + 32 + r]; float bb = M[k * 64 + r]; bb = r <= k ? bb : 0.f;
        X = __builtin_amdgcn_mfma_f32_32x32x2f32(a, bb, X, 0, 0, 0); }
#pragma unroll
    for (int reg = 0; reg < 16; ++reg) M[crow16(reg, hh) * 64 + 32 + r] = X[reg];
    LDS_WAIT(); asm volatile("" ::: "memory");
    f32x16 Y;
#pragma unroll
    for (int e = 0; e < 16; ++e) Y[e] = 0.f;
#pragma unroll
    for (int s2 = 0; s2 < 16; ++s2) { const int k = 2 * s2 + hh; float a = M[(32 + r) * 64 + 32 + k]; a = k <= r ? a : 0.f; const float bb = M[k * 64 + 32 + r];
        Y = __builtin_amdgcn_mfma_f32_32x32x2f32(a, bb, Y, 0, 0, 0); }
#pragma unroll
    for (int reg = 0; reg < 16; ++reg) M[(32 + crow16(reg, hh)) * 64 + r] = -Y[reg];
    LDS_WAIT(); asm volatile("" ::: "memory");
#pragma unroll
    for (int f = 0; f < 8; ++f) { const int rb = f >> 2, ks = f & 3, row = 32 * rb + r, k0 = 16 * ks + 4 * hh;
        f32x4 lo = *(const LAS f32x4*)(M + row * 64 + k0), hi = *(const LAS f32x4*)(M + row * 64 + k0 + 8);
#pragma unroll
        for (int e = 0; e < 4; ++e) { lo[e] = k0 + e <= row ? lo[e] : 0.f; hi[e] = k0 + 8 + e <= row ? hi[e] : 0.f; }
        st16_sc1(slot + SL_T + ((rb * 4 + ks) * 64 + lane) * 16, pack8f(lo, hi)); }
    LDS_WAIT();
    asm volatile("s_waitcnt vmcnt(0)" ::: "memory");
    if (lane == 0) __hip_atomic_store(item_granule(A, item), ((unsigned long long)ep << 32) | (unsigned long long)__float_as_uint(gcl), __ATOMIC_RELAXED, __HIP_MEMORY_SCOPE_AGENT);
}
DI void scan_seq(KA A, int seq, int w, int lane, unsigned ep) {
    const int r = lane & 31, hh = lane >> 5, dv = 32 * w + r;
    const bool sample = seq >= N_PROMPT_SEQ; const int sidx = sample ? seq - N_PROMPT_SEQ : seq, b = sidx >> 2, h = sidx & 3, nch = sample ? 1 : CHUNKS_P;
    f32x16 S[4];
    if (sample) {
        const float* S0 = A->state_delta + ((size_t)(b * 4 + h) * 128) * 128 + dv;
#pragma unroll
        for (int kb = 0; kb < 4; ++kb)
#pragma unroll
            for (int reg = 0; reg < 16; ++reg) S[kb][reg] = S0[(size_t)(32 * kb + crow16(reg, hh)) * 128];
    } else {
#pragma unroll
        for (int kb = 0; kb < 4; ++kb)
#pragma unroll
            for (int reg = 0; reg < 16; ++reg) S[kb][reg] = 0.f;
    }
    bf16* OBR = (bf16*)((unsigned char*)A->out + DO_OB);
#pragma unroll 1
    for (int c = 0; c < nch; ++c) {
        const int item = sample ? N_ITEMS_P + sidx : seq * CHUNKS_P + c;
        const unsigned char* slot = slot_ptr(A, item);
        const float gcl = wait_item(item_granule(A, item), ep);
        __builtin_amdgcn_fence(__ATOMIC_ACQUIRE, "agent");
        const bf16x8* bek = (const bf16x8*)(slot + SL_BEK) + lane; const bf16x8* tp = (const bf16x8*)(slot + SL_T) + lane;
        const bf16x8* qe = (const bf16x8*)(slot + SL_QE) + lane; const bf16x8* qkd = (const bf16x8*)(slot + SL_QKD) + lane; const bf16x8* kwt = (const bf16x8*)(slot + SL_KWT) + lane;
        bf16x8 sf[8];
#pragma unroll
        for (int kb = 0; kb < 4; ++kb) { sf[2 * kb] = pack_step<0>(S[kb]); sf[2 * kb + 1] = pack_step<1>(S[kb]); }
        f32x16 x0, x1;
#pragma unroll
        for (int e = 0; e < 16; ++e) { x0[e] = 0.f; x1[e] = 0.f; }
#pragma unroll
        for (int ks = 0; ks < 8; ++ks) { x0 = MFMA32(bek[ks * 64], sf[ks], x0); x1 = MFMA32(bek[(8 + ks) * 64], sf[ks], x1); }
        {
            const u32x4* bv = (const u32x4*)(slot + SL_BV) + ((w * 2) * 64 + lane) * 2;
            const u32x4 a0 = bv[0], a1 = bv[1], c0 = bv[128], c1 = bv[129];
            x0[0] = bflo(a0.x) - x0[0]; x0[1] = bfhi(a0.x) - x0[1]; x0[2] = bflo(a0.y) - x0[2]; x0[3] = bfhi(a0.y) - x0[3];
            x0[4] = bflo(a0.z) - x0[4]; x0[5] = bfhi(a0.z) - x0[5]; x0[6] = bflo(a0.w) - x0[6]; x0[7] = bfhi(a0.w) - x0[7];
            x0[8] = bflo(a1.x) - x0[8]; x0[9] = bfhi(a1.x) - x0[9]; x0[10] = bflo(a1.y) - x0[10]; x0[11] = bfhi(a1.y) - x0[11];
            x0[12] = bflo(a1.z) - x0[12]; x0[13] = bfhi(a1.z) - x0[13]; x0[14] = bflo(a1.w) - x0[14]; x0[15] = bfhi(a1.w) - x0[15];
            x1[0] = bflo(c0.x) - x1[0]; x1[1] = bfhi(c0.x) - x1[1]; x1[2] = bflo(c0.y) - x1[2]; x1[3] = bfhi(c0.y) - x1[3];
            x1[4] = bflo(c0.z) - x1[4]; x1[5] = bfhi(c0.z) - x1[5]; x1[6] = bflo(c0.w) - x1[6]; x1[7] = bfhi(c0.w) - x1[7];
            x1[8] = bflo(c1.x) - x1[8]; x1[9] = bfhi(c1.x) - x1[9]; x1[10] = bflo(c1.y) - x1[10]; x1[11] = bfhi(c1.y) - x1[11];
            x1[12] = bflo(c1.z) - x1[12]; x1[13] = bfhi(c1.z) - x1[13]; x1[14] = bflo(c1.w) - x1[14]; x1[15] = bfhi(c1.w) - x1[15];
        }
        bf16x8 rf[4] = {pack_step<0>(x0), pack_step<1>(x0), pack_step<0>(x1), pack_step<1>(x1)};
        f32x16 u0, u1;
#pragma unroll
        for (int e = 0; e < 16; ++e) { u0[e] = 0.f; u1[e] = 0.f; }
        u0 = MFMA32(tp[0 * 64], rf[0], u0); u0 = MFMA32(tp[1 * 64], rf[1], u0);
#pragma unroll
        for (int ks = 0; ks < 4; ++ks) u1 = MFMA32(tp[(4 + ks) * 64], rf[ks], u1);
        bf16x8 uf[4] = {pack_step<0>(u0), pack_step<1>(u0), pack_step<0>(u1), pack_step<1>(u1)};
        if (sample || c > 0) {
#pragma unroll
            for (int e = 0; e < 16; ++e) { x0[e] = 0.f; x1[e] = 0.f; }
#pragma unroll
            for (int ks = 0; ks < 8; ++ks) { x0 = MFMA32(qe[ks * 64], sf[ks], x0); x1 = MFMA32(qe[(8 + ks) * 64], sf[ks], x1); }
            x0 = MFMA32(qkd[0 * 64], uf[0], x0); x0 = MFMA32(qkd[1 * 64], uf[1], x0);
#pragma unroll
            for (int ks = 0; ks < 4; ++ks) x1 = MFMA32(qkd[(4 + ks) * 64], uf[ks], x1);
            const int crow0 = sample ? NBATCH * SEQ + b * TS : b * SEQ + 64 * (c - 1), L = sample ? TS : 64;
#pragma unroll
            for (int reg = 0; reg < 16; ++reg) { const int i0 = crow16(reg, hh), i1 = 32 + i0;
                if (i0 < L) OBR[(size_t)(crow0 + i0) * 512 + h * 128 + dv] = f2bf(x0[reg]);
                if (i1 < L) OBR[(size_t)(crow0 + i1) * 512 + h * 128 + dv] = f2bf(x1[reg]); }
        }
#pragma unroll
        for (int kb = 0; kb < 4; ++kb) {
            S[kb] = S[kb] * gcl;
#pragma unroll
            for (int ks = 0; ks < 4; ++ks) S[kb] = MFMA32(kwt[(kb * 4 + ks) * 64], uf[ks], S[kb]);
        }
    }
    float* So = A->out + (sample ? O_DS : O_DP) + ((size_t)(b * 4 + h) * 128) * 128 + dv;
#pragma unroll
    for (int kb = 0; kb < 4; ++kb)
#pragma unroll
        for (int reg = 0; reg < 16; ++reg) So[(size_t)(32 * kb + crow16(reg, hh)) * 128] = S[kb][reg];
}

constexpr int HALF_BYTES = 40960;
DI void scan_prompt_wg(KA A, int seq, LAS unsigned char* lds, unsigned ep) {
    const int tid = threadIdx.x, lane = tid & 63, wave = __builtin_amdgcn_readfirstlane(tid >> 6);
    const int b = seq >> 2, h = seq & 3;
    constexpr int N = 2 * CHUNKS_P;
    if (wave >= 4) {
        const int loff = (wave - 4) * 10240 + lane * 16;
        u32x4 r0[10], r1[10];
        LAS u32x4* d0 = (LAS u32x4*)(lds + loff); LAS u32x4* d1 = (LAS u32x4*)(lds + HALF_BYTES + loff);
        LAS float* gclw = (LAS float*)(lds + 2 * HALF_BYTES);
#define SCAN_LOAD(n, R) do { const int item_ = seq * CHUNKS_P + ((n) >> 1); \
            if (((n) & 1) == 0) { const float g_ = wait_item(item_granule(A, item_), ep); if (wave == 4 && lane == 0) gclw[((n) >> 1) & 3] = g_; } \
            const __amdgpu_buffer_rsrc_t rs_ = __builtin_amdgcn_make_buffer_rsrc((void*)slot_ptr(A, item_), 0, (int)PREP_SLOT, 0x00020000); \
            _Pragma("unroll") for (int q = 0; q < 10; ++q) R[q] = __builtin_bit_cast(u32x4, __builtin_amdgcn_raw_buffer_load_b128(rs_, ((n) & 1) * HALF_BYTES + loff + q * 1024, 0, 16)); } while (0)
        SCAN_LOAD(0, r0);
#pragma unroll
        for (int q = 0; q < 10; ++q) d0[q * 64] = r0[q];
        SCAN_LOAD(1, r1);
        LDS_BARRIER();
#pragma unroll 1
        for (int n = 0; n < N; n += 2) {
            if (n + 2 < N) SCAN_LOAD(n + 2, r0);
#pragma unroll
            for (int q = 0; q < 10; ++q) d1[q * 64] = r1[q];
            LDS_BARRIER();
            if (n + 3 < N) SCAN_LOAD(n + 3, r1);
            if (n + 2 < N) {
#pragma unroll
                for (int q = 0; q < 10; ++q) d0[q * 64] = r0[q]; }
            LDS_BARRIER();
        }
#undef SCAN_LOAD
    } else {
        const int w = wave, r = lane & 31, hh = lane >> 5, dv = 32 * w + r;
        f32x16 S[4];
#pragma unroll
        for (int kb = 0; kb < 4; ++kb)
#pragma unroll
            for (int reg = 0; reg < 16; ++reg) S[kb][reg] = 0.f;
        bf16* OBR = (bf16*)((unsigned char*)A->out + DO_OB);
        const LAS float* gclw = (const LAS float*)(lds + 2 * HALF_BYTES);
        const LAS bf16x8* bek = (const LAS bf16x8*)(lds + SL_BEK) + lane; const LAS bf16x8* tp = (const LAS bf16x8*)(lds + SL_T) + lane;
        const LAS u32x4* bv = (const LAS u32x4*)(lds + SL_BV) + ((w * 2) * 64 + lane) * 2;
        const LAS bf16x8* qkd = (const LAS bf16x8*)(lds + HALF_BYTES + (SL_QKD - HALF_BYTES)) + lane; const LAS bf16x8* qe = (const LAS bf16x8*)(lds + HALF_BYTES + (SL_QE - HALF_BYTES)) + lane;
        const LAS bf16x8* kwt = (const LAS bf16x8*)(lds + HALF_BYTES + (SL_KWT - HALF_BYTES)) + lane;
        LDS_BARRIER();
#pragma unroll 1
        for (int c = 0; c < CHUNKS_P; ++c) {
            bf16x8 sf[8];
#pragma unroll
            for (int kb = 0; kb < 4; ++kb) { sf[2 * kb] = pack_step<0>(S[kb]); sf[2 * kb + 1] = pack_step<1>(S[kb]); }
            f32x16 x0, x1;
#pragma unroll
            for (int e = 0; e < 16; ++e) { x0[e] = 0.f; x1[e] = 0.f; }
#pragma unroll
            for (int ks = 0; ks < 8; ++ks) { x0 = MFMA32(bek[ks * 64], sf[ks], x0); x1 = MFMA32(bek[(8 + ks) * 64], sf[ks], x1); }
            {
                const u32x4 a0 = bv[0], a1 = bv[1], c0 = bv[128], c1 = bv[129];
                x0[0] = bflo(a0.x) - x0[0]; x0[1] = bfhi(a0.x) - x0[1]; x0[2] = bflo(a0.y) - x0[2]; x0[3] = bfhi(a0.y) - x0[3];
                x0[4] = bflo(a0.z) - x0[4]; x0[5] = bfhi(a0.z) - x0[5]; x0[6] = bflo(a0.w) - x0[6]; x0[7] = bfhi(a0.w) - x0[7];
                x0[8] = bflo(a1.x) - x0[8]; x0[9] = bfhi(a1.x) - x0[9]; x0[10] = bflo(a1.y) - x0[10]; x0[11] = bfhi(a1.y) - x0[11];
                x0[12] = bflo(a1.z) - x0[12]; x0[13] = bfhi(a1.z) - x0[13]; x0[14] = bflo(a1.w) - x0[14]; x0[15] = bfhi(a1.w) - x0[15];
                x1[0] = bflo(c0.x) - x1[0]; x1[1] = bfhi(c0.x) - x1[1]; x1[2] = bflo(c0.y) - x1[2]; x1[3] = bfhi(c0.y) - x1[3];
                x1[4] = bflo(c0.z) - x1[4]; x1[5] = bfhi(c0.z) - x1[5]; x1[6] = bflo(c0.w) - x1[6]; x1[7] = bfhi(c0.w) - x1[7];
                x1[8] = bflo(c1.x) - x1[8]; x1[9] = bfhi(c1.x) - x1[9]; x1[10] = bflo(c1.y) - x1[10]; x1[11] = bfhi(c1.y) - x1[11];
                x1[12] = bflo(c1.z) - x1[12]; x1[13] = bfhi(c1.z) - x1[13]; x1[14] = bflo(c1.w) - x1[14]; x1[15] = bfhi(c1.w) - x1[15];
            }
            bf16x8 rf[4] = {pack_step<0>(x0), pack_step<1>(x0), pack_step<0>(x1), pack_step<1>(x1)};
            f32x16 u0, u1;
#pragma unroll
            for (int e = 0; e < 16; ++e) { u0[e] = 0.f; u1[e] = 0.f; }
            u0 = MFMA32(tp[0 * 64], rf[0], u0); u0 = MFMA32(tp[1 * 64], rf[1], u0);
#pragma unroll
            for (int ks = 0; ks < 4; ++ks) u1 = MFMA32(tp[(4 + ks) * 64], rf[ks], u1);
            bf16x8 uf[4] = {pack_step<0>(u0), pack_step<1>(u0), pack_step<0>(u1), pack_step<1>(u1)};
            LDS_BARRIER();
            if (c > 0) {
#pragma unroll
                for (int e = 0; e < 16; ++e) { x0[e] = 0.f; x1[e] = 0.f; }
#pragma unroll
                for (int ks = 0; ks < 8; ++ks) { x0 = MFMA32(qe[ks * 64], sf[ks], x0); x1 = MFMA32(qe[(8 + ks) * 64], sf[ks], x1); }
                x0 = MFMA32(qkd[0 * 64], uf[0], x0); x0 = MFMA32(qkd[1 * 64], uf[1], x0);
#pragma unroll
                for (int ks = 0; ks < 4; ++ks) x1 = MFMA32(qkd[(4 + ks) * 64], uf[ks], x1);
                bf16* orow = OBR + (size_t)(b * SEQ + 64 * (c - 1)) * 512 + h * 128 + dv;
#pragma unroll
                for (int reg = 0; reg < 16; ++reg) { const int i0 = crow16(reg, hh); orow[(size_t)i0 * 512] = f2bf(x0[reg]); orow[(size_t)(32 + i0) * 512] = f2bf(x1[reg]); }
            }
            const float gcl = gclw[c & 3];
#pragma unroll
            for (int kb = 0; kb < 4; ++kb) {
                S[kb] = S[kb] * gcl;
#pragma unroll
                for (int ks = 0; ks < 4; ++ks) S[kb] = MFMA32(kwt[(kb * 4 + ks) * 64], uf[ks], S[kb]);
            }
            LDS_BARRIER();
        }
        float* So = A->out + O_DP + ((size_t)(b * 4 + h) * 128) * 128 + dv;
#pragma unroll
        for (int kb = 0; kb < 4; ++kb)
#pragma unroll
            for (int reg = 0; reg < 16; ++reg) So[(size_t)(32 * kb + crow16(reg, hh)) * 128] = S[kb][reg];
    }
}

constexpr int KPITCH = 72, VPITCH = 264;
DI void attn_unit(KA A, int unit, LAS unsigned char* ldsb) {
    const int tid = threadIdx.x, lane = tid & 63, wave = __builtin_amdgcn_readfirstlane(tid >> 6), r = lane & 31, hh = lane >> 5;
    const int b = unit >> 6, kh = (unit >> 5) & 1, jb = unit & 31, T0 = NMETA + 128 * jb;
    LAS bf16* Ksm = (LAS bf16*)ldsb; LAS bf16* VTs = Ksm + 256 * KPITCH;
    const bf16* KVg = (const bf16*)(A->ws + WS_KV); const bf16* QAg = (const bf16*)(A->ws + WS_QA);
#pragma unroll
    for (int e4 = 0; e4 < 4; ++e4) {
        const int id = tid + 512 * e4, key = id >> 3, cch = id & 7, tk = T0 - 128 + key;
        u32x4 kq = (u32x4){0u, 0u, 0u, 0u}, vq = kq;
        if (tk >= 0) { const bf16* src = KVg + (size_t)(b * TP + tk) * 256 + kh * 64 + 8 * cch; kq = *(const u32x4*)src; vq = *(const u32x4*)(src + 128); }
        *(LAS u32x4*)(Ksm + key * KPITCH + 8 * cch) = kq;
        const int kkk = key & 15, pos = (key & ~15) + 8 * ((kkk >> 2) & 1) + (((kkk >> 3) << 2) | (kkk & 3));
        LAS bf16* vd = VTs + (8 * cch) * VPITCH + pos;
        vd[0 * VPITCH] = (bf16)(vq.x & 0xffffu); vd[1 * VPITCH] = (bf16)(vq.x >> 16); vd[2 * VPITCH] = (bf16)(vq.y & 0xffffu); vd[3 * VPITCH] = (bf16)(vq.y >> 16);
        vd[4 * VPITCH] = (bf16)(vq.z & 0xffffu); vd[5 * VPITCH] = (bf16)(vq.z >> 16); vd[6 * VPITCH] = (bf16)(vq.w & 0xffffu); vd[7 * VPITCH] = (bf16)(vq.w >> 16);
    }
    LDS_BARRIER();
    const int g = wave >> 1, qh = wave & 1, head = 4 * kh + g;
    const float sink2 = A->sinks[head] * 1.4426950408889634f;
    const int kmin = jb == 0 ? 128 - NMETA : 0;
#pragma unroll 1
    for (int q2 = 0; q2 < 2; ++q2) {
        const int qb = 2 * qh + q2, iq = 32 * qb + r;
        const bf16* qrow = QAg + (size_t)(b * TP + T0 + iq) * 512 + head * 64 + 8 * hh;
        bf16x8 qf[4];
#pragma unroll
        for (int s = 0; s < 4; ++s) qf[s] = *(const bf16x8*)(qrow + 16 * s);
        f32x16 st[5];
        float m = sink2;
#pragma unroll
        for (int kt5 = 0; kt5 < 5; ++kt5) {
            const int kt = qb + kt5;
            f32x16 acc;
#pragma unroll
            for (int e = 0; e < 16; ++e) acc[e] = 0.f;
#pragma unroll
            for (int s = 0; s < 4; ++s) acc = MFMA32(*(const LAS bf16x8*)(Ksm + (32 * kt + r) * KPITCH + 16 * s + 8 * hh), qf[s], acc);
#pragma unroll
            for (int reg = 0; reg < 16; ++reg) { const int kk = 32 * kt + crow16(reg, hh); const bool ok = kk >= iq && kk <= iq + 128 && kk >= kmin;
                acc[reg] = ok ? acc[reg] : -INFINITY; m = fmaxf(m, acc[reg]); }
            st[kt5] = acc;
        }
        m = fmaxf(m, __shfl_xor(m, 32));
        float l = 0.f;
#pragma unroll
        for (int kt5 = 0; kt5 < 5; ++kt5)
#pragma unroll
            for (int reg = 0; reg < 16; ++reg) { const float p = exp2f(st[kt5][reg] - m); st[kt5][reg] = p; l += p; }
        l += __shfl_xor(l, 32); l += exp2f(sink2 - m);
        f32x16 o0, o1;
#pragma unroll
        for (int e = 0; e < 16; ++e) { o0[e] = 0.f; o1[e] = 0.f; }
#pragma unroll
        for (int kt5 = 0; kt5 < 5; ++kt5) {
            const int kt = qb + kt5;
            const bf16x8 p0 = pack_step<0>(st[kt5]), p1 = pack_step<1>(st[kt5]);
            const LAS bf16* vb = VTs + r * VPITCH + 32 * kt + 8 * hh;
            o0 = MFMA32(*(const LAS bf16x8*)(vb), p0, o0); o0 = MFMA32(*(const LAS bf16x8*)(vb + 16), p1, o0);
            o1 = MFMA32(*(const LAS bf16x8*)(vb + 32 * VPITCH), p0, o1); o1 = MFMA32(*(const LAS bf16x8*)(vb + 32 * VPITCH + 16), p1, o1);
        }
        const float rl = 1.0f / l;
        bf16* orow = (bf16*)((unsigned char*)A->out + DO_OA) + (size_t)(b * SEQ + 128 * jb + iq) * 512 + head * 64 + 4 * hh;
#pragma unroll
        for (int g4 = 0; g4 < 4; ++g4) {
            *(u32x2*)(orow + 8 * g4) = (u32x2){cvtpk(o0[4 * g4] * rl, o0[4 * g4 + 1] * rl), cvtpk(o0[4 * g4 + 2] * rl, o0[4 * g4 + 3] * rl)};
            *(u32x2*)(orow + 32 + 8 * g4) = (u32x2){cvtpk(o1[4 * g4] * rl, o1[4 * g4 + 1] * rl), cvtpk(o1[4 * g4 + 2] * rl, o1[4 * g4 + 3] * rl)};
        }
    }
    LDS_BARRIER();
}
DI void sample_attn(KA A, int b, int head, LAS float* wl, int lane) {
    const int kh = head >> 2;
    LAS float* qn = wl; LAS float* ps = wl + 256;
    const bf16* QAg = (const bf16*)(A->ws + WS_QA); const bf16* KVg = (const bf16*)(A->ws + WS_KV);
#pragma unroll
    for (int i = 0; i < 4; ++i) qn[i * 64 + lane] = bf2f(QAg[(size_t)(MP + b * TS + i) * 512 + head * 64 + pos_of_d(lane)]);
    LDS_WAIT(); asm volatile("" ::: "memory");
    const float sink2 = A->sinks[head] * 1.4426950408889634f;
#pragma unroll 1
    for (int kq = 0; kq < 3; ++kq) {
        const int kj = lane + 64 * kq;
        float sc0 = 0.f, sc1 = 0.f, sc2 = 0.f, sc3 = 0.f;
        if (kj < 128) {
            const f32x4* kr = (const f32x4*)(A->cache_k + ((size_t)(b * 128 + kj) * 2 + kh) * 64);
#pragma unroll 4
            for (int d4 = 0; d4 < 16; ++d4) { const f32x4 kv = kr[d4];
                const f32x4 q0 = *(const LAS f32x4*)(qn + 4 * d4), q1 = *(const LAS f32x4*)(qn + 64 + 4 * d4), q2 = *(const LAS f32x4*)(qn + 128 + 4 * d4), q3 = *(const LAS f32x4*)(qn + 192 + 4 * d4);
                sc0 += (kv[0] * q0[0] + kv[1] * q0[1]) + (kv[2] * q0[2] + kv[3] * q0[3]); sc1 += (kv[0] * q1[0] + kv[1] * q1[1]) + (kv[2] * q1[2] + kv[3] * q1[3]);
                sc2 += (kv[0] * q2[0] + kv[1] * q2[1]) + (kv[2] * q2[2] + kv[3] * q2[3]); sc3 += (kv[0] * q3[0] + kv[1] * q3[1]) + (kv[2] * q3[2] + kv[3] * q3[3]); }
        } else if (kj < 132) {
            const bf16* kr = KVg + (size_t)(MP + b * TS + (kj - 128)) * 256 + kh * 64;
#pragma unroll 4
            for (int p = 0; p < 64; ++p) { const float kv = bf2f(kr[p]); const int d = d_of_pos(p);
                sc0 += kv * qn[d]; sc1 += kv * qn[64 + d]; sc2 += kv * qn[128 + d]; sc3 += kv * qn[192 + d]; }
        }
        if (kj < 132) {
            ps[0 * 132 + kj] = (kj >= 0 && kj <= 128) ? sc0 : -INFINITY; ps[1 * 132 + kj] = (kj >= 1 && kj <= 129) ? sc1 : -INFINITY;
            ps[2 * 132 + kj] = (kj >= 2 && kj <= 130) ? sc2 : -INFINITY; ps[3 * 132 + kj] = (kj >= 3 && kj <= 131) ? sc3 : -INFINITY; }
    }
    LDS_WAIT(); asm volatile("" ::: "memory");
    float linv[4];
#pragma unroll
    for (int i = 0; i < 4; ++i) {
        const float s0 = ps[i * 132 + lane], s1 = ps[i * 132 + 64 + lane], s2 = lane < 4 ? ps[i * 132 + 128 + lane] : -INFINITY;
        const float m = wave_max(fmaxf(fmaxf(s0, s1), fmaxf(s2, sink2)));
        const float p0 = exp2f(s0 - m), p1 = exp2f(s1 - m), p2 = exp2f(s2 - m);
        ps[i * 132 + lane] = p0; ps[i * 132 + 64 + lane] = p1; if (lane < 4) ps[i * 132 + 128 + lane] = p2;
        linv[i] = 1.0f / (wave_sum(p0 + p1 + p2) + exp2f(sink2 - m));
    }
    LDS_WAIT(); asm volatile("" ::: "memory");
    float o[4] = {0.f, 0.f, 0.f, 0.f};
#pragma unroll 4
    for (int kj = 0; kj < 128; ++kj) { const float v = A->cache_v[((size_t)(b * 128 + kj) * 2 + kh) * 64 + lane];
#pragma unroll
        for (int i = 0; i < 4; ++i) o[i] += ps[i * 132 + kj] * v; }
#pragma unroll
    for (int kj = 128; kj < 132; ++kj) { const float v = bf2f(KVg[(size_t)(MP + b * TS + (kj - 128)) * 256 + 128 + kh * 64 + lane]);
#pragma unroll
        for (int i = 0; i < 4; ++i) o[i] += ps[i * 132 + kj] * v; }
    bf16* OAg = (bf16*)((unsigned char*)A->out + DO_OA);
#pragma unroll
    for (int i = 0; i < 4; ++i) OAg[(size_t)(NBATCH * SEQ + b * TS + i) * 512 + head * 64 + lane] = f2bf(o[i] * linv[i]);
    LDS_WAIT(); asm volatile("" ::: "memory");
}
constexpr int NINV_WG = 24;
DI void p23_mixers(KA A, LAS unsigned char* lds, const XcdBarrier& dbg_bar, unsigned ep, int pmode = 0) {
    const int tid = threadIdx.x, lane = tid & 63, wave = __builtin_amdgcn_readfirstlane(tid >> 6), G = gridDim.x, wg = blockIdx.x;
    const int NSCAN = N_PROMPT_SEQ, NP = G - NSCAN - NINV_WG;
    if (wg < NSCAN) { if (!(pmode & 2)) scan_prompt_wg(A, wg, lds, ep); return; }
    if (wg < NSCAN + NINV_WG) {
        const int wv = (wg - NSCAN) * NWAVES + wave, NWV = NINV_WG * NWAVES;
#pragma unroll 1
        for (int m = wv; m < N_ITEMS; m += NWV) {
            const int item = order_item(m), p = m % NP, k = m / NP;
            const float gcl = wait_item(item_flag1(A, item), ep);
            __builtin_amdgcn_fence(__ATOMIC_ACQUIRE, "agent");
            const float* ats = (const float*)((const unsigned char*)A->out + DO_ATS + ((size_t)p * 8 + (k & 7)) * ATS_ITEM);
            if (pmode & 16) { if (lane == 0) __hip_atomic_store(item_granule(A, item), ((unsigned long long)ep << 32), __ATOMIC_RELAXED, __HIP_MEMORY_SCOPE_AGENT); }
            else prep_stage2(A, item, gcl, ats, (LAS float*)(lds + wave * 16384), ep);
        }
        return;
    }
    const int p = wg - NSCAN - NINV_WG;
    {
        const int ntot = p < N_ITEMS ? (N_ITEMS - 1 - p) / NP + 1 : 0;
        S1Pre P;
        if (ntot > 0) stage1_issue(A, order_item(p), P);
        int prev = -1;
#pragma unroll 1
        for (int k = 0; k < ntot; ++k) {
            const int m = p + NP * k, item = order_item(m), nxt = k + 1 < ntot ? order_item(m + NP) : N_ITEMS;
            float* ats = (float*)((unsigned char*)A->out + DO_ATS + ((size_t)p * 8 + (k & 7)) * ATS_ITEM);
            prep_stage1(A, item, nxt, prev, k >= 8 ? order_item(m - 8 * NP) : -1, k & 1, ats, P, lds, ep, pmode);
            prev = item;
        }
        asm volatile("s_waitcnt vmcnt(0)" ::: "memory"); __syncthreads();
        if (prev >= 0 && tid == 0) __hip_atomic_store(item_flag1(A, prev), ((unsigned long long)ep << 32) | (unsigned long long)__float_as_uint(((const LAS float*)(lds + LDS_GCL))[(ntot - 1) & 1]), __ATOMIC_RELAXED, __HIP_MEMORY_SCOPE_AGENT);
    }
    if (pmode & 1) return;
    for (int u = p; u < NBATCH * NKV * 32; u += NP) attn_unit(A, u, lds);
    const int worker = p * NWAVES + wave, NW = NP * NWAVES;
    LAS float* wl = (LAS float*)(lds + 98304 + wave * 4096);
    for (int it = worker; it < SBATCH * NHB * 4 + SBATCH * NHA; it += NW) {
        if (it < SBATCH * NHB * 4) scan_seq(A, N_PROMPT_SEQ + (it >> 2), it & 3, lane, ep);
        else { const int q = it - SBATCH * NHB * 4; sample_attn(A, q >> 3, q & 7, wl, lane); }
    }
}

DI void p3b_gated_norm(KA A) {
    const int tid = threadIdx.x, lane = tid & 63, wave = tid >> 6, gw = blockIdx.x * NWAVES + wave, NGW = gridDim.x * NWAVES;
    const int head = lane >> 4, dv0 = 8 * (lane & 15);
    const f32x4 w0 = *(const f32x4*)(A->gdn_norm + dv0), w1 = *(const f32x4*)(A->gdn_norm + dv0 + 4);
    bf16* OBg = (bf16*)((unsigned char*)A->out + DO_OB); const bf16* Zg = (const bf16*)(A->ws + WS_Z);
    for (int crow = gw; crow < MC; crow += NGW) {
        const u32x4 ow = *(const u32x4*)(OBg + (size_t)crow * 512 + head * 128 + dv0);
        const f32x4 a = {bflo(ow.x), bfhi(ow.x), bflo(ow.y), bfhi(ow.y)}, c = {bflo(ow.z), bfhi(ow.z), bflo(ow.w), bfhi(ow.w)};
        float ss = (a[0] * a[0] + a[1] * a[1]) + (a[2] * a[2] + a[3] * a[3]) + (c[0] * c[0] + c[1] * c[1]) + (c[2] * c[2] + c[3] * c[3]);
        ss += __shfl_xor(ss, 1); ss += __shfl_xor(ss, 2); ss += __shfl_xor(ss, 4); ss += __shfl_xor(ss, 8);
        const float rstd = rsqrtf(ss * (1.0f / 128.0f) + EPS);
        const u32x4 zw = *(const u32x4*)(Zg + (size_t)pg8::crow_to_urow(crow) * 512 + head * 128 + dv0);
        f32x4 y0, y1;
        y0[0] = a[0] * rstd * w0[0] * siluf_(bflo(zw.x)); y0[1] = a[1] * rstd * w0[1] * siluf_(bfhi(zw.x)); y0[2] = a[2] * rstd * w0[2] * siluf_(bflo(zw.y)); y0[3] = a[3] * rstd * w0[3] * siluf_(bfhi(zw.y));
        y1[0] = c[0] * rstd * w1[0] * siluf_(bflo(zw.z)); y1[1] = c[1] * rstd * w1[1] * siluf_(bfhi(zw.z)); y1[2] = c[2] * rstd * w1[2] * siluf_(bflo(zw.w)); y1[3] = c[3] * rstd * w1[3] * siluf_(bfhi(zw.w));
        *(u32x4*)(OBg + (size_t)crow * 512 + head * 128 + dv0) = pack8f(y0, y1);
    }
}
DI void p8_final_norm(KA A) {
    const int tid = threadIdx.x, lane = tid & 63, wave = tid >> 6, gw = blockIdx.x * NWAVES + wave, NGW = gridDim.x * NWAVES;
    f32x4 nf[4];
#pragma unroll
    for (int j = 0; j < 4; ++j) nf[j] = ((const f32x4*)A->norm_final)[lane + 64 * j];
    for (int crow = gw; crow < MC; crow += NGW) {
        f32x4* row = (f32x4*)(A->out + (size_t)crow * D);
        f32x4 v[4]; float ss = 0.f;
#pragma unroll
        for (int j = 0; j < 4; ++j) { v[j] = row[lane + 64 * j]; ss += (v[j][0] * v[j][0] + v[j][1] * v[j][1]) + (v[j][2] * v[j][2] + v[j][3] * v[j][3]); }
        const float rstd = rsqrtf(wave_sum(ss) * (1.0f / D) + EPS);
#pragma unroll
        for (int j = 0; j < 4; ++j) row[lane + 64 * j] = v[j] * rstd * nf[j];
    }
}
__global__ void __launch_bounds__(NTHREADS, 2) hybrid_fwd(Args Aval) {
    extern __shared__ __attribute__((aligned(16))) unsigned char lds_raw[];
    LAS unsigned char* lds = (LAS unsigned char*)lds_raw;
    const int tid = threadIdx.x;
    int lo, hi; { KA A0 = kargs(); lo = A0->ph_lo; hi = A0->ph_hi; }
#if MK_N_LAUNCHES == 1
#if MK_BARRIER == 1
    volatile LAS unsigned* MISC = (volatile LAS unsigned*)(lds + LDS_MISC);
    if (tid < 64) MISC[tid] = 0u;
    __syncthreads();
    XcdBarrier bar; { KA A0 = kargs(); bar = xcd_barrier_post((unsigned*)(A0->ws + WS_CTL) + 4096, MISC + 8); }
#define GRID_BAR() xcd_barrier(bar)
#else
    cg::grid_group grid = cg::this_grid();
#define GRID_BAR() grid.sync()
#endif
#else
#define GRID_BAR() do {} while (0)
#endif
#ifndef PH_MASK
#define PH_MASK 0x1ff
#endif
#define IN(k) (((PH_MASK >> (k)) & 1) && lo <= (k) && (k) < hi)
#ifndef PROBE_REP
#define PROBE_REP -1
#endif
#define NREP(k) (PROBE_REP == (k) ? 2 : 1)
#define SEAM(k) do { if (IN(k) && IN((k) + 1)) GRID_BAR(); } while (0)
    const int G = gridDim.x, wgid = blockIdx.x;
#if PROBE_REP == 0
    if (IN(0)) { KA A = kargs(); p0_prologue(A, lds); __syncthreads(); }
#endif
    if (IN(0)) { KA A = kargs(); p0_prologue(A, lds); } SEAM(0);
    if (IN(1)) for (int rep = 0; rep < NREP(1); ++rep) { KA A = kargs(); unsigned char* ws = A->ws;
        pg8::Gemm g{(const bf16*)(ws + WS_XN), (const bf16*)(ws + WS_WIN), MUP, NIN, D}; pg8::StaticOrder S; S.init(MUP, NIN, G, wgid);
        pg8::EpiInProj E{(bf16*)(ws + WS_QA), (bf16*)(ws + WS_KV), (bf16*)(ws + WS_QKVB), (bf16*)(ws + WS_Z), (bf16*)(ws + WS_G),
                         (const float*)(ws + WS_ROPE), (const float*)(ws + WS_ROPE) + (TP + TS) * 32, A->out};
        pg8::gemm_phase<pg8::EpiInProj, pg8::StaticOrder, true, true>(lds, g, S, E);
    } SEAM(1);
#ifndef PROBE_MODE
#define PROBE_MODE 0
#endif
#if PROBE_REP == 2
    if (IN(2)) { KA A = kargs(); p23_mixers(A, lds, bar, 1u); GRID_BAR(); }
    if (IN(2)) { KA A = kargs(); p23_mixers(A, lds, bar, 2u, PROBE_MODE); } SEAM(2);
#else
    if (IN(2)) { KA A = kargs(); p23_mixers(A, lds, bar, 1u); } SEAM(2);
#endif
    if (IN(3)) for (int rep = 0; rep < NREP(3); ++rep) { KA A = kargs(); p3b_gated_norm(A); } SEAM(3);
    if (IN(4)) for (int rep = 0; rep < NREP(4); ++rep) { KA A = kargs(); unsigned char* ws = A->ws;
        const bf16* OAp = (const bf16*)((unsigned char*)A->out + DO_OA); const bf16* OBp = (const bf16*)((unsigned char*)A->out + DO_OB);
        { pg8::Gemm g{OAp, (const bf16*)(ws + WS_WOA), MC, D, 512}; pg8::StaticOrder S; S.init(MC, D, G, wgid); S.lim = (S.nwg / G) * G;
          pg8::EpiMerge<false> E{(bf16*)(ws + WS_MB), (const bf16*)(ws + WS_G), 0};
          pg8::gemm_phase<pg8::EpiMerge<false>, pg8::StaticOrder, true, true>(lds, g, S, E); }
        asm volatile("s_waitcnt vmcnt(0)" ::: "memory"); __syncthreads();
        { pg8::Gemm g{OBp, (const bf16*)(ws + WS_WOB), MC, D, 512}; pg8::StaticOrder S; S.init(MC, D, G, wgid); S.lim = (S.nwg / G) * G;
          pg8::EpiMerge<true> E{(bf16*)(ws + WS_MB), (const bf16*)(ws + WS_G), 1024};
          pg8::gemm_phase<pg8::EpiMerge<true>, pg8::StaticOrder, true, true>(lds, g, S, E); }
        { const int nstr = (MC / 256) * 4 - ((MC / 256) * 4 / G) * G;
          if (wgid < nstr * 4) { const int t = wgid >> 2, sl = wgid & 3, isb = sl >> 1, koff = (sl & 1) * 256;
            pg8::Gemm g{(isb ? OBp : OAp) + koff, (const bf16*)(ws + (isb ? WS_WOB : WS_WOA)) + koff, MC, D, 256, 512};
            pg8::SliceOrder S; S.init_slice(MC, D, G, ((MC / 256) * 4 / G) * G, t);
            pg8::EpiSplit<pg8::EpiStoreMB, true> E{pg8::EpiStoreMB{(bf16*)(ws + WS_MB)}, (float*)(ws + WS_SCR) + (size_t)t * 65536, (unsigned*)(ws + WS_CTL + CTL_SPL) + t * 8, 4u, (const bf16*)(ws + WS_G), isb ? 1024 : 0};
            pg8::gemm_phase<pg8::EpiSplit<pg8::EpiStoreMB, true>, pg8::SliceOrder, true, true>(lds, g, S, E); } }
    } SEAM(4);
    if (IN(5)) { KA A = kargs(); unsigned char* ws = A->ws;
        { pg8::Gemm g{(const bf16*)(ws + WS_MB), (const bf16*)(ws + WS_WOUT), MC, D, D}; pg8::StaticOrder S; S.init(MC, D, G, wgid); S.lim = (S.nwg / G) * G;
          pg8::EpiWout<true> E{A->x_prompt, A->x_sample, (bf16*)(ws + WS_HB1), (float*)(ws + WS_CTL + CTL_SS1)};
          pg8::gemm_phase<pg8::EpiWout<true>, pg8::StaticOrder, true, true>(lds, g, S, E); }
        { const int nstr = (MC / 256) * 4 - ((MC / 256) * 4 / G) * G;
          if (wgid < nstr * 4) { const int t = wgid >> 2, koff = (wgid & 3) * 256;
            pg8::Gemm g{(const bf16*)(ws + WS_MB) + koff, (const bf16*)(ws + WS_WOUT) + koff, MC, D, 256, D};
            pg8::SliceOrder S; S.init_slice(MC, D, G, ((MC / 256) * 4 / G) * G, t);
            pg8::EpiSplit<pg8::EpiWout<true>, false> E{pg8::EpiWout<true>{A->x_prompt, A->x_sample, (bf16*)(ws + WS_HB1), (float*)(ws + WS_CTL + CTL_SS1)}, (float*)(ws + WS_SCR) + (size_t)t * 65536, (unsigned*)(ws + WS_CTL + CTL_SPL) + t * 8, 4u, nullptr, 0};
            pg8::gemm_phase<pg8::EpiSplit<pg8::EpiWout<true>, false>, pg8::SliceOrder, true, true>(lds, g, S, E); } }
    } SEAM(5);
    if (IN(6)) for (int rep = 0; rep < NREP(6); ++rep) { KA A = kargs(); unsigned char* ws = A->ws;
        pg8::Gemm g{(const bf16*)(ws + WS_HB1), (const bf16*)(ws + WS_WGU), MC, 2 * DFF, D}; pg8::StaticOrder S; S.init(MC, 2 * DFF, G, wgid);
        pg8::EpiGateUp E{(bf16*)(ws + WS_ACT), (const float*)(ws + WS_CTL + CTL_SS1)};
        pg8::gemm_phase<pg8::EpiGateUp, pg8::StaticOrder, true, true>(lds, g, S, E);
    } SEAM(6);
    if (IN(7)) for (int rep = 0; rep < NREP(7); ++rep) { KA A = kargs(); unsigned char* ws = A->ws;
        { pg8::Gemm g{(const bf16*)(ws + WS_ACT), (const bf16*)(ws + WS_WD), MC, D, DFF}; pg8::StaticOrder S; S.init(MC, D, G, wgid); S.lim = (S.nwg / G) * G;
          pg8::EpiDown<false> E{(const bf16*)(ws + WS_HB1), A->out};
          pg8::gemm_phase<pg8::EpiDown<false>, pg8::StaticOrder, true, true>(lds, g, S, E); }
        { const int nstr = (MC / 256) * 4 - ((MC / 256) * 4 / G) * G;
          if (wgid < nstr * 11) { const int t = wgid / 11, koff = (wgid % 11) * 256;
            pg8::Gemm g{(const bf16*)(ws + WS_ACT) + koff, (const bf16*)(ws + WS_WD) + koff, MC, D, 256, DFF};
            pg8::SliceOrder S; S.init_slice(MC, D, G, ((MC / 256) * 4 / G) * G, t);
            pg8::EpiSplit<pg8::EpiDown<false>, false> E{pg8::EpiDown<false>{(const bf16*)(ws + WS_HB1), A->out}, (float*)(ws + WS_SCR) + (size_t)t * 65536, (unsigned*)(ws + WS_CTL + CTL_SPL) + t * 8, 11u, nullptr, 0};
            pg8::gemm_phase<pg8::EpiSplit<pg8::EpiDown<false>, false>, pg8::SliceOrder, true, true>(lds, g, S, E); } }
    } SEAM(7);
    if (IN(8)) { KA A = kargs(); p8_final_norm(A); }
#undef IN
#undef SEAM
}

extern "C" void kernel_launch(void* const* d_in, const int* in_sizes, int n_in, void* d_out, int out_size, void* d_ws, size_t ws_size, hipStream_t stream) {
    static int grid = 0;
    if (grid == 0) {
        if (n_in != 22 || out_size != (int)O_END || ws_size < WS_END) { fprintf(stderr, "kernel_launch: unexpected problem (n_in %d, out %d, ws %zu)\n", n_in, out_size, ws_size); grid = -1; return; }
        int dev = 0, cus = 0, per_cu = 0;
        if (hipGetDevice(&dev) != hipSuccess || hipDeviceGetAttribute(&cus, hipDeviceAttributeMultiprocessorCount, dev) != hipSuccess) { grid = -1; return; }
        if (hipFuncSetAttribute((const void*)hybrid_fwd, hipFuncAttributeMaxDynamicSharedMemorySize, LDS_BYTES) != hipSuccess) { fprintf(stderr, "kernel_launch: hipFuncSetAttribute failed\n"); grid = -1; return; }
        if (hipOccupancyMaxActiveBlocksPerMultiprocessor(&per_cu, (const void*)hybrid_fwd, NTHREADS, LDS_BYTES) != hipSuccess || per_cu < 1) { fprintf(stderr, "kernel_launch: occupancy query says %d\n", per_cu); per_cu = 1; }
        (void)hipGetLastError();
        grid = cus;
        if (grid > 256) grid = 256;
    }
    if (grid < 0) return;
    (void)hipMemsetAsync((char*)d_ws + WS_CTL, 0, CTL_BYTES, stream);
    (void)hipMemsetAsync((char*)d_ws + WS_SCR, 0, SCR_BYTES, stream);
    Args a{};
    const float** ap = (const float**)&a;
    for (int i = 0; i < 22; ++i) ap[i] = (const float*)d_in[i];
    a.out = (float*)d_out; a.ws = (unsigned char*)d_ws;
#if MK_N_LAUNCHES == 1
    a.ph_lo = 0; a.ph_hi = N_PHASES;
#if MK_BARRIER == 1
    hipLaunchKernelGGL(hybrid_fwd, dim3(grid), dim3(NTHREADS), LDS_BYTES, stream, a);
#else
    void* args[] = {&a};
    hipError_t e = hipLaunchCooperativeKernel((const void*)hybrid_fwd, dim3(grid), dim3(NTHREADS), args, LDS_BYTES, stream);
    if (e != hipSuccess) fprintf(stderr, "cooperative launch failed: %s (grid %d)\n", hipGetErrorString(e), grid);
#endif
#else
    for (int p = 0; p < N_PHASES; ++p) { a.ph_lo = p; a.ph_hi = p + 1; hipLaunchKernelGGL(hybrid_fwd, dim3(grid), dim3(NTHREADS), LDS_BYTES, stream, a); }
#endif
}
```

```cpp
#include <hip/hip_runtime.h>
#include <hip/hip_cooperative_groups.h>
#include <cstdio>
#include <cstdint>
namespace cg = cooperative_groups;

#ifndef MK_N_LAUNCHES
#define MK_N_LAUNCHES 1
#endif
#ifndef MK_BARRIER
#define MK_BARRIER 1
#endif

constexpr int D = 1024, NBATCH = 8, SEQ = 4096, NMETA = 16, TP = SEQ + NMETA, MP = NBATCH * TP;
constexpr int SBATCH = 128, TS = 4, MS = SBATCH * TS, MU = MP + MS, MUP = 33536, MC = NBATCH * SEQ + MS;
constexpr int PAST = 16384;
constexpr int HD = 64, NHA = 8, NKV = 2;
constexpr int NHB = 4, CONVD = 1536;
constexpr int DFF = 2816, NIN_SRC = 4872, NIN = 4864;
constexpr float EPS = 1e-6f;
constexpr float QSCALE = 0.125f * 1.4426950408889634f;

constexpr size_t MiB = 1u << 20, KiB = 1024;
constexpr size_t WS_CTL = 0, CTL_BYTES = 1 * MiB;
constexpr size_t WS_WIN = 1 * MiB;
constexpr size_t WS_WOA = 11 * MiB, WS_WOB = 12 * MiB;
constexpr size_t WS_WOUT = 13 * MiB;
constexpr size_t WS_WGU = 15 * MiB;
constexpr size_t WS_WD = 26 * MiB;
constexpr size_t WS_ROPE = 32 * MiB;
constexpr size_t WS_GB = 34 * MiB;
constexpr size_t WS_SC = 36 * MiB;
constexpr size_t WS_SS1 = 37 * MiB, WS_SS2 = 37 * MiB + 512 * KiB;
constexpr size_t WS_SCR = 38 * MiB, SCR_BYTES = 2 * MiB;
constexpr size_t CTL_SPL = 49152;
constexpr size_t WS_QA = 41 * MiB;
constexpr size_t WS_KV = WS_QA + (size_t)MUP * 512 * 2;
constexpr size_t WS_QKVB = WS_KV + (size_t)MUP * 256 * 2;
constexpr size_t WS_Z = WS_QKVB + (size_t)MUP * 1536 * 2;
constexpr size_t WS_G = WS_Z + (size_t)MUP * 512 * 2;
constexpr size_t WS_GEND = WS_G + (size_t)MUP * 2048 * 2;
constexpr size_t WS_B = 353 * MiB, WS_END = 512 * MiB;
static_assert(WS_GEND <= WS_B, "ws map");
constexpr size_t WS_XN = WS_B;
constexpr size_t PREP_SLOT = 80 * KiB;
constexpr int PREP_N1 = (int)((WS_END - WS_B) / PREP_SLOT);
constexpr size_t DO_OA = 44 * MiB;
constexpr int OAB_PITCH = 1024;
constexpr size_t DO_OB = DO_OA + 512 * 2;
constexpr size_t DO_ATS = DO_OA + (size_t)MC * OAB_PITCH * 2;
constexpr size_t ATS_ITEM = 3 * 32 * 32 * 4;
static_assert(DO_ATS + 212 * 8 * ATS_ITEM <= (size_t)MC * 1024 * 4, "d_out scratch map");
constexpr size_t WS_MB = WS_B;
constexpr size_t WS_HB1 = WS_B + 66 * MiB;
static_assert(WS_HB1 + (size_t)MC * 1024 * 2 <= WS_END, "ws map");
constexpr size_t WS_ACT = WS_QA;
static_assert(WS_ACT + (size_t)MC * DFF * 2 <= WS_G, "ws map");
constexpr int SL_BEK = 0, SL_BV = 16 * 1024, SL_T = 32 * 1024, SL_QKD = 40 * 1024, SL_QE = 48 * 1024, SL_KWT = 64 * 1024;
constexpr int N_PROMPT_SEQ = NBATCH * NHB, CHUNKS_P = 65, N_ITEMS_P = N_PROMPT_SEQ * CHUNKS_P, N_ITEMS = N_ITEMS_P + SBATCH * NHB;
static_assert((size_t)(N_ITEMS - PREP_N1) * PREP_SLOT <= DO_OA, "prep slots");

constexpr size_t O_YP = 0, O_YS = (size_t)NBATCH * SEQ * D, O_KP = O_YS + (size_t)MS * D, O_VP = O_KP + 8 * 128 * 2 * 64, O_DP = O_VP + 8 * 128 * 2 * 64,
                 O_CP = O_DP + 8 * 4 * 128 * 128, O_KS = O_CP + 8 * 3 * 1536, O_VS = O_KS + (size_t)128 * 128 * 2 * 64, O_DS = O_VS + (size_t)128 * 128 * 2 * 64,
                 O_CS = O_DS + (size_t)128 * 4 * 128 * 128, O_END = O_CS + (size_t)128 * 3 * 1536;
static_assert(O_END == 48074752, "d_out size");

#define DI __device__ __forceinline__
#define GAS __attribute__((address_space(1)))
#define LAS __attribute__((address_space(3)))
typedef unsigned short bf16;
typedef short bf16x8 __attribute__((ext_vector_type(8)));
typedef float f32x4 __attribute__((ext_vector_type(4)));
typedef float f32x2 __attribute__((ext_vector_type(2)));
typedef float f32x16 __attribute__((ext_vector_type(16)));
typedef unsigned u32x4 __attribute__((ext_vector_type(4)));
typedef unsigned u32x2 __attribute__((ext_vector_type(2)));
typedef __bf16 bf16x2_t __attribute__((ext_vector_type(2)));

DI unsigned cvtpk(float lo, float hi) { f32x2 v = {lo, hi}; bf16x2_t b = __builtin_convertvector(v, bf16x2_t); return __builtin_bit_cast(unsigned, b); }
DI bf16 f2bf(float f) { return (bf16)(cvtpk(f, 0.f) & 0xffffu); }
DI float bf2f(unsigned short h) { return __uint_as_float((unsigned)h << 16); }
DI float bflo(unsigned w) { return __uint_as_float(w << 16); }
DI float bfhi(unsigned w) { return __uint_as_float(w & 0xffff0000u); }
DI u32x4 pack8f(f32x4 a, f32x4 b) { u32x4 w; w.x = cvtpk(a[0], a[1]); w.y = cvtpk(a[2], a[3]); w.z = cvtpk(b[0], b[1]); w.w = cvtpk(b[2], b[3]); return w; }
DI float frcp_(float x) { return __builtin_amdgcn_rcpf(x); }
DI float sigmoidf_(float x) { return frcp_(1.0f + __builtin_amdgcn_exp2f(x * -1.4426950408889634f)); }
DI float siluf_(float x) { return x * sigmoidf_(x); }
DI void st16_sc1(void* p, u32x4 v) { asm volatile("global_store_dwordx4 %0, %1, off sc1\n\ts_nop 1" :: "v"(p), "v"(v) : "memory"); }
DI void st16_sc1f(void* p, f32x4 v) { asm volatile("global_store_dwordx4 %0, %1, off sc1\n\ts_nop 1" :: "v"(p), "v"(v) : "memory"); }
DI void st2_sc1(void* p, unsigned v) { asm volatile("global_store_short %0, %1, off sc1\n\ts_nop 1" :: "v"(p), "v"(v) : "memory"); }
constexpr size_t CTL_GRAN = 65536, CTL_CNT = 245760, CTL_SS1 = 458752;
static_assert(CTL_CNT + 5 * 130 * 256 <= CTL_SS1 && CTL_SS1 + 33280 * 4 <= 1048576 && CTL_GRAN + 2592 * 64 <= CTL_CNT, "control region map");
constexpr int CNT_STRIDE = 130 * 64;
DI int pos_of_d(int d) { const int dd = d & 31; return 8 * (dd >> 2) + (dd & 3) + ((d >> 5) << 2); }
DI int d_of_pos(int p) { const int j = p & 7; return 4 * (p >> 3) + (j & 3) + ((j >> 2) << 5); }
namespace pg8 {
#define PG8_LAS __attribute__((address_space(3)))
typedef unsigned short bf16_t;
typedef short bf16x8 __attribute__((ext_vector_type(8)));
typedef float f32x4 __attribute__((ext_vector_type(4)));
typedef unsigned u32x4 __attribute__((ext_vector_type(4)));
constexpr int BM = 256, BK = 64, HALF = 128, HTB = HALF * BK * 2  , STAGE_BYTES = 8 * HTB, NXCD = 8, WGM = 8;

__host__ __device__ __forceinline__ int lds_byte(int r, int c) { const int st = (r >> 4) * 2 + (c >> 5), rr = r & 15, cc = c & 31, ob = rr * 64 + cc * 2; return st * 1024 + (ob ^ (((ob >> 9) & 1) << 5)); }
__host__ __device__ __forceinline__ void stage_rc(int b, int& R, int& C) { const int st = b / 1024, sb = b % 1024, swz = sb ^ (((sb >> 9) & 1) << 5); R = (st >> 1) * 16 + swz / 64; C = (st & 1) * 32 + (swz % 64) / 2; }
__host__ __device__ __forceinline__ int perm32(int rho) { const int n = rho >> 4, i = rho & 15; return 8 * (i >> 2) + 4 * n + (i & 3); }

struct Unit { int pm, pn; };
struct Gemm { const bf16_t* A; const bf16_t* Bt; int M, N, K; int ldk; };

struct StaticOrder {
    static constexpr bool A_SC1 = false;
    int nM, nN, nwg, G, c, lim;
    __host__ __device__ void init(int M, int N, int G_, int c_) { nM = M / BM; nN = N / BM; nwg = nM * nN; G = G_; c = c_; lim = nwg; }
    __host__ __device__ bool next(int i, Unit& u) const {
        const long L = (long)i * G + c; if (L >= lim) return false;
        int wgid = (int)L; { const int q = nwg / NXCD, r = nwg % NXCD, xcd = wgid % NXCD, off = wgid / NXCD; wgid = (xcd < r ? xcd * (q + 1) : r * (q + 1) + (xcd - r) * q) + off; }
        const int nig = WGM * nN, gid = wgid / nig, fm = gid * WGM, gsz = (nM - fm) < WGM ? (nM - fm) : WGM;
        u.pm = fm + ((wgid % nig) % gsz); u.pn = (wgid % nig) / gsz; return true;
    }
    __device__ __forceinline__ void a_ready(const Unit&) const {}
    __device__ __forceinline__ void done(const Unit&) const {}
};
struct FlagOrder : StaticOrder {
    static constexpr bool A_SC1 = true;
    const unsigned* ready; unsigned need; unsigned* pub; unsigned* gpub;
    __device__ __forceinline__ void a_ready(const Unit& u) const {
        if (ready) {
            if (threadIdx.x < 64) { unsigned spins = 0;
                while ((unsigned)__builtin_amdgcn_readfirstlane(__hip_atomic_load(ready + 64 * u.pm, __ATOMIC_RELAXED, __HIP_MEMORY_SCOPE_AGENT)) < need) { __builtin_amdgcn_s_sleep(2); if (++spins > (1u << 22)) break; } }
            asm volatile("" ::: "memory"); __builtin_amdgcn_s_barrier(); asm volatile("" ::: "memory");
        }
    }
    __device__ __forceinline__ void done(const Unit& u) const {
        if (pub) { asm volatile("s_waitcnt vmcnt(0)" ::: "memory");
            if ((threadIdx.x & 63) == 0) { __hip_atomic_fetch_add(pub + 64 * u.pm, 1u, __ATOMIC_RELAXED, __HIP_MEMORY_SCOPE_AGENT); if (gpub) __hip_atomic_fetch_add(gpub, 1u, __ATOMIC_RELAXED, __HIP_MEMORY_SCOPE_AGENT); } }
    }
};
struct SliceOrder : StaticOrder {
    int t;
    __host__ __device__ void init_slice(int M, int N, int G_, int first, int t_) { init(M, N, G_, 0); t = t_; c = first + t_; G = 0; }
    __host__ __device__ bool next(int i, Unit& u) const { return i == 0 ? StaticOrder::next(0, u) : false; }
};

__device__ __forceinline__ void urow_info(int urow, int& kind, int& b, int& t, int& ridx) {
    if (urow < MP) { b = urow / TP; t = urow - b * TP; kind = 0; ridx = t; }
    else if (urow < MU) { const int s = urow - MP; b = s >> 2; t = s & 3; kind = 1; ridx = TP + t; }
    else { kind = 2; b = 0; t = 0; ridx = 0; }
}
__device__ __forceinline__ int crow_to_urow(int crow) { return crow < NBATCH * SEQ ? crow + NMETA * ((crow >> 12) + 1) : MP + (crow - NBATCH * SEQ); }

struct EpiInProj {
    static constexpr bool PERM = true, AFTER_DRAIN = false;
    bf16_t *QA, *KV, *QKVB, *Z, *G; const float *COS, *SIN; float* out;
    __device__ __forceinline__ void operator()(const f32x4 (&acc)[2][2][4][2], const Unit& u, int wr, int wc, int fr, int fq) const {
        const int pn = u.pn;
#pragma unroll
        for (int ai = 0; ai < 2; ++ai)
#pragma unroll
            for (int m = 0; m < 4; ++m) {
                const int row = u.pm * BM + ai * HALF + wr * 64 + m * 16 + fr;
                int kind, b, t, ridx; urow_info(row, kind, b, t, ridx);
#pragma unroll
                for (int bj = 0; bj < 2; ++bj) {
                    const int cl = bj * HALF + wc * 32 + 8 * fq;
                    const f32x4 v0 = acc[ai][bj][m][0], v1 = acc[ai][bj][m][1];
                    if (pn < 2) {
                        const int c = pn * 256 + cl, d0 = ((c & 63) >> 3) * 4;
                        const f32x4 cs = *(const f32x4*)(COS + ridx * 32 + d0), sn = *(const f32x4*)(SIN + ridx * 32 + d0);
                        const f32x4 o1 = (v0 * cs - v1 * sn) * QSCALE, o2 = (v1 * cs + v0 * sn) * QSCALE;
                        *(u32x4*)(QA + (size_t)row * 512 + c) = pack8f(o1, o2);
                    } else if (pn == 2) {
                        if (bj == 0) {
                            const int kh = cl >> 6, d0 = ((cl & 63) >> 3) * 4;
                            const f32x4 cs = *(const f32x4*)(COS + ridx * 32 + d0), sn = *(const f32x4*)(SIN + ridx * 32 + d0);
                            const f32x4 o1 = v0 * cs - v1 * sn, o2 = v1 * cs + v0 * sn;
                            *(u32x4*)(KV + (size_t)row * 256 + cl) = pack8f(o1, o2);
                            float* dst = nullptr;
                            if (kind == 0 && t >= TP - 128) dst = out + O_KP + ((size_t)(b * 128 + (t - (TP - 128))) * 2 + kh) * 64;
                            else if (kind == 1) dst = out + O_KS + ((size_t)(b * 128 + 124 + t) * 2 + kh) * 64;
                            if (dst) { *(f32x4*)(dst + d0) = o1; *(f32x4*)(dst + 32 + d0) = o2; }
                        } else {
                            const int cv = cl - 128, kh = cv >> 6, dd = cv & 63;
                            *(u32x4*)(KV + (size_t)row * 256 + cl) = pack8f(v0, v1);
                            float* dst = nullptr;
                            if (kind == 0 && t >= TP - 128) dst = out + O_VP + ((size_t)(b * 128 + (t - (TP - 128))) * 2 + kh) * 64;
                            else if (kind == 1) dst = out + O_VS + ((size_t)(b * 128 + 124 + t) * 2 + kh) * 64;
                            if (dst) { *(f32x4*)(dst + dd) = v0; *(f32x4*)(dst + dd + 4) = v1; }
                        }
                    } else if (pn < 9) {
                        const int c = (pn - 3) * 256 + cl;
                        *(u32x4*)(QKVB + (size_t)row * 1536 + c) = pack8f(v0, v1);
                        float* dst = nullptr;
                        if (kind == 0 && t >= TP - 3) dst = out + O_CP + ((size_t)b * 3 + (t - (TP - 3))) * 1536;
                        else if (kind == 1 && t >= 1) dst = out + O_CS + ((size_t)b * 3 + (t - 1)) * 1536;
                        if (dst) { *(f32x4*)(dst + c) = v0; *(f32x4*)(dst + c + 4) = v1; }
                    } else if (pn < 11) {
                        const int c = (pn - 9) * 256 + cl;
                        *(u32x4*)(Z + (size_t)row * 512 + c) = pack8f(v0, v1);
                    } else {
                        const int c = (pn - 11) * 256 + cl;
                        f32x4 g0, g1;
#pragma unroll
                        for (int e = 0; e < 4; ++e) { g0[e] = sigmoidf_(v0[e]); g1[e] = sigmoidf_(v1[e]); }
                        *(u32x4*)(G + (size_t)row * 2048 + c) = pack8f(g0, g1);
                    }
                }
            }
    }
};

template <bool ACCUM> struct EpiMerge {
    static constexpr bool PERM = true, AFTER_DRAIN = false;
    bf16_t* MBp; const bf16_t* G; int gate_off;
    __device__ __forceinline__ void operator()(const f32x4 (&acc)[2][2][4][2], const Unit& u, int wr, int wc, int fr, int fq) const {
#pragma unroll
        for (int ai = 0; ai < 2; ++ai)
#pragma unroll
            for (int m = 0; m < 4; ++m) {
                const int crow = u.pm * BM + ai * HALF + wr * 64 + m * 16 + fr, urow = crow_to_urow(crow);
#pragma unroll
                for (int bj = 0; bj < 2; ++bj) {
                    const int c = u.pn * BM + bj * HALF + wc * 32 + 8 * fq;
                    const u32x4 gw = *(const u32x4*)(G + (size_t)urow * 2048 + gate_off + c);
                    f32x4 v0 = acc[ai][bj][m][0], v1 = acc[ai][bj][m][1];
                    v0[0] *= bflo(gw.x); v0[1] *= bfhi(gw.x); v0[2] *= bflo(gw.y); v0[3] *= bfhi(gw.y);
                    v1[0] *= bflo(gw.z); v1[1] *= bfhi(gw.z); v1[2] *= bflo(gw.w); v1[3] *= bfhi(gw.w);
                    bf16_t* p = MBp + (size_t)crow * 1024 + c;
                    if (ACCUM) { const u32x4 pw = *(const u32x4*)p;
                        v0[0] += bflo(pw.x); v0[1] += bfhi(pw.x); v0[2] += bflo(pw.y); v0[3] += bfhi(pw.y);
                        v1[0] += bflo(pw.z); v1[1] += bfhi(pw.z); v1[2] += bflo(pw.w); v1[3] += bfhi(pw.w); }
                    *(u32x4*)p = pack8f(v0, v1);
                }
            }
    }
};

template <bool ATOM = true> struct EpiWout {
    static constexpr bool PERM = true, AFTER_DRAIN = false;
    const float* xp; const float* xs; bf16_t* HB; float* SS;
    __device__ __forceinline__ void operator()(const f32x4 (&acc)[2][2][4][2], const Unit& u, int wr, int wc, int fr, int fq) const {
#pragma unroll
        for (int ai = 0; ai < 2; ++ai)
#pragma unroll
            for (int m = 0; m < 4; ++m) {
                const int crow = u.pm * BM + ai * HALF + wr * 64 + m * 16 + fr;
                const float* hs = crow < NBATCH * SEQ ? xp + (size_t)crow * D : xs + (size_t)(crow - NBATCH * SEQ) * D;
                float ss = 0.f;
#pragma unroll
                for (int bj = 0; bj < 2; ++bj) {
                    const int c = u.pn * BM + bj * HALF + wc * 32 + 8 * fq;
                    const f32x4 r0 = *(const f32x4*)(hs + c) + acc[ai][bj][m][0], r1 = *(const f32x4*)(hs + c + 4) + acc[ai][bj][m][1];
                    *(u32x4*)(HB + (size_t)crow * D + c) = pack8f(r0, r1);
                    ss += (r0[0] * r0[0] + r0[1] * r0[1]) + (r0[2] * r0[2] + r0[3] * r0[3]) + (r1[0] * r1[0] + r1[1] * r1[1]) + (r1[2] * r1[2] + r1[3] * r1[3]);
                }
                ss += __shfl_xor(ss, 16); ss += __shfl_xor(ss, 32);
                if (ATOM && fq == 0) atomicAdd(SS + crow, ss);
            }
    }
};

struct EpiGateUp {
    static constexpr bool PERM = true, AFTER_DRAIN = false;
    bf16_t* ACT; const float* SS;
    __device__ __forceinline__ void operator()(const f32x4 (&acc)[2][2][4][2], const Unit& u, int wr, int wc, int fr, int fq) const {
#pragma unroll
        for (int ai = 0; ai < 2; ++ai)
#pragma unroll
            for (int m = 0; m < 4; ++m) {
                const int crow = u.pm * BM + ai * HALF + wr * 64 + m * 16 + fr;
                const float rstd = rsqrtf(SS[crow] * (1.0f / D) + EPS);
                f32x4 a[2];
#pragma unroll
                for (int n = 0; n < 2; ++n)
#pragma unroll
                    for (int e = 0; e < 4; ++e) { const float g = acc[ai][0][m][n][e] * rstd, up = acc[ai][1][m][n][e] * rstd; a[n][e] = siluf_(g) * up; }
                *(u32x4*)(ACT + (size_t)crow * DFF + u.pn * HALF + wc * 32 + 8 * fq) = pack8f(a[0], a[1]);
            }
    }
};

template <bool DRY = false> struct EpiDown {
    static constexpr bool PERM = true, AFTER_DRAIN = false;
    const bf16_t* HB; float* H;
    __device__ __forceinline__ void operator()(const f32x4 (&acc)[2][2][4][2], const Unit& u, int wr, int wc, int fr, int fq) const {
#pragma unroll
        for (int ai = 0; ai < 2; ++ai)
#pragma unroll
            for (int m = 0; m < 4; ++m) {
                const int crow = u.pm * BM + ai * HALF + wr * 64 + m * 16 + fr;
#pragma unroll
                for (int bj = 0; bj < 2; ++bj) {
                    const size_t off = (size_t)crow * D + u.pn * BM + bj * HALF + wc * 32 + 8 * fq;
                    const u32x4 hw = *(const u32x4*)(HB + off);
                    f32x4 r0 = acc[ai][bj][m][0], r1 = acc[ai][bj][m][1];
                    r0[0] += bflo(hw.x); r0[1] += bfhi(hw.x); r0[2] += bflo(hw.y); r0[3] += bfhi(hw.y);
                    r1[0] += bflo(hw.z); r1[1] += bfhi(hw.z); r1[2] += bflo(hw.w); r1[3] += bfhi(hw.w);
                    *(f32x4*)(H + off) = r0; *(f32x4*)(H + off + 4) = r1;
                }
            }
    }
};

template <class Inner, bool GATED = false> struct EpiSplit {
    static constexpr bool PERM = Inner::PERM, AFTER_DRAIN = false;
    Inner inner; float* scr; unsigned* cnt; unsigned S; const bf16_t* G; int gate_off;
    __device__ __forceinline__ void operator()(const f32x4 (&acc_)[2][2][4][2], const Unit& u, int wr, int wc, int fr, int fq) const {
        f32x4 (&acc)[2][2][4][2] = const_cast<f32x4 (&)[2][2][4][2]>(acc_);
        const int lane = fr + 16 * fq, wave = wr * 4 + wc;
        float* p = scr + (size_t)wave * 8192 + lane;
#pragma unroll
        for (int ai = 0; ai < 2; ++ai)
#pragma unroll
            for (int m = 0; m < 4; ++m) {
                int urow = 0;
                if (GATED) urow = crow_to_urow(u.pm * BM + ai * HALF + wr * 64 + m * 16 + fr);
#pragma unroll
                for (int bj = 0; bj < 2; ++bj) {
                    f32x4 v0 = acc[ai][bj][m][0], v1 = acc[ai][bj][m][1];
                    if (GATED) { const u32x4 gw = *(const u32x4*)(G + (size_t)urow * 2048 + gate_off + u.pn * BM + bj * HALF + wc * 32 + 8 * fq);
                        v0[0] *= bflo(gw.x); v0[1] *= bfhi(gw.x); v0[2] *= bflo(gw.y); v0[3] *= bfhi(gw.y); v1[0] *= bflo(gw.z); v1[1] *= bfhi(gw.z); v1[2] *= bflo(gw.w); v1[3] *= bfhi(gw.w); }
                    float* q = p + (((ai * 2 + bj) * 4 + m) * 8) * 64;
                    asm volatile("" : "+v"(q));
#pragma unroll
                    for (int x = 0; x < 4; ++x) { unsafeAtomicAdd(q + x * 64, v0[x]); unsafeAtomicAdd(q + (4 + x) * 64, v1[x]); }
                }
            }
        asm volatile("s_waitcnt vmcnt(0)" ::: "memory");
        unsigned old = 0u;
        if (lane == 0) old = __hip_atomic_fetch_add(cnt + wave, 1u, __ATOMIC_RELAXED, __HIP_MEMORY_SCOPE_AGENT);
        old = (unsigned)__builtin_amdgcn_readfirstlane((int)old);
        if (old == S - 1u) {
#pragma unroll
            for (int ai = 0; ai < 2; ++ai)
#pragma unroll
                for (int bj = 0; bj < 2; ++bj)
#pragma unroll
                    for (int m = 0; m < 4; ++m) {
                        float* q = p + (((ai * 2 + bj) * 4 + m) * 8) * 64;
                        asm volatile("" : "+v"(q));
#pragma unroll
                        for (int n = 0; n < 2; ++n)
#pragma unroll
                            for (int x = 0; x < 4; ++x) acc[ai][bj][m][n][x] = __hip_atomic_exchange(q + (n * 4 + x) * 64, 0.0f, __ATOMIC_RELAXED, __HIP_MEMORY_SCOPE_AGENT);
                    }
            if (lane == 0) __hip_atomic_store(cnt + wave, 0u, __ATOMIC_RELAXED, __HIP_MEMORY_SCOPE_AGENT);
            inner(acc, u, wr, wc, fr, fq);
        }
    }
};
struct EpiStoreMB {
    static constexpr bool PERM = true, AFTER_DRAIN = false;
    bf16_t* MBp;
    __device__ __forceinline__ void operator()(const f32x4 (&acc)[2][2][4][2], const Unit& u, int wr, int wc, int fr, int fq) const {
#pragma unroll
        for (int ai = 0; ai < 2; ++ai)
#pragma unroll
            for (int m = 0; m < 4; ++m) {
                const int crow = u.pm * BM + ai * HALF + wr * 64 + m * 16 + fr;
#pragma unroll
                for (int bj = 0; bj < 2; ++bj) *(u32x4*)(MBp + (size_t)crow * 1024 + u.pn * BM + bj * HALF + wc * 32 + 8 * fq) = pack8f(acc[ai][bj][m][0], acc[ai][bj][m][1]);
            }
    }
};

template <class Epi, class Sched, bool ALIGN_EPI = false, bool SP2 = false>
__device__ __forceinline__ void gemm_phase(PG8_LAS unsigned char* lds, const Gemm g, const Sched& S, const Epi& E) {
    const int tid = threadIdx.x, wid = __builtin_amdgcn_readfirstlane(tid >> 6), lane = tid & 63, wr = wid >> 2, wc = wid & 3, fr = lane & 15, fq = lane >> 4;
    const int K = g.ldk ? g.ldk : g.K, nt = g.K / BK;
    unsigned voffA[2], voffB[2];
#pragma unroll
    for (int i = 0; i < 2; ++i) { int R, C; stage_rc(tid * 16 + i * 8192, R, C); const int Rb = Epi::PERM ? ((R & ~31) + perm32(R & 31)) : R;
        voffA[i] = (unsigned)(R * K + C) * 2u; voffB[i] = (unsigned)(Rb * K + C) * 2u; }
    const size_t kstep = (size_t)(BK * 2);
    const size_t hstep = (size_t)HALF * K * 2;
    const size_t tstep = 2 * hstep;
    const unsigned ldsw = (unsigned)wid * 1024u;
    const int aoff = lds_byte(wr * 64 + fr, fq * 8), boff = lds_byte(wc * 32 + fr, fq * 8);
#define PG8_SA(b, h) (((b) * 2 + (h)) * HTB)
#define PG8_SB(b, h) ((4 + (b) * 2 + (h)) * HTB)
#define PG8_STAGE(bufoff, gbase, voff) do { _Pragma("unroll") for (int _i = 0; _i < 2; ++_i) \
        __builtin_amdgcn_global_load_lds((const unsigned*)((const char*)(gbase) + (voff)[_i]), (PG8_LAS unsigned*)(lds + (bufoff) + ldsw + _i * 8192), 16, 0, 0); } while (0)
#define PG8_STAGE_A(bufoff, gbase, voff) do { _Pragma("unroll") for (int _i = 0; _i < 2; ++_i) { \
        if constexpr (Sched::A_SC1) __builtin_amdgcn_global_load_lds((const unsigned*)((const char*)(gbase) + (voff)[_i]), (PG8_LAS unsigned*)(lds + (bufoff) + ldsw + _i * 8192), 16, 0, 16); \
        else __builtin_amdgcn_global_load_lds((const unsigned*)((const char*)(gbase) + (voff)[_i]), (PG8_LAS unsigned*)(lds + (bufoff) + ldsw + _i * 8192), 16, 0, 0); } } while (0)
#define PG8_LDA(dst, b, h) do { _Pragma("unroll") for (int m = 0; m < 4; ++m) _Pragma("unroll") for (int k = 0; k < 2; ++k) dst[m][k] = *(const PG8_LAS bf16x8*)(lds + PG8_SA(b, h) + aoff + m * 2048 + k * 1024); } while (0)
#define PG8_LDB(dst, b, h) do { _Pragma("unroll") for (int n = 0; n < 2; ++n) _Pragma("unroll") for (int k = 0; k < 2; ++k) dst[n][k] = *(const PG8_LAS bf16x8*)(lds + PG8_SB(b, h) + boff + n * 2048 + k * 1024); } while (0)
#define PG8_MMA(ai, bj, At, Bt) do { __builtin_amdgcn_s_setprio(1); _Pragma("unroll") for (int m = 0; m < 4; ++m) _Pragma("unroll") for (int n = 0; n < 2; ++n) _Pragma("unroll") for (int k = 0; k < 2; ++k) \
        acc[ai][bj][m][n] = __builtin_amdgcn_mfma_f32_16x16x32_bf16(Bt[n][k], At[m][k], acc[ai][bj][m][n], 0, 0, 0); __builtin_amdgcn_s_setprio(0); } while (0)
#define PG8_WAIT_V(n) asm volatile("s_waitcnt vmcnt(" #n ")" ::: "memory")
#define PG8_WAIT_L(n) asm volatile("s_waitcnt lgkmcnt(" #n ")" ::: "memory")
#define PG8_BAR __builtin_amdgcn_s_barrier()
#define PG8_SCHED __builtin_amdgcn_sched_barrier(0)
    Unit cur, nxt; int ui = 0;
    if (!S.next(0, cur)) return;
    f32x4 acc[2][2][4][2];
#pragma unroll
    for (int a = 0; a < 2; ++a)
#pragma unroll
        for (int b = 0; b < 2; ++b)
#pragma unroll
            for (int m = 0; m < 4; ++m)
#pragma unroll
                for (int n = 0; n < 2; ++n) acc[a][b][m][n] = (f32x4){0.f, 0.f, 0.f, 0.f};
    bf16x8 At[4][2], B0[2][2], B1[2][2];
    const char* cA = (const char*)g.A + (size_t)cur.pm * tstep; const char* cB = (const char*)g.Bt + (size_t)cur.pn * tstep;
    S.a_ready(cur);
    if constexpr (SP2) {
        PG8_STAGE(PG8_SB(0, 0), cB, voffB); PG8_STAGE(PG8_SB(0, 1), cB + hstep, voffB); PG8_STAGE_A(PG8_SA(0, 0), cA, voffA); PG8_STAGE_A(PG8_SA(0, 1), cA + hstep, voffA);
        if (wr == 1) PG8_BAR;
        PG8_WAIT_V(2); PG8_BAR;
        PG8_STAGE(PG8_SB(1, 0), cB + kstep, voffB); PG8_STAGE_A(PG8_SA(1, 0), cA + kstep, voffA); PG8_STAGE(PG8_SB(1, 1), cB + hstep + kstep, voffB);
        PG8_WAIT_V(6); PG8_BAR;
    } else {
        PG8_STAGE(PG8_SB(0, 0), cB, voffB); PG8_STAGE_A(PG8_SA(0, 0), cA, voffA); PG8_STAGE(PG8_SB(0, 1), cB + hstep, voffB); PG8_STAGE_A(PG8_SA(0, 1), cA + hstep, voffA);
        if (wr == 1) PG8_BAR;
        PG8_WAIT_V(4); PG8_BAR;
        PG8_STAGE(PG8_SB(1, 0), cB + kstep, voffB); PG8_STAGE_A(PG8_SA(1, 0), cA + kstep, voffA); PG8_STAGE(PG8_SB(1, 1), cB + hstep + kstep, voffB);
        PG8_WAIT_V(6); PG8_BAR;
    }
    for (;;) {
        const bool has_next = S.next(ui + 1, nxt);
        const char* nA = has_next ? (const char*)g.A + (size_t)nxt.pm * tstep : cA; const char* nB = has_next ? (const char*)g.Bt + (size_t)nxt.pn * tstep : cB;
        for (int t = 0; t < nt; t += 2) {
            const bool last = (t == nt - 2);
            const char* a1 = cA + (size_t)(t + 1) * kstep;
            const char* a2 = last ? nA : cA + (size_t)(t + 2) * kstep; const char* b2 = last ? nB : cB + (size_t)(t + 2) * kstep;
            const char* a3 = a2 + kstep; const char* b3 = b2 + kstep;
            if (last && has_next) S.a_ready(nxt);
            if constexpr (SP2) {
            PG8_LDB(B0, 0, 0); PG8_LDB(B1, 0, 1); PG8_SCHED; PG8_LDA(At, 0, 0); PG8_STAGE_A(PG8_SA(1, 1), a1 + hstep, voffA);
            PG8_WAIT_V(8); PG8_WAIT_L(0); PG8_BAR; PG8_MMA(0, 0, At, B0); PG8_MMA(0, 1, At, B1); PG8_BAR; PG8_SCHED;
            PG8_LDA(At, 0, 1); PG8_STAGE(PG8_SB(0, 0), b2, voffB); PG8_STAGE(PG8_SB(0, 1), b2 + hstep, voffB); PG8_STAGE_A(PG8_SA(0, 0), a2, voffA);
            PG8_WAIT_V(8); PG8_WAIT_L(0); PG8_BAR; PG8_MMA(1, 0, At, B0); PG8_MMA(1, 1, At, B1); PG8_BAR; PG8_SCHED;
            PG8_LDB(B0, 1, 0); PG8_LDB(B1, 1, 1); PG8_SCHED; PG8_LDA(At, 1, 0); PG8_STAGE_A(PG8_SA(0, 1), a2 + hstep, voffA);
            PG8_WAIT_V(8); PG8_WAIT_L(0); PG8_BAR; PG8_MMA(0, 0, At, B0); PG8_MMA(0, 1, At, B1); PG8_BAR; PG8_SCHED;
            PG8_LDA(At, 1, 1); PG8_STAGE(PG8_SB(1, 0), b3, voffB); PG8_STAGE(PG8_SB(1, 1), b3 + hstep, voffB); PG8_STAGE_A(PG8_SA(1, 0), a3, voffA);
            PG8_WAIT_V(8); PG8_WAIT_L(0); PG8_BAR; PG8_MMA(1, 0, At, B0); PG8_MMA(1, 1, At, B1); PG8_BAR; PG8_SCHED;
            } else {
            PG8_LDB(B0, 0, 0); PG8_SCHED; PG8_LDA(At, 0, 0); PG8_STAGE_A(PG8_SA(1, 1), a1 + hstep, voffA);
            PG8_WAIT_L(8); PG8_BAR; PG8_WAIT_L(0); PG8_MMA(0, 0, At, B0); PG8_BAR; PG8_SCHED;
            PG8_LDB(B1, 0, 1); PG8_STAGE(PG8_SB(0, 0), b2, voffB);
            PG8_BAR; PG8_WAIT_L(0); PG8_MMA(0, 1, At, B1); PG8_BAR;
            PG8_LDA(At, 0, 1); PG8_STAGE_A(PG8_SA(0, 0), a2, voffA);
            PG8_BAR; PG8_WAIT_L(0); PG8_MMA(1, 0, At, B0); PG8_BAR; PG8_SCHED;
            PG8_STAGE(PG8_SB(0, 1), b2 + hstep, voffB);
            PG8_WAIT_V(6); PG8_BAR; PG8_MMA(1, 1, At, B1); PG8_BAR;
            PG8_LDB(B0, 1, 0); PG8_SCHED; PG8_LDA(At, 1, 0); PG8_STAGE_A(PG8_SA(0, 1), a2 + hstep, voffA);
            PG8_WAIT_L(8); PG8_BAR; PG8_WAIT_L(0); PG8_MMA(0, 0, At, B0); PG8_BAR; PG8_SCHED;
            PG8_LDB(B1, 1, 1); PG8_STAGE(PG8_SB(1, 0), b3, voffB);
            PG8_BAR; PG8_WAIT_L(0); PG8_MMA(0, 1, At, B1); PG8_BAR;
            PG8_LDA(At, 1, 1); PG8_STAGE_A(PG8_SA(1, 0), a3, voffA);
            PG8_BAR; PG8_WAIT_L(0); PG8_MMA(1, 0, At, B0); PG8_BAR; PG8_SCHED;
            PG8_STAGE(PG8_SB(1, 1), b3 + hstep, voffB);
            PG8_WAIT_V(6); PG8_BAR; PG8_MMA(1, 1, At, B1); PG8_BAR;
            }
        }
        if constexpr (ALIGN_EPI) { if (wr == 0) PG8_BAR; }
        if constexpr (!Epi::AFTER_DRAIN) { E(acc, cur, wr, wc, fr, fq); S.done(cur); }
        if (!has_next) break;
#pragma unroll
        for (int a = 0; a < 2; ++a)
#pragma unroll
            for (int b = 0; b < 2; ++b)
#pragma unroll
                for (int m = 0; m < 4; ++m)
#pragma unroll
                    for (int n = 0; n < 2; ++n) acc[a][b][m][n] = (f32x4){0.f, 0.f, 0.f, 0.f};
        cur = nxt; cA = nA; cB = nB; ++ui;
        if constexpr (ALIGN_EPI) { if (wr == 1) PG8_BAR; }
    }
    PG8_WAIT_V(0);
    if constexpr (!ALIGN_EPI) { if (wr == 0) PG8_BAR; }
    PG8_BAR;
    if constexpr (Epi::AFTER_DRAIN) { E.fused(acc, cur, wr, wc, fr, fq, lds, wid, lane); S.done(cur); }
#undef PG8_SA
#undef PG8_SB
#undef PG8_STAGE
#undef PG8_STAGE_A
#undef PG8_LDA
#undef PG8_LDB
#undef PG8_MMA
#undef PG8_WAIT_V
#undef PG8_WAIT_L
#undef PG8_BAR
#undef PG8_SCHED
}
}
constexpr int NWAVES = 8, NTHREADS = NWAVES * 64;
constexpr int LDS_BYTES = 147456;
constexpr int LDS_MISC = 131072;
constexpr int N_PHASES = 9;

struct Args {
    const float *x_prompt, *x_sample, *cache_k, *cache_v, *state_delta, *state_conv, *meta, *norm_mix, *w_in, *conv_w, *a_log, *dt_bias, *sinks, *gdn_norm,
                *w_oa, *w_ob, *w_out, *norm_ffn, *w_gate, *w_up, *w_down, *norm_final;
    float* out; unsigned char* ws; int ph_lo, ph_hi;
};

typedef const __attribute__((address_space(4))) Args* KA;
DI KA kargs() { KA p = (KA)__builtin_amdgcn_kernarg_segment_ptr(); asm volatile("" : "+s"(p)); return p; }
#define RLX_AGENT __ATOMIC_RELAXED, __HIP_MEMORY_SCOPE_AGENT
#define LDS_WAIT() asm volatile("s_waitcnt lgkmcnt(0)" ::: "memory")
#define MFMA32(a, b, c) __builtin_amdgcn_mfma_f32_32x32x16_bf16((a), (b), (c), 0, 0, 0)
DI int crow16(int reg, int h) { return (reg & 3) + 8 * (reg >> 2) + 4 * h; }
DI float wave_sum(float v) {
#pragma unroll
    for (int o = 1; o < 64; o <<= 1) v += __shfl_xor(v, o);
    return v;
}
DI float wave_max(float v) {
#pragma unroll
    for (int o = 1; o < 64; o <<= 1) v = fmaxf(v, __shfl_xor(v, o));
    return v;
}
template <int S> DI bf16x8 pack_step(const f32x16& x) {
    u32x4 p; p.x = cvtpk(x[8 * S], x[8 * S + 1]); p.y = cvtpk(x[8 * S + 2], x[8 * S + 3]); p.z = cvtpk(x[8 * S + 4], x[8 * S + 5]); p.w = cvtpk(x[8 * S + 6], x[8 * S + 7]);
    return __builtin_bit_cast(bf16x8, p);
}
DI int frag_idx(int row, int k, int NKS) { const int kkk = k & 15; return (((row >> 5) * NKS + (k >> 4)) * 64 + (row & 31) + 32 * ((kkk >> 2) & 1)) * 8 + (((kkk >> 3) << 2) | (kkk & 3)); }
DI unsigned char* slot_ptr(KA A, int item) { return item < PREP_N1 ? A->ws + WS_B + (size_t)item * PREP_SLOT : (unsigned char*)A->out + (size_t)(item - PREP_N1) * PREP_SLOT; }

#define XB_TMO      128
#define XB_XCNT(j)  (256  + 64 * (j))
#define XB_XSUB(j)  (1280 + 64 * (j))
#define XB_XGEN(j)  (2304 + 64 * (j))
#define XB_TOP      3328
#define XB_TOPGEN   3392
#define XCD_BAR_WORDS 3456
#define XB_SPIN_CAP (1u << 20)
DI unsigned xb_ld(unsigned* p)              { return __hip_atomic_load(p, __ATOMIC_RELAXED, __HIP_MEMORY_SCOPE_AGENT); }
DI unsigned xb_add(unsigned* p, unsigned v) { return __hip_atomic_fetch_add(p, v, __ATOMIC_RELAXED, __HIP_MEMORY_SCOPE_AGENT); }
DI unsigned xb_xcc_id() { return (unsigned)__builtin_amdgcn_s_getreg((3 << 11) | 20) & 0xFu; }
#define XB_SPIN(cond, bar) do { unsigned _sp = 0; while (cond) { __builtin_amdgcn_s_sleep(1); \
    if ((++_sp & 255u) == 0u) { if (xb_ld(&(bar)[XB_TMO])) break; if (_sp > XB_SPIN_CAP) { atomicAdd(&(bar)[XB_TMO], 1u); break; } } } } while (0)
struct XcdBarrier { unsigned* bar; unsigned x; volatile LAS unsigned* st; };
DI XcdBarrier xcd_barrier_post(unsigned* bar, volatile LAS unsigned* st) {
    XcdBarrier b; b.bar = bar; b.x = xb_xcc_id(); b.st = st;
    if (threadIdx.x == 0) (void)xb_add(&bar[XB_XCNT(b.x)], 1u);
    return b;
}
DI void xcd_barrier_complete(unsigned* bar, unsigned x, unsigned& nloc, unsigned& nx) {
    const unsigned G = gridDim.x * gridDim.y * gridDim.z;
    unsigned sum, cnt, mine, sp = 0u;
    for (;;) {
        sum = 0u; cnt = 0u; mine = 0u;
#pragma unroll
        for (unsigned j = 0; j < 16; ++j) { const unsigned c = xb_ld(&bar[XB_XCNT(j)]); sum += c; cnt += (c > 0u) ? 1u : 0u; mine = (j == x) ? c : mine; }
        if (sum == G) break;
        __builtin_amdgcn_s_sleep(1);
        if ((++sp & 255u) == 0u) { if (xb_ld(&bar[XB_TMO])) break; if (sp > XB_SPIN_CAP) { atomicAdd(&bar[XB_TMO], 1u); break; } }
    }
    nloc = mine > 0u ? mine : 1u; nx = cnt > 0u ? cnt : 1u;
}
DI void xcd_barrier(const XcdBarrier& b) {
    asm volatile("s_waitcnt vmcnt(0)" ::: "memory");
    __syncthreads();
    if (threadIdx.x == 0) {
        unsigned* bar = b.bar;
        __builtin_amdgcn_s_waitcnt(0);
        unsigned nloc = b.st[0], nx = b.st[1];
        if (nloc == 0u) { xcd_barrier_complete(bar, b.x, nloc, nx); b.st[0] = nloc; b.st[1] = nx; }
        const unsigned old = xb_add(&bar[XB_XSUB(b.x)], 1u);
        const unsigned gen = old / nloc;
        if (old + 1u == (gen + 1u) * nloc) {
            __builtin_amdgcn_fence(__ATOMIC_RELEASE, "agent");
            asm volatile("s_waitcnt vmcnt(0)" ::: "memory");
            const unsigned og = xb_add(&bar[XB_TOP], 1u);
            const unsigned tg = og / nx;
            if (og + 1u == (tg + 1u) * nx) xb_add(&bar[XB_TOPGEN], 1u);
            else XB_SPIN(xb_ld(&bar[XB_TOPGEN]) == tg, bar);
            __builtin_amdgcn_fence(__ATOMIC_ACQUIRE, "agent");
            xb_add(&bar[XB_XGEN(b.x)], 1u);
            asm volatile("s_waitcnt vmcnt(0)" ::: "memory");
        } else {
            XB_SPIN(xb_ld(&bar[XB_XGEN(b.x)]) == gen, bar);
            __builtin_amdgcn_fence(__ATOMIC_ACQUIRE, "agent");
            asm volatile("s_waitcnt vmcnt(0)" ::: "memory");
        }
    }
    __syncthreads();
}

template <class RowMap> DI void transpose_item(const float* W, int K, int N, bf16* WT, RowMap rm, const float* kscale, LAS float* scr, int item, int lane, int ldw = 0) {
    if (ldw == 0) ldw = K;
    const int nblk = (N + 31) / 32, kb = item / nblk, nb = item - kb * nblk, k0 = 64 * kb, n0 = 32 * nb;
    const int n4 = n0 + (lane & 7) * 4;
    f32x4 v[8];
#pragma unroll
    for (int i = 0; i < 8; ++i) { const int kk = 8 * i + (lane >> 3);
        v[i] = n4 < N ? *(const f32x4*)(W + (size_t)(k0 + kk) * N + n4) : (f32x4){0.f, 0.f, 0.f, 0.f}; }
#pragma unroll
    for (int i = 0; i < 8; ++i) { const int kk = 8 * i + (lane >> 3);
        if (kscale) v[i] = v[i] * kscale[k0 + kk];
        LAS float* d = scr + kk * 33 + (lane & 7) * 4; d[0] = v[i][0]; d[1] = v[i][1]; d[2] = v[i][2]; d[3] = v[i][3]; }
    LDS_WAIT(); asm volatile("" ::: "memory");
    const int c = lane & 7;
#pragma unroll
    for (int j = 0; j < 4; ++j) { const int n = (lane >> 3) + 8 * j; const LAS float* s = scr + (8 * c) * 33 + n;
        const int nsrc = n0 + n; const int drow = nsrc < N ? rm(nsrc) : -1;
        u32x4 o; o.x = cvtpk(s[0 * 33], s[1 * 33]); o.y = cvtpk(s[2 * 33], s[3 * 33]); o.z = cvtpk(s[4 * 33], s[5 * 33]); o.w = cvtpk(s[6 * 33], s[7 * 33]);
        if (drow >= 0) *(u32x4*)(WT + (size_t)drow * ldw + k0 + 8 * c) = o; }
    LDS_WAIT(); asm volatile("" ::: "memory");
}
DI float softplusf_(float x) { return x > 20.f ? x : log1pf(__expf(x)); }

#ifndef PROBE_REP
#define PROBE_REP -1
#endif
DI void p0_prologue(KA A, LAS unsigned char* lds) {
    const int tid = threadIdx.x, lane = tid & 63, wave = __builtin_amdgcn_readfirstlane(tid >> 6);
    const int G = gridDim.x, gw = blockIdx.x * NWAVES + wave, NGW = G * NWAVES;
    const int gt = blockIdx.x * NTHREADS + tid, NGT = G * NTHREADS;
    unsigned char* ws = A->ws;
    for (int rep = 0; rep < (PROBE_REP == 1001 ? 2 : 1); ++rep) {
        LAS float* scr = (LAS float*)(lds + wave * 16384);
        constexpr int I_IN = 16 * 153, I_OA = 8 * 32, I_OUT = 16 * 32, I_G = 16 * 88, I_D = 44 * 32;
        constexpr int NIT = I_IN + 2 * I_OA + I_OUT + 2 * I_G + I_D;
        for (int it = gw; it < NIT; it += NGW) {
            int r = it;
            if (r < I_IN) { transpose_item(A->w_in, 1024, NIN_SRC, (bf16*)(ws + WS_WIN), [](int c) -> int {
                    if (c < 640) return (c & ~63) + pos_of_d(c & 63);
                    if (c < 2816) return c;
                    if (c < 2824) return -1;
                    return c - 8; }, nullptr, scr, r, lane); continue; } r -= I_IN;
            if (r < I_OA) { transpose_item(A->w_oa, 512, 1024, (bf16*)(ws + WS_WOA), [](int c) -> int { return c; }, nullptr, scr, r, lane, 1024); continue; } r -= I_OA;
            if (r < I_OA) { transpose_item(A->w_ob, 512, 1024, (bf16*)(ws + WS_WOA) + 512, [](int c) -> int { return c; }, nullptr, scr, r, lane, 1024); continue; } r -= I_OA;
            if (r < I_OUT) { transpose_item(A->w_out, 1024, 1024, (bf16*)(ws + WS_WOUT), [](int c) -> int { return c; }, nullptr, scr, r, lane); continue; } r -= I_OUT;
            if (r < I_G) { transpose_item(A->w_gate, 1024, DFF, (bf16*)(ws + WS_WGU), [](int c) -> int { return 256 * (c >> 7) + (c & 127); }, A->norm_ffn, scr, r, lane); continue; } r -= I_G;
            if (r < I_G) { transpose_item(A->w_up, 1024, DFF, (bf16*)(ws + WS_WGU), [](int c) -> int { return 256 * (c >> 7) + 128 + (c & 127); }, A->norm_ffn, scr, r, lane); continue; } r -= I_G;
            transpose_item(A->w_down, DFF, 1024, (bf16*)(ws + WS_WD), [](int c) -> int { return c; }, nullptr, scr, r, lane);
        }
    }
    for (int rep = 0; rep < (PROBE_REP == 1002 ? 2 : 1); ++rep) {
        float* COS = (float*)(ws + WS_ROPE); float* SIN = COS + (TP + TS) * 32;
        for (int i = gt; i < (TP + TS) * 32; i += NGT) { const int ri = i >> 5, f = i & 31; const double pos = ri < TP ? (double)ri : (double)(PAST + ri - TP);
            const double inv = exp2(-(double)f * (13.287712379549449 / 32.0)), ang = pos * inv; COS[i] = (float)cos(ang); SIN[i] = (float)sin(ang); }
        constexpr int PERB = 124 * 128 / 4;
        for (int i = gt; i < SBATCH * PERB; i += NGT) { const int b = i / PERB, o = i - b * PERB;
            ((f32x4*)(A->out + O_KS))[(size_t)b * 4096 + o] = ((const f32x4*)A->cache_k)[(size_t)b * 4096 + 128 + o];
            ((f32x4*)(A->out + O_VS))[(size_t)b * 4096 + o] = ((const f32x4*)A->cache_v)[(size_t)b * 4096 + 128 + o]; }
    }
    for (int rep = 0; rep < (PROBE_REP == 1003 ? 2 : 1); ++rep) {
        unsigned wab[16][4];
        f32x4 nm[4];
#pragma unroll
        for (int j = 0; j < 4; ++j) {
            nm[j] = ((const f32x4*)A->norm_mix)[lane + 64 * j];
#pragma unroll
            for (int e = 0; e < 4; ++e) { const float* p = A->w_in + (size_t)(4 * (lane + 64 * j) + e) * NIN_SRC + 2816;
                const f32x4 a = *(const f32x4*)p, b = *(const f32x4*)(p + 4);
                wab[j * 4 + e][0] = cvtpk(a[0], a[1]); wab[j * 4 + e][1] = cvtpk(a[2], a[3]); wab[j * 4 + e][2] = cvtpk(b[0], b[1]); wab[j * 4 + e][3] = cvtpk(b[2], b[3]); }
        }
        bf16* XN = (bf16*)(ws + WS_XN); f32x2* GB = (f32x2*)(ws + WS_GB);
        auto row_src = [&](int urow) -> const float* {
            if (urow < MP) { const int b = urow / TP, t = urow - b * TP; return t < NMETA ? A->meta + (size_t)t * D : A->x_prompt + ((size_t)b * SEQ + (t - NMETA)) * D; }
            if (urow < MU) return A->x_sample + (size_t)(urow - MP) * D;
            return nullptr; };
        f32x4 nx[4];
        { const float* s0 = gw < MUP ? row_src(gw) : nullptr;
#pragma unroll
          for (int j = 0; j < 4; ++j) nx[j] = s0 ? ((const f32x4*)s0)[lane + 64 * j] : (f32x4){0.f, 0.f, 0.f, 0.f}; }
#pragma unroll 1
        for (int urow = gw; urow < MUP; urow += NGW) {
            f32x4 v[4];
#pragma unroll
            for (int j = 0; j < 4; ++j) v[j] = nx[j];
            { const int un = urow + NGW; const float* s1 = un < MUP ? row_src(un) : nullptr;
#pragma unroll
              for (int j = 0; j < 4; ++j) nx[j] = s1 ? ((const f32x4*)s1)[lane + 64 * j] : (f32x4){0.f, 0.f, 0.f, 0.f}; }
            u32x2* o8 = (u32x2*)(XN + (size_t)urow * D) + lane;
            float ss = 0.f;
#pragma unroll
            for (int j = 0; j < 4; ++j) ss += (v[j][0] * v[j][0] + v[j][1] * v[j][1]) + (v[j][2] * v[j][2] + v[j][3] * v[j][3]);
            const float rstd = urow < MU ? rsqrtf(wave_sum(ss) * (1.0f / D) + EPS) : 0.f;
            float dot[8];
#pragma unroll
            for (int c = 0; c < 8; ++c) dot[c] = 0.f;
#pragma unroll
            for (int j = 0; j < 4; ++j) { v[j] = v[j] * rstd * nm[j];
                o8[64 * j] = (u32x2){cvtpk(v[j][0], v[j][1]), cvtpk(v[j][2], v[j][3])};
#pragma unroll
                for (int e = 0; e < 4; ++e)
#pragma unroll
                    for (int c = 0; c < 4; ++c) { dot[2 * c] += v[j][e] * bflo(wab[j * 4 + e][c]); dot[2 * c + 1] += v[j][e] * bfhi(wab[j * 4 + e][c]); } }
            float d4[4], d2[2], d1;
#pragma unroll
            for (int c = 0; c < 4; ++c) { const float keep = (lane & 32) ? dot[4 + c] : dot[c], send = (lane & 32) ? dot[c] : dot[4 + c]; d4[c] = keep + __shfl_xor(send, 32); }
#pragma unroll
            for (int c = 0; c < 2; ++c) { const float keep = (lane & 16) ? d4[2 + c] : d4[c], send = (lane & 16) ? d4[c] : d4[2 + c]; d2[c] = keep + __shfl_xor(send, 16); }
            { const float keep = (lane & 8) ? d2[1] : d2[0], send = (lane & 8) ? d2[0] : d2[1]; d1 = keep + __shfl_xor(send, 8); }
            d1 += __shfl_xor(d1, 4); d1 += __shfl_xor(d1, 2); d1 += __shfl_xor(d1, 1);
            const float a_ = __shfl(d1, ((lane & 2) ? 16 : 0) + ((lane & 1) ? 8 : 0));
            const float b_ = __shfl(d1, 32 + ((lane & 2) ? 16 : 0) + ((lane & 1) ? 8 : 0));
            if (lane < 4) {
                const float g = -__expf(A->a_log[lane]) * softplusf_(a_ + A->dt_bias[lane]);
                GB[(size_t)urow * 4 + lane] = urow < MU ? (f32x2){g, sigmoidf_(b_)} : (f32x2){0.f, 0.f};
            }
        }
    }
}
DI void item_decode(int item, int& b, int& h, bool& sample, int& t0, int& L) {
    if (item < N_ITEMS_P) { const int s = item / CHUNKS_P, c = item - s * CHUNKS_P; b = s >> 2; h = s & 3; sample = false; if (c == 0) { t0 = 0; L = NMETA; } else { t0 = NMETA + 64 * (c - 1); L = 64; } }
    else { const int s = item - N_ITEMS_P; b = s >> 2; h = s & 3; sample = true; t0 = 0; L = TS; }
}
#define LDS_BARRIER() do { asm volatile("s_waitcnt lgkmcnt(0)" ::: "memory"); __builtin_amdgcn_s_barrier(); asm volatile("" ::: "memory"); } while (0)
typedef GAS unsigned long long gu64;
constexpr size_t CTL_F1 = 655360;
static_assert(CTL_F1 + 2592 * 64 <= 1048576, "control region map");
DI gu64* item_flag1(KA A, int item) { return (gu64*)(A->ws + WS_CTL + CTL_F1 + (size_t)item * 64); }
DI int order_item(int m) { return m < N_ITEMS_P ? (m & 31) * CHUNKS_P + (m >> 5) : m; }
DI gu64* item_granule(KA A, int item) { return (gu64*)(A->ws + WS_CTL + CTL_GRAN + (size_t)item * 64); }
DI float wait_item(gu64* g, unsigned ep = 1u) {
    unsigned long long x; unsigned spins = 0;
    for (;;) { x = __hip_atomic_load(g, __ATOMIC_RELAXED, __HIP_MEMORY_SCOPE_AGENT); if ((unsigned)(x >> 32) >= ep) break; __builtin_amdgcn_s_sleep(8); if (++spins > (1u << 20)) break; }
    asm volatile("" ::: "memory");
    return __uint_as_float((unsigned)__builtin_amdgcn_readfirstlane((int)(unsigned)x));
}
constexpr int LDS_GCL = 139264;
constexpr int PITCH = 132;
DI bf16x8 frag_nat(const LAS float* src, int row, int k0) {
    const f32x4 lo = *(const LAS f32x4*)(src + row * PITCH + k0), hi = *(const LAS f32x4*)(src + row * PITCH + k0 + 4);
    return __builtin_bit_cast(bf16x8, pack8f(lo, hi));
}
struct S1Pre { u32x4 xr[11]; f32x4 w[4][2]; f32x2 gb; };
DI void stage1_issue(KA A, int item, S1Pre& P) {
    const int tid = threadIdx.x, lane = tid & 63, wave = __builtin_amdgcn_readfirstlane(tid >> 6);
    int b, h, t0, L; bool sample; item_decode(item, b, h, sample, t0, L);
    const bf16* QKVB = (const bf16*)(A->ws + WS_QKVB);
    const int cv = lane < 48 ? lane : 47, grp = cv >> 4, col0 = (cv & 15) * 8, r0 = wave * 8, cidx = grp * 512 + h * 128 + col0;
#pragma unroll
    for (int q = 0; q < 11; ++q) {
        const int i = r0 - 3 + q;
        long urow = sample ? (long)MP + b * TS + i : (long)b * TP + t0 + i;
        const bool ok = sample ? i >= 0 : t0 + i >= 0;
        if (!ok) urow = 0;
        P.xr[q] = *(const u32x4*)(QKVB + (size_t)urow * CONVD + cidx);
        if (!ok) P.xr[q] = (u32x4){0u, 0u, 0u, 0u};
    }
#pragma unroll
    for (int i = 0; i < 4; ++i) { P.w[i][0] = *(const f32x4*)(A->conv_w + i * CONVD + cidx); P.w[i][1] = *(const f32x4*)(A->conv_w + i * CONVD + cidx + 4); }
    P.gb = (f32x2){0.f, 0.f};
    if (wave == 7 && lane < L) { const int urow = sample ? MP + b * TS + lane : b * TP + t0 + lane; P.gb = ((const f32x2*)(A->ws + WS_GB))[(size_t)urow * 4 + h]; }
}
DI void prep_stage1(KA A, int item, int next_item, int prev_item, int wait_item_idx, int bslot, float* ats, S1Pre& P, LAS unsigned char* ldsb, unsigned ep, int pmode = 0) {
    const int tid = threadIdx.x, lane = tid & 63, wave = __builtin_amdgcn_readfirstlane(tid >> 6), r = lane & 31, hh = lane >> 5;
#ifdef PROBE_PLAIN
    const bool plain_ = ep == 2u;
#define ST16(p, ...) do { if (plain_) *(u32x4*)(p) = (__VA_ARGS__); else st16_sc1((p), (__VA_ARGS__)); } while (0)
#define ST16F(p, ...) do { if (plain_) *(f32x4*)(p) = (__VA_ARGS__); else st16_sc1f((p), (__VA_ARGS__)); } while (0)
#else
#define ST16(p, ...) st16_sc1((p), (__VA_ARGS__))
#define ST16F(p, ...) st16_sc1f((p), (__VA_ARGS__))
#endif
    int b, h, t0, L; bool sample; item_decode(item, b, h, sample, t0, L);
    LAS float* Qs = (LAS float*)ldsb; LAS float* Ks = Qs + 64 * PITCH; LAS float* Vs = Ks + 64 * PITCH; LAS float* gcs = Vs + 64 * PITCH; LAS float* betas = gcs + 64;
    unsigned char* slot = slot_ptr(A, item);
    if (!(pmode & 8)) {
        const int cv = lane < 48 ? lane : 47, grp = cv >> 4, col0 = (cv & 15) * 8, r0 = wave * 8, cidx = grp * 512 + h * 128 + col0;
        float x[11][8];
#pragma unroll
        for (int q = 0; q < 11; ++q) { x[q][0] = bflo(P.xr[q].x); x[q][1] = bfhi(P.xr[q].x); x[q][2] = bflo(P.xr[q].y); x[q][3] = bfhi(P.xr[q].y);
                                       x[q][4] = bflo(P.xr[q].z); x[q][5] = bfhi(P.xr[q].z); x[q][6] = bflo(P.xr[q].w); x[q][7] = bfhi(P.xr[q].w); }
        if (sample && wave == 0) {
#pragma unroll
            for (int q = 0; q < 3; ++q) { const float* sp = A->state_conv + ((size_t)b * 3 + q) * CONVD + cidx; const f32x4 s0 = *(const f32x4*)sp, s1 = *(const f32x4*)(sp + 4);
                x[q][0] = s0[0]; x[q][1] = s0[1]; x[q][2] = s0[2]; x[q][3] = s0[3]; x[q][4] = s1[0]; x[q][5] = s1[1]; x[q][6] = s1[2]; x[q][7] = s1[3]; }
        }
        float w[4][8];
#pragma unroll
        for (int i = 0; i < 4; ++i) { w[i][0] = P.w[i][0][0]; w[i][1] = P.w[i][0][1]; w[i][2] = P.w[i][0][2]; w[i][3] = P.w[i][0][3]; w[i][4] = P.w[i][1][0]; w[i][5] = P.w[i][1][1]; w[i][6] = P.w[i][1][2]; w[i][7] = P.w[i][1][3]; }
        LAS float* dst = Qs + grp * 64 * PITCH + col0;
        const float nsc = grp == 0 ? 0.08838834764831845f : 1.0f;
#pragma unroll
        for (int q = 3; q < 11; ++q) {
            const int rr = r0 + q - 3;
            float v[8]; float ss = 0.f;
#pragma unroll
            for (int e = 0; e < 8; ++e) {
                const float y = __builtin_fmaf(w[3][e], x[q][e], __builtin_fmaf(w[2][e], x[q - 1][e], __builtin_fmaf(w[1][e], x[q - 2][e], w[0][e] * x[q - 3][e])));
                const float sv = siluf_(y); v[e] = sv; ss = __builtin_fmaf(sv, sv, ss); }
            ss += __builtin_bit_cast(float, __builtin_amdgcn_update_dpp(0, __builtin_bit_cast(int, ss), 0xB1, 0xF, 0xF, true));
            ss += __builtin_bit_cast(float, __builtin_amdgcn_update_dpp(0, __builtin_bit_cast(int, ss), 0x4E, 0xF, 0xF, true));
            ss += __builtin_bit_cast(float, __builtin_amdgcn_update_dpp(0, __builtin_bit_cast(int, ss), 0x141, 0xF, 0xF, true));
            ss += __builtin_bit_cast(float, __builtin_amdgcn_update_dpp(0, __builtin_bit_cast(int, ss), 0x140, 0xF, 0xF, true));
            float sc = grp == 2 ? 1.0f : rsqrtf(ss + EPS) * nsc;
            sc = rr < L ? sc : 0.f;
            if (lane < 48) { *(LAS f32x4*)(dst + rr * PITCH) = (f32x4){v[0] * sc, v[1] * sc, v[2] * sc, v[3] * sc}; *(LAS f32x4*)(dst + rr * PITCH + 4) = (f32x4){v[4] * sc, v[5] * sc, v[6] * sc, v[7] * sc}; }
        }
    }
    if (wave == 7) {
        float gc = P.gb[0];
#pragma unroll
        for (int o = 1; o < 64; o <<= 1) { const float t = __shfl_up(gc, o); if (lane >= o) gc += t; }
        gcs[lane] = gc; betas[lane] = P.gb[1];
        if (lane == 63) ((LAS float*)(ldsb + LDS_GCL))[bslot] = __expf(gc);
    }
    asm volatile("s_waitcnt vmcnt(0)" ::: "memory");
    if (next_item < N_ITEMS) stage1_issue(A, next_item, P);
    if (wait_item_idx >= 0 && wave == 0) (void)wait_item(item_granule(A, wait_item_idx), ep);
    LDS_BARRIER();
    if (prev_item >= 0 && tid == 0) __hip_atomic_store(item_flag1(A, prev_item), ((unsigned long long)ep << 32) | (unsigned long long)__float_as_uint(((const LAS float*)(ldsb + LDS_GCL))[bslot ^ 1]), __ATOMIC_RELAXED, __HIP_MEMORY_SCOPE_AGENT);
    if (wave < 6 && !(pmode & 4)) {
        const bool isqk = wave >= 3; const int tsel = isqk ? wave - 3 : wave, ib = tsel == 0 ? 0 : 1, jb = tsel == 2 ? 1 : 0;
        const LAS float* Asrc = isqk ? Qs : Ks;
        f32x16 acc;
#pragma unroll
        for (int e = 0; e < 16; ++e) acc[e] = 0.f;
#pragma unroll
        for (int s = 0; s < 8; ++s) acc = MFMA32(frag_nat(Asrc, 32 * ib + r, 16 * s + 8 * hh), frag_nat(Ks, 32 * jb + r, 16 * s + 8 * hh), acc);
        const int j = 32 * jb + r; const float gcj = gcs[j];
        float* Aout = ats + (ib + jb) * 1024; bf16* QKD = (bf16*)(slot + SL_QKD);
        if (!isqk) {
#pragma unroll
            for (int g4 = 0; g4 < 4; ++g4) { f32x4 v;
#pragma unroll
                for (int e = 0; e < 4; ++e) { const int i = 32 * ib + 8 * g4 + 4 * hh + e; v[e] = i > j ? betas[i] * __expf(fminf(gcs[i] - gcj, 0.f)) * acc[4 * g4 + e] : 0.f; }
                ST16F(Aout + r * 32 + 8 * g4 + 4 * hh, v); }
        } else {
            LAS float* patch = (LAS float*)(ldsb + 106496) + (wave - 3) * (32 * 36);
#pragma unroll
            for (int reg = 0; reg < 16; ++reg) { const int il = crow16(reg, hh), i = 32 * ib + il; const float dec = __expf(fminf(gcs[i] - gcj, 0.f));
                patch[il * 36 + r] = i >= j ? dec * acc[reg] : 0.f; }
            LDS_WAIT(); asm volatile("" ::: "memory");
#pragma unroll
            for (int ks2 = 0; ks2 < 2; ++ks2) { const int k0 = 16 * ks2 + 4 * hh;
                const f32x4 lo = *(const LAS f32x4*)(patch + r * 36 + k0), hi = *(const LAS f32x4*)(patch + r * 36 + k0 + 8);
                ST16((unsigned char*)QKD + ((ib * 4 + 2 * jb + ks2) * 64 + lane) * 16, pack8f(lo, hi)); }
        }
    }
    const float gcl = gcs[63];
#pragma unroll 1
    for (int job = (pmode & 4) ? 56 : wave; job < 56; job += 8) {
        if (job < 32) {
            const bool isq = job >= 16; const int jj = job & 15, rb = jj >> 3, ks = jj & 7, row = 32 * rb + r, k0 = 16 * ks + 4 * hh;
            const LAS float* src = isq ? Qs : Ks; const float sc = isq ? __expf(gcs[row]) : betas[row] * __expf(gcs[row]);
            const f32x4 lo = *(const LAS f32x4*)(src + row * PITCH + k0) * sc, hi = *(const LAS f32x4*)(src + row * PITCH + k0 + 8) * sc;
            ST16(slot + (isq ? SL_QE : SL_BEK) + ((rb * 8 + ks) * 64 + lane) * 16, pack8f(lo, hi));
        } else if (job < 48) {
            const int jj = job - 32, rb = jj >> 2, ks = jj & 3, dk = 32 * rb + r;
            f32x4 lo, hi;
#pragma unroll
            for (int e = 0; e < 4; ++e) { const int j0 = 16 * ks + 4 * hh + e, j1 = j0 + 8;
                lo[e] = Ks[j0 * PITCH + dk] * __expf(gcl - gcs[j0]); hi[e] = Ks[j1 * PITCH + dk] * __expf(gcl - gcs[j1]); }
            ST16(slot + SL_KWT + ((rb * 4 + ks) * 64 + lane) * 16, pack8f(lo, hi));
        } else {
            const int q = job - 48, w = q >> 1, ib = q & 1, dv = 32 * w + r;
            float v[16];
#pragma unroll
            for (int reg = 0; reg < 16; ++reg) { const int i = 32 * ib + crow16(reg, hh); v[reg] = betas[i] * Vs[i * PITCH + dv]; }
            u32x4* dst = (u32x4*)(slot + SL_BV + ((w * 2 + ib) * 64 + lane) * 32);
            ST16(dst, (u32x4){cvtpk(v[0], v[1]), cvtpk(v[2], v[3]), cvtpk(v[4], v[5]), cvtpk(v[6], v[7])});
            ST16(dst + 1, (u32x4){cvtpk(v[8], v[9]), cvtpk(v[10], v[11]), cvtpk(v[12], v[13]), cvtpk(v[14], v[15])});
        }
    }
    LDS_BARRIER();
}
DI void prep_stage2(KA A, int item, float gcl, const float* ats, LAS float* M, unsigned ep) {
    int lane = threadIdx.x & 63; asm volatile("" : "+v"(lane));
    const int r = lane & 31, hh = lane >> 5, base = 32 * hh;
    unsigned char* slot = slot_ptr(A, item);
    const f32x4* Ain = (const f32x4*)ats;
#pragma unroll
    for (int tt = 0; tt < 3; ++tt) { const int jb = tt >> 1, ib = (tt + 1) >> 1;
#pragma unroll
        for (int q = 0; q < 4; ++q) { const int idx = q * 64 + lane, jj = idx >> 3, i4 = idx & 7;
            *(LAS f32x4*)(M + (32 * jb + jj) * 64 + 32 * ib + 4 * i4) = Ain[tt * 256 + idx]; } }
    LDS_WAIT(); asm volatile("" ::: "memory");
#pragma unroll 1
    for (int rb = 0; rb < 2; ++rb) {
        float acc[16];
#pragma unroll
        for (int i = 0; i < 16; ++i) acc[i] = r == 16 * rb + i ? 1.f : 0.f;
        if (rb == 1) {
#pragma unroll 4
            for (int j = 0; j < 16; ++j) {
                float tj = M[(base + j) * 64 + base + r]; tj = r <= j ? tj : 0.f;
                const LAS f32x4* ar = (const LAS f32x4*)(M + (base + j) * 64 + base + 16);
                const f32x4 a0 = ar[0], a1 = ar[1], a2 = ar[2], a3 = ar[3];
#pragma unroll
                for (int e = 0; e < 4; ++e) { acc[e] -= a0[e] * tj; acc[4 + e] -= a1[e] * tj; acc[8 + e] -= a2[e] * tj; acc[12 + e] -= a3[e] * tj; }
            }
        }
#pragma unroll
        for (int j = 0; j < 16; ++j) {
            const float tj = acc[j]; const int row = base + 16 * rb + j;
            const LAS f32x4* ar = (const LAS f32x4*)(M + row * 64 + base + 16 * rb);
            float a[16];
#pragma unroll
            for (int q = j >> 2; q < 4; ++q) { const f32x4 v = ar[q]; a[4 * q] = v[0]; a[4 * q + 1] = v[1]; a[4 * q + 2] = v[2]; a[4 * q + 3] = v[3]; }
            if (r <= 16 * rb + j) M[row * 64 + base + r] = tj;
#pragma unroll
            for (int i = j + 1; i < 16; ++i) acc[i] -= a[i] * tj;
        }
        asm volatile("" ::: "memory");
    }
    LDS_WAIT(); asm volatile("" ::: "memory");
    f32x16 X;
#pragma unroll
    for (int e = 0; e < 16; ++e) X[e] = 0.f;
#pragma unroll
    for (int s2 = 0; s2 < 16; ++s2) { const int k = 2 * s2 + hh; const float a = M[k * 64 + 32 + r]; float bb = M[k * 64 + r]; bb = r <= k ? bb : 0.f;
        X = __builtin_amdgcn_mfma_f32_32x32x2f32(a, bb, X, 0, 0, 0); }
#pragma unroll
    for (int reg = 0; reg < 16; ++reg) M[crow16(reg, hh) * 64 + 32 + r] = X[reg];
    LDS_WAIT(); asm volatile("" ::: "memory");
    f32x16 Y;
#pragma unroll
    for (int e = 0; e < 16; ++e) Y[e] = 0.f;
#pragma unroll
    for (int s2 = 0; s2 < 16; ++s2) { const int k = 2 * s2 + hh; float a = M[(32 + r) * 64 + 32 + k]; a = k <= r ? a : 0.f; const float bb = M[k * 64 + 32 + r];
        Y = __builtin_amdgcn_mfma_f32_32x32x2f32(a, bb, Y, 0, 0, 0); }
#pragma unroll
    for (int reg = 0; reg < 16; ++reg) M[(32 + crow16(reg, hh)) * 64 + r] = -Y[reg];
    LDS_WAIT(); asm volatile("" ::: "memory");
#pragma unroll
    for (int f = 0; f < 8; ++f) { const int rb = f >> 2, ks = f & 3, row = 32 * rb + r, k0 = 16 * ks + 4 * hh;
        f32x4 lo = *(const LAS f32x4*)(M + row * 64 + k0), hi = *(const LAS f32x4*)(M + row * 64 + k0 + 8);
#pragma unroll
        for (int e = 0; e < 4; ++e) { lo[e] = k0 + e <= row ? lo[e] : 0.f; hi[e] = k0 + 8 + e <= row ? hi[e] : 0.f; }
        st16_sc1(slot + SL_T + ((rb * 4 + ks) * 64 + lane) * 16, pack8f(lo, hi)); }
    LDS_WAIT();
    asm volatile("s_waitcnt vmcnt(0)" ::: "memory");
    if (lane == 0) __hip_atomic_store(item_granule(A, item), ((unsigned long long)ep << 32) | (unsigned long long)__float_as_uint(gcl), __ATOMIC_RELAXED, __HIP_MEMORY_SCOPE_AGENT);
}
DI void scan_seq(KA A, int seq, int w, int lane, unsigned ep) {
    const int r = lane & 31, hh = lane >> 5, dv = 32 * w + r;
    const bool sample = seq >= N_PROMPT_SEQ; const int sidx = sample ? seq - N_PROMPT_SEQ : seq, b = sidx >> 2, h = sidx & 3, nch = sample ? 1 : CHUNKS_P;
    f32x16 S[4];
    if (sample) {
        const float* S0 = A->state_delta + ((size_t)(b * 4 + h) * 128) * 128 + dv;
#pragma unroll
        for (int kb = 0; kb < 4; ++kb)
#pragma unroll
            for (int reg = 0; reg < 16; ++reg) S[kb][reg] = S0[(size_t)(32 * kb + crow16(reg, hh)) * 128];
    } else {
#pragma unroll
        for (int kb = 0; kb < 4; ++kb)
#pragma unroll
            for (int reg = 0; reg < 16; ++reg) S[kb][reg] = 0.f;
    }
    bf16* OBR = (bf16*)((unsigned char*)A->out + DO_OB);
#pragma unroll 1
    for (int c = 0; c < nch; ++c) {
        const int item = sample ? N_ITEMS_P + sidx : seq * CHUNKS_P + c;
        const unsigned char* slot = slot_ptr(A, item);
        const float gcl = wait_item(item_granule(A, item), ep);
        __builtin_amdgcn_fence(__ATOMIC_ACQUIRE, "agent");
        const bf16x8* bek = (const bf16x8*)(slot + SL_BEK) + lane; const bf16x8* tp = (const bf16x8*)(slot + SL_T) + lane;
        const bf16x8* qe = (const bf16x8*)(slot + SL_QE) + lane; const bf16x8* qkd = (const bf16x8*)(slot + SL_QKD) + lane; const bf16x8* kwt = (const bf16x8*)(slot + SL_KWT) + lane;
        bf16x8 sf[8];
#pragma unroll
        for (int kb = 0; kb < 4; ++kb) { sf[2 * kb] = pack_step<0>(S[kb]); sf[2 * kb + 1] = pack_step<1>(S[kb]); }
        f32x16 x0, x1;
#pragma unroll
        for (int e = 0; e < 16; ++e) { x0[e] = 0.f; x1[e] = 0.f; }
#pragma unroll
        for (int ks = 0; ks < 8; ++ks) { x0 = MFMA32(bek[ks * 64], sf[ks], x0); x1 = MFMA32(bek[(8 + ks) * 64], sf[ks], x1); }
        {
            const u32x4* bv = (const u32x4*)(slot + SL_BV) + ((w * 2) * 64 + lane) * 2;
            const u32x4 a0 = bv[0], a1 = bv[1], c0 = bv[128], c1 = bv[129];
            x0[0] = bflo(a0.x) - x0[0]; x0[1] = bfhi(a0.x) - x0[1]; x0[2] = bflo(a0.y) - x0[2]; x0[3] = bfhi(a0.y) - x0[3];
            x0[4] = bflo(a0.z) - x0[4]; x0[5] = bfhi(a0.z) - x0[5]; x0[6] = bflo(a0.w) - x0[6]; x0[7] = bfhi(a0.w) - x0[7];
            x0[8] = bflo(a1.x) - x0[8]; x0[9] = bfhi(a1.x) - x0[9]; x0[10] = bflo(a1.y) - x0[10]; x0[11] = bfhi(a1.y) - x0[11];
            x0[12] = bflo(a1.z) - x0[12]; x0[13] = bfhi(a1.z) - x0[13]; x0[14] = bflo(a1.w) - x0[14]; x0[15] = bfhi(a1.w) - x0[15];
            x1[0] = bflo(c0.x) - x1[0]; x1[1] = bfhi(c0.x) - x1[1]; x1[2] = bflo(c0.y) - x1[2]; x1[3] = bfhi(c0.y) - x1[3];
            x1[4] = bflo(c0.z) - x1[4]; x1[5] = bfhi(c0.z) - x1[5]; x1[6] = bflo(c0.w) - x1[6]; x1[7] = bfhi(c0.w) - x1[7];
            x1[8] = bflo(c1.x) - x1[8]; x1[9] = bfhi(c1.x) - x1[9]; x1[10] = bflo(c1.y) - x1[10]; x1[11] = bfhi(c1.y) - x1[11];
            x1[12] = bflo(c1.z) - x1[12]; x1[13] = bfhi(c1.z) - x1[13]; x1[14] = bflo(c1.w) - x1[14]; x1[15] = bfhi(c1.w) - x1[15];
        }
        bf16x8 rf[4] = {pack_step<0>(x0), pack_step<1>(x0), pack_step<0>(x1), pack_step<1>(x1)};
        f32x16 u0, u1;
#pragma unroll
        for (int e = 0; e < 16; ++e) { u0[e] = 0.f; u1[e] = 0.f; }
        u0 = MFMA32(tp[0 * 64], rf[0], u0); u0 = MFMA32(tp[1 * 64], rf[1], u0);
#pragma unroll
        for (int ks = 0; ks < 4; ++ks) u1 = MFMA32(tp[(4 + ks) * 64], rf[ks], u1);
        bf16x8 uf[4] = {pack_step<0>(u0), pack_step<1>(u0), pack_step<0>(u1), pack_step<1>(u1)};
        if (sample || c > 0) {
#pragma unroll
            for (int e = 0; e < 16; ++e) { x0[e] = 0.f; x1[e] = 0.f; }
#pragma unroll
            for (int ks = 0; ks < 8; ++ks) { x0 = MFMA32(qe[ks * 64], sf[ks], x0); x1 = MFMA32(qe[(8 + ks) * 64], sf[ks], x1); }
            x0 = MFMA32(qkd[0 * 64], uf[0], x0); x0 = MFMA32(qkd[1 * 64], uf[1], x0);
#pragma unroll
            for (int ks = 0; ks < 4; ++ks) x1 = MFMA32(qkd[(4 + ks) * 64], uf[ks], x1);
            const int crow0 = sample ? NBATCH * SEQ + b * TS : b * SEQ + 64 * (c - 1), L = sample ? TS : 64;
#pragma unroll
            for (int reg = 0; reg < 16; ++reg) { const int i0 = crow16(reg, hh), i1 = 32 + i0;
                if (i0 < L) OBR[(size_t)(crow0 + i0) * OAB_PITCH + h * 128 + dv] = f2bf(x0[reg]);
                if (i1 < L) OBR[(size_t)(crow0 + i1) * OAB_PITCH + h * 128 + dv] = f2bf(x1[reg]); }
        }
#pragma unroll
        for (int kb = 0; kb < 4; ++kb) {
            S[kb] = S[kb] * gcl;
#pragma unroll
            for (int ks = 0; ks < 4; ++ks) S[kb] = MFMA32(kwt[(kb * 4 + ks) * 64], uf[ks], S[kb]);
        }
    }
    float* So = A->out + (sample ? O_DS : O_DP) + ((size_t)(b * 4 + h) * 128) * 128 + dv;
#pragma unroll
    for (int kb = 0; kb < 4; ++kb)
#pragma unroll
        for (int reg = 0; reg < 16; ++reg) So[(size_t)(32 * kb + crow16(reg, hh)) * 128] = S[kb][reg];
}

constexpr int HALF_BYTES = 40960;
DI void scan_prompt_wg(KA A, int seq, LAS unsigned char* lds, unsigned ep) {
    const int tid = threadIdx.x, lane = tid & 63, wave = __builtin_amdgcn_readfirstlane(tid >> 6);
    const int b = seq >> 2, h = seq & 3;
    constexpr int N = 2 * CHUNKS_P;
    if (wave >= 4) {
        const int loff = (wave - 4) * 10240 + lane * 16;
        u32x4 r0[10], r1[10];
        LAS u32x4* d0 = (LAS u32x4*)(lds + loff); LAS u32x4* d1 = (LAS u32x4*)(lds + HALF_BYTES + loff);
        LAS float* gclw = (LAS float*)(lds + 2 * HALF_BYTES);
#define SCAN_LOAD(n, R) do { const int item_ = seq * CHUNKS_P + ((n) >> 1); \
            if (((n) & 1) == 0) { const float g_ = wait_item(item_granule(A, item_), ep); if (wave == 4 && lane == 0) gclw[((n) >> 1) & 3] = g_; } \
            const __amdgpu_buffer_rsrc_t rs_ = __builtin_amdgcn_make_buffer_rsrc((void*)slot_ptr(A, item_), 0, (int)PREP_SLOT, 0x00020000); \
            _Pragma("unroll") for (int q = 0; q < 10; ++q) R[q] = __builtin_bit_cast(u32x4, __builtin_amdgcn_raw_buffer_load_b128(rs_, ((n) & 1) * HALF_BYTES + loff + q * 1024, 0, 16)); } while (0)
        SCAN_LOAD(0, r0);
#pragma unroll
        for (int q = 0; q < 10; ++q) d0[q * 64] = r0[q];
        SCAN_LOAD(1, r1);
        LDS_BARRIER();
#pragma unroll 1
        for (int n = 0; n < N; n += 2) {
            if (n + 2 < N) SCAN_LOAD(n + 2, r0);
#pragma unroll
            for (int q = 0; q < 10; ++q) d1[q * 64] = r1[q];
            LDS_BARRIER();
            if (n + 3 < N) SCAN_LOAD(n + 3, r1);
            if (n + 2 < N) {
#pragma unroll
                for (int q = 0; q < 10; ++q) d0[q * 64] = r0[q]; }
            LDS_BARRIER();
        }
#undef SCAN_LOAD
    } else {
        const int w = wave, r = lane & 31, hh = lane >> 5, dv = 32 * w + r;
        f32x16 S[4];
#pragma unroll
        for (int kb = 0; kb < 4; ++kb)
#pragma unroll
            for (int reg = 0; reg < 16; ++reg) S[kb][reg] = 0.f;
        bf16* OBR = (bf16*)((unsigned char*)A->out + DO_OB);
        const LAS float* gclw = (const LAS float*)(lds + 2 * HALF_BYTES);
        const LAS bf16x8* bek = (const LAS bf16x8*)(lds + SL_BEK) + lane; const LAS bf16x8* tp = (const LAS bf16x8*)(lds + SL_T) + lane;
        const LAS u32x4* bv = (const LAS u32x4*)(lds + SL_BV) + ((w * 2) * 64 + lane) * 2;
        const LAS bf16x8* qkd = (const LAS bf16x8*)(lds + HALF_BYTES + (SL_QKD - HALF_BYTES)) + lane; const LAS bf16x8* qe = (const LAS bf16x8*)(lds + HALF_BYTES + (SL_QE - HALF_BYTES)) + lane;
        const LAS bf16x8* kwt = (const LAS bf16x8*)(lds + HALF_BYTES + (SL_KWT - HALF_BYTES)) + lane;
        LDS_BARRIER();
#pragma unroll 1
        for (int c = 0; c < CHUNKS_P; ++c) {
            bf16x8 sf[8];
#pragma unroll
            for (int kb = 0; kb < 4; ++kb) { sf[2 * kb] = pack_step<0>(S[kb]); sf[2 * kb + 1] = pack_step<1>(S[kb]); }
            f32x16 x0, x1;
#pragma unroll
            for (int e = 0; e < 16; ++e) { x0[e] = 0.f; x1[e] = 0.f; }
#pragma unroll
            for (int ks = 0; ks < 8; ++ks) { x0 = MFMA32(bek[ks * 64], sf[ks], x0); x1 = MFMA32(bek[(8 + ks) * 64], sf[ks], x1); }
            {
                const u32x4 a0 = bv[0], a1 = bv[1], c0 = bv[128], c1 = bv[129];
                x0[0] = bflo(a0.x) - x0[0]; x0[1] = bfhi(a0.x) - x0[1]; x0[2] = bflo(a0.y) - x0[2]; x0[3] = bfhi(a0.y) - x0[3];
                x0[4] = bflo(a0.z) - x0[4]; x0[5] = bfhi(a0.z) - x0[5]; x0[6] = bflo(a0.w) - x0[6]; x0[7] = bfhi(a0.w) - x0[7];
                x0[8] = bflo(a1.x) - x0[8]; x0[9] = bfhi(a1.x) - x0[9]; x0[10] = bflo(a1.y) - x0[10]; x0[11] = bfhi(a1.y) - x0[11];
                x0[12] = bflo(a1.z) - x0[12]; x0[13] = bfhi(a1.z) - x0[13]; x0[14] = bflo(a1.w) - x0[14]; x0[15] = bfhi(a1.w) - x0[15];
                x1[0] = bflo(c0.x) - x1[0]; x1[1] = bfhi(c0.x) - x1[1]; x1[2] = bflo(c0.y) - x1[2]; x1[3] = bfhi(c0.y) - x1[3];
                x1[4] = bflo(c0.z) - x1[4]; x1[5] = bfhi(c0.z) - x1[5]; x1[6] = bflo(c0.w) - x1[6]; x1[7] = bfhi(c0.w) - x1[7];
                x1[8] = bflo(c1.x) - x1[8]; x1[9] = bfhi(c1.x) - x1[9]; x1[10] = bflo(c1.y) - x1[10]; x1[11] = bfhi(c1.y) - x1[11];
                x1[12] = bflo(c1.z) - x1[12]; x1[13] = bfhi(c1.z) - x1[13]; x1[14] = bflo(c1.w) - x1[14]; x1[15] = bfhi(c1.w) - x1[15];
            }
            bf16x8 rf[4] = {pack_step<0>(x0), pack_step<1>(x0), pack_step<0>(x1), pack_step<1>(x1)};
            f32x16 u0, u1;
#pragma unroll
            for (int e = 0; e < 16; ++e) { u0[e] = 0.f; u1[e] = 0.f; }
            u0 = MFMA32(tp[0 * 64], rf[0], u0); u0 = MFMA32(tp[1 * 64], rf[1], u0);
#pragma unroll
            for (int ks = 0; ks < 4; ++ks) u1 = MFMA32(tp[(4 + ks) * 64], rf[ks], u1);
            bf16x8 uf[4] = {pack_step<0>(u0), pack_step<1>(u0), pack_step<0>(u1), pack_step<1>(u1)};
            LDS_BARRIER();
            if (c > 0) {
#pragma unroll
                for (int e = 0; e < 16; ++e) { x0[e] = 0.f; x1[e] = 0.f; }
#pragma unroll
                for (int ks = 0; ks < 8; ++ks) { x0 = MFMA32(qe[ks * 64], sf[ks], x0); x1 = MFMA32(qe[(8 + ks) * 64], sf[ks], x1); }
                x0 = MFMA32(qkd[0 * 64], uf[0], x0); x0 = MFMA32(qkd[1 * 64], uf[1], x0);
#pragma unroll
                for (int ks = 0; ks < 4; ++ks) x1 = MFMA32(qkd[(4 + ks) * 64], uf[ks], x1);
                bf16* orow = OBR + (size_t)(b * SEQ + 64 * (c - 1)) * OAB_PITCH + h * 128 + dv;
#pragma unroll
                for (int reg = 0; reg < 16; ++reg) { const int i0 = crow16(reg, hh); orow[(size_t)i0 * OAB_PITCH] = f2bf(x0[reg]); orow[(size_t)(32 + i0) * OAB_PITCH] = f2bf(x1[reg]); }
            }
            const float gcl = gclw[c & 3];
#pragma unroll
            for (int kb = 0; kb < 4; ++kb) {
                S[kb] = S[kb] * gcl;
#pragma unroll
                for (int ks = 0; ks < 4; ++ks) S[kb] = MFMA32(kwt[(kb * 4 + ks) * 64], uf[ks], S[kb]);
            }
            LDS_BARRIER();
        }
        float* So = A->out + O_DP + ((size_t)(b * 4 + h) * 128) * 128 + dv;
#pragma unroll
        for (int kb = 0; kb < 4; ++kb)
#pragma unroll
            for (int reg = 0; reg < 16; ++reg) So[(size_t)(32 * kb + crow16(reg, hh)) * 128] = S[kb][reg];
    }
}

constexpr int KPITCH = 72, VPITCH = 264;
DI void attn_unit(KA A, int unit, LAS unsigned char* ldsb) {
    const int tid = threadIdx.x, lane = tid & 63, wave = __builtin_amdgcn_readfirstlane(tid >> 6), r = lane & 31, hh = lane >> 5;
    const int b = unit >> 6, kh = (unit >> 5) & 1, jb = unit & 31, T0 = NMETA + 128 * jb;
    LAS bf16* Ksm = (LAS bf16*)ldsb; LAS bf16* VTs = Ksm + 256 * KPITCH;
    const bf16* KVg = (const bf16*)(A->ws + WS_KV); const bf16* QAg = (const bf16*)(A->ws + WS_QA);
#pragma unroll
    for (int e4 = 0; e4 < 4; ++e4) {
        const int id = tid + 512 * e4, key = id >> 3, cch = id & 7, tk = T0 - 128 + key;
        u32x4 kq = (u32x4){0u, 0u, 0u, 0u}, vq = kq;
        if (tk >= 0) { const bf16* src = KVg + (size_t)(b * TP + tk) * 256 + kh * 64 + 8 * cch; kq = *(const u32x4*)src; vq = *(const u32x4*)(src + 128); }
        *(LAS u32x4*)(Ksm + key * KPITCH + 8 * cch) = kq;
        const int kkk = key & 15, pos = (key & ~15) + 8 * ((kkk >> 2) & 1) + (((kkk >> 3) << 2) | (kkk & 3));
        LAS bf16* vd = VTs + (8 * cch) * VPITCH + pos;
        vd[0 * VPITCH] = (bf16)(vq.x & 0xffffu); vd[1 * VPITCH] = (bf16)(vq.x >> 16); vd[2 * VPITCH] = (bf16)(vq.y & 0xffffu); vd[3 * VPITCH] = (bf16)(vq.y >> 16);
        vd[4 * VPITCH] = (bf16)(vq.z & 0xffffu); vd[5 * VPITCH] = (bf16)(vq.z >> 16); vd[6 * VPITCH] = (bf16)(vq.w & 0xffffu); vd[7 * VPITCH] = (bf16)(vq.w >> 16);
    }
    LDS_BARRIER();
    const int g = wave >> 1, qh = wave & 1, head = 4 * kh + g;
    const float sink2 = A->sinks[head] * 1.4426950408889634f;
    const int kmin = jb == 0 ? 128 - NMETA : 0;
#pragma unroll 1
    for (int q2 = 0; q2 < 2; ++q2) {
        const int qb = 2 * qh + q2, iq = 32 * qb + r;
        const bf16* qrow = QAg + (size_t)(b * TP + T0 + iq) * 512 + head * 64 + 8 * hh;
        bf16x8 qf[4];
#pragma unroll
        for (int s = 0; s < 4; ++s) qf[s] = *(const bf16x8*)(qrow + 16 * s);
        f32x16 st[5];
        float m = sink2;
#pragma unroll
        for (int kt5 = 0; kt5 < 5; ++kt5) {
            const int kt = qb + kt5;
            f32x16 acc;
#pragma unroll
            for (int e = 0; e < 16; ++e) acc[e] = 0.f;
#pragma unroll
            for (int s = 0; s < 4; ++s) acc = MFMA32(*(const LAS bf16x8*)(Ksm + (32 * kt + r) * KPITCH + 16 * s + 8 * hh), qf[s], acc);
#pragma unroll
            for (int reg = 0; reg < 16; ++reg) { const int kk = 32 * kt + crow16(reg, hh); const bool ok = kk >= iq && kk <= iq + 128 && kk >= kmin;
                acc[reg] = ok ? acc[reg] : -INFINITY; m = fmaxf(m, acc[reg]); }
            st[kt5] = acc;
        }
        m = fmaxf(m, __shfl_xor(m, 32));
        float l = 0.f;
#pragma unroll
        for (int kt5 = 0; kt5 < 5; ++kt5)
#pragma unroll
            for (int reg = 0; reg < 16; ++reg) { const float p = exp2f(st[kt5][reg] - m); st[kt5][reg] = p; l += p; }
        l += __shfl_xor(l, 32); l += exp2f(sink2 - m);
        f32x16 o0, o1;
#pragma unroll
        for (int e = 0; e < 16; ++e) { o0[e] = 0.f; o1[e] = 0.f; }
#pragma unroll
        for (int kt5 = 0; kt5 < 5; ++kt5) {
            const int kt = qb + kt5;
            const bf16x8 p0 = pack_step<0>(st[kt5]), p1 = pack_step<1>(st[kt5]);
            const LAS bf16* vb = VTs + r * VPITCH + 32 * kt + 8 * hh;
            o0 = MFMA32(*(const LAS bf16x8*)(vb), p0, o0); o0 = MFMA32(*(const LAS bf16x8*)(vb + 16), p1, o0);
            o1 = MFMA32(*(const LAS bf16x8*)(vb + 32 * VPITCH), p0, o1); o1 = MFMA32(*(const LAS bf16x8*)(vb + 32 * VPITCH + 16), p1, o1);
        }
        const float rl = 1.0f / l;
        bf16* orow = (bf16*)((unsigned char*)A->out + DO_OA) + (size_t)(b * SEQ + 128 * jb + iq) * OAB_PITCH + head * 64 + 4 * hh;
#pragma unroll
        for (int g4 = 0; g4 < 4; ++g4) {
            *(u32x2*)(orow + 8 * g4) = (u32x2){cvtpk(o0[4 * g4] * rl, o0[4 * g4 + 1] * rl), cvtpk(o0[4 * g4 + 2] * rl, o0[4 * g4 + 3] * rl)};
            *(u32x2*)(orow + 32 + 8 * g4) = (u32x2){cvtpk(o1[4 * g4] * rl, o1[4 * g4 + 1] * rl), cvtpk(o1[4 * g4 + 2] * rl, o1[4 * g4 + 3] * rl)};
        }
    }
    LDS_BARRIER();
}
DI void sample_attn(KA A, int b, int head, LAS float* wl, int lane) {
    const int kh = head >> 2;
    LAS float* qn = wl; LAS float* ps = wl + 256;
    const bf16* QAg = (const bf16*)(A->ws + WS_QA); const bf16* KVg = (const bf16*)(A->ws + WS_KV);
#pragma unroll
    for (int i = 0; i < 4; ++i) qn[i * 64 + lane] = bf2f(QAg[(size_t)(MP + b * TS + i) * 512 + head * 64 + pos_of_d(lane)]);
    LDS_WAIT(); asm volatile("" ::: "memory");
    const float sink2 = A->sinks[head] * 1.4426950408889634f;
#pragma unroll 1
    for (int kq = 0; kq < 3; ++kq) {
        const int kj = lane + 64 * kq;
        float sc0 = 0.f, sc1 = 0.f, sc2 = 0.f, sc3 = 0.f;
        if (kj < 128) {
            const f32x4* kr = (const f32x4*)(A->cache_k + ((size_t)(b * 128 + kj) * 2 + kh) * 64);
#pragma unroll 4
            for (int d4 = 0; d4 < 16; ++d4) { const f32x4 kv = kr[d4];
                const f32x4 q0 = *(const LAS f32x4*)(qn + 4 * d4), q1 = *(const LAS f32x4*)(qn + 64 + 4 * d4), q2 = *(const LAS f32x4*)(qn + 128 + 4 * d4), q3 = *(const LAS f32x4*)(qn + 192 + 4 * d4);
                sc0 += (kv[0] * q0[0] + kv[1] * q0[1]) + (kv[2] * q0[2] + kv[3] * q0[3]); sc1 += (kv[0] * q1[0] + kv[1] * q1[1]) + (kv[2] * q1[2] + kv[3] * q1[3]);
                sc2 += (kv[0] * q2[0] + kv[1] * q2[1]) + (kv[2] * q2[2] + kv[3] * q2[3]); sc3 += (kv[0] * q3[0] + kv[1] * q3[1]) + (kv[2] * q3[2] + kv[3] * q3[3]); }
        } else if (kj < 132) {
            const bf16* kr = KVg + (size_t)(MP + b * TS + (kj - 128)) * 256 + kh * 64;
#pragma unroll 4
            for (int p = 0; p < 64; ++p) { const float kv = bf2f(kr[p]); const int d = d_of_pos(p);
                sc0 += kv * qn[d]; sc1 += kv * qn[64 + d]; sc2 += kv * qn[128 + d]; sc3 += kv * qn[192 + d]; }
        }
        if (kj < 132) {
            ps[0 * 132 + kj] = (kj >= 0 && kj <= 128) ? sc0 : -INFINITY; ps[1 * 132 + kj] = (kj >= 1 && kj <= 129) ? sc1 : -INFINITY;
            ps[2 * 132 + kj] = (kj >= 2 && kj <= 130) ? sc2 : -INFINITY; ps[3 * 132 + kj] = (kj >= 3 && kj <= 131) ? sc3 : -INFINITY; }
    }
    LDS_WAIT(); asm volatile("" ::: "memory");
    float linv[4];
#pragma unroll
    for (int i = 0; i < 4; ++i) {
        const float s0 = ps[i * 132 + lane], s1 = ps[i * 132 + 64 + lane], s2 = lane < 4 ? ps[i * 132 + 128 + lane] : -INFINITY;
        const float m = wave_max(fmaxf(fmaxf(s0, s1), fmaxf(s2, sink2)));
        const float p0 = exp2f(s0 - m), p1 = exp2f(s1 - m), p2 = exp2f(s2 - m);
        ps[i * 132 + lane] = p0; ps[i * 132 + 64 + lane] = p1; if (lane < 4) ps[i * 132 + 128 + lane] = p2;
        linv[i] = 1.0f / (wave_sum(p0 + p1 + p2) + exp2f(sink2 - m));
    }
    LDS_WAIT(); asm volatile("" ::: "memory");
    float o[4] = {0.f, 0.f, 0.f, 0.f};
#pragma unroll 4
    for (int kj = 0; kj < 128; ++kj) { const float v = A->cache_v[((size_t)(b * 128 + kj) * 2 + kh) * 64 + lane];
#pragma unroll
        for (int i = 0; i < 4; ++i) o[i] += ps[i * 132 + kj] * v; }
#pragma unroll
    for (int kj = 128; kj < 132; ++kj) { const float v = bf2f(KVg[(size_t)(MP + b * TS + (kj - 128)) * 256 + 128 + kh * 64 + lane]);
#pragma unroll
        for (int i = 0; i < 4; ++i) o[i] += ps[i * 132 + kj] * v; }
    bf16* OAg = (bf16*)((unsigned char*)A->out + DO_OA);
#pragma unroll
    for (int i = 0; i < 4; ++i) OAg[(size_t)(NBATCH * SEQ + b * TS + i) * OAB_PITCH + head * 64 + lane] = f2bf(o[i] * linv[i]);
    LDS_WAIT(); asm volatile("" ::: "memory");
}
constexpr int NINV_WG = 24;
DI void p23_mixers(KA A, LAS unsigned char* lds, const XcdBarrier& dbg_bar, unsigned ep, int pmode = 0) {
    const int tid = threadIdx.x, lane = tid & 63, wave = __builtin_amdgcn_readfirstlane(tid >> 6), G = gridDim.x, wg = blockIdx.x;
    const int NSCAN = N_PROMPT_SEQ, NP = G - NSCAN - NINV_WG;
    if (wg < NSCAN) { if (!(pmode & 2)) scan_prompt_wg(A, wg, lds, ep); return; }
    if (wg < NSCAN + NINV_WG) {
        const int wv = (wg - NSCAN) * NWAVES + wave, NWV = NINV_WG * NWAVES;
#pragma unroll 1
        for (int m = wv; m < N_ITEMS; m += NWV) {
            const int item = order_item(m), p = m % NP, k = m / NP;
            const float gcl = wait_item(item_flag1(A, item), ep);
            __builtin_amdgcn_fence(__ATOMIC_ACQUIRE, "agent");
            const float* ats = (const float*)((const unsigned char*)A->out + DO_ATS + ((size_t)p * 8 + (k & 7)) * ATS_ITEM);
            if (pmode & 16) { if (lane == 0) __hip_atomic_store(item_granule(A, item), ((unsigned long long)ep << 32), __ATOMIC_RELAXED, __HIP_MEMORY_SCOPE_AGENT); }
            else prep_stage2(A, item, gcl, ats, (LAS float*)(lds + wave * 16384), ep);
        }
        return;
    }
    const int p = wg - NSCAN - NINV_WG;
    {
        const int ntot = p < N_ITEMS ? (N_ITEMS - 1 - p) / NP + 1 : 0;
        S1Pre P;
        if (ntot > 0) stage1_issue(A, order_item(p), P);
        int prev = -1;
#pragma unroll 1
        for (int k = 0; k < ntot; ++k) {
            const int m = p + NP * k, item = order_item(m), nxt = k + 1 < ntot ? order_item(m + NP) : N_ITEMS;
            float* ats = (float*)((unsigned char*)A->out + DO_ATS + ((size_t)p * 8 + (k & 7)) * ATS_ITEM);
            prep_stage1(A, item, nxt, prev, k >= 8 ? order_item(m - 8 * NP) : -1, k & 1, ats, P, lds, ep, pmode);
            prev = item;
        }
        asm volatile("s_waitcnt vmcnt(0)" ::: "memory"); __syncthreads();
        if (prev >= 0 && tid == 0) __hip_atomic_store(item_flag1(A, prev), ((unsigned long long)ep << 32) | (unsigned long long)__float_as_uint(((const LAS float*)(lds + LDS_GCL))[(ntot - 1) & 1]), __ATOMIC_RELAXED, __HIP_MEMORY_SCOPE_AGENT);
    }
    if (pmode & 1) return;
    for (int u = p; u < NBATCH * NKV * 32; u += NP) attn_unit(A, u, lds);
    const int worker = p * NWAVES + wave, NW = NP * NWAVES;
    LAS float* wl = (LAS float*)(lds + 98304 + wave * 4096);
    for (int it = worker; it < SBATCH * NHB * 4 + SBATCH * NHA; it += NW) {
        if (it < SBATCH * NHB * 4) scan_seq(A, N_PROMPT_SEQ + (it >> 2), it & 3, lane, ep);
        else { const int q = it - SBATCH * NHB * 4; sample_attn(A, q >> 3, q & 7, wl, lane); }
    }
}

DI void p3b_gated_norm(KA A) {
    const int tid = threadIdx.x, lane = tid & 63, wave = tid >> 6, gw = blockIdx.x * NWAVES + wave, NGW = gridDim.x * NWAVES;
    const int head = lane >> 4, dv0 = 8 * (lane & 15);
    const f32x4 w0 = *(const f32x4*)(A->gdn_norm + dv0), w1 = *(const f32x4*)(A->gdn_norm + dv0 + 4);
    bf16* OBg = (bf16*)((unsigned char*)A->out + DO_OB); const bf16* Zg = (const bf16*)(A->ws + WS_Z);
    for (int crow = gw; crow < MC; crow += NGW) {
        const u32x4 ow = *(const u32x4*)(OBg + (size_t)crow * OAB_PITCH + head * 128 + dv0);
        const f32x4 a = {bflo(ow.x), bfhi(ow.x), bflo(ow.y), bfhi(ow.y)}, c = {bflo(ow.z), bfhi(ow.z), bflo(ow.w), bfhi(ow.w)};
        float ss = (a[0] * a[0] + a[1] * a[1]) + (a[2] * a[2] + a[3] * a[3]) + (c[0] * c[0] + c[1] * c[1]) + (c[2] * c[2] + c[3] * c[3]);
        ss += __shfl_xor(ss, 1); ss += __shfl_xor(ss, 2); ss += __shfl_xor(ss, 4); ss += __shfl_xor(ss, 8);
        const float rstd = rsqrtf(ss * (1.0f / 128.0f) + EPS);
        const u32x4 zw = *(const u32x4*)(Zg + (size_t)pg8::crow_to_urow(crow) * 512 + head * 128 + dv0);
        f32x4 y0, y1;
        y0[0] = a[0] * rstd * w0[0] * siluf_(bflo(zw.x)); y0[1] = a[1] * rstd * w0[1] * siluf_(bfhi(zw.x)); y0[2] = a[2] * rstd * w0[2] * siluf_(bflo(zw.y)); y0[3] = a[3] * rstd * w0[3] * siluf_(bfhi(zw.y));
        y1[0] = c[0] * rstd * w1[0] * siluf_(bflo(zw.z)); y1[1] = c[1] * rstd * w1[1] * siluf_(bfhi(zw.z)); y1[2] = c[2] * rstd * w1[2] * siluf_(bflo(zw.w)); y1[3] = c[3] * rstd * w1[3] * siluf_(bfhi(zw.w));
        *(u32x4*)(OBg + (size_t)crow * OAB_PITCH + head * 128 + dv0) = pack8f(y0, y1);
    }
}
DI void p8_final_norm(KA A) {
    const int tid = threadIdx.x, lane = tid & 63, wave = tid >> 6, gw = blockIdx.x * NWAVES + wave, NGW = gridDim.x * NWAVES;
    f32x4 nf[4];
#pragma unroll
    for (int j = 0; j < 4; ++j) nf[j] = ((const f32x4*)A->norm_final)[lane + 64 * j];
    for (int crow = gw; crow < MC; crow += NGW) {
        f32x4* row = (f32x4*)(A->out + (size_t)crow * D);
        f32x4 v[4]; float ss = 0.f;
#pragma unroll
        for (int j = 0; j < 4; ++j) { v[j] = row[lane + 64 * j]; ss += (v[j][0] * v[j][0] + v[j][1] * v[j][1]) + (v[j][2] * v[j][2] + v[j][3] * v[j][3]); }
        const float rstd = rsqrtf(wave_sum(ss) * (1.0f / D) + EPS);
#pragma unroll
        for (int j = 0; j < 4; ++j) row[lane + 64 * j] = v[j] * rstd * nf[j];
    }
}
__global__ void __launch_bounds__(NTHREADS, 2) hybrid_fwd(Args Aval) {
    extern __shared__ __attribute__((aligned(16))) unsigned char lds_raw[];
    LAS unsigned char* lds = (LAS unsigned char*)lds_raw;
    const int tid = threadIdx.x;
    int lo, hi; { KA A0 = kargs(); lo = A0->ph_lo; hi = A0->ph_hi; }
#if MK_N_LAUNCHES == 1
#if MK_BARRIER == 1
    volatile LAS unsigned* MISC = (volatile LAS unsigned*)(lds + LDS_MISC);
    if (tid < 64) MISC[tid] = 0u;
    __syncthreads();
    XcdBarrier bar; { KA A0 = kargs(); bar = xcd_barrier_post((unsigned*)(A0->ws + WS_CTL) + 4096, MISC + 8); }
#define GRID_BAR() xcd_barrier(bar)
#else
    cg::grid_group grid = cg::this_grid();
#define GRID_BAR() grid.sync()
#endif
#else
#define GRID_BAR() do {} while (0)
#endif
#ifndef PH_MASK
#define PH_MASK 0x1ff
#endif
#define IN(k) (((PH_MASK >> (k)) & 1) && lo <= (k) && (k) < hi)
#ifndef PROBE_REP
#define PROBE_REP -1
#endif
#define NREP(k) (PROBE_REP == (k) ? 2 : 1)
#define SEAM(k) do { if (IN(k) && IN((k) + 1)) GRID_BAR(); } while (0)
    const int G = gridDim.x, wgid = blockIdx.x;
#if PROBE_REP == 0
    if (IN(0)) { KA A = kargs(); p0_prologue(A, lds); __syncthreads(); }
#endif
    if (IN(0)) { KA A = kargs(); p0_prologue(A, lds); } SEAM(0);
    if (IN(1)) for (int rep = 0; rep < NREP(1); ++rep) { KA A = kargs(); unsigned char* ws = A->ws;
        pg8::Gemm g{(const bf16*)(ws + WS_XN), (const bf16*)(ws + WS_WIN), MUP, NIN, D}; pg8::StaticOrder S; S.init(MUP, NIN, G, wgid);
        pg8::EpiInProj E{(bf16*)(ws + WS_QA), (bf16*)(ws + WS_KV), (bf16*)(ws + WS_QKVB), (bf16*)(ws + WS_Z), (bf16*)(ws + WS_G),
                         (const float*)(ws + WS_ROPE), (const float*)(ws + WS_ROPE) + (TP + TS) * 32, A->out};
        pg8::gemm_phase<pg8::EpiInProj, pg8::StaticOrder, true, true>(lds, g, S, E);
    } SEAM(1);
#ifndef PROBE_MODE
#define PROBE_MODE 0
#endif
#if PROBE_REP == 2
    if (IN(2)) { KA A = kargs(); p23_mixers(A, lds, bar, 1u); GRID_BAR(); }
    if (IN(2)) { KA A = kargs(); p23_mixers(A, lds, bar, 2u, PROBE_MODE); } SEAM(2);
#else
    if (IN(2)) { KA A = kargs(); p23_mixers(A, lds, bar, 1u); } SEAM(2);
#endif
    if (IN(3)) for (int rep = 0; rep < NREP(3); ++rep) { KA A = kargs(); p3b_gated_norm(A); } SEAM(3);
    if (IN(4)) for (int rep = 0; rep < NREP(4); ++rep) { KA A = kargs(); unsigned char* ws = A->ws;
        const bf16* OABp = (const bf16*)((unsigned char*)A->out + DO_OA); const bf16* Wm = (const bf16*)(ws + WS_WOA);
        { pg8::Gemm g{OABp, Wm, MC, D, 512, 1024}; pg8::StaticOrder S; S.init(MC, D, G, wgid); S.lim = (S.nwg / G) * G;
          pg8::EpiMerge<false> E{(bf16*)(ws + WS_MB), (const bf16*)(ws + WS_G), 0};
          pg8::gemm_phase<pg8::EpiMerge<false>, pg8::StaticOrder, true, true>(lds, g, S, E); }
        asm volatile("s_waitcnt vmcnt(0)" ::: "memory"); __syncthreads();
        { pg8::Gemm g{OABp + 512, Wm + 512, MC, D, 512, 1024}; pg8::StaticOrder S; S.init(MC, D, G, wgid); S.lim = (S.nwg / G) * G;
          pg8::EpiMerge<true> E{(bf16*)(ws + WS_MB), (const bf16*)(ws + WS_G), 1024};
          pg8::gemm_phase<pg8::EpiMerge<true>, pg8::StaticOrder, true, true>(lds, g, S, E); }
        { const int nstr = (MC / 256) * 4 - ((MC / 256) * 4 / G) * G;
          if (wgid < nstr * 4) { const int t = wgid >> 2, sl = wgid & 3, koff = sl * 256;
            pg8::Gemm g{OABp + koff, Wm + koff, MC, D, 256, 1024};
            pg8::SliceOrder S; S.init_slice(MC, D, G, ((MC / 256) * 4 / G) * G, t);
            pg8::EpiSplit<pg8::EpiStoreMB, true> E{pg8::EpiStoreMB{(bf16*)(ws + WS_MB)}, (float*)(ws + WS_SCR) + (size_t)t * 65536, (unsigned*)(ws + WS_CTL + CTL_SPL) + t * 8, 4u, (const bf16*)(ws + WS_G), (sl >> 1) ? 1024 : 0};
            pg8::gemm_phase<pg8::EpiSplit<pg8::EpiStoreMB, true>, pg8::SliceOrder, true, true>(lds, g, S, E); } }
    } SEAM(4);
    if (IN(5)) { KA A = kargs(); unsigned char* ws = A->ws;
        { pg8::Gemm g{(const bf16*)(ws + WS_MB), (const bf16*)(ws + WS_WOUT), MC, D, D}; pg8::StaticOrder S; S.init(MC, D, G, wgid); S.lim = (S.nwg / G) * G;
          pg8::EpiWout<true> E{A->x_prompt, A->x_sample, (bf16*)(ws + WS_HB1), (float*)(ws + WS_CTL + CTL_SS1)};
          pg8::gemm_phase<pg8::EpiWout<true>, pg8::StaticOrder, true, true>(lds, g, S, E); }
        { const int nstr = (MC / 256) * 4 - ((MC / 256) * 4 / G) * G;
          if (wgid < nstr * 4) { const int t = wgid >> 2, koff = (wgid & 3) * 256;
            pg8::Gemm g{(const bf16*)(ws + WS_MB) + koff, (const bf16*)(ws + WS_WOUT) + koff, MC, D, 256, D};
            pg8::SliceOrder S; S.init_slice(MC, D, G, ((MC / 256) * 4 / G) * G, t);
            pg8::EpiSplit<pg8::EpiWout<true>, false> E{pg8::EpiWout<true>{A->x_prompt, A->x_sample, (bf16*)(ws + WS_HB1), (float*)(ws + WS_CTL + CTL_SS1)}, (float*)(ws + WS_SCR) + (size_t)t * 65536, (unsigned*)(ws + WS_CTL + CTL_SPL) + t * 8, 4u, nullptr, 0};
            pg8::gemm_phase<pg8::EpiSplit<pg8::EpiWout<true>, false>, pg8::SliceOrder, true, true>(lds, g, S, E); } }
    } SEAM(5);
    if (IN(6)) for (int rep = 0; rep < NREP(6); ++rep) { KA A = kargs(); unsigned char* ws = A->ws;
        pg8::Gemm g{(const bf16*)(ws + WS_HB1), (const bf16*)(ws + WS_WGU), MC, 2 * DFF, D}; pg8::StaticOrder S; S.init(MC, 2 * DFF, G, wgid);
        pg8::EpiGateUp E{(bf16*)(ws + WS_ACT), (const float*)(ws + WS_CTL + CTL_SS1)};
        pg8::gemm_phase<pg8::EpiGateUp, pg8::StaticOrder, true, true>(lds, g, S, E);
    } SEAM(6);
    if (IN(7)) for (int rep = 0; rep < NREP(7); ++rep) { KA A = kargs(); unsigned char* ws = A->ws;
        { pg8::Gemm g{(const bf16*)(ws + WS_ACT), (const bf16*)(ws + WS_WD), MC, D, DFF}; pg8::StaticOrder S; S.init(MC, D, G, wgid); S.lim = (S.nwg / G) * G;
          pg8::EpiDown<false> E{(const bf16*)(ws + WS_HB1), A->out};
          pg8::gemm_phase<pg8::EpiDown<false>, pg8::StaticOrder, true, true>(lds, g, S, E); }
        { const int nstr = (MC / 256) * 4 - ((MC / 256) * 4 / G) * G;
          if (wgid < nstr * 11) { const int t = wgid / 11, koff = (wgid % 11) * 256;
            pg8::Gemm g{(const bf16*)(ws + WS_ACT) + koff, (const bf16*)(ws + WS_WD) + koff, MC, D, 256, DFF};
            pg8::SliceOrder S; S.init_slice(MC, D, G, ((MC / 256) * 4 / G) * G, t);
            pg8::EpiSplit<pg8::EpiDown<false>, false> E{pg8::EpiDown<false>{(const bf16*)(ws + WS_HB1), A->out}, (float*)(ws + WS_SCR) + (size_t)t * 65536, (unsigned*)(ws + WS_CTL + CTL_SPL) + t * 8, 11u, nullptr, 0};
            pg8::gemm_phase<pg8::EpiSplit<pg8::EpiDown<false>, false>, pg8::SliceOrder, true, true>(lds, g, S, E); } }
    } SEAM(7);
    if (IN(8)) { KA A = kargs(); p8_final_norm(A); }
#undef IN
#undef SEAM
}

extern "C" void kernel_launch(void* const* d_in, const int* in_sizes, int n_in, void* d_out, int out_size, void* d_ws, size_t ws_size, hipStream_t stream) {
    static int grid = 0;
    if (grid == 0) {
        if (n_in != 22 || out_size != (int)O_END || ws_size < WS_END) { fprintf(stderr, "kernel_launch: unexpected problem (n_in %d, out %d, ws %zu)\n", n_in, out_size, ws_size); grid = -1; return; }
        int dev = 0, cus = 0, per_cu = 0;
        if (hipGetDevice(&dev) != hipSuccess || hipDeviceGetAttribute(&cus, hipDeviceAttributeMultiprocessorCount, dev) != hipSuccess) { grid = -1; return; }
        if (hipFuncSetAttribute((const void*)hybrid_fwd, hipFuncAttributeMaxDynamicSharedMemorySize, LDS_BYTES) != hipSuccess) { fprintf(stderr, "kernel_launch: hipFuncSetAttribute failed\n"); grid = -1; return; }
        if (hipOccupancyMaxActiveBlocksPerMultiprocessor(&per_cu, (const void*)hybrid_fwd, NTHREADS, LDS_BYTES) != hipSuccess || per_cu < 1) { fprintf(stderr, "kernel_launch: occupancy query says %d\n", per_cu); per_cu = 1; }
        (void)hipGetLastError();
        grid = cus;
        if (grid > 256) grid = 256;
    }
    if (grid < 0) return;
    (void)hipMemsetAsync((char*)d_ws + WS_CTL, 0, CTL_BYTES, stream);
    (void)hipMemsetAsync((char*)d_ws + WS_SCR, 0, SCR_BYTES, stream);
    Args a{};
    const float** ap = (const float**)&a;
    for (int i = 0; i < 22; ++i) ap[i] = (const float*)d_in[i];
    a.out = (float*)d_out; a.ws = (unsigned char*)d_ws;
#if MK_N_LAUNCHES == 1
    a.ph_lo = 0; a.ph_hi = N_PHASES;
#if MK_BARRIER == 1
    hipLaunchKernelGGL(hybrid_fwd, dim3(grid), dim3(NTHREADS), LDS_BYTES, stream, a);
#else
    void* args[] = {&a};
    hipError_t e = hipLaunchCooperativeKernel((const void*)hybrid_fwd, dim3(grid), dim3(NTHREADS), args, LDS_BYTES, stream);
    if (e != hipSuccess) fprintf(stderr, "cooperative launch failed: %s (grid %d)\n", hipGetErrorString(e), grid);
#endif
#else
    for (int p = 0; p < N_PHASES; ++p) { a.ph_lo = p; a.ph_hi = p + 1; hipLaunchKernelGGL(hybrid_fwd, dim3(grid), dim3(NTHREADS), LDS_BYTES, stream, a); }
#endif
}
```

```cpp
#include <hip/hip_runtime.h>
#include <hip/hip_cooperative_groups.h>
#include <cstdio>
#include <cstdint>
namespace cg = cooperative_groups;

#ifndef MK_N_LAUNCHES
#define MK_N_LAUNCHES 1
#endif
#ifndef MK_BARRIER
#define MK_BARRIER 1
#endif

constexpr int D = 1024, NBATCH = 8, SEQ = 4096, NMETA = 16, TP = SEQ + NMETA, MP = NBATCH * TP;
constexpr int SBATCH = 128, TS = 4, MS = SBATCH * TS, MU = MP + MS, MUP = 33536, MC = NBATCH * SEQ + MS;
constexpr int PAST = 16384;
constexpr int HD = 64, NHA = 8, NKV = 2;
constexpr int NHB = 4, CONVD = 1536;
constexpr int DFF = 2816, NIN_SRC = 4872, NIN = 4864;
constexpr float EPS = 1e-6f;
constexpr float QSCALE = 0.125f * 1.4426950408889634f;

constexpr size_t MiB = 1u << 20, KiB = 1024;
constexpr size_t WS_CTL = 0, CTL_BYTES = 1 * MiB;
constexpr size_t WS_WIN = 1 * MiB;
constexpr size_t WS_WOA = 11 * MiB, WS_WOB = 12 * MiB;
constexpr size_t WS_WOUT = 13 * MiB;
constexpr size_t WS_WGU = 15 * MiB;
constexpr size_t WS_WD = 26 * MiB;
constexpr size_t WS_ROPE = 32 * MiB;
constexpr size_t WS_GB = 34 * MiB;
constexpr size_t WS_SC = 36 * MiB;
constexpr size_t WS_SS1 = 37 * MiB, WS_SS2 = 37 * MiB + 512 * KiB;
constexpr size_t WS_SCR = 38 * MiB, SCR_BYTES = 2 * MiB;
constexpr size_t CTL_SPL = 49152;
constexpr size_t WS_QA = 41 * MiB;
constexpr size_t WS_KV = WS_QA + (size_t)MUP * 512 * 2;
constexpr size_t WS_QKVB = WS_KV + (size_t)MUP * 256 * 2;
constexpr size_t WS_Z = WS_QKVB + (size_t)MUP * 1536 * 2;
constexpr size_t WS_G = WS_Z + (size_t)MUP * 512 * 2;
constexpr size_t WS_GEND = WS_G + (size_t)MUP * 2048 * 2;
constexpr size_t WS_B = 353 * MiB, WS_END = 512 * MiB;
static_assert(WS_GEND <= WS_B, "ws map");
constexpr size_t WS_XN = WS_B;
constexpr size_t PREP_SLOT = 80 * KiB;
constexpr int PREP_N1 = (int)((WS_END - WS_B) / PREP_SLOT);
constexpr size_t DO_OA = 44 * MiB;
constexpr int OAB_PITCH = 1024;
constexpr size_t DO_OB = DO_OA + 512 * 2;
constexpr size_t DO_ATS = DO_OA + (size_t)MC * OAB_PITCH * 2;
constexpr size_t ATS_ITEM = 3 * 32 * 32 * 4;
static_assert(DO_ATS + 212 * 8 * ATS_ITEM <= (size_t)MC * 1024 * 4, "d_out scratch map");
constexpr size_t WS_MB = WS_B;
constexpr size_t WS_HB1 = WS_B + 66 * MiB;
static_assert(WS_HB1 + (size_t)MC * 1024 * 2 <= WS_END, "ws map");
constexpr size_t WS_ACT = WS_QA;
static_assert(WS_ACT + (size_t)MC * DFF * 2 <= WS_G, "ws map");
constexpr int SL_BEK = 0, SL_BV = 16 * 1024, SL_T = 32 * 1024, SL_QKD = 40 * 1024, SL_QE = 48 * 1024, SL_KWT = 64 * 1024;
constexpr int N_PROMPT_SEQ = NBATCH * NHB, CHUNKS_P = 65, N_ITEMS_P = N_PROMPT_SEQ * CHUNKS_P, N_ITEMS = N_ITEMS_P + SBATCH * NHB;
static_assert((size_t)(N_ITEMS - PREP_N1) * PREP_SLOT <= DO_OA, "prep slots");

constexpr size_t O_YP = 0, O_YS = (size_t)NBATCH * SEQ * D, O_KP = O_YS + (size_t)MS * D, O_VP = O_KP + 8 * 128 * 2 * 64, O_DP = O_VP + 8 * 128 * 2 * 64,
                 O_CP = O_DP + 8 * 4 * 128 * 128, O_KS = O_CP + 8 * 3 * 1536, O_VS = O_KS + (size_t)128 * 128 * 2 * 64, O_DS = O_VS + (size_t)128 * 128 * 2 * 64,
                 O_CS = O_DS + (size_t)128 * 4 * 128 * 128, O_END = O_CS + (size_t)128 * 3 * 1536;
static_assert(O_END == 48074752, "d_out size");

#define DI __device__ __forceinline__
#define GAS __attribute__((address_space(1)))
#define LAS __attribute__((address_space(3)))
typedef unsigned short bf16;
typedef short bf16x8 __attribute__((ext_vector_type(8)));
typedef float f32x4 __attribute__((ext_vector_type(4)));
typedef float f32x2 __attribute__((ext_vector_type(2)));
typedef float f32x16 __attribute__((ext_vector_type(16)));
typedef unsigned u32x4 __attribute__((ext_vector_type(4)));
typedef unsigned u32x2 __attribute__((ext_vector_type(2)));
typedef __bf16 bf16x2_t __attribute__((ext_vector_type(2)));

DI unsigned cvtpk(float lo, float hi) { f32x2 v = {lo, hi}; bf16x2_t b = __builtin_convertvector(v, bf16x2_t); return __builtin_bit_cast(unsigned, b); }
DI bf16 f2bf(float f) { return (bf16)(cvtpk(f, 0.f) & 0xffffu); }
DI float bf2f(unsigned short h) { return __uint_as_float((unsigned)h << 16); }
DI float bflo(unsigned w) { return __uint_as_float(w << 16); }
DI float bfhi(unsigned w) { return __uint_as_float(w & 0xffff0000u); }
DI u32x4 pack8f(f32x4 a, f32x4 b) { u32x4 w; w.x = cvtpk(a[0], a[1]); w.y = cvtpk(a[2], a[3]); w.z = cvtpk(b[0], b[1]); w.w = cvtpk(b[2], b[3]); return w; }
DI float frcp_(float x) { return __builtin_amdgcn_rcpf(x); }
DI float sigmoidf_(float x) { return frcp_(1.0f + __builtin_amdgcn_exp2f(x * -1.4426950408889634f)); }
DI float siluf_(float x) { return x * sigmoidf_(x); }
DI void st16_sc1(void* p, u32x4 v) { asm volatile("global_store_dwordx4 %0, %1, off sc1\n\ts_nop 1" :: "v"(p), "v"(v) : "memory"); }
DI void st16_sc1f(void* p, f32x4 v) { asm volatile("global_store_dwordx4 %0, %1, off sc1\n\ts_nop 1" :: "v"(p), "v"(v) : "memory"); }
DI void st2_sc1(void* p, unsigned v) { asm volatile("global_store_short %0, %1, off sc1\n\ts_nop 1" :: "v"(p), "v"(v) : "memory"); }
constexpr size_t CTL_GRAN = 65536, CTL_CNT = 245760, CTL_SS1 = 458752;
static_assert(CTL_CNT + 5 * 130 * 256 <= CTL_SS1 && CTL_SS1 + 33280 * 4 <= 1048576 && CTL_GRAN + 2592 * 64 <= CTL_CNT, "control region map");
constexpr int CNT_STRIDE = 130 * 64;
DI int pos_of_d(int d) { const int dd = d & 31; return 8 * (dd >> 2) + (dd & 3) + ((d >> 5) << 2); }
DI int d_of_pos(int p) { const int j = p & 7; return 4 * (p >> 3) + (j & 3) + ((j >> 2) << 5); }
namespace pg8 {
#define PG8_LAS __attribute__((address_space(3)))
typedef unsigned short bf16_t;
typedef short bf16x8 __attribute__((ext_vector_type(8)));
typedef float f32x4 __attribute__((ext_vector_type(4)));
typedef unsigned u32x4 __attribute__((ext_vector_type(4)));
constexpr int BM = 256, BK = 64, HALF = 128, HTB = HALF * BK * 2  , STAGE_BYTES = 8 * HTB, NXCD = 8, WGM = 8;

__host__ __device__ __forceinline__ int lds_byte(int r, int c) { const int st = (r >> 4) * 2 + (c >> 5), rr = r & 15, cc = c & 31, ob = rr * 64 + cc * 2; return st * 1024 + (ob ^ (((ob >> 9) & 1) << 5)); }
__host__ __device__ __forceinline__ void stage_rc(int b, int& R, int& C) { const int st = b / 1024, sb = b % 1024, swz = sb ^ (((sb >> 9) & 1) << 5); R = (st >> 1) * 16 + swz / 64; C = (st & 1) * 32 + (swz % 64) / 2; }
__host__ __device__ __forceinline__ int perm32(int rho) { const int n = rho >> 4, i = rho & 15; return 8 * (i >> 2) + 4 * n + (i & 3); }

struct Unit { int pm, pn; };
struct Gemm { const bf16_t* A; const bf16_t* Bt; int M, N, K; int ldk; };

struct StaticOrder {
    static constexpr bool A_SC1 = false;
    int nM, nN, nwg, G, c, lim;
    __host__ __device__ void init(int M, int N, int G_, int c_) { nM = M / BM; nN = N / BM; nwg = nM * nN; G = G_; c = c_; lim = nwg; }
    __host__ __device__ bool next(int i, Unit& u) const {
        const long L = (long)i * G + c; if (L >= lim) return false;
        int wgid = (int)L; { const int q = nwg / NXCD, r = nwg % NXCD, xcd = wgid % NXCD, off = wgid / NXCD; wgid = (xcd < r ? xcd * (q + 1) : r * (q + 1) + (xcd - r) * q) + off; }
        const int nig = WGM * nN, gid = wgid / nig, fm = gid * WGM, gsz = (nM - fm) < WGM ? (nM - fm) : WGM;
        u.pm = fm + ((wgid % nig) % gsz); u.pn = (wgid % nig) / gsz; return true;
    }
    __device__ __forceinline__ void a_ready(const Unit&) const {}
    __device__ __forceinline__ void done(const Unit&) const {}
};
struct FlagOrder : StaticOrder {
    static constexpr bool A_SC1 = true;
    const unsigned* ready; unsigned need; unsigned* pub; unsigned* gpub;
    __device__ __forceinline__ void a_ready(const Unit& u) const {
        if (ready) {
            if (threadIdx.x < 64) { unsigned spins = 0;
                while ((unsigned)__builtin_amdgcn_readfirstlane(__hip_atomic_load(ready + 64 * u.pm, __ATOMIC_RELAXED, __HIP_MEMORY_SCOPE_AGENT)) < need) { __builtin_amdgcn_s_sleep(2); if (++spins > (1u << 22)) break; } }
            asm volatile("" ::: "memory"); __builtin_amdgcn_s_barrier(); asm volatile("" ::: "memory");
        }
    }
    __device__ __forceinline__ void done(const Unit& u) const {
        if (pub) { asm volatile("s_waitcnt vmcnt(0)" ::: "memory");
            if ((threadIdx.x & 63) == 0) { __hip_atomic_fetch_add(pub + 64 * u.pm, 1u, __ATOMIC_RELAXED, __HIP_MEMORY_SCOPE_AGENT); if (gpub) __hip_atomic_fetch_add(gpub, 1u, __ATOMIC_RELAXED, __HIP_MEMORY_SCOPE_AGENT); } }
    }
};
struct SliceOrder : StaticOrder {
    int t;
    __host__ __device__ void init_slice(int M, int N, int G_, int first, int t_) { init(M, N, G_, 0); t = t_; c = first + t_; G = 0; }
    __host__ __device__ bool next(int i, Unit& u) const { return i == 0 ? StaticOrder::next(0, u) : false; }
};

__device__ __forceinline__ void urow_info(int urow, int& kind, int& b, int& t, int& ridx) {
    if (urow < MP) { b = urow / TP; t = urow - b * TP; kind = 0; ridx = t; }
    else if (urow < MU) { const int s = urow - MP; b = s >> 2; t = s & 3; kind = 1; ridx = TP + t; }
    else { kind = 2; b = 0; t = 0; ridx = 0; }
}
__device__ __forceinline__ int crow_to_urow(int crow) { return crow < NBATCH * SEQ ? crow + NMETA * ((crow >> 12) + 1) : MP + (crow - NBATCH * SEQ); }

struct EpiInProj {
    static constexpr bool PERM = true, AFTER_DRAIN = false;
    bf16_t *QA, *KV, *QKVB, *Z, *G; const float *COS, *SIN; float* out;
    __device__ __forceinline__ void operator()(const f32x4 (&acc)[2][2][4][2], const Unit& u, int wr, int wc, int fr, int fq) const {
        const int pn = u.pn;
#pragma unroll
        for (int ai = 0; ai < 2; ++ai)
#pragma unroll
            for (int m = 0; m < 4; ++m) {
                const int row = u.pm * BM + ai * HALF + wr * 64 + m * 16 + fr;
                int kind, b, t, ridx; urow_info(row, kind, b, t, ridx);
#pragma unroll
                for (int bj = 0; bj < 2; ++bj) {
                    const int cl = bj * HALF + wc * 32 + 8 * fq;
                    const f32x4 v0 = acc[ai][bj][m][0], v1 = acc[ai][bj][m][1];
                    if (pn < 2) {
                        const int c = pn * 256 + cl, d0 = ((c & 63) >> 3) * 4;
                        const f32x4 cs = *(const f32x4*)(COS + ridx * 32 + d0), sn = *(const f32x4*)(SIN + ridx * 32 + d0);
                        const f32x4 o1 = (v0 * cs - v1 * sn) * QSCALE, o2 = (v1 * cs + v0 * sn) * QSCALE;
                        *(u32x4*)(QA + (size_t)row * 512 + c) = pack8f(o1, o2);
                    } else if (pn == 2) {
                        if (bj == 0) {
                            const int kh = cl >> 6, d0 = ((cl & 63) >> 3) * 4;
                            const f32x4 cs = *(const f32x4*)(COS + ridx * 32 + d0), sn = *(const f32x4*)(SIN + ridx * 32 + d0);
                            const f32x4 o1 = v0 * cs - v1 * sn, o2 = v1 * cs + v0 * sn;
                            *(u32x4*)(KV + (size_t)row * 256 + cl) = pack8f(o1, o2);
                            float* dst = nullptr;
                            if (kind == 0 && t >= TP - 128) dst = out + O_KP + ((size_t)(b * 128 + (t - (TP - 128))) * 2 + kh) * 64;
                            else if (kind == 1) dst = out + O_KS + ((size_t)(b * 128 + 124 + t) * 2 + kh) * 64;
                            if (dst) { *(f32x4*)(dst + d0) = o1; *(f32x4*)(dst + 32 + d0) = o2; }
                        } else {
                            const int cv = cl - 128, kh = cv >> 6, dd = cv & 63;
                            *(u32x4*)(KV + (size_t)row * 256 + cl) = pack8f(v0, v1);
                            float* dst = nullptr;
                            if (kind == 0 && t >= TP - 128) dst = out + O_VP + ((size_t)(b * 128 + (t - (TP - 128))) * 2 + kh) * 64;
                            else if (kind == 1) dst = out + O_VS + ((size_t)(b * 128 + 124 + t) * 2 + kh) * 64;
                            if (dst) { *(f32x4*)(dst + dd) = v0; *(f32x4*)(dst + dd + 4) = v1; }
                        }
                    } else if (pn < 9) {
                        const int c = (pn - 3) * 256 + cl;
                        *(u32x4*)(QKVB + (size_t)row * 1536 + c) = pack8f(v0, v1);
                        float* dst = nullptr;
                        if (kind == 0 && t >= TP - 3) dst = out + O_CP + ((size_t)b * 3 + (t - (TP - 3))) * 1536;
                        else if (kind == 1 && t >= 1) dst = out + O_CS + ((size_t)b * 3 + (t - 1)) * 1536;
                        if (dst) { *(f32x4*)(dst + c) = v0; *(f32x4*)(dst + c + 4) = v1; }
                    } else if (pn < 11) {
                        const int c = (pn - 9) * 256 + cl;
                        *(u32x4*)(Z + (size_t)row * 512 + c) = pack8f(v0, v1);
                    } else {
                        const int c = (pn - 11) * 256 + cl;
                        f32x4 g0, g1;
#pragma unroll
                        for (int e = 0; e < 4; ++e) { g0[e] = sigmoidf_(v0[e]); g1[e] = sigmoidf_(v1[e]); }
                        *(u32x4*)(G + (size_t)row * 2048 + c) = pack8f(g0, g1);
                    }
                }
            }
    }
};

template <bool ACCUM> struct EpiMerge {
    static constexpr bool PERM = true, AFTER_DRAIN = false;
    bf16_t* MBp; const bf16_t* G; int gate_off;
    __device__ __forceinline__ void operator()(const f32x4 (&acc)[2][2][4][2], const Unit& u, int wr, int wc, int fr, int fq) const {
#pragma unroll
        for (int ai = 0; ai < 2; ++ai)
#pragma unroll
            for (int m = 0; m < 4; ++m) {
                const int crow = u.pm * BM + ai * HALF + wr * 64 + m * 16 + fr, urow = crow_to_urow(crow);
#pragma unroll
                for (int bj = 0; bj < 2; ++bj) {
                    const int c = u.pn * BM + bj * HALF + wc * 32 + 8 * fq;
                    const u32x4 gw = *(const u32x4*)(G + (size_t)urow * 2048 + gate_off + c);
                    f32x4 v0 = acc[ai][bj][m][0], v1 = acc[ai][bj][m][1];
                    v0[0] *= bflo(gw.x); v0[1] *= bfhi(gw.x); v0[2] *= bflo(gw.y); v0[3] *= bfhi(gw.y);
                    v1[0] *= bflo(gw.z); v1[1] *= bfhi(gw.z); v1[2] *= bflo(gw.w); v1[3] *= bfhi(gw.w);
                    bf16_t* p = MBp + (size_t)crow * 1024 + c;
                    if (ACCUM) { const u32x4 pw = *(const u32x4*)p;
                        v0[0] += bflo(pw.x); v0[1] += bfhi(pw.x); v0[2] += bflo(pw.y); v0[3] += bfhi(pw.y);
                        v1[0] += bflo(pw.z); v1[1] += bfhi(pw.z); v1[2] += bflo(pw.w); v1[3] += bfhi(pw.w); }
                    *(u32x4*)p = pack8f(v0, v1);
                }
            }
    }
};

template <bool ATOM = true> struct EpiWout {
    static constexpr bool PERM = true, AFTER_DRAIN = false;
    const float* xp; const float* xs; bf16_t* HB; float* SS;
    __device__ __forceinline__ void operator()(const f32x4 (&acc)[2][2][4][2], const Unit& u, int wr, int wc, int fr, int fq) const {
#pragma unroll
        for (int ai = 0; ai < 2; ++ai)
#pragma unroll
            for (int m = 0; m < 4; ++m) {
                const int crow = u.pm * BM + ai * HALF + wr * 64 + m * 16 + fr;
                const float* hs = crow < NBATCH * SEQ ? xp + (size_t)crow * D : xs + (size_t)(crow - NBATCH * SEQ) * D;
                float ss = 0.f;
#pragma unroll
                for (int bj = 0; bj < 2; ++bj) {
                    const int c = u.pn * BM + bj * HALF + wc * 32 + 8 * fq;
                    const f32x4 r0 = *(const f32x4*)(hs + c) + acc[ai][bj][m][0], r1 = *(const f32x4*)(hs + c + 4) + acc[ai][bj][m][1];
                    *(u32x4*)(HB + (size_t)crow * D + c) = pack8f(r0, r1);
                    ss += (r0[0] * r0[0] + r0[1] * r0[1]) + (r0[2] * r0[2] + r0[3] * r0[3]) + (r1[0] * r1[0] + r1[1] * r1[1]) + (r1[2] * r1[2] + r1[3] * r1[3]);
                }
                ss += __shfl_xor(ss, 16); ss += __shfl_xor(ss, 32);
                if (ATOM && fq == 0) atomicAdd(SS + crow, ss);
            }
    }
};

struct EpiGateUp {
    static constexpr bool PERM = true, AFTER_DRAIN = false;
    bf16_t* ACT; const float* SS;
    __device__ __forceinline__ void operator()(const f32x4 (&acc)[2][2][4][2], const Unit& u, int wr, int wc, int fr, int fq) const {
#pragma unroll
        for (int ai = 0; ai < 2; ++ai)
#pragma unroll
            for (int m = 0; m < 4; ++m) {
                const int crow = u.pm * BM + ai * HALF + wr * 64 + m * 16 + fr;
                const float rstd = rsqrtf(SS[crow] * (1.0f / D) + EPS);
                f32x4 a[2];
#pragma unroll
                for (int n = 0; n < 2; ++n)
#pragma unroll
                    for (int e = 0; e < 4; ++e) { const float g = acc[ai][0][m][n][e] * rstd, up = acc[ai][1][m][n][e] * rstd; a[n][e] = siluf_(g) * up; }
                *(u32x4*)(ACT + (size_t)crow * DFF + u.pn * HALF + wc * 32 + 8 * fq) = pack8f(a[0], a[1]);
            }
    }
};

template <bool DRY = false> struct EpiDown {
    static constexpr bool PERM = true, AFTER_DRAIN = false;
    const bf16_t* HB; float* H;
    __device__ __forceinline__ void operator()(const f32x4 (&acc)[2][2][4][2], const Unit& u, int wr, int wc, int fr, int fq) const {
#pragma unroll
        for (int ai = 0; ai < 2; ++ai)
#pragma unroll
            for (int m = 0; m < 4; ++m) {
                const int crow = u.pm * BM + ai * HALF + wr * 64 + m * 16 + fr;
#pragma unroll
                for (int bj = 0; bj < 2; ++bj) {
                    const size_t off = (size_t)crow * D + u.pn * BM + bj * HALF + wc * 32 + 8 * fq;
                    const u32x4 hw = *(const u32x4*)(HB + off);
                    f32x4 r0 = acc[ai][bj][m][0], r1 = acc[ai][bj][m][1];
                    r0[0] += bflo(hw.x); r0[1] += bfhi(hw.x); r0[2] += bflo(hw.y); r0[3] += bfhi(hw.y);
                    r1[0] += bflo(hw.z); r1[1] += bfhi(hw.z); r1[2] += bflo(hw.w); r1[3] += bfhi(hw.w);
                    *(f32x4*)(H + off) = r0; *(f32x4*)(H + off + 4) = r1;
                }
            }
    }
};

template <class Inner, bool GATED = false> struct EpiSplit {
    static constexpr bool PERM = Inner::PERM, AFTER_DRAIN = false;
    Inner inner; float* scr; unsigned* cnt; unsigned S; const bf16_t* G; int gate_off;
    __device__ __forceinline__ void operator()(const f32x4 (&acc_)[2][2][4][2], const Unit& u, int wr, int wc, int fr, int fq) const {
        f32x4 (&acc)[2][2][4][2] = const_cast<f32x4 (&)[2][2][4][2]>(acc_);
        const int lane = fr + 16 * fq, wave = wr * 4 + wc;
        float* p = scr + (size_t)wave * 8192 + lane;
#pragma unroll
        for (int ai = 0; ai < 2; ++ai)
#pragma unroll
            for (int m = 0; m < 4; ++m) {
                int urow = 0;
                if (GATED) urow = crow_to_urow(u.pm * BM + ai * HALF + wr * 64 + m * 16 + fr);
#pragma unroll
                for (int bj = 0; bj < 2; ++bj) {
                    f32x4 v0 = acc[ai][bj][m][0], v1 = acc[ai][bj][m][1];
                    if (GATED) { const u32x4 gw = *(const u32x4*)(G + (size_t)urow * 2048 + gate_off + u.pn * BM + bj * HALF + wc * 32 + 8 * fq);
                        v0[0] *= bflo(gw.x); v0[1] *= bfhi(gw.x); v0[2] *= bflo(gw.y); v0[3] *= bfhi(gw.y); v1[0] *= bflo(gw.z); v1[1] *= bfhi(gw.z); v1[2] *= bflo(gw.w); v1[3] *= bfhi(gw.w); }
                    float* q = p + (((ai * 2 + bj) * 4 + m) * 8) * 64;
                    asm volatile("" : "+v"(q));
#pragma unroll
                    for (int x = 0; x < 4; ++x) { unsafeAtomicAdd(q + x * 64, v0[x]); unsafeAtomicAdd(q + (4 + x) * 64, v1[x]); }
                }
            }
        asm volatile("s_waitcnt vmcnt(0)" ::: "memory");
        unsigned old = 0u;
        if (lane == 0) old = __hip_atomic_fetch_add(cnt + wave, 1u, __ATOMIC_RELAXED, __HIP_MEMORY_SCOPE_AGENT);
        old = (unsigned)__builtin_amdgcn_readfirstlane((int)old);
        if (old == S - 1u) {
#pragma unroll
            for (int ai = 0; ai < 2; ++ai)
#pragma unroll
                for (int bj = 0; bj < 2; ++bj)
#pragma unroll
                    for (int m = 0; m < 4; ++m) {
                        float* q = p + (((ai * 2 + bj) * 4 + m) * 8) * 64;
                        asm volatile("" : "+v"(q));
#pragma unroll
                        for (int n = 0; n < 2; ++n)
#pragma unroll
                            for (int x = 0; x < 4; ++x) acc[ai][bj][m][n][x] = __hip_atomic_exchange(q + (n * 4 + x) * 64, 0.0f, __ATOMIC_RELAXED, __HIP_MEMORY_SCOPE_AGENT);
                    }
            if (lane == 0) __hip_atomic_store(cnt + wave, 0u, __ATOMIC_RELAXED, __HIP_MEMORY_SCOPE_AGENT);
            inner(acc, u, wr, wc, fr, fq);
        }
    }
};
struct EpiStoreMB {
    static constexpr bool PERM = true, AFTER_DRAIN = false;
    bf16_t* MBp;
    __device__ __forceinline__ void operator()(const f32x4 (&acc)[2][2][4][2], const Unit& u, int wr, int wc, int fr, int fq) const {
#pragma unroll
        for (int ai = 0; ai < 2; ++ai)
#pragma unroll
            for (int m = 0; m < 4; ++m) {
                const int crow = u.pm * BM + ai * HALF + wr * 64 + m * 16 + fr;
#pragma unroll
                for (int bj = 0; bj < 2; ++bj) *(u32x4*)(MBp + (size_t)crow * 1024 + u.pn * BM + bj * HALF + wc * 32 + 8 * fq) = pack8f(acc[ai][bj][m][0], acc[ai][bj][m][1]);
            }
    }
};

template <class Epi, class Sched, bool ALIGN_EPI = false, bool SP2 = false>
__device__ __forceinline__ void gemm_phase(PG8_LAS unsigned char* lds, const Gemm g, const Sched& S, const Epi& E) {
    const int tid = threadIdx.x, wid = __builtin_amdgcn_readfirstlane(tid >> 6), lane = tid & 63, wr = wid >> 2, wc = wid & 3, fr = lane & 15, fq = lane >> 4;
    const int K = g.ldk ? g.ldk : g.K, nt = g.K / BK;
    unsigned voffA[2], voffB[2];
#pragma unroll
    for (int i = 0; i < 2; ++i) { int R, C; stage_rc(tid * 16 + i * 8192, R, C); const int Rb = Epi::PERM ? ((R & ~31) + perm32(R & 31)) : R;
        voffA[i] = (unsigned)(R * K + C) * 2u; voffB[i] = (unsigned)(Rb * K + C) * 2u; }
    const size_t kstep = (size_t)(BK * 2);
    const size_t hstep = (size_t)HALF * K * 2;
    const size_t tstep = 2 * hstep;
    const unsigned ldsw = (unsigned)wid * 1024u;
    const int aoff = lds_byte(wr * 64 + fr, fq * 8), boff = lds_byte(wc * 32 + fr, fq * 8);
#define PG8_SA(b, h) (((b) * 2 + (h)) * HTB)
#define PG8_SB(b, h) ((4 + (b) * 2 + (h)) * HTB)
#define PG8_STAGE(bufoff, gbase, voff) do { _Pragma("unroll") for (int _i = 0; _i < 2; ++_i) \
        __builtin_amdgcn_global_load_lds((const unsigned*)((const char*)(gbase) + (voff)[_i]), (PG8_LAS unsigned*)(lds + (bufoff) + ldsw + _i * 8192), 16, 0, 0); } while (0)
#define PG8_STAGE_A(bufoff, gbase, voff) do { _Pragma("unroll") for (int _i = 0; _i < 2; ++_i) { \
        if constexpr (Sched::A_SC1) __builtin_amdgcn_global_load_lds((const unsigned*)((const char*)(gbase) + (voff)[_i]), (PG8_LAS unsigned*)(lds + (bufoff) + ldsw + _i * 8192), 16, 0, 16); \
        else __builtin_amdgcn_global_load_lds((const unsigned*)((const char*)(gbase) + (voff)[_i]), (PG8_LAS unsigned*)(lds + (bufoff) + ldsw + _i * 8192), 16, 0, 0); } } while (0)
#define PG8_LDA(dst, b, h) do { _Pragma("unroll") for (int m = 0; m < 4; ++m) _Pragma("unroll") for (int k = 0; k < 2; ++k) dst[m][k] = *(const PG8_LAS bf16x8*)(lds + PG8_SA(b, h) + aoff + m * 2048 + k * 1024); } while (0)
#define PG8_LDB(dst, b, h) do { _Pragma("unroll") for (int n = 0; n < 2; ++n) _Pragma("unroll") for (int k = 0; k < 2; ++k) dst[n][k] = *(const PG8_LAS bf16x8*)(lds + PG8_SB(b, h) + boff + n * 2048 + k * 1024); } while (0)
#define PG8_MMA(ai, bj, At, Bt) do { __builtin_amdgcn_s_setprio(1); _Pragma("unroll") for (int m = 0; m < 4; ++m) _Pragma("unroll") for (int n = 0; n < 2; ++n) _Pragma("unroll") for (int k = 0; k < 2; ++k) \
        acc[ai][bj][m][n] = __builtin_amdgcn_mfma_f32_16x16x32_bf16(Bt[n][k], At[m][k], acc[ai][bj][m][n], 0, 0, 0); __builtin_amdgcn_s_setprio(0); } while (0)
#define PG8_WAIT_V(n) asm volatile("s_waitcnt vmcnt(" #n ")" ::: "memory")
#define PG8_WAIT_L(n) asm volatile("s_waitcnt lgkmcnt(" #n ")" ::: "memory")
#define PG8_BAR __builtin_amdgcn_s_barrier()
#define PG8_SCHED __builtin_amdgcn_sched_barrier(0)
    Unit cur, nxt; int ui = 0;
    if (!S.next(0, cur)) return;
    f32x4 acc[2][2][4][2];
#pragma unroll
    for (int a = 0; a < 2; ++a)
#pragma unroll
        for (int b = 0; b < 2; ++b)
#pragma unroll
            for (int m = 0; m < 4; ++m)
#pragma unroll
                for (int n = 0; n < 2; ++n) acc[a][b][m][n] = (f32x4){0.f, 0.f, 0.f, 0.f};
    bf16x8 At[4][2], B0[2][2], B1[2][2];
    const char* cA = (const char*)g.A + (size_t)cur.pm * tstep; const char* cB = (const char*)g.Bt + (size_t)cur.pn * tstep;
    S.a_ready(cur);
    if constexpr (SP2) {
        PG8_STAGE(PG8_SB(0, 0), cB, voffB); PG8_STAGE(PG8_SB(0, 1), cB + hstep, voffB); PG8_STAGE_A(PG8_SA(0, 0), cA, voffA); PG8_STAGE_A(PG8_SA(0, 1), cA + hstep, voffA);
        if (wr == 1) PG8_BAR;
        PG8_WAIT_V(2); PG8_BAR;
        PG8_STAGE(PG8_SB(1, 0), cB + kstep, voffB); PG8_STAGE_A(PG8_SA(1, 0), cA + kstep, voffA); PG8_STAGE(PG8_SB(1, 1), cB + hstep + kstep, voffB);
        PG8_WAIT_V(6); PG8_BAR;
    } else {
        PG8_STAGE(PG8_SB(0, 0), cB, voffB); PG8_STAGE_A(PG8_SA(0, 0), cA, voffA); PG8_STAGE(PG8_SB(0, 1), cB + hstep, voffB); PG8_STAGE_A(PG8_SA(0, 1), cA + hstep, voffA);
        if (wr == 1) PG8_BAR;
        PG8_WAIT_V(4); PG8_BAR;
        PG8_STAGE(PG8_SB(1, 0), cB + kstep, voffB); PG8_STAGE_A(PG8_SA(1, 0), cA + kstep, voffA); PG8_STAGE(PG8_SB(1, 1), cB + hstep + kstep, voffB);
        PG8_WAIT_V(6); PG8_BAR;
    }
    for (;;) {
        const bool has_next = S.next(ui + 1, nxt);
        const char* nA = has_next ? (const char*)g.A + (size_t)nxt.pm * tstep : cA; const char* nB = has_next ? (const char*)g.Bt + (size_t)nxt.pn * tstep : cB;
        for (int t = 0; t < nt; t += 2) {
            const bool last = (t == nt - 2);
            const char* a1 = cA + (size_t)(t + 1) * kstep;
            const char* a2 = last ? nA : cA + (size_t)(t + 2) * kstep; const char* b2 = last ? nB : cB + (size_t)(t + 2) * kstep;
            const char* a3 = a2 + kstep; const char* b3 = b2 + kstep;
            if (last && has_next) S.a_ready(nxt);
            if constexpr (SP2) {
            PG8_LDB(B0, 0, 0); PG8_LDB(B1, 0, 1); PG8_SCHED; PG8_LDA(At, 0, 0); PG8_STAGE_A(PG8_SA(1, 1), a1 + hstep, voffA);
            PG8_WAIT_V(8); PG8_WAIT_L(0); PG8_BAR; PG8_MMA(0, 0, At, B0); PG8_MMA(0, 1, At, B1); PG8_BAR; PG8_SCHED;
            PG8_LDA(At, 0, 1); PG8_STAGE(PG8_SB(0, 0), b2, voffB); PG8_STAGE(PG8_SB(0, 1), b2 + hstep, voffB); PG8_STAGE_A(PG8_SA(0, 0), a2, voffA);
            PG8_WAIT_V(8); PG8_WAIT_L(0); PG8_BAR; PG8_MMA(1, 0, At, B0); PG8_MMA(1, 1, At, B1); PG8_BAR; PG8_SCHED;
            PG8_LDB(B0, 1, 0); PG8_LDB(B1, 1, 1); PG8_SCHED; PG8_LDA(At, 1, 0); PG8_STAGE_A(PG8_SA(0, 1), a2 + hstep, voffA);
            PG8_WAIT_V(8); PG8_WAIT_L(0); PG8_BAR; PG8_MMA(0, 0, At, B0); PG8_MMA(0, 1, At, B1); PG8_BAR; PG8_SCHED;
            PG8_LDA(At, 1, 1); PG8_STAGE(PG8_SB(1, 0), b3, voffB); PG8_STAGE(PG8_SB(1, 1), b3 + hstep, voffB); PG8_STAGE_A(PG8_SA(1, 0), a3, voffA);
            PG8_WAIT_V(8); PG8_WAIT_L(0); PG8_BAR; PG8_MMA(1, 0, At, B0); PG8_MMA(1, 1, At, B1); PG8_BAR; PG8_SCHED;
            } else {
            PG8_LDB(B0, 0, 0); PG8_SCHED; PG8_LDA(At, 0, 0); PG8_STAGE_A(PG8_SA(1, 1), a1 + hstep, voffA);
            PG8_WAIT_L(8); PG8_BAR; PG8_WAIT_L(0); PG8_MMA(0, 0, At, B0); PG8_BAR; PG8_SCHED;
            PG8_LDB(B1, 0, 1); PG8_STAGE(PG8_SB(0, 0), b2, voffB);
            PG8_BAR; PG8_WAIT_L(0); PG8_MMA(0, 1, At, B1); PG8_BAR;
            PG8_LDA(At, 0, 1); PG8_STAGE_A(PG8_SA(0, 0), a2, voffA);
            PG8_BAR; PG8_WAIT_L(0); PG8_MMA(1, 0, At, B0); PG8_BAR; PG8_SCHED;
            PG8_STAGE(PG8_SB(0, 1), b2 + hstep, voffB);
            PG8_WAIT_V(6); PG8_BAR; PG8_MMA(1, 1, At, B1); PG8_BAR;
            PG8_LDB(B0, 1, 0); PG8_SCHED; PG8_LDA(At, 1, 0); PG8_STAGE_A(PG8_SA(0, 1), a2 + hstep, voffA);
            PG8_WAIT_L(8); PG8_BAR; PG8_WAIT_L(0); PG8_MMA(0, 0, At, B0); PG8_BAR; PG8_SCHED;
            PG8_LDB(B1, 1, 1); PG8_STAGE(PG8_SB(1, 0), b3, voffB);
            PG8_BAR; PG8_WAIT_L(0); PG8_MMA(0, 1, At, B1); PG8_BAR;
            PG8_LDA(At, 1, 1); PG8_STAGE_A(PG8_SA(1, 0), a3, voffA);
            PG8_BAR; PG8_WAIT_L(0); PG8_MMA(1, 0, At, B0); PG8_BAR; PG8_SCHED;
            PG8_STAGE(PG8_SB(1, 1), b3 + hstep, voffB);
            PG8_WAIT_V(6); PG8_BAR; PG8_MMA(1, 1, At, B1); PG8_BAR;
            }
        }
        if constexpr (ALIGN_EPI) { if (wr == 0) PG8_BAR; }
        if constexpr (!Epi::AFTER_DRAIN) { E(acc, cur, wr, wc, fr, fq); S.done(cur); }
        if (!has_next) break;
#pragma unroll
        for (int a = 0; a < 2; ++a)
#pragma unroll
            for (int b = 0; b < 2; ++b)
#pragma unroll
                for (int m = 0; m < 4; ++m)
#pragma unroll
                    for (int n = 0; n < 2; ++n) acc[a][b][m][n] = (f32x4){0.f, 0.f, 0.f, 0.f};
        cur = nxt; cA = nA; cB = nB; ++ui;
        if constexpr (ALIGN_EPI) { if (wr == 1) PG8_BAR; }
    }
    PG8_WAIT_V(0);
    if constexpr (!ALIGN_EPI) { if (wr == 0) PG8_BAR; }
    PG8_BAR;
    if constexpr (Epi::AFTER_DRAIN) { E.fused(acc, cur, wr, wc, fr, fq, lds, wid, lane); S.done(cur); }
#undef PG8_SA
#undef PG8_SB
#undef PG8_STAGE
#undef PG8_STAGE_A
#undef PG8_LDA
#undef PG8_LDB
#undef PG8_MMA
#undef PG8_WAIT_V
#undef PG8_WAIT_L
#undef PG8_BAR
#undef PG8_SCHED
}
}
constexpr int NWAVES = 8, NTHREADS = NWAVES * 64;
constexpr int LDS_BYTES = 147456;
constexpr int LDS_MISC = 131072;
constexpr int N_PHASES = 9;

struct Args {
    const float *x_prompt, *x_sample, *cache_k, *cache_v, *state_delta, *state_conv, *meta, *norm_mix, *w_in, *conv_w, *a_log, *dt_bias, *sinks, *gdn_norm,
                *w_oa, *w_ob, *w_out, *norm_ffn, *w_gate, *w_up, *w_down, *norm_final;
    float* out; unsigned char* ws; int ph_lo, ph_hi;
};

typedef const __attribute__((address_space(4))) Args* KA;
DI KA kargs() { KA p = (KA)__builtin_amdgcn_kernarg_segment_ptr(); asm volatile("" : "+s"(p)); return p; }
#define RLX_AGENT __ATOMIC_RELAXED, __HIP_MEMORY_SCOPE_AGENT
#define LDS_WAIT() asm volatile("s_waitcnt lgkmcnt(0)" ::: "memory")
#define MFMA32(a, b, c) __builtin_amdgcn_mfma_f32_32x32x16_bf16((a), (b), (c), 0, 0, 0)
DI int crow16(int reg, int h) { return (reg & 3) + 8 * (reg >> 2) + 4 * h; }
DI float wave_sum(float v) {
#pragma unroll
    for (int o = 1; o < 64; o <<= 1) v += __shfl_xor(v, o);
    return v;
}
DI float wave_max(float v) {
#pragma unroll
    for (int o = 1; o < 64; o <<= 1) v = fmaxf(v, __shfl_xor(v, o));
    return v;
}
template <int S> DI bf16x8 pack_step(const f32x16& x) {
    u32x4 p; p.x = cvtpk(x[8 * S], x[8 * S + 1]); p.y = cvtpk(x[8 * S + 2], x[8 * S + 3]); p.z = cvtpk(x[8 * S + 4], x[8 * S + 5]); p.w = cvtpk(x[8 * S + 6], x[8 * S + 7]);
    return __builtin_bit_cast(bf16x8, p);
}
DI int frag_idx(int row, int k, int NKS) { const int kkk = k & 15; return (((row >> 5) * NKS + (k >> 4)) * 64 + (row & 31) + 32 * ((kkk >> 2) & 1)) * 8 + (((kkk >> 3) << 2) | (kkk & 3)); }
DI unsigned char* slot_ptr(KA A, int item) { return item < PREP_N1 ? A->ws + WS_B + (size_t)item * PREP_SLOT : (unsigned char*)A->out + (size_t)(item - PREP_N1) * PREP_SLOT; }

#define XB_TMO      128
#define XB_XCNT(j)  (256  + 64 * (j))
#define XB_XSUB(j)  (1280 + 64 * (j))
#define XB_XGEN(j)  (2304 + 64 * (j))
#define XB_TOP      3328
#define XB_TOPGEN   3392
#define XCD_BAR_WORDS 3456
#define XB_SPIN_CAP (1u << 20)
DI unsigned xb_ld(unsigned* p)              { return __hip_atomic_load(p, __ATOMIC_RELAXED, __HIP_MEMORY_SCOPE_AGENT); }
DI unsigned xb_add(unsigned* p, unsigned v) { return __hip_atomic_fetch_add(p, v, __ATOMIC_RELAXED, __HIP_MEMORY_SCOPE_AGENT); }
DI unsigned xb_xcc_id() { return (unsigned)__builtin_amdgcn_s_getreg((3 << 11) | 20) & 0xFu; }
#define XB_SPIN(cond, bar) do { unsigned _sp = 0; while (cond) { __builtin_amdgcn_s_sleep(1); \
    if ((++_sp & 255u) == 0u) { if (xb_ld(&(bar)[XB_TMO])) break; if (_sp > XB_SPIN_CAP) { atomicAdd(&(bar)[XB_TMO], 1u); break; } } } } while (0)
struct XcdBarrier { unsigned* bar; unsigned x; volatile LAS unsigned* st; };
DI XcdBarrier xcd_barrier_post(unsigned* bar, volatile LAS unsigned* st) {
    XcdBarrier b; b.bar = bar; b.x = xb_xcc_id(); b.st = st;
    if (threadIdx.x == 0) (void)xb_add(&bar[XB_XCNT(b.x)], 1u);
    return b;
}
DI void xcd_barrier_complete(unsigned* bar, unsigned x, unsigned& nloc, unsigned& nx) {
    const unsigned G = gridDim.x * gridDim.y * gridDim.z;
    unsigned sum, cnt, mine, sp = 0u;
    for (;;) {
        sum = 0u; cnt = 0u; mine = 0u;
#pragma unroll
        for (unsigned j = 0; j < 16; ++j) { const unsigned c = xb_ld(&bar[XB_XCNT(j)]); sum += c; cnt += (c > 0u) ? 1u : 0u; mine = (j == x) ? c : mine; }
        if (sum == G) break;
        __builtin_amdgcn_s_sleep(1);
        if ((++sp & 255u) == 0u) { if (xb_ld(&bar[XB_TMO])) break; if (sp > XB_SPIN_CAP) { atomicAdd(&bar[XB_TMO], 1u); break; } }
    }
    nloc = mine > 0u ? mine : 1u; nx = cnt > 0u ? cnt : 1u;
}
DI void xcd_barrier(const XcdBarrier& b) {
    asm volatile("s_waitcnt vmcnt(0)" ::: "memory");
    __syncthreads();
    if (threadIdx.x == 0) {
        unsigned* bar = b.bar;
        __builtin_amdgcn_s_waitcnt(0);
        unsigned nloc = b.st[0], nx = b.st[1];
        if (nloc == 0u) { xcd_barrier_complete(bar, b.x, nloc, nx); b.st[0] = nloc; b.st[1] = nx; }
        const unsigned old = xb_add(&bar[XB_XSUB(b.x)], 1u);
        const unsigned gen = old / nloc;
        if (old + 1u == (gen + 1u) * nloc) {
            __builtin_amdgcn_fence(__ATOMIC_RELEASE, "agent");
            asm volatile("s_waitcnt vmcnt(0)" ::: "memory");
            const unsigned og = xb_add(&bar[XB_TOP], 1u);
            const unsigned tg = og / nx;
            if (og + 1u == (tg + 1u) * nx) xb_add(&bar[XB_TOPGEN], 1u);
            else XB_SPIN(xb_ld(&bar[XB_TOPGEN]) == tg, bar);
            __builtin_amdgcn_fence(__ATOMIC_ACQUIRE, "agent");
            xb_add(&bar[XB_XGEN(b.x)], 1u);
            asm volatile("s_waitcnt vmcnt(0)" ::: "memory");
        } else {
            XB_SPIN(xb_ld(&bar[XB_XGEN(b.x)]) == gen, bar);
            __builtin_amdgcn_fence(__ATOMIC_ACQUIRE, "agent");
            asm volatile("s_waitcnt vmcnt(0)" ::: "memory");
        }
    }
    __syncthreads();
}

template <class RowMap> DI void transpose_item(const float* W, int K, int N, bf16* WT, RowMap rm, const float* kscale, LAS float* scr, int item, int lane, int ldw = 0) {
    if (ldw == 0) ldw = K;
    const int nblk = (N + 31) / 32, kb = item / nblk, nb = item - kb * nblk, k0 = 64 * kb, n0 = 32 * nb;
    const int n4 = n0 + (lane & 7) * 4;
    f32x4 v[8];
#pragma unroll
    for (int i = 0; i < 8; ++i) { const int kk = 8 * i + (lane >> 3);
        v[i] = n4 < N ? *(const f32x4*)(W + (size_t)(k0 + kk) * N + n4) : (f32x4){0.f, 0.f, 0.f, 0.f}; }
#pragma unroll
    for (int i = 0; i < 8; ++i) { const int kk = 8 * i + (lane >> 3);
        if (kscale) v[i] = v[i] * kscale[k0 + kk];
        LAS float* d = scr + kk * 33 + (lane & 7) * 4; d[0] = v[i][0]; d[1] = v[i][1]; d[2] = v[i][2]; d[3] = v[i][3]; }
    LDS_WAIT(); asm volatile("" ::: "memory");
    const int c = lane & 7;
#pragma unroll
    for (int j = 0; j < 4; ++j) { const int n = (lane >> 3) + 8 * j; const LAS float* s = scr + (8 * c) * 33 + n;
        const int nsrc = n0 + n; const int drow = nsrc < N ? rm(nsrc) : -1;
        u32x4 o; o.x = cvtpk(s[0 * 33], s[1 * 33]); o.y = cvtpk(s[2 * 33], s[3 * 33]); o.z = cvtpk(s[4 * 33], s[5 * 33]); o.w = cvtpk(s[6 * 33], s[7 * 33]);
        if (drow >= 0) *(u32x4*)(WT + (size_t)drow * ldw + k0 + 8 * c) = o; }
    LDS_WAIT(); asm volatile("" ::: "memory");
}
DI float softplusf_(float x) { return x > 20.f ? x : log1pf(__expf(x)); }

#ifndef PROBE_REP
#define PROBE_REP -1
#endif
DI void p0_prologue(KA A, LAS unsigned char* lds) {
    const int tid = threadIdx.x, lane = tid & 63, wave = __builtin_amdgcn_readfirstlane(tid >> 6);
    const int G = gridDim.x, gw = blockIdx.x * NWAVES + wave, NGW = G * NWAVES;
    const int gt = blockIdx.x * NTHREADS + tid, NGT = G * NTHREADS;
    unsigned char* ws = A->ws;
    for (int rep = 0; rep < (PROBE_REP == 1001 ? 2 : 1); ++rep) {
        LAS float* scr = (LAS float*)(lds + wave * 16384);
        constexpr int I_IN = 16 * 153, I_OA = 8 * 32, I_OUT = 16 * 32, I_G = 16 * 88, I_D = 44 * 32;
        constexpr int NIT = I_IN + 2 * I_OA + I_OUT + 2 * I_G + I_D;
        for (int it = gw; it < NIT; it += NGW) {
            int r = it;
            if (r < I_IN) { transpose_item(A->w_in, 1024, NIN_SRC, (bf16*)(ws + WS_WIN), [](int c) -> int {
                    if (c < 640) return (c & ~63) + pos_of_d(c & 63);
                    if (c < 2816) return c;
                    if (c < 2824) return -1;
                    return c - 8; }, nullptr, scr, r, lane); continue; } r -= I_IN;
            if (r < I_OA) { transpose_item(A->w_oa, 512, 1024, (bf16*)(ws + WS_WOA), [](int c) -> int { return c; }, nullptr, scr, r, lane, 1024); continue; } r -= I_OA;
            if (r < I_OA) { transpose_item(A->w_ob, 512, 1024, (bf16*)(ws + WS_WOA) + 512, [](int c) -> int { return c; }, nullptr, scr, r, lane, 1024); continue; } r -= I_OA;
            if (r < I_OUT) { transpose_item(A->w_out, 1024, 1024, (bf16*)(ws + WS_WOUT), [](int c) -> int { return c; }, nullptr, scr, r, lane); continue; } r -= I_OUT;
            if (r < I_G) { transpose_item(A->w_gate, 1024, DFF, (bf16*)(ws + WS_WGU), [](int c) -> int { return 256 * (c >> 7) + (c & 127); }, A->norm_ffn, scr, r, lane); continue; } r -= I_G;
            if (r < I_G) { transpose_item(A->w_up, 1024, DFF, (bf16*)(ws + WS_WGU), [](int c) -> int { return 256 * (c >> 7) + 128 + (c & 127); }, A->norm_ffn, scr, r, lane); continue; } r -= I_G;
            transpose_item(A->w_down, DFF, 1024, (bf16*)(ws + WS_WD), [](int c) -> int { return c; }, nullptr, scr, r, lane);
        }
    }
    for (int rep = 0; rep < (PROBE_REP == 1002 ? 2 : 1); ++rep) {
        float* COS = (float*)(ws + WS_ROPE); float* SIN = COS + (TP + TS) * 32;
        for (int i = gt; i < (TP + TS) * 32; i += NGT) { const int ri = i >> 5, f = i & 31; const double pos = ri < TP ? (double)ri : (double)(PAST + ri - TP);
            const double inv = exp2(-(double)f * (13.287712379549449 / 32.0)), ang = pos * inv; COS[i] = (float)cos(ang); SIN[i] = (float)sin(ang); }
        constexpr int PERB = 124 * 128 / 4;
        for (int i = gt; i < SBATCH * PERB; i += NGT) { const int b = i / PERB, o = i - b * PERB;
            ((f32x4*)(A->out + O_KS))[(size_t)b * 4096 + o] = ((const f32x4*)A->cache_k)[(size_t)b * 4096 + 128 + o];
            ((f32x4*)(A->out + O_VS))[(size_t)b * 4096 + o] = ((const f32x4*)A->cache_v)[(size_t)b * 4096 + 128 + o]; }
    }
    for (int rep = 0; rep < (PROBE_REP == 1003 ? 2 : 1); ++rep) {
        unsigned wab[16][4];
        f32x4 nm[4];
#pragma unroll
        for (int j = 0; j < 4; ++j) {
            nm[j] = ((const f32x4*)A->norm_mix)[lane + 64 * j];
#pragma unroll
            for (int e = 0; e < 4; ++e) { const float* p = A->w_in + (size_t)(4 * (lane + 64 * j) + e) * NIN_SRC + 2816;
                const f32x4 a = *(const f32x4*)p, b = *(const f32x4*)(p + 4);
                wab[j * 4 + e][0] = cvtpk(a[0], a[1]); wab[j * 4 + e][1] = cvtpk(a[2], a[3]); wab[j * 4 + e][2] = cvtpk(b[0], b[1]); wab[j * 4 + e][3] = cvtpk(b[2], b[3]); }
        }
        bf16* XN = (bf16*)(ws + WS_XN); f32x2* GB = (f32x2*)(ws + WS_GB);
        auto row_src = [&](int urow) -> const float* {
            if (urow < MP) { const int b = urow / TP, t = urow - b * TP; return t < NMETA ? A->meta + (size_t)t * D : A->x_prompt + ((size_t)b * SEQ + (t - NMETA)) * D; }
            if (urow < MU) return A->x_sample + (size_t)(urow - MP) * D;
            return nullptr; };
        f32x4 nx[4];
        { const float* s0 = gw < MUP ? row_src(gw) : nullptr;
#pragma unroll
          for (int j = 0; j < 4; ++j) nx[j] = s0 ? ((const f32x4*)s0)[lane + 64 * j] : (f32x4){0.f, 0.f, 0.f, 0.f}; }
#pragma unroll 1
        for (int urow = gw; urow < MUP; urow += NGW) {
            f32x4 v[4];
#pragma unroll
            for (int j = 0; j < 4; ++j) v[j] = nx[j];
            { const int un = urow + NGW; const float* s1 = un < MUP ? row_src(un) : nullptr;
#pragma unroll
              for (int j = 0; j < 4; ++j) nx[j] = s1 ? ((const f32x4*)s1)[lane + 64 * j] : (f32x4){0.f, 0.f, 0.f, 0.f}; }
            u32x2* o8 = (u32x2*)(XN + (size_t)urow * D) + lane;
            float ss = 0.f;
#pragma unroll
            for (int j = 0; j < 4; ++j) ss += (v[j][0] * v[j][0] + v[j][1] * v[j][1]) + (v[j][2] * v[j][2] + v[j][3] * v[j][3]);
            const float rstd = urow < MU ? rsqrtf(wave_sum(ss) * (1.0f / D) + EPS) : 0.f;
            float dot[8];
#pragma unroll
            for (int c = 0; c < 8; ++c) dot[c] = 0.f;
#pragma unroll
            for (int j = 0; j < 4; ++j) { v[j] = v[j] * rstd * nm[j];
                o8[64 * j] = (u32x2){cvtpk(v[j][0], v[j][1]), cvtpk(v[j][2], v[j][3])};
#pragma unroll
                for (int e = 0; e < 4; ++e)
#pragma unroll
                    for (int c = 0; c < 4; ++c) { dot[2 * c] += v[j][e] * bflo(wab[j * 4 + e][c]); dot[2 * c + 1] += v[j][e] * bfhi(wab[j * 4 + e][c]); } }
            float d4[4], d2[2], d1;
#pragma unroll
            for (int c = 0; c < 4; ++c) { const float keep = (lane & 32) ? dot[4 + c] : dot[c], send = (lane & 32) ? dot[c] : dot[4 + c]; d4[c] = keep + __shfl_xor(send, 32); }
#pragma unroll
            for (int c = 0; c < 2; ++c) { const float keep = (lane & 16) ? d4[2 + c] : d4[c], send = (lane & 16) ? d4[c] : d4[2 + c]; d2[c] = keep + __shfl_xor(send, 16); }
            { const float keep = (lane & 8) ? d2[1] : d2[0], send = (lane & 8) ? d2[0] : d2[1]; d1 = keep + __shfl_xor(send, 8); }
            d1 += __shfl_xor(d1, 4); d1 += __shfl_xor(d1, 2); d1 += __shfl_xor(d1, 1);
            const float a_ = __shfl(d1, ((lane & 2) ? 16 : 0) + ((lane & 1) ? 8 : 0));
            const float b_ = __shfl(d1, 32 + ((lane & 2) ? 16 : 0) + ((lane & 1) ? 8 : 0));
            if (lane < 4) {
                const float g = -__expf(A->a_log[lane]) * softplusf_(a_ + A->dt_bias[lane]);
                GB[(size_t)urow * 4 + lane] = urow < MU ? (f32x2){g, sigmoidf_(b_)} : (f32x2){0.f, 0.f};
            }
        }
    }
}
DI void item_decode(int item, int& b, int& h, bool& sample, int& t0, int& L) {
    if (item < N_ITEMS_P) { const int s = item / CHUNKS_P, c = item - s * CHUNKS_P; b = s >> 2; h = s & 3; sample = false; if (c == 0) { t0 = 0; L = NMETA; } else { t0 = NMETA + 64 * (c - 1); L = 64; } }
    else { const int s = item - N_ITEMS_P; b = s >> 2; h = s & 3; sample = true; t0 = 0; L = TS; }
}
#define LDS_BARRIER() do { asm volatile("s_waitcnt lgkmcnt(0)" ::: "memory"); __builtin_amdgcn_s_barrier(); asm volatile("" ::: "memory"); } while (0)
typedef GAS unsigned long long gu64;
constexpr size_t CTL_F1 = 655360;
static_assert(CTL_F1 + 2592 * 64 <= 1048576, "control region map");
DI gu64* item_flag1(KA A, int item) { return (gu64*)(A->ws + WS_CTL + CTL_F1 + (size_t)item * 64); }
DI int order_item(int m) { return m < N_ITEMS_P ? (m & 31) * CHUNKS_P + (m >> 5) : m; }
DI gu64* item_granule(KA A, int item) { return (gu64*)(A->ws + WS_CTL + CTL_GRAN + (size_t)item * 64); }
DI float wait_item(gu64* g, unsigned ep = 1u) {
    unsigned long long x; unsigned spins = 0;
    for (;;) { x = __hip_atomic_load(g, __ATOMIC_RELAXED, __HIP_MEMORY_SCOPE_AGENT); if ((unsigned)(x >> 32) >= ep) break; __builtin_amdgcn_s_sleep(8); if (++spins > (1u << 20)) break; }
    asm volatile("" ::: "memory");
    return __uint_as_float((unsigned)__builtin_amdgcn_readfirstlane((int)(unsigned)x));
}
constexpr int LDS_GCL = 139264;
constexpr int PITCH = 132;
DI bf16x8 frag_nat(const LAS float* src, int row, int k0) {
    const f32x4 lo = *(const LAS f32x4*)(src + row * PITCH + k0), hi = *(const LAS f32x4*)(src + row * PITCH + k0 + 4);
    return __builtin_bit_cast(bf16x8, pack8f(lo, hi));
}
struct S1Pre { u32x4 xr[11]; f32x4 w[4][2]; f32x2 gb; };
DI void stage1_issue(KA A, int item, S1Pre& P) {
    const int tid = threadIdx.x, lane = tid & 63, wave = __builtin_amdgcn_readfirstlane(tid >> 6);
    int b, h, t0, L; bool sample; item_decode(item, b, h, sample, t0, L);
    const bf16* QKVB = (const bf16*)(A->ws + WS_QKVB);
    const int cv = lane < 48 ? lane : 47, grp = cv >> 4, col0 = (cv & 15) * 8, r0 = wave * 8, cidx = grp * 512 + h * 128 + col0;
#pragma unroll
    for (int q = 0; q < 11; ++q) {
        const int i = r0 - 3 + q;
        long urow = sample ? (long)MP + b * TS + i : (long)b * TP + t0 + i;
        const bool ok = sample ? i >= 0 : t0 + i >= 0;
        if (!ok) urow = 0;
        P.xr[q] = *(const u32x4*)(QKVB + (size_t)urow * CONVD + cidx);
        if (!ok) P.xr[q] = (u32x4){0u, 0u, 0u, 0u};
    }
#pragma unroll
    for (int i = 0; i < 4; ++i) { P.w[i][0] = *(const f32x4*)(A->conv_w + i * CONVD + cidx); P.w[i][1] = *(const f32x4*)(A->conv_w + i * CONVD + cidx + 4); }
    P.gb = (f32x2){0.f, 0.f};
    if (wave == 7 && lane < L) { const int urow = sample ? MP + b * TS + lane : b * TP + t0 + lane; P.gb = ((const f32x2*)(A->ws + WS_GB))[(size_t)urow * 4 + h]; }
}
DI void prep_stage1(KA A, int item, int next_item, int prev_item, int wait_item_idx, int bslot, float* ats, S1Pre& P, LAS unsigned char* ldsb, unsigned ep, int pmode = 0) {
    const int tid = threadIdx.x, lane = tid & 63, wave = __builtin_amdgcn_readfirstlane(tid >> 6), r = lane & 31, hh = lane >> 5;
#define ST16(p, ...) __builtin_amdgcn_raw_buffer_store_b128(__builtin_bit_cast(v4u_t, (__VA_ARGS__)), rs_slot, (int)((const unsigned char*)(p) - (const unsigned char*)slot), 0, 16)
#define ST16F(p, ...) __builtin_amdgcn_raw_buffer_store_b128(__builtin_bit_cast(v4u_t, (__VA_ARGS__)), rs_ats, (int)((const unsigned char*)(p) - (const unsigned char*)ats), 0, 16)
    int b, h, t0, L; bool sample; item_decode(item, b, h, sample, t0, L);
    LAS float* Qs = (LAS float*)ldsb; LAS float* Ks = Qs + 64 * PITCH; LAS float* Vs = Ks + 64 * PITCH; LAS float* gcs = Vs + 64 * PITCH; LAS float* betas = gcs + 64;
    unsigned char* slot = slot_ptr(A, item);
    typedef unsigned v4u_t __attribute__((__vector_size__(16)));
    const __amdgpu_buffer_rsrc_t rs_slot = __builtin_amdgcn_make_buffer_rsrc((void*)slot, 0, (int)PREP_SLOT, 0x00020000);
    const __amdgpu_buffer_rsrc_t rs_ats = __builtin_amdgcn_make_buffer_rsrc((void*)ats, 0, (int)ATS_ITEM, 0x00020000);
    if (!(pmode & 8)) {
        const int cv = lane < 48 ? lane : 47, grp = cv >> 4, col0 = (cv & 15) * 8, r0 = wave * 8, cidx = grp * 512 + h * 128 + col0;
        float x[11][8];
#pragma unroll
        for (int q = 0; q < 11; ++q) { x[q][0] = bflo(P.xr[q].x); x[q][1] = bfhi(P.xr[q].x); x[q][2] = bflo(P.xr[q].y); x[q][3] = bfhi(P.xr[q].y);
                                       x[q][4] = bflo(P.xr[q].z); x[q][5] = bfhi(P.xr[q].z); x[q][6] = bflo(P.xr[q].w); x[q][7] = bfhi(P.xr[q].w); }
        if (sample && wave == 0) {
#pragma unroll
            for (int q = 0; q < 3; ++q) { const float* sp = A->state_conv + ((size_t)b * 3 + q) * CONVD + cidx; const f32x4 s0 = *(const f32x4*)sp, s1 = *(const f32x4*)(sp + 4);
                x[q][0] = s0[0]; x[q][1] = s0[1]; x[q][2] = s0[2]; x[q][3] = s0[3]; x[q][4] = s1[0]; x[q][5] = s1[1]; x[q][6] = s1[2]; x[q][7] = s1[3]; }
        }
        float w[4][8];
#pragma unroll
        for (int i = 0; i < 4; ++i) { w[i][0] = P.w[i][0][0]; w[i][1] = P.w[i][0][1]; w[i][2] = P.w[i][0][2]; w[i][3] = P.w[i][0][3]; w[i][4] = P.w[i][1][0]; w[i][5] = P.w[i][1][1]; w[i][6] = P.w[i][1][2]; w[i][7] = P.w[i][1][3]; }
        LAS float* dst = Qs + grp * 64 * PITCH + col0;
        const float nsc = grp == 0 ? 0.08838834764831845f : 1.0f;
#pragma unroll
        for (int q = 3; q < 11; ++q) {
            const int rr = r0 + q - 3;
            float v[8]; float ss = 0.f;
#pragma unroll
            for (int e = 0; e < 8; ++e) {
                const float y = __builtin_fmaf(w[3][e], x[q][e], __builtin_fmaf(w[2][e], x[q - 1][e], __builtin_fmaf(w[1][e], x[q - 2][e], w[0][e] * x[q - 3][e])));
                const float sv = siluf_(y); v[e] = sv; ss = __builtin_fmaf(sv, sv, ss); }
            ss += __builtin_bit_cast(float, __builtin_amdgcn_update_dpp(0, __builtin_bit_cast(int, ss), 0xB1, 0xF, 0xF, true));
            ss += __builtin_bit_cast(float, __builtin_amdgcn_update_dpp(0, __builtin_bit_cast(int, ss), 0x4E, 0xF, 0xF, true));
            ss += __builtin_bit_cast(float, __builtin_amdgcn_update_dpp(0, __builtin_bit_cast(int, ss), 0x141, 0xF, 0xF, true));
            ss += __builtin_bit_cast(float, __builtin_amdgcn_update_dpp(0, __builtin_bit_cast(int, ss), 0x140, 0xF, 0xF, true));
            float sc = grp == 2 ? 1.0f : rsqrtf(ss + EPS) * nsc;
            sc = rr < L ? sc : 0.f;
            if (lane < 48) { *(LAS f32x4*)(dst + rr * PITCH) = (f32x4){v[0] * sc, v[1] * sc, v[2] * sc, v[3] * sc}; *(LAS f32x4*)(dst + rr * PITCH + 4) = (f32x4){v[4] * sc, v[5] * sc, v[6] * sc, v[7] * sc}; }
        }
    }
    if (wave == 7) {
        float gc = P.gb[0];
#pragma unroll
        for (int o = 1; o < 64; o <<= 1) { const float t = __shfl_up(gc, o); if (lane >= o) gc += t; }
        gcs[lane] = gc; betas[lane] = P.gb[1];
        if (lane == 63) ((LAS float*)(ldsb + LDS_GCL))[bslot] = __expf(gc);
    }
    asm volatile("s_waitcnt vmcnt(0)" ::: "memory");
    if (next_item < N_ITEMS) stage1_issue(A, next_item, P);
    if (wait_item_idx >= 0 && wave == 0) (void)wait_item(item_granule(A, wait_item_idx), ep);
    LDS_BARRIER();
    if (prev_item >= 0 && tid == 0) __hip_atomic_store(item_flag1(A, prev_item), ((unsigned long long)ep << 32) | (unsigned long long)__float_as_uint(((const LAS float*)(ldsb + LDS_GCL))[bslot ^ 1]), __ATOMIC_RELAXED, __HIP_MEMORY_SCOPE_AGENT);
    if (wave < 6 && !(pmode & 4)) {
        const bool isqk = wave >= 3; const int tsel = isqk ? wave - 3 : wave, ib = tsel == 0 ? 0 : 1, jb = tsel == 2 ? 1 : 0;
        const LAS float* Asrc = isqk ? Qs : Ks;
        f32x16 acc;
#pragma unroll
        for (int e = 0; e < 16; ++e) acc[e] = 0.f;
#pragma unroll
        for (int s = 0; s < 8; ++s) acc = MFMA32(frag_nat(Asrc, 32 * ib + r, 16 * s + 8 * hh), frag_nat(Ks, 32 * jb + r, 16 * s + 8 * hh), acc);
        const int j = 32 * jb + r; const float gcj = gcs[j];
        float* Aout = ats + (ib + jb) * 1024; bf16* QKD = (bf16*)(slot + SL_QKD);
        if (!isqk) {
#pragma unroll
            for (int g4 = 0; g4 < 4; ++g4) { f32x4 v;
#pragma unroll
                for (int e = 0; e < 4; ++e) { const int i = 32 * ib + 8 * g4 + 4 * hh + e; v[e] = i > j ? betas[i] * __expf(fminf(gcs[i] - gcj, 0.f)) * acc[4 * g4 + e] : 0.f; }
                ST16F(Aout + r * 32 + 8 * g4 + 4 * hh, v); }
        } else {
            LAS float* patch = (LAS float*)(ldsb + 106496) + (wave - 3) * (32 * 36);
#pragma unroll
            for (int reg = 0; reg < 16; ++reg) { const int il = crow16(reg, hh), i = 32 * ib + il; const float dec = __expf(fminf(gcs[i] - gcj, 0.f));
                patch[il * 36 + r] = i >= j ? dec * acc[reg] : 0.f; }
            LDS_WAIT(); asm volatile("" ::: "memory");
#pragma unroll
            for (int ks2 = 0; ks2 < 2; ++ks2) { const int k0 = 16 * ks2 + 4 * hh;
                const f32x4 lo = *(const LAS f32x4*)(patch + r * 36 + k0), hi = *(const LAS f32x4*)(patch + r * 36 + k0 + 8);
                ST16((unsigned char*)QKD + ((ib * 4 + 2 * jb + ks2) * 64 + lane) * 16, pack8f(lo, hi)); }
        }
    }
    const float gcl = gcs[63];
#pragma unroll 1
    for (int job = (pmode & 4) ? 56 : wave; job < 56; job += 8) {
        if (job < 32) {
            const bool isq = job >= 16; const int jj = job & 15, rb = jj >> 3, ks = jj & 7, row = 32 * rb + r, k0 = 16 * ks + 4 * hh;
            const LAS float* src = isq ? Qs : Ks; const float sc = isq ? __expf(gcs[row]) : betas[row] * __expf(gcs[row]);
            const f32x4 lo = *(const LAS f32x4*)(src + row * PITCH + k0) * sc, hi = *(const LAS f32x4*)(src + row * PITCH + k0 + 8) * sc;
            ST16(slot + (isq ? SL_QE : SL_BEK) + ((rb * 8 + ks) * 64 + lane) * 16, pack8f(lo, hi));
        } else if (job < 48) {
            const int jj = job - 32, rb = jj >> 2, ks = jj & 3, dk = 32 * rb + r;
            f32x4 lo, hi;
#pragma unroll
            for (int e = 0; e < 4; ++e) { const int j0 = 16 * ks + 4 * hh + e, j1 = j0 + 8;
                lo[e] = Ks[j0 * PITCH + dk] * __expf(gcl - gcs[j0]); hi[e] = Ks[j1 * PITCH + dk] * __expf(gcl - gcs[j1]); }
            ST16(slot + SL_KWT + ((rb * 4 + ks) * 64 + lane) * 16, pack8f(lo, hi));
        } else {
            const int q = job - 48, w = q >> 1, ib = q & 1, dv = 32 * w + r;
            float v[16];
#pragma unroll
            for (int reg = 0; reg < 16; ++reg) { const int i = 32 * ib + crow16(reg, hh); v[reg] = betas[i] * Vs[i * PITCH + dv]; }
            u32x4* dst = (u32x4*)(slot + SL_BV + ((w * 2 + ib) * 64 + lane) * 32);
            ST16(dst, (u32x4){cvtpk(v[0], v[1]), cvtpk(v[2], v[3]), cvtpk(v[4], v[5]), cvtpk(v[6], v[7])});
            ST16(dst + 1, (u32x4){cvtpk(v[8], v[9]), cvtpk(v[10], v[11]), cvtpk(v[12], v[13]), cvtpk(v[14], v[15])});
        }
    }
    LDS_BARRIER();
}
DI void prep_stage2(KA A, int item, float gcl, const float* ats, LAS float* M, unsigned ep) {
    int lane = threadIdx.x & 63; asm volatile("" : "+v"(lane));
    const int r = lane & 31, hh = lane >> 5, base = 32 * hh;
    unsigned char* slot = slot_ptr(A, item);
    const f32x4* Ain = (const f32x4*)ats;
#pragma unroll
    for (int tt = 0; tt < 3; ++tt) { const int jb = tt >> 1, ib = (tt + 1) >> 1;
#pragma unroll
        for (int q = 0; q < 4; ++q) { const int idx = q * 64 + lane, jj = idx >> 3, i4 = idx & 7;
            *(LAS f32x4*)(M + (32 * jb + jj) * 64 + 32 * ib + 4 * i4) = Ain[tt * 256 + idx]; } }
    LDS_WAIT(); asm volatile("" ::: "memory");
#pragma unroll 1
    for (int rb = 0; rb < 2; ++rb) {
        float acc[16];
#pragma unroll
        for (int i = 0; i < 16; ++i) acc[i] = r == 16 * rb + i ? 1.f : 0.f;
        if (rb == 1) {
#pragma unroll 4
            for (int j = 0; j < 16; ++j) {
                float tj = M[(base + j) * 64 + base + r]; tj = r <= j ? tj : 0.f;
                const LAS f32x4* ar = (const LAS f32x4*)(M + (base + j) * 64 + base + 16);
                const f32x4 a0 = ar[0], a1 = ar[1], a2 = ar[2], a3 = ar[3];
#pragma unroll
                for (int e = 0; e < 4; ++e) { acc[e] -= a0[e] * tj; acc[4 + e] -= a1[e] * tj; acc[8 + e] -= a2[e] * tj; acc[12 + e] -= a3[e] * tj; }
            }
        }
#pragma unroll
        for (int j = 0; j < 16; ++j) {
            const float tj = acc[j]; const int row = base + 16 * rb + j;
            const LAS f32x4* ar = (const LAS f32x4*)(M + row * 64 + base + 16 * rb);
            float a[16];
#pragma unroll
            for (int q = j >> 2; q < 4; ++q) { const f32x4 v = ar[q]; a[4 * q] = v[0]; a[4 * q + 1] = v[1]; a[4 * q + 2] = v[2]; a[4 * q + 3] = v[3]; }
            if (r <= 16 * rb + j) M[row * 64 + base + r] = tj;
#pragma unroll
            for (int i = j + 1; i < 16; ++i) acc[i] -= a[i] * tj;
        }
        asm volatile("" ::: "memory");
    }
    LDS_WAIT(); asm volatile("" ::: "memory");
    f32x16 X;
#pragma unroll
    for (int e = 0; e < 16; ++e) X[e] = 0.f;
#pragma unroll
    for (int s2 = 0; s2 < 16; ++s2) { const int k = 2 * s2 + hh; const float a = M[k * 64 + 32 + r]; float bb = M[k * 64 + r]; bb = r <= k ? bb : 0.f;
        X = __builtin_amdgcn_mfma_f32_32x32x2f32(a, bb, X, 0, 0, 0); }
#pragma unroll
    for (int reg = 0; reg < 16; ++reg) M[crow16(reg, hh) * 64 + 32 + r] = X[reg];
    LDS_WAIT(); asm volatile("" ::: "memory");
    f32x16 Y;
#pragma unroll
    for (int e = 0; e < 16; ++e) Y[e] = 0.f;
#pragma unroll
    for (int s2 = 0; s2 < 16; ++s2) { const int k = 2 * s2 + hh; float a = M[(32 + r) * 64 + 32 + k]; a = k <= r ? a : 0.f; const float bb = M[k * 64 + 32 + r];
        Y = __builtin_amdgcn_mfma_f32_32x32x2f32(a, bb, Y, 0, 0, 0); }
#pragma unroll
    for (int reg = 0; reg < 16; ++reg) M[(32 + crow16(reg, hh)) * 64 + r] = -Y[reg];
    LDS_WAIT(); asm volatile("" ::: "memory");
#pragma unroll
    for (int f = 0; f < 8; ++f) { const int rb = f >> 2, ks = f & 3, row = 32 * rb + r, k0 = 16 * ks + 4 * hh;
        f32x4 lo = *(const LAS f32x4*)(M + row * 64 + k0), hi = *(const LAS f32x4*)(M + row * 64 + k0 + 8);
#pragma unroll
        for (int e = 0; e < 4; ++e) { lo[e] = k0 + e <= row ? lo[e] : 0.f; hi[e] = k0 + 8 + e <= row ? hi[e] : 0.f; }
        st16_sc1(slot + SL_T + ((rb * 4 + ks) * 64 + lane) * 16, pack8f(lo, hi)); }
    LDS_WAIT();
    asm volatile("s_waitcnt vmcnt(0)" ::: "memory");
    if (lane == 0) __hip_atomic_store(item_granule(A, item), ((unsigned long long)ep << 32) | (unsigned long long)__float_as_uint(gcl), __ATOMIC_RELAXED, __HIP_MEMORY_SCOPE_AGENT);
}
DI void scan_seq(KA A, int seq, int w, int lane, unsigned ep) {
    const int r = lane & 31, hh = lane >> 5, dv = 32 * w + r;
    const bool sample = seq >= N_PROMPT_SEQ; const int sidx = sample ? seq - N_PROMPT_SEQ : seq, b = sidx >> 2, h = sidx & 3, nch = sample ? 1 : CHUNKS_P;
    f32x16 S[4];
    if (sample) {
        const float* S0 = A->state_delta + ((size_t)(b * 4 + h) * 128) * 128 + dv;
#pragma unroll
        for (int kb = 0; kb < 4; ++kb)
#pragma unroll
            for (int reg = 0; reg < 16; ++reg) S[kb][reg] = S0[(size_t)(32 * kb + crow16(reg, hh)) * 128];
    } else {
#pragma unroll
        for (int kb = 0; kb < 4; ++kb)
#pragma unroll
            for (int reg = 0; reg < 16; ++reg) S[kb][reg] = 0.f;
    }
    bf16* OBR = (bf16*)((unsigned char*)A->out + DO_OB);
#pragma unroll 1
    for (int c = 0; c < nch; ++c) {
        const int item = sample ? N_ITEMS_P + sidx : seq * CHUNKS_P + c;
        const unsigned char* slot = slot_ptr(A, item);
        const float gcl = wait_item(item_granule(A, item), ep);
        __builtin_amdgcn_fence(__ATOMIC_ACQUIRE, "agent");
        const bf16x8* bek = (const bf16x8*)(slot + SL_BEK) + lane; const bf16x8* tp = (const bf16x8*)(slot + SL_T) + lane;
        const bf16x8* qe = (const bf16x8*)(slot + SL_QE) + lane; const bf16x8* qkd = (const bf16x8*)(slot + SL_QKD) + lane; const bf16x8* kwt = (const bf16x8*)(slot + SL_KWT) + lane;
        bf16x8 sf[8];
#pragma unroll
        for (int kb = 0; kb < 4; ++kb) { sf[2 * kb] = pack_step<0>(S[kb]); sf[2 * kb + 1] = pack_step<1>(S[kb]); }
        f32x16 x0, x1;
#pragma unroll
        for (int e = 0; e < 16; ++e) { x0[e] = 0.f; x1[e] = 0.f; }
#pragma unroll
        for (int ks = 0; ks < 8; ++ks) { x0 = MFMA32(bek[ks * 64], sf[ks], x0); x1 = MFMA32(bek[(8 + ks) * 64], sf[ks], x1); }
        {
            const u32x4* bv = (const u32x4*)(slot + SL_BV) + ((w * 2) * 64 + lane) * 2;
            const u32x4 a0 = bv[0], a1 = bv[1], c0 = bv[128], c1 = bv[129];
            x0[0] = bflo(a0.x) - x0[0]; x0[1] = bfhi(a0.x) - x0[1]; x0[2] = bflo(a0.y) - x0[2]; x0[3] = bfhi(a0.y) - x0[3];
            x0[4] = bflo(a0.z) - x0[4]; x0[5] = bfhi(a0.z) - x0[5]; x0[6] = bflo(a0.w) - x0[6]; x0[7] = bfhi(a0.w) - x0[7];
            x0[8] = bflo(a1.x) - x0[8]; x0[9] = bfhi(a1.x) - x0[9]; x0[10] = bflo(a1.y) - x0[10]; x0[11] = bfhi(a1.y) - x0[11];
            x0[12] = bflo(a1.z) - x0[12]; x0[13] = bfhi(a1.z) - x0[13]; x0[14] = bflo(a1.w) - x0[14]; x0[15] = bfhi(a1.w) - x0[15];
            x1[0] = bflo(c0.x) - x1[0]; x1[1] = bfhi(c0.x) - x1[1]; x1[2] = bflo(c0.y) - x1[2]; x1[3] = bfhi(c0.y) - x1[3];
            x1[4] = bflo(c0.z) - x1[4]; x1[5] = bfhi(c0.z) - x1[5]; x1[6] = bflo(c0.w) - x1[6]; x1[7] = bfhi(c0.w) - x1[7];
            x1[8] = bflo(c1.x) - x1[8]; x1[9] = bfhi(c1.x) - x1[9]; x1[10] = bflo(c1.y) - x1[10]; x1[11] = bfhi(c1.y) - x1[11];
            x1[12] = bflo(c1.z) - x1[12]; x1[13] = bfhi(c1.z) - x1[13]; x1[14] = bflo(c1.w) - x1[14]; x1[15] = bfhi(c1.w) - x1[15];
        }
        bf16x8 rf[4] = {pack_step<0>(x0), pack_step<1>(x0), pack_step<0>(x1), pack_step<1>(x1)};
        f32x16 u0, u1;
#pragma unroll
        for (int e = 0; e < 16; ++e) { u0[e] = 0.f; u1[e] = 0.f; }
        u0 = MFMA32(tp[0 * 64], rf[0], u0); u0 = MFMA32(tp[1 * 64], rf[1], u0);
#pragma unroll
        for (int ks = 0; ks < 4; ++ks) u1 = MFMA32(tp[(4 + ks) * 64], rf[ks], u1);
        bf16x8 uf[4] = {pack_step<0>(u0), pack_step<1>(u0), pack_step<0>(u1), pack_step<1>(u1)};
        if (sample || c > 0) {
#pragma unroll
            for (int e = 0; e < 16; ++e) { x0[e] = 0.f; x1[e] = 0.f; }
#pragma unroll
            for (int ks = 0; ks < 8; ++ks) { x0 = MFMA32(qe[ks * 64], sf[ks], x0); x1 = MFMA32(qe[(8 + ks) * 64], sf[ks], x1); }
            x0 = MFMA32(qkd[0 * 64], uf[0], x0); x0 = MFMA32(qkd[1 * 64], uf[1], x0);
#pragma unroll
            for (int ks = 0; ks < 4; ++ks) x1 = MFMA32(qkd[(4 + ks) * 64], uf[ks], x1);
            const int crow0 = sample ? NBATCH * SEQ + b * TS : b * SEQ + 64 * (c - 1), L = sample ? TS : 64;
#pragma unroll
            for (int reg = 0; reg < 16; ++reg) { const int i0 = crow16(reg, hh), i1 = 32 + i0;
                if (i0 < L) OBR[(size_t)(crow0 + i0) * OAB_PITCH + h * 128 + dv] = f2bf(x0[reg]);
                if (i1 < L) OBR[(size_t)(crow0 + i1) * OAB_PITCH + h * 128 + dv] = f2bf(x1[reg]); }
        }
#pragma unroll
        for (int kb = 0; kb < 4; ++kb) {
            S[kb] = S[kb] * gcl;
#pragma unroll
            for (int ks = 0; ks < 4; ++ks) S[kb] = MFMA32(kwt[(kb * 4 + ks) * 64], uf[ks], S[kb]);
        }
    }
    float* So = A->out + (sample ? O_DS : O_DP) + ((size_t)(b * 4 + h) * 128) * 128 + dv;
#pragma unroll
    for (int kb = 0; kb < 4; ++kb)
#pragma unroll
        for (int reg = 0; reg < 16; ++reg) So[(size_t)(32 * kb + crow16(reg, hh)) * 128] = S[kb][reg];
}

constexpr int HALF_BYTES = 40960;
DI void scan_prompt_wg(KA A, int seq, LAS unsigned char* lds, unsigned ep) {
    const int tid = threadIdx.x, lane = tid & 63, wave = __builtin_amdgcn_readfirstlane(tid >> 6);
    const int b = seq >> 2, h = seq & 3;
    constexpr int N = 2 * CHUNKS_P;
    if (wave >= 4) {
        const int loff = (wave - 4) * 10240 + lane * 16;
        u32x4 r0[10], r1[10];
        LAS u32x4* d0 = (LAS u32x4*)(lds + loff); LAS u32x4* d1 = (LAS u32x4*)(lds + HALF_BYTES + loff);
        LAS float* gclw = (LAS float*)(lds + 2 * HALF_BYTES);
#define SCAN_LOAD(n, R) do { const int item_ = seq * CHUNKS_P + ((n) >> 1); \
            if (((n) & 1) == 0) { const float g_ = wait_item(item_granule(A, item_), ep); if (wave == 4 && lane == 0) gclw[((n) >> 1) & 3] = g_; } \
            const __amdgpu_buffer_rsrc_t rs_ = __builtin_amdgcn_make_buffer_rsrc((void*)slot_ptr(A, item_), 0, (int)PREP_SLOT, 0x00020000); \
            _Pragma("unroll") for (int q = 0; q < 10; ++q) R[q] = __builtin_bit_cast(u32x4, __builtin_amdgcn_raw_buffer_load_b128(rs_, ((n) & 1) * HALF_BYTES + loff + q * 1024, 0, 16)); } while (0)
        SCAN_LOAD(0, r0);
#pragma unroll
        for (int q = 0; q < 10; ++q) d0[q * 64] = r0[q];
        SCAN_LOAD(1, r1);
        LDS_BARRIER();
#pragma unroll 1
        for (int n = 0; n < N; n += 2) {
            if (n + 2 < N) SCAN_LOAD(n + 2, r0);
#pragma unroll
            for (int q = 0; q < 10; ++q) d1[q * 64] = r1[q];
            LDS_BARRIER();
            if (n + 3 < N) SCAN_LOAD(n + 3, r1);
            if (n + 2 < N) {
#pragma unroll
                for (int q = 0; q < 10; ++q) d0[q * 64] = r0[q]; }
            LDS_BARRIER();
        }
#undef SCAN_LOAD
    } else {
        const int w = wave, r = lane & 31, hh = lane >> 5, dv = 32 * w + r;
        f32x16 S[4];
#pragma unroll
        for (int kb = 0; kb < 4; ++kb)
#pragma unroll
            for (int reg = 0; reg < 16; ++reg) S[kb][reg] = 0.f;
        bf16* OBR = (bf16*)((unsigned char*)A->out + DO_OB);
        const LAS float* gclw = (const LAS float*)(lds + 2 * HALF_BYTES);
        const LAS bf16x8* bek = (const LAS bf16x8*)(lds + SL_BEK) + lane; const LAS bf16x8* tp = (const LAS bf16x8*)(lds + SL_T) + lane;
        const LAS u32x4* bv = (const LAS u32x4*)(lds + SL_BV) + ((w * 2) * 64 + lane) * 2;
        const LAS bf16x8* qkd = (const LAS bf16x8*)(lds + HALF_BYTES + (SL_QKD - HALF_BYTES)) + lane; const LAS bf16x8* qe = (const LAS bf16x8*)(lds + HALF_BYTES + (SL_QE - HALF_BYTES)) + lane;
        const LAS bf16x8* kwt = (const LAS bf16x8*)(lds + HALF_BYTES + (SL_KWT - HALF_BYTES)) + lane;
        LDS_BARRIER();
#pragma unroll 1
        for (int c = 0; c < CHUNKS_P; ++c) {
            bf16x8 sf[8];
#pragma unroll
            for (int kb = 0; kb < 4; ++kb) { sf[2 * kb] = pack_step<0>(S[kb]); sf[2 * kb + 1] = pack_step<1>(S[kb]); }
            f32x16 x0, x1;
#pragma unroll
            for (int e = 0; e < 16; ++e) { x0[e] = 0.f; x1[e] = 0.f; }
#pragma unroll
            for (int ks = 0; ks < 8; ++ks) { x0 = MFMA32(bek[ks * 64], sf[ks], x0); x1 = MFMA32(bek[(8 + ks) * 64], sf[ks], x1); }
            {
                const u32x4 a0 = bv[0], a1 = bv[1], c0 = bv[128], c1 = bv[129];
                x0[0] = bflo(a0.x) - x0[0]; x0[1] = bfhi(a0.x) - x0[1]; x0[2] = bflo(a0.y) - x0[2]; x0[3] = bfhi(a0.y) - x0[3];
                x0[4] = bflo(a0.z) - x0[4]; x0[5] = bfhi(a0.z) - x0[5]; x0[6] = bflo(a0.w) - x0[6]; x0[7] = bfhi(a0.w) - x0[7];
                x0[8] = bflo(a1.x) - x0[8]; x0[9] = bfhi(a1.x) - x0[9]; x0[10] = bflo(a1.y) - x0[10]; x0[11] = bfhi(a1.y) - x0[11];
                x0[12] = bflo(a1.z) - x0[12]; x0[13] = bfhi(a1.z) - x0[13]; x0[14] = bflo(a1.w) - x0[14]; x0[15] = bfhi(a1.w) - x0[15];
                x1[0] = bflo(c0.x) - x1[0]; x1[1] = bfhi(c0.x) - x1[1]; x1[2] = bflo(c0.y) - x1[2]; x1[3] = bfhi(c0.y) - x1[3];
                x1[4] = bflo(c0.z) - x1[4]; x1[5] = bfhi(c0.z) - x1[5]; x1[6] = bflo(c0.w) - x1[6]; x1[7] = bfhi(c0.w) - x1[7];
                x1[8] = bflo(c1.x) - x1[8]; x1[9] = bfhi(c1.x) - x1[9]; x1[10] = bflo(c1.y) - x1[10]; x1[11] = bfhi(c1.y) - x1[11];
                x1[12] = bflo(c1.z) - x1[12]; x1[13] = bfhi(c1.z) - x1[13]; x1[14] = bflo(c1.w) - x1[14]; x1[15] = bfhi(c1.w) - x1[15];
            }
            bf16x8 rf[4] = {pack_step<0>(x0), pack_step<1>(x0), pack_step<0>(x1), pack_step<1>(x1)};
            f32x16 u0, u1;
#pragma unroll
            for (int e = 0; e < 16; ++e) { u0[e] = 0.f; u1[e] = 0.f; }
            u0 = MFMA32(tp[0 * 64], rf[0], u0); u0 = MFMA32(tp[1 * 64], rf[1], u0);
#pragma unroll
            for (int ks = 0; ks < 4; ++ks) u1 = MFMA32(tp[(4 + ks) * 64], rf[ks], u1);
            bf16x8 uf[4] = {pack_step<0>(u0), pack_step<1>(u0), pack_step<0>(u1), pack_step<1>(u1)};
            LDS_BARRIER();
            if (c > 0) {
#pragma unroll
                for (int e = 0; e < 16; ++e) { x0[e] = 0.f; x1[e] = 0.f; }
#pragma unroll
                for (int ks = 0; ks < 8; ++ks) { x0 = MFMA32(qe[ks * 64], sf[ks], x0); x1 = MFMA32(qe[(8 + ks) * 64], sf[ks], x1); }
                x0 = MFMA32(qkd[0 * 64], uf[0], x0); x0 = MFMA32(qkd[1 * 64], uf[1], x0);
#pragma unroll
                for (int ks = 0; ks < 4; ++ks) x1 = MFMA32(qkd[(4 + ks) * 64], uf[ks], x1);
                bf16* orow = OBR + (size_t)(b * SEQ + 64 * (c - 1)) * OAB_PITCH + h * 128 + dv;
#pragma unroll
                for (int reg = 0; reg < 16; ++reg) { const int i0 = crow16(reg, hh); orow[(size_t)i0 * OAB_PITCH] = f2bf(x0[reg]); orow[(size_t)(32 + i0) * OAB_PITCH] = f2bf(x1[reg]); }
            }
            const float gcl = gclw[c & 3];
#pragma unroll
            for (int kb = 0; kb < 4; ++kb) {
                S[kb] = S[kb] * gcl;
#pragma unroll
                for (int ks = 0; ks < 4; ++ks) S[kb] = MFMA32(kwt[(kb * 4 + ks) * 64], uf[ks], S[kb]);
            }
            LDS_BARRIER();
        }
        float* So = A->out + O_DP + ((size_t)(b * 4 + h) * 128) * 128 + dv;
#pragma unroll
        for (int kb = 0; kb < 4; ++kb)
#pragma unroll
            for (int reg = 0; reg < 16; ++reg) So[(size_t)(32 * kb + crow16(reg, hh)) * 128] = S[kb][reg];
    }
}

constexpr int KPITCH = 72, VPITCH = 264;
DI void attn_unit(KA A, int unit, LAS unsigned char* ldsb) {
    const int tid = threadIdx.x, lane = tid & 63, wave = __builtin_amdgcn_readfirstlane(tid >> 6), r = lane & 31, hh = lane >> 5;
    const int b = unit >> 6, kh = (unit >> 5) & 1, jb = unit & 31, T0 = NMETA + 128 * jb;
    LAS bf16* Ksm = (LAS bf16*)ldsb; LAS bf16* VTs = Ksm + 256 * KPITCH;
    const bf16* KVg = (const bf16*)(A->ws + WS_KV); const bf16* QAg = (const bf16*)(A->ws + WS_QA);
#pragma unroll
    for (int e4 = 0; e4 < 4; ++e4) {
        const int id = tid + 512 * e4, key = id >> 3, cch = id & 7, tk = T0 - 128 + key;
        u32x4 kq = (u32x4){0u, 0u, 0u, 0u}, vq = kq;
        if (tk >= 0) { const bf16* src = KVg + (size_t)(b * TP + tk) * 256 + kh * 64 + 8 * cch; kq = *(const u32x4*)src; vq = *(const u32x4*)(src + 128); }
        *(LAS u32x4*)(Ksm + key * KPITCH + 8 * cch) = kq;
        const int kkk = key & 15, pos = (key & ~15) + 8 * ((kkk >> 2) & 1) + (((kkk >> 3) << 2) | (kkk & 3));
        LAS bf16* vd = VTs + (8 * cch) * VPITCH + pos;
        vd[0 * VPITCH] = (bf16)(vq.x & 0xffffu); vd[1 * VPITCH] = (bf16)(vq.x >> 16); vd[2 * VPITCH] = (bf16)(vq.y & 0xffffu); vd[3 * VPITCH] = (bf16)(vq.y >> 16);
        vd[4 * VPITCH] = (bf16)(vq.z & 0xffffu); vd[5 * VPITCH] = (bf16)(vq.z >> 16); vd[6 * VPITCH] = (bf16)(vq.w & 0xffffu); vd[7 * VPITCH] = (bf16)(vq.w >> 16);
    }
    LDS_BARRIER();
    const int g = wave >> 1, qh = wave & 1, head = 4 * kh + g;
    const float sink2 = A->sinks[head] * 1.4426950408889634f;
    const int kmin = jb == 0 ? 128 - NMETA : 0;
#pragma unroll 1
    for (int q2 = 0; q2 < 2; ++q2) {
        const int qb = 2 * qh + q2, iq = 32 * qb + r;
        const bf16* qrow = QAg + (size_t)(b * TP + T0 + iq) * 512 + head * 64 + 8 * hh;
        bf16x8 qf[4];
#pragma unroll
        for (int s = 0; s < 4; ++s) qf[s] = *(const bf16x8*)(qrow + 16 * s);
        f32x16 st[5];
        float m = sink2;
#pragma unroll
        for (int kt5 = 0; kt5 < 5; ++kt5) {
            const int kt = qb + kt5;
            f32x16 acc;
#pragma unroll
            for (int e = 0; e < 16; ++e) acc[e] = 0.f;
#pragma unroll
            for (int s = 0; s < 4; ++s) acc = MFMA32(*(const LAS bf16x8*)(Ksm + (32 * kt + r) * KPITCH + 16 * s + 8 * hh), qf[s], acc);
#pragma unroll
            for (int reg = 0; reg < 16; ++reg) { const int kk = 32 * kt + crow16(reg, hh); const bool ok = kk >= iq && kk <= iq + 128 && kk >= kmin;
                acc[reg] = ok ? acc[reg] : -INFINITY; m = fmaxf(m, acc[reg]); }
            st[kt5] = acc;
        }
        m = fmaxf(m, __shfl_xor(m, 32));
        float l = 0.f;
#pragma unroll
        for (int kt5 = 0; kt5 < 5; ++kt5)
#pragma unroll
            for (int reg = 0; reg < 16; ++reg) { const float p = exp2f(st[kt5][reg] - m); st[kt5][reg] = p; l += p; }
        l += __shfl_xor(l, 32); l += exp2f(sink2 - m);
        f32x16 o0, o1;
#pragma unroll
        for (int e = 0; e < 16; ++e) { o0[e] = 0.f; o1[e] = 0.f; }
#pragma unroll
        for (int kt5 = 0; kt5 < 5; ++kt5) {
            const int kt = qb + kt5;
            const bf16x8 p0 = pack_step<0>(st[kt5]), p1 = pack_step<1>(st[kt5]);
            const LAS bf16* vb = VTs + r * VPITCH + 32 * kt + 8 * hh;
            o0 = MFMA32(*(const LAS bf16x8*)(vb), p0, o0); o0 = MFMA32(*(const LAS bf16x8*)(vb + 16), p1, o0);
            o1 = MFMA32(*(const LAS bf16x8*)(vb + 32 * VPITCH), p0, o1); o1 = MFMA32(*(const LAS bf16x8*)(vb + 32 * VPITCH + 16), p1, o1);
        }
        const float rl = 1.0f / l;
        bf16* orow = (bf16*)((unsigned char*)A->out + DO_OA) + (size_t)(b * SEQ + 128 * jb + iq) * OAB_PITCH + head * 64 + 4 * hh;
#pragma unroll
        for (int g4 = 0; g4 < 4; ++g4) {
            *(u32x2*)(orow + 8 * g4) = (u32x2){cvtpk(o0[4 * g4] * rl, o0[4 * g4 + 1] * rl), cvtpk(o0[4 * g4 + 2] * rl, o0[4 * g4 + 3] * rl)};
            *(u32x2*)(orow + 32 + 8 * g4) = (u32x2){cvtpk(o1[4 * g4] * rl, o1[4 * g4 + 1] * rl), cvtpk(o1[4 * g4 + 2] * rl, o1[4 * g4 + 3] * rl)};
        }
    }
    LDS_BARRIER();
}
DI void sample_attn(KA A, int b, int head, LAS float* wl, int lane) {
    const int kh = head >> 2;
    LAS float* qn = wl; LAS float* ps = wl + 256;
    const bf16* QAg = (const bf16*)(A->ws + WS_QA); const bf16* KVg = (const bf16*)(A->ws + WS_KV);
#pragma unroll
    for (int i = 0; i < 4; ++i) qn[i * 64 + lane] = bf2f(QAg[(size_t)(MP + b * TS + i) * 512 + head * 64 + pos_of_d(lane)]);
    LDS_WAIT(); asm volatile("" ::: "memory");
    const float sink2 = A->sinks[head] * 1.4426950408889634f;
#pragma unroll 1
    for (int kq = 0; kq < 3; ++kq) {
        const int kj = lane + 64 * kq;
        float sc0 = 0.f, sc1 = 0.f, sc2 = 0.f, sc3 = 0.f;
        if (kj < 128) {
            const f32x4* kr = (const f32x4*)(A->cache_k + ((size_t)(b * 128 + kj) * 2 + kh) * 64);
#pragma unroll 4
            for (int d4 = 0; d4 < 16; ++d4) { const f32x4 kv = kr[d4];
                const f32x4 q0 = *(const LAS f32x4*)(qn + 4 * d4), q1 = *(const LAS f32x4*)(qn + 64 + 4 * d4), q2 = *(const LAS f32x4*)(qn + 128 + 4 * d4), q3 = *(const LAS f32x4*)(qn + 192 + 4 * d4);
                sc0 += (kv[0] * q0[0] + kv[1] * q0[1]) + (kv[2] * q0[2] + kv[3] * q0[3]); sc1 += (kv[0] * q1[0] + kv[1] * q1[1]) + (kv[2] * q1[2] + kv[3] * q1[3]);
                sc2 += (kv[0] * q2[0] + kv[1] * q2[1]) + (kv[2] * q2[2] + kv[3] * q2[3]); sc3 += (kv[0] * q3[0] + kv[1] * q3[1]) + (kv[2] * q3[2] + kv[3] * q3[3]); }
        } else if (kj < 132) {
            const bf16* kr = KVg + (size_t)(MP + b * TS + (kj - 128)) * 256 + kh * 64;
#pragma unroll 4
            for (int p = 0; p < 64; ++p) { const float kv = bf2f(kr[p]); const int d = d_of_pos(p);
                sc0 += kv * qn[d]; sc1 += kv * qn[64 + d]; sc2 += kv * qn[128 + d]; sc3 += kv * qn[192 + d]; }
        }
        if (kj < 132) {
            ps[0 * 132 + kj] = (kj >= 0 && kj <= 128) ? sc0 : -INFINITY; ps[1 * 132 + kj] = (kj >= 1 && kj <= 129) ? sc1 : -INFINITY;
            ps[2 * 132 + kj] = (kj >= 2 && kj <= 130) ? sc2 : -INFINITY; ps[3 * 132 + kj] = (kj >= 3 && kj <= 131) ? sc3 : -INFINITY; }
    }
    LDS_WAIT(); asm volatile("" ::: "memory");
    float linv[4];
#pragma unroll
    for (int i = 0; i < 4; ++i) {
        const float s0 = ps[i * 132 + lane], s1 = ps[i * 132 + 64 + lane], s2 = lane < 4 ? ps[i * 132 + 128 + lane] : -INFINITY;
        const float m = wave_max(fmaxf(fmaxf(s0, s1), fmaxf(s2, sink2)));
        const float p0 = exp2f(s0 - m), p1 = exp2f(s1 - m), p2 = exp2f(s2 - m);
        ps[i * 132 + lane] = p0; ps[i * 132 + 64 + lane] = p1; if (lane < 4) ps[i * 132 + 128 + lane] = p2;
        linv[i] = 1.0f / (wave_sum(p0 + p1 + p2) + exp2f(sink2 - m));
    }
    LDS_WAIT(); asm volatile("" ::: "memory");
    float o[4] = {0.f, 0.f, 0.f, 0.f};
#pragma unroll 4
    for (int kj = 0; kj < 128; ++kj) { const float v = A->cache_v[((size_t)(b * 128 + kj) * 2 + kh) * 64 + lane];
#pragma unroll
        for (int i = 0; i < 4; ++i) o[i] += ps[i * 132 + kj] * v; }
#pragma unroll
    for (int kj = 128; kj < 132; ++kj) { const float v = bf2f(KVg[(size_t)(MP + b * TS + (kj - 128)) * 256 + 128 + kh * 64 + lane]);
#pragma unroll
        for (int i = 0; i < 4; ++i) o[i] += ps[i * 132 + kj] * v; }
    bf16* OAg = (bf16*)((unsigned char*)A->out + DO_OA);
#pragma unroll
    for (int i = 0; i < 4; ++i) OAg[(size_t)(NBATCH * SEQ + b * TS + i) * OAB_PITCH + head * 64 + lane] = f2bf(o[i] * linv[i]);
    LDS_WAIT(); asm volatile("" ::: "memory");
}
constexpr int NINV_WG = 24;
DI void p23_mixers(KA A, LAS unsigned char* lds, const XcdBarrier& dbg_bar, unsigned ep, int pmode = 0) {
    const int tid = threadIdx.x, lane = tid & 63, wave = __builtin_amdgcn_readfirstlane(tid >> 6), G = gridDim.x, wg = blockIdx.x;
    const int NSCAN = N_PROMPT_SEQ, NP = G - NSCAN - NINV_WG;
    if (wg < NSCAN) { if (!(pmode & 2)) scan_prompt_wg(A, wg, lds, ep); return; }
    if (wg < NSCAN + NINV_WG) {
        const int wv = (wg - NSCAN) * NWAVES + wave, NWV = NINV_WG * NWAVES;
#pragma unroll 1
        for (int m = wv; m < N_ITEMS; m += NWV) {
            const int item = order_item(m), p = m % NP, k = m / NP;
            const float gcl = wait_item(item_flag1(A, item), ep);
            __builtin_amdgcn_fence(__ATOMIC_ACQUIRE, "agent");
            const float* ats = (const float*)((const unsigned char*)A->out + DO_ATS + ((size_t)p * 8 + (k & 7)) * ATS_ITEM);
            if (pmode & 16) { if (lane == 0) __hip_atomic_store(item_granule(A, item), ((unsigned long long)ep << 32), __ATOMIC_RELAXED, __HIP_MEMORY_SCOPE_AGENT); }
            else prep_stage2(A, item, gcl, ats, (LAS float*)(lds + wave * 16384), ep);
        }
        return;
    }
    const int p = wg - NSCAN - NINV_WG;
    {
        const int ntot = p < N_ITEMS ? (N_ITEMS - 1 - p) / NP + 1 : 0;
        S1Pre P;
        if (ntot > 0) stage1_issue(A, order_item(p), P);
        int prev = -1;
#pragma unroll 1
        for (int k = 0; k < ntot; ++k) {
            const int m = p + NP * k, item = order_item(m), nxt = k + 1 < ntot ? order_item(m + NP) : N_ITEMS;
            float* ats = (float*)((unsigned char*)A->out + DO_ATS + ((size_t)p * 8 + (k & 7)) * ATS_ITEM);
            prep_stage1(A, item, nxt, prev, k >= 8 ? order_item(m - 8 * NP) : -1, k & 1, ats, P, lds, ep, pmode);
            prev = item;
        }
        asm volatile("s_waitcnt vmcnt(0)" ::: "memory"); __syncthreads();
        if (prev >= 0 && tid == 0) __hip_atomic_store(item_flag1(A, prev), ((unsigned long long)ep << 32) | (unsigned long long)__float_as_uint(((const LAS float*)(lds + LDS_GCL))[(ntot - 1) & 1]), __ATOMIC_RELAXED, __HIP_MEMORY_SCOPE_AGENT);
    }
    if (pmode & 1) return;
    for (int u = p; u < NBATCH * NKV * 32; u += NP) attn_unit(A, u, lds);
    const int worker = p * NWAVES + wave, NW = NP * NWAVES;
    LAS float* wl = (LAS float*)(lds + 98304 + wave * 4096);
    for (int it = worker; it < SBATCH * NHB * 4 + SBATCH * NHA; it += NW) {
        if (it < SBATCH * NHB * 4) scan_seq(A, N_PROMPT_SEQ + (it >> 2), it & 3, lane, ep);
        else { const int q = it - SBATCH * NHB * 4; sample_attn(A, q >> 3, q & 7, wl, lane); }
    }
}

DI void p3b_gated_norm(KA A) {
    const int tid = threadIdx.x, lane = tid & 63, wave = tid >> 6, gw = blockIdx.x * NWAVES + wave, NGW = gridDim.x * NWAVES;
    const int head = lane >> 4, dv0 = 8 * (lane & 15);
    const f32x4 w0 = *(const f32x4*)(A->gdn_norm + dv0), w1 = *(const f32x4*)(A->gdn_norm + dv0 + 4);
    bf16* OBg = (bf16*)((unsigned char*)A->out + DO_OB); const bf16* Zg = (const bf16*)(A->ws + WS_Z);
    for (int crow = gw; crow < MC; crow += NGW) {
        const u32x4 ow = *(const u32x4*)(OBg + (size_t)crow * OAB_PITCH + head * 128 + dv0);
        const f32x4 a = {bflo(ow.x), bfhi(ow.x), bflo(ow.y), bfhi(ow.y)}, c = {bflo(ow.z), bfhi(ow.z), bflo(ow.w), bfhi(ow.w)};
        float ss = (a[0] * a[0] + a[1] * a[1]) + (a[2] * a[2] + a[3] * a[3]) + (c[0] * c[0] + c[1] * c[1]) + (c[2] * c[2] + c[3] * c[3]);
        ss += __shfl_xor(ss, 1); ss += __shfl_xor(ss, 2); ss += __shfl_xor(ss, 4); ss += __shfl_xor(ss, 8);
        const float rstd = rsqrtf(ss * (1.0f / 128.0f) + EPS);
        const u32x4 zw = *(const u32x4*)(Zg + (size_t)pg8::crow_to_urow(crow) * 512 + head * 128 + dv0);
        f32x4 y0, y1;
        y0[0] = a[0] * rstd * w0[0] * siluf_(bflo(zw.x)); y0[1] = a[1] * rstd * w0[1] * siluf_(bfhi(zw.x)); y0[2] = a[2] * rstd * w0[2] * siluf_(bflo(zw.y)); y0[3] = a[3] * rstd * w0[3] * siluf_(bfhi(zw.y));
        y1[0] = c[0] * rstd * w1[0] * siluf_(bflo(zw.z)); y1[1] = c[1] * rstd * w1[1] * siluf_(bfhi(zw.z)); y1[2] = c[2] * rstd * w1[2] * siluf_(bflo(zw.w)); y1[3] = c[3] * rstd * w1[3] * siluf_(bfhi(zw.w));
        *(u32x4*)(OBg + (size_t)crow * OAB_PITCH + head * 128 + dv0) = pack8f(y0, y1);
    }
}
DI void p8_final_norm(KA A) {
    const int tid = threadIdx.x, lane = tid & 63, wave = tid >> 6, gw = blockIdx.x * NWAVES + wave, NGW = gridDim.x * NWAVES;
    f32x4 nf[4];
#pragma unroll
    for (int j = 0; j < 4; ++j) nf[j] = ((const f32x4*)A->norm_final)[lane + 64 * j];
    for (int crow = gw; crow < MC; crow += NGW) {
        f32x4* row = (f32x4*)(A->out + (size_t)crow * D);
        f32x4 v[4]; float ss = 0.f;
#pragma unroll
        for (int j = 0; j < 4; ++j) { v[j] = row[lane + 64 * j]; ss += (v[j][0] * v[j][0] + v[j][1] * v[j][1]) + (v[j][2] * v[j][2] + v[j][3] * v[j][3]); }
        const float rstd = rsqrtf(wave_sum(ss) * (1.0f / D) + EPS);
#pragma unroll
        for (int j = 0; j < 4; ++j) row[lane + 64 * j] = v[j] * rstd * nf[j];
    }
}
__global__ void __launch_bounds__(NTHREADS, 2) hybrid_fwd(Args Aval) {
    extern __shared__ __attribute__((aligned(16))) unsigned char lds_raw[];
    LAS unsigned char* lds = (LAS unsigned char*)lds_raw;
    const int tid = threadIdx.x;
    int lo, hi; { KA A0 = kargs(); lo = A0->ph_lo; hi = A0->ph_hi; }
#if MK_N_LAUNCHES == 1
#if MK_BARRIER == 1
    volatile LAS unsigned* MISC = (volatile LAS unsigned*)(lds + LDS_MISC);
    if (tid < 64) MISC[tid] = 0u;
    __syncthreads();
    XcdBarrier bar; { KA A0 = kargs(); bar = xcd_barrier_post((unsigned*)(A0->ws + WS_CTL) + 4096, MISC + 8); }
#define GRID_BAR() xcd_barrier(bar)
#else
    cg::grid_group grid = cg::this_grid();
#define GRID_BAR() grid.sync()
#endif
#else
#define GRID_BAR() do {} while (0)
#endif
#ifndef PH_MASK
#define PH_MASK 0x1ff
#endif
#define IN(k) (((PH_MASK >> (k)) & 1) && lo <= (k) && (k) < hi)
#ifndef PROBE_REP
#define PROBE_REP -1
#endif
#define NREP(k) (PROBE_REP == (k) ? 2 : 1)
#define SEAM(k) do { if (IN(k) && IN((k) + 1)) GRID_BAR(); } while (0)
    const int G = gridDim.x, wgid = blockIdx.x;
#if PROBE_REP == 0
    if (IN(0)) { KA A = kargs(); p0_prologue(A, lds); __syncthreads(); }
#endif
    if (IN(0)) { KA A = kargs(); p0_prologue(A, lds); } SEAM(0);
    if (IN(1)) for (int rep = 0; rep < NREP(1); ++rep) { KA A = kargs(); unsigned char* ws = A->ws;
        pg8::Gemm g{(const bf16*)(ws + WS_XN), (const bf16*)(ws + WS_WIN), MUP, NIN, D}; pg8::StaticOrder S; S.init(MUP, NIN, G, wgid);
        pg8::EpiInProj E{(bf16*)(ws + WS_QA), (bf16*)(ws + WS_KV), (bf16*)(ws + WS_QKVB), (bf16*)(ws + WS_Z), (bf16*)(ws + WS_G),
                         (const float*)(ws + WS_ROPE), (const float*)(ws + WS_ROPE) + (TP + TS) * 32, A->out};
        pg8::gemm_phase<pg8::EpiInProj, pg8::StaticOrder, true, true>(lds, g, S, E);
    } SEAM(1);
#ifndef PROBE_MODE
#define PROBE_MODE 0
#endif
#if PROBE_REP == 2
    if (IN(2)) { KA A = kargs(); p23_mixers(A, lds, bar, 1u); GRID_BAR(); }
    if (IN(2)) { KA A = kargs(); p23_mixers(A, lds, bar, 2u, PROBE_MODE); } SEAM(2);
#else
    if (IN(2)) { KA A = kargs(); p23_mixers(A, lds, bar, 1u); } SEAM(2);
#endif
    if (IN(3)) for (int rep = 0; rep < NREP(3); ++rep) { KA A = kargs(); p3b_gated_norm(A); } SEAM(3);
    if (IN(4)) for (int rep = 0; rep < NREP(4); ++rep) { KA A = kargs(); unsigned char* ws = A->ws;
        const bf16* OABp = (const bf16*)((unsigned char*)A->out + DO_OA); const bf16* Wm = (const bf16*)(ws + WS_WOA);
        { pg8::Gemm g{OABp, Wm, MC, D, 512, 1024}; pg8::StaticOrder S; S.init(MC, D, G, wgid); S.lim = (S.nwg / G) * G;
          pg8::EpiMerge<false> E{(bf16*)(ws + WS_MB), (const bf16*)(ws + WS_G), 0};
          pg8::gemm_phase<pg8::EpiMerge<false>, pg8::StaticOrder, true, true>(lds, g, S, E); }
        asm volatile("s_waitcnt vmcnt(0)" ::: "memory"); __syncthreads();
        { pg8::Gemm g{OABp + 512, Wm + 512, MC, D, 512, 1024}; pg8::StaticOrder S; S.init(MC, D, G, wgid); S.lim = (S.nwg / G) * G;
          pg8::EpiMerge<true> E{(bf16*)(ws + WS_MB), (const bf16*)(ws + WS_G), 1024};
          pg8::gemm_phase<pg8::EpiMerge<true>, pg8::StaticOrder, true, true>(lds, g, S, E); }
        { const int nstr = (MC / 256) * 4 - ((MC / 256) * 4 / G) * G;
          if (wgid < nstr * 4) { const int t = wgid >> 2, sl = wgid & 3, koff = sl * 256;
            pg8::Gemm g{OABp + koff, Wm + koff, MC, D, 256, 1024};
            pg8::SliceOrder S; S.init_slice(MC, D, G, ((MC / 256) * 4 / G) * G, t);
            pg8::EpiSplit<pg8::EpiStoreMB, true> E{pg8::EpiStoreMB{(bf16*)(ws + WS_MB)}, (float*)(ws + WS_SCR) + (size_t)t * 65536, (unsigned*)(ws + WS_CTL + CTL_SPL) + t * 8, 4u, (const bf16*)(ws + WS_G), (sl >> 1) ? 1024 : 0};
            pg8::gemm_phase<pg8::EpiSplit<pg8::EpiStoreMB, true>, pg8::SliceOrder, true, true>(lds, g, S, E); } }
    } SEAM(4);
    if (IN(5)) { KA A = kargs(); unsigned char* ws = A->ws;
        { pg8::Gemm g{(const bf16*)(ws + WS_MB), (const bf16*)(ws + WS_WOUT), MC, D, D}; pg8::StaticOrder S; S.init(MC, D, G, wgid); S.lim = (S.nwg / G) * G;
          pg8::EpiWout<true> E{A->x_prompt, A->x_sample, (bf16*)(ws + WS_HB1), (float*)(ws + WS_CTL + CTL_SS1)};
          pg8::gemm_phase<pg8::EpiWout<true>, pg8::StaticOrder, true, true>(lds, g, S, E); }
        { const int nstr = (MC / 256) * 4 - ((MC / 256) * 4 / G) * G;
          if (wgid < nstr * 4) { const int t = wgid >> 2, koff = (wgid & 3) * 256;
            pg8::Gemm g{(const bf16*)(ws + WS_MB) + koff, (const bf16*)(ws + WS_WOUT) + koff, MC, D, 256, D};
            pg8::SliceOrder S; S.init_slice(MC, D, G, ((MC / 256) * 4 / G) * G, t);
            pg8::EpiSplit<pg8::EpiWout<true>, false> E{pg8::EpiWout<true>{A->x_prompt, A->x_sample, (bf16*)(ws + WS_HB1), (float*)(ws + WS_CTL + CTL_SS1)}, (float*)(ws + WS_SCR) + (size_t)t * 65536, (unsigned*)(ws + WS_CTL + CTL_SPL) + t * 8, 4u, nullptr, 0};
            pg8::gemm_phase<pg8::EpiSplit<pg8::EpiWout<true>, false>, pg8::SliceOrder, true, true>(lds, g, S, E); } }
    } SEAM(5);
    if (IN(6)) for (int rep = 0; rep < NREP(6); ++rep) { KA A = kargs(); unsigned char* ws = A->ws;
        pg8::Gemm g{(const bf16*)(ws + WS_HB1), (const bf16*)(ws + WS_WGU), MC, 2 * DFF, D}; pg8::StaticOrder S; S.init(MC, 2 * DFF, G, wgid);
        pg8::EpiGateUp E{(bf16*)(ws + WS_ACT), (const float*)(ws + WS_CTL + CTL_SS1)};
        pg8::gemm_phase<pg8::EpiGateUp, pg8::StaticOrder, true, true>(lds, g, S, E);
    } SEAM(6);
    if (IN(7)) for (int rep = 0; rep < NREP(7); ++rep) { KA A = kargs(); unsigned char* ws = A->ws;
        { pg8::Gemm g{(const bf16*)(ws + WS_ACT), (const bf16*)(ws + WS_WD), MC, D, DFF}; pg8::StaticOrder S; S.init(MC, D, G, wgid); S.lim = (S.nwg / G) * G;
          pg8::EpiDown<false> E{(const bf16*)(ws + WS_HB1), A->out};
          pg8::gemm_phase<pg8::EpiDown<false>, pg8::StaticOrder, true, true>(lds, g, S, E); }
        { const int nstr = (MC / 256) * 4 - ((MC / 256) * 4 / G) * G;
          if (wgid < nstr * 11) { const int t = wgid / 11, koff = (wgid % 11) * 256;
            pg8::Gemm g{(const bf16*)(ws + WS_ACT) + koff, (const bf16*)(ws + WS_WD) + koff, MC, D, 256, DFF};
            pg8::SliceOrder S; S.init_slice(MC, D, G, ((MC / 256) * 4 / G) * G, t);
            pg8::EpiSplit<pg8::EpiDown<false>, false> E{pg8::EpiDown<false>{(const bf16*)(ws + WS_HB1), A->out}, (float*)(ws + WS_SCR) + (size_t)t * 65536, (unsigned*)(ws + WS_CTL + CTL_SPL) + t * 8, 11u, nullptr, 0};
            pg8::gemm_phase<pg8::EpiSplit<pg8::EpiDown<false>, false>, pg8::SliceOrder, true, true>(lds, g, S, E); } }
    } SEAM(7);
    if (IN(8)) { KA A = kargs(); p8_final_norm(A); }
#undef IN
#undef SEAM
}

extern "C" void kernel_launch(void* const* d_in, const int* in_sizes, int n_in, void* d_out, int out_size, void* d_ws, size_t ws_size, hipStream_t stream) {
    static int grid = 0;
    if (grid == 0) {
        if (n_in != 22 || out_size != (int)O_END || ws_size < WS_END) { fprintf(stderr, "kernel_launch: unexpected problem (n_in %d, out %d, ws %zu)\n", n_in, out_size, ws_size); grid = -1; return; }
        int dev = 0, cus = 0, per_cu = 0;
        if (hipGetDevice(&dev) != hipSuccess || hipDeviceGetAttribute(&cus, hipDeviceAttributeMultiprocessorCount, dev) != hipSuccess) { grid = -1; return; }
        if (hipFuncSetAttribute((const void*)hybrid_fwd, hipFuncAttributeMaxDynamicSharedMemorySize, LDS_BYTES) != hipSuccess) { fprintf(stderr, "kernel_launch: hipFuncSetAttribute failed\n"); grid = -1; return; }
        if (hipOccupancyMaxActiveBlocksPerMultiprocessor(&per_cu, (const void*)hybrid_fwd, NTHREADS, LDS_BYTES) != hipSuccess || per_cu < 1) { fprintf(stderr, "kernel_launch: occupancy query says %d\n", per_cu); per_cu = 1; }
        (void)hipGetLastError();
        grid = cus;
        if (grid > 256) grid = 256;
    }
    if (grid < 0) return;
    (void)hipMemsetAsync((char*)d_ws + WS_CTL, 0, CTL_BYTES, stream);
    (void)hipMemsetAsync((char*)d_ws + WS_SCR, 0, SCR_BYTES, stream);
    Args a{};
    const float** ap = (const float**)&a;
    for (int i = 0; i < 22; ++i) ap[i] = (const float*)d_in[i];
    a.out = (float*)d_out; a.ws = (unsigned char*)d_ws;
#if MK_N_LAUNCHES == 1
    a.ph_lo = 0; a.ph_hi = N_PHASES;
#if MK_BARRIER == 1
    hipLaunchKernelGGL(hybrid_fwd, dim3(grid), dim3(NTHREADS), LDS_BYTES, stream, a);
#else
    void* args[] = {&a};
    hipError_t e = hipLaunchCooperativeKernel((const void*)hybrid_fwd, dim3(grid), dim3(NTHREADS), args, LDS_BYTES, stream);
    if (e != hipSuccess) fprintf(stderr, "cooperative launch failed: %s (grid %d)\n", hipGetErrorString(e), grid);
#endif
#else
    for (int p = 0; p < N_PHASES; ++p) { a.ph_lo = p; a.ph_hi = p + 1; hipLaunchKernelGGL(hybrid_fwd, dim3(grid), dim3(NTHREADS), LDS_BYTES, stream, a); }
#endif
}
```

```cpp
#include <hip/hip_runtime.h>
#include <hip/hip_cooperative_groups.h>
#include <cstdio>
#include <cstdint>
namespace cg = cooperative_groups;

#ifndef MK_N_LAUNCHES
#define MK_N_LAUNCHES 1
#endif
#ifndef MK_BARRIER
#define MK_BARRIER 1
#endif

constexpr int D = 1024, NBATCH = 8, SEQ = 4096, NMETA = 16, TP = SEQ + NMETA, MP = NBATCH * TP;
constexpr int SBATCH = 128, TS = 4, MS = SBATCH * TS, MU = MP + MS, MUP = 33536, MC = NBATCH * SEQ + MS;
constexpr int PAST = 16384;
constexpr int HD = 64, NHA = 8, NKV = 2;
constexpr int NHB = 4, CONVD = 1536;
constexpr int DFF = 2816, NIN_SRC = 4872, NIN = 4864;
constexpr float EPS = 1e-6f;
constexpr float QSCALE = 0.125f * 1.4426950408889634f;

constexpr size_t MiB = 1u << 20, KiB = 1024;
constexpr size_t WS_CTL = 0, CTL_BYTES = 1 * MiB;
constexpr size_t WS_WIN = 1 * MiB;
constexpr size_t WS_WOA = 11 * MiB, WS_WOB = 12 * MiB;
constexpr size_t WS_WOUT = 13 * MiB;
constexpr size_t WS_WGU = 15 * MiB;
constexpr size_t WS_WD = 26 * MiB;
constexpr size_t WS_ROPE = 32 * MiB;
constexpr size_t WS_GB = 34 * MiB;
constexpr size_t WS_SC = 36 * MiB;
constexpr size_t WS_SS1 = 37 * MiB, WS_SS2 = 37 * MiB + 512 * KiB;
constexpr size_t WS_SCR = 38 * MiB, SCR_BYTES = 2 * MiB;
constexpr size_t CTL_SPL = 49152;
constexpr size_t WS_QA = 41 * MiB;
constexpr size_t WS_KV = WS_QA + (size_t)MUP * 512 * 2;
constexpr size_t WS_QKVB = WS_KV + (size_t)MUP * 256 * 2;
constexpr size_t WS_Z = WS_QKVB + (size_t)MUP * 1536 * 2;
constexpr size_t WS_G = WS_Z + (size_t)MUP * 512 * 2;
constexpr size_t WS_GEND = WS_G + (size_t)MUP * 2048 * 2;
constexpr size_t WS_B = 353 * MiB, WS_END = 512 * MiB;
static_assert(WS_GEND <= WS_B, "ws map");
constexpr size_t WS_XN = WS_B;
constexpr size_t PREP_SLOT = 80 * KiB;
constexpr int PREP_N1 = (int)((WS_END - WS_B) / PREP_SLOT);
constexpr size_t DO_OA = 44 * MiB;
constexpr int OAB_PITCH = 1024;
constexpr size_t DO_OB = DO_OA + 512 * 2;
constexpr size_t DO_ATS = DO_OA + (size_t)MC * OAB_PITCH * 2;
constexpr size_t ATS_ITEM = 3 * 32 * 32 * 4;
static_assert(DO_ATS + 212 * 8 * ATS_ITEM <= (size_t)MC * 1024 * 4, "d_out scratch map");
constexpr size_t WS_MB = WS_B;
constexpr size_t WS_HB1 = WS_B + 66 * MiB;
static_assert(WS_HB1 + (size_t)MC * 1024 * 2 <= WS_END, "ws map");
constexpr size_t WS_ACT = WS_QA;
static_assert(WS_ACT + (size_t)MC * DFF * 2 <= WS_G, "ws map");
constexpr int SL_BEK = 0, SL_BV = 16 * 1024, SL_T = 32 * 1024, SL_QKD = 40 * 1024, SL_QE = 48 * 1024, SL_KWT = 64 * 1024;
constexpr int N_PROMPT_SEQ = NBATCH * NHB, CHUNKS_P = 65, N_ITEMS_P = N_PROMPT_SEQ * CHUNKS_P, N_ITEMS = N_ITEMS_P + SBATCH * NHB;
static_assert((size_t)(N_ITEMS - PREP_N1) * PREP_SLOT <= DO_OA, "prep slots");

constexpr size_t O_YP = 0, O_YS = (size_t)NBATCH * SEQ * D, O_KP = O_YS + (size_t)MS * D, O_VP = O_KP + 8 * 128 * 2 * 64, O_DP = O_VP + 8 * 128 * 2 * 64,
                 O_CP = O_DP + 8 * 4 * 128 * 128, O_KS = O_CP + 8 * 3 * 1536, O_VS = O_KS + (size_t)128 * 128 * 2 * 64, O_DS = O_VS + (size_t)128 * 128 * 2 * 64,
                 O_CS = O_DS + (size_t)128 * 4 * 128 * 128, O_END = O_CS + (size_t)128 * 3 * 1536;
static_assert(O_END == 48074752, "d_out size");

#define DI __device__ __forceinline__
#define GAS __attribute__((address_space(1)))
#define LAS __attribute__((address_space(3)))
typedef unsigned short bf16;
typedef short bf16x8 __attribute__((ext_vector_type(8)));
typedef float f32x4 __attribute__((ext_vector_type(4)));
typedef float f32x2 __attribute__((ext_vector_type(2)));
typedef float f32x16 __attribute__((ext_vector_type(16)));
typedef unsigned u32x4 __attribute__((ext_vector_type(4)));
typedef unsigned u32x2 __attribute__((ext_vector_type(2)));
typedef __bf16 bf16x2_t __attribute__((ext_vector_type(2)));

DI unsigned cvtpk(float lo, float hi) { f32x2 v = {lo, hi}; bf16x2_t b = __builtin_convertvector(v, bf16x2_t); return __builtin_bit_cast(unsigned, b); }
DI bf16 f2bf(float f) { return (bf16)(cvtpk(f, 0.f) & 0xffffu); }
DI float bf2f(unsigned short h) { return __uint_as_float((unsigned)h << 16); }
DI float bflo(unsigned w) { return __uint_as_float(w << 16); }
DI float bfhi(unsigned w) { return __uint_as_float(w & 0xffff0000u); }
DI u32x4 pack8f(f32x4 a, f32x4 b) { u32x4 w; w.x = cvtpk(a[0], a[1]); w.y = cvtpk(a[2], a[3]); w.z = cvtpk(b[0], b[1]); w.w = cvtpk(b[2], b[3]); return w; }
DI float frcp_(float x) { return __builtin_amdgcn_rcpf(x); }
DI float sigmoidf_(float x) { return frcp_(1.0f + __builtin_amdgcn_exp2f(x * -1.4426950408889634f)); }
DI float siluf_(float x) { return x * sigmoidf_(x); }
DI void st16_sc1(void* p, u32x4 v) { asm volatile("global_store_dwordx4 %0, %1, off sc1\n\ts_nop 1" :: "v"(p), "v"(v) : "memory"); }
DI void st16_sc1f(void* p, f32x4 v) { asm volatile("global_store_dwordx4 %0, %1, off sc1\n\ts_nop 1" :: "v"(p), "v"(v) : "memory"); }
DI void st2_sc1(void* p, unsigned v) { asm volatile("global_store_short %0, %1, off sc1\n\ts_nop 1" :: "v"(p), "v"(v) : "memory"); }
constexpr size_t CTL_GRAN = 65536, CTL_CNT = 245760, CTL_SS1 = 458752;
static_assert(CTL_CNT + 5 * 130 * 256 <= CTL_SS1 && CTL_SS1 + 33280 * 4 <= 1048576 && CTL_GRAN + 2592 * 64 <= CTL_CNT, "control region map");
constexpr int CNT_STRIDE = 130 * 64;
DI int pos_of_d(int d) { const int dd = d & 31; return 8 * (dd >> 2) + (dd & 3) + ((d >> 5) << 2); }
DI int d_of_pos(int p) { const int j = p & 7; return 4 * (p >> 3) + (j & 3) + ((j >> 2) << 5); }
namespace pg8 {
#define PG8_LAS __attribute__((address_space(3)))
typedef unsigned short bf16_t;
typedef short bf16x8 __attribute__((ext_vector_type(8)));
typedef float f32x4 __attribute__((ext_vector_type(4)));
typedef unsigned u32x4 __attribute__((ext_vector_type(4)));
constexpr int BM = 256, BK = 64, HALF = 128, HTB = HALF * BK * 2  , STAGE_BYTES = 8 * HTB, NXCD = 8, WGM = 8;

__host__ __device__ __forceinline__ int lds_byte(int r, int c) { const int st = (r >> 4) * 2 + (c >> 5), rr = r & 15, cc = c & 31, ob = rr * 64 + cc * 2; return st * 1024 + (ob ^ (((ob >> 9) & 1) << 5)); }
__host__ __device__ __forceinline__ void stage_rc(int b, int& R, int& C) { const int st = b / 1024, sb = b % 1024, swz = sb ^ (((sb >> 9) & 1) << 5); R = (st >> 1) * 16 + swz / 64; C = (st & 1) * 32 + (swz % 64) / 2; }
__host__ __device__ __forceinline__ int perm32(int rho) { const int n = rho >> 4, i = rho & 15; return 8 * (i >> 2) + 4 * n + (i & 3); }

struct Unit { int pm, pn; };
struct Gemm { const bf16_t* A; const bf16_t* Bt; int M, N, K; int ldk; };

struct StaticOrder {
    static constexpr bool A_SC1 = false;
    int nM, nN, nwg, G, c, lim;
    __host__ __device__ void init(int M, int N, int G_, int c_) { nM = M / BM; nN = N / BM; nwg = nM * nN; G = G_; c = c_; lim = nwg; }
    __host__ __device__ bool next(int i, Unit& u) const {
        const long L = (long)i * G + c; if (L >= lim) return false;
        int wgid = (int)L; { const int q = nwg / NXCD, r = nwg % NXCD, xcd = wgid % NXCD, off = wgid / NXCD; wgid = (xcd < r ? xcd * (q + 1) : r * (q + 1) + (xcd - r) * q) + off; }
        const int nig = WGM * nN, gid = wgid / nig, fm = gid * WGM, gsz = (nM - fm) < WGM ? (nM - fm) : WGM;
        u.pm = fm + ((wgid % nig) % gsz); u.pn = (wgid % nig) / gsz; return true;
    }
    __device__ __forceinline__ void a_ready(const Unit&) const {}
    __device__ __forceinline__ void done(const Unit&) const {}
};
struct FlagOrder : StaticOrder {
    static constexpr bool A_SC1 = true;
    const unsigned* ready; unsigned need; unsigned* pub; unsigned* gpub;
    __device__ __forceinline__ void a_ready(const Unit& u) const {
        if (ready) {
            if (threadIdx.x < 64) { unsigned spins = 0;
                while ((unsigned)__builtin_amdgcn_readfirstlane(__hip_atomic_load(ready + 64 * u.pm, __ATOMIC_RELAXED, __HIP_MEMORY_SCOPE_AGENT)) < need) { __builtin_amdgcn_s_sleep(2); if (++spins > (1u << 22)) break; } }
            asm volatile("" ::: "memory"); __builtin_amdgcn_s_barrier(); asm volatile("" ::: "memory");
        }
    }
    __device__ __forceinline__ void done(const Unit& u) const {
        if (pub) { asm volatile("s_waitcnt vmcnt(0)" ::: "memory");
            if ((threadIdx.x & 63) == 0) { __hip_atomic_fetch_add(pub + 64 * u.pm, 1u, __ATOMIC_RELAXED, __HIP_MEMORY_SCOPE_AGENT); if (gpub) __hip_atomic_fetch_add(gpub, 1u, __ATOMIC_RELAXED, __HIP_MEMORY_SCOPE_AGENT); } }
    }
};
struct SliceOrder : StaticOrder {
    int t;
    __host__ __device__ void init_slice(int M, int N, int G_, int first, int t_) { init(M, N, G_, 0); t = t_; c = first + t_; G = 0; }
    __host__ __device__ bool next(int i, Unit& u) const { return i == 0 ? StaticOrder::next(0, u) : false; }
};

__device__ __forceinline__ void urow_info(int urow, int& kind, int& b, int& t, int& ridx) {
    if (urow < MP) { b = urow / TP; t = urow - b * TP; kind = 0; ridx = t; }
    else if (urow < MU) { const int s = urow - MP; b = s >> 2; t = s & 3; kind = 1; ridx = TP + t; }
    else { kind = 2; b = 0; t = 0; ridx = 0; }
}
__device__ __forceinline__ int crow_to_urow(int crow) { return crow < NBATCH * SEQ ? crow + NMETA * ((crow >> 12) + 1) : MP + (crow - NBATCH * SEQ); }

struct EpiInProj {
    static constexpr bool PERM = true, AFTER_DRAIN = false;
    bf16_t *QA, *KV, *QKVB, *Z, *G; const float *COS, *SIN; float* out;
    __device__ __forceinline__ void operator()(const f32x4 (&acc)[2][2][4][2], const Unit& u, int wr, int wc, int fr, int fq) const {
        const int pn = u.pn;
#pragma unroll
        for (int ai = 0; ai < 2; ++ai)
#pragma unroll
            for (int m = 0; m < 4; ++m) {
                const int row = u.pm * BM + ai * HALF + wr * 64 + m * 16 + fr;
                int kind, b, t, ridx; urow_info(row, kind, b, t, ridx);
#pragma unroll
                for (int bj = 0; bj < 2; ++bj) {
                    const int cl = bj * HALF + wc * 32 + 8 * fq;
                    const f32x4 v0 = acc[ai][bj][m][0], v1 = acc[ai][bj][m][1];
                    if (pn < 2) {
                        const int c = pn * 256 + cl, d0 = ((c & 63) >> 3) * 4;
                        const f32x4 cs = *(const f32x4*)(COS + ridx * 32 + d0), sn = *(const f32x4*)(SIN + ridx * 32 + d0);
                        const f32x4 o1 = (v0 * cs - v1 * sn) * QSCALE, o2 = (v1 * cs + v0 * sn) * QSCALE;
                        *(u32x4*)(QA + (size_t)row * 512 + c) = pack8f(o1, o2);
                    } else if (pn == 2) {
                        if (bj == 0) {
                            const int kh = cl >> 6, d0 = ((cl & 63) >> 3) * 4;
                            const f32x4 cs = *(const f32x4*)(COS + ridx * 32 + d0), sn = *(const f32x4*)(SIN + ridx * 32 + d0);
                            const f32x4 o1 = v0 * cs - v1 * sn, o2 = v1 * cs + v0 * sn;
                            *(u32x4*)(KV + (size_t)row * 256 + cl) = pack8f(o1, o2);
                            float* dst = nullptr;
                            if (kind == 0 && t >= TP - 128) dst = out + O_KP + ((size_t)(b * 128 + (t - (TP - 128))) * 2 + kh) * 64;
                            else if (kind == 1) dst = out + O_KS + ((size_t)(b * 128 + 124 + t) * 2 + kh) * 64;
                            if (dst) { *(f32x4*)(dst + d0) = o1; *(f32x4*)(dst + 32 + d0) = o2; }
                        } else {
                            const int cv = cl - 128, kh = cv >> 6, dd = cv & 63;
                            *(u32x4*)(KV + (size_t)row * 256 + cl) = pack8f(v0, v1);
                            float* dst = nullptr;
                            if (kind == 0 && t >= TP - 128) dst = out + O_VP + ((size_t)(b * 128 + (t - (TP - 128))) * 2 + kh) * 64;
                            else if (kind == 1) dst = out + O_VS + ((size_t)(b * 128 + 124 + t) * 2 + kh) * 64;
                            if (dst) { *(f32x4*)(dst + dd) = v0; *(f32x4*)(dst + dd + 4) = v1; }
                        }
                    } else if (pn < 9) {
                        const int c = (pn - 3) * 256 + cl;
                        *(u32x4*)(QKVB + (size_t)row * 1536 + c) = pack8f(v0, v1);
                        float* dst = nullptr;
                        if (kind == 0 && t >= TP - 3) dst = out + O_CP + ((size_t)b * 3 + (t - (TP - 3))) * 1536;
                        else if (kind == 1 && t >= 1) dst = out + O_CS + ((size_t)b * 3 + (t - 1)) * 1536;
                        if (dst) { *(f32x4*)(dst + c) = v0; *(f32x4*)(dst + c + 4) = v1; }
                    } else if (pn < 11) {
                        const int c = (pn - 9) * 256 + cl;
                        *(u32x4*)(Z + (size_t)row * 512 + c) = pack8f(v0, v1);
                    } else {
                        const int c = (pn - 11) * 256 + cl;
                        f32x4 g0, g1;
#pragma unroll
                        for (int e = 0; e < 4; ++e) { g0[e] = sigmoidf_(v0[e]); g1[e] = sigmoidf_(v1[e]); }
                        *(u32x4*)(G + (size_t)row * 2048 + c) = pack8f(g0, g1);
                    }
                }
            }
    }
};

template <bool ACCUM> struct EpiMerge {
    static constexpr bool PERM = true, AFTER_DRAIN = false;
    bf16_t* MBp; const bf16_t* G; int gate_off;
    __device__ __forceinline__ void operator()(const f32x4 (&acc)[2][2][4][2], const Unit& u, int wr, int wc, int fr, int fq) const {
#pragma unroll
        for (int ai = 0; ai < 2; ++ai)
#pragma unroll
            for (int m = 0; m < 4; ++m) {
                const int crow = u.pm * BM + ai * HALF + wr * 64 + m * 16 + fr, urow = crow_to_urow(crow);
#pragma unroll
                for (int bj = 0; bj < 2; ++bj) {
                    const int c = u.pn * BM + bj * HALF + wc * 32 + 8 * fq;
                    const u32x4 gw = *(const u32x4*)(G + (size_t)urow * 2048 + gate_off + c);
                    f32x4 v0 = acc[ai][bj][m][0], v1 = acc[ai][bj][m][1];
                    v0[0] *= bflo(gw.x); v0[1] *= bfhi(gw.x); v0[2] *= bflo(gw.y); v0[3] *= bfhi(gw.y);
                    v1[0] *= bflo(gw.z); v1[1] *= bfhi(gw.z); v1[2] *= bflo(gw.w); v1[3] *= bfhi(gw.w);
                    bf16_t* p = MBp + (size_t)crow * 1024 + c;
                    if (ACCUM) { const u32x4 pw = *(const u32x4*)p;
                        v0[0] += bflo(pw.x); v0[1] += bfhi(pw.x); v0[2] += bflo(pw.y); v0[3] += bfhi(pw.y);
                        v1[0] += bflo(pw.z); v1[1] += bfhi(pw.z); v1[2] += bflo(pw.w); v1[3] += bfhi(pw.w); }
                    *(u32x4*)p = pack8f(v0, v1);
                }
            }
    }
};

template <bool ATOM = true> struct EpiWout {
    static constexpr bool PERM = true, AFTER_DRAIN = false;
    const float* xp; const float* xs; bf16_t* HB; float* SS;
    __device__ __forceinline__ void operator()(const f32x4 (&acc)[2][2][4][2], const Unit& u, int wr, int wc, int fr, int fq) const {
#pragma unroll
        for (int ai = 0; ai < 2; ++ai)
#pragma unroll
            for (int m = 0; m < 4; ++m) {
                const int crow = u.pm * BM + ai * HALF + wr * 64 + m * 16 + fr;
                const float* hs = crow < NBATCH * SEQ ? xp + (size_t)crow * D : xs + (size_t)(crow - NBATCH * SEQ) * D;
                float ss = 0.f;
#pragma unroll
                for (int bj = 0; bj < 2; ++bj) {
                    const int c = u.pn * BM + bj * HALF + wc * 32 + 8 * fq;
                    const f32x4 r0 = *(const f32x4*)(hs + c) + acc[ai][bj][m][0], r1 = *(const f32x4*)(hs + c + 4) + acc[ai][bj][m][1];
                    *(u32x4*)(HB + (size_t)crow * D + c) = pack8f(r0, r1);
                    ss += (r0[0] * r0[0] + r0[1] * r0[1]) + (r0[2] * r0[2] + r0[3] * r0[3]) + (r1[0] * r1[0] + r1[1] * r1[1]) + (r1[2] * r1[2] + r1[3] * r1[3]);
                }
                ss += __shfl_xor(ss, 16); ss += __shfl_xor(ss, 32);
                if (ATOM && fq == 0) atomicAdd(SS + crow, ss);
            }
    }
};

struct EpiGateUp {
    static constexpr bool PERM = true, AFTER_DRAIN = false;
    bf16_t* ACT; const float* SS;
    __device__ __forceinline__ void operator()(const f32x4 (&acc)[2][2][4][2], const Unit& u, int wr, int wc, int fr, int fq) const {
#pragma unroll
        for (int ai = 0; ai < 2; ++ai)
#pragma unroll
            for (int m = 0; m < 4; ++m) {
                const int crow = u.pm * BM + ai * HALF + wr * 64 + m * 16 + fr;
                const float rstd = rsqrtf(SS[crow] * (1.0f / D) + EPS);
                f32x4 a[2];
#pragma unroll
                for (int n = 0; n < 2; ++n)
#pragma unroll
                    for (int e = 0; e < 4; ++e) { const float g = acc[ai][0][m][n][e] * rstd, up = acc[ai][1][m][n][e] * rstd; a[n][e] = siluf_(g) * up; }
                *(u32x4*)(ACT + (size_t)crow * DFF + u.pn * HALF + wc * 32 + 8 * fq) = pack8f(a[0], a[1]);
            }
    }
};

template <bool DRY = false> struct EpiDown {
    static constexpr bool PERM = true, AFTER_DRAIN = false;
    const bf16_t* HB; bf16_t* H2;
    __device__ __forceinline__ void operator()(const f32x4 (&acc)[2][2][4][2], const Unit& u, int wr, int wc, int fr, int fq) const {
#pragma unroll
        for (int ai = 0; ai < 2; ++ai)
#pragma unroll
            for (int m = 0; m < 4; ++m) {
                const int crow = u.pm * BM + ai * HALF + wr * 64 + m * 16 + fr;
#pragma unroll
                for (int bj = 0; bj < 2; ++bj) {
                    const size_t off = (size_t)crow * D + u.pn * BM + bj * HALF + wc * 32 + 8 * fq;
                    const u32x4 hw = *(const u32x4*)(HB + off);
                    f32x4 r0 = acc[ai][bj][m][0], r1 = acc[ai][bj][m][1];
                    r0[0] += bflo(hw.x); r0[1] += bfhi(hw.x); r0[2] += bflo(hw.y); r0[3] += bfhi(hw.y);
                    r1[0] += bflo(hw.z); r1[1] += bfhi(hw.z); r1[2] += bflo(hw.w); r1[3] += bfhi(hw.w);
                    *(u32x4*)(H2 + off) = pack8f(r0, r1);
                }
            }
    }
};

template <class Inner, bool GATED = false> struct EpiSplit {
    static constexpr bool PERM = Inner::PERM, AFTER_DRAIN = false;
    Inner inner; float* scr; unsigned* cnt; unsigned S; const bf16_t* G; int gate_off;
    __device__ __forceinline__ void operator()(const f32x4 (&acc_)[2][2][4][2], const Unit& u, int wr, int wc, int fr, int fq) const {
        f32x4 (&acc)[2][2][4][2] = const_cast<f32x4 (&)[2][2][4][2]>(acc_);
        const int lane = fr + 16 * fq, wave = wr * 4 + wc;
        float* p = scr + (size_t)wave * 8192 + lane;
#pragma unroll
        for (int ai = 0; ai < 2; ++ai)
#pragma unroll
            for (int m = 0; m < 4; ++m) {
                int urow = 0;
                if (GATED) urow = crow_to_urow(u.pm * BM + ai * HALF + wr * 64 + m * 16 + fr);
#pragma unroll
                for (int bj = 0; bj < 2; ++bj) {
                    f32x4 v0 = acc[ai][bj][m][0], v1 = acc[ai][bj][m][1];
                    if (GATED) { const u32x4 gw = *(const u32x4*)(G + (size_t)urow * 2048 + gate_off + u.pn * BM + bj * HALF + wc * 32 + 8 * fq);
                        v0[0] *= bflo(gw.x); v0[1] *= bfhi(gw.x); v0[2] *= bflo(gw.y); v0[3] *= bfhi(gw.y); v1[0] *= bflo(gw.z); v1[1] *= bfhi(gw.z); v1[2] *= bflo(gw.w); v1[3] *= bfhi(gw.w); }
                    float* q = p + (((ai * 2 + bj) * 4 + m) * 8) * 64;
                    asm volatile("" : "+v"(q));
#pragma unroll
                    for (int x = 0; x < 4; ++x) { unsafeAtomicAdd(q + x * 64, v0[x]); unsafeAtomicAdd(q + (4 + x) * 64, v1[x]); }
                }
            }
        asm volatile("s_waitcnt vmcnt(0)" ::: "memory");
        unsigned old = 0u;
        if (lane == 0) old = __hip_atomic_fetch_add(cnt + wave, 1u, __ATOMIC_RELAXED, __HIP_MEMORY_SCOPE_AGENT);
        old = (unsigned)__builtin_amdgcn_readfirstlane((int)old);
        if (old == S - 1u) {
#pragma unroll
            for (int ai = 0; ai < 2; ++ai)
#pragma unroll
                for (int bj = 0; bj < 2; ++bj)
#pragma unroll
                    for (int m = 0; m < 4; ++m) {
                        float* q = p + (((ai * 2 + bj) * 4 + m) * 8) * 64;
                        asm volatile("" : "+v"(q));
#pragma unroll
                        for (int n = 0; n < 2; ++n)
#pragma unroll
                            for (int x = 0; x < 4; ++x) acc[ai][bj][m][n][x] = __hip_atomic_exchange(q + (n * 4 + x) * 64, 0.0f, __ATOMIC_RELAXED, __HIP_MEMORY_SCOPE_AGENT);
                    }
            if (lane == 0) __hip_atomic_store(cnt + wave, 0u, __ATOMIC_RELAXED, __HIP_MEMORY_SCOPE_AGENT);
            inner(acc, u, wr, wc, fr, fq);
        }
    }
};
struct EpiStoreMB {
    static constexpr bool PERM = true, AFTER_DRAIN = false;
    bf16_t* MBp;
    __device__ __forceinline__ void operator()(const f32x4 (&acc)[2][2][4][2], const Unit& u, int wr, int wc, int fr, int fq) const {
#pragma unroll
        for (int ai = 0; ai < 2; ++ai)
#pragma unroll
            for (int m = 0; m < 4; ++m) {
                const int crow = u.pm * BM + ai * HALF + wr * 64 + m * 16 + fr;
#pragma unroll
                for (int bj = 0; bj < 2; ++bj) *(u32x4*)(MBp + (size_t)crow * 1024 + u.pn * BM + bj * HALF + wc * 32 + 8 * fq) = pack8f(acc[ai][bj][m][0], acc[ai][bj][m][1]);
            }
    }
};

template <class Epi, class Sched, bool ALIGN_EPI = false, bool SP2 = false>
__device__ __forceinline__ void gemm_phase(PG8_LAS unsigned char* lds, const Gemm g, const Sched& S, const Epi& E) {
    const int tid = threadIdx.x, wid = __builtin_amdgcn_readfirstlane(tid >> 6), lane = tid & 63, wr = wid >> 2, wc = wid & 3, fr = lane & 15, fq = lane >> 4;
    const int K = g.ldk ? g.ldk : g.K, nt = g.K / BK;
    unsigned voffA[2], voffB[2];
#pragma unroll
    for (int i = 0; i < 2; ++i) { int R, C; stage_rc(tid * 16 + i * 8192, R, C); const int Rb = Epi::PERM ? ((R & ~31) + perm32(R & 31)) : R;
        voffA[i] = (unsigned)(R * K + C) * 2u; voffB[i] = (unsigned)(Rb * K + C) * 2u; }
    const size_t kstep = (size_t)(BK * 2);
    const size_t hstep = (size_t)HALF * K * 2;
    const size_t tstep = 2 * hstep;
    const unsigned ldsw = (unsigned)wid * 1024u;
    const int aoff = lds_byte(wr * 64 + fr, fq * 8), boff = lds_byte(wc * 32 + fr, fq * 8);
#define PG8_SA(b, h) (((b) * 2 + (h)) * HTB)
#define PG8_SB(b, h) ((4 + (b) * 2 + (h)) * HTB)
#define PG8_STAGE(bufoff, gbase, voff) do { _Pragma("unroll") for (int _i = 0; _i < 2; ++_i) \
        __builtin_amdgcn_global_load_lds((const unsigned*)((const char*)(gbase) + (voff)[_i]), (PG8_LAS unsigned*)(lds + (bufoff) + ldsw + _i * 8192), 16, 0, 0); } while (0)
#define PG8_STAGE_A(bufoff, gbase, voff) do { _Pragma("unroll") for (int _i = 0; _i < 2; ++_i) { \
        if constexpr (Sched::A_SC1) __builtin_amdgcn_global_load_lds((const unsigned*)((const char*)(gbase) + (voff)[_i]), (PG8_LAS unsigned*)(lds + (bufoff) + ldsw + _i * 8192), 16, 0, 16); \
        else __builtin_amdgcn_global_load_lds((const unsigned*)((const char*)(gbase) + (voff)[_i]), (PG8_LAS unsigned*)(lds + (bufoff) + ldsw + _i * 8192), 16, 0, 0); } } while (0)
#define PG8_LDA(dst, b, h) do { _Pragma("unroll") for (int m = 0; m < 4; ++m) _Pragma("unroll") for (int k = 0; k < 2; ++k) dst[m][k] = *(const PG8_LAS bf16x8*)(lds + PG8_SA(b, h) + aoff + m * 2048 + k * 1024); } while (0)
#define PG8_LDB(dst, b, h) do { _Pragma("unroll") for (int n = 0; n < 2; ++n) _Pragma("unroll") for (int k = 0; k < 2; ++k) dst[n][k] = *(const PG8_LAS bf16x8*)(lds + PG8_SB(b, h) + boff + n * 2048 + k * 1024); } while (0)
#define PG8_MMA(ai, bj, At, Bt) do { __builtin_amdgcn_s_setprio(1); _Pragma("unroll") for (int m = 0; m < 4; ++m) _Pragma("unroll") for (int n = 0; n < 2; ++n) _Pragma("unroll") for (int k = 0; k < 2; ++k) \
        acc[ai][bj][m][n] = __builtin_amdgcn_mfma_f32_16x16x32_bf16(Bt[n][k], At[m][k], acc[ai][bj][m][n], 0, 0, 0); __builtin_amdgcn_s_setprio(0); } while (0)
#define PG8_WAIT_V(n) asm volatile("s_waitcnt vmcnt(" #n ")" ::: "memory")
#define PG8_WAIT_L(n) asm volatile("s_waitcnt lgkmcnt(" #n ")" ::: "memory")
#define PG8_BAR __builtin_amdgcn_s_barrier()
#define PG8_SCHED __builtin_amdgcn_sched_barrier(0)
    Unit cur, nxt; int ui = 0;
    if (!S.next(0, cur)) return;
    f32x4 acc[2][2][4][2];
#pragma unroll
    for (int a = 0; a < 2; ++a)
#pragma unroll
        for (int b = 0; b < 2; ++b)
#pragma unroll
            for (int m = 0; m < 4; ++m)
#pragma unroll
                for (int n = 0; n < 2; ++n) acc[a][b][m][n] = (f32x4){0.f, 0.f, 0.f, 0.f};
    bf16x8 At[4][2], B0[2][2], B1[2][2];
    const char* cA = (const char*)g.A + (size_t)cur.pm * tstep; const char* cB = (const char*)g.Bt + (size_t)cur.pn * tstep;
    S.a_ready(cur);
    if constexpr (SP2) {
        PG8_STAGE(PG8_SB(0, 0), cB, voffB); PG8_STAGE(PG8_SB(0, 1), cB + hstep, voffB); PG8_STAGE_A(PG8_SA(0, 0), cA, voffA); PG8_STAGE_A(PG8_SA(0, 1), cA + hstep, voffA);
        if (wr == 1) PG8_BAR;
        PG8_WAIT_V(2); PG8_BAR;
        PG8_STAGE(PG8_SB(1, 0), cB + kstep, voffB); PG8_STAGE_A(PG8_SA(1, 0), cA + kstep, voffA); PG8_STAGE(PG8_SB(1, 1), cB + hstep + kstep, voffB);
        PG8_WAIT_V(6); PG8_BAR;
    } else {
        PG8_STAGE(PG8_SB(0, 0), cB, voffB); PG8_STAGE_A(PG8_SA(0, 0), cA, voffA); PG8_STAGE(PG8_SB(0, 1), cB + hstep, voffB); PG8_STAGE_A(PG8_SA(0, 1), cA + hstep, voffA);
        if (wr == 1) PG8_BAR;
        PG8_WAIT_V(4); PG8_BAR;
        PG8_STAGE(PG8_SB(1, 0), cB + kstep, voffB); PG8_STAGE_A(PG8_SA(1, 0), cA + kstep, voffA); PG8_STAGE(PG8_SB(1, 1), cB + hstep + kstep, voffB);
        PG8_WAIT_V(6); PG8_BAR;
    }
    for (;;) {
        const bool has_next = S.next(ui + 1, nxt);
        const char* nA = has_next ? (const char*)g.A + (size_t)nxt.pm * tstep : cA; const char* nB = has_next ? (const char*)g.Bt + (size_t)nxt.pn * tstep : cB;
        for (int t = 0; t < nt; t += 2) {
            const bool last = (t == nt - 2);
            const char* a1 = cA + (size_t)(t + 1) * kstep;
            const char* a2 = last ? nA : cA + (size_t)(t + 2) * kstep; const char* b2 = last ? nB : cB + (size_t)(t + 2) * kstep;
            const char* a3 = a2 + kstep; const char* b3 = b2 + kstep;
            if (last && has_next) S.a_ready(nxt);
            if constexpr (SP2) {
            PG8_LDB(B0, 0, 0); PG8_LDB(B1, 0, 1); PG8_SCHED; PG8_LDA(At, 0, 0); PG8_STAGE_A(PG8_SA(1, 1), a1 + hstep, voffA);
            PG8_WAIT_V(8); PG8_WAIT_L(0); PG8_BAR; PG8_MMA(0, 0, At, B0); PG8_MMA(0, 1, At, B1); PG8_BAR; PG8_SCHED;
            PG8_LDA(At, 0, 1); PG8_STAGE(PG8_SB(0, 0), b2, voffB); PG8_STAGE(PG8_SB(0, 1), b2 + hstep, voffB); PG8_STAGE_A(PG8_SA(0, 0), a2, voffA);
            PG8_WAIT_V(8); PG8_WAIT_L(0); PG8_BAR; PG8_MMA(1, 0, At, B0); PG8_MMA(1, 1, At, B1); PG8_BAR; PG8_SCHED;
            PG8_LDB(B0, 1, 0); PG8_LDB(B1, 1, 1); PG8_SCHED; PG8_LDA(At, 1, 0); PG8_STAGE_A(PG8_SA(0, 1), a2 + hstep, voffA);
            PG8_WAIT_V(8); PG8_WAIT_L(0); PG8_BAR; PG8_MMA(0, 0, At, B0); PG8_MMA(0, 1, At, B1); PG8_BAR; PG8_SCHED;
            PG8_LDA(At, 1, 1); PG8_STAGE(PG8_SB(1, 0), b3, voffB); PG8_STAGE(PG8_SB(1, 1), b3 + hstep, voffB); PG8_STAGE_A(PG8_SA(1, 0), a3, voffA);
            PG8_WAIT_V(8); PG8_WAIT_L(0); PG8_BAR; PG8_MMA(1, 0, At, B0); PG8_MMA(1, 1, At, B1); PG8_BAR; PG8_SCHED;
            } else {
            PG8_LDB(B0, 0, 0); PG8_SCHED; PG8_LDA(At, 0, 0); PG8_STAGE_A(PG8_SA(1, 1), a1 + hstep, voffA);
            PG8_WAIT_L(8); PG8_BAR; PG8_WAIT_L(0); PG8_MMA(0, 0, At, B0); PG8_BAR; PG8_SCHED;
            PG8_LDB(B1, 0, 1); PG8_STAGE(PG8_SB(0, 0), b2, voffB);
            PG8_BAR; PG8_WAIT_L(0); PG8_MMA(0, 1, At, B1); PG8_BAR;
            PG8_LDA(At, 0, 1); PG8_STAGE_A(PG8_SA(0, 0), a2, voffA);
            PG8_BAR; PG8_WAIT_L(0); PG8_MMA(1, 0, At, B0); PG8_BAR; PG8_SCHED;
            PG8_STAGE(PG8_SB(0, 1), b2 + hstep, voffB);
            PG8_WAIT_V(6); PG8_BAR; PG8_MMA(1, 1, At, B1); PG8_BAR;
            PG8_LDB(B0, 1, 0); PG8_SCHED; PG8_LDA(At, 1, 0); PG8_STAGE_A(PG8_SA(0, 1), a2 + hstep, voffA);
            PG8_WAIT_L(8); PG8_BAR; PG8_WAIT_L(0); PG8_MMA(0, 0, At, B0); PG8_BAR; PG8_SCHED;
            PG8_LDB(B1, 1, 1); PG8_STAGE(PG8_SB(1, 0), b3, voffB);
            PG8_BAR; PG8_WAIT_L(0); PG8_MMA(0, 1, At, B1); PG8_BAR;
            PG8_LDA(At, 1, 1); PG8_STAGE_A(PG8_SA(1, 0), a3, voffA);
            PG8_BAR; PG8_WAIT_L(0); PG8_MMA(1, 0, At, B0); PG8_BAR; PG8_SCHED;
            PG8_STAGE(PG8_SB(1, 1), b3 + hstep, voffB);
            PG8_WAIT_V(6); PG8_BAR; PG8_MMA(1, 1, At, B1); PG8_BAR;
            }
        }
        if constexpr (ALIGN_EPI) { if (wr == 0) PG8_BAR; }
        if constexpr (!Epi::AFTER_DRAIN) { E(acc, cur, wr, wc, fr, fq); S.done(cur); }
        if (!has_next) break;
#pragma unroll
        for (int a = 0; a < 2; ++a)
#pragma unroll
            for (int b = 0; b < 2; ++b)
#pragma unroll
                for (int m = 0; m < 4; ++m)
#pragma unroll
                    for (int n = 0; n < 2; ++n) acc[a][b][m][n] = (f32x4){0.f, 0.f, 0.f, 0.f};
        cur = nxt; cA = nA; cB = nB; ++ui;
        if constexpr (ALIGN_EPI) { if (wr == 1) PG8_BAR; }
    }
    PG8_WAIT_V(0);
    if constexpr (!ALIGN_EPI) { if (wr == 0) PG8_BAR; }
    PG8_BAR;
    if constexpr (Epi::AFTER_DRAIN) { E.fused(acc, cur, wr, wc, fr, fq, lds, wid, lane); S.done(cur); }
#undef PG8_SA
#undef PG8_SB
#undef PG8_STAGE
#undef PG8_STAGE_A
#undef PG8_LDA
#undef PG8_LDB
#undef PG8_MMA
#undef PG8_WAIT_V
#undef PG8_WAIT_L
#undef PG8_BAR
#undef PG8_SCHED
}
}
constexpr int NWAVES = 8, NTHREADS = NWAVES * 64;
constexpr int LDS_BYTES = 147456;
constexpr int LDS_MISC = 131072;
constexpr int N_PHASES = 9;

struct Args {
    const float *x_prompt, *x_sample, *cache_k, *cache_v, *state_delta, *state_conv, *meta, *norm_mix, *w_in, *conv_w, *a_log, *dt_bias, *sinks, *gdn_norm,
                *w_oa, *w_ob, *w_out, *norm_ffn, *w_gate, *w_up, *w_down, *norm_final;
    float* out; unsigned char* ws; int ph_lo, ph_hi;
};

typedef const __attribute__((address_space(4))) Args* KA;
DI KA kargs() { KA p = (KA)__builtin_amdgcn_kernarg_segment_ptr(); asm volatile("" : "+s"(p)); return p; }
#define RLX_AGENT __ATOMIC_RELAXED, __HIP_MEMORY_SCOPE_AGENT
#define LDS_WAIT() asm volatile("s_waitcnt lgkmcnt(0)" ::: "memory")
#define MFMA32(a, b, c) __builtin_amdgcn_mfma_f32_32x32x16_bf16((a), (b), (c), 0, 0, 0)
DI int crow16(int reg, int h) { return (reg & 3) + 8 * (reg >> 2) + 4 * h; }
DI float wave_sum(float v) {
#pragma unroll
    for (int o = 1; o < 64; o <<= 1) v += __shfl_xor(v, o);
    return v;
}
DI float wave_max(float v) {
#pragma unroll
    for (int o = 1; o < 64; o <<= 1) v = fmaxf(v, __shfl_xor(v, o));
    return v;
}
template <int S> DI bf16x8 pack_step(const f32x16& x) {
    u32x4 p; p.x = cvtpk(x[8 * S], x[8 * S + 1]); p.y = cvtpk(x[8 * S + 2], x[8 * S + 3]); p.z = cvtpk(x[8 * S + 4], x[8 * S + 5]); p.w = cvtpk(x[8 * S + 6], x[8 * S + 7]);
    return __builtin_bit_cast(bf16x8, p);
}
DI int frag_idx(int row, int k, int NKS) { const int kkk = k & 15; return (((row >> 5) * NKS + (k >> 4)) * 64 + (row & 31) + 32 * ((kkk >> 2) & 1)) * 8 + (((kkk >> 3) << 2) | (kkk & 3)); }
DI unsigned char* slot_ptr(KA A, int item) { return item < PREP_N1 ? A->ws + WS_B + (size_t)item * PREP_SLOT : (unsigned char*)A->out + (size_t)(item - PREP_N1) * PREP_SLOT; }

#define XB_TMO      128
#define XB_XCNT(j)  (256  + 64 * (j))
#define XB_XSUB(j)  (1280 + 64 * (j))
#define XB_XGEN(j)  (2304 + 64 * (j))
#define XB_TOP      3328
#define XB_TOPGEN   3392
#define XCD_BAR_WORDS 3456
#define XB_SPIN_CAP (1u << 20)
DI unsigned xb_ld(unsigned* p)              { return __hip_atomic_load(p, __ATOMIC_RELAXED, __HIP_MEMORY_SCOPE_AGENT); }
DI unsigned xb_add(unsigned* p, unsigned v) { return __hip_atomic_fetch_add(p, v, __ATOMIC_RELAXED, __HIP_MEMORY_SCOPE_AGENT); }
DI unsigned xb_xcc_id() { return (unsigned)__builtin_amdgcn_s_getreg((3 << 11) | 20) & 0xFu; }
#define XB_SPIN(cond, bar) do { unsigned _sp = 0; while (cond) { __builtin_amdgcn_s_sleep(1); \
    if ((++_sp & 255u) == 0u) { if (xb_ld(&(bar)[XB_TMO])) break; if (_sp > XB_SPIN_CAP) { atomicAdd(&(bar)[XB_TMO], 1u); break; } } } } while (0)
struct XcdBarrier { unsigned* bar; unsigned x; volatile LAS unsigned* st; };
DI XcdBarrier xcd_barrier_post(unsigned* bar, volatile LAS unsigned* st) {
    XcdBarrier b; b.bar = bar; b.x = xb_xcc_id(); b.st = st;
    if (threadIdx.x == 0) (void)xb_add(&bar[XB_XCNT(b.x)], 1u);
    return b;
}
DI void xcd_barrier_complete(unsigned* bar, unsigned x, unsigned& nloc, unsigned& nx) {
    const unsigned G = gridDim.x * gridDim.y * gridDim.z;
    unsigned sum, cnt, mine, sp = 0u;
    for (;;) {
        sum = 0u; cnt = 0u; mine = 0u;
#pragma unroll
        for (unsigned j = 0; j < 16; ++j) { const unsigned c = xb_ld(&bar[XB_XCNT(j)]); sum += c; cnt += (c > 0u) ? 1u : 0u; mine = (j == x) ? c : mine; }
        if (sum == G) break;
        __builtin_amdgcn_s_sleep(1);
        if ((++sp & 255u) == 0u) { if (xb_ld(&bar[XB_TMO])) break; if (sp > XB_SPIN_CAP) { atomicAdd(&bar[XB_TMO], 1u); break; } }
    }
    nloc = mine > 0u ? mine : 1u; nx = cnt > 0u ? cnt : 1u;
}
DI void xcd_barrier(const XcdBarrier& b) {
    asm volatile("s_waitcnt vmcnt(0)" ::: "memory");
    __syncthreads();
    if (threadIdx.x == 0) {
        unsigned* bar = b.bar;
        __builtin_amdgcn_s_waitcnt(0);
        unsigned nloc = b.st[0], nx = b.st[1];
        if (nloc == 0u) { xcd_barrier_complete(bar, b.x, nloc, nx); b.st[0] = nloc; b.st[1] = nx; }
        const unsigned old = xb_add(&bar[XB_XSUB(b.x)], 1u);
        const unsigned gen = old / nloc;
        if (old + 1u == (gen + 1u) * nloc) {
            __builtin_amdgcn_fence(__ATOMIC_RELEASE, "agent");
            asm volatile("s_waitcnt vmcnt(0)" ::: "memory");
            const unsigned og = xb_add(&bar[XB_TOP], 1u);
            const unsigned tg = og / nx;
            if (og + 1u == (tg + 1u) * nx) xb_add(&bar[XB_TOPGEN], 1u);
            else XB_SPIN(xb_ld(&bar[XB_TOPGEN]) == tg, bar);
            __builtin_amdgcn_fence(__ATOMIC_ACQUIRE, "agent");
            xb_add(&bar[XB_XGEN(b.x)], 1u);
            asm volatile("s_waitcnt vmcnt(0)" ::: "memory");
        } else {
            XB_SPIN(xb_ld(&bar[XB_XGEN(b.x)]) == gen, bar);
            __builtin_amdgcn_fence(__ATOMIC_ACQUIRE, "agent");
            asm volatile("s_waitcnt vmcnt(0)" ::: "memory");
        }
    }
    __syncthreads();
}

template <class RowMap> DI void transpose_item(const float* W, int K, int N, bf16* WT, RowMap rm, const float* kscale, LAS float* scr, int item, int lane, int ldw = 0) {
    if (ldw == 0) ldw = K;
    const int nblk = (N + 31) / 32, kb = item / nblk, nb = item - kb * nblk, k0 = 64 * kb, n0 = 32 * nb;
    const int n4 = n0 + (lane & 7) * 4;
    f32x4 v[8];
#pragma unroll
    for (int i = 0; i < 8; ++i) { const int kk = 8 * i + (lane >> 3);
        v[i] = n4 < N ? *(const f32x4*)(W + (size_t)(k0 + kk) * N + n4) : (f32x4){0.f, 0.f, 0.f, 0.f}; }
#pragma unroll
    for (int i = 0; i < 8; ++i) { const int kk = 8 * i + (lane >> 3);
        if (kscale) v[i] = v[i] * kscale[k0 + kk];
        LAS float* d = scr + kk * 33 + (lane & 7) * 4; d[0] = v[i][0]; d[1] = v[i][1]; d[2] = v[i][2]; d[3] = v[i][3]; }
    LDS_WAIT(); asm volatile("" ::: "memory");
    const int c = lane & 7;
#pragma unroll
    for (int j = 0; j < 4; ++j) { const int n = (lane >> 3) + 8 * j; const LAS float* s = scr + (8 * c) * 33 + n;
        const int nsrc = n0 + n; const int drow = nsrc < N ? rm(nsrc) : -1;
        u32x4 o; o.x = cvtpk(s[0 * 33], s[1 * 33]); o.y = cvtpk(s[2 * 33], s[3 * 33]); o.z = cvtpk(s[4 * 33], s[5 * 33]); o.w = cvtpk(s[6 * 33], s[7 * 33]);
        if (drow >= 0) *(u32x4*)(WT + (size_t)drow * ldw + k0 + 8 * c) = o; }
    LDS_WAIT(); asm volatile("" ::: "memory");
}
DI float softplusf_(float x) { return x > 20.f ? x : log1pf(__expf(x)); }

#ifndef PROBE_REP
#define PROBE_REP -1
#endif
DI void p0_prologue(KA A, LAS unsigned char* lds) {
    const int tid = threadIdx.x, lane = tid & 63, wave = __builtin_amdgcn_readfirstlane(tid >> 6);
    const int G = gridDim.x, gw = blockIdx.x * NWAVES + wave, NGW = G * NWAVES;
    const int gt = blockIdx.x * NTHREADS + tid, NGT = G * NTHREADS;
    unsigned char* ws = A->ws;
    for (int rep = 0; rep < (PROBE_REP == 1001 ? 2 : 1); ++rep) {
        LAS float* scr = (LAS float*)(lds + wave * 16384);
        constexpr int I_IN = 16 * 153, I_OA = 8 * 32, I_OUT = 16 * 32, I_G = 16 * 88, I_D = 44 * 32;
        constexpr int NIT = I_IN + 2 * I_OA + I_OUT + 2 * I_G + I_D;
        for (int it = gw; it < NIT; it += NGW) {
            int r = it;
            if (r < I_IN) { transpose_item(A->w_in, 1024, NIN_SRC, (bf16*)(ws + WS_WIN), [](int c) -> int {
                    if (c < 640) return (c & ~63) + pos_of_d(c & 63);
                    if (c < 2816) return c;
                    if (c < 2824) return -1;
                    return c - 8; }, nullptr, scr, r, lane); continue; } r -= I_IN;
            if (r < I_OA) { transpose_item(A->w_oa, 512, 1024, (bf16*)(ws + WS_WOA), [](int c) -> int { return c; }, nullptr, scr, r, lane, 1024); continue; } r -= I_OA;
            if (r < I_OA) { transpose_item(A->w_ob, 512, 1024, (bf16*)(ws + WS_WOA) + 512, [](int c) -> int { return c; }, nullptr, scr, r, lane, 1024); continue; } r -= I_OA;
            if (r < I_OUT) { transpose_item(A->w_out, 1024, 1024, (bf16*)(ws + WS_WOUT), [](int c) -> int { return c; }, nullptr, scr, r, lane); continue; } r -= I_OUT;
            if (r < I_G) { transpose_item(A->w_gate, 1024, DFF, (bf16*)(ws + WS_WGU), [](int c) -> int { return 256 * (c >> 7) + (c & 127); }, A->norm_ffn, scr, r, lane); continue; } r -= I_G;
            if (r < I_G) { transpose_item(A->w_up, 1024, DFF, (bf16*)(ws + WS_WGU), [](int c) -> int { return 256 * (c >> 7) + 128 + (c & 127); }, A->norm_ffn, scr, r, lane); continue; } r -= I_G;
            transpose_item(A->w_down, DFF, 1024, (bf16*)(ws + WS_WD), [](int c) -> int { return c; }, nullptr, scr, r, lane);
        }
    }
    for (int rep = 0; rep < (PROBE_REP == 1002 ? 2 : 1); ++rep) {
        float* COS = (float*)(ws + WS_ROPE); float* SIN = COS + (TP + TS) * 32;
        for (int i = gt; i < (TP + TS) * 32; i += NGT) { const int ri = i >> 5, f = i & 31; const double pos = ri < TP ? (double)ri : (double)(PAST + ri - TP);
            const double inv = exp2(-(double)f * (13.287712379549449 / 32.0)), ang = pos * inv; COS[i] = (float)cos(ang); SIN[i] = (float)sin(ang); }
        constexpr int PERB = 124 * 128 / 4;
        for (int i = gt; i < SBATCH * PERB; i += NGT) { const int b = i / PERB, o = i - b * PERB;
            ((f32x4*)(A->out + O_KS))[(size_t)b * 4096 + o] = ((const f32x4*)A->cache_k)[(size_t)b * 4096 + 128 + o];
            ((f32x4*)(A->out + O_VS))[(size_t)b * 4096 + o] = ((const f32x4*)A->cache_v)[(size_t)b * 4096 + 128 + o]; }
    }
    for (int rep = 0; rep < (PROBE_REP == 1003 ? 2 : 1); ++rep) {
        unsigned wab[16][4];
        f32x4 nm[4];
#pragma unroll
        for (int j = 0; j < 4; ++j) {
            nm[j] = ((const f32x4*)A->norm_mix)[lane + 64 * j];
#pragma unroll
            for (int e = 0; e < 4; ++e) { const float* p = A->w_in + (size_t)(4 * (lane + 64 * j) + e) * NIN_SRC + 2816;
                const f32x4 a = *(const f32x4*)p, b = *(const f32x4*)(p + 4);
                wab[j * 4 + e][0] = cvtpk(a[0], a[1]); wab[j * 4 + e][1] = cvtpk(a[2], a[3]); wab[j * 4 + e][2] = cvtpk(b[0], b[1]); wab[j * 4 + e][3] = cvtpk(b[2], b[3]); }
        }
        bf16* XN = (bf16*)(ws + WS_XN); f32x2* GB = (f32x2*)(ws + WS_GB);
        auto row_src = [&](int urow) -> const float* {
            if (urow < MP) { const int b = urow / TP, t = urow - b * TP; return t < NMETA ? A->meta + (size_t)t * D : A->x_prompt + ((size_t)b * SEQ + (t - NMETA)) * D; }
            if (urow < MU) return A->x_sample + (size_t)(urow - MP) * D;
            return nullptr; };
        f32x4 nx[4];
        { const float* s0 = gw < MUP ? row_src(gw) : nullptr;
#pragma unroll
          for (int j = 0; j < 4; ++j) nx[j] = s0 ? ((const f32x4*)s0)[lane + 64 * j] : (f32x4){0.f, 0.f, 0.f, 0.f}; }
#pragma unroll 1
        for (int urow = gw; urow < MUP; urow += NGW) {
            f32x4 v[4];
#pragma unroll
            for (int j = 0; j < 4; ++j) v[j] = nx[j];
            { const int un = urow + NGW; const float* s1 = un < MUP ? row_src(un) : nullptr;
#pragma unroll
              for (int j = 0; j < 4; ++j) nx[j] = s1 ? ((const f32x4*)s1)[lane + 64 * j] : (f32x4){0.f, 0.f, 0.f, 0.f}; }
            u32x2* o8 = (u32x2*)(XN + (size_t)urow * D) + lane;
            float ss = 0.f;
#pragma unroll
            for (int j = 0; j < 4; ++j) ss += (v[j][0] * v[j][0] + v[j][1] * v[j][1]) + (v[j][2] * v[j][2] + v[j][3] * v[j][3]);
            const float rstd = urow < MU ? rsqrtf(wave_sum(ss) * (1.0f / D) + EPS) : 0.f;
            float dot[8];
#pragma unroll
            for (int c = 0; c < 8; ++c) dot[c] = 0.f;
#pragma unroll
            for (int j = 0; j < 4; ++j) { v[j] = v[j] * rstd * nm[j];
                o8[64 * j] = (u32x2){cvtpk(v[j][0], v[j][1]), cvtpk(v[j][2], v[j][3])};
#pragma unroll
                for (int e = 0; e < 4; ++e)
#pragma unroll
                    for (int c = 0; c < 4; ++c) { dot[2 * c] += v[j][e] * bflo(wab[j * 4 + e][c]); dot[2 * c + 1] += v[j][e] * bfhi(wab[j * 4 + e][c]); } }
            float d4[4], d2[2], d1;
#pragma unroll
            for (int c = 0; c < 4; ++c) { const float keep = (lane & 32) ? dot[4 + c] : dot[c], send = (lane & 32) ? dot[c] : dot[4 + c]; d4[c] = keep + __shfl_xor(send, 32); }
#pragma unroll
            for (int c = 0; c < 2; ++c) { const float keep = (lane & 16) ? d4[2 + c] : d4[c], send = (lane & 16) ? d4[c] : d4[2 + c]; d2[c] = keep + __shfl_xor(send, 16); }
            { const float keep = (lane & 8) ? d2[1] : d2[0], send = (lane & 8) ? d2[0] : d2[1]; d1 = keep + __shfl_xor(send, 8); }
            d1 += __shfl_xor(d1, 4); d1 += __shfl_xor(d1, 2); d1 += __shfl_xor(d1, 1);
            const float a_ = __shfl(d1, ((lane & 2) ? 16 : 0) + ((lane & 1) ? 8 : 0));
            const float b_ = __shfl(d1, 32 + ((lane & 2) ? 16 : 0) + ((lane & 1) ? 8 : 0));
            if (lane < 4) {
                const float g = -__expf(A->a_log[lane]) * softplusf_(a_ + A->dt_bias[lane]);
                GB[(size_t)urow * 4 + lane] = urow < MU ? (f32x2){g, sigmoidf_(b_)} : (f32x2){0.f, 0.f};
            }
        }
    }
}
DI void item_decode(int item, int& b, int& h, bool& sample, int& t0, int& L) {
    if (item < N_ITEMS_P) { const int s = item / CHUNKS_P, c = item - s * CHUNKS_P; b = s >> 2; h = s & 3; sample = false; if (c == 0) { t0 = 0; L = NMETA; } else { t0 = NMETA + 64 * (c - 1); L = 64; } }
    else { const int s = item - N_ITEMS_P; b = s >> 2; h = s & 3; sample = true; t0 = 0; L = TS; }
}
#define LDS_BARRIER() do { asm volatile("s_waitcnt lgkmcnt(0)" ::: "memory"); __builtin_amdgcn_s_barrier(); asm volatile("" ::: "memory"); } while (0)
typedef GAS unsigned long long gu64;
constexpr size_t CTL_F1 = 655360;
static_assert(CTL_F1 + 2592 * 64 <= 1048576, "control region map");
DI gu64* item_flag1(KA A, int item) { return (gu64*)(A->ws + WS_CTL + CTL_F1 + (size_t)item * 64); }
DI int order_item(int m) { return m < N_ITEMS_P ? (m & 31) * CHUNKS_P + (m >> 5) : m; }
DI gu64* item_granule(KA A, int item) { return (gu64*)(A->ws + WS_CTL + CTL_GRAN + (size_t)item * 64); }
DI float wait_item(gu64* g, unsigned ep = 1u) {
    unsigned long long x; unsigned spins = 0;
    for (;;) { x = __hip_atomic_load(g, __ATOMIC_RELAXED, __HIP_MEMORY_SCOPE_AGENT); if ((unsigned)(x >> 32) >= ep) break; __builtin_amdgcn_s_sleep(8); if (++spins > (1u << 20)) break; }
    asm volatile("" ::: "memory");
    return __uint_as_float((unsigned)__builtin_amdgcn_readfirstlane((int)(unsigned)x));
}
constexpr int LDS_GCL = 139264;
constexpr int PITCH = 132;
DI bf16x8 frag_nat(const LAS float* src, int row, int k0) {
    const f32x4 lo = *(const LAS f32x4*)(src + row * PITCH + k0), hi = *(const LAS f32x4*)(src + row * PITCH + k0 + 4);
    return __builtin_bit_cast(bf16x8, pack8f(lo, hi));
}
struct S1Pre { u32x4 xr[11]; f32x4 w[4][2]; f32x2 gb; };
DI void stage1_issue(KA A, int item, S1Pre& P) {
    const int tid = threadIdx.x, lane = tid & 63, wave = __builtin_amdgcn_readfirstlane(tid >> 6);
    int b, h, t0, L; bool sample; item_decode(item, b, h, sample, t0, L);
    const bf16* QKVB = (const bf16*)(A->ws + WS_QKVB);
    const int cv = lane < 48 ? lane : 47, grp = cv >> 4, col0 = (cv & 15) * 8, r0 = wave * 8, cidx = grp * 512 + h * 128 + col0;
#pragma unroll
    for (int q = 0; q < 11; ++q) {
        const int i = r0 - 3 + q;
        long urow = sample ? (long)MP + b * TS + i : (long)b * TP + t0 + i;
        const bool ok = sample ? i >= 0 : t0 + i >= 0;
        if (!ok) urow = 0;
        P.xr[q] = *(const u32x4*)(QKVB + (size_t)urow * CONVD + cidx);
        if (!ok) P.xr[q] = (u32x4){0u, 0u, 0u, 0u};
    }
#pragma unroll
    for (int i = 0; i < 4; ++i) { P.w[i][0] = *(const f32x4*)(A->conv_w + i * CONVD + cidx); P.w[i][1] = *(const f32x4*)(A->conv_w + i * CONVD + cidx + 4); }
    P.gb = (f32x2){0.f, 0.f};
    if (wave == 7 && lane < L) { const int urow = sample ? MP + b * TS + lane : b * TP + t0 + lane; P.gb = ((const f32x2*)(A->ws + WS_GB))[(size_t)urow * 4 + h]; }
}
DI void prep_stage1(KA A, int item, int next_item, int prev_item, int wait_item_idx, int bslot, float* ats, S1Pre& P, LAS unsigned char* ldsb, unsigned ep, int pmode = 0) {
    const int tid = threadIdx.x, lane = tid & 63, wave = __builtin_amdgcn_readfirstlane(tid >> 6), r = lane & 31, hh = lane >> 5;
#define ST16(p, ...) __builtin_amdgcn_raw_buffer_store_b128(__builtin_bit_cast(v4u_t, (__VA_ARGS__)), rs_slot, (int)((const unsigned char*)(p) - (const unsigned char*)slot), 0, 16)
#define ST16F(p, ...) __builtin_amdgcn_raw_buffer_store_b128(__builtin_bit_cast(v4u_t, (__VA_ARGS__)), rs_ats, (int)((const unsigned char*)(p) - (const unsigned char*)ats), 0, 16)
    int b, h, t0, L; bool sample; item_decode(item, b, h, sample, t0, L);
    LAS float* Qs = (LAS float*)ldsb; LAS float* Ks = Qs + 64 * PITCH; LAS float* Vs = Ks + 64 * PITCH; LAS float* gcs = Vs + 64 * PITCH; LAS float* betas = gcs + 64;
    unsigned char* slot = slot_ptr(A, item);
    typedef unsigned v4u_t __attribute__((__vector_size__(16)));
    const __amdgpu_buffer_rsrc_t rs_slot = __builtin_amdgcn_make_buffer_rsrc((void*)slot, 0, (int)PREP_SLOT, 0x00020000);
    const __amdgpu_buffer_rsrc_t rs_ats = __builtin_amdgcn_make_buffer_rsrc((void*)ats, 0, (int)ATS_ITEM, 0x00020000);
    if (!(pmode & 8)) {
        const int cv = lane < 48 ? lane : 47, grp = cv >> 4, col0 = (cv & 15) * 8, r0 = wave * 8, cidx = grp * 512 + h * 128 + col0;
        float x[11][8];
#pragma unroll
        for (int q = 0; q < 11; ++q) { x[q][0] = bflo(P.xr[q].x); x[q][1] = bfhi(P.xr[q].x); x[q][2] = bflo(P.xr[q].y); x[q][3] = bfhi(P.xr[q].y);
                                       x[q][4] = bflo(P.xr[q].z); x[q][5] = bfhi(P.xr[q].z); x[q][6] = bflo(P.xr[q].w); x[q][7] = bfhi(P.xr[q].w); }
        if (sample && wave == 0) {
#pragma unroll
            for (int q = 0; q < 3; ++q) { const float* sp = A->state_conv + ((size_t)b * 3 + q) * CONVD + cidx; const f32x4 s0 = *(const f32x4*)sp, s1 = *(const f32x4*)(sp + 4);
                x[q][0] = s0[0]; x[q][1] = s0[1]; x[q][2] = s0[2]; x[q][3] = s0[3]; x[q][4] = s1[0]; x[q][5] = s1[1]; x[q][6] = s1[2]; x[q][7] = s1[3]; }
        }
        float w[4][8];
#pragma unroll
        for (int i = 0; i < 4; ++i) { w[i][0] = P.w[i][0][0]; w[i][1] = P.w[i][0][1]; w[i][2] = P.w[i][0][2]; w[i][3] = P.w[i][0][3]; w[i][4] = P.w[i][1][0]; w[i][5] = P.w[i][1][1]; w[i][6] = P.w[i][1][2]; w[i][7] = P.w[i][1][3]; }
        LAS float* dst = Qs + grp * 64 * PITCH + col0;
        const float nsc = grp == 0 ? 0.08838834764831845f : 1.0f;
#pragma unroll
        for (int q = 3; q < 11; ++q) {
            const int rr = r0 + q - 3;
            float v[8]; float ss = 0.f;
#pragma unroll
            for (int e = 0; e < 8; ++e) {
                const float y = __builtin_fmaf(w[3][e], x[q][e], __builtin_fmaf(w[2][e], x[q - 1][e], __builtin_fmaf(w[1][e], x[q - 2][e], w[0][e] * x[q - 3][e])));
                const float sv = siluf_(y); v[e] = sv; ss = __builtin_fmaf(sv, sv, ss); }
            ss += __builtin_bit_cast(float, __builtin_amdgcn_update_dpp(0, __builtin_bit_cast(int, ss), 0xB1, 0xF, 0xF, true));
            ss += __builtin_bit_cast(float, __builtin_amdgcn_update_dpp(0, __builtin_bit_cast(int, ss), 0x4E, 0xF, 0xF, true));
            ss += __builtin_bit_cast(float, __builtin_amdgcn_update_dpp(0, __builtin_bit_cast(int, ss), 0x141, 0xF, 0xF, true));
            ss += __builtin_bit_cast(float, __builtin_amdgcn_update_dpp(0, __builtin_bit_cast(int, ss), 0x140, 0xF, 0xF, true));
            float sc = grp == 2 ? 1.0f : rsqrtf(ss + EPS) * nsc;
            sc = rr < L ? sc : 0.f;
            if (lane < 48) { *(LAS f32x4*)(dst + rr * PITCH) = (f32x4){v[0] * sc, v[1] * sc, v[2] * sc, v[3] * sc}; *(LAS f32x4*)(dst + rr * PITCH + 4) = (f32x4){v[4] * sc, v[5] * sc, v[6] * sc, v[7] * sc}; }
        }
    }
    if (wave == 7) {
        float gc = P.gb[0];
#pragma unroll
        for (int o = 1; o < 64; o <<= 1) { const float t = __shfl_up(gc, o); if (lane >= o) gc += t; }
        gcs[lane] = gc; betas[lane] = P.gb[1];
        if (lane == 63) ((LAS float*)(ldsb + LDS_GCL))[bslot] = __expf(gc);
    }
    asm volatile("s_waitcnt vmcnt(0)" ::: "memory");
    if (next_item < N_ITEMS) stage1_issue(A, next_item, P);
    if (wait_item_idx >= 0 && wave == 0) (void)wait_item(item_granule(A, wait_item_idx), ep);
    LDS_BARRIER();
    if (prev_item >= 0 && tid == 0) __hip_atomic_store(item_flag1(A, prev_item), ((unsigned long long)ep << 32) | (unsigned long long)__float_as_uint(((const LAS float*)(ldsb + LDS_GCL))[bslot ^ 1]), __ATOMIC_RELAXED, __HIP_MEMORY_SCOPE_AGENT);
    if (wave < 6 && !(pmode & 4)) {
        const bool isqk = wave >= 3; const int tsel = isqk ? wave - 3 : wave, ib = tsel == 0 ? 0 : 1, jb = tsel == 2 ? 1 : 0;
        const LAS float* Asrc = isqk ? Qs : Ks;
        f32x16 acc;
#pragma unroll
        for (int e = 0; e < 16; ++e) acc[e] = 0.f;
#pragma unroll
        for (int s = 0; s < 8; ++s) acc = MFMA32(frag_nat(Asrc, 32 * ib + r, 16 * s + 8 * hh), frag_nat(Ks, 32 * jb + r, 16 * s + 8 * hh), acc);
        const int j = 32 * jb + r; const float gcj = gcs[j];
        float* Aout = ats + (ib + jb) * 1024; bf16* QKD = (bf16*)(slot + SL_QKD);
        if (!isqk) {
#pragma unroll
            for (int g4 = 0; g4 < 4; ++g4) { f32x4 v;
#pragma unroll
                for (int e = 0; e < 4; ++e) { const int i = 32 * ib + 8 * g4 + 4 * hh + e; v[e] = i > j ? betas[i] * __expf(fminf(gcs[i] - gcj, 0.f)) * acc[4 * g4 + e] : 0.f; }
                ST16F(Aout + r * 32 + 8 * g4 + 4 * hh, v); }
        } else {
            LAS float* patch = (LAS float*)(ldsb + 106496) + (wave - 3) * (32 * 36);
#pragma unroll
            for (int reg = 0; reg < 16; ++reg) { const int il = crow16(reg, hh), i = 32 * ib + il; const float dec = __expf(fminf(gcs[i] - gcj, 0.f));
                patch[il * 36 + r] = i >= j ? dec * acc[reg] : 0.f; }
            LDS_WAIT(); asm volatile("" ::: "memory");
#pragma unroll
            for (int ks2 = 0; ks2 < 2; ++ks2) { const int k0 = 16 * ks2 + 4 * hh;
                const f32x4 lo = *(const LAS f32x4*)(patch + r * 36 + k0), hi = *(const LAS f32x4*)(patch + r * 36 + k0 + 8);
                ST16((unsigned char*)QKD + ((ib * 4 + 2 * jb + ks2) * 64 + lane) * 16, pack8f(lo, hi)); }
        }
    }
    const float gcl = gcs[63];
#pragma unroll 1
    for (int job = (pmode & 4) ? 56 : wave; job < 56; job += 8) {
        if (job < 32) {
            const bool isq = job >= 16; const int jj = job & 15, rb = jj >> 3, ks = jj & 7, row = 32 * rb + r, k0 = 16 * ks + 4 * hh;
            const LAS float* src = isq ? Qs : Ks; const float sc = isq ? __expf(gcs[row]) : betas[row] * __expf(gcs[row]);
            const f32x4 lo = *(const LAS f32x4*)(src + row * PITCH + k0) * sc, hi = *(const LAS f32x4*)(src + row * PITCH + k0 + 8) * sc;
            ST16(slot + (isq ? SL_QE : SL_BEK) + ((rb * 8 + ks) * 64 + lane) * 16, pack8f(lo, hi));
        } else if (job < 48) {
            const int jj = job - 32, rb = jj >> 2, ks = jj & 3, dk = 32 * rb + r;
            f32x4 lo, hi;
#pragma unroll
            for (int e = 0; e < 4; ++e) { const int j0 = 16 * ks + 4 * hh + e, j1 = j0 + 8;
                lo[e] = Ks[j0 * PITCH + dk] * __expf(gcl - gcs[j0]); hi[e] = Ks[j1 * PITCH + dk] * __expf(gcl - gcs[j1]); }
            ST16(slot + SL_KWT + ((rb * 4 + ks) * 64 + lane) * 16, pack8f(lo, hi));
        } else {
            const int q = job - 48, w = q >> 1, ib = q & 1, dv = 32 * w + r;
            float v[16];
#pragma unroll
            for (int reg = 0; reg < 16; ++reg) { const int i = 32 * ib + crow16(reg, hh); v[reg] = betas[i] * Vs[i * PITCH + dv]; }
            u32x4* dst = (u32x4*)(slot + SL_BV + ((w * 2 + ib) * 64 + lane) * 32);
            ST16(dst, (u32x4){cvtpk(v[0], v[1]), cvtpk(v[2], v[3]), cvtpk(v[4], v[5]), cvtpk(v[6], v[7])});
            ST16(dst + 1, (u32x4){cvtpk(v[8], v[9]), cvtpk(v[10], v[11]), cvtpk(v[12], v[13]), cvtpk(v[14], v[15])});
        }
    }
    LDS_BARRIER();
}
DI void prep_stage2(KA A, int item, float gcl, const float* ats, LAS float* M, unsigned ep) {
    int lane = threadIdx.x & 63; asm volatile("" : "+v"(lane));
    const int r = lane & 31, hh = lane >> 5, base = 32 * hh;
    unsigned char* slot = slot_ptr(A, item);
    const f32x4* Ain = (const f32x4*)ats;
#pragma unroll
    for (int tt = 0; tt < 3; ++tt) { const int jb = tt >> 1, ib = (tt + 1) >> 1;
#pragma unroll
        for (int q = 0; q < 4; ++q) { const int idx = q * 64 + lane, jj = idx >> 3, i4 = idx & 7;
            *(LAS f32x4*)(M + (32 * jb + jj) * 64 + 32 * ib + 4 * i4) = Ain[tt * 256 + idx]; } }
    LDS_WAIT(); asm volatile("" ::: "memory");
#pragma unroll 1
    for (int rb = 0; rb < 2; ++rb) {
        float acc[16];
#pragma unroll
        for (int i = 0; i < 16; ++i) acc[i] = r == 16 * rb + i ? 1.f : 0.f;
        if (rb == 1) {
#pragma unroll 4
            for (int j = 0; j < 16; ++j) {
                float tj = M[(base + j) * 64 + base + r]; tj = r <= j ? tj : 0.f;
                const LAS f32x4* ar = (const LAS f32x4*)(M + (base + j) * 64 + base + 16);
                const f32x4 a0 = ar[0], a1 = ar[1], a2 = ar[2], a3 = ar[3];
#pragma unroll
                for (int e = 0; e < 4; ++e) { acc[e] -= a0[e] * tj; acc[4 + e] -= a1[e] * tj; acc[8 + e] -= a2[e] * tj; acc[12 + e] -= a3[e] * tj; }
            }
        }
#pragma unroll
        for (int j = 0; j < 16; ++j) {
            const float tj = acc[j]; const int row = base + 16 * rb + j;
            const LAS f32x4* ar = (const LAS f32x4*)(M + row * 64 + base + 16 * rb);
            float a[16];
#pragma unroll
            for (int q = j >> 2; q < 4; ++q) { const f32x4 v = ar[q]; a[4 * q] = v[0]; a[4 * q + 1] = v[1]; a[4 * q + 2] = v[2]; a[4 * q + 3] = v[3]; }
            if (r <= 16 * rb + j) M[row * 64 + base + r] = tj;
#pragma unroll
            for (int i = j + 1; i < 16; ++i) acc[i] -= a[i] * tj;
        }
        asm volatile("" ::: "memory");
    }
    LDS_WAIT(); asm volatile("" ::: "memory");
    f32x16 X;
#pragma unroll
    for (int e = 0; e < 16; ++e) X[e] = 0.f;
#pragma unroll
    for (int s2 = 0; s2 < 16; ++s2) { const int k = 2 * s2 + hh; const float a = M[k * 64 + 32 + r]; float bb = M[k * 64 + r]; bb = r <= k ? bb : 0.f;
        X = __builtin_amdgcn_mfma_f32_32x32x2f32(a, bb, X, 0, 0, 0); }
#pragma unroll
    for (int reg = 0; reg < 16; ++reg) M[crow16(reg, hh) * 64 + 32 + r] = X[reg];
    LDS_WAIT(); asm volatile("" ::: "memory");
    f32x16 Y;
#pragma unroll
    for (int e = 0; e < 16; ++e) Y[e] = 0.f;
#pragma unroll
    for (int s2 = 0; s2 < 16; ++s2) { const int k = 2 * s2 + hh; float a = M[(32 + r) * 64 + 32 + k]; a = k <= r ? a : 0.f; const float bb = M[k * 64 + 32 + r];
        Y = __builtin_amdgcn_mfma_f32_32x32x2f32(a, bb, Y, 0, 0, 0); }
#pragma unroll
    for (int reg = 0; reg < 16; ++reg) M[(32 + crow16(reg, hh)) * 64 + r] = -Y[reg];
    LDS_WAIT(); asm volatile("" ::: "memory");
#pragma unroll
    for (int f = 0; f < 8; ++f) { const int rb = f >> 2, ks = f & 3, row = 32 * rb + r, k0 = 16 * ks + 4 * hh;
        f32x4 lo = *(const LAS f32x4*)(M + row * 64 + k0), hi = *(const LAS f32x4*)(M + row * 64 + k0 + 8);
#pragma unroll
        for (int e = 0; e < 4; ++e) { lo[e] = k0 + e <= row ? lo[e] : 0.f; hi[e] = k0 + 8 + e <= row ? hi[e] : 0.f; }
        st16_sc1(slot + SL_T + ((rb * 4 + ks) * 64 + lane) * 16, pack8f(lo, hi)); }
    LDS_WAIT();
    asm volatile("s_waitcnt vmcnt(0)" ::: "memory");
    if (lane == 0) __hip_atomic_store(item_granule(A, item), ((unsigned long long)ep << 32) | (unsigned long long)__float_as_uint(gcl), __ATOMIC_RELAXED, __HIP_MEMORY_SCOPE_AGENT);
}
DI void scan_seq(KA A, int seq, int w, int lane, unsigned ep) {
    const int r = lane & 31, hh = lane >> 5, dv = 32 * w + r;
    const bool sample = seq >= N_PROMPT_SEQ; const int sidx = sample ? seq - N_PROMPT_SEQ : seq, b = sidx >> 2, h = sidx & 3, nch = sample ? 1 : CHUNKS_P;
    f32x16 S[4];
    if (sample) {
        const float* S0 = A->state_delta + ((size_t)(b * 4 + h) * 128) * 128 + dv;
#pragma unroll
        for (int kb = 0; kb < 4; ++kb)
#pragma unroll
            for (int reg = 0; reg < 16; ++reg) S[kb][reg] = S0[(size_t)(32 * kb + crow16(reg, hh)) * 128];
    } else {
#pragma unroll
        for (int kb = 0; kb < 4; ++kb)
#pragma unroll
            for (int reg = 0; reg < 16; ++reg) S[kb][reg] = 0.f;
    }
    bf16* OBR = (bf16*)((unsigned char*)A->out + DO_OB);
#pragma unroll 1
    for (int c = 0; c < nch; ++c) {
        const int item = sample ? N_ITEMS_P + sidx : seq * CHUNKS_P + c;
        const unsigned char* slot = slot_ptr(A, item);
        const float gcl = wait_item(item_granule(A, item), ep);
        __builtin_amdgcn_fence(__ATOMIC_ACQUIRE, "agent");
        const bf16x8* bek = (const bf16x8*)(slot + SL_BEK) + lane; const bf16x8* tp = (const bf16x8*)(slot + SL_T) + lane;
        const bf16x8* qe = (const bf16x8*)(slot + SL_QE) + lane; const bf16x8* qkd = (const bf16x8*)(slot + SL_QKD) + lane; const bf16x8* kwt = (const bf16x8*)(slot + SL_KWT) + lane;
        bf16x8 sf[8];
#pragma unroll
        for (int kb = 0; kb < 4; ++kb) { sf[2 * kb] = pack_step<0>(S[kb]); sf[2 * kb + 1] = pack_step<1>(S[kb]); }
        f32x16 x0, x1;
#pragma unroll
        for (int e = 0; e < 16; ++e) { x0[e] = 0.f; x1[e] = 0.f; }
#pragma unroll
        for (int ks = 0; ks < 8; ++ks) { x0 = MFMA32(bek[ks * 64], sf[ks], x0); x1 = MFMA32(bek[(8 + ks) * 64], sf[ks], x1); }
        {
            const u32x4* bv = (const u32x4*)(slot + SL_BV) + ((w * 2) * 64 + lane) * 2;
            const u32x4 a0 = bv[0], a1 = bv[1], c0 = bv[128], c1 = bv[129];
            x0[0] = bflo(a0.x) - x0[0]; x0[1] = bfhi(a0.x) - x0[1]; x0[2] = bflo(a0.y) - x0[2]; x0[3] = bfhi(a0.y) - x0[3];
            x0[4] = bflo(a0.z) - x0[4]; x0[5] = bfhi(a0.z) - x0[5]; x0[6] = bflo(a0.w) - x0[6]; x0[7] = bfhi(a0.w) - x0[7];
            x0[8] = bflo(a1.x) - x0[8]; x0[9] = bfhi(a1.x) - x0[9]; x0[10] = bflo(a1.y) - x0[10]; x0[11] = bfhi(a1.y) - x0[11];
            x0[12] = bflo(a1.z) - x0[12]; x0[13] = bfhi(a1.z) - x0[13]; x0[14] = bflo(a1.w) - x0[14]; x0[15] = bfhi(a1.w) - x0[15];
            x1[0] = bflo(c0.x) - x1[0]; x1[1] = bfhi(c0.x) - x1[1]; x1[2] = bflo(c0.y) - x1[2]; x1[3] = bfhi(c0.y) - x1[3];
            x1[4] = bflo(c0.z) - x1[4]; x1[5] = bfhi(c0.z) - x1[5]; x1[6] = bflo(c0.w) - x1[6]; x1[7] = bfhi(c0.w) - x1[7];
            x1[8] = bflo(c1.x) - x1[8]; x1[9] = bfhi(c1.x) - x1[9]; x1[10] = bflo(c1.y) - x1[10]; x1[11] = bfhi(c1.y) - x1[11];
            x1[12] = bflo(c1.z) - x1[12]; x1[13] = bfhi(c1.z) - x1[13]; x1[14] = bflo(c1.w) - x1[14]; x1[15] = bfhi(c1.w) - x1[15];
        }
        bf16x8 rf[4] = {pack_step<0>(x0), pack_step<1>(x0), pack_step<0>(x1), pack_step<1>(x1)};
        f32x16 u0, u1;
#pragma unroll
        for (int e = 0; e < 16; ++e) { u0[e] = 0.f; u1[e] = 0.f; }
        u0 = MFMA32(tp[0 * 64], rf[0], u0); u0 = MFMA32(tp[1 * 64], rf[1], u0);
#pragma unroll
        for (int ks = 0; ks < 4; ++ks) u1 = MFMA32(tp[(4 + ks) * 64], rf[ks], u1);
        bf16x8 uf[4] = {pack_step<0>(u0), pack_step<1>(u0), pack_step<0>(u1), pack_step<1>(u1)};
        if (sample || c > 0) {
#pragma unroll
            for (int e = 0; e < 16; ++e) { x0[e] = 0.f; x1[e] = 0.f; }
#pragma unroll
            for (int ks = 0; ks < 8; ++ks) { x0 = MFMA32(qe[ks * 64], sf[ks], x0); x1 = MFMA32(qe[(8 + ks) * 64], sf[ks], x1); }
            x0 = MFMA32(qkd[0 * 64], uf[0], x0); x0 = MFMA32(qkd[1 * 64], uf[1], x0);
#pragma unroll
            for (int ks = 0; ks < 4; ++ks) x1 = MFMA32(qkd[(4 + ks) * 64], uf[ks], x1);
            const int crow0 = sample ? NBATCH * SEQ + b * TS : b * SEQ + 64 * (c - 1), L = sample ? TS : 64;
#pragma unroll
            for (int reg = 0; reg < 16; ++reg) { const int i0 = crow16(reg, hh), i1 = 32 + i0;
                if (i0 < L) OBR[(size_t)(crow0 + i0) * OAB_PITCH + h * 128 + dv] = f2bf(x0[reg]);
                if (i1 < L) OBR[(size_t)(crow0 + i1) * OAB_PITCH + h * 128 + dv] = f2bf(x1[reg]); }
        }
#pragma unroll
        for (int kb = 0; kb < 4; ++kb) {
            S[kb] = S[kb] * gcl;
#pragma unroll
            for (int ks = 0; ks < 4; ++ks) S[kb] = MFMA32(kwt[(kb * 4 + ks) * 64], uf[ks], S[kb]);
        }
    }
    float* So = A->out + (sample ? O_DS : O_DP) + ((size_t)(b * 4 + h) * 128) * 128 + dv;
#pragma unroll
    for (int kb = 0; kb < 4; ++kb)
#pragma unroll
        for (int reg = 0; reg < 16; ++reg) So[(size_t)(32 * kb + crow16(reg, hh)) * 128] = S[kb][reg];
}

constexpr int HALF_BYTES = 40960;
DI void scan_prompt_wg(KA A, int seq, LAS unsigned char* lds, unsigned ep) {
    const int tid = threadIdx.x, lane = tid & 63, wave = __builtin_amdgcn_readfirstlane(tid >> 6);
    const int b = seq >> 2, h = seq & 3;
    constexpr int N = 2 * CHUNKS_P;
    if (wave >= 4) {
        const int loff = (wave - 4) * 10240 + lane * 16;
        u32x4 r0[10], r1[10];
        LAS u32x4* d0 = (LAS u32x4*)(lds + loff); LAS u32x4* d1 = (LAS u32x4*)(lds + HALF_BYTES + loff);
        LAS float* gclw = (LAS float*)(lds + 2 * HALF_BYTES);
#define SCAN_LOAD(n, R) do { const int item_ = seq * CHUNKS_P + ((n) >> 1); \
            if (((n) & 1) == 0) { const float g_ = wait_item(item_granule(A, item_), ep); if (wave == 4 && lane == 0) gclw[((n) >> 1) & 3] = g_; } \
            const __amdgpu_buffer_rsrc_t rs_ = __builtin_amdgcn_make_buffer_rsrc((void*)slot_ptr(A, item_), 0, (int)PREP_SLOT, 0x00020000); \
            _Pragma("unroll") for (int q = 0; q < 10; ++q) R[q] = __builtin_bit_cast(u32x4, __builtin_amdgcn_raw_buffer_load_b128(rs_, ((n) & 1) * HALF_BYTES + loff + q * 1024, 0, 16)); } while (0)
        SCAN_LOAD(0, r0);
#pragma unroll
        for (int q = 0; q < 10; ++q) d0[q * 64] = r0[q];
        SCAN_LOAD(1, r1);
        LDS_BARRIER();
#pragma unroll 1
        for (int n = 0; n < N; n += 2) {
            if (n + 2 < N) SCAN_LOAD(n + 2, r0);
#pragma unroll
            for (int q = 0; q < 10; ++q) d1[q * 64] = r1[q];
            LDS_BARRIER();
            if (n + 3 < N) SCAN_LOAD(n + 3, r1);
            if (n + 2 < N) {
#pragma unroll
                for (int q = 0; q < 10; ++q) d0[q * 64] = r0[q]; }
            LDS_BARRIER();
        }
#undef SCAN_LOAD
    } else {
        const int w = wave, r = lane & 31, hh = lane >> 5, dv = 32 * w + r;
        f32x16 S[4];
#pragma unroll
        for (int kb = 0; kb < 4; ++kb)
#pragma unroll
            for (int reg = 0; reg < 16; ++reg) S[kb][reg] = 0.f;
        bf16* OBR = (bf16*)((unsigned char*)A->out + DO_OB);
        const LAS float* gclw = (const LAS float*)(lds + 2 * HALF_BYTES);
        const LAS bf16x8* bek = (const LAS bf16x8*)(lds + SL_BEK) + lane; const LAS bf16x8* tp = (const LAS bf16x8*)(lds + SL_T) + lane;
        const LAS u32x4* bv = (const LAS u32x4*)(lds + SL_BV) + ((w * 2) * 64 + lane) * 2;
        const LAS bf16x8* qkd = (const LAS bf16x8*)(lds + HALF_BYTES + (SL_QKD - HALF_BYTES)) + lane; const LAS bf16x8* qe = (const LAS bf16x8*)(lds + HALF_BYTES + (SL_QE - HALF_BYTES)) + lane;
        const LAS bf16x8* kwt = (const LAS bf16x8*)(lds + HALF_BYTES + (SL_KWT - HALF_BYTES)) + lane;
        LDS_BARRIER();
#pragma unroll 1
        for (int c = 0; c < CHUNKS_P; ++c) {
            bf16x8 sf[8];
#pragma unroll
            for (int kb = 0; kb < 4; ++kb) { sf[2 * kb] = pack_step<0>(S[kb]); sf[2 * kb + 1] = pack_step<1>(S[kb]); }
            f32x16 x0, x1;
#pragma unroll
            for (int e = 0; e < 16; ++e) { x0[e] = 0.f; x1[e] = 0.f; }
#pragma unroll
            for (int ks = 0; ks < 8; ++ks) { x0 = MFMA32(bek[ks * 64], sf[ks], x0); x1 = MFMA32(bek[(8 + ks) * 64], sf[ks], x1); }
            {
                const u32x4 a0 = bv[0], a1 = bv[1], c0 = bv[128], c1 = bv[129];
                x0[0] = bflo(a0.x) - x0[0]; x0[1] = bfhi(a0.x) - x0[1]; x0[2] = bflo(a0.y) - x0[2]; x0[3] = bfhi(a0.y) - x0[3];
                x0[4] = bflo(a0.z) - x0[4]; x0[5] = bfhi(a0.z) - x0[5]; x0[6] = bflo(a0.w) - x0[6]; x0[7] = bfhi(a0.w) - x0[7];
                x0[8] = bflo(a1.x) - x0[8]; x0[9] = bfhi(a1.x) - x0[9]; x0[10] = bflo(a1.y) - x0[10]; x0[11] = bfhi(a1.y) - x0[11];
                x0[12] = bflo(a1.z) - x0[12]; x0[13] = bfhi(a1.z) - x0[13]; x0[14] = bflo(a1.w) - x0[14]; x0[15] = bfhi(a1.w) - x0[15];
                x1[0] = bflo(c0.x) - x1[0]; x1[1] = bfhi(c0.x) - x1[1]; x1[2] = bflo(c0.y) - x1[2]; x1[3] = bfhi(c0.y) - x1[3];
                x1[4] = bflo(c0.z) - x1[4]; x1[5] = bfhi(c0.z) - x1[5]; x1[6] = bflo(c0.w) - x1[6]; x1[7] = bfhi(c0.w) - x1[7];
                x1[8] = bflo(c1.x) - x1[8]; x1[9] = bfhi(c1.x) - x1[9]; x1[10] = bflo(c1.y) - x1[10]; x1[11] = bfhi(c1.y) - x1[11];
                x1[12] = bflo(c1.z) - x1[12]; x1[13] = bfhi(c1.z) - x1[13]; x1[14] = bflo(c1.w) - x1[14]; x1[15] = bfhi(c1.w) - x1[15];
            }
            bf16x8 rf[4] = {pack_step<0>(x0), pack_step<1>(x0), pack_step<0>(x1), pack_step<1>(x1)};
            f32x16 u0, u1;
#pragma unroll
            for (int e = 0; e < 16; ++e) { u0[e] = 0.f; u1[e] = 0.f; }
            u0 = MFMA32(tp[0 * 64], rf[0], u0); u0 = MFMA32(tp[1 * 64], rf[1], u0);
#pragma unroll
            for (int ks = 0; ks < 4; ++ks) u1 = MFMA32(tp[(4 + ks) * 64], rf[ks], u1);
            bf16x8 uf[4] = {pack_step<0>(u0), pack_step<1>(u0), pack_step<0>(u1), pack_step<1>(u1)};
            LDS_BARRIER();
            if (c > 0) {
#pragma unroll
                for (int e = 0; e < 16; ++e) { x0[e] = 0.f; x1[e] = 0.f; }
#pragma unroll
                for (int ks = 0; ks < 8; ++ks) { x0 = MFMA32(qe[ks * 64], sf[ks], x0); x1 = MFMA32(qe[(8 + ks) * 64], sf[ks], x1); }
                x0 = MFMA32(qkd[0 * 64], uf[0], x0); x0 = MFMA32(qkd[1 * 64], uf[1], x0);
#pragma unroll
                for (int ks = 0; ks < 4; ++ks) x1 = MFMA32(qkd[(4 + ks) * 64], uf[ks], x1);
                bf16* orow = OBR + (size_t)(b * SEQ + 64 * (c - 1)) * OAB_PITCH + h * 128 + dv;
#pragma unroll
                for (int reg = 0; reg < 16; ++reg) { const int i0 = crow16(reg, hh); orow[(size_t)i0 * OAB_PITCH] = f2bf(x0[reg]); orow[(size_t)(32 + i0) * OAB_PITCH] = f2bf(x1[reg]); }
            }
            const float gcl = gclw[c & 3];
#pragma unroll
            for (int kb = 0; kb < 4; ++kb) {
                S[kb] = S[kb] * gcl;
#pragma unroll
                for (int ks = 0; ks < 4; ++ks) S[kb] = MFMA32(kwt[(kb * 4 + ks) * 64], uf[ks], S[kb]);
            }
            LDS_BARRIER();
        }
        float* So = A->out + O_DP + ((size_t)(b * 4 + h) * 128) * 128 + dv;
#pragma unroll
        for (int kb = 0; kb < 4; ++kb)
#pragma unroll
            for (int reg = 0; reg < 16; ++reg) So[(size_t)(32 * kb + crow16(reg, hh)) * 128] = S[kb][reg];
    }
}

constexpr int KPITCH = 72, VPITCH = 264;
typedef short v4i16_t __attribute__((ext_vector_type(4)));
DI void attn_unit(KA A, int unit, LAS unsigned char* ldsb) {
    const int tid = threadIdx.x, lane = tid & 63, wave = __builtin_amdgcn_readfirstlane(tid >> 6), r = lane & 31, hh = lane >> 5;
    const int b = unit >> 6, kh = (unit >> 5) & 1, jb = unit & 31, T0 = NMETA + 128 * jb;
    LAS bf16* Ksm = (LAS bf16*)ldsb; LAS bf16* VTs = Ksm + 256 * KPITCH;
    const bf16* KVg = (const bf16*)(A->ws + WS_KV); const bf16* QAg = (const bf16*)(A->ws + WS_QA);
#pragma unroll
    for (int e4 = 0; e4 < 4; ++e4) {
        const int id = tid + 512 * e4, key = id >> 3, cch = id & 7, tk = T0 - 128 + key;
        u32x4 kq = (u32x4){0u, 0u, 0u, 0u}, vq = kq;
        if (tk >= 0) { const bf16* src = KVg + (size_t)(b * TP + tk) * 256 + kh * 64 + 8 * cch; kq = *(const u32x4*)src; vq = *(const u32x4*)(src + 128); }
        *(LAS u32x4*)(Ksm + key * KPITCH + 8 * cch) = kq;
        *(LAS u32x4*)(VTs + key * KPITCH + 8 * cch) = vq;
    }
    LDS_BARRIER();
    const int g = wave >> 1, qh = wave & 1, head = 4 * kh + g;
    const float sink2 = A->sinks[head] * 1.4426950408889634f;
    const int kmin = jb == 0 ? 128 - NMETA : 0;
#pragma unroll 1
    for (int q2 = 0; q2 < 2; ++q2) {
        const int qb = 2 * qh + q2, iq = 32 * qb + r;
        const bf16* qrow = QAg + (size_t)(b * TP + T0 + iq) * 512 + head * 64 + 8 * hh;
        bf16x8 qf[4];
#pragma unroll
        for (int s = 0; s < 4; ++s) qf[s] = *(const bf16x8*)(qrow + 16 * s);
        f32x16 st[5];
        float m = sink2;
#pragma unroll
        for (int kt5 = 0; kt5 < 5; ++kt5) {
            const int kt = qb + kt5;
            f32x16 acc;
#pragma unroll
            for (int e = 0; e < 16; ++e) acc[e] = 0.f;
#pragma unroll
            for (int s = 0; s < 4; ++s) acc = MFMA32(*(const LAS bf16x8*)(Ksm + (32 * kt + r) * KPITCH + 16 * s + 8 * hh), qf[s], acc);
#pragma unroll
            for (int reg = 0; reg < 16; ++reg) { const int kk = 32 * kt + crow16(reg, hh); const bool ok = kk >= iq && kk <= iq + 128 && kk >= kmin;
                acc[reg] = ok ? acc[reg] : -INFINITY; m = fmaxf(m, acc[reg]); }
            st[kt5] = acc;
        }
        m = fmaxf(m, __shfl_xor(m, 32));
        float l = 0.f;
#pragma unroll
        for (int kt5 = 0; kt5 < 5; ++kt5)
#pragma unroll
            for (int reg = 0; reg < 16; ++reg) { const float p = exp2f(st[kt5][reg] - m); st[kt5][reg] = p; l += p; }
        l += __shfl_xor(l, 32); l += exp2f(sink2 - m);
        f32x16 o0, o1;
#pragma unroll
        for (int e = 0; e < 16; ++e) { o0[e] = 0.f; o1[e] = 0.f; }
#pragma unroll
        for (int kt5 = 0; kt5 < 5; ++kt5) {
            const int kt = qb + kt5;
            const bf16x8 p0 = pack_step<0>(st[kt5]), p1 = pack_step<1>(st[kt5]);
            const LAS bf16* vb = VTs + (32 * kt + 4 * hh + ((lane & 15) >> 2)) * KPITCH + 16 * ((lane >> 4) & 1) + 4 * (lane & 3);
#define VTR(ptr) __builtin_amdgcn_ds_read_tr16_b64_v4i16((LAS v4i16_t*)(ptr))
            const v4i16_t a00 = VTR(vb), a01 = VTR(vb + 8 * KPITCH), a10 = VTR(vb + 16 * KPITCH), a11 = VTR(vb + 24 * KPITCH);
            const v4i16_t b00 = VTR(vb + 32), b01 = VTR(vb + 8 * KPITCH + 32), b10 = VTR(vb + 16 * KPITCH + 32), b11 = VTR(vb + 24 * KPITCH + 32);
#undef VTR
            o0 = MFMA32(__builtin_shufflevector(a00, a01, 0, 1, 2, 3, 4, 5, 6, 7), p0, o0); o0 = MFMA32(__builtin_shufflevector(a10, a11, 0, 1, 2, 3, 4, 5, 6, 7), p1, o0);
            o1 = MFMA32(__builtin_shufflevector(b00, b01, 0, 1, 2, 3, 4, 5, 6, 7), p0, o1); o1 = MFMA32(__builtin_shufflevector(b10, b11, 0, 1, 2, 3, 4, 5, 6, 7), p1, o1);
        }
        const float rl = 1.0f / l;
        bf16* orow = (bf16*)((unsigned char*)A->out + DO_OA) + (size_t)(b * SEQ + 128 * jb + iq) * OAB_PITCH + head * 64 + 4 * hh;
#pragma unroll
        for (int g4 = 0; g4 < 4; ++g4) {
            *(u32x2*)(orow + 8 * g4) = (u32x2){cvtpk(o0[4 * g4] * rl, o0[4 * g4 + 1] * rl), cvtpk(o0[4 * g4 + 2] * rl, o0[4 * g4 + 3] * rl)};
            *(u32x2*)(orow + 32 + 8 * g4) = (u32x2){cvtpk(o1[4 * g4] * rl, o1[4 * g4 + 1] * rl), cvtpk(o1[4 * g4 + 2] * rl, o1[4 * g4 + 3] * rl)};
        }
    }
    LDS_BARRIER();
}
DI void sample_attn(KA A, int b, int head, LAS float* wl, int lane) {
    const int kh = head >> 2;
    LAS float* qn = wl; LAS float* ps = wl + 256;
    const bf16* QAg = (const bf16*)(A->ws + WS_QA); const bf16* KVg = (const bf16*)(A->ws + WS_KV);
#pragma unroll
    for (int i = 0; i < 4; ++i) qn[i * 64 + lane] = bf2f(QAg[(size_t)(MP + b * TS + i) * 512 + head * 64 + pos_of_d(lane)]);
    LDS_WAIT(); asm volatile("" ::: "memory");
    const float sink2 = A->sinks[head] * 1.4426950408889634f;
#pragma unroll 1
    for (int kq = 0; kq < 3; ++kq) {
        const int kj = lane + 64 * kq;
        float sc0 = 0.f, sc1 = 0.f, sc2 = 0.f, sc3 = 0.f;
        if (kj < 128) {
            const f32x4* kr = (const f32x4*)(A->cache_k + ((size_t)(b * 128 + kj) * 2 + kh) * 64);
#pragma unroll 4
            for (int d4 = 0; d4 < 16; ++d4) { const f32x4 kv = kr[d4];
                const f32x4 q0 = *(const LAS f32x4*)(qn + 4 * d4), q1 = *(const LAS f32x4*)(qn + 64 + 4 * d4), q2 = *(const LAS f32x4*)(qn + 128 + 4 * d4), q3 = *(const LAS f32x4*)(qn + 192 + 4 * d4);
                sc0 += (kv[0] * q0[0] + kv[1] * q0[1]) + (kv[2] * q0[2] + kv[3] * q0[3]); sc1 += (kv[0] * q1[0] + kv[1] * q1[1]) + (kv[2] * q1[2] + kv[3] * q1[3]);
                sc2 += (kv[0] * q2[0] + kv[1] * q2[1]) + (kv[2] * q2[2] + kv[3] * q2[3]); sc3 += (kv[0] * q3[0] + kv[1] * q3[1]) + (kv[2] * q3[2] + kv[3] * q3[3]); }
        } else if (kj < 132) {
            const bf16* kr = KVg + (size_t)(MP + b * TS + (kj - 128)) * 256 + kh * 64;
#pragma unroll 4
            for (int p = 0; p < 64; ++p) { const float kv = bf2f(kr[p]); const int d = d_of_pos(p);
                sc0 += kv * qn[d]; sc1 += kv * qn[64 + d]; sc2 += kv * qn[128 + d]; sc3 += kv * qn[192 + d]; }
        }
        if (kj < 132) {
            ps[0 * 132 + kj] = (kj >= 0 && kj <= 128) ? sc0 : -INFINITY; ps[1 * 132 + kj] = (kj >= 1 && kj <= 129) ? sc1 : -INFINITY;
            ps[2 * 132 + kj] = (kj >= 2 && kj <= 130) ? sc2 : -INFINITY; ps[3 * 132 + kj] = (kj >= 3 && kj <= 131) ? sc3 : -INFINITY; }
    }
    LDS_WAIT(); asm volatile("" ::: "memory");
    float linv[4];
#pragma unroll
    for (int i = 0; i < 4; ++i) {
        const float s0 = ps[i * 132 + lane], s1 = ps[i * 132 + 64 + lane], s2 = lane < 4 ? ps[i * 132 + 128 + lane] : -INFINITY;
        const float m = wave_max(fmaxf(fmaxf(s0, s1), fmaxf(s2, sink2)));
        const float p0 = exp2f(s0 - m), p1 = exp2f(s1 - m), p2 = exp2f(s2 - m);
        ps[i * 132 + lane] = p0; ps[i * 132 + 64 + lane] = p1; if (lane < 4) ps[i * 132 + 128 + lane] = p2;
        linv[i] = 1.0f / (wave_sum(p0 + p1 + p2) + exp2f(sink2 - m));
    }
    LDS_WAIT(); asm volatile("" ::: "memory");
    float o[4] = {0.f, 0.f, 0.f, 0.f};
#pragma unroll 4
    for (int kj = 0; kj < 128; ++kj) { const float v = A->cache_v[((size_t)(b * 128 + kj) * 2 + kh) * 64 + lane];
#pragma unroll
        for (int i = 0; i < 4; ++i) o[i] += ps[i * 132 + kj] * v; }
#pragma unroll
    for (int kj = 128; kj < 132; ++kj) { const float v = bf2f(KVg[(size_t)(MP + b * TS + (kj - 128)) * 256 + 128 + kh * 64 + lane]);
#pragma unroll
        for (int i = 0; i < 4; ++i) o[i] += ps[i * 132 + kj] * v; }
    bf16* OAg = (bf16*)((unsigned char*)A->out + DO_OA);
#pragma unroll
    for (int i = 0; i < 4; ++i) OAg[(size_t)(NBATCH * SEQ + b * TS + i) * OAB_PITCH + head * 64 + lane] = f2bf(o[i] * linv[i]);
    LDS_WAIT(); asm volatile("" ::: "memory");
}
constexpr int NINV_WG = 24;
DI void p23_mixers(KA A, LAS unsigned char* lds, const XcdBarrier& dbg_bar, unsigned ep, int pmode = 0) {
    const int tid = threadIdx.x, lane = tid & 63, wave = __builtin_amdgcn_readfirstlane(tid >> 6), G = gridDim.x, wg = blockIdx.x;
    const int NSCAN = N_PROMPT_SEQ, NP = G - NSCAN - NINV_WG;
    if (wg < NSCAN) { if (!(pmode & 2)) scan_prompt_wg(A, wg, lds, ep); return; }
    if (wg < NSCAN + NINV_WG) {
        const int wv = (wg - NSCAN) * NWAVES + wave, NWV = NINV_WG * NWAVES;
#pragma unroll 1
        for (int m = wv; m < N_ITEMS; m += NWV) {
            const int item = order_item(m), p = m % NP, k = m / NP;
            const float gcl = wait_item(item_flag1(A, item), ep);
            __builtin_amdgcn_fence(__ATOMIC_ACQUIRE, "agent");
            const float* ats = (const float*)((const unsigned char*)A->out + DO_ATS + ((size_t)p * 8 + (k & 7)) * ATS_ITEM);
            if (pmode & 16) { if (lane == 0) __hip_atomic_store(item_granule(A, item), ((unsigned long long)ep << 32), __ATOMIC_RELAXED, __HIP_MEMORY_SCOPE_AGENT); }
            else prep_stage2(A, item, gcl, ats, (LAS float*)(lds + wave * 16384), ep);
        }
        return;
    }
    const int p = wg - NSCAN - NINV_WG;
    {
        const int ntot = p < N_ITEMS ? (N_ITEMS - 1 - p) / NP + 1 : 0;
        S1Pre P;
        if (ntot > 0) stage1_issue(A, order_item(p), P);
        int prev = -1;
#pragma unroll 1
        for (int k = 0; k < ntot; ++k) {
            const int m = p + NP * k, item = order_item(m), nxt = k + 1 < ntot ? order_item(m + NP) : N_ITEMS;
            float* ats = (float*)((unsigned char*)A->out + DO_ATS + ((size_t)p * 8 + (k & 7)) * ATS_ITEM);
            prep_stage1(A, item, nxt, prev, k >= 8 ? order_item(m - 8 * NP) : -1, k & 1, ats, P, lds, ep, pmode);
            prev = item;
        }
        asm volatile("s_waitcnt vmcnt(0)" ::: "memory"); __syncthreads();
        if (prev >= 0 && tid == 0) __hip_atomic_store(item_flag1(A, prev), ((unsigned long long)ep << 32) | (unsigned long long)__float_as_uint(((const LAS float*)(lds + LDS_GCL))[(ntot - 1) & 1]), __ATOMIC_RELAXED, __HIP_MEMORY_SCOPE_AGENT);
    }
    if (pmode & 1) return;
    for (int u = p; u < NBATCH * NKV * 32; u += NP) attn_unit(A, u, lds);
    const int worker = p * NWAVES + wave, NW = NP * NWAVES;
    LAS float* wl = (LAS float*)(lds + 98304 + wave * 4096);
    for (int it = worker; it < SBATCH * NHB * 4 + SBATCH * NHA; it += NW) {
        if (it < SBATCH * NHB * 4) scan_seq(A, N_PROMPT_SEQ + (it >> 2), it & 3, lane, ep);
        else { const int q = it - SBATCH * NHB * 4; sample_attn(A, q >> 3, q & 7, wl, lane); }
    }
}

DI void p3b_gated_norm(KA A) {
    const int tid = threadIdx.x, lane = tid & 63, wave = tid >> 6, gw = blockIdx.x * NWAVES + wave, NGW = gridDim.x * NWAVES;
    const int head = lane >> 4, dv0 = 8 * (lane & 15);
    const f32x4 w0 = *(const f32x4*)(A->gdn_norm + dv0), w1 = *(const f32x4*)(A->gdn_norm + dv0 + 4);
    bf16* OBg = (bf16*)((unsigned char*)A->out + DO_OB); const bf16* Zg = (const bf16*)(A->ws + WS_Z);
    for (int crow = gw; crow < MC; crow += NGW) {
        const u32x4 ow = *(const u32x4*)(OBg + (size_t)crow * OAB_PITCH + head * 128 + dv0);
        const f32x4 a = {bflo(ow.x), bfhi(ow.x), bflo(ow.y), bfhi(ow.y)}, c = {bflo(ow.z), bfhi(ow.z), bflo(ow.w), bfhi(ow.w)};
        float ss = (a[0] * a[0] + a[1] * a[1]) + (a[2] * a[2] + a[3] * a[3]) + (c[0] * c[0] + c[1] * c[1]) + (c[2] * c[2] + c[3] * c[3]);
        ss += __shfl_xor(ss, 1); ss += __shfl_xor(ss, 2); ss += __shfl_xor(ss, 4); ss += __shfl_xor(ss, 8);
        const float rstd = rsqrtf(ss * (1.0f / 128.0f) + EPS);
        const u32x4 zw = *(const u32x4*)(Zg + (size_t)pg8::crow_to_urow(crow) * 512 + head * 128 + dv0);
        f32x4 y0, y1;
        y0[0] = a[0] * rstd * w0[0] * siluf_(bflo(zw.x)); y0[1] = a[1] * rstd * w0[1] * siluf_(bfhi(zw.x)); y0[2] = a[2] * rstd * w0[2] * siluf_(bflo(zw.y)); y0[3] = a[3] * rstd * w0[3] * siluf_(bfhi(zw.y));
        y1[0] = c[0] * rstd * w1[0] * siluf_(bflo(zw.z)); y1[1] = c[1] * rstd * w1[1] * siluf_(bfhi(zw.z)); y1[2] = c[2] * rstd * w1[2] * siluf_(bflo(zw.w)); y1[3] = c[3] * rstd * w1[3] * siluf_(bfhi(zw.w));
        *(u32x4*)(OBg + (size_t)crow * OAB_PITCH + head * 128 + dv0) = pack8f(y0, y1);
    }
}
DI void p8_final_norm(KA A) {
    const int tid = threadIdx.x, lane = tid & 63, wave = tid >> 6, gw = blockIdx.x * NWAVES + wave, NGW = gridDim.x * NWAVES;
    f32x4 nf[4];
#pragma unroll
    for (int j = 0; j < 4; ++j) nf[j] = ((const f32x4*)A->norm_final)[lane + 64 * j];
    const bf16* H2 = (const bf16*)(A->ws + WS_MB);
    for (int crow = gw; crow < MC; crow += NGW) {
        const u32x2* hrow = (const u32x2*)(H2 + (size_t)crow * D);
        f32x4* row = (f32x4*)(A->out + (size_t)crow * D);
        f32x4 v[4]; float ss = 0.f;
#pragma unroll
        for (int j = 0; j < 4; ++j) { const u32x2 hw = hrow[lane + 64 * j]; v[j] = (f32x4){bflo(hw.x), bfhi(hw.x), bflo(hw.y), bfhi(hw.y)};
            ss += (v[j][0] * v[j][0] + v[j][1] * v[j][1]) + (v[j][2] * v[j][2] + v[j][3] * v[j][3]); }
        const float rstd = rsqrtf(wave_sum(ss) * (1.0f / D) + EPS);
#pragma unroll
        for (int j = 0; j < 4; ++j) row[lane + 64 * j] = v[j] * rstd * nf[j];
    }
}
__global__ void __launch_bounds__(NTHREADS, 2) hybrid_fwd(Args Aval) {
    extern __shared__ __attribute__((aligned(16))) unsigned char lds_raw[];
    LAS unsigned char* lds = (LAS unsigned char*)lds_raw;
    const int tid = threadIdx.x;
    int lo, hi; { KA A0 = kargs(); lo = A0->ph_lo; hi = A0->ph_hi; }
#if MK_N_LAUNCHES == 1
#if MK_BARRIER == 1
    volatile LAS unsigned* MISC = (volatile LAS unsigned*)(lds + LDS_MISC);
    if (tid < 64) MISC[tid] = 0u;
    __syncthreads();
    XcdBarrier bar; { KA A0 = kargs(); bar = xcd_barrier_post((unsigned*)(A0->ws + WS_CTL) + 4096, MISC + 8); }
#define GRID_BAR() xcd_barrier(bar)
#else
    cg::grid_group grid = cg::this_grid();
#define GRID_BAR() grid.sync()
#endif
#else
#define GRID_BAR() do {} while (0)
#endif
#ifndef PH_MASK
#define PH_MASK 0x1ff
#endif
#define IN(k) (((PH_MASK >> (k)) & 1) && lo <= (k) && (k) < hi)
#ifndef PROBE_REP
#define PROBE_REP -1
#endif
#define NREP(k) (PROBE_REP == (k) ? 2 : 1)
#define SEAM(k) do { if (IN(k) && IN((k) + 1)) GRID_BAR(); } while (0)
    const int G = gridDim.x, wgid = blockIdx.x;
#if PROBE_REP == 0
    if (IN(0)) { KA A = kargs(); p0_prologue(A, lds); __syncthreads(); }
#endif
    if (IN(0)) { KA A = kargs(); p0_prologue(A, lds); } SEAM(0);
    if (IN(1)) for (int rep = 0; rep < NREP(1); ++rep) { KA A = kargs(); unsigned char* ws = A->ws;
        pg8::Gemm g{(const bf16*)(ws + WS_XN), (const bf16*)(ws + WS_WIN), MUP, NIN, D}; pg8::StaticOrder S; S.init(MUP, NIN, G, wgid);
        pg8::EpiInProj E{(bf16*)(ws + WS_QA), (bf16*)(ws + WS_KV), (bf16*)(ws + WS_QKVB), (bf16*)(ws + WS_Z), (bf16*)(ws + WS_G),
                         (const float*)(ws + WS_ROPE), (const float*)(ws + WS_ROPE) + (TP + TS) * 32, A->out};
        pg8::gemm_phase<pg8::EpiInProj, pg8::StaticOrder, true, true>(lds, g, S, E);
    } SEAM(1);
#ifndef PROBE_MODE
#define PROBE_MODE 0
#endif
#if PROBE_REP == 2
    if (IN(2)) { KA A = kargs(); p23_mixers(A, lds, bar, 1u); GRID_BAR(); }
    if (IN(2)) { KA A = kargs(); p23_mixers(A, lds, bar, 2u, PROBE_MODE); } SEAM(2);
#else
    if (IN(2)) { KA A = kargs(); p23_mixers(A, lds, bar, 1u); } SEAM(2);
#endif
    if (IN(3)) for (int rep = 0; rep < NREP(3); ++rep) { KA A = kargs(); p3b_gated_norm(A); } SEAM(3);
    if (IN(4)) for (int rep = 0; rep < NREP(4); ++rep) { KA A = kargs(); unsigned char* ws = A->ws;
        const bf16* OABp = (const bf16*)((unsigned char*)A->out + DO_OA); const bf16* Wm = (const bf16*)(ws + WS_WOA);
        { pg8::Gemm g{OABp, Wm, MC, D, 512, 1024}; pg8::StaticOrder S; S.init(MC, D, G, wgid); S.lim = (S.nwg / G) * G;
          pg8::EpiMerge<false> E{(bf16*)(ws + WS_MB), (const bf16*)(ws + WS_G), 0};
          pg8::gemm_phase<pg8::EpiMerge<false>, pg8::StaticOrder, true, true>(lds, g, S, E); }
        asm volatile("s_waitcnt vmcnt(0)" ::: "memory"); __syncthreads();
        { pg8::Gemm g{OABp + 512, Wm + 512, MC, D, 512, 1024}; pg8::StaticOrder S; S.init(MC, D, G, wgid); S.lim = (S.nwg / G) * G;
          pg8::EpiMerge<true> E{(bf16*)(ws + WS_MB), (const bf16*)(ws + WS_G), 1024};
          pg8::gemm_phase<pg8::EpiMerge<true>, pg8::StaticOrder, true, true>(lds, g, S, E); }
        { const int nstr = (MC / 256) * 4 - ((MC / 256) * 4 / G) * G;
          if (wgid < nstr * 4) { const int t = wgid >> 2, sl = wgid & 3, koff = sl * 256;
            pg8::Gemm g{OABp + koff, Wm + koff, MC, D, 256, 1024};
            pg8::SliceOrder S; S.init_slice(MC, D, G, ((MC / 256) * 4 / G) * G, t);
            pg8::EpiSplit<pg8::EpiStoreMB, true> E{pg8::EpiStoreMB{(bf16*)(ws + WS_MB)}, (float*)(ws + WS_SCR) + (size_t)t * 65536, (unsigned*)(ws + WS_CTL + CTL_SPL) + t * 8, 4u, (const bf16*)(ws + WS_G), (sl >> 1) ? 1024 : 0};
            pg8::gemm_phase<pg8::EpiSplit<pg8::EpiStoreMB, true>, pg8::SliceOrder, true, true>(lds, g, S, E); } }
    } SEAM(4);
    if (IN(5)) { KA A = kargs(); unsigned char* ws = A->ws;
        { pg8::Gemm g{(const bf16*)(ws + WS_MB), (const bf16*)(ws + WS_WOUT), MC, D, D}; pg8::StaticOrder S; S.init(MC, D, G, wgid); S.lim = (S.nwg / G) * G;
          pg8::EpiWout<true> E{A->x_prompt, A->x_sample, (bf16*)(ws + WS_HB1), (float*)(ws + WS_CTL + CTL_SS1)};
          pg8::gemm_phase<pg8::EpiWout<true>, pg8::StaticOrder, true, true>(lds, g, S, E); }
        { const int nstr = (MC / 256) * 4 - ((MC / 256) * 4 / G) * G;
          if (wgid < nstr * 4) { const int t = wgid >> 2, koff = (wgid & 3) * 256;
            pg8::Gemm g{(const bf16*)(ws + WS_MB) + koff, (const bf16*)(ws + WS_WOUT) + koff, MC, D, 256, D};
            pg8::SliceOrder S; S.init_slice(MC, D, G, ((MC / 256) * 4 / G) * G, t);
            pg8::EpiSplit<pg8::EpiWout<true>, false> E{pg8::EpiWout<true>{A->x_prompt, A->x_sample, (bf16*)(ws + WS_HB1), (float*)(ws + WS_CTL + CTL_SS1)}, (float*)(ws + WS_SCR) + (size_t)t * 65536, (unsigned*)(ws + WS_CTL + CTL_SPL) + t * 8, 4u, nullptr, 0};
            pg8::gemm_phase<pg8::EpiSplit<pg8::EpiWout<true>, false>, pg8::SliceOrder, true, true>(lds, g, S, E); } }
    } SEAM(5);
    if (IN(6)) for (int rep = 0; rep < NREP(6); ++rep) { KA A = kargs(); unsigned char* ws = A->ws;
        pg8::Gemm g{(const bf16*)(ws + WS_HB1), (const bf16*)(ws + WS_WGU), MC, 2 * DFF, D}; pg8::StaticOrder S; S.init(MC, 2 * DFF, G, wgid);
        pg8::EpiGateUp E{(bf16*)(ws + WS_ACT), (const float*)(ws + WS_CTL + CTL_SS1)};
        pg8::gemm_phase<pg8::EpiGateUp, pg8::StaticOrder, true, true>(lds, g, S, E);
    } SEAM(6);
    if (IN(7)) for (int rep = 0; rep < NREP(7); ++rep) { KA A = kargs(); unsigned char* ws = A->ws;
        { pg8::Gemm g{(const bf16*)(ws + WS_ACT), (const bf16*)(ws + WS_WD), MC, D, DFF}; pg8::StaticOrder S; S.init(MC, D, G, wgid); S.lim = (S.nwg / G) * G;
          pg8::EpiDown<false> E{(const bf16*)(ws + WS_HB1), (bf16*)(ws + WS_MB)};
          pg8::gemm_phase<pg8::EpiDown<false>, pg8::StaticOrder, true, true>(lds, g, S, E); }
        { const int nstr = (MC / 256) * 4 - ((MC / 256) * 4 / G) * G;
          if (wgid < nstr * 11) { const int t = wgid / 11, koff = (wgid % 11) * 256;
            pg8::Gemm g{(const bf16*)(ws + WS_ACT) + koff, (const bf16*)(ws + WS_WD) + koff, MC, D, 256, DFF};
            pg8::SliceOrder S; S.init_slice(MC, D, G, ((MC / 256) * 4 / G) * G, t);
            pg8::EpiSplit<pg8::EpiDown<false>, false> E{pg8::EpiDown<false>{(const bf16*)(ws + WS_HB1), (bf16*)(ws + WS_MB)}, (float*)(ws + WS_SCR) + (size_t)t * 65536, (unsigned*)(ws + WS_CTL + CTL_SPL) + t * 8, 11u, nullptr, 0};
            pg8::gemm_phase<pg8::EpiSplit<pg8::EpiDown<false>, false>, pg8::SliceOrder, true, true>(lds, g, S, E); } }
    } SEAM(7);
    if (IN(8)) { KA A = kargs(); p8_final_norm(A); }
#undef IN
#undef SEAM
}

extern "C" void kernel_launch(void* const* d_in, const int* in_sizes, int n_in, void* d_out, int out_size, void* d_ws, size_t ws_size, hipStream_t stream) {
    static int grid = 0;
    if (grid == 0) {
        if (n_in != 22 || out_size != (int)O_END || ws_size < WS_END) { fprintf(stderr, "kernel_launch: unexpected problem (n_in %d, out %d, ws %zu)\n", n_in, out_size, ws_size); grid = -1; return; }
        int dev = 0, cus = 0, per_cu = 0;
        if (hipGetDevice(&dev) != hipSuccess || hipDeviceGetAttribute(&cus, hipDeviceAttributeMultiprocessorCount, dev) != hipSuccess) { grid = -1; return; }
        if (hipFuncSetAttribute((const void*)hybrid_fwd, hipFuncAttributeMaxDynamicSharedMemorySize, LDS_BYTES) != hipSuccess) { fprintf(stderr, "kernel_launch: hipFuncSetAttribute failed\n"); grid = -1; return; }
        if (hipOccupancyMaxActiveBlocksPerMultiprocessor(&per_cu, (const void*)hybrid_fwd, NTHREADS, LDS_BYTES) != hipSuccess || per_cu < 1) { fprintf(stderr, "kernel_launch: occupancy query says %d\n", per_cu); per_cu = 1; }
        (void)hipGetLastError();
        grid = cus;
        if (grid > 256) grid = 256;
    }
    if (grid < 0) return;
    (void)hipMemsetAsync((char*)d_ws + WS_CTL, 0, CTL_BYTES, stream);
    (void)hipMemsetAsync((char*)d_ws + WS_SCR, 0, SCR_BYTES, stream);
    Args a{};
    const float** ap = (const float**)&a;
    for (int i = 0; i < 22; ++i) ap[i] = (const float*)d_in[i];
    a.out = (float*)d_out; a.ws = (unsigned char*)d_ws;
#if MK_N_LAUNCHES == 1
    a.ph_lo = 0; a.ph_hi = N_PHASES;
#if MK_BARRIER == 1
    hipLaunchKernelGGL(hybrid_fwd, dim3(grid), dim3(NTHREADS), LDS_BYTES, stream, a);
#else
    void* args[] = {&a};
    hipError_t e = hipLaunchCooperativeKernel((const void*)hybrid_fwd, dim3(grid), dim3(NTHREADS), args, LDS_BYTES, stream);
    if (e != hipSuccess) fprintf(stderr, "cooperative launch failed: %s (grid %d)\n", hipGetErrorString(e), grid);
#endif
#else
    for (int p = 0; p < N_PHASES; ++p) { a.ph_lo = p; a.ph_hi = p + 1; hipLaunchKernelGGL(hybrid_fwd, dim3(grid), dim3(NTHREADS), LDS_BYTES, stream, a); }
#endif
}
```

```cpp
#include <hip/hip_runtime.h>
#include <hip/hip_cooperative_groups.h>
#include <cstdio>
#include <cstdint>
namespace cg = cooperative_groups;

#ifndef MK_N_LAUNCHES
#define MK_N_LAUNCHES 1
#endif
#ifndef MK_BARRIER
#define MK_BARRIER 1
#endif

constexpr int D = 1024, NBATCH = 8, SEQ = 4096, NMETA = 16, TP = SEQ + NMETA, MP = NBATCH * TP;
constexpr int SBATCH = 128, TS = 4, MS = SBATCH * TS, MU = MP + MS, MUP = 33536, MC = NBATCH * SEQ + MS;
constexpr int PAST = 16384;
constexpr int HD = 64, NHA = 8, NKV = 2;
constexpr int NHB = 4, CONVD = 1536;
constexpr int DFF = 2816, NIN_SRC = 4872, NIN = 4864;
constexpr float EPS = 1e-6f;
constexpr float QSCALE = 0.125f * 1.4426950408889634f;

constexpr size_t MiB = 1u << 20, KiB = 1024;
constexpr size_t WS_CTL = 0, CTL_BYTES = 1 * MiB;
constexpr size_t WS_WIN = 1 * MiB;
constexpr size_t WS_WOA = 11 * MiB, WS_WOB = 12 * MiB;
constexpr size_t WS_WOUT = 13 * MiB;
constexpr size_t WS_WGU = 15 * MiB;
constexpr size_t WS_WD = 26 * MiB;
constexpr size_t WS_ROPE = 32 * MiB;
constexpr size_t WS_GB = 34 * MiB;
constexpr size_t WS_SC = 36 * MiB;
constexpr size_t WS_SS1 = 37 * MiB, WS_SS2 = 37 * MiB + 512 * KiB;
constexpr size_t WS_SCR = 38 * MiB, SCR_BYTES = 2 * MiB;
constexpr size_t CTL_SPL6 = 53248;
constexpr size_t CTL_SPL = 49152;
constexpr size_t WS_QA = 41 * MiB;
constexpr size_t WS_KV = WS_QA + (size_t)MUP * 512 * 2;
constexpr size_t WS_QKVB = WS_KV + (size_t)MUP * 256 * 2;
constexpr size_t WS_Z = WS_QKVB + (size_t)MUP * 1536 * 2;
constexpr size_t WS_G = WS_Z + (size_t)MUP * 512 * 2;
constexpr size_t WS_GEND = WS_G + (size_t)MUP * 2048 * 2;
constexpr size_t WS_B = 353 * MiB, WS_END = 512 * MiB;
static_assert(WS_GEND <= WS_B, "ws map");
constexpr size_t WS_XN = WS_B;
constexpr size_t PREP_SLOT = 80 * KiB;
constexpr int PREP_N1 = (int)((WS_END - WS_B) / PREP_SLOT);
constexpr size_t DO_OA = 44 * MiB;
constexpr int OAB_PITCH = 1024;
constexpr size_t DO_OB = DO_OA + 512 * 2;
constexpr size_t DO_ATS = DO_OA + (size_t)MC * OAB_PITCH * 2;
constexpr size_t ATS_ITEM = 3 * 32 * 32 * 4;
static_assert(DO_ATS + 212 * 8 * ATS_ITEM <= (size_t)MC * 1024 * 4, "d_out scratch map");
constexpr size_t WS_MB = WS_B;
constexpr size_t WS_HB1 = WS_B + 66 * MiB;
static_assert(WS_HB1 + (size_t)MC * 1024 * 2 <= WS_END, "ws map");
constexpr size_t WS_ACT = WS_QA;
static_assert(WS_ACT + (size_t)MC * DFF * 2 <= WS_G, "ws map");
constexpr int SL_BEK = 0, SL_BV = 16 * 1024, SL_T = 32 * 1024, SL_QKD = 40 * 1024, SL_QE = 48 * 1024, SL_KWT = 64 * 1024;
constexpr int N_PROMPT_SEQ = NBATCH * NHB, CHUNKS_P = 65, N_ITEMS_P = N_PROMPT_SEQ * CHUNKS_P, N_ITEMS = N_ITEMS_P + SBATCH * NHB;
static_assert((size_t)(N_ITEMS - PREP_N1) * PREP_SLOT <= DO_OA, "prep slots");

constexpr size_t O_YP = 0, O_YS = (size_t)NBATCH * SEQ * D, O_KP = O_YS + (size_t)MS * D, O_VP = O_KP + 8 * 128 * 2 * 64, O_DP = O_VP + 8 * 128 * 2 * 64,
                 O_CP = O_DP + 8 * 4 * 128 * 128, O_KS = O_CP + 8 * 3 * 1536, O_VS = O_KS + (size_t)128 * 128 * 2 * 64, O_DS = O_VS + (size_t)128 * 128 * 2 * 64,
                 O_CS = O_DS + (size_t)128 * 4 * 128 * 128, O_END = O_CS + (size_t)128 * 3 * 1536;
static_assert(O_END == 48074752, "d_out size");

#define DI __device__ __forceinline__
#define GAS __attribute__((address_space(1)))
#define LAS __attribute__((address_space(3)))
typedef unsigned short bf16;
typedef short bf16x8 __attribute__((ext_vector_type(8)));
typedef float f32x4 __attribute__((ext_vector_type(4)));
typedef float f32x2 __attribute__((ext_vector_type(2)));
typedef float f32x16 __attribute__((ext_vector_type(16)));
typedef unsigned u32x4 __attribute__((ext_vector_type(4)));
typedef unsigned u32x2 __attribute__((ext_vector_type(2)));
typedef __bf16 bf16x2_t __attribute__((ext_vector_type(2)));

DI unsigned cvtpk(float lo, float hi) { f32x2 v = {lo, hi}; bf16x2_t b = __builtin_convertvector(v, bf16x2_t); return __builtin_bit_cast(unsigned, b); }
DI bf16 f2bf(float f) { return (bf16)(cvtpk(f, 0.f) & 0xffffu); }
DI float bf2f(unsigned short h) { return __uint_as_float((unsigned)h << 16); }
DI float bflo(unsigned w) { return __uint_as_float(w << 16); }
DI float bfhi(unsigned w) { return __uint_as_float(w & 0xffff0000u); }
DI u32x4 pack8f(f32x4 a, f32x4 b) { u32x4 w; w.x = cvtpk(a[0], a[1]); w.y = cvtpk(a[2], a[3]); w.z = cvtpk(b[0], b[1]); w.w = cvtpk(b[2], b[3]); return w; }
DI float frcp_(float x) { return __builtin_amdgcn_rcpf(x); }
DI float sigmoidf_(float x) { return frcp_(1.0f + __builtin_amdgcn_exp2f(x * -1.4426950408889634f)); }
DI float siluf_(float x) { return x * sigmoidf_(x); }
DI void st16_sc1(void* p, u32x4 v) { asm volatile("global_store_dwordx4 %0, %1, off sc1\n\ts_nop 1" :: "v"(p), "v"(v) : "memory"); }
DI void st16_sc1f(void* p, f32x4 v) { asm volatile("global_store_dwordx4 %0, %1, off sc1\n\ts_nop 1" :: "v"(p), "v"(v) : "memory"); }
DI void st2_sc1(void* p, unsigned v) { asm volatile("global_store_short %0, %1, off sc1\n\ts_nop 1" :: "v"(p), "v"(v) : "memory"); }
constexpr size_t CTL_GRAN = 65536, CTL_CNT = 245760, CTL_SS1 = 458752;
static_assert(CTL_CNT + 5 * 130 * 256 <= CTL_SS1 && CTL_SS1 + 33280 * 4 <= 1048576 && CTL_GRAN + 2592 * 64 <= CTL_CNT, "control region map");
constexpr int CNT_STRIDE = 130 * 64;
DI int pos_of_d(int d) { const int dd = d & 31; return 8 * (dd >> 2) + (dd & 3) + ((d >> 5) << 2); }
DI int d_of_pos(int p) { const int j = p & 7; return 4 * (p >> 3) + (j & 3) + ((j >> 2) << 5); }
namespace pg8 {
#define PG8_LAS __attribute__((address_space(3)))
typedef unsigned short bf16_t;
typedef short bf16x8 __attribute__((ext_vector_type(8)));
typedef float f32x4 __attribute__((ext_vector_type(4)));
typedef unsigned u32x4 __attribute__((ext_vector_type(4)));
constexpr int BM = 256, BK = 64, HALF = 128, HTB = HALF * BK * 2  , STAGE_BYTES = 8 * HTB, NXCD = 8, WGM = 8;

__host__ __device__ __forceinline__ int lds_byte(int r, int c) { const int st = (r >> 4) * 2 + (c >> 5), rr = r & 15, cc = c & 31, ob = rr * 64 + cc * 2; return st * 1024 + (ob ^ (((ob >> 9) & 1) << 5)); }
__host__ __device__ __forceinline__ void stage_rc(int b, int& R, int& C) { const int st = b / 1024, sb = b % 1024, swz = sb ^ (((sb >> 9) & 1) << 5); R = (st >> 1) * 16 + swz / 64; C = (st & 1) * 32 + (swz % 64) / 2; }
__host__ __device__ __forceinline__ int perm32(int rho) { const int n = rho >> 4, i = rho & 15; return 8 * (i >> 2) + 4 * n + (i & 3); }

struct Unit { int pm, pn; };
struct Gemm { const bf16_t* A; const bf16_t* Bt; int M, N, K; int ldk; };

struct StaticOrder {
    static constexpr bool A_SC1 = false;
    int nM, nN, nwg, G, c, lim;
    __host__ __device__ void init(int M, int N, int G_, int c_) { nM = M / BM; nN = N / BM; nwg = nM * nN; G = G_; c = c_; lim = nwg; }
    __host__ __device__ bool next(int i, Unit& u) const {
        const long L = (long)i * G + c; if (L >= lim) return false;
        int wgid = (int)L; { const int q = nwg / NXCD, r = nwg % NXCD, xcd = wgid % NXCD, off = wgid / NXCD; wgid = (xcd < r ? xcd * (q + 1) : r * (q + 1) + (xcd - r) * q) + off; }
        const int nig = WGM * nN, gid = wgid / nig, fm = gid * WGM, gsz = (nM - fm) < WGM ? (nM - fm) : WGM;
        u.pm = fm + ((wgid % nig) % gsz); u.pn = (wgid % nig) / gsz; return true;
    }
    __device__ __forceinline__ void a_ready(const Unit&) const {}
    __device__ __forceinline__ void done(const Unit&) const {}
};
struct FlagOrder : StaticOrder {
    static constexpr bool A_SC1 = true;
    const unsigned* ready; unsigned need; unsigned* pub; unsigned* gpub;
    __device__ __forceinline__ void a_ready(const Unit& u) const {
        if (ready) {
            if (threadIdx.x < 64) { unsigned spins = 0;
                while ((unsigned)__builtin_amdgcn_readfirstlane(__hip_atomic_load(ready + 64 * u.pm, __ATOMIC_RELAXED, __HIP_MEMORY_SCOPE_AGENT)) < need) { __builtin_amdgcn_s_sleep(2); if (++spins > (1u << 22)) break; } }
            asm volatile("" ::: "memory"); __builtin_amdgcn_s_barrier(); asm volatile("" ::: "memory");
        }
    }
    __device__ __forceinline__ void done(const Unit& u) const {
        if (pub) { asm volatile("s_waitcnt vmcnt(0)" ::: "memory");
            if ((threadIdx.x & 63) == 0) { __hip_atomic_fetch_add(pub + 64 * u.pm, 1u, __ATOMIC_RELAXED, __HIP_MEMORY_SCOPE_AGENT); if (gpub) __hip_atomic_fetch_add(gpub, 1u, __ATOMIC_RELAXED, __HIP_MEMORY_SCOPE_AGENT); } }
    }
};
struct SliceOrder : StaticOrder {
    int t;
    __host__ __device__ void init_slice(int M, int N, int G_, int first, int t_) { init(M, N, G_, 0); t = t_; c = first + t_; G = 0; }
    __host__ __device__ bool next(int i, Unit& u) const { return i == 0 ? StaticOrder::next(0, u) : false; }
};

__device__ __forceinline__ void urow_info(int urow, int& kind, int& b, int& t, int& ridx) {
    if (urow < MP) { b = urow / TP; t = urow - b * TP; kind = 0; ridx = t; }
    else if (urow < MU) { const int s = urow - MP; b = s >> 2; t = s & 3; kind = 1; ridx = TP + t; }
    else { kind = 2; b = 0; t = 0; ridx = 0; }
}
__device__ __forceinline__ int crow_to_urow(int crow) { return crow < NBATCH * SEQ ? crow + NMETA * ((crow >> 12) + 1) : MP + (crow - NBATCH * SEQ); }

struct EpiInProj {
    static constexpr bool PERM = true, AFTER_DRAIN = false;
    bf16_t *QA, *KV, *QKVB, *Z, *G; const float *COS, *SIN; float* out;
    __device__ __forceinline__ void operator()(const f32x4 (&acc)[2][2][4][2], const Unit& u, int wr, int wc, int fr, int fq) const {
        const int pn = u.pn;
#pragma unroll
        for (int ai = 0; ai < 2; ++ai)
#pragma unroll
            for (int m = 0; m < 4; ++m) {
                const int row = u.pm * BM + ai * HALF + wr * 64 + m * 16 + fr;
                int kind, b, t, ridx; urow_info(row, kind, b, t, ridx);
#pragma unroll
                for (int bj = 0; bj < 2; ++bj) {
                    const int cl = bj * HALF + wc * 32 + 8 * fq;
                    const f32x4 v0 = acc[ai][bj][m][0], v1 = acc[ai][bj][m][1];
                    if (pn < 2) {
                        const int c = pn * 256 + cl, d0 = ((c & 63) >> 3) * 4;
                        const f32x4 cs = *(const f32x4*)(COS + ridx * 32 + d0), sn = *(const f32x4*)(SIN + ridx * 32 + d0);
                        const f32x4 o1 = (v0 * cs - v1 * sn) * QSCALE, o2 = (v1 * cs + v0 * sn) * QSCALE;
                        *(u32x4*)(QA + (size_t)row * 512 + c) = pack8f(o1, o2);
                    } else if (pn == 2) {
                        if (bj == 0) {
                            const int kh = cl >> 6, d0 = ((cl & 63) >> 3) * 4;
                            const f32x4 cs = *(const f32x4*)(COS + ridx * 32 + d0), sn = *(const f32x4*)(SIN + ridx * 32 + d0);
                            const f32x4 o1 = v0 * cs - v1 * sn, o2 = v1 * cs + v0 * sn;
                            *(u32x4*)(KV + (size_t)row * 256 + cl) = pack8f(o1, o2);
                            float* dst = nullptr;
                            if (kind == 0 && t >= TP - 128) dst = out + O_KP + ((size_t)(b * 128 + (t - (TP - 128))) * 2 + kh) * 64;
                            else if (kind == 1) dst = out + O_KS + ((size_t)(b * 128 + 124 + t) * 2 + kh) * 64;
                            if (dst) { *(f32x4*)(dst + d0) = o1; *(f32x4*)(dst + 32 + d0) = o2; }
                        } else {
                            const int cv = cl - 128, kh = cv >> 6, dd = cv & 63;
                            *(u32x4*)(KV + (size_t)row * 256 + cl) = pack8f(v0, v1);
                            float* dst = nullptr;
                            if (kind == 0 && t >= TP - 128) dst = out + O_VP + ((size_t)(b * 128 + (t - (TP - 128))) * 2 + kh) * 64;
                            else if (kind == 1) dst = out + O_VS + ((size_t)(b * 128 + 124 + t) * 2 + kh) * 64;
                            if (dst) { *(f32x4*)(dst + dd) = v0; *(f32x4*)(dst + dd + 4) = v1; }
                        }
                    } else if (pn < 9) {
                        const int c = (pn - 3) * 256 + cl;
                        *(u32x4*)(QKVB + (size_t)row * 1536 + c) = pack8f(v0, v1);
                        float* dst = nullptr;
                        if (kind == 0 && t >= TP - 3) dst = out + O_CP + ((size_t)b * 3 + (t - (TP - 3))) * 1536;
                        else if (kind == 1 && t >= 1) dst = out + O_CS + ((size_t)b * 3 + (t - 1)) * 1536;
                        if (dst) { *(f32x4*)(dst + c) = v0; *(f32x4*)(dst + c + 4) = v1; }
                    } else if (pn < 11) {
                        const int c = (pn - 9) * 256 + cl;
                        *(u32x4*)(Z + (size_t)row * 512 + c) = pack8f(v0, v1);
                    } else {
                        const int c = (pn - 11) * 256 + cl;
                        f32x4 g0, g1;
#pragma unroll
                        for (int e = 0; e < 4; ++e) { g0[e] = sigmoidf_(v0[e]); g1[e] = sigmoidf_(v1[e]); }
                        *(u32x4*)(G + (size_t)row * 2048 + c) = pack8f(g0, g1);
                    }
                }
            }
    }
};

template <bool ACCUM> struct EpiMerge {
    static constexpr bool PERM = true, AFTER_DRAIN = false;
    bf16_t* MBp; const bf16_t* G; int gate_off;
    __device__ __forceinline__ void operator()(const f32x4 (&acc)[2][2][4][2], const Unit& u, int wr, int wc, int fr, int fq) const {
#pragma unroll
        for (int ai = 0; ai < 2; ++ai)
#pragma unroll
            for (int m = 0; m < 4; ++m) {
                const int crow = u.pm * BM + ai * HALF + wr * 64 + m * 16 + fr, urow = crow_to_urow(crow);
#pragma unroll
                for (int bj = 0; bj < 2; ++bj) {
                    const int c = u.pn * BM + bj * HALF + wc * 32 + 8 * fq;
                    const u32x4 gw = *(const u32x4*)(G + (size_t)urow * 2048 + gate_off + c);
                    f32x4 v0 = acc[ai][bj][m][0], v1 = acc[ai][bj][m][1];
                    v0[0] *= bflo(gw.x); v0[1] *= bfhi(gw.x); v0[2] *= bflo(gw.y); v0[3] *= bfhi(gw.y);
                    v1[0] *= bflo(gw.z); v1[1] *= bfhi(gw.z); v1[2] *= bflo(gw.w); v1[3] *= bfhi(gw.w);
                    bf16_t* p = MBp + (size_t)crow * 1024 + c;
                    if (ACCUM) { const u32x4 pw = *(const u32x4*)p;
                        v0[0] += bflo(pw.x); v0[1] += bfhi(pw.x); v0[2] += bflo(pw.y); v0[3] += bfhi(pw.y);
                        v1[0] += bflo(pw.z); v1[1] += bfhi(pw.z); v1[2] += bflo(pw.w); v1[3] += bfhi(pw.w); }
                    *(u32x4*)p = pack8f(v0, v1);
                }
            }
    }
};

template <bool ATOM = true> struct EpiWout {
    static constexpr bool PERM = true, AFTER_DRAIN = false;
    const float* xp; const float* xs; bf16_t* HB; float* SS;
    __device__ __forceinline__ void operator()(const f32x4 (&acc)[2][2][4][2], const Unit& u, int wr, int wc, int fr, int fq) const {
#pragma unroll
        for (int ai = 0; ai < 2; ++ai)
#pragma unroll
            for (int m = 0; m < 4; ++m) {
                const int crow = u.pm * BM + ai * HALF + wr * 64 + m * 16 + fr;
                const float* hs = crow < NBATCH * SEQ ? xp + (size_t)crow * D : xs + (size_t)(crow - NBATCH * SEQ) * D;
                float ss = 0.f;
#pragma unroll
                for (int bj = 0; bj < 2; ++bj) {
                    const int c = u.pn * BM + bj * HALF + wc * 32 + 8 * fq;
                    const f32x4 r0 = *(const f32x4*)(hs + c) + acc[ai][bj][m][0], r1 = *(const f32x4*)(hs + c + 4) + acc[ai][bj][m][1];
                    *(u32x4*)(HB + (size_t)crow * D + c) = pack8f(r0, r1);
                    ss += (r0[0] * r0[0] + r0[1] * r0[1]) + (r0[2] * r0[2] + r0[3] * r0[3]) + (r1[0] * r1[0] + r1[1] * r1[1]) + (r1[2] * r1[2] + r1[3] * r1[3]);
                }
                ss += __shfl_xor(ss, 16); ss += __shfl_xor(ss, 32);
                if (ATOM && fq == 0) atomicAdd(SS + crow, ss);
            }
    }
};

struct EpiGateUp {
    static constexpr bool PERM = true, AFTER_DRAIN = false;
    bf16_t* ACT; const float* SS;
    __device__ __forceinline__ void operator()(const f32x4 (&acc)[2][2][4][2], const Unit& u, int wr, int wc, int fr, int fq) const {
#pragma unroll
        for (int ai = 0; ai < 2; ++ai)
#pragma unroll
            for (int m = 0; m < 4; ++m) {
                const int crow = u.pm * BM + ai * HALF + wr * 64 + m * 16 + fr;
                const float rstd = rsqrtf(SS[crow] * (1.0f / D) + EPS);
                f32x4 a[2];
#pragma unroll
                for (int n = 0; n < 2; ++n)
#pragma unroll
                    for (int e = 0; e < 4; ++e) { const float g = acc[ai][0][m][n][e] * rstd, up = acc[ai][1][m][n][e] * rstd; a[n][e] = siluf_(g) * up; }
                *(u32x4*)(ACT + (size_t)crow * DFF + u.pn * HALF + wc * 32 + 8 * fq) = pack8f(a[0], a[1]);
            }
    }
};

template <bool DRY = false> struct EpiDown {
    static constexpr bool PERM = true, AFTER_DRAIN = false;
    const bf16_t* HB; bf16_t* H2;
    __device__ __forceinline__ void operator()(const f32x4 (&acc)[2][2][4][2], const Unit& u, int wr, int wc, int fr, int fq) const {
#pragma unroll
        for (int ai = 0; ai < 2; ++ai)
#pragma unroll
            for (int m = 0; m < 4; ++m) {
                const int crow = u.pm * BM + ai * HALF + wr * 64 + m * 16 + fr;
#pragma unroll
                for (int bj = 0; bj < 2; ++bj) {
                    const size_t off = (size_t)crow * D + u.pn * BM + bj * HALF + wc * 32 + 8 * fq;
                    const u32x4 hw = *(const u32x4*)(HB + off);
                    f32x4 r0 = acc[ai][bj][m][0], r1 = acc[ai][bj][m][1];
                    r0[0] += bflo(hw.x); r0[1] += bfhi(hw.x); r0[2] += bflo(hw.y); r0[3] += bfhi(hw.y);
                    r1[0] += bflo(hw.z); r1[1] += bfhi(hw.z); r1[2] += bflo(hw.w); r1[3] += bfhi(hw.w);
                    *(u32x4*)(H2 + off) = pack8f(r0, r1);
                }
            }
    }
};

template <class Inner, bool GATED = false> struct EpiSplit {
    static constexpr bool PERM = Inner::PERM, AFTER_DRAIN = false;
    Inner inner; float* scr; unsigned* cnt; unsigned S; const bf16_t* G; int gate_off;
    __device__ __forceinline__ void operator()(const f32x4 (&acc_)[2][2][4][2], const Unit& u, int wr, int wc, int fr, int fq) const {
        f32x4 (&acc)[2][2][4][2] = const_cast<f32x4 (&)[2][2][4][2]>(acc_);
        const int lane = fr + 16 * fq, wave = wr * 4 + wc;
        float* p = scr + (size_t)wave * 8192 + lane;
#pragma unroll
        for (int ai = 0; ai < 2; ++ai)
#pragma unroll
            for (int m = 0; m < 4; ++m) {
                int urow = 0;
                if (GATED) urow = crow_to_urow(u.pm * BM + ai * HALF + wr * 64 + m * 16 + fr);
#pragma unroll
                for (int bj = 0; bj < 2; ++bj) {
                    f32x4 v0 = acc[ai][bj][m][0], v1 = acc[ai][bj][m][1];
                    if (GATED) { const u32x4 gw = *(const u32x4*)(G + (size_t)urow * 2048 + gate_off + u.pn * BM + bj * HALF + wc * 32 + 8 * fq);
                        v0[0] *= bflo(gw.x); v0[1] *= bfhi(gw.x); v0[2] *= bflo(gw.y); v0[3] *= bfhi(gw.y); v1[0] *= bflo(gw.z); v1[1] *= bfhi(gw.z); v1[2] *= bflo(gw.w); v1[3] *= bfhi(gw.w); }
                    float* q = p + (((ai * 2 + bj) * 4 + m) * 8) * 64;
                    asm volatile("" : "+v"(q));
#pragma unroll
                    for (int x = 0; x < 4; ++x) { unsafeAtomicAdd(q + x * 64, v0[x]); unsafeAtomicAdd(q + (4 + x) * 64, v1[x]); }
                }
            }
        asm volatile("s_waitcnt vmcnt(0)" ::: "memory");
        unsigned old = 0u;
        if (lane == 0) old = __hip_atomic_fetch_add(cnt + wave, 1u, __ATOMIC_RELAXED, __HIP_MEMORY_SCOPE_AGENT);
        old = (unsigned)__builtin_amdgcn_readfirstlane((int)old);
        if (old == S - 1u) {
#pragma unroll
            for (int ai = 0; ai < 2; ++ai)
#pragma unroll
                for (int bj = 0; bj < 2; ++bj)
#pragma unroll
                    for (int m = 0; m < 4; ++m) {
                        float* q = p + (((ai * 2 + bj) * 4 + m) * 8) * 64;
                        asm volatile("" : "+v"(q));
#pragma unroll
                        for (int n = 0; n < 2; ++n)
#pragma unroll
                            for (int x = 0; x < 4; ++x) acc[ai][bj][m][n][x] = __hip_atomic_exchange(q + (n * 4 + x) * 64, 0.0f, __ATOMIC_RELAXED, __HIP_MEMORY_SCOPE_AGENT);
                    }
            if (lane == 0) __hip_atomic_store(cnt + wave, 0u, __ATOMIC_RELAXED, __HIP_MEMORY_SCOPE_AGENT);
            inner(acc, u, wr, wc, fr, fq);
        }
    }
};
struct EpiStoreMB {
    static constexpr bool PERM = true, AFTER_DRAIN = false;
    bf16_t* MBp;
    __device__ __forceinline__ void operator()(const f32x4 (&acc)[2][2][4][2], const Unit& u, int wr, int wc, int fr, int fq) const {
#pragma unroll
        for (int ai = 0; ai < 2; ++ai)
#pragma unroll
            for (int m = 0; m < 4; ++m) {
                const int crow = u.pm * BM + ai * HALF + wr * 64 + m * 16 + fr;
#pragma unroll
                for (int bj = 0; bj < 2; ++bj) *(u32x4*)(MBp + (size_t)crow * 1024 + u.pn * BM + bj * HALF + wc * 32 + 8 * fq) = pack8f(acc[ai][bj][m][0], acc[ai][bj][m][1]);
            }
    }
};

template <class Epi, class Sched, bool ALIGN_EPI = false, bool SP2 = false>
__device__ __forceinline__ void gemm_phase(PG8_LAS unsigned char* lds, const Gemm g, const Sched& S, const Epi& E) {
    const int tid = threadIdx.x, wid = __builtin_amdgcn_readfirstlane(tid >> 6), lane = tid & 63, wr = wid >> 2, wc = wid & 3, fr = lane & 15, fq = lane >> 4;
    const int K = g.ldk ? g.ldk : g.K, nt = g.K / BK;
    unsigned voffA[2], voffB[2];
#pragma unroll
    for (int i = 0; i < 2; ++i) { int R, C; stage_rc(tid * 16 + i * 8192, R, C); const int Rb = Epi::PERM ? ((R & ~31) + perm32(R & 31)) : R;
        voffA[i] = (unsigned)(R * K + C) * 2u; voffB[i] = (unsigned)(Rb * K + C) * 2u; }
    const size_t kstep = (size_t)(BK * 2);
    const size_t hstep = (size_t)HALF * K * 2;
    const size_t tstep = 2 * hstep;
    const unsigned ldsw = (unsigned)wid * 1024u;
    const int aoff = lds_byte(wr * 64 + fr, fq * 8), boff = lds_byte(wc * 32 + fr, fq * 8);
#define PG8_SA(b, h) (((b) * 2 + (h)) * HTB)
#define PG8_SB(b, h) ((4 + (b) * 2 + (h)) * HTB)
#define PG8_STAGE(bufoff, gbase, voff) do { _Pragma("unroll") for (int _i = 0; _i < 2; ++_i) \
        __builtin_amdgcn_global_load_lds((const unsigned*)((const char*)(gbase) + (voff)[_i]), (PG8_LAS unsigned*)(lds + (bufoff) + ldsw + _i * 8192), 16, 0, 0); } while (0)
#define PG8_STAGE_A(bufoff, gbase, voff) do { _Pragma("unroll") for (int _i = 0; _i < 2; ++_i) { \
        if constexpr (Sched::A_SC1) __builtin_amdgcn_global_load_lds((const unsigned*)((const char*)(gbase) + (voff)[_i]), (PG8_LAS unsigned*)(lds + (bufoff) + ldsw + _i * 8192), 16, 0, 16); \
        else __builtin_amdgcn_global_load_lds((const unsigned*)((const char*)(gbase) + (voff)[_i]), (PG8_LAS unsigned*)(lds + (bufoff) + ldsw + _i * 8192), 16, 0, 0); } } while (0)
#define PG8_LDA(dst, b, h) do { _Pragma("unroll") for (int m = 0; m < 4; ++m) _Pragma("unroll") for (int k = 0; k < 2; ++k) dst[m][k] = *(const PG8_LAS bf16x8*)(lds + PG8_SA(b, h) + aoff + m * 2048 + k * 1024); } while (0)
#define PG8_LDB(dst, b, h) do { _Pragma("unroll") for (int n = 0; n < 2; ++n) _Pragma("unroll") for (int k = 0; k < 2; ++k) dst[n][k] = *(const PG8_LAS bf16x8*)(lds + PG8_SB(b, h) + boff + n * 2048 + k * 1024); } while (0)
#define PG8_MMA(ai, bj, At, Bt) do { __builtin_amdgcn_s_setprio(1); _Pragma("unroll") for (int m = 0; m < 4; ++m) _Pragma("unroll") for (int n = 0; n < 2; ++n) _Pragma("unroll") for (int k = 0; k < 2; ++k) \
        acc[ai][bj][m][n] = __builtin_amdgcn_mfma_f32_16x16x32_bf16(Bt[n][k], At[m][k], acc[ai][bj][m][n], 0, 0, 0); __builtin_amdgcn_s_setprio(0); } while (0)
#define PG8_WAIT_V(n) asm volatile("s_waitcnt vmcnt(" #n ")" ::: "memory")
#define PG8_WAIT_L(n) asm volatile("s_waitcnt lgkmcnt(" #n ")" ::: "memory")
#define PG8_BAR __builtin_amdgcn_s_barrier()
#define PG8_SCHED __builtin_amdgcn_sched_barrier(0)
    Unit cur, nxt; int ui = 0;
    if (!S.next(0, cur)) return;
    f32x4 acc[2][2][4][2];
#pragma unroll
    for (int a = 0; a < 2; ++a)
#pragma unroll
        for (int b = 0; b < 2; ++b)
#pragma unroll
            for (int m = 0; m < 4; ++m)
#pragma unroll
                for (int n = 0; n < 2; ++n) acc[a][b][m][n] = (f32x4){0.f, 0.f, 0.f, 0.f};
    bf16x8 At[4][2], B0[2][2], B1[2][2];
    const char* cA = (const char*)g.A + (size_t)cur.pm * tstep; const char* cB = (const char*)g.Bt + (size_t)cur.pn * tstep;
    S.a_ready(cur);
    if constexpr (SP2) {
        PG8_STAGE(PG8_SB(0, 0), cB, voffB); PG8_STAGE(PG8_SB(0, 1), cB + hstep, voffB); PG8_STAGE_A(PG8_SA(0, 0), cA, voffA); PG8_STAGE_A(PG8_SA(0, 1), cA + hstep, voffA);
        if (wr == 1) PG8_BAR;
        PG8_WAIT_V(2); PG8_BAR;
        PG8_STAGE(PG8_SB(1, 0), cB + kstep, voffB); PG8_STAGE_A(PG8_SA(1, 0), cA + kstep, voffA); PG8_STAGE(PG8_SB(1, 1), cB + hstep + kstep, voffB);
        PG8_WAIT_V(6); PG8_BAR;
    } else {
        PG8_STAGE(PG8_SB(0, 0), cB, voffB); PG8_STAGE_A(PG8_SA(0, 0), cA, voffA); PG8_STAGE(PG8_SB(0, 1), cB + hstep, voffB); PG8_STAGE_A(PG8_SA(0, 1), cA + hstep, voffA);
        if (wr == 1) PG8_BAR;
        PG8_WAIT_V(4); PG8_BAR;
        PG8_STAGE(PG8_SB(1, 0), cB + kstep, voffB); PG8_STAGE_A(PG8_SA(1, 0), cA + kstep, voffA); PG8_STAGE(PG8_SB(1, 1), cB + hstep + kstep, voffB);
        PG8_WAIT_V(6); PG8_BAR;
    }
    for (;;) {
        const bool has_next = S.next(ui + 1, nxt);
        const char* nA = has_next ? (const char*)g.A + (size_t)nxt.pm * tstep : cA; const char* nB = has_next ? (const char*)g.Bt + (size_t)nxt.pn * tstep : cB;
        for (int t = 0; t < nt; t += 2) {
            const bool last = (t == nt - 2);
            const char* a1 = cA + (size_t)(t + 1) * kstep;
            const char* a2 = last ? nA : cA + (size_t)(t + 2) * kstep; const char* b2 = last ? nB : cB + (size_t)(t + 2) * kstep;
            const char* a3 = a2 + kstep; const char* b3 = b2 + kstep;
            if (last && has_next) S.a_ready(nxt);
            if constexpr (SP2) {
            PG8_LDB(B0, 0, 0); PG8_LDB(B1, 0, 1); PG8_SCHED; PG8_LDA(At, 0, 0); PG8_STAGE_A(PG8_SA(1, 1), a1 + hstep, voffA);
            PG8_WAIT_V(8); PG8_WAIT_L(0); PG8_BAR; PG8_MMA(0, 0, At, B0); PG8_MMA(0, 1, At, B1); PG8_BAR; PG8_SCHED;
            PG8_LDA(At, 0, 1); PG8_STAGE(PG8_SB(0, 0), b2, voffB); PG8_STAGE(PG8_SB(0, 1), b2 + hstep, voffB); PG8_STAGE_A(PG8_SA(0, 0), a2, voffA);
            PG8_WAIT_V(8); PG8_WAIT_L(0); PG8_BAR; PG8_MMA(1, 0, At, B0); PG8_MMA(1, 1, At, B1); PG8_BAR; PG8_SCHED;
            PG8_LDB(B0, 1, 0); PG8_LDB(B1, 1, 1); PG8_SCHED; PG8_LDA(At, 1, 0); PG8_STAGE_A(PG8_SA(0, 1), a2 + hstep, voffA);
            PG8_WAIT_V(8); PG8_WAIT_L(0); PG8_BAR; PG8_MMA(0, 0, At, B0); PG8_MMA(0, 1, At, B1); PG8_BAR; PG8_SCHED;
            PG8_LDA(At, 1, 1); PG8_STAGE(PG8_SB(1, 0), b3, voffB); PG8_STAGE(PG8_SB(1, 1), b3 + hstep, voffB); PG8_STAGE_A(PG8_SA(1, 0), a3, voffA);
            PG8_WAIT_V(8); PG8_WAIT_L(0); PG8_BAR; PG8_MMA(1, 0, At, B0); PG8_MMA(1, 1, At, B1); PG8_BAR; PG8_SCHED;
            } else {
            PG8_LDB(B0, 0, 0); PG8_SCHED; PG8_LDA(At, 0, 0); PG8_STAGE_A(PG8_SA(1, 1), a1 + hstep, voffA);
            PG8_WAIT_L(8); PG8_BAR; PG8_WAIT_L(0); PG8_MMA(0, 0, At, B0); PG8_BAR; PG8_SCHED;
            PG8_LDB(B1, 0, 1); PG8_STAGE(PG8_SB(0, 0), b2, voffB);
            PG8_BAR; PG8_WAIT_L(0); PG8_MMA(0, 1, At, B1); PG8_BAR;
            PG8_LDA(At, 0, 1); PG8_STAGE_A(PG8_SA(0, 0), a2, voffA);
            PG8_BAR; PG8_WAIT_L(0); PG8_MMA(1, 0, At, B0); PG8_BAR; PG8_SCHED;
            PG8_STAGE(PG8_SB(0, 1), b2 + hstep, voffB);
            PG8_WAIT_V(6); PG8_BAR; PG8_MMA(1, 1, At, B1); PG8_BAR;
            PG8_LDB(B0, 1, 0); PG8_SCHED; PG8_LDA(At, 1, 0); PG8_STAGE_A(PG8_SA(0, 1), a2 + hstep, voffA);
            PG8_WAIT_L(8); PG8_BAR; PG8_WAIT_L(0); PG8_MMA(0, 0, At, B0); PG8_BAR; PG8_SCHED;
            PG8_LDB(B1, 1, 1); PG8_STAGE(PG8_SB(1, 0), b3, voffB);
            PG8_BAR; PG8_WAIT_L(0); PG8_MMA(0, 1, At, B1); PG8_BAR;
            PG8_LDA(At, 1, 1); PG8_STAGE_A(PG8_SA(1, 0), a3, voffA);
            PG8_BAR; PG8_WAIT_L(0); PG8_MMA(1, 0, At, B0); PG8_BAR; PG8_SCHED;
            PG8_STAGE(PG8_SB(1, 1), b3 + hstep, voffB);
            PG8_WAIT_V(6); PG8_BAR; PG8_MMA(1, 1, At, B1); PG8_BAR;
            }
        }
        if constexpr (ALIGN_EPI) { if (wr == 0) PG8_BAR; }
        if constexpr (!Epi::AFTER_DRAIN) { E(acc, cur, wr, wc, fr, fq); S.done(cur); }
        if (!has_next) break;
#pragma unroll
        for (int a = 0; a < 2; ++a)
#pragma unroll
            for (int b = 0; b < 2; ++b)
#pragma unroll
                for (int m = 0; m < 4; ++m)
#pragma unroll
                    for (int n = 0; n < 2; ++n) acc[a][b][m][n] = (f32x4){0.f, 0.f, 0.f, 0.f};
        cur = nxt; cA = nA; cB = nB; ++ui;
        if constexpr (ALIGN_EPI) { if (wr == 1) PG8_BAR; }
    }
    PG8_WAIT_V(0);
    if constexpr (!ALIGN_EPI) { if (wr == 0) PG8_BAR; }
    PG8_BAR;
    if constexpr (Epi::AFTER_DRAIN) { E.fused(acc, cur, wr, wc, fr, fq, lds, wid, lane); S.done(cur); }
#undef PG8_SA
#undef PG8_SB
#undef PG8_STAGE
#undef PG8_STAGE_A
#undef PG8_LDA
#undef PG8_LDB
#undef PG8_MMA
#undef PG8_WAIT_V
#undef PG8_WAIT_L
#undef PG8_BAR
#undef PG8_SCHED
}
}
constexpr int NWAVES = 8, NTHREADS = NWAVES * 64;
constexpr int LDS_BYTES = 147456;
constexpr int LDS_MISC = 131072;
constexpr int N_PHASES = 9;

struct Args {
    const float *x_prompt, *x_sample, *cache_k, *cache_v, *state_delta, *state_conv, *meta, *norm_mix, *w_in, *conv_w, *a_log, *dt_bias, *sinks, *gdn_norm,
                *w_oa, *w_ob, *w_out, *norm_ffn, *w_gate, *w_up, *w_down, *norm_final;
    float* out; unsigned char* ws; int ph_lo, ph_hi;
};

typedef const __attribute__((address_space(4))) Args* KA;
DI KA kargs() { KA p = (KA)__builtin_amdgcn_kernarg_segment_ptr(); asm volatile("" : "+s"(p)); return p; }
#define RLX_AGENT __ATOMIC_RELAXED, __HIP_MEMORY_SCOPE_AGENT
#define LDS_WAIT() asm volatile("s_waitcnt lgkmcnt(0)" ::: "memory")
#define MFMA32(a, b, c) __builtin_amdgcn_mfma_f32_32x32x16_bf16((a), (b), (c), 0, 0, 0)
DI int crow16(int reg, int h) { return (reg & 3) + 8 * (reg >> 2) + 4 * h; }
DI float wave_sum(float v) {
#pragma unroll
    for (int o = 1; o < 64; o <<= 1) v += __shfl_xor(v, o);
    return v;
}
DI float wave_max(float v) {
#pragma unroll
    for (int o = 1; o < 64; o <<= 1) v = fmaxf(v, __shfl_xor(v, o));
    return v;
}
template <int S> DI bf16x8 pack_step(const f32x16& x) {
    u32x4 p; p.x = cvtpk(x[8 * S], x[8 * S + 1]); p.y = cvtpk(x[8 * S + 2], x[8 * S + 3]); p.z = cvtpk(x[8 * S + 4], x[8 * S + 5]); p.w = cvtpk(x[8 * S + 6], x[8 * S + 7]);
    return __builtin_bit_cast(bf16x8, p);
}
DI int frag_idx(int row, int k, int NKS) { const int kkk = k & 15; return (((row >> 5) * NKS + (k >> 4)) * 64 + (row & 31) + 32 * ((kkk >> 2) & 1)) * 8 + (((kkk >> 3) << 2) | (kkk & 3)); }
DI unsigned char* slot_ptr(KA A, int item) { return item < PREP_N1 ? A->ws + WS_B + (size_t)item * PREP_SLOT : (unsigned char*)A->out + (size_t)(item - PREP_N1) * PREP_SLOT; }

#define XB_TMO      128
#define XB_XCNT(j)  (256  + 64 * (j))
#define XB_XSUB(j)  (1280 + 64 * (j))
#define XB_XGEN(j)  (2304 + 64 * (j))
#define XB_TOP      3328
#define XB_TOPGEN   3392
#define XCD_BAR_WORDS 3456
#define XB_SPIN_CAP (1u << 20)
DI unsigned xb_ld(unsigned* p)              { return __hip_atomic_load(p, __ATOMIC_RELAXED, __HIP_MEMORY_SCOPE_AGENT); }
DI unsigned xb_add(unsigned* p, unsigned v) { return __hip_atomic_fetch_add(p, v, __ATOMIC_RELAXED, __HIP_MEMORY_SCOPE_AGENT); }
DI unsigned xb_xcc_id() { return (unsigned)__builtin_amdgcn_s_getreg((3 << 11) | 20) & 0xFu; }
#define XB_SPIN(cond, bar) do { unsigned _sp = 0; while (cond) { __builtin_amdgcn_s_sleep(1); \
    if ((++_sp & 255u) == 0u) { if (xb_ld(&(bar)[XB_TMO])) break; if (_sp > XB_SPIN_CAP) { atomicAdd(&(bar)[XB_TMO], 1u); break; } } } } while (0)
struct XcdBarrier { unsigned* bar; unsigned x; volatile LAS unsigned* st; };
DI XcdBarrier xcd_barrier_post(unsigned* bar, volatile LAS unsigned* st) {
    XcdBarrier b; b.bar = bar; b.x = xb_xcc_id(); b.st = st;
    if (threadIdx.x == 0) (void)xb_add(&bar[XB_XCNT(b.x)], 1u);
    return b;
}
DI void xcd_barrier_complete(unsigned* bar, unsigned x, unsigned& nloc, unsigned& nx) {
    const unsigned G = gridDim.x * gridDim.y * gridDim.z;
    unsigned sum, cnt, mine, sp = 0u;
    for (;;) {
        sum = 0u; cnt = 0u; mine = 0u;
#pragma unroll
        for (unsigned j = 0; j < 16; ++j) { const unsigned c = xb_ld(&bar[XB_XCNT(j)]); sum += c; cnt += (c > 0u) ? 1u : 0u; mine = (j == x) ? c : mine; }
        if (sum == G) break;
        __builtin_amdgcn_s_sleep(1);
        if ((++sp & 255u) == 0u) { if (xb_ld(&bar[XB_TMO])) break; if (sp > XB_SPIN_CAP) { atomicAdd(&bar[XB_TMO], 1u); break; } }
    }
    nloc = mine > 0u ? mine : 1u; nx = cnt > 0u ? cnt : 1u;
}
DI void xcd_barrier(const XcdBarrier& b) {
    asm volatile("s_waitcnt vmcnt(0)" ::: "memory");
    __syncthreads();
    if (threadIdx.x == 0) {
        unsigned* bar = b.bar;
        __builtin_amdgcn_s_waitcnt(0);
        unsigned nloc = b.st[0], nx = b.st[1];
        if (nloc == 0u) { xcd_barrier_complete(bar, b.x, nloc, nx); b.st[0] = nloc; b.st[1] = nx; }
        const unsigned old = xb_add(&bar[XB_XSUB(b.x)], 1u);
        const unsigned gen = old / nloc;
        if (old + 1u == (gen + 1u) * nloc) {
            __builtin_amdgcn_fence(__ATOMIC_RELEASE, "agent");
            asm volatile("s_waitcnt vmcnt(0)" ::: "memory");
            const unsigned og = xb_add(&bar[XB_TOP], 1u);
            const unsigned tg = og / nx;
            if (og + 1u == (tg + 1u) * nx) xb_add(&bar[XB_TOPGEN], 1u);
            else XB_SPIN(xb_ld(&bar[XB_TOPGEN]) == tg, bar);
            __builtin_amdgcn_fence(__ATOMIC_ACQUIRE, "agent");
            xb_add(&bar[XB_XGEN(b.x)], 1u);
            asm volatile("s_waitcnt vmcnt(0)" ::: "memory");
        } else {
            XB_SPIN(xb_ld(&bar[XB_XGEN(b.x)]) == gen, bar);
            __builtin_amdgcn_fence(__ATOMIC_ACQUIRE, "agent");
            asm volatile("s_waitcnt vmcnt(0)" ::: "memory");
        }
    }
    __syncthreads();
}

template <class RowMap> DI void transpose_item(const float* W, int K, int N, bf16* WT, RowMap rm, const float* kscale, LAS float* scr, int item, int lane, int ldw = 0) {
    if (ldw == 0) ldw = K;
    const int nblk = (N + 31) / 32, kb = item / nblk, nb = item - kb * nblk, k0 = 64 * kb, n0 = 32 * nb;
    const int n4 = n0 + (lane & 7) * 4;
    f32x4 v[8];
#pragma unroll
    for (int i = 0; i < 8; ++i) { const int kk = 8 * i + (lane >> 3);
        v[i] = n4 < N ? *(const f32x4*)(W + (size_t)(k0 + kk) * N + n4) : (f32x4){0.f, 0.f, 0.f, 0.f}; }
#pragma unroll
    for (int i = 0; i < 8; ++i) { const int kk = 8 * i + (lane >> 3);
        if (kscale) v[i] = v[i] * kscale[k0 + kk];
        LAS float* d = scr + kk * 33 + (lane & 7) * 4; d[0] = v[i][0]; d[1] = v[i][1]; d[2] = v[i][2]; d[3] = v[i][3]; }
    LDS_WAIT(); asm volatile("" ::: "memory");
    const int c = lane & 7;
#pragma unroll
    for (int j = 0; j < 4; ++j) { const int n = (lane >> 3) + 8 * j; const LAS float* s = scr + (8 * c) * 33 + n;
        const int nsrc = n0 + n; const int drow = nsrc < N ? rm(nsrc) : -1;
        u32x4 o; o.x = cvtpk(s[0 * 33], s[1 * 33]); o.y = cvtpk(s[2 * 33], s[3 * 33]); o.z = cvtpk(s[4 * 33], s[5 * 33]); o.w = cvtpk(s[6 * 33], s[7 * 33]);
        if (drow >= 0) *(u32x4*)(WT + (size_t)drow * ldw + k0 + 8 * c) = o; }
    LDS_WAIT(); asm volatile("" ::: "memory");
}
DI float softplusf_(float x) { return x > 20.f ? x : log1pf(__expf(x)); }

#ifndef PROBE_REP
#define PROBE_REP -1
#endif
DI void p0_prologue(KA A, LAS unsigned char* lds) {
    const int tid = threadIdx.x, lane = tid & 63, wave = __builtin_amdgcn_readfirstlane(tid >> 6);
    const int G = gridDim.x;
    const int gw = blockIdx.x * 4 + (wave & 3), NGW = G * 4;
    const int gt = blockIdx.x * 256 + (tid & 255), NGT = G * 256;
    unsigned char* ws = A->ws;
    if (wave >= 4) for (int rep = 0; rep < (PROBE_REP == 1001 ? 2 : 1); ++rep) {
        LAS float* scr = (LAS float*)(lds + wave * 16384);
        constexpr int I_IN = 16 * 153, I_OA = 8 * 32, I_OUT = 16 * 32, I_G = 16 * 88, I_D = 44 * 32;
        constexpr int NIT = I_IN + 2 * I_OA + I_OUT + 2 * I_G + I_D;
        for (int it = gw; it < NIT; it += NGW) {
            int r = it;
            if (r < I_IN) { transpose_item(A->w_in, 1024, NIN_SRC, (bf16*)(ws + WS_WIN), [](int c) -> int {
                    if (c < 640) return (c & ~63) + pos_of_d(c & 63);
                    if (c < 2816) return c;
                    if (c < 2824) return -1;
                    return c - 8; }, nullptr, scr, r, lane); continue; } r -= I_IN;
            if (r < I_OA) { transpose_item(A->w_oa, 512, 1024, (bf16*)(ws + WS_WOA), [](int c) -> int { return c; }, nullptr, scr, r, lane, 1024); continue; } r -= I_OA;
            if (r < I_OA) { transpose_item(A->w_ob, 512, 1024, (bf16*)(ws + WS_WOA) + 512, [](int c) -> int { return c; }, nullptr, scr, r, lane, 1024); continue; } r -= I_OA;
            if (r < I_OUT) { transpose_item(A->w_out, 1024, 1024, (bf16*)(ws + WS_WOUT), [](int c) -> int { return c; }, nullptr, scr, r, lane); continue; } r -= I_OUT;
            if (r < I_G) { transpose_item(A->w_gate, 1024, DFF, (bf16*)(ws + WS_WGU), [](int c) -> int { return 256 * (c >> 7) + (c & 127); }, A->norm_ffn, scr, r, lane); continue; } r -= I_G;
            if (r < I_G) { transpose_item(A->w_up, 1024, DFF, (bf16*)(ws + WS_WGU), [](int c) -> int { return 256 * (c >> 7) + 128 + (c & 127); }, A->norm_ffn, scr, r, lane); continue; } r -= I_G;
            transpose_item(A->w_down, DFF, 1024, (bf16*)(ws + WS_WD), [](int c) -> int { return c; }, nullptr, scr, r, lane);
        }
    }
    if (wave >= 4) for (int rep = 0; rep < (PROBE_REP == 1002 ? 2 : 1); ++rep) {
        float* COS = (float*)(ws + WS_ROPE); float* SIN = COS + (TP + TS) * 32;
        for (int i = gt; i < (TP + TS) * 32; i += NGT) { const int ri = i >> 5, f = i & 31; const double pos = ri < TP ? (double)ri : (double)(PAST + ri - TP);
            const double inv = exp2(-(double)f * (13.287712379549449 / 32.0)), ang = pos * inv; COS[i] = (float)cos(ang); SIN[i] = (float)sin(ang); }
        constexpr int PERB = 124 * 128 / 4;
        for (int i = gt; i < SBATCH * PERB; i += NGT) { const int b = i / PERB, o = i - b * PERB;
            ((f32x4*)(A->out + O_KS))[(size_t)b * 4096 + o] = ((const f32x4*)A->cache_k)[(size_t)b * 4096 + 128 + o];
            ((f32x4*)(A->out + O_VS))[(size_t)b * 4096 + o] = ((const f32x4*)A->cache_v)[(size_t)b * 4096 + 128 + o]; }
    }
    if (wave < 4) for (int rep = 0; rep < (PROBE_REP == 1003 ? 2 : 1); ++rep) {
        unsigned wab[16][4];
        f32x4 nm[4];
#pragma unroll
        for (int j = 0; j < 4; ++j) {
            nm[j] = ((const f32x4*)A->norm_mix)[lane + 64 * j];
#pragma unroll
            for (int e = 0; e < 4; ++e) { const float* p = A->w_in + (size_t)(4 * (lane + 64 * j) + e) * NIN_SRC + 2816;
                const f32x4 a = *(const f32x4*)p, b = *(const f32x4*)(p + 4);
                wab[j * 4 + e][0] = cvtpk(a[0], a[1]); wab[j * 4 + e][1] = cvtpk(a[2], a[3]); wab[j * 4 + e][2] = cvtpk(b[0], b[1]); wab[j * 4 + e][3] = cvtpk(b[2], b[3]); }
        }
        bf16* XN = (bf16*)(ws + WS_XN); f32x2* GB = (f32x2*)(ws + WS_GB);
        auto row_src = [&](int urow) -> const float* {
            if (urow < MP) { const int b = urow / TP, t = urow - b * TP; return t < NMETA ? A->meta + (size_t)t * D : A->x_prompt + ((size_t)b * SEQ + (t - NMETA)) * D; }
            if (urow < MU) return A->x_sample + (size_t)(urow - MP) * D;
            return nullptr; };
        f32x4 nx[4], nx2[4];
        { const float* s0 = gw < MUP ? row_src(gw) : nullptr; const float* s1 = gw + NGW < MUP ? row_src(gw + NGW) : nullptr;
#pragma unroll
          for (int j = 0; j < 4; ++j) { nx[j] = s0 ? ((const f32x4*)s0)[lane + 64 * j] : (f32x4){0.f, 0.f, 0.f, 0.f}; nx2[j] = s1 ? ((const f32x4*)s1)[lane + 64 * j] : (f32x4){0.f, 0.f, 0.f, 0.f}; } }
#pragma unroll 1
        for (int urow = gw; urow < MUP; urow += NGW) {
            f32x4 v[4];
#pragma unroll
            for (int j = 0; j < 4; ++j) { v[j] = nx[j]; nx[j] = nx2[j]; }
            { const int un = urow + 2 * NGW; const float* s2 = un < MUP ? row_src(un) : nullptr;
#pragma unroll
              for (int j = 0; j < 4; ++j) nx2[j] = s2 ? ((const f32x4*)s2)[lane + 64 * j] : (f32x4){0.f, 0.f, 0.f, 0.f}; }
            u32x2* o8 = (u32x2*)(XN + (size_t)urow * D) + lane;
            float ss = 0.f;
#pragma unroll
            for (int j = 0; j < 4; ++j) ss += (v[j][0] * v[j][0] + v[j][1] * v[j][1]) + (v[j][2] * v[j][2] + v[j][3] * v[j][3]);
            const float rstd = urow < MU ? rsqrtf(wave_sum(ss) * (1.0f / D) + EPS) : 0.f;
            float dot[8];
#pragma unroll
            for (int c = 0; c < 8; ++c) dot[c] = 0.f;
#pragma unroll
            for (int j = 0; j < 4; ++j) { v[j] = v[j] * rstd * nm[j];
                o8[64 * j] = (u32x2){cvtpk(v[j][0], v[j][1]), cvtpk(v[j][2], v[j][3])};
#pragma unroll
                for (int e = 0; e < 4; ++e)
#pragma unroll
                    for (int c = 0; c < 4; ++c) { dot[2 * c] += v[j][e] * bflo(wab[j * 4 + e][c]); dot[2 * c + 1] += v[j][e] * bfhi(wab[j * 4 + e][c]); } }
            float d4[4], d2[2], d1;
#pragma unroll
            for (int c = 0; c < 4; ++c) { const float keep = (lane & 32) ? dot[4 + c] : dot[c], send = (lane & 32) ? dot[c] : dot[4 + c]; d4[c] = keep + __shfl_xor(send, 32); }
#pragma unroll
            for (int c = 0; c < 2; ++c) { const float keep = (lane & 16) ? d4[2 + c] : d4[c], send = (lane & 16) ? d4[c] : d4[2 + c]; d2[c] = keep + __shfl_xor(send, 16); }
            { const float keep = (lane & 8) ? d2[1] : d2[0], send = (lane & 8) ? d2[0] : d2[1]; d1 = keep + __shfl_xor(send, 8); }
            d1 += __shfl_xor(d1, 4); d1 += __shfl_xor(d1, 2); d1 += __shfl_xor(d1, 1);
            const float a_ = __shfl(d1, ((lane & 2) ? 16 : 0) + ((lane & 1) ? 8 : 0));
            const float b_ = __shfl(d1, 32 + ((lane & 2) ? 16 : 0) + ((lane & 1) ? 8 : 0));
            if (lane < 4) {
                const float g = -__expf(A->a_log[lane]) * softplusf_(a_ + A->dt_bias[lane]);
                GB[(size_t)urow * 4 + lane] = urow < MU ? (f32x2){g, sigmoidf_(b_)} : (f32x2){0.f, 0.f};
            }
        }
    }
}
DI void item_decode(int item, int& b, int& h, bool& sample, int& t0, int& L) {
    if (item < N_ITEMS_P) { const int s = item / CHUNKS_P, c = item - s * CHUNKS_P; b = s >> 2; h = s & 3; sample = false; if (c == 0) { t0 = 0; L = NMETA; } else { t0 = NMETA + 64 * (c - 1); L = 64; } }
    else { const int s = item - N_ITEMS_P; b = s >> 2; h = s & 3; sample = true; t0 = 0; L = TS; }
}
#define LDS_BARRIER() do { asm volatile("s_waitcnt lgkmcnt(0)" ::: "memory"); __builtin_amdgcn_s_barrier(); asm volatile("" ::: "memory"); } while (0)
typedef GAS unsigned long long gu64;
typedef GAS unsigned gu32;
constexpr size_t CTL_QUEUE = 40960;
constexpr size_t CTL_F1 = 655360;
static_assert(CTL_F1 + 2592 * 64 <= 1048576, "control region map");
DI gu64* item_flag1(KA A, int item) { return (gu64*)(A->ws + WS_CTL + CTL_F1 + (size_t)item * 64); }
DI int order_item(int m) { return m < N_ITEMS_P ? (m & 31) * CHUNKS_P + (m >> 5) : m; }
DI gu64* item_granule(KA A, int item) { return (gu64*)(A->ws + WS_CTL + CTL_GRAN + (size_t)item * 64); }
DI float wait_item(gu64* g, unsigned ep = 1u) {
    unsigned long long x; unsigned spins = 0;
    for (;;) { x = __hip_atomic_load(g, __ATOMIC_RELAXED, __HIP_MEMORY_SCOPE_AGENT); if ((unsigned)(x >> 32) >= ep) break; __builtin_amdgcn_s_sleep(8); if (++spins > (1u << 20)) break; }
    asm volatile("" ::: "memory");
    return __uint_as_float((unsigned)__builtin_amdgcn_readfirstlane((int)(unsigned)x));
}
constexpr int LDS_GCL = 139264;
constexpr int PITCH = 132;
DI bf16x8 frag_nat(const LAS float* src, int row, int k0) {
    const f32x4 lo = *(const LAS f32x4*)(src + row * PITCH + k0), hi = *(const LAS f32x4*)(src + row * PITCH + k0 + 4);
    return __builtin_bit_cast(bf16x8, pack8f(lo, hi));
}
struct S1Pre { u32x4 xr[11]; f32x4 w[4][2]; f32x2 gb; };
DI void stage1_issue(KA A, int item, S1Pre& P) {
    const int tid = threadIdx.x, lane = tid & 63, wave = __builtin_amdgcn_readfirstlane(tid >> 6);
    int b, h, t0, L; bool sample; item_decode(item, b, h, sample, t0, L);
    const bf16* QKVB = (const bf16*)(A->ws + WS_QKVB);
    const int cv = lane < 48 ? lane : 47, grp = cv >> 4, col0 = (cv & 15) * 8, r0 = wave * 8, cidx = grp * 512 + h * 128 + col0;
#pragma unroll
    for (int q = 0; q < 11; ++q) {
        const int i = r0 - 3 + q;
        long urow = sample ? (long)MP + b * TS + i : (long)b * TP + t0 + i;
        const bool ok = sample ? i >= 0 : t0 + i >= 0;
        if (!ok) urow = 0;
        P.xr[q] = *(const u32x4*)(QKVB + (size_t)urow * CONVD + cidx);
        if (!ok) P.xr[q] = (u32x4){0u, 0u, 0u, 0u};
    }
#pragma unroll
    for (int i = 0; i < 4; ++i) { P.w[i][0] = *(const f32x4*)(A->conv_w + i * CONVD + cidx); P.w[i][1] = *(const f32x4*)(A->conv_w + i * CONVD + cidx + 4); }
    P.gb = (f32x2){0.f, 0.f};
    if (wave == 7 && lane < L) { const int urow = sample ? MP + b * TS + lane : b * TP + t0 + lane; P.gb = ((const f32x2*)(A->ws + WS_GB))[(size_t)urow * 4 + h]; }
}
DI void prep_stage1(KA A, int item, int next_item, int prev_item, int wait_item_idx, int bslot, float* ats, S1Pre& P, LAS unsigned char* ldsb, unsigned ep, int pmode = 0) {
    const int tid = threadIdx.x, lane = tid & 63, wave = __builtin_amdgcn_readfirstlane(tid >> 6), r = lane & 31, hh = lane >> 5;
#define ST16(p, ...) __builtin_amdgcn_raw_buffer_store_b128(__builtin_bit_cast(v4u_t, (__VA_ARGS__)), rs_slot, (int)((const unsigned char*)(p) - (const unsigned char*)slot), 0, 16)
#define ST16F(p, ...) __builtin_amdgcn_raw_buffer_store_b128(__builtin_bit_cast(v4u_t, (__VA_ARGS__)), rs_ats, (int)((const unsigned char*)(p) - (const unsigned char*)ats), 0, 16)
    int b, h, t0, L; bool sample; item_decode(item, b, h, sample, t0, L);
    LAS float* Qs = (LAS float*)ldsb; LAS float* Ks = Qs + 64 * PITCH; LAS float* Vs = Ks + 64 * PITCH; LAS float* gcs = Vs + 64 * PITCH; LAS float* betas = gcs + 64;
    unsigned char* slot = slot_ptr(A, item);
    typedef unsigned v4u_t __attribute__((__vector_size__(16)));
    const __amdgpu_buffer_rsrc_t rs_slot = __builtin_amdgcn_make_buffer_rsrc((void*)slot, 0, (int)PREP_SLOT, 0x00020000);
    const __amdgpu_buffer_rsrc_t rs_ats = __builtin_amdgcn_make_buffer_rsrc((void*)ats, 0, (int)ATS_ITEM, 0x00020000);
    if (!(pmode & 8)) {
        const int cv = lane < 48 ? lane : 47, grp = cv >> 4, col0 = (cv & 15) * 8, r0 = wave * 8, cidx = grp * 512 + h * 128 + col0;
        float x[11][8];
#pragma unroll
        for (int q = 0; q < 11; ++q) { x[q][0] = bflo(P.xr[q].x); x[q][1] = bfhi(P.xr[q].x); x[q][2] = bflo(P.xr[q].y); x[q][3] = bfhi(P.xr[q].y);
                                       x[q][4] = bflo(P.xr[q].z); x[q][5] = bfhi(P.xr[q].z); x[q][6] = bflo(P.xr[q].w); x[q][7] = bfhi(P.xr[q].w); }
        if (sample && wave == 0) {
#pragma unroll
            for (int q = 0; q < 3; ++q) { const float* sp = A->state_conv + ((size_t)b * 3 + q) * CONVD + cidx; const f32x4 s0 = *(const f32x4*)sp, s1 = *(const f32x4*)(sp + 4);
                x[q][0] = s0[0]; x[q][1] = s0[1]; x[q][2] = s0[2]; x[q][3] = s0[3]; x[q][4] = s1[0]; x[q][5] = s1[1]; x[q][6] = s1[2]; x[q][7] = s1[3]; }
        }
        float w[4][8];
#pragma unroll
        for (int i = 0; i < 4; ++i) { w[i][0] = P.w[i][0][0]; w[i][1] = P.w[i][0][1]; w[i][2] = P.w[i][0][2]; w[i][3] = P.w[i][0][3]; w[i][4] = P.w[i][1][0]; w[i][5] = P.w[i][1][1]; w[i][6] = P.w[i][1][2]; w[i][7] = P.w[i][1][3]; }
        LAS float* dst = Qs + grp * 64 * PITCH + col0;
        const float nsc = grp == 0 ? 0.08838834764831845f : 1.0f;
#pragma unroll
        for (int q = 3; q < 11; ++q) {
            const int rr = r0 + q - 3;
            float v[8]; float ss = 0.f;
#pragma unroll
            for (int e = 0; e < 8; ++e) {
                const float y = __builtin_fmaf(w[3][e], x[q][e], __builtin_fmaf(w[2][e], x[q - 1][e], __builtin_fmaf(w[1][e], x[q - 2][e], w[0][e] * x[q - 3][e])));
                const float sv = siluf_(y); v[e] = sv; ss = __builtin_fmaf(sv, sv, ss); }
            ss += __builtin_bit_cast(float, __builtin_amdgcn_update_dpp(0, __builtin_bit_cast(int, ss), 0xB1, 0xF, 0xF, true));
            ss += __builtin_bit_cast(float, __builtin_amdgcn_update_dpp(0, __builtin_bit_cast(int, ss), 0x4E, 0xF, 0xF, true));
            ss += __builtin_bit_cast(float, __builtin_amdgcn_update_dpp(0, __builtin_bit_cast(int, ss), 0x141, 0xF, 0xF, true));
            ss += __builtin_bit_cast(float, __builtin_amdgcn_update_dpp(0, __builtin_bit_cast(int, ss), 0x140, 0xF, 0xF, true));
            float sc = grp == 2 ? 1.0f : rsqrtf(ss + EPS) * nsc;
            sc = rr < L ? sc : 0.f;
            if (lane < 48) { *(LAS f32x4*)(dst + rr * PITCH) = (f32x4){v[0] * sc, v[1] * sc, v[2] * sc, v[3] * sc}; *(LAS f32x4*)(dst + rr * PITCH + 4) = (f32x4){v[4] * sc, v[5] * sc, v[6] * sc, v[7] * sc}; }
        }
    }
    if (wave == 7) {
        float gc = P.gb[0];
#pragma unroll
        for (int o = 1; o < 64; o <<= 1) { const float t = __shfl_up(gc, o); if (lane >= o) gc += t; }
        gcs[lane] = gc; betas[lane] = P.gb[1];
        if (lane == 63) ((LAS float*)(ldsb + LDS_GCL))[bslot] = __expf(gc);
    }
    asm volatile("s_waitcnt vmcnt(0)" ::: "memory");
    if (next_item < N_ITEMS) stage1_issue(A, next_item, P);
    if (wait_item_idx >= 0 && wave == 0) (void)wait_item(item_granule(A, wait_item_idx), ep);
    LDS_BARRIER();
    if (prev_item >= 0 && tid == 0) __hip_atomic_store(item_flag1(A, prev_item), ((unsigned long long)ep << 32) | (unsigned long long)__float_as_uint(((const LAS float*)(ldsb + LDS_GCL))[bslot ^ 1]), __ATOMIC_RELAXED, __HIP_MEMORY_SCOPE_AGENT);
    if (wave < 6 && !(pmode & 4)) {
        const bool isqk = wave >= 3; const int tsel = isqk ? wave - 3 : wave, ib = tsel == 0 ? 0 : 1, jb = tsel == 2 ? 1 : 0;
        const LAS float* Asrc = isqk ? Qs : Ks;
        f32x16 acc;
#pragma unroll
        for (int e = 0; e < 16; ++e) acc[e] = 0.f;
#pragma unroll
        for (int s = 0; s < 8; ++s) acc = MFMA32(frag_nat(Asrc, 32 * ib + r, 16 * s + 8 * hh), frag_nat(Ks, 32 * jb + r, 16 * s + 8 * hh), acc);
        const int j = 32 * jb + r; const float gcj = gcs[j];
        float* Aout = ats + (ib + jb) * 1024; bf16* QKD = (bf16*)(slot + SL_QKD);
        if (!isqk) {
#pragma unroll
            for (int g4 = 0; g4 < 4; ++g4) { f32x4 v;
#pragma unroll
                for (int e = 0; e < 4; ++e) { const int i = 32 * ib + 8 * g4 + 4 * hh + e; v[e] = i > j ? betas[i] * __expf(fminf(gcs[i] - gcj, 0.f)) * acc[4 * g4 + e] : 0.f; }
                ST16F(Aout + r * 32 + 8 * g4 + 4 * hh, v); }
        } else {
            LAS float* patch = (LAS float*)(ldsb + 106496) + (wave - 3) * (32 * 36);
#pragma unroll
            for (int reg = 0; reg < 16; ++reg) { const int il = crow16(reg, hh), i = 32 * ib + il; const float dec = __expf(fminf(gcs[i] - gcj, 0.f));
                patch[il * 36 + r] = i >= j ? dec * acc[reg] : 0.f; }
            LDS_WAIT(); asm volatile("" ::: "memory");
#pragma unroll
            for (int ks2 = 0; ks2 < 2; ++ks2) { const int k0 = 16 * ks2 + 4 * hh;
                const f32x4 lo = *(const LAS f32x4*)(patch + r * 36 + k0), hi = *(const LAS f32x4*)(patch + r * 36 + k0 + 8);
                ST16((unsigned char*)QKD + ((ib * 4 + 2 * jb + ks2) * 64 + lane) * 16, pack8f(lo, hi)); }
        }
    }
    const float gcl = gcs[63];
#pragma unroll 1
    for (int job = (pmode & 4) ? 56 : wave; job < 56; job += 8) {
        if (job < 32) {
            const bool isq = job >= 16; const int jj = job & 15, rb = jj >> 3, ks = jj & 7, row = 32 * rb + r, k0 = 16 * ks + 4 * hh;
            const LAS float* src = isq ? Qs : Ks; const float sc = isq ? __expf(gcs[row]) : betas[row] * __expf(gcs[row]);
            const f32x4 lo = *(const LAS f32x4*)(src + row * PITCH + k0) * sc, hi = *(const LAS f32x4*)(src + row * PITCH + k0 + 8) * sc;
            ST16(slot + (isq ? SL_QE : SL_BEK) + ((rb * 8 + ks) * 64 + lane) * 16, pack8f(lo, hi));
        } else if (job < 48) {
            const int jj = job - 32, rb = jj >> 2, ks = jj & 3, dk = 32 * rb + r;
            f32x4 lo, hi;
#pragma unroll
            for (int e = 0; e < 4; ++e) { const int j0 = 16 * ks + 4 * hh + e, j1 = j0 + 8;
                lo[e] = Ks[j0 * PITCH + dk] * __expf(gcl - gcs[j0]); hi[e] = Ks[j1 * PITCH + dk] * __expf(gcl - gcs[j1]); }
            ST16(slot + SL_KWT + ((rb * 4 + ks) * 64 + lane) * 16, pack8f(lo, hi));
        } else {
            const int q = job - 48, w = q >> 1, ib = q & 1, dv = 32 * w + r;
            float v[16];
#pragma unroll
            for (int reg = 0; reg < 16; ++reg) { const int i = 32 * ib + crow16(reg, hh); v[reg] = betas[i] * Vs[i * PITCH + dv]; }
            u32x4* dst = (u32x4*)(slot + SL_BV + ((w * 2 + ib) * 64 + lane) * 32);
            ST16(dst, (u32x4){cvtpk(v[0], v[1]), cvtpk(v[2], v[3]), cvtpk(v[4], v[5]), cvtpk(v[6], v[7])});
            ST16(dst + 1, (u32x4){cvtpk(v[8], v[9]), cvtpk(v[10], v[11]), cvtpk(v[12], v[13]), cvtpk(v[14], v[15])});
        }
    }
    LDS_BARRIER();
}
DI void prep_stage2(KA A, int item, float gcl, const float* ats, LAS float* M, unsigned ep) {
    int lane = threadIdx.x & 63; asm volatile("" : "+v"(lane));
    const int r = lane & 31, hh = lane >> 5, base = 32 * hh;
    unsigned char* slot = slot_ptr(A, item);
    const f32x4* Ain = (const f32x4*)ats;
#pragma unroll
    for (int tt = 0; tt < 3; ++tt) { const int jb = tt >> 1, ib = (tt + 1) >> 1;
#pragma unroll
        for (int q = 0; q < 4; ++q) { const int idx = q * 64 + lane, jj = idx >> 3, i4 = idx & 7;
            *(LAS f32x4*)(M + (32 * jb + jj) * 64 + 32 * ib + 4 * i4) = Ain[tt * 256 + idx]; } }
    LDS_WAIT(); asm volatile("" ::: "memory");
#pragma unroll 1
    for (int rb = 0; rb < 2; ++rb) {
        float acc[16];
#pragma unroll
        for (int i = 0; i < 16; ++i) acc[i] = r == 16 * rb + i ? 1.f : 0.f;
        if (rb == 1) {
#pragma unroll 4
            for (int j = 0; j < 16; ++j) {
                float tj = M[(base + j) * 64 + base + r]; tj = r <= j ? tj : 0.f;
                const LAS f32x4* ar = (const LAS f32x4*)(M + (base + j) * 64 + base + 16);
                const f32x4 a0 = ar[0], a1 = ar[1], a2 = ar[2], a3 = ar[3];
#pragma unroll
                for (int e = 0; e < 4; ++e) { acc[e] -= a0[e] * tj; acc[4 + e] -= a1[e] * tj; acc[8 + e] -= a2[e] * tj; acc[12 + e] -= a3[e] * tj; }
            }
        }
#pragma unroll
        for (int j = 0; j < 16; ++j) {
            const float tj = acc[j]; const int row = base + 16 * rb + j;
            const LAS f32x4* ar = (const LAS f32x4*)(M + row * 64 + base + 16 * rb);
            float a[16];
#pragma unroll
            for (int q = j >> 2; q < 4; ++q) { const f32x4 v = ar[q]; a[4 * q] = v[0]; a[4 * q + 1] = v[1]; a[4 * q + 2] = v[2]; a[4 * q + 3] = v[3]; }
            if (r <= 16 * rb + j) M[row * 64 + base + r] = tj;
#pragma unroll
            for (int i = j + 1; i < 16; ++i) acc[i] -= a[i] * tj;
        }
        asm volatile("" ::: "memory");
    }
    LDS_WAIT(); asm volatile("" ::: "memory");
    f32x16 X;
#pragma unroll
    for (int e = 0; e < 16; ++e) X[e] = 0.f;
#pragma unroll
    for (int s2 = 0; s2 < 16; ++s2) { const int k = 2 * s2 + hh; const float a = M[k * 64 + 32 + r]; float bb = M[k * 64 + r]; bb = r <= k ? bb : 0.f;
        X = __builtin_amdgcn_mfma_f32_32x32x2f32(a, bb, X, 0, 0, 0); }
#pragma unroll
    for (int reg = 0; reg < 16; ++reg) M[crow16(reg, hh) * 64 + 32 + r] = X[reg];
    LDS_WAIT(); asm volatile("" ::: "memory");
    f32x16 Y;
#pragma unroll
    for (int e = 0; e < 16; ++e) Y[e] = 0.f;
#pragma unroll
    for (int s2 = 0; s2 < 16; ++s2) { const int k = 2 * s2 + hh; float a = M[(32 + r) * 64 + 32 + k]; a = k <= r ? a : 0.f; const float bb = M[k * 64 + 32 + r];
        Y = __builtin_amdgcn_mfma_f32_32x32x2f32(a, bb, Y, 0, 0, 0); }
#pragma unroll
    for (int reg = 0; reg < 16; ++reg) M[(32 + crow16(reg, hh)) * 64 + r] = -Y[reg];
    LDS_WAIT(); asm volatile("" ::: "memory");
#pragma unroll
    for (int f = 0; f < 8; ++f) { const int rb = f >> 2, ks = f & 3, row = 32 * rb + r, k0 = 16 * ks + 4 * hh;
        f32x4 lo = *(const LAS f32x4*)(M + row * 64 + k0), hi = *(const LAS f32x4*)(M + row * 64 + k0 + 8);
#pragma unroll
        for (int e = 0; e < 4; ++e) { lo[e] = k0 + e <= row ? lo[e] : 0.f; hi[e] = k0 + 8 + e <= row ? hi[e] : 0.f; }
        st16_sc1(slot + SL_T + ((rb * 4 + ks) * 64 + lane) * 16, pack8f(lo, hi)); }
    LDS_WAIT();
    asm volatile("s_waitcnt vmcnt(0)" ::: "memory");
    if (lane == 0) __hip_atomic_store(item_granule(A, item), ((unsigned long long)ep << 32) | (unsigned long long)__float_as_uint(gcl), __ATOMIC_RELAXED, __HIP_MEMORY_SCOPE_AGENT);
}
DI void scan_seq(KA A, int seq, int w, int lane, unsigned ep) {
    const int r = lane & 31, hh = lane >> 5, dv = 32 * w + r;
    const bool sample = seq >= N_PROMPT_SEQ; const int sidx = sample ? seq - N_PROMPT_SEQ : seq, b = sidx >> 2, h = sidx & 3, nch = sample ? 1 : CHUNKS_P;
    f32x16 S[4];
    if (sample) {
        const float* S0 = A->state_delta + ((size_t)(b * 4 + h) * 128) * 128 + dv;
#pragma unroll
        for (int kb = 0; kb < 4; ++kb)
#pragma unroll
            for (int reg = 0; reg < 16; ++reg) S[kb][reg] = S0[(size_t)(32 * kb + crow16(reg, hh)) * 128];
    } else {
#pragma unroll
        for (int kb = 0; kb < 4; ++kb)
#pragma unroll
            for (int reg = 0; reg < 16; ++reg) S[kb][reg] = 0.f;
    }
    bf16* OBR = (bf16*)((unsigned char*)A->out + DO_OB);
#pragma unroll 1
    for (int c = 0; c < nch; ++c) {
        const int item = sample ? N_ITEMS_P + sidx : seq * CHUNKS_P + c;
        const unsigned char* slot = slot_ptr(A, item);
        const float gcl = wait_item(item_granule(A, item), ep);
        __builtin_amdgcn_fence(__ATOMIC_ACQUIRE, "agent");
        const bf16x8* bek = (const bf16x8*)(slot + SL_BEK) + lane; const bf16x8* tp = (const bf16x8*)(slot + SL_T) + lane;
        const bf16x8* qe = (const bf16x8*)(slot + SL_QE) + lane; const bf16x8* qkd = (const bf16x8*)(slot + SL_QKD) + lane; const bf16x8* kwt = (const bf16x8*)(slot + SL_KWT) + lane;
        bf16x8 sf[8];
#pragma unroll
        for (int kb = 0; kb < 4; ++kb) { sf[2 * kb] = pack_step<0>(S[kb]); sf[2 * kb + 1] = pack_step<1>(S[kb]); }
        f32x16 x0, x1;
#pragma unroll
        for (int e = 0; e < 16; ++e) { x0[e] = 0.f; x1[e] = 0.f; }
#pragma unroll
        for (int ks = 0; ks < 8; ++ks) { x0 = MFMA32(bek[ks * 64], sf[ks], x0); x1 = MFMA32(bek[(8 + ks) * 64], sf[ks], x1); }
        {
            const u32x4* bv = (const u32x4*)(slot + SL_BV) + ((w * 2) * 64 + lane) * 2;
            const u32x4 a0 = bv[0], a1 = bv[1], c0 = bv[128], c1 = bv[129];
            x0[0] = bflo(a0.x) - x0[0]; x0[1] = bfhi(a0.x) - x0[1]; x0[2] = bflo(a0.y) - x0[2]; x0[3] = bfhi(a0.y) - x0[3];
            x0[4] = bflo(a0.z) - x0[4]; x0[5] = bfhi(a0.z) - x0[5]; x0[6] = bflo(a0.w) - x0[6]; x0[7] = bfhi(a0.w) - x0[7];
            x0[8] = bflo(a1.x) - x0[8]; x0[9] = bfhi(a1.x) - x0[9]; x0[10] = bflo(a1.y) - x0[10]; x0[11] = bfhi(a1.y) - x0[11];
            x0[12] = bflo(a1.z) - x0[12]; x0[13] = bfhi(a1.z) - x0[13]; x0[14] = bflo(a1.w) - x0[14]; x0[15] = bfhi(a1.w) - x0[15];
            x1[0] = bflo(c0.x) - x1[0]; x1[1] = bfhi(c0.x) - x1[1]; x1[2] = bflo(c0.y) - x1[2]; x1[3] = bfhi(c0.y) - x1[3];
            x1[4] = bflo(c0.z) - x1[4]; x1[5] = bfhi(c0.z) - x1[5]; x1[6] = bflo(c0.w) - x1[6]; x1[7] = bfhi(c0.w) - x1[7];
            x1[8] = bflo(c1.x) - x1[8]; x1[9] = bfhi(c1.x) - x1[9]; x1[10] = bflo(c1.y) - x1[10]; x1[11] = bfhi(c1.y) - x1[11];
            x1[12] = bflo(c1.z) - x1[12]; x1[13] = bfhi(c1.z) - x1[13]; x1[14] = bflo(c1.w) - x1[14]; x1[15] = bfhi(c1.w) - x1[15];
        }
        bf16x8 rf[4] = {pack_step<0>(x0), pack_step<1>(x0), pack_step<0>(x1), pack_step<1>(x1)};
        f32x16 u0, u1;
#pragma unroll
        for (int e = 0; e < 16; ++e) { u0[e] = 0.f; u1[e] = 0.f; }
        u0 = MFMA32(tp[0 * 64], rf[0], u0); u0 = MFMA32(tp[1 * 64], rf[1], u0);
#pragma unroll
        for (int ks = 0; ks < 4; ++ks) u1 = MFMA32(tp[(4 + ks) * 64], rf[ks], u1);
        bf16x8 uf[4] = {pack_step<0>(u0), pack_step<1>(u0), pack_step<0>(u1), pack_step<1>(u1)};
        if (sample || c > 0) {
#pragma unroll
            for (int e = 0; e < 16; ++e) { x0[e] = 0.f; x1[e] = 0.f; }
#pragma unroll
            for (int ks = 0; ks < 8; ++ks) { x0 = MFMA32(qe[ks * 64], sf[ks], x0); x1 = MFMA32(qe[(8 + ks) * 64], sf[ks], x1); }
            x0 = MFMA32(qkd[0 * 64], uf[0], x0); x0 = MFMA32(qkd[1 * 64], uf[1], x0);
#pragma unroll
            for (int ks = 0; ks < 4; ++ks) x1 = MFMA32(qkd[(4 + ks) * 64], uf[ks], x1);
            const int crow0 = sample ? NBATCH * SEQ + b * TS : b * SEQ + 64 * (c - 1), L = sample ? TS : 64;
#pragma unroll
            for (int reg = 0; reg < 16; ++reg) { const int i0 = crow16(reg, hh), i1 = 32 + i0;
                if (i0 < L) OBR[(size_t)(crow0 + i0) * OAB_PITCH + h * 128 + dv] = f2bf(x0[reg]);
                if (i1 < L) OBR[(size_t)(crow0 + i1) * OAB_PITCH + h * 128 + dv] = f2bf(x1[reg]); }
        }
#pragma unroll
        for (int kb = 0; kb < 4; ++kb) {
            S[kb] = S[kb] * gcl;
#pragma unroll
            for (int ks = 0; ks < 4; ++ks) S[kb] = MFMA32(kwt[(kb * 4 + ks) * 64], uf[ks], S[kb]);
        }
    }
    float* So = A->out + (sample ? O_DS : O_DP) + ((size_t)(b * 4 + h) * 128) * 128 + dv;
#pragma unroll
    for (int kb = 0; kb < 4; ++kb)
#pragma unroll
        for (int reg = 0; reg < 16; ++reg) So[(size_t)(32 * kb + crow16(reg, hh)) * 128] = S[kb][reg];
}

constexpr int HALF_BYTES = 40960;
DI void scan_prompt_wg(KA A, int seq, LAS unsigned char* lds, unsigned ep) {
    const int tid = threadIdx.x, lane = tid & 63, wave = __builtin_amdgcn_readfirstlane(tid >> 6);
    const int b = seq >> 2, h = seq & 3;
    constexpr int N = 2 * CHUNKS_P;
    if (wave >= 4) {
        const int loff = (wave - 4) * 10240 + lane * 16;
        u32x4 r0[10], r1[10];
        LAS u32x4* d0 = (LAS u32x4*)(lds + loff); LAS u32x4* d1 = (LAS u32x4*)(lds + HALF_BYTES + loff);
        LAS float* gclw = (LAS float*)(lds + 2 * HALF_BYTES);
#define SCAN_LOAD(n, R) do { const int item_ = seq * CHUNKS_P + ((n) >> 1); \
            if (((n) & 1) == 0) { const float g_ = wait_item(item_granule(A, item_), ep); if (wave == 4 && lane == 0) gclw[((n) >> 1) & 3] = g_; } \
            const __amdgpu_buffer_rsrc_t rs_ = __builtin_amdgcn_make_buffer_rsrc((void*)slot_ptr(A, item_), 0, (int)PREP_SLOT, 0x00020000); \
            _Pragma("unroll") for (int q = 0; q < 10; ++q) R[q] = __builtin_bit_cast(u32x4, __builtin_amdgcn_raw_buffer_load_b128(rs_, ((n) & 1) * HALF_BYTES + loff + q * 1024, 0, 16)); } while (0)
        SCAN_LOAD(0, r0);
#pragma unroll
        for (int q = 0; q < 10; ++q) d0[q * 64] = r0[q];
        SCAN_LOAD(1, r1);
        LDS_BARRIER();
#pragma unroll 1
        for (int n = 0; n < N; n += 2) {
            if (n + 2 < N) SCAN_LOAD(n + 2, r0);
#pragma unroll
            for (int q = 0; q < 10; ++q) d1[q * 64] = r1[q];
            LDS_BARRIER();
            if (n + 3 < N) SCAN_LOAD(n + 3, r1);
            if (n + 2 < N) {
#pragma unroll
                for (int q = 0; q < 10; ++q) d0[q * 64] = r0[q]; }
            LDS_BARRIER();
        }
#undef SCAN_LOAD
    } else {
        const int w = wave, r = lane & 31, hh = lane >> 5, dv = 32 * w + r;
        f32x16 S[4];
#pragma unroll
        for (int kb = 0; kb < 4; ++kb)
#pragma unroll
            for (int reg = 0; reg < 16; ++reg) S[kb][reg] = 0.f;
        bf16* OBR = (bf16*)((unsigned char*)A->out + DO_OB);
        const LAS float* gclw = (const LAS float*)(lds + 2 * HALF_BYTES);
        const LAS bf16x8* bek = (const LAS bf16x8*)(lds + SL_BEK) + lane; const LAS bf16x8* tp = (const LAS bf16x8*)(lds + SL_T) + lane;
        const LAS u32x4* bv = (const LAS u32x4*)(lds + SL_BV) + ((w * 2) * 64 + lane) * 2;
        const LAS bf16x8* qkd = (const LAS bf16x8*)(lds + HALF_BYTES + (SL_QKD - HALF_BYTES)) + lane; const LAS bf16x8* qe = (const LAS bf16x8*)(lds + HALF_BYTES + (SL_QE - HALF_BYTES)) + lane;
        const LAS bf16x8* kwt = (const LAS bf16x8*)(lds + HALF_BYTES + (SL_KWT - HALF_BYTES)) + lane;
        LDS_BARRIER();
#pragma unroll 1
        for (int c = 0; c < CHUNKS_P; ++c) {
            bf16x8 sf[8];
#pragma unroll
            for (int kb = 0; kb < 4; ++kb) { sf[2 * kb] = pack_step<0>(S[kb]); sf[2 * kb + 1] = pack_step<1>(S[kb]); }
            f32x16 x0, x1;
#pragma unroll
            for (int e = 0; e < 16; ++e) { x0[e] = 0.f; x1[e] = 0.f; }
#pragma unroll
            for (int ks = 0; ks < 8; ++ks) { x0 = MFMA32(bek[ks * 64], sf[ks], x0); x1 = MFMA32(bek[(8 + ks) * 64], sf[ks], x1); }
            {
                const u32x4 a0 = bv[0], a1 = bv[1], c0 = bv[128], c1 = bv[129];
                x0[0] = bflo(a0.x) - x0[0]; x0[1] = bfhi(a0.x) - x0[1]; x0[2] = bflo(a0.y) - x0[2]; x0[3] = bfhi(a0.y) - x0[3];
                x0[4] = bflo(a0.z) - x0[4]; x0[5] = bfhi(a0.z) - x0[5]; x0[6] = bflo(a0.w) - x0[6]; x0[7] = bfhi(a0.w) - x0[7];
                x0[8] = bflo(a1.x) - x0[8]; x0[9] = bfhi(a1.x) - x0[9]; x0[10] = bflo(a1.y) - x0[10]; x0[11] = bfhi(a1.y) - x0[11];
                x0[12] = bflo(a1.z) - x0[12]; x0[13] = bfhi(a1.z) - x0[13]; x0[14] = bflo(a1.w) - x0[14]; x0[15] = bfhi(a1.w) - x0[15];
                x1[0] = bflo(c0.x) - x1[0]; x1[1] = bfhi(c0.x) - x1[1]; x1[2] = bflo(c0.y) - x1[2]; x1[3] = bfhi(c0.y) - x1[3];
                x1[4] = bflo(c0.z) - x1[4]; x1[5] = bfhi(c0.z) - x1[5]; x1[6] = bflo(c0.w) - x1[6]; x1[7] = bfhi(c0.w) - x1[7];
                x1[8] = bflo(c1.x) - x1[8]; x1[9] = bfhi(c1.x) - x1[9]; x1[10] = bflo(c1.y) - x1[10]; x1[11] = bfhi(c1.y) - x1[11];
                x1[12] = bflo(c1.z) - x1[12]; x1[13] = bfhi(c1.z) - x1[13]; x1[14] = bflo(c1.w) - x1[14]; x1[15] = bfhi(c1.w) - x1[15];
            }
            bf16x8 rf[4] = {pack_step<0>(x0), pack_step<1>(x0), pack_step<0>(x1), pack_step<1>(x1)};
            f32x16 u0, u1;
#pragma unroll
            for (int e = 0; e < 16; ++e) { u0[e] = 0.f; u1[e] = 0.f; }
            u0 = MFMA32(tp[0 * 64], rf[0], u0); u0 = MFMA32(tp[1 * 64], rf[1], u0);
#pragma unroll
            for (int ks = 0; ks < 4; ++ks) u1 = MFMA32(tp[(4 + ks) * 64], rf[ks], u1);
            bf16x8 uf[4] = {pack_step<0>(u0), pack_step<1>(u0), pack_step<0>(u1), pack_step<1>(u1)};
            LDS_BARRIER();
            if (c > 0) {
#pragma unroll
                for (int e = 0; e < 16; ++e) { x0[e] = 0.f; x1[e] = 0.f; }
#pragma unroll
                for (int ks = 0; ks < 8; ++ks) { x0 = MFMA32(qe[ks * 64], sf[ks], x0); x1 = MFMA32(qe[(8 + ks) * 64], sf[ks], x1); }
                x0 = MFMA32(qkd[0 * 64], uf[0], x0); x0 = MFMA32(qkd[1 * 64], uf[1], x0);
#pragma unroll
                for (int ks = 0; ks < 4; ++ks) x1 = MFMA32(qkd[(4 + ks) * 64], uf[ks], x1);
                bf16* orow = OBR + (size_t)(b * SEQ + 64 * (c - 1)) * OAB_PITCH + h * 128 + dv;
#pragma unroll
                for (int reg = 0; reg < 16; ++reg) { const int i0 = crow16(reg, hh); orow[(size_t)i0 * OAB_PITCH] = f2bf(x0[reg]); orow[(size_t)(32 + i0) * OAB_PITCH] = f2bf(x1[reg]); }
            }
            const float gcl = gclw[c & 3];
#pragma unroll
            for (int kb = 0; kb < 4; ++kb) {
                S[kb] = S[kb] * gcl;
#pragma unroll
                for (int ks = 0; ks < 4; ++ks) S[kb] = MFMA32(kwt[(kb * 4 + ks) * 64], uf[ks], S[kb]);
            }
            LDS_BARRIER();
        }
        float* So = A->out + O_DP + ((size_t)(b * 4 + h) * 128) * 128 + dv;
#pragma unroll
        for (int kb = 0; kb < 4; ++kb)
#pragma unroll
            for (int reg = 0; reg < 16; ++reg) So[(size_t)(32 * kb + crow16(reg, hh)) * 128] = S[kb][reg];
    }
}

constexpr int KPITCH = 72, VPITCH = 264;
typedef short v4i16_t __attribute__((ext_vector_type(4)));
DI void attn_unit(KA A, int unit, LAS unsigned char* ldsb) {
    const int tid = threadIdx.x, lane = tid & 63, wave = __builtin_amdgcn_readfirstlane(tid >> 6), r = lane & 31, hh = lane >> 5;
    const int b = unit >> 6, kh = (unit >> 5) & 1, jb = unit & 31, T0 = NMETA + 128 * jb;
    LAS bf16* Ksm = (LAS bf16*)ldsb; LAS bf16* VTs = Ksm + 256 * KPITCH;
    const bf16* KVg = (const bf16*)(A->ws + WS_KV); const bf16* QAg = (const bf16*)(A->ws + WS_QA);
#pragma unroll
    for (int e4 = 0; e4 < 4; ++e4) {
        const int id = tid + 512 * e4, key = id >> 3, cch = id & 7, tk = T0 - 128 + key;
        u32x4 kq = (u32x4){0u, 0u, 0u, 0u}, vq = kq;
        if (tk >= 0) { const bf16* src = KVg + (size_t)(b * TP + tk) * 256 + kh * 64 + 8 * cch; kq = *(const u32x4*)src; vq = *(const u32x4*)(src + 128); }
        *(LAS u32x4*)(Ksm + key * KPITCH + 8 * cch) = kq;
        *(LAS u32x4*)(VTs + key * KPITCH + 8 * cch) = vq;
    }
    LDS_BARRIER();
    const int g = wave >> 1, qh = wave & 1, head = 4 * kh + g;
    const float sink2 = A->sinks[head] * 1.4426950408889634f;
    const int kmin = jb == 0 ? 128 - NMETA : 0;
#pragma unroll 1
    for (int q2 = 0; q2 < 2; ++q2) {
        const int qb = 2 * qh + q2, iq = 32 * qb + r;
        const bf16* qrow = QAg + (size_t)(b * TP + T0 + iq) * 512 + head * 64 + 8 * hh;
        bf16x8 qf[4];
#pragma unroll
        for (int s = 0; s < 4; ++s) qf[s] = *(const bf16x8*)(qrow + 16 * s);
        f32x16 st[5];
        float m = sink2;
#pragma unroll
        for (int kt5 = 0; kt5 < 5; ++kt5) {
            const int kt = qb + kt5;
            f32x16 acc;
#pragma unroll
            for (int e = 0; e < 16; ++e) acc[e] = 0.f;
#pragma unroll
            for (int s = 0; s < 4; ++s) acc = MFMA32(*(const LAS bf16x8*)(Ksm + (32 * kt + r) * KPITCH + 16 * s + 8 * hh), qf[s], acc);
#pragma unroll
            for (int reg = 0; reg < 16; ++reg) { const int kk = 32 * kt + crow16(reg, hh); const bool ok = kk >= iq && kk <= iq + 128 && kk >= kmin;
                acc[reg] = ok ? acc[reg] : -INFINITY; m = fmaxf(m, acc[reg]); }
            st[kt5] = acc;
        }
        m = fmaxf(m, __shfl_xor(m, 32));
        float l = 0.f;
#pragma unroll
        for (int kt5 = 0; kt5 < 5; ++kt5)
#pragma unroll
            for (int reg = 0; reg < 16; ++reg) { const float p = exp2f(st[kt5][reg] - m); st[kt5][reg] = p; l += p; }
        l += __shfl_xor(l, 32); l += exp2f(sink2 - m);
        f32x16 o0, o1;
#pragma unroll
        for (int e = 0; e < 16; ++e) { o0[e] = 0.f; o1[e] = 0.f; }
#pragma unroll
        for (int kt5 = 0; kt5 < 5; ++kt5) {
            const int kt = qb + kt5;
            const bf16x8 p0 = pack_step<0>(st[kt5]), p1 = pack_step<1>(st[kt5]);
            const LAS bf16* vb = VTs + (32 * kt + 4 * hh + ((lane & 15) >> 2)) * KPITCH + 16 * ((lane >> 4) & 1) + 4 * (lane & 3);
#define VTR(ptr) __builtin_amdgcn_ds_read_tr16_b64_v4i16((LAS v4i16_t*)(ptr))
            const v4i16_t a00 = VTR(vb), a01 = VTR(vb + 8 * KPITCH), a10 = VTR(vb + 16 * KPITCH), a11 = VTR(vb + 24 * KPITCH);
            const v4i16_t b00 = VTR(vb + 32), b01 = VTR(vb + 8 * KPITCH + 32), b10 = VTR(vb + 16 * KPITCH + 32), b11 = VTR(vb + 24 * KPITCH + 32);
#undef VTR
            o0 = MFMA32(__builtin_shufflevector(a00, a01, 0, 1, 2, 3, 4, 5, 6, 7), p0, o0); o0 = MFMA32(__builtin_shufflevector(a10, a11, 0, 1, 2, 3, 4, 5, 6, 7), p1, o0);
            o1 = MFMA32(__builtin_shufflevector(b00, b01, 0, 1, 2, 3, 4, 5, 6, 7), p0, o1); o1 = MFMA32(__builtin_shufflevector(b10, b11, 0, 1, 2, 3, 4, 5, 6, 7), p1, o1);
        }
        const float rl = 1.0f / l;
        bf16* orow = (bf16*)((unsigned char*)A->out + DO_OA) + (size_t)(b * SEQ + 128 * jb + iq) * OAB_PITCH + head * 64 + 4 * hh;
#pragma unroll
        for (int g4 = 0; g4 < 4; ++g4) {
            *(u32x2*)(orow + 8 * g4) = (u32x2){cvtpk(o0[4 * g4] * rl, o0[4 * g4 + 1] * rl), cvtpk(o0[4 * g4 + 2] * rl, o0[4 * g4 + 3] * rl)};
            *(u32x2*)(orow + 32 + 8 * g4) = (u32x2){cvtpk(o1[4 * g4] * rl, o1[4 * g4 + 1] * rl), cvtpk(o1[4 * g4 + 2] * rl, o1[4 * g4 + 3] * rl)};
        }
    }
    LDS_BARRIER();
}
DI void sample_attn(KA A, int b, int head, LAS float* wl, int lane) {
    const int kh = head >> 2;
    LAS float* qn = wl; LAS float* ps = wl + 256;
    const bf16* QAg = (const bf16*)(A->ws + WS_QA); const bf16* KVg = (const bf16*)(A->ws + WS_KV);
#pragma unroll
    for (int i = 0; i < 4; ++i) qn[i * 64 + lane] = bf2f(QAg[(size_t)(MP + b * TS + i) * 512 + head * 64 + pos_of_d(lane)]);
    LDS_WAIT(); asm volatile("" ::: "memory");
    const float sink2 = A->sinks[head] * 1.4426950408889634f;
#pragma unroll 1
    for (int kq = 0; kq < 3; ++kq) {
        const int kj = lane + 64 * kq;
        float sc0 = 0.f, sc1 = 0.f, sc2 = 0.f, sc3 = 0.f;
        if (kj < 128) {
            const f32x4* kr = (const f32x4*)(A->cache_k + ((size_t)(b * 128 + kj) * 2 + kh) * 64);
#pragma unroll 4
            for (int d4 = 0; d4 < 16; ++d4) { const f32x4 kv = kr[d4];
                const f32x4 q0 = *(const LAS f32x4*)(qn + 4 * d4), q1 = *(const LAS f32x4*)(qn + 64 + 4 * d4), q2 = *(const LAS f32x4*)(qn + 128 + 4 * d4), q3 = *(const LAS f32x4*)(qn + 192 + 4 * d4);
                sc0 += (kv[0] * q0[0] + kv[1] * q0[1]) + (kv[2] * q0[2] + kv[3] * q0[3]); sc1 += (kv[0] * q1[0] + kv[1] * q1[1]) + (kv[2] * q1[2] + kv[3] * q1[3]);
                sc2 += (kv[0] * q2[0] + kv[1] * q2[1]) + (kv[2] * q2[2] + kv[3] * q2[3]); sc3 += (kv[0] * q3[0] + kv[1] * q3[1]) + (kv[2] * q3[2] + kv[3] * q3[3]); }
        } else if (kj < 132) {
            const bf16* kr = KVg + (size_t)(MP + b * TS + (kj - 128)) * 256 + kh * 64;
#pragma unroll 4
            for (int p = 0; p < 64; ++p) { const float kv = bf2f(kr[p]); const int d = d_of_pos(p);
                sc0 += kv * qn[d]; sc1 += kv * qn[64 + d]; sc2 += kv * qn[128 + d]; sc3 += kv * qn[192 + d]; }
        }
        if (kj < 132) {
            ps[0 * 132 + kj] = (kj >= 0 && kj <= 128) ? sc0 : -INFINITY; ps[1 * 132 + kj] = (kj >= 1 && kj <= 129) ? sc1 : -INFINITY;
            ps[2 * 132 + kj] = (kj >= 2 && kj <= 130) ? sc2 : -INFINITY; ps[3 * 132 + kj] = (kj >= 3 && kj <= 131) ? sc3 : -INFINITY; }
    }
    LDS_WAIT(); asm volatile("" ::: "memory");
    float linv[4];
#pragma unroll
    for (int i = 0; i < 4; ++i) {
        const float s0 = ps[i * 132 + lane], s1 = ps[i * 132 + 64 + lane], s2 = lane < 4 ? ps[i * 132 + 128 + lane] : -INFINITY;
        const float m = wave_max(fmaxf(fmaxf(s0, s1), fmaxf(s2, sink2)));
        const float p0 = exp2f(s0 - m), p1 = exp2f(s1 - m), p2 = exp2f(s2 - m);
        ps[i * 132 + lane] = p0; ps[i * 132 + 64 + lane] = p1; if (lane < 4) ps[i * 132 + 128 + lane] = p2;
        linv[i] = 1.0f / (wave_sum(p0 + p1 + p2) + exp2f(sink2 - m));
    }
    LDS_WAIT(); asm volatile("" ::: "memory");
    float o[4] = {0.f, 0.f, 0.f, 0.f};
#pragma unroll 4
    for (int kj = 0; kj < 128; ++kj) { const float v = A->cache_v[((size_t)(b * 128 + kj) * 2 + kh) * 64 + lane];
#pragma unroll
        for (int i = 0; i < 4; ++i) o[i] += ps[i * 132 + kj] * v; }
#pragma unroll
    for (int kj = 128; kj < 132; ++kj) { const float v = bf2f(KVg[(size_t)(MP + b * TS + (kj - 128)) * 256 + 128 + kh * 64 + lane]);
#pragma unroll
        for (int i = 0; i < 4; ++i) o[i] += ps[i * 132 + kj] * v; }
    bf16* OAg = (bf16*)((unsigned char*)A->out + DO_OA);
#pragma unroll
    for (int i = 0; i < 4; ++i) OAg[(size_t)(NBATCH * SEQ + b * TS + i) * OAB_PITCH + head * 64 + lane] = f2bf(o[i] * linv[i]);
    LDS_WAIT(); asm volatile("" ::: "memory");
}
constexpr int NINV_WG = 24;
DI void p23_mixers(KA A, LAS unsigned char* lds, const XcdBarrier& dbg_bar, unsigned ep, int pmode = 0) {
    const int tid = threadIdx.x, lane = tid & 63, wave = __builtin_amdgcn_readfirstlane(tid >> 6), G = gridDim.x, wg = blockIdx.x;
    const int NSCAN = N_PROMPT_SEQ, NP = G - NSCAN - NINV_WG;
    if (wg < NSCAN) { if (!(pmode & 2)) scan_prompt_wg(A, wg, lds, ep); return; }
    if (wg < NSCAN + NINV_WG) {
        const int wv = (wg - NSCAN) * NWAVES + wave, NWV = NINV_WG * NWAVES;
#pragma unroll 1
        for (int m = wv; m < N_ITEMS; m += NWV) {
            const int item = order_item(m), p = m % NP, k = m / NP;
            const float gcl = wait_item(item_flag1(A, item), ep);
            __builtin_amdgcn_fence(__ATOMIC_ACQUIRE, "agent");
            const float* ats = (const float*)((const unsigned char*)A->out + DO_ATS + ((size_t)p * 8 + (k & 7)) * ATS_ITEM);
            if (pmode & 16) { if (lane == 0) __hip_atomic_store(item_granule(A, item), ((unsigned long long)ep << 32), __ATOMIC_RELAXED, __HIP_MEMORY_SCOPE_AGENT); }
            else prep_stage2(A, item, gcl, ats, (LAS float*)(lds + wave * 16384), ep);
        }
        return;
    }
    const int p = wg - NSCAN - NINV_WG;
    {
        const int ntot = p < N_ITEMS ? (N_ITEMS - 1 - p) / NP + 1 : 0;
        S1Pre P;
        if (ntot > 0) stage1_issue(A, order_item(p), P);
        int prev = -1;
#pragma unroll 1
        for (int k = 0; k < ntot; ++k) {
            const int m = p + NP * k, item = order_item(m), nxt = k + 1 < ntot ? order_item(m + NP) : N_ITEMS;
            float* ats = (float*)((unsigned char*)A->out + DO_ATS + ((size_t)p * 8 + (k & 7)) * ATS_ITEM);
            prep_stage1(A, item, nxt, prev, k >= 8 ? order_item(m - 8 * NP) : -1, k & 1, ats, P, lds, ep, pmode);
            prev = item;
        }
        asm volatile("s_waitcnt vmcnt(0)" ::: "memory"); __syncthreads();
        if (prev >= 0 && tid == 0) __hip_atomic_store(item_flag1(A, prev), ((unsigned long long)ep << 32) | (unsigned long long)__float_as_uint(((const LAS float*)(lds + LDS_GCL))[(ntot - 1) & 1]), __ATOMIC_RELAXED, __HIP_MEMORY_SCOPE_AGENT);
    }
    if (pmode & 1) return;
    for (int u = p; u < NBATCH * NKV * 32; u += NP) attn_unit(A, u, lds);
    const int worker = p * NWAVES + wave, NW = NP * NWAVES;
    LAS float* wl = (LAS float*)(lds + 98304 + wave * 4096);
    for (int it = worker; it < SBATCH * NHB * 4 + SBATCH * NHA; it += NW) {
        if (it < SBATCH * NHB * 4) scan_seq(A, N_PROMPT_SEQ + (it >> 2), it & 3, lane, ep);
        else { const int q = it - SBATCH * NHB * 4; sample_attn(A, q >> 3, q & 7, wl, lane); }
    }
}

DI void p3b_gated_norm(KA A) {
    const int tid = threadIdx.x, lane = tid & 63, wave = tid >> 6, gw = blockIdx.x * NWAVES + wave, NGW = gridDim.x * NWAVES;
    const int head = lane >> 4, dv0 = 8 * (lane & 15);
    const f32x4 w0 = *(const f32x4*)(A->gdn_norm + dv0), w1 = *(const f32x4*)(A->gdn_norm + dv0 + 4);
    bf16* OBg = (bf16*)((unsigned char*)A->out + DO_OB); const bf16* Zg = (const bf16*)(A->ws + WS_Z);
    for (int crow = gw; crow < MC; crow += NGW) {
        const u32x4 ow = *(const u32x4*)(OBg + (size_t)crow * OAB_PITCH + head * 128 + dv0);
        const f32x4 a = {bflo(ow.x), bfhi(ow.x), bflo(ow.y), bfhi(ow.y)}, c = {bflo(ow.z), bfhi(ow.z), bflo(ow.w), bfhi(ow.w)};
        float ss = (a[0] * a[0] + a[1] * a[1]) + (a[2] * a[2] + a[3] * a[3]) + (c[0] * c[0] + c[1] * c[1]) + (c[2] * c[2] + c[3] * c[3]);
        ss += __shfl_xor(ss, 1); ss += __shfl_xor(ss, 2); ss += __shfl_xor(ss, 4); ss += __shfl_xor(ss, 8);
        const float rstd = rsqrtf(ss * (1.0f / 128.0f) + EPS);
        const u32x4 zw = *(const u32x4*)(Zg + (size_t)pg8::crow_to_urow(crow) * 512 + head * 128 + dv0);
        f32x4 y0, y1;
        y0[0] = a[0] * rstd * w0[0] * siluf_(bflo(zw.x)); y0[1] = a[1] * rstd * w0[1] * siluf_(bfhi(zw.x)); y0[2] = a[2] * rstd * w0[2] * siluf_(bflo(zw.y)); y0[3] = a[3] * rstd * w0[3] * siluf_(bfhi(zw.y));
        y1[0] = c[0] * rstd * w1[0] * siluf_(bflo(zw.z)); y1[1] = c[1] * rstd * w1[1] * siluf_(bfhi(zw.z)); y1[2] = c[2] * rstd * w1[2] * siluf_(bflo(zw.w)); y1[3] = c[3] * rstd * w1[3] * siluf_(bfhi(zw.w));
        *(u32x4*)(OBg + (size_t)crow * OAB_PITCH + head * 128 + dv0) = pack8f(y0, y1);
    }
}
DI void p8_final_norm(KA A) {
    const int tid = threadIdx.x, lane = tid & 63, wave = tid >> 6, gw = blockIdx.x * NWAVES + wave, NGW = gridDim.x * NWAVES;
    f32x4 nf[4];
#pragma unroll
    for (int j = 0; j < 4; ++j) nf[j] = ((const f32x4*)A->norm_final)[lane + 64 * j];
    const bf16* H2 = (const bf16*)(A->ws + WS_MB);
    for (int crow = gw; crow < MC; crow += NGW) {
        const u32x2* hrow = (const u32x2*)(H2 + (size_t)crow * D);
        f32x4* row = (f32x4*)(A->out + (size_t)crow * D);
        f32x4 v[4]; float ss = 0.f;
#pragma unroll
        for (int j = 0; j < 4; ++j) { const u32x2 hw = hrow[lane + 64 * j]; v[j] = (f32x4){bflo(hw.x), bfhi(hw.x), bflo(hw.y), bfhi(hw.y)};
            ss += (v[j][0] * v[j][0] + v[j][1] * v[j][1]) + (v[j][2] * v[j][2] + v[j][3] * v[j][3]); }
        const float rstd = rsqrtf(wave_sum(ss) * (1.0f / D) + EPS);
#pragma unroll
        for (int j = 0; j < 4; ++j) row[lane + 64 * j] = v[j] * rstd * nf[j];
    }
}
__global__ void __launch_bounds__(NTHREADS, 2) hybrid_fwd(Args Aval) {
    extern __shared__ __attribute__((aligned(16))) unsigned char lds_raw[];
    LAS unsigned char* lds = (LAS unsigned char*)lds_raw;
    const int tid = threadIdx.x;
    int lo, hi; { KA A0 = kargs(); lo = A0->ph_lo; hi = A0->ph_hi; }
#if MK_N_LAUNCHES == 1
#if MK_BARRIER == 1
    volatile LAS unsigned* MISC = (volatile LAS unsigned*)(lds + LDS_MISC);
    if (tid < 64) MISC[tid] = 0u;
    __syncthreads();
    XcdBarrier bar; { KA A0 = kargs(); bar = xcd_barrier_post((unsigned*)(A0->ws + WS_CTL) + 4096, MISC + 8); }
#define GRID_BAR() xcd_barrier(bar)
#else
    cg::grid_group grid = cg::this_grid();
#define GRID_BAR() grid.sync()
#endif
#else
#define GRID_BAR() do {} while (0)
#endif
#ifndef PH_MASK
#define PH_MASK 0x1ff
#endif
#define IN(k) (((PH_MASK >> (k)) & 1) && lo <= (k) && (k) < hi)
#ifndef PROBE_REP
#define PROBE_REP -1
#endif
#define NREP(k) (PROBE_REP == (k) ? 2 : 1)
#define SEAM(k) do { if (IN(k) && IN((k) + 1)) GRID_BAR(); } while (0)
    const int G = gridDim.x, wgid = blockIdx.x;
#if PROBE_REP == 0
    if (IN(0)) { KA A = kargs(); p0_prologue(A, lds); __syncthreads(); }
#endif
    if (IN(0)) { KA A = kargs(); p0_prologue(A, lds); } SEAM(0);
    if (IN(1)) for (int rep = 0; rep < NREP(1); ++rep) { KA A = kargs(); unsigned char* ws = A->ws;
        pg8::Gemm g{(const bf16*)(ws + WS_XN), (const bf16*)(ws + WS_WIN), MUP, NIN, D}; pg8::StaticOrder S; S.init(MUP, NIN, G, wgid);
        pg8::EpiInProj E{(bf16*)(ws + WS_QA), (bf16*)(ws + WS_KV), (bf16*)(ws + WS_QKVB), (bf16*)(ws + WS_Z), (bf16*)(ws + WS_G),
                         (const float*)(ws + WS_ROPE), (const float*)(ws + WS_ROPE) + (TP + TS) * 32, A->out};
        pg8::gemm_phase<pg8::EpiInProj, pg8::StaticOrder, true, true>(lds, g, S, E);
    } SEAM(1);
#ifndef PROBE_MODE
#define PROBE_MODE 0
#endif
#if PROBE_REP == 2
    if (IN(2)) { KA A = kargs(); p23_mixers(A, lds, bar, 1u); GRID_BAR(); }
    if (IN(2)) { KA A = kargs(); p23_mixers(A, lds, bar, 2u, PROBE_MODE); } SEAM(2);
#else
    if (IN(2)) { KA A = kargs(); p23_mixers(A, lds, bar, 1u); } SEAM(2);
#endif
    if (IN(3)) for (int rep = 0; rep < NREP(3); ++rep) { KA A = kargs(); p3b_gated_norm(A); } SEAM(3);
    if (IN(4)) for (int rep = 0; rep < NREP(4); ++rep) { KA A = kargs(); unsigned char* ws = A->ws;
        const bf16* OABp = (const bf16*)((unsigned char*)A->out + DO_OA); const bf16* Wm = (const bf16*)(ws + WS_WOA);
        { pg8::Gemm g{OABp, Wm, MC, D, 512, 1024}; pg8::StaticOrder S; S.init(MC, D, G, wgid); S.lim = (S.nwg / G) * G;
          pg8::EpiMerge<false> E{(bf16*)(ws + WS_MB), (const bf16*)(ws + WS_G), 0};
          pg8::gemm_phase<pg8::EpiMerge<false>, pg8::StaticOrder, true, true>(lds, g, S, E); }
        asm volatile("s_waitcnt vmcnt(0)" ::: "memory"); __syncthreads();
        { pg8::Gemm g{OABp + 512, Wm + 512, MC, D, 512, 1024}; pg8::StaticOrder S; S.init(MC, D, G, wgid); S.lim = (S.nwg / G) * G;
          pg8::EpiMerge<true> E{(bf16*)(ws + WS_MB), (const bf16*)(ws + WS_G), 1024};
          pg8::gemm_phase<pg8::EpiMerge<true>, pg8::StaticOrder, true, true>(lds, g, S, E); }
        { const int nstr = (MC / 256) * 4 - ((MC / 256) * 4 / G) * G;
          if (wgid < nstr * 4) { const int t = wgid >> 2, sl = wgid & 3, koff = sl * 256;
            pg8::Gemm g{OABp + koff, Wm + koff, MC, D, 256, 1024};
            pg8::SliceOrder S; S.init_slice(MC, D, G, ((MC / 256) * 4 / G) * G, t);
            pg8::EpiSplit<pg8::EpiStoreMB, true> E{pg8::EpiStoreMB{(bf16*)(ws + WS_MB)}, (float*)(ws + WS_SCR) + (size_t)t * 65536, (unsigned*)(ws + WS_CTL + CTL_SPL) + t * 8, 4u, (const bf16*)(ws + WS_G), (sl >> 1) ? 1024 : 0};
            pg8::gemm_phase<pg8::EpiSplit<pg8::EpiStoreMB, true>, pg8::SliceOrder, true, true>(lds, g, S, E); } }
    } SEAM(4);
    if (IN(5)) { KA A = kargs(); unsigned char* ws = A->ws;
        { pg8::Gemm g{(const bf16*)(ws + WS_MB), (const bf16*)(ws + WS_WOUT), MC, D, D}; pg8::StaticOrder S; S.init(MC, D, G, wgid); S.lim = (S.nwg / G) * G;
          pg8::EpiWout<true> E{A->x_prompt, A->x_sample, (bf16*)(ws + WS_HB1), (float*)(ws + WS_CTL + CTL_SS1)};
          pg8::gemm_phase<pg8::EpiWout<true>, pg8::StaticOrder, true, true>(lds, g, S, E); }
        { const int nstr = (MC / 256) * 4 - ((MC / 256) * 4 / G) * G;
          if (wgid < nstr * 4) { const int t = wgid >> 2, koff = (wgid & 3) * 256;
            pg8::Gemm g{(const bf16*)(ws + WS_MB) + koff, (const bf16*)(ws + WS_WOUT) + koff, MC, D, 256, D};
            pg8::SliceOrder S; S.init_slice(MC, D, G, ((MC / 256) * 4 / G) * G, t);
            pg8::EpiSplit<pg8::EpiWout<true>, false> E{pg8::EpiWout<true>{A->x_prompt, A->x_sample, (bf16*)(ws + WS_HB1), (float*)(ws + WS_CTL + CTL_SS1)}, (float*)(ws + WS_SCR) + (size_t)t * 65536, (unsigned*)(ws + WS_CTL + CTL_SPL) + t * 8, 4u, nullptr, 0};
            pg8::gemm_phase<pg8::EpiSplit<pg8::EpiWout<true>, false>, pg8::SliceOrder, true, true>(lds, g, S, E); } }
    } SEAM(5);
    if (IN(6)) for (int rep = 0; rep < NREP(6); ++rep) { KA A = kargs(); unsigned char* ws = A->ws;
        pg8::Gemm g{(const bf16*)(ws + WS_HB1), (const bf16*)(ws + WS_WGU), MC, 2 * DFF, D}; pg8::StaticOrder S; S.init(MC, 2 * DFF, G, wgid);
        pg8::EpiGateUp E{(bf16*)(ws + WS_ACT), (const float*)(ws + WS_CTL + CTL_SS1)};
        pg8::gemm_phase<pg8::EpiGateUp, pg8::StaticOrder, true, true>(lds, g, S, E);
    } SEAM(6);
    if (IN(7)) for (int rep = 0; rep < NREP(7); ++rep) { KA A = kargs(); unsigned char* ws = A->ws;
        { pg8::Gemm g{(const bf16*)(ws + WS_ACT), (const bf16*)(ws + WS_WD), MC, D, DFF}; pg8::StaticOrder S; S.init(MC, D, G, wgid); S.lim = (S.nwg / G) * G;
          pg8::EpiDown<false> E{(const bf16*)(ws + WS_HB1), (bf16*)(ws + WS_MB)};
          pg8::gemm_phase<pg8::EpiDown<false>, pg8::StaticOrder, true, true>(lds, g, S, E); }
        { const int nstr = (MC / 256) * 4 - ((MC / 256) * 4 / G) * G;
          if (wgid < nstr * 11) { const int t = wgid / 11, koff = (wgid % 11) * 256;
            pg8::Gemm g{(const bf16*)(ws + WS_ACT) + koff, (const bf16*)(ws + WS_WD) + koff, MC, D, 256, DFF};
            pg8::SliceOrder S; S.init_slice(MC, D, G, ((MC / 256) * 4 / G) * G, t);
            pg8::EpiSplit<pg8::EpiDown<false>, false> E{pg8::EpiDown<false>{(const bf16*)(ws + WS_HB1), (bf16*)(ws + WS_MB)}, (float*)(ws + WS_SCR) + (size_t)t * 65536, (unsigned*)(ws + WS_CTL + CTL_SPL) + t * 8, 11u, nullptr, 0};
            pg8::gemm_phase<pg8::EpiSplit<pg8::EpiDown<false>, false>, pg8::SliceOrder, true, true>(lds, g, S, E); } }
    } SEAM(7);
    if (IN(8)) { KA A = kargs(); p8_final_norm(A); }
#undef IN
#undef SEAM
}

extern "C" void kernel_launch(void* const* d_in, const int* in_sizes, int n_in, void* d_out, int out_size, void* d_ws, size_t ws_size, hipStream_t stream) {
    static int grid = 0;
    if (grid == 0) {
        if (n_in != 22 || out_size != (int)O_END || ws_size < WS_END) { fprintf(stderr, "kernel_launch: unexpected problem (n_in %d, out %d, ws %zu)\n", n_in, out_size, ws_size); grid = -1; return; }
        int dev = 0, cus = 0, per_cu = 0;
        if (hipGetDevice(&dev) != hipSuccess || hipDeviceGetAttribute(&cus, hipDeviceAttributeMultiprocessorCount, dev) != hipSuccess) { grid = -1; return; }
        if (hipFuncSetAttribute((const void*)hybrid_fwd, hipFuncAttributeMaxDynamicSharedMemorySize, LDS_BYTES) != hipSuccess) { fprintf(stderr, "kernel_launch: hipFuncSetAttribute failed\n"); grid = -1; return; }
        if (hipOccupancyMaxActiveBlocksPerMultiprocessor(&per_cu, (const void*)hybrid_fwd, NTHREADS, LDS_BYTES) != hipSuccess || per_cu < 1) { fprintf(stderr, "kernel_launch: occupancy query says %d\n", per_cu); per_cu = 1; }
        (void)hipGetLastError();
        grid = cus;
        if (grid > 256) grid = 256;
    }
    if (grid < 0) return;
    (void)hipMemsetAsync((char*)d_ws + WS_CTL, 0, CTL_BYTES, stream);
    (void)hipMemsetAsync((char*)d_ws + WS_SCR, 0, SCR_BYTES, stream);
    Args a{};
    const float** ap = (const float**)&a;
    for (int i = 0; i < 22; ++i) ap[i] = (const float*)d_in[i];
    a.out = (float*)d_out; a.ws = (unsigned char*)d_ws;
#if MK_N_LAUNCHES == 1
    a.ph_lo = 0; a.ph_hi = N_PHASES;
#if MK_BARRIER == 1
    hipLaunchKernelGGL(hybrid_fwd, dim3(grid), dim3(NTHREADS), LDS_BYTES, stream, a);
#else
    void* args[] = {&a};
    hipError_t e = hipLaunchCooperativeKernel((const void*)hybrid_fwd, dim3(grid), dim3(NTHREADS), args, LDS_BYTES, stream);
    if (e != hipSuccess) fprintf(stderr, "cooperative launch failed: %s (grid %d)\n", hipGetErrorString(e), grid);
#endif
#else
    for (int p = 0; p < N_PHASES; ++p) { a.ph_lo = p; a.ph_hi = p + 1; hipLaunchKernelGGL(hybrid_fwd, dim3(grid), dim3(NTHREADS), LDS_BYTES, stream, a); }
#endif
}
```

```cpp
#include <hip/hip_runtime.h>
#include <hip/hip_cooperative_groups.h>
#include <cstdio>
#include <cstdint>
namespace cg = cooperative_groups;

#ifndef MK_N_LAUNCHES
#define MK_N_LAUNCHES 1
#endif
#ifndef MK_BARRIER
#define MK_BARRIER 1
#endif

constexpr int D = 1024, NBATCH = 8, SEQ = 4096, NMETA = 16, TP = SEQ + NMETA, MP = NBATCH * TP;
constexpr int SBATCH = 128, TS = 4, MS = SBATCH * TS, MU = MP + MS, MUP = 33536, MC = NBATCH * SEQ + MS;
constexpr int PAST = 16384;
constexpr int HD = 64, NHA = 8, NKV = 2;
constexpr int NHB = 4, CONVD = 1536;
constexpr int DFF = 2816, NIN_SRC = 4872, NIN = 4864;
constexpr float EPS = 1e-6f;
constexpr float QSCALE = 0.125f * 1.4426950408889634f;

constexpr size_t MiB = 1u << 20, KiB = 1024;
constexpr size_t WS_CTL = 0, CTL_BYTES = 1 * MiB;
constexpr size_t WS_WIN = 1 * MiB;
constexpr size_t WS_WOA = 11 * MiB, WS_WOB = 12 * MiB;
constexpr size_t WS_WOUT = 13 * MiB;
constexpr size_t WS_WGU = 15 * MiB;
constexpr size_t WS_WD = 26 * MiB;
constexpr size_t WS_ROPE = 32 * MiB;
constexpr size_t WS_GB = 34 * MiB;
constexpr size_t WS_SC = 36 * MiB;
constexpr size_t WS_SS1 = 37 * MiB, WS_SS2 = 37 * MiB + 512 * KiB;
constexpr size_t WS_SCR = 38 * MiB, SCR_BYTES = 2 * MiB;
constexpr size_t CTL_SPL6 = 53248;
constexpr size_t CTL_SPL = 49152;
constexpr size_t WS_QA = 41 * MiB;
constexpr size_t WS_KV = WS_QA + (size_t)MUP * 512 * 2;
constexpr size_t WS_QKVB = WS_KV + (size_t)MUP * 256 * 2;
constexpr size_t WS_Z = WS_QKVB + (size_t)MUP * 1536 * 2;
constexpr size_t WS_G = WS_Z + (size_t)MUP * 512 * 2;
constexpr size_t WS_GEND = WS_G + (size_t)MUP * 2048 * 2;
constexpr size_t WS_B = 353 * MiB, WS_END = 512 * MiB;
static_assert(WS_GEND <= WS_B, "ws map");
constexpr size_t WS_XN = WS_B;
constexpr size_t PREP_SLOT = 80 * KiB;
constexpr int PREP_N1 = (int)((WS_END - WS_B) / PREP_SLOT);
constexpr size_t DO_OA = 44 * MiB;
constexpr int OAB_PITCH = 1024;
constexpr size_t DO_OB = DO_OA + 512 * 2;
constexpr size_t DO_ATS = DO_OA + (size_t)MC * OAB_PITCH * 2;
constexpr size_t ATS_ITEM = 3 * 32 * 32 * 4;
static_assert(DO_ATS + 212 * 8 * ATS_ITEM <= (size_t)MC * 1024 * 4, "d_out scratch map");
constexpr size_t WS_MB = WS_B;
constexpr size_t WS_HB1 = WS_B + 66 * MiB;
static_assert(WS_HB1 + (size_t)MC * 1024 * 2 <= WS_END, "ws map");
constexpr size_t WS_ACT = WS_QA;
static_assert(WS_ACT + (size_t)MC * DFF * 2 <= WS_G, "ws map");
constexpr int SL_BEK = 0, SL_BV = 16 * 1024, SL_T = 32 * 1024, SL_QKD = 40 * 1024, SL_QE = 48 * 1024, SL_KWT = 64 * 1024;
constexpr int N_PROMPT_SEQ = NBATCH * NHB, CHUNKS_P = 65, N_ITEMS_P = N_PROMPT_SEQ * CHUNKS_P, N_ITEMS = N_ITEMS_P;
static_assert((size_t)(N_ITEMS - PREP_N1) * PREP_SLOT <= DO_OA, "prep slots");

constexpr size_t O_YP = 0, O_YS = (size_t)NBATCH * SEQ * D, O_KP = O_YS + (size_t)MS * D, O_VP = O_KP + 8 * 128 * 2 * 64, O_DP = O_VP + 8 * 128 * 2 * 64,
                 O_CP = O_DP + 8 * 4 * 128 * 128, O_KS = O_CP + 8 * 3 * 1536, O_VS = O_KS + (size_t)128 * 128 * 2 * 64, O_DS = O_VS + (size_t)128 * 128 * 2 * 64,
                 O_CS = O_DS + (size_t)128 * 4 * 128 * 128, O_END = O_CS + (size_t)128 * 3 * 1536;
static_assert(O_END == 48074752, "d_out size");

#define DI __device__ __forceinline__
#define GAS __attribute__((address_space(1)))
#define LAS __attribute__((address_space(3)))
typedef unsigned short bf16;
typedef short bf16x8 __attribute__((ext_vector_type(8)));
typedef float f32x4 __attribute__((ext_vector_type(4)));
typedef float f32x2 __attribute__((ext_vector_type(2)));
typedef float f32x16 __attribute__((ext_vector_type(16)));
typedef unsigned u32x4 __attribute__((ext_vector_type(4)));
typedef unsigned u32x2 __attribute__((ext_vector_type(2)));
typedef __bf16 bf16x2_t __attribute__((ext_vector_type(2)));

DI unsigned cvtpk(float lo, float hi) { f32x2 v = {lo, hi}; bf16x2_t b = __builtin_convertvector(v, bf16x2_t); return __builtin_bit_cast(unsigned, b); }
DI bf16 f2bf(float f) { return (bf16)(cvtpk(f, 0.f) & 0xffffu); }
DI float bf2f(unsigned short h) { return __uint_as_float((unsigned)h << 16); }
DI float bflo(unsigned w) { return __uint_as_float(w << 16); }
DI float bfhi(unsigned w) { return __uint_as_float(w & 0xffff0000u); }
DI u32x4 pack8f(f32x4 a, f32x4 b) { u32x4 w; w.x = cvtpk(a[0], a[1]); w.y = cvtpk(a[2], a[3]); w.z = cvtpk(b[0], b[1]); w.w = cvtpk(b[2], b[3]); return w; }
DI float frcp_(float x) { return __builtin_amdgcn_rcpf(x); }
DI float sigmoidf_(float x) { return frcp_(1.0f + __builtin_amdgcn_exp2f(x * -1.4426950408889634f)); }
DI float siluf_(float x) { return x * sigmoidf_(x); }
DI void st16_sc1(void* p, u32x4 v) { asm volatile("global_store_dwordx4 %0, %1, off sc1\n\ts_nop 1" :: "v"(p), "v"(v) : "memory"); }
DI void st16_sc1f(void* p, f32x4 v) { asm volatile("global_store_dwordx4 %0, %1, off sc1\n\ts_nop 1" :: "v"(p), "v"(v) : "memory"); }
DI void st2_sc1(void* p, unsigned v) { asm volatile("global_store_short %0, %1, off sc1\n\ts_nop 1" :: "v"(p), "v"(v) : "memory"); }
constexpr size_t CTL_GRAN = 65536, CTL_CNT = 245760, CTL_SS1 = 458752;
static_assert(CTL_CNT + 5 * 130 * 256 <= CTL_SS1 && CTL_SS1 + 33280 * 4 <= 1048576 && CTL_GRAN + 2592 * 64 <= CTL_CNT, "control region map");
constexpr int CNT_STRIDE = 130 * 64;
DI int pos_of_d(int d) { const int dd = d & 31; return 8 * (dd >> 2) + (dd & 3) + ((d >> 5) << 2); }
DI int d_of_pos(int p) { const int j = p & 7; return 4 * (p >> 3) + (j & 3) + ((j >> 2) << 5); }
namespace pg8 {
#define PG8_LAS __attribute__((address_space(3)))
typedef unsigned short bf16_t;
typedef short bf16x8 __attribute__((ext_vector_type(8)));
typedef float f32x4 __attribute__((ext_vector_type(4)));
typedef unsigned u32x4 __attribute__((ext_vector_type(4)));
constexpr int BM = 256, BK = 64, HALF = 128, HTB = HALF * BK * 2  , STAGE_BYTES = 8 * HTB, NXCD = 8, WGM = 8;

__host__ __device__ __forceinline__ int lds_byte(int r, int c) { const int st = (r >> 4) * 2 + (c >> 5), rr = r & 15, cc = c & 31, ob = rr * 64 + cc * 2; return st * 1024 + (ob ^ (((ob >> 9) & 1) << 5)); }
__host__ __device__ __forceinline__ void stage_rc(int b, int& R, int& C) { const int st = b / 1024, sb = b % 1024, swz = sb ^ (((sb >> 9) & 1) << 5); R = (st >> 1) * 16 + swz / 64; C = (st & 1) * 32 + (swz % 64) / 2; }
__host__ __device__ __forceinline__ int perm32(int rho) { const int n = rho >> 4, i = rho & 15; return 8 * (i >> 2) + 4 * n + (i & 3); }

struct Unit { int pm, pn; };
struct Gemm { const bf16_t* A; const bf16_t* Bt; int M, N, K; int ldk; };

struct StaticOrder {
    static constexpr bool A_SC1 = false;
    int nM, nN, nwg, G, c, lim;
    __host__ __device__ void init(int M, int N, int G_, int c_) { nM = M / BM; nN = N / BM; nwg = nM * nN; G = G_; c = c_; lim = nwg; }
    __host__ __device__ bool next(int i, Unit& u) const {
        const long L = (long)i * G + c; if (L >= lim) return false;
        int wgid = (int)L; { const int q = nwg / NXCD, r = nwg % NXCD, xcd = wgid % NXCD, off = wgid / NXCD; wgid = (xcd < r ? xcd * (q + 1) : r * (q + 1) + (xcd - r) * q) + off; }
        const int nig = WGM * nN, gid = wgid / nig, fm = gid * WGM, gsz = (nM - fm) < WGM ? (nM - fm) : WGM;
        u.pm = fm + ((wgid % nig) % gsz); u.pn = (wgid % nig) / gsz; return true;
    }
    __device__ __forceinline__ void a_ready(const Unit&) const {}
    __device__ __forceinline__ void done(const Unit&) const {}
};
struct FlagOrder : StaticOrder {
    static constexpr bool A_SC1 = true;
    const unsigned* ready; unsigned need; unsigned* pub; unsigned* gpub;
    __device__ __forceinline__ void a_ready(const Unit& u) const {
        if (ready) {
            if (threadIdx.x < 64) { unsigned spins = 0;
                while ((unsigned)__builtin_amdgcn_readfirstlane(__hip_atomic_load(ready + 64 * u.pm, __ATOMIC_RELAXED, __HIP_MEMORY_SCOPE_AGENT)) < need) { __builtin_amdgcn_s_sleep(2); if (++spins > (1u << 22)) break; } }
            asm volatile("" ::: "memory"); __builtin_amdgcn_s_barrier(); asm volatile("" ::: "memory");
        }
    }
    __device__ __forceinline__ void done(const Unit& u) const {
        if (pub) { asm volatile("s_waitcnt vmcnt(0)" ::: "memory");
            if ((threadIdx.x & 63) == 0) { __hip_atomic_fetch_add(pub + 64 * u.pm, 1u, __ATOMIC_RELAXED, __HIP_MEMORY_SCOPE_AGENT); if (gpub) __hip_atomic_fetch_add(gpub, 1u, __ATOMIC_RELAXED, __HIP_MEMORY_SCOPE_AGENT); } }
    }
};
struct SliceOrder : StaticOrder {
    int t;
    __host__ __device__ void init_slice(int M, int N, int G_, int first, int t_) { init(M, N, G_, 0); t = t_; c = first + t_; G = 0; }
    __host__ __device__ bool next(int i, Unit& u) const { return i == 0 ? StaticOrder::next(0, u) : false; }
};

__device__ __forceinline__ void urow_info(int urow, int& kind, int& b, int& t, int& ridx) {
    if (urow < MP) { b = urow / TP; t = urow - b * TP; kind = 0; ridx = t; }
    else if (urow < MU) { const int s = urow - MP; b = s >> 2; t = s & 3; kind = 1; ridx = TP + t; }
    else { kind = 2; b = 0; t = 0; ridx = 0; }
}
__device__ __forceinline__ int crow_to_urow(int crow) { return crow < NBATCH * SEQ ? crow + NMETA * ((crow >> 12) + 1) : MP + (crow - NBATCH * SEQ); }

struct EpiInProj {
    static constexpr bool PERM = true, AFTER_DRAIN = false;
    bf16_t *QA, *KV, *QKVB, *Z, *G; const float *COS, *SIN; float* out;
    __device__ __forceinline__ void operator()(const f32x4 (&acc)[2][2][4][2], const Unit& u, int wr, int wc, int fr, int fq) const {
        const int pn = u.pn;
#pragma unroll
        for (int ai = 0; ai < 2; ++ai)
#pragma unroll
            for (int m = 0; m < 4; ++m) {
                const int row = u.pm * BM + ai * HALF + wr * 64 + m * 16 + fr;
                int kind, b, t, ridx; urow_info(row, kind, b, t, ridx);
#pragma unroll
                for (int bj = 0; bj < 2; ++bj) {
                    const int cl = bj * HALF + wc * 32 + 8 * fq;
                    const f32x4 v0 = acc[ai][bj][m][0], v1 = acc[ai][bj][m][1];
                    if (pn < 2) {
                        const int c = pn * 256 + cl, d0 = ((c & 63) >> 3) * 4;
                        const f32x4 cs = *(const f32x4*)(COS + ridx * 32 + d0), sn = *(const f32x4*)(SIN + ridx * 32 + d0);
                        const f32x4 o1 = (v0 * cs - v1 * sn) * QSCALE, o2 = (v1 * cs + v0 * sn) * QSCALE;
                        *(u32x4*)(QA + (size_t)row * 512 + c) = pack8f(o1, o2);
                    } else if (pn == 2) {
                        if (bj == 0) {
                            const int kh = cl >> 6, d0 = ((cl & 63) >> 3) * 4;
                            const f32x4 cs = *(const f32x4*)(COS + ridx * 32 + d0), sn = *(const f32x4*)(SIN + ridx * 32 + d0);
                            const f32x4 o1 = v0 * cs - v1 * sn, o2 = v1 * cs + v0 * sn;
                            *(u32x4*)(KV + (size_t)row * 256 + cl) = pack8f(o1, o2);
                            float* dst = nullptr;
                            if (kind == 0 && t >= TP - 128) dst = out + O_KP + ((size_t)(b * 128 + (t - (TP - 128))) * 2 + kh) * 64;
                            else if (kind == 1) dst = out + O_KS + ((size_t)(b * 128 + 124 + t) * 2 + kh) * 64;
                            if (dst) { *(f32x4*)(dst + d0) = o1; *(f32x4*)(dst + 32 + d0) = o2; }
                        } else {
                            const int cv = cl - 128, kh = cv >> 6, dd = cv & 63;
                            *(u32x4*)(KV + (size_t)row * 256 + cl) = pack8f(v0, v1);
                            float* dst = nullptr;
                            if (kind == 0 && t >= TP - 128) dst = out + O_VP + ((size_t)(b * 128 + (t - (TP - 128))) * 2 + kh) * 64;
                            else if (kind == 1) dst = out + O_VS + ((size_t)(b * 128 + 124 + t) * 2 + kh) * 64;
                            if (dst) { *(f32x4*)(dst + dd) = v0; *(f32x4*)(dst + dd + 4) = v1; }
                        }
                    } else if (pn < 9) {
                        const int c = (pn - 3) * 256 + cl;
                        *(u32x4*)(QKVB + (size_t)row * 1536 + c) = pack8f(v0, v1);
                        float* dst = nullptr;
                        if (kind == 0 && t >= TP - 3) dst = out + O_CP + ((size_t)b * 3 + (t - (TP - 3))) * 1536;
                        else if (kind == 1 && t >= 1) dst = out + O_CS + ((size_t)b * 3 + (t - 1)) * 1536;
                        if (dst) { *(f32x4*)(dst + c) = v0; *(f32x4*)(dst + c + 4) = v1; }
                    } else if (pn < 11) {
                        const int c = (pn - 9) * 256 + cl;
                        *(u32x4*)(Z + (size_t)row * 512 + c) = pack8f(v0, v1);
                    } else {
                        const int c = (pn - 11) * 256 + cl;
                        f32x4 g0, g1;
#pragma unroll
                        for (int e = 0; e < 4; ++e) { g0[e] = sigmoidf_(v0[e]); g1[e] = sigmoidf_(v1[e]); }
                        *(u32x4*)(G + (size_t)row * 2048 + c) = pack8f(g0, g1);
                    }
                }
            }
    }
};

template <bool ACCUM> struct EpiMerge {
    static constexpr bool PERM = true, AFTER_DRAIN = false;
    bf16_t* MBp; const bf16_t* G; int gate_off;
    __device__ __forceinline__ void operator()(const f32x4 (&acc)[2][2][4][2], const Unit& u, int wr, int wc, int fr, int fq) const {
#pragma unroll
        for (int ai = 0; ai < 2; ++ai)
#pragma unroll
            for (int m = 0; m < 4; ++m) {
                const int crow = u.pm * BM + ai * HALF + wr * 64 + m * 16 + fr, urow = crow_to_urow(crow);
#pragma unroll
                for (int bj = 0; bj < 2; ++bj) {
                    const int c = u.pn * BM + bj * HALF + wc * 32 + 8 * fq;
                    const u32x4 gw = *(const u32x4*)(G + (size_t)urow * 2048 + gate_off + c);
                    f32x4 v0 = acc[ai][bj][m][0], v1 = acc[ai][bj][m][1];
                    v0[0] *= bflo(gw.x); v0[1] *= bfhi(gw.x); v0[2] *= bflo(gw.y); v0[3] *= bfhi(gw.y);
                    v1[0] *= bflo(gw.z); v1[1] *= bfhi(gw.z); v1[2] *= bflo(gw.w); v1[3] *= bfhi(gw.w);
                    bf16_t* p = MBp + (size_t)crow * 1024 + c;
                    if (ACCUM) { const u32x4 pw = *(const u32x4*)p;
                        v0[0] += bflo(pw.x); v0[1] += bfhi(pw.x); v0[2] += bflo(pw.y); v0[3] += bfhi(pw.y);
                        v1[0] += bflo(pw.z); v1[1] += bfhi(pw.z); v1[2] += bflo(pw.w); v1[3] += bfhi(pw.w); }
                    *(u32x4*)p = pack8f(v0, v1);
                }
            }
    }
};

template <bool ATOM = true> struct EpiWout {
    static constexpr bool PERM = true, AFTER_DRAIN = false;
    const float* xp; const float* xs; bf16_t* HB; float* SS;
    __device__ __forceinline__ void operator()(const f32x4 (&acc)[2][2][4][2], const Unit& u, int wr, int wc, int fr, int fq) const {
#pragma unroll
        for (int ai = 0; ai < 2; ++ai)
#pragma unroll
            for (int m = 0; m < 4; ++m) {
                const int crow = u.pm * BM + ai * HALF + wr * 64 + m * 16 + fr;
                const float* hs = crow < NBATCH * SEQ ? xp + (size_t)crow * D : xs + (size_t)(crow - NBATCH * SEQ) * D;
                float ss = 0.f;
#pragma unroll
                for (int bj = 0; bj < 2; ++bj) {
                    const int c = u.pn * BM + bj * HALF + wc * 32 + 8 * fq;
                    const f32x4 r0 = *(const f32x4*)(hs + c) + acc[ai][bj][m][0], r1 = *(const f32x4*)(hs + c + 4) + acc[ai][bj][m][1];
                    *(u32x4*)(HB + (size_t)crow * D + c) = pack8f(r0, r1);
                    ss += (r0[0] * r0[0] + r0[1] * r0[1]) + (r0[2] * r0[2] + r0[3] * r0[3]) + (r1[0] * r1[0] + r1[1] * r1[1]) + (r1[2] * r1[2] + r1[3] * r1[3]);
                }
                ss += __shfl_xor(ss, 16); ss += __shfl_xor(ss, 32);
                if (ATOM && fq == 0) atomicAdd(SS + crow, ss);
            }
    }
};

struct EpiGateUp {
    static constexpr bool PERM = true, AFTER_DRAIN = false;
    bf16_t* ACT; const float* SS;
    __device__ __forceinline__ void operator()(const f32x4 (&acc)[2][2][4][2], const Unit& u, int wr, int wc, int fr, int fq) const {
#pragma unroll
        for (int ai = 0; ai < 2; ++ai)
#pragma unroll
            for (int m = 0; m < 4; ++m) {
                const int crow = u.pm * BM + ai * HALF + wr * 64 + m * 16 + fr;
                const float rstd = rsqrtf(SS[crow] * (1.0f / D) + EPS);
                f32x4 a[2];
#pragma unroll
                for (int n = 0; n < 2; ++n)
#pragma unroll
                    for (int e = 0; e < 4; ++e) { const float g = acc[ai][0][m][n][e] * rstd, up = acc[ai][1][m][n][e] * rstd; a[n][e] = siluf_(g) * up; }
                *(u32x4*)(ACT + (size_t)crow * DFF + u.pn * HALF + wc * 32 + 8 * fq) = pack8f(a[0], a[1]);
            }
    }
};

template <bool DRY = false> struct EpiDown {
    static constexpr bool PERM = true, AFTER_DRAIN = false;
    const bf16_t* HB; bf16_t* H2;
    __device__ __forceinline__ void operator()(const f32x4 (&acc)[2][2][4][2], const Unit& u, int wr, int wc, int fr, int fq) const {
#pragma unroll
        for (int ai = 0; ai < 2; ++ai)
#pragma unroll
            for (int m = 0; m < 4; ++m) {
                const int crow = u.pm * BM + ai * HALF + wr * 64 + m * 16 + fr;
#pragma unroll
                for (int bj = 0; bj < 2; ++bj) {
                    const size_t off = (size_t)crow * D + u.pn * BM + bj * HALF + wc * 32 + 8 * fq;
                    const u32x4 hw = *(const u32x4*)(HB + off);
                    f32x4 r0 = acc[ai][bj][m][0], r1 = acc[ai][bj][m][1];
                    r0[0] += bflo(hw.x); r0[1] += bfhi(hw.x); r0[2] += bflo(hw.y); r0[3] += bfhi(hw.y);
                    r1[0] += bflo(hw.z); r1[1] += bfhi(hw.z); r1[2] += bflo(hw.w); r1[3] += bfhi(hw.w);
                    *(u32x4*)(H2 + off) = pack8f(r0, r1);
                }
            }
    }
};

template <class Inner, bool GATED = false> struct EpiSplit {
    static constexpr bool PERM = Inner::PERM, AFTER_DRAIN = false;
    Inner inner; float* scr; unsigned* cnt; unsigned S; const bf16_t* G; int gate_off;
    __device__ __forceinline__ void operator()(const f32x4 (&acc_)[2][2][4][2], const Unit& u, int wr, int wc, int fr, int fq) const {
        f32x4 (&acc)[2][2][4][2] = const_cast<f32x4 (&)[2][2][4][2]>(acc_);
        const int lane = fr + 16 * fq, wave = wr * 4 + wc;
        float* p = scr + (size_t)wave * 8192 + lane;
#pragma unroll
        for (int ai = 0; ai < 2; ++ai)
#pragma unroll
            for (int m = 0; m < 4; ++m) {
                int urow = 0;
                if (GATED) urow = crow_to_urow(u.pm * BM + ai * HALF + wr * 64 + m * 16 + fr);
#pragma unroll
                for (int bj = 0; bj < 2; ++bj) {
                    f32x4 v0 = acc[ai][bj][m][0], v1 = acc[ai][bj][m][1];
                    if (GATED) { const u32x4 gw = *(const u32x4*)(G + (size_t)urow * 2048 + gate_off + u.pn * BM + bj * HALF + wc * 32 + 8 * fq);
                        v0[0] *= bflo(gw.x); v0[1] *= bfhi(gw.x); v0[2] *= bflo(gw.y); v0[3] *= bfhi(gw.y); v1[0] *= bflo(gw.z); v1[1] *= bfhi(gw.z); v1[2] *= bflo(gw.w); v1[3] *= bfhi(gw.w); }
                    float* q = p + (((ai * 2 + bj) * 4 + m) * 8) * 64;
                    asm volatile("" : "+v"(q));
#pragma unroll
                    for (int x = 0; x < 4; ++x) { unsafeAtomicAdd(q + x * 64, v0[x]); unsafeAtomicAdd(q + (4 + x) * 64, v1[x]); }
                }
            }
        asm volatile("s_waitcnt vmcnt(0)" ::: "memory");
        unsigned old = 0u;
        if (lane == 0) old = __hip_atomic_fetch_add(cnt + wave, 1u, __ATOMIC_RELAXED, __HIP_MEMORY_SCOPE_AGENT);
        old = (unsigned)__builtin_amdgcn_readfirstlane((int)old);
        if (old == S - 1u) {
#pragma unroll
            for (int ai = 0; ai < 2; ++ai)
#pragma unroll
                for (int bj = 0; bj < 2; ++bj)
#pragma unroll
                    for (int m = 0; m < 4; ++m) {
                        float* q = p + (((ai * 2 + bj) * 4 + m) * 8) * 64;
                        asm volatile("" : "+v"(q));
#pragma unroll
                        for (int n = 0; n < 2; ++n)
#pragma unroll
                            for (int x = 0; x < 4; ++x) acc[ai][bj][m][n][x] = __hip_atomic_exchange(q + (n * 4 + x) * 64, 0.0f, __ATOMIC_RELAXED, __HIP_MEMORY_SCOPE_AGENT);
                    }
            if (lane == 0) __hip_atomic_store(cnt + wave, 0u, __ATOMIC_RELAXED, __HIP_MEMORY_SCOPE_AGENT);
            inner(acc, u, wr, wc, fr, fq);
        }
    }
};
struct EpiStoreMB {
    static constexpr bool PERM = true, AFTER_DRAIN = false;
    bf16_t* MBp;
    __device__ __forceinline__ void operator()(const f32x4 (&acc)[2][2][4][2], const Unit& u, int wr, int wc, int fr, int fq) const {
#pragma unroll
        for (int ai = 0; ai < 2; ++ai)
#pragma unroll
            for (int m = 0; m < 4; ++m) {
                const int crow = u.pm * BM + ai * HALF + wr * 64 + m * 16 + fr;
#pragma unroll
                for (int bj = 0; bj < 2; ++bj) *(u32x4*)(MBp + (size_t)crow * 1024 + u.pn * BM + bj * HALF + wc * 32 + 8 * fq) = pack8f(acc[ai][bj][m][0], acc[ai][bj][m][1]);
            }
    }
};

template <class Epi, class Sched, bool ALIGN_EPI = false, bool SP2 = false>
__device__ __forceinline__ void gemm_phase(PG8_LAS unsigned char* lds, const Gemm g, const Sched& S, const Epi& E) {
    const int tid = threadIdx.x, wid = __builtin_amdgcn_readfirstlane(tid >> 6), lane = tid & 63, wr = wid >> 2, wc = wid & 3, fr = lane & 15, fq = lane >> 4;
    const int K = g.ldk ? g.ldk : g.K, nt = g.K / BK;
    unsigned voffA[2], voffB[2];
#pragma unroll
    for (int i = 0; i < 2; ++i) { int R, C; stage_rc(tid * 16 + i * 8192, R, C); const int Rb = Epi::PERM ? ((R & ~31) + perm32(R & 31)) : R;
        voffA[i] = (unsigned)(R * K + C) * 2u; voffB[i] = (unsigned)(Rb * K + C) * 2u; }
    const size_t kstep = (size_t)(BK * 2);
    const size_t hstep = (size_t)HALF * K * 2;
    const size_t tstep = 2 * hstep;
    const unsigned ldsw = (unsigned)wid * 1024u;
    const int aoff = lds_byte(wr * 64 + fr, fq * 8), boff = lds_byte(wc * 32 + fr, fq * 8);
#define PG8_SA(b, h) (((b) * 2 + (h)) * HTB)
#define PG8_SB(b, h) ((4 + (b) * 2 + (h)) * HTB)
#define PG8_STAGE(bufoff, gbase, voff) do { _Pragma("unroll") for (int _i = 0; _i < 2; ++_i) \
        __builtin_amdgcn_global_load_lds((const unsigned*)((const char*)(gbase) + (voff)[_i]), (PG8_LAS unsigned*)(lds + (bufoff) + ldsw + _i * 8192), 16, 0, 0); } while (0)
#define PG8_STAGE_A(bufoff, gbase, voff) do { _Pragma("unroll") for (int _i = 0; _i < 2; ++_i) { \
        if constexpr (Sched::A_SC1) __builtin_amdgcn_global_load_lds((const unsigned*)((const char*)(gbase) + (voff)[_i]), (PG8_LAS unsigned*)(lds + (bufoff) + ldsw + _i * 8192), 16, 0, 16); \
        else __builtin_amdgcn_global_load_lds((const unsigned*)((const char*)(gbase) + (voff)[_i]), (PG8_LAS unsigned*)(lds + (bufoff) + ldsw + _i * 8192), 16, 0, 0); } } while (0)
#define PG8_LDA(dst, b, h) do { _Pragma("unroll") for (int m = 0; m < 4; ++m) _Pragma("unroll") for (int k = 0; k < 2; ++k) dst[m][k] = *(const PG8_LAS bf16x8*)(lds + PG8_SA(b, h) + aoff + m * 2048 + k * 1024); } while (0)
#define PG8_LDB(dst, b, h) do { _Pragma("unroll") for (int n = 0; n < 2; ++n) _Pragma("unroll") for (int k = 0; k < 2; ++k) dst[n][k] = *(const PG8_LAS bf16x8*)(lds + PG8_SB(b, h) + boff + n * 2048 + k * 1024); } while (0)
#define PG8_MMA(ai, bj, At, Bt) do { __builtin_amdgcn_s_setprio(1); _Pragma("unroll") for (int m = 0; m < 4; ++m) _Pragma("unroll") for (int n = 0; n < 2; ++n) _Pragma("unroll") for (int k = 0; k < 2; ++k) \
        acc[ai][bj][m][n] = __builtin_amdgcn_mfma_f32_16x16x32_bf16(Bt[n][k], At[m][k], acc[ai][bj][m][n], 0, 0, 0); __builtin_amdgcn_s_setprio(0); } while (0)
#define PG8_WAIT_V(n) asm volatile("s_waitcnt vmcnt(" #n ")" ::: "memory")
#define PG8_WAIT_L(n) asm volatile("s_waitcnt lgkmcnt(" #n ")" ::: "memory")
#define PG8_BAR __builtin_amdgcn_s_barrier()
#define PG8_SCHED __builtin_amdgcn_sched_barrier(0)
    Unit cur, nxt; int ui = 0;
    if (!S.next(0, cur)) return;
    f32x4 acc[2][2][4][2];
#pragma unroll
    for (int a = 0; a < 2; ++a)
#pragma unroll
        for (int b = 0; b < 2; ++b)
#pragma unroll
            for (int m = 0; m < 4; ++m)
#pragma unroll
                for (int n = 0; n < 2; ++n) acc[a][b][m][n] = (f32x4){0.f, 0.f, 0.f, 0.f};
    bf16x8 At[4][2], B0[2][2], B1[2][2];
    const char* cA = (const char*)g.A + (size_t)cur.pm * tstep; const char* cB = (const char*)g.Bt + (size_t)cur.pn * tstep;
    S.a_ready(cur);
    if constexpr (SP2) {
        PG8_STAGE(PG8_SB(0, 0), cB, voffB); PG8_STAGE(PG8_SB(0, 1), cB + hstep, voffB); PG8_STAGE_A(PG8_SA(0, 0), cA, voffA); PG8_STAGE_A(PG8_SA(0, 1), cA + hstep, voffA);
        if (wr == 1) PG8_BAR;
        PG8_WAIT_V(2); PG8_BAR;
        PG8_STAGE(PG8_SB(1, 0), cB + kstep, voffB); PG8_STAGE_A(PG8_SA(1, 0), cA + kstep, voffA); PG8_STAGE(PG8_SB(1, 1), cB + hstep + kstep, voffB);
        PG8_WAIT_V(6); PG8_BAR;
    } else {
        PG8_STAGE(PG8_SB(0, 0), cB, voffB); PG8_STAGE_A(PG8_SA(0, 0), cA, voffA); PG8_STAGE(PG8_SB(0, 1), cB + hstep, voffB); PG8_STAGE_A(PG8_SA(0, 1), cA + hstep, voffA);
        if (wr == 1) PG8_BAR;
        PG8_WAIT_V(4); PG8_BAR;
        PG8_STAGE(PG8_SB(1, 0), cB + kstep, voffB); PG8_STAGE_A(PG8_SA(1, 0), cA + kstep, voffA); PG8_STAGE(PG8_SB(1, 1), cB + hstep + kstep, voffB);
        PG8_WAIT_V(6); PG8_BAR;
    }
    for (;;) {
        const bool has_next = S.next(ui + 1, nxt);
        const char* nA = has_next ? (const char*)g.A + (size_t)nxt.pm * tstep : cA; const char* nB = has_next ? (const char*)g.Bt + (size_t)nxt.pn * tstep : cB;
        for (int t = 0; t < nt; t += 2) {
            const bool last = (t == nt - 2);
            const char* a1 = cA + (size_t)(t + 1) * kstep;
            const char* a2 = last ? nA : cA + (size_t)(t + 2) * kstep; const char* b2 = last ? nB : cB + (size_t)(t + 2) * kstep;
            const char* a3 = a2 + kstep; const char* b3 = b2 + kstep;
            if (last && has_next) S.a_ready(nxt);
            if constexpr (SP2) {
            PG8_LDB(B0, 0, 0); PG8_LDB(B1, 0, 1); PG8_SCHED; PG8_LDA(At, 0, 0); PG8_STAGE_A(PG8_SA(1, 1), a1 + hstep, voffA);
            PG8_WAIT_V(8); PG8_WAIT_L(0); PG8_BAR; PG8_MMA(0, 0, At, B0); PG8_MMA(0, 1, At, B1); PG8_BAR; PG8_SCHED;
            PG8_LDA(At, 0, 1); PG8_STAGE(PG8_SB(0, 0), b2, voffB); PG8_STAGE(PG8_SB(0, 1), b2 + hstep, voffB); PG8_STAGE_A(PG8_SA(0, 0), a2, voffA);
            PG8_WAIT_V(8); PG8_WAIT_L(0); PG8_BAR; PG8_MMA(1, 0, At, B0); PG8_MMA(1, 1, At, B1); PG8_BAR; PG8_SCHED;
            PG8_LDB(B0, 1, 0); PG8_LDB(B1, 1, 1); PG8_SCHED; PG8_LDA(At, 1, 0); PG8_STAGE_A(PG8_SA(0, 1), a2 + hstep, voffA);
            PG8_WAIT_V(8); PG8_WAIT_L(0); PG8_BAR; PG8_MMA(0, 0, At, B0); PG8_MMA(0, 1, At, B1); PG8_BAR; PG8_SCHED;
            PG8_LDA(At, 1, 1); PG8_STAGE(PG8_SB(1, 0), b3, voffB); PG8_STAGE(PG8_SB(1, 1), b3 + hstep, voffB); PG8_STAGE_A(PG8_SA(1, 0), a3, voffA);
            PG8_WAIT_V(8); PG8_WAIT_L(0); PG8_BAR; PG8_MMA(1, 0, At, B0); PG8_MMA(1, 1, At, B1); PG8_BAR; PG8_SCHED;
            } else {
            PG8_LDB(B0, 0, 0); PG8_SCHED; PG8_LDA(At, 0, 0); PG8_STAGE_A(PG8_SA(1, 1), a1 + hstep, voffA);
            PG8_WAIT_L(8); PG8_BAR; PG8_WAIT_L(0); PG8_MMA(0, 0, At, B0); PG8_BAR; PG8_SCHED;
            PG8_LDB(B1, 0, 1); PG8_STAGE(PG8_SB(0, 0), b2, voffB);
            PG8_BAR; PG8_WAIT_L(0); PG8_MMA(0, 1, At, B1); PG8_BAR;
            PG8_LDA(At, 0, 1); PG8_STAGE_A(PG8_SA(0, 0), a2, voffA);
            PG8_BAR; PG8_WAIT_L(0); PG8_MMA(1, 0, At, B0); PG8_BAR; PG8_SCHED;
            PG8_STAGE(PG8_SB(0, 1), b2 + hstep, voffB);
            PG8_WAIT_V(6); PG8_BAR; PG8_MMA(1, 1, At, B1); PG8_BAR;
            PG8_LDB(B0, 1, 0); PG8_SCHED; PG8_LDA(At, 1, 0); PG8_STAGE_A(PG8_SA(0, 1), a2 + hstep, voffA);
            PG8_WAIT_L(8); PG8_BAR; PG8_WAIT_L(0); PG8_MMA(0, 0, At, B0); PG8_BAR; PG8_SCHED;
            PG8_LDB(B1, 1, 1); PG8_STAGE(PG8_SB(1, 0), b3, voffB);
            PG8_BAR; PG8_WAIT_L(0); PG8_MMA(0, 1, At, B1); PG8_BAR;
            PG8_LDA(At, 1, 1); PG8_STAGE_A(PG8_SA(1, 0), a3, voffA);
            PG8_BAR; PG8_WAIT_L(0); PG8_MMA(1, 0, At, B0); PG8_BAR; PG8_SCHED;
            PG8_STAGE(PG8_SB(1, 1), b3 + hstep, voffB);
            PG8_WAIT_V(6); PG8_BAR; PG8_MMA(1, 1, At, B1); PG8_BAR;
            }
        }
        if constexpr (ALIGN_EPI) { if (wr == 0) PG8_BAR; }
        if constexpr (!Epi::AFTER_DRAIN) { E(acc, cur, wr, wc, fr, fq); S.done(cur); }
        if (!has_next) break;
#pragma unroll
        for (int a = 0; a < 2; ++a)
#pragma unroll
            for (int b = 0; b < 2; ++b)
#pragma unroll
                for (int m = 0; m < 4; ++m)
#pragma unroll
                    for (int n = 0; n < 2; ++n) acc[a][b][m][n] = (f32x4){0.f, 0.f, 0.f, 0.f};
        cur = nxt; cA = nA; cB = nB; ++ui;
        if constexpr (ALIGN_EPI) { if (wr == 1) PG8_BAR; }
    }
    PG8_WAIT_V(0);
    if constexpr (!ALIGN_EPI) { if (wr == 0) PG8_BAR; }
    PG8_BAR;
    if constexpr (Epi::AFTER_DRAIN) { E.fused(acc, cur, wr, wc, fr, fq, lds, wid, lane); S.done(cur); }
#undef PG8_SA
#undef PG8_SB
#undef PG8_STAGE
#undef PG8_STAGE_A
#undef PG8_LDA
#undef PG8_LDB
#undef PG8_MMA
#undef PG8_WAIT_V
#undef PG8_WAIT_L
#undef PG8_BAR
#undef PG8_SCHED
}
}
constexpr int NWAVES = 8, NTHREADS = NWAVES * 64;
constexpr int LDS_BYTES = 147456;
constexpr int LDS_MISC = 131072;
constexpr int N_PHASES = 9;

struct Args {
    const float *x_prompt, *x_sample, *cache_k, *cache_v, *state_delta, *state_conv, *meta, *norm_mix, *w_in, *conv_w, *a_log, *dt_bias, *sinks, *gdn_norm,
                *w_oa, *w_ob, *w_out, *norm_ffn, *w_gate, *w_up, *w_down, *norm_final;
    float* out; unsigned char* ws; int ph_lo, ph_hi;
};

typedef const __attribute__((address_space(4))) Args* KA;
DI KA kargs() { KA p = (KA)__builtin_amdgcn_kernarg_segment_ptr(); asm volatile("" : "+s"(p)); return p; }
#define RLX_AGENT __ATOMIC_RELAXED, __HIP_MEMORY_SCOPE_AGENT
#define LDS_WAIT() asm volatile("s_waitcnt lgkmcnt(0)" ::: "memory")
#define MFMA32(a, b, c) __builtin_amdgcn_mfma_f32_32x32x16_bf16((a), (b), (c), 0, 0, 0)
DI int crow16(int reg, int h) { return (reg & 3) + 8 * (reg >> 2) + 4 * h; }
DI float wave_sum(float v) {
#pragma unroll
    for (int o = 1; o < 64; o <<= 1) v += __shfl_xor(v, o);
    return v;
}
DI float wave_max(float v) {
#pragma unroll
    for (int o = 1; o < 64; o <<= 1) v = fmaxf(v, __shfl_xor(v, o));
    return v;
}
template <int S> DI bf16x8 pack_step(const f32x16& x) {
    u32x4 p; p.x = cvtpk(x[8 * S], x[8 * S + 1]); p.y = cvtpk(x[8 * S + 2], x[8 * S + 3]); p.z = cvtpk(x[8 * S + 4], x[8 * S + 5]); p.w = cvtpk(x[8 * S + 6], x[8 * S + 7]);
    return __builtin_bit_cast(bf16x8, p);
}
DI int frag_idx(int row, int k, int NKS) { const int kkk = k & 15; return (((row >> 5) * NKS + (k >> 4)) * 64 + (row & 31) + 32 * ((kkk >> 2) & 1)) * 8 + (((kkk >> 3) << 2) | (kkk & 3)); }
DI unsigned char* slot_ptr(KA A, int item) { return item < PREP_N1 ? A->ws + WS_B + (size_t)item * PREP_SLOT : (unsigned char*)A->out + (size_t)(item - PREP_N1) * PREP_SLOT; }

#define XB_TMO      128
#define XB_XCNT(j)  (256  + 64 * (j))
#define XB_XSUB(j)  (1280 + 64 * (j))
#define XB_XGEN(j)  (2304 + 64 * (j))
#define XB_TOP      3328
#define XB_TOPGEN   3392
#define XCD_BAR_WORDS 3456
#define XB_SPIN_CAP (1u << 20)
DI unsigned xb_ld(unsigned* p)              { return __hip_atomic_load(p, __ATOMIC_RELAXED, __HIP_MEMORY_SCOPE_AGENT); }
DI unsigned xb_add(unsigned* p, unsigned v) { return __hip_atomic_fetch_add(p, v, __ATOMIC_RELAXED, __HIP_MEMORY_SCOPE_AGENT); }
DI unsigned xb_xcc_id() { return (unsigned)__builtin_amdgcn_s_getreg((3 << 11) | 20) & 0xFu; }
#define XB_SPIN(cond, bar) do { unsigned _sp = 0; while (cond) { __builtin_amdgcn_s_sleep(1); \
    if ((++_sp & 255u) == 0u) { if (xb_ld(&(bar)[XB_TMO])) break; if (_sp > XB_SPIN_CAP) { atomicAdd(&(bar)[XB_TMO], 1u); break; } } } } while (0)
struct XcdBarrier { unsigned* bar; unsigned x; volatile LAS unsigned* st; };
DI XcdBarrier xcd_barrier_post(unsigned* bar, volatile LAS unsigned* st) {
    XcdBarrier b; b.bar = bar; b.x = xb_xcc_id(); b.st = st;
    if (threadIdx.x == 0) (void)xb_add(&bar[XB_XCNT(b.x)], 1u);
    return b;
}
DI void xcd_barrier_complete(unsigned* bar, unsigned x, unsigned& nloc, unsigned& nx) {
    const unsigned G = gridDim.x * gridDim.y * gridDim.z;
    unsigned sum, cnt, mine, sp = 0u;
    for (;;) {
        sum = 0u; cnt = 0u; mine = 0u;
#pragma unroll
        for (unsigned j = 0; j < 16; ++j) { const unsigned c = xb_ld(&bar[XB_XCNT(j)]); sum += c; cnt += (c > 0u) ? 1u : 0u; mine = (j == x) ? c : mine; }
        if (sum == G) break;
        __builtin_amdgcn_s_sleep(1);
        if ((++sp & 255u) == 0u) { if (xb_ld(&bar[XB_TMO])) break; if (sp > XB_SPIN_CAP) { atomicAdd(&bar[XB_TMO], 1u); break; } }
    }
    nloc = mine > 0u ? mine : 1u; nx = cnt > 0u ? cnt : 1u;
}
DI void xcd_barrier(const XcdBarrier& b) {
    asm volatile("s_waitcnt vmcnt(0)" ::: "memory");
    __syncthreads();
    if (threadIdx.x == 0) {
        unsigned* bar = b.bar;
        __builtin_amdgcn_s_waitcnt(0);
        unsigned nloc = b.st[0], nx = b.st[1];
        if (nloc == 0u) { xcd_barrier_complete(bar, b.x, nloc, nx); b.st[0] = nloc; b.st[1] = nx; }
        const unsigned old = xb_add(&bar[XB_XSUB(b.x)], 1u);
        const unsigned gen = old / nloc;
        if (old + 1u == (gen + 1u) * nloc) {
            __builtin_amdgcn_fence(__ATOMIC_RELEASE, "agent");
            asm volatile("s_waitcnt vmcnt(0)" ::: "memory");
            const unsigned og = xb_add(&bar[XB_TOP], 1u);
            const unsigned tg = og / nx;
            if (og + 1u == (tg + 1u) * nx) xb_add(&bar[XB_TOPGEN], 1u);
            else XB_SPIN(xb_ld(&bar[XB_TOPGEN]) == tg, bar);
            __builtin_amdgcn_fence(__ATOMIC_ACQUIRE, "agent");
            xb_add(&bar[XB_XGEN(b.x)], 1u);
            asm volatile("s_waitcnt vmcnt(0)" ::: "memory");
        } else {
            XB_SPIN(xb_ld(&bar[XB_XGEN(b.x)]) == gen, bar);
            __builtin_amdgcn_fence(__ATOMIC_ACQUIRE, "agent");
            asm volatile("s_waitcnt vmcnt(0)" ::: "memory");
        }
    }
    __syncthreads();
}

template <class RowMap> DI void transpose_item(const float* W, int K, int N, bf16* WT, RowMap rm, const float* kscale, LAS float* scr, int item, int lane, int ldw = 0) {
    if (ldw == 0) ldw = K;
    const int nblk = (N + 31) / 32, kb = item / nblk, nb = item - kb * nblk, k0 = 64 * kb, n0 = 32 * nb;
    const int n4 = n0 + (lane & 7) * 4;
    f32x4 v[8];
#pragma unroll
    for (int i = 0; i < 8; ++i) { const int kk = 8 * i + (lane >> 3);
        v[i] = n4 < N ? *(const f32x4*)(W + (size_t)(k0 + kk) * N + n4) : (f32x4){0.f, 0.f, 0.f, 0.f}; }
#pragma unroll
    for (int i = 0; i < 8; ++i) { const int kk = 8 * i + (lane >> 3);
        if (kscale) v[i] = v[i] * kscale[k0 + kk];
        LAS float* d = scr + kk * 33 + (lane & 7) * 4; d[0] = v[i][0]; d[1] = v[i][1]; d[2] = v[i][2]; d[3] = v[i][3]; }
    LDS_WAIT(); asm volatile("" ::: "memory");
    const int c = lane & 7;
#pragma unroll
    for (int j = 0; j < 4; ++j) { const int n = (lane >> 3) + 8 * j; const LAS float* s = scr + (8 * c) * 33 + n;
        const int nsrc = n0 + n; const int drow = nsrc < N ? rm(nsrc) : -1;
        u32x4 o; o.x = cvtpk(s[0 * 33], s[1 * 33]); o.y = cvtpk(s[2 * 33], s[3 * 33]); o.z = cvtpk(s[4 * 33], s[5 * 33]); o.w = cvtpk(s[6 * 33], s[7 * 33]);
        if (drow >= 0) *(u32x4*)(WT + (size_t)drow * ldw + k0 + 8 * c) = o; }
    LDS_WAIT(); asm volatile("" ::: "memory");
}
DI float softplusf_(float x) { return x > 20.f ? x : log1pf(__expf(x)); }

#ifndef PROBE_REP
#define PROBE_REP -1
#endif
#ifndef P0_ROW_WAVES
#define P0_ROW_WAVES 4
#endif
DI void p0_prologue(KA A, LAS unsigned char* lds) {
    const int tid = threadIdx.x, lane = tid & 63, wave = __builtin_amdgcn_readfirstlane(tid >> 6);
    const int G = gridDim.x;
    constexpr int NR = P0_ROW_WAVES, NT = NWAVES - NR;
    const bool rowrole = wave < NR;
    const int gw = rowrole ? blockIdx.x * NR + wave : blockIdx.x * NT + (wave - NR), NGW = G * (rowrole ? NR : NT);
    const int gt = blockIdx.x * (NT * 64) + (tid - NR * 64), NGT = G * NT * 64;
    unsigned char* ws = A->ws;
    if (!rowrole) for (int rep = 0; rep < (PROBE_REP == 1001 ? 2 : 1); ++rep) {
        LAS float* scr = (LAS float*)(lds + wave * 16384);
        constexpr int I_IN = 16 * 153, I_OA = 8 * 32, I_OUT = 16 * 32, I_G = 16 * 88, I_D = 44 * 32;
        constexpr int NIT = I_IN + 2 * I_OA + I_OUT + 2 * I_G + I_D;
        for (int it = gw; it < NIT; it += NGW) {
            int r = it;
            if (r < I_IN) { transpose_item(A->w_in, 1024, NIN_SRC, (bf16*)(ws + WS_WIN), [](int c) -> int {
                    if (c < 640) return (c & ~63) + pos_of_d(c & 63);
                    if (c < 2816) return c;
                    if (c < 2824) return -1;
                    return c - 8; }, nullptr, scr, r, lane); continue; } r -= I_IN;
            if (r < I_OA) { transpose_item(A->w_oa, 512, 1024, (bf16*)(ws + WS_WOA), [](int c) -> int { return c; }, nullptr, scr, r, lane, 1024); continue; } r -= I_OA;
            if (r < I_OA) { transpose_item(A->w_ob, 512, 1024, (bf16*)(ws + WS_WOA) + 512, [](int c) -> int { return c; }, nullptr, scr, r, lane, 1024); continue; } r -= I_OA;
            if (r < I_OUT) { transpose_item(A->w_out, 1024, 1024, (bf16*)(ws + WS_WOUT), [](int c) -> int { return c; }, nullptr, scr, r, lane); continue; } r -= I_OUT;
            if (r < I_G) { transpose_item(A->w_gate, 1024, DFF, (bf16*)(ws + WS_WGU), [](int c) -> int { return 256 * (c >> 7) + (c & 127); }, A->norm_ffn, scr, r, lane); continue; } r -= I_G;
            if (r < I_G) { transpose_item(A->w_up, 1024, DFF, (bf16*)(ws + WS_WGU), [](int c) -> int { return 256 * (c >> 7) + 128 + (c & 127); }, A->norm_ffn, scr, r, lane); continue; } r -= I_G;
            transpose_item(A->w_down, DFF, 1024, (bf16*)(ws + WS_WD), [](int c) -> int { return c; }, nullptr, scr, r, lane);
        }
    }
    if (!rowrole) for (int rep = 0; rep < (PROBE_REP == 1002 ? 2 : 1); ++rep) {
        float* COS = (float*)(ws + WS_ROPE); float* SIN = COS + (TP + TS) * 32;
        for (int i = gt; i < (TP + TS) * 32; i += NGT) { const int ri = i >> 5, f = i & 31; const double pos = ri < TP ? (double)ri : (double)(PAST + ri - TP);
            const double inv = exp2(-(double)f * (13.287712379549449 / 32.0)), ang = pos * inv; COS[i] = (float)cos(ang); SIN[i] = (float)sin(ang); }
        constexpr int PERB = 124 * 128 / 4;
        for (int i = gt; i < SBATCH * PERB; i += NGT) { const int b = i / PERB, o = i - b * PERB;
            ((f32x4*)(A->out + O_KS))[(size_t)b * 4096 + o] = ((const f32x4*)A->cache_k)[(size_t)b * 4096 + 128 + o];
            ((f32x4*)(A->out + O_VS))[(size_t)b * 4096 + o] = ((const f32x4*)A->cache_v)[(size_t)b * 4096 + 128 + o]; }
    }
    if (rowrole) for (int rep = 0; rep < (PROBE_REP == 1003 ? 2 : 1); ++rep) {
        unsigned wab[16][4];
        f32x4 nm[4];
#pragma unroll
        for (int j = 0; j < 4; ++j) {
            nm[j] = ((const f32x4*)A->norm_mix)[lane + 64 * j];
#pragma unroll
            for (int e = 0; e < 4; ++e) { const float* p = A->w_in + (size_t)(4 * (lane + 64 * j) + e) * NIN_SRC + 2816;
                const f32x4 a = *(const f32x4*)p, b = *(const f32x4*)(p + 4);
                wab[j * 4 + e][0] = cvtpk(a[0], a[1]); wab[j * 4 + e][1] = cvtpk(a[2], a[3]); wab[j * 4 + e][2] = cvtpk(b[0], b[1]); wab[j * 4 + e][3] = cvtpk(b[2], b[3]); }
        }
        bf16* XN = (bf16*)(ws + WS_XN); f32x2* GB = (f32x2*)(ws + WS_GB);
        auto row_src = [&](int urow) -> const float* {
            if (urow < MP) { const int b = urow / TP, t = urow - b * TP; return t < NMETA ? A->meta + (size_t)t * D : A->x_prompt + ((size_t)b * SEQ + (t - NMETA)) * D; }
            if (urow < MU) return A->x_sample + (size_t)(urow - MP) * D;
            return nullptr; };
        f32x4 nx[4], nx2[4];
        { const float* s0 = gw < MUP ? row_src(gw) : nullptr; const float* s1 = gw + NGW < MUP ? row_src(gw + NGW) : nullptr;
#pragma unroll
          for (int j = 0; j < 4; ++j) { nx[j] = s0 ? ((const f32x4*)s0)[lane + 64 * j] : (f32x4){0.f, 0.f, 0.f, 0.f}; nx2[j] = s1 ? ((const f32x4*)s1)[lane + 64 * j] : (f32x4){0.f, 0.f, 0.f, 0.f}; } }
#pragma unroll 1
        for (int urow = gw; urow < MUP; urow += NGW) {
            f32x4 v[4];
#pragma unroll
            for (int j = 0; j < 4; ++j) { v[j] = nx[j]; nx[j] = nx2[j]; }
            { const int un = urow + 2 * NGW; const float* s2 = un < MUP ? row_src(un) : nullptr;
#pragma unroll
              for (int j = 0; j < 4; ++j) nx2[j] = s2 ? ((const f32x4*)s2)[lane + 64 * j] : (f32x4){0.f, 0.f, 0.f, 0.f}; }
            u32x2* o8 = (u32x2*)(XN + (size_t)urow * D) + lane;
            float ss = 0.f;
#pragma unroll
            for (int j = 0; j < 4; ++j) ss += (v[j][0] * v[j][0] + v[j][1] * v[j][1]) + (v[j][2] * v[j][2] + v[j][3] * v[j][3]);
            const float rstd = urow < MU ? rsqrtf(wave_sum(ss) * (1.0f / D) + EPS) : 0.f;
            float dot[8];
#pragma unroll
            for (int c = 0; c < 8; ++c) dot[c] = 0.f;
#pragma unroll
            for (int j = 0; j < 4; ++j) { v[j] = v[j] * rstd * nm[j];
                o8[64 * j] = (u32x2){cvtpk(v[j][0], v[j][1]), cvtpk(v[j][2], v[j][3])};
#pragma unroll
                for (int e = 0; e < 4; ++e)
#pragma unroll
                    for (int c = 0; c < 4; ++c) { dot[2 * c] += v[j][e] * bflo(wab[j * 4 + e][c]); dot[2 * c + 1] += v[j][e] * bfhi(wab[j * 4 + e][c]); } }
            float d4[4], d2[2], d1;
#pragma unroll
            for (int c = 0; c < 4; ++c) { const float keep = (lane & 32) ? dot[4 + c] : dot[c], send = (lane & 32) ? dot[c] : dot[4 + c]; d4[c] = keep + __shfl_xor(send, 32); }
#pragma unroll
            for (int c = 0; c < 2; ++c) { const float keep = (lane & 16) ? d4[2 + c] : d4[c], send = (lane & 16) ? d4[c] : d4[2 + c]; d2[c] = keep + __shfl_xor(send, 16); }
            { const float keep = (lane & 8) ? d2[1] : d2[0], send = (lane & 8) ? d2[0] : d2[1]; d1 = keep + __shfl_xor(send, 8); }
            d1 += __shfl_xor(d1, 4); d1 += __shfl_xor(d1, 2); d1 += __shfl_xor(d1, 1);
            const float a_ = __shfl(d1, ((lane & 2) ? 16 : 0) + ((lane & 1) ? 8 : 0));
            const float b_ = __shfl(d1, 32 + ((lane & 2) ? 16 : 0) + ((lane & 1) ? 8 : 0));
            if (lane < 4) {
                const float g = -__expf(A->a_log[lane]) * softplusf_(a_ + A->dt_bias[lane]);
                GB[(size_t)urow * 4 + lane] = urow < MU ? (f32x2){g, sigmoidf_(b_)} : (f32x2){0.f, 0.f};
            }
        }
    }
}
DI void item_decode(int item, int& b, int& h, bool& sample, int& t0, int& L) {
    if (item < N_ITEMS_P) { const int s = item / CHUNKS_P, c = item - s * CHUNKS_P; b = s >> 2; h = s & 3; sample = false; if (c == 0) { t0 = 0; L = NMETA; } else { t0 = NMETA + 64 * (c - 1); L = 64; } }
    else { const int s = item - N_ITEMS_P; b = s >> 2; h = s & 3; sample = true; t0 = 0; L = TS; }
}
#define LDS_BARRIER() do { asm volatile("s_waitcnt lgkmcnt(0)" ::: "memory"); __builtin_amdgcn_s_barrier(); asm volatile("" ::: "memory"); } while (0)
typedef GAS unsigned long long gu64;
typedef GAS unsigned gu32;
constexpr size_t CTL_QUEUE = 40960;
constexpr size_t CTL_F1 = 655360;
static_assert(CTL_F1 + 2592 * 64 <= 1048576, "control region map");
DI gu64* item_flag1(KA A, int item) { return (gu64*)(A->ws + WS_CTL + CTL_F1 + (size_t)item * 64); }
DI int order_item(int m) { return m < N_ITEMS_P ? (m & 31) * CHUNKS_P + (m >> 5) : m; }
DI gu64* item_granule(KA A, int item) { return (gu64*)(A->ws + WS_CTL + CTL_GRAN + (size_t)item * 64); }
DI float wait_item(gu64* g, unsigned ep = 1u) {
    unsigned long long x; unsigned spins = 0;
    for (;;) { x = __hip_atomic_load(g, __ATOMIC_RELAXED, __HIP_MEMORY_SCOPE_AGENT); if ((unsigned)(x >> 32) >= ep) break; __builtin_amdgcn_s_sleep(8); if (++spins > (1u << 20)) break; }
    asm volatile("" ::: "memory");
    return __uint_as_float((unsigned)__builtin_amdgcn_readfirstlane((int)(unsigned)x));
}
constexpr int LDS_GCL = 139264;
constexpr int PITCH = 132;
DI bf16x8 frag_nat(const LAS float* src, int row, int k0) {
    const f32x4 lo = *(const LAS f32x4*)(src + row * PITCH + k0), hi = *(const LAS f32x4*)(src + row * PITCH + k0 + 4);
    return __builtin_bit_cast(bf16x8, pack8f(lo, hi));
}
struct S1Pre { u32x4 xr[11]; f32x4 w[4][2]; f32x2 gb; };
DI void stage1_issue(KA A, int item, S1Pre& P) {
    const int tid = threadIdx.x, lane = tid & 63, wave = __builtin_amdgcn_readfirstlane(tid >> 6);
    int b, h, t0, L; bool sample; item_decode(item, b, h, sample, t0, L);
    const bf16* QKVB = (const bf16*)(A->ws + WS_QKVB);
    const int cv = lane < 48 ? lane : 47, grp = cv >> 4, col0 = (cv & 15) * 8, r0 = wave * 8, cidx = grp * 512 + h * 128 + col0;
#pragma unroll
    for (int q = 0; q < 11; ++q) {
        const int i = r0 - 3 + q;
        long urow = sample ? (long)MP + b * TS + i : (long)b * TP + t0 + i;
        const bool ok = sample ? i >= 0 : t0 + i >= 0;
        if (!ok) urow = 0;
        P.xr[q] = *(const u32x4*)(QKVB + (size_t)urow * CONVD + cidx);
        if (!ok) P.xr[q] = (u32x4){0u, 0u, 0u, 0u};
    }
#pragma unroll
    for (int i = 0; i < 4; ++i) { P.w[i][0] = *(const f32x4*)(A->conv_w + i * CONVD + cidx); P.w[i][1] = *(const f32x4*)(A->conv_w + i * CONVD + cidx + 4); }
    P.gb = (f32x2){0.f, 0.f};
    if (wave == 7 && lane < L) { const int urow = sample ? MP + b * TS + lane : b * TP + t0 + lane; P.gb = ((const f32x2*)(A->ws + WS_GB))[(size_t)urow * 4 + h]; }
}
DI void prep_stage1(KA A, int item, int next_item, int prev_item, int wait_item_idx, int bslot, float* ats, S1Pre& P, LAS unsigned char* ldsb, unsigned ep, int pmode = 0) {
    const int tid = threadIdx.x, lane = tid & 63, wave = __builtin_amdgcn_readfirstlane(tid >> 6), r = lane & 31, hh = lane >> 5;
#define ST16(p, ...) __builtin_amdgcn_raw_buffer_store_b128(__builtin_bit_cast(v4u_t, (__VA_ARGS__)), rs_slot, (int)((const unsigned char*)(p) - (const unsigned char*)slot), 0, 16)
#define ST16F(p, ...) __builtin_amdgcn_raw_buffer_store_b128(__builtin_bit_cast(v4u_t, (__VA_ARGS__)), rs_ats, (int)((const unsigned char*)(p) - (const unsigned char*)ats), 0, 16)
    int b, h, t0, L; bool sample; item_decode(item, b, h, sample, t0, L);
    LAS float* Qs = (LAS float*)ldsb; LAS float* Ks = Qs + 64 * PITCH; LAS float* Vs = Ks + 64 * PITCH; LAS float* gcs = Vs + 64 * PITCH; LAS float* betas = gcs + 64;
    unsigned char* slot = slot_ptr(A, item);
    typedef unsigned v4u_t __attribute__((__vector_size__(16)));
    const __amdgpu_buffer_rsrc_t rs_slot = __builtin_amdgcn_make_buffer_rsrc((void*)slot, 0, (int)PREP_SLOT, 0x00020000);
    const __amdgpu_buffer_rsrc_t rs_ats = __builtin_amdgcn_make_buffer_rsrc((void*)ats, 0, (int)ATS_ITEM, 0x00020000);
    if (!(pmode & 8)) {
        const int cv = lane < 48 ? lane : 47, grp = cv >> 4, col0 = (cv & 15) * 8, r0 = wave * 8, cidx = grp * 512 + h * 128 + col0;
        float x[11][8];
#pragma unroll
        for (int q = 0; q < 11; ++q) { x[q][0] = bflo(P.xr[q].x); x[q][1] = bfhi(P.xr[q].x); x[q][2] = bflo(P.xr[q].y); x[q][3] = bfhi(P.xr[q].y);
                                       x[q][4] = bflo(P.xr[q].z); x[q][5] = bfhi(P.xr[q].z); x[q][6] = bflo(P.xr[q].w); x[q][7] = bfhi(P.xr[q].w); }
        if (sample && wave == 0) {
#pragma unroll
            for (int q = 0; q < 3; ++q) { const float* sp = A->state_conv + ((size_t)b * 3 + q) * CONVD + cidx; const f32x4 s0 = *(const f32x4*)sp, s1 = *(const f32x4*)(sp + 4);
                x[q][0] = s0[0]; x[q][1] = s0[1]; x[q][2] = s0[2]; x[q][3] = s0[3]; x[q][4] = s1[0]; x[q][5] = s1[1]; x[q][6] = s1[2]; x[q][7] = s1[3]; }
        }
        float w[4][8];
#pragma unroll
        for (int i = 0; i < 4; ++i) { w[i][0] = P.w[i][0][0]; w[i][1] = P.w[i][0][1]; w[i][2] = P.w[i][0][2]; w[i][3] = P.w[i][0][3]; w[i][4] = P.w[i][1][0]; w[i][5] = P.w[i][1][1]; w[i][6] = P.w[i][1][2]; w[i][7] = P.w[i][1][3]; }
        LAS float* dst = Qs + grp * 64 * PITCH + col0;
        const float nsc = grp == 0 ? 0.08838834764831845f : 1.0f;
#pragma unroll
        for (int q = 3; q < 11; ++q) {
            const int rr = r0 + q - 3;
            float v[8]; float ss = 0.f;
#pragma unroll
            for (int e = 0; e < 8; ++e) {
                const float y = __builtin_fmaf(w[3][e], x[q][e], __builtin_fmaf(w[2][e], x[q - 1][e], __builtin_fmaf(w[1][e], x[q - 2][e], w[0][e] * x[q - 3][e])));
                const float sv = siluf_(y); v[e] = sv; ss = __builtin_fmaf(sv, sv, ss); }
            ss += __builtin_bit_cast(float, __builtin_amdgcn_update_dpp(0, __builtin_bit_cast(int, ss), 0xB1, 0xF, 0xF, true));
            ss += __builtin_bit_cast(float, __builtin_amdgcn_update_dpp(0, __builtin_bit_cast(int, ss), 0x4E, 0xF, 0xF, true));
            ss += __builtin_bit_cast(float, __builtin_amdgcn_update_dpp(0, __builtin_bit_cast(int, ss), 0x141, 0xF, 0xF, true));
            ss += __builtin_bit_cast(float, __builtin_amdgcn_update_dpp(0, __builtin_bit_cast(int, ss), 0x140, 0xF, 0xF, true));
            float sc = grp == 2 ? 1.0f : rsqrtf(ss + EPS) * nsc;
            sc = rr < L ? sc : 0.f;
            if (lane < 48) { *(LAS f32x4*)(dst + rr * PITCH) = (f32x4){v[0] * sc, v[1] * sc, v[2] * sc, v[3] * sc}; *(LAS f32x4*)(dst + rr * PITCH + 4) = (f32x4){v[4] * sc, v[5] * sc, v[6] * sc, v[7] * sc}; }
        }
    }
    if (wave == 7) {
        float gc = P.gb[0];
#pragma unroll
        for (int o = 1; o < 64; o <<= 1) { const float t = __shfl_up(gc, o); if (lane >= o) gc += t; }
        gcs[lane] = gc; betas[lane] = P.gb[1];
        if (lane == 63) ((LAS float*)(ldsb + LDS_GCL))[bslot] = __expf(gc);
    }
    asm volatile("s_waitcnt vmcnt(0)" ::: "memory");
    if (next_item < N_ITEMS) stage1_issue(A, next_item, P);
    if (wait_item_idx >= 0 && wave == 0) (void)wait_item(item_granule(A, wait_item_idx), ep);
    LDS_BARRIER();
    if (prev_item >= 0 && tid == 0) __hip_atomic_store(item_flag1(A, prev_item), ((unsigned long long)ep << 32) | (unsigned long long)__float_as_uint(((const LAS float*)(ldsb + LDS_GCL))[bslot ^ 1]), __ATOMIC_RELAXED, __HIP_MEMORY_SCOPE_AGENT);
    if (wave < 6 && !(pmode & 4)) {
        const bool isqk = wave >= 3; const int tsel = isqk ? wave - 3 : wave, ib = tsel == 0 ? 0 : 1, jb = tsel == 2 ? 1 : 0;
        const LAS float* Asrc = isqk ? Qs : Ks;
        f32x16 acc;
#pragma unroll
        for (int e = 0; e < 16; ++e) acc[e] = 0.f;
#pragma unroll
        for (int s = 0; s < 8; ++s) acc = MFMA32(frag_nat(Asrc, 32 * ib + r, 16 * s + 8 * hh), frag_nat(Ks, 32 * jb + r, 16 * s + 8 * hh), acc);
        const int j = 32 * jb + r; const float gcj = gcs[j];
        float* Aout = ats + (ib + jb) * 1024; bf16* QKD = (bf16*)(slot + SL_QKD);
        if (!isqk) {
#pragma unroll
            for (int g4 = 0; g4 < 4; ++g4) { f32x4 v;
#pragma unroll
                for (int e = 0; e < 4; ++e) { const int i = 32 * ib + 8 * g4 + 4 * hh + e; v[e] = i > j ? betas[i] * __expf(fminf(gcs[i] - gcj, 0.f)) * acc[4 * g4 + e] : 0.f; }
                ST16F(Aout + r * 32 + 8 * g4 + 4 * hh, v); }
        } else {
            LAS float* patch = (LAS float*)(ldsb + 106496) + (wave - 3) * (32 * 36);
#pragma unroll
            for (int reg = 0; reg < 16; ++reg) { const int il = crow16(reg, hh), i = 32 * ib + il; const float dec = __expf(fminf(gcs[i] - gcj, 0.f));
                patch[il * 36 + r] = i >= j ? dec * acc[reg] : 0.f; }
            LDS_WAIT(); asm volatile("" ::: "memory");
#pragma unroll
            for (int ks2 = 0; ks2 < 2; ++ks2) { const int k0 = 16 * ks2 + 4 * hh;
                const f32x4 lo = *(const LAS f32x4*)(patch + r * 36 + k0), hi = *(const LAS f32x4*)(patch + r * 36 + k0 + 8);
                ST16((unsigned char*)QKD + ((ib * 4 + 2 * jb + ks2) * 64 + lane) * 16, pack8f(lo, hi)); }
        }
    }
    const float gcl = gcs[63];
#pragma unroll 1
    for (int job = (pmode & 4) ? 56 : wave; job < 56; job += 8) {
        if (job < 32) {
            const bool isq = job >= 16; const int jj = job & 15, rb = jj >> 3, ks = jj & 7, row = 32 * rb + r, k0 = 16 * ks + 4 * hh;
            const LAS float* src = isq ? Qs : Ks; const float sc = isq ? __expf(gcs[row]) : betas[row] * __expf(gcs[row]);
            const f32x4 lo = *(const LAS f32x4*)(src + row * PITCH + k0) * sc, hi = *(const LAS f32x4*)(src + row * PITCH + k0 + 8) * sc;
            ST16(slot + (isq ? SL_QE : SL_BEK) + ((rb * 8 + ks) * 64 + lane) * 16, pack8f(lo, hi));
        } else if (job < 48) {
            const int jj = job - 32, rb = jj >> 2, ks = jj & 3, dk = 32 * rb + r;
            f32x4 lo, hi;
#pragma unroll
            for (int e = 0; e < 4; ++e) { const int j0 = 16 * ks + 4 * hh + e, j1 = j0 + 8;
                lo[e] = Ks[j0 * PITCH + dk] * __expf(gcl - gcs[j0]); hi[e] = Ks[j1 * PITCH + dk] * __expf(gcl - gcs[j1]); }
            ST16(slot + SL_KWT + ((rb * 4 + ks) * 64 + lane) * 16, pack8f(lo, hi));
        } else {
            const int q = job - 48, w = q >> 1, ib = q & 1, dv = 32 * w + r;
            float v[16];
#pragma unroll
            for (int reg = 0; reg < 16; ++reg) { const int i = 32 * ib + crow16(reg, hh); v[reg] = betas[i] * Vs[i * PITCH + dv]; }
            u32x4* dst = (u32x4*)(slot + SL_BV + ((w * 2 + ib) * 64 + lane) * 32);
            ST16(dst, (u32x4){cvtpk(v[0], v[1]), cvtpk(v[2], v[3]), cvtpk(v[4], v[5]), cvtpk(v[6], v[7])});
            ST16(dst + 1, (u32x4){cvtpk(v[8], v[9]), cvtpk(v[10], v[11]), cvtpk(v[12], v[13]), cvtpk(v[14], v[15])});
        }
    }
    LDS_BARRIER();
}
DI void prep_stage2(KA A, int item, float gcl, const float* ats, LAS float* M, unsigned ep) {
    int lane = threadIdx.x & 63; asm volatile("" : "+v"(lane));
    const int r = lane & 31, hh = lane >> 5, base = 32 * hh;
    unsigned char* slot = slot_ptr(A, item);
    const f32x4* Ain = (const f32x4*)ats;
#pragma unroll
    for (int tt = 0; tt < 3; ++tt) { const int jb = tt >> 1, ib = (tt + 1) >> 1;
#pragma unroll
        for (int q = 0; q < 4; ++q) { const int idx = q * 64 + lane, jj = idx >> 3, i4 = idx & 7;
            *(LAS f32x4*)(M + (32 * jb + jj) * 64 + 32 * ib + 4 * i4) = Ain[tt * 256 + idx]; } }
    LDS_WAIT(); asm volatile("" ::: "memory");
#pragma unroll 1
    for (int rb = 0; rb < 2; ++rb) {
        float acc[16];
#pragma unroll
        for (int i = 0; i < 16; ++i) acc[i] = r == 16 * rb + i ? 1.f : 0.f;
        if (rb == 1) {
#pragma unroll 4
            for (int j = 0; j < 16; ++j) {
                float tj = M[(base + j) * 64 + base + r]; tj = r <= j ? tj : 0.f;
                const LAS f32x4* ar = (const LAS f32x4*)(M + (base + j) * 64 + base + 16);
                const f32x4 a0 = ar[0], a1 = ar[1], a2 = ar[2], a3 = ar[3];
#pragma unroll
                for (int e = 0; e < 4; ++e) { acc[e] -= a0[e] * tj; acc[4 + e] -= a1[e] * tj; acc[8 + e] -= a2[e] * tj; acc[12 + e] -= a3[e] * tj; }
            }
        }
#pragma unroll
        for (int j = 0; j < 16; ++j) {
            const float tj = acc[j]; const int row = base + 16 * rb + j;
            const LAS f32x4* ar = (const LAS f32x4*)(M + row * 64 + base + 16 * rb);
            float a[16];
#pragma unroll
            for (int q = j >> 2; q < 4; ++q) { const f32x4 v = ar[q]; a[4 * q] = v[0]; a[4 * q + 1] = v[1]; a[4 * q + 2] = v[2]; a[4 * q + 3] = v[3]; }
            if (r <= 16 * rb + j) M[row * 64 + base + r] = tj;
#pragma unroll
            for (int i = j + 1; i < 16; ++i) acc[i] -= a[i] * tj;
        }
        asm volatile("" ::: "memory");
    }
    LDS_WAIT(); asm volatile("" ::: "memory");
    f32x16 X;
#pragma unroll
    for (int e = 0; e < 16; ++e) X[e] = 0.f;
#pragma unroll
    for (int s2 = 0; s2 < 16; ++s2) { const int k = 2 * s2 + hh; const float a = M[k * 64 + 32 + r]; float bb = M[k * 64 + r]; bb = r <= k ? bb : 0.f;
        X = __builtin_amdgcn_mfma_f32_32x32x2f32(a, bb, X, 0, 0, 0); }
#pragma unroll
    for (int reg = 0; reg < 16; ++reg) M[crow16(reg, hh) * 64 + 32 + r] = X[reg];
    LDS_WAIT(); asm volatile("" ::: "memory");
    f32x16 Y;
#pragma unroll
    for (int e = 0; e < 16; ++e) Y[e] = 0.f;
#pragma unroll
    for (int s2 = 0; s2 < 16; ++s2) { const int k = 2 * s2 + hh; float a = M[(32 + r) * 64 + 32 + k]; a = k <= r ? a : 0.f; const float bb = M[k * 64 + 32 + r];
        Y = __builtin_amdgcn_mfma_f32_32x32x2f32(a, bb, Y, 0, 0, 0); }
#pragma unroll
    for (int reg = 0; reg < 16; ++reg) M[(32 + crow16(reg, hh)) * 64 + r] = -Y[reg];
    LDS_WAIT(); asm volatile("" ::: "memory");
#pragma unroll
    for (int f = 0; f < 8; ++f) { const int rb = f >> 2, ks = f & 3, row = 32 * rb + r, k0 = 16 * ks + 4 * hh;
        f32x4 lo = *(const LAS f32x4*)(M + row * 64 + k0), hi = *(const LAS f32x4*)(M + row * 64 + k0 + 8);
#pragma unroll
        for (int e = 0; e < 4; ++e) { lo[e] = k0 + e <= row ? lo[e] : 0.f; hi[e] = k0 + 8 + e <= row ? hi[e] : 0.f; }
        st16_sc1(slot + SL_T + ((rb * 4 + ks) * 64 + lane) * 16, pack8f(lo, hi)); }
    LDS_WAIT();
    asm volatile("s_waitcnt vmcnt(0)" ::: "memory");
    if (lane == 0) __hip_atomic_store(item_granule(A, item), ((unsigned long long)ep << 32) | (unsigned long long)__float_as_uint(gcl), __ATOMIC_RELAXED, __HIP_MEMORY_SCOPE_AGENT);
}
DI void scan_seq(KA A, int seq, int w, int lane, unsigned ep) {
    const int r = lane & 31, hh = lane >> 5, dv = 32 * w + r;
    const bool sample = seq >= N_PROMPT_SEQ; const int sidx = sample ? seq - N_PROMPT_SEQ : seq, b = sidx >> 2, h = sidx & 3, nch = sample ? 1 : CHUNKS_P;
    f32x16 S[4];
    if (sample) {
        const float* S0 = A->state_delta + ((size_t)(b * 4 + h) * 128) * 128 + dv;
#pragma unroll
        for (int kb = 0; kb < 4; ++kb)
#pragma unroll
            for (int reg = 0; reg < 16; ++reg) S[kb][reg] = S0[(size_t)(32 * kb + crow16(reg, hh)) * 128];
    } else {
#pragma unroll
        for (int kb = 0; kb < 4; ++kb)
#pragma unroll
            for (int reg = 0; reg < 16; ++reg) S[kb][reg] = 0.f;
    }
    bf16* OBR = (bf16*)((unsigned char*)A->out + DO_OB);
#pragma unroll 1
    for (int c = 0; c < nch; ++c) {
        const int item = sample ? N_ITEMS_P + sidx : seq * CHUNKS_P + c;
        const unsigned char* slot = slot_ptr(A, item);
        const float gcl = wait_item(item_granule(A, item), ep);
        __builtin_amdgcn_fence(__ATOMIC_ACQUIRE, "agent");
        const bf16x8* bek = (const bf16x8*)(slot + SL_BEK) + lane; const bf16x8* tp = (const bf16x8*)(slot + SL_T) + lane;
        const bf16x8* qe = (const bf16x8*)(slot + SL_QE) + lane; const bf16x8* qkd = (const bf16x8*)(slot + SL_QKD) + lane; const bf16x8* kwt = (const bf16x8*)(slot + SL_KWT) + lane;
        bf16x8 sf[8];
#pragma unroll
        for (int kb = 0; kb < 4; ++kb) { sf[2 * kb] = pack_step<0>(S[kb]); sf[2 * kb + 1] = pack_step<1>(S[kb]); }
        f32x16 x0, x1;
#pragma unroll
        for (int e = 0; e < 16; ++e) { x0[e] = 0.f; x1[e] = 0.f; }
#pragma unroll
        for (int ks = 0; ks < 8; ++ks) { x0 = MFMA32(bek[ks * 64], sf[ks], x0); x1 = MFMA32(bek[(8 + ks) * 64], sf[ks], x1); }
        {
            const u32x4* bv = (const u32x4*)(slot + SL_BV) + ((w * 2) * 64 + lane) * 2;
            const u32x4 a0 = bv[0], a1 = bv[1], c0 = bv[128], c1 = bv[129];
            x0[0] = bflo(a0.x) - x0[0]; x0[1] = bfhi(a0.x) - x0[1]; x0[2] = bflo(a0.y) - x0[2]; x0[3] = bfhi(a0.y) - x0[3];
            x0[4] = bflo(a0.z) - x0[4]; x0[5] = bfhi(a0.z) - x0[5]; x0[6] = bflo(a0.w) - x0[6]; x0[7] = bfhi(a0.w) - x0[7];
            x0[8] = bflo(a1.x) - x0[8]; x0[9] = bfhi(a1.x) - x0[9]; x0[10] = bflo(a1.y) - x0[10]; x0[11] = bfhi(a1.y) - x0[11];
            x0[12] = bflo(a1.z) - x0[12]; x0[13] = bfhi(a1.z) - x0[13]; x0[14] = bflo(a1.w) - x0[14]; x0[15] = bfhi(a1.w) - x0[15];
            x1[0] = bflo(c0.x) - x1[0]; x1[1] = bfhi(c0.x) - x1[1]; x1[2] = bflo(c0.y) - x1[2]; x1[3] = bfhi(c0.y) - x1[3];
            x1[4] = bflo(c0.z) - x1[4]; x1[5] = bfhi(c0.z) - x1[5]; x1[6] = bflo(c0.w) - x1[6]; x1[7] = bfhi(c0.w) - x1[7];
            x1[8] = bflo(c1.x) - x1[8]; x1[9] = bfhi(c1.x) - x1[9]; x1[10] = bflo(c1.y) - x1[10]; x1[11] = bfhi(c1.y) - x1[11];
            x1[12] = bflo(c1.z) - x1[12]; x1[13] = bfhi(c1.z) - x1[13]; x1[14] = bflo(c1.w) - x1[14]; x1[15] = bfhi(c1.w) - x1[15];
        }
        bf16x8 rf[4] = {pack_step<0>(x0), pack_step<1>(x0), pack_step<0>(x1), pack_step<1>(x1)};
        f32x16 u0, u1;
#pragma unroll
        for (int e = 0; e < 16; ++e) { u0[e] = 0.f; u1[e] = 0.f; }
        u0 = MFMA32(tp[0 * 64], rf[0], u0); u0 = MFMA32(tp[1 * 64], rf[1], u0);
#pragma unroll
        for (int ks = 0; ks < 4; ++ks) u1 = MFMA32(tp[(4 + ks) * 64], rf[ks], u1);
        bf16x8 uf[4] = {pack_step<0>(u0), pack_step<1>(u0), pack_step<0>(u1), pack_step<1>(u1)};
        if (sample || c > 0) {
#pragma unroll
            for (int e = 0; e < 16; ++e) { x0[e] = 0.f; x1[e] = 0.f; }
#pragma unroll
            for (int ks = 0; ks < 8; ++ks) { x0 = MFMA32(qe[ks * 64], sf[ks], x0); x1 = MFMA32(qe[(8 + ks) * 64], sf[ks], x1); }
            x0 = MFMA32(qkd[0 * 64], uf[0], x0); x0 = MFMA32(qkd[1 * 64], uf[1], x0);
#pragma unroll
            for (int ks = 0; ks < 4; ++ks) x1 = MFMA32(qkd[(4 + ks) * 64], uf[ks], x1);
            const int crow0 = sample ? NBATCH * SEQ + b * TS : b * SEQ + 64 * (c - 1), L = sample ? TS : 64;
#pragma unroll
            for (int reg = 0; reg < 16; ++reg) { const int i0 = crow16(reg, hh), i1 = 32 + i0;
                if (i0 < L) OBR[(size_t)(crow0 + i0) * OAB_PITCH + h * 128 + dv] = f2bf(x0[reg]);
                if (i1 < L) OBR[(size_t)(crow0 + i1) * OAB_PITCH + h * 128 + dv] = f2bf(x1[reg]); }
        }
#pragma unroll
        for (int kb = 0; kb < 4; ++kb) {
            S[kb] = S[kb] * gcl;
#pragma unroll
            for (int ks = 0; ks < 4; ++ks) S[kb] = MFMA32(kwt[(kb * 4 + ks) * 64], uf[ks], S[kb]);
        }
    }
    float* So = A->out + (sample ? O_DS : O_DP) + ((size_t)(b * 4 + h) * 128) * 128 + dv;
#pragma unroll
    for (int kb = 0; kb < 4; ++kb)
#pragma unroll
        for (int reg = 0; reg < 16; ++reg) So[(size_t)(32 * kb + crow16(reg, hh)) * 128] = S[kb][reg];
}

constexpr int HALF_BYTES = 40960;
DI void scan_prompt_wg(KA A, int seq, LAS unsigned char* lds, unsigned ep) {
    const int tid = threadIdx.x, lane = tid & 63, wave = __builtin_amdgcn_readfirstlane(tid >> 6);
    const int b = seq >> 2, h = seq & 3;
    constexpr int N = 2 * CHUNKS_P;
    if (wave >= 4) {
        const int loff = (wave - 4) * 10240 + lane * 16;
        u32x4 r0[10], r1[10], r2[10], r3[10];
        LAS u32x4* d0 = (LAS u32x4*)(lds + loff); LAS u32x4* d1 = (LAS u32x4*)(lds + HALF_BYTES + loff);
        LAS float* gclw = (LAS float*)(lds + 2 * HALF_BYTES);
        unsigned long long pv;
#define SL_PEEK(c) do { if ((c) < CHUNKS_P) pv = __hip_atomic_load(item_granule(A, seq * CHUNKS_P + (c)), __ATOMIC_RELAXED, __HIP_MEMORY_SCOPE_AGENT); } while (0)
#define SL_POLL(c) do { float g_; if ((unsigned)(pv >> 32) >= ep) { asm volatile("" ::: "memory"); g_ = __uint_as_float((unsigned)__builtin_amdgcn_readfirstlane((int)(unsigned)pv)); } \
            else g_ = wait_item(item_granule(A, seq * CHUNKS_P + (c)), ep); if (wave == 4 && lane == 0) gclw[(c) & 7] = g_; } while (0)
#define SL_ISSUE(h, R) do { const __amdgpu_buffer_rsrc_t rs_ = __builtin_amdgcn_make_buffer_rsrc((void*)slot_ptr(A, seq * CHUNKS_P + ((h) >> 1)), 0, (int)PREP_SLOT, 0x00020000); \
            _Pragma("unroll") for (int q = 0; q < 10; ++q) R[q] = __builtin_bit_cast(u32x4, __builtin_amdgcn_raw_buffer_load_b128(rs_, ((h) & 1) * HALF_BYTES + loff + q * 1024, 0, 16)); } while (0)
#define SL_WRITE(D, R) do { _Pragma("unroll") for (int q = 0; q < 10; ++q) D[q * 64] = R[q]; } while (0)
#define SL_STEP(k, D, R, FIRST) do { if ((k) < N) { \
            if ((k) + 1 < N) SL_WRITE(D, R); \
            LDS_BARRIER(); \
            if ((k) + 5 < N) { if (FIRST) SL_POLL(((k) + 5) >> 1); SL_ISSUE((k) + 5, R); } \
            if (!(FIRST)) SL_PEEK(((k) + 6) >> 1); } } while (0)
        SL_PEEK(0); SL_POLL(0); SL_ISSUE(0, r0); SL_ISSUE(1, r1);
        SL_PEEK(1); SL_POLL(1); SL_ISSUE(2, r2); SL_ISSUE(3, r3);
        SL_PEEK(2);
        SL_WRITE(d0, r0);
        LDS_BARRIER();
        SL_POLL(2); SL_ISSUE(4, r0);
#pragma unroll 1
        for (int k = 0; k < N; k += 4) {
            SL_STEP(k, d1, r1, false);
            SL_STEP(k + 1, d0, r2, true);
            SL_STEP(k + 2, d1, r3, false);
            SL_STEP(k + 3, d0, r0, true);
        }
#undef SL_PEEK
#undef SL_POLL
#undef SL_ISSUE
#undef SL_WRITE
#undef SL_STEP
    } else {
        const int w = wave, r = lane & 31, hh = lane >> 5, dv = 32 * w + r;
        f32x16 S[4];
#pragma unroll
        for (int kb = 0; kb < 4; ++kb)
#pragma unroll
            for (int reg = 0; reg < 16; ++reg) S[kb][reg] = 0.f;
        bf16* OBR = (bf16*)((unsigned char*)A->out + DO_OB);
        const LAS float* gclw = (const LAS float*)(lds + 2 * HALF_BYTES);
        const LAS bf16x8* bek = (const LAS bf16x8*)(lds + SL_BEK) + lane; const LAS bf16x8* tp = (const LAS bf16x8*)(lds + SL_T) + lane;
        const LAS u32x4* bv = (const LAS u32x4*)(lds + SL_BV) + ((w * 2) * 64 + lane) * 2;
        const LAS bf16x8* qkd = (const LAS bf16x8*)(lds + HALF_BYTES + (SL_QKD - HALF_BYTES)) + lane; const LAS bf16x8* qe = (const LAS bf16x8*)(lds + HALF_BYTES + (SL_QE - HALF_BYTES)) + lane;
        const LAS bf16x8* kwt = (const LAS bf16x8*)(lds + HALF_BYTES + (SL_KWT - HALF_BYTES)) + lane;
        LDS_BARRIER();
#pragma unroll 1
        for (int c = 0; c < CHUNKS_P; ++c) {
            bf16x8 sf[8];
#pragma unroll
            for (int kb = 0; kb < 4; ++kb) { sf[2 * kb] = pack_step<0>(S[kb]); sf[2 * kb + 1] = pack_step<1>(S[kb]); }
            f32x16 x0, x1;
#pragma unroll
            for (int e = 0; e < 16; ++e) { x0[e] = 0.f; x1[e] = 0.f; }
#pragma unroll
            for (int ks = 0; ks < 8; ++ks) { x0 = MFMA32(bek[ks * 64], sf[ks], x0); x1 = MFMA32(bek[(8 + ks) * 64], sf[ks], x1); }
            {
                const u32x4 a0 = bv[0], a1 = bv[1], c0 = bv[128], c1 = bv[129];
                x0[0] = bflo(a0.x) - x0[0]; x0[1] = bfhi(a0.x) - x0[1]; x0[2] = bflo(a0.y) - x0[2]; x0[3] = bfhi(a0.y) - x0[3];
                x0[4] = bflo(a0.z) - x0[4]; x0[5] = bfhi(a0.z) - x0[5]; x0[6] = bflo(a0.w) - x0[6]; x0[7] = bfhi(a0.w) - x0[7];
                x0[8] = bflo(a1.x) - x0[8]; x0[9] = bfhi(a1.x) - x0[9]; x0[10] = bflo(a1.y) - x0[10]; x0[11] = bfhi(a1.y) - x0[11];
                x0[12] = bflo(a1.z) - x0[12]; x0[13] = bfhi(a1.z) - x0[13]; x0[14] = bflo(a1.w) - x0[14]; x0[15] = bfhi(a1.w) - x0[15];
                x1[0] = bflo(c0.x) - x1[0]; x1[1] = bfhi(c0.x) - x1[1]; x1[2] = bflo(c0.y) - x1[2]; x1[3] = bfhi(c0.y) - x1[3];
                x1[4] = bflo(c0.z) - x1[4]; x1[5] = bfhi(c0.z) - x1[5]; x1[6] = bflo(c0.w) - x1[6]; x1[7] = bfhi(c0.w) - x1[7];
                x1[8] = bflo(c1.x) - x1[8]; x1[9] = bfhi(c1.x) - x1[9]; x1[10] = bflo(c1.y) - x1[10]; x1[11] = bfhi(c1.y) - x1[11];
                x1[12] = bflo(c1.z) - x1[12]; x1[13] = bfhi(c1.z) - x1[13]; x1[14] = bflo(c1.w) - x1[14]; x1[15] = bfhi(c1.w) - x1[15];
            }
            bf16x8 rf[4] = {pack_step<0>(x0), pack_step<1>(x0), pack_step<0>(x1), pack_step<1>(x1)};
            f32x16 u0, u1;
#pragma unroll
            for (int e = 0; e < 16; ++e) { u0[e] = 0.f; u1[e] = 0.f; }
            u0 = MFMA32(tp[0 * 64], rf[0], u0); u0 = MFMA32(tp[1 * 64], rf[1], u0);
#pragma unroll
            for (int ks = 0; ks < 4; ++ks) u1 = MFMA32(tp[(4 + ks) * 64], rf[ks], u1);
            bf16x8 uf[4] = {pack_step<0>(u0), pack_step<1>(u0), pack_step<0>(u1), pack_step<1>(u1)};
            LDS_BARRIER();
            if (c > 0) {
#pragma unroll
                for (int e = 0; e < 16; ++e) { x0[e] = 0.f; x1[e] = 0.f; }
#pragma unroll
                for (int ks = 0; ks < 8; ++ks) { x0 = MFMA32(qe[ks * 64], sf[ks], x0); x1 = MFMA32(qe[(8 + ks) * 64], sf[ks], x1); }
                x0 = MFMA32(qkd[0 * 64], uf[0], x0); x0 = MFMA32(qkd[1 * 64], uf[1], x0);
#pragma unroll
                for (int ks = 0; ks < 4; ++ks) x1 = MFMA32(qkd[(4 + ks) * 64], uf[ks], x1);
                bf16* orow = OBR + (size_t)(b * SEQ + 64 * (c - 1)) * OAB_PITCH + h * 128 + dv;
#pragma unroll
                for (int reg = 0; reg < 16; ++reg) { const int i0 = crow16(reg, hh); orow[(size_t)i0 * OAB_PITCH] = f2bf(x0[reg]); orow[(size_t)(32 + i0) * OAB_PITCH] = f2bf(x1[reg]); }
            }
            const float gcl = gclw[c & 7];
#pragma unroll
            for (int kb = 0; kb < 4; ++kb) {
                S[kb] = S[kb] * gcl;
#pragma unroll
                for (int ks = 0; ks < 4; ++ks) S[kb] = MFMA32(kwt[(kb * 4 + ks) * 64], uf[ks], S[kb]);
            }
            LDS_BARRIER();
        }
        float* So = A->out + O_DP + ((size_t)(b * 4 + h) * 128) * 128 + dv;
#pragma unroll
        for (int kb = 0; kb < 4; ++kb)
#pragma unroll
            for (int reg = 0; reg < 16; ++reg) So[(size_t)(32 * kb + crow16(reg, hh)) * 128] = S[kb][reg];
    }
}

constexpr int KPITCH = 72, VPITCH = 264;
typedef short v4i16_t __attribute__((ext_vector_type(4)));
DI void attn_unit(KA A, int unit, LAS unsigned char* ldsb) {
    const int tid = threadIdx.x, lane = tid & 63, wave = __builtin_amdgcn_readfirstlane(tid >> 6), r = lane & 31, hh = lane >> 5;
    const int b = unit >> 6, kh = (unit >> 5) & 1, jb = unit & 31, T0 = NMETA + 128 * jb;
    LAS bf16* Ksm = (LAS bf16*)ldsb; LAS bf16* VTs = Ksm + 256 * KPITCH;
    const bf16* KVg = (const bf16*)(A->ws + WS_KV); const bf16* QAg = (const bf16*)(A->ws + WS_QA);
#pragma unroll
    for (int e4 = 0; e4 < 4; ++e4) {
        const int id = tid + 512 * e4, key = id >> 3, cch = id & 7, tk = T0 - 128 + key;
        u32x4 kq = (u32x4){0u, 0u, 0u, 0u}, vq = kq;
        if (tk >= 0) { const bf16* src = KVg + (size_t)(b * TP + tk) * 256 + kh * 64 + 8 * cch; kq = *(const u32x4*)src; vq = *(const u32x4*)(src + 128); }
        *(LAS u32x4*)(Ksm + key * KPITCH + 8 * cch) = kq;
        *(LAS u32x4*)(VTs + key * KPITCH + 8 * cch) = vq;
    }
    LDS_BARRIER();
    const int g = wave >> 1, qh = wave & 1, head = 4 * kh + g;
    const float sink2 = A->sinks[head] * 1.4426950408889634f;
    const int kmin = jb == 0 ? 128 - NMETA : 0;
#pragma unroll 1
    for (int q2 = 0; q2 < 2; ++q2) {
        const int qb = 2 * qh + q2, iq = 32 * qb + r;
        const bf16* qrow = QAg + (size_t)(b * TP + T0 + iq) * 512 + head * 64 + 8 * hh;
        bf16x8 qf[4];
#pragma unroll
        for (int s = 0; s < 4; ++s) qf[s] = *(const bf16x8*)(qrow + 16 * s);
        f32x16 st[5];
        float m = sink2;
#pragma unroll
        for (int kt5 = 0; kt5 < 5; ++kt5) {
            const int kt = qb + kt5;
            f32x16 acc;
#pragma unroll
            for (int e = 0; e < 16; ++e) acc[e] = 0.f;
#pragma unroll
            for (int s = 0; s < 4; ++s) acc = MFMA32(*(const LAS bf16x8*)(Ksm + (32 * kt + r) * KPITCH + 16 * s + 8 * hh), qf[s], acc);
#pragma unroll
            for (int reg = 0; reg < 16; ++reg) { const int kk = 32 * kt + crow16(reg, hh); const bool ok = kk >= iq && kk <= iq + 128 && kk >= kmin;
                acc[reg] = ok ? acc[reg] : -INFINITY; m = fmaxf(m, acc[reg]); }
            st[kt5] = acc;
        }
        m = fmaxf(m, __shfl_xor(m, 32));
        float l = 0.f;
#pragma unroll
        for (int kt5 = 0; kt5 < 5; ++kt5)
#pragma unroll
            for (int reg = 0; reg < 16; ++reg) { const float p = exp2f(st[kt5][reg] - m); st[kt5][reg] = p; l += p; }
        l += __shfl_xor(l, 32); l += exp2f(sink2 - m);
        f32x16 o0, o1;
#pragma unroll
        for (int e = 0; e < 16; ++e) { o0[e] = 0.f; o1[e] = 0.f; }
#pragma unroll
        for (int kt5 = 0; kt5 < 5; ++kt5) {
            const int kt = qb + kt5;
            const bf16x8 p0 = pack_step<0>(st[kt5]), p1 = pack_step<1>(st[kt5]);
            const LAS bf16* vb = VTs + (32 * kt + 4 * hh + ((lane & 15) >> 2)) * KPITCH + 16 * ((lane >> 4) & 1) + 4 * (lane & 3);
#define VTR(ptr) __builtin_amdgcn_ds_read_tr16_b64_v4i16((LAS v4i16_t*)(ptr))
            const v4i16_t a00 = VTR(vb), a01 = VTR(vb + 8 * KPITCH), a10 = VTR(vb + 16 * KPITCH), a11 = VTR(vb + 24 * KPITCH);
            const v4i16_t b00 = VTR(vb + 32), b01 = VTR(vb + 8 * KPITCH + 32), b10 = VTR(vb + 16 * KPITCH + 32), b11 = VTR(vb + 24 * KPITCH + 32);
#undef VTR
            o0 = MFMA32(__builtin_shufflevector(a00, a01, 0, 1, 2, 3, 4, 5, 6, 7), p0, o0); o0 = MFMA32(__builtin_shufflevector(a10, a11, 0, 1, 2, 3, 4, 5, 6, 7), p1, o0);
            o1 = MFMA32(__builtin_shufflevector(b00, b01, 0, 1, 2, 3, 4, 5, 6, 7), p0, o1); o1 = MFMA32(__builtin_shufflevector(b10, b11, 0, 1, 2, 3, 4, 5, 6, 7), p1, o1);
        }
        const float rl = 1.0f / l;
        bf16* orow = (bf16*)((unsigned char*)A->out + DO_OA) + (size_t)(b * SEQ + 128 * jb + iq) * OAB_PITCH + head * 64 + 4 * hh;
#pragma unroll
        for (int g4 = 0; g4 < 4; ++g4) {
            *(u32x2*)(orow + 8 * g4) = (u32x2){cvtpk(o0[4 * g4] * rl, o0[4 * g4 + 1] * rl), cvtpk(o0[4 * g4 + 2] * rl, o0[4 * g4 + 3] * rl)};
            *(u32x2*)(orow + 32 + 8 * g4) = (u32x2){cvtpk(o1[4 * g4] * rl, o1[4 * g4 + 1] * rl), cvtpk(o1[4 * g4 + 2] * rl, o1[4 * g4 + 3] * rl)};
        }
    }
    LDS_BARRIER();
}
DI void sample_attn(KA A, int b, int head, LAS float* wl, int lane) {
    const int kh = head >> 2;
    LAS float* qn = wl; LAS float* ps = wl + 256;
    const bf16* QAg = (const bf16*)(A->ws + WS_QA); const bf16* KVg = (const bf16*)(A->ws + WS_KV);
#pragma unroll
    for (int i = 0; i < 4; ++i) qn[i * 64 + lane] = bf2f(QAg[(size_t)(MP + b * TS + i) * 512 + head * 64 + pos_of_d(lane)]);
    LDS_WAIT(); asm volatile("" ::: "memory");
    const float sink2 = A->sinks[head] * 1.4426950408889634f;
#pragma unroll 1
    for (int kq = 0; kq < 3; ++kq) {
        const int kj = lane + 64 * kq;
        float sc0 = 0.f, sc1 = 0.f, sc2 = 0.f, sc3 = 0.f;
        if (kj < 128) {
            const f32x4* kr = (const f32x4*)(A->cache_k + ((size_t)(b * 128 + kj) * 2 + kh) * 64);
#pragma unroll 4
            for (int d4 = 0; d4 < 16; ++d4) { const f32x4 kv = kr[d4];
                const f32x4 q0 = *(const LAS f32x4*)(qn + 4 * d4), q1 = *(const LAS f32x4*)(qn + 64 + 4 * d4), q2 = *(const LAS f32x4*)(qn + 128 + 4 * d4), q3 = *(const LAS f32x4*)(qn + 192 + 4 * d4);
                sc0 += (kv[0] * q0[0] + kv[1] * q0[1]) + (kv[2] * q0[2] + kv[3] * q0[3]); sc1 += (kv[0] * q1[0] + kv[1] * q1[1]) + (kv[2] * q1[2] + kv[3] * q1[3]);
                sc2 += (kv[0] * q2[0] + kv[1] * q2[1]) + (kv[2] * q2[2] + kv[3] * q2[3]); sc3 += (kv[0] * q3[0] + kv[1] * q3[1]) + (kv[2] * q3[2] + kv[3] * q3[3]); }
        } else if (kj < 132) {
            const bf16* kr = KVg + (size_t)(MP + b * TS + (kj - 128)) * 256 + kh * 64;
#pragma unroll 4
            for (int p = 0; p < 64; ++p) { const float kv = bf2f(kr[p]); const int d = d_of_pos(p);
                sc0 += kv * qn[d]; sc1 += kv * qn[64 + d]; sc2 += kv * qn[128 + d]; sc3 += kv * qn[192 + d]; }
        }
        if (kj < 132) {
            ps[0 * 132 + kj] = (kj >= 0 && kj <= 128) ? sc0 : -INFINITY; ps[1 * 132 + kj] = (kj >= 1 && kj <= 129) ? sc1 : -INFINITY;
            ps[2 * 132 + kj] = (kj >= 2 && kj <= 130) ? sc2 : -INFINITY; ps[3 * 132 + kj] = (kj >= 3 && kj <= 131) ? sc3 : -INFINITY; }
    }
    LDS_WAIT(); asm volatile("" ::: "memory");
    float linv[4];
#pragma unroll
    for (int i = 0; i < 4; ++i) {
        const float s0 = ps[i * 132 + lane], s1 = ps[i * 132 + 64 + lane], s2 = lane < 4 ? ps[i * 132 + 128 + lane] : -INFINITY;
        const float m = wave_max(fmaxf(fmaxf(s0, s1), fmaxf(s2, sink2)));
        const float p0 = exp2f(s0 - m), p1 = exp2f(s1 - m), p2 = exp2f(s2 - m);
        ps[i * 132 + lane] = p0; ps[i * 132 + 64 + lane] = p1; if (lane < 4) ps[i * 132 + 128 + lane] = p2;
        linv[i] = 1.0f / (wave_sum(p0 + p1 + p2) + exp2f(sink2 - m));
    }
    LDS_WAIT(); asm volatile("" ::: "memory");
    float o[4] = {0.f, 0.f, 0.f, 0.f};
#pragma unroll 4
    for (int kj = 0; kj < 128; ++kj) { const float v = A->cache_v[((size_t)(b * 128 + kj) * 2 + kh) * 64 + lane];
#pragma unroll
        for (int i = 0; i < 4; ++i) o[i] += ps[i * 132 + kj] * v; }
#pragma unroll
    for (int kj = 128; kj < 132; ++kj) { const float v = bf2f(KVg[(size_t)(MP + b * TS + (kj - 128)) * 256 + 128 + kh * 64 + lane]);
#pragma unroll
        for (int i = 0; i < 4; ++i) o[i] += ps[i * 132 + kj] * v; }
    bf16* OAg = (bf16*)((unsigned char*)A->out + DO_OA);
#pragma unroll
    for (int i = 0; i < 4; ++i) OAg[(size_t)(NBATCH * SEQ + b * TS + i) * OAB_PITCH + head * 64 + lane] = f2bf(o[i] * linv[i]);
    LDS_WAIT(); asm volatile("" ::: "memory");
}
DI void sample_delta(KA A, int b, int h, int quarter, LAS float* wl, int lane) {
    const bf16* QKVB = (const bf16*)(A->ws + WS_QKVB);
    LAS float* qs = wl; LAS float* ks = wl + 512;
#pragma unroll
    for (int grp = 0; grp < 2; ++grp) {
        float c[4][2];
#pragma unroll
        for (int cc = 0; cc < 2; ++cc) {
            const int ch = grp * 512 + h * 128 + lane + 64 * cc;
            float x[7];
#pragma unroll
            for (int i = 0; i < 3; ++i) x[i] = A->state_conv[((size_t)b * 3 + i) * CONVD + ch];
#pragma unroll
            for (int t = 0; t < 4; ++t) x[3 + t] = bf2f(QKVB[(size_t)(MP + b * TS + t) * CONVD + ch]);
            const float w0 = A->conv_w[ch], w1 = A->conv_w[CONVD + ch], w2 = A->conv_w[2 * CONVD + ch], w3 = A->conv_w[3 * CONVD + ch];
#pragma unroll
            for (int t = 0; t < 4; ++t) c[t][cc] = siluf_(w0 * x[t] + w1 * x[t + 1] + w2 * x[t + 2] + w3 * x[t + 3]);
        }
        LAS float* dst = grp == 0 ? qs : ks;
#pragma unroll
        for (int t = 0; t < 4; ++t) { const float rn = rsqrtf(wave_sum(c[t][0] * c[t][0] + c[t][1] * c[t][1]) + EPS) * (grp == 0 ? 0.08838834764831845f : 1.0f);
            dst[t * 128 + lane] = c[t][0] * rn; dst[t * 128 + 64 + lane] = c[t][1] * rn; }
    }
    LDS_WAIT(); asm volatile("" ::: "memory");
    const int dv = 32 * quarter + (lane >> 1), part = lane & 1;
    float s[64];
    { const float* S0 = A->state_delta + ((size_t)(b * 4 + h) * 128 + 64 * part) * 128 + dv;
#pragma unroll
      for (int i = 0; i < 64; ++i) s[i] = S0[(size_t)i * 128]; }
    bf16* OBR = (bf16*)((unsigned char*)A->out + DO_OB) + (size_t)(NBATCH * SEQ + b * TS) * OAB_PITCH + h * 128 + dv;
#pragma unroll 1
    for (int t = 0; t < 4; ++t) {
        const f32x2 gb = ((const f32x2*)(A->ws + WS_GB))[(size_t)(MP + b * TS + t) * 4 + h];
        float vt;
        { const int ch = 1024 + h * 128 + dv; float x[4];
#pragma unroll
          for (int i = 0; i < 4; ++i) { const int tt = t - 3 + i; x[i] = tt < 0 ? A->state_conv[((size_t)b * 3 + (3 + tt)) * CONVD + ch] : bf2f(QKVB[(size_t)(MP + b * TS + tt) * CONVD + ch]); }
          vt = siluf_(A->conv_w[ch] * x[0] + A->conv_w[CONVD + ch] * x[1] + A->conv_w[2 * CONVD + ch] * x[2] + A->conv_w[3 * CONVD + ch] * x[3]); }
        const float eg = __expf(gb[0]);
        const LAS float* kt = ks + t * 128 + 64 * part; const LAS float* qt = qs + t * 128 + 64 * part;
        float ksum = 0.f;
#pragma unroll
        for (int j = 0; j < 16; ++j) { const f32x4 kk = *(const LAS f32x4*)(kt + 4 * j);
            s[4 * j] *= eg; s[4 * j + 1] *= eg; s[4 * j + 2] *= eg; s[4 * j + 3] *= eg;
            ksum += (s[4 * j] * kk[0] + s[4 * j + 1] * kk[1]) + (s[4 * j + 2] * kk[2] + s[4 * j + 3] * kk[3]); }
        ksum += __shfl_xor(ksum, 1);
        const float u = gb[1] * (vt - ksum);
        float osum = 0.f;
#pragma unroll
        for (int j = 0; j < 16; ++j) { const f32x4 kk = *(const LAS f32x4*)(kt + 4 * j), qq = *(const LAS f32x4*)(qt + 4 * j);
            s[4 * j] += kk[0] * u; s[4 * j + 1] += kk[1] * u; s[4 * j + 2] += kk[2] * u; s[4 * j + 3] += kk[3] * u;
            osum += (s[4 * j] * qq[0] + s[4 * j + 1] * qq[1]) + (s[4 * j + 2] * qq[2] + s[4 * j + 3] * qq[3]); }
        osum += __shfl_xor(osum, 1);
        if (part == 0) OBR[(size_t)t * OAB_PITCH] = f2bf(osum);
    }
    { float* So = A->out + O_DS + ((size_t)(b * 4 + h) * 128 + 64 * part) * 128 + dv;
#pragma unroll
      for (int i = 0; i < 64; ++i) So[(size_t)i * 128] = s[i]; }
    LDS_WAIT(); asm volatile("" ::: "memory");
}
constexpr int NINV_WG = 24;
DI void p23_mixers(KA A, LAS unsigned char* lds, const XcdBarrier& dbg_bar, unsigned ep, int pmode = 0) {
    const int tid = threadIdx.x, lane = tid & 63, wave = __builtin_amdgcn_readfirstlane(tid >> 6), G = gridDim.x, wg = blockIdx.x;
    const int NSCAN = N_PROMPT_SEQ, NP = G - NSCAN - NINV_WG;
    if (wg < NSCAN) { if (!(pmode & 2)) scan_prompt_wg(A, wg, lds, ep); return; }
    if (wg < NSCAN + NINV_WG) {
        const int wv = (wg - NSCAN) * NWAVES + wave, NWV = NINV_WG * NWAVES;
#pragma unroll 1
        for (int m = wv; m < N_ITEMS; m += NWV) {
            const int item = order_item(m), p = m % NP, k = m / NP;
            const float gcl = wait_item(item_flag1(A, item), ep);
            __builtin_amdgcn_fence(__ATOMIC_ACQUIRE, "agent");
            const float* ats = (const float*)((const unsigned char*)A->out + DO_ATS + ((size_t)p * 8 + (k & 7)) * ATS_ITEM);
            if (pmode & 16) { if (lane == 0) __hip_atomic_store(item_granule(A, item), ((unsigned long long)ep << 32) | (unsigned long long)__float_as_uint(gcl), __ATOMIC_RELAXED, __HIP_MEMORY_SCOPE_AGENT); }
            else prep_stage2(A, item, gcl, ats, (LAS float*)(lds + wave * 16384), ep);
        }
        return;
    }
    const int p = wg - NSCAN - NINV_WG;
    if (pmode & 32) {
        for (int m = p * NTHREADS + tid; m < N_ITEMS; m += NP * NTHREADS) { gu64* f = item_flag1(A, order_item(m));
            const unsigned long long o = __hip_atomic_load(f, __ATOMIC_RELAXED, __HIP_MEMORY_SCOPE_AGENT);
            __hip_atomic_store(f, ((unsigned long long)ep << 32) | (o & 0xffffffffull), __ATOMIC_RELAXED, __HIP_MEMORY_SCOPE_AGENT); }
    } else {
        const int ntot = p < N_ITEMS ? (N_ITEMS - 1 - p) / NP + 1 : 0;
        S1Pre P;
        if (ntot > 0) stage1_issue(A, order_item(p), P);
        int prev = -1;
#pragma unroll 1
        for (int k = 0; k < ntot; ++k) {
            const int m = p + NP * k, item = order_item(m), nxt = k + 1 < ntot ? order_item(m + NP) : N_ITEMS;
            float* ats = (float*)((unsigned char*)A->out + DO_ATS + ((size_t)p * 8 + (k & 7)) * ATS_ITEM);
            prep_stage1(A, item, nxt, prev, k >= 8 ? order_item(m - 8 * NP) : -1, k & 1, ats, P, lds, ep, pmode);
            prev = item;
        }
        asm volatile("s_waitcnt vmcnt(0)" ::: "memory"); __syncthreads();
        if (prev >= 0 && tid == 0) __hip_atomic_store(item_flag1(A, prev), ((unsigned long long)ep << 32) | (unsigned long long)__float_as_uint(((const LAS float*)(lds + LDS_GCL))[(ntot - 1) & 1]), __ATOMIC_RELAXED, __HIP_MEMORY_SCOPE_AGENT);
    }
    if (pmode & 1) return;
    for (int u = p; u < NBATCH * NKV * 32; u += NP) attn_unit(A, u, lds);
    const int worker = p * NWAVES + wave, NW = NP * NWAVES;
    LAS float* wl = (LAS float*)(lds + 98304 + wave * 4096);
    for (int it = worker; it < SBATCH * NHB * 4 + SBATCH * NHA; it += NW) {
        if (it < SBATCH * NHB * 4) sample_delta(A, it >> 4, (it >> 2) & 3, it & 3, wl, lane);
        else { const int q = it - SBATCH * NHB * 4; sample_attn(A, q >> 3, q & 7, wl, lane); }
    }
}

DI void p3b_gated_norm(KA A) {
    const int tid = threadIdx.x, lane = tid & 63, wave = tid >> 6, gw = blockIdx.x * NWAVES + wave, NGW = gridDim.x * NWAVES;
    const int head = lane >> 4, dv0 = 8 * (lane & 15);
    const f32x4 w0 = *(const f32x4*)(A->gdn_norm + dv0), w1 = *(const f32x4*)(A->gdn_norm + dv0 + 4);
    bf16* OBg = (bf16*)((unsigned char*)A->out + DO_OB); const bf16* Zg = (const bf16*)(A->ws + WS_Z);
    for (int crow = gw; crow < MC; crow += NGW) {
        const u32x4 ow = *(const u32x4*)(OBg + (size_t)crow * OAB_PITCH + head * 128 + dv0);
        const f32x4 a = {bflo(ow.x), bfhi(ow.x), bflo(ow.y), bfhi(ow.y)}, c = {bflo(ow.z), bfhi(ow.z), bflo(ow.w), bfhi(ow.w)};
        float ss = (a[0] * a[0] + a[1] * a[1]) + (a[2] * a[2] + a[3] * a[3]) + (c[0] * c[0] + c[1] * c[1]) + (c[2] * c[2] + c[3] * c[3]);
        ss += __shfl_xor(ss, 1); ss += __shfl_xor(ss, 2); ss += __shfl_xor(ss, 4); ss += __shfl_xor(ss, 8);
        const float rstd = rsqrtf(ss * (1.0f / 128.0f) + EPS);
        const u32x4 zw = *(const u32x4*)(Zg + (size_t)pg8::crow_to_urow(crow) * 512 + head * 128 + dv0);
        f32x4 y0, y1;
        y0[0] = a[0] * rstd * w0[0] * siluf_(bflo(zw.x)); y0[1] = a[1] * rstd * w0[1] * siluf_(bfhi(zw.x)); y0[2] = a[2] * rstd * w0[2] * siluf_(bflo(zw.y)); y0[3] = a[3] * rstd * w0[3] * siluf_(bfhi(zw.y));
        y1[0] = c[0] * rstd * w1[0] * siluf_(bflo(zw.z)); y1[1] = c[1] * rstd * w1[1] * siluf_(bfhi(zw.z)); y1[2] = c[2] * rstd * w1[2] * siluf_(bflo(zw.w)); y1[3] = c[3] * rstd * w1[3] * siluf_(bfhi(zw.w));
        *(u32x4*)(OBg + (size_t)crow * OAB_PITCH + head * 128 + dv0) = pack8f(y0, y1);
    }
}
DI void p8_final_norm(KA A) {
    const int tid = threadIdx.x, lane = tid & 63, wave = tid >> 6, gw = blockIdx.x * NWAVES + wave, NGW = gridDim.x * NWAVES;
    f32x4 nf[4];
#pragma unroll
    for (int j = 0; j < 4; ++j) nf[j] = ((const f32x4*)A->norm_final)[lane + 64 * j];
    const bf16* H2 = (const bf16*)(A->ws + WS_MB);
    for (int crow = gw; crow < MC; crow += NGW) {
        const u32x2* hrow = (const u32x2*)(H2 + (size_t)crow * D);
        f32x4* row = (f32x4*)(A->out + (size_t)crow * D);
        f32x4 v[4]; float ss = 0.f;
#pragma unroll
        for (int j = 0; j < 4; ++j) { const u32x2 hw = hrow[lane + 64 * j]; v[j] = (f32x4){bflo(hw.x), bfhi(hw.x), bflo(hw.y), bfhi(hw.y)};
            ss += (v[j][0] * v[j][0] + v[j][1] * v[j][1]) + (v[j][2] * v[j][2] + v[j][3] * v[j][3]); }
        const float rstd = rsqrtf(wave_sum(ss) * (1.0f / D) + EPS);
#pragma unroll
        for (int j = 0; j < 4; ++j) row[lane + 64 * j] = v[j] * rstd * nf[j];
    }
}
__global__ void __launch_bounds__(NTHREADS, 2) hybrid_fwd(Args Aval) {
    extern __shared__ __attribute__((aligned(16))) unsigned char lds_raw[];
    LAS unsigned char* lds = (LAS unsigned char*)lds_raw;
    const int tid = threadIdx.x;
    int lo, hi; { KA A0 = kargs(); lo = A0->ph_lo; hi = A0->ph_hi; }
#if MK_N_LAUNCHES == 1
#if MK_BARRIER == 1
    volatile LAS unsigned* MISC = (volatile LAS unsigned*)(lds + LDS_MISC);
    if (tid < 64) MISC[tid] = 0u;
    __syncthreads();
    XcdBarrier bar; { KA A0 = kargs(); bar = xcd_barrier_post((unsigned*)(A0->ws + WS_CTL) + 4096, MISC + 8); }
#define GRID_BAR() xcd_barrier(bar)
#else
    cg::grid_group grid = cg::this_grid();
#define GRID_BAR() grid.sync()
#endif
#else
#define GRID_BAR() do {} while (0)
#endif
#ifndef PH_MASK
#define PH_MASK 0x1ff
#endif
#define IN(k) (((PH_MASK >> (k)) & 1) && lo <= (k) && (k) < hi)
#ifndef PROBE_REP
#define PROBE_REP -1
#endif
#define NREP(k) (PROBE_REP == (k) ? 2 : 1)
#define SEAM(k) do { if (IN(k) && IN((k) + 1)) GRID_BAR(); } while (0)
    const int G = gridDim.x, wgid = blockIdx.x;
#if PROBE_REP == 0
    if (IN(0)) { KA A = kargs(); p0_prologue(A, lds); __syncthreads(); }
#endif
    if (IN(0)) { KA A = kargs(); p0_prologue(A, lds); } SEAM(0);
    if (IN(1)) for (int rep = 0; rep < NREP(1); ++rep) { KA A = kargs(); unsigned char* ws = A->ws;
        pg8::Gemm g{(const bf16*)(ws + WS_XN), (const bf16*)(ws + WS_WIN), MUP, NIN, D}; pg8::StaticOrder S; S.init(MUP, NIN, G, wgid);
        pg8::EpiInProj E{(bf16*)(ws + WS_QA), (bf16*)(ws + WS_KV), (bf16*)(ws + WS_QKVB), (bf16*)(ws + WS_Z), (bf16*)(ws + WS_G),
                         (const float*)(ws + WS_ROPE), (const float*)(ws + WS_ROPE) + (TP + TS) * 32, A->out};
        pg8::gemm_phase<pg8::EpiInProj, pg8::StaticOrder, true, true>(lds, g, S, E);
    } SEAM(1);
#ifndef PROBE_MODE
#define PROBE_MODE 0
#endif
#if PROBE_REP == 2
    if (IN(2)) { KA A = kargs(); p23_mixers(A, lds, bar, 1u); GRID_BAR(); }
    if (IN(2)) { KA A = kargs(); p23_mixers(A, lds, bar, 2u, PROBE_MODE); } SEAM(2);
#else
    if (IN(2)) { KA A = kargs(); p23_mixers(A, lds, bar, 1u); } SEAM(2);
#endif
    if (IN(3)) for (int rep = 0; rep < NREP(3); ++rep) { KA A = kargs(); p3b_gated_norm(A); } SEAM(3);
    if (IN(4)) for (int rep = 0; rep < NREP(4); ++rep) { KA A = kargs(); unsigned char* ws = A->ws;
        const bf16* OABp = (const bf16*)((unsigned char*)A->out + DO_OA); const bf16* Wm = (const bf16*)(ws + WS_WOA);
        { pg8::Gemm g{OABp, Wm, MC, D, 512, 1024}; pg8::StaticOrder S; S.init(MC, D, G, wgid); S.lim = (S.nwg / G) * G;
          pg8::EpiMerge<false> E{(bf16*)(ws + WS_MB), (const bf16*)(ws + WS_G), 0};
          pg8::gemm_phase<pg8::EpiMerge<false>, pg8::StaticOrder, true, true>(lds, g, S, E); }
        asm volatile("s_waitcnt vmcnt(0)" ::: "memory"); __syncthreads();
        { pg8::Gemm g{OABp + 512, Wm + 512, MC, D, 512, 1024}; pg8::StaticOrder S; S.init(MC, D, G, wgid); S.lim = (S.nwg / G) * G;
          pg8::EpiMerge<true> E{(bf16*)(ws + WS_MB), (const bf16*)(ws + WS_G), 1024};
          pg8::gemm_phase<pg8::EpiMerge<true>, pg8::StaticOrder, true, true>(lds, g, S, E); }
        { const int nstr = (MC / 256) * 4 - ((MC / 256) * 4 / G) * G;
          if (wgid < nstr * 4) { const int t = wgid >> 2, sl = wgid & 3, koff = sl * 256;
            pg8::Gemm g{OABp + koff, Wm + koff, MC, D, 256, 1024};
            pg8::SliceOrder S; S.init_slice(MC, D, G, ((MC / 256) * 4 / G) * G, t);
            pg8::EpiSplit<pg8::EpiStoreMB, true> E{pg8::EpiStoreMB{(bf16*)(ws + WS_MB)}, (float*)(ws + WS_SCR) + (size_t)t * 65536, (unsigned*)(ws + WS_CTL + CTL_SPL) + t * 8, 4u, (const bf16*)(ws + WS_G), (sl >> 1) ? 1024 : 0};
            pg8::gemm_phase<pg8::EpiSplit<pg8::EpiStoreMB, true>, pg8::SliceOrder, true, true>(lds, g, S, E); } }
    } SEAM(4);
    if (IN(5)) { KA A = kargs(); unsigned char* ws = A->ws;
        { pg8::Gemm g{(const bf16*)(ws + WS_MB), (const bf16*)(ws + WS_WOUT), MC, D, D}; pg8::StaticOrder S; S.init(MC, D, G, wgid); S.lim = (S.nwg / G) * G;
          pg8::EpiWout<true> E{A->x_prompt, A->x_sample, (bf16*)(ws + WS_HB1), (float*)(ws + WS_CTL + CTL_SS1)};
          pg8::gemm_phase<pg8::EpiWout<true>, pg8::StaticOrder, true, true>(lds, g, S, E); }
        { const int nstr = (MC / 256) * 4 - ((MC / 256) * 4 / G) * G;
          if (wgid < nstr * 4) { const int t = wgid >> 2, koff = (wgid & 3) * 256;
            pg8::Gemm g{(const bf16*)(ws + WS_MB) + koff, (const bf16*)(ws + WS_WOUT) + koff, MC, D, 256, D};
            pg8::SliceOrder S; S.init_slice(MC, D, G, ((MC / 256) * 4 / G) * G, t);
            pg8::EpiSplit<pg8::EpiWout<true>, false> E{pg8::EpiWout<true>{A->x_prompt, A->x_sample, (bf16*)(ws + WS_HB1), (float*)(ws + WS_CTL + CTL_SS1)}, (float*)(ws + WS_SCR) + (size_t)t * 65536, (unsigned*)(ws + WS_CTL + CTL_SPL) + t * 8, 4u, nullptr, 0};
            pg8::gemm_phase<pg8::EpiSplit<pg8::EpiWout<true>, false>, pg8::SliceOrder, true, true>(lds, g, S, E); } }
    } SEAM(5);
    if (IN(6)) for (int rep = 0; rep < NREP(6); ++rep) { KA A = kargs(); unsigned char* ws = A->ws;
        pg8::Gemm g{(const bf16*)(ws + WS_HB1), (const bf16*)(ws + WS_WGU), MC, 2 * DFF, D}; pg8::StaticOrder S; S.init(MC, 2 * DFF, G, wgid);
        pg8::EpiGateUp E{(bf16*)(ws + WS_ACT), (const float*)(ws + WS_CTL + CTL_SS1)};
        pg8::gemm_phase<pg8::EpiGateUp, pg8::StaticOrder, true, true>(lds, g, S, E);
    } SEAM(6);
    if (IN(7)) for (int rep = 0; rep < NREP(7); ++rep) { KA A = kargs(); unsigned char* ws = A->ws;
        { pg8::Gemm g{(const bf16*)(ws + WS_ACT), (const bf16*)(ws + WS_WD), MC, D, DFF}; pg8::StaticOrder S; S.init(MC, D, G, wgid); S.lim = (S.nwg / G) * G;
          pg8::EpiDown<false> E{(const bf16*)(ws + WS_HB1), (bf16*)(ws + WS_MB)};
          pg8::gemm_phase<pg8::EpiDown<false>, pg8::StaticOrder, true, true>(lds, g, S, E); }
        { const int nstr = (MC / 256) * 4 - ((MC / 256) * 4 / G) * G;
          if (wgid < nstr * 11) { const int t = wgid / 11, koff = (wgid % 11) * 256;
            pg8::Gemm g{(const bf16*)(ws + WS_ACT) + koff, (const bf16*)(ws + WS_WD) + koff, MC, D, 256, DFF};
            pg8::SliceOrder S; S.init_slice(MC, D, G, ((MC / 256) * 4 / G) * G, t);
            pg8::EpiSplit<pg8::EpiDown<false>, false> E{pg8::EpiDown<false>{(const bf16*)(ws + WS_HB1), (bf16*)(ws + WS_MB)}, (float*)(ws + WS_SCR) + (size_t)t * 65536, (unsigned*)(ws + WS_CTL + CTL_SPL) + t * 8, 11u, nullptr, 0};
            pg8::gemm_phase<pg8::EpiSplit<pg8::EpiDown<false>, false>, pg8::SliceOrder, true, true>(lds, g, S, E); } }
    } SEAM(7);
    if (IN(8)) { KA A = kargs(); p8_final_norm(A); }
#undef IN
#undef SEAM
}

extern "C" void kernel_launch(void* const* d_in, const int* in_sizes, int n_in, void* d_out, int out_size, void* d_ws, size_t ws_size, hipStream_t stream) {
    static int grid = 0;
    if (grid == 0) {
        if (n_in != 22 || out_size != (int)O_END || ws_size < WS_END) { fprintf(stderr, "kernel_launch: unexpected problem (n_in %d, out %d, ws %zu)\n", n_in, out_size, ws_size); grid = -1; return; }
        int dev = 0, cus = 0, per_cu = 0;
        if (hipGetDevice(&dev) != hipSuccess || hipDeviceGetAttribute(&cus, hipDeviceAttributeMultiprocessorCount, dev) != hipSuccess) { grid = -1; return; }
        if (hipFuncSetAttribute((const void*)hybrid_fwd, hipFuncAttributeMaxDynamicSharedMemorySize, LDS_BYTES) != hipSuccess) { fprintf(stderr, "kernel_launch: hipFuncSetAttribute failed\n"); grid = -1; return; }
        if (hipOccupancyMaxActiveBlocksPerMultiprocessor(&per_cu, (const void*)hybrid_fwd, NTHREADS, LDS_BYTES) != hipSuccess || per_cu < 1) { fprintf(stderr, "kernel_launch: occupancy query says %d\n", per_cu); per_cu = 1; }
        (void)hipGetLastError();
        grid = cus;
        if (grid > 256) grid = 256;
    }
    if (grid < 0) return;
    (void)hipMemsetAsync((char*)d_ws + WS_CTL, 0, CTL_BYTES, stream);
    (void)hipMemsetAsync((char*)d_ws + WS_SCR, 0, SCR_BYTES, stream);
    Args a{};
    const float** ap = (const float**)&a;
    for (int i = 0; i < 22; ++i) ap[i] = (const float*)d_in[i];
    a.out = (float*)d_out; a.ws = (unsigned char*)d_ws;
#if MK_N_LAUNCHES == 1
    a.ph_lo = 0; a.ph_hi = N_PHASES;
#if MK_BARRIER == 1
    hipLaunchKernelGGL(hybrid_fwd, dim3(grid), dim3(NTHREADS), LDS_BYTES, stream, a);
#else
    void* args[] = {&a};
    hipError_t e = hipLaunchCooperativeKernel((const void*)hybrid_fwd, dim3(grid), dim3(NTHREADS), args, LDS_BYTES, stream);
    if (e != hipSuccess) fprintf(stderr, "cooperative launch failed: %s (grid %d)\n", hipGetErrorString(e), grid);
#endif
#else
    for (int p = 0; p < N_PHASES; ++p) { a.ph_lo = p; a.ph_hi = p + 1; hipLaunchKernelGGL(hybrid_fwd, dim3(grid), dim3(NTHREADS), LDS_BYTES, stream, a); }
#endif
}
```

```cpp
#include <hip/hip_runtime.h>
#include <hip/hip_cooperative_groups.h>
#include <cstdio>
#include <cstdint>
namespace cg = cooperative_groups;

#ifndef MK_N_LAUNCHES
#define MK_N_LAUNCHES 1
#endif
#ifndef MK_BARRIER
#define MK_BARRIER 1
#endif

constexpr int D = 1024, NBATCH = 8, SEQ = 4096, NMETA = 16, TP = SEQ + NMETA, MP = NBATCH * TP;
constexpr int SBATCH = 128, TS = 4, MS = SBATCH * TS, MU = MP + MS, MUP = 33536, MC = NBATCH * SEQ + MS;
constexpr int PAST = 16384;
constexpr int HD = 64, NHA = 8, NKV = 2;
constexpr int NHB = 4, CONVD = 1536;
constexpr int DFF = 2816, NIN_SRC = 4872, NIN = 4864;
constexpr float EPS = 1e-6f;
constexpr float QSCALE = 0.125f * 1.4426950408889634f;

constexpr size_t MiB = 1u << 20, KiB = 1024;
constexpr size_t WS_CTL = 0, CTL_BYTES = 1 * MiB;
constexpr size_t WS_WIN = 1 * MiB;
constexpr size_t WS_WOA = 11 * MiB, WS_WOB = 12 * MiB;
constexpr size_t WS_WOUT = 13 * MiB;
constexpr size_t WS_WGU = 15 * MiB;
constexpr size_t WS_WD = 26 * MiB;
constexpr size_t WS_ROPE = 32 * MiB;
constexpr size_t WS_GB = 34 * MiB;
constexpr size_t WS_SC = 36 * MiB;
constexpr size_t WS_SS1 = 37 * MiB, WS_SS2 = 37 * MiB + 512 * KiB;
constexpr size_t WS_SCR = 38 * MiB, SCR_BYTES = 2 * MiB;
constexpr size_t CTL_SPL6 = 53248;
constexpr size_t CTL_SPL = 49152;
constexpr size_t WS_QA = 41 * MiB;
constexpr size_t WS_KV = WS_QA + (size_t)MUP * 512 * 2;
constexpr size_t WS_QKVB = WS_KV + (size_t)MUP * 256 * 2;
constexpr size_t WS_Z = WS_QKVB + (size_t)MUP * 1536 * 2;
constexpr size_t WS_G = WS_Z + (size_t)MUP * 512 * 2;
constexpr size_t WS_GEND = WS_G + (size_t)MUP * 2048 * 2;
constexpr size_t WS_B = 353 * MiB, WS_END = 512 * MiB;
static_assert(WS_GEND <= WS_B, "ws map");
constexpr size_t WS_XN = WS_B;
constexpr size_t PREP_SLOT = 80 * KiB;
constexpr int PREP_N1 = (int)((WS_END - WS_B) / PREP_SLOT);
constexpr size_t DO_OA = 44 * MiB;
constexpr int OAB_PITCH = 1024;
constexpr size_t DO_OB = DO_OA + 512 * 2;
constexpr size_t DO_ATS = DO_OA + (size_t)MC * OAB_PITCH * 2;
constexpr size_t ATS_ITEM = 3 * 32 * 32 * 4;
static_assert(DO_ATS + 212 * 8 * ATS_ITEM <= (size_t)MC * 1024 * 4, "d_out scratch map");
constexpr size_t WS_MB = WS_B;
constexpr size_t WS_HB1 = WS_B + 66 * MiB;
static_assert(WS_HB1 + (size_t)MC * 1024 * 2 <= WS_END, "ws map");
constexpr size_t WS_ACT = WS_QA;
static_assert(WS_ACT + (size_t)MC * DFF * 2 <= WS_G, "ws map");
constexpr int SL_BEK = 0, SL_BV = 16 * 1024, SL_T = 32 * 1024, SL_QKD = 40 * 1024, SL_QE = 48 * 1024, SL_KWT = 64 * 1024;
constexpr int N_PROMPT_SEQ = NBATCH * NHB, CHUNKS_P = 65, N_ITEMS_P = N_PROMPT_SEQ * CHUNKS_P, N_ITEMS = N_ITEMS_P;
static_assert((size_t)(N_ITEMS - PREP_N1) * PREP_SLOT <= DO_OA, "prep slots");

constexpr size_t O_YP = 0, O_YS = (size_t)NBATCH * SEQ * D, O_KP = O_YS + (size_t)MS * D, O_VP = O_KP + 8 * 128 * 2 * 64, O_DP = O_VP + 8 * 128 * 2 * 64,
                 O_CP = O_DP + 8 * 4 * 128 * 128, O_KS = O_CP + 8 * 3 * 1536, O_VS = O_KS + (size_t)128 * 128 * 2 * 64, O_DS = O_VS + (size_t)128 * 128 * 2 * 64,
                 O_CS = O_DS + (size_t)128 * 4 * 128 * 128, O_END = O_CS + (size_t)128 * 3 * 1536;
static_assert(O_END == 48074752, "d_out size");

#define DI __device__ __forceinline__
#define GAS __attribute__((address_space(1)))
#define LAS __attribute__((address_space(3)))
typedef unsigned short bf16;
typedef short bf16x8 __attribute__((ext_vector_type(8)));
typedef float f32x4 __attribute__((ext_vector_type(4)));
typedef float f32x2 __attribute__((ext_vector_type(2)));
typedef float f32x16 __attribute__((ext_vector_type(16)));
typedef unsigned u32x4 __attribute__((ext_vector_type(4)));
typedef unsigned u32x2 __attribute__((ext_vector_type(2)));
typedef __bf16 bf16x2_t __attribute__((ext_vector_type(2)));

DI unsigned cvtpk(float lo, float hi) { f32x2 v = {lo, hi}; bf16x2_t b = __builtin_convertvector(v, bf16x2_t); return __builtin_bit_cast(unsigned, b); }
DI bf16 f2bf(float f) { return (bf16)(cvtpk(f, 0.f) & 0xffffu); }
DI float bf2f(unsigned short h) { return __uint_as_float((unsigned)h << 16); }
DI float bflo(unsigned w) { return __uint_as_float(w << 16); }
DI float bfhi(unsigned w) { return __uint_as_float(w & 0xffff0000u); }
DI u32x4 pack8f(f32x4 a, f32x4 b) { u32x4 w; w.x = cvtpk(a[0], a[1]); w.y = cvtpk(a[2], a[3]); w.z = cvtpk(b[0], b[1]); w.w = cvtpk(b[2], b[3]); return w; }
DI float frcp_(float x) { return __builtin_amdgcn_rcpf(x); }
DI float sigmoidf_(float x) { return frcp_(1.0f + __builtin_amdgcn_exp2f(x * -1.4426950408889634f)); }
DI float siluf_(float x) { return x * sigmoidf_(x); }
DI void st16_sc1(void* p, u32x4 v) { asm volatile("global_store_dwordx4 %0, %1, off sc1\n\ts_nop 1" :: "v"(p), "v"(v) : "memory"); }
DI void st16_sc1f(void* p, f32x4 v) { asm volatile("global_store_dwordx4 %0, %1, off sc1\n\ts_nop 1" :: "v"(p), "v"(v) : "memory"); }
DI void st2_sc1(void* p, unsigned v) { asm volatile("global_store_short %0, %1, off sc1\n\ts_nop 1" :: "v"(p), "v"(v) : "memory"); }
constexpr size_t CTL_GRAN = 65536, CTL_CNT = 245760, CTL_SS1 = 458752;
static_assert(CTL_CNT + 5 * 130 * 256 <= CTL_SS1 && CTL_SS1 + 33280 * 4 <= 1048576 && CTL_GRAN + 2592 * 64 <= CTL_CNT, "control region map");
constexpr int CNT_STRIDE = 130 * 64;
DI int pos_of_d(int d) { const int dd = d & 31; return 8 * (dd >> 2) + (dd & 3) + ((d >> 5) << 2); }
DI int d_of_pos(int p) { const int j = p & 7; return 4 * (p >> 3) + (j & 3) + ((j >> 2) << 5); }
namespace pg8 {
#define PG8_LAS __attribute__((address_space(3)))
typedef unsigned short bf16_t;
typedef short bf16x8 __attribute__((ext_vector_type(8)));
typedef float f32x4 __attribute__((ext_vector_type(4)));
typedef unsigned u32x4 __attribute__((ext_vector_type(4)));
constexpr int BM = 256, BK = 64, HALF = 128, HTB = HALF * BK * 2  , STAGE_BYTES = 8 * HTB, NXCD = 8, WGM = 8;

__host__ __device__ __forceinline__ int lds_byte(int r, int c) { const int st = (r >> 4) * 2 + (c >> 5), rr = r & 15, cc = c & 31, ob = rr * 64 + cc * 2; return st * 1024 + (ob ^ (((ob >> 9) & 1) << 5)); }
__host__ __device__ __forceinline__ void stage_rc(int b, int& R, int& C) { const int st = b / 1024, sb = b % 1024, swz = sb ^ (((sb >> 9) & 1) << 5); R = (st >> 1) * 16 + swz / 64; C = (st & 1) * 32 + (swz % 64) / 2; }
__host__ __device__ __forceinline__ int perm32(int rho) { const int n = rho >> 4, i = rho & 15; return 8 * (i >> 2) + 4 * n + (i & 3); }

struct Unit { int pm, pn; };
struct Gemm { const bf16_t* A; const bf16_t* Bt; int M, N, K; int ldk; };

struct StaticOrder {
    static constexpr bool A_SC1 = false;
    int nM, nN, nwg, G, c, lim;
    __host__ __device__ void init(int M, int N, int G_, int c_) { nM = M / BM; nN = N / BM; nwg = nM * nN; G = G_; c = c_; lim = nwg; }
    __host__ __device__ bool next(int i, Unit& u) const {
        const long L = (long)i * G + c; if (L >= lim) return false;
        int wgid = (int)L; { const int q = nwg / NXCD, r = nwg % NXCD, xcd = wgid % NXCD, off = wgid / NXCD; wgid = (xcd < r ? xcd * (q + 1) : r * (q + 1) + (xcd - r) * q) + off; }
        const int nig = WGM * nN, gid = wgid / nig, fm = gid * WGM, gsz = (nM - fm) < WGM ? (nM - fm) : WGM;
        u.pm = fm + ((wgid % nig) % gsz); u.pn = (wgid % nig) / gsz; return true;
    }
    __device__ __forceinline__ void a_ready(const Unit&) const {}
    __device__ __forceinline__ void done(const Unit&) const {}
};
struct FlagOrder : StaticOrder {
    static constexpr bool A_SC1 = true;
    const unsigned* ready; unsigned need; unsigned* pub; unsigned* gpub;
    __device__ __forceinline__ void a_ready(const Unit& u) const {
        if (ready) {
            if (threadIdx.x < 64) { unsigned spins = 0;
                while ((unsigned)__builtin_amdgcn_readfirstlane(__hip_atomic_load(ready + 64 * u.pm, __ATOMIC_RELAXED, __HIP_MEMORY_SCOPE_AGENT)) < need) { __builtin_amdgcn_s_sleep(2); if (++spins > (1u << 22)) break; } }
            asm volatile("" ::: "memory"); __builtin_amdgcn_s_barrier(); asm volatile("" ::: "memory");
        }
    }
    __device__ __forceinline__ void done(const Unit& u) const {
        if (pub) { asm volatile("s_waitcnt vmcnt(0)" ::: "memory");
            if ((threadIdx.x & 63) == 0) { __hip_atomic_fetch_add(pub + 64 * u.pm, 1u, __ATOMIC_RELAXED, __HIP_MEMORY_SCOPE_AGENT); if (gpub) __hip_atomic_fetch_add(gpub, 1u, __ATOMIC_RELAXED, __HIP_MEMORY_SCOPE_AGENT); } }
    }
};
struct SliceOrder : StaticOrder {
    int t;
    __host__ __device__ void init_slice(int M, int N, int G_, int first, int t_) { init(M, N, G_, 0); t = t_; c = first + t_; G = 0; }
    __host__ __device__ bool next(int i, Unit& u) const { return i == 0 ? StaticOrder::next(0, u) : false; }
};

__device__ __forceinline__ void urow_info(int urow, int& kind, int& b, int& t, int& ridx) {
    if (urow < MP) { b = urow / TP; t = urow - b * TP; kind = 0; ridx = t; }
    else if (urow < MU) { const int s = urow - MP; b = s >> 2; t = s & 3; kind = 1; ridx = TP + t; }
    else { kind = 2; b = 0; t = 0; ridx = 0; }
}
__device__ __forceinline__ int crow_to_urow(int crow) { return crow < NBATCH * SEQ ? crow + NMETA * ((crow >> 12) + 1) : MP + (crow - NBATCH * SEQ); }

struct EpiInProj {
    static constexpr bool PERM = true, AFTER_DRAIN = false;
    bf16_t *QA, *KV, *QKVB, *Z, *G; const float *COS, *SIN; float* out;
    __device__ __forceinline__ void operator()(const f32x4 (&acc)[2][2][4][2], const Unit& u, int wr, int wc, int fr, int fq) const {
        const int pn = u.pn;
#pragma unroll
        for (int ai = 0; ai < 2; ++ai)
#pragma unroll
            for (int m = 0; m < 4; ++m) {
                const int row = u.pm * BM + ai * HALF + wr * 64 + m * 16 + fr;
                int kind, b, t, ridx; urow_info(row, kind, b, t, ridx);
#pragma unroll
                for (int bj = 0; bj < 2; ++bj) {
                    const int cl = bj * HALF + wc * 32 + 8 * fq;
                    const f32x4 v0 = acc[ai][bj][m][0], v1 = acc[ai][bj][m][1];
                    if (pn < 2) {
                        const int c = pn * 256 + cl, d0 = ((c & 63) >> 3) * 4;
                        const f32x4 cs = *(const f32x4*)(COS + ridx * 32 + d0), sn = *(const f32x4*)(SIN + ridx * 32 + d0);
                        const f32x4 o1 = (v0 * cs - v1 * sn) * QSCALE, o2 = (v1 * cs + v0 * sn) * QSCALE;
                        *(u32x4*)(QA + (size_t)row * 512 + c) = pack8f(o1, o2);
                    } else if (pn == 2) {
                        if (bj == 0) {
                            const int kh = cl >> 6, d0 = ((cl & 63) >> 3) * 4;
                            const f32x4 cs = *(const f32x4*)(COS + ridx * 32 + d0), sn = *(const f32x4*)(SIN + ridx * 32 + d0);
                            const f32x4 o1 = v0 * cs - v1 * sn, o2 = v1 * cs + v0 * sn;
                            *(u32x4*)(KV + (size_t)row * 256 + cl) = pack8f(o1, o2);
                            float* dst = nullptr;
                            if (kind == 0 && t >= TP - 128) dst = out + O_KP + ((size_t)(b * 128 + (t - (TP - 128))) * 2 + kh) * 64;
                            else if (kind == 1) dst = out + O_KS + ((size_t)(b * 128 + 124 + t) * 2 + kh) * 64;
                            if (dst) { *(f32x4*)(dst + d0) = o1; *(f32x4*)(dst + 32 + d0) = o2; }
                        } else {
                            const int cv = cl - 128, kh = cv >> 6, dd = cv & 63;
                            *(u32x4*)(KV + (size_t)row * 256 + cl) = pack8f(v0, v1);
                            float* dst = nullptr;
                            if (kind == 0 && t >= TP - 128) dst = out + O_VP + ((size_t)(b * 128 + (t - (TP - 128))) * 2 + kh) * 64;
                            else if (kind == 1) dst = out + O_VS + ((size_t)(b * 128 + 124 + t) * 2 + kh) * 64;
                            if (dst) { *(f32x4*)(dst + dd) = v0; *(f32x4*)(dst + dd + 4) = v1; }
                        }
                    } else if (pn < 9) {
                        const int c = (pn - 3) * 256 + cl;
                        *(u32x4*)(QKVB + (size_t)row * 1536 + c) = pack8f(v0, v1);
                        float* dst = nullptr;
                        if (kind == 0 && t >= TP - 3) dst = out + O_CP + ((size_t)b * 3 + (t - (TP - 3))) * 1536;
                        else if (kind == 1 && t >= 1) dst = out + O_CS + ((size_t)b * 3 + (t - 1)) * 1536;
                        if (dst) { *(f32x4*)(dst + c) = v0; *(f32x4*)(dst + c + 4) = v1; }
                    } else if (pn < 11) {
                        const int c = (pn - 9) * 256 + cl;
                        *(u32x4*)(Z + (size_t)row * 512 + c) = pack8f(v0, v1);
                    } else {
                        const int c = (pn - 11) * 256 + cl;
                        f32x4 g0, g1;
#pragma unroll
                        for (int e = 0; e < 4; ++e) { g0[e] = sigmoidf_(v0[e]); g1[e] = sigmoidf_(v1[e]); }
                        *(u32x4*)(G + (size_t)row * 2048 + c) = pack8f(g0, g1);
                    }
                }
            }
    }
};

template <bool ACCUM> struct EpiMerge {
    static constexpr bool PERM = true, AFTER_DRAIN = false;
    bf16_t* MBp; const bf16_t* G; int gate_off;
    __device__ __forceinline__ void operator()(const f32x4 (&acc)[2][2][4][2], const Unit& u, int wr, int wc, int fr, int fq) const {
#pragma unroll
        for (int ai = 0; ai < 2; ++ai)
#pragma unroll
            for (int m = 0; m < 4; ++m) {
                const int crow = u.pm * BM + ai * HALF + wr * 64 + m * 16 + fr, urow = crow_to_urow(crow);
#pragma unroll
                for (int bj = 0; bj < 2; ++bj) {
                    const int c = u.pn * BM + bj * HALF + wc * 32 + 8 * fq;
                    const u32x4 gw = *(const u32x4*)(G + (size_t)urow * 2048 + gate_off + c);
                    f32x4 v0 = acc[ai][bj][m][0], v1 = acc[ai][bj][m][1];
                    v0[0] *= bflo(gw.x); v0[1] *= bfhi(gw.x); v0[2] *= bflo(gw.y); v0[3] *= bfhi(gw.y);
                    v1[0] *= bflo(gw.z); v1[1] *= bfhi(gw.z); v1[2] *= bflo(gw.w); v1[3] *= bfhi(gw.w);
                    bf16_t* p = MBp + (size_t)crow * 1024 + c;
                    if (ACCUM) { const u32x4 pw = *(const u32x4*)p;
                        v0[0] += bflo(pw.x); v0[1] += bfhi(pw.x); v0[2] += bflo(pw.y); v0[3] += bfhi(pw.y);
                        v1[0] += bflo(pw.z); v1[1] += bfhi(pw.z); v1[2] += bflo(pw.w); v1[3] += bfhi(pw.w); }
                    *(u32x4*)p = pack8f(v0, v1);
                }
            }
    }
};

template <bool ATOM = true> struct EpiWout {
    static constexpr bool PERM = true, AFTER_DRAIN = false;
    const float* xp; const float* xs; bf16_t* HB; float* SS;
    __device__ __forceinline__ void operator()(const f32x4 (&acc)[2][2][4][2], const Unit& u, int wr, int wc, int fr, int fq) const {
#pragma unroll
        for (int ai = 0; ai < 2; ++ai)
#pragma unroll
            for (int m = 0; m < 4; ++m) {
                const int crow = u.pm * BM + ai * HALF + wr * 64 + m * 16 + fr;
                const float* hs = crow < NBATCH * SEQ ? xp + (size_t)crow * D : xs + (size_t)(crow - NBATCH * SEQ) * D;
                float ss = 0.f;
#pragma unroll
                for (int bj = 0; bj < 2; ++bj) {
                    const int c = u.pn * BM + bj * HALF + wc * 32 + 8 * fq;
                    const f32x4 r0 = *(const f32x4*)(hs + c) + acc[ai][bj][m][0], r1 = *(const f32x4*)(hs + c + 4) + acc[ai][bj][m][1];
                    *(u32x4*)(HB + (size_t)crow * D + c) = pack8f(r0, r1);
                    ss += (r0[0] * r0[0] + r0[1] * r0[1]) + (r0[2] * r0[2] + r0[3] * r0[3]) + (r1[0] * r1[0] + r1[1] * r1[1]) + (r1[2] * r1[2] + r1[3] * r1[3]);
                }
                ss += __shfl_xor(ss, 16); ss += __shfl_xor(ss, 32);
                if (ATOM && fq == 0) atomicAdd(SS + crow, ss);
            }
    }
};

struct EpiGateUp {
    static constexpr bool PERM = true, AFTER_DRAIN = false;
    bf16_t* ACT; const float* SS;
    __device__ __forceinline__ void operator()(const f32x4 (&acc)[2][2][4][2], const Unit& u, int wr, int wc, int fr, int fq) const {
#pragma unroll
        for (int ai = 0; ai < 2; ++ai)
#pragma unroll
            for (int m = 0; m < 4; ++m) {
                const int crow = u.pm * BM + ai * HALF + wr * 64 + m * 16 + fr;
                const float rstd = rsqrtf(SS[crow] * (1.0f / D) + EPS);
                f32x4 a[2];
#pragma unroll
                for (int n = 0; n < 2; ++n)
#pragma unroll
                    for (int e = 0; e < 4; ++e) { const float g = acc[ai][0][m][n][e] * rstd, up = acc[ai][1][m][n][e] * rstd; a[n][e] = siluf_(g) * up; }
                *(u32x4*)(ACT + (size_t)crow * DFF + u.pn * HALF + wc * 32 + 8 * fq) = pack8f(a[0], a[1]);
            }
    }
};

template <bool DRY = false> struct EpiDown {
    static constexpr bool PERM = true, AFTER_DRAIN = false;
    const bf16_t* HB; bf16_t* H2;
    __device__ __forceinline__ void operator()(const f32x4 (&acc)[2][2][4][2], const Unit& u, int wr, int wc, int fr, int fq) const {
#pragma unroll
        for (int ai = 0; ai < 2; ++ai)
#pragma unroll
            for (int m = 0; m < 4; ++m) {
                const int crow = u.pm * BM + ai * HALF + wr * 64 + m * 16 + fr;
#pragma unroll
                for (int bj = 0; bj < 2; ++bj) {
                    const size_t off = (size_t)crow * D + u.pn * BM + bj * HALF + wc * 32 + 8 * fq;
                    const u32x4 hw = *(const u32x4*)(HB + off);
                    f32x4 r0 = acc[ai][bj][m][0], r1 = acc[ai][bj][m][1];
                    r0[0] += bflo(hw.x); r0[1] += bfhi(hw.x); r0[2] += bflo(hw.y); r0[3] += bfhi(hw.y);
                    r1[0] += bflo(hw.z); r1[1] += bfhi(hw.z); r1[2] += bflo(hw.w); r1[3] += bfhi(hw.w);
                    *(u32x4*)(H2 + off) = pack8f(r0, r1);
                }
            }
    }
};

template <class Inner, bool GATED = false> struct EpiSplit {
    static constexpr bool PERM = Inner::PERM, AFTER_DRAIN = false;
    Inner inner; float* scr; unsigned* cnt; unsigned S; const bf16_t* G; int gate_off;
    __device__ __forceinline__ void operator()(const f32x4 (&acc_)[2][2][4][2], const Unit& u, int wr, int wc, int fr, int fq) const {
        f32x4 (&acc)[2][2][4][2] = const_cast<f32x4 (&)[2][2][4][2]>(acc_);
        const int lane = fr + 16 * fq, wave = wr * 4 + wc;
        float* p = scr + (size_t)wave * 8192 + lane;
#pragma unroll
        for (int ai = 0; ai < 2; ++ai)
#pragma unroll
            for (int m = 0; m < 4; ++m) {
                int urow = 0;
                if (GATED) urow = crow_to_urow(u.pm * BM + ai * HALF + wr * 64 + m * 16 + fr);
#pragma unroll
                for (int bj = 0; bj < 2; ++bj) {
                    f32x4 v0 = acc[ai][bj][m][0], v1 = acc[ai][bj][m][1];
                    if (GATED) { const u32x4 gw = *(const u32x4*)(G + (size_t)urow * 2048 + gate_off + u.pn * BM + bj * HALF + wc * 32 + 8 * fq);
                        v0[0] *= bflo(gw.x); v0[1] *= bfhi(gw.x); v0[2] *= bflo(gw.y); v0[3] *= bfhi(gw.y); v1[0] *= bflo(gw.z); v1[1] *= bfhi(gw.z); v1[2] *= bflo(gw.w); v1[3] *= bfhi(gw.w); }
                    float* q = p + (((ai * 2 + bj) * 4 + m) * 8) * 64;
                    asm volatile("" : "+v"(q));
#pragma unroll
                    for (int x = 0; x < 4; ++x) { unsafeAtomicAdd(q + x * 64, v0[x]); unsafeAtomicAdd(q + (4 + x) * 64, v1[x]); }
                }
            }
        asm volatile("s_waitcnt vmcnt(0)" ::: "memory");
        unsigned old = 0u;
        if (lane == 0) old = __hip_atomic_fetch_add(cnt + wave, 1u, __ATOMIC_RELAXED, __HIP_MEMORY_SCOPE_AGENT);
        old = (unsigned)__builtin_amdgcn_readfirstlane((int)old);
        if (old == S - 1u) {
#pragma unroll
            for (int ai = 0; ai < 2; ++ai)
#pragma unroll
                for (int bj = 0; bj < 2; ++bj)
#pragma unroll
                    for (int m = 0; m < 4; ++m) {
                        float* q = p + (((ai * 2 + bj) * 4 + m) * 8) * 64;
                        asm volatile("" : "+v"(q));
#pragma unroll
                        for (int n = 0; n < 2; ++n)
#pragma unroll
                            for (int x = 0; x < 4; ++x) acc[ai][bj][m][n][x] = __hip_atomic_exchange(q + (n * 4 + x) * 64, 0.0f, __ATOMIC_RELAXED, __HIP_MEMORY_SCOPE_AGENT);
                    }
            if (lane == 0) __hip_atomic_store(cnt + wave, 0u, __ATOMIC_RELAXED, __HIP_MEMORY_SCOPE_AGENT);
            inner(acc, u, wr, wc, fr, fq);
        }
    }
};
struct EpiStoreMB {
    static constexpr bool PERM = true, AFTER_DRAIN = false;
    bf16_t* MBp;
    __device__ __forceinline__ void operator()(const f32x4 (&acc)[2][2][4][2], const Unit& u, int wr, int wc, int fr, int fq) const {
#pragma unroll
        for (int ai = 0; ai < 2; ++ai)
#pragma unroll
            for (int m = 0; m < 4; ++m) {
                const int crow = u.pm * BM + ai * HALF + wr * 64 + m * 16 + fr;
#pragma unroll
                for (int bj = 0; bj < 2; ++bj) *(u32x4*)(MBp + (size_t)crow * 1024 + u.pn * BM + bj * HALF + wc * 32 + 8 * fq) = pack8f(acc[ai][bj][m][0], acc[ai][bj][m][1]);
            }
    }
};

template <class Epi, class Sched, bool ALIGN_EPI = false, bool SP2 = false>
__device__ __forceinline__ void gemm_phase(PG8_LAS unsigned char* lds, const Gemm g, const Sched& S, const Epi& E) {
    const int tid = threadIdx.x, wid = __builtin_amdgcn_readfirstlane(tid >> 6), lane = tid & 63, wr = wid >> 2, wc = wid & 3, fr = lane & 15, fq = lane >> 4;
    const int K = g.ldk ? g.ldk : g.K, nt = g.K / BK;
    unsigned voffA[2], voffB[2];
#pragma unroll
    for (int i = 0; i < 2; ++i) { int R, C; stage_rc(tid * 16 + i * 8192, R, C); const int Rb = Epi::PERM ? ((R & ~31) + perm32(R & 31)) : R;
        voffA[i] = (unsigned)(R * K + C) * 2u; voffB[i] = (unsigned)(Rb * K + C) * 2u; }
    const size_t kstep = (size_t)(BK * 2);
    const size_t hstep = (size_t)HALF * K * 2;
    const size_t tstep = 2 * hstep;
    const unsigned ldsw = (unsigned)wid * 1024u;
    const int aoff = lds_byte(wr * 64 + fr, fq * 8), boff = lds_byte(wc * 32 + fr, fq * 8);
#define PG8_SA(b, h) (((b) * 2 + (h)) * HTB)
#define PG8_SB(b, h) ((4 + (b) * 2 + (h)) * HTB)
#define PG8_STAGE(bufoff, gbase, voff) do { _Pragma("unroll") for (int _i = 0; _i < 2; ++_i) \
        __builtin_amdgcn_global_load_lds((const unsigned*)((const char*)(gbase) + (voff)[_i]), (PG8_LAS unsigned*)(lds + (bufoff) + ldsw + _i * 8192), 16, 0, 0); } while (0)
#define PG8_STAGE_A(bufoff, gbase, voff) do { _Pragma("unroll") for (int _i = 0; _i < 2; ++_i) { \
        if constexpr (Sched::A_SC1) __builtin_amdgcn_global_load_lds((const unsigned*)((const char*)(gbase) + (voff)[_i]), (PG8_LAS unsigned*)(lds + (bufoff) + ldsw + _i * 8192), 16, 0, 16); \
        else __builtin_amdgcn_global_load_lds((const unsigned*)((const char*)(gbase) + (voff)[_i]), (PG8_LAS unsigned*)(lds + (bufoff) + ldsw + _i * 8192), 16, 0, 0); } } while (0)
#define PG8_LDA(dst, b, h) do { _Pragma("unroll") for (int m = 0; m < 4; ++m) _Pragma("unroll") for (int k = 0; k < 2; ++k) dst[m][k] = *(const PG8_LAS bf16x8*)(lds + PG8_SA(b, h) + aoff + m * 2048 + k * 1024); } while (0)
#define PG8_LDB(dst, b, h) do { _Pragma("unroll") for (int n = 0; n < 2; ++n) _Pragma("unroll") for (int k = 0; k < 2; ++k) dst[n][k] = *(const PG8_LAS bf16x8*)(lds + PG8_SB(b, h) + boff + n * 2048 + k * 1024); } while (0)
#define PG8_MMA(ai, bj, At, Bt) do { __builtin_amdgcn_s_setprio(1); _Pragma("unroll") for (int m = 0; m < 4; ++m) _Pragma("unroll") for (int n = 0; n < 2; ++n) _Pragma("unroll") for (int k = 0; k < 2; ++k) \
        acc[ai][bj][m][n] = __builtin_amdgcn_mfma_f32_16x16x32_bf16(Bt[n][k], At[m][k], acc[ai][bj][m][n], 0, 0, 0); __builtin_amdgcn_s_setprio(0); } while (0)
#define PG8_WAIT_V(n) asm volatile("s_waitcnt vmcnt(" #n ")" ::: "memory")
#define PG8_WAIT_L(n) asm volatile("s_waitcnt lgkmcnt(" #n ")" ::: "memory")
#define PG8_BAR __builtin_amdgcn_s_barrier()
#define PG8_SCHED __builtin_amdgcn_sched_barrier(0)
    Unit cur, nxt; int ui = 0;
    if (!S.next(0, cur)) return;
    f32x4 acc[2][2][4][2];
#pragma unroll
    for (int a = 0; a < 2; ++a)
#pragma unroll
        for (int b = 0; b < 2; ++b)
#pragma unroll
            for (int m = 0; m < 4; ++m)
#pragma unroll
                for (int n = 0; n < 2; ++n) acc[a][b][m][n] = (f32x4){0.f, 0.f, 0.f, 0.f};
    bf16x8 At[4][2], B0[2][2], B1[2][2];
    const char* cA = (const char*)g.A + (size_t)cur.pm * tstep; const char* cB = (const char*)g.Bt + (size_t)cur.pn * tstep;
    S.a_ready(cur);
    if constexpr (SP2) {
        PG8_STAGE(PG8_SB(0, 0), cB, voffB); PG8_STAGE(PG8_SB(0, 1), cB + hstep, voffB); PG8_STAGE_A(PG8_SA(0, 0), cA, voffA); PG8_STAGE_A(PG8_SA(0, 1), cA + hstep, voffA);
        if (wr == 1) PG8_BAR;
        PG8_WAIT_V(2); PG8_BAR;
        PG8_STAGE(PG8_SB(1, 0), cB + kstep, voffB); PG8_STAGE_A(PG8_SA(1, 0), cA + kstep, voffA); PG8_STAGE(PG8_SB(1, 1), cB + hstep + kstep, voffB);
        PG8_WAIT_V(6); PG8_BAR;
    } else {
        PG8_STAGE(PG8_SB(0, 0), cB, voffB); PG8_STAGE_A(PG8_SA(0, 0), cA, voffA); PG8_STAGE(PG8_SB(0, 1), cB + hstep, voffB); PG8_STAGE_A(PG8_SA(0, 1), cA + hstep, voffA);
        if (wr == 1) PG8_BAR;
        PG8_WAIT_V(4); PG8_BAR;
        PG8_STAGE(PG8_SB(1, 0), cB + kstep, voffB); PG8_STAGE_A(PG8_SA(1, 0), cA + kstep, voffA); PG8_STAGE(PG8_SB(1, 1), cB + hstep + kstep, voffB);
        PG8_WAIT_V(6); PG8_BAR;
    }
    for (;;) {
        const bool has_next = S.next(ui + 1, nxt);
        const char* nA = has_next ? (const char*)g.A + (size_t)nxt.pm * tstep : cA; const char* nB = has_next ? (const char*)g.Bt + (size_t)nxt.pn * tstep : cB;
        for (int t = 0; t < nt; t += 2) {
            const bool last = (t == nt - 2);
            const char* a1 = cA + (size_t)(t + 1) * kstep;
            const char* a2 = last ? nA : cA + (size_t)(t + 2) * kstep; const char* b2 = last ? nB : cB + (size_t)(t + 2) * kstep;
            const char* a3 = a2 + kstep; const char* b3 = b2 + kstep;
            if (last && has_next) S.a_ready(nxt);
            if constexpr (SP2) {
            PG8_LDB(B0, 0, 0); PG8_LDB(B1, 0, 1); PG8_SCHED; PG8_LDA(At, 0, 0); PG8_STAGE_A(PG8_SA(1, 1), a1 + hstep, voffA);
            PG8_WAIT_V(8); PG8_WAIT_L(0); PG8_BAR; PG8_MMA(0, 0, At, B0); PG8_MMA(0, 1, At, B1); PG8_BAR; PG8_SCHED;
            PG8_LDA(At, 0, 1); PG8_STAGE(PG8_SB(0, 0), b2, voffB); PG8_STAGE(PG8_SB(0, 1), b2 + hstep, voffB); PG8_STAGE_A(PG8_SA(0, 0), a2, voffA);
            PG8_WAIT_V(8); PG8_WAIT_L(0); PG8_BAR; PG8_MMA(1, 0, At, B0); PG8_MMA(1, 1, At, B1); PG8_BAR; PG8_SCHED;
            PG8_LDB(B0, 1, 0); PG8_LDB(B1, 1, 1); PG8_SCHED; PG8_LDA(At, 1, 0); PG8_STAGE_A(PG8_SA(0, 1), a2 + hstep, voffA);
            PG8_WAIT_V(8); PG8_WAIT_L(0); PG8_BAR; PG8_MMA(0, 0, At, B0); PG8_MMA(0, 1, At, B1); PG8_BAR; PG8_SCHED;
            PG8_LDA(At, 1, 1); PG8_STAGE(PG8_SB(1, 0), b3, voffB); PG8_STAGE(PG8_SB(1, 1), b3 + hstep, voffB); PG8_STAGE_A(PG8_SA(1, 0), a3, voffA);
            PG8_WAIT_V(8); PG8_WAIT_L(0); PG8_BAR; PG8_MMA(1, 0, At, B0); PG8_MMA(1, 1, At, B1); PG8_BAR; PG8_SCHED;
            } else {
            PG8_LDB(B0, 0, 0); PG8_SCHED; PG8_LDA(At, 0, 0); PG8_STAGE_A(PG8_SA(1, 1), a1 + hstep, voffA);
            PG8_WAIT_L(8); PG8_BAR; PG8_WAIT_L(0); PG8_MMA(0, 0, At, B0); PG8_BAR; PG8_SCHED;
            PG8_LDB(B1, 0, 1); PG8_STAGE(PG8_SB(0, 0), b2, voffB);
            PG8_BAR; PG8_WAIT_L(0); PG8_MMA(0, 1, At, B1); PG8_BAR;
            PG8_LDA(At, 0, 1); PG8_STAGE_A(PG8_SA(0, 0), a2, voffA);
            PG8_BAR; PG8_WAIT_L(0); PG8_MMA(1, 0, At, B0); PG8_BAR; PG8_SCHED;
            PG8_STAGE(PG8_SB(0, 1), b2 + hstep, voffB);
            PG8_WAIT_V(6); PG8_BAR; PG8_MMA(1, 1, At, B1); PG8_BAR;
            PG8_LDB(B0, 1, 0); PG8_SCHED; PG8_LDA(At, 1, 0); PG8_STAGE_A(PG8_SA(0, 1), a2 + hstep, voffA);
            PG8_WAIT_L(8); PG8_BAR; PG8_WAIT_L(0); PG8_MMA(0, 0, At, B0); PG8_BAR; PG8_SCHED;
            PG8_LDB(B1, 1, 1); PG8_STAGE(PG8_SB(1, 0), b3, voffB);
            PG8_BAR; PG8_WAIT_L(0); PG8_MMA(0, 1, At, B1); PG8_BAR;
            PG8_LDA(At, 1, 1); PG8_STAGE_A(PG8_SA(1, 0), a3, voffA);
            PG8_BAR; PG8_WAIT_L(0); PG8_MMA(1, 0, At, B0); PG8_BAR; PG8_SCHED;
            PG8_STAGE(PG8_SB(1, 1), b3 + hstep, voffB);
            PG8_WAIT_V(6); PG8_BAR; PG8_MMA(1, 1, At, B1); PG8_BAR;
            }
        }
        if constexpr (ALIGN_EPI) { if (wr == 0) PG8_BAR; }
        if constexpr (!Epi::AFTER_DRAIN) { E(acc, cur, wr, wc, fr, fq); S.done(cur); }
        if (!has_next) break;
#pragma unroll
        for (int a = 0; a < 2; ++a)
#pragma unroll
            for (int b = 0; b < 2; ++b)
#pragma unroll
                for (int m = 0; m < 4; ++m)
#pragma unroll
                    for (int n = 0; n < 2; ++n) acc[a][b][m][n] = (f32x4){0.f, 0.f, 0.f, 0.f};
        cur = nxt; cA = nA; cB = nB; ++ui;
        if constexpr (ALIGN_EPI) { if (wr == 1) PG8_BAR; }
    }
    PG8_WAIT_V(0);
    if constexpr (!ALIGN_EPI) { if (wr == 0) PG8_BAR; }
    PG8_BAR;
    if constexpr (Epi::AFTER_DRAIN) { E.fused(acc, cur, wr, wc, fr, fq, lds, wid, lane); S.done(cur); }
#undef PG8_SA
#undef PG8_SB
#undef PG8_STAGE
#undef PG8_STAGE_A
#undef PG8_LDA
#undef PG8_LDB
#undef PG8_MMA
#undef PG8_WAIT_V
#undef PG8_WAIT_L
#undef PG8_BAR
#undef PG8_SCHED
}
}
constexpr int NWAVES = 8, NTHREADS = NWAVES * 64;
constexpr int LDS_BYTES = 147456;
constexpr int LDS_MISC = 131072;
constexpr int N_PHASES = 9;

struct Args {
    const float *x_prompt, *x_sample, *cache_k, *cache_v, *state_delta, *state_conv, *meta, *norm_mix, *w_in, *conv_w, *a_log, *dt_bias, *sinks, *gdn_norm,
                *w_oa, *w_ob, *w_out, *norm_ffn, *w_gate, *w_up, *w_down, *norm_final;
    float* out; unsigned char* ws; int ph_lo, ph_hi;
};

typedef const __attribute__((address_space(4))) Args* KA;
DI KA kargs() { KA p = (KA)__builtin_amdgcn_kernarg_segment_ptr(); asm volatile("" : "+s"(p)); return p; }
#define RLX_AGENT __ATOMIC_RELAXED, __HIP_MEMORY_SCOPE_AGENT
#define LDS_WAIT() asm volatile("s_waitcnt lgkmcnt(0)" ::: "memory")
#define MFMA32(a, b, c) __builtin_amdgcn_mfma_f32_32x32x16_bf16((a), (b), (c), 0, 0, 0)
DI int crow16(int reg, int h) { return (reg & 3) + 8 * (reg >> 2) + 4 * h; }
DI float wave_sum(float v) {
#pragma unroll
    for (int o = 1; o < 64; o <<= 1) v += __shfl_xor(v, o);
    return v;
}
DI float wave_max(float v) {
#pragma unroll
    for (int o = 1; o < 64; o <<= 1) v = fmaxf(v, __shfl_xor(v, o));
    return v;
}
template <int S> DI bf16x8 pack_step(const f32x16& x) {
    u32x4 p; p.x = cvtpk(x[8 * S], x[8 * S + 1]); p.y = cvtpk(x[8 * S + 2], x[8 * S + 3]); p.z = cvtpk(x[8 * S + 4], x[8 * S + 5]); p.w = cvtpk(x[8 * S + 6], x[8 * S + 7]);
    return __builtin_bit_cast(bf16x8, p);
}
DI int frag_idx(int row, int k, int NKS) { const int kkk = k & 15; return (((row >> 5) * NKS + (k >> 4)) * 64 + (row & 31) + 32 * ((kkk >> 2) & 1)) * 8 + (((kkk >> 3) << 2) | (kkk & 3)); }
DI unsigned char* slot_ptr(KA A, int item) { return item < PREP_N1 ? A->ws + WS_B + (size_t)item * PREP_SLOT : (unsigned char*)A->out + (size_t)(item - PREP_N1) * PREP_SLOT; }

#define XB_TMO      128
#define XB_XCNT(j)  (256  + 64 * (j))
#define XB_XSUB(j)  (1280 + 64 * (j))
#define XB_XGEN(j)  (2304 + 64 * (j))
#define XB_TOP      3328
#define XB_TOPGEN   3392
#define XCD_BAR_WORDS 3456
#define XB_SPIN_CAP (1u << 20)
DI unsigned xb_ld(unsigned* p)              { return __hip_atomic_load(p, __ATOMIC_RELAXED, __HIP_MEMORY_SCOPE_AGENT); }
DI unsigned xb_add(unsigned* p, unsigned v) { return __hip_atomic_fetch_add(p, v, __ATOMIC_RELAXED, __HIP_MEMORY_SCOPE_AGENT); }
DI unsigned xb_xcc_id() { return (unsigned)__builtin_amdgcn_s_getreg((3 << 11) | 20) & 0xFu; }
#define XB_SPIN(cond, bar) do { unsigned _sp = 0; while (cond) { __builtin_amdgcn_s_sleep(1); \
    if ((++_sp & 255u) == 0u) { if (xb_ld(&(bar)[XB_TMO])) break; if (_sp > XB_SPIN_CAP) { atomicAdd(&(bar)[XB_TMO], 1u); break; } } } } while (0)
struct XcdBarrier { unsigned* bar; unsigned x; volatile LAS unsigned* st; };
DI XcdBarrier xcd_barrier_post(unsigned* bar, volatile LAS unsigned* st) {
    XcdBarrier b; b.bar = bar; b.x = xb_xcc_id(); b.st = st;
    if (threadIdx.x == 0) (void)xb_add(&bar[XB_XCNT(b.x)], 1u);
    return b;
}
DI void xcd_barrier_complete(unsigned* bar, unsigned x, unsigned& nloc, unsigned& nx) {
    const unsigned G = gridDim.x * gridDim.y * gridDim.z;
    unsigned sum, cnt, mine, sp = 0u;
    for (;;) {
        sum = 0u; cnt = 0u; mine = 0u;
#pragma unroll
        for (unsigned j = 0; j < 16; ++j) { const unsigned c = xb_ld(&bar[XB_XCNT(j)]); sum += c; cnt += (c > 0u) ? 1u : 0u; mine = (j == x) ? c : mine; }
        if (sum == G) break;
        __builtin_amdgcn_s_sleep(1);
        if ((++sp & 255u) == 0u) { if (xb_ld(&bar[XB_TMO])) break; if (sp > XB_SPIN_CAP) { atomicAdd(&bar[XB_TMO], 1u); break; } }
    }
    nloc = mine > 0u ? mine : 1u; nx = cnt > 0u ? cnt : 1u;
}
DI void xcd_barrier(const XcdBarrier& b) {
    asm volatile("s_waitcnt vmcnt(0)" ::: "memory");
    __syncthreads();
    if (threadIdx.x == 0) {
        unsigned* bar = b.bar;
        __builtin_amdgcn_s_waitcnt(0);
        unsigned nloc = b.st[0], nx = b.st[1];
        if (nloc == 0u) { xcd_barrier_complete(bar, b.x, nloc, nx); b.st[0] = nloc; b.st[1] = nx; }
        const unsigned old = xb_add(&bar[XB_XSUB(b.x)], 1u);
        const unsigned gen = old / nloc;
        if (old + 1u == (gen + 1u) * nloc) {
            __builtin_amdgcn_fence(__ATOMIC_RELEASE, "agent");
            asm volatile("s_waitcnt vmcnt(0)" ::: "memory");
            const unsigned og = xb_add(&bar[XB_TOP], 1u);
            const unsigned tg = og / nx;
            if (og + 1u == (tg + 1u) * nx) xb_add(&bar[XB_TOPGEN], 1u);
            else XB_SPIN(xb_ld(&bar[XB_TOPGEN]) == tg, bar);
            __builtin_amdgcn_fence(__ATOMIC_ACQUIRE, "agent");
            xb_add(&bar[XB_XGEN(b.x)], 1u);
            asm volatile("s_waitcnt vmcnt(0)" ::: "memory");
        } else {
            XB_SPIN(xb_ld(&bar[XB_XGEN(b.x)]) == gen, bar);
            __builtin_amdgcn_fence(__ATOMIC_ACQUIRE, "agent");
            asm volatile("s_waitcnt vmcnt(0)" ::: "memory");
        }
    }
    __syncthreads();
}

template <class RowMap> DI void transpose_item(const float* W, int K, int N, bf16* WT, RowMap rm, const float* kscale, LAS float* scr, int item, int lane, int ldw = 0) {
    if (ldw == 0) ldw = K;
    const int nblk = (N + 31) / 32, kb = item / nblk, nb = item - kb * nblk, k0 = 64 * kb, n0 = 32 * nb;
    const int n4 = n0 + (lane & 7) * 4;
    f32x4 v[8];
#pragma unroll
    for (int i = 0; i < 8; ++i) { const int kk = 8 * i + (lane >> 3);
        v[i] = n4 < N ? *(const f32x4*)(W + (size_t)(k0 + kk) * N + n4) : (f32x4){0.f, 0.f, 0.f, 0.f}; }
#pragma unroll
    for (int i = 0; i < 8; ++i) { const int kk = 8 * i + (lane >> 3);
        if (kscale) v[i] = v[i] * kscale[k0 + kk];
        LAS float* d = scr + kk * 33 + (lane & 7) * 4; d[0] = v[i][0]; d[1] = v[i][1]; d[2] = v[i][2]; d[3] = v[i][3]; }
    LDS_WAIT(); asm volatile("" ::: "memory");
    const int c = lane & 7;
#pragma unroll
    for (int j = 0; j < 4; ++j) { const int n = (lane >> 3) + 8 * j; const LAS float* s = scr + (8 * c) * 33 + n;
        const int nsrc = n0 + n; const int drow = nsrc < N ? rm(nsrc) : -1;
        u32x4 o; o.x = cvtpk(s[0 * 33], s[1 * 33]); o.y = cvtpk(s[2 * 33], s[3 * 33]); o.z = cvtpk(s[4 * 33], s[5 * 33]); o.w = cvtpk(s[6 * 33], s[7 * 33]);
        if (drow >= 0) *(u32x4*)(WT + (size_t)drow * ldw + k0 + 8 * c) = o; }
    LDS_WAIT(); asm volatile("" ::: "memory");
}
DI float softplusf_(float x) { return x > 20.f ? x : log1pf(__expf(x)); }

#ifndef PROBE_REP
#define PROBE_REP -1
#endif
#ifndef P0_ROW_WAVES
#define P0_ROW_WAVES 4
#endif
DI void p0_prologue(KA A, LAS unsigned char* lds) {
    const int tid = threadIdx.x, lane = tid & 63, wave = __builtin_amdgcn_readfirstlane(tid >> 6);
    const int G = gridDim.x;
    constexpr int NR = P0_ROW_WAVES, NT = NWAVES - NR;
    const bool rowrole = wave < NR;
    const int gw = rowrole ? blockIdx.x * NR + wave : blockIdx.x * NT + (wave - NR), NGW = G * (rowrole ? NR : NT);
    const int gt = blockIdx.x * (NT * 64) + (tid - NR * 64), NGT = G * NT * 64;
    unsigned char* ws = A->ws;
    if (!rowrole) for (int rep = 0; rep < (PROBE_REP == 1001 ? 2 : 1); ++rep) {
        LAS float* scr = (LAS float*)(lds + wave * 16384);
        constexpr int I_IN = 16 * 153, I_OA = 8 * 32, I_OUT = 16 * 32, I_G = 16 * 88, I_D = 44 * 32;
        constexpr int NIT = I_IN + 2 * I_OA + I_OUT + 2 * I_G + I_D;
        for (int it = gw; it < NIT; it += NGW) {
            int r = it;
            if (r < I_IN) { transpose_item(A->w_in, 1024, NIN_SRC, (bf16*)(ws + WS_WIN), [](int c) -> int {
                    if (c < 640) return (c & ~63) + pos_of_d(c & 63);
                    if (c < 2816) return c;
                    if (c < 2824) return -1;
                    return c - 8; }, nullptr, scr, r, lane); continue; } r -= I_IN;
            if (r < I_OA) { transpose_item(A->w_oa, 512, 1024, (bf16*)(ws + WS_WOA), [](int c) -> int { return c; }, nullptr, scr, r, lane, 1024); continue; } r -= I_OA;
            if (r < I_OA) { transpose_item(A->w_ob, 512, 1024, (bf16*)(ws + WS_WOA) + 512, [](int c) -> int { return c; }, nullptr, scr, r, lane, 1024); continue; } r -= I_OA;
            if (r < I_OUT) { transpose_item(A->w_out, 1024, 1024, (bf16*)(ws + WS_WOUT), [](int c) -> int { return c; }, nullptr, scr, r, lane); continue; } r -= I_OUT;
            if (r < I_G) { transpose_item(A->w_gate, 1024, DFF, (bf16*)(ws + WS_WGU), [](int c) -> int { return 256 * (c >> 7) + (c & 127); }, A->norm_ffn, scr, r, lane); continue; } r -= I_G;
            if (r < I_G) { transpose_item(A->w_up, 1024, DFF, (bf16*)(ws + WS_WGU), [](int c) -> int { return 256 * (c >> 7) + 128 + (c & 127); }, A->norm_ffn, scr, r, lane); continue; } r -= I_G;
            transpose_item(A->w_down, DFF, 1024, (bf16*)(ws + WS_WD), [](int c) -> int { return c; }, nullptr, scr, r, lane);
        }
    }
    if (!rowrole) for (int rep = 0; rep < (PROBE_REP == 1002 ? 2 : 1); ++rep) {
        float* COS = (float*)(ws + WS_ROPE); float* SIN = COS + (TP + TS) * 32;
        for (int i = gt; i < (TP + TS) * 32; i += NGT) { const int ri = i >> 5, f = i & 31; const double pos = ri < TP ? (double)ri : (double)(PAST + ri - TP);
            const double inv = exp2(-(double)f * (13.287712379549449 / 32.0)), ang = pos * inv; COS[i] = (float)cos(ang); SIN[i] = (float)sin(ang); }
        constexpr int PERB = 124 * 128 / 4;
        for (int i = gt; i < SBATCH * PERB; i += NGT) { const int b = i / PERB, o = i - b * PERB;
            ((f32x4*)(A->out + O_KS))[(size_t)b * 4096 + o] = ((const f32x4*)A->cache_k)[(size_t)b * 4096 + 128 + o];
            ((f32x4*)(A->out + O_VS))[(size_t)b * 4096 + o] = ((const f32x4*)A->cache_v)[(size_t)b * 4096 + 128 + o]; }
    }
    if (rowrole) for (int rep = 0; rep < (PROBE_REP == 1003 ? 2 : 1); ++rep) {
        unsigned wab[16][4];
        f32x4 nm[4];
#pragma unroll
        for (int j = 0; j < 4; ++j) {
            nm[j] = ((const f32x4*)A->norm_mix)[lane + 64 * j];
#pragma unroll
            for (int e = 0; e < 4; ++e) { const float* p = A->w_in + (size_t)(4 * (lane + 64 * j) + e) * NIN_SRC + 2816;
                const f32x4 a = *(const f32x4*)p, b = *(const f32x4*)(p + 4);
                wab[j * 4 + e][0] = cvtpk(a[0], a[1]); wab[j * 4 + e][1] = cvtpk(a[2], a[3]); wab[j * 4 + e][2] = cvtpk(b[0], b[1]); wab[j * 4 + e][3] = cvtpk(b[2], b[3]); }
        }
        bf16* XN = (bf16*)(ws + WS_XN); f32x2* GB = (f32x2*)(ws + WS_GB);
        auto row_src = [&](int urow) -> const float* {
            if (urow < MP) { const int b = urow / TP, t = urow - b * TP; return t < NMETA ? A->meta + (size_t)t * D : A->x_prompt + ((size_t)b * SEQ + (t - NMETA)) * D; }
            if (urow < MU) return A->x_sample + (size_t)(urow - MP) * D;
            return nullptr; };
        f32x4 nx[4], nx2[4];
        { const float* s0 = gw < MUP ? row_src(gw) : nullptr; const float* s1 = gw + NGW < MUP ? row_src(gw + NGW) : nullptr;
#pragma unroll
          for (int j = 0; j < 4; ++j) { nx[j] = s0 ? ((const f32x4*)s0)[lane + 64 * j] : (f32x4){0.f, 0.f, 0.f, 0.f}; nx2[j] = s1 ? ((const f32x4*)s1)[lane + 64 * j] : (f32x4){0.f, 0.f, 0.f, 0.f}; } }
#pragma unroll 1
        for (int urow = gw; urow < MUP; urow += NGW) {
            f32x4 v[4];
#pragma unroll
            for (int j = 0; j < 4; ++j) { v[j] = nx[j]; nx[j] = nx2[j]; }
            { const int un = urow + 2 * NGW; const float* s2 = un < MUP ? row_src(un) : nullptr;
#pragma unroll
              for (int j = 0; j < 4; ++j) nx2[j] = s2 ? ((const f32x4*)s2)[lane + 64 * j] : (f32x4){0.f, 0.f, 0.f, 0.f}; }
            u32x2* o8 = (u32x2*)(XN + (size_t)urow * D) + lane;
            float ss = 0.f;
#pragma unroll
            for (int j = 0; j < 4; ++j) ss += (v[j][0] * v[j][0] + v[j][1] * v[j][1]) + (v[j][2] * v[j][2] + v[j][3] * v[j][3]);
            const float rstd = urow < MU ? rsqrtf(wave_sum(ss) * (1.0f / D) + EPS) : 0.f;
            float dot[8];
#pragma unroll
            for (int c = 0; c < 8; ++c) dot[c] = 0.f;
#pragma unroll
            for (int j = 0; j < 4; ++j) { v[j] = v[j] * rstd * nm[j];
                o8[64 * j] = (u32x2){cvtpk(v[j][0], v[j][1]), cvtpk(v[j][2], v[j][3])};
#pragma unroll
                for (int e = 0; e < 4; ++e)
#pragma unroll
                    for (int c = 0; c < 4; ++c) { dot[2 * c] += v[j][e] * bflo(wab[j * 4 + e][c]); dot[2 * c + 1] += v[j][e] * bfhi(wab[j * 4 + e][c]); } }
            float d4[4], d2[2], d1;
#pragma unroll
            for (int c = 0; c < 4; ++c) { const float keep = (lane & 32) ? dot[4 + c] : dot[c], send = (lane & 32) ? dot[c] : dot[4 + c]; d4[c] = keep + __shfl_xor(send, 32); }
#pragma unroll
            for (int c = 0; c < 2; ++c) { const float keep = (lane & 16) ? d4[2 + c] : d4[c], send = (lane & 16) ? d4[c] : d4[2 + c]; d2[c] = keep + __shfl_xor(send, 16); }
            { const float keep = (lane & 8) ? d2[1] : d2[0], send = (lane & 8) ? d2[0] : d2[1]; d1 = keep + __shfl_xor(send, 8); }
            d1 += __shfl_xor(d1, 4); d1 += __shfl_xor(d1, 2); d1 += __shfl_xor(d1, 1);
            const float a_ = __shfl(d1, ((lane & 2) ? 16 : 0) + ((lane & 1) ? 8 : 0));
            const float b_ = __shfl(d1, 32 + ((lane & 2) ? 16 : 0) + ((lane & 1) ? 8 : 0));
            if (lane < 4) {
                const float g = -__expf(A->a_log[lane]) * softplusf_(a_ + A->dt_bias[lane]);
                GB[(size_t)urow * 4 + lane] = urow < MU ? (f32x2){g, sigmoidf_(b_)} : (f32x2){0.f, 0.f};
            }
        }
    }
}
DI void item_decode(int item, int& b, int& h, bool& sample, int& t0, int& L) {
    if (item < N_ITEMS_P) { const int s = item / CHUNKS_P, c = item - s * CHUNKS_P; b = s >> 2; h = s & 3; sample = false; if (c == 0) { t0 = 0; L = NMETA; } else { t0 = NMETA + 64 * (c - 1); L = 64; } }
    else { const int s = item - N_ITEMS_P; b = s >> 2; h = s & 3; sample = true; t0 = 0; L = TS; }
}
#define LDS_BARRIER() do { asm volatile("s_waitcnt lgkmcnt(0)" ::: "memory"); __builtin_amdgcn_s_barrier(); asm volatile("" ::: "memory"); } while (0)
typedef GAS unsigned long long gu64;
typedef GAS unsigned gu32;
constexpr size_t CTL_QUEUE = 40960;
constexpr size_t CTL_F1 = 655360;
static_assert(CTL_F1 + 2592 * 64 <= 1048576, "control region map");
DI gu64* item_flag1(KA A, int item) { return (gu64*)(A->ws + WS_CTL + CTL_F1 + (size_t)item * 64); }
DI int order_item(int m) { return m < N_ITEMS_P ? (m & 31) * CHUNKS_P + (m >> 5) : m; }
DI gu64* item_granule(KA A, int item) { return (gu64*)(A->ws + WS_CTL + CTL_GRAN + (size_t)item * 64); }
DI float wait_item(gu64* g, unsigned ep = 1u) {
    unsigned long long x; unsigned spins = 0;
    for (;;) { x = __hip_atomic_load(g, __ATOMIC_RELAXED, __HIP_MEMORY_SCOPE_AGENT); if ((unsigned)(x >> 32) >= ep) break; __builtin_amdgcn_s_sleep(8); if (++spins > (1u << 20)) break; }
    asm volatile("" ::: "memory");
    return __uint_as_float((unsigned)__builtin_amdgcn_readfirstlane((int)(unsigned)x));
}
constexpr int LDS_GCL = 139264;
constexpr int PITCH = 132;
DI bf16x8 frag_nat(const LAS float* src, int row, int k0) {
    const f32x4 lo = *(const LAS f32x4*)(src + row * PITCH + k0), hi = *(const LAS f32x4*)(src + row * PITCH + k0 + 4);
    return __builtin_bit_cast(bf16x8, pack8f(lo, hi));
}
struct S1Pre { u32x4 xr[11]; f32x4 w[4][2]; f32x2 gb; };
DI void stage1_issue(KA A, int item, S1Pre& P) {
    const int tid = threadIdx.x, lane = tid & 63, wave = __builtin_amdgcn_readfirstlane(tid >> 6);
    int b, h, t0, L; bool sample; item_decode(item, b, h, sample, t0, L);
    const bf16* QKVB = (const bf16*)(A->ws + WS_QKVB);
    const int cv = lane < 48 ? lane : 47, grp = cv >> 4, col0 = (cv & 15) * 8, r0 = wave * 8, cidx = grp * 512 + h * 128 + col0;
#pragma unroll
    for (int q = 0; q < 11; ++q) {
        const int i = r0 - 3 + q;
        long urow = sample ? (long)MP + b * TS + i : (long)b * TP + t0 + i;
        const bool ok = sample ? i >= 0 : t0 + i >= 0;
        if (!ok) urow = 0;
        P.xr[q] = *(const u32x4*)(QKVB + (size_t)urow * CONVD + cidx);
        if (!ok) P.xr[q] = (u32x4){0u, 0u, 0u, 0u};
    }
#pragma unroll
    for (int i = 0; i < 4; ++i) { P.w[i][0] = *(const f32x4*)(A->conv_w + i * CONVD + cidx); P.w[i][1] = *(const f32x4*)(A->conv_w + i * CONVD + cidx + 4); }
    P.gb = (f32x2){0.f, 0.f};
    if (wave == 7 && lane < L) { const int urow = sample ? MP + b * TS + lane : b * TP + t0 + lane; P.gb = ((const f32x2*)(A->ws + WS_GB))[(size_t)urow * 4 + h]; }
}
DI void prep_stage1(KA A, int item, int next_item, int prev_item, int wait_item_idx, int bslot, float* ats, S1Pre& P, LAS unsigned char* ldsb, unsigned ep, int pmode = 0) {
    const int tid = threadIdx.x, lane = tid & 63, wave = __builtin_amdgcn_readfirstlane(tid >> 6), r = lane & 31, hh = lane >> 5;
#define ST16(p, ...) __builtin_amdgcn_raw_buffer_store_b128(__builtin_bit_cast(v4u_t, (__VA_ARGS__)), rs_slot, (int)((const unsigned char*)(p) - (const unsigned char*)slot), 0, 16)
#define ST16F(p, ...) __builtin_amdgcn_raw_buffer_store_b128(__builtin_bit_cast(v4u_t, (__VA_ARGS__)), rs_ats, (int)((const unsigned char*)(p) - (const unsigned char*)ats), 0, 16)
    int b, h, t0, L; bool sample; item_decode(item, b, h, sample, t0, L);
    LAS float* Qs = (LAS float*)ldsb; LAS float* Ks = Qs + 64 * PITCH; LAS float* Vs = Ks + 64 * PITCH; LAS float* gcs = Vs + 64 * PITCH; LAS float* betas = gcs + 64;
    unsigned char* slot = slot_ptr(A, item);
    typedef unsigned v4u_t __attribute__((__vector_size__(16)));
    const __amdgpu_buffer_rsrc_t rs_slot = __builtin_amdgcn_make_buffer_rsrc((void*)slot, 0, (int)PREP_SLOT, 0x00020000);
    const __amdgpu_buffer_rsrc_t rs_ats = __builtin_amdgcn_make_buffer_rsrc((void*)ats, 0, (int)ATS_ITEM, 0x00020000);
    if (!(pmode & 8)) {
        const int cv = lane < 48 ? lane : 47, grp = cv >> 4, col0 = (cv & 15) * 8, r0 = wave * 8, cidx = grp * 512 + h * 128 + col0;
        float x[11][8];
#pragma unroll
        for (int q = 0; q < 11; ++q) { x[q][0] = bflo(P.xr[q].x); x[q][1] = bfhi(P.xr[q].x); x[q][2] = bflo(P.xr[q].y); x[q][3] = bfhi(P.xr[q].y);
                                       x[q][4] = bflo(P.xr[q].z); x[q][5] = bfhi(P.xr[q].z); x[q][6] = bflo(P.xr[q].w); x[q][7] = bfhi(P.xr[q].w); }
        if (sample && wave == 0) {
#pragma unroll
            for (int q = 0; q < 3; ++q) { const float* sp = A->state_conv + ((size_t)b * 3 + q) * CONVD + cidx; const f32x4 s0 = *(const f32x4*)sp, s1 = *(const f32x4*)(sp + 4);
                x[q][0] = s0[0]; x[q][1] = s0[1]; x[q][2] = s0[2]; x[q][3] = s0[3]; x[q][4] = s1[0]; x[q][5] = s1[1]; x[q][6] = s1[2]; x[q][7] = s1[3]; }
        }
        float w[4][8];
#pragma unroll
        for (int i = 0; i < 4; ++i) { w[i][0] = P.w[i][0][0]; w[i][1] = P.w[i][0][1]; w[i][2] = P.w[i][0][2]; w[i][3] = P.w[i][0][3]; w[i][4] = P.w[i][1][0]; w[i][5] = P.w[i][1][1]; w[i][6] = P.w[i][1][2]; w[i][7] = P.w[i][1][3]; }
        LAS float* dst = Qs + grp * 64 * PITCH + col0;
        const float nsc = grp == 0 ? 0.08838834764831845f : 1.0f;
#pragma unroll
        for (int q = 3; q < 11; ++q) {
            const int rr = r0 + q - 3;
            float v[8]; float ss = 0.f;
#pragma unroll
            for (int e = 0; e < 8; ++e) {
                const float y = __builtin_fmaf(w[3][e], x[q][e], __builtin_fmaf(w[2][e], x[q - 1][e], __builtin_fmaf(w[1][e], x[q - 2][e], w[0][e] * x[q - 3][e])));
                const float sv = siluf_(y); v[e] = sv; ss = __builtin_fmaf(sv, sv, ss); }
            ss += __builtin_bit_cast(float, __builtin_amdgcn_update_dpp(0, __builtin_bit_cast(int, ss), 0xB1, 0xF, 0xF, true));
            ss += __builtin_bit_cast(float, __builtin_amdgcn_update_dpp(0, __builtin_bit_cast(int, ss), 0x4E, 0xF, 0xF, true));
            ss += __builtin_bit_cast(float, __builtin_amdgcn_update_dpp(0, __builtin_bit_cast(int, ss), 0x141, 0xF, 0xF, true));
            ss += __builtin_bit_cast(float, __builtin_amdgcn_update_dpp(0, __builtin_bit_cast(int, ss), 0x140, 0xF, 0xF, true));
            float sc = grp == 2 ? 1.0f : rsqrtf(ss + EPS) * nsc;
            sc = rr < L ? sc : 0.f;
            if (lane < 48) { *(LAS f32x4*)(dst + rr * PITCH) = (f32x4){v[0] * sc, v[1] * sc, v[2] * sc, v[3] * sc}; *(LAS f32x4*)(dst + rr * PITCH + 4) = (f32x4){v[4] * sc, v[5] * sc, v[6] * sc, v[7] * sc}; }
        }
    }
    if (wave == 7) {
        float gc = P.gb[0];
#pragma unroll
        for (int o = 1; o < 64; o <<= 1) { const float t = __shfl_up(gc, o); if (lane >= o) gc += t; }
        gcs[lane] = gc; betas[lane] = P.gb[1];
        if (lane == 63) ((LAS float*)(ldsb + LDS_GCL))[bslot] = __expf(gc);
    }
    asm volatile("s_waitcnt vmcnt(0)" ::: "memory");
    if (next_item < N_ITEMS) stage1_issue(A, next_item, P);
    if (wait_item_idx >= 0 && wave == 0) (void)wait_item(item_granule(A, wait_item_idx), ep);
    LDS_BARRIER();
    if (prev_item >= 0 && tid == 0) __hip_atomic_store(item_flag1(A, prev_item), ((unsigned long long)ep << 32) | (unsigned long long)__float_as_uint(((const LAS float*)(ldsb + LDS_GCL))[bslot ^ 1]), __ATOMIC_RELAXED, __HIP_MEMORY_SCOPE_AGENT);
    if (wave < 6 && !(pmode & 4)) {
        const bool isqk = wave >= 3; const int tsel = isqk ? wave - 3 : wave, ib = tsel == 0 ? 0 : 1, jb = tsel == 2 ? 1 : 0;
        const LAS float* Asrc = isqk ? Qs : Ks;
        f32x16 acc;
#pragma unroll
        for (int e = 0; e < 16; ++e) acc[e] = 0.f;
#pragma unroll
        for (int s = 0; s < 8; ++s) acc = MFMA32(frag_nat(Asrc, 32 * ib + r, 16 * s + 8 * hh), frag_nat(Ks, 32 * jb + r, 16 * s + 8 * hh), acc);
        const int j = 32 * jb + r; const float gcj = gcs[j];
        float* Aout = ats + (ib + jb) * 1024; bf16* QKD = (bf16*)(slot + SL_QKD);
        if (!isqk) {
#pragma unroll
            for (int g4 = 0; g4 < 4; ++g4) { f32x4 v;
#pragma unroll
                for (int e = 0; e < 4; ++e) { const int i = 32 * ib + 8 * g4 + 4 * hh + e; v[e] = i > j ? betas[i] * __expf(fminf(gcs[i] - gcj, 0.f)) * acc[4 * g4 + e] : 0.f; }
                ST16F(Aout + r * 32 + 8 * g4 + 4 * hh, v); }
        } else {
            LAS float* patch = (LAS float*)(ldsb + 106496) + (wave - 3) * (32 * 36);
#pragma unroll
            for (int reg = 0; reg < 16; ++reg) { const int il = crow16(reg, hh), i = 32 * ib + il; const float dec = __expf(fminf(gcs[i] - gcj, 0.f));
                patch[il * 36 + r] = i >= j ? dec * acc[reg] : 0.f; }
            LDS_WAIT(); asm volatile("" ::: "memory");
#pragma unroll
            for (int ks2 = 0; ks2 < 2; ++ks2) { const int k0 = 16 * ks2 + 4 * hh;
                const f32x4 lo = *(const LAS f32x4*)(patch + r * 36 + k0), hi = *(const LAS f32x4*)(patch + r * 36 + k0 + 8);
                ST16((unsigned char*)QKD + ((ib * 4 + 2 * jb + ks2) * 64 + lane) * 16, pack8f(lo, hi)); }
        }
    }
    const float gcl = gcs[63];
#pragma unroll 1
    for (int job = (pmode & 4) ? 56 : wave; job < 56; job += 8) {
        if (job < 32) {
            const bool isq = job >= 16; const int jj = job & 15, rb = jj >> 3, ks = jj & 7, row = 32 * rb + r, k0 = 16 * ks + 4 * hh;
            const LAS float* src = isq ? Qs : Ks; const float sc = isq ? __expf(gcs[row]) : betas[row] * __expf(gcs[row]);
            const f32x4 lo = *(const LAS f32x4*)(src + row * PITCH + k0) * sc, hi = *(const LAS f32x4*)(src + row * PITCH + k0 + 8) * sc;
            ST16(slot + (isq ? SL_QE : SL_BEK) + ((rb * 8 + ks) * 64 + lane) * 16, pack8f(lo, hi));
        } else if (job < 48) {
            const int jj = job - 32, rb = jj >> 2, ks = jj & 3, dk = 32 * rb + r;
            f32x4 lo, hi;
#pragma unroll
            for (int e = 0; e < 4; ++e) { const int j0 = 16 * ks + 4 * hh + e, j1 = j0 + 8;
                lo[e] = Ks[j0 * PITCH + dk] * __expf(gcl - gcs[j0]); hi[e] = Ks[j1 * PITCH + dk] * __expf(gcl - gcs[j1]); }
            ST16(slot + SL_KWT + ((rb * 4 + ks) * 64 + lane) * 16, pack8f(lo, hi));
        } else {
            const int q = job - 48, w = q >> 1, ib = q & 1, dv = 32 * w + r;
            float v[16];
#pragma unroll
            for (int reg = 0; reg < 16; ++reg) { const int i = 32 * ib + crow16(reg, hh); v[reg] = betas[i] * Vs[i * PITCH + dv]; }
            u32x4* dst = (u32x4*)(slot + SL_BV + ((w * 2 + ib) * 64 + lane) * 32);
            ST16(dst, (u32x4){cvtpk(v[0], v[1]), cvtpk(v[2], v[3]), cvtpk(v[4], v[5]), cvtpk(v[6], v[7])});
            ST16(dst + 1, (u32x4){cvtpk(v[8], v[9]), cvtpk(v[10], v[11]), cvtpk(v[12], v[13]), cvtpk(v[14], v[15])});
        }
    }
    LDS_BARRIER();
}
DI void prep_stage2(KA A, int item, float gcl, const float* ats, LAS float* M, unsigned ep) {
    int lane = threadIdx.x & 63; asm volatile("" : "+v"(lane));
    const int r = lane & 31, hh = lane >> 5, base = 32 * hh;
    unsigned char* slot = slot_ptr(A, item);
    const f32x4* Ain = (const f32x4*)ats;
#pragma unroll
    for (int tt = 0; tt < 3; ++tt) { const int jb = tt >> 1, ib = (tt + 1) >> 1;
#pragma unroll
        for (int q = 0; q < 4; ++q) { const int idx = q * 64 + lane, jj = idx >> 3, i4 = idx & 7;
            *(LAS f32x4*)(M + (32 * jb + jj) * 64 + 32 * ib + 4 * i4) = Ain[tt * 256 + idx]; } }
    LDS_WAIT(); asm volatile("" ::: "memory");
#pragma unroll 1
    for (int rb = 0; rb < 2; ++rb) {
        float acc[16];
#pragma unroll
        for (int i = 0; i < 16; ++i) acc[i] = r == 16 * rb + i ? 1.f : 0.f;
        if (rb == 1) {
#pragma unroll 4
            for (int j = 0; j < 16; ++j) {
                float tj = M[(base + j) * 64 + base + r]; tj = r <= j ? tj : 0.f;
                const LAS f32x4* ar = (const LAS f32x4*)(M + (base + j) * 64 + base + 16);
                const f32x4 a0 = ar[0], a1 = ar[1], a2 = ar[2], a3 = ar[3];
#pragma unroll
                for (int e = 0; e < 4; ++e) { acc[e] -= a0[e] * tj; acc[4 + e] -= a1[e] * tj; acc[8 + e] -= a2[e] * tj; acc[12 + e] -= a3[e] * tj; }
            }
        }
#pragma unroll
        for (int j = 0; j < 16; ++j) {
            const float tj = acc[j]; const int row = base + 16 * rb + j;
            const LAS f32x4* ar = (const LAS f32x4*)(M + row * 64 + base + 16 * rb);
            float a[16];
#pragma unroll
            for (int q = j >> 2; q < 4; ++q) { const f32x4 v = ar[q]; a[4 * q] = v[0]; a[4 * q + 1] = v[1]; a[4 * q + 2] = v[2]; a[4 * q + 3] = v[3]; }
            if (r <= 16 * rb + j) M[row * 64 + base + r] = tj;
#pragma unroll
            for (int i = j + 1; i < 16; ++i) acc[i] -= a[i] * tj;
        }
        asm volatile("" ::: "memory");
    }
    LDS_WAIT(); asm volatile("" ::: "memory");
    f32x16 X;
#pragma unroll
    for (int e = 0; e < 16; ++e) X[e] = 0.f;
#pragma unroll
    for (int s2 = 0; s2 < 16; ++s2) { const int k = 2 * s2 + hh; const float a = M[k * 64 + 32 + r]; float bb = M[k * 64 + r]; bb = r <= k ? bb : 0.f;
        X = __builtin_amdgcn_mfma_f32_32x32x2f32(a, bb, X, 0, 0, 0); }
#pragma unroll
    for (int reg = 0; reg < 16; ++reg) M[crow16(reg, hh) * 64 + 32 + r] = X[reg];
    LDS_WAIT(); asm volatile("" ::: "memory");
    f32x16 Y;
#pragma unroll
    for (int e = 0; e < 16; ++e) Y[e] = 0.f;
#pragma unroll
    for (int s2 = 0; s2 < 16; ++s2) { const int k = 2 * s2 + hh; float a = M[(32 + r) * 64 + 32 + k]; a = k <= r ? a : 0.f; const float bb = M[k * 64 + 32 + r];
        Y = __builtin_amdgcn_mfma_f32_32x32x2f32(a, bb, Y, 0, 0, 0); }
#pragma unroll
    for (int reg = 0; reg < 16; ++reg) M[(32 + crow16(reg, hh)) * 64 + r] = -Y[reg];
    LDS_WAIT(); asm volatile("" ::: "memory");
#pragma unroll
    for (int f = 0; f < 8; ++f) { const int rb = f >> 2, ks = f & 3, row = 32 * rb + r, k0 = 16 * ks + 4 * hh;
        f32x4 lo = *(const LAS f32x4*)(M + row * 64 + k0), hi = *(const LAS f32x4*)(M + row * 64 + k0 + 8);
#pragma unroll
        for (int e = 0; e < 4; ++e) { lo[e] = k0 + e <= row ? lo[e] : 0.f; hi[e] = k0 + 8 + e <= row ? hi[e] : 0.f; }
        st16_sc1(slot + SL_T + ((rb * 4 + ks) * 64 + lane) * 16, pack8f(lo, hi)); }
    LDS_WAIT();
    asm volatile("s_waitcnt vmcnt(0)" ::: "memory");
    if (lane == 0) __hip_atomic_store(item_granule(A, item), ((unsigned long long)ep << 32) | (unsigned long long)__float_as_uint(gcl), __ATOMIC_RELAXED, __HIP_MEMORY_SCOPE_AGENT);
}
DI void scan_seq(KA A, int seq, int w, int lane, unsigned ep) {
    const int r = lane & 31, hh = lane >> 5, dv = 32 * w + r;
    const bool sample = seq >= N_PROMPT_SEQ; const int sidx = sample ? seq - N_PROMPT_SEQ : seq, b = sidx >> 2, h = sidx & 3, nch = sample ? 1 : CHUNKS_P;
    f32x16 S[4];
    if (sample) {
        const float* S0 = A->state_delta + ((size_t)(b * 4 + h) * 128) * 128 + dv;
#pragma unroll
        for (int kb = 0; kb < 4; ++kb)
#pragma unroll
            for (int reg = 0; reg < 16; ++reg) S[kb][reg] = S0[(size_t)(32 * kb + crow16(reg, hh)) * 128];
    } else {
#pragma unroll
        for (int kb = 0; kb < 4; ++kb)
#pragma unroll
            for (int reg = 0; reg < 16; ++reg) S[kb][reg] = 0.f;
    }
    bf16* OBR = (bf16*)((unsigned char*)A->out + DO_OB);
#pragma unroll 1
    for (int c = 0; c < nch; ++c) {
        const int item = sample ? N_ITEMS_P + sidx : seq * CHUNKS_P + c;
        const unsigned char* slot = slot_ptr(A, item);
        const float gcl = wait_item(item_granule(A, item), ep);
        __builtin_amdgcn_fence(__ATOMIC_ACQUIRE, "agent");
        const bf16x8* bek = (const bf16x8*)(slot + SL_BEK) + lane; const bf16x8* tp = (const bf16x8*)(slot + SL_T) + lane;
        const bf16x8* qe = (const bf16x8*)(slot + SL_QE) + lane; const bf16x8* qkd = (const bf16x8*)(slot + SL_QKD) + lane; const bf16x8* kwt = (const bf16x8*)(slot + SL_KWT) + lane;
        bf16x8 sf[8];
#pragma unroll
        for (int kb = 0; kb < 4; ++kb) { sf[2 * kb] = pack_step<0>(S[kb]); sf[2 * kb + 1] = pack_step<1>(S[kb]); }
        f32x16 x0, x1;
#pragma unroll
        for (int e = 0; e < 16; ++e) { x0[e] = 0.f; x1[e] = 0.f; }
#pragma unroll
        for (int ks = 0; ks < 8; ++ks) { x0 = MFMA32(bek[ks * 64], sf[ks], x0); x1 = MFMA32(bek[(8 + ks) * 64], sf[ks], x1); }
        {
            const u32x4* bv = (const u32x4*)(slot + SL_BV) + ((w * 2) * 64 + lane) * 2;
            const u32x4 a0 = bv[0], a1 = bv[1], c0 = bv[128], c1 = bv[129];
            x0[0] = bflo(a0.x) - x0[0]; x0[1] = bfhi(a0.x) - x0[1]; x0[2] = bflo(a0.y) - x0[2]; x0[3] = bfhi(a0.y) - x0[3];
            x0[4] = bflo(a0.z) - x0[4]; x0[5] = bfhi(a0.z) - x0[5]; x0[6] = bflo(a0.w) - x0[6]; x0[7] = bfhi(a0.w) - x0[7];
            x0[8] = bflo(a1.x) - x0[8]; x0[9] = bfhi(a1.x) - x0[9]; x0[10] = bflo(a1.y) - x0[10]; x0[11] = bfhi(a1.y) - x0[11];
            x0[12] = bflo(a1.z) - x0[12]; x0[13] = bfhi(a1.z) - x0[13]; x0[14] = bflo(a1.w) - x0[14]; x0[15] = bfhi(a1.w) - x0[15];
            x1[0] = bflo(c0.x) - x1[0]; x1[1] = bfhi(c0.x) - x1[1]; x1[2] = bflo(c0.y) - x1[2]; x1[3] = bfhi(c0.y) - x1[3];
            x1[4] = bflo(c0.z) - x1[4]; x1[5] = bfhi(c0.z) - x1[5]; x1[6] = bflo(c0.w) - x1[6]; x1[7] = bfhi(c0.w) - x1[7];
            x1[8] = bflo(c1.x) - x1[8]; x1[9] = bfhi(c1.x) - x1[9]; x1[10] = bflo(c1.y) - x1[10]; x1[11] = bfhi(c1.y) - x1[11];
            x1[12] = bflo(c1.z) - x1[12]; x1[13] = bfhi(c1.z) - x1[13]; x1[14] = bflo(c1.w) - x1[14]; x1[15] = bfhi(c1.w) - x1[15];
        }
        bf16x8 rf[4] = {pack_step<0>(x0), pack_step<1>(x0), pack_step<0>(x1), pack_step<1>(x1)};
        f32x16 u0, u1;
#pragma unroll
        for (int e = 0; e < 16; ++e) { u0[e] = 0.f; u1[e] = 0.f; }
        u0 = MFMA32(tp[0 * 64], rf[0], u0); u0 = MFMA32(tp[1 * 64], rf[1], u0);
#pragma unroll
        for (int ks = 0; ks < 4; ++ks) u1 = MFMA32(tp[(4 + ks) * 64], rf[ks], u1);
        bf16x8 uf[4] = {pack_step<0>(u0), pack_step<1>(u0), pack_step<0>(u1), pack_step<1>(u1)};
        if (sample || c > 0) {
#pragma unroll
            for (int e = 0; e < 16; ++e) { x0[e] = 0.f; x1[e] = 0.f; }
#pragma unroll
            for (int ks = 0; ks < 8; ++ks) { x0 = MFMA32(qe[ks * 64], sf[ks], x0); x1 = MFMA32(qe[(8 + ks) * 64], sf[ks], x1); }
            x0 = MFMA32(qkd[0 * 64], uf[0], x0); x0 = MFMA32(qkd[1 * 64], uf[1], x0);
#pragma unroll
            for (int ks = 0; ks < 4; ++ks) x1 = MFMA32(qkd[(4 + ks) * 64], uf[ks], x1);
            const int crow0 = sample ? NBATCH * SEQ + b * TS : b * SEQ + 64 * (c - 1), L = sample ? TS : 64;
#pragma unroll
            for (int reg = 0; reg < 16; ++reg) { const int i0 = crow16(reg, hh), i1 = 32 + i0;
                if (i0 < L) OBR[(size_t)(crow0 + i0) * OAB_PITCH + h * 128 + dv] = f2bf(x0[reg]);
                if (i1 < L) OBR[(size_t)(crow0 + i1) * OAB_PITCH + h * 128 + dv] = f2bf(x1[reg]); }
        }
#pragma unroll
        for (int kb = 0; kb < 4; ++kb) {
            S[kb] = S[kb] * gcl;
#pragma unroll
            for (int ks = 0; ks < 4; ++ks) S[kb] = MFMA32(kwt[(kb * 4 + ks) * 64], uf[ks], S[kb]);
        }
    }
    float* So = A->out + (sample ? O_DS : O_DP) + ((size_t)(b * 4 + h) * 128) * 128 + dv;
#pragma unroll
    for (int kb = 0; kb < 4; ++kb)
#pragma unroll
        for (int reg = 0; reg < 16; ++reg) So[(size_t)(32 * kb + crow16(reg, hh)) * 128] = S[kb][reg];
}

constexpr int HALF_BYTES = 40960;
DI void scan_prompt_wg(KA A, int seq, LAS unsigned char* lds, unsigned ep) {
    const int tid = threadIdx.x, lane = tid & 63, wave = __builtin_amdgcn_readfirstlane(tid >> 6);
    const int b = seq >> 2, h = seq & 3;
    constexpr int N = 2 * CHUNKS_P;
    if (wave >= 4) {
        const int loff = (wave - 4) * 10240 + lane * 16;
        u32x4 r0[10], r1[10], r2[10], r3[10];
        LAS u32x4* d0 = (LAS u32x4*)(lds + loff); LAS u32x4* d1 = (LAS u32x4*)(lds + HALF_BYTES + loff);
        LAS float* gclw = (LAS float*)(lds + 2 * HALF_BYTES);
        unsigned long long pv;
#define SL_PEEK(c) do { if ((c) < CHUNKS_P) pv = __hip_atomic_load(item_granule(A, seq * CHUNKS_P + (c)), __ATOMIC_RELAXED, __HIP_MEMORY_SCOPE_AGENT); } while (0)
#define SL_POLL(c) do { float g_; if ((unsigned)(pv >> 32) >= ep) { asm volatile("" ::: "memory"); g_ = __uint_as_float((unsigned)__builtin_amdgcn_readfirstlane((int)(unsigned)pv)); } \
            else g_ = wait_item(item_granule(A, seq * CHUNKS_P + (c)), ep); if (wave == 4 && lane == 0) gclw[(c) & 7] = g_; } while (0)
#define SL_ISSUE(h, R) do { const __amdgpu_buffer_rsrc_t rs_ = __builtin_amdgcn_make_buffer_rsrc((void*)slot_ptr(A, seq * CHUNKS_P + ((h) >> 1)), 0, (int)PREP_SLOT, 0x00020000); \
            _Pragma("unroll") for (int q = 0; q < 10; ++q) R[q] = __builtin_bit_cast(u32x4, __builtin_amdgcn_raw_buffer_load_b128(rs_, ((h) & 1) * HALF_BYTES + loff + q * 1024, 0, 16)); } while (0)
#define SL_WRITE(D, R) do { _Pragma("unroll") for (int q = 0; q < 10; ++q) D[q * 64] = R[q]; } while (0)
#define SL_STEP(k, D, R, FIRST) do { if ((k) < N) { \
            if ((k) + 1 < N) SL_WRITE(D, R); \
            LDS_BARRIER(); \
            if ((k) + 5 < N) { if (FIRST) SL_POLL(((k) + 5) >> 1); SL_ISSUE((k) + 5, R); } \
            if (!(FIRST)) SL_PEEK(((k) + 6) >> 1); } } while (0)
        SL_PEEK(0); SL_POLL(0); SL_ISSUE(0, r0); SL_ISSUE(1, r1);
        SL_PEEK(1); SL_POLL(1); SL_ISSUE(2, r2); SL_ISSUE(3, r3);
        SL_PEEK(2);
        SL_WRITE(d0, r0);
        LDS_BARRIER();
        SL_POLL(2); SL_ISSUE(4, r0);
#pragma unroll 1
        for (int k = 0; k < N; k += 4) {
            SL_STEP(k, d1, r1, false);
            SL_STEP(k + 1, d0, r2, true);
            SL_STEP(k + 2, d1, r3, false);
            SL_STEP(k + 3, d0, r0, true);
        }
#undef SL_PEEK
#undef SL_POLL
#undef SL_ISSUE
#undef SL_WRITE
#undef SL_STEP
    } else {
        const int w = wave, r = lane & 31, hh = lane >> 5, dv = 32 * w + r;
        f32x16 S[4];
#pragma unroll
        for (int kb = 0; kb < 4; ++kb)
#pragma unroll
            for (int reg = 0; reg < 16; ++reg) S[kb][reg] = 0.f;
        bf16x8 uf[4], kw2[8];
#pragma unroll
        for (int i = 0; i < 4; ++i) uf[i] = (bf16x8){0, 0, 0, 0, 0, 0, 0, 0};
#pragma unroll
        for (int i = 0; i < 8; ++i) kw2[i] = (bf16x8){0, 0, 0, 0, 0, 0, 0, 0};
        float gprev = 1.0f;
        bf16* OBR = (bf16*)((unsigned char*)A->out + DO_OB);
        const LAS float* gclw = (const LAS float*)(lds + 2 * HALF_BYTES);
        const LAS bf16x8* bek = (const LAS bf16x8*)(lds + SL_BEK) + lane; const LAS bf16x8* tp = (const LAS bf16x8*)(lds + SL_T) + lane;
        const LAS u32x4* bv = (const LAS u32x4*)(lds + SL_BV) + ((w * 2) * 64 + lane) * 2;
        const LAS bf16x8* qkd = (const LAS bf16x8*)(lds + HALF_BYTES + (SL_QKD - HALF_BYTES)) + lane; const LAS bf16x8* qe = (const LAS bf16x8*)(lds + HALF_BYTES + (SL_QE - HALF_BYTES)) + lane;
        const LAS bf16x8* kwt = (const LAS bf16x8*)(lds + HALF_BYTES + (SL_KWT - HALF_BYTES)) + lane;
#define SB() __builtin_amdgcn_sched_barrier(0)
        LDS_BARRIER();
#pragma unroll 1
        for (int c = 0; c < CHUNKS_P; ++c) {
            bf16x8 g0[8], g1[8];
#pragma unroll
            for (int ks = 0; ks < 4; ++ks) { g0[ks] = bek[ks * 64]; g0[4 + ks] = bek[(8 + ks) * 64]; }
            SB();
#pragma unroll
            for (int kb = 2; kb < 4; ++kb) {
                S[kb] = S[kb] * gprev;
#pragma unroll
                for (int ks = 0; ks < 4; ++ks) S[kb] = MFMA32(kw2[(kb - 2) * 4 + ks], uf[ks], S[kb]);
            }
            bf16x8 sf[8];
#pragma unroll
            for (int kb = 0; kb < 4; ++kb) { sf[2 * kb] = pack_step<0>(S[kb]); sf[2 * kb + 1] = pack_step<1>(S[kb]); }
            SB();
#pragma unroll
            for (int ks = 0; ks < 4; ++ks) { g1[ks] = bek[(4 + ks) * 64]; g1[4 + ks] = bek[(12 + ks) * 64]; }
            SB();
            f32x16 x0, x1;
#pragma unroll
            for (int e = 0; e < 16; ++e) { x0[e] = 0.f; x1[e] = 0.f; }
#pragma unroll
            for (int ks = 0; ks < 4; ++ks) { x0 = MFMA32(g0[ks], sf[ks], x0); x1 = MFMA32(g0[4 + ks], sf[ks], x1); }
            SB();
            const u32x4 a0 = bv[0], a1 = bv[1], c0 = bv[128], c1 = bv[129];
            bf16x8 tf[6];
            tf[0] = tp[0 * 64]; tf[1] = tp[1 * 64];
#pragma unroll
            for (int ks = 0; ks < 4; ++ks) tf[2 + ks] = tp[(4 + ks) * 64];
            SB();
#pragma unroll
            for (int ks = 0; ks < 4; ++ks) { x0 = MFMA32(g1[ks], sf[4 + ks], x0); x1 = MFMA32(g1[4 + ks], sf[4 + ks], x1); }
            {
                x0[0] = bflo(a0.x) - x0[0]; x0[1] = bfhi(a0.x) - x0[1]; x0[2] = bflo(a0.y) - x0[2]; x0[3] = bfhi(a0.y) - x0[3];
                x0[4] = bflo(a0.z) - x0[4]; x0[5] = bfhi(a0.z) - x0[5]; x0[6] = bflo(a0.w) - x0[6]; x0[7] = bfhi(a0.w) - x0[7];
                x0[8] = bflo(a1.x) - x0[8]; x0[9] = bfhi(a1.x) - x0[9]; x0[10] = bflo(a1.y) - x0[10]; x0[11] = bfhi(a1.y) - x0[11];
                x0[12] = bflo(a1.z) - x0[12]; x0[13] = bfhi(a1.z) - x0[13]; x0[14] = bflo(a1.w) - x0[14]; x0[15] = bfhi(a1.w) - x0[15];
                x1[0] = bflo(c0.x) - x1[0]; x1[1] = bfhi(c0.x) - x1[1]; x1[2] = bflo(c0.y) - x1[2]; x1[3] = bfhi(c0.y) - x1[3];
                x1[4] = bflo(c0.z) - x1[4]; x1[5] = bfhi(c0.z) - x1[5]; x1[6] = bflo(c0.w) - x1[6]; x1[7] = bfhi(c0.w) - x1[7];
                x1[8] = bflo(c1.x) - x1[8]; x1[9] = bfhi(c1.x) - x1[9]; x1[10] = bflo(c1.y) - x1[10]; x1[11] = bfhi(c1.y) - x1[11];
                x1[12] = bflo(c1.z) - x1[12]; x1[13] = bfhi(c1.z) - x1[13]; x1[14] = bflo(c1.w) - x1[14]; x1[15] = bfhi(c1.w) - x1[15];
            }
            const bf16x8 rf[4] = {pack_step<0>(x0), pack_step<1>(x0), pack_step<0>(x1), pack_step<1>(x1)};
            LDS_BARRIER();
#pragma unroll
            for (int ks = 0; ks < 4; ++ks) { g0[ks] = qe[ks * 64]; g0[4 + ks] = qe[(8 + ks) * 64]; }
            SB();
            f32x16 u0, u1;
#pragma unroll
            for (int e = 0; e < 16; ++e) { u0[e] = 0.f; u1[e] = 0.f; }
            u0 = MFMA32(tf[0], rf[0], u0); u1 = MFMA32(tf[2], rf[0], u1); u0 = MFMA32(tf[1], rf[1], u0);
#pragma unroll
            for (int ks = 1; ks < 4; ++ks) u1 = MFMA32(tf[2 + ks], rf[ks], u1);
            uf[0] = pack_step<0>(u0); uf[1] = pack_step<1>(u0); uf[2] = pack_step<0>(u1); uf[3] = pack_step<1>(u1);
            SB();
#pragma unroll
            for (int ks = 0; ks < 4; ++ks) { g1[ks] = qe[(4 + ks) * 64]; g1[4 + ks] = qe[(12 + ks) * 64]; }
            SB();
#pragma unroll
            for (int e = 0; e < 16; ++e) { x0[e] = 0.f; x1[e] = 0.f; }
#pragma unroll
            for (int ks = 0; ks < 4; ++ks) { x0 = MFMA32(g0[ks], sf[ks], x0); x1 = MFMA32(g0[4 + ks], sf[ks], x1); }
            SB();
            bf16x8 qk[6];
            qk[0] = qkd[0 * 64]; qk[1] = qkd[1 * 64];
#pragma unroll
            for (int ks = 0; ks < 4; ++ks) qk[2 + ks] = qkd[(4 + ks) * 64];
            SB();
#pragma unroll
            for (int ks = 0; ks < 4; ++ks) { x0 = MFMA32(g1[ks], sf[4 + ks], x0); x1 = MFMA32(g1[4 + ks], sf[4 + ks], x1); }
            SB();
#pragma unroll
            for (int i = 0; i < 8; ++i) g0[i] = kwt[i * 64];
            SB();
            x0 = MFMA32(qk[0], uf[0], x0); x1 = MFMA32(qk[2], uf[0], x1); x0 = MFMA32(qk[1], uf[1], x0);
#pragma unroll
            for (int ks = 1; ks < 4; ++ks) x1 = MFMA32(qk[2 + ks], uf[ks], x1);
            SB();
#pragma unroll
            for (int i = 0; i < 8; ++i) kw2[i] = kwt[(8 + i) * 64];
            const float gcl = gclw[c & 7];
            SB();
#pragma unroll
            for (int kb = 0; kb < 2; ++kb) {
                S[kb] = S[kb] * gcl;
#pragma unroll
                for (int ks = 0; ks < 4; ++ks) S[kb] = MFMA32(g0[kb * 4 + ks], uf[ks], S[kb]);
            }
            if (c > 0) {
                bf16* orow = OBR + (size_t)(b * SEQ + 64 * (c - 1)) * OAB_PITCH + h * 128 + dv;
#pragma unroll
                for (int reg = 0; reg < 16; ++reg) { const int i0 = crow16(reg, hh); orow[(size_t)i0 * OAB_PITCH] = f2bf(x0[reg]); orow[(size_t)(32 + i0) * OAB_PITCH] = f2bf(x1[reg]); }
            }
            gprev = gcl;
            LDS_BARRIER();
        }
#pragma unroll
        for (int kb = 2; kb < 4; ++kb) {
            S[kb] = S[kb] * gprev;
#pragma unroll
            for (int ks = 0; ks < 4; ++ks) S[kb] = MFMA32(kw2[(kb - 2) * 4 + ks], uf[ks], S[kb]);
        }
#undef SB
        float* So = A->out + O_DP + ((size_t)(b * 4 + h) * 128) * 128 + dv;
#pragma unroll
        for (int kb = 0; kb < 4; ++kb)
#pragma unroll
            for (int reg = 0; reg < 16; ++reg) So[(size_t)(32 * kb + crow16(reg, hh)) * 128] = S[kb][reg];
    }
}

constexpr int KPITCH = 72, VPITCH = 264;
typedef short v4i16_t __attribute__((ext_vector_type(4)));
DI void attn_unit(KA A, int unit, LAS unsigned char* ldsb) {
    const int tid = threadIdx.x, lane = tid & 63, wave = __builtin_amdgcn_readfirstlane(tid >> 6), r = lane & 31, hh = lane >> 5;
    const int b = unit >> 6, kh = (unit >> 5) & 1, jb = unit & 31, T0 = NMETA + 128 * jb;
    LAS bf16* Ksm = (LAS bf16*)ldsb; LAS bf16* VTs = Ksm + 256 * KPITCH;
    const bf16* KVg = (const bf16*)(A->ws + WS_KV); const bf16* QAg = (const bf16*)(A->ws + WS_QA);
#pragma unroll
    for (int e4 = 0; e4 < 4; ++e4) {
        const int id = tid + 512 * e4, key = id >> 3, cch = id & 7, tk = T0 - 128 + key;
        u32x4 kq = (u32x4){0u, 0u, 0u, 0u}, vq = kq;
        if (tk >= 0) { const bf16* src = KVg + (size_t)(b * TP + tk) * 256 + kh * 64 + 8 * cch; kq = *(const u32x4*)src; vq = *(const u32x4*)(src + 128); }
        *(LAS u32x4*)(Ksm + key * KPITCH + 8 * cch) = kq;
        *(LAS u32x4*)(VTs + key * KPITCH + 8 * cch) = vq;
    }
    LDS_BARRIER();
    const int g = wave >> 1, qh = wave & 1, head = 4 * kh + g;
    const float sink2 = A->sinks[head] * 1.4426950408889634f;
    const int kmin = jb == 0 ? 128 - NMETA : 0;
#pragma unroll 1
    for (int q2 = 0; q2 < 2; ++q2) {
        const int qb = 2 * qh + q2, iq = 32 * qb + r;
        const bf16* qrow = QAg + (size_t)(b * TP + T0 + iq) * 512 + head * 64 + 8 * hh;
        bf16x8 qf[4];
#pragma unroll
        for (int s = 0; s < 4; ++s) qf[s] = *(const bf16x8*)(qrow + 16 * s);
        f32x16 st[5];
        float m = sink2;
#pragma unroll
        for (int kt5 = 0; kt5 < 5; ++kt5) {
            const int kt = qb + kt5;
            f32x16 acc;
#pragma unroll
            for (int e = 0; e < 16; ++e) acc[e] = 0.f;
#pragma unroll
            for (int s = 0; s < 4; ++s) acc = MFMA32(*(const LAS bf16x8*)(Ksm + (32 * kt + r) * KPITCH + 16 * s + 8 * hh), qf[s], acc);
#pragma unroll
            for (int reg = 0; reg < 16; ++reg) { const int kk = 32 * kt + crow16(reg, hh); const bool ok = kk >= iq && kk <= iq + 128 && kk >= kmin;
                acc[reg] = ok ? acc[reg] : -INFINITY; m = fmaxf(m, acc[reg]); }
            st[kt5] = acc;
        }
        m = fmaxf(m, __shfl_xor(m, 32));
        float l = 0.f;
#pragma unroll
        for (int kt5 = 0; kt5 < 5; ++kt5)
#pragma unroll
            for (int reg = 0; reg < 16; ++reg) { const float p = exp2f(st[kt5][reg] - m); st[kt5][reg] = p; l += p; }
        l += __shfl_xor(l, 32); l += exp2f(sink2 - m);
        f32x16 o0, o1;
#pragma unroll
        for (int e = 0; e < 16; ++e) { o0[e] = 0.f; o1[e] = 0.f; }
#pragma unroll
        for (int kt5 = 0; kt5 < 5; ++kt5) {
            const int kt = qb + kt5;
            const bf16x8 p0 = pack_step<0>(st[kt5]), p1 = pack_step<1>(st[kt5]);
            const LAS bf16* vb = VTs + (32 * kt + 4 * hh + ((lane & 15) >> 2)) * KPITCH + 16 * ((lane >> 4) & 1) + 4 * (lane & 3);
#define VTR(ptr) __builtin_amdgcn_ds_read_tr16_b64_v4i16((LAS v4i16_t*)(ptr))
            const v4i16_t a00 = VTR(vb), a01 = VTR(vb + 8 * KPITCH), a10 = VTR(vb + 16 * KPITCH), a11 = VTR(vb + 24 * KPITCH);
            const v4i16_t b00 = VTR(vb + 32), b01 = VTR(vb + 8 * KPITCH + 32), b10 = VTR(vb + 16 * KPITCH + 32), b11 = VTR(vb + 24 * KPITCH + 32);
#undef VTR
            o0 = MFMA32(__builtin_shufflevector(a00, a01, 0, 1, 2, 3, 4, 5, 6, 7), p0, o0); o0 = MFMA32(__builtin_shufflevector(a10, a11, 0, 1, 2, 3, 4, 5, 6, 7), p1, o0);
            o1 = MFMA32(__builtin_shufflevector(b00, b01, 0, 1, 2, 3, 4, 5, 6, 7), p0, o1); o1 = MFMA32(__builtin_shufflevector(b10, b11, 0, 1, 2, 3, 4, 5, 6, 7), p1, o1);
        }
        const float rl = 1.0f / l;
        bf16* orow = (bf16*)((unsigned char*)A->out + DO_OA) + (size_t)(b * SEQ + 128 * jb + iq) * OAB_PITCH + head * 64 + 4 * hh;
#pragma unroll
        for (int g4 = 0; g4 < 4; ++g4) {
            *(u32x2*)(orow + 8 * g4) = (u32x2){cvtpk(o0[4 * g4] * rl, o0[4 * g4 + 1] * rl), cvtpk(o0[4 * g4 + 2] * rl, o0[4 * g4 + 3] * rl)};
            *(u32x2*)(orow + 32 + 8 * g4) = (u32x2){cvtpk(o1[4 * g4] * rl, o1[4 * g4 + 1] * rl), cvtpk(o1[4 * g4 + 2] * rl, o1[4 * g4 + 3] * rl)};
        }
    }
    LDS_BARRIER();
}
DI void sample_attn(KA A, int b, int head, LAS float* wl, int lane) {
    const int kh = head >> 2;
    LAS float* qn = wl; LAS float* ps = wl + 256;
    const bf16* QAg = (const bf16*)(A->ws + WS_QA); const bf16* KVg = (const bf16*)(A->ws + WS_KV);
#pragma unroll
    for (int i = 0; i < 4; ++i) qn[i * 64 + lane] = bf2f(QAg[(size_t)(MP + b * TS + i) * 512 + head * 64 + pos_of_d(lane)]);
    LDS_WAIT(); asm volatile("" ::: "memory");
    const float sink2 = A->sinks[head] * 1.4426950408889634f;
#pragma unroll 1
    for (int kq = 0; kq < 3; ++kq) {
        const int kj = lane + 64 * kq;
        float sc0 = 0.f, sc1 = 0.f, sc2 = 0.f, sc3 = 0.f;
        if (kj < 128) {
            const f32x4* kr = (const f32x4*)(A->cache_k + ((size_t)(b * 128 + kj) * 2 + kh) * 64);
#pragma unroll 4
            for (int d4 = 0; d4 < 16; ++d4) { const f32x4 kv = kr[d4];
                const f32x4 q0 = *(const LAS f32x4*)(qn + 4 * d4), q1 = *(const LAS f32x4*)(qn + 64 + 4 * d4), q2 = *(const LAS f32x4*)(qn + 128 + 4 * d4), q3 = *(const LAS f32x4*)(qn + 192 + 4 * d4);
                sc0 += (kv[0] * q0[0] + kv[1] * q0[1]) + (kv[2] * q0[2] + kv[3] * q0[3]); sc1 += (kv[0] * q1[0] + kv[1] * q1[1]) + (kv[2] * q1[2] + kv[3] * q1[3]);
                sc2 += (kv[0] * q2[0] + kv[1] * q2[1]) + (kv[2] * q2[2] + kv[3] * q2[3]); sc3 += (kv[0] * q3[0] + kv[1] * q3[1]) + (kv[2] * q3[2] + kv[3] * q3[3]); }
        } else if (kj < 132) {
            const bf16* kr = KVg + (size_t)(MP + b * TS + (kj - 128)) * 256 + kh * 64;
#pragma unroll 4
            for (int p = 0; p < 64; ++p) { const float kv = bf2f(kr[p]); const int d = d_of_pos(p);
                sc0 += kv * qn[d]; sc1 += kv * qn[64 + d]; sc2 += kv * qn[128 + d]; sc3 += kv * qn[192 + d]; }
        }
        if (kj < 132) {
            ps[0 * 132 + kj] = (kj >= 0 && kj <= 128) ? sc0 : -INFINITY; ps[1 * 132 + kj] = (kj >= 1 && kj <= 129) ? sc1 : -INFINITY;
            ps[2 * 132 + kj] = (kj >= 2 && kj <= 130) ? sc2 : -INFINITY; ps[3 * 132 + kj] = (kj >= 3 && kj <= 131) ? sc3 : -INFINITY; }
    }
    LDS_WAIT(); asm volatile("" ::: "memory");
    float linv[4];
#pragma unroll
    for (int i = 0; i < 4; ++i) {
        const float s0 = ps[i * 132 + lane], s1 = ps[i * 132 + 64 + lane], s2 = lane < 4 ? ps[i * 132 + 128 + lane] : -INFINITY;
        const float m = wave_max(fmaxf(fmaxf(s0, s1), fmaxf(s2, sink2)));
        const float p0 = exp2f(s0 - m), p1 = exp2f(s1 - m), p2 = exp2f(s2 - m);
        ps[i * 132 + lane] = p0; ps[i * 132 + 64 + lane] = p1; if (lane < 4) ps[i * 132 + 128 + lane] = p2;
        linv[i] = 1.0f / (wave_sum(p0 + p1 + p2) + exp2f(sink2 - m));
    }
    LDS_WAIT(); asm volatile("" ::: "memory");
    float o[4] = {0.f, 0.f, 0.f, 0.f};
#pragma unroll 4
    for (int kj = 0; kj < 128; ++kj) { const float v = A->cache_v[((size_t)(b * 128 + kj) * 2 + kh) * 64 + lane];
#pragma unroll
        for (int i = 0; i < 4; ++i) o[i] += ps[i * 132 + kj] * v; }
#pragma unroll
    for (int kj = 128; kj < 132; ++kj) { const float v = bf2f(KVg[(size_t)(MP + b * TS + (kj - 128)) * 256 + 128 + kh * 64 + lane]);
#pragma unroll
        for (int i = 0; i < 4; ++i) o[i] += ps[i * 132 + kj] * v; }
    bf16* OAg = (bf16*)((unsigned char*)A->out + DO_OA);
#pragma unroll
    for (int i = 0; i < 4; ++i) OAg[(size_t)(NBATCH * SEQ + b * TS + i) * OAB_PITCH + head * 64 + lane] = f2bf(o[i] * linv[i]);
    LDS_WAIT(); asm volatile("" ::: "memory");
}
DI void sample_delta(KA A, int b, int h, int quarter, LAS float* wl, int lane) {
    const bf16* QKVB = (const bf16*)(A->ws + WS_QKVB);
    LAS float* qs = wl; LAS float* ks = wl + 512;
#pragma unroll
    for (int grp = 0; grp < 2; ++grp) {
        float c[4][2];
#pragma unroll
        for (int cc = 0; cc < 2; ++cc) {
            const int ch = grp * 512 + h * 128 + lane + 64 * cc;
            float x[7];
#pragma unroll
            for (int i = 0; i < 3; ++i) x[i] = A->state_conv[((size_t)b * 3 + i) * CONVD + ch];
#pragma unroll
            for (int t = 0; t < 4; ++t) x[3 + t] = bf2f(QKVB[(size_t)(MP + b * TS + t) * CONVD + ch]);
            const float w0 = A->conv_w[ch], w1 = A->conv_w[CONVD + ch], w2 = A->conv_w[2 * CONVD + ch], w3 = A->conv_w[3 * CONVD + ch];
#pragma unroll
            for (int t = 0; t < 4; ++t) c[t][cc] = siluf_(w0 * x[t] + w1 * x[t + 1] + w2 * x[t + 2] + w3 * x[t + 3]);
        }
        LAS float* dst = grp == 0 ? qs : ks;
#pragma unroll
        for (int t = 0; t < 4; ++t) { const float rn = rsqrtf(wave_sum(c[t][0] * c[t][0] + c[t][1] * c[t][1]) + EPS) * (grp == 0 ? 0.08838834764831845f : 1.0f);
            dst[t * 128 + lane] = c[t][0] * rn; dst[t * 128 + 64 + lane] = c[t][1] * rn; }
    }
    LDS_WAIT(); asm volatile("" ::: "memory");
    const int dv = 32 * quarter + (lane >> 1), part = lane & 1;
    float s[64];
    { const float* S0 = A->state_delta + ((size_t)(b * 4 + h) * 128 + 64 * part) * 128 + dv;
#pragma unroll
      for (int i = 0; i < 64; ++i) s[i] = S0[(size_t)i * 128]; }
    bf16* OBR = (bf16*)((unsigned char*)A->out + DO_OB) + (size_t)(NBATCH * SEQ + b * TS) * OAB_PITCH + h * 128 + dv;
#pragma unroll 1
    for (int t = 0; t < 4; ++t) {
        const f32x2 gb = ((const f32x2*)(A->ws + WS_GB))[(size_t)(MP + b * TS + t) * 4 + h];
        float vt;
        { const int ch = 1024 + h * 128 + dv; float x[4];
#pragma unroll
          for (int i = 0; i < 4; ++i) { const int tt = t - 3 + i; x[i] = tt < 0 ? A->state_conv[((size_t)b * 3 + (3 + tt)) * CONVD + ch] : bf2f(QKVB[(size_t)(MP + b * TS + tt) * CONVD + ch]); }
          vt = siluf_(A->conv_w[ch] * x[0] + A->conv_w[CONVD + ch] * x[1] + A->conv_w[2 * CONVD + ch] * x[2] + A->conv_w[3 * CONVD + ch] * x[3]); }
        const float eg = __expf(gb[0]);
        const LAS float* kt = ks + t * 128 + 64 * part; const LAS float* qt = qs + t * 128 + 64 * part;
        float ksum = 0.f;
#pragma unroll
        for (int j = 0; j < 16; ++j) { const f32x4 kk = *(const LAS f32x4*)(kt + 4 * j);
            s[4 * j] *= eg; s[4 * j + 1] *= eg; s[4 * j + 2] *= eg; s[4 * j + 3] *= eg;
            ksum += (s[4 * j] * kk[0] + s[4 * j + 1] * kk[1]) + (s[4 * j + 2] * kk[2] + s[4 * j + 3] * kk[3]); }
        ksum += __shfl_xor(ksum, 1);
        const float u = gb[1] * (vt - ksum);
        float osum = 0.f;
#pragma unroll
        for (int j = 0; j < 16; ++j) { const f32x4 kk = *(const LAS f32x4*)(kt + 4 * j), qq = *(const LAS f32x4*)(qt + 4 * j);
            s[4 * j] += kk[0] * u; s[4 * j + 1] += kk[1] * u; s[4 * j + 2] += kk[2] * u; s[4 * j + 3] += kk[3] * u;
            osum += (s[4 * j] * qq[0] + s[4 * j + 1] * qq[1]) + (s[4 * j + 2] * qq[2] + s[4 * j + 3] * qq[3]); }
        osum += __shfl_xor(osum, 1);
        if (part == 0) OBR[(size_t)t * OAB_PITCH] = f2bf(osum);
    }
    { float* So = A->out + O_DS + ((size_t)(b * 4 + h) * 128 + 64 * part) * 128 + dv;
#pragma unroll
      for (int i = 0; i < 64; ++i) So[(size_t)i * 128] = s[i]; }
    LDS_WAIT(); asm volatile("" ::: "memory");
}
constexpr int NINV_WG = 24;
DI void p23_mixers(KA A, LAS unsigned char* lds, const XcdBarrier& dbg_bar, unsigned ep, int pmode = 0) {
    const int tid = threadIdx.x, lane = tid & 63, wave = __builtin_amdgcn_readfirstlane(tid >> 6), G = gridDim.x, wg = blockIdx.x;
    const int NSCAN = N_PROMPT_SEQ, NP = G - NSCAN - NINV_WG;
    if (wg < NSCAN) { if (!(pmode & 2)) scan_prompt_wg(A, wg, lds, ep); return; }
    if (wg < NSCAN + NINV_WG) {
        const int wv = (wg - NSCAN) * NWAVES + wave, NWV = NINV_WG * NWAVES;
#pragma unroll 1
        for (int m = wv; m < N_ITEMS; m += NWV) {
            const int item = order_item(m), p = m % NP, k = m / NP;
            const float gcl = wait_item(item_flag1(A, item), ep);
            __builtin_amdgcn_fence(__ATOMIC_ACQUIRE, "agent");
            const float* ats = (const float*)((const unsigned char*)A->out + DO_ATS + ((size_t)p * 8 + (k & 7)) * ATS_ITEM);
            if (pmode & 16) { if (lane == 0) __hip_atomic_store(item_granule(A, item), ((unsigned long long)ep << 32) | (unsigned long long)__float_as_uint(gcl), __ATOMIC_RELAXED, __HIP_MEMORY_SCOPE_AGENT); }
            else prep_stage2(A, item, gcl, ats, (LAS float*)(lds + wave * 16384), ep);
        }
        return;
    }
    const int p = wg - NSCAN - NINV_WG;
    if (pmode & 32) {
        for (int m = p * NTHREADS + tid; m < N_ITEMS; m += NP * NTHREADS) { gu64* f = item_flag1(A, order_item(m));
            const unsigned long long o = __hip_atomic_load(f, __ATOMIC_RELAXED, __HIP_MEMORY_SCOPE_AGENT);
            __hip_atomic_store(f, ((unsigned long long)ep << 32) | (o & 0xffffffffull), __ATOMIC_RELAXED, __HIP_MEMORY_SCOPE_AGENT); }
    } else {
        const int ntot = p < N_ITEMS ? (N_ITEMS - 1 - p) / NP + 1 : 0;
        S1Pre P;
        if (ntot > 0) stage1_issue(A, order_item(p), P);
        int prev = -1;
#pragma unroll 1
        for (int k = 0; k < ntot; ++k) {
            const int m = p + NP * k, item = order_item(m), nxt = k + 1 < ntot ? order_item(m + NP) : N_ITEMS;
            float* ats = (float*)((unsigned char*)A->out + DO_ATS + ((size_t)p * 8 + (k & 7)) * ATS_ITEM);
            prep_stage1(A, item, nxt, prev, k >= 8 ? order_item(m - 8 * NP) : -1, k & 1, ats, P, lds, ep, pmode);
            prev = item;
        }
        asm volatile("s_waitcnt vmcnt(0)" ::: "memory"); __syncthreads();
        if (prev >= 0 && tid == 0) __hip_atomic_store(item_flag1(A, prev), ((unsigned long long)ep << 32) | (unsigned long long)__float_as_uint(((const LAS float*)(lds + LDS_GCL))[(ntot - 1) & 1]), __ATOMIC_RELAXED, __HIP_MEMORY_SCOPE_AGENT);
    }
    if (pmode & 1) return;
    for (int u = p; u < NBATCH * NKV * 32; u += NP) attn_unit(A, u, lds);
    const int worker = p * NWAVES + wave, NW = NP * NWAVES;
    LAS float* wl = (LAS float*)(lds + 98304 + wave * 4096);
    for (int it = worker; it < SBATCH * NHB * 4 + SBATCH * NHA; it += NW) {
        if (it < SBATCH * NHB * 4) sample_delta(A, it >> 4, (it >> 2) & 3, it & 3, wl, lane);
        else { const int q = it - SBATCH * NHB * 4; sample_attn(A, q >> 3, q & 7, wl, lane); }
    }
}

DI void p3b_gated_norm(KA A) {
    const int tid = threadIdx.x, lane = tid & 63, wave = tid >> 6, gw = blockIdx.x * NWAVES + wave, NGW = gridDim.x * NWAVES;
    const int head = lane >> 4, dv0 = 8 * (lane & 15);
    const f32x4 w0 = *(const f32x4*)(A->gdn_norm + dv0), w1 = *(const f32x4*)(A->gdn_norm + dv0 + 4);
    bf16* OBg = (bf16*)((unsigned char*)A->out + DO_OB); const bf16* Zg = (const bf16*)(A->ws + WS_Z);
    for (int crow = gw; crow < MC; crow += NGW) {
        const u32x4 ow = *(const u32x4*)(OBg + (size_t)crow * OAB_PITCH + head * 128 + dv0);
        const f32x4 a = {bflo(ow.x), bfhi(ow.x), bflo(ow.y), bfhi(ow.y)}, c = {bflo(ow.z), bfhi(ow.z), bflo(ow.w), bfhi(ow.w)};
        float ss = (a[0] * a[0] + a[1] * a[1]) + (a[2] * a[2] + a[3] * a[3]) + (c[0] * c[0] + c[1] * c[1]) + (c[2] * c[2] + c[3] * c[3]);
        ss += __shfl_xor(ss, 1); ss += __shfl_xor(ss, 2); ss += __shfl_xor(ss, 4); ss += __shfl_xor(ss, 8);
        const float rstd = rsqrtf(ss * (1.0f / 128.0f) + EPS);
        const u32x4 zw = *(const u32x4*)(Zg + (size_t)pg8::crow_to_urow(crow) * 512 + head * 128 + dv0);
        f32x4 y0, y1;
        y0[0] = a[0] * rstd * w0[0] * siluf_(bflo(zw.x)); y0[1] = a[1] * rstd * w0[1] * siluf_(bfhi(zw.x)); y0[2] = a[2] * rstd * w0[2] * siluf_(bflo(zw.y)); y0[3] = a[3] * rstd * w0[3] * siluf_(bfhi(zw.y));
        y1[0] = c[0] * rstd * w1[0] * siluf_(bflo(zw.z)); y1[1] = c[1] * rstd * w1[1] * siluf_(bfhi(zw.z)); y1[2] = c[2] * rstd * w1[2] * siluf_(bflo(zw.w)); y1[3] = c[3] * rstd * w1[3] * siluf_(bfhi(zw.w));
        *(u32x4*)(OBg + (size_t)crow * OAB_PITCH + head * 128 + dv0) = pack8f(y0, y1);
    }
}
DI void p8_final_norm(KA A) {
    const int tid = threadIdx.x, lane = tid & 63, wave = tid >> 6, gw = blockIdx.x * NWAVES + wave, NGW = gridDim.x * NWAVES;
    f32x4 nf[4];
#pragma unroll
    for (int j = 0; j < 4; ++j) nf[j] = ((const f32x4*)A->norm_final)[lane + 64 * j];
    const bf16* H2 = (const bf16*)(A->ws + WS_MB);
    for (int crow = gw; crow < MC; crow += NGW) {
        const u32x2* hrow = (const u32x2*)(H2 + (size_t)crow * D);
        f32x4* row = (f32x4*)(A->out + (size_t)crow * D);
        f32x4 v[4]; float ss = 0.f;
#pragma unroll
        for (int j = 0; j < 4; ++j) { const u32x2 hw = hrow[lane + 64 * j]; v[j] = (f32x4){bflo(hw.x), bfhi(hw.x), bflo(hw.y), bfhi(hw.y)};
            ss += (v[j][0] * v[j][0] + v[j][1] * v[j][1]) + (v[j][2] * v[j][2] + v[j][3] * v[j][3]); }
        const float rstd = rsqrtf(wave_sum(ss) * (1.0f / D) + EPS);
#pragma unroll
        for (int j = 0; j < 4; ++j) row[lane + 64 * j] = v[j] * rstd * nf[j];
    }
}
__global__ void __launch_bounds__(NTHREADS, 2) hybrid_fwd(Args Aval) {
    extern __shared__ __attribute__((aligned(16))) unsigned char lds_raw[];
    LAS unsigned char* lds = (LAS unsigned char*)lds_raw;
    const int tid = threadIdx.x;
    int lo, hi; { KA A0 = kargs(); lo = A0->ph_lo; hi = A0->ph_hi; }
#if MK_N_LAUNCHES == 1
#if MK_BARRIER == 1
    volatile LAS unsigned* MISC = (volatile LAS unsigned*)(lds + LDS_MISC);
    if (tid < 64) MISC[tid] = 0u;
    __syncthreads();
    XcdBarrier bar; { KA A0 = kargs(); bar = xcd_barrier_post((unsigned*)(A0->ws + WS_CTL) + 4096, MISC + 8); }
#define GRID_BAR() xcd_barrier(bar)
#else
    cg::grid_group grid = cg::this_grid();
#define GRID_BAR() grid.sync()
#endif
#else
#define GRID_BAR() do {} while (0)
#endif
#ifndef PH_MASK
#define PH_MASK 0x1ff
#endif
#define IN(k) (((PH_MASK >> (k)) & 1) && lo <= (k) && (k) < hi)
#ifndef PROBE_REP
#define PROBE_REP -1
#endif
#define NREP(k) (PROBE_REP == (k) ? 2 : 1)
#define SEAM(k) do { if (IN(k) && IN((k) + 1)) GRID_BAR(); } while (0)
    const int G = gridDim.x, wgid = blockIdx.x;
#if PROBE_REP == 0
    if (IN(0)) { KA A = kargs(); p0_prologue(A, lds); __syncthreads(); }
#endif
    if (IN(0)) { KA A = kargs(); p0_prologue(A, lds); } SEAM(0);
    if (IN(1)) for (int rep = 0; rep < NREP(1); ++rep) { KA A = kargs(); unsigned char* ws = A->ws;
        pg8::Gemm g{(const bf16*)(ws + WS_XN), (const bf16*)(ws + WS_WIN), MUP, NIN, D}; pg8::StaticOrder S; S.init(MUP, NIN, G, wgid);
        pg8::EpiInProj E{(bf16*)(ws + WS_QA), (bf16*)(ws + WS_KV), (bf16*)(ws + WS_QKVB), (bf16*)(ws + WS_Z), (bf16*)(ws + WS_G),
                         (const float*)(ws + WS_ROPE), (const float*)(ws + WS_ROPE) + (TP + TS) * 32, A->out};
        pg8::gemm_phase<pg8::EpiInProj, pg8::StaticOrder, true, true>(lds, g, S, E);
    } SEAM(1);
#ifndef PROBE_MODE
#define PROBE_MODE 0
#endif
#if PROBE_REP == 2
    if (IN(2)) { KA A = kargs(); p23_mixers(A, lds, bar, 1u); GRID_BAR(); }
    if (IN(2)) { KA A = kargs(); p23_mixers(A, lds, bar, 2u, PROBE_MODE); } SEAM(2);
#else
    if (IN(2)) { KA A = kargs(); p23_mixers(A, lds, bar, 1u); } SEAM(2);
#endif
    if (IN(3)) for (int rep = 0; rep < NREP(3); ++rep) { KA A = kargs(); p3b_gated_norm(A); } SEAM(3);
    if (IN(4)) for (int rep = 0; rep < NREP(4); ++rep) { KA A = kargs(); unsigned char* ws = A->ws;
        const bf16* OABp = (const bf16*)((unsigned char*)A->out + DO_OA); const bf16* Wm = (const bf16*)(ws + WS_WOA);
        { pg8::Gemm g{OABp, Wm, MC, D, 512, 1024}; pg8::StaticOrder S; S.init(MC, D, G, wgid); S.lim = (S.nwg / G) * G;
          pg8::EpiMerge<false> E{(bf16*)(ws + WS_MB), (const bf16*)(ws + WS_G), 0};
          pg8::gemm_phase<pg8::EpiMerge<false>, pg8::StaticOrder, true, true>(lds, g, S, E); }
        asm volatile("s_waitcnt vmcnt(0)" ::: "memory"); __syncthreads();
        { pg8::Gemm g{OABp + 512, Wm + 512, MC, D, 512, 1024}; pg8::StaticOrder S; S.init(MC, D, G, wgid); S.lim = (S.nwg / G) * G;
          pg8::EpiMerge<true> E{(bf16*)(ws + WS_MB), (const bf16*)(ws + WS_G), 1024};
          pg8::gemm_phase<pg8::EpiMerge<true>, pg8::StaticOrder, true, true>(lds, g, S, E); }
        { const int nstr = (MC / 256) * 4 - ((MC / 256) * 4 / G) * G;
          if (wgid < nstr * 4) { const int t = wgid >> 2, sl = wgid & 3, koff = sl * 256;
            pg8::Gemm g{OABp + koff, Wm + koff, MC, D, 256, 1024};
            pg8::SliceOrder S; S.init_slice(MC, D, G, ((MC / 256) * 4 / G) * G, t);
            pg8::EpiSplit<pg8::EpiStoreMB, true> E{pg8::EpiStoreMB{(bf16*)(ws + WS_MB)}, (float*)(ws + WS_SCR) + (size_t)t * 65536, (unsigned*)(ws + WS_CTL + CTL_SPL) + t * 8, 4u, (const bf16*)(ws + WS_G), (sl >> 1) ? 1024 : 0};
            pg8::gemm_phase<pg8::EpiSplit<pg8::EpiStoreMB, true>, pg8::SliceOrder, true, true>(lds, g, S, E); } }
    } SEAM(4);
    if (IN(5)) { KA A = kargs(); unsigned char* ws = A->ws;
        { pg8::Gemm g{(const bf16*)(ws + WS_MB), (const bf16*)(ws + WS_WOUT), MC, D, D}; pg8::StaticOrder S; S.init(MC, D, G, wgid); S.lim = (S.nwg / G) * G;
          pg8::EpiWout<true> E{A->x_prompt, A->x_sample, (bf16*)(ws + WS_HB1), (float*)(ws + WS_CTL + CTL_SS1)};
          pg8::gemm_phase<pg8::EpiWout<true>, pg8::StaticOrder, true, true>(lds, g, S, E); }
        { const int nstr = (MC / 256) * 4 - ((MC / 256) * 4 / G) * G;
          if (wgid < nstr * 4) { const int t = wgid >> 2, koff = (wgid & 3) * 256;
            pg8::Gemm g{(const bf16*)(ws + WS_MB) + koff, (const bf16*)(ws + WS_WOUT) + koff, MC, D, 256, D};
            pg8::SliceOrder S; S.init_slice(MC, D, G, ((MC / 256) * 4 / G) * G, t);
            pg8::EpiSplit<pg8::EpiWout<true>, false> E{pg8::EpiWout<true>{A->x_prompt, A->x_sample, (bf16*)(ws + WS_HB1), (float*)(ws + WS_CTL + CTL_SS1)}, (float*)(ws + WS_SCR) + (size_t)t * 65536, (unsigned*)(ws + WS_CTL + CTL_SPL) + t * 8, 4u, nullptr, 0};
            pg8::gemm_phase<pg8::EpiSplit<pg8::EpiWout<true>, false>, pg8::SliceOrder, true, true>(lds, g, S, E); } }
    } SEAM(5);
    if (IN(6)) for (int rep = 0; rep < NREP(6); ++rep) { KA A = kargs(); unsigned char* ws = A->ws;
        pg8::Gemm g{(const bf16*)(ws + WS_HB1), (const bf16*)(ws + WS_WGU), MC, 2 * DFF, D}; pg8::StaticOrder S; S.init(MC, 2 * DFF, G, wgid);
        pg8::EpiGateUp E{(bf16*)(ws + WS_ACT), (const float*)(ws + WS_CTL + CTL_SS1)};
        pg8::gemm_phase<pg8::EpiGateUp, pg8::StaticOrder, true, true>(lds, g, S, E);
    } SEAM(6);
    if (IN(7)) for (int rep = 0; rep < NREP(7); ++rep) { KA A = kargs(); unsigned char* ws = A->ws;
        { pg8::Gemm g{(const bf16*)(ws + WS_ACT), (const bf16*)(ws + WS_WD), MC, D, DFF}; pg8::StaticOrder S; S.init(MC, D, G, wgid); S.lim = (S.nwg / G) * G;
          pg8::EpiDown<false> E{(const bf16*)(ws + WS_HB1), (bf16*)(ws + WS_MB)};
          pg8::gemm_phase<pg8::EpiDown<false>, pg8::StaticOrder, true, true>(lds, g, S, E); }
        { const int nstr = (MC / 256) * 4 - ((MC / 256) * 4 / G) * G;
          if (wgid < nstr * 11) { const int t = wgid / 11, koff = (wgid % 11) * 256;
            pg8::Gemm g{(const bf16*)(ws + WS_ACT) + koff, (const bf16*)(ws + WS_WD) + koff, MC, D, 256, DFF};
            pg8::SliceOrder S; S.init_slice(MC, D, G, ((MC / 256) * 4 / G) * G, t);
            pg8::EpiSplit<pg8::EpiDown<false>, false> E{pg8::EpiDown<false>{(const bf16*)(ws + WS_HB1), (bf16*)(ws + WS_MB)}, (float*)(ws + WS_SCR) + (size_t)t * 65536, (unsigned*)(ws + WS_CTL + CTL_SPL) + t * 8, 11u, nullptr, 0};
            pg8::gemm_phase<pg8::EpiSplit<pg8::EpiDown<false>, false>, pg8::SliceOrder, true, true>(lds, g, S, E); } }
    } SEAM(7);
    if (IN(8)) { KA A = kargs(); p8_final_norm(A); }
#undef IN
#undef SEAM
}

extern "C" void kernel_launch(void* const* d_in, const int* in_sizes, int n_in, void* d_out, int out_size, void* d_ws, size_t ws_size, hipStream_t stream) {
    static int grid = 0;
    if (grid == 0) {
        if (n_in != 22 || out_size != (int)O_END || ws_size < WS_END) { fprintf(stderr, "kernel_launch: unexpected problem (n_in %d, out %d, ws %zu)\n", n_in, out_size, ws_size); grid = -1; return; }
        int dev = 0, cus = 0, per_cu = 0;
        if (hipGetDevice(&dev) != hipSuccess || hipDeviceGetAttribute(&cus, hipDeviceAttributeMultiprocessorCount, dev) != hipSuccess) { grid = -1; return; }
        if (hipFuncSetAttribute((const void*)hybrid_fwd, hipFuncAttributeMaxDynamicSharedMemorySize, LDS_BYTES) != hipSuccess) { fprintf(stderr, "kernel_launch: hipFuncSetAttribute failed\n"); grid = -1; return; }
        if (hipOccupancyMaxActiveBlocksPerMultiprocessor(&per_cu, (const void*)hybrid_fwd, NTHREADS, LDS_BYTES) != hipSuccess || per_cu < 1) { fprintf(stderr, "kernel_launch: occupancy query says %d\n", per_cu); per_cu = 1; }
        (void)hipGetLastError();
        grid = cus;
        if (grid > 256) grid = 256;
    }
    if (grid < 0) return;
    (void)hipMemsetAsync((char*)d_ws + WS_CTL, 0, CTL_BYTES, stream);
    (void)hipMemsetAsync((char*)d_ws + WS_SCR, 0, SCR_BYTES, stream);
    Args a{};
    const float** ap = (const float**)&a;
    for (int i = 0; i < 22; ++i) ap[i] = (const float*)d_in[i];
    a.out = (float*)d_out; a.ws = (unsigned char*)d_ws;
#if MK_N_LAUNCHES == 1
    a.ph_lo = 0; a.ph_hi = N_PHASES;
#if MK_BARRIER == 1
    hipLaunchKernelGGL(hybrid_fwd, dim3(grid), dim3(NTHREADS), LDS_BYTES, stream, a);
#else
    void* args[] = {&a};
    hipError_t e = hipLaunchCooperativeKernel((const void*)hybrid_fwd, dim3(grid), dim3(NTHREADS), args, LDS_BYTES, stream);
    if (e != hipSuccess) fprintf(stderr, "cooperative launch failed: %s (grid %d)\n", hipGetErrorString(e), grid);
#endif
#else
    for (int p = 0; p < N_PHASES; ++p) { a.ph_lo = p; a.ph_hi = p + 1; hipLaunchKernelGGL(hybrid_fwd, dim3(grid), dim3(NTHREADS), LDS_BYTES, stream, a); }
#endif
}
```

```cpp
#include <hip/hip_runtime.h>
#include <hip/hip_cooperative_groups.h>
#include <cstdio>
#include <cstdint>
namespace cg = cooperative_groups;

#ifndef MK_N_LAUNCHES
#define MK_N_LAUNCHES 1
#endif
#ifndef MK_BARRIER
#define MK_BARRIER 1
#endif

constexpr int D = 1024, NBATCH = 8, SEQ = 4096, NMETA = 16, TP = SEQ + NMETA, MP = NBATCH * TP;
constexpr int SBATCH = 128, TS = 4, MS = SBATCH * TS, MU = MP + MS, MUP = 33536, MC = NBATCH * SEQ + MS;
constexpr int PAST = 16384;
constexpr int HD = 64, NHA = 8, NKV = 2;
constexpr int NHB = 4, CONVD = 1536;
constexpr int DFF = 2816, NIN_SRC = 4872, NIN = 4864;
constexpr float EPS = 1e-6f;
constexpr float QSCALE = 0.125f * 1.4426950408889634f;

constexpr size_t MiB = 1u << 20, KiB = 1024;
constexpr size_t WS_CTL = 0, CTL_BYTES = 1 * MiB;
constexpr size_t WS_WIN = 1 * MiB;
constexpr size_t WS_WOA = 11 * MiB, WS_WOB = 12 * MiB;
constexpr size_t WS_WOUT = 13 * MiB;
constexpr size_t WS_WGU = 15 * MiB;
constexpr size_t WS_WD = 26 * MiB;
constexpr size_t WS_ROPE = 32 * MiB;
constexpr size_t WS_GB = 34 * MiB;
constexpr size_t WS_SC = 36 * MiB;
constexpr size_t WS_SS1 = 37 * MiB, WS_SS2 = 37 * MiB + 512 * KiB;
constexpr size_t WS_SCR = 38 * MiB, SCR_BYTES = 2 * MiB;
constexpr size_t CTL_SPL6 = 53248;
constexpr size_t CTL_SPL = 49152;
constexpr size_t WS_QA = 41 * MiB;
constexpr size_t WS_KV = WS_QA + (size_t)MUP * 512 * 2;
constexpr size_t WS_QKVB = WS_KV + (size_t)MUP * 256 * 2;
constexpr size_t WS_Z = WS_QKVB + (size_t)MUP * 1536 * 2;
constexpr size_t WS_G = WS_Z + (size_t)MUP * 512 * 2;
constexpr size_t WS_GEND = WS_G + (size_t)MUP * 2048 * 2;
constexpr size_t WS_B = 353 * MiB, WS_END = 512 * MiB;
static_assert(WS_GEND <= WS_B, "ws map");
constexpr size_t WS_XN = WS_B;
constexpr size_t PREP_SLOT = 80 * KiB;
constexpr int PREP_N1 = (int)((WS_END - WS_B) / PREP_SLOT);
constexpr size_t DO_OA = 44 * MiB;
constexpr int OAB_PITCH = 1024;
constexpr size_t DO_OB = DO_OA + 512 * 2;
constexpr size_t DO_ATS = DO_OA + (size_t)MC * OAB_PITCH * 2;
constexpr size_t ATS_ITEM = 3 * 32 * 32 * 4;
static_assert(DO_ATS + 212 * 8 * ATS_ITEM <= (size_t)MC * 1024 * 4, "d_out scratch map");
constexpr size_t WS_MB = WS_B;
constexpr size_t WS_HB1 = WS_B + 66 * MiB;
static_assert(WS_HB1 + (size_t)MC * 1024 * 2 <= WS_END, "ws map");
constexpr size_t WS_ACT = WS_QA;
static_assert(WS_ACT + (size_t)MC * DFF * 2 <= WS_G, "ws map");
constexpr int SL_BEK = 0, SL_BV = 16 * 1024, SL_T = 32 * 1024, SL_QKD = 40 * 1024, SL_QE = 48 * 1024, SL_KWT = 64 * 1024;
constexpr int N_PROMPT_SEQ = NBATCH * NHB, CHUNKS_P = 65, N_ITEMS_P = N_PROMPT_SEQ * CHUNKS_P, N_ITEMS = N_ITEMS_P;
static_assert((size_t)(N_ITEMS - PREP_N1) * PREP_SLOT <= DO_OA, "prep slots");

constexpr size_t O_YP = 0, O_YS = (size_t)NBATCH * SEQ * D, O_KP = O_YS + (size_t)MS * D, O_VP = O_KP + 8 * 128 * 2 * 64, O_DP = O_VP + 8 * 128 * 2 * 64,
                 O_CP = O_DP + 8 * 4 * 128 * 128, O_KS = O_CP + 8 * 3 * 1536, O_VS = O_KS + (size_t)128 * 128 * 2 * 64, O_DS = O_VS + (size_t)128 * 128 * 2 * 64,
                 O_CS = O_DS + (size_t)128 * 4 * 128 * 128, O_END = O_CS + (size_t)128 * 3 * 1536;
static_assert(O_END == 48074752, "d_out size");

#define DI __device__ __forceinline__
#define GAS __attribute__((address_space(1)))
#define LAS __attribute__((address_space(3)))
typedef unsigned short bf16;
typedef short bf16x8 __attribute__((ext_vector_type(8)));
typedef float f32x4 __attribute__((ext_vector_type(4)));
typedef float f32x2 __attribute__((ext_vector_type(2)));
typedef float f32x16 __attribute__((ext_vector_type(16)));
typedef unsigned u32x4 __attribute__((ext_vector_type(4)));
typedef unsigned u32x2 __attribute__((ext_vector_type(2)));
typedef __bf16 bf16x2_t __attribute__((ext_vector_type(2)));

DI int tid_opaque() { int t = threadIdx.x; asm volatile("" : "+v"(t)); return t; }
DI unsigned cvtpk(float lo, float hi) { f32x2 v = {lo, hi}; bf16x2_t b = __builtin_convertvector(v, bf16x2_t); return __builtin_bit_cast(unsigned, b); }
DI bf16 f2bf(float f) { return (bf16)(cvtpk(f, 0.f) & 0xffffu); }
DI float bf2f(unsigned short h) { return __uint_as_float((unsigned)h << 16); }
DI float bflo(unsigned w) { return __uint_as_float(w << 16); }
DI float bfhi(unsigned w) { return __uint_as_float(w & 0xffff0000u); }
DI u32x4 pack8f(f32x4 a, f32x4 b) { u32x4 w; w.x = cvtpk(a[0], a[1]); w.y = cvtpk(a[2], a[3]); w.z = cvtpk(b[0], b[1]); w.w = cvtpk(b[2], b[3]); return w; }
DI float frcp_(float x) { return __builtin_amdgcn_rcpf(x); }
DI float sigmoidf_(float x) { return frcp_(1.0f + __builtin_amdgcn_exp2f(x * -1.4426950408889634f)); }
DI float siluf_(float x) { return x * sigmoidf_(x); }
DI void st16_sc1(void* p, u32x4 v) { asm volatile("global_store_dwordx4 %0, %1, off sc1\n\ts_nop 1" :: "v"(p), "v"(v) : "memory"); }
DI void st16_sc1f(void* p, f32x4 v) { asm volatile("global_store_dwordx4 %0, %1, off sc1\n\ts_nop 1" :: "v"(p), "v"(v) : "memory"); }
DI void st2_sc1(void* p, unsigned v) { asm volatile("global_store_short %0, %1, off sc1\n\ts_nop 1" :: "v"(p), "v"(v) : "memory"); }
constexpr size_t CTL_GRAN = 65536, CTL_CNT = 245760, CTL_SS1 = 458752;
static_assert(CTL_CNT + 5 * 130 * 256 <= CTL_SS1 && CTL_SS1 + 33280 * 4 <= 1048576 && CTL_GRAN + 2592 * 64 <= CTL_CNT, "control region map");
constexpr int CNT_STRIDE = 130 * 64;
DI int pos_of_d(int d) { const int dd = d & 31; return 8 * (dd >> 2) + (dd & 3) + ((d >> 5) << 2); }
DI int d_of_pos(int p) { const int j = p & 7; return 4 * (p >> 3) + (j & 3) + ((j >> 2) << 5); }
namespace pg8 {
#define PG8_LAS __attribute__((address_space(3)))
typedef unsigned short bf16_t;
typedef short bf16x8 __attribute__((ext_vector_type(8)));
typedef float f32x4 __attribute__((ext_vector_type(4)));
typedef unsigned u32x4 __attribute__((ext_vector_type(4)));
constexpr int BM = 256, BK = 64, HALF = 128, HTB = HALF * BK * 2  , STAGE_BYTES = 8 * HTB, NXCD = 8, WGM = 8;

__host__ __device__ __forceinline__ int lds_byte(int r, int c) { const int st = (r >> 4) * 2 + (c >> 5), rr = r & 15, cc = c & 31, ob = rr * 64 + cc * 2; return st * 1024 + (ob ^ (((ob >> 9) & 1) << 5)); }
__host__ __device__ __forceinline__ void stage_rc(int b, int& R, int& C) { const int st = b / 1024, sb = b % 1024, swz = sb ^ (((sb >> 9) & 1) << 5); R = (st >> 1) * 16 + swz / 64; C = (st & 1) * 32 + (swz % 64) / 2; }
__host__ __device__ __forceinline__ int perm32(int rho) { const int n = rho >> 4, i = rho & 15; return 8 * (i >> 2) + 4 * n + (i & 3); }

struct Unit { int pm, pn; };
struct Gemm { const bf16_t* A; const bf16_t* Bt; int M, N, K; int ldk; };

struct StaticOrder {
    static constexpr bool A_SC1 = false;
    int nM, nN, nwg, G, c, lim;
    __host__ __device__ void init(int M, int N, int G_, int c_) { nM = M / BM; nN = N / BM; nwg = nM * nN; G = G_; c = c_; lim = nwg; }
    __host__ __device__ bool next(int i, Unit& u) const {
        const long L = (long)i * G + c; if (L >= lim) return false;
        int wgid = (int)L; { const int q = nwg / NXCD, r = nwg % NXCD, xcd = wgid % NXCD, off = wgid / NXCD; wgid = (xcd < r ? xcd * (q + 1) : r * (q + 1) + (xcd - r) * q) + off; }
        const int nig = WGM * nN, gid = wgid / nig, fm = gid * WGM, gsz = (nM - fm) < WGM ? (nM - fm) : WGM;
        u.pm = fm + ((wgid % nig) % gsz); u.pn = (wgid % nig) / gsz; return true;
    }
    __device__ __forceinline__ void a_ready(const Unit&) const {}
    __device__ __forceinline__ void done(const Unit&) const {}
};
struct FlagOrder : StaticOrder {
    static constexpr bool A_SC1 = true;
    const unsigned* ready; unsigned need; unsigned* pub; unsigned* gpub;
    __device__ __forceinline__ void a_ready(const Unit& u) const {
        if (ready) {
            if (threadIdx.x < 64) { unsigned spins = 0;
                while ((unsigned)__builtin_amdgcn_readfirstlane(__hip_atomic_load(ready + 64 * u.pm, __ATOMIC_RELAXED, __HIP_MEMORY_SCOPE_AGENT)) < need) { __builtin_amdgcn_s_sleep(2); if (++spins > (1u << 22)) break; } }
            asm volatile("" ::: "memory"); __builtin_amdgcn_s_barrier(); asm volatile("" ::: "memory");
        }
    }
    __device__ __forceinline__ void done(const Unit& u) const {
        if (pub) { asm volatile("s_waitcnt vmcnt(0)" ::: "memory");
            if ((threadIdx.x & 63) == 0) { __hip_atomic_fetch_add(pub + 64 * u.pm, 1u, __ATOMIC_RELAXED, __HIP_MEMORY_SCOPE_AGENT); if (gpub) __hip_atomic_fetch_add(gpub, 1u, __ATOMIC_RELAXED, __HIP_MEMORY_SCOPE_AGENT); } }
    }
};
struct SliceOrder : StaticOrder {
    int t;
    __host__ __device__ void init_slice(int M, int N, int G_, int first, int t_) { init(M, N, G_, 0); t = t_; c = first + t_; G = 0; }
    __host__ __device__ bool next(int i, Unit& u) const { return i == 0 ? StaticOrder::next(0, u) : false; }
};

__device__ __forceinline__ void urow_info(int urow, int& kind, int& b, int& t, int& ridx) {
    if (urow < MP) { b = urow / TP; t = urow - b * TP; kind = 0; ridx = t; }
    else if (urow < MU) { const int s = urow - MP; b = s >> 2; t = s & 3; kind = 1; ridx = TP + t; }
    else { kind = 2; b = 0; t = 0; ridx = 0; }
}
__device__ __forceinline__ int crow_to_urow(int crow) { return crow < NBATCH * SEQ ? crow + NMETA * ((crow >> 12) + 1) : MP + (crow - NBATCH * SEQ); }

struct EpiInProj {
    static constexpr bool PERM = true, AFTER_DRAIN = false;
    bf16_t *QA, *KV, *QKVB, *Z, *G; const float *COS, *SIN; float* out;
    __device__ __forceinline__ void operator()(const f32x4 (&acc)[2][2][4][2], const Unit& u, int wr, int wc, int fr, int fq) const {
        const int pn = u.pn;
#pragma unroll
        for (int ai = 0; ai < 2; ++ai)
#pragma unroll
            for (int m = 0; m < 4; ++m) {
                const int row = u.pm * BM + ai * HALF + wr * 64 + m * 16 + fr;
                int kind, b, t, ridx; urow_info(row, kind, b, t, ridx);
#pragma unroll
                for (int bj = 0; bj < 2; ++bj) {
                    const int cl = bj * HALF + wc * 32 + 8 * fq;
                    const f32x4 v0 = acc[ai][bj][m][0], v1 = acc[ai][bj][m][1];
                    if (pn < 2) {
                        const int c = pn * 256 + cl, d0 = ((c & 63) >> 3) * 4;
                        const f32x4 cs = *(const f32x4*)(COS + ridx * 32 + d0), sn = *(const f32x4*)(SIN + ridx * 32 + d0);
                        const f32x4 o1 = (v0 * cs - v1 * sn) * QSCALE, o2 = (v1 * cs + v0 * sn) * QSCALE;
                        *(u32x4*)(QA + (size_t)row * 512 + c) = pack8f(o1, o2);
                    } else if (pn == 2) {
                        if (bj == 0) {
                            const int kh = cl >> 6, d0 = ((cl & 63) >> 3) * 4;
                            const f32x4 cs = *(const f32x4*)(COS + ridx * 32 + d0), sn = *(const f32x4*)(SIN + ridx * 32 + d0);
                            const f32x4 o1 = v0 * cs - v1 * sn, o2 = v1 * cs + v0 * sn;
                            *(u32x4*)(KV + (size_t)row * 256 + cl) = pack8f(o1, o2);
                            float* dst = nullptr;
                            if (kind == 0 && t >= TP - 128) dst = out + O_KP + ((size_t)(b * 128 + (t - (TP - 128))) * 2 + kh) * 64;
                            else if (kind == 1) dst = out + O_KS + ((size_t)(b * 128 + 124 + t) * 2 + kh) * 64;
                            if (dst) { *(f32x4*)(dst + d0) = o1; *(f32x4*)(dst + 32 + d0) = o2; }
                        } else {
                            const int cv = cl - 128, kh = cv >> 6, dd = cv & 63;
                            *(u32x4*)(KV + (size_t)row * 256 + cl) = pack8f(v0, v1);
                            float* dst = nullptr;
                            if (kind == 0 && t >= TP - 128) dst = out + O_VP + ((size_t)(b * 128 + (t - (TP - 128))) * 2 + kh) * 64;
                            else if (kind == 1) dst = out + O_VS + ((size_t)(b * 128 + 124 + t) * 2 + kh) * 64;
                            if (dst) { *(f32x4*)(dst + dd) = v0; *(f32x4*)(dst + dd + 4) = v1; }
                        }
                    } else if (pn < 9) {
                        const int c = (pn - 3) * 256 + cl;
                        *(u32x4*)(QKVB + (size_t)row * 1536 + c) = pack8f(v0, v1);
                        float* dst = nullptr;
                        if (kind == 0 && t >= TP - 3) dst = out + O_CP + ((size_t)b * 3 + (t - (TP - 3))) * 1536;
                        else if (kind == 1 && t >= 1) dst = out + O_CS + ((size_t)b * 3 + (t - 1)) * 1536;
                        if (dst) { *(f32x4*)(dst + c) = v0; *(f32x4*)(dst + c + 4) = v1; }
                    } else if (pn < 11) {
                        const int c = (pn - 9) * 256 + cl;
                        *(u32x4*)(Z + (size_t)row * 512 + c) = pack8f(v0, v1);
                    } else {
                        const int c = (pn - 11) * 256 + cl;
                        f32x4 g0, g1;
#pragma unroll
                        for (int e = 0; e < 4; ++e) { g0[e] = sigmoidf_(v0[e]); g1[e] = sigmoidf_(v1[e]); }
                        *(u32x4*)(G + (size_t)row * 2048 + c) = pack8f(g0, g1);
                    }
                }
            }
    }
};

template <bool ACCUM> struct EpiMerge {
    static constexpr bool PERM = true, AFTER_DRAIN = false;
    bf16_t* MBp; const bf16_t* G; int gate_off;
    __device__ __forceinline__ void operator()(const f32x4 (&acc)[2][2][4][2], const Unit& u, int wr, int wc, int fr, int fq) const {
#pragma unroll
        for (int ai = 0; ai < 2; ++ai)
#pragma unroll
            for (int m = 0; m < 4; ++m) {
                const int crow = u.pm * BM + ai * HALF + wr * 64 + m * 16 + fr, urow = crow_to_urow(crow);
#pragma unroll
                for (int bj = 0; bj < 2; ++bj) {
                    const int c = u.pn * BM + bj * HALF + wc * 32 + 8 * fq;
                    const u32x4 gw = *(const u32x4*)(G + (size_t)urow * 2048 + gate_off + c);
                    f32x4 v0 = acc[ai][bj][m][0], v1 = acc[ai][bj][m][1];
                    v0[0] *= bflo(gw.x); v0[1] *= bfhi(gw.x); v0[2] *= bflo(gw.y); v0[3] *= bfhi(gw.y);
                    v1[0] *= bflo(gw.z); v1[1] *= bfhi(gw.z); v1[2] *= bflo(gw.w); v1[3] *= bfhi(gw.w);
                    bf16_t* p = MBp + (size_t)crow * 1024 + c;
                    if (ACCUM) { const u32x4 pw = *(const u32x4*)p;
                        v0[0] += bflo(pw.x); v0[1] += bfhi(pw.x); v0[2] += bflo(pw.y); v0[3] += bfhi(pw.y);
                        v1[0] += bflo(pw.z); v1[1] += bfhi(pw.z); v1[2] += bflo(pw.w); v1[3] += bfhi(pw.w); }
                    *(u32x4*)p = pack8f(v0, v1);
                }
            }
    }
};

template <bool ATOM = true> struct EpiWout {
    static constexpr bool PERM = true, AFTER_DRAIN = false;
    const float* xp; const float* xs; bf16_t* HB; float* SS;
    __device__ __forceinline__ void operator()(const f32x4 (&acc)[2][2][4][2], const Unit& u, int wr, int wc, int fr, int fq) const {
#pragma unroll
        for (int ai = 0; ai < 2; ++ai)
#pragma unroll
            for (int m = 0; m < 4; ++m) {
                const int crow = u.pm * BM + ai * HALF + wr * 64 + m * 16 + fr;
                const float* hs = crow < NBATCH * SEQ ? xp + (size_t)crow * D : xs + (size_t)(crow - NBATCH * SEQ) * D;
                float ss = 0.f;
#pragma unroll
                for (int bj = 0; bj < 2; ++bj) {
                    const int c = u.pn * BM + bj * HALF + wc * 32 + 8 * fq;
                    const f32x4 r0 = *(const f32x4*)(hs + c) + acc[ai][bj][m][0], r1 = *(const f32x4*)(hs + c + 4) + acc[ai][bj][m][1];
                    *(u32x4*)(HB + (size_t)crow * D + c) = pack8f(r0, r1);
                    ss += (r0[0] * r0[0] + r0[1] * r0[1]) + (r0[2] * r0[2] + r0[3] * r0[3]) + (r1[0] * r1[0] + r1[1] * r1[1]) + (r1[2] * r1[2] + r1[3] * r1[3]);
                }
                ss += __shfl_xor(ss, 16); ss += __shfl_xor(ss, 32);
                if (ATOM && fq == 0) atomicAdd(SS + crow, ss);
            }
    }
};

struct EpiGateUp {
    static constexpr bool PERM = true, AFTER_DRAIN = false;
    bf16_t* ACT; const float* SS;
    __device__ __forceinline__ void operator()(const f32x4 (&acc)[2][2][4][2], const Unit& u, int wr, int wc, int fr, int fq) const {
#pragma unroll
        for (int ai = 0; ai < 2; ++ai)
#pragma unroll
            for (int m = 0; m < 4; ++m) {
                const int crow = u.pm * BM + ai * HALF + wr * 64 + m * 16 + fr;
                const float rstd = rsqrtf(SS[crow] * (1.0f / D) + EPS);
                f32x4 a[2];
#pragma unroll
                for (int n = 0; n < 2; ++n)
#pragma unroll
                    for (int e = 0; e < 4; ++e) { const float g = acc[ai][0][m][n][e] * rstd, up = acc[ai][1][m][n][e] * rstd; a[n][e] = siluf_(g) * up; }
                *(u32x4*)(ACT + (size_t)crow * DFF + u.pn * HALF + wc * 32 + 8 * fq) = pack8f(a[0], a[1]);
            }
    }
};

template <bool DRY = false> struct EpiDown {
    static constexpr bool PERM = true, AFTER_DRAIN = false;
    const bf16_t* HB; bf16_t* H2;
    __device__ __forceinline__ void operator()(const f32x4 (&acc)[2][2][4][2], const Unit& u, int wr, int wc, int fr, int fq) const {
#pragma unroll
        for (int ai = 0; ai < 2; ++ai)
#pragma unroll
            for (int m = 0; m < 4; ++m) {
                const int crow = u.pm * BM + ai * HALF + wr * 64 + m * 16 + fr;
#pragma unroll
                for (int bj = 0; bj < 2; ++bj) {
                    const size_t off = (size_t)crow * D + u.pn * BM + bj * HALF + wc * 32 + 8 * fq;
                    const u32x4 hw = *(const u32x4*)(HB + off);
                    f32x4 r0 = acc[ai][bj][m][0], r1 = acc[ai][bj][m][1];
                    r0[0] += bflo(hw.x); r0[1] += bfhi(hw.x); r0[2] += bflo(hw.y); r0[3] += bfhi(hw.y);
                    r1[0] += bflo(hw.z); r1[1] += bfhi(hw.z); r1[2] += bflo(hw.w); r1[3] += bfhi(hw.w);
                    *(u32x4*)(H2 + off) = pack8f(r0, r1);
                }
            }
    }
};

template <class Inner, bool GATED = false> struct EpiSplit {
    static constexpr bool PERM = Inner::PERM, AFTER_DRAIN = false;
    Inner inner; float* scr; unsigned* cnt; unsigned S; const bf16_t* G; int gate_off;
    __device__ __forceinline__ void operator()(const f32x4 (&acc_)[2][2][4][2], const Unit& u, int wr, int wc, int fr, int fq) const {
        f32x4 (&acc)[2][2][4][2] = const_cast<f32x4 (&)[2][2][4][2]>(acc_);
        const int lane = fr + 16 * fq, wave = wr * 4 + wc;
        float* p = scr + (size_t)wave * 8192 + lane;
#pragma unroll
        for (int ai = 0; ai < 2; ++ai)
#pragma unroll
            for (int m = 0; m < 4; ++m) {
                int urow = 0;
                if (GATED) urow = crow_to_urow(u.pm * BM + ai * HALF + wr * 64 + m * 16 + fr);
#pragma unroll
                for (int bj = 0; bj < 2; ++bj) {
                    f32x4 v0 = acc[ai][bj][m][0], v1 = acc[ai][bj][m][1];
                    if (GATED) { const u32x4 gw = *(const u32x4*)(G + (size_t)urow * 2048 + gate_off + u.pn * BM + bj * HALF + wc * 32 + 8 * fq);
                        v0[0] *= bflo(gw.x); v0[1] *= bfhi(gw.x); v0[2] *= bflo(gw.y); v0[3] *= bfhi(gw.y); v1[0] *= bflo(gw.z); v1[1] *= bfhi(gw.z); v1[2] *= bflo(gw.w); v1[3] *= bfhi(gw.w); }
                    float* q = p + (((ai * 2 + bj) * 4 + m) * 8) * 64;
                    asm volatile("" : "+v"(q));
#pragma unroll
                    for (int x = 0; x < 4; ++x) { unsafeAtomicAdd(q + x * 64, v0[x]); unsafeAtomicAdd(q + (4 + x) * 64, v1[x]); }
                }
            }
        asm volatile("s_waitcnt vmcnt(0)" ::: "memory");
        unsigned old = 0u;
        if (lane == 0) old = __hip_atomic_fetch_add(cnt + wave, 1u, __ATOMIC_RELAXED, __HIP_MEMORY_SCOPE_AGENT);
        old = (unsigned)__builtin_amdgcn_readfirstlane((int)old);
        if (old == S - 1u) {
#pragma unroll
            for (int ai = 0; ai < 2; ++ai)
#pragma unroll
                for (int bj = 0; bj < 2; ++bj)
#pragma unroll
                    for (int m = 0; m < 4; ++m) {
                        float* q = p + (((ai * 2 + bj) * 4 + m) * 8) * 64;
                        asm volatile("" : "+v"(q));
#pragma unroll
                        for (int n = 0; n < 2; ++n)
#pragma unroll
                            for (int x = 0; x < 4; ++x) acc[ai][bj][m][n][x] = __hip_atomic_exchange(q + (n * 4 + x) * 64, 0.0f, __ATOMIC_RELAXED, __HIP_MEMORY_SCOPE_AGENT);
                    }
            if (lane == 0) __hip_atomic_store(cnt + wave, 0u, __ATOMIC_RELAXED, __HIP_MEMORY_SCOPE_AGENT);
            inner(acc, u, wr, wc, fr, fq);
        }
    }
};
struct EpiStoreMB {
    static constexpr bool PERM = true, AFTER_DRAIN = false;
    bf16_t* MBp;
    __device__ __forceinline__ void operator()(const f32x4 (&acc)[2][2][4][2], const Unit& u, int wr, int wc, int fr, int fq) const {
#pragma unroll
        for (int ai = 0; ai < 2; ++ai)
#pragma unroll
            for (int m = 0; m < 4; ++m) {
                const int crow = u.pm * BM + ai * HALF + wr * 64 + m * 16 + fr;
#pragma unroll
                for (int bj = 0; bj < 2; ++bj) *(u32x4*)(MBp + (size_t)crow * 1024 + u.pn * BM + bj * HALF + wc * 32 + 8 * fq) = pack8f(acc[ai][bj][m][0], acc[ai][bj][m][1]);
            }
    }
};

template <class Epi, class Sched, bool ALIGN_EPI = false, bool SP2 = false>
__device__ __forceinline__ void gemm_phase(PG8_LAS unsigned char* lds, const Gemm g, const Sched& S, const Epi& E) {
    const int tid = tid_opaque(), wid = __builtin_amdgcn_readfirstlane(tid >> 6), lane = tid & 63, wr = wid >> 2, wc = wid & 3, fr = lane & 15, fq = lane >> 4;
    const int K = g.ldk ? g.ldk : g.K, nt = g.K / BK;
    unsigned voffA[2], voffB[2];
#pragma unroll
    for (int i = 0; i < 2; ++i) { int R, C; stage_rc(tid * 16 + i * 8192, R, C); const int Rb = Epi::PERM ? ((R & ~31) + perm32(R & 31)) : R;
        voffA[i] = (unsigned)(R * K + C) * 2u; voffB[i] = (unsigned)(Rb * K + C) * 2u; }
    const size_t kstep = (size_t)(BK * 2);
    const size_t hstep = (size_t)HALF * K * 2;
    const size_t tstep = 2 * hstep;
    const unsigned ldsw = (unsigned)wid * 1024u;
    const int aoff = lds_byte(wr * 64 + fr, fq * 8), boff = lds_byte(wc * 32 + fr, fq * 8);
#define PG8_SA(b, h) (((b) * 2 + (h)) * HTB)
#define PG8_SB(b, h) ((4 + (b) * 2 + (h)) * HTB)
#define PG8_STAGE(bufoff, gbase, voff) do { _Pragma("unroll") for (int _i = 0; _i < 2; ++_i) \
        __builtin_amdgcn_global_load_lds((const unsigned*)((const char*)(gbase) + (voff)[_i]), (PG8_LAS unsigned*)(lds + (bufoff) + ldsw + _i * 8192), 16, 0, 0); } while (0)
#define PG8_STAGE_A(bufoff, gbase, voff) do { _Pragma("unroll") for (int _i = 0; _i < 2; ++_i) { \
        if constexpr (Sched::A_SC1) __builtin_amdgcn_global_load_lds((const unsigned*)((const char*)(gbase) + (voff)[_i]), (PG8_LAS unsigned*)(lds + (bufoff) + ldsw + _i * 8192), 16, 0, 16); \
        else __builtin_amdgcn_global_load_lds((const unsigned*)((const char*)(gbase) + (voff)[_i]), (PG8_LAS unsigned*)(lds + (bufoff) + ldsw + _i * 8192), 16, 0, 0); } } while (0)
#define PG8_LDA(dst, b, h) do { _Pragma("unroll") for (int m = 0; m < 4; ++m) _Pragma("unroll") for (int k = 0; k < 2; ++k) dst[m][k] = *(const PG8_LAS bf16x8*)(lds + PG8_SA(b, h) + aoff + m * 2048 + k * 1024); } while (0)
#define PG8_LDB(dst, b, h) do { _Pragma("unroll") for (int n = 0; n < 2; ++n) _Pragma("unroll") for (int k = 0; k < 2; ++k) dst[n][k] = *(const PG8_LAS bf16x8*)(lds + PG8_SB(b, h) + boff + n * 2048 + k * 1024); } while (0)
#define PG8_MMA(ai, bj, At, Bt) do { __builtin_amdgcn_s_setprio(1); _Pragma("unroll") for (int m = 0; m < 4; ++m) _Pragma("unroll") for (int n = 0; n < 2; ++n) _Pragma("unroll") for (int k = 0; k < 2; ++k) \
        acc[ai][bj][m][n] = __builtin_amdgcn_mfma_f32_16x16x32_bf16(Bt[n][k], At[m][k], acc[ai][bj][m][n], 0, 0, 0); __builtin_amdgcn_s_setprio(0); } while (0)
#define PG8_WAIT_V(n) asm volatile("s_waitcnt vmcnt(" #n ")" ::: "memory")
#define PG8_WAIT_L(n) asm volatile("s_waitcnt lgkmcnt(" #n ")" ::: "memory")
#define PG8_BAR __builtin_amdgcn_s_barrier()
#define PG8_SCHED __builtin_amdgcn_sched_barrier(0)
    Unit cur, nxt; int ui = 0;
    if (!S.next(0, cur)) return;
    f32x4 acc[2][2][4][2];
#pragma unroll
    for (int a = 0; a < 2; ++a)
#pragma unroll
        for (int b = 0; b < 2; ++b)
#pragma unroll
            for (int m = 0; m < 4; ++m)
#pragma unroll
                for (int n = 0; n < 2; ++n) acc[a][b][m][n] = (f32x4){0.f, 0.f, 0.f, 0.f};
    bf16x8 At[4][2], B0[2][2], B1[2][2];
    const char* cA = (const char*)g.A + (size_t)cur.pm * tstep; const char* cB = (const char*)g.Bt + (size_t)cur.pn * tstep;
    S.a_ready(cur);
    if constexpr (SP2) {
        PG8_STAGE(PG8_SB(0, 0), cB, voffB); PG8_STAGE(PG8_SB(0, 1), cB + hstep, voffB); PG8_STAGE_A(PG8_SA(0, 0), cA, voffA); PG8_STAGE_A(PG8_SA(0, 1), cA + hstep, voffA);
        if (wr == 1) PG8_BAR;
        PG8_WAIT_V(2); PG8_BAR;
        PG8_STAGE(PG8_SB(1, 0), cB + kstep, voffB); PG8_STAGE_A(PG8_SA(1, 0), cA + kstep, voffA); PG8_STAGE(PG8_SB(1, 1), cB + hstep + kstep, voffB);
        PG8_WAIT_V(6); PG8_BAR;
    } else {
        PG8_STAGE(PG8_SB(0, 0), cB, voffB); PG8_STAGE_A(PG8_SA(0, 0), cA, voffA); PG8_STAGE(PG8_SB(0, 1), cB + hstep, voffB); PG8_STAGE_A(PG8_SA(0, 1), cA + hstep, voffA);
        if (wr == 1) PG8_BAR;
        PG8_WAIT_V(4); PG8_BAR;
        PG8_STAGE(PG8_SB(1, 0), cB + kstep, voffB); PG8_STAGE_A(PG8_SA(1, 0), cA + kstep, voffA); PG8_STAGE(PG8_SB(1, 1), cB + hstep + kstep, voffB);
        PG8_WAIT_V(6); PG8_BAR;
    }
    for (;;) {
        const bool has_next = S.next(ui + 1, nxt);
        const char* nA = has_next ? (const char*)g.A + (size_t)nxt.pm * tstep : cA; const char* nB = has_next ? (const char*)g.Bt + (size_t)nxt.pn * tstep : cB;
        for (int t = 0; t < nt; t += 2) {
            const bool last = (t == nt - 2);
            const char* a1 = cA + (size_t)(t + 1) * kstep;
            const char* a2 = last ? nA : cA + (size_t)(t + 2) * kstep; const char* b2 = last ? nB : cB + (size_t)(t + 2) * kstep;
            const char* a3 = a2 + kstep; const char* b3 = b2 + kstep;
            if (last && has_next) S.a_ready(nxt);
            if constexpr (SP2) {
            PG8_LDB(B0, 0, 0); PG8_LDB(B1, 0, 1); PG8_SCHED; PG8_LDA(At, 0, 0); PG8_STAGE_A(PG8_SA(1, 1), a1 + hstep, voffA);
            PG8_WAIT_V(8); PG8_WAIT_L(0); PG8_BAR; PG8_MMA(0, 0, At, B0); PG8_MMA(0, 1, At, B1); PG8_BAR; PG8_SCHED;
            PG8_LDA(At, 0, 1); PG8_STAGE(PG8_SB(0, 0), b2, voffB); PG8_STAGE(PG8_SB(0, 1), b2 + hstep, voffB); PG8_STAGE_A(PG8_SA(0, 0), a2, voffA);
            PG8_WAIT_V(8); PG8_WAIT_L(0); PG8_BAR; PG8_MMA(1, 0, At, B0); PG8_MMA(1, 1, At, B1); PG8_BAR; PG8_SCHED;
            PG8_LDB(B0, 1, 0); PG8_LDB(B1, 1, 1); PG8_SCHED; PG8_LDA(At, 1, 0); PG8_STAGE_A(PG8_SA(0, 1), a2 + hstep, voffA);
            PG8_WAIT_V(8); PG8_WAIT_L(0); PG8_BAR; PG8_MMA(0, 0, At, B0); PG8_MMA(0, 1, At, B1); PG8_BAR; PG8_SCHED;
            PG8_LDA(At, 1, 1); PG8_STAGE(PG8_SB(1, 0), b3, voffB); PG8_STAGE(PG8_SB(1, 1), b3 + hstep, voffB); PG8_STAGE_A(PG8_SA(1, 0), a3, voffA);
            PG8_WAIT_V(8); PG8_WAIT_L(0); PG8_BAR; PG8_MMA(1, 0, At, B0); PG8_MMA(1, 1, At, B1); PG8_BAR; PG8_SCHED;
            } else {
            PG8_LDB(B0, 0, 0); PG8_SCHED; PG8_LDA(At, 0, 0); PG8_STAGE_A(PG8_SA(1, 1), a1 + hstep, voffA);
            PG8_WAIT_L(8); PG8_BAR; PG8_WAIT_L(0); PG8_MMA(0, 0, At, B0); PG8_BAR; PG8_SCHED;
            PG8_LDB(B1, 0, 1); PG8_STAGE(PG8_SB(0, 0), b2, voffB);
            PG8_BAR; PG8_WAIT_L(0); PG8_MMA(0, 1, At, B1); PG8_BAR;
            PG8_LDA(At, 0, 1); PG8_STAGE_A(PG8_SA(0, 0), a2, voffA);
            PG8_BAR; PG8_WAIT_L(0); PG8_MMA(1, 0, At, B0); PG8_BAR; PG8_SCHED;
            PG8_STAGE(PG8_SB(0, 1), b2 + hstep, voffB);
            PG8_WAIT_V(6); PG8_BAR; PG8_MMA(1, 1, At, B1); PG8_BAR;
            PG8_LDB(B0, 1, 0); PG8_SCHED; PG8_LDA(At, 1, 0); PG8_STAGE_A(PG8_SA(0, 1), a2 + hstep, voffA);
            PG8_WAIT_L(8); PG8_BAR; PG8_WAIT_L(0); PG8_MMA(0, 0, At, B0); PG8_BAR; PG8_SCHED;
            PG8_LDB(B1, 1, 1); PG8_STAGE(PG8_SB(1, 0), b3, voffB);
            PG8_BAR; PG8_WAIT_L(0); PG8_MMA(0, 1, At, B1); PG8_BAR;
            PG8_LDA(At, 1, 1); PG8_STAGE_A(PG8_SA(1, 0), a3, voffA);
            PG8_BAR; PG8_WAIT_L(0); PG8_MMA(1, 0, At, B0); PG8_BAR; PG8_SCHED;
            PG8_STAGE(PG8_SB(1, 1), b3 + hstep, voffB);
            PG8_WAIT_V(6); PG8_BAR; PG8_MMA(1, 1, At, B1); PG8_BAR;
            }
        }
        if constexpr (ALIGN_EPI) { if (wr == 0) PG8_BAR; }
        if constexpr (!Epi::AFTER_DRAIN) { E(acc, cur, wr, wc, fr, fq); S.done(cur); }
        if (!has_next) break;
#pragma unroll
        for (int a = 0; a < 2; ++a)
#pragma unroll
            for (int b = 0; b < 2; ++b)
#pragma unroll
                for (int m = 0; m < 4; ++m)
#pragma unroll
                    for (int n = 0; n < 2; ++n) acc[a][b][m][n] = (f32x4){0.f, 0.f, 0.f, 0.f};
        cur = nxt; cA = nA; cB = nB; ++ui;
        if constexpr (ALIGN_EPI) { if (wr == 1) PG8_BAR; }
    }
    PG8_WAIT_V(0);
    if constexpr (!ALIGN_EPI) { if (wr == 0) PG8_BAR; }
    PG8_BAR;
    if constexpr (Epi::AFTER_DRAIN) { E.fused(acc, cur, wr, wc, fr, fq, lds, wid, lane); S.done(cur); }
#undef PG8_SA
#undef PG8_SB
#undef PG8_STAGE
#undef PG8_STAGE_A
#undef PG8_LDA
#undef PG8_LDB
#undef PG8_MMA
#undef PG8_WAIT_V
#undef PG8_WAIT_L
#undef PG8_BAR
#undef PG8_SCHED
}
}
constexpr int NWAVES = 8, NTHREADS = NWAVES * 64;
constexpr int LDS_BYTES = 147456;
constexpr int LDS_MISC = 131072;
constexpr int N_PHASES = 9;

struct Args {
    const float *x_prompt, *x_sample, *cache_k, *cache_v, *state_delta, *state_conv, *meta, *norm_mix, *w_in, *conv_w, *a_log, *dt_bias, *sinks, *gdn_norm,
                *w_oa, *w_ob, *w_out, *norm_ffn, *w_gate, *w_up, *w_down, *norm_final;
    float* out; unsigned char* ws; int ph_lo, ph_hi;
};

typedef const __attribute__((address_space(4))) Args* KA;
DI KA kargs() { KA p = (KA)__builtin_amdgcn_kernarg_segment_ptr(); asm volatile("" : "+s"(p)); return p; }
#define RLX_AGENT __ATOMIC_RELAXED, __HIP_MEMORY_SCOPE_AGENT
#define LDS_WAIT() asm volatile("s_waitcnt lgkmcnt(0)" ::: "memory")
#define MFMA32(a, b, c) __builtin_amdgcn_mfma_f32_32x32x16_bf16((a), (b), (c), 0, 0, 0)
DI int crow16(int reg, int h) { return (reg & 3) + 8 * (reg >> 2) + 4 * h; }
DI float wave_sum(float v) {
#pragma unroll
    for (int o = 1; o < 64; o <<= 1) v += __shfl_xor(v, o);
    return v;
}
DI float wave_max(float v) {
#pragma unroll
    for (int o = 1; o < 64; o <<= 1) v = fmaxf(v, __shfl_xor(v, o));
    return v;
}
template <int S> DI bf16x8 pack_step(const f32x16& x) {
    u32x4 p; p.x = cvtpk(x[8 * S], x[8 * S + 1]); p.y = cvtpk(x[8 * S + 2], x[8 * S + 3]); p.z = cvtpk(x[8 * S + 4], x[8 * S + 5]); p.w = cvtpk(x[8 * S + 6], x[8 * S + 7]);
    return __builtin_bit_cast(bf16x8, p);
}
DI int frag_idx(int row, int k, int NKS) { const int kkk = k & 15; return (((row >> 5) * NKS + (k >> 4)) * 64 + (row & 31) + 32 * ((kkk >> 2) & 1)) * 8 + (((kkk >> 3) << 2) | (kkk & 3)); }
DI unsigned char* slot_ptr(KA A, int item) { return item < PREP_N1 ? A->ws + WS_B + (size_t)item * PREP_SLOT : (unsigned char*)A->out + (size_t)(item - PREP_N1) * PREP_SLOT; }

#define XB_TMO      128
#define XB_XCNT(j)  (256  + 64 * (j))
#define XB_XSUB(j)  (1280 + 64 * (j))
#define XB_XGEN(j)  (2304 + 64 * (j))
#define XB_TOP      3328
#define XB_TOPGEN   3392
#define XCD_BAR_WORDS 3456
#define XB_SPIN_CAP (1u << 20)
DI unsigned xb_ld(unsigned* p)              { return __hip_atomic_load(p, __ATOMIC_RELAXED, __HIP_MEMORY_SCOPE_AGENT); }
DI unsigned xb_add(unsigned* p, unsigned v) { return __hip_atomic_fetch_add(p, v, __ATOMIC_RELAXED, __HIP_MEMORY_SCOPE_AGENT); }
DI unsigned xb_xcc_id() { return (unsigned)__builtin_amdgcn_s_getreg((3 << 11) | 20) & 0xFu; }
#define XB_SPIN(cond, bar) do { unsigned _sp = 0; while (cond) { __builtin_amdgcn_s_sleep(1); \
    if ((++_sp & 255u) == 0u) { if (xb_ld(&(bar)[XB_TMO])) break; if (_sp > XB_SPIN_CAP) { atomicAdd(&(bar)[XB_TMO], 1u); break; } } } } while (0)
struct XcdBarrier { unsigned* bar; unsigned x; volatile LAS unsigned* st; };
DI XcdBarrier xcd_barrier_post(unsigned* bar, volatile LAS unsigned* st) {
    XcdBarrier b; b.bar = bar; b.x = xb_xcc_id(); b.st = st;
    if (threadIdx.x == 0) (void)xb_add(&bar[XB_XCNT(b.x)], 1u);
    return b;
}
DI void xcd_barrier_complete(unsigned* bar, unsigned x, unsigned& nloc, unsigned& nx) {
    const unsigned G = gridDim.x * gridDim.y * gridDim.z;
    unsigned sum, cnt, mine, sp = 0u;
    for (;;) {
        sum = 0u; cnt = 0u; mine = 0u;
#pragma unroll
        for (unsigned j = 0; j < 16; ++j) { const unsigned c = xb_ld(&bar[XB_XCNT(j)]); sum += c; cnt += (c > 0u) ? 1u : 0u; mine = (j == x) ? c : mine; }
        if (sum == G) break;
        __builtin_amdgcn_s_sleep(1);
        if ((++sp & 255u) == 0u) { if (xb_ld(&bar[XB_TMO])) break; if (sp > XB_SPIN_CAP) { atomicAdd(&bar[XB_TMO], 1u); break; } }
    }
    nloc = mine > 0u ? mine : 1u; nx = cnt > 0u ? cnt : 1u;
}
DI void xcd_barrier(const XcdBarrier& b) {
    asm volatile("s_waitcnt vmcnt(0)" ::: "memory");
    __syncthreads();
    if (threadIdx.x == 0) {
        unsigned* bar = b.bar;
        __builtin_amdgcn_s_waitcnt(0);
        unsigned nloc = b.st[0], nx = b.st[1];
        if (nloc == 0u) { xcd_barrier_complete(bar, b.x, nloc, nx); b.st[0] = nloc; b.st[1] = nx; }
        const unsigned old = xb_add(&bar[XB_XSUB(b.x)], 1u);
        const unsigned gen = old / nloc;
        if (old + 1u == (gen + 1u) * nloc) {
            __builtin_amdgcn_fence(__ATOMIC_RELEASE, "agent");
            asm volatile("s_waitcnt vmcnt(0)" ::: "memory");
            const unsigned og = xb_add(&bar[XB_TOP], 1u);
            const unsigned tg = og / nx;
            if (og + 1u == (tg + 1u) * nx) xb_add(&bar[XB_TOPGEN], 1u);
            else XB_SPIN(xb_ld(&bar[XB_TOPGEN]) == tg, bar);
            __builtin_amdgcn_fence(__ATOMIC_ACQUIRE, "agent");
            xb_add(&bar[XB_XGEN(b.x)], 1u);
            asm volatile("s_waitcnt vmcnt(0)" ::: "memory");
        } else {
            XB_SPIN(xb_ld(&bar[XB_XGEN(b.x)]) == gen, bar);
            __builtin_amdgcn_fence(__ATOMIC_ACQUIRE, "agent");
            asm volatile("s_waitcnt vmcnt(0)" ::: "memory");
        }
    }
    __syncthreads();
}

template <class RowMap> DI void transpose_item(const float* W, int K, int N, bf16* WT, RowMap rm, const float* kscale, LAS float* scr, int item, int lane, int ldw = 0) {
    if (ldw == 0) ldw = K;
    const int nblk = (N + 31) / 32, kb = item / nblk, nb = item - kb * nblk, k0 = 64 * kb, n0 = 32 * nb;
    const int n4 = n0 + (lane & 7) * 4;
    f32x4 v[8];
#pragma unroll
    for (int i = 0; i < 8; ++i) { const int kk = 8 * i + (lane >> 3);
        v[i] = n4 < N ? *(const f32x4*)(W + (size_t)(k0 + kk) * N + n4) : (f32x4){0.f, 0.f, 0.f, 0.f}; }
#pragma unroll
    for (int i = 0; i < 8; ++i) { const int kk = 8 * i + (lane >> 3);
        if (kscale) v[i] = v[i] * kscale[k0 + kk];
        LAS float* d = scr + kk * 33 + (lane & 7) * 4; d[0] = v[i][0]; d[1] = v[i][1]; d[2] = v[i][2]; d[3] = v[i][3]; }
    LDS_WAIT(); asm volatile("" ::: "memory");
    const int c = lane & 7;
#pragma unroll
    for (int j = 0; j < 4; ++j) { const int n = (lane >> 3) + 8 * j; const LAS float* s = scr + (8 * c) * 33 + n;
        const int nsrc = n0 + n; const int drow = nsrc < N ? rm(nsrc) : -1;
        u32x4 o; o.x = cvtpk(s[0 * 33], s[1 * 33]); o.y = cvtpk(s[2 * 33], s[3 * 33]); o.z = cvtpk(s[4 * 33], s[5 * 33]); o.w = cvtpk(s[6 * 33], s[7 * 33]);
        if (drow >= 0) *(u32x4*)(WT + (size_t)drow * ldw + k0 + 8 * c) = o; }
    LDS_WAIT(); asm volatile("" ::: "memory");
}
DI float softplusf_(float x) { return x > 20.f ? x : log1pf(__expf(x)); }

#ifndef PROBE_REP
#define PROBE_REP -1
#endif
#ifndef P0_ROW_WAVES
#define P0_ROW_WAVES 4
#endif
DI void p0_prologue(KA A, LAS unsigned char* lds) {
    const int tid = tid_opaque(), lane = tid & 63, wave = __builtin_amdgcn_readfirstlane(tid >> 6);
    const int G = gridDim.x;
    constexpr int NR = P0_ROW_WAVES, NT = NWAVES - NR;
    const bool rowrole = wave < NR;
    const int gw = rowrole ? blockIdx.x * NR + wave : blockIdx.x * NT + (wave - NR), NGW = G * (rowrole ? NR : NT);
    const int gt = blockIdx.x * (NT * 64) + (tid - NR * 64), NGT = G * NT * 64;
    unsigned char* ws = A->ws;
    if (!rowrole) for (int rep = 0; rep < (PROBE_REP == 1001 ? 2 : 1); ++rep) {
        LAS float* scr = (LAS float*)(lds + wave * 16384);
        constexpr int I_IN = 16 * 153, I_OA = 8 * 32, I_OUT = 16 * 32, I_G = 16 * 88, I_D = 44 * 32;
        constexpr int NIT = I_IN + 2 * I_OA + I_OUT + 2 * I_G + I_D;
        for (int it = gw; it < NIT; it += NGW) {
            int r = it;
            if (r < I_IN) { transpose_item(A->w_in, 1024, NIN_SRC, (bf16*)(ws + WS_WIN), [](int c) -> int {
                    if (c < 640) return (c & ~63) + pos_of_d(c & 63);
                    if (c < 2816) return c;
                    if (c < 2824) return -1;
                    return c - 8; }, nullptr, scr, r, lane); continue; } r -= I_IN;
            if (r < I_OA) { transpose_item(A->w_oa, 512, 1024, (bf16*)(ws + WS_WOA), [](int c) -> int { return c; }, nullptr, scr, r, lane, 1024); continue; } r -= I_OA;
            if (r < I_OA) { transpose_item(A->w_ob, 512, 1024, (bf16*)(ws + WS_WOA) + 512, [](int c) -> int { return c; }, nullptr, scr, r, lane, 1024); continue; } r -= I_OA;
            if (r < I_OUT) { transpose_item(A->w_out, 1024, 1024, (bf16*)(ws + WS_WOUT), [](int c) -> int { return c; }, nullptr, scr, r, lane); continue; } r -= I_OUT;
            if (r < I_G) { transpose_item(A->w_gate, 1024, DFF, (bf16*)(ws + WS_WGU), [](int c) -> int { return 256 * (c >> 7) + (c & 127); }, A->norm_ffn, scr, r, lane); continue; } r -= I_G;
            if (r < I_G) { transpose_item(A->w_up, 1024, DFF, (bf16*)(ws + WS_WGU), [](int c) -> int { return 256 * (c >> 7) + 128 + (c & 127); }, A->norm_ffn, scr, r, lane); continue; } r -= I_G;
            transpose_item(A->w_down, DFF, 1024, (bf16*)(ws + WS_WD), [](int c) -> int { return c; }, nullptr, scr, r, lane);
        }
    }
    if (!rowrole) for (int rep = 0; rep < (PROBE_REP == 1002 ? 2 : 1); ++rep) {
        float* COS = (float*)(ws + WS_ROPE); float* SIN = COS + (TP + TS) * 32;
        for (int i = gt; i < (TP + TS) * 32; i += NGT) { const int ri = i >> 5, f = i & 31; const double pos = ri < TP ? (double)ri : (double)(PAST + ri - TP);
            const double inv = exp2(-(double)f * (13.287712379549449 / 32.0)), ang = pos * inv; COS[i] = (float)cos(ang); SIN[i] = (float)sin(ang); }
        constexpr int PERB = 124 * 128 / 4;
        for (int i = gt; i < SBATCH * PERB; i += NGT) { const int b = i / PERB, o = i - b * PERB;
            ((f32x4*)(A->out + O_KS))[(size_t)b * 4096 + o] = ((const f32x4*)A->cache_k)[(size_t)b * 4096 + 128 + o];
            ((f32x4*)(A->out + O_VS))[(size_t)b * 4096 + o] = ((const f32x4*)A->cache_v)[(size_t)b * 4096 + 128 + o]; }
    }
    if (rowrole) for (int rep = 0; rep < (PROBE_REP == 1003 ? 2 : 1); ++rep) {
        unsigned wab[16][4];
        f32x4 nm[4];
#pragma unroll
        for (int j = 0; j < 4; ++j) {
            nm[j] = ((const f32x4*)A->norm_mix)[lane + 64 * j];
#pragma unroll
            for (int e = 0; e < 4; ++e) { const float* p = A->w_in + (size_t)(4 * (lane + 64 * j) + e) * NIN_SRC + 2816;
                const f32x4 a = *(const f32x4*)p, b = *(const f32x4*)(p + 4);
                wab[j * 4 + e][0] = cvtpk(a[0], a[1]); wab[j * 4 + e][1] = cvtpk(a[2], a[3]); wab[j * 4 + e][2] = cvtpk(b[0], b[1]); wab[j * 4 + e][3] = cvtpk(b[2], b[3]); }
        }
        bf16* XN = (bf16*)(ws + WS_XN); f32x2* GB = (f32x2*)(ws + WS_GB);
        auto row_src = [&](int urow) -> const float* {
            if (urow < MP) { const int b = urow / TP, t = urow - b * TP; return t < NMETA ? A->meta + (size_t)t * D : A->x_prompt + ((size_t)b * SEQ + (t - NMETA)) * D; }
            if (urow < MU) return A->x_sample + (size_t)(urow - MP) * D;
            return nullptr; };
        f32x4 nx[4], nx2[4];
        { const float* s0 = gw < MUP ? row_src(gw) : nullptr; const float* s1 = gw + NGW < MUP ? row_src(gw + NGW) : nullptr;
#pragma unroll
          for (int j = 0; j < 4; ++j) { nx[j] = s0 ? ((const f32x4*)s0)[lane + 64 * j] : (f32x4){0.f, 0.f, 0.f, 0.f}; nx2[j] = s1 ? ((const f32x4*)s1)[lane + 64 * j] : (f32x4){0.f, 0.f, 0.f, 0.f}; } }
#pragma unroll 1
        for (int urow = gw; urow < MUP; urow += NGW) {
            f32x4 v[4];
#pragma unroll
            for (int j = 0; j < 4; ++j) { v[j] = nx[j]; nx[j] = nx2[j]; }
            { const int un = urow + 2 * NGW; const float* s2 = un < MUP ? row_src(un) : nullptr;
#pragma unroll
              for (int j = 0; j < 4; ++j) nx2[j] = s2 ? ((const f32x4*)s2)[lane + 64 * j] : (f32x4){0.f, 0.f, 0.f, 0.f}; }
            u32x2* o8 = (u32x2*)(XN + (size_t)urow * D) + lane;
            float ss = 0.f;
#pragma unroll
            for (int j = 0; j < 4; ++j) ss += (v[j][0] * v[j][0] + v[j][1] * v[j][1]) + (v[j][2] * v[j][2] + v[j][3] * v[j][3]);
            const float rstd = urow < MU ? rsqrtf(wave_sum(ss) * (1.0f / D) + EPS) : 0.f;
            float dot[8];
#pragma unroll
            for (int c = 0; c < 8; ++c) dot[c] = 0.f;
#pragma unroll
            for (int j = 0; j < 4; ++j) { v[j] = v[j] * rstd * nm[j];
                o8[64 * j] = (u32x2){cvtpk(v[j][0], v[j][1]), cvtpk(v[j][2], v[j][3])};
#pragma unroll
                for (int e = 0; e < 4; ++e)
#pragma unroll
                    for (int c = 0; c < 4; ++c) { dot[2 * c] += v[j][e] * bflo(wab[j * 4 + e][c]); dot[2 * c + 1] += v[j][e] * bfhi(wab[j * 4 + e][c]); } }
            float d4[4], d2[2], d1;
#pragma unroll
            for (int c = 0; c < 4; ++c) { const float keep = (lane & 32) ? dot[4 + c] : dot[c], send = (lane & 32) ? dot[c] : dot[4 + c]; d4[c] = keep + __shfl_xor(send, 32); }
#pragma unroll
            for (int c = 0; c < 2; ++c) { const float keep = (lane & 16) ? d4[2 + c] : d4[c], send = (lane & 16) ? d4[c] : d4[2 + c]; d2[c] = keep + __shfl_xor(send, 16); }
            { const float keep = (lane & 8) ? d2[1] : d2[0], send = (lane & 8) ? d2[0] : d2[1]; d1 = keep + __shfl_xor(send, 8); }
            d1 += __shfl_xor(d1, 4); d1 += __shfl_xor(d1, 2); d1 += __shfl_xor(d1, 1);
            const float a_ = __shfl(d1, ((lane & 2) ? 16 : 0) + ((lane & 1) ? 8 : 0));
            const float b_ = __shfl(d1, 32 + ((lane & 2) ? 16 : 0) + ((lane & 1) ? 8 : 0));
            if (lane < 4) {
                const float g = -__expf(A->a_log[lane]) * softplusf_(a_ + A->dt_bias[lane]);
                GB[(size_t)urow * 4 + lane] = urow < MU ? (f32x2){g, sigmoidf_(b_)} : (f32x2){0.f, 0.f};
            }
        }
    }
}
DI void item_decode(int item, int& b, int& h, bool& sample, int& t0, int& L) {
    if (item < N_ITEMS_P) { const int s = item / CHUNKS_P, c = item - s * CHUNKS_P; b = s >> 2; h = s & 3; sample = false; if (c == 0) { t0 = 0; L = NMETA; } else { t0 = NMETA + 64 * (c - 1); L = 64; } }
    else { const int s = item - N_ITEMS_P; b = s >> 2; h = s & 3; sample = true; t0 = 0; L = TS; }
}
#define LDS_BARRIER() do { asm volatile("s_waitcnt lgkmcnt(0)" ::: "memory"); __builtin_amdgcn_s_barrier(); asm volatile("" ::: "memory"); } while (0)
typedef GAS unsigned long long gu64;
typedef GAS unsigned gu32;
constexpr size_t CTL_QUEUE = 40960;
constexpr size_t CTL_F1 = 655360;
static_assert(CTL_F1 + 2592 * 64 <= 1048576, "control region map");
DI gu64* item_flag1(KA A, int item) { return (gu64*)(A->ws + WS_CTL + CTL_F1 + (size_t)item * 64); }
DI int order_item(int m) { return m < N_ITEMS_P ? (m & 31) * CHUNKS_P + (m >> 5) : m; }
DI gu64* item_granule(KA A, int item) { return (gu64*)(A->ws + WS_CTL + CTL_GRAN + (size_t)item * 64); }
DI float wait_item(gu64* g, unsigned ep = 1u) {
    unsigned long long x; unsigned spins = 0;
    for (;;) { x = __hip_atomic_load(g, __ATOMIC_RELAXED, __HIP_MEMORY_SCOPE_AGENT); if ((unsigned)(x >> 32) >= ep) break; __builtin_amdgcn_s_sleep(8); if (++spins > (1u << 20)) break; }
    asm volatile("" ::: "memory");
    return __uint_as_float((unsigned)__builtin_amdgcn_readfirstlane((int)(unsigned)x));
}
constexpr int LDS_GCL = 139264;
constexpr int PITCH = 132;
DI bf16x8 frag_nat(const LAS float* src, int row, int k0) {
    const f32x4 lo = *(const LAS f32x4*)(src + row * PITCH + k0), hi = *(const LAS f32x4*)(src + row * PITCH + k0 + 4);
    return __builtin_bit_cast(bf16x8, pack8f(lo, hi));
}
struct S1Pre { u32x4 xr[11]; f32x4 w[4][2]; f32x2 gb; };
DI void stage1_issue(KA A, int item, S1Pre& P) {
    const int tid = tid_opaque(), lane = tid & 63, wave = __builtin_amdgcn_readfirstlane(tid >> 6);
    int b, h, t0, L; bool sample; item_decode(item, b, h, sample, t0, L);
    const bf16* QKVB = (const bf16*)(A->ws + WS_QKVB);
    const int cv = lane < 48 ? lane : 47, grp = cv >> 4, col0 = (cv & 15) * 8, r0 = wave * 8, cidx = grp * 512 + h * 128 + col0;
#pragma unroll
    for (int q = 0; q < 11; ++q) {
        const int i = r0 - 3 + q;
        long urow = sample ? (long)MP + b * TS + i : (long)b * TP + t0 + i;
        const bool ok = sample ? i >= 0 : t0 + i >= 0;
        if (!ok) urow = 0;
        P.xr[q] = *(const u32x4*)(QKVB + (size_t)urow * CONVD + cidx);
        if (!ok) P.xr[q] = (u32x4){0u, 0u, 0u, 0u};
    }
#pragma unroll
    for (int i = 0; i < 4; ++i) { P.w[i][0] = *(const f32x4*)(A->conv_w + i * CONVD + cidx); P.w[i][1] = *(const f32x4*)(A->conv_w + i * CONVD + cidx + 4); }
    P.gb = (f32x2){0.f, 0.f};
    if (wave == 7 && lane < L) { const int urow = sample ? MP + b * TS + lane : b * TP + t0 + lane; P.gb = ((const f32x2*)(A->ws + WS_GB))[(size_t)urow * 4 + h]; }
}
DI void prep_stage1(KA A, int item, int next_item, int prev_item, int wait_item_idx, int bslot, float* ats, S1Pre& P, LAS unsigned char* ldsb, unsigned ep, int pmode = 0) {
    const int tid = tid_opaque(), lane = tid & 63, wave = __builtin_amdgcn_readfirstlane(tid >> 6), r = lane & 31, hh = lane >> 5;
#define ST16(p, ...) __builtin_amdgcn_raw_buffer_store_b128(__builtin_bit_cast(v4u_t, (__VA_ARGS__)), rs_slot, (int)((const unsigned char*)(p) - (const unsigned char*)slot), 0, 16)
#define ST16F(p, ...) __builtin_amdgcn_raw_buffer_store_b128(__builtin_bit_cast(v4u_t, (__VA_ARGS__)), rs_ats, (int)((const unsigned char*)(p) - (const unsigned char*)ats), 0, 16)
    int b, h, t0, L; bool sample; item_decode(item, b, h, sample, t0, L);
    LAS float* Qs = (LAS float*)ldsb; LAS float* Ks = Qs + 64 * PITCH; LAS float* Vs = Ks + 64 * PITCH; LAS float* gcs = Vs + 64 * PITCH; LAS float* betas = gcs + 64;
    unsigned char* slot = slot_ptr(A, item);
    typedef unsigned v4u_t __attribute__((__vector_size__(16)));
    const __amdgpu_buffer_rsrc_t rs_slot = __builtin_amdgcn_make_buffer_rsrc((void*)slot, 0, (int)PREP_SLOT, 0x00020000);
    const __amdgpu_buffer_rsrc_t rs_ats = __builtin_amdgcn_make_buffer_rsrc((void*)ats, 0, (int)ATS_ITEM, 0x00020000);
    if (!(pmode & 8)) {
        const int cv = lane < 48 ? lane : 47, grp = cv >> 4, col0 = (cv & 15) * 8, r0 = wave * 8, cidx = grp * 512 + h * 128 + col0;
        float x[11][8];
#pragma unroll
        for (int q = 0; q < 11; ++q) { x[q][0] = bflo(P.xr[q].x); x[q][1] = bfhi(P.xr[q].x); x[q][2] = bflo(P.xr[q].y); x[q][3] = bfhi(P.xr[q].y);
                                       x[q][4] = bflo(P.xr[q].z); x[q][5] = bfhi(P.xr[q].z); x[q][6] = bflo(P.xr[q].w); x[q][7] = bfhi(P.xr[q].w); }
        if (sample && wave == 0) {
#pragma unroll
            for (int q = 0; q < 3; ++q) { const float* sp = A->state_conv + ((size_t)b * 3 + q) * CONVD + cidx; const f32x4 s0 = *(const f32x4*)sp, s1 = *(const f32x4*)(sp + 4);
                x[q][0] = s0[0]; x[q][1] = s0[1]; x[q][2] = s0[2]; x[q][3] = s0[3]; x[q][4] = s1[0]; x[q][5] = s1[1]; x[q][6] = s1[2]; x[q][7] = s1[3]; }
        }
        float w[4][8];
#pragma unroll
        for (int i = 0; i < 4; ++i) { w[i][0] = P.w[i][0][0]; w[i][1] = P.w[i][0][1]; w[i][2] = P.w[i][0][2]; w[i][3] = P.w[i][0][3]; w[i][4] = P.w[i][1][0]; w[i][5] = P.w[i][1][1]; w[i][6] = P.w[i][1][2]; w[i][7] = P.w[i][1][3]; }
        LAS float* dst = Qs + grp * 64 * PITCH + col0;
        const float nsc = grp == 0 ? 0.08838834764831845f : 1.0f;
#pragma unroll
        for (int q = 3; q < 11; ++q) {
            const int rr = r0 + q - 3;
            float v[8]; float ss = 0.f;
#pragma unroll
            for (int e = 0; e < 8; ++e) {
                const float y = __builtin_fmaf(w[3][e], x[q][e], __builtin_fmaf(w[2][e], x[q - 1][e], __builtin_fmaf(w[1][e], x[q - 2][e], w[0][e] * x[q - 3][e])));
                const float sv = siluf_(y); v[e] = sv; ss = __builtin_fmaf(sv, sv, ss); }
            ss += __builtin_bit_cast(float, __builtin_amdgcn_update_dpp(0, __builtin_bit_cast(int, ss), 0xB1, 0xF, 0xF, true));
            ss += __builtin_bit_cast(float, __builtin_amdgcn_update_dpp(0, __builtin_bit_cast(int, ss), 0x4E, 0xF, 0xF, true));
            ss += __builtin_bit_cast(float, __builtin_amdgcn_update_dpp(0, __builtin_bit_cast(int, ss), 0x141, 0xF, 0xF, true));
            ss += __builtin_bit_cast(float, __builtin_amdgcn_update_dpp(0, __builtin_bit_cast(int, ss), 0x140, 0xF, 0xF, true));
            float sc = grp == 2 ? 1.0f : rsqrtf(ss + EPS) * nsc;
            sc = rr < L ? sc : 0.f;
            if (lane < 48) { *(LAS f32x4*)(dst + rr * PITCH) = (f32x4){v[0] * sc, v[1] * sc, v[2] * sc, v[3] * sc}; *(LAS f32x4*)(dst + rr * PITCH + 4) = (f32x4){v[4] * sc, v[5] * sc, v[6] * sc, v[7] * sc}; }
        }
    }
    if (wave == 7) {
        float gc = P.gb[0];
#pragma unroll
        for (int o = 1; o < 64; o <<= 1) { const float t = __shfl_up(gc, o); if (lane >= o) gc += t; }
        gcs[lane] = gc; betas[lane] = P.gb[1];
        if (lane == 63) ((LAS float*)(ldsb + LDS_GCL))[bslot] = __expf(gc);
    }
    asm volatile("s_waitcnt vmcnt(0)" ::: "memory");
    if (next_item < N_ITEMS) stage1_issue(A, next_item, P);
    if (wait_item_idx >= 0 && wave == 0) (void)wait_item(item_granule(A, wait_item_idx), ep);
    LDS_BARRIER();
    if (prev_item >= 0 && tid == 0) __hip_atomic_store(item_flag1(A, prev_item), ((unsigned long long)ep << 32) | (unsigned long long)__float_as_uint(((const LAS float*)(ldsb + LDS_GCL))[bslot ^ 1]), __ATOMIC_RELAXED, __HIP_MEMORY_SCOPE_AGENT);
    if (wave < 6 && !(pmode & 4)) {
        const bool isqk = wave >= 3; const int tsel = isqk ? wave - 3 : wave, ib = tsel == 0 ? 0 : 1, jb = tsel == 2 ? 1 : 0;
        const LAS float* Asrc = isqk ? Qs : Ks;
        f32x16 acc;
#pragma unroll
        for (int e = 0; e < 16; ++e) acc[e] = 0.f;
#pragma unroll
        for (int s = 0; s < 8; ++s) acc = MFMA32(frag_nat(Asrc, 32 * ib + r, 16 * s + 8 * hh), frag_nat(Ks, 32 * jb + r, 16 * s + 8 * hh), acc);
        const int j = 32 * jb + r; const float gcj = gcs[j];
        float* Aout = ats + (ib + jb) * 1024; bf16* QKD = (bf16*)(slot + SL_QKD);
        if (!isqk) {
#pragma unroll
            for (int g4 = 0; g4 < 4; ++g4) { f32x4 v;
#pragma unroll
                for (int e = 0; e < 4; ++e) { const int i = 32 * ib + 8 * g4 + 4 * hh + e; v[e] = i > j ? betas[i] * __expf(fminf(gcs[i] - gcj, 0.f)) * acc[4 * g4 + e] : 0.f; }
                ST16F(Aout + r * 32 + 8 * g4 + 4 * hh, v); }
        } else {
            LAS float* patch = (LAS float*)(ldsb + 106496) + (wave - 3) * (32 * 36);
#pragma unroll
            for (int reg = 0; reg < 16; ++reg) { const int il = crow16(reg, hh), i = 32 * ib + il; const float dec = __expf(fminf(gcs[i] - gcj, 0.f));
                patch[il * 36 + r] = i >= j ? dec * acc[reg] : 0.f; }
            LDS_WAIT(); asm volatile("" ::: "memory");
#pragma unroll
            for (int ks2 = 0; ks2 < 2; ++ks2) { const int k0 = 16 * ks2 + 4 * hh;
                const f32x4 lo = *(const LAS f32x4*)(patch + r * 36 + k0), hi = *(const LAS f32x4*)(patch + r * 36 + k0 + 8);
                ST16((unsigned char*)QKD + ((ib * 4 + 2 * jb + ks2) * 64 + lane) * 16, pack8f(lo, hi)); }
        }
    }
    const float gcl = gcs[63];
#pragma unroll 1
    for (int job = (pmode & 4) ? 56 : wave; job < 56; job += 8) {
        if (job < 32) {
            const bool isq = job >= 16; const int jj = job & 15, rb = jj >> 3, ks = jj & 7, row = 32 * rb + r, k0 = 16 * ks + 4 * hh;
            const LAS float* src = isq ? Qs : Ks; const float sc = isq ? __expf(gcs[row]) : betas[row] * __expf(gcs[row]);
            const f32x4 lo = *(const LAS f32x4*)(src + row * PITCH + k0) * sc, hi = *(const LAS f32x4*)(src + row * PITCH + k0 + 8) * sc;
            ST16(slot + (isq ? SL_QE : SL_BEK) + ((rb * 8 + ks) * 64 + lane) * 16, pack8f(lo, hi));
        } else if (job < 48) {
            const int jj = job - 32, rb = jj >> 2, ks = jj & 3, dk = 32 * rb + r;
            f32x4 lo, hi;
#pragma unroll
            for (int e = 0; e < 4; ++e) { const int j0 = 16 * ks + 4 * hh + e, j1 = j0 + 8;
                lo[e] = Ks[j0 * PITCH + dk] * __expf(gcl - gcs[j0]); hi[e] = Ks[j1 * PITCH + dk] * __expf(gcl - gcs[j1]); }
            ST16(slot + SL_KWT + ((rb * 4 + ks) * 64 + lane) * 16, pack8f(lo, hi));
        } else {
            const int q = job - 48, w = q >> 1, ib = q & 1, dv = 32 * w + r;
            float v[16];
#pragma unroll
            for (int reg = 0; reg < 16; ++reg) { const int i = 32 * ib + crow16(reg, hh); v[reg] = betas[i] * Vs[i * PITCH + dv]; }
            u32x4* dst = (u32x4*)(slot + SL_BV + ((w * 2 + ib) * 64 + lane) * 32);
            ST16(dst, (u32x4){cvtpk(v[0], v[1]), cvtpk(v[2], v[3]), cvtpk(v[4], v[5]), cvtpk(v[6], v[7])});
            ST16(dst + 1, (u32x4){cvtpk(v[8], v[9]), cvtpk(v[10], v[11]), cvtpk(v[12], v[13]), cvtpk(v[14], v[15])});
        }
    }
    LDS_BARRIER();
}
DI void prep_stage2(KA A, int item, float gcl, const float* ats, LAS float* M, unsigned ep) {
    int lane = threadIdx.x & 63; asm volatile("" : "+v"(lane));
    const int r = lane & 31, hh = lane >> 5, base = 32 * hh;
    unsigned char* slot = slot_ptr(A, item);
    const f32x4* Ain = (const f32x4*)ats;
#pragma unroll
    for (int tt = 0; tt < 3; ++tt) { const int jb = tt >> 1, ib = (tt + 1) >> 1;
#pragma unroll
        for (int q = 0; q < 4; ++q) { const int idx = q * 64 + lane, jj = idx >> 3, i4 = idx & 7;
            *(LAS f32x4*)(M + (32 * jb + jj) * 64 + 32 * ib + 4 * i4) = Ain[tt * 256 + idx]; } }
    LDS_WAIT(); asm volatile("" ::: "memory");
#pragma unroll 1
    for (int rb = 0; rb < 2; ++rb) {
        float acc[16];
#pragma unroll
        for (int i = 0; i < 16; ++i) acc[i] = r == 16 * rb + i ? 1.f : 0.f;
        if (rb == 1) {
#pragma unroll 4
            for (int j = 0; j < 16; ++j) {
                float tj = M[(base + j) * 64 + base + r]; tj = r <= j ? tj : 0.f;
                const LAS f32x4* ar = (const LAS f32x4*)(M + (base + j) * 64 + base + 16);
                const f32x4 a0 = ar[0], a1 = ar[1], a2 = ar[2], a3 = ar[3];
#pragma unroll
                for (int e = 0; e < 4; ++e) { acc[e] -= a0[e] * tj; acc[4 + e] -= a1[e] * tj; acc[8 + e] -= a2[e] * tj; acc[12 + e] -= a3[e] * tj; }
            }
        }
#pragma unroll
        for (int j = 0; j < 16; ++j) {
            const float tj = acc[j]; const int row = base + 16 * rb + j;
            const LAS f32x4* ar = (const LAS f32x4*)(M + row * 64 + base + 16 * rb);
            float a[16];
#pragma unroll
            for (int q = j >> 2; q < 4; ++q) { const f32x4 v = ar[q]; a[4 * q] = v[0]; a[4 * q + 1] = v[1]; a[4 * q + 2] = v[2]; a[4 * q + 3] = v[3]; }
            if (r <= 16 * rb + j) M[row * 64 + base + r] = tj;
#pragma unroll
            for (int i = j + 1; i < 16; ++i) acc[i] -= a[i] * tj;
        }
        asm volatile("" ::: "memory");
    }
    LDS_WAIT(); asm volatile("" ::: "memory");
    f32x16 X;
#pragma unroll
    for (int e = 0; e < 16; ++e) X[e] = 0.f;
#pragma unroll
    for (int s2 = 0; s2 < 16; ++s2) { const int k = 2 * s2 + hh; const float a = M[k * 64 + 32 + r]; float bb = M[k * 64 + r]; bb = r <= k ? bb : 0.f;
        X = __builtin_amdgcn_mfma_f32_32x32x2f32(a, bb, X, 0, 0, 0); }
#pragma unroll
    for (int reg = 0; reg < 16; ++reg) M[crow16(reg, hh) * 64 + 32 + r] = X[reg];
    LDS_WAIT(); asm volatile("" ::: "memory");
    f32x16 Y;
#pragma unroll
    for (int e = 0; e < 16; ++e) Y[e] = 0.f;
#pragma unroll
    for (int s2 = 0; s2 < 16; ++s2) { const int k = 2 * s2 + hh; float a = M[(32 + r) * 64 + 32 + k]; a = k <= r ? a : 0.f; const float bb = M[k * 64 + 32 + r];
        Y = __builtin_amdgcn_mfma_f32_32x32x2f32(a, bb, Y, 0, 0, 0); }
#pragma unroll
    for (int reg = 0; reg < 16; ++reg) M[(32 + crow16(reg, hh)) * 64 + r] = -Y[reg];
    LDS_WAIT(); asm volatile("" ::: "memory");
#pragma unroll
    for (int f = 0; f < 8; ++f) { const int rb = f >> 2, ks = f & 3, row = 32 * rb + r, k0 = 16 * ks + 4 * hh;
        f32x4 lo = *(const LAS f32x4*)(M + row * 64 + k0), hi = *(const LAS f32x4*)(M + row * 64 + k0 + 8);
#pragma unroll
        for (int e = 0; e < 4; ++e) { lo[e] = k0 + e <= row ? lo[e] : 0.f; hi[e] = k0 + 8 + e <= row ? hi[e] : 0.f; }
        st16_sc1(slot + SL_T + ((rb * 4 + ks) * 64 + lane) * 16, pack8f(lo, hi)); }
    LDS_WAIT();
    asm volatile("s_waitcnt vmcnt(0)" ::: "memory");
    if (lane == 0) __hip_atomic_store(item_granule(A, item), ((unsigned long long)ep << 32) | (unsigned long long)__float_as_uint(gcl), __ATOMIC_RELAXED, __HIP_MEMORY_SCOPE_AGENT);
}
DI void scan_seq(KA A, int seq, int w, int lane, unsigned ep) {
    const int r = lane & 31, hh = lane >> 5, dv = 32 * w + r;
    const bool sample = seq >= N_PROMPT_SEQ; const int sidx = sample ? seq - N_PROMPT_SEQ : seq, b = sidx >> 2, h = sidx & 3, nch = sample ? 1 : CHUNKS_P;
    f32x16 S[4];
    if (sample) {
        const float* S0 = A->state_delta + ((size_t)(b * 4 + h) * 128) * 128 + dv;
#pragma unroll
        for (int kb = 0; kb < 4; ++kb)
#pragma unroll
            for (int reg = 0; reg < 16; ++reg) S[kb][reg] = S0[(size_t)(32 * kb + crow16(reg, hh)) * 128];
    } else {
#pragma unroll
        for (int kb = 0; kb < 4; ++kb)
#pragma unroll
            for (int reg = 0; reg < 16; ++reg) S[kb][reg] = 0.f;
    }
    bf16* OBR = (bf16*)((unsigned char*)A->out + DO_OB);
#pragma unroll 1
    for (int c = 0; c < nch; ++c) {
        const int item = sample ? N_ITEMS_P + sidx : seq * CHUNKS_P + c;
        const unsigned char* slot = slot_ptr(A, item);
        const float gcl = wait_item(item_granule(A, item), ep);
        __builtin_amdgcn_fence(__ATOMIC_ACQUIRE, "agent");
        const bf16x8* bek = (const bf16x8*)(slot + SL_BEK) + lane; const bf16x8* tp = (const bf16x8*)(slot + SL_T) + lane;
        const bf16x8* qe = (const bf16x8*)(slot + SL_QE) + lane; const bf16x8* qkd = (const bf16x8*)(slot + SL_QKD) + lane; const bf16x8* kwt = (const bf16x8*)(slot + SL_KWT) + lane;
        bf16x8 sf[8];
#pragma unroll
        for (int kb = 0; kb < 4; ++kb) { sf[2 * kb] = pack_step<0>(S[kb]); sf[2 * kb + 1] = pack_step<1>(S[kb]); }
        f32x16 x0, x1;
#pragma unroll
        for (int e = 0; e < 16; ++e) { x0[e] = 0.f; x1[e] = 0.f; }
#pragma unroll
        for (int ks = 0; ks < 8; ++ks) { x0 = MFMA32(bek[ks * 64], sf[ks], x0); x1 = MFMA32(bek[(8 + ks) * 64], sf[ks], x1); }
        {
            const u32x4* bv = (const u32x4*)(slot + SL_BV) + ((w * 2) * 64 + lane) * 2;
            const u32x4 a0 = bv[0], a1 = bv[1], c0 = bv[128], c1 = bv[129];
            x0[0] = bflo(a0.x) - x0[0]; x0[1] = bfhi(a0.x) - x0[1]; x0[2] = bflo(a0.y) - x0[2]; x0[3] = bfhi(a0.y) - x0[3];
            x0[4] = bflo(a0.z) - x0[4]; x0[5] = bfhi(a0.z) - x0[5]; x0[6] = bflo(a0.w) - x0[6]; x0[7] = bfhi(a0.w) - x0[7];
            x0[8] = bflo(a1.x) - x0[8]; x0[9] = bfhi(a1.x) - x0[9]; x0[10] = bflo(a1.y) - x0[10]; x0[11] = bfhi(a1.y) - x0[11];
            x0[12] = bflo(a1.z) - x0[12]; x0[13] = bfhi(a1.z) - x0[13]; x0[14] = bflo(a1.w) - x0[14]; x0[15] = bfhi(a1.w) - x0[15];
            x1[0] = bflo(c0.x) - x1[0]; x1[1] = bfhi(c0.x) - x1[1]; x1[2] = bflo(c0.y) - x1[2]; x1[3] = bfhi(c0.y) - x1[3];
            x1[4] = bflo(c0.z) - x1[4]; x1[5] = bfhi(c0.z) - x1[5]; x1[6] = bflo(c0.w) - x1[6]; x1[7] = bfhi(c0.w) - x1[7];
            x1[8] = bflo(c1.x) - x1[8]; x1[9] = bfhi(c1.x) - x1[9]; x1[10] = bflo(c1.y) - x1[10]; x1[11] = bfhi(c1.y) - x1[11];
            x1[12] = bflo(c1.z) - x1[12]; x1[13] = bfhi(c1.z) - x1[13]; x1[14] = bflo(c1.w) - x1[14]; x1[15] = bfhi(c1.w) - x1[15];
        }
        bf16x8 rf[4] = {pack_step<0>(x0), pack_step<1>(x0), pack_step<0>(x1), pack_step<1>(x1)};
        f32x16 u0, u1;
#pragma unroll
        for (int e = 0; e < 16; ++e) { u0[e] = 0.f; u1[e] = 0.f; }
        u0 = MFMA32(tp[0 * 64], rf[0], u0); u0 = MFMA32(tp[1 * 64], rf[1], u0);
#pragma unroll
        for (int ks = 0; ks < 4; ++ks) u1 = MFMA32(tp[(4 + ks) * 64], rf[ks], u1);
        bf16x8 uf[4] = {pack_step<0>(u0), pack_step<1>(u0), pack_step<0>(u1), pack_step<1>(u1)};
        if (sample || c > 0) {
#pragma unroll
            for (int e = 0; e < 16; ++e) { x0[e] = 0.f; x1[e] = 0.f; }
#pragma unroll
            for (int ks = 0; ks < 8; ++ks) { x0 = MFMA32(qe[ks * 64], sf[ks], x0); x1 = MFMA32(qe[(8 + ks) * 64], sf[ks], x1); }
            x0 = MFMA32(qkd[0 * 64], uf[0], x0); x0 = MFMA32(qkd[1 * 64], uf[1], x0);
#pragma unroll
            for (int ks = 0; ks < 4; ++ks) x1 = MFMA32(qkd[(4 + ks) * 64], uf[ks], x1);
            const int crow0 = sample ? NBATCH * SEQ + b * TS : b * SEQ + 64 * (c - 1), L = sample ? TS : 64;
#pragma unroll
            for (int reg = 0; reg < 16; ++reg) { const int i0 = crow16(reg, hh), i1 = 32 + i0;
                if (i0 < L) OBR[(size_t)(crow0 + i0) * OAB_PITCH + h * 128 + dv] = f2bf(x0[reg]);
                if (i1 < L) OBR[(size_t)(crow0 + i1) * OAB_PITCH + h * 128 + dv] = f2bf(x1[reg]); }
        }
#pragma unroll
        for (int kb = 0; kb < 4; ++kb) {
            S[kb] = S[kb] * gcl;
#pragma unroll
            for (int ks = 0; ks < 4; ++ks) S[kb] = MFMA32(kwt[(kb * 4 + ks) * 64], uf[ks], S[kb]);
        }
    }
    float* So = A->out + (sample ? O_DS : O_DP) + ((size_t)(b * 4 + h) * 128) * 128 + dv;
#pragma unroll
    for (int kb = 0; kb < 4; ++kb)
#pragma unroll
        for (int reg = 0; reg < 16; ++reg) So[(size_t)(32 * kb + crow16(reg, hh)) * 128] = S[kb][reg];
}

constexpr int HALF_BYTES = 40960;
DI void scan_prompt_wg(KA A, int seq, LAS unsigned char* lds, unsigned ep) {
    const int tid = tid_opaque(), lane = tid & 63, wave = __builtin_amdgcn_readfirstlane(tid >> 6);
    const int b = seq >> 2, h = seq & 3;
    constexpr int N = 2 * CHUNKS_P;
    if (wave >= 4) {
        const int loff = (wave - 4) * 10240 + lane * 16;
        u32x4 r0[10], r1[10], r2[10], r3[10];
        LAS u32x4* d0 = (LAS u32x4*)(lds + loff); LAS u32x4* d1 = (LAS u32x4*)(lds + HALF_BYTES + loff);
        LAS float* gclw = (LAS float*)(lds + 2 * HALF_BYTES);
        unsigned long long pv;
#define SL_PEEK(c) do { if ((c) < CHUNKS_P) pv = __hip_atomic_load(item_granule(A, seq * CHUNKS_P + (c)), __ATOMIC_RELAXED, __HIP_MEMORY_SCOPE_AGENT); } while (0)
#define SL_POLL(c) do { float g_; if ((unsigned)(pv >> 32) >= ep) { asm volatile("" ::: "memory"); g_ = __uint_as_float((unsigned)__builtin_amdgcn_readfirstlane((int)(unsigned)pv)); } \
            else g_ = wait_item(item_granule(A, seq * CHUNKS_P + (c)), ep); if (wave == 4 && lane == 0) gclw[(c) & 7] = g_; } while (0)
#define SL_ISSUE(h, R) do { const __amdgpu_buffer_rsrc_t rs_ = __builtin_amdgcn_make_buffer_rsrc((void*)slot_ptr(A, seq * CHUNKS_P + ((h) >> 1)), 0, (int)PREP_SLOT, 0x00020000); \
            _Pragma("unroll") for (int q = 0; q < 10; ++q) R[q] = __builtin_bit_cast(u32x4, __builtin_amdgcn_raw_buffer_load_b128(rs_, ((h) & 1) * HALF_BYTES + loff + q * 1024, 0, 16)); } while (0)
#define SL_WRITE(D, R) do { _Pragma("unroll") for (int q = 0; q < 10; ++q) D[q * 64] = R[q]; } while (0)
#define SL_STEP(k, D, R, FIRST) do { if ((k) < N) { \
            if ((k) + 1 < N) SL_WRITE(D, R); \
            LDS_BARRIER(); \
            if ((k) + 5 < N) { if (FIRST) { SL_POLL(((k) + 5) >> 1); SL_PEEK(((k) + 7) >> 1); } SL_ISSUE((k) + 5, R); } } } while (0)
#define SL_STEPU(k, D, R, FIRST) do { SL_WRITE(D, R); LDS_BARRIER(); if (FIRST) { SL_POLL(((k) + 5) >> 1); pv = __hip_atomic_load(item_granule(A, seq * CHUNKS_P + (((k) + 7) >> 1)), __ATOMIC_RELAXED, __HIP_MEMORY_SCOPE_AGENT); } SL_ISSUE((k) + 5, R); } while (0)
        SL_PEEK(0); SL_POLL(0); SL_ISSUE(0, r0); SL_ISSUE(1, r1);
        SL_PEEK(1); SL_POLL(1); SL_ISSUE(2, r2); SL_ISSUE(3, r3);
        SL_WRITE(d0, r0);
        LDS_BARRIER();
        SL_PEEK(2); SL_POLL(2); SL_PEEK(3); SL_ISSUE(4, r0);
#pragma unroll
        for (int k = 0; k < N; k += 4) {
            SL_STEP(k, d1, r1, false);
            SL_STEP(k + 1, d0, r2, true);
            SL_STEP(k + 2, d1, r3, false);
            SL_STEP(k + 3, d0, r0, true);
        }
#undef SL_PEEK
#undef SL_POLL
#undef SL_ISSUE
#undef SL_WRITE
#undef SL_STEP
#undef SL_STEPU
    } else {
        const int w = wave, r = lane & 31, hh = lane >> 5, dv = 32 * w + r;
        f32x16 S[4];
#pragma unroll
        for (int kb = 0; kb < 4; ++kb)
#pragma unroll
            for (int reg = 0; reg < 16; ++reg) S[kb][reg] = 0.f;
        bf16x8 uf[4], kw2[8];
#pragma unroll
        for (int i = 0; i < 4; ++i) uf[i] = (bf16x8){0, 0, 0, 0, 0, 0, 0, 0};
#pragma unroll
        for (int i = 0; i < 8; ++i) kw2[i] = (bf16x8){0, 0, 0, 0, 0, 0, 0, 0};
        float gprev = 1.0f;
        bf16* OBR = (bf16*)((unsigned char*)A->out + DO_OB);
        const LAS float* gclw = (const LAS float*)(lds + 2 * HALF_BYTES);
        const LAS bf16x8* bek = (const LAS bf16x8*)(lds + SL_BEK) + lane; const LAS bf16x8* tp = (const LAS bf16x8*)(lds + SL_T) + lane;
        const LAS u32x4* bv = (const LAS u32x4*)(lds + SL_BV) + ((w * 2) * 64 + lane) * 2;
        const LAS bf16x8* qkd = (const LAS bf16x8*)(lds + HALF_BYTES + (SL_QKD - HALF_BYTES)) + lane; const LAS bf16x8* qe = (const LAS bf16x8*)(lds + HALF_BYTES + (SL_QE - HALF_BYTES)) + lane;
        const LAS bf16x8* kwt = (const LAS bf16x8*)(lds + HALF_BYTES + (SL_KWT - HALF_BYTES)) + lane;
#define SB() __builtin_amdgcn_sched_barrier(0)
        LDS_BARRIER();
#pragma unroll 1
        for (int c = 0; c < CHUNKS_P; ++c) {
            bf16x8 g0[8], g1[8];
#pragma unroll
            for (int ks = 0; ks < 4; ++ks) { g0[ks] = bek[ks * 64]; g0[4 + ks] = bek[(8 + ks) * 64]; }
            SB();
#pragma unroll
            for (int kb = 2; kb < 4; ++kb) {
                S[kb] = S[kb] * gprev;
#pragma unroll
                for (int ks = 0; ks < 4; ++ks) S[kb] = MFMA32(kw2[(kb - 2) * 4 + ks], uf[ks], S[kb]);
            }
            bf16x8 sf[8];
#pragma unroll
            for (int kb = 0; kb < 4; ++kb) { sf[2 * kb] = pack_step<0>(S[kb]); sf[2 * kb + 1] = pack_step<1>(S[kb]); }
            SB();
#pragma unroll
            for (int ks = 0; ks < 4; ++ks) { g1[ks] = bek[(4 + ks) * 64]; g1[4 + ks] = bek[(12 + ks) * 64]; }
            SB();
            f32x16 x0, x1;
#pragma unroll
            for (int e = 0; e < 16; ++e) { x0[e] = 0.f; x1[e] = 0.f; }
#pragma unroll
            for (int ks = 0; ks < 4; ++ks) { x0 = MFMA32(g0[ks], sf[ks], x0); x1 = MFMA32(g0[4 + ks], sf[ks], x1); }
            SB();
            const u32x4 a0 = bv[0], a1 = bv[1], c0 = bv[128], c1 = bv[129];
            bf16x8 tf[6];
            tf[0] = tp[0 * 64]; tf[1] = tp[1 * 64];
#pragma unroll
            for (int ks = 0; ks < 4; ++ks) tf[2 + ks] = tp[(4 + ks) * 64];
            SB();
#pragma unroll
            for (int ks = 0; ks < 4; ++ks) { x0 = MFMA32(g1[ks], sf[4 + ks], x0); x1 = MFMA32(g1[4 + ks], sf[4 + ks], x1); }
            {
                x0[0] = bflo(a0.x) - x0[0]; x0[1] = bfhi(a0.x) - x0[1]; x0[2] = bflo(a0.y) - x0[2]; x0[3] = bfhi(a0.y) - x0[3];
                x0[4] = bflo(a0.z) - x0[4]; x0[5] = bfhi(a0.z) - x0[5]; x0[6] = bflo(a0.w) - x0[6]; x0[7] = bfhi(a0.w) - x0[7];
                x0[8] = bflo(a1.x) - x0[8]; x0[9] = bfhi(a1.x) - x0[9]; x0[10] = bflo(a1.y) - x0[10]; x0[11] = bfhi(a1.y) - x0[11];
                x0[12] = bflo(a1.z) - x0[12]; x0[13] = bfhi(a1.z) - x0[13]; x0[14] = bflo(a1.w) - x0[14]; x0[15] = bfhi(a1.w) - x0[15];
                x1[0] = bflo(c0.x) - x1[0]; x1[1] = bfhi(c0.x) - x1[1]; x1[2] = bflo(c0.y) - x1[2]; x1[3] = bfhi(c0.y) - x1[3];
                x1[4] = bflo(c0.z) - x1[4]; x1[5] = bfhi(c0.z) - x1[5]; x1[6] = bflo(c0.w) - x1[6]; x1[7] = bfhi(c0.w) - x1[7];
                x1[8] = bflo(c1.x) - x1[8]; x1[9] = bfhi(c1.x) - x1[9]; x1[10] = bflo(c1.y) - x1[10]; x1[11] = bfhi(c1.y) - x1[11];
                x1[12] = bflo(c1.z) - x1[12]; x1[13] = bfhi(c1.z) - x1[13]; x1[14] = bflo(c1.w) - x1[14]; x1[15] = bfhi(c1.w) - x1[15];
            }
            const bf16x8 rf[4] = {pack_step<0>(x0), pack_step<1>(x0), pack_step<0>(x1), pack_step<1>(x1)};
            LDS_BARRIER();
#pragma unroll
            for (int ks = 0; ks < 4; ++ks) { g0[ks] = qe[ks * 64]; g0[4 + ks] = qe[(8 + ks) * 64]; }
            SB();
            f32x16 u0, u1;
#pragma unroll
            for (int e = 0; e < 16; ++e) { u0[e] = 0.f; u1[e] = 0.f; }
            u0 = MFMA32(tf[0], rf[0], u0); u1 = MFMA32(tf[2], rf[0], u1); u0 = MFMA32(tf[1], rf[1], u0);
#pragma unroll
            for (int ks = 1; ks < 4; ++ks) u1 = MFMA32(tf[2 + ks], rf[ks], u1);
            uf[0] = pack_step<0>(u0); uf[1] = pack_step<1>(u0); uf[2] = pack_step<0>(u1); uf[3] = pack_step<1>(u1);
            SB();
#pragma unroll
            for (int ks = 0; ks < 4; ++ks) { g1[ks] = qe[(4 + ks) * 64]; g1[4 + ks] = qe[(12 + ks) * 64]; }
            SB();
#pragma unroll
            for (int e = 0; e < 16; ++e) { x0[e] = 0.f; x1[e] = 0.f; }
#pragma unroll
            for (int ks = 0; ks < 4; ++ks) { x0 = MFMA32(g0[ks], sf[ks], x0); x1 = MFMA32(g0[4 + ks], sf[ks], x1); }
            SB();
            bf16x8 qk[6];
            qk[0] = qkd[0 * 64]; qk[1] = qkd[1 * 64];
#pragma unroll
            for (int ks = 0; ks < 4; ++ks) qk[2 + ks] = qkd[(4 + ks) * 64];
            SB();
#pragma unroll
            for (int ks = 0; ks < 4; ++ks) { x0 = MFMA32(g1[ks], sf[4 + ks], x0); x1 = MFMA32(g1[4 + ks], sf[4 + ks], x1); }
            SB();
#pragma unroll
            for (int i = 0; i < 8; ++i) g0[i] = kwt[i * 64];
            SB();
            x0 = MFMA32(qk[0], uf[0], x0); x1 = MFMA32(qk[2], uf[0], x1); x0 = MFMA32(qk[1], uf[1], x0);
#pragma unroll
            for (int ks = 1; ks < 4; ++ks) x1 = MFMA32(qk[2 + ks], uf[ks], x1);
            SB();
#pragma unroll
            for (int i = 0; i < 8; ++i) kw2[i] = kwt[(8 + i) * 64];
            const float gcl = gclw[c & 7];
            SB();
#pragma unroll
            for (int kb = 0; kb < 2; ++kb) {
                S[kb] = S[kb] * gcl;
#pragma unroll
                for (int ks = 0; ks < 4; ++ks) S[kb] = MFMA32(g0[kb * 4 + ks], uf[ks], S[kb]);
            }
            if (c > 0) {
                bf16* orow = OBR + (size_t)(b * SEQ + 64 * (c - 1)) * OAB_PITCH + h * 128 + dv;
#pragma unroll
                for (int reg = 0; reg < 16; ++reg) { const int i0 = crow16(reg, hh); orow[(size_t)i0 * OAB_PITCH] = f2bf(x0[reg]); orow[(size_t)(32 + i0) * OAB_PITCH] = f2bf(x1[reg]); }
            }
            gprev = gcl;
            LDS_BARRIER();
        }
#pragma unroll
        for (int kb = 2; kb < 4; ++kb) {
            S[kb] = S[kb] * gprev;
#pragma unroll
            for (int ks = 0; ks < 4; ++ks) S[kb] = MFMA32(kw2[(kb - 2) * 4 + ks], uf[ks], S[kb]);
        }
#undef SB
        float* So = A->out + O_DP + ((size_t)(b * 4 + h) * 128) * 128 + dv;
#pragma unroll
        for (int kb = 0; kb < 4; ++kb)
#pragma unroll
            for (int reg = 0; reg < 16; ++reg) So[(size_t)(32 * kb + crow16(reg, hh)) * 128] = S[kb][reg];
    }
}

constexpr int KPITCH = 72, VPITCH = 264;
typedef short v4i16_t __attribute__((ext_vector_type(4)));
DI void attn_unit(KA A, int unit, LAS unsigned char* ldsb) {
    const int tid = tid_opaque(), lane = tid & 63, wave = __builtin_amdgcn_readfirstlane(tid >> 6), r = lane & 31, hh = lane >> 5;
    const int b = unit >> 6, kh = (unit >> 5) & 1, jb = unit & 31, T0 = NMETA + 128 * jb;
    LAS bf16* Ksm = (LAS bf16*)ldsb; LAS bf16* VTs = Ksm + 256 * KPITCH;
    const bf16* KVg = (const bf16*)(A->ws + WS_KV); const bf16* QAg = (const bf16*)(A->ws + WS_QA);
#pragma unroll
    for (int e4 = 0; e4 < 4; ++e4) {
        const int id = tid + 512 * e4, key = id >> 3, cch = id & 7, tk = T0 - 128 + key;
        u32x4 kq = (u32x4){0u, 0u, 0u, 0u}, vq = kq;
        if (tk >= 0) { const bf16* src = KVg + (size_t)(b * TP + tk) * 256 + kh * 64 + 8 * cch; kq = *(const u32x4*)src; vq = *(const u32x4*)(src + 128); }
        *(LAS u32x4*)(Ksm + key * KPITCH + 8 * cch) = kq;
        *(LAS u32x4*)(VTs + key * KPITCH + 8 * cch) = vq;
    }
    LDS_BARRIER();
    const int g = wave >> 1, qh = wave & 1, head = 4 * kh + g;
    const float sink2 = A->sinks[head] * 1.4426950408889634f;
    const int kmin = jb == 0 ? 128 - NMETA : 0;
#pragma unroll 1
    for (int q2 = 0; q2 < 2; ++q2) {
        const int qb = 2 * qh + q2, iq = 32 * qb + r;
        const bf16* qrow = QAg + (size_t)(b * TP + T0 + iq) * 512 + head * 64 + 8 * hh;
        bf16x8 qf[4];
#pragma unroll
        for (int s = 0; s < 4; ++s) qf[s] = *(const bf16x8*)(qrow + 16 * s);
        f32x16 st[5];
        float m = sink2;
#pragma unroll
        for (int kt5 = 0; kt5 < 5; ++kt5) {
            const int kt = qb + kt5;
            f32x16 acc;
#pragma unroll
            for (int e = 0; e < 16; ++e) acc[e] = 0.f;
#pragma unroll
            for (int s = 0; s < 4; ++s) acc = MFMA32(*(const LAS bf16x8*)(Ksm + (32 * kt + r) * KPITCH + 16 * s + 8 * hh), qf[s], acc);
#pragma unroll
            for (int reg = 0; reg < 16; ++reg) { const int kk = 32 * kt + crow16(reg, hh); const bool ok = kk >= iq && kk <= iq + 128 && kk >= kmin;
                acc[reg] = ok ? acc[reg] : -INFINITY; m = fmaxf(m, acc[reg]); }
            st[kt5] = acc;
        }
        m = fmaxf(m, __shfl_xor(m, 32));
        float l = 0.f;
#pragma unroll
        for (int kt5 = 0; kt5 < 5; ++kt5)
#pragma unroll
            for (int reg = 0; reg < 16; ++reg) { const float p = exp2f(st[kt5][reg] - m); st[kt5][reg] = p; l += p; }
        l += __shfl_xor(l, 32); l += exp2f(sink2 - m);
        f32x16 o0, o1;
#pragma unroll
        for (int e = 0; e < 16; ++e) { o0[e] = 0.f; o1[e] = 0.f; }
#pragma unroll
        for (int kt5 = 0; kt5 < 5; ++kt5) {
            const int kt = qb + kt5;
            const bf16x8 p0 = pack_step<0>(st[kt5]), p1 = pack_step<1>(st[kt5]);
            const LAS bf16* vb = VTs + (32 * kt + 4 * hh + ((lane & 15) >> 2)) * KPITCH + 16 * ((lane >> 4) & 1) + 4 * (lane & 3);
#define VTR(ptr) __builtin_amdgcn_ds_read_tr16_b64_v4i16((LAS v4i16_t*)(ptr))
            const v4i16_t a00 = VTR(vb), a01 = VTR(vb + 8 * KPITCH), a10 = VTR(vb + 16 * KPITCH), a11 = VTR(vb + 24 * KPITCH);
            const v4i16_t b00 = VTR(vb + 32), b01 = VTR(vb + 8 * KPITCH + 32), b10 = VTR(vb + 16 * KPITCH + 32), b11 = VTR(vb + 24 * KPITCH + 32);
#undef VTR
            o0 = MFMA32(__builtin_shufflevector(a00, a01, 0, 1, 2, 3, 4, 5, 6, 7), p0, o0); o0 = MFMA32(__builtin_shufflevector(a10, a11, 0, 1, 2, 3, 4, 5, 6, 7), p1, o0);
            o1 = MFMA32(__builtin_shufflevector(b00, b01, 0, 1, 2, 3, 4, 5, 6, 7), p0, o1); o1 = MFMA32(__builtin_shufflevector(b10, b11, 0, 1, 2, 3, 4, 5, 6, 7), p1, o1);
        }
        const float rl = 1.0f / l;
        bf16* orow = (bf16*)((unsigned char*)A->out + DO_OA) + (size_t)(b * SEQ + 128 * jb + iq) * OAB_PITCH + head * 64 + 4 * hh;
#pragma unroll
        for (int g4 = 0; g4 < 4; ++g4) {
            *(u32x2*)(orow + 8 * g4) = (u32x2){cvtpk(o0[4 * g4] * rl, o0[4 * g4 + 1] * rl), cvtpk(o0[4 * g4 + 2] * rl, o0[4 * g4 + 3] * rl)};
            *(u32x2*)(orow + 32 + 8 * g4) = (u32x2){cvtpk(o1[4 * g4] * rl, o1[4 * g4 + 1] * rl), cvtpk(o1[4 * g4 + 2] * rl, o1[4 * g4 + 3] * rl)};
        }
    }
    LDS_BARRIER();
}
DI void sample_attn(KA A, int b, int head, LAS float* wl, int lane) {
    const int kh = head >> 2;
    LAS float* qn = wl; LAS float* ps = wl + 256;
    const bf16* QAg = (const bf16*)(A->ws + WS_QA); const bf16* KVg = (const bf16*)(A->ws + WS_KV);
    u32x4 nk[8];
    { const u32x4* kn = (const u32x4*)(KVg + (size_t)(MP + b * TS + (lane & 3)) * 256 + kh * 64);
#pragma unroll
      for (int i = 0; i < 8; ++i) nk[i] = kn[i]; }
#pragma unroll
    for (int i = 0; i < 4; ++i) qn[i * 64 + lane] = bf2f(QAg[(size_t)(MP + b * TS + i) * 512 + head * 64 + pos_of_d(lane)]);
    const float sink2 = A->sinks[head] * 1.4426950408889634f;
    LDS_WAIT(); asm volatile("" ::: "memory");
    float s0[4] = {0.f, 0.f, 0.f, 0.f}, s1[4] = {0.f, 0.f, 0.f, 0.f}, s2[4] = {0.f, 0.f, 0.f, 0.f};
    const f32x4* kr0 = (const f32x4*)(A->cache_k + ((size_t)(b * 128 + lane) * 2 + kh) * 64);
#pragma unroll 1
    for (int c = 0; c < 2; ++c) {
        f32x4 k0[8], k1[8];
#pragma unroll
        for (int d = 0; d < 8; ++d) { k0[d] = kr0[8 * c + d]; k1[d] = kr0[8 * c + d + 64 * 2 * 16]; }
#pragma unroll
        for (int d = 0; d < 8; ++d) {
#pragma unroll
            for (int i = 0; i < 4; ++i) { const f32x4 q = *(const LAS f32x4*)(qn + i * 64 + 32 * c + 4 * d);
                s0[i] = __builtin_fmaf(k0[d][3], q[3], __builtin_fmaf(k0[d][2], q[2], __builtin_fmaf(k0[d][1], q[1], __builtin_fmaf(k0[d][0], q[0], s0[i]))));
                s1[i] = __builtin_fmaf(k1[d][3], q[3], __builtin_fmaf(k1[d][2], q[2], __builtin_fmaf(k1[d][1], q[1], __builtin_fmaf(k1[d][0], q[0], s1[i])))); }
        }
        asm volatile("" : "+v"(s0[0]), "+v"(s0[1]), "+v"(s0[2]), "+v"(s0[3]), "+v"(s1[0]), "+v"(s1[1]), "+v"(s1[2]), "+v"(s1[3]));
    }
#pragma unroll
    for (int g8 = 0; g8 < 8; ++g8) {
        const float e0 = bflo(nk[g8].x), e1 = bfhi(nk[g8].x), e2 = bflo(nk[g8].y), e3 = bfhi(nk[g8].y), e4 = bflo(nk[g8].z), e5 = bfhi(nk[g8].z), e6 = bflo(nk[g8].w), e7 = bfhi(nk[g8].w);
#pragma unroll
        for (int i = 0; i < 4; ++i) { const f32x4 qa = *(const LAS f32x4*)(qn + i * 64 + 4 * g8), qb = *(const LAS f32x4*)(qn + i * 64 + 32 + 4 * g8);
            s2[i] = __builtin_fmaf(e3, qa[3], __builtin_fmaf(e2, qa[2], __builtin_fmaf(e1, qa[1], __builtin_fmaf(e0, qa[0], s2[i]))));
            s2[i] = __builtin_fmaf(e7, qb[3], __builtin_fmaf(e6, qb[2], __builtin_fmaf(e5, qb[1], __builtin_fmaf(e4, qb[0], s2[i])))); }
        asm volatile("" : "+v"(s2[0]), "+v"(s2[1]), "+v"(s2[2]), "+v"(s2[3]));
    }
#pragma unroll
    for (int i = 0; i < 4; ++i) { ps[i * 132 + lane] = lane >= i ? s0[i] : -INFINITY; ps[i * 132 + 64 + lane] = s1[i]; if (lane < 4) ps[i * 132 + 128 + lane] = lane <= i ? s2[i] : -INFINITY; }
    const int kg = lane >> 4, d4l = lane & 15;
    const u32x2 vn = *(const u32x2*)(KVg + (size_t)(MP + b * TS + kg) * 256 + 128 + kh * 64 + 4 * d4l);
    LDS_WAIT(); asm volatile("" ::: "memory");
    float linv[4];
#pragma unroll
    for (int i = 0; i < 4; ++i) {
        const float t0 = ps[i * 132 + lane], t1 = ps[i * 132 + 64 + lane], t2 = lane < 4 ? ps[i * 132 + 128 + lane] : -INFINITY;
        const float m = wave_max(fmaxf(fmaxf(t0, t1), fmaxf(t2, sink2)));
        const float p0 = exp2f(t0 - m), p1 = exp2f(t1 - m), p2 = exp2f(t2 - m);
        ps[i * 132 + lane] = p0; ps[i * 132 + 64 + lane] = p1; if (lane < 4) ps[i * 132 + 128 + lane] = p2;
        linv[i] = 1.0f / (wave_sum(p0 + p1 + p2) + exp2f(sink2 - m));
    }
    LDS_WAIT(); asm volatile("" ::: "memory");
    f32x4 o[4];
#pragma unroll
    for (int i = 0; i < 4; ++i) { const float pn = ps[i * 132 + 128 + kg]; o[i] = (f32x4){bflo(vn.x) * pn, bfhi(vn.x) * pn, bflo(vn.y) * pn, bfhi(vn.y) * pn}; }
    const float* vb = A->cache_v + ((size_t)(b * 128 + kg) * 2 + kh) * 64 + 4 * d4l;
#pragma unroll 1
    for (int c = 0; c < 2; ++c) {
        f32x4 vv[16];
#pragma unroll
        for (int j = 0; j < 16; ++j) vv[j] = *(const f32x4*)(vb + (size_t)(16 * c + j) * 4 * 128);
#pragma unroll
        for (int j = 0; j < 16; ++j)
#pragma unroll
            for (int i = 0; i < 4; ++i) { const float pj = ps[i * 132 + 64 * c + 4 * j + kg]; o[i] += vv[j] * pj; }
        asm volatile("" : "+v"(o[0]), "+v"(o[1]), "+v"(o[2]), "+v"(o[3]));
    }
    bf16* OAg = (bf16*)((unsigned char*)A->out + DO_OA);
#pragma unroll
    for (int i = 0; i < 4; ++i) {
#pragma unroll
        for (int e = 0; e < 4; ++e) { float t = o[i][e]; t += __shfl_xor(t, 16); t += __shfl_xor(t, 32); o[i][e] = t * linv[i]; }
        if (lane < 16) *(u32x2*)(OAg + (size_t)(NBATCH * SEQ + b * TS + i) * OAB_PITCH + head * 64 + 4 * d4l) = (u32x2){cvtpk(o[i][0], o[i][1]), cvtpk(o[i][2], o[i][3])};
    }
    LDS_WAIT(); asm volatile("" ::: "memory");
}
DI void sample_delta(KA A, int b, int h, int quarter, LAS float* wl, int lane) {
    const bf16* QKVB = (const bf16*)(A->ws + WS_QKVB);
    LAS float* qs = wl; LAS float* ks = wl + 512;
    const int dv = 32 * quarter + (lane >> 1), part = lane & 1;
    f32x2 gb[4];
#pragma unroll
    for (int t = 0; t < 4; ++t) gb[t] = ((const f32x2*)(A->ws + WS_GB))[(size_t)(MP + b * TS + t) * 4 + h];
    float xw[5][7], ww[5][4];
#pragma unroll
    for (int cidx = 0; cidx < 5; ++cidx) {
        const int ch = cidx < 4 ? (cidx >> 1) * 512 + h * 128 + lane + 64 * (cidx & 1) : 1024 + h * 128 + dv;
#pragma unroll
        for (int i = 0; i < 3; ++i) xw[cidx][i] = A->state_conv[((size_t)b * 3 + i) * CONVD + ch];
#pragma unroll
        for (int t = 0; t < 4; ++t) xw[cidx][3 + t] = bf2f(QKVB[(size_t)(MP + b * TS + t) * CONVD + ch]);
#pragma unroll
        for (int i = 0; i < 4; ++i) ww[cidx][i] = A->conv_w[i * CONVD + ch];
    }
    float cv[5][4];
#pragma unroll
    for (int cidx = 0; cidx < 5; ++cidx)
#pragma unroll
        for (int t = 0; t < 4; ++t) cv[cidx][t] = siluf_(ww[cidx][0] * xw[cidx][t] + ww[cidx][1] * xw[cidx][t + 1] + ww[cidx][2] * xw[cidx][t + 2] + ww[cidx][3] * xw[cidx][t + 3]);
    __builtin_amdgcn_sched_barrier(0);
    float s[64];
    { const float* S0 = A->state_delta + ((size_t)(b * 4 + h) * 128 + 64 * part) * 128 + dv;
#pragma unroll
      for (int i = 0; i < 64; ++i) s[i] = S0[(size_t)i * 128]; }
    __builtin_amdgcn_sched_barrier(0);
#pragma unroll
    for (int grp = 0; grp < 2; ++grp) {
        LAS float* dst = grp == 0 ? qs : ks;
#pragma unroll
        for (int t = 0; t < 4; ++t) { const float c0 = cv[2 * grp][t], c1 = cv[2 * grp + 1][t];
            const float rn = rsqrtf(wave_sum(c0 * c0 + c1 * c1) + EPS) * (grp == 0 ? 0.08838834764831845f : 1.0f);
            dst[t * 128 + lane] = c0 * rn; dst[t * 128 + 64 + lane] = c1 * rn; }
    }
    LDS_WAIT(); asm volatile("" ::: "memory");
    bf16* OBR = (bf16*)((unsigned char*)A->out + DO_OB) + (size_t)(NBATCH * SEQ + b * TS) * OAB_PITCH + h * 128 + dv;
#pragma unroll
    for (int t = 0; t < 4; ++t) {
        const float eg = __expf(gb[t][0]);
        const LAS float* kt = ks + t * 128 + 64 * part; const LAS float* qt = qs + t * 128 + 64 * part;
        float ksum = 0.f;
#pragma unroll
        for (int j = 0; j < 16; ++j) { if ((j & 3) == 0) __builtin_amdgcn_sched_barrier(0);
            const f32x4 kk = *(const LAS f32x4*)(kt + 4 * j);
            s[4 * j] *= eg; s[4 * j + 1] *= eg; s[4 * j + 2] *= eg; s[4 * j + 3] *= eg;
            ksum += (s[4 * j] * kk[0] + s[4 * j + 1] * kk[1]) + (s[4 * j + 2] * kk[2] + s[4 * j + 3] * kk[3]); }
        ksum += __shfl_xor(ksum, 1);
        const float u = gb[t][1] * (cv[4][t] - ksum);
        float osum = 0.f;
#pragma unroll
        for (int j = 0; j < 16; ++j) { if ((j & 3) == 0) __builtin_amdgcn_sched_barrier(0);
            const f32x4 kk = *(const LAS f32x4*)(kt + 4 * j), qq = *(const LAS f32x4*)(qt + 4 * j);
            s[4 * j] += kk[0] * u; s[4 * j + 1] += kk[1] * u; s[4 * j + 2] += kk[2] * u; s[4 * j + 3] += kk[3] * u;
            osum += (s[4 * j] * qq[0] + s[4 * j + 1] * qq[1]) + (s[4 * j + 2] * qq[2] + s[4 * j + 3] * qq[3]); }
        osum += __shfl_xor(osum, 1);
        if (part == 0) OBR[(size_t)t * OAB_PITCH] = f2bf(osum);
    }
    { float* So = A->out + O_DS + ((size_t)(b * 4 + h) * 128 + 64 * part) * 128 + dv;
#pragma unroll
      for (int i = 0; i < 64; ++i) So[(size_t)i * 128] = s[i]; }
    LDS_WAIT(); asm volatile("" ::: "memory");
}
constexpr int NINV_WG = 24;
DI void p23_mixers(KA A, LAS unsigned char* lds, const XcdBarrier& dbg_bar, unsigned ep, int pmode = 0) {
    const int tid = tid_opaque(), lane = tid & 63, wave = __builtin_amdgcn_readfirstlane(tid >> 6), G = gridDim.x, wg = blockIdx.x;
    const int NSCAN = N_PROMPT_SEQ, NP = G - NSCAN - NINV_WG;
    if (wg < NSCAN) { if (!(pmode & 2)) scan_prompt_wg(A, wg, lds, ep); return; }
    if (wg < NSCAN + NINV_WG) {
        const int wv = (wg - NSCAN) * NWAVES + wave, NWV = NINV_WG * NWAVES;
#pragma unroll 1
        for (int m = wv; m < N_ITEMS; m += NWV) {
            const int item = order_item(m), p = m % NP, k = m / NP;
            const float gcl = wait_item(item_flag1(A, item), ep);
            __builtin_amdgcn_fence(__ATOMIC_ACQUIRE, "agent");
            const float* ats = (const float*)((const unsigned char*)A->out + DO_ATS + ((size_t)p * 8 + (k & 7)) * ATS_ITEM);
            if (pmode & 16) { if (lane == 0) __hip_atomic_store(item_granule(A, item), ((unsigned long long)ep << 32) | (unsigned long long)__float_as_uint(gcl), __ATOMIC_RELAXED, __HIP_MEMORY_SCOPE_AGENT); }
            else prep_stage2(A, item, gcl, ats, (LAS float*)(lds + wave * 16384), ep);
        }
        return;
    }
    const int p = wg - NSCAN - NINV_WG;
    if (pmode & 32) {
        for (int m = p * NTHREADS + tid; m < N_ITEMS; m += NP * NTHREADS) { gu64* f = item_flag1(A, order_item(m));
            const unsigned long long o = __hip_atomic_load(f, __ATOMIC_RELAXED, __HIP_MEMORY_SCOPE_AGENT);
            __hip_atomic_store(f, ((unsigned long long)ep << 32) | (o & 0xffffffffull), __ATOMIC_RELAXED, __HIP_MEMORY_SCOPE_AGENT); }
    } else {
        const int ntot = p < N_ITEMS ? (N_ITEMS - 1 - p) / NP + 1 : 0;
        S1Pre P;
        if (ntot > 0) stage1_issue(A, order_item(p), P);
        int prev = -1;
#pragma unroll 1
        for (int k = 0; k < ntot; ++k) {
            const int m = p + NP * k, item = order_item(m), nxt = k + 1 < ntot ? order_item(m + NP) : N_ITEMS;
            float* ats = (float*)((unsigned char*)A->out + DO_ATS + ((size_t)p * 8 + (k & 7)) * ATS_ITEM);
            prep_stage1(A, item, nxt, prev, k >= 8 ? order_item(m - 8 * NP) : -1, k & 1, ats, P, lds, ep, pmode);
            prev = item;
        }
        asm volatile("s_waitcnt vmcnt(0)" ::: "memory"); __syncthreads();
        if (prev >= 0 && tid == 0) __hip_atomic_store(item_flag1(A, prev), ((unsigned long long)ep << 32) | (unsigned long long)__float_as_uint(((const LAS float*)(lds + LDS_GCL))[(ntot - 1) & 1]), __ATOMIC_RELAXED, __HIP_MEMORY_SCOPE_AGENT);
    }
    if (pmode & 1) return;
    if (!(pmode & 128)) for (int u = p; u < NBATCH * NKV * 32; u += NP) attn_unit(A, u, lds);
    if (pmode & 64) return;
    const int worker = p * NWAVES + wave, NW = NP * NWAVES;
    LAS float* wl = (LAS float*)(lds + 98304 + wave * 4096);
    for (int it = worker; it < SBATCH * NHB * 4 + SBATCH * NHA; it += NW) {
        int ln = lane; asm volatile("" : "+v"(ln));
        if (it < SBATCH * NHB * 4) sample_delta(A, it >> 4, (it >> 2) & 3, it & 3, wl, ln);
        else { const int q = it - SBATCH * NHB * 4; sample_attn(A, q >> 3, q & 7, wl, ln); }
    }
}

DI void p3b_gated_norm(KA A) {
    const int tid = tid_opaque(), lane = tid & 63, wave = tid >> 6, gw = blockIdx.x * NWAVES + wave, NGW = gridDim.x * NWAVES;
    const int head = lane >> 4, dv0 = 8 * (lane & 15);
    const f32x4 w0 = *(const f32x4*)(A->gdn_norm + dv0), w1 = *(const f32x4*)(A->gdn_norm + dv0 + 4);
    bf16* OBg = (bf16*)((unsigned char*)A->out + DO_OB); const bf16* Zg = (const bf16*)(A->ws + WS_Z);
    for (int crow = gw; crow < MC; crow += NGW) {
        const u32x4 ow = *(const u32x4*)(OBg + (size_t)crow * OAB_PITCH + head * 128 + dv0);
        const f32x4 a = {bflo(ow.x), bfhi(ow.x), bflo(ow.y), bfhi(ow.y)}, c = {bflo(ow.z), bfhi(ow.z), bflo(ow.w), bfhi(ow.w)};
        float ss = (a[0] * a[0] + a[1] * a[1]) + (a[2] * a[2] + a[3] * a[3]) + (c[0] * c[0] + c[1] * c[1]) + (c[2] * c[2] + c[3] * c[3]);
        ss += __shfl_xor(ss, 1); ss += __shfl_xor(ss, 2); ss += __shfl_xor(ss, 4); ss += __shfl_xor(ss, 8);
        const float rstd = rsqrtf(ss * (1.0f / 128.0f) + EPS);
        const u32x4 zw = *(const u32x4*)(Zg + (size_t)pg8::crow_to_urow(crow) * 512 + head * 128 + dv0);
        f32x4 y0, y1;
        y0[0] = a[0] * rstd * w0[0] * siluf_(bflo(zw.x)); y0[1] = a[1] * rstd * w0[1] * siluf_(bfhi(zw.x)); y0[2] = a[2] * rstd * w0[2] * siluf_(bflo(zw.y)); y0[3] = a[3] * rstd * w0[3] * siluf_(bfhi(zw.y));
        y1[0] = c[0] * rstd * w1[0] * siluf_(bflo(zw.z)); y1[1] = c[1] * rstd * w1[1] * siluf_(bfhi(zw.z)); y1[2] = c[2] * rstd * w1[2] * siluf_(bflo(zw.w)); y1[3] = c[3] * rstd * w1[3] * siluf_(bfhi(zw.w));
        *(u32x4*)(OBg + (size_t)crow * OAB_PITCH + head * 128 + dv0) = pack8f(y0, y1);
    }
}
DI void p8_final_norm(KA A) {
    const int tid = tid_opaque(), lane = tid & 63, wave = tid >> 6, gw = blockIdx.x * NWAVES + wave, NGW = gridDim.x * NWAVES;
    f32x4 nf[4];
#pragma unroll
    for (int j = 0; j < 4; ++j) nf[j] = ((const f32x4*)A->norm_final)[lane + 64 * j];
    const bf16* H2 = (const bf16*)(A->ws + WS_MB);
    for (int crow = gw; crow < MC; crow += NGW) {
        const u32x2* hrow = (const u32x2*)(H2 + (size_t)crow * D);
        f32x4* row = (f32x4*)(A->out + (size_t)crow * D);
        f32x4 v[4]; float ss = 0.f;
#pragma unroll
        for (int j = 0; j < 4; ++j) { const u32x2 hw = hrow[lane + 64 * j]; v[j] = (f32x4){bflo(hw.x), bfhi(hw.x), bflo(hw.y), bfhi(hw.y)};
            ss += (v[j][0] * v[j][0] + v[j][1] * v[j][1]) + (v[j][2] * v[j][2] + v[j][3] * v[j][3]); }
        const float rstd = rsqrtf(wave_sum(ss) * (1.0f / D) + EPS);
#pragma unroll
        for (int j = 0; j < 4; ++j) row[lane + 64 * j] = v[j] * rstd * nf[j];
    }
}
__global__ void __launch_bounds__(NTHREADS, 2) hybrid_fwd(Args Aval) {
    extern __shared__ __attribute__((aligned(16))) unsigned char lds_raw[];
    LAS unsigned char* lds = (LAS unsigned char*)lds_raw;
    const int tid = threadIdx.x;
    int lo, hi; { KA A0 = kargs(); lo = A0->ph_lo; hi = A0->ph_hi; }
#if MK_N_LAUNCHES == 1
#if MK_BARRIER == 1
    volatile LAS unsigned* MISC = (volatile LAS unsigned*)(lds + LDS_MISC);
    if (tid < 64) MISC[tid] = 0u;
    __syncthreads();
    XcdBarrier bar; { KA A0 = kargs(); bar = xcd_barrier_post((unsigned*)(A0->ws + WS_CTL) + 4096, MISC + 8); }
#define GRID_BAR() xcd_barrier(bar)
#else
    cg::grid_group grid = cg::this_grid();
#define GRID_BAR() grid.sync()
#endif
#else
#define GRID_BAR() do {} while (0)
#endif
#ifndef PH_MASK
#define PH_MASK 0x1ff
#endif
#define IN(k) (((PH_MASK >> (k)) & 1) && lo <= (k) && (k) < hi)
#ifndef PROBE_REP
#define PROBE_REP -1
#endif
#define NREP(k) (PROBE_REP == (k) ? 2 : 1)
#define SEAM(k) do { if (IN(k) && IN((k) + 1)) GRID_BAR(); } while (0)
    const int G = gridDim.x, wgid = blockIdx.x;
#if PROBE_REP == 0
    if (IN(0)) { KA A = kargs(); p0_prologue(A, lds); __syncthreads(); }
#endif
    if (IN(0)) { KA A = kargs(); p0_prologue(A, lds); } SEAM(0);
    if (IN(1)) for (int rep = 0; rep < NREP(1); ++rep) { KA A = kargs(); unsigned char* ws = A->ws;
        pg8::Gemm g{(const bf16*)(ws + WS_XN), (const bf16*)(ws + WS_WIN), MUP, NIN, D}; pg8::StaticOrder S; S.init(MUP, NIN, G, wgid);
        pg8::EpiInProj E{(bf16*)(ws + WS_QA), (bf16*)(ws + WS_KV), (bf16*)(ws + WS_QKVB), (bf16*)(ws + WS_Z), (bf16*)(ws + WS_G),
                         (const float*)(ws + WS_ROPE), (const float*)(ws + WS_ROPE) + (TP + TS) * 32, A->out};
        pg8::gemm_phase<pg8::EpiInProj, pg8::StaticOrder, true, true>(lds, g, S, E);
    } SEAM(1);
#ifndef PROBE_MODE
#define PROBE_MODE 0
#endif
#if PROBE_REP == 2
    if (IN(2)) { KA A = kargs(); p23_mixers(A, lds, bar, 1u); GRID_BAR(); }
    if (IN(2)) { KA A = kargs(); p23_mixers(A, lds, bar, 2u, PROBE_MODE); } SEAM(2);
#else
    if (IN(2)) { KA A = kargs(); p23_mixers(A, lds, bar, 1u); } SEAM(2);
#endif
    if (IN(3)) for (int rep = 0; rep < NREP(3); ++rep) { KA A = kargs(); p3b_gated_norm(A); } SEAM(3);
    if (IN(4)) for (int rep = 0; rep < NREP(4); ++rep) { KA A = kargs(); unsigned char* ws = A->ws;
        const bf16* OABp = (const bf16*)((unsigned char*)A->out + DO_OA); const bf16* Wm = (const bf16*)(ws + WS_WOA);
        { pg8::Gemm g{OABp, Wm, MC, D, 512, 1024}; pg8::StaticOrder S; S.init(MC, D, G, wgid); S.lim = (S.nwg / G) * G;
          pg8::EpiMerge<false> E{(bf16*)(ws + WS_MB), (const bf16*)(ws + WS_G), 0};
          pg8::gemm_phase<pg8::EpiMerge<false>, pg8::StaticOrder, true, true>(lds, g, S, E); }
        asm volatile("s_waitcnt vmcnt(0)" ::: "memory"); __syncthreads();
        { pg8::Gemm g{OABp + 512, Wm + 512, MC, D, 512, 1024}; pg8::StaticOrder S; S.init(MC, D, G, wgid); S.lim = (S.nwg / G) * G;
          pg8::EpiMerge<true> E{(bf16*)(ws + WS_MB), (const bf16*)(ws + WS_G), 1024};
          pg8::gemm_phase<pg8::EpiMerge<true>, pg8::StaticOrder, true, true>(lds, g, S, E); }
        { const int nstr = (MC / 256) * 4 - ((MC / 256) * 4 / G) * G;
          if (wgid < nstr * 4) { const int t = wgid >> 2, sl = wgid & 3, koff = sl * 256;
            pg8::Gemm g{OABp + koff, Wm + koff, MC, D, 256, 1024};
            pg8::SliceOrder S; S.init_slice(MC, D, G, ((MC / 256) * 4 / G) * G, t);
            pg8::EpiSplit<pg8::EpiStoreMB, true> E{pg8::EpiStoreMB{(bf16*)(ws + WS_MB)}, (float*)(ws + WS_SCR) + (size_t)t * 65536, (unsigned*)(ws + WS_CTL + CTL_SPL) + t * 8, 4u, (const bf16*)(ws + WS_G), (sl >> 1) ? 1024 : 0};
            pg8::gemm_phase<pg8::EpiSplit<pg8::EpiStoreMB, true>, pg8::SliceOrder, true, true>(lds, g, S, E); } }
    } SEAM(4);
    if (IN(5)) { KA A = kargs(); unsigned char* ws = A->ws;
        { pg8::Gemm g{(const bf16*)(ws + WS_MB), (const bf16*)(ws + WS_WOUT), MC, D, D}; pg8::StaticOrder S; S.init(MC, D, G, wgid); S.lim = (S.nwg / G) * G;
          pg8::EpiWout<true> E{A->x_prompt, A->x_sample, (bf16*)(ws + WS_HB1), (float*)(ws + WS_CTL + CTL_SS1)};
          pg8::gemm_phase<pg8::EpiWout<true>, pg8::StaticOrder, true, true>(lds, g, S, E); }
        { const int nstr = (MC / 256) * 4 - ((MC / 256) * 4 / G) * G;
          if (wgid < nstr * 4) { const int t = wgid >> 2, koff = (wgid & 3) * 256;
            pg8::Gemm g{(const bf16*)(ws + WS_MB) + koff, (const bf16*)(ws + WS_WOUT) + koff, MC, D, 256, D};
            pg8::SliceOrder S; S.init_slice(MC, D, G, ((MC / 256) * 4 / G) * G, t);
            pg8::EpiSplit<pg8::EpiWout<true>, false> E{pg8::EpiWout<true>{A->x_prompt, A->x_sample, (bf16*)(ws + WS_HB1), (float*)(ws + WS_CTL + CTL_SS1)}, (float*)(ws + WS_SCR) + (size_t)t * 65536, (unsigned*)(ws + WS_CTL + CTL_SPL) + t * 8, 4u, nullptr, 0};
            pg8::gemm_phase<pg8::EpiSplit<pg8::EpiWout<true>, false>, pg8::SliceOrder, true, true>(lds, g, S, E); } }
    } SEAM(5);
    if (IN(6)) for (int rep = 0; rep < NREP(6); ++rep) { KA A = kargs(); unsigned char* ws = A->ws;
        pg8::Gemm g{(const bf16*)(ws + WS_HB1), (const bf16*)(ws + WS_WGU), MC, 2 * DFF, D}; pg8::StaticOrder S; S.init(MC, 2 * DFF, G, wgid);
        pg8::EpiGateUp E{(bf16*)(ws + WS_ACT), (const float*)(ws + WS_CTL + CTL_SS1)};
        pg8::gemm_phase<pg8::EpiGateUp, pg8::StaticOrder, true, true>(lds, g, S, E);
    } SEAM(6);
    if (IN(7)) for (int rep = 0; rep < NREP(7); ++rep) { KA A = kargs(); unsigned char* ws = A->ws;
        { pg8::Gemm g{(const bf16*)(ws + WS_ACT), (const bf16*)(ws + WS_WD), MC, D, DFF}; pg8::StaticOrder S; S.init(MC, D, G, wgid); S.lim = (S.nwg / G) * G;
          pg8::EpiDown<false> E{(const bf16*)(ws + WS_HB1), (bf16*)(ws + WS_MB)};
          pg8::gemm_phase<pg8::EpiDown<false>, pg8::StaticOrder, true, true>(lds, g, S, E); }
        { const int nstr = (MC / 256) * 4 - ((MC / 256) * 4 / G) * G;
          if (wgid < nstr * 11) { const int t = wgid / 11, koff = (wgid % 11) * 256;
            pg8::Gemm g{(const bf16*)(ws + WS_ACT) + koff, (const bf16*)(ws + WS_WD) + koff, MC, D, 256, DFF};
            pg8::SliceOrder S; S.init_slice(MC, D, G, ((MC / 256) * 4 / G) * G, t);
            pg8::EpiSplit<pg8::EpiDown<false>, false> E{pg8::EpiDown<false>{(const bf16*)(ws + WS_HB1), (bf16*)(ws + WS_MB)}, (float*)(ws + WS_SCR) + (size_t)t * 65536, (unsigned*)(ws + WS_CTL + CTL_SPL) + t * 8, 11u, nullptr, 0};
            pg8::gemm_phase<pg8::EpiSplit<pg8::EpiDown<false>, false>, pg8::SliceOrder, true, true>(lds, g, S, E); } }
    } SEAM(7);
    if (IN(8)) { KA A = kargs(); p8_final_norm(A); }
#undef IN
#undef SEAM
}

extern "C" void kernel_launch(void* const* d_in, const int* in_sizes, int n_in, void* d_out, int out_size, void* d_ws, size_t ws_size, hipStream_t stream) {
    static int grid = 0;
    if (grid == 0) {
        if (n_in != 22 || out_size != (int)O_END || ws_size < WS_END) { fprintf(stderr, "kernel_launch: unexpected problem (n_in %d, out %d, ws %zu)\n", n_in, out_size, ws_size); grid = -1; return; }
        int dev = 0, cus = 0, per_cu = 0;
        if (hipGetDevice(&dev) != hipSuccess || hipDeviceGetAttribute(&cus, hipDeviceAttributeMultiprocessorCount, dev) != hipSuccess) { grid = -1; return; }
        if (hipFuncSetAttribute((const void*)hybrid_fwd, hipFuncAttributeMaxDynamicSharedMemorySize, LDS_BYTES) != hipSuccess) { fprintf(stderr, "kernel_launch: hipFuncSetAttribute failed\n"); grid = -1; return; }
        if (hipOccupancyMaxActiveBlocksPerMultiprocessor(&per_cu, (const void*)hybrid_fwd, NTHREADS, LDS_BYTES) != hipSuccess || per_cu < 1) { fprintf(stderr, "kernel_launch: occupancy query says %d\n", per_cu); per_cu = 1; }
        (void)hipGetLastError();
        grid = cus;
        if (grid > 256) grid = 256;
    }
    if (grid < 0) return;
    (void)hipMemsetAsync((char*)d_ws + WS_CTL, 0, CTL_BYTES, stream);
    (void)hipMemsetAsync((char*)d_ws + WS_SCR, 0, SCR_BYTES, stream);
    Args a{};
    const float** ap = (const float**)&a;
    for (int i = 0; i < 22; ++i) ap[i] = (const float*)d_in[i];
    a.out = (float*)d_out; a.ws = (unsigned char*)d_ws;
#if MK_N_LAUNCHES == 1
    a.ph_lo = 0; a.ph_hi = N_PHASES;
#if MK_BARRIER == 1
    hipLaunchKernelGGL(hybrid_fwd, dim3(grid), dim3(NTHREADS), LDS_BYTES, stream, a);
#else
    void* args[] = {&a};
    hipError_t e = hipLaunchCooperativeKernel((const void*)hybrid_fwd, dim3(grid), dim3(NTHREADS), args, LDS_BYTES, stream);
    if (e != hipSuccess) fprintf(stderr, "cooperative launch failed: %s (grid %d)\n", hipGetErrorString(e), grid);
#endif
#else
    for (int p = 0; p < N_PHASES; ++p) { a.ph_lo = p; a.ph_hi = p + 1; hipLaunchKernelGGL(hybrid_fwd, dim3(grid), dim3(NTHREADS), LDS_BYTES, stream, a); }
#endif
}
```

```cpp
#include <hip/hip_runtime.h>
#include <hip/hip_cooperative_groups.h>
#include <cstdio>
#include <cstdint>
namespace cg = cooperative_groups;

#ifndef MK_N_LAUNCHES
#define MK_N_LAUNCHES 1
#endif
#ifndef MK_BARRIER
#define MK_BARRIER 1
#endif

constexpr int D = 1024, NBATCH = 8, SEQ = 4096, NMETA = 16, TP = SEQ + NMETA, MP = NBATCH * TP;
constexpr int SBATCH = 128, TS = 4, MS = SBATCH * TS, MU = MP + MS, MUP = 33536, MC = NBATCH * SEQ + MS;
constexpr int PAST = 16384;
constexpr int HD = 64, NHA = 8, NKV = 2;
constexpr int NHB = 4, CONVD = 1536;
constexpr int DFF = 2816, NIN_SRC = 4872, NIN = 4864;
constexpr float EPS = 1e-6f;
constexpr float QSCALE = 0.125f * 1.4426950408889634f;

constexpr size_t MiB = 1u << 20, KiB = 1024;
constexpr size_t WS_CTL = 0, CTL_BYTES = 1 * MiB;
constexpr size_t WS_WIN = 1 * MiB;
constexpr size_t WS_WOA = 11 * MiB, WS_WOB = 12 * MiB;
constexpr size_t WS_WOUT = 13 * MiB;
constexpr size_t WS_WGU = 15 * MiB;
constexpr size_t WS_WD = 26 * MiB;
constexpr size_t WS_ROPE = 32 * MiB;
constexpr size_t WS_GB = 34 * MiB;
constexpr size_t WS_SC = 36 * MiB;
constexpr size_t WS_SS1 = 37 * MiB, WS_SS2 = 37 * MiB + 512 * KiB;
constexpr size_t WS_SCR = 38 * MiB, SCR_BYTES = 2 * MiB;
constexpr size_t CTL_SPL6 = 53248;
constexpr size_t CTL_SPL = 49152;
constexpr size_t WS_QA = 41 * MiB;
constexpr size_t WS_KV = WS_QA + (size_t)MUP * 512 * 2;
constexpr size_t WS_QKVB = WS_KV + (size_t)MUP * 256 * 2;
constexpr size_t WS_Z = WS_QKVB + (size_t)MUP * 1536 * 2;
constexpr size_t WS_G = WS_Z + (size_t)MUP * 512 * 2;
constexpr size_t WS_GEND = WS_G + (size_t)MUP * 2048 * 2;
constexpr size_t WS_B = 353 * MiB, WS_END = 512 * MiB;
static_assert(WS_GEND <= WS_B, "ws map");
constexpr size_t WS_XN = WS_B;
constexpr size_t PREP_SLOT = 80 * KiB;
constexpr int PREP_N1 = (int)((WS_END - WS_B) / PREP_SLOT);
constexpr size_t DO_OA = 44 * MiB;
constexpr int OAB_PITCH = 1024;
constexpr size_t DO_OB = DO_OA + 512 * 2;
constexpr size_t DO_ATS = DO_OA + (size_t)MC * OAB_PITCH * 2;
constexpr size_t ATS_ITEM = 3 * 32 * 32 * 4;
static_assert(DO_ATS + 212 * 8 * ATS_ITEM <= (size_t)MC * 1024 * 4, "d_out scratch map");
constexpr size_t WS_MB = WS_B;
constexpr size_t WS_HB1 = WS_B + 66 * MiB;
static_assert(WS_HB1 + (size_t)MC * 1024 * 2 <= WS_END, "ws map");
constexpr size_t WS_ACT = WS_QA;
static_assert(WS_ACT + (size_t)MC * DFF * 2 <= WS_G, "ws map");
constexpr int SL_BEK = 0, SL_BV = 16 * 1024, SL_T = 32 * 1024, SL_QKD = 40 * 1024, SL_QE = 48 * 1024, SL_KWT = 64 * 1024;
constexpr int N_PROMPT_SEQ = NBATCH * NHB, CHUNKS_P = 65, N_ITEMS_P = N_PROMPT_SEQ * CHUNKS_P, N_ITEMS = N_ITEMS_P;
static_assert((size_t)(N_ITEMS - PREP_N1) * PREP_SLOT <= DO_OA, "prep slots");

constexpr size_t O_YP = 0, O_YS = (size_t)NBATCH * SEQ * D, O_KP = O_YS + (size_t)MS * D, O_VP = O_KP + 8 * 128 * 2 * 64, O_DP = O_VP + 8 * 128 * 2 * 64,
                 O_CP = O_DP + 8 * 4 * 128 * 128, O_KS = O_CP + 8 * 3 * 1536, O_VS = O_KS + (size_t)128 * 128 * 2 * 64, O_DS = O_VS + (size_t)128 * 128 * 2 * 64,
                 O_CS = O_DS + (size_t)128 * 4 * 128 * 128, O_END = O_CS + (size_t)128 * 3 * 1536;
static_assert(O_END == 48074752, "d_out size");

#define DI __device__ __forceinline__
#define GAS __attribute__((address_space(1)))
#define LAS __attribute__((address_space(3)))
typedef unsigned short bf16;
typedef short bf16x8 __attribute__((ext_vector_type(8)));
typedef float f32x4 __attribute__((ext_vector_type(4)));
typedef float f32x2 __attribute__((ext_vector_type(2)));
typedef float f32x16 __attribute__((ext_vector_type(16)));
typedef unsigned u32x4 __attribute__((ext_vector_type(4)));
typedef unsigned u32x2 __attribute__((ext_vector_type(2)));
typedef __bf16 bf16x2_t __attribute__((ext_vector_type(2)));

DI int tid_opaque() { int t = threadIdx.x; asm volatile("" : "+v"(t)); return t; }
DI unsigned cvtpk(float lo, float hi) { f32x2 v = {lo, hi}; bf16x2_t b = __builtin_convertvector(v, bf16x2_t); return __builtin_bit_cast(unsigned, b); }
DI bf16 f2bf(float f) { return (bf16)(cvtpk(f, 0.f) & 0xffffu); }
DI float bf2f(unsigned short h) { return __uint_as_float((unsigned)h << 16); }
DI float bflo(unsigned w) { return __uint_as_float(w << 16); }
DI float bfhi(unsigned w) { return __uint_as_float(w & 0xffff0000u); }
DI u32x4 pack8f(f32x4 a, f32x4 b) { u32x4 w; w.x = cvtpk(a[0], a[1]); w.y = cvtpk(a[2], a[3]); w.z = cvtpk(b[0], b[1]); w.w = cvtpk(b[2], b[3]); return w; }
DI float frcp_(float x) { return __builtin_amdgcn_rcpf(x); }
DI float sigmoidf_(float x) { return frcp_(1.0f + __builtin_amdgcn_exp2f(x * -1.4426950408889634f)); }
DI float siluf_(float x) { return x * sigmoidf_(x); }
DI void st16_sc1(void* p, u32x4 v) { asm volatile("global_store_dwordx4 %0, %1, off sc1\n\ts_nop 1" :: "v"(p), "v"(v) : "memory"); }
DI void st16_sc1f(void* p, f32x4 v) { asm volatile("global_store_dwordx4 %0, %1, off sc1\n\ts_nop 1" :: "v"(p), "v"(v) : "memory"); }
DI void st2_sc1(void* p, unsigned v) { asm volatile("global_store_short %0, %1, off sc1\n\ts_nop 1" :: "v"(p), "v"(v) : "memory"); }
constexpr size_t CTL_GRAN = 65536, CTL_CNT = 245760, CTL_SS1 = 458752;
static_assert(CTL_CNT + 5 * 130 * 256 <= CTL_SS1 && CTL_SS1 + 33280 * 4 <= 1048576 && CTL_GRAN + 2592 * 64 <= CTL_CNT, "control region map");
constexpr int CNT_STRIDE = 130 * 64;
DI int pos_of_d(int d) { const int dd = d & 31; return 8 * (dd >> 2) + (dd & 3) + ((d >> 5) << 2); }
DI int d_of_pos(int p) { const int j = p & 7; return 4 * (p >> 3) + (j & 3) + ((j >> 2) << 5); }
namespace pg8 {
#define PG8_LAS __attribute__((address_space(3)))
typedef unsigned short bf16_t;
typedef short bf16x8 __attribute__((ext_vector_type(8)));
typedef float f32x4 __attribute__((ext_vector_type(4)));
typedef unsigned u32x4 __attribute__((ext_vector_type(4)));
constexpr int BM = 256, BK = 64, HALF = 128, HTB = HALF * BK * 2  , STAGE_BYTES = 8 * HTB, NXCD = 8, WGM = 8;

__host__ __device__ __forceinline__ int lds_byte(int r, int c) { const int st = (r >> 4) * 2 + (c >> 5), rr = r & 15, cc = c & 31, ob = rr * 64 + cc * 2; return st * 1024 + (ob ^ (((ob >> 9) & 1) << 5)); }
__host__ __device__ __forceinline__ void stage_rc(int b, int& R, int& C) { const int st = b / 1024, sb = b % 1024, swz = sb ^ (((sb >> 9) & 1) << 5); R = (st >> 1) * 16 + swz / 64; C = (st & 1) * 32 + (swz % 64) / 2; }
__host__ __device__ __forceinline__ int perm32(int rho) { const int n = rho >> 4, i = rho & 15; return 8 * (i >> 2) + 4 * n + (i & 3); }

struct Unit { int pm, pn; };
struct Gemm { const bf16_t* A; const bf16_t* Bt; int M, N, K; int ldk; };

struct StaticOrder {
    static constexpr bool A_SC1 = false;
    int nM, nN, nwg, G, c, lim;
    __host__ __device__ void init(int M, int N, int G_, int c_) { nM = M / BM; nN = N / BM; nwg = nM * nN; G = G_; c = c_; lim = nwg; }
    __host__ __device__ bool next(int i, Unit& u) const {
        const long L = (long)i * G + c; if (L >= lim) return false;
        int wgid = (int)L; { const int q = nwg / NXCD, r = nwg % NXCD, xcd = wgid % NXCD, off = wgid / NXCD; wgid = (xcd < r ? xcd * (q + 1) : r * (q + 1) + (xcd - r) * q) + off; }
        const int nig = WGM * nN, gid = wgid / nig, fm = gid * WGM, gsz = (nM - fm) < WGM ? (nM - fm) : WGM;
        u.pm = fm + ((wgid % nig) % gsz); u.pn = (wgid % nig) / gsz; return true;
    }
    __device__ __forceinline__ void a_ready(const Unit&) const {}
    __device__ __forceinline__ void done(const Unit&) const {}
};
struct FlagOrder : StaticOrder {
    static constexpr bool A_SC1 = true;
    const unsigned* ready; unsigned need; unsigned* pub; unsigned* gpub;
    __device__ __forceinline__ void a_ready(const Unit& u) const {
        if (ready) {
            if (threadIdx.x < 64) { unsigned spins = 0;
                while ((unsigned)__builtin_amdgcn_readfirstlane(__hip_atomic_load(ready + 64 * u.pm, __ATOMIC_RELAXED, __HIP_MEMORY_SCOPE_AGENT)) < need) { __builtin_amdgcn_s_sleep(2); if (++spins > (1u << 22)) break; } }
            asm volatile("" ::: "memory"); __builtin_amdgcn_s_barrier(); asm volatile("" ::: "memory");
        }
    }
    __device__ __forceinline__ void done(const Unit& u) const {
        if (pub) { asm volatile("s_waitcnt vmcnt(0)" ::: "memory");
            if ((threadIdx.x & 63) == 0) { __hip_atomic_fetch_add(pub + 64 * u.pm, 1u, __ATOMIC_RELAXED, __HIP_MEMORY_SCOPE_AGENT); if (gpub) __hip_atomic_fetch_add(gpub, 1u, __ATOMIC_RELAXED, __HIP_MEMORY_SCOPE_AGENT); } }
    }
};
struct SliceOrder : StaticOrder {
    int t;
    __host__ __device__ void init_slice(int M, int N, int G_, int first, int t_) { init(M, N, G_, 0); t = t_; c = first + t_; G = 0; }
    __host__ __device__ bool next(int i, Unit& u) const { return i == 0 ? StaticOrder::next(0, u) : false; }
};

__device__ __forceinline__ void urow_info(int urow, int& kind, int& b, int& t, int& ridx) {
    if (urow < MP) { b = urow / TP; t = urow - b * TP; kind = 0; ridx = t; }
    else if (urow < MU) { const int s = urow - MP; b = s >> 2; t = s & 3; kind = 1; ridx = TP + t; }
    else { kind = 2; b = 0; t = 0; ridx = 0; }
}
__device__ __forceinline__ int crow_to_urow(int crow) { return crow < NBATCH * SEQ ? crow + NMETA * ((crow >> 12) + 1) : MP + (crow - NBATCH * SEQ); }

struct EpiInProj {
    static constexpr bool PERM = true, AFTER_DRAIN = false;
    bf16_t *QA, *KV, *QKVB, *Z, *G; const float *COS, *SIN; float* out;
    __device__ __forceinline__ void operator()(const f32x4 (&acc)[2][2][4][2], const Unit& u, int wr, int wc, int fr, int fq) const {
        const int pn = u.pn;
#pragma unroll
        for (int ai = 0; ai < 2; ++ai)
#pragma unroll
            for (int m = 0; m < 4; ++m) {
                const int row = u.pm * BM + ai * HALF + wr * 64 + m * 16 + fr;
                int kind, b, t, ridx; urow_info(row, kind, b, t, ridx);
#pragma unroll
                for (int bj = 0; bj < 2; ++bj) {
                    const int cl = bj * HALF + wc * 32 + 8 * fq;
                    const f32x4 v0 = acc[ai][bj][m][0], v1 = acc[ai][bj][m][1];
                    if (pn < 2) {
                        const int c = pn * 256 + cl, d0 = ((c & 63) >> 3) * 4;
                        const f32x4 cs = *(const f32x4*)(COS + ridx * 32 + d0), sn = *(const f32x4*)(SIN + ridx * 32 + d0);
                        const f32x4 o1 = (v0 * cs - v1 * sn) * QSCALE, o2 = (v1 * cs + v0 * sn) * QSCALE;
                        *(u32x4*)(QA + (size_t)row * 512 + c) = pack8f(o1, o2);
                    } else if (pn == 2) {
                        if (bj == 0) {
                            const int kh = cl >> 6, d0 = ((cl & 63) >> 3) * 4;
                            const f32x4 cs = *(const f32x4*)(COS + ridx * 32 + d0), sn = *(const f32x4*)(SIN + ridx * 32 + d0);
                            const f32x4 o1 = v0 * cs - v1 * sn, o2 = v1 * cs + v0 * sn;
                            *(u32x4*)(KV + (size_t)row * 256 + cl) = pack8f(o1, o2);
                            float* dst = nullptr;
                            if (kind == 0 && t >= TP - 128) dst = out + O_KP + ((size_t)(b * 128 + (t - (TP - 128))) * 2 + kh) * 64;
                            else if (kind == 1) dst = out + O_KS + ((size_t)(b * 128 + 124 + t) * 2 + kh) * 64;
                            if (dst) { *(f32x4*)(dst + d0) = o1; *(f32x4*)(dst + 32 + d0) = o2; }
                        } else {
                            const int cv = cl - 128, kh = cv >> 6, dd = cv & 63;
                            *(u32x4*)(KV + (size_t)row * 256 + cl) = pack8f(v0, v1);
                            float* dst = nullptr;
                            if (kind == 0 && t >= TP - 128) dst = out + O_VP + ((size_t)(b * 128 + (t - (TP - 128))) * 2 + kh) * 64;
                            else if (kind == 1) dst = out + O_VS + ((size_t)(b * 128 + 124 + t) * 2 + kh) * 64;
                            if (dst) { *(f32x4*)(dst + dd) = v0; *(f32x4*)(dst + dd + 4) = v1; }
                        }
                    } else if (pn < 9) {
                        const int c = (pn - 3) * 256 + cl;
                        *(u32x4*)(QKVB + (size_t)row * 1536 + c) = pack8f(v0, v1);
                        float* dst = nullptr;
                        if (kind == 0 && t >= TP - 3) dst = out + O_CP + ((size_t)b * 3 + (t - (TP - 3))) * 1536;
                        else if (kind == 1 && t >= 1) dst = out + O_CS + ((size_t)b * 3 + (t - 1)) * 1536;
                        if (dst) { *(f32x4*)(dst + c) = v0; *(f32x4*)(dst + c + 4) = v1; }
                    } else if (pn < 11) {
                        const int c = (pn - 9) * 256 + cl;
                        *(u32x4*)(Z + (size_t)row * 512 + c) = pack8f(v0, v1);
                    } else {
                        const int c = (pn - 11) * 256 + cl;
                        f32x4 g0, g1;
#pragma unroll
                        for (int e = 0; e < 4; ++e) { g0[e] = sigmoidf_(v0[e]); g1[e] = sigmoidf_(v1[e]); }
                        *(u32x4*)(G + (size_t)row * 2048 + c) = pack8f(g0, g1);
                    }
                }
            }
    }
};

template <bool ACCUM> struct EpiMerge {
    static constexpr bool PERM = true, AFTER_DRAIN = false;
    bf16_t* MBp; const bf16_t* G; int gate_off;
    __device__ __forceinline__ void operator()(const f32x4 (&acc)[2][2][4][2], const Unit& u, int wr, int wc, int fr, int fq) const {
#pragma unroll
        for (int ai = 0; ai < 2; ++ai)
#pragma unroll
            for (int m = 0; m < 4; ++m) {
                const int crow = u.pm * BM + ai * HALF + wr * 64 + m * 16 + fr, urow = crow_to_urow(crow);
#pragma unroll
                for (int bj = 0; bj < 2; ++bj) {
                    const int c = u.pn * BM + bj * HALF + wc * 32 + 8 * fq;
                    const u32x4 gw = *(const u32x4*)(G + (size_t)urow * 2048 + gate_off + c);
                    f32x4 v0 = acc[ai][bj][m][0], v1 = acc[ai][bj][m][1];
                    v0[0] *= bflo(gw.x); v0[1] *= bfhi(gw.x); v0[2] *= bflo(gw.y); v0[3] *= bfhi(gw.y);
                    v1[0] *= bflo(gw.z); v1[1] *= bfhi(gw.z); v1[2] *= bflo(gw.w); v1[3] *= bfhi(gw.w);
                    bf16_t* p = MBp + (size_t)crow * 1024 + c;
                    if (ACCUM) { const u32x4 pw = *(const u32x4*)p;
                        v0[0] += bflo(pw.x); v0[1] += bfhi(pw.x); v0[2] += bflo(pw.y); v0[3] += bfhi(pw.y);
                        v1[0] += bflo(pw.z); v1[1] += bfhi(pw.z); v1[2] += bflo(pw.w); v1[3] += bfhi(pw.w); }
                    *(u32x4*)p = pack8f(v0, v1);
                }
            }
    }
};

template <bool ATOM = true> struct EpiWout {
    static constexpr bool PERM = true, AFTER_DRAIN = false;
    const float* xp; const float* xs; bf16_t* HB; float* SS;
    __device__ __forceinline__ void operator()(const f32x4 (&acc)[2][2][4][2], const Unit& u, int wr, int wc, int fr, int fq) const {
#pragma unroll
        for (int ai = 0; ai < 2; ++ai)
#pragma unroll
            for (int m = 0; m < 4; ++m) {
                const int crow = u.pm * BM + ai * HALF + wr * 64 + m * 16 + fr;
                const float* hs = crow < NBATCH * SEQ ? xp + (size_t)crow * D : xs + (size_t)(crow - NBATCH * SEQ) * D;
                float ss = 0.f;
#pragma unroll
                for (int bj = 0; bj < 2; ++bj) {
                    const int c = u.pn * BM + bj * HALF + wc * 32 + 8 * fq;
                    const f32x4 r0 = *(const f32x4*)(hs + c) + acc[ai][bj][m][0], r1 = *(const f32x4*)(hs + c + 4) + acc[ai][bj][m][1];
                    *(u32x4*)(HB + (size_t)crow * D + c) = pack8f(r0, r1);
                    ss += (r0[0] * r0[0] + r0[1] * r0[1]) + (r0[2] * r0[2] + r0[3] * r0[3]) + (r1[0] * r1[0] + r1[1] * r1[1]) + (r1[2] * r1[2] + r1[3] * r1[3]);
                }
                ss += __shfl_xor(ss, 16); ss += __shfl_xor(ss, 32);
                if (ATOM && fq == 0) atomicAdd(SS + crow, ss);
            }
    }
};

struct EpiGateUp {
    static constexpr bool PERM = true, AFTER_DRAIN = false;
    bf16_t* ACT; const float* SS;
    __device__ __forceinline__ void operator()(const f32x4 (&acc)[2][2][4][2], const Unit& u, int wr, int wc, int fr, int fq) const {
#pragma unroll
        for (int ai = 0; ai < 2; ++ai)
#pragma unroll
            for (int m = 0; m < 4; ++m) {
                const int crow = u.pm * BM + ai * HALF + wr * 64 + m * 16 + fr;
                const float rstd = rsqrtf(SS[crow] * (1.0f / D) + EPS);
                f32x4 a[2];
#pragma unroll
                for (int n = 0; n < 2; ++n)
#pragma unroll
                    for (int e = 0; e < 4; ++e) { const float g = acc[ai][0][m][n][e] * rstd, up = acc[ai][1][m][n][e] * rstd; a[n][e] = siluf_(g) * up; }
                *(u32x4*)(ACT + (size_t)crow * DFF + u.pn * HALF + wc * 32 + 8 * fq) = pack8f(a[0], a[1]);
            }
    }
};

template <bool DRY = false> struct EpiDown {
    static constexpr bool PERM = true, AFTER_DRAIN = false;
    const bf16_t* HB; bf16_t* H2;
    __device__ __forceinline__ void operator()(const f32x4 (&acc)[2][2][4][2], const Unit& u, int wr, int wc, int fr, int fq) const {
#pragma unroll
        for (int ai = 0; ai < 2; ++ai)
#pragma unroll
            for (int m = 0; m < 4; ++m) {
                const int crow = u.pm * BM + ai * HALF + wr * 64 + m * 16 + fr;
#pragma unroll
                for (int bj = 0; bj < 2; ++bj) {
                    const size_t off = (size_t)crow * D + u.pn * BM + bj * HALF + wc * 32 + 8 * fq;
                    const u32x4 hw = *(const u32x4*)(HB + off);
                    f32x4 r0 = acc[ai][bj][m][0], r1 = acc[ai][bj][m][1];
                    r0[0] += bflo(hw.x); r0[1] += bfhi(hw.x); r0[2] += bflo(hw.y); r0[3] += bfhi(hw.y);
                    r1[0] += bflo(hw.z); r1[1] += bfhi(hw.z); r1[2] += bflo(hw.w); r1[3] += bfhi(hw.w);
                    *(u32x4*)(H2 + off) = pack8f(r0, r1);
                }
            }
    }
};

template <class Inner, bool GATED = false> struct EpiSplit {
    static constexpr bool PERM = Inner::PERM, AFTER_DRAIN = false;
    Inner inner; float* scr; unsigned* cnt; unsigned S; const bf16_t* G; int gate_off;
    __device__ __forceinline__ void operator()(const f32x4 (&acc_)[2][2][4][2], const Unit& u, int wr, int wc, int fr, int fq) const {
        f32x4 (&acc)[2][2][4][2] = const_cast<f32x4 (&)[2][2][4][2]>(acc_);
        const int lane = fr + 16 * fq, wave = wr * 4 + wc;
        float* p = scr + (size_t)wave * 8192 + lane;
#pragma unroll
        for (int ai = 0; ai < 2; ++ai)
#pragma unroll
            for (int m = 0; m < 4; ++m) {
                int urow = 0;
                if (GATED) urow = crow_to_urow(u.pm * BM + ai * HALF + wr * 64 + m * 16 + fr);
#pragma unroll
                for (int bj = 0; bj < 2; ++bj) {
                    f32x4 v0 = acc[ai][bj][m][0], v1 = acc[ai][bj][m][1];
                    if (GATED) { const u32x4 gw = *(const u32x4*)(G + (size_t)urow * 2048 + gate_off + u.pn * BM + bj * HALF + wc * 32 + 8 * fq);
                        v0[0] *= bflo(gw.x); v0[1] *= bfhi(gw.x); v0[2] *= bflo(gw.y); v0[3] *= bfhi(gw.y); v1[0] *= bflo(gw.z); v1[1] *= bfhi(gw.z); v1[2] *= bflo(gw.w); v1[3] *= bfhi(gw.w); }
                    float* q = p + (((ai * 2 + bj) * 4 + m) * 8) * 64;
                    asm volatile("" : "+v"(q));
#pragma unroll
                    for (int x = 0; x < 4; ++x) { unsafeAtomicAdd(q + x * 64, v0[x]); unsafeAtomicAdd(q + (4 + x) * 64, v1[x]); }
                }
            }
        asm volatile("s_waitcnt vmcnt(0)" ::: "memory");
        unsigned old = 0u;
        if (lane == 0) old = __hip_atomic_fetch_add(cnt + wave, 1u, __ATOMIC_RELAXED, __HIP_MEMORY_SCOPE_AGENT);
        old = (unsigned)__builtin_amdgcn_readfirstlane((int)old);
        if (old == S - 1u) {
#pragma unroll
            for (int ai = 0; ai < 2; ++ai)
#pragma unroll
                for (int bj = 0; bj < 2; ++bj)
#pragma unroll
                    for (int m = 0; m < 4; ++m) {
                        float* q = p + (((ai * 2 + bj) * 4 + m) * 8) * 64;
                        asm volatile("" : "+v"(q));
#pragma unroll
                        for (int n = 0; n < 2; ++n)
#pragma unroll
                            for (int x = 0; x < 4; ++x) acc[ai][bj][m][n][x] = __hip_atomic_exchange(q + (n * 4 + x) * 64, 0.0f, __ATOMIC_RELAXED, __HIP_MEMORY_SCOPE_AGENT);
                    }
            if (lane == 0) __hip_atomic_store(cnt + wave, 0u, __ATOMIC_RELAXED, __HIP_MEMORY_SCOPE_AGENT);
            inner(acc, u, wr, wc, fr, fq);
        }
    }
};
struct EpiStoreMB {
    static constexpr bool PERM = true, AFTER_DRAIN = false;
    bf16_t* MBp;
    __device__ __forceinline__ void operator()(const f32x4 (&acc)[2][2][4][2], const Unit& u, int wr, int wc, int fr, int fq) const {
#pragma unroll
        for (int ai = 0; ai < 2; ++ai)
#pragma unroll
            for (int m = 0; m < 4; ++m) {
                const int crow = u.pm * BM + ai * HALF + wr * 64 + m * 16 + fr;
#pragma unroll
                for (int bj = 0; bj < 2; ++bj) *(u32x4*)(MBp + (size_t)crow * 1024 + u.pn * BM + bj * HALF + wc * 32 + 8 * fq) = pack8f(acc[ai][bj][m][0], acc[ai][bj][m][1]);
            }
    }
};

template <class Epi, class Sched, bool ALIGN_EPI = false, bool SP2 = false>
__device__ __forceinline__ void gemm_phase(PG8_LAS unsigned char* lds, const Gemm g, const Sched& S, const Epi& E) {
    const int tid = tid_opaque(), wid = __builtin_amdgcn_readfirstlane(tid >> 6), lane = tid & 63, wr = wid >> 2, wc = wid & 3, fr = lane & 15, fq = lane >> 4;
    const int K = g.ldk ? g.ldk : g.K, nt = g.K / BK;
    unsigned voffA[2], voffB[2];
#pragma unroll
    for (int i = 0; i < 2; ++i) { int R, C; stage_rc(tid * 16 + i * 8192, R, C); const int Rb = Epi::PERM ? ((R & ~31) + perm32(R & 31)) : R;
        voffA[i] = (unsigned)(R * K + C) * 2u; voffB[i] = (unsigned)(Rb * K + C) * 2u; }
    const size_t kstep = (size_t)(BK * 2);
    const size_t hstep = (size_t)HALF * K * 2;
    const size_t tstep = 2 * hstep;
    const unsigned ldsw = (unsigned)wid * 1024u;
    const int aoff = lds_byte(wr * 64 + fr, fq * 8), boff = lds_byte(wc * 32 + fr, fq * 8);
#define PG8_SA(b, h) (((b) * 2 + (h)) * HTB)
#define PG8_SB(b, h) ((4 + (b) * 2 + (h)) * HTB)
#define PG8_STAGE(bufoff, gbase, voff) do { _Pragma("unroll") for (int _i = 0; _i < 2; ++_i) \
        __builtin_amdgcn_global_load_lds((const unsigned*)((const char*)(gbase) + (voff)[_i]), (PG8_LAS unsigned*)(lds + (bufoff) + ldsw + _i * 8192), 16, 0, 0); } while (0)
#define PG8_STAGE_A(bufoff, gbase, voff) do { _Pragma("unroll") for (int _i = 0; _i < 2; ++_i) { \
        if constexpr (Sched::A_SC1) __builtin_amdgcn_global_load_lds((const unsigned*)((const char*)(gbase) + (voff)[_i]), (PG8_LAS unsigned*)(lds + (bufoff) + ldsw + _i * 8192), 16, 0, 16); \
        else __builtin_amdgcn_global_load_lds((const unsigned*)((const char*)(gbase) + (voff)[_i]), (PG8_LAS unsigned*)(lds + (bufoff) + ldsw + _i * 8192), 16, 0, 0); } } while (0)
#define PG8_LDA(dst, b, h) do { _Pragma("unroll") for (int m = 0; m < 4; ++m) _Pragma("unroll") for (int k = 0; k < 2; ++k) dst[m][k] = *(const PG8_LAS bf16x8*)(lds + PG8_SA(b, h) + aoff + m * 2048 + k * 1024); } while (0)
#define PG8_LDB(dst, b, h) do { _Pragma("unroll") for (int n = 0; n < 2; ++n) _Pragma("unroll") for (int k = 0; k < 2; ++k) dst[n][k] = *(const PG8_LAS bf16x8*)(lds + PG8_SB(b, h) + boff + n * 2048 + k * 1024); } while (0)
#define PG8_MMA(ai, bj, At, Bt) do { __builtin_amdgcn_s_setprio(1); _Pragma("unroll") for (int m = 0; m < 4; ++m) _Pragma("unroll") for (int n = 0; n < 2; ++n) _Pragma("unroll") for (int k = 0; k < 2; ++k) \
        acc[ai][bj][m][n] = __builtin_amdgcn_mfma_f32_16x16x32_bf16(Bt[n][k], At[m][k], acc[ai][bj][m][n], 0, 0, 0); __builtin_amdgcn_s_setprio(0); } while (0)
#define PG8_WAIT_V(n) asm volatile("s_waitcnt vmcnt(" #n ")" ::: "memory")
#define PG8_WAIT_L(n) asm volatile("s_waitcnt lgkmcnt(" #n ")" ::: "memory")
#define PG8_BAR __builtin_amdgcn_s_barrier()
#define PG8_SCHED __builtin_amdgcn_sched_barrier(0)
    Unit cur, nxt; int ui = 0;
    if (!S.next(0, cur)) return;
    f32x4 acc[2][2][4][2];
#pragma unroll
    for (int a = 0; a < 2; ++a)
#pragma unroll
        for (int b = 0; b < 2; ++b)
#pragma unroll
            for (int m = 0; m < 4; ++m)
#pragma unroll
                for (int n = 0; n < 2; ++n) acc[a][b][m][n] = (f32x4){0.f, 0.f, 0.f, 0.f};
    bf16x8 At[4][2], B0[2][2], B1[2][2];
    const char* cA = (const char*)g.A + (size_t)cur.pm * tstep; const char* cB = (const char*)g.Bt + (size_t)cur.pn * tstep;
    S.a_ready(cur);
    if constexpr (SP2) {
        PG8_STAGE(PG8_SB(0, 0), cB, voffB); PG8_STAGE(PG8_SB(0, 1), cB + hstep, voffB); PG8_STAGE_A(PG8_SA(0, 0), cA, voffA); PG8_STAGE_A(PG8_SA(0, 1), cA + hstep, voffA);
        if (wr == 1) PG8_BAR;
        PG8_WAIT_V(2); PG8_BAR;
        PG8_STAGE(PG8_SB(1, 0), cB + kstep, voffB); PG8_STAGE_A(PG8_SA(1, 0), cA + kstep, voffA); PG8_STAGE(PG8_SB(1, 1), cB + hstep + kstep, voffB);
        PG8_WAIT_V(6); PG8_BAR;
    } else {
        PG8_STAGE(PG8_SB(0, 0), cB, voffB); PG8_STAGE_A(PG8_SA(0, 0), cA, voffA); PG8_STAGE(PG8_SB(0, 1), cB + hstep, voffB); PG8_STAGE_A(PG8_SA(0, 1), cA + hstep, voffA);
        if (wr == 1) PG8_BAR;
        PG8_WAIT_V(4); PG8_BAR;
        PG8_STAGE(PG8_SB(1, 0), cB + kstep, voffB); PG8_STAGE_A(PG8_SA(1, 0), cA + kstep, voffA); PG8_STAGE(PG8_SB(1, 1), cB + hstep + kstep, voffB);
        PG8_WAIT_V(6); PG8_BAR;
    }
    for (;;) {
        const bool has_next = S.next(ui + 1, nxt);
        const char* nA = has_next ? (const char*)g.A + (size_t)nxt.pm * tstep : cA; const char* nB = has_next ? (const char*)g.Bt + (size_t)nxt.pn * tstep : cB;
        for (int t = 0; t < nt; t += 2) {
            const bool last = (t == nt - 2);
            const char* a1 = cA + (size_t)(t + 1) * kstep;
            const char* a2 = last ? nA : cA + (size_t)(t + 2) * kstep; const char* b2 = last ? nB : cB + (size_t)(t + 2) * kstep;
            const char* a3 = a2 + kstep; const char* b3 = b2 + kstep;
            if (last && has_next) S.a_ready(nxt);
            if constexpr (SP2) {
            PG8_LDB(B0, 0, 0); PG8_LDB(B1, 0, 1); PG8_SCHED; PG8_LDA(At, 0, 0); PG8_STAGE_A(PG8_SA(1, 1), a1 + hstep, voffA);
            PG8_WAIT_V(8); PG8_WAIT_L(0); PG8_BAR; PG8_MMA(0, 0, At, B0); PG8_MMA(0, 1, At, B1); PG8_BAR; PG8_SCHED;
            PG8_LDA(At, 0, 1); PG8_STAGE(PG8_SB(0, 0), b2, voffB); PG8_STAGE(PG8_SB(0, 1), b2 + hstep, voffB); PG8_STAGE_A(PG8_SA(0, 0), a2, voffA);
            PG8_WAIT_V(8); PG8_WAIT_L(0); PG8_BAR; PG8_MMA(1, 0, At, B0); PG8_MMA(1, 1, At, B1); PG8_BAR; PG8_SCHED;
            PG8_LDB(B0, 1, 0); PG8_LDB(B1, 1, 1); PG8_SCHED; PG8_LDA(At, 1, 0); PG8_STAGE_A(PG8_SA(0, 1), a2 + hstep, voffA);
            PG8_WAIT_V(8); PG8_WAIT_L(0); PG8_BAR; PG8_MMA(0, 0, At, B0); PG8_MMA(0, 1, At, B1); PG8_BAR; PG8_SCHED;
            PG8_LDA(At, 1, 1); PG8_STAGE(PG8_SB(1, 0), b3, voffB); PG8_STAGE(PG8_SB(1, 1), b3 + hstep, voffB); PG8_STAGE_A(PG8_SA(1, 0), a3, voffA);
            PG8_WAIT_V(8); PG8_WAIT_L(0); PG8_BAR; PG8_MMA(1, 0, At, B0); PG8_MMA(1, 1, At, B1); PG8_BAR; PG8_SCHED;
            } else {
            PG8_LDB(B0, 0, 0); PG8_SCHED; PG8_LDA(At, 0, 0); PG8_STAGE_A(PG8_SA(1, 1), a1 + hstep, voffA);
            PG8_WAIT_L(8); PG8_BAR; PG8_WAIT_L(0); PG8_MMA(0, 0, At, B0); PG8_BAR; PG8_SCHED;
            PG8_LDB(B1, 0, 1); PG8_STAGE(PG8_SB(0, 0), b2, voffB);
            PG8_BAR; PG8_WAIT_L(0); PG8_MMA(0, 1, At, B1); PG8_BAR;
            PG8_LDA(At, 0, 1); PG8_STAGE_A(PG8_SA(0, 0), a2, voffA);
            PG8_BAR; PG8_WAIT_L(0); PG8_MMA(1, 0, At, B0); PG8_BAR; PG8_SCHED;
            PG8_STAGE(PG8_SB(0, 1), b2 + hstep, voffB);
            PG8_WAIT_V(6); PG8_BAR; PG8_MMA(1, 1, At, B1); PG8_BAR;
            PG8_LDB(B0, 1, 0); PG8_SCHED; PG8_LDA(At, 1, 0); PG8_STAGE_A(PG8_SA(0, 1), a2 + hstep, voffA);
            PG8_WAIT_L(8); PG8_BAR; PG8_WAIT_L(0); PG8_MMA(0, 0, At, B0); PG8_BAR; PG8_SCHED;
            PG8_LDB(B1, 1, 1); PG8_STAGE(PG8_SB(1, 0), b3, voffB);
            PG8_BAR; PG8_WAIT_L(0); PG8_MMA(0, 1, At, B1); PG8_BAR;
            PG8_LDA(At, 1, 1); PG8_STAGE_A(PG8_SA(1, 0), a3, voffA);
            PG8_BAR; PG8_WAIT_L(0); PG8_MMA(1, 0, At, B0); PG8_BAR; PG8_SCHED;
            PG8_STAGE(PG8_SB(1, 1), b3 + hstep, voffB);
            PG8_WAIT_V(6); PG8_BAR; PG8_MMA(1, 1, At, B1); PG8_BAR;
            }
        }
        if constexpr (ALIGN_EPI) { if (wr == 0) PG8_BAR; }
        if constexpr (!Epi::AFTER_DRAIN) { E(acc, cur, wr, wc, fr, fq); S.done(cur); }
        if (!has_next) break;
#pragma unroll
        for (int a = 0; a < 2; ++a)
#pragma unroll
            for (int b = 0; b < 2; ++b)
#pragma unroll
                for (int m = 0; m < 4; ++m)
#pragma unroll
                    for (int n = 0; n < 2; ++n) acc[a][b][m][n] = (f32x4){0.f, 0.f, 0.f, 0.f};
        cur = nxt; cA = nA; cB = nB; ++ui;
        if constexpr (ALIGN_EPI) { if (wr == 1) PG8_BAR; }
    }
    PG8_WAIT_V(0);
    if constexpr (!ALIGN_EPI) { if (wr == 0) PG8_BAR; }
    PG8_BAR;
    if constexpr (Epi::AFTER_DRAIN) { E.fused(acc, cur, wr, wc, fr, fq, lds, wid, lane); S.done(cur); }
#undef PG8_SA
#undef PG8_SB
#undef PG8_STAGE
#undef PG8_STAGE_A
#undef PG8_LDA
#undef PG8_LDB
#undef PG8_MMA
#undef PG8_WAIT_V
#undef PG8_WAIT_L
#undef PG8_BAR
#undef PG8_SCHED
}
}
constexpr int NWAVES = 8, NTHREADS = NWAVES * 64;
constexpr int LDS_BYTES = 147456;
constexpr int LDS_MISC = 131072;
constexpr int N_PHASES = 9;

struct Args {
    const float *x_prompt, *x_sample, *cache_k, *cache_v, *state_delta, *state_conv, *meta, *norm_mix, *w_in, *conv_w, *a_log, *dt_bias, *sinks, *gdn_norm,
                *w_oa, *w_ob, *w_out, *norm_ffn, *w_gate, *w_up, *w_down, *norm_final;
    float* out; unsigned char* ws; int ph_lo, ph_hi;
};

typedef const __attribute__((address_space(4))) Args* KA;
DI KA kargs() { KA p = (KA)__builtin_amdgcn_kernarg_segment_ptr(); asm volatile("" : "+s"(p)); return p; }
#define RLX_AGENT __ATOMIC_RELAXED, __HIP_MEMORY_SCOPE_AGENT
#define LDS_WAIT() asm volatile("s_waitcnt lgkmcnt(0)" ::: "memory")
#define MFMA32(a, b, c) __builtin_amdgcn_mfma_f32_32x32x16_bf16((a), (b), (c), 0, 0, 0)
DI int crow16(int reg, int h) { return (reg & 3) + 8 * (reg >> 2) + 4 * h; }
DI float wave_sum(float v) {
#pragma unroll
    for (int o = 1; o < 64; o <<= 1) v += __shfl_xor(v, o);
    return v;
}
DI float wave_max(float v) {
#pragma unroll
    for (int o = 1; o < 64; o <<= 1) v = fmaxf(v, __shfl_xor(v, o));
    return v;
}
template <int S> DI bf16x8 pack_step(const f32x16& x) {
    u32x4 p; p.x = cvtpk(x[8 * S], x[8 * S + 1]); p.y = cvtpk(x[8 * S + 2], x[8 * S + 3]); p.z = cvtpk(x[8 * S + 4], x[8 * S + 5]); p.w = cvtpk(x[8 * S + 6], x[8 * S + 7]);
    return __builtin_bit_cast(bf16x8, p);
}
DI int frag_idx(int row, int k, int NKS) { const int kkk = k & 15; return (((row >> 5) * NKS + (k >> 4)) * 64 + (row & 31) + 32 * ((kkk >> 2) & 1)) * 8 + (((kkk >> 3) << 2) | (kkk & 3)); }
DI unsigned char* slot_ptr(KA A, int item) { return item < PREP_N1 ? A->ws + WS_B + (size_t)item * PREP_SLOT : (unsigned char*)A->out + (size_t)(item - PREP_N1) * PREP_SLOT; }

#define XB_TMO      128
#define XB_XCNT(j)  (256  + 64 * (j))
#define XB_XSUB(j)  (1280 + 64 * (j))
#define XB_XGEN(j)  (2304 + 64 * (j))
#define XB_TOP      3328
#define XB_TOPGEN   3392
#define XCD_BAR_WORDS 3456
#define XB_SPIN_CAP (1u << 20)
DI unsigned xb_ld(unsigned* p)              { return __hip_atomic_load(p, __ATOMIC_RELAXED, __HIP_MEMORY_SCOPE_AGENT); }
DI unsigned xb_add(unsigned* p, unsigned v) { return __hip_atomic_fetch_add(p, v, __ATOMIC_RELAXED, __HIP_MEMORY_SCOPE_AGENT); }
DI unsigned xb_xcc_id() { return (unsigned)__builtin_amdgcn_s_getreg((3 << 11) | 20) & 0xFu; }
#define XB_SPIN(cond, bar) do { unsigned _sp = 0; while (cond) { __builtin_amdgcn_s_sleep(1); \
    if ((++_sp & 255u) == 0u) { if (xb_ld(&(bar)[XB_TMO])) break; if (_sp > XB_SPIN_CAP) { atomicAdd(&(bar)[XB_TMO], 1u); break; } } } } while (0)
struct XcdBarrier { unsigned* bar; unsigned x; volatile LAS unsigned* st; };
DI XcdBarrier xcd_barrier_post(unsigned* bar, volatile LAS unsigned* st) {
    XcdBarrier b; b.bar = bar; b.x = xb_xcc_id(); b.st = st;
    if (threadIdx.x == 0) (void)xb_add(&bar[XB_XCNT(b.x)], 1u);
    return b;
}
DI void xcd_barrier_complete(unsigned* bar, unsigned x, unsigned& nloc, unsigned& nx) {
    const unsigned G = gridDim.x * gridDim.y * gridDim.z;
    unsigned sum, cnt, mine, sp = 0u;
    for (;;) {
        sum = 0u; cnt = 0u; mine = 0u;
#pragma unroll
        for (unsigned j = 0; j < 16; ++j) { const unsigned c = xb_ld(&bar[XB_XCNT(j)]); sum += c; cnt += (c > 0u) ? 1u : 0u; mine = (j == x) ? c : mine; }
        if (sum == G) break;
        __builtin_amdgcn_s_sleep(1);
        if ((++sp & 255u) == 0u) { if (xb_ld(&bar[XB_TMO])) break; if (sp > XB_SPIN_CAP) { atomicAdd(&bar[XB_TMO], 1u); break; } }
    }
    nloc = mine > 0u ? mine : 1u; nx = cnt > 0u ? cnt : 1u;
}
DI void xcd_barrier(const XcdBarrier& b) {
    asm volatile("s_waitcnt vmcnt(0)" ::: "memory");
    __syncthreads();
    if (threadIdx.x == 0) {
        unsigned* bar = b.bar;
        __builtin_amdgcn_s_waitcnt(0);
        unsigned nloc = b.st[0], nx = b.st[1];
        if (nloc == 0u) { xcd_barrier_complete(bar, b.x, nloc, nx); b.st[0] = nloc; b.st[1] = nx; }
        const unsigned old = xb_add(&bar[XB_XSUB(b.x)], 1u);
        const unsigned gen = old / nloc;
        if (old + 1u == (gen + 1u) * nloc) {
            __builtin_amdgcn_fence(__ATOMIC_RELEASE, "agent");
            asm volatile("s_waitcnt vmcnt(0)" ::: "memory");
            const unsigned og = xb_add(&bar[XB_TOP], 1u);
            const unsigned tg = og / nx;
            if (og + 1u == (tg + 1u) * nx) xb_add(&bar[XB_TOPGEN], 1u);
            else XB_SPIN(xb_ld(&bar[XB_TOPGEN]) == tg, bar);
            __builtin_amdgcn_fence(__ATOMIC_ACQUIRE, "agent");
            xb_add(&bar[XB_XGEN(b.x)], 1u);
            asm volatile("s_waitcnt vmcnt(0)" ::: "memory");
        } else {
            XB_SPIN(xb_ld(&bar[XB_XGEN(b.x)]) == gen, bar);
            __builtin_amdgcn_fence(__ATOMIC_ACQUIRE, "agent");
            asm volatile("s_waitcnt vmcnt(0)" ::: "memory");
        }
    }
    __syncthreads();
}

template <class RowMap> DI void transpose_item(const float* W, int K, int N, bf16* WT, RowMap rm, const float* kscale, LAS float* scr, int item, int lane, int ldw = 0) {
    if (ldw == 0) ldw = K;
    const int nblk = (N + 31) / 32, kb = item / nblk, nb = item - kb * nblk, k0 = 64 * kb, n0 = 32 * nb;
    const int n4 = n0 + (lane & 7) * 4;
    f32x4 v[8];
#pragma unroll
    for (int i = 0; i < 8; ++i) { const int kk = 8 * i + (lane >> 3);
        v[i] = n4 < N ? *(const f32x4*)(W + (size_t)(k0 + kk) * N + n4) : (f32x4){0.f, 0.f, 0.f, 0.f}; }
#pragma unroll
    for (int i = 0; i < 8; ++i) { const int kk = 8 * i + (lane >> 3);
        if (kscale) v[i] = v[i] * kscale[k0 + kk];
        LAS float* d = scr + kk * 33 + (lane & 7) * 4; d[0] = v[i][0]; d[1] = v[i][1]; d[2] = v[i][2]; d[3] = v[i][3]; }
    LDS_WAIT(); asm volatile("" ::: "memory");
    const int c = lane & 7;
#pragma unroll
    for (int j = 0; j < 4; ++j) { const int n = (lane >> 3) + 8 * j; const LAS float* s = scr + (8 * c) * 33 + n;
        const int nsrc = n0 + n; const int drow = nsrc < N ? rm(nsrc) : -1;
        u32x4 o; o.x = cvtpk(s[0 * 33], s[1 * 33]); o.y = cvtpk(s[2 * 33], s[3 * 33]); o.z = cvtpk(s[4 * 33], s[5 * 33]); o.w = cvtpk(s[6 * 33], s[7 * 33]);
        if (drow >= 0) *(u32x4*)(WT + (size_t)drow * ldw + k0 + 8 * c) = o; }
    LDS_WAIT(); asm volatile("" ::: "memory");
}
DI float softplusf_(float x) { return x > 20.f ? x : log1pf(__expf(x)); }

#ifndef PROBE_REP
#define PROBE_REP -1
#endif
#ifndef P0_ROW_WAVES
#define P0_ROW_WAVES 4
#endif
DI void p0_prologue(KA A, LAS unsigned char* lds) {
    const int tid = tid_opaque(), lane = tid & 63, wave = __builtin_amdgcn_readfirstlane(tid >> 6);
    const int G = gridDim.x;
    constexpr int NR = P0_ROW_WAVES, NT = NWAVES - NR;
    const bool rowrole = wave < NR;
    const int gw = rowrole ? blockIdx.x * NR + wave : blockIdx.x * NT + (wave - NR), NGW = G * (rowrole ? NR : NT);
    const int gt = blockIdx.x * (NT * 64) + (tid - NR * 64), NGT = G * NT * 64;
    unsigned char* ws = A->ws;
    if (!rowrole) for (int rep = 0; rep < (PROBE_REP == 1001 ? 2 : 1); ++rep) {
        LAS float* scr = (LAS float*)(lds + wave * 16384);
        constexpr int I_IN = 16 * 153, I_OA = 8 * 32, I_OUT = 16 * 32, I_G = 16 * 88, I_D = 44 * 32;
        constexpr int NIT = I_IN + 2 * I_OA + I_OUT + 2 * I_G + I_D;
        for (int it = gw; it < NIT; it += NGW) {
            int r = it;
            if (r < I_IN) { transpose_item(A->w_in, 1024, NIN_SRC, (bf16*)(ws + WS_WIN), [](int c) -> int {
                    if (c < 640) return (c & ~63) + pos_of_d(c & 63);
                    if (c < 2816) return c;
                    if (c < 2824) return -1;
                    return c - 8; }, nullptr, scr, r, lane); continue; } r -= I_IN;
            if (r < I_OA) { transpose_item(A->w_oa, 512, 1024, (bf16*)(ws + WS_WOA), [](int c) -> int { return c; }, nullptr, scr, r, lane, 1024); continue; } r -= I_OA;
            if (r < I_OA) { transpose_item(A->w_ob, 512, 1024, (bf16*)(ws + WS_WOA) + 512, [](int c) -> int { return c; }, nullptr, scr, r, lane, 1024); continue; } r -= I_OA;
            if (r < I_OUT) { transpose_item(A->w_out, 1024, 1024, (bf16*)(ws + WS_WOUT), [](int c) -> int { return c; }, nullptr, scr, r, lane); continue; } r -= I_OUT;
            if (r < I_G) { transpose_item(A->w_gate, 1024, DFF, (bf16*)(ws + WS_WGU), [](int c) -> int { return 256 * (c >> 7) + (c & 127); }, A->norm_ffn, scr, r, lane); continue; } r -= I_G;
            if (r < I_G) { transpose_item(A->w_up, 1024, DFF, (bf16*)(ws + WS_WGU), [](int c) -> int { return 256 * (c >> 7) + 128 + (c & 127); }, A->norm_ffn, scr, r, lane); continue; } r -= I_G;
            transpose_item(A->w_down, DFF, 1024, (bf16*)(ws + WS_WD), [](int c) -> int { return c; }, nullptr, scr, r, lane);
        }
    }
    if (!rowrole) for (int rep = 0; rep < (PROBE_REP == 1002 ? 2 : 1); ++rep) {
        float* COS = (float*)(ws + WS_ROPE); float* SIN = COS + (TP + TS) * 32;
        for (int i = gt; i < (TP + TS) * 32; i += NGT) { const int ri = i >> 5, f = i & 31; const double pos = ri < TP ? (double)ri : (double)(PAST + ri - TP);
            const double inv = exp2(-(double)f * (13.287712379549449 / 32.0)), ang = pos * inv; COS[i] = (float)cos(ang); SIN[i] = (float)sin(ang); }
        constexpr int PERB = 124 * 128 / 4;
        for (int i = gt; i < SBATCH * PERB; i += NGT) { const int b = i / PERB, o = i - b * PERB;
            ((f32x4*)(A->out + O_KS))[(size_t)b * 4096 + o] = ((const f32x4*)A->cache_k)[(size_t)b * 4096 + 128 + o];
            ((f32x4*)(A->out + O_VS))[(size_t)b * 4096 + o] = ((const f32x4*)A->cache_v)[(size_t)b * 4096 + 128 + o]; }
    }
    if (rowrole) for (int rep = 0; rep < (PROBE_REP == 1003 ? 2 : 1); ++rep) {
        unsigned wab[16][4];
        f32x4 nm[4];
#pragma unroll
        for (int j = 0; j < 4; ++j) {
            nm[j] = ((const f32x4*)A->norm_mix)[lane + 64 * j];
#pragma unroll
            for (int e = 0; e < 4; ++e) { const float* p = A->w_in + (size_t)(4 * (lane + 64 * j) + e) * NIN_SRC + 2816;
                const f32x4 a = *(const f32x4*)p, b = *(const f32x4*)(p + 4);
                wab[j * 4 + e][0] = cvtpk(a[0], a[1]); wab[j * 4 + e][1] = cvtpk(a[2], a[3]); wab[j * 4 + e][2] = cvtpk(b[0], b[1]); wab[j * 4 + e][3] = cvtpk(b[2], b[3]); }
        }
        bf16* XN = (bf16*)(ws + WS_XN); f32x2* GB = (f32x2*)(ws + WS_GB);
        auto row_src = [&](int urow) -> const float* {
            if (urow < MP) { const int b = urow / TP, t = urow - b * TP; return t < NMETA ? A->meta + (size_t)t * D : A->x_prompt + ((size_t)b * SEQ + (t - NMETA)) * D; }
            if (urow < MU) return A->x_sample + (size_t)(urow - MP) * D;
            return nullptr; };
        f32x4 nx[4], nx2[4];
        { const float* s0 = gw < MUP ? row_src(gw) : nullptr; const float* s1 = gw + NGW < MUP ? row_src(gw + NGW) : nullptr;
#pragma unroll
          for (int j = 0; j < 4; ++j) { nx[j] = s0 ? ((const f32x4*)s0)[lane + 64 * j] : (f32x4){0.f, 0.f, 0.f, 0.f}; nx2[j] = s1 ? ((const f32x4*)s1)[lane + 64 * j] : (f32x4){0.f, 0.f, 0.f, 0.f}; } }
#pragma unroll 1
        for (int urow = gw; urow < MUP; urow += NGW) {
            f32x4 v[4];
#pragma unroll
            for (int j = 0; j < 4; ++j) { v[j] = nx[j]; nx[j] = nx2[j]; }
            { const int un = urow + 2 * NGW; const float* s2 = un < MUP ? row_src(un) : nullptr;
#pragma unroll
              for (int j = 0; j < 4; ++j) nx2[j] = s2 ? ((const f32x4*)s2)[lane + 64 * j] : (f32x4){0.f, 0.f, 0.f, 0.f}; }
            u32x2* o8 = (u32x2*)(XN + (size_t)urow * D) + lane;
            float ss = 0.f;
#pragma unroll
            for (int j = 0; j < 4; ++j) ss += (v[j][0] * v[j][0] + v[j][1] * v[j][1]) + (v[j][2] * v[j][2] + v[j][3] * v[j][3]);
            const float rstd = urow < MU ? rsqrtf(wave_sum(ss) * (1.0f / D) + EPS) : 0.f;
            float dot[8];
#pragma unroll
            for (int c = 0; c < 8; ++c) dot[c] = 0.f;
#pragma unroll
            for (int j = 0; j < 4; ++j) { v[j] = v[j] * rstd * nm[j];
                o8[64 * j] = (u32x2){cvtpk(v[j][0], v[j][1]), cvtpk(v[j][2], v[j][3])};
#pragma unroll
                for (int e = 0; e < 4; ++e)
#pragma unroll
                    for (int c = 0; c < 4; ++c) { dot[2 * c] += v[j][e] * bflo(wab[j * 4 + e][c]); dot[2 * c + 1] += v[j][e] * bfhi(wab[j * 4 + e][c]); } }
            float d4[4], d2[2], d1;
#pragma unroll
            for (int c = 0; c < 4; ++c) { const float keep = (lane & 32) ? dot[4 + c] : dot[c], send = (lane & 32) ? dot[c] : dot[4 + c]; d4[c] = keep + __shfl_xor(send, 32); }
#pragma unroll
            for (int c = 0; c < 2; ++c) { const float keep = (lane & 16) ? d4[2 + c] : d4[c], send = (lane & 16) ? d4[c] : d4[2 + c]; d2[c] = keep + __shfl_xor(send, 16); }
            { const float keep = (lane & 8) ? d2[1] : d2[0], send = (lane & 8) ? d2[0] : d2[1]; d1 = keep + __shfl_xor(send, 8); }
            d1 += __shfl_xor(d1, 4); d1 += __shfl_xor(d1, 2); d1 += __shfl_xor(d1, 1);
            const float a_ = __shfl(d1, ((lane & 2) ? 16 : 0) + ((lane & 1) ? 8 : 0));
            const float b_ = __shfl(d1, 32 + ((lane & 2) ? 16 : 0) + ((lane & 1) ? 8 : 0));
            if (lane < 4) {
                const float g = -__expf(A->a_log[lane]) * softplusf_(a_ + A->dt_bias[lane]);
                GB[(size_t)urow * 4 + lane] = urow < MU ? (f32x2){g, sigmoidf_(b_)} : (f32x2){0.f, 0.f};
            }
        }
    }
}
DI void item_decode(int item, int& b, int& h, bool& sample, int& t0, int& L) {
    if (item < N_ITEMS_P) { const int s = item / CHUNKS_P, c = item - s * CHUNKS_P; b = s >> 2; h = s & 3; sample = false; if (c == 0) { t0 = 0; L = NMETA; } else { t0 = NMETA + 64 * (c - 1); L = 64; } }
    else { const int s = item - N_ITEMS_P; b = s >> 2; h = s & 3; sample = true; t0 = 0; L = TS; }
}
#define LDS_BARRIER() do { asm volatile("s_waitcnt lgkmcnt(0)" ::: "memory"); __builtin_amdgcn_s_barrier(); asm volatile("" ::: "memory"); } while (0)
typedef GAS unsigned long long gu64;
typedef GAS unsigned gu32;
constexpr size_t CTL_QUEUE = 40960;
constexpr size_t CTL_F1 = 655360;
static_assert(CTL_F1 + 2592 * 64 <= 1048576, "control region map");
DI gu64* item_flag1(KA A, int item) { return (gu64*)(A->ws + WS_CTL + CTL_F1 + (size_t)item * 64); }
DI int order_item(int m) { return m < N_ITEMS_P ? (m & 31) * CHUNKS_P + (m >> 5) : m; }
DI gu64* item_granule(KA A, int item) { return (gu64*)(A->ws + WS_CTL + CTL_GRAN + (size_t)item * 64); }
DI float wait_item(gu64* g, unsigned ep = 1u) {
    unsigned long long x; unsigned spins = 0;
    for (;;) { x = __hip_atomic_load(g, __ATOMIC_RELAXED, __HIP_MEMORY_SCOPE_AGENT); if ((unsigned)(x >> 32) >= ep) break; __builtin_amdgcn_s_sleep(8); if (++spins > (1u << 20)) break; }
    asm volatile("" ::: "memory");
    return __uint_as_float((unsigned)__builtin_amdgcn_readfirstlane((int)(unsigned)x));
}
constexpr int LDS_GCL = 139264;
constexpr int PITCH = 132;
DI bf16x8 frag_nat(const LAS float* src, int row, int k0) {
    const f32x4 lo = *(const LAS f32x4*)(src + row * PITCH + k0), hi = *(const LAS f32x4*)(src + row * PITCH + k0 + 4);
    return __builtin_bit_cast(bf16x8, pack8f(lo, hi));
}
struct S1Pre { u32x4 xr[11]; f32x4 w[4][2]; f32x2 gb; };
DI void stage1_issue(KA A, int item, S1Pre& P) {
    const int tid = tid_opaque(), lane = tid & 63, wave = __builtin_amdgcn_readfirstlane(tid >> 6);
    int b, h, t0, L; bool sample; item_decode(item, b, h, sample, t0, L);
    const bf16* QKVB = (const bf16*)(A->ws + WS_QKVB);
    const int cv = lane < 48 ? lane : 47, grp = cv >> 4, col0 = (cv & 15) * 8, r0 = wave * 8, cidx = grp * 512 + h * 128 + col0;
#pragma unroll
    for (int q = 0; q < 11; ++q) {
        const int i = r0 - 3 + q;
        long urow = sample ? (long)MP + b * TS + i : (long)b * TP + t0 + i;
        const bool ok = sample ? i >= 0 : t0 + i >= 0;
        if (!ok) urow = 0;
        P.xr[q] = *(const u32x4*)(QKVB + (size_t)urow * CONVD + cidx);
        if (!ok) P.xr[q] = (u32x4){0u, 0u, 0u, 0u};
    }
#pragma unroll
    for (int i = 0; i < 4; ++i) { P.w[i][0] = *(const f32x4*)(A->conv_w + i * CONVD + cidx); P.w[i][1] = *(const f32x4*)(A->conv_w + i * CONVD + cidx + 4); }
    P.gb = (f32x2){0.f, 0.f};
    if (wave == 7 && lane < L) { const int urow = sample ? MP + b * TS + lane : b * TP + t0 + lane; P.gb = ((const f32x2*)(A->ws + WS_GB))[(size_t)urow * 4 + h]; }
}
DI void prep_stage1(KA A, int item, int next_item, int prev_item, int wait_item_idx, int bslot, float* ats, S1Pre& P, LAS unsigned char* ldsb, unsigned ep, int pmode = 0) {
    const int tid = tid_opaque(), lane = tid & 63, wave = __builtin_amdgcn_readfirstlane(tid >> 6), r = lane & 31, hh = lane >> 5;
#define ST16(p, ...) __builtin_amdgcn_raw_buffer_store_b128(__builtin_bit_cast(v4u_t, (__VA_ARGS__)), rs_slot, (int)((const unsigned char*)(p) - (const unsigned char*)slot), 0, 16)
#define ST16F(p, ...) __builtin_amdgcn_raw_buffer_store_b128(__builtin_bit_cast(v4u_t, (__VA_ARGS__)), rs_ats, (int)((const unsigned char*)(p) - (const unsigned char*)ats), 0, 16)
    int b, h, t0, L; bool sample; item_decode(item, b, h, sample, t0, L);
    LAS float* Qs = (LAS float*)ldsb; LAS float* Ks = Qs + 64 * PITCH; LAS float* Vs = Ks + 64 * PITCH; LAS float* gcs = Vs + 64 * PITCH; LAS float* betas = gcs + 64;
    unsigned char* slot = slot_ptr(A, item);
    typedef unsigned v4u_t __attribute__((__vector_size__(16)));
    const __amdgpu_buffer_rsrc_t rs_slot = __builtin_amdgcn_make_buffer_rsrc((void*)slot, 0, (int)PREP_SLOT, 0x00020000);
    const __amdgpu_buffer_rsrc_t rs_ats = __builtin_amdgcn_make_buffer_rsrc((void*)ats, 0, (int)ATS_ITEM, 0x00020000);
    if (!(pmode & 8)) {
        const int cv = lane < 48 ? lane : 47, grp = cv >> 4, col0 = (cv & 15) * 8, r0 = wave * 8, cidx = grp * 512 + h * 128 + col0;
        float x[11][8];
#pragma unroll
        for (int q = 0; q < 11; ++q) { x[q][0] = bflo(P.xr[q].x); x[q][1] = bfhi(P.xr[q].x); x[q][2] = bflo(P.xr[q].y); x[q][3] = bfhi(P.xr[q].y);
                                       x[q][4] = bflo(P.xr[q].z); x[q][5] = bfhi(P.xr[q].z); x[q][6] = bflo(P.xr[q].w); x[q][7] = bfhi(P.xr[q].w); }
        if (sample && wave == 0) {
#pragma unroll
            for (int q = 0; q < 3; ++q) { const float* sp = A->state_conv + ((size_t)b * 3 + q) * CONVD + cidx; const f32x4 s0 = *(const f32x4*)sp, s1 = *(const f32x4*)(sp + 4);
                x[q][0] = s0[0]; x[q][1] = s0[1]; x[q][2] = s0[2]; x[q][3] = s0[3]; x[q][4] = s1[0]; x[q][5] = s1[1]; x[q][6] = s1[2]; x[q][7] = s1[3]; }
        }
        float w[4][8];
#pragma unroll
        for (int i = 0; i < 4; ++i) { w[i][0] = P.w[i][0][0]; w[i][1] = P.w[i][0][1]; w[i][2] = P.w[i][0][2]; w[i][3] = P.w[i][0][3]; w[i][4] = P.w[i][1][0]; w[i][5] = P.w[i][1][1]; w[i][6] = P.w[i][1][2]; w[i][7] = P.w[i][1][3]; }
        LAS float* dst = Qs + grp * 64 * PITCH + col0;
        const float nsc = grp == 0 ? 0.08838834764831845f : 1.0f;
#pragma unroll
        for (int q = 3; q < 11; ++q) {
            const int rr = r0 + q - 3;
            float v[8]; float ss = 0.f;
#pragma unroll
            for (int e = 0; e < 8; ++e) {
                const float y = __builtin_fmaf(w[3][e], x[q][e], __builtin_fmaf(w[2][e], x[q - 1][e], __builtin_fmaf(w[1][e], x[q - 2][e], w[0][e] * x[q - 3][e])));
                const float sv = siluf_(y); v[e] = sv; ss = __builtin_fmaf(sv, sv, ss); }
            ss += __builtin_bit_cast(float, __builtin_amdgcn_update_dpp(0, __builtin_bit_cast(int, ss), 0xB1, 0xF, 0xF, true));
            ss += __builtin_bit_cast(float, __builtin_amdgcn_update_dpp(0, __builtin_bit_cast(int, ss), 0x4E, 0xF, 0xF, true));
            ss += __builtin_bit_cast(float, __builtin_amdgcn_update_dpp(0, __builtin_bit_cast(int, ss), 0x141, 0xF, 0xF, true));
            ss += __builtin_bit_cast(float, __builtin_amdgcn_update_dpp(0, __builtin_bit_cast(int, ss), 0x140, 0xF, 0xF, true));
            float sc = grp == 2 ? 1.0f : rsqrtf(ss + EPS) * nsc;
            sc = rr < L ? sc : 0.f;
            if (lane < 48) { *(LAS f32x4*)(dst + rr * PITCH) = (f32x4){v[0] * sc, v[1] * sc, v[2] * sc, v[3] * sc}; *(LAS f32x4*)(dst + rr * PITCH + 4) = (f32x4){v[4] * sc, v[5] * sc, v[6] * sc, v[7] * sc}; }
        }
    }
    if (wave == 7) {
        float gc = P.gb[0];
#pragma unroll
        for (int o = 1; o < 64; o <<= 1) { const float t = __shfl_up(gc, o); if (lane >= o) gc += t; }
        gcs[lane] = gc; betas[lane] = P.gb[1];
        if (lane == 63) ((LAS float*)(ldsb + LDS_GCL))[bslot] = __expf(gc);
    }
    asm volatile("s_waitcnt vmcnt(0)" ::: "memory");
    if (next_item < N_ITEMS) stage1_issue(A, next_item, P);
    if (wait_item_idx >= 0 && wave == 0) (void)wait_item(item_granule(A, wait_item_idx), ep);
    LDS_BARRIER();
    if (prev_item >= 0 && tid == 0) __hip_atomic_store(item_flag1(A, prev_item), ((unsigned long long)ep << 32) | (unsigned long long)__float_as_uint(((const LAS float*)(ldsb + LDS_GCL))[bslot ^ 1]), __ATOMIC_RELAXED, __HIP_MEMORY_SCOPE_AGENT);
    if (wave < 6 && !(pmode & 4)) {
        const bool isqk = wave >= 3; const int tsel = isqk ? wave - 3 : wave, ib = tsel == 0 ? 0 : 1, jb = tsel == 2 ? 1 : 0;
        const LAS float* Asrc = isqk ? Qs : Ks;
        f32x16 acc;
#pragma unroll
        for (int e = 0; e < 16; ++e) acc[e] = 0.f;
#pragma unroll
        for (int s = 0; s < 8; ++s) acc = MFMA32(frag_nat(Asrc, 32 * ib + r, 16 * s + 8 * hh), frag_nat(Ks, 32 * jb + r, 16 * s + 8 * hh), acc);
        const int j = 32 * jb + r; const float gcj = gcs[j];
        float* Aout = ats + (ib + jb) * 1024; bf16* QKD = (bf16*)(slot + SL_QKD);
        if (!isqk) {
#pragma unroll
            for (int g4 = 0; g4 < 4; ++g4) { f32x4 v;
#pragma unroll
                for (int e = 0; e < 4; ++e) { const int i = 32 * ib + 8 * g4 + 4 * hh + e; v[e] = i > j ? betas[i] * __expf(fminf(gcs[i] - gcj, 0.f)) * acc[4 * g4 + e] : 0.f; }
                ST16F(Aout + r * 32 + 8 * g4 + 4 * hh, v); }
        } else {
            LAS float* patch = (LAS float*)(ldsb + 106496) + (wave - 3) * (32 * 36);
#pragma unroll
            for (int reg = 0; reg < 16; ++reg) { const int il = crow16(reg, hh), i = 32 * ib + il; const float dec = __expf(fminf(gcs[i] - gcj, 0.f));
                patch[il * 36 + r] = i >= j ? dec * acc[reg] : 0.f; }
            LDS_WAIT(); asm volatile("" ::: "memory");
#pragma unroll
            for (int ks2 = 0; ks2 < 2; ++ks2) { const int k0 = 16 * ks2 + 4 * hh;
                const f32x4 lo = *(const LAS f32x4*)(patch + r * 36 + k0), hi = *(const LAS f32x4*)(patch + r * 36 + k0 + 8);
                ST16((unsigned char*)QKD + ((ib * 4 + 2 * jb + ks2) * 64 + lane) * 16, pack8f(lo, hi)); }
        }
    }
    const float gcl = gcs[63];
#pragma unroll 1
    for (int job = (pmode & 4) ? 56 : wave; job < 56; job += 8) {
        if (job < 32) {
            const bool isq = job >= 16; const int jj = job & 15, rb = jj >> 3, ks = jj & 7, row = 32 * rb + r, k0 = 16 * ks + 4 * hh;
            const LAS float* src = isq ? Qs : Ks; const float sc = isq ? __expf(gcs[row]) : betas[row] * __expf(gcs[row]);
            const f32x4 lo = *(const LAS f32x4*)(src + row * PITCH + k0) * sc, hi = *(const LAS f32x4*)(src + row * PITCH + k0 + 8) * sc;
            ST16(slot + (isq ? SL_QE : SL_BEK) + ((rb * 8 + ks) * 64 + lane) * 16, pack8f(lo, hi));
        } else if (job < 48) {
            const int jj = job - 32, rb = jj >> 2, ks = jj & 3, dk = 32 * rb + r;
            f32x4 lo, hi;
#pragma unroll
            for (int e = 0; e < 4; ++e) { const int j0 = 16 * ks + 4 * hh + e, j1 = j0 + 8;
                lo[e] = Ks[j0 * PITCH + dk] * __expf(gcl - gcs[j0]); hi[e] = Ks[j1 * PITCH + dk] * __expf(gcl - gcs[j1]); }
            ST16(slot + SL_KWT + ((rb * 4 + ks) * 64 + lane) * 16, pack8f(lo, hi));
        } else {
            const int q = job - 48, w = q >> 1, ib = q & 1, dv = 32 * w + r;
            float v[16];
#pragma unroll
            for (int reg = 0; reg < 16; ++reg) { const int i = 32 * ib + crow16(reg, hh); v[reg] = betas[i] * Vs[i * PITCH + dv]; }
            u32x4* dst = (u32x4*)(slot + SL_BV + ((w * 2 + ib) * 64 + lane) * 32);
            ST16(dst, (u32x4){cvtpk(v[0], v[1]), cvtpk(v[2], v[3]), cvtpk(v[4], v[5]), cvtpk(v[6], v[7])});
            ST16(dst + 1, (u32x4){cvtpk(v[8], v[9]), cvtpk(v[10], v[11]), cvtpk(v[12], v[13]), cvtpk(v[14], v[15])});
        }
    }
    LDS_BARRIER();
}
DI void prep_stage2(KA A, int item, float gcl, const float* ats, LAS float* M, unsigned ep) {
    int lane = threadIdx.x & 63; asm volatile("" : "+v"(lane));
    const int r = lane & 31, hh = lane >> 5, base = 32 * hh;
    unsigned char* slot = slot_ptr(A, item);
    const f32x4* Ain = (const f32x4*)ats;
#pragma unroll
    for (int tt = 0; tt < 3; ++tt) { const int jb = tt >> 1, ib = (tt + 1) >> 1;
#pragma unroll
        for (int q = 0; q < 4; ++q) { const int idx = q * 64 + lane, jj = idx >> 3, i4 = idx & 7;
            *(LAS f32x4*)(M + (32 * jb + jj) * 64 + 32 * ib + 4 * i4) = Ain[tt * 256 + idx]; } }
    LDS_WAIT(); asm volatile("" ::: "memory");
#pragma unroll 1
    for (int rb = 0; rb < 2; ++rb) {
        float acc[16];
#pragma unroll
        for (int i = 0; i < 16; ++i) acc[i] = r == 16 * rb + i ? 1.f : 0.f;
        if (rb == 1) {
#pragma unroll 4
            for (int j = 0; j < 16; ++j) {
                float tj = M[(base + j) * 64 + base + r]; tj = r <= j ? tj : 0.f;
                const LAS f32x4* ar = (const LAS f32x4*)(M + (base + j) * 64 + base + 16);
                const f32x4 a0 = ar[0], a1 = ar[1], a2 = ar[2], a3 = ar[3];
#pragma unroll
                for (int e = 0; e < 4; ++e) { acc[e] -= a0[e] * tj; acc[4 + e] -= a1[e] * tj; acc[8 + e] -= a2[e] * tj; acc[12 + e] -= a3[e] * tj; }
            }
        }
#pragma unroll
        for (int j = 0; j < 16; ++j) {
            const float tj = acc[j]; const int row = base + 16 * rb + j;
            const LAS f32x4* ar = (const LAS f32x4*)(M + row * 64 + base + 16 * rb);
            float a[16];
#pragma unroll
            for (int q = j >> 2; q < 4; ++q) { const f32x4 v = ar[q]; a[4 * q] = v[0]; a[4 * q + 1] = v[1]; a[4 * q + 2] = v[2]; a[4 * q + 3] = v[3]; }
            if (r <= 16 * rb + j) M[row * 64 + base + r] = tj;
#pragma unroll
            for (int i = j + 1; i < 16; ++i) acc[i] -= a[i] * tj;
        }
        asm volatile("" ::: "memory");
    }
    LDS_WAIT(); asm volatile("" ::: "memory");
    f32x16 X;
#pragma unroll
    for (int e = 0; e < 16; ++e) X[e] = 0.f;
#pragma unroll
    for (int s2 = 0; s2 < 16; ++s2) { const int k = 2 * s2 + hh; const float a = M[k * 64 + 32 + r]; float bb = M[k * 64 + r]; bb = r <= k ? bb : 0.f;
        X = __builtin_amdgcn_mfma_f32_32x32x2f32(a, bb, X, 0, 0, 0); }
#pragma unroll
    for (int reg = 0; reg < 16; ++reg) M[crow16(reg, hh) * 64 + 32 + r] = X[reg];
    LDS_WAIT(); asm volatile("" ::: "memory");
    f32x16 Y;
#pragma unroll
    for (int e = 0; e < 16; ++e) Y[e] = 0.f;
#pragma unroll
    for (int s2 = 0; s2 < 16; ++s2) { const int k = 2 * s2 + hh; float a = M[(32 + r) * 64 + 32 + k]; a = k <= r ? a : 0.f; const float bb = M[k * 64 + 32 + r];
        Y = __builtin_amdgcn_mfma_f32_32x32x2f32(a, bb, Y, 0, 0, 0); }
#pragma unroll
    for (int reg = 0; reg < 16; ++reg) M[(32 + crow16(reg, hh)) * 64 + r] = -Y[reg];
    LDS_WAIT(); asm volatile("" ::: "memory");
#pragma unroll
    for (int f = 0; f < 8; ++f) { const int rb = f >> 2, ks = f & 3, row = 32 * rb + r, k0 = 16 * ks + 4 * hh;
        f32x4 lo = *(const LAS f32x4*)(M + row * 64 + k0), hi = *(const LAS f32x4*)(M + row * 64 + k0 + 8);
#pragma unroll
        for (int e = 0; e < 4; ++e) { lo[e] = k0 + e <= row ? lo[e] : 0.f; hi[e] = k0 + 8 + e <= row ? hi[e] : 0.f; }
        st16_sc1(slot + SL_T + ((rb * 4 + ks) * 64 + lane) * 16, pack8f(lo, hi)); }
    LDS_WAIT();
    asm volatile("s_waitcnt vmcnt(0)" ::: "memory");
    if (lane == 0) __hip_atomic_store(item_granule(A, item), ((unsigned long long)ep << 32) | (unsigned long long)__float_as_uint(gcl), __ATOMIC_RELAXED, __HIP_MEMORY_SCOPE_AGENT);
}
DI void scan_seq(KA A, int seq, int w, int lane, unsigned ep) {
    const int r = lane & 31, hh = lane >> 5, dv = 32 * w + r;
    const bool sample = seq >= N_PROMPT_SEQ; const int sidx = sample ? seq - N_PROMPT_SEQ : seq, b = sidx >> 2, h = sidx & 3, nch = sample ? 1 : CHUNKS_P;
    f32x16 S[4];
    if (sample) {
        const float* S0 = A->state_delta + ((size_t)(b * 4 + h) * 128) * 128 + dv;
#pragma unroll
        for (int kb = 0; kb < 4; ++kb)
#pragma unroll
            for (int reg = 0; reg < 16; ++reg) S[kb][reg] = S0[(size_t)(32 * kb + crow16(reg, hh)) * 128];
    } else {
#pragma unroll
        for (int kb = 0; kb < 4; ++kb)
#pragma unroll
            for (int reg = 0; reg < 16; ++reg) S[kb][reg] = 0.f;
    }
    bf16* OBR = (bf16*)((unsigned char*)A->out + DO_OB);
#pragma unroll 1
    for (int c = 0; c < nch; ++c) {
        const int item = sample ? N_ITEMS_P + sidx : seq * CHUNKS_P + c;
        const unsigned char* slot = slot_ptr(A, item);
        const float gcl = wait_item(item_granule(A, item), ep);
        __builtin_amdgcn_fence(__ATOMIC_ACQUIRE, "agent");
        const bf16x8* bek = (const bf16x8*)(slot + SL_BEK) + lane; const bf16x8* tp = (const bf16x8*)(slot + SL_T) + lane;
        const bf16x8* qe = (const bf16x8*)(slot + SL_QE) + lane; const bf16x8* qkd = (const bf16x8*)(slot + SL_QKD) + lane; const bf16x8* kwt = (const bf16x8*)(slot + SL_KWT) + lane;
        bf16x8 sf[8];
#pragma unroll
        for (int kb = 0; kb < 4; ++kb) { sf[2 * kb] = pack_step<0>(S[kb]); sf[2 * kb + 1] = pack_step<1>(S[kb]); }
        f32x16 x0, x1;
#pragma unroll
        for (int e = 0; e < 16; ++e) { x0[e] = 0.f; x1[e] = 0.f; }
#pragma unroll
        for (int ks = 0; ks < 8; ++ks) { x0 = MFMA32(bek[ks * 64], sf[ks], x0); x1 = MFMA32(bek[(8 + ks) * 64], sf[ks], x1); }
        {
            const u32x4* bv = (const u32x4*)(slot + SL_BV) + ((w * 2) * 64 + lane) * 2;
            const u32x4 a0 = bv[0], a1 = bv[1], c0 = bv[128], c1 = bv[129];
            x0[0] = bflo(a0.x) - x0[0]; x0[1] = bfhi(a0.x) - x0[1]; x0[2] = bflo(a0.y) - x0[2]; x0[3] = bfhi(a0.y) - x0[3];
            x0[4] = bflo(a0.z) - x0[4]; x0[5] = bfhi(a0.z) - x0[5]; x0[6] = bflo(a0.w) - x0[6]; x0[7] = bfhi(a0.w) - x0[7];
            x0[8] = bflo(a1.x) - x0[8]; x0[9] = bfhi(a1.x) - x0[9]; x0[10] = bflo(a1.y) - x0[10]; x0[11] = bfhi(a1.y) - x0[11];
            x0[12] = bflo(a1.z) - x0[12]; x0[13] = bfhi(a1.z) - x0[13]; x0[14] = bflo(a1.w) - x0[14]; x0[15] = bfhi(a1.w) - x0[15];
            x1[0] = bflo(c0.x) - x1[0]; x1[1] = bfhi(c0.x) - x1[1]; x1[2] = bflo(c0.y) - x1[2]; x1[3] = bfhi(c0.y) - x1[3];
            x1[4] = bflo(c0.z) - x1[4]; x1[5] = bfhi(c0.z) - x1[5]; x1[6] = bflo(c0.w) - x1[6]; x1[7] = bfhi(c0.w) - x1[7];
            x1[8] = bflo(c1.x) - x1[8]; x1[9] = bfhi(c1.x) - x1[9]; x1[10] = bflo(c1.y) - x1[10]; x1[11] = bfhi(c1.y) - x1[11];
            x1[12] = bflo(c1.z) - x1[12]; x1[13] = bfhi(c1.z) - x1[13]; x1[14] = bflo(c1.w) - x1[14]; x1[15] = bfhi(c1.w) - x1[15];
        }
        bf16x8 rf[4] = {pack_step<0>(x0), pack_step<1>(x0), pack_step<0>(x1), pack_step<1>(x1)};
        f32x16 u0, u1;
#pragma unroll
        for (int e = 0; e < 16; ++e) { u0[e] = 0.f; u1[e] = 0.f; }
        u0 = MFMA32(tp[0 * 64], rf[0], u0); u0 = MFMA32(tp[1 * 64], rf[1], u0);
#pragma unroll
        for (int ks = 0; ks < 4; ++ks) u1 = MFMA32(tp[(4 + ks) * 64], rf[ks], u1);
        bf16x8 uf[4] = {pack_step<0>(u0), pack_step<1>(u0), pack_step<0>(u1), pack_step<1>(u1)};
        if (sample || c > 0) {
#pragma unroll
            for (int e = 0; e < 16; ++e) { x0[e] = 0.f; x1[e] = 0.f; }
#pragma unroll
            for (int ks = 0; ks < 8; ++ks) { x0 = MFMA32(qe[ks * 64], sf[ks], x0); x1 = MFMA32(qe[(8 + ks) * 64], sf[ks], x1); }
            x0 = MFMA32(qkd[0 * 64], uf[0], x0); x0 = MFMA32(qkd[1 * 64], uf[1], x0);
#pragma unroll
            for (int ks = 0; ks < 4; ++ks) x1 = MFMA32(qkd[(4 + ks) * 64], uf[ks], x1);
            const int crow0 = sample ? NBATCH * SEQ + b * TS : b * SEQ + 64 * (c - 1), L = sample ? TS : 64;
#pragma unroll
            for (int reg = 0; reg < 16; ++reg) { const int i0 = crow16(reg, hh), i1 = 32 + i0;
                if (i0 < L) OBR[(size_t)(crow0 + i0) * OAB_PITCH + h * 128 + dv] = f2bf(x0[reg]);
                if (i1 < L) OBR[(size_t)(crow0 + i1) * OAB_PITCH + h * 128 + dv] = f2bf(x1[reg]); }
        }
#pragma unroll
        for (int kb = 0; kb < 4; ++kb) {
            S[kb] = S[kb] * gcl;
#pragma unroll
            for (int ks = 0; ks < 4; ++ks) S[kb] = MFMA32(kwt[(kb * 4 + ks) * 64], uf[ks], S[kb]);
        }
    }
    float* So = A->out + (sample ? O_DS : O_DP) + ((size_t)(b * 4 + h) * 128) * 128 + dv;
#pragma unroll
    for (int kb = 0; kb < 4; ++kb)
#pragma unroll
        for (int reg = 0; reg < 16; ++reg) So[(size_t)(32 * kb + crow16(reg, hh)) * 128] = S[kb][reg];
}

constexpr int HALF_BYTES = 40960;
DI void scan_prompt_wg(KA A, int seq, LAS unsigned char* lds, unsigned ep) {
    const int tid = tid_opaque(), lane = tid & 63, wave = __builtin_amdgcn_readfirstlane(tid >> 6);
    const int b = seq >> 2, h = seq & 3;
    constexpr int N = 2 * CHUNKS_P;
    if (wave >= 4) {
        const int loff = (wave - 4) * 10240 + lane * 16;
        u32x4 r0[10], r1[10], r2[10], r3[10];
        LAS u32x4* d0 = (LAS u32x4*)(lds + loff); LAS u32x4* d1 = (LAS u32x4*)(lds + HALF_BYTES + loff);
        LAS float* gclw = (LAS float*)(lds + 2 * HALF_BYTES);
        unsigned long long pv;
#define SL_PEEK(c) do { if ((c) < CHUNKS_P) pv = __hip_atomic_load(item_granule(A, seq * CHUNKS_P + (c)), __ATOMIC_RELAXED, __HIP_MEMORY_SCOPE_AGENT); } while (0)
#define SL_POLL(c) do { float g_; if ((unsigned)(pv >> 32) >= ep) { asm volatile("" ::: "memory"); g_ = __uint_as_float((unsigned)__builtin_amdgcn_readfirstlane((int)(unsigned)pv)); } \
            else g_ = wait_item(item_granule(A, seq * CHUNKS_P + (c)), ep); if (wave == 4 && lane == 0) gclw[(c) & 7] = g_; } while (0)
#define SL_ISSUE(h, R) do { const __amdgpu_buffer_rsrc_t rs_ = __builtin_amdgcn_make_buffer_rsrc((void*)slot_ptr(A, seq * CHUNKS_P + ((h) >> 1)), 0, (int)PREP_SLOT, 0x00020000); \
            _Pragma("unroll") for (int q = 0; q < 10; ++q) R[q] = __builtin_bit_cast(u32x4, __builtin_amdgcn_raw_buffer_load_b128(rs_, ((h) & 1) * HALF_BYTES + loff + q * 1024, 0, 16)); } while (0)
#define SL_WRITE(D, R) do { _Pragma("unroll") for (int q = 0; q < 10; ++q) D[q * 64] = R[q]; } while (0)
#define SL_STEP(k, D, R, FIRST) do { if ((k) < N) { \
            if ((k) + 1 < N) SL_WRITE(D, R); \
            LDS_BARRIER(); \
            if ((k) + 5 < N) { if (FIRST) { SL_POLL(((k) + 5) >> 1); SL_PEEK(((k) + 7) >> 1); } SL_ISSUE((k) + 5, R); } } } while (0)
#define SL_STEPU(k, D, R, FIRST) do { SL_WRITE(D, R); LDS_BARRIER(); if (FIRST) { SL_POLL(((k) + 5) >> 1); pv = __hip_atomic_load(item_granule(A, seq * CHUNKS_P + (((k) + 7) >> 1)), __ATOMIC_RELAXED, __HIP_MEMORY_SCOPE_AGENT); } SL_ISSUE((k) + 5, R); } while (0)
        SL_PEEK(0); SL_POLL(0); SL_ISSUE(0, r0); SL_ISSUE(1, r1);
        SL_PEEK(1); SL_POLL(1); SL_ISSUE(2, r2); SL_ISSUE(3, r3);
        SL_WRITE(d0, r0);
        LDS_BARRIER();
        SL_PEEK(2); SL_POLL(2); SL_PEEK(3); SL_ISSUE(4, r0);
#pragma unroll
        for (int k = 0; k < N; k += 4) {
            SL_STEP(k, d1, r1, false);
            SL_STEP(k + 1, d0, r2, true);
            SL_STEP(k + 2, d1, r3, false);
            SL_STEP(k + 3, d0, r0, true);
        }
#undef SL_PEEK
#undef SL_POLL
#undef SL_ISSUE
#undef SL_WRITE
#undef SL_STEP
#undef SL_STEPU
    } else {
        const int w = wave, r = lane & 31, hh = lane >> 5, dv = 32 * w + r;
        f32x16 S[4];
#pragma unroll
        for (int kb = 0; kb < 4; ++kb)
#pragma unroll
            for (int reg = 0; reg < 16; ++reg) S[kb][reg] = 0.f;
        bf16x8 uf[4], kw2[8];
#pragma unroll
        for (int i = 0; i < 4; ++i) uf[i] = (bf16x8){0, 0, 0, 0, 0, 0, 0, 0};
#pragma unroll
        for (int i = 0; i < 8; ++i) kw2[i] = (bf16x8){0, 0, 0, 0, 0, 0, 0, 0};
        float gprev = 1.0f;
        bf16* OBR = (bf16*)((unsigned char*)A->out + DO_OB);
        const LAS float* gclw = (const LAS float*)(lds + 2 * HALF_BYTES);
        const LAS bf16x8* bek = (const LAS bf16x8*)(lds + SL_BEK) + lane; const LAS bf16x8* tp = (const LAS bf16x8*)(lds + SL_T) + lane;
        const LAS u32x4* bv = (const LAS u32x4*)(lds + SL_BV) + ((w * 2) * 64 + lane) * 2;
        const LAS bf16x8* qkd = (const LAS bf16x8*)(lds + HALF_BYTES + (SL_QKD - HALF_BYTES)) + lane; const LAS bf16x8* qe = (const LAS bf16x8*)(lds + HALF_BYTES + (SL_QE - HALF_BYTES)) + lane;
        const LAS bf16x8* kwt = (const LAS bf16x8*)(lds + HALF_BYTES + (SL_KWT - HALF_BYTES)) + lane;
#define SB() __builtin_amdgcn_sched_barrier(0)
        LDS_BARRIER();
#pragma unroll 1
        for (int c = 0; c < CHUNKS_P; ++c) {
            bf16x8 g0[8], g1[8];
#pragma unroll
            for (int ks = 0; ks < 4; ++ks) { g0[ks] = bek[ks * 64]; g0[4 + ks] = bek[(8 + ks) * 64]; }
            SB();
#pragma unroll
            for (int kb = 2; kb < 4; ++kb) {
                S[kb] = S[kb] * gprev;
#pragma unroll
                for (int ks = 0; ks < 4; ++ks) S[kb] = MFMA32(kw2[(kb - 2) * 4 + ks], uf[ks], S[kb]);
            }
            bf16x8 sf[8];
#pragma unroll
            for (int kb = 0; kb < 4; ++kb) { sf[2 * kb] = pack_step<0>(S[kb]); sf[2 * kb + 1] = pack_step<1>(S[kb]); }
            SB();
#pragma unroll
            for (int ks = 0; ks < 4; ++ks) { g1[ks] = bek[(4 + ks) * 64]; g1[4 + ks] = bek[(12 + ks) * 64]; }
            SB();
            f32x16 x0, x1;
#pragma unroll
            for (int e = 0; e < 16; ++e) { x0[e] = 0.f; x1[e] = 0.f; }
#pragma unroll
            for (int ks = 0; ks < 4; ++ks) { x0 = MFMA32(g0[ks], sf[ks], x0); x1 = MFMA32(g0[4 + ks], sf[ks], x1); }
            SB();
            const u32x4 a0 = bv[0], a1 = bv[1], c0 = bv[128], c1 = bv[129];
            bf16x8 tf[6];
            tf[0] = tp[0 * 64]; tf[1] = tp[1 * 64];
#pragma unroll
            for (int ks = 0; ks < 4; ++ks) tf[2 + ks] = tp[(4 + ks) * 64];
            SB();
#pragma unroll
            for (int ks = 0; ks < 4; ++ks) { x0 = MFMA32(g1[ks], sf[4 + ks], x0); x1 = MFMA32(g1[4 + ks], sf[4 + ks], x1); }
            {
                x0[0] = bflo(a0.x) - x0[0]; x0[1] = bfhi(a0.x) - x0[1]; x0[2] = bflo(a0.y) - x0[2]; x0[3] = bfhi(a0.y) - x0[3];
                x0[4] = bflo(a0.z) - x0[4]; x0[5] = bfhi(a0.z) - x0[5]; x0[6] = bflo(a0.w) - x0[6]; x0[7] = bfhi(a0.w) - x0[7];
                x0[8] = bflo(a1.x) - x0[8]; x0[9] = bfhi(a1.x) - x0[9]; x0[10] = bflo(a1.y) - x0[10]; x0[11] = bfhi(a1.y) - x0[11];
                x0[12] = bflo(a1.z) - x0[12]; x0[13] = bfhi(a1.z) - x0[13]; x0[14] = bflo(a1.w) - x0[14]; x0[15] = bfhi(a1.w) - x0[15];
                x1[0] = bflo(c0.x) - x1[0]; x1[1] = bfhi(c0.x) - x1[1]; x1[2] = bflo(c0.y) - x1[2]; x1[3] = bfhi(c0.y) - x1[3];
                x1[4] = bflo(c0.z) - x1[4]; x1[5] = bfhi(c0.z) - x1[5]; x1[6] = bflo(c0.w) - x1[6]; x1[7] = bfhi(c0.w) - x1[7];
                x1[8] = bflo(c1.x) - x1[8]; x1[9] = bfhi(c1.x) - x1[9]; x1[10] = bflo(c1.y) - x1[10]; x1[11] = bfhi(c1.y) - x1[11];
                x1[12] = bflo(c1.z) - x1[12]; x1[13] = bfhi(c1.z) - x1[13]; x1[14] = bflo(c1.w) - x1[14]; x1[15] = bfhi(c1.w) - x1[15];
            }
            const bf16x8 rf[4] = {pack_step<0>(x0), pack_step<1>(x0), pack_step<0>(x1), pack_step<1>(x1)};
            LDS_BARRIER();
#pragma unroll
            for (int ks = 0; ks < 4; ++ks) { g0[ks] = qe[ks * 64]; g0[4 + ks] = qe[(8 + ks) * 64]; }
            SB();
            f32x16 u0, u1;
#pragma unroll
            for (int e = 0; e < 16; ++e) { u0[e] = 0.f; u1[e] = 0.f; }
            u0 = MFMA32(tf[0], rf[0], u0); u1 = MFMA32(tf[2], rf[0], u1); u0 = MFMA32(tf[1], rf[1], u0);
#pragma unroll
            for (int ks = 1; ks < 4; ++ks) u1 = MFMA32(tf[2 + ks], rf[ks], u1);
            uf[0] = pack_step<0>(u0); uf[1] = pack_step<1>(u0); uf[2] = pack_step<0>(u1); uf[3] = pack_step<1>(u1);
            SB();
#pragma unroll
            for (int ks = 0; ks < 4; ++ks) { g1[ks] = qe[(4 + ks) * 64]; g1[4 + ks] = qe[(12 + ks) * 64]; }
            SB();
#pragma unroll
            for (int e = 0; e < 16; ++e) { x0[e] = 0.f; x1[e] = 0.f; }
#pragma unroll
            for (int ks = 0; ks < 4; ++ks) { x0 = MFMA32(g0[ks], sf[ks], x0); x1 = MFMA32(g0[4 + ks], sf[ks], x1); }
            SB();
            bf16x8 qk[6];
            qk[0] = qkd[0 * 64]; qk[1] = qkd[1 * 64];
#pragma unroll
            for (int ks = 0; ks < 4; ++ks) qk[2 + ks] = qkd[(4 + ks) * 64];
            SB();
#pragma unroll
            for (int ks = 0; ks < 4; ++ks) { x0 = MFMA32(g1[ks], sf[4 + ks], x0); x1 = MFMA32(g1[4 + ks], sf[4 + ks], x1); }
            SB();
#pragma unroll
            for (int i = 0; i < 8; ++i) g0[i] = kwt[i * 64];
            SB();
            x0 = MFMA32(qk[0], uf[0], x0); x1 = MFMA32(qk[2], uf[0], x1); x0 = MFMA32(qk[1], uf[1], x0);
#pragma unroll
            for (int ks = 1; ks < 4; ++ks) x1 = MFMA32(qk[2 + ks], uf[ks], x1);
            SB();
#pragma unroll
            for (int i = 0; i < 8; ++i) kw2[i] = kwt[(8 + i) * 64];
            const float gcl = gclw[c & 7];
            SB();
#pragma unroll
            for (int kb = 0; kb < 2; ++kb) {
                S[kb] = S[kb] * gcl;
#pragma unroll
                for (int ks = 0; ks < 4; ++ks) S[kb] = MFMA32(g0[kb * 4 + ks], uf[ks], S[kb]);
            }
            if (c > 0) {
                bf16* orow = OBR + (size_t)(b * SEQ + 64 * (c - 1)) * OAB_PITCH + h * 128 + dv;
#pragma unroll
                for (int reg = 0; reg < 16; ++reg) { const int i0 = crow16(reg, hh); orow[(size_t)i0 * OAB_PITCH] = f2bf(x0[reg]); orow[(size_t)(32 + i0) * OAB_PITCH] = f2bf(x1[reg]); }
            }
            gprev = gcl;
            LDS_BARRIER();
        }
#pragma unroll
        for (int kb = 2; kb < 4; ++kb) {
            S[kb] = S[kb] * gprev;
#pragma unroll
            for (int ks = 0; ks < 4; ++ks) S[kb] = MFMA32(kw2[(kb - 2) * 4 + ks], uf[ks], S[kb]);
        }
#undef SB
        float* So = A->out + O_DP + ((size_t)(b * 4 + h) * 128) * 128 + dv;
#pragma unroll
        for (int kb = 0; kb < 4; ++kb)
#pragma unroll
            for (int reg = 0; reg < 16; ++reg) So[(size_t)(32 * kb + crow16(reg, hh)) * 128] = S[kb][reg];
    }
}

constexpr int KPITCH = 72, VPITCH = 264;
typedef short v4i16_t __attribute__((ext_vector_type(4)));
DI void attn_unit(KA A, int unit, LAS unsigned char* ldsb) {
    const int tid = tid_opaque(), lane = tid & 63, wave = __builtin_amdgcn_readfirstlane(tid >> 6), r = lane & 31, hh = lane >> 5;
    const int b = unit >> 6, kh = (unit >> 5) & 1, jb = unit & 31, T0 = NMETA + 128 * jb;
    LAS bf16* Ksm = (LAS bf16*)ldsb; LAS bf16* VTs = Ksm + 256 * KPITCH;
    const bf16* KVg = (const bf16*)(A->ws + WS_KV); const bf16* QAg = (const bf16*)(A->ws + WS_QA);
#pragma unroll
    for (int e4 = 0; e4 < 4; ++e4) {
        const int id = tid + 512 * e4, key = id >> 3, cch = id & 7, tk = T0 - 128 + key;
        u32x4 kq = (u32x4){0u, 0u, 0u, 0u}, vq = kq;
        if (tk >= 0) { const bf16* src = KVg + (size_t)(b * TP + tk) * 256 + kh * 64 + 8 * cch; kq = *(const u32x4*)src; vq = *(const u32x4*)(src + 128); }
        *(LAS u32x4*)(Ksm + key * KPITCH + 8 * cch) = kq;
        *(LAS u32x4*)(VTs + key * KPITCH + 8 * cch) = vq;
    }
    LDS_BARRIER();
    const int g = wave >> 1, qh = wave & 1, head = 4 * kh + g;
    const float sink2 = A->sinks[head] * 1.4426950408889634f;
    const int kmin = jb == 0 ? 128 - NMETA : 0;
#pragma unroll 1
    for (int q2 = 0; q2 < 2; ++q2) {
        const int qb = 2 * qh + q2, iq = 32 * qb + r;
        const bf16* qrow = QAg + (size_t)(b * TP + T0 + iq) * 512 + head * 64 + 8 * hh;
        bf16x8 qf[4];
#pragma unroll
        for (int s = 0; s < 4; ++s) qf[s] = *(const bf16x8*)(qrow + 16 * s);
        f32x16 st[5];
        float m = sink2;
#pragma unroll
        for (int kt5 = 0; kt5 < 5; ++kt5) {
            const int kt = qb + kt5;
            f32x16 acc;
#pragma unroll
            for (int e = 0; e < 16; ++e) acc[e] = 0.f;
#pragma unroll
            for (int s = 0; s < 4; ++s) acc = MFMA32(*(const LAS bf16x8*)(Ksm + (32 * kt + r) * KPITCH + 16 * s + 8 * hh), qf[s], acc);
#pragma unroll
            for (int reg = 0; reg < 16; ++reg) { const int kk = 32 * kt + crow16(reg, hh); const bool ok = kk >= iq && kk <= iq + 128 && kk >= kmin;
                acc[reg] = ok ? acc[reg] : -INFINITY; m = fmaxf(m, acc[reg]); }
            st[kt5] = acc;
        }
        m = fmaxf(m, __shfl_xor(m, 32));
        float l = 0.f;
#pragma unroll
        for (int kt5 = 0; kt5 < 5; ++kt5)
#pragma unroll
            for (int reg = 0; reg < 16; ++reg) { const float p = exp2f(st[kt5][reg] - m); st[kt5][reg] = p; l += p; }
        l += __shfl_xor(l, 32); l += exp2f(sink2 - m);
        f32x16 o0, o1;
#pragma unroll
        for (int e = 0; e < 16; ++e) { o0[e] = 0.f; o1[e] = 0.f; }
#pragma unroll
        for (int kt5 = 0; kt5 < 5; ++kt5) {
            const int kt = qb + kt5;
            const bf16x8 p0 = pack_step<0>(st[kt5]), p1 = pack_step<1>(st[kt5]);
            const LAS bf16* vb = VTs + (32 * kt + 4 * hh + ((lane & 15) >> 2)) * KPITCH + 16 * ((lane >> 4) & 1) + 4 * (lane & 3);
#define VTR(ptr) __builtin_amdgcn_ds_read_tr16_b64_v4i16((LAS v4i16_t*)(ptr))
            const v4i16_t a00 = VTR(vb), a01 = VTR(vb + 8 * KPITCH), a10 = VTR(vb + 16 * KPITCH), a11 = VTR(vb + 24 * KPITCH);
            const v4i16_t b00 = VTR(vb + 32), b01 = VTR(vb + 8 * KPITCH + 32), b10 = VTR(vb + 16 * KPITCH + 32), b11 = VTR(vb + 24 * KPITCH + 32);
#undef VTR
            o0 = MFMA32(__builtin_shufflevector(a00, a01, 0, 1, 2, 3, 4, 5, 6, 7), p0, o0); o0 = MFMA32(__builtin_shufflevector(a10, a11, 0, 1, 2, 3, 4, 5, 6, 7), p1, o0);
            o1 = MFMA32(__builtin_shufflevector(b00, b01, 0, 1, 2, 3, 4, 5, 6, 7), p0, o1); o1 = MFMA32(__builtin_shufflevector(b10, b11, 0, 1, 2, 3, 4, 5, 6, 7), p1, o1);
        }
        const float rl = 1.0f / l;
        bf16* orow = (bf16*)((unsigned char*)A->out + DO_OA) + (size_t)(b * SEQ + 128 * jb + iq) * OAB_PITCH + head * 64 + 4 * hh;
#pragma unroll
        for (int g4 = 0; g4 < 4; ++g4) {
            *(u32x2*)(orow + 8 * g4) = (u32x2){cvtpk(o0[4 * g4] * rl, o0[4 * g4 + 1] * rl), cvtpk(o0[4 * g4 + 2] * rl, o0[4 * g4 + 3] * rl)};
            *(u32x2*)(orow + 32 + 8 * g4) = (u32x2){cvtpk(o1[4 * g4] * rl, o1[4 * g4 + 1] * rl), cvtpk(o1[4 * g4 + 2] * rl, o1[4 * g4 + 3] * rl)};
        }
    }
    LDS_BARRIER();
}
DI void sample_attn(KA A, int b, int head, LAS float* wl, int lane) {
    const int kh = head >> 2;
    LAS float* qn = wl; LAS float* ps = wl + 256;
    const bf16* QAg = (const bf16*)(A->ws + WS_QA); const bf16* KVg = (const bf16*)(A->ws + WS_KV);
    u32x4 nk[8];
    { const u32x4* kn = (const u32x4*)(KVg + (size_t)(MP + b * TS + (lane & 3)) * 256 + kh * 64);
#pragma unroll
      for (int i = 0; i < 8; ++i) nk[i] = kn[i]; }
#pragma unroll
    for (int i = 0; i < 4; ++i) qn[i * 64 + lane] = bf2f(QAg[(size_t)(MP + b * TS + i) * 512 + head * 64 + pos_of_d(lane)]);
    const float sink2 = A->sinks[head] * 1.4426950408889634f;
    LDS_WAIT(); asm volatile("" ::: "memory");
    float s0[4] = {0.f, 0.f, 0.f, 0.f}, s1[4] = {0.f, 0.f, 0.f, 0.f}, s2[4] = {0.f, 0.f, 0.f, 0.f};
    const f32x4* kr0 = (const f32x4*)(A->cache_k + ((size_t)(b * 128 + lane) * 2 + kh) * 64);
#pragma unroll 1
    for (int c = 0; c < 2; ++c) {
        f32x4 k0[8], k1[8];
#pragma unroll
        for (int d = 0; d < 8; ++d) { k0[d] = kr0[8 * c + d]; k1[d] = kr0[8 * c + d + 64 * 2 * 16]; }
#pragma unroll
        for (int d = 0; d < 8; ++d) {
#pragma unroll
            for (int i = 0; i < 4; ++i) { const f32x4 q = *(const LAS f32x4*)(qn + i * 64 + 32 * c + 4 * d);
                s0[i] = __builtin_fmaf(k0[d][3], q[3], __builtin_fmaf(k0[d][2], q[2], __builtin_fmaf(k0[d][1], q[1], __builtin_fmaf(k0[d][0], q[0], s0[i]))));
                s1[i] = __builtin_fmaf(k1[d][3], q[3], __builtin_fmaf(k1[d][2], q[2], __builtin_fmaf(k1[d][1], q[1], __builtin_fmaf(k1[d][0], q[0], s1[i])))); }
        }
        asm volatile("" : "+v"(s0[0]), "+v"(s0[1]), "+v"(s0[2]), "+v"(s0[3]), "+v"(s1[0]), "+v"(s1[1]), "+v"(s1[2]), "+v"(s1[3]));
    }
#pragma unroll
    for (int g8 = 0; g8 < 8; ++g8) {
        const float e0 = bflo(nk[g8].x), e1 = bfhi(nk[g8].x), e2 = bflo(nk[g8].y), e3 = bfhi(nk[g8].y), e4 = bflo(nk[g8].z), e5 = bfhi(nk[g8].z), e6 = bflo(nk[g8].w), e7 = bfhi(nk[g8].w);
#pragma unroll
        for (int i = 0; i < 4; ++i) { const f32x4 qa = *(const LAS f32x4*)(qn + i * 64 + 4 * g8), qb = *(const LAS f32x4*)(qn + i * 64 + 32 + 4 * g8);
            s2[i] = __builtin_fmaf(e3, qa[3], __builtin_fmaf(e2, qa[2], __builtin_fmaf(e1, qa[1], __builtin_fmaf(e0, qa[0], s2[i]))));
            s2[i] = __builtin_fmaf(e7, qb[3], __builtin_fmaf(e6, qb[2], __builtin_fmaf(e5, qb[1], __builtin_fmaf(e4, qb[0], s2[i])))); }
        asm volatile("" : "+v"(s2[0]), "+v"(s2[1]), "+v"(s2[2]), "+v"(s2[3]));
    }
#pragma unroll
    for (int i = 0; i < 4; ++i) { ps[i * 132 + lane] = lane >= i ? s0[i] : -INFINITY; ps[i * 132 + 64 + lane] = s1[i]; if (lane < 4) ps[i * 132 + 128 + lane] = lane <= i ? s2[i] : -INFINITY; }
    const int kg = lane >> 4, d4l = lane & 15;
    const u32x2 vn = *(const u32x2*)(KVg + (size_t)(MP + b * TS + kg) * 256 + 128 + kh * 64 + 4 * d4l);
    LDS_WAIT(); asm volatile("" ::: "memory");
    float linv[4];
#pragma unroll
    for (int i = 0; i < 4; ++i) {
        const float t0 = ps[i * 132 + lane], t1 = ps[i * 132 + 64 + lane], t2 = lane < 4 ? ps[i * 132 + 128 + lane] : -INFINITY;
        const float m = wave_max(fmaxf(fmaxf(t0, t1), fmaxf(t2, sink2)));
        const float p0 = exp2f(t0 - m), p1 = exp2f(t1 - m), p2 = exp2f(t2 - m);
        ps[i * 132 + lane] = p0; ps[i * 132 + 64 + lane] = p1; if (lane < 4) ps[i * 132 + 128 + lane] = p2;
        linv[i] = 1.0f / (wave_sum(p0 + p1 + p2) + exp2f(sink2 - m));
    }
    LDS_WAIT(); asm volatile("" ::: "memory");
    f32x4 o[4];
#pragma unroll
    for (int i = 0; i < 4; ++i) { const float pn = ps[i * 132 + 128 + kg]; o[i] = (f32x4){bflo(vn.x) * pn, bfhi(vn.x) * pn, bflo(vn.y) * pn, bfhi(vn.y) * pn}; }
    const float* vb = A->cache_v + ((size_t)(b * 128 + kg) * 2 + kh) * 64 + 4 * d4l;
#pragma unroll 1
    for (int c = 0; c < 2; ++c) {
        f32x4 vv[16];
#pragma unroll
        for (int j = 0; j < 16; ++j) vv[j] = *(const f32x4*)(vb + (size_t)(16 * c + j) * 4 * 128);
#pragma unroll
        for (int j = 0; j < 16; ++j)
#pragma unroll
            for (int i = 0; i < 4; ++i) { const float pj = ps[i * 132 + 64 * c + 4 * j + kg]; o[i] += vv[j] * pj; }
        asm volatile("" : "+v"(o[0]), "+v"(o[1]), "+v"(o[2]), "+v"(o[3]));
    }
    bf16* OAg = (bf16*)((unsigned char*)A->out + DO_OA);
#pragma unroll
    for (int i = 0; i < 4; ++i) {
#pragma unroll
        for (int e = 0; e < 4; ++e) { float t = o[i][e]; t += __shfl_xor(t, 16); t += __shfl_xor(t, 32); o[i][e] = t * linv[i]; }
        if (lane < 16) *(u32x2*)(OAg + (size_t)(NBATCH * SEQ + b * TS + i) * OAB_PITCH + head * 64 + 4 * d4l) = (u32x2){cvtpk(o[i][0], o[i][1]), cvtpk(o[i][2], o[i][3])};
    }
    LDS_WAIT(); asm volatile("" ::: "memory");
}
DI void sample_delta(KA A, int b, int h, int quarter, LAS float* wl, int lane) {
    const bf16* QKVB = (const bf16*)(A->ws + WS_QKVB);
    LAS float* qs = wl; LAS float* ks = wl + 512;
    const int dv = 32 * quarter + (lane >> 1), part = lane & 1;
    f32x2 gb[4];
#pragma unroll
    for (int t = 0; t < 4; ++t) gb[t] = ((const f32x2*)(A->ws + WS_GB))[(size_t)(MP + b * TS + t) * 4 + h];
    float xw[5][7], ww[5][4];
#pragma unroll
    for (int cidx = 0; cidx < 5; ++cidx) {
        const int ch = cidx < 4 ? (cidx >> 1) * 512 + h * 128 + lane + 64 * (cidx & 1) : 1024 + h * 128 + dv;
#pragma unroll
        for (int i = 0; i < 3; ++i) xw[cidx][i] = A->state_conv[((size_t)b * 3 + i) * CONVD + ch];
#pragma unroll
        for (int t = 0; t < 4; ++t) xw[cidx][3 + t] = bf2f(QKVB[(size_t)(MP + b * TS + t) * CONVD + ch]);
#pragma unroll
        for (int i = 0; i < 4; ++i) ww[cidx][i] = A->conv_w[i * CONVD + ch];
    }
    float cv[5][4];
#pragma unroll
    for (int cidx = 0; cidx < 5; ++cidx)
#pragma unroll
        for (int t = 0; t < 4; ++t) cv[cidx][t] = siluf_(ww[cidx][0] * xw[cidx][t] + ww[cidx][1] * xw[cidx][t + 1] + ww[cidx][2] * xw[cidx][t + 2] + ww[cidx][3] * xw[cidx][t + 3]);
    __builtin_amdgcn_sched_barrier(0);
    float s[64];
    { const float* S0 = A->state_delta + ((size_t)(b * 4 + h) * 128 + 64 * part) * 128 + dv;
#pragma unroll
      for (int i = 0; i < 64; ++i) s[i] = S0[(size_t)i * 128]; }
    __builtin_amdgcn_sched_barrier(0);
#pragma unroll
    for (int grp = 0; grp < 2; ++grp) {
        LAS float* dst = grp == 0 ? qs : ks;
#pragma unroll
        for (int t = 0; t < 4; ++t) { const float c0 = cv[2 * grp][t], c1 = cv[2 * grp + 1][t];
            const float rn = rsqrtf(wave_sum(c0 * c0 + c1 * c1) + EPS) * (grp == 0 ? 0.08838834764831845f : 1.0f);
            dst[t * 128 + lane] = c0 * rn; dst[t * 128 + 64 + lane] = c1 * rn; }
    }
    LDS_WAIT(); asm volatile("" ::: "memory");
    bf16* OBR = (bf16*)((unsigned char*)A->out + DO_OB) + (size_t)(NBATCH * SEQ + b * TS) * OAB_PITCH + h * 128 + dv;
#pragma unroll
    for (int t = 0; t < 4; ++t) {
        const float eg = __expf(gb[t][0]);
        const LAS float* kt = ks + t * 128 + 64 * part; const LAS float* qt = qs + t * 128 + 64 * part;
        float ksum = 0.f;
#pragma unroll
        for (int j = 0; j < 16; ++j) { if ((j & 3) == 0) __builtin_amdgcn_sched_barrier(0);
            const f32x4 kk = *(const LAS f32x4*)(kt + 4 * j);
            s[4 * j] *= eg; s[4 * j + 1] *= eg; s[4 * j + 2] *= eg; s[4 * j + 3] *= eg;
            ksum += (s[4 * j] * kk[0] + s[4 * j + 1] * kk[1]) + (s[4 * j + 2] * kk[2] + s[4 * j + 3] * kk[3]); }
        ksum += __shfl_xor(ksum, 1);
        const float u = gb[t][1] * (cv[4][t] - ksum);
        float osum = 0.f;
#pragma unroll
        for (int j = 0; j < 16; ++j) { if ((j & 3) == 0) __builtin_amdgcn_sched_barrier(0);
            const f32x4 kk = *(const LAS f32x4*)(kt + 4 * j), qq = *(const LAS f32x4*)(qt + 4 * j);
            s[4 * j] += kk[0] * u; s[4 * j + 1] += kk[1] * u; s[4 * j + 2] += kk[2] * u; s[4 * j + 3] += kk[3] * u;
            osum += (s[4 * j] * qq[0] + s[4 * j + 1] * qq[1]) + (s[4 * j + 2] * qq[2] + s[4 * j + 3] * qq[3]); }
        osum += __shfl_xor(osum, 1);
        if (part == 0) OBR[(size_t)t * OAB_PITCH] = f2bf(osum);
    }
    { float* So = A->out + O_DS + ((size_t)(b * 4 + h) * 128 + 64 * part) * 128 + dv;
#pragma unroll
      for (int i = 0; i < 64; ++i) So[(size_t)i * 128] = s[i]; }
    LDS_WAIT(); asm volatile("" ::: "memory");
}
constexpr int NINV_WG = 24;
DI void p23_mixers(KA A, LAS unsigned char* lds, const XcdBarrier& dbg_bar, unsigned ep, int pmode = 0) {
    const int tid = tid_opaque(), lane = tid & 63, wave = __builtin_amdgcn_readfirstlane(tid >> 6), G = gridDim.x, wg = blockIdx.x;
    const int NSCAN = N_PROMPT_SEQ, NP = G - NSCAN - NINV_WG;
    LAS float* wl = (LAS float*)(lds + 98304 + wave * 4096);
    if (wg < NSCAN) { if (!(pmode & 2)) scan_prompt_wg(A, wg, lds, ep); }
    else if (wg < NSCAN + NINV_WG) {
        const int wv = (wg - NSCAN) * NWAVES + wave, NWV = NINV_WG * NWAVES;
#pragma unroll 1
        for (int m = wv; m < N_ITEMS; m += NWV) {
            const int item = order_item(m), p = m % NP, k = m / NP;
            const float gcl = wait_item(item_flag1(A, item), ep);
            __builtin_amdgcn_fence(__ATOMIC_ACQUIRE, "agent");
            const float* ats = (const float*)((const unsigned char*)A->out + DO_ATS + ((size_t)p * 8 + (k & 7)) * ATS_ITEM);
            if (pmode & 16) { if (lane == 0) __hip_atomic_store(item_granule(A, item), ((unsigned long long)ep << 32) | (unsigned long long)__float_as_uint(gcl), __ATOMIC_RELAXED, __HIP_MEMORY_SCOPE_AGENT); }
            else prep_stage2(A, item, gcl, ats, (LAS float*)(lds + wave * 16384), ep);
        }
        wl = (LAS float*)(lds + wave * 16384);
    } else {
        const int p = wg - NSCAN - NINV_WG;
        if (pmode & 32) {
            for (int m = p * NTHREADS + tid; m < N_ITEMS; m += NP * NTHREADS) { gu64* f = item_flag1(A, order_item(m));
                const unsigned long long o = __hip_atomic_load(f, __ATOMIC_RELAXED, __HIP_MEMORY_SCOPE_AGENT);
                __hip_atomic_store(f, ((unsigned long long)ep << 32) | (o & 0xffffffffull), __ATOMIC_RELAXED, __HIP_MEMORY_SCOPE_AGENT); }
        } else {
            const int ntot = p < N_ITEMS ? (N_ITEMS - 1 - p) / NP + 1 : 0;
            S1Pre P;
            if (ntot > 0) stage1_issue(A, order_item(p), P);
            int prev = -1;
#pragma unroll 1
            for (int k = 0; k < ntot; ++k) {
                const int m = p + NP * k, item = order_item(m), nxt = k + 1 < ntot ? order_item(m + NP) : N_ITEMS;
                float* ats = (float*)((unsigned char*)A->out + DO_ATS + ((size_t)p * 8 + (k & 7)) * ATS_ITEM);
                prep_stage1(A, item, nxt, prev, k >= 8 ? order_item(m - 8 * NP) : -1, k & 1, ats, P, lds, ep, pmode);
                prev = item;
            }
            asm volatile("s_waitcnt vmcnt(0)" ::: "memory"); __syncthreads();
            if (prev >= 0 && tid == 0) __hip_atomic_store(item_flag1(A, prev), ((unsigned long long)ep << 32) | (unsigned long long)__float_as_uint(((const LAS float*)(lds + LDS_GCL))[(ntot - 1) & 1]), __ATOMIC_RELAXED, __HIP_MEMORY_SCOPE_AGENT);
        }
        if (pmode & 1) return;
        if (!(pmode & 128)) {
            constexpr int NU = NBATCH * NKV * 32;
            const int R = NU / NP, extra = NU - R * NP, nlong = N_ITEMS % NP, first = nlong < NP - extra ? nlong : NP - extra;
            for (int rnd = 0; rnd < R; ++rnd) attn_unit(A, rnd * NP + p, lds);
            if (p >= first && p < first + extra) attn_unit(A, R * NP + (p - first), lds);
        }
    }
    if (pmode & (1 | 64)) return;
    if (wg < NSCAN + NINV_WG) return;
    { const int p = wg - NSCAN - NINV_WG, worker = p * NWAVES + wave, NW = NP * NWAVES;
      for (int it = worker; it < SBATCH * NHB * 4 + SBATCH * NHA; it += NW) {
        int ln = lane; asm volatile("" : "+v"(ln));
        if (it < SBATCH * NHB * 4) sample_delta(A, it >> 4, (it >> 2) & 3, it & 3, wl, ln);
        else { const int q = it - SBATCH * NHB * 4; sample_attn(A, q >> 3, q & 7, wl, ln); }
      } }
}

DI void p3b_gated_norm(KA A) {
    const int tid = tid_opaque(), lane = tid & 63, wave = tid >> 6, gw = blockIdx.x * NWAVES + wave, NGW = gridDim.x * NWAVES;
    const int head = lane >> 4, dv0 = 8 * (lane & 15);
    const f32x4 w0 = *(const f32x4*)(A->gdn_norm + dv0), w1 = *(const f32x4*)(A->gdn_norm + dv0 + 4);
    bf16* OBg = (bf16*)((unsigned char*)A->out + DO_OB); const bf16* Zg = (const bf16*)(A->ws + WS_Z);
    for (int crow = gw; crow < MC; crow += NGW) {
        const u32x4 ow = *(const u32x4*)(OBg + (size_t)crow * OAB_PITCH + head * 128 + dv0);
        const f32x4 a = {bflo(ow.x), bfhi(ow.x), bflo(ow.y), bfhi(ow.y)}, c = {bflo(ow.z), bfhi(ow.z), bflo(ow.w), bfhi(ow.w)};
        float ss = (a[0] * a[0] + a[1] * a[1]) + (a[2] * a[2] + a[3] * a[3]) + (c[0] * c[0] + c[1] * c[1]) + (c[2] * c[2] + c[3] * c[3]);
        ss += __shfl_xor(ss, 1); ss += __shfl_xor(ss, 2); ss += __shfl_xor(ss, 4); ss += __shfl_xor(ss, 8);
        const float rstd = rsqrtf(ss * (1.0f / 128.0f) + EPS);
        const u32x4 zw = *(const u32x4*)(Zg + (size_t)pg8::crow_to_urow(crow) * 512 + head * 128 + dv0);
        f32x4 y0, y1;
        y0[0] = a[0] * rstd * w0[0] * siluf_(bflo(zw.x)); y0[1] = a[1] * rstd * w0[1] * siluf_(bfhi(zw.x)); y0[2] = a[2] * rstd * w0[2] * siluf_(bflo(zw.y)); y0[3] = a[3] * rstd * w0[3] * siluf_(bfhi(zw.y));
        y1[0] = c[0] * rstd * w1[0] * siluf_(bflo(zw.z)); y1[1] = c[1] * rstd * w1[1] * siluf_(bfhi(zw.z)); y1[2] = c[2] * rstd * w1[2] * siluf_(bflo(zw.w)); y1[3] = c[3] * rstd * w1[3] * siluf_(bfhi(zw.w));
        *(u32x4*)(OBg + (size_t)crow * OAB_PITCH + head * 128 + dv0) = pack8f(y0, y1);
    }
}
DI void p8_final_norm(KA A) {
    const int tid = tid_opaque(), lane = tid & 63, wave = tid >> 6, gw = blockIdx.x * NWAVES + wave, NGW = gridDim.x * NWAVES;
    f32x4 nf[4];
#pragma unroll
    for (int j = 0; j < 4; ++j) nf[j] = ((const f32x4*)A->norm_final)[lane + 64 * j];
    const bf16* H2 = (const bf16*)(A->ws + WS_MB);
    for (int crow = gw; crow < MC; crow += NGW) {
        const u32x2* hrow = (const u32x2*)(H2 + (size_t)crow * D);
        f32x4* row = (f32x4*)(A->out + (size_t)crow * D);
        f32x4 v[4]; float ss = 0.f;
#pragma unroll
        for (int j = 0; j < 4; ++j) { const u32x2 hw = hrow[lane + 64 * j]; v[j] = (f32x4){bflo(hw.x), bfhi(hw.x), bflo(hw.y), bfhi(hw.y)};
            ss += (v[j][0] * v[j][0] + v[j][1] * v[j][1]) + (v[j][2] * v[j][2] + v[j][3] * v[j][3]); }
        const float rstd = rsqrtf(wave_sum(ss) * (1.0f / D) + EPS);
#pragma unroll
        for (int j = 0; j < 4; ++j) row[lane + 64 * j] = v[j] * rstd * nf[j];
    }
}
__global__ void __launch_bounds__(NTHREADS, 2) hybrid_fwd(Args Aval) {
    extern __shared__ __attribute__((aligned(16))) unsigned char lds_raw[];
    LAS unsigned char* lds = (LAS unsigned char*)lds_raw;
    const int tid = threadIdx.x;
    int lo, hi; { KA A0 = kargs(); lo = A0->ph_lo; hi = A0->ph_hi; }
#if MK_N_LAUNCHES == 1
#if MK_BARRIER == 1
    volatile LAS unsigned* MISC = (volatile LAS unsigned*)(lds + LDS_MISC);
    if (tid < 64) MISC[tid] = 0u;
    __syncthreads();
    XcdBarrier bar; { KA A0 = kargs(); bar = xcd_barrier_post((unsigned*)(A0->ws + WS_CTL) + 4096, MISC + 8); }
#define GRID_BAR() xcd_barrier(bar)
#else
    cg::grid_group grid = cg::this_grid();
#define GRID_BAR() grid.sync()
#endif
#else
#define GRID_BAR() do {} while (0)
#endif
#ifndef PH_MASK
#define PH_MASK 0x1ff
#endif
#define IN(k) (((PH_MASK >> (k)) & 1) && lo <= (k) && (k) < hi)
#ifndef PROBE_REP
#define PROBE_REP -1
#endif
#define NREP(k) (PROBE_REP == (k) ? 2 : 1)
#define SEAM(k) do { if (IN(k) && IN((k) + 1)) GRID_BAR(); } while (0)
    const int G = gridDim.x, wgid = blockIdx.x;
#if PROBE_REP == 0
    if (IN(0)) { KA A = kargs(); p0_prologue(A, lds); __syncthreads(); }
#endif
    if (IN(0)) { KA A = kargs(); p0_prologue(A, lds); } SEAM(0);
    if (IN(1)) for (int rep = 0; rep < NREP(1); ++rep) { KA A = kargs(); unsigned char* ws = A->ws;
        pg8::Gemm g{(const bf16*)(ws + WS_XN), (const bf16*)(ws + WS_WIN), MUP, NIN, D}; pg8::StaticOrder S; S.init(MUP, NIN, G, wgid);
        pg8::EpiInProj E{(bf16*)(ws + WS_QA), (bf16*)(ws + WS_KV), (bf16*)(ws + WS_QKVB), (bf16*)(ws + WS_Z), (bf16*)(ws + WS_G),
                         (const float*)(ws + WS_ROPE), (const float*)(ws + WS_ROPE) + (TP + TS) * 32, A->out};
        pg8::gemm_phase<pg8::EpiInProj, pg8::StaticOrder, true, true>(lds, g, S, E);
    } SEAM(1);
#ifndef PROBE_MODE
#define PROBE_MODE 0
#endif
#if PROBE_REP == 2
    if (IN(2)) { KA A = kargs(); p23_mixers(A, lds, bar, 1u); GRID_BAR(); }
    if (IN(2)) { KA A = kargs(); p23_mixers(A, lds, bar, 2u, PROBE_MODE); } SEAM(2);
#else
    if (IN(2)) { KA A = kargs(); p23_mixers(A, lds, bar, 1u); } SEAM(2);
#endif
    if (IN(3)) for (int rep = 0; rep < NREP(3); ++rep) { KA A = kargs(); p3b_gated_norm(A); } SEAM(3);
    if (IN(4)) for (int rep = 0; rep < NREP(4); ++rep) { KA A = kargs(); unsigned char* ws = A->ws;
        const bf16* OABp = (const bf16*)((unsigned char*)A->out + DO_OA); const bf16* Wm = (const bf16*)(ws + WS_WOA);
        { pg8::Gemm g{OABp, Wm, MC, D, 512, 1024}; pg8::StaticOrder S; S.init(MC, D, G, wgid); S.lim = (S.nwg / G) * G;
          pg8::EpiMerge<false> E{(bf16*)(ws + WS_MB), (const bf16*)(ws + WS_G), 0};
          pg8::gemm_phase<pg8::EpiMerge<false>, pg8::StaticOrder, true, true>(lds, g, S, E); }
        asm volatile("s_waitcnt vmcnt(0)" ::: "memory"); __syncthreads();
        { pg8::Gemm g{OABp + 512, Wm + 512, MC, D, 512, 1024}; pg8::StaticOrder S; S.init(MC, D, G, wgid); S.lim = (S.nwg / G) * G;
          pg8::EpiMerge<true> E{(bf16*)(ws + WS_MB), (const bf16*)(ws + WS_G), 1024};
          pg8::gemm_phase<pg8::EpiMerge<true>, pg8::StaticOrder, true, true>(lds, g, S, E); }
        { const int nstr = (MC / 256) * 4 - ((MC / 256) * 4 / G) * G;
          if (wgid < nstr * 4) { const int t = wgid >> 2, sl = wgid & 3, koff = sl * 256;
            pg8::Gemm g{OABp + koff, Wm + koff, MC, D, 256, 1024};
            pg8::SliceOrder S; S.init_slice(MC, D, G, ((MC / 256) * 4 / G) * G, t);
            pg8::EpiSplit<pg8::EpiStoreMB, true> E{pg8::EpiStoreMB{(bf16*)(ws + WS_MB)}, (float*)(ws + WS_SCR) + (size_t)t * 65536, (unsigned*)(ws + WS_CTL + CTL_SPL) + t * 8, 4u, (const bf16*)(ws + WS_G), (sl >> 1) ? 1024 : 0};
            pg8::gemm_phase<pg8::EpiSplit<pg8::EpiStoreMB, true>, pg8::SliceOrder, true, true>(lds, g, S, E); } }
    } SEAM(4);
    if (IN(5)) { KA A = kargs(); unsigned char* ws = A->ws;
        { pg8::Gemm g{(const bf16*)(ws + WS_MB), (const bf16*)(ws + WS_WOUT), MC, D, D}; pg8::StaticOrder S; S.init(MC, D, G, wgid); S.lim = (S.nwg / G) * G;
          pg8::EpiWout<true> E{A->x_prompt, A->x_sample, (bf16*)(ws + WS_HB1), (float*)(ws + WS_CTL + CTL_SS1)};
          pg8::gemm_phase<pg8::EpiWout<true>, pg8::StaticOrder, true, true>(lds, g, S, E); }
        { const int nstr = (MC / 256) * 4 - ((MC / 256) * 4 / G) * G;
          if (wgid < nstr * 4) { const int t = wgid >> 2, koff = (wgid & 3) * 256;
            pg8::Gemm g{(const bf16*)(ws + WS_MB) + koff, (const bf16*)(ws + WS_WOUT) + koff, MC, D, 256, D};
            pg8::SliceOrder S; S.init_slice(MC, D, G, ((MC / 256) * 4 / G) * G, t);
            pg8::EpiSplit<pg8::EpiWout<true>, false> E{pg8::EpiWout<true>{A->x_prompt, A->x_sample, (bf16*)(ws + WS_HB1), (float*)(ws + WS_CTL + CTL_SS1)}, (float*)(ws + WS_SCR) + (size_t)t * 65536, (unsigned*)(ws + WS_CTL + CTL_SPL) + t * 8, 4u, nullptr, 0};
            pg8::gemm_phase<pg8::EpiSplit<pg8::EpiWout<true>, false>, pg8::SliceOrder, true, true>(lds, g, S, E); } }
    } SEAM(5);
    if (IN(6)) for (int rep = 0; rep < NREP(6); ++rep) { KA A = kargs(); unsigned char* ws = A->ws;
        pg8::Gemm g{(const bf16*)(ws + WS_HB1), (const bf16*)(ws + WS_WGU), MC, 2 * DFF, D}; pg8::StaticOrder S; S.init(MC, 2 * DFF, G, wgid);
        pg8::EpiGateUp E{(bf16*)(ws + WS_ACT), (const float*)(ws + WS_CTL + CTL_SS1)};
        pg8::gemm_phase<pg8::EpiGateUp, pg8::StaticOrder, true, true>(lds, g, S, E);
    } SEAM(6);
    if (IN(7)) for (int rep = 0; rep < NREP(7); ++rep) { KA A = kargs(); unsigned char* ws = A->ws;
        { pg8::Gemm g{(const bf16*)(ws + WS_ACT), (const bf16*)(ws + WS_WD), MC, D, DFF}; pg8::StaticOrder S; S.init(MC, D, G, wgid); S.lim = (S.nwg / G) * G;
          pg8::EpiDown<false> E{(const bf16*)(ws + WS_HB1), (bf16*)(ws + WS_MB)};
          pg8::gemm_phase<pg8::EpiDown<false>, pg8::StaticOrder, true, true>(lds, g, S, E); }
        { const int nstr = (MC / 256) * 4 - ((MC / 256) * 4 / G) * G;
          if (wgid < nstr * 11) { const int t = wgid / 11, koff = (wgid % 11) * 256;
            pg8::Gemm g{(const bf16*)(ws + WS_ACT) + koff, (const bf16*)(ws + WS_WD) + koff, MC, D, 256, DFF};
            pg8::SliceOrder S; S.init_slice(MC, D, G, ((MC / 256) * 4 / G) * G, t);
            pg8::EpiSplit<pg8::EpiDown<false>, false> E{pg8::EpiDown<false>{(const bf16*)(ws + WS_HB1), (bf16*)(ws + WS_MB)}, (float*)(ws + WS_SCR) + (size_t)t * 65536, (unsigned*)(ws + WS_CTL + CTL_SPL) + t * 8, 11u, nullptr, 0};
            pg8::gemm_phase<pg8::EpiSplit<pg8::EpiDown<false>, false>, pg8::SliceOrder, true, true>(lds, g, S, E); } }
    } SEAM(7);
    if (IN(8)) { KA A = kargs(); p8_final_norm(A); }
#undef IN
#undef SEAM
}

extern "C" void kernel_launch(void* const* d_in, const int* in_sizes, int n_in, void* d_out, int out_size, void* d_ws, size_t ws_size, hipStream_t stream) {
    static int grid = 0;
    if (grid == 0) {
        if (n_in != 22 || out_size != (int)O_END || ws_size < WS_END) { fprintf(stderr, "kernel_launch: unexpected problem (n_in %d, out %d, ws %zu)\n", n_in, out_size, ws_size); grid = -1; return; }
        int dev = 0, cus = 0, per_cu = 0;
        if (hipGetDevice(&dev) != hipSuccess || hipDeviceGetAttribute(&cus, hipDeviceAttributeMultiprocessorCount, dev) != hipSuccess) { grid = -1; return; }
        if (hipFuncSetAttribute((const void*)hybrid_fwd, hipFuncAttributeMaxDynamicSharedMemorySize, LDS_BYTES) != hipSuccess) { fprintf(stderr, "kernel_launch: hipFuncSetAttribute failed\n"); grid = -1; return; }
        if (hipOccupancyMaxActiveBlocksPerMultiprocessor(&per_cu, (const void*)hybrid_fwd, NTHREADS, LDS_BYTES) != hipSuccess || per_cu < 1) { fprintf(stderr, "kernel_launch: occupancy query says %d\n", per_cu); per_cu = 1; }
        (void)hipGetLastError();
        grid = cus;
        if (grid > 256) grid = 256;
    }
    if (grid < 0) return;
    (void)hipMemsetAsync((char*)d_ws + WS_CTL, 0, CTL_BYTES, stream);
    (void)hipMemsetAsync((char*)d_ws + WS_SCR, 0, SCR_BYTES, stream);
    Args a{};
    const float** ap = (const float**)&a;
    for (int i = 0; i < 22; ++i) ap[i] = (const float*)d_in[i];
    a.out = (float*)d_out; a.ws = (unsigned char*)d_ws;
#if MK_N_LAUNCHES == 1
    a.ph_lo = 0; a.ph_hi = N_PHASES;
#if MK_BARRIER == 1
    hipLaunchKernelGGL(hybrid_fwd, dim3(grid), dim3(NTHREADS), LDS_BYTES, stream, a);
#else
    void* args[] = {&a};
    hipError_t e = hipLaunchCooperativeKernel((const void*)hybrid_fwd, dim3(grid), dim3(NTHREADS), args, LDS_BYTES, stream);
    if (e != hipSuccess) fprintf(stderr, "cooperative launch failed: %s (grid %d)\n", hipGetErrorString(e), grid);
#endif
#else
    for (int p = 0; p < N_PHASES; ++p) { a.ph_lo = p; a.ph_hi = p + 1; hipLaunchKernelGGL(hybrid_fwd, dim3(grid), dim3(NTHREADS), LDS_BYTES, stream, a); }
#endif
}
```

```cpp
#include <hip/hip_runtime.h>
#include <hip/hip_cooperative_groups.h>
#include <cstdio>
#include <cstdint>
namespace cg = cooperative_groups;

#ifndef MK_N_LAUNCHES
#define MK_N_LAUNCHES 1
#endif
#ifndef MK_BARRIER
#define MK_BARRIER 1
#endif

constexpr int D = 1024, NBATCH = 8, SEQ = 4096, NMETA = 16, TP = SEQ + NMETA, MP = NBATCH * TP;
constexpr int SBATCH = 128, TS = 4, MS = SBATCH * TS, MU = MP + MS, MUP = 33536, MC = NBATCH * SEQ + MS;
constexpr int PAST = 16384;
constexpr int HD = 64, NHA = 8, NKV = 2;
constexpr int NHB = 4, CONVD = 1536;
constexpr int DFF = 2816, NIN_SRC = 4872, NIN = 4864;
constexpr float EPS = 1e-6f;
constexpr float QSCALE = 0.125f * 1.4426950408889634f;

constexpr size_t MiB = 1u << 20, KiB = 1024;
constexpr size_t WS_CTL = 0, CTL_BYTES = 1 * MiB;
constexpr size_t WS_WIN = 1 * MiB;
constexpr size_t WS_WOA = 11 * MiB, WS_WOB = 12 * MiB;
constexpr size_t WS_WOUT = 13 * MiB;
constexpr size_t WS_WGU = 15 * MiB;
constexpr size_t WS_WD = 26 * MiB;
constexpr size_t WS_ROPE = 32 * MiB;
constexpr size_t WS_GB = 34 * MiB;
constexpr size_t WS_SC = 36 * MiB;
constexpr size_t WS_SS1 = 37 * MiB, WS_SS2 = 37 * MiB + 512 * KiB;
constexpr size_t WS_SCR = 38 * MiB, SCR_BYTES = 2 * MiB;
constexpr size_t CTL_SPL6 = 53248;
constexpr size_t CTL_SPL = 49152;
constexpr size_t WS_QA = 41 * MiB;
constexpr size_t WS_KV = WS_QA + (size_t)MUP * 512 * 2;
constexpr size_t WS_QKVB = WS_KV + (size_t)MUP * 256 * 2;
constexpr size_t WS_Z = WS_QKVB + (size_t)MUP * 1536 * 2;
constexpr size_t WS_G = WS_Z + (size_t)MUP * 512 * 2;
constexpr size_t WS_GEND = WS_G + (size_t)MUP * 2048 * 2;
constexpr size_t WS_B = 353 * MiB, WS_END = 512 * MiB;
static_assert(WS_GEND <= WS_B, "ws map");
constexpr size_t WS_XN = WS_B;
constexpr size_t PREP_SLOT = 80 * KiB;
constexpr int PREP_N1 = (int)((WS_END - WS_B) / PREP_SLOT);
constexpr size_t DO_OA = 44 * MiB;
constexpr int OAB_PITCH = 1024;
constexpr size_t DO_OB = DO_OA + 512 * 2;
constexpr size_t DO_ATS = DO_OA + (size_t)MC * OAB_PITCH * 2;
constexpr size_t ATS_ITEM = 3 * 32 * 32 * 4;
static_assert(DO_ATS + 212 * 8 * ATS_ITEM <= (size_t)MC * 1024 * 4, "d_out scratch map");
constexpr size_t WS_MB = WS_B;
constexpr size_t WS_HB1 = WS_B + 66 * MiB;
static_assert(WS_HB1 + (size_t)MC * 1024 * 2 <= WS_END, "ws map");
constexpr size_t WS_ACT = WS_QA;
static_assert(WS_ACT + (size_t)MC * DFF * 2 <= WS_G, "ws map");
constexpr int SL_BEK = 0, SL_BV = 16 * 1024, SL_T = 32 * 1024, SL_QKD = 40 * 1024, SL_QE = 48 * 1024, SL_KWT = 64 * 1024;
constexpr int N_PROMPT_SEQ = NBATCH * NHB, CHUNKS_P = 65, N_ITEMS_P = N_PROMPT_SEQ * CHUNKS_P, N_ITEMS = N_ITEMS_P;
static_assert((size_t)(N_ITEMS - PREP_N1) * PREP_SLOT <= DO_OA, "prep slots");

constexpr size_t O_YP = 0, O_YS = (size_t)NBATCH * SEQ * D, O_KP = O_YS + (size_t)MS * D, O_VP = O_KP + 8 * 128 * 2 * 64, O_DP = O_VP + 8 * 128 * 2 * 64,
                 O_CP = O_DP + 8 * 4 * 128 * 128, O_KS = O_CP + 8 * 3 * 1536, O_VS = O_KS + (size_t)128 * 128 * 2 * 64, O_DS = O_VS + (size_t)128 * 128 * 2 * 64,
                 O_CS = O_DS + (size_t)128 * 4 * 128 * 128, O_END = O_CS + (size_t)128 * 3 * 1536;
static_assert(O_END == 48074752, "d_out size");

#define DI __device__ __forceinline__
#define GAS __attribute__((address_space(1)))
#define LAS __attribute__((address_space(3)))
typedef unsigned short bf16;
typedef short bf16x8 __attribute__((ext_vector_type(8)));
typedef float f32x4 __attribute__((ext_vector_type(4)));
typedef float f32x2 __attribute__((ext_vector_type(2)));
typedef float f32x16 __attribute__((ext_vector_type(16)));
typedef unsigned u32x4 __attribute__((ext_vector_type(4)));
typedef unsigned u32x2 __attribute__((ext_vector_type(2)));
typedef __bf16 bf16x2_t __attribute__((ext_vector_type(2)));

DI int tid_opaque(int wave_s) { int t = wave_s * 64 + (int)__builtin_amdgcn_mbcnt_hi(~0u, __builtin_amdgcn_mbcnt_lo(~0u, 0u)); asm volatile("" : "+v"(t)); return t; }
DI unsigned cvtpk(float lo, float hi) { f32x2 v = {lo, hi}; bf16x2_t b = __builtin_convertvector(v, bf16x2_t); return __builtin_bit_cast(unsigned, b); }
DI bf16 f2bf(float f) { return (bf16)(cvtpk(f, 0.f) & 0xffffu); }
DI float bf2f(unsigned short h) { return __uint_as_float((unsigned)h << 16); }
DI float bflo(unsigned w) { return __uint_as_float(w << 16); }
DI float bfhi(unsigned w) { return __uint_as_float(w & 0xffff0000u); }
DI u32x4 pack8f(f32x4 a, f32x4 b) { u32x4 w; w.x = cvtpk(a[0], a[1]); w.y = cvtpk(a[2], a[3]); w.z = cvtpk(b[0], b[1]); w.w = cvtpk(b[2], b[3]); return w; }
DI unsigned pack4u8(f32x4 g) { const unsigned a = (unsigned)(g[0] * 255.f + 0.5f), b = (unsigned)(g[1] * 255.f + 0.5f), c = (unsigned)(g[2] * 255.f + 0.5f), d = (unsigned)(g[3] * 255.f + 0.5f); return a | (b << 8) | (c << 16) | (d << 24); }
DI f32x4 unpack4u8(unsigned w) { return (f32x4){(float)(w & 0xffu), (float)((w >> 8) & 0xffu), (float)((w >> 16) & 0xffu), (float)(w >> 24)} * (1.0f / 255.0f); }
DI float frcp_(float x) { return __builtin_amdgcn_rcpf(x); }
DI float sigmoidf_(float x) { return frcp_(1.0f + __builtin_amdgcn_exp2f(x * -1.4426950408889634f)); }
DI float siluf_(float x) { return x * sigmoidf_(x); }
DI void st16_sc1(void* p, u32x4 v) { asm volatile("global_store_dwordx4 %0, %1, off sc1\n\ts_nop 1" :: "v"(p), "v"(v) : "memory"); }
DI void st16_sc1f(void* p, f32x4 v) { asm volatile("global_store_dwordx4 %0, %1, off sc1\n\ts_nop 1" :: "v"(p), "v"(v) : "memory"); }
DI void st2_sc1(void* p, unsigned v) { asm volatile("global_store_short %0, %1, off sc1\n\ts_nop 1" :: "v"(p), "v"(v) : "memory"); }
constexpr size_t CTL_GRAN = 65536, CTL_CNT = 245760, CTL_SS1 = 458752;
static_assert(CTL_CNT + 5 * 130 * 256 <= CTL_SS1 && CTL_SS1 + 33280 * 4 <= 1048576 && CTL_GRAN + 2592 * 64 <= CTL_CNT, "control region map");
constexpr int CNT_STRIDE = 130 * 64;
DI int pos_of_d(int d) { const int dd = d & 31; return 8 * (dd >> 2) + (dd & 3) + ((d >> 5) << 2); }
DI int d_of_pos(int p) { const int j = p & 7; return 4 * (p >> 3) + (j & 3) + ((j >> 2) << 5); }
namespace pg8 {
#define PG8_LAS __attribute__((address_space(3)))
typedef unsigned short bf16_t;
typedef short bf16x8 __attribute__((ext_vector_type(8)));
typedef float f32x4 __attribute__((ext_vector_type(4)));
typedef unsigned u32x4 __attribute__((ext_vector_type(4)));
constexpr int BM = 256, BK = 64, HALF = 128, HTB = HALF * BK * 2  , STAGE_BYTES = 8 * HTB, NXCD = 8, WGM = 8;

__host__ __device__ __forceinline__ int lds_byte(int r, int c) { const int st = (r >> 4) * 2 + (c >> 5), rr = r & 15, cc = c & 31, ob = rr * 64 + cc * 2; return st * 1024 + (ob ^ (((ob >> 9) & 1) << 5)); }
__host__ __device__ __forceinline__ void stage_rc(int b, int& R, int& C) { const int st = b / 1024, sb = b % 1024, swz = sb ^ (((sb >> 9) & 1) << 5); R = (st >> 1) * 16 + swz / 64; C = (st & 1) * 32 + (swz % 64) / 2; }
__host__ __device__ __forceinline__ int perm32(int rho) { const int n = rho >> 4, i = rho & 15; return 8 * (i >> 2) + 4 * n + (i & 3); }

struct Unit { int pm, pn; };
struct Gemm { const bf16_t* A; const bf16_t* Bt; int M, N, K; int ldk; };

struct StaticOrder {
    static constexpr bool A_SC1 = false;
    int nM, nN, nwg, G, c, lim;
    __host__ __device__ void init(int M, int N, int G_, int c_) { nM = M / BM; nN = N / BM; nwg = nM * nN; G = G_; c = c_; lim = nwg; }
    __host__ __device__ bool next(int i, Unit& u) const {
        const long L = (long)i * G + c; if (L >= lim) return false;
        int wgid = (int)L; { const int q = nwg / NXCD, r = nwg % NXCD, xcd = wgid % NXCD, off = wgid / NXCD; wgid = (xcd < r ? xcd * (q + 1) : r * (q + 1) + (xcd - r) * q) + off; }
        const int nig = WGM * nN, gid = wgid / nig, fm = gid * WGM, gsz = (nM - fm) < WGM ? (nM - fm) : WGM;
        u.pm = fm + ((wgid % nig) % gsz); u.pn = (wgid % nig) / gsz; return true;
    }
    __device__ __forceinline__ void a_ready(const Unit&) const {}
    __device__ __forceinline__ void done(const Unit&) const {}
};
struct FlagOrder : StaticOrder {
    static constexpr bool A_SC1 = true;
    const unsigned* ready; unsigned need; unsigned* pub; unsigned* gpub;
    __device__ __forceinline__ void a_ready(const Unit& u) const {
        if (ready) {
            if (threadIdx.x < 64) { unsigned spins = 0;
                while ((unsigned)__builtin_amdgcn_readfirstlane(__hip_atomic_load(ready + 64 * u.pm, __ATOMIC_RELAXED, __HIP_MEMORY_SCOPE_AGENT)) < need) { __builtin_amdgcn_s_sleep(2); if (++spins > (1u << 22)) break; } }
            asm volatile("" ::: "memory"); __builtin_amdgcn_s_barrier(); asm volatile("" ::: "memory");
        }
    }
    __device__ __forceinline__ void done(const Unit& u) const {
        if (pub) { asm volatile("s_waitcnt vmcnt(0)" ::: "memory");
            if ((threadIdx.x & 63) == 0) { __hip_atomic_fetch_add(pub + 64 * u.pm, 1u, __ATOMIC_RELAXED, __HIP_MEMORY_SCOPE_AGENT); if (gpub) __hip_atomic_fetch_add(gpub, 1u, __ATOMIC_RELAXED, __HIP_MEMORY_SCOPE_AGENT); } }
    }
};
struct SliceOrder : StaticOrder {
    int t;
    __host__ __device__ void init_slice(int M, int N, int G_, int first, int t_) { init(M, N, G_, 0); t = t_; c = first + t_; G = 0; }
    __host__ __device__ bool next(int i, Unit& u) const { return i == 0 ? StaticOrder::next(0, u) : false; }
};

__device__ __forceinline__ void urow_info(int urow, int& kind, int& b, int& t, int& ridx) {
    if (urow < MP) { b = urow / TP; t = urow - b * TP; kind = 0; ridx = t; }
    else if (urow < MU) { const int s = urow - MP; b = s >> 2; t = s & 3; kind = 1; ridx = TP + t; }
    else { kind = 2; b = 0; t = 0; ridx = 0; }
}
__device__ __forceinline__ int crow_to_urow(int crow) { return crow < NBATCH * SEQ ? crow + NMETA * ((crow >> 12) + 1) : MP + (crow - NBATCH * SEQ); }

struct EpiInProj {
    static constexpr bool PERM = true, AFTER_DRAIN = false;
    bf16_t *QA, *KV, *QKVB, *Z, *G; const float *COS, *SIN; float* out; const float* gnw;
    __device__ __forceinline__ void operator()(const f32x4 (&acc)[2][2][4][2], const Unit& u, int wr, int wc, int fr, int fq) const {
        const int pn = u.pn;
#pragma unroll
        for (int ai = 0; ai < 2; ++ai)
#pragma unroll
            for (int m = 0; m < 4; ++m) {
                const int row = u.pm * BM + ai * HALF + wr * 64 + m * 16 + fr;
                int kind, b, t, ridx; urow_info(row, kind, b, t, ridx);
#pragma unroll
                for (int bj = 0; bj < 2; ++bj) {
                    const int cl = bj * HALF + wc * 32 + 8 * fq;
                    const f32x4 v0 = acc[ai][bj][m][0], v1 = acc[ai][bj][m][1];
                    if (pn < 2) {
                        const int c = pn * 256 + cl, d0 = ((c & 63) >> 3) * 4;
                        const f32x4 cs = *(const f32x4*)(COS + ridx * 32 + d0), sn = *(const f32x4*)(SIN + ridx * 32 + d0);
                        const f32x4 o1 = (v0 * cs - v1 * sn) * QSCALE, o2 = (v1 * cs + v0 * sn) * QSCALE;
                        *(u32x4*)(QA + (size_t)row * 512 + c) = pack8f(o1, o2);
                    } else if (pn == 2) {
                        if (bj == 0) {
                            const int kh = cl >> 6, d0 = ((cl & 63) >> 3) * 4;
                            const f32x4 cs = *(const f32x4*)(COS + ridx * 32 + d0), sn = *(const f32x4*)(SIN + ridx * 32 + d0);
                            const f32x4 o1 = v0 * cs - v1 * sn, o2 = v1 * cs + v0 * sn;
                            *(u32x4*)(KV + (size_t)row * 256 + cl) = pack8f(o1, o2);
                            float* dst = nullptr;
                            if (kind == 0 && t >= TP - 128) dst = out + O_KP + ((size_t)(b * 128 + (t - (TP - 128))) * 2 + kh) * 64;
                            else if (kind == 1) dst = out + O_KS + ((size_t)(b * 128 + 124 + t) * 2 + kh) * 64;
                            if (dst) { *(f32x4*)(dst + d0) = o1; *(f32x4*)(dst + 32 + d0) = o2; }
                        } else {
                            const int cv = cl - 128, kh = cv >> 6, dd = cv & 63;
                            *(u32x4*)(KV + (size_t)row * 256 + cl) = pack8f(v0, v1);
                            float* dst = nullptr;
                            if (kind == 0 && t >= TP - 128) dst = out + O_VP + ((size_t)(b * 128 + (t - (TP - 128))) * 2 + kh) * 64;
                            else if (kind == 1) dst = out + O_VS + ((size_t)(b * 128 + 124 + t) * 2 + kh) * 64;
                            if (dst) { *(f32x4*)(dst + dd) = v0; *(f32x4*)(dst + dd + 4) = v1; }
                        }
                    } else if (pn < 9) {
                        const int c = (pn - 3) * 256 + cl;
                        *(u32x4*)(QKVB + (size_t)row * 1536 + c) = pack8f(v0, v1);
                        float* dst = nullptr;
                        if (kind == 0 && t >= TP - 3) dst = out + O_CP + ((size_t)b * 3 + (t - (TP - 3))) * 1536;
                        else if (kind == 1 && t >= 1) dst = out + O_CS + ((size_t)b * 3 + (t - 1)) * 1536;
                        if (dst) { *(f32x4*)(dst + c) = v0; *(f32x4*)(dst + c + 4) = v1; }
                    } else if (pn < 11) {
                        const int c = (pn - 9) * 256 + cl;
                        const f32x4 w0 = *(const f32x4*)(gnw + (c & 127)), w1 = *(const f32x4*)(gnw + (c & 127) + 4);
                        f32x4 z0, z1;
#pragma unroll
                        for (int e = 0; e < 4; ++e) { z0[e] = siluf_(v0[e]) * w0[e]; z1[e] = siluf_(v1[e]) * w1[e]; }
                        *(u32x4*)(Z + (size_t)row * 512 + c) = pack8f(z0, z1);
                    } else {
                        const int c = (pn - 11) * 256 + cl;
                        f32x4 g0, g1;
#pragma unroll
                        for (int e = 0; e < 4; ++e) { g0[e] = sigmoidf_(v0[e]); g1[e] = sigmoidf_(v1[e]); }
                        *(u32x2*)((unsigned char*)G + (size_t)row * 2048 + c) = (u32x2){pack4u8(g0), pack4u8(g1)};
                    }
                }
            }
    }
};

template <bool ACCUM> struct EpiMerge {
    static constexpr bool PERM = true, AFTER_DRAIN = false;
    bf16_t* MBp; const bf16_t* G; int gate_off;
    __device__ __forceinline__ void operator()(const f32x4 (&acc)[2][2][4][2], const Unit& u, int wr, int wc, int fr, int fq) const {
#pragma unroll
        for (int ai = 0; ai < 2; ++ai)
#pragma unroll
            for (int m = 0; m < 4; ++m) {
                const int crow = u.pm * BM + ai * HALF + wr * 64 + m * 16 + fr, urow = crow_to_urow(crow);
#pragma unroll
                for (int bj = 0; bj < 2; ++bj) {
                    const int c = u.pn * BM + bj * HALF + wc * 32 + 8 * fq;
                    const u32x2 gw = *(const u32x2*)((const unsigned char*)G + (size_t)urow * 2048 + gate_off + c);
                    f32x4 v0 = acc[ai][bj][m][0] * unpack4u8(gw.x), v1 = acc[ai][bj][m][1] * unpack4u8(gw.y);
                    bf16_t* p = MBp + (size_t)crow * 1024 + c;
                    if (ACCUM) { const u32x4 pw = *(const u32x4*)p;
                        v0[0] += bflo(pw.x); v0[1] += bfhi(pw.x); v0[2] += bflo(pw.y); v0[3] += bfhi(pw.y);
                        v1[0] += bflo(pw.z); v1[1] += bfhi(pw.z); v1[2] += bflo(pw.w); v1[3] += bfhi(pw.w); }
                    *(u32x4*)p = pack8f(v0, v1);
                }
            }
    }
};

template <bool ATOM = true> struct EpiWout {
    static constexpr bool PERM = true, AFTER_DRAIN = false;
    const float* xp; const float* xs; bf16_t* HB; float* SS;
    __device__ __forceinline__ void operator()(const f32x4 (&acc)[2][2][4][2], const Unit& u, int wr, int wc, int fr, int fq) const {
#pragma unroll
        for (int ai = 0; ai < 2; ++ai)
#pragma unroll
            for (int m = 0; m < 4; ++m) {
                const int crow = u.pm * BM + ai * HALF + wr * 64 + m * 16 + fr;
                const float* hs = crow < NBATCH * SEQ ? xp + (size_t)crow * D : xs + (size_t)(crow - NBATCH * SEQ) * D;
                float ss = 0.f;
#pragma unroll
                for (int bj = 0; bj < 2; ++bj) {
                    const int c = u.pn * BM + bj * HALF + wc * 32 + 8 * fq;
                    const f32x4 r0 = *(const f32x4*)(hs + c) + acc[ai][bj][m][0], r1 = *(const f32x4*)(hs + c + 4) + acc[ai][bj][m][1];
                    *(u32x4*)(HB + (size_t)crow * D + c) = pack8f(r0, r1);
                    ss += (r0[0] * r0[0] + r0[1] * r0[1]) + (r0[2] * r0[2] + r0[3] * r0[3]) + (r1[0] * r1[0] + r1[1] * r1[1]) + (r1[2] * r1[2] + r1[3] * r1[3]);
                }
                ss += __shfl_xor(ss, 16); ss += __shfl_xor(ss, 32);
                if (ATOM && fq == 0) atomicAdd(SS + crow, ss);
            }
    }
};

struct EpiGateUp {
    static constexpr bool PERM = true, AFTER_DRAIN = false;
    bf16_t* ACT; const float* SS;
    __device__ __forceinline__ void operator()(const f32x4 (&acc)[2][2][4][2], const Unit& u, int wr, int wc, int fr, int fq) const {
#pragma unroll
        for (int ai = 0; ai < 2; ++ai)
#pragma unroll
            for (int m = 0; m < 4; ++m) {
                const int crow = u.pm * BM + ai * HALF + wr * 64 + m * 16 + fr;
                const float rstd = rsqrtf(SS[crow] * (1.0f / D) + EPS);
                f32x4 a[2];
#pragma unroll
                for (int n = 0; n < 2; ++n)
#pragma unroll
                    for (int e = 0; e < 4; ++e) { const float g = acc[ai][0][m][n][e] * rstd, up = acc[ai][1][m][n][e] * rstd; a[n][e] = siluf_(g) * up; }
                *(u32x4*)(ACT + (size_t)crow * DFF + u.pn * HALF + wc * 32 + 8 * fq) = pack8f(a[0], a[1]);
            }
    }
};

template <bool DRY = false> struct EpiDown {
    static constexpr bool PERM = true, AFTER_DRAIN = false;
    const bf16_t* HB; bf16_t* H2;
    __device__ __forceinline__ void operator()(const f32x4 (&acc)[2][2][4][2], const Unit& u, int wr, int wc, int fr, int fq) const {
#pragma unroll
        for (int ai = 0; ai < 2; ++ai)
#pragma unroll
            for (int m = 0; m < 4; ++m) {
                const int crow = u.pm * BM + ai * HALF + wr * 64 + m * 16 + fr;
#pragma unroll
                for (int bj = 0; bj < 2; ++bj) {
                    const size_t off = (size_t)crow * D + u.pn * BM + bj * HALF + wc * 32 + 8 * fq;
                    const u32x4 hw = *(const u32x4*)(HB + off);
                    f32x4 r0 = acc[ai][bj][m][0], r1 = acc[ai][bj][m][1];
                    r0[0] += bflo(hw.x); r0[1] += bfhi(hw.x); r0[2] += bflo(hw.y); r0[3] += bfhi(hw.y);
                    r1[0] += bflo(hw.z); r1[1] += bfhi(hw.z); r1[2] += bflo(hw.w); r1[3] += bfhi(hw.w);
                    *(u32x4*)(H2 + off) = pack8f(r0, r1);
                }
            }
    }
};

template <class Inner, bool GATED = false> struct EpiSplitP {
    static constexpr bool PERM = Inner::PERM, AFTER_DRAIN = false;
    Inner inner; float* scr; unsigned* cnt; unsigned S; int sl; const bf16_t* G; int gate_off;
    __device__ __forceinline__ void operator()(const f32x4 (&acc_)[2][2][4][2], const Unit& u, int wr, int wc, int fr, int fq) const {
        f32x4 (&acc)[2][2][4][2] = const_cast<f32x4 (&)[2][2][4][2]>(acc_);
        const int lane = fr + 16 * fq, wave = wr * 4 + wc;
        f32x4* mine = (f32x4*)scr + ((size_t)sl * 8 + wave) * 2048 + lane;
#pragma unroll
        for (int ai = 0; ai < 2; ++ai)
#pragma unroll
            for (int m = 0; m < 4; ++m) {
                int urow = 0;
                if (GATED) urow = crow_to_urow(u.pm * BM + ai * HALF + wr * 64 + m * 16 + fr);
#pragma unroll
                for (int bj = 0; bj < 2; ++bj) {
                    if (GATED) { const u32x2 gw = *(const u32x2*)((const unsigned char*)G + (size_t)urow * 2048 + gate_off + u.pn * BM + bj * HALF + wc * 32 + 8 * fq);
                        acc[ai][bj][m][0] = acc[ai][bj][m][0] * unpack4u8(gw.x); acc[ai][bj][m][1] = acc[ai][bj][m][1] * unpack4u8(gw.y); }
                    f32x4* q = mine + (((ai * 2 + bj) * 4 + m) * 2) * 64;
                    asm volatile("" : "+v"(q));
                    st16_sc1f(q, acc[ai][bj][m][0]); st16_sc1f(q + 64, acc[ai][bj][m][1]);
                }
            }
        asm volatile("s_waitcnt vmcnt(0)" ::: "memory");
        unsigned old = 0u;
        if (lane == 0) old = __hip_atomic_fetch_add(cnt + wave, 1u, __ATOMIC_RELAXED, __HIP_MEMORY_SCOPE_AGENT);
        old = (unsigned)__builtin_amdgcn_readfirstlane((int)old);
        if (old == S - 1u) {
#pragma unroll 1
            for (int s = 0; s < (int)S; ++s) {
                if (s == sl) continue;
                const f32x4* oth = (const f32x4*)scr + ((size_t)s * 8 + wave) * 2048 + lane;
#pragma unroll
                for (int ai = 0; ai < 2; ++ai)
#pragma unroll
                    for (int bj = 0; bj < 2; ++bj) {
                        const f32x4* q = oth + ((ai * 2 + bj) * 8) * 64;
                        f32x4 t[8];
                        asm volatile("global_load_dwordx4 %0, %8, off sc1\n\tglobal_load_dwordx4 %1, %8, off offset:1024 sc1\n\tglobal_load_dwordx4 %2, %8, off offset:2048 sc1\n\tglobal_load_dwordx4 %3, %8, off offset:3072 sc1\n\t"
                                     "global_load_dwordx4 %4, %9, off sc1\n\tglobal_load_dwordx4 %5, %9, off offset:1024 sc1\n\tglobal_load_dwordx4 %6, %9, off offset:2048 sc1\n\tglobal_load_dwordx4 %7, %9, off offset:3072 sc1\n\ts_waitcnt vmcnt(0)"
                                     : "=&v"(t[0]), "=&v"(t[1]), "=&v"(t[2]), "=&v"(t[3]), "=&v"(t[4]), "=&v"(t[5]), "=&v"(t[6]), "=&v"(t[7]) : "v"(q), "v"(q + 256) : "memory");
#pragma unroll
                        for (int m = 0; m < 4; ++m) { acc[ai][bj][m][0] += t[2 * m]; acc[ai][bj][m][1] += t[2 * m + 1]; }
                    }
            }
            if (lane == 0) __hip_atomic_store(cnt + wave, 0u, __ATOMIC_RELAXED, __HIP_MEMORY_SCOPE_AGENT);
            inner(acc, u, wr, wc, fr, fq);
        }
    }
};
template <class Inner, bool GATED = false> struct EpiSplit {
    static constexpr bool PERM = Inner::PERM, AFTER_DRAIN = false;
    Inner inner; float* scr; unsigned* cnt; unsigned S; const bf16_t* G; int gate_off;
    __device__ __forceinline__ void operator()(const f32x4 (&acc_)[2][2][4][2], const Unit& u, int wr, int wc, int fr, int fq) const {
        f32x4 (&acc)[2][2][4][2] = const_cast<f32x4 (&)[2][2][4][2]>(acc_);
        const int lane = fr + 16 * fq, wave = wr * 4 + wc;
        float* p = scr + (size_t)wave * 8192 + lane;
#pragma unroll
        for (int ai = 0; ai < 2; ++ai)
#pragma unroll
            for (int m = 0; m < 4; ++m) {
                int urow = 0;
                if (GATED) urow = crow_to_urow(u.pm * BM + ai * HALF + wr * 64 + m * 16 + fr);
#pragma unroll
                for (int bj = 0; bj < 2; ++bj) {
                    f32x4 v0 = acc[ai][bj][m][0], v1 = acc[ai][bj][m][1];
                    if (GATED) { const u32x2 gw = *(const u32x2*)((const unsigned char*)G + (size_t)urow * 2048 + gate_off + u.pn * BM + bj * HALF + wc * 32 + 8 * fq);
                        v0 = v0 * unpack4u8(gw.x); v1 = v1 * unpack4u8(gw.y); }
                    float* q = p + (((ai * 2 + bj) * 4 + m) * 8) * 64;
                    asm volatile("" : "+v"(q));
#pragma unroll
                    for (int x = 0; x < 4; ++x) { unsafeAtomicAdd(q + x * 64, v0[x]); unsafeAtomicAdd(q + (4 + x) * 64, v1[x]); }
                }
            }
        asm volatile("s_waitcnt vmcnt(0)" ::: "memory");
        unsigned old = 0u;
        if (lane == 0) old = __hip_atomic_fetch_add(cnt + wave, 1u, __ATOMIC_RELAXED, __HIP_MEMORY_SCOPE_AGENT);
        old = (unsigned)__builtin_amdgcn_readfirstlane((int)old);
        if (old == S - 1u) {
#pragma unroll
            for (int ai = 0; ai < 2; ++ai)
#pragma unroll
                for (int bj = 0; bj < 2; ++bj)
#pragma unroll
                    for (int m = 0; m < 4; ++m) {
                        float* q = p + (((ai * 2 + bj) * 4 + m) * 8) * 64;
                        asm volatile("" : "+v"(q));
#pragma unroll
                        for (int n = 0; n < 2; ++n)
#pragma unroll
                            for (int x = 0; x < 4; ++x) acc[ai][bj][m][n][x] = __hip_atomic_exchange(q + (n * 4 + x) * 64, 0.0f, __ATOMIC_RELAXED, __HIP_MEMORY_SCOPE_AGENT);
                    }
            if (lane == 0) __hip_atomic_store(cnt + wave, 0u, __ATOMIC_RELAXED, __HIP_MEMORY_SCOPE_AGENT);
            inner(acc, u, wr, wc, fr, fq);
        }
    }
};
struct EpiStoreMB {
    static constexpr bool PERM = true, AFTER_DRAIN = false;
    bf16_t* MBp;
    __device__ __forceinline__ void operator()(const f32x4 (&acc)[2][2][4][2], const Unit& u, int wr, int wc, int fr, int fq) const {
#pragma unroll
        for (int ai = 0; ai < 2; ++ai)
#pragma unroll
            for (int m = 0; m < 4; ++m) {
                const int crow = u.pm * BM + ai * HALF + wr * 64 + m * 16 + fr;
#pragma unroll
                for (int bj = 0; bj < 2; ++bj) *(u32x4*)(MBp + (size_t)crow * 1024 + u.pn * BM + bj * HALF + wc * 32 + 8 * fq) = pack8f(acc[ai][bj][m][0], acc[ai][bj][m][1]);
            }
    }
};

template <class Epi, class Sched, bool ALIGN_EPI = false, bool SP2 = false>
__device__ __forceinline__ void gemm_phase(PG8_LAS unsigned char* lds, const Gemm g, const Sched& S, const Epi& E, int wave_s) {
    const int tid = tid_opaque(wave_s), wid = __builtin_amdgcn_readfirstlane(tid >> 6), lane = tid & 63, wr = wid >> 2, wc = wid & 3, fr = lane & 15, fq = lane >> 4;
    const int K = g.ldk ? g.ldk : g.K, nt = g.K / BK;
    unsigned voffA[2], voffB[2];
#pragma unroll
    for (int i = 0; i < 2; ++i) { int R, C; stage_rc(tid * 16 + i * 8192, R, C); const int Rb = Epi::PERM ? ((R & ~31) + perm32(R & 31)) : R;
        voffA[i] = (unsigned)(R * K + C) * 2u; voffB[i] = (unsigned)(Rb * K + C) * 2u; }
    const size_t kstep = (size_t)(BK * 2);
    const size_t hstep = (size_t)HALF * K * 2;
    const size_t tstep = 2 * hstep;
    const unsigned ldsw = (unsigned)wid * 1024u;
    const int aoff = lds_byte(wr * 64 + fr, fq * 8), boff = lds_byte(wc * 32 + fr, fq * 8);
#define PG8_SA(b, h) (((b) * 2 + (h)) * HTB)
#define PG8_SB(b, h) ((4 + (b) * 2 + (h)) * HTB)
#define PG8_STAGE(bufoff, gbase, voff) do { _Pragma("unroll") for (int _i = 0; _i < 2; ++_i) \
        __builtin_amdgcn_global_load_lds((const unsigned*)((const char*)(gbase) + (voff)[_i]), (PG8_LAS unsigned*)(lds + (bufoff) + ldsw + _i * 8192), 16, 0, 0); } while (0)
#define PG8_STAGE_A(bufoff, gbase, voff) do { _Pragma("unroll") for (int _i = 0; _i < 2; ++_i) { \
        if constexpr (Sched::A_SC1) __builtin_amdgcn_global_load_lds((const unsigned*)((const char*)(gbase) + (voff)[_i]), (PG8_LAS unsigned*)(lds + (bufoff) + ldsw + _i * 8192), 16, 0, 16); \
        else __builtin_amdgcn_global_load_lds((const unsigned*)((const char*)(gbase) + (voff)[_i]), (PG8_LAS unsigned*)(lds + (bufoff) + ldsw + _i * 8192), 16, 0, 0); } } while (0)
#define PG8_LDA(dst, b, h) do { _Pragma("unroll") for (int m = 0; m < 4; ++m) _Pragma("unroll") for (int k = 0; k < 2; ++k) dst[m][k] = *(const PG8_LAS bf16x8*)(lds + PG8_SA(b, h) + aoff + m * 2048 + k * 1024); } while (0)
#define PG8_LDB(dst, b, h) do { _Pragma("unroll") for (int n = 0; n < 2; ++n) _Pragma("unroll") for (int k = 0; k < 2; ++k) dst[n][k] = *(const PG8_LAS bf16x8*)(lds + PG8_SB(b, h) + boff + n * 2048 + k * 1024); } while (0)
#define PG8_MMA(ai, bj, At, Bt) do { __builtin_amdgcn_s_setprio(1); _Pragma("unroll") for (int m = 0; m < 4; ++m) _Pragma("unroll") for (int n = 0; n < 2; ++n) _Pragma("unroll") for (int k = 0; k < 2; ++k) \
        acc[ai][bj][m][n] = __builtin_amdgcn_mfma_f32_16x16x32_bf16(Bt[n][k], At[m][k], acc[ai][bj][m][n], 0, 0, 0); __builtin_amdgcn_s_setprio(0); } while (0)
#define PG8_WAIT_V(n) asm volatile("s_waitcnt vmcnt(" #n ")" ::: "memory")
#define PG8_WAIT_L(n) asm volatile("s_waitcnt lgkmcnt(" #n ")" ::: "memory")
#define PG8_BAR __builtin_amdgcn_s_barrier()
#define PG8_SCHED __builtin_amdgcn_sched_barrier(0)
    Unit cur, nxt; int ui = 0;
    if (!S.next(0, cur)) return;
    f32x4 acc[2][2][4][2];
#pragma unroll
    for (int a = 0; a < 2; ++a)
#pragma unroll
        for (int b = 0; b < 2; ++b)
#pragma unroll
            for (int m = 0; m < 4; ++m)
#pragma unroll
                for (int n = 0; n < 2; ++n) acc[a][b][m][n] = (f32x4){0.f, 0.f, 0.f, 0.f};
    bf16x8 At[4][2], B0[2][2], B1[2][2];
    const char* cA = (const char*)g.A + (size_t)cur.pm * tstep; const char* cB = (const char*)g.Bt + (size_t)cur.pn * tstep;
    S.a_ready(cur);
    if constexpr (SP2) {
        PG8_STAGE(PG8_SB(0, 0), cB, voffB); PG8_STAGE(PG8_SB(0, 1), cB + hstep, voffB); PG8_STAGE_A(PG8_SA(0, 0), cA, voffA); PG8_STAGE_A(PG8_SA(0, 1), cA + hstep, voffA);
        if (wr == 1) PG8_BAR;
        PG8_WAIT_V(2); PG8_BAR;
        PG8_STAGE(PG8_SB(1, 0), cB + kstep, voffB); PG8_STAGE_A(PG8_SA(1, 0), cA + kstep, voffA); PG8_STAGE(PG8_SB(1, 1), cB + hstep + kstep, voffB);
        PG8_WAIT_V(6); PG8_BAR;
    } else {
        PG8_STAGE(PG8_SB(0, 0), cB, voffB); PG8_STAGE_A(PG8_SA(0, 0), cA, voffA); PG8_STAGE(PG8_SB(0, 1), cB + hstep, voffB); PG8_STAGE_A(PG8_SA(0, 1), cA + hstep, voffA);
        if (wr == 1) PG8_BAR;
        PG8_WAIT_V(4); PG8_BAR;
        PG8_STAGE(PG8_SB(1, 0), cB + kstep, voffB); PG8_STAGE_A(PG8_SA(1, 0), cA + kstep, voffA); PG8_STAGE(PG8_SB(1, 1), cB + hstep + kstep, voffB);
        PG8_WAIT_V(6); PG8_BAR;
    }
    for (;;) {
        const bool has_next = S.next(ui + 1, nxt);
        const char* nA = has_next ? (const char*)g.A + (size_t)nxt.pm * tstep : cA; const char* nB = has_next ? (const char*)g.Bt + (size_t)nxt.pn * tstep : cB;
        for (int t = 0; t < nt; t += 2) {
            const bool last = (t == nt - 2);
            const char* a1 = cA + (size_t)(t + 1) * kstep;
            const char* a2 = last ? nA : cA + (size_t)(t + 2) * kstep; const char* b2 = last ? nB : cB + (size_t)(t + 2) * kstep;
            const char* a3 = a2 + kstep; const char* b3 = b2 + kstep;
            if (last && has_next) S.a_ready(nxt);
            if constexpr (SP2) {
            PG8_LDB(B0, 0, 0); PG8_LDB(B1, 0, 1); PG8_SCHED; PG8_LDA(At, 0, 0); PG8_STAGE_A(PG8_SA(1, 1), a1 + hstep, voffA);
            PG8_WAIT_V(8); PG8_WAIT_L(0); PG8_BAR; PG8_MMA(0, 0, At, B0); PG8_MMA(0, 1, At, B1); PG8_BAR; PG8_SCHED;
            PG8_LDA(At, 0, 1); PG8_STAGE(PG8_SB(0, 0), b2, voffB); PG8_STAGE(PG8_SB(0, 1), b2 + hstep, voffB); PG8_STAGE_A(PG8_SA(0, 0), a2, voffA);
            PG8_WAIT_V(8); PG8_WAIT_L(0); PG8_BAR; PG8_MMA(1, 0, At, B0); PG8_MMA(1, 1, At, B1); PG8_BAR; PG8_SCHED;
            PG8_LDB(B0, 1, 0); PG8_LDB(B1, 1, 1); PG8_SCHED; PG8_LDA(At, 1, 0); PG8_STAGE_A(PG8_SA(0, 1), a2 + hstep, voffA);
            PG8_WAIT_V(8); PG8_WAIT_L(0); PG8_BAR; PG8_MMA(0, 0, At, B0); PG8_MMA(0, 1, At, B1); PG8_BAR; PG8_SCHED;
            PG8_LDA(At, 1, 1); PG8_STAGE(PG8_SB(1, 0), b3, voffB); PG8_STAGE(PG8_SB(1, 1), b3 + hstep, voffB); PG8_STAGE_A(PG8_SA(1, 0), a3, voffA);
            PG8_WAIT_V(8); PG8_WAIT_L(0); PG8_BAR; PG8_MMA(1, 0, At, B0); PG8_MMA(1, 1, At, B1); PG8_BAR; PG8_SCHED;
            } else {
            PG8_LDB(B0, 0, 0); PG8_SCHED; PG8_LDA(At, 0, 0); PG8_STAGE_A(PG8_SA(1, 1), a1 + hstep, voffA);
            PG8_WAIT_L(8); PG8_BAR; PG8_WAIT_L(0); PG8_MMA(0, 0, At, B0); PG8_BAR; PG8_SCHED;
            PG8_LDB(B1, 0, 1); PG8_STAGE(PG8_SB(0, 0), b2, voffB);
            PG8_BAR; PG8_WAIT_L(0); PG8_MMA(0, 1, At, B1); PG8_BAR;
            PG8_LDA(At, 0, 1); PG8_STAGE_A(PG8_SA(0, 0), a2, voffA);
            PG8_BAR; PG8_WAIT_L(0); PG8_MMA(1, 0, At, B0); PG8_BAR; PG8_SCHED;
            PG8_STAGE(PG8_SB(0, 1), b2 + hstep, voffB);
            PG8_WAIT_V(6); PG8_BAR; PG8_MMA(1, 1, At, B1); PG8_BAR;
            PG8_LDB(B0, 1, 0); PG8_SCHED; PG8_LDA(At, 1, 0); PG8_STAGE_A(PG8_SA(0, 1), a2 + hstep, voffA);
            PG8_WAIT_L(8); PG8_BAR; PG8_WAIT_L(0); PG8_MMA(0, 0, At, B0); PG8_BAR; PG8_SCHED;
            PG8_LDB(B1, 1, 1); PG8_STAGE(PG8_SB(1, 0), b3, voffB);
            PG8_BAR; PG8_WAIT_L(0); PG8_MMA(0, 1, At, B1); PG8_BAR;
            PG8_LDA(At, 1, 1); PG8_STAGE_A(PG8_SA(1, 0), a3, voffA);
            PG8_BAR; PG8_WAIT_L(0); PG8_MMA(1, 0, At, B0); PG8_BAR; PG8_SCHED;
            PG8_STAGE(PG8_SB(1, 1), b3 + hstep, voffB);
            PG8_WAIT_V(6); PG8_BAR; PG8_MMA(1, 1, At, B1); PG8_BAR;
            }
        }
        if constexpr (ALIGN_EPI) { if (wr == 0) PG8_BAR; }
        if constexpr (!Epi::AFTER_DRAIN) { E(acc, cur, wr, wc, fr, fq); S.done(cur); }
        if (!has_next) break;
#pragma unroll
        for (int a = 0; a < 2; ++a)
#pragma unroll
            for (int b = 0; b < 2; ++b)
#pragma unroll
                for (int m = 0; m < 4; ++m)
#pragma unroll
                    for (int n = 0; n < 2; ++n) acc[a][b][m][n] = (f32x4){0.f, 0.f, 0.f, 0.f};
        cur = nxt; cA = nA; cB = nB; ++ui;
        if constexpr (ALIGN_EPI) { if (wr == 1) PG8_BAR; }
    }
    PG8_WAIT_V(0);
    if constexpr (!ALIGN_EPI) { if (wr == 0) PG8_BAR; }
    PG8_BAR;
    if constexpr (Epi::AFTER_DRAIN) { E.fused(acc, cur, wr, wc, fr, fq, lds, wid, lane); S.done(cur); }
#undef PG8_SA
#undef PG8_SB
#undef PG8_STAGE
#undef PG8_STAGE_A
#undef PG8_LDA
#undef PG8_LDB
#undef PG8_MMA
#undef PG8_WAIT_V
#undef PG8_WAIT_L
#undef PG8_BAR
#undef PG8_SCHED
}
}
constexpr int NWAVES = 8, NTHREADS = NWAVES * 64;
constexpr int LDS_BYTES = 147456;
constexpr int LDS_MISC = 131072;
constexpr int N_PHASES = 9;

struct Args {
    const float *x_prompt, *x_sample, *cache_k, *cache_v, *state_delta, *state_conv, *meta, *norm_mix, *w_in, *conv_w, *a_log, *dt_bias, *sinks, *gdn_norm,
                *w_oa, *w_ob, *w_out, *norm_ffn, *w_gate, *w_up, *w_down, *norm_final;
    float* out; unsigned char* ws; int ph_lo, ph_hi;
};

typedef const __attribute__((address_space(4))) Args* KA;
DI KA kargs() { KA p = (KA)__builtin_amdgcn_kernarg_segment_ptr(); asm volatile("" : "+s"(p)); return p; }
#define RLX_AGENT __ATOMIC_RELAXED, __HIP_MEMORY_SCOPE_AGENT
#define LDS_WAIT() asm volatile("s_waitcnt lgkmcnt(0)" ::: "memory")
#define MFMA32(a, b, c) __builtin_amdgcn_mfma_f32_32x32x16_bf16((a), (b), (c), 0, 0, 0)
DI int crow16(int reg, int h) { return (reg & 3) + 8 * (reg >> 2) + 4 * h; }
DI float wave_sum(float v) {
#pragma unroll
    for (int o = 1; o < 64; o <<= 1) v += __shfl_xor(v, o);
    return v;
}
DI float wave_max(float v) {
#pragma unroll
    for (int o = 1; o < 64; o <<= 1) v = fmaxf(v, __shfl_xor(v, o));
    return v;
}
template <int S> DI bf16x8 pack_step(const f32x16& x) {
    u32x4 p; p.x = cvtpk(x[8 * S], x[8 * S + 1]); p.y = cvtpk(x[8 * S + 2], x[8 * S + 3]); p.z = cvtpk(x[8 * S + 4], x[8 * S + 5]); p.w = cvtpk(x[8 * S + 6], x[8 * S + 7]);
    return __builtin_bit_cast(bf16x8, p);
}
DI int frag_idx(int row, int k, int NKS) { const int kkk = k & 15; return (((row >> 5) * NKS + (k >> 4)) * 64 + (row & 31) + 32 * ((kkk >> 2) & 1)) * 8 + (((kkk >> 3) << 2) | (kkk & 3)); }
DI unsigned char* slot_ptr(KA A, int item) { return item < PREP_N1 ? A->ws + WS_B + (size_t)item * PREP_SLOT : (unsigned char*)A->out + (size_t)(item - PREP_N1) * PREP_SLOT; }

#define XB_TMO      128
#define XB_XCNT(j)  (256  + 64 * (j))
#define XB_XSUB(j)  (1280 + 64 * (j))
#define XB_XGEN(j)  (2304 + 64 * (j))
#define XB_TOP      3328
#define XB_TOPGEN   3392
#define XCD_BAR_WORDS 3456
#define XB_SPIN_CAP (1u << 20)
DI unsigned xb_ld(unsigned* p)              { return __hip_atomic_load(p, __ATOMIC_RELAXED, __HIP_MEMORY_SCOPE_AGENT); }
DI unsigned xb_add(unsigned* p, unsigned v) { return __hip_atomic_fetch_add(p, v, __ATOMIC_RELAXED, __HIP_MEMORY_SCOPE_AGENT); }
DI unsigned xb_xcc_id() { return (unsigned)__builtin_amdgcn_s_getreg((3 << 11) | 20) & 0xFu; }
#define XB_SPIN(cond, bar) do { unsigned _sp = 0; while (cond) { __builtin_amdgcn_s_sleep(1); \
    if ((++_sp & 255u) == 0u) { if (xb_ld(&(bar)[XB_TMO])) break; if (_sp > XB_SPIN_CAP) { atomicAdd(&(bar)[XB_TMO], 1u); break; } } } } while (0)
struct XcdBarrier { unsigned* bar; unsigned x; volatile LAS unsigned* st; int w; };
DI bool xb_elected(int w) { return w == 0 && __builtin_amdgcn_mbcnt_hi(~0u, __builtin_amdgcn_mbcnt_lo(~0u, 0u)) == 0u; }
DI XcdBarrier xcd_barrier_post(unsigned* bar, volatile LAS unsigned* st, int w) {
    XcdBarrier b; b.bar = bar; b.x = xb_xcc_id(); b.st = st; b.w = w;
    if (xb_elected(w)) (void)xb_add(&bar[XB_XCNT(b.x)], 1u);
    return b;
}
DI void xcd_barrier_complete(unsigned* bar, unsigned x, unsigned& nloc, unsigned& nx) {
    const unsigned G = gridDim.x * gridDim.y * gridDim.z;
    unsigned sum, cnt, mine, sp = 0u;
    for (;;) {
        sum = 0u; cnt = 0u; mine = 0u;
#pragma unroll
        for (unsigned j = 0; j < 16; ++j) { const unsigned c = xb_ld(&bar[XB_XCNT(j)]); sum += c; cnt += (c > 0u) ? 1u : 0u; mine = (j == x) ? c : mine; }
        if (sum == G) break;
        __builtin_amdgcn_s_sleep(1);
        if ((++sp & 255u) == 0u) { if (xb_ld(&bar[XB_TMO])) break; if (sp > XB_SPIN_CAP) { atomicAdd(&bar[XB_TMO], 1u); break; } }
    }
    nloc = mine > 0u ? mine : 1u; nx = cnt > 0u ? cnt : 1u;
}
DI void xcd_barrier(const XcdBarrier& b) {
    asm volatile("s_waitcnt vmcnt(0)" ::: "memory");
    __syncthreads();
    if (xb_elected(b.w)) {
        unsigned* bar = b.bar;
        __builtin_amdgcn_s_waitcnt(0);
        unsigned nloc = b.st[0], nx = b.st[1];
        if (nloc == 0u) { xcd_barrier_complete(bar, b.x, nloc, nx); b.st[0] = nloc; b.st[1] = nx; }
        const unsigned old = xb_add(&bar[XB_XSUB(b.x)], 1u);
        const unsigned gen = old / nloc;
        if (old + 1u == (gen + 1u) * nloc) {
            __builtin_amdgcn_fence(__ATOMIC_RELEASE, "agent");
            asm volatile("s_waitcnt vmcnt(0)" ::: "memory");
            const unsigned og = xb_add(&bar[XB_TOP], 1u);
            const unsigned tg = og / nx;
            if (og + 1u == (tg + 1u) * nx) xb_add(&bar[XB_TOPGEN], 1u);
            else XB_SPIN(xb_ld(&bar[XB_TOPGEN]) == tg, bar);
            __builtin_amdgcn_fence(__ATOMIC_ACQUIRE, "agent");
            xb_add(&bar[XB_XGEN(b.x)], 1u);
            asm volatile("s_waitcnt vmcnt(0)" ::: "memory");
        } else {
            XB_SPIN(xb_ld(&bar[XB_XGEN(b.x)]) == gen, bar);
            __builtin_amdgcn_fence(__ATOMIC_ACQUIRE, "agent");
            asm volatile("s_waitcnt vmcnt(0)" ::: "memory");
        }
    }
    __syncthreads();
}

template <class RowMap> DI void transpose_item(const float* W, int K, int N, bf16* WT, RowMap rm, const float* kscale, LAS float* scr, int item, int lane, int ldw = 0) {
    if (ldw == 0) ldw = K;
    const int nblk = (N + 31) / 32, kb = item / nblk, nb = item - kb * nblk, k0 = 64 * kb, n0 = 32 * nb;
    const int n4 = n0 + (lane & 7) * 4;
    f32x4 v[8];
#pragma unroll
    for (int i = 0; i < 8; ++i) { const int kk = 8 * i + (lane >> 3);
        v[i] = n4 < N ? *(const f32x4*)(W + (size_t)(k0 + kk) * N + n4) : (f32x4){0.f, 0.f, 0.f, 0.f}; }
#pragma unroll
    for (int i = 0; i < 8; ++i) { const int kk = 8 * i + (lane >> 3);
        if (kscale) v[i] = v[i] * kscale[k0 + kk];
        LAS float* d = scr + kk * 33 + (lane & 7) * 4; d[0] = v[i][0]; d[1] = v[i][1]; d[2] = v[i][2]; d[3] = v[i][3]; }
    LDS_WAIT(); asm volatile("" ::: "memory");
    const int c = lane & 7;
#pragma unroll
    for (int j = 0; j < 4; ++j) { const int n = (lane >> 3) + 8 * j; const LAS float* s = scr + (8 * c) * 33 + n;
        const int nsrc = n0 + n; const int drow = nsrc < N ? rm(nsrc) : -1;
        u32x4 o; o.x = cvtpk(s[0 * 33], s[1 * 33]); o.y = cvtpk(s[2 * 33], s[3 * 33]); o.z = cvtpk(s[4 * 33], s[5 * 33]); o.w = cvtpk(s[6 * 33], s[7 * 33]);
        if (drow >= 0) *(u32x4*)(WT + (size_t)drow * ldw + k0 + 8 * c) = o; }
    LDS_WAIT(); asm volatile("" ::: "memory");
}
DI float softplusf_(float x) { return x > 20.f ? x : log1pf(__expf(x)); }

#ifndef PROBE_REP
#define PROBE_REP -1
#endif
#ifndef P0_ROW_WAVES
#define P0_ROW_WAVES 4
#endif
DI void p0_prologue(KA A, LAS unsigned char* lds, int wave_s) {
    const int tid = tid_opaque(wave_s), lane = tid & 63, wave = __builtin_amdgcn_readfirstlane(tid >> 6);
    const int G = gridDim.x;
    constexpr int NR = P0_ROW_WAVES, NT = NWAVES - NR;
    const bool rowrole = wave < NR;
    const int gw = rowrole ? blockIdx.x * NR + wave : blockIdx.x * NT + (wave - NR), NGW = G * (rowrole ? NR : NT);
    const int gt = blockIdx.x * (NT * 64) + (tid - NR * 64), NGT = G * NT * 64;
    unsigned char* ws = A->ws;
    if (!rowrole) for (int rep = 0; rep < (PROBE_REP == 1001 ? 2 : 1); ++rep) {
        LAS float* scr = (LAS float*)(lds + wave * 16384);
        constexpr int I_IN = 16 * 153, I_OA = 8 * 32, I_OUT = 16 * 32, I_G = 16 * 88, I_D = 44 * 32;
        constexpr int NIT = I_IN + 2 * I_OA + I_OUT + 2 * I_G + I_D;
        for (int it = gw; it < NIT; it += NGW) {
            int r = it;
            if (r < I_IN) { transpose_item(A->w_in, 1024, NIN_SRC, (bf16*)(ws + WS_WIN), [](int c) -> int {
                    if (c < 640) return (c & ~63) + pos_of_d(c & 63);
                    if (c < 2816) return c;
                    if (c < 2824) return -1;
                    return c - 8; }, nullptr, scr, r, lane); continue; } r -= I_IN;
            if (r < I_OA) { transpose_item(A->w_oa, 512, 1024, (bf16*)(ws + WS_WOA), [](int c) -> int { return c; }, nullptr, scr, r, lane, 1024); continue; } r -= I_OA;
            if (r < I_OA) { transpose_item(A->w_ob, 512, 1024, (bf16*)(ws + WS_WOA) + 512, [](int c) -> int { return c; }, nullptr, scr, r, lane, 1024); continue; } r -= I_OA;
            if (r < I_OUT) { transpose_item(A->w_out, 1024, 1024, (bf16*)(ws + WS_WOUT), [](int c) -> int { return c; }, nullptr, scr, r, lane); continue; } r -= I_OUT;
            if (r < I_G) { transpose_item(A->w_gate, 1024, DFF, (bf16*)(ws + WS_WGU), [](int c) -> int { return 256 * (c >> 7) + (c & 127); }, A->norm_ffn, scr, r, lane); continue; } r -= I_G;
            if (r < I_G) { transpose_item(A->w_up, 1024, DFF, (bf16*)(ws + WS_WGU), [](int c) -> int { return 256 * (c >> 7) + 128 + (c & 127); }, A->norm_ffn, scr, r, lane); continue; } r -= I_G;
            transpose_item(A->w_down, DFF, 1024, (bf16*)(ws + WS_WD), [](int c) -> int { return c; }, nullptr, scr, r, lane);
        }
    }
    if (!rowrole) for (int rep = 0; rep < (PROBE_REP == 1002 ? 2 : 1); ++rep) {
        float* COS = (float*)(ws + WS_ROPE); float* SIN = COS + (TP + TS) * 32;
        for (int i = gt; i < (TP + TS) * 32; i += NGT) { const int ri = i >> 5, f = i & 31; const double pos = ri < TP ? (double)ri : (double)(PAST + ri - TP);
            const double inv = exp2(-(double)f * (13.287712379549449 / 32.0)), ang = pos * inv; COS[i] = (float)cos(ang); SIN[i] = (float)sin(ang); }
        constexpr int PERB = 124 * 128 / 4;
        for (int i = gt; i < SBATCH * PERB; i += NGT) { const int b = i / PERB, o = i - b * PERB;
            ((f32x4*)(A->out + O_KS))[(size_t)b * 4096 + o] = ((const f32x4*)A->cache_k)[(size_t)b * 4096 + 128 + o];
            ((f32x4*)(A->out + O_VS))[(size_t)b * 4096 + o] = ((const f32x4*)A->cache_v)[(size_t)b * 4096 + 128 + o]; }
    }
    if (rowrole) for (int rep = 0; rep < (PROBE_REP == 1003 ? 2 : 1); ++rep) {
        unsigned wab[16][4];
        f32x4 nm[4];
#pragma unroll
        for (int j = 0; j < 4; ++j) {
            nm[j] = ((const f32x4*)A->norm_mix)[lane + 64 * j];
#pragma unroll
            for (int e = 0; e < 4; ++e) { const float* p = A->w_in + (size_t)(4 * (lane + 64 * j) + e) * NIN_SRC + 2816;
                const f32x4 a = *(const f32x4*)p, b = *(const f32x4*)(p + 4);
                wab[j * 4 + e][0] = cvtpk(a[0], a[1]); wab[j * 4 + e][1] = cvtpk(a[2], a[3]); wab[j * 4 + e][2] = cvtpk(b[0], b[1]); wab[j * 4 + e][3] = cvtpk(b[2], b[3]); }
        }
        bf16* XN = (bf16*)(ws + WS_XN); f32x2* GB = (f32x2*)(ws + WS_GB);
        auto row_src = [&](int urow) -> const float* {
            if (urow < MP) { const int b = urow / TP, t = urow - b * TP; return t < NMETA ? A->meta + (size_t)t * D : A->x_prompt + ((size_t)b * SEQ + (t - NMETA)) * D; }
            if (urow < MU) return A->x_sample + (size_t)(urow - MP) * D;
            return nullptr; };
        f32x4 nx[4], nx2[4];
        { const float* s0 = gw < MUP ? row_src(gw) : nullptr; const float* s1 = gw + NGW < MUP ? row_src(gw + NGW) : nullptr;
#pragma unroll
          for (int j = 0; j < 4; ++j) { nx[j] = s0 ? ((const f32x4*)s0)[lane + 64 * j] : (f32x4){0.f, 0.f, 0.f, 0.f}; nx2[j] = s1 ? ((const f32x4*)s1)[lane + 64 * j] : (f32x4){0.f, 0.f, 0.f, 0.f}; } }
#pragma unroll 1
        for (int urow = gw; urow < MUP; urow += NGW) {
            f32x4 v[4];
#pragma unroll
            for (int j = 0; j < 4; ++j) { v[j] = nx[j]; nx[j] = nx2[j]; }
            { const int un = urow + 2 * NGW; const float* s2 = un < MUP ? row_src(un) : nullptr;
#pragma unroll
              for (int j = 0; j < 4; ++j) nx2[j] = s2 ? ((const f32x4*)s2)[lane + 64 * j] : (f32x4){0.f, 0.f, 0.f, 0.f}; }
            u32x2* o8 = (u32x2*)(XN + (size_t)urow * D) + lane;
            float ss = 0.f;
#pragma unroll
            for (int j = 0; j < 4; ++j) ss += (v[j][0] * v[j][0] + v[j][1] * v[j][1]) + (v[j][2] * v[j][2] + v[j][3] * v[j][3]);
            const float rstd = urow < MU ? rsqrtf(wave_sum(ss) * (1.0f / D) + EPS) : 0.f;
            float dot[8];
#pragma unroll
            for (int c = 0; c < 8; ++c) dot[c] = 0.f;
#pragma unroll
            for (int j = 0; j < 4; ++j) { v[j] = v[j] * rstd * nm[j];
                o8[64 * j] = (u32x2){cvtpk(v[j][0], v[j][1]), cvtpk(v[j][2], v[j][3])};
#pragma unroll
                for (int e = 0; e < 4; ++e)
#pragma unroll
                    for (int c = 0; c < 4; ++c) { dot[2 * c] += v[j][e] * bflo(wab[j * 4 + e][c]); dot[2 * c + 1] += v[j][e] * bfhi(wab[j * 4 + e][c]); } }
            float d4[4], d2[2], d1;
#pragma unroll
            for (int c = 0; c < 4; ++c) { const float keep = (lane & 32) ? dot[4 + c] : dot[c], send = (lane & 32) ? dot[c] : dot[4 + c]; d4[c] = keep + __shfl_xor(send, 32); }
#pragma unroll
            for (int c = 0; c < 2; ++c) { const float keep = (lane & 16) ? d4[2 + c] : d4[c], send = (lane & 16) ? d4[c] : d4[2 + c]; d2[c] = keep + __shfl_xor(send, 16); }
            { const float keep = (lane & 8) ? d2[1] : d2[0], send = (lane & 8) ? d2[0] : d2[1]; d1 = keep + __shfl_xor(send, 8); }
            d1 += __shfl_xor(d1, 4); d1 += __shfl_xor(d1, 2); d1 += __shfl_xor(d1, 1);
            const float a_ = __shfl(d1, ((lane & 2) ? 16 : 0) + ((lane & 1) ? 8 : 0));
            const float b_ = __shfl(d1, 32 + ((lane & 2) ? 16 : 0) + ((lane & 1) ? 8 : 0));
            if (lane < 4) {
                const float g = -__expf(A->a_log[lane]) * softplusf_(a_ + A->dt_bias[lane]);
                GB[(size_t)urow * 4 + lane] = urow < MU ? (f32x2){g, sigmoidf_(b_)} : (f32x2){0.f, 0.f};
            }
        }
    }
}
DI void item_decode(int item, int& b, int& h, bool& sample, int& t0, int& L) {
    if (item < N_ITEMS_P) { const int s = item / CHUNKS_P, c = item - s * CHUNKS_P; b = s >> 2; h = s & 3; sample = false; if (c == 0) { t0 = 0; L = NMETA; } else { t0 = NMETA + 64 * (c - 1); L = 64; } }
    else { const int s = item - N_ITEMS_P; b = s >> 2; h = s & 3; sample = true; t0 = 0; L = TS; }
}
#define LDS_BARRIER() do { asm volatile("s_waitcnt lgkmcnt(0)" ::: "memory"); __builtin_amdgcn_s_barrier(); asm volatile("" ::: "memory"); } while (0)
typedef GAS unsigned long long gu64;
typedef GAS unsigned gu32;
constexpr size_t CTL_QUEUE = 40960;
constexpr size_t CTL_F1 = 655360;
static_assert(CTL_F1 + 2592 * 64 <= 1048576, "control region map");
DI gu64* item_flag1(KA A, int item) { return (gu64*)(A->ws + WS_CTL + CTL_F1 + (size_t)item * 64); }
DI int order_item(int m) { return m < N_ITEMS_P ? (m & 31) * CHUNKS_P + (m >> 5) : m; }
DI gu32* scan_progress(KA A, int seq, int quarter) { return (gu32*)(A->ws + WS_CTL + CTL_QUEUE + (size_t)(seq * 4 + quarter) * 64); }
DI gu64* item_granule(KA A, int item) { return (gu64*)(A->ws + WS_CTL + CTL_GRAN + (size_t)item * 64); }
DI float wait_item(gu64* g, unsigned ep = 1u) {
    unsigned long long x; unsigned spins = 0;
    for (;;) { x = __hip_atomic_load(g, __ATOMIC_RELAXED, __HIP_MEMORY_SCOPE_AGENT); if ((unsigned)(x >> 32) >= ep) break; __builtin_amdgcn_s_sleep(8); if (++spins > (1u << 20)) break; }
    asm volatile("" ::: "memory");
    return __uint_as_float((unsigned)__builtin_amdgcn_readfirstlane((int)(unsigned)x));
}
constexpr int LDS_GCL = 139264;
constexpr int PITCH = 132;
DI bf16x8 frag_nat(const LAS float* src, int row, int k0) {
    const f32x4 lo = *(const LAS f32x4*)(src + row * PITCH + k0), hi = *(const LAS f32x4*)(src + row * PITCH + k0 + 4);
    return __builtin_bit_cast(bf16x8, pack8f(lo, hi));
}
struct S1Pre { u32x4 xr[11]; f32x4 w[4][2]; f32x2 gb; };
DI void stage1_issue(KA A, int item, S1Pre& P, int wave_s) {
    const int tid = tid_opaque(wave_s), lane = tid & 63, wave = __builtin_amdgcn_readfirstlane(tid >> 6);
    int b, h, t0, L; bool sample; item_decode(item, b, h, sample, t0, L);
    const bf16* QKVB = (const bf16*)(A->ws + WS_QKVB);
    const int cv = lane < 48 ? lane : 47, grp = cv >> 4, col0 = (cv & 15) * 8, r0 = wave * 8, cidx = grp * 512 + h * 128 + col0;
#pragma unroll
    for (int q = 0; q < 11; ++q) {
        const int i = r0 - 3 + q;
        long urow = sample ? (long)MP + b * TS + i : (long)b * TP + t0 + i;
        const bool ok = sample ? i >= 0 : t0 + i >= 0;
        if (!ok) urow = 0;
        P.xr[q] = *(const u32x4*)(QKVB + (size_t)urow * CONVD + cidx);
        if (!ok) P.xr[q] = (u32x4){0u, 0u, 0u, 0u};
    }
#pragma unroll
    for (int i = 0; i < 4; ++i) { P.w[i][0] = *(const f32x4*)(A->conv_w + i * CONVD + cidx); P.w[i][1] = *(const f32x4*)(A->conv_w + i * CONVD + cidx + 4); }
    P.gb = (f32x2){0.f, 0.f};
    if (wave == 7 && lane < L) { const int urow = sample ? MP + b * TS + lane : b * TP + t0 + lane; P.gb = ((const f32x2*)(A->ws + WS_GB))[(size_t)urow * 4 + h]; }
}
DI void prep_stage1(KA A, int item, int next_item, int prev_item, int wait_item_idx, int bslot, float* ats, S1Pre& P, LAS unsigned char* ldsb, unsigned ep, int wave_s, int pmode = 0) {
    const int tid = tid_opaque(wave_s), lane = tid & 63, wave = __builtin_amdgcn_readfirstlane(tid >> 6), r = lane & 31, hh = lane >> 5;
#define ST16(p, ...) __builtin_amdgcn_raw_buffer_store_b128(__builtin_bit_cast(v4u_t, (__VA_ARGS__)), rs_slot, (int)((const unsigned char*)(p) - (const unsigned char*)slot), 0, 16)
#define ST16F(p, ...) __builtin_amdgcn_raw_buffer_store_b128(__builtin_bit_cast(v4u_t, (__VA_ARGS__)), rs_ats, (int)((const unsigned char*)(p) - (const unsigned char*)ats), 0, 16)
    unsigned long long ringp = 0ull;
    if (wait_item_idx >= 0 && wave == 0) ringp = __hip_atomic_load(item_granule(A, wait_item_idx), __ATOMIC_RELAXED, __HIP_MEMORY_SCOPE_AGENT);
    int b, h, t0, L; bool sample; item_decode(item, b, h, sample, t0, L);
    LAS float* Qs = (LAS float*)ldsb; LAS float* Ks = Qs + 64 * PITCH; LAS float* Vs = Ks + 64 * PITCH; LAS float* gcs = Vs + 64 * PITCH; LAS float* betas = gcs + 64;
    unsigned char* slot = slot_ptr(A, item);
    typedef unsigned v4u_t __attribute__((__vector_size__(16)));
    const __amdgpu_buffer_rsrc_t rs_slot = __builtin_amdgcn_make_buffer_rsrc((void*)slot, 0, (int)PREP_SLOT, 0x00020000);
    const __amdgpu_buffer_rsrc_t rs_ats = __builtin_amdgcn_make_buffer_rsrc((void*)ats, 0, (int)ATS_ITEM, 0x00020000);
    if (!(pmode & 8)) {
        const int cv = lane < 48 ? lane : 47, grp = cv >> 4, col0 = (cv & 15) * 8, r0 = wave * 8, cidx = grp * 512 + h * 128 + col0;
        float x[11][8];
#pragma unroll
        for (int q = 0; q < 11; ++q) { x[q][0] = bflo(P.xr[q].x); x[q][1] = bfhi(P.xr[q].x); x[q][2] = bflo(P.xr[q].y); x[q][3] = bfhi(P.xr[q].y);
                                       x[q][4] = bflo(P.xr[q].z); x[q][5] = bfhi(P.xr[q].z); x[q][6] = bflo(P.xr[q].w); x[q][7] = bfhi(P.xr[q].w); }
        if (sample && wave == 0) {
#pragma unroll
            for (int q = 0; q < 3; ++q) { const float* sp = A->state_conv + ((size_t)b * 3 + q) * CONVD + cidx; const f32x4 s0 = *(const f32x4*)sp, s1 = *(const f32x4*)(sp + 4);
                x[q][0] = s0[0]; x[q][1] = s0[1]; x[q][2] = s0[2]; x[q][3] = s0[3]; x[q][4] = s1[0]; x[q][5] = s1[1]; x[q][6] = s1[2]; x[q][7] = s1[3]; }
        }
        float w[4][8];
#pragma unroll
        for (int i = 0; i < 4; ++i) { w[i][0] = P.w[i][0][0]; w[i][1] = P.w[i][0][1]; w[i][2] = P.w[i][0][2]; w[i][3] = P.w[i][0][3]; w[i][4] = P.w[i][1][0]; w[i][5] = P.w[i][1][1]; w[i][6] = P.w[i][1][2]; w[i][7] = P.w[i][1][3]; }
        LAS float* dst = Qs + grp * 64 * PITCH + col0;
        const float nsc = grp == 0 ? 0.08838834764831845f : 1.0f;
#pragma unroll
        for (int q = 3; q < 11; ++q) {
            const int rr = r0 + q - 3;
            float v[8]; float ss = 0.f;
#pragma unroll
            for (int e = 0; e < 8; ++e) {
                const float y = __builtin_fmaf(w[3][e], x[q][e], __builtin_fmaf(w[2][e], x[q - 1][e], __builtin_fmaf(w[1][e], x[q - 2][e], w[0][e] * x[q - 3][e])));
                const float sv = siluf_(y); v[e] = sv; ss = __builtin_fmaf(sv, sv, ss); }
            ss += __builtin_bit_cast(float, __builtin_amdgcn_update_dpp(0, __builtin_bit_cast(int, ss), 0xB1, 0xF, 0xF, true));
            ss += __builtin_bit_cast(float, __builtin_amdgcn_update_dpp(0, __builtin_bit_cast(int, ss), 0x4E, 0xF, 0xF, true));
            ss += __builtin_bit_cast(float, __builtin_amdgcn_update_dpp(0, __builtin_bit_cast(int, ss), 0x141, 0xF, 0xF, true));
            ss += __builtin_bit_cast(float, __builtin_amdgcn_update_dpp(0, __builtin_bit_cast(int, ss), 0x140, 0xF, 0xF, true));
            float sc = grp == 2 ? 1.0f : rsqrtf(ss + EPS) * nsc;
            sc = rr < L ? sc : 0.f;
            if (lane < 48) { *(LAS f32x4*)(dst + rr * PITCH) = (f32x4){v[0] * sc, v[1] * sc, v[2] * sc, v[3] * sc}; *(LAS f32x4*)(dst + rr * PITCH + 4) = (f32x4){v[4] * sc, v[5] * sc, v[6] * sc, v[7] * sc}; }
        }
    }
    if (wave == 7) {
        float gc = P.gb[0];
#pragma unroll
        for (int o = 1; o < 64; o <<= 1) { const float t = __shfl_up(gc, o); if (lane >= o) gc += t; }
        gcs[lane] = gc; betas[lane] = P.gb[1];
        if (lane == 63) ((LAS float*)(ldsb + LDS_GCL))[bslot] = __expf(gc);
    }
    asm volatile("s_waitcnt vmcnt(0)" ::: "memory");
    if (next_item < N_ITEMS) stage1_issue(A, next_item, P, wave_s);
    if (wait_item_idx >= 0 && wave == 0 && (unsigned)(ringp >> 32) < ep) (void)wait_item(item_granule(A, wait_item_idx), ep);
    LDS_BARRIER();
    if (prev_item >= 0 && tid == 0) __hip_atomic_store(item_flag1(A, prev_item), ((unsigned long long)ep << 32) | (unsigned long long)__float_as_uint(((const LAS float*)(ldsb + LDS_GCL))[bslot ^ 1]), __ATOMIC_RELAXED, __HIP_MEMORY_SCOPE_AGENT);
    if (wave < 6 && !(pmode & 4)) {
        const bool isqk = wave >= 3; const int tsel = isqk ? wave - 3 : wave, ib = tsel == 0 ? 0 : 1, jb = tsel == 2 ? 1 : 0;
        const LAS float* Asrc = isqk ? Qs : Ks;
        f32x16 acc;
#pragma unroll
        for (int e = 0; e < 16; ++e) acc[e] = 0.f;
#pragma unroll
        for (int s = 0; s < 8; ++s) acc = MFMA32(frag_nat(Asrc, 32 * ib + r, 16 * s + 8 * hh), frag_nat(Ks, 32 * jb + r, 16 * s + 8 * hh), acc);
        const int j = 32 * jb + r; const float gcj = gcs[j];
        float* Aout = ats + (ib + jb) * 1024; bf16* QKD = (bf16*)(slot + SL_QKD);
        if (!isqk) {
#pragma unroll
            for (int g4 = 0; g4 < 4; ++g4) { f32x4 v;
#pragma unroll
                for (int e = 0; e < 4; ++e) { const int i = 32 * ib + 8 * g4 + 4 * hh + e; v[e] = i > j ? betas[i] * __expf(fminf(gcs[i] - gcj, 0.f)) * acc[4 * g4 + e] : 0.f; }
                ST16F(Aout + r * 32 + 8 * g4 + 4 * hh, v); }
        } else {
            LAS float* patch = (LAS float*)(ldsb + 106496) + (wave - 3) * (32 * 36);
#pragma unroll
            for (int reg = 0; reg < 16; ++reg) { const int il = crow16(reg, hh), i = 32 * ib + il; const float dec = __expf(fminf(gcs[i] - gcj, 0.f));
                patch[il * 36 + r] = i >= j ? dec * acc[reg] : 0.f; }
            LDS_WAIT(); asm volatile("" ::: "memory");
#pragma unroll
            for (int ks2 = 0; ks2 < 2; ++ks2) { const int k0 = 16 * ks2 + 4 * hh;
                const f32x4 lo = *(const LAS f32x4*)(patch + r * 36 + k0), hi = *(const LAS f32x4*)(patch + r * 36 + k0 + 8);
                ST16((unsigned char*)QKD + ((ib * 4 + 2 * jb + ks2) * 64 + lane) * 16, pack8f(lo, hi)); }
        }
    }
    const float gcl = gcs[63];
#pragma unroll 1
    for (int job = (pmode & 4) ? 56 : wave; job < 56; job += 8) {
        if (job < 32) {
            const bool isq = job >= 16; const int jj = job & 15, rb = jj >> 3, ks = jj & 7, row = 32 * rb + r, k0 = 16 * ks + 4 * hh;
            const LAS float* src = isq ? Qs : Ks; const float sc = isq ? __expf(gcs[row]) : betas[row] * __expf(gcs[row]);
            const f32x4 lo = *(const LAS f32x4*)(src + row * PITCH + k0) * sc, hi = *(const LAS f32x4*)(src + row * PITCH + k0 + 8) * sc;
            ST16(slot + (isq ? SL_QE : SL_BEK) + ((rb * 8 + ks) * 64 + lane) * 16, pack8f(lo, hi));
        } else if (job < 48) {
            const int jj = job - 32, rb = jj >> 2, ks = jj & 3, dk = 32 * rb + r;
            f32x4 lo, hi;
#pragma unroll
            for (int e = 0; e < 4; ++e) { const int j0 = 16 * ks + 4 * hh + e, j1 = j0 + 8;
                lo[e] = Ks[j0 * PITCH + dk] * __expf(gcl - gcs[j0]); hi[e] = Ks[j1 * PITCH + dk] * __expf(gcl - gcs[j1]); }
            ST16(slot + SL_KWT + ((rb * 4 + ks) * 64 + lane) * 16, pack8f(lo, hi));
        } else {
            const int q = job - 48, w = q >> 1, ib = q & 1, dv = 32 * w + r;
            float v[16];
#pragma unroll
            for (int reg = 0; reg < 16; ++reg) { const int i = 32 * ib + crow16(reg, hh); v[reg] = betas[i] * Vs[i * PITCH + dv]; }
            u32x4* dst = (u32x4*)(slot + SL_BV + ((w * 2 + ib) * 64 + lane) * 32);
            ST16(dst, (u32x4){cvtpk(v[0], v[1]), cvtpk(v[2], v[3]), cvtpk(v[4], v[5]), cvtpk(v[6], v[7])});
            ST16(dst + 1, (u32x4){cvtpk(v[8], v[9]), cvtpk(v[10], v[11]), cvtpk(v[12], v[13]), cvtpk(v[14], v[15])});
        }
    }
    LDS_BARRIER();
}
DI void prep_stage2(KA A, int item, float gcl, const float* ats, LAS float* M, unsigned ep) {
    int lane = (int)__builtin_amdgcn_mbcnt_hi(~0u, __builtin_amdgcn_mbcnt_lo(~0u, 0u)); asm volatile("" : "+v"(lane));
    const int r = lane & 31, hh = lane >> 5, base = 32 * hh;
    unsigned char* slot = slot_ptr(A, item);
    const f32x4* Ain = (const f32x4*)ats + lane;
    f32x4 nt[12];
    asm volatile("global_load_dwordx4 %0, %12, off sc1\n\tglobal_load_dwordx4 %1, %12, off offset:1024 sc1\n\tglobal_load_dwordx4 %2, %12, off offset:2048 sc1\n\tglobal_load_dwordx4 %3, %12, off offset:3072 sc1\n\t"
                 "global_load_dwordx4 %4, %13, off sc1\n\tglobal_load_dwordx4 %5, %13, off offset:1024 sc1\n\tglobal_load_dwordx4 %6, %13, off offset:2048 sc1\n\tglobal_load_dwordx4 %7, %13, off offset:3072 sc1\n\t"
                 "global_load_dwordx4 %8, %14, off sc1\n\tglobal_load_dwordx4 %9, %14, off offset:1024 sc1\n\tglobal_load_dwordx4 %10, %14, off offset:2048 sc1\n\tglobal_load_dwordx4 %11, %14, off offset:3072 sc1\n\ts_waitcnt vmcnt(0)"
                 : "=&v"(nt[0]), "=&v"(nt[1]), "=&v"(nt[2]), "=&v"(nt[3]), "=&v"(nt[4]), "=&v"(nt[5]), "=&v"(nt[6]), "=&v"(nt[7]), "=&v"(nt[8]), "=&v"(nt[9]), "=&v"(nt[10]), "=&v"(nt[11])
                 : "v"(Ain), "v"(Ain + 256), "v"(Ain + 512) : "memory");
#pragma unroll
    for (int tt = 0; tt < 3; ++tt) { const int jb = tt >> 1, ib = (tt + 1) >> 1;
#pragma unroll
        for (int q = 0; q < 4; ++q) { const int idx = q * 64 + lane, jj = idx >> 3, i4 = idx & 7;
            *(LAS f32x4*)(M + (32 * jb + jj) * 64 + 32 * ib + 4 * i4) = nt[tt * 4 + q]; } }
    LDS_WAIT(); asm volatile("" ::: "memory");
#pragma unroll 1
    for (int rb = 0; rb < 2; ++rb) {
        float acc[16];
#pragma unroll
        for (int i = 0; i < 16; ++i) acc[i] = r == 16 * rb + i ? 1.f : 0.f;
        if (rb == 1) {
#pragma unroll 4
            for (int j = 0; j < 16; ++j) {
                float tj = M[(base + j) * 64 + base + r]; tj = r <= j ? tj : 0.f;
                const LAS f32x4* ar = (const LAS f32x4*)(M + (base + j) * 64 + base + 16);
                const f32x4 a0 = ar[0], a1 = ar[1], a2 = ar[2], a3 = ar[3];
#pragma unroll
                for (int e = 0; e < 4; ++e) { acc[e] -= a0[e] * tj; acc[4 + e] -= a1[e] * tj; acc[8 + e] -= a2[e] * tj; acc[12 + e] -= a3[e] * tj; }
            }
        }
#pragma unroll
        for (int j = 0; j < 16; ++j) {
            const float tj = acc[j]; const int row = base + 16 * rb + j;
            const LAS f32x4* ar = (const LAS f32x4*)(M + row * 64 + base + 16 * rb);
            float a[16];
#pragma unroll
            for (int q = j >> 2; q < 4; ++q) { const f32x4 v = ar[q]; a[4 * q] = v[0]; a[4 * q + 1] = v[1]; a[4 * q + 2] = v[2]; a[4 * q + 3] = v[3]; }
            if (r <= 16 * rb + j) M[row * 64 + base + r] = tj;
#pragma unroll
            for (int i = j + 1; i < 16; ++i) acc[i] -= a[i] * tj;
        }
        asm volatile("" ::: "memory");
    }
    LDS_WAIT(); asm volatile("" ::: "memory");
    f32x16 X;
#pragma unroll
    for (int e = 0; e < 16; ++e) X[e] = 0.f;
#pragma unroll
    for (int s2 = 0; s2 < 16; ++s2) { const int k = 2 * s2 + hh; const float a = M[k * 64 + 32 + r]; float bb = M[k * 64 + r]; bb = r <= k ? bb : 0.f;
        X = __builtin_amdgcn_mfma_f32_32x32x2f32(a, bb, X, 0, 0, 0); }
#pragma unroll
    for (int reg = 0; reg < 16; ++reg) M[crow16(reg, hh) * 64 + 32 + r] = X[reg];
    LDS_WAIT(); asm volatile("" ::: "memory");
    f32x16 Y;
#pragma unroll
    for (int e = 0; e < 16; ++e) Y[e] = 0.f;
#pragma unroll
    for (int s2 = 0; s2 < 16; ++s2) { const int k = 2 * s2 + hh; float a = M[(32 + r) * 64 + 32 + k]; a = k <= r ? a : 0.f; const float bb = M[k * 64 + 32 + r];
        Y = __builtin_amdgcn_mfma_f32_32x32x2f32(a, bb, Y, 0, 0, 0); }
#pragma unroll
    for (int reg = 0; reg < 16; ++reg) M[(32 + crow16(reg, hh)) * 64 + r] = -Y[reg];
    LDS_WAIT(); asm volatile("" ::: "memory");
#pragma unroll
    for (int f = 0; f < 8; ++f) { const int rb = f >> 2, ks = f & 3, row = 32 * rb + r, k0 = 16 * ks + 4 * hh;
        f32x4 lo = *(const LAS f32x4*)(M + row * 64 + k0), hi = *(const LAS f32x4*)(M + row * 64 + k0 + 8);
#pragma unroll
        for (int e = 0; e < 4; ++e) { lo[e] = k0 + e <= row ? lo[e] : 0.f; hi[e] = k0 + 8 + e <= row ? hi[e] : 0.f; }
        st16_sc1(slot + SL_T + ((rb * 4 + ks) * 64 + lane) * 16, pack8f(lo, hi)); }
    LDS_WAIT();
    asm volatile("s_waitcnt vmcnt(0)" ::: "memory");
    if (lane == 0) __hip_atomic_store(item_granule(A, item), ((unsigned long long)ep << 32) | (unsigned long long)__float_as_uint(gcl), __ATOMIC_RELAXED, __HIP_MEMORY_SCOPE_AGENT);
}
DI void scan_seq(KA A, int seq, int w, int lane, unsigned ep) {
    const int r = lane & 31, hh = lane >> 5, dv = 32 * w + r;
    const bool sample = seq >= N_PROMPT_SEQ; const int sidx = sample ? seq - N_PROMPT_SEQ : seq, b = sidx >> 2, h = sidx & 3, nch = sample ? 1 : CHUNKS_P;
    f32x16 S[4];
    if (sample) {
        const float* S0 = A->state_delta + ((size_t)(b * 4 + h) * 128) * 128 + dv;
#pragma unroll
        for (int kb = 0; kb < 4; ++kb)
#pragma unroll
            for (int reg = 0; reg < 16; ++reg) S[kb][reg] = S0[(size_t)(32 * kb + crow16(reg, hh)) * 128];
    } else {
#pragma unroll
        for (int kb = 0; kb < 4; ++kb)
#pragma unroll
            for (int reg = 0; reg < 16; ++reg) S[kb][reg] = 0.f;
    }
    bf16* OBR = (bf16*)((unsigned char*)A->out + DO_OB);
#pragma unroll 1
    for (int c = 0; c < nch; ++c) {
        const int item = sample ? N_ITEMS_P + sidx : seq * CHUNKS_P + c;
        const unsigned char* slot = slot_ptr(A, item);
        const float gcl = wait_item(item_granule(A, item), ep);
        __builtin_amdgcn_fence(__ATOMIC_ACQUIRE, "agent");
        const bf16x8* bek = (const bf16x8*)(slot + SL_BEK) + lane; const bf16x8* tp = (const bf16x8*)(slot + SL_T) + lane;
        const bf16x8* qe = (const bf16x8*)(slot + SL_QE) + lane; const bf16x8* qkd = (const bf16x8*)(slot + SL_QKD) + lane; const bf16x8* kwt = (const bf16x8*)(slot + SL_KWT) + lane;
        bf16x8 sf[8];
#pragma unroll
        for (int kb = 0; kb < 4; ++kb) { sf[2 * kb] = pack_step<0>(S[kb]); sf[2 * kb + 1] = pack_step<1>(S[kb]); }
        f32x16 x0, x1;
#pragma unroll
        for (int e = 0; e < 16; ++e) { x0[e] = 0.f; x1[e] = 0.f; }
#pragma unroll
        for (int ks = 0; ks < 8; ++ks) { x0 = MFMA32(bek[ks * 64], sf[ks], x0); x1 = MFMA32(bek[(8 + ks) * 64], sf[ks], x1); }
        {
            const u32x4* bv = (const u32x4*)(slot + SL_BV) + ((w * 2) * 64 + lane) * 2;
            const u32x4 a0 = bv[0], a1 = bv[1], c0 = bv[128], c1 = bv[129];
            x0[0] = bflo(a0.x) - x0[0]; x0[1] = bfhi(a0.x) - x0[1]; x0[2] = bflo(a0.y) - x0[2]; x0[3] = bfhi(a0.y) - x0[3];
            x0[4] = bflo(a0.z) - x0[4]; x0[5] = bfhi(a0.z) - x0[5]; x0[6] = bflo(a0.w) - x0[6]; x0[7] = bfhi(a0.w) - x0[7];
            x0[8] = bflo(a1.x) - x0[8]; x0[9] = bfhi(a1.x) - x0[9]; x0[10] = bflo(a1.y) - x0[10]; x0[11] = bfhi(a1.y) - x0[11];
            x0[12] = bflo(a1.z) - x0[12]; x0[13] = bfhi(a1.z) - x0[13]; x0[14] = bflo(a1.w) - x0[14]; x0[15] = bfhi(a1.w) - x0[15];
            x1[0] = bflo(c0.x) - x1[0]; x1[1] = bfhi(c0.x) - x1[1]; x1[2] = bflo(c0.y) - x1[2]; x1[3] = bfhi(c0.y) - x1[3];
            x1[4] = bflo(c0.z) - x1[4]; x1[5] = bfhi(c0.z) - x1[5]; x1[6] = bflo(c0.w) - x1[6]; x1[7] = bfhi(c0.w) - x1[7];
            x1[8] = bflo(c1.x) - x1[8]; x1[9] = bfhi(c1.x) - x1[9]; x1[10] = bflo(c1.y) - x1[10]; x1[11] = bfhi(c1.y) - x1[11];
            x1[12] = bflo(c1.z) - x1[12]; x1[13] = bfhi(c1.z) - x1[13]; x1[14] = bflo(c1.w) - x1[14]; x1[15] = bfhi(c1.w) - x1[15];
        }
        bf16x8 rf[4] = {pack_step<0>(x0), pack_step<1>(x0), pack_step<0>(x1), pack_step<1>(x1)};
        f32x16 u0, u1;
#pragma unroll
        for (int e = 0; e < 16; ++e) { u0[e] = 0.f; u1[e] = 0.f; }
        u0 = MFMA32(tp[0 * 64], rf[0], u0); u0 = MFMA32(tp[1 * 64], rf[1], u0);
#pragma unroll
        for (int ks = 0; ks < 4; ++ks) u1 = MFMA32(tp[(4 + ks) * 64], rf[ks], u1);
        bf16x8 uf[4] = {pack_step<0>(u0), pack_step<1>(u0), pack_step<0>(u1), pack_step<1>(u1)};
        if (sample || c > 0) {
#pragma unroll
            for (int e = 0; e < 16; ++e) { x0[e] = 0.f; x1[e] = 0.f; }
#pragma unroll
            for (int ks = 0; ks < 8; ++ks) { x0 = MFMA32(qe[ks * 64], sf[ks], x0); x1 = MFMA32(qe[(8 + ks) * 64], sf[ks], x1); }
            x0 = MFMA32(qkd[0 * 64], uf[0], x0); x0 = MFMA32(qkd[1 * 64], uf[1], x0);
#pragma unroll
            for (int ks = 0; ks < 4; ++ks) x1 = MFMA32(qkd[(4 + ks) * 64], uf[ks], x1);
            const int crow0 = sample ? NBATCH * SEQ + b * TS : b * SEQ + 64 * (c - 1), L = sample ? TS : 64;
#pragma unroll
            for (int reg = 0; reg < 16; ++reg) { const int i0 = crow16(reg, hh), i1 = 32 + i0;
                if (i0 < L) OBR[(size_t)(crow0 + i0) * OAB_PITCH + h * 128 + dv] = f2bf(x0[reg]);
                if (i1 < L) OBR[(size_t)(crow0 + i1) * OAB_PITCH + h * 128 + dv] = f2bf(x1[reg]); }
        }
#pragma unroll
        for (int kb = 0; kb < 4; ++kb) {
            S[kb] = S[kb] * gcl;
#pragma unroll
            for (int ks = 0; ks < 4; ++ks) S[kb] = MFMA32(kwt[(kb * 4 + ks) * 64], uf[ks], S[kb]);
        }
    }
    float* So = A->out + (sample ? O_DS : O_DP) + ((size_t)(b * 4 + h) * 128) * 128 + dv;
#pragma unroll
    for (int kb = 0; kb < 4; ++kb)
#pragma unroll
        for (int reg = 0; reg < 16; ++reg) So[(size_t)(32 * kb + crow16(reg, hh)) * 128] = S[kb][reg];
}

constexpr int HALF_BYTES = 40960;
constexpr int OPITCH = 136, OBUF_BYTES = 64 * OPITCH * 2, OBUF0 = 83968;
static_assert(OBUF0 >= 2 * HALF_BYTES + 64 && OBUF0 + 2 * OBUF_BYTES <= LDS_MISC, "scan LDS map");
DI void scan_prompt_wg(KA A, int seq, LAS unsigned char* lds, unsigned ep, int wave_s) {
    const int tid = tid_opaque(wave_s), lane = tid & 63, wave = __builtin_amdgcn_readfirstlane(tid >> 6);
    const int b = seq >> 2, h = seq & 3;
    constexpr int N = 2 * CHUNKS_P;
    if (wave >= 4) {
        const int loff = (wave - 4) * 10240 + lane * 16;
        u32x4 r0[10], r1[10], r2[10], r3[10];
        const int loff_a = loff + (wave == 7 ? (1 << 20) : 0), loff_b = loff + (wave == 4 ? (1 << 20) : 0);
        LAS u32x4* d0 = (LAS u32x4*)(lds + loff); LAS u32x4* d1 = (LAS u32x4*)(lds + HALF_BYTES + loff);
        LAS float* gclw = (LAS float*)(lds + 2 * HALF_BYTES);
        unsigned long long pv;
#define SL_PEEK(c) do { if ((c) < CHUNKS_P) pv = __hip_atomic_load(item_granule(A, seq * CHUNKS_P + (c)), __ATOMIC_RELAXED, __HIP_MEMORY_SCOPE_AGENT); } while (0)
#define SL_POLL(c) do { float g_; if ((unsigned)(pv >> 32) >= ep) { asm volatile("" ::: "memory"); g_ = __uint_as_float((unsigned)__builtin_amdgcn_readfirstlane((int)(unsigned)pv)); } \
            else g_ = wait_item(item_granule(A, seq * CHUNKS_P + (c)), ep); if (wave == 4 && lane == 0) gclw[(c) & 7] = g_; } while (0)
#define SL_ISSUE(h, R) do { const __amdgpu_buffer_rsrc_t rs_ = __builtin_amdgcn_make_buffer_rsrc((void*)slot_ptr(A, seq * CHUNKS_P + ((h) >> 1)), 0, (int)PREP_SLOT, 0x00020000); \
            _Pragma("unroll") for (int q = 0; q < 10; ++q) R[q] = __builtin_bit_cast(u32x4, __builtin_amdgcn_raw_buffer_load_b128(rs_, ((h) & 1) ? ((q == 2 || q == 3) ? loff_b : loff) : ((q == 4 || q == 5) ? loff_a : loff), ((h) & 1) * HALF_BYTES + q * 1024, 16)); } while (0)
#define SL_WRITE(D, R) do { LAS u32x4* D_ = D; asm volatile("" : "+v"(D_)); _Pragma("unroll") for (int q = 0; q < 10; ++q) D_[q * 64] = R[q]; } while (0)
#define SL_STEP(k, D, R, FIRST) do { if ((k) < N) { \
            if ((k) + 1 < N) SL_WRITE(D, R); \
            LDS_BARRIER(); \
            if ((k) + 5 < N) { if (FIRST) { SL_POLL(((k) + 5) >> 1); SL_PEEK(((k) + 7) >> 1); } SL_ISSUE((k) + 5, R); } } } while (0)
        SL_PEEK(0); SL_POLL(0); SL_ISSUE(0, r0); SL_ISSUE(1, r1);
        SL_PEEK(1); SL_POLL(1); SL_ISSUE(2, r2); SL_ISSUE(3, r3);
        SL_WRITE(d0, r0);
        LDS_BARRIER();
        SL_PEEK(2); SL_POLL(2); SL_PEEK(3); SL_ISSUE(4, r0);
#define SL_S4(k) SL_STEP(k, d1, r1, false); SL_STEP((k) + 1, d0, r2, true); SL_STEP((k) + 2, d1, r3, false); SL_STEP((k) + 3, d0, r0, true);
#define SL_S20(k) SL_S4(k) SL_S4((k) + 4) SL_S4((k) + 8) SL_S4((k) + 12) SL_S4((k) + 16)
        SL_S20(0) SL_S20(20) SL_S20(40) SL_S20(60) SL_S20(80) SL_S20(100) SL_S4(120) SL_S4(124) SL_S4(128)
        static_assert(N <= 132, "scan loader steps");
#undef SL_S20
#undef SL_S4
#undef SL_PEEK
#undef SL_POLL
#undef SL_ISSUE
#undef SL_WRITE
#undef SL_STEP
    } else {
        const int w = wave, r = lane & 31, hh = lane >> 5, dv = 32 * w + r;
        f32x16 S[4];
#pragma unroll
        for (int kb = 0; kb < 4; ++kb)
#pragma unroll
            for (int reg = 0; reg < 16; ++reg) S[kb][reg] = 0.f;
        bf16x8 uf[4], kw2[8];
#pragma unroll
        for (int i = 0; i < 4; ++i) uf[i] = (bf16x8){0, 0, 0, 0, 0, 0, 0, 0};
#pragma unroll
        for (int i = 0; i < 8; ++i) kw2[i] = (bf16x8){0, 0, 0, 0, 0, 0, 0, 0};
        float gprev = 1.0f;
        const LAS float* gclw = (const LAS float*)(lds + 2 * HALF_BYTES);
        const LAS bf16x8* bek = (const LAS bf16x8*)(lds + SL_BEK) + lane; const LAS bf16x8* tp = (const LAS bf16x8*)(lds + SL_T) + lane;
        const LAS u32x4* bv = (const LAS u32x4*)(lds + SL_BV) + ((w * 2) * 64 + lane) * 2;
        const LAS bf16x8* qkd = (const LAS bf16x8*)(lds + HALF_BYTES + (SL_QKD - HALF_BYTES)) + lane; const LAS bf16x8* qe = (const LAS bf16x8*)(lds + HALF_BYTES + (SL_QE - HALF_BYTES)) + lane;
        const LAS bf16x8* kwt = (const LAS bf16x8*)(lds + HALF_BYTES + (SL_KWT - HALF_BYTES)) + lane;
#define SB() __builtin_amdgcn_sched_barrier(0)
        const int nrow = 4 * w + (lane >> 4), ndv0 = 8 * (lane & 15);
        const int loff_o = OBUF0 + nrow * (OPITCH * 2) + ndv0 * 2;
        bf16* obase = (bf16*)((unsigned char*)A->out + DO_OB) + (size_t)(b * SEQ + nrow) * OAB_PITCH + h * 128 + ndv0;
        gu32* prog = scan_progress(A, seq, w);
#define SC_COPYOUT(cp) do { _Pragma("unroll") for (int q = 0; q < 4; ++q) { const u32x4 ow = *(const LAS u32x4*)(lds + loff_o + ((cp) & 1) * OBUF_BYTES + (16 * q) * (OPITCH * 2)); \
            st16_sc1(obase + (size_t)(64 * ((cp) - 1) + 16 * q) * OAB_PITCH, ow); } } while (0)
        LDS_BARRIER();
#pragma unroll 1
        for (int c = 0; c < CHUNKS_P; ++c) {
            if (c >= 4) { asm volatile("s_waitcnt vmcnt(4)" ::: "memory"); if (lane == 0) __hip_atomic_store(prog, ep * 256u + (unsigned)(c - 3), __ATOMIC_RELAXED, __HIP_MEMORY_SCOPE_AGENT); }
            if (c >= 2) SC_COPYOUT(c - 1);
            bf16x8 g0[8], g1[8];
#pragma unroll
            for (int ks = 0; ks < 4; ++ks) { g0[ks] = bek[ks * 64]; g0[4 + ks] = bek[(8 + ks) * 64]; }
            SB();
#pragma unroll
            for (int kb = 2; kb < 4; ++kb) {
                S[kb] = S[kb] * gprev;
#pragma unroll
                for (int ks = 0; ks < 4; ++ks) S[kb] = MFMA32(kw2[(kb - 2) * 4 + ks], uf[ks], S[kb]);
            }
            bf16x8 sf[8];
#pragma unroll
            for (int kb = 0; kb < 4; ++kb) { sf[2 * kb] = pack_step<0>(S[kb]); sf[2 * kb + 1] = pack_step<1>(S[kb]); }
            SB();
#pragma unroll
            for (int ks = 0; ks < 4; ++ks) { g1[ks] = bek[(4 + ks) * 64]; g1[4 + ks] = bek[(12 + ks) * 64]; }
            SB();
            f32x16 x0, x1;
#pragma unroll
            for (int e = 0; e < 16; ++e) { x0[e] = 0.f; x1[e] = 0.f; }
#pragma unroll
            for (int ks = 0; ks < 4; ++ks) { x0 = MFMA32(g0[ks], sf[ks], x0); x1 = MFMA32(g0[4 + ks], sf[ks], x1); }
            SB();
            const u32x4 a0 = bv[0], a1 = bv[1], c0 = bv[128], c1 = bv[129];
            bf16x8 tf[6];
            tf[0] = tp[0 * 64]; tf[1] = tp[1 * 64];
#pragma unroll
            for (int ks = 0; ks < 4; ++ks) tf[2 + ks] = tp[(4 + ks) * 64];
            SB();
#pragma unroll
            for (int ks = 0; ks < 4; ++ks) { x0 = MFMA32(g1[ks], sf[4 + ks], x0); x1 = MFMA32(g1[4 + ks], sf[4 + ks], x1); }
            {
                x0[0] = bflo(a0.x) - x0[0]; x0[1] = bfhi(a0.x) - x0[1]; x0[2] = bflo(a0.y) - x0[2]; x0[3] = bfhi(a0.y) - x0[3];
                x0[4] = bflo(a0.z) - x0[4]; x0[5] = bfhi(a0.z) - x0[5]; x0[6] = bflo(a0.w) - x0[6]; x0[7] = bfhi(a0.w) - x0[7];
                x0[8] = bflo(a1.x) - x0[8]; x0[9] = bfhi(a1.x) - x0[9]; x0[10] = bflo(a1.y) - x0[10]; x0[11] = bfhi(a1.y) - x0[11];
                x0[12] = bflo(a1.z) - x0[12]; x0[13] = bfhi(a1.z) - x0[13]; x0[14] = bflo(a1.w) - x0[14]; x0[15] = bfhi(a1.w) - x0[15];
                x1[0] = bflo(c0.x) - x1[0]; x1[1] = bfhi(c0.x) - x1[1]; x1[2] = bflo(c0.y) - x1[2]; x1[3] = bfhi(c0.y) - x1[3];
                x1[4] = bflo(c0.z) - x1[4]; x1[5] = bfhi(c0.z) - x1[5]; x1[6] = bflo(c0.w) - x1[6]; x1[7] = bfhi(c0.w) - x1[7];
                x1[8] = bflo(c1.x) - x1[8]; x1[9] = bfhi(c1.x) - x1[9]; x1[10] = bflo(c1.y) - x1[10]; x1[11] = bfhi(c1.y) - x1[11];
                x1[12] = bflo(c1.z) - x1[12]; x1[13] = bfhi(c1.z) - x1[13]; x1[14] = bflo(c1.w) - x1[14]; x1[15] = bfhi(c1.w) - x1[15];
            }
            const bf16x8 rf[4] = {pack_step<0>(x0), pack_step<1>(x0), pack_step<0>(x1), pack_step<1>(x1)};
            LDS_BARRIER();
#pragma unroll
            for (int ks = 0; ks < 4; ++ks) { g0[ks] = qe[ks * 64]; g0[4 + ks] = qe[(8 + ks) * 64]; }
            SB();
            f32x16 u0, u1;
#pragma unroll
            for (int e = 0; e < 16; ++e) { u0[e] = 0.f; u1[e] = 0.f; }
            u0 = MFMA32(tf[0], rf[0], u0); u1 = MFMA32(tf[2], rf[0], u1); u0 = MFMA32(tf[1], rf[1], u0);
#pragma unroll
            for (int ks = 1; ks < 4; ++ks) u1 = MFMA32(tf[2 + ks], rf[ks], u1);
            uf[0] = pack_step<0>(u0); uf[1] = pack_step<1>(u0); uf[2] = pack_step<0>(u1); uf[3] = pack_step<1>(u1);
            SB();
#pragma unroll
            for (int ks = 0; ks < 4; ++ks) { g1[ks] = qe[(4 + ks) * 64]; g1[4 + ks] = qe[(12 + ks) * 64]; }
            SB();
#pragma unroll
            for (int e = 0; e < 16; ++e) { x0[e] = 0.f; x1[e] = 0.f; }
#pragma unroll
            for (int ks = 0; ks < 4; ++ks) { x0 = MFMA32(g0[ks], sf[ks], x0); x1 = MFMA32(g0[4 + ks], sf[ks], x1); }
            SB();
            bf16x8 qk[6];
            qk[0] = qkd[0 * 64]; qk[1] = qkd[1 * 64];
#pragma unroll
            for (int ks = 0; ks < 4; ++ks) qk[2 + ks] = qkd[(4 + ks) * 64];
            SB();
#pragma unroll
            for (int ks = 0; ks < 4; ++ks) { x0 = MFMA32(g1[ks], sf[4 + ks], x0); x1 = MFMA32(g1[4 + ks], sf[4 + ks], x1); }
            SB();
#pragma unroll
            for (int i = 0; i < 8; ++i) g0[i] = kwt[i * 64];
            SB();
            x0 = MFMA32(qk[0], uf[0], x0); x1 = MFMA32(qk[2], uf[0], x1); x0 = MFMA32(qk[1], uf[1], x0);
#pragma unroll
            for (int ks = 1; ks < 4; ++ks) x1 = MFMA32(qk[2 + ks], uf[ks], x1);
            SB();
#pragma unroll
            for (int i = 0; i < 8; ++i) kw2[i] = kwt[(8 + i) * 64];
            const float gcl = gclw[c & 7];
            SB();
#pragma unroll
            for (int kb = 0; kb < 2; ++kb) {
                S[kb] = S[kb] * gcl;
#pragma unroll
                for (int ks = 0; ks < 4; ++ks) S[kb] = MFMA32(g0[kb * 4 + ks], uf[ks], S[kb]);
            }
            if (c > 0) {
                LAS bf16* orow = (LAS bf16*)(lds + OBUF0 + (c & 1) * OBUF_BYTES) + dv;
#pragma unroll
                for (int reg = 0; reg < 16; ++reg) { const int i0 = crow16(reg, hh); orow[i0 * OPITCH] = f2bf(x0[reg]); orow[(32 + i0) * OPITCH] = f2bf(x1[reg]); }
            }
            gprev = gcl;
            LDS_BARRIER();
        }
#pragma unroll
        for (int kb = 2; kb < 4; ++kb) {
            S[kb] = S[kb] * gprev;
#pragma unroll
            for (int ks = 0; ks < 4; ++ks) S[kb] = MFMA32(kw2[(kb - 2) * 4 + ks], uf[ks], S[kb]);
        }
#undef SB
        asm volatile("s_waitcnt vmcnt(0)" ::: "memory");
        if (lane == 0) __hip_atomic_store(prog, ep * 256u + (unsigned)(CHUNKS_P - 2), __ATOMIC_RELAXED, __HIP_MEMORY_SCOPE_AGENT);
        {
            constexpr int cp = CHUNKS_P - 1;
            const bf16* zp = (const bf16*)(A->ws + WS_Z) + (size_t)(b * TP + NMETA + 64 * (cp - 1) + nrow) * 512 + h * 128 + ndv0;
            u32x4 zw[4];
#pragma unroll
            for (int q = 0; q < 4; ++q) zw[q] = *(const u32x4*)(zp + (size_t)16 * q * 512);
#pragma unroll
            for (int q = 0; q < 4; ++q) {
                const u32x4 ow = *(const LAS u32x4*)(lds + loff_o + (cp & 1) * OBUF_BYTES + (16 * q) * (OPITCH * 2));
                const f32x4 a = {bflo(ow.x), bfhi(ow.x), bflo(ow.y), bfhi(ow.y)}, cc = {bflo(ow.z), bfhi(ow.z), bflo(ow.w), bfhi(ow.w)};
                float ss = (a[0] * a[0] + a[1] * a[1]) + (a[2] * a[2] + a[3] * a[3]) + (cc[0] * cc[0] + cc[1] * cc[1]) + (cc[2] * cc[2] + cc[3] * cc[3]);
                ss += __shfl_xor(ss, 1); ss += __shfl_xor(ss, 2); ss += __shfl_xor(ss, 4); ss += __shfl_xor(ss, 8);
                const float rstd = rsqrtf(ss * (1.0f / 128.0f) + EPS);
                f32x4 y0, y1;
                y0[0] = a[0] * rstd * bflo(zw[q].x); y0[1] = a[1] * rstd * bfhi(zw[q].x); y0[2] = a[2] * rstd * bflo(zw[q].y); y0[3] = a[3] * rstd * bfhi(zw[q].y);
                y1[0] = cc[0] * rstd * bflo(zw[q].z); y1[1] = cc[1] * rstd * bfhi(zw[q].z); y1[2] = cc[2] * rstd * bflo(zw[q].w); y1[3] = cc[3] * rstd * bfhi(zw[q].w);
                *(u32x4*)(obase + (size_t)(64 * (cp - 1) + 16 * q) * OAB_PITCH) = pack8f(y0, y1);
            }
        }
#undef SC_COPYOUT
        float* So = A->out + O_DP + ((size_t)(b * 4 + h) * 128) * 128 + dv;
#pragma unroll
        for (int kb = 0; kb < 4; ++kb)
#pragma unroll
            for (int reg = 0; reg < 16; ++reg) So[(size_t)(32 * kb + crow16(reg, hh)) * 128] = S[kb][reg];
    }
}

constexpr int KPITCH = 72, VPITCH = 264;
typedef short v4i16_t __attribute__((ext_vector_type(4)));
DI void attn_unit(KA A, int unit, LAS unsigned char* ldsb, int wave_s) {
    const int tid = tid_opaque(wave_s), lane = tid & 63, wave = __builtin_amdgcn_readfirstlane(tid >> 6), r = lane & 31, hh = lane >> 5;
    const int b = unit >> 6, kh = (unit >> 5) & 1, jb = unit & 31, T0 = NMETA + 128 * jb;
    LAS bf16* Ksm = (LAS bf16*)ldsb; LAS bf16* VTs = Ksm + 256 * KPITCH;
    const bf16* KVg = (const bf16*)(A->ws + WS_KV); const bf16* QAg = (const bf16*)(A->ws + WS_QA);
#pragma unroll
    for (int e4 = 0; e4 < 4; ++e4) {
        const int id = tid + 512 * e4, key = id >> 3, cch = id & 7, tk = T0 - 128 + key;
        u32x4 kq = (u32x4){0u, 0u, 0u, 0u}, vq = kq;
        if (tk >= 0) { const bf16* src = KVg + (size_t)(b * TP + tk) * 256 + kh * 64 + 8 * cch; kq = *(const u32x4*)src; vq = *(const u32x4*)(src + 128); }
        *(LAS u32x4*)(Ksm + key * KPITCH + 8 * cch) = kq;
        *(LAS u32x4*)(VTs + key * KPITCH + 8 * cch) = vq;
    }
    LDS_BARRIER();
    const int g = wave >> 1, qh = wave & 1, head = 4 * kh + g;
    const float sink2 = A->sinks[head] * 1.4426950408889634f;
    const int kmin = jb == 0 ? 128 - NMETA : 0;
#pragma unroll 1
    for (int q2 = 0; q2 < 2; ++q2) {
        const int qb = 2 * qh + q2, iq = 32 * qb + r;
        const bf16* qrow = QAg + (size_t)(b * TP + T0 + iq) * 512 + head * 64 + 8 * hh;
        bf16x8 qf[4];
#pragma unroll
        for (int s = 0; s < 4; ++s) qf[s] = *(const bf16x8*)(qrow + 16 * s);
        f32x16 st[5];
        float m = sink2;
#pragma unroll
        for (int kt5 = 0; kt5 < 5; ++kt5) {
            const int kt = qb + kt5;
            f32x16 acc;
#pragma unroll
            for (int e = 0; e < 16; ++e) acc[e] = 0.f;
#pragma unroll
            for (int s = 0; s < 4; ++s) acc = MFMA32(*(const LAS bf16x8*)(Ksm + (32 * kt + r) * KPITCH + 16 * s + 8 * hh), qf[s], acc);
#pragma unroll
            for (int reg = 0; reg < 16; ++reg) { const int kk = 32 * kt + crow16(reg, hh); const bool ok = kk >= iq && kk <= iq + 128 && kk >= kmin;
                acc[reg] = ok ? acc[reg] : -INFINITY; m = fmaxf(m, acc[reg]); }
            st[kt5] = acc;
        }
        m = fmaxf(m, __shfl_xor(m, 32));
        float l = 0.f;
#pragma unroll
        for (int kt5 = 0; kt5 < 5; ++kt5)
#pragma unroll
            for (int reg = 0; reg < 16; ++reg) { const float p = exp2f(st[kt5][reg] - m); st[kt5][reg] = p; l += p; }
        l += __shfl_xor(l, 32); l += exp2f(sink2 - m);
        f32x16 o0, o1;
#pragma unroll
        for (int e = 0; e < 16; ++e) { o0[e] = 0.f; o1[e] = 0.f; }
#pragma unroll
        for (int kt5 = 0; kt5 < 5; ++kt5) {
            const int kt = qb + kt5;
            const bf16x8 p0 = pack_step<0>(st[kt5]), p1 = pack_step<1>(st[kt5]);
            const LAS bf16* vb = VTs + (32 * kt + 4 * hh + ((lane & 15) >> 2)) * KPITCH + 16 * ((lane >> 4) & 1) + 4 * (lane & 3);
#define VTR(ptr) __builtin_amdgcn_ds_read_tr16_b64_v4i16((LAS v4i16_t*)(ptr))
            const v4i16_t a00 = VTR(vb), a01 = VTR(vb + 8 * KPITCH), a10 = VTR(vb + 16 * KPITCH), a11 = VTR(vb + 24 * KPITCH);
            const v4i16_t b00 = VTR(vb + 32), b01 = VTR(vb + 8 * KPITCH + 32), b10 = VTR(vb + 16 * KPITCH + 32), b11 = VTR(vb + 24 * KPITCH + 32);
#undef VTR
            o0 = MFMA32(__builtin_shufflevector(a00, a01, 0, 1, 2, 3, 4, 5, 6, 7), p0, o0); o0 = MFMA32(__builtin_shufflevector(a10, a11, 0, 1, 2, 3, 4, 5, 6, 7), p1, o0);
            o1 = MFMA32(__builtin_shufflevector(b00, b01, 0, 1, 2, 3, 4, 5, 6, 7), p0, o1); o1 = MFMA32(__builtin_shufflevector(b10, b11, 0, 1, 2, 3, 4, 5, 6, 7), p1, o1);
        }
        const float rl = 1.0f / l;
        bf16* orow = (bf16*)((unsigned char*)A->out + DO_OA) + (size_t)(b * SEQ + 128 * jb + iq) * OAB_PITCH + head * 64 + 4 * hh;
#pragma unroll
        for (int g4 = 0; g4 < 4; ++g4) {
            *(u32x2*)(orow + 8 * g4) = (u32x2){cvtpk(o0[4 * g4] * rl, o0[4 * g4 + 1] * rl), cvtpk(o0[4 * g4 + 2] * rl, o0[4 * g4 + 3] * rl)};
            *(u32x2*)(orow + 32 + 8 * g4) = (u32x2){cvtpk(o1[4 * g4] * rl, o1[4 * g4 + 1] * rl), cvtpk(o1[4 * g4 + 2] * rl, o1[4 * g4 + 3] * rl)};
        }
    }
    LDS_BARRIER();
}
DI void sample_attn(KA A, int b, int head, LAS float* wl, int lane) {
    const int kh = head >> 2;
    LAS float* qn = wl; LAS float* ps = wl + 256;
    const bf16* QAg = (const bf16*)(A->ws + WS_QA); const bf16* KVg = (const bf16*)(A->ws + WS_KV);
    u32x4 nk[8];
    { const u32x4* kn = (const u32x4*)(KVg + (size_t)(MP + b * TS + (lane & 3)) * 256 + kh * 64);
#pragma unroll
      for (int i = 0; i < 8; ++i) nk[i] = kn[i]; }
#pragma unroll
    for (int i = 0; i < 4; ++i) qn[i * 64 + lane] = bf2f(QAg[(size_t)(MP + b * TS + i) * 512 + head * 64 + pos_of_d(lane)]);
    const float sink2 = A->sinks[head] * 1.4426950408889634f;
    LDS_WAIT(); asm volatile("" ::: "memory");
    float s0[4] = {0.f, 0.f, 0.f, 0.f}, s1[4] = {0.f, 0.f, 0.f, 0.f}, s2[4] = {0.f, 0.f, 0.f, 0.f};
    const f32x4* kr0 = (const f32x4*)(A->cache_k + ((size_t)(b * 128 + lane) * 2 + kh) * 64);
#pragma unroll 1
    for (int c = 0; c < 2; ++c) {
        f32x4 k0[8], k1[8];
#pragma unroll
        for (int d = 0; d < 8; ++d) { k0[d] = kr0[8 * c + d]; k1[d] = kr0[8 * c + d + 64 * 2 * 16]; }
#pragma unroll
        for (int d = 0; d < 8; ++d) {
#pragma unroll
            for (int i = 0; i < 4; ++i) { const f32x4 q = *(const LAS f32x4*)(qn + i * 64 + 32 * c + 4 * d);
                s0[i] = __builtin_fmaf(k0[d][3], q[3], __builtin_fmaf(k0[d][2], q[2], __builtin_fmaf(k0[d][1], q[1], __builtin_fmaf(k0[d][0], q[0], s0[i]))));
                s1[i] = __builtin_fmaf(k1[d][3], q[3], __builtin_fmaf(k1[d][2], q[2], __builtin_fmaf(k1[d][1], q[1], __builtin_fmaf(k1[d][0], q[0], s1[i])))); }
        }
        asm volatile("" : "+v"(s0[0]), "+v"(s0[1]), "+v"(s0[2]), "+v"(s0[3]), "+v"(s1[0]), "+v"(s1[1]), "+v"(s1[2]), "+v"(s1[3]));
    }
#pragma unroll
    for (int g8 = 0; g8 < 8; ++g8) {
        const float e0 = bflo(nk[g8].x), e1 = bfhi(nk[g8].x), e2 = bflo(nk[g8].y), e3 = bfhi(nk[g8].y), e4 = bflo(nk[g8].z), e5 = bfhi(nk[g8].z), e6 = bflo(nk[g8].w), e7 = bfhi(nk[g8].w);
#pragma unroll
        for (int i = 0; i < 4; ++i) { const f32x4 qa = *(const LAS f32x4*)(qn + i * 64 + 4 * g8), qb = *(const LAS f32x4*)(qn + i * 64 + 32 + 4 * g8);
            s2[i] = __builtin_fmaf(e3, qa[3], __builtin_fmaf(e2, qa[2], __builtin_fmaf(e1, qa[1], __builtin_fmaf(e0, qa[0], s2[i]))));
            s2[i] = __builtin_fmaf(e7, qb[3], __builtin_fmaf(e6, qb[2], __builtin_fmaf(e5, qb[1], __builtin_fmaf(e4, qb[0], s2[i])))); }
        asm volatile("" : "+v"(s2[0]), "+v"(s2[1]), "+v"(s2[2]), "+v"(s2[3]));
    }
#pragma unroll
    for (int i = 0; i < 4; ++i) { ps[i * 132 + lane] = lane >= i ? s0[i] : -INFINITY; ps[i * 132 + 64 + lane] = s1[i]; if (lane < 4) ps[i * 132 + 128 + lane] = lane <= i ? s2[i] : -INFINITY; }
    const int kg = lane >> 4, d4l = lane & 15;
    const u32x2 vn = *(const u32x2*)(KVg + (size_t)(MP + b * TS + kg) * 256 + 128 + kh * 64 + 4 * d4l);
    LDS_WAIT(); asm volatile("" ::: "memory");
    float linv[4];
#pragma unroll
    for (int i = 0; i < 4; ++i) {
        const float t0 = ps[i * 132 + lane], t1 = ps[i * 132 + 64 + lane], t2 = lane < 4 ? ps[i * 132 + 128 + lane] : -INFINITY;
        const float m = wave_max(fmaxf(fmaxf(t0, t1), fmaxf(t2, sink2)));
        const float p0 = exp2f(t0 - m), p1 = exp2f(t1 - m), p2 = exp2f(t2 - m);
        ps[i * 132 + lane] = p0; ps[i * 132 + 64 + lane] = p1; if (lane < 4) ps[i * 132 + 128 + lane] = p2;
        linv[i] = 1.0f / (wave_sum(p0 + p1 + p2) + exp2f(sink2 - m));
    }
    LDS_WAIT(); asm volatile("" ::: "memory");
    f32x4 o[4];
#pragma unroll
    for (int i = 0; i < 4; ++i) { const float pn = ps[i * 132 + 128 + kg]; o[i] = (f32x4){bflo(vn.x) * pn, bfhi(vn.x) * pn, bflo(vn.y) * pn, bfhi(vn.y) * pn}; }
    const float* vb = A->cache_v + ((size_t)(b * 128 + kg) * 2 + kh) * 64 + 4 * d4l;
#pragma unroll 1
    for (int c = 0; c < 2; ++c) {
        f32x4 vv[16];
#pragma unroll
        for (int j = 0; j < 16; ++j) vv[j] = *(const f32x4*)(vb + (size_t)(16 * c + j) * 4 * 128);
#pragma unroll
        for (int j = 0; j < 16; ++j)
#pragma unroll
            for (int i = 0; i < 4; ++i) { const float pj = ps[i * 132 + 64 * c + 4 * j + kg]; o[i] += vv[j] * pj; }
        asm volatile("" : "+v"(o[0]), "+v"(o[1]), "+v"(o[2]), "+v"(o[3]));
    }
    bf16* OAg = (bf16*)((unsigned char*)A->out + DO_OA);
#pragma unroll
    for (int i = 0; i < 4; ++i) {
#pragma unroll
        for (int e = 0; e < 4; ++e) { float t = o[i][e]; t += __shfl_xor(t, 16); t += __shfl_xor(t, 32); o[i][e] = t * linv[i]; }
        if (lane < 16) *(u32x2*)(OAg + (size_t)(NBATCH * SEQ + b * TS + i) * OAB_PITCH + head * 64 + 4 * d4l) = (u32x2){cvtpk(o[i][0], o[i][1]), cvtpk(o[i][2], o[i][3])};
    }
    LDS_WAIT(); asm volatile("" ::: "memory");
}
DI void sample_delta(KA A, int b, int h, int quarter, LAS float* wl, int lane, LAS float* coop, int nset) {
    const bf16* QKVB = (const bf16*)(A->ws + WS_QKVB);
    LAS float* qs = wl; LAS float* ks = wl + 512;
    const int dv = 32 * quarter + (lane >> 1), part = lane & 1;
    if (quarter == 0 && lane < 8) coop[((nset + 1) % 3) * 8 + lane] = 0.f;
    LAS float* cell = coop + (nset % 3) * 8;
    float zs[4];
#pragma unroll
    for (int t = 0; t < 4; ++t) zs[t] = bf2f(((const bf16*)(A->ws + WS_Z))[(size_t)(MP + b * TS + t) * 512 + h * 128 + dv]);
    f32x2 gb[4];
#pragma unroll
    for (int t = 0; t < 4; ++t) gb[t] = ((const f32x2*)(A->ws + WS_GB))[(size_t)(MP + b * TS + t) * 4 + h];
    float xw[5][7], ww[5][4];
#pragma unroll
    for (int cidx = 0; cidx < 5; ++cidx) {
        const int ch = cidx < 4 ? (cidx >> 1) * 512 + h * 128 + lane + 64 * (cidx & 1) : 1024 + h * 128 + dv;
#pragma unroll
        for (int i = 0; i < 3; ++i) xw[cidx][i] = A->state_conv[((size_t)b * 3 + i) * CONVD + ch];
#pragma unroll
        for (int t = 0; t < 4; ++t) xw[cidx][3 + t] = bf2f(QKVB[(size_t)(MP + b * TS + t) * CONVD + ch]);
#pragma unroll
        for (int i = 0; i < 4; ++i) ww[cidx][i] = A->conv_w[i * CONVD + ch];
    }
    float cv[5][4];
#pragma unroll
    for (int cidx = 0; cidx < 5; ++cidx)
#pragma unroll
        for (int t = 0; t < 4; ++t) cv[cidx][t] = siluf_(ww[cidx][0] * xw[cidx][t] + ww[cidx][1] * xw[cidx][t + 1] + ww[cidx][2] * xw[cidx][t + 2] + ww[cidx][3] * xw[cidx][t + 3]);
    __builtin_amdgcn_sched_barrier(0);
    float s[64];
    { const float* S0 = A->state_delta + ((size_t)(b * 4 + h) * 128 + 64 * part) * 128 + dv;
#pragma unroll
      for (int i = 0; i < 64; ++i) s[i] = S0[(size_t)i * 128]; }
    __builtin_amdgcn_sched_barrier(0);
#pragma unroll
    for (int grp = 0; grp < 2; ++grp) {
        LAS float* dst = grp == 0 ? qs : ks;
#pragma unroll
        for (int t = 0; t < 4; ++t) { const float c0 = cv[2 * grp][t], c1 = cv[2 * grp + 1][t];
            const float rn = rsqrtf(wave_sum(c0 * c0 + c1 * c1) + EPS) * (grp == 0 ? 0.08838834764831845f : 1.0f);
            dst[t * 128 + lane] = c0 * rn; dst[t * 128 + 64 + lane] = c1 * rn; }
    }
    LDS_WAIT(); asm volatile("" ::: "memory");
    bf16* OBR = (bf16*)((unsigned char*)A->out + DO_OB) + (size_t)(NBATCH * SEQ + b * TS) * OAB_PITCH + h * 128 + dv;
    float ov[4];
#pragma unroll
    for (int t = 0; t < 4; ++t) {
        const float eg = __expf(gb[t][0]);
        const LAS float* kt = ks + t * 128 + 64 * part; const LAS float* qt = qs + t * 128 + 64 * part;
        float ksum = 0.f;
#pragma unroll
        for (int j = 0; j < 16; ++j) { if ((j & 3) == 0) __builtin_amdgcn_sched_barrier(0);
            const f32x4 kk = *(const LAS f32x4*)(kt + 4 * j);
            s[4 * j] *= eg; s[4 * j + 1] *= eg; s[4 * j + 2] *= eg; s[4 * j + 3] *= eg;
            ksum += (s[4 * j] * kk[0] + s[4 * j + 1] * kk[1]) + (s[4 * j + 2] * kk[2] + s[4 * j + 3] * kk[3]); }
        ksum += __shfl_xor(ksum, 1);
        const float u = gb[t][1] * (cv[4][t] - ksum);
        float osum = 0.f;
#pragma unroll
        for (int j = 0; j < 16; ++j) { if ((j & 3) == 0) __builtin_amdgcn_sched_barrier(0);
            const f32x4 kk = *(const LAS f32x4*)(kt + 4 * j), qq = *(const LAS f32x4*)(qt + 4 * j);
            s[4 * j] += kk[0] * u; s[4 * j + 1] += kk[1] * u; s[4 * j + 2] += kk[2] * u; s[4 * j + 3] += kk[3] * u;
            osum += (s[4 * j] * qq[0] + s[4 * j + 1] * qq[1]) + (s[4 * j + 2] * qq[2] + s[4 * j + 3] * qq[3]); }
        osum += __shfl_xor(osum, 1);
        ov[t] = osum;
    }
    {
        float sq[4];
#pragma unroll
        for (int t = 0; t < 4; ++t) sq[t] = wave_sum(part == 0 ? ov[t] * ov[t] : 0.f);
        if (lane == 0) {
#pragma unroll
            for (int t = 0; t < 4; ++t) (void)__hip_atomic_fetch_add(cell + t, sq[t], __ATOMIC_RELAXED, __HIP_MEMORY_SCOPE_WORKGROUP);
            LDS_WAIT();
            (void)__hip_atomic_fetch_add((LAS unsigned*)(cell + 4), 1u, __ATOMIC_RELAXED, __HIP_MEMORY_SCOPE_WORKGROUP);
        }
        { unsigned spins = 0; while (*(volatile LAS unsigned*)(cell + 4) < 4u && ++spins < (1u << 22)) __builtin_amdgcn_s_sleep(1); }
        asm volatile("" ::: "memory");
#pragma unroll
        for (int t = 0; t < 4; ++t) { const float rstd = rsqrtf(*(volatile LAS float*)(cell + t) * (1.0f / 128.0f) + EPS);
            if (part == 0) OBR[(size_t)t * OAB_PITCH] = f2bf(ov[t] * rstd * zs[t]); }
    }
    { float* So = A->out + O_DS + ((size_t)(b * 4 + h) * 128 + 64 * part) * 128 + dv;
#pragma unroll
      for (int i = 0; i < 64; ++i) So[(size_t)i * 128] = s[i]; }
    LDS_WAIT(); asm volatile("" ::: "memory");
}
DI void norm_rows(const u32x4 (&ow)[4], const u32x4 (&zw)[4], bf16* op) {
#pragma unroll
    for (int q = 0; q < 4; ++q) {
        const f32x4 a = {bflo(ow[q].x), bfhi(ow[q].x), bflo(ow[q].y), bfhi(ow[q].y)}, cc = {bflo(ow[q].z), bfhi(ow[q].z), bflo(ow[q].w), bfhi(ow[q].w)};
        float ss = (a[0] * a[0] + a[1] * a[1]) + (a[2] * a[2] + a[3] * a[3]) + (cc[0] * cc[0] + cc[1] * cc[1]) + (cc[2] * cc[2] + cc[3] * cc[3]);
        ss += __shfl_xor(ss, 1); ss += __shfl_xor(ss, 2); ss += __shfl_xor(ss, 4); ss += __shfl_xor(ss, 8);
        const float rstd = rsqrtf(ss * (1.0f / 128.0f) + EPS);
        f32x4 y0, y1;
        y0[0] = a[0] * rstd * bflo(zw[q].x); y0[1] = a[1] * rstd * bfhi(zw[q].x); y0[2] = a[2] * rstd * bflo(zw[q].y); y0[3] = a[3] * rstd * bfhi(zw[q].y);
        y1[0] = cc[0] * rstd * bflo(zw[q].z); y1[1] = cc[1] * rstd * bfhi(zw[q].z); y1[2] = cc[2] * rstd * bflo(zw[q].w); y1[3] = cc[3] * rstd * bfhi(zw[q].w);
        *(u32x4*)(op + (size_t)16 * q * OAB_PITCH) = pack8f(y0, y1);
    }
}
DI void norm_items(KA A, int v, int NV, unsigned ep, int lane) {
    const int nrowl = lane >> 4, ndv0 = 8 * (lane & 15);
    constexpr int NI = (CHUNKS_P - 2) * N_PROMPT_SEQ * 4;
#define NI_DECODE(idx, op, zp, pg, need) \
        const int wq_##op = (idx) & 3, s_##op = ((idx) >> 2) & 31, c_##op = ((idx) >> 7) + 1, b_##op = s_##op >> 2, h_##op = s_##op & 3; \
        bf16* op = (bf16*)((unsigned char*)A->out + DO_OB) + (size_t)(b_##op * SEQ + 64 * (c_##op - 1) + 4 * wq_##op + nrowl) * OAB_PITCH + h_##op * 128 + ndv0; \
        const bf16* zp = (const bf16*)(A->ws + WS_Z) + (size_t)(b_##op * TP + NMETA + 64 * (c_##op - 1) + 4 * wq_##op + nrowl) * 512 + h_##op * 128 + ndv0; \
        gu32* pg = scan_progress(A, s_##op, wq_##op); const unsigned need = ep * 256u + (unsigned)c_##op;
#pragma unroll 1
    for (int idx = v; idx < NI; ) {
        NI_DECODE(idx, op, zp, pg, need)
        { unsigned spins = 0;
          for (;;) { const unsigned cur = __hip_atomic_load(pg, __ATOMIC_RELAXED, __HIP_MEMORY_SCOPE_AGENT); if (cur >= need || ++spins > (1u << 18)) break;
              const unsigned far = (cur < ep * 256u ? need - ep * 256u : need - cur);
              if (far <= 1u) __builtin_amdgcn_s_sleep(24); else for (unsigned i = 0; i < (far > 6u ? 6u : far) - 1u; ++i) __builtin_amdgcn_s_sleep(100); }
          asm volatile("" ::: "memory"); }
        const int idx2 = idx + NV; bool two = false;
        if (idx2 < NI) { NI_DECODE(idx2, op2, zp2, pg2, need2) two = __hip_atomic_load(pg2, __ATOMIC_RELAXED, __HIP_MEMORY_SCOPE_AGENT) >= need2; asm volatile("" ::: "memory");
            if (two) {
                u32x4 ow[4], zw[4], ow2[4], zw2[4];
#pragma unroll
                for (int q = 0; q < 4; ++q) { zw[q] = *(const u32x4*)(zp + (size_t)16 * q * 512); zw2[q] = *(const u32x4*)(zp2 + (size_t)16 * q * 512); }
                asm volatile("global_load_dwordx4 %0, %8, off sc1\n\tglobal_load_dwordx4 %1, %9, off sc1\n\tglobal_load_dwordx4 %2, %10, off sc1\n\tglobal_load_dwordx4 %3, %11, off sc1\n\t"
                             "global_load_dwordx4 %4, %12, off sc1\n\tglobal_load_dwordx4 %5, %13, off sc1\n\tglobal_load_dwordx4 %6, %14, off sc1\n\tglobal_load_dwordx4 %7, %15, off sc1\n\ts_waitcnt vmcnt(0)"
                             : "=&v"(ow[0]), "=&v"(ow[1]), "=&v"(ow[2]), "=&v"(ow[3]), "=&v"(ow2[0]), "=&v"(ow2[1]), "=&v"(ow2[2]), "=&v"(ow2[3])
                             : "v"(op), "v"(op + (size_t)16 * OAB_PITCH), "v"(op + (size_t)32 * OAB_PITCH), "v"(op + (size_t)48 * OAB_PITCH),
                               "v"(op2), "v"(op2 + (size_t)16 * OAB_PITCH), "v"(op2 + (size_t)32 * OAB_PITCH), "v"(op2 + (size_t)48 * OAB_PITCH) : "memory");
                norm_rows(ow, zw, op); norm_rows(ow2, zw2, op2);
                idx += 2 * NV; continue;
            } }
        u32x4 ow[4], zw[4];
#pragma unroll
        for (int q = 0; q < 4; ++q) zw[q] = *(const u32x4*)(zp + (size_t)16 * q * 512);
        asm volatile("global_load_dwordx4 %0, %4, off sc1\n\tglobal_load_dwordx4 %1, %5, off sc1\n\tglobal_load_dwordx4 %2, %6, off sc1\n\tglobal_load_dwordx4 %3, %7, off sc1\n\ts_waitcnt vmcnt(0)"
                     : "=&v"(ow[0]), "=&v"(ow[1]), "=&v"(ow[2]), "=&v"(ow[3]) : "v"(op), "v"(op + (size_t)16 * OAB_PITCH), "v"(op + (size_t)32 * OAB_PITCH), "v"(op + (size_t)48 * OAB_PITCH) : "memory");
        norm_rows(ow, zw, op);
        idx += NV;
    }
#undef NI_DECODE
}
constexpr int NINV_WG = 24;
DI void p23_mixers(KA A, LAS unsigned char* lds, const XcdBarrier& dbg_bar, unsigned ep, int wave_s, int pmode = 0) {
    const int wave = __builtin_amdgcn_readfirstlane(tid_opaque(wave_s) >> 6), G = gridDim.x, wg = blockIdx.x;
    const int NSCAN = N_PROMPT_SEQ, NP = G - NSCAN - NINV_WG;
    LAS float* wl = (LAS float*)(lds + 98304 + wave * 4096);
    if (wg < NSCAN) { if (!(pmode & 2)) scan_prompt_wg(A, wg, lds, ep, wave_s); }
    else if (wg < NSCAN + NINV_WG) {
        const int wv = (wg - NSCAN) * NWAVES + wave, NWV = NINV_WG * NWAVES;
#pragma unroll 1
        for (int m = wv; m < N_ITEMS; m += NWV) {
            const int item = order_item(m), p = m % NP, k = m / NP;
            const float gcl = wait_item(item_flag1(A, item), ep);
            const float* ats = (const float*)((const unsigned char*)A->out + DO_ATS + ((size_t)p * 8 + (k & 7)) * ATS_ITEM);
            if (pmode & 16) { if ((tid_opaque(wave_s) & 63) == 0) __hip_atomic_store(item_granule(A, item), ((unsigned long long)ep << 32) | (unsigned long long)__float_as_uint(gcl), __ATOMIC_RELAXED, __HIP_MEMORY_SCOPE_AGENT); }
            else prep_stage2(A, item, gcl, ats, (LAS float*)(lds + wave * 16384), ep);
        }
        if (!(pmode & (1 | 64 | 256))) norm_items(A, (wg - NSCAN) * NWAVES + wave, (G - NSCAN) * NWAVES, ep, tid_opaque(wave_s) & 63);
    } else {
        const int p = wg - NSCAN - NINV_WG;
        if (pmode & 32) {
            for (int m = p * NTHREADS + tid_opaque(wave_s); m < N_ITEMS; m += NP * NTHREADS) { gu64* f = item_flag1(A, order_item(m));
                const unsigned long long o = __hip_atomic_load(f, __ATOMIC_RELAXED, __HIP_MEMORY_SCOPE_AGENT);
                __hip_atomic_store(f, ((unsigned long long)ep << 32) | (o & 0xffffffffull), __ATOMIC_RELAXED, __HIP_MEMORY_SCOPE_AGENT); }
        } else {
            const int ntot = p < N_ITEMS ? (N_ITEMS - 1 - p) / NP + 1 : 0;
            S1Pre P;
            if (ntot > 0) stage1_issue(A, order_item(p), P, wave_s);
            int prev = -1;
#pragma unroll 1
            for (int k = 0; k < ntot; ++k) {
                const int m = p + NP * k, item = order_item(m), nxt = k + 1 < ntot ? order_item(m + NP) : N_ITEMS;
                float* ats = (float*)((unsigned char*)A->out + DO_ATS + ((size_t)p * 8 + (k & 7)) * ATS_ITEM);
                prep_stage1(A, item, nxt, prev, k >= 8 ? order_item(m - 8 * NP) : -1, k & 1, ats, P, lds, ep, wave_s, pmode);
                prev = item;
            }
            asm volatile("s_waitcnt vmcnt(0)" ::: "memory"); __syncthreads();
            if (prev >= 0 && tid_opaque(wave_s) == 0) __hip_atomic_store(item_flag1(A, prev), ((unsigned long long)ep << 32) | (unsigned long long)__float_as_uint(((const LAS float*)(lds + LDS_GCL))[(ntot - 1) & 1]), __ATOMIC_RELAXED, __HIP_MEMORY_SCOPE_AGENT);
        }
        if (pmode & 1) return;
        if (!(pmode & 128)) {
            constexpr int NU = NBATCH * NKV * 32;
            const int R = NU / NP, extra = NU - R * NP, nlong = N_ITEMS % NP, first = nlong < NP - extra ? nlong : NP - extra;
            for (int rnd = 0; rnd < R; ++rnd) attn_unit(A, rnd * NP + p, lds, wave_s);
            if (p >= first && p < first + extra) attn_unit(A, R * NP + (p - first), lds, wave_s);
        }
    }
    if (pmode & (1 | 64)) return;
    if (wg < NSCAN + NINV_WG) return;
    { const int p = wg - NSCAN - NINV_WG, worker = p * NWAVES + wave, NW = NP * NWAVES;
      LAS float* coop = (LAS float*)(lds + LDS_MISC + 512) + (wave >> 2) * 24;
      { const int t_ = tid_opaque(wave_s); if (t_ < 48) ((LAS float*)(lds + LDS_MISC + 512))[t_] = 0.f; }
      LDS_BARRIER();
      int nset = 0;
      for (int it = worker; it < SBATCH * NHB * 4 + SBATCH * NHA; it += NW) {
        int ln = tid_opaque(wave_s) & 63;
        if (it < SBATCH * NHB * 4) { sample_delta(A, it >> 4, (it >> 2) & 3, it & 3, wl, ln, coop, nset); ++nset; }
        else { const int q = it - SBATCH * NHB * 4; sample_attn(A, q >> 3, q & 7, wl, ln); }
      } }
    if (!(pmode & 256)) norm_items(A, (wg - NSCAN) * NWAVES + wave, (G - NSCAN) * NWAVES, ep, tid_opaque(wave_s) & 63);
}

DI void p3b_gated_norm(KA A, int wave_s) {
    const int tid = tid_opaque(wave_s), lane = tid & 63, wave = tid >> 6, gw = blockIdx.x * NWAVES + wave, NGW = gridDim.x * NWAVES;
    const int head = lane >> 4, dv0 = 8 * (lane & 15);
    bf16* OBg = (bf16*)((unsigned char*)A->out + DO_OB); const bf16* Zg = (const bf16*)(A->ws + WS_Z);
    for (int crow = NBATCH * SEQ + gw; crow < MC; crow += NGW) {
        const u32x4 ow = *(const u32x4*)(OBg + (size_t)crow * OAB_PITCH + head * 128 + dv0);
        const f32x4 a = {bflo(ow.x), bfhi(ow.x), bflo(ow.y), bfhi(ow.y)}, c = {bflo(ow.z), bfhi(ow.z), bflo(ow.w), bfhi(ow.w)};
        float ss = (a[0] * a[0] + a[1] * a[1]) + (a[2] * a[2] + a[3] * a[3]) + (c[0] * c[0] + c[1] * c[1]) + (c[2] * c[2] + c[3] * c[3]);
        ss += __shfl_xor(ss, 1); ss += __shfl_xor(ss, 2); ss += __shfl_xor(ss, 4); ss += __shfl_xor(ss, 8);
        const float rstd = rsqrtf(ss * (1.0f / 128.0f) + EPS);
        const u32x4 zw = *(const u32x4*)(Zg + (size_t)pg8::crow_to_urow(crow) * 512 + head * 128 + dv0);
        f32x4 y0, y1;
        y0[0] = a[0] * rstd * bflo(zw.x); y0[1] = a[1] * rstd * bfhi(zw.x); y0[2] = a[2] * rstd * bflo(zw.y); y0[3] = a[3] * rstd * bfhi(zw.y);
        y1[0] = c[0] * rstd * bflo(zw.z); y1[1] = c[1] * rstd * bfhi(zw.z); y1[2] = c[2] * rstd * bflo(zw.w); y1[3] = c[3] * rstd * bfhi(zw.w);
        *(u32x4*)(OBg + (size_t)crow * OAB_PITCH + head * 128 + dv0) = pack8f(y0, y1);
    }
}
DI void p8_final_norm(KA A, int wave_s) {
    const int tid = tid_opaque(wave_s), lane = tid & 63, wave = tid >> 6, gw = blockIdx.x * NWAVES + wave, NGW = gridDim.x * NWAVES;
    f32x4 nf[4];
#pragma unroll
    for (int j = 0; j < 4; ++j) nf[j] = ((const f32x4*)A->norm_final)[lane + 64 * j];
    const bf16* H2 = (const bf16*)(A->ws + WS_MB);
    for (int crow = gw; crow < MC; crow += NGW) {
        const u32x2* hrow = (const u32x2*)(H2 + (size_t)crow * D);
        f32x4* row = (f32x4*)(A->out + (size_t)crow * D);
        f32x4 v[4]; float ss = 0.f;
#pragma unroll
        for (int j = 0; j < 4; ++j) { const u32x2 hw = hrow[lane + 64 * j]; v[j] = (f32x4){bflo(hw.x), bfhi(hw.x), bflo(hw.y), bfhi(hw.y)};
            ss += (v[j][0] * v[j][0] + v[j][1] * v[j][1]) + (v[j][2] * v[j][2] + v[j][3] * v[j][3]); }
        const float rstd = rsqrtf(wave_sum(ss) * (1.0f / D) + EPS);
#pragma unroll
        for (int j = 0; j < 4; ++j) row[lane + 64 * j] = v[j] * rstd * nf[j];
    }
}
__global__ void __launch_bounds__(NTHREADS, 2) hybrid_fwd(Args Aval) {
    extern __shared__ __attribute__((aligned(16))) unsigned char lds_raw[];
    LAS unsigned char* lds = (LAS unsigned char*)lds_raw;
    const int tid = threadIdx.x;
    const int wave_s = __builtin_amdgcn_readfirstlane(tid >> 6);
    int lo, hi; { KA A0 = kargs(); lo = A0->ph_lo; hi = A0->ph_hi; }
#if MK_N_LAUNCHES == 1
#if MK_BARRIER == 1
    volatile LAS unsigned* MISC = (volatile LAS unsigned*)(lds + LDS_MISC);
    if (tid < 64) MISC[tid] = 0u;
    __syncthreads();
    XcdBarrier bar; { KA A0 = kargs(); bar = xcd_barrier_post((unsigned*)(A0->ws + WS_CTL) + 4096, MISC + 8, wave_s); }
#define GRID_BAR() xcd_barrier(bar)
#else
    cg::grid_group grid = cg::this_grid();
#define GRID_BAR() grid.sync()
#endif
#else
#define GRID_BAR() do {} while (0)
#endif
#ifndef PH_MASK
#define PH_MASK 0x1ff
#endif
#define IN(k) (((PH_MASK >> (k)) & 1) && lo <= (k) && (k) < hi)
#ifndef PROBE_REP
#define PROBE_REP -1
#endif
#define NREP(k) (PROBE_REP == (k) ? 2 : 1)
#define SEAM(k) do { if (IN(k) && IN((k) + 1)) GRID_BAR(); } while (0)
    const int G = gridDim.x, wgid = blockIdx.x;
#if PROBE_REP == 0
    if (IN(0)) { KA A = kargs(); p0_prologue(A, lds, wave_s); __syncthreads(); }
#endif
    if (IN(0)) { KA A = kargs();
        { f32x4* z = (f32x4*)(A->ws + WS_SCR);
          for (int i = wgid * NTHREADS + tid_opaque(wave_s); i < (int)(SCR_BYTES / 16); i += G * NTHREADS) z[i] = (f32x4){0.f, 0.f, 0.f, 0.f}; }
        p0_prologue(A, lds, wave_s); } SEAM(0);
    if (IN(1)) for (int rep = 0; rep < NREP(1); ++rep) { KA A = kargs(); unsigned char* ws = A->ws;
        pg8::Gemm g{(const bf16*)(ws + WS_XN), (const bf16*)(ws + WS_WIN), MUP, NIN, D}; pg8::StaticOrder S; S.init(MUP, NIN, G, wgid);
        pg8::EpiInProj E{(bf16*)(ws + WS_QA), (bf16*)(ws + WS_KV), (bf16*)(ws + WS_QKVB), (bf16*)(ws + WS_Z), (bf16*)(ws + WS_G),
                         (const float*)(ws + WS_ROPE), (const float*)(ws + WS_ROPE) + (TP + TS) * 32, A->out, A->gdn_norm};
        pg8::gemm_phase<pg8::EpiInProj, pg8::StaticOrder, true, true>(lds, g, S, E, wave_s);
    } SEAM(1);
#ifndef PROBE_MODE
#define PROBE_MODE 0
#endif
#if PROBE_REP == 2
    if (IN(2)) { KA A = kargs(); p23_mixers(A, lds, bar, 1u, wave_s); GRID_BAR(); }
    if (IN(2)) { KA A = kargs(); p23_mixers(A, lds, bar, 2u, wave_s, PROBE_MODE); } SEAM(2);
#else
    if (IN(2)) { KA A = kargs(); p23_mixers(A, lds, bar, 1u, wave_s); } SEAM(2);
#endif
    if (IN(4)) for (int rep = 0; rep < NREP(4); ++rep) { KA A = kargs(); unsigned char* ws = A->ws;
        const bf16* OABp = (const bf16*)((unsigned char*)A->out + DO_OA); const bf16* Wm = (const bf16*)(ws + WS_WOA);
        { pg8::Gemm g{OABp, Wm, MC, D, 512, 1024}; pg8::StaticOrder S; S.init(MC, D, G, wgid); S.lim = (S.nwg / G) * G;
          pg8::EpiMerge<false> E{(bf16*)(ws + WS_MB), (const bf16*)(ws + WS_G), 0};
          pg8::gemm_phase<pg8::EpiMerge<false>, pg8::StaticOrder, true, true>(lds, g, S, E, wave_s); }
        asm volatile("s_waitcnt vmcnt(0)" ::: "memory"); __syncthreads();
        { pg8::Gemm g{OABp + 512, Wm + 512, MC, D, 512, 1024}; pg8::StaticOrder S; S.init(MC, D, G, wgid); S.lim = (S.nwg / G) * G;
          pg8::EpiMerge<true> E{(bf16*)(ws + WS_MB), (const bf16*)(ws + WS_G), 1024};
          pg8::gemm_phase<pg8::EpiMerge<true>, pg8::StaticOrder, true, true>(lds, g, S, E, wave_s); }
        { const int nstr = (MC / 256) * 4 - ((MC / 256) * 4 / G) * G;
          if (wgid < nstr * 4) { const int t = wgid >> 2, sl = wgid & 3, koff = sl * 256;
            pg8::Gemm g{OABp + koff, Wm + koff, MC, D, 256, 1024};
            pg8::SliceOrder S; S.init_slice(MC, D, G, ((MC / 256) * 4 / G) * G, t);
            pg8::EpiSplitP<pg8::EpiStoreMB, true> E{pg8::EpiStoreMB{(bf16*)(ws + WS_MB)}, (float*)(ws + WS_QKVB) + (size_t)t * 4 * 65536, (unsigned*)(ws + WS_CTL + CTL_SPL) + t * 8, 4u, sl, (const bf16*)(ws + WS_G), (sl >> 1) ? 1024 : 0};
            pg8::gemm_phase<pg8::EpiSplitP<pg8::EpiStoreMB, true>, pg8::SliceOrder, true, true>(lds, g, S, E, wave_s); } }
    } SEAM(4);
    if (IN(5)) { KA A = kargs(); unsigned char* ws = A->ws;
        { pg8::Gemm g{(const bf16*)(ws + WS_MB), (const bf16*)(ws + WS_WOUT), MC, D, D}; pg8::StaticOrder S; S.init(MC, D, G, wgid); S.lim = (S.nwg / G) * G;
          pg8::EpiWout<true> E{A->x_prompt, A->x_sample, (bf16*)(ws + WS_HB1), (float*)(ws + WS_CTL + CTL_SS1)};
          pg8::gemm_phase<pg8::EpiWout<true>, pg8::StaticOrder, true, true>(lds, g, S, E, wave_s); }
        { const int nstr = (MC / 256) * 4 - ((MC / 256) * 4 / G) * G;
          if (wgid < nstr * 4) { const int t = wgid >> 2, koff = (wgid & 3) * 256;
            pg8::Gemm g{(const bf16*)(ws + WS_MB) + koff, (const bf16*)(ws + WS_WOUT) + koff, MC, D, 256, D};
            pg8::SliceOrder S; S.init_slice(MC, D, G, ((MC / 256) * 4 / G) * G, t);
            pg8::EpiSplitP<pg8::EpiWout<true>, false> E{pg8::EpiWout<true>{A->x_prompt, A->x_sample, (bf16*)(ws + WS_HB1), (float*)(ws + WS_CTL + CTL_SS1)}, (float*)(ws + WS_QKVB) + (size_t)t * 4 * 65536, (unsigned*)(ws + WS_CTL + CTL_SPL) + t * 8, 4u, (int)(wgid & 3), nullptr, 0};
            pg8::gemm_phase<pg8::EpiSplitP<pg8::EpiWout<true>, false>, pg8::SliceOrder, true, true>(lds, g, S, E, wave_s); } }
    } SEAM(5);
    if (IN(6)) for (int rep = 0; rep < NREP(6); ++rep) { KA A = kargs(); unsigned char* ws = A->ws;
        pg8::Gemm g{(const bf16*)(ws + WS_HB1), (const bf16*)(ws + WS_WGU), MC, 2 * DFF, D}; pg8::StaticOrder S; S.init(MC, 2 * DFF, G, wgid);
        pg8::EpiGateUp E{(bf16*)(ws + WS_ACT), (const float*)(ws + WS_CTL + CTL_SS1)};
        pg8::gemm_phase<pg8::EpiGateUp, pg8::StaticOrder, true, true>(lds, g, S, E, wave_s);
    } SEAM(6);
    if (IN(7)) for (int rep = 0; rep < NREP(7); ++rep) { KA A = kargs(); unsigned char* ws = A->ws;
        { pg8::Gemm g{(const bf16*)(ws + WS_ACT), (const bf16*)(ws + WS_WD), MC, D, DFF}; pg8::StaticOrder S; S.init(MC, D, G, wgid); S.lim = (S.nwg / G) * G;
          pg8::EpiDown<false> E{(const bf16*)(ws + WS_HB1), (bf16*)(ws + WS_MB)};
          pg8::gemm_phase<pg8::EpiDown<false>, pg8::StaticOrder, true, true>(lds, g, S, E, wave_s); }
        { const int nstr = (MC / 256) * 4 - ((MC / 256) * 4 / G) * G;
          if (wgid < nstr * 11) { const int t = wgid / 11, koff = (wgid % 11) * 256;
            pg8::Gemm g{(const bf16*)(ws + WS_ACT) + koff, (const bf16*)(ws + WS_WD) + koff, MC, D, 256, DFF};
            pg8::SliceOrder S; S.init_slice(MC, D, G, ((MC / 256) * 4 / G) * G, t);
            pg8::EpiSplit<pg8::EpiDown<false>, false> E{pg8::EpiDown<false>{(const bf16*)(ws + WS_HB1), (bf16*)(ws + WS_MB)}, (float*)(ws + WS_SCR) + (size_t)t * 65536, (unsigned*)(ws + WS_CTL + CTL_SPL) + t * 8, 11u, nullptr, 0};
            pg8::gemm_phase<pg8::EpiSplit<pg8::EpiDown<false>, false>, pg8::SliceOrder, true, true>(lds, g, S, E, wave_s); } }
    } SEAM(7);
    if (IN(8)) { KA A = kargs(); p8_final_norm(A, wave_s); }
#undef IN
#undef SEAM
}

extern "C" void kernel_launch(void* const* d_in, const int* in_sizes, int n_in, void* d_out, int out_size, void* d_ws, size_t ws_size, hipStream_t stream) {
    static int grid = 0;
    if (grid == 0) {
        if (n_in != 22 || out_size != (int)O_END || ws_size < WS_END) { fprintf(stderr, "kernel_launch: unexpected problem (n_in %d, out %d, ws %zu)\n", n_in, out_size, ws_size); grid = -1; return; }
        int dev = 0, cus = 0, per_cu = 0;
        if (hipGetDevice(&dev) != hipSuccess || hipDeviceGetAttribute(&cus, hipDeviceAttributeMultiprocessorCount, dev) != hipSuccess) { grid = -1; return; }
        if (hipFuncSetAttribute((const void*)hybrid_fwd, hipFuncAttributeMaxDynamicSharedMemorySize, LDS_BYTES) != hipSuccess) { fprintf(stderr, "kernel_launch: hipFuncSetAttribute failed\n"); grid = -1; return; }
        if (hipOccupancyMaxActiveBlocksPerMultiprocessor(&per_cu, (const void*)hybrid_fwd, NTHREADS, LDS_BYTES) != hipSuccess || per_cu < 1) { fprintf(stderr, "kernel_launch: occupancy query says %d\n", per_cu); per_cu = 1; }
        (void)hipGetLastError();
        grid = cus;
        if (grid > 256) grid = 256;
    }
    if (grid < 0) return;
    (void)hipMemsetAsync((char*)d_ws + WS_CTL, 0, CTL_BYTES, stream);
    Args a{};
    const float** ap = (const float**)&a;
    for (int i = 0; i < 22; ++i) ap[i] = (const float*)d_in[i];
    a.out = (float*)d_out; a.ws = (unsigned char*)d_ws;
#if MK_N_LAUNCHES == 1
    a.ph_lo = 0; a.ph_hi = N_PHASES;
#if MK_BARRIER == 1
    hipLaunchKernelGGL(hybrid_fwd, dim3(grid), dim3(NTHREADS), LDS_BYTES, stream, a);
#else
    void* args[] = {&a};
    hipError_t e = hipLaunchCooperativeKernel((const void*)hybrid_fwd, dim3(grid), dim3(NTHREADS), args, LDS_BYTES, stream);
    if (e != hipSuccess) fprintf(stderr, "cooperative launch failed: %s (grid %d)\n", hipGetErrorString(e), grid);
#endif
#else
    for (int p = 0; p < N_PHASES; ++p) { a.ph_lo = p; a.ph_hi = p + 1; hipLaunchKernelGGL(hybrid_fwd, dim3(grid), dim3(NTHREADS), LDS_BYTES, stream, a); }
#endif
}
```
